# Optimizing an MI355X kernel written in HIP

```python
import jax, jax.numpy as jnp
from jax import lax
import numpy as np

D_MODEL = 2048
BATCH = 1
SEQ = 8192
DEPTH = 1

MLA_HEADS = 16
MLA_Q_RANK = 512
MLA_KV_RANK = 512
MLA_NOPE = 128
MLA_ROPE = 64
MLA_V = 128
MLA_QK_DIM = MLA_NOPE + MLA_ROPE
ROPE_THETA = 10000.0
FOX_HEADS = 16
FOX_HEAD_DIM = 128
FOX_FORGET_BIAS = 2.0
MLA_WIDTH = MLA_HEADS * MLA_V
FOX_WIDTH = FOX_HEADS * FOX_HEAD_DIM
MIX_WIDTH = MLA_WIDTH + FOX_WIDTH
Q_BLOCK = 128
PEER_HEADS = 8
PEER_QUERY_DIM = 256
PEER_HALF = PEER_QUERY_DIM // 2
PEER_N_KEYS = 128
PEER_N_EXPERTS = PEER_N_KEYS * PEER_N_KEYS
PEER_TOPK = 16
PEER_BLOCK = 128
NORM_EPS = 1e-6

IN_SPLIT_SIZES = (MLA_Q_RANK, MLA_KV_RANK, MLA_ROPE,
                  FOX_WIDTH, FOX_WIDTH, FOX_WIDTH, FOX_HEADS,
                  MLA_WIDTH, FOX_WIDTH)
IN_WIDTH = sum(IN_SPLIT_SIZES)
IN_SPLIT_POINTS = tuple(sum(IN_SPLIT_SIZES[:i + 1]) for i in range(len(IN_SPLIT_SIZES) - 1))

kernel_name = "hybrid_mla_fox_peer_block"


def rms_norm(x, g):
    xf = x.astype(jnp.float32)
    y = xf * lax.rsqrt(jnp.mean(xf * xf, axis=-1, keepdims=True) + NORM_EPS)
    return (y * g.astype(jnp.float32)).astype(x.dtype)


def rope(x, positions):
    half = x.shape[-1] // 2
    inv_freq = ROPE_THETA ** (-jnp.arange(half, dtype=jnp.float32) / half)
    ang = positions.astype(jnp.float32)[:, :, None, None] * inv_freq
    cos, sin = jnp.cos(ang), jnp.sin(ang)
    xf = x.astype(jnp.float32)
    x1, x2 = xf[..., :half], xf[..., half:]
    return jnp.concatenate([x1 * cos - x2 * sin, x1 * sin + x2 * cos], axis=-1).astype(x.dtype)


def causal_block_attention(q, k, v, log_forget_cum=None):
    B, S, H, Dk = q.shape
    Dv = v.shape[-1]
    nb = S // Q_BLOCK
    scale = Dk ** -0.5
    kf = k.astype(jnp.float32)
    vf = v.astype(jnp.float32)
    key_pos = jnp.arange(S, dtype=jnp.int32)
    q_blocks = q.reshape(B, nb, Q_BLOCK, H, Dk).swapaxes(0, 1)
    starts = jnp.arange(nb, dtype=jnp.int32) * Q_BLOCK
    if log_forget_cum is None:
        xs = (q_blocks, starts)
    else:
        cum_keys = log_forget_cum.astype(jnp.float32).transpose(0, 2, 1)
        cum_blocks = log_forget_cum.astype(jnp.float32).reshape(B, nb, Q_BLOCK, H).swapaxes(0, 1)
        xs = (q_blocks, starts, cum_blocks)

    def one_block(args):
        q_blk, start = args[0], args[1]
        s = jnp.einsum('bqhd,bkhd->bhqk', q_blk.astype(jnp.float32), kf) * scale
        if log_forget_cum is not None:
            cum_q = args[2].transpose(0, 2, 1)
            s = s + cum_q[..., :, None] - cum_keys[:, :, None, :]
        q_pos = start + jnp.arange(Q_BLOCK, dtype=jnp.int32)
        mask = key_pos[None, :] <= q_pos[:, None]
        s = jnp.where(mask, s, -jnp.inf)
        p = jax.nn.softmax(s, axis=-1)
        return jnp.einsum('bhqk,bkhd->bqhd', p, vf).astype(v.dtype)

    out = lax.map(one_block, xs)
    return out.swapaxes(0, 1).reshape(B, S, H, Dv)


def peer_ffn(h, w_q, sub_keys, u, v):
    B, S, D = h.shape
    T = B * S
    ht = h.reshape(T, D)
    q = jnp.einsum('td,de->te', ht, w_q).reshape(T, PEER_HEADS, 2, PEER_HALF).astype(jnp.float32)
    scores = jnp.einsum('thcd,hcnd->thcn', q, sub_keys.astype(jnp.float32))
    s1, i1 = lax.top_k(scores[:, :, 0], PEER_TOPK)
    s2, i2 = lax.top_k(scores[:, :, 1], PEER_TOPK)
    cand_scores = (s1[..., :, None] + s2[..., None, :]).reshape(T, PEER_HEADS, PEER_TOPK * PEER_TOPK)
    cand_idx = (i1[..., :, None] * PEER_N_KEYS + i2[..., None, :]).reshape(T, PEER_HEADS, PEER_TOPK * PEER_TOPK)
    top_scores, top_pos = lax.top_k(cand_scores, PEER_TOPK)
    experts = jnp.take_along_axis(cand_idx, top_pos, axis=-1)
    gates = jax.nn.softmax(top_scores, axis=-1)

    nb = T // PEER_BLOCK
    xs = (ht.reshape(nb, PEER_BLOCK, D),
          experts.reshape(nb, PEER_BLOCK, PEER_HEADS, PEER_TOPK),
          gates.reshape(nb, PEER_BLOCK, PEER_HEADS, PEER_TOPK))

    def apply_block(args):
        xb, eb, gb = args
        ub = u[eb].astype(jnp.float32)
        a = jnp.einsum('td,thkd->thk', xb.astype(jnp.float32), ub)
        w = gb * jax.nn.gelu(a, approximate=False)
        vb = v[eb].astype(jnp.float32)
        return jnp.einsum('thk,thkd->td', w, vb).astype(h.dtype)

    out = lax.map(apply_block, xs)
    return out.reshape(B, S, D)


def setup_inputs(seed: int = 0) -> dict:
    key = jax.random.key(seed)
    ks = jax.random.split(key, 24)
    f32 = jnp.float32

    def normal(k, shape, scale):
        return jax.random.normal(k, shape, f32) * scale

    def gain(k, shape):
        return 1.0 + 0.02 * jax.random.normal(k, shape, f32)

    L = DEPTH
    return {
        "x": jax.random.normal(ks[0], (BATCH, SEQ, D_MODEL), f32),
        "positions": jnp.broadcast_to(jnp.arange(SEQ, dtype=jnp.int32)[None, :], (BATCH, SEQ)),
        "mix_norm_g": gain(ks[1], (L, D_MODEL)),
        "w_in": normal(ks[2], (L, D_MODEL, IN_WIDTH), D_MODEL ** -0.5),
        "b_forget": FOX_FORGET_BIAS + 0.1 * jax.random.normal(ks[3], (L, FOX_HEADS), f32),
        "b_gate": normal(ks[4], (L, MIX_WIDTH), 0.02),
        "mla_q_latent_g": gain(ks[5], (L, MLA_Q_RANK)),
        "w_q_up": normal(ks[6], (L, MLA_Q_RANK, MLA_HEADS * MLA_QK_DIM), MLA_Q_RANK ** -0.5),
        "mla_kv_latent_g": gain(ks[7], (L, MLA_KV_RANK)),
        "w_kv_up": normal(ks[8], (L, MLA_KV_RANK, MLA_HEADS * (MLA_NOPE + MLA_V)), MLA_KV_RANK ** -0.5),
        "mla_q_norm_g": gain(ks[9], (L, MLA_QK_DIM)),
        "mla_k_norm_g": gain(ks[10], (L, MLA_QK_DIM)),
        "fox_q_norm_g": gain(ks[11], (L, FOX_HEAD_DIM)),
        "fox_k_norm_g": gain(ks[12], (L, FOX_HEAD_DIM)),
        "w_out": normal(ks[13], (L, MIX_WIDTH, D_MODEL), MIX_WIDTH ** -0.5),
        "ffn_norm_g": gain(ks[14], (L, D_MODEL)),
        "w_peer_q": normal(ks[15], (L, D_MODEL, PEER_HEADS * PEER_QUERY_DIM), D_MODEL ** -0.5),
        "peer_sub_keys": normal(ks[16], (L, PEER_HEADS, 2, PEER_N_KEYS, PEER_HALF), PEER_HALF ** -0.5),
        "peer_u": normal(ks[17], (L, PEER_N_EXPERTS, D_MODEL), D_MODEL ** -0.5),
        "peer_v": normal(ks[18], (L, PEER_N_EXPERTS, D_MODEL), PEER_HEADS ** -0.5),
    }


def reference(x, positions, mix_norm_g, w_in, b_forget, b_gate, mla_q_latent_g, w_q_up,
              mla_kv_latent_g, w_kv_up, mla_q_norm_g, mla_k_norm_g, fox_q_norm_g, fox_k_norm_g,
              w_out, ffn_norm_g, w_peer_q, peer_sub_keys, peer_u, peer_v):
    B, S, _ = x.shape
    for layer in range(DEPTH):
        h = rms_norm(x, mix_norm_g[layer])
        proj = jnp.einsum('bsd,de->bse', h, w_in[layer])
        (c_q, c_kv, k_pe, fq, fk, fv, f_logit, gate_a, gate_b) = jnp.split(proj, IN_SPLIT_POINTS, axis=-1)

        q_a = jnp.einsum('bsr,re->bse', rms_norm(c_q, mla_q_latent_g[layer]), w_q_up[layer])
        q_a = q_a.reshape(B, S, MLA_HEADS, MLA_QK_DIM)
        kv = jnp.einsum('bsr,re->bse', rms_norm(c_kv, mla_kv_latent_g[layer]), w_kv_up[layer])
        kv = kv.reshape(B, S, MLA_HEADS, MLA_NOPE + MLA_V)
        k_nope, v_a = kv[..., :MLA_NOPE], kv[..., MLA_NOPE:]
        k_pe_h = jnp.broadcast_to(k_pe[:, :, None, :], (B, S, MLA_HEADS, MLA_ROPE))
        k_a = jnp.concatenate([k_nope, k_pe_h], axis=-1)
        q_a = rms_norm(q_a, mla_q_norm_g[layer])
        k_a = rms_norm(k_a, mla_k_norm_g[layer])
        q_a = jnp.concatenate([q_a[..., :MLA_NOPE], rope(q_a[..., MLA_NOPE:], positions)], axis=-1)
        k_a = jnp.concatenate([k_a[..., :MLA_NOPE], rope(k_a[..., MLA_NOPE:], positions)], axis=-1)
        y_a = causal_block_attention(q_a, k_a, v_a).reshape(B, S, MLA_WIDTH)

        q_b = rms_norm(fq.reshape(B, S, FOX_HEADS, FOX_HEAD_DIM), fox_q_norm_g[layer])
        k_b = rms_norm(fk.reshape(B, S, FOX_HEADS, FOX_HEAD_DIM), fox_k_norm_g[layer])
        v_b = fv.reshape(B, S, FOX_HEADS, FOX_HEAD_DIM)
        log_f = jax.nn.log_sigmoid((f_logit + b_forget[layer]).astype(jnp.float32))
        cum_log_f = jnp.cumsum(log_f, axis=1)
        y_b = causal_block_attention(q_b, k_b, v_b, cum_log_f).reshape(B, S, FOX_WIDTH)

        gates = jax.nn.sigmoid(jnp.concatenate([gate_a, gate_b], axis=-1) + b_gate[layer])
        merged = jnp.concatenate([y_a, y_b], axis=-1) * gates
        x = x + jnp.einsum('bse,ed->bsd', merged, w_out[layer])

        h2 = rms_norm(x, ffn_norm_g[layer])
        x = x + peer_ffn(h2, w_peer_q[layer], peer_sub_keys[layer], peer_u[layer], peer_v[layer])
    return x
```

```cpp
#include <hip/hip_runtime.h>
#include <stdint.h>
#include <math.h>

typedef unsigned short bf16_t;

constexpr int S = 8192, DM = 2048, INW = 11344;
constexpr int OFF_CQ = 0, OFF_CKV = 512, OFF_KPE = 1024, OFF_FQ = 1088, OFF_FK = 3136, OFF_FV = 5184, OFF_FLOG = 7232, OFF_GA = 7248;
constexpr float EPS = 1e-6f;

__device__ __forceinline__ float bf2f(bf16_t v) { return __uint_as_float(((unsigned)v) << 16); }
__device__ __forceinline__ bf16_t f2bf(float f) { unsigned u = __float_as_uint(f); u += 0x7fffu + ((u >> 16) & 1u); return (bf16_t)(u >> 16); }
__device__ __forceinline__ float ldf(const float* p) { return *p; }
__device__ __forceinline__ float ldf(const bf16_t* p) { return bf2f(*p); }
__device__ __forceinline__ void stf(float* p, float v) { *p = v; }
__device__ __forceinline__ void stf(bf16_t* p, float v) { *p = f2bf(v); }

__device__ __forceinline__ float wave_sum(float v) {
#pragma unroll
    for (int o = 32; o >= 1; o >>= 1) v += __shfl_xor(v, o);
    return v;
}
__device__ __forceinline__ float wave_max(float v) {
#pragma unroll
    for (int o = 32; o >= 1; o >>= 1) v = fmaxf(v, __shfl_xor(v, o));
    return v;
}

template <typename TI>
__global__ __launch_bounds__(256) void rmsnorm_rows(const TI* __restrict__ in, int ld_in, const float* __restrict__ g, bf16_t* __restrict__ out, int ld_out, int n) {
    __shared__ float red[4];
    const int row = blockIdx.x;
    const TI* p = in + (size_t)row * ld_in;
    float ss = 0.f;
    for (int i = threadIdx.x; i < n; i += 256) { float v = ldf(p + i); ss += v * v; }
    ss = wave_sum(ss);
    if ((threadIdx.x & 63) == 0) red[threadIdx.x >> 6] = ss;
    __syncthreads();
    ss = red[0] + red[1] + red[2] + red[3];
    const float r = rsqrtf(ss / (float)n + EPS);
    for (int i = threadIdx.x; i < n; i += 256) out[(size_t)row * ld_out + i] = f2bf(ldf(p + i) * r * g[i]);
}

template <typename TA, typename TC, bool BT, bool RES>
__global__ __launch_bounds__(256) void gemm_naive(const TA* __restrict__ A, int lda, const float* __restrict__ B, int ldb, TC* __restrict__ C, int ldc,
                                                  int M, int N, int K, const float* __restrict__ res, int ldres) {
    __shared__ float As[16][68];
    __shared__ float Bs[16][68];
    const int tid = threadIdx.x, ty = tid >> 4, tx = tid & 15;
    const int m0 = blockIdx.y * 64, n0 = blockIdx.x * 64;
    float acc[4][4];
#pragma unroll
    for (int i = 0; i < 4; ++i)
#pragma unroll
        for (int j = 0; j < 4; ++j) acc[i][j] = 0.f;
    for (int k0 = 0; k0 < K; k0 += 16) {
        {
            const int r = tid >> 2, kk = (tid & 3) * 4;
            const TA* ap = A + (size_t)(m0 + r) * lda + k0 + kk;
#pragma unroll
            for (int c = 0; c < 4; ++c) As[kk + c][r] = ldf(ap + c);
        }
        if (!BT) {
            const int kk = tid >> 4, nn = (tid & 15) * 4;
#pragma unroll
            for (int c = 0; c < 4; ++c) { const int n = n0 + nn + c; Bs[kk][nn + c] = (n < N) ? B[(size_t)(k0 + kk) * ldb + n] : 0.f; }
        } else {
            const int nn = tid >> 2, kk = (tid & 3) * 4; const int n = n0 + nn;
#pragma unroll
            for (int c = 0; c < 4; ++c) Bs[kk + c][nn] = (n < N) ? B[(size_t)n * ldb + k0 + kk + c] : 0.f;
        }
        __syncthreads();
#pragma unroll
        for (int k = 0; k < 16; ++k) {
            float a[4], b[4];
#pragma unroll
            for (int i = 0; i < 4; ++i) a[i] = As[k][ty * 4 + i];
#pragma unroll
            for (int j = 0; j < 4; ++j) b[j] = Bs[k][tx * 4 + j];
#pragma unroll
            for (int i = 0; i < 4; ++i)
#pragma unroll
                for (int j = 0; j < 4; ++j) acc[i][j] += a[i] * b[j];
        }
        __syncthreads();
    }
#pragma unroll
    for (int i = 0; i < 4; ++i)
#pragma unroll
        for (int j = 0; j < 4; ++j) {
            const int r = m0 + ty * 4 + i, c = n0 + tx * 4 + j;
            if (c < N) { float v = acc[i][j]; if (RES) v += res[(size_t)r * ldres + c]; stf(C + (size_t)r * ldc + c, v); }
        }
}

__device__ __forceinline__ void rope_cs(int pos, int i, float& c, float& s) {
    const double inv = exp(-(double)i * (1.0 / 32.0) * 9.210340371976184);
    double ang = (double)((float)pos * (float)inv);
    const double twopi = 6.283185307179586;
    ang -= twopi * rint(ang / twopi);
    c = cosf((float)ang); s = sinf((float)ang);
}

__global__ __launch_bounds__(256) void mla_prep(bf16_t* __restrict__ qa, const bf16_t* __restrict__ kvraw, const bf16_t* __restrict__ proj, const int* __restrict__ pos,
                                                const float* __restrict__ gq, const float* __restrict__ gk, bf16_t* __restrict__ ka) {
    const int w = (blockIdx.x * 256 + threadIdx.x) >> 6, lane = threadIdx.x & 63;
    const int t = w >> 4, h = w & 15;
    float c, s; rope_cs(pos[t], lane & 31, c, s);
    {
        bf16_t* q = qa + (size_t)t * 3072 + h * 192;
        float v0 = bf2f(q[lane]), v1 = bf2f(q[lane + 64]), v2 = bf2f(q[lane + 128]);
        const float ss = wave_sum(v0 * v0 + v1 * v1 + v2 * v2);
        const float r = rsqrtf(ss / 192.f + EPS);
        v0 *= r * gq[lane]; v1 *= r * gq[lane + 64]; v2 *= r * gq[lane + 128];
        const float o = __shfl_xor(v2, 32);
        const float rr = lane < 32 ? v2 * c - o * s : o * s + v2 * c;
        q[lane] = f2bf(v0); q[lane + 64] = f2bf(v1); q[lane + 128] = f2bf(rr);
    }
    {
        const bf16_t* kn = kvraw + (size_t)t * 4096 + h * 256;
        float v0 = bf2f(kn[lane]), v1 = bf2f(kn[lane + 64]), v2 = bf2f(proj[(size_t)t * INW + OFF_KPE + lane]);
        const float ss = wave_sum(v0 * v0 + v1 * v1 + v2 * v2);
        const float r = rsqrtf(ss / 192.f + EPS);
        v0 *= r * gk[lane]; v1 *= r * gk[lane + 64]; v2 *= r * gk[lane + 128];
        const float o = __shfl_xor(v2, 32);
        const float rr = lane < 32 ? v2 * c - o * s : o * s + v2 * c;
        bf16_t* k = ka + (size_t)t * 3072 + h * 192;
        k[lane] = f2bf(v0); k[lane + 64] = f2bf(v1); k[lane + 128] = f2bf(rr);
    }
}

__global__ __launch_bounds__(256) void fox_prep(bf16_t* __restrict__ proj, const float* __restrict__ gq, const float* __restrict__ gk) {
    const int w = (blockIdx.x * 256 + threadIdx.x) >> 6, lane = threadIdx.x & 63;
    const int t = w >> 4, h = w & 15;
#pragma unroll
    for (int which = 0; which < 2; ++which) {
        bf16_t* p = proj + (size_t)t * INW + (which ? OFF_FK : OFF_FQ) + h * 128;
        const float* g = which ? gk : gq;
        float v0 = bf2f(p[lane]), v1 = bf2f(p[lane + 64]);
        const float ss = wave_sum(v0 * v0 + v1 * v1);
        const float r = rsqrtf(ss / 128.f + EPS);
        p[lane] = f2bf(v0 * r * g[lane]); p[lane + 64] = f2bf(v1 * r * g[lane + 64]);
    }
}

__global__ __launch_bounds__(256) void fox_cumsum(const bf16_t* __restrict__ proj, const float* __restrict__ bfor, float* __restrict__ F) {
    __shared__ double part[256];
    const int h = blockIdx.x, tid = threadIdx.x;
    const float b = bfor[h];
    double sum = 0.0;
    for (int i = 0; i < 32; ++i) {
        const int t = tid * 32 + i;
        const float z = bf2f(proj[(size_t)t * INW + OFF_FLOG + h]) + b;
        const float lf = fminf(z, 0.f) - log1pf(expf(-fabsf(z)));
        sum += (double)lf;
    }
    part[tid] = sum;
    __syncthreads();
    if (tid == 0) { double run = 0.0; for (int i = 0; i < 256; ++i) { const double v = part[i]; part[i] = run; run += v; } }
    __syncthreads();
    double run = part[tid];
    for (int i = 0; i < 32; ++i) {
        const int t = tid * 32 + i;
        const float z = bf2f(proj[(size_t)t * INW + OFF_FLOG + h]) + b;
        const float lf = fminf(z, 0.f) - log1pf(expf(-fabsf(z)));
        run += (double)lf; F[(size_t)h * S + t] = (float)run;
    }
}

__global__ __launch_bounds__(256) void copy_gates(const bf16_t* __restrict__ proj, bf16_t* __restrict__ merged) {
    const int t = blockIdx.x;
    for (int i = threadIdx.x; i < 4096; i += 256) merged[(size_t)t * 4096 + i] = proj[(size_t)t * INW + OFF_GA + i];
}

template <int DK, bool FOX>
__global__ __launch_bounds__(256) void attn_naive(const bf16_t* __restrict__ Q, int ldq, const bf16_t* __restrict__ K, int ldk, const bf16_t* __restrict__ V, int ldv, int vstride,
                                                  const float* __restrict__ F, bf16_t* __restrict__ merged, int col0, const float* __restrict__ b_gate, float scale) {
    extern __shared__ __attribute__((aligned(16))) float sm[];
    constexpr int LQ = DK + 1;
    float* Qs = sm;
    float* Ks = Qs + 64 * LQ;
    float* Vs = Ks + 64 * LQ;
    float* Ps = Vs + 64 * 128;
    float* mrow = Ps + 64 * 65;
    float* lrow = mrow + 64;
    float* arow = lrow + 64;
    const int tid = threadIdx.x, ty = tid >> 4, tx = tid & 15;
    const int qb = (int)gridDim.x - 1 - (int)blockIdx.x, h = blockIdx.y;
    const int q0 = qb * 64;
    for (int idx = tid; idx < 64 * DK; idx += 256) { const int r = idx / DK, d = idx % DK; Qs[r * LQ + d] = bf2f(Q[(size_t)(q0 + r) * ldq + h * DK + d]); }
    if (tid < 64) { mrow[tid] = -INFINITY; lrow[tid] = 0.f; }
    float o[4][8];
#pragma unroll
    for (int i = 0; i < 4; ++i)
#pragma unroll
        for (int c = 0; c < 8; ++c) o[i][c] = 0.f;
    float fq[4];
#pragma unroll
    for (int i = 0; i < 4; ++i) fq[i] = FOX ? F[(size_t)h * S + q0 + ty * 4 + i] : 0.f;
    __syncthreads();
    for (int kb = 0; kb <= qb; ++kb) {
        const int k0 = kb * 64;
        for (int idx = tid; idx < 64 * DK; idx += 256) { const int r = idx / DK, d = idx % DK; Ks[r * LQ + d] = bf2f(K[(size_t)(k0 + r) * ldk + h * DK + d]); }
        for (int idx = tid; idx < 64 * 128; idx += 256) { const int r = idx >> 7, d = idx & 127; Vs[r * 128 + d] = bf2f(V[(size_t)(k0 + r) * ldv + h * vstride + d]); }
        __syncthreads();
        float sacc[4][4];
#pragma unroll
        for (int i = 0; i < 4; ++i)
#pragma unroll
            for (int j = 0; j < 4; ++j) sacc[i][j] = 0.f;
        for (int d = 0; d < DK; ++d) {
            float a[4], b[4];
#pragma unroll
            for (int i = 0; i < 4; ++i) a[i] = Qs[(ty * 4 + i) * LQ + d];
#pragma unroll
            for (int j = 0; j < 4; ++j) b[j] = Ks[(tx + 16 * j) * LQ + d];
#pragma unroll
            for (int i = 0; i < 4; ++i)
#pragma unroll
                for (int j = 0; j < 4; ++j) sacc[i][j] += a[i] * b[j];
        }
#pragma unroll
        for (int j = 0; j < 4; ++j) {
            const int kc = tx + 16 * j, kpos = k0 + kc;
            const float fk = FOX ? F[(size_t)h * S + kpos] : 0.f;
#pragma unroll
            for (int i = 0; i < 4; ++i) {
                const int qr = ty * 4 + i, qpos = q0 + qr;
                float v = sacc[i][j] * scale;
                if (FOX) v += fq[i] - fk;
                if (kpos > qpos) v = -INFINITY;
                Ps[qr * 65 + kc] = v;
            }
        }
        __syncthreads();
        {
            const int r = tid >> 2, part = tid & 3;
            float* pr = Ps + r * 65 + part * 16;
            float mx = -INFINITY;
#pragma unroll
            for (int c = 0; c < 16; ++c) mx = fmaxf(mx, pr[c]);
            mx = fmaxf(mx, __shfl_xor(mx, 1)); mx = fmaxf(mx, __shfl_xor(mx, 2));
            const float mo = mrow[r];
            const float mn = fmaxf(mo, mx);
            float sum = 0.f;
#pragma unroll
            for (int c = 0; c < 16; ++c) { const float p = expf(pr[c] - mn); pr[c] = p; sum += p; }
            sum += __shfl_xor(sum, 1); sum += __shfl_xor(sum, 2);
            const float al = expf(mo - mn);
            if (part == 0) { lrow[r] = lrow[r] * al + sum; mrow[r] = mn; arow[r] = al; }
        }
        __syncthreads();
#pragma unroll
        for (int i = 0; i < 4; ++i) { const float al = arow[ty * 4 + i];
#pragma unroll
            for (int c = 0; c < 8; ++c) o[i][c] *= al; }
        for (int k = 0; k < 64; ++k) {
            float p[4], v[8];
#pragma unroll
            for (int i = 0; i < 4; ++i) p[i] = Ps[(ty * 4 + i) * 65 + k];
#pragma unroll
            for (int c = 0; c < 8; ++c) v[c] = Vs[k * 128 + tx * 8 + c];
#pragma unroll
            for (int i = 0; i < 4; ++i)
#pragma unroll
                for (int c = 0; c < 8; ++c) o[i][c] += p[i] * v[c];
        }
        __syncthreads();
    }
#pragma unroll
    for (int i = 0; i < 4; ++i) {
        const int qr = ty * 4 + i; const float inv = 1.f / lrow[qr];
#pragma unroll
        for (int c = 0; c < 8; ++c) {
            const int col = col0 + h * 128 + tx * 8 + c;
            bf16_t* mp = merged + (size_t)(q0 + qr) * 4096 + col;
            const float gl = bf2f(*mp) + b_gate[col];
            const float gate = 1.f / (1.f + expf(-gl));
            *mp = f2bf(o[i][c] * inv * gate);
        }
    }
}

__device__ __forceinline__ void wave_argmax(float& v, int& i) {
#pragma unroll
    for (int o = 32; o >= 1; o >>= 1) {
        const float ov = __shfl_xor(v, o); const int oi = __shfl_xor(i, o);
        if (ov > v || (ov == v && oi < i)) { v = ov; i = oi; }
    }
}

__global__ __launch_bounds__(512) void peer_kernel(const float* __restrict__ x1, const bf16_t* __restrict__ h2, const float* __restrict__ scores,
                                                   const float* __restrict__ U, const float* __restrict__ Vt, float* __restrict__ out) {
    extern __shared__ __attribute__((aligned(16))) float red[];
    const int t = blockIdx.x, tid = threadIdx.x, h = tid >> 6, lane = tid & 63;
    const float* sc = scores + (size_t)t * 2048 + h * 256;
    float sv[2]; int si[2];
#pragma unroll
    for (int c = 0; c < 2; ++c) {
        float a0 = sc[c * 128 + lane], a1 = sc[c * 128 + 64 + lane];
        float mv = -INFINITY; int mi = 0;
        for (int k = 0; k < 16; ++k) {
            float bv; int bi;
            if (a0 >= a1) { bv = a0; bi = lane; } else { bv = a1; bi = lane + 64; }
            wave_argmax(bv, bi);
            if (bi == lane) a0 = -INFINITY;
            if (bi == lane + 64) a1 = -INFINITY;
            if (lane == k) { mv = bv; mi = bi; }
        }
        sv[c] = mv; si[c] = mi;
    }
    float cand[4];
#pragma unroll
    for (int m = 0; m < 4; ++m) cand[m] = __shfl(sv[0], (lane >> 4) + 4 * m) + __shfl(sv[1], lane & 15);
    float ts = -INFINITY; int tp = 0;
    for (int k = 0; k < 16; ++k) {
        float bv = cand[0]; int bp = lane;
#pragma unroll
        for (int m = 1; m < 4; ++m) if (cand[m] > bv) { bv = cand[m]; bp = lane + 64 * m; }
        wave_argmax(bv, bp);
#pragma unroll
        for (int m = 0; m < 4; ++m) if (bp == lane + 64 * m) cand[m] = -INFINITY;
        if (lane == k) { ts = bv; tp = bp; }
    }
    const int expert = __shfl(si[0], tp >> 4) * 128 + __shfl(si[1], tp & 15);
    const float mx = wave_max(ts);
    const float e = lane < 16 ? expf(ts - mx) : 0.f;
    const float gate = e / wave_sum(e);
    float hr[32];
#pragma unroll
    for (int j = 0; j < 8; ++j)
#pragma unroll
        for (int c = 0; c < 4; ++c) hr[j * 4 + c] = bf2f(h2[(size_t)t * DM + j * 256 + lane * 4 + c]);
    float acc[32];
#pragma unroll
    for (int i = 0; i < 32; ++i) acc[i] = 0.f;
    for (int k = 0; k < 16; ++k) {
        const int ek = __shfl(expert, k); const float gk = __shfl(gate, k);
        const float* up = U + (size_t)ek * DM;
        float dot = 0.f;
#pragma unroll
        for (int j = 0; j < 8; ++j) { const float4 u4 = *(const float4*)(up + j * 256 + lane * 4);
            dot += hr[j * 4] * u4.x + hr[j * 4 + 1] * u4.y + hr[j * 4 + 2] * u4.z + hr[j * 4 + 3] * u4.w; }
        dot = wave_sum(dot);
        const float w = gk * 0.5f * dot * (1.f + erff(dot * 0.70710678118654752f));
        const float* vp = Vt + (size_t)ek * DM;
#pragma unroll
        for (int j = 0; j < 8; ++j) { const float4 v4 = *(const float4*)(vp + j * 256 + lane * 4);
            acc[j * 4] += w * v4.x; acc[j * 4 + 1] += w * v4.y; acc[j * 4 + 2] += w * v4.z; acc[j * 4 + 3] += w * v4.w; }
    }
#pragma unroll
    for (int j = 0; j < 8; ++j)
#pragma unroll
        for (int c = 0; c < 4; ++c) red[h * 2048 + j * 256 + lane * 4 + c] = acc[j * 4 + c];
    __syncthreads();
    for (int i = tid; i < 2048; i += 512) {
        float s = x1[(size_t)t * DM + i];
#pragma unroll
        for (int w = 0; w < 8; ++w) s += red[w * 2048 + i];
        out[(size_t)t * DM + i] = s;
    }
}

extern "C" void kernel_launch(void* const* d_in, const int* in_sizes, int n_in,
                              void* d_out, int out_size, void* d_ws, size_t ws_size,
                              hipStream_t stream) {
    const float* x = (const float*)d_in[0];
    const int* pos = (const int*)d_in[1];
    const float* mix_g = (const float*)d_in[2];
    const float* w_in = (const float*)d_in[3];
    const float* b_forget = (const float*)d_in[4];
    const float* b_gate = (const float*)d_in[5];
    const float* q_lat_g = (const float*)d_in[6];
    const float* w_q_up = (const float*)d_in[7];
    const float* kv_lat_g = (const float*)d_in[8];
    const float* w_kv_up = (const float*)d_in[9];
    const float* mla_qg = (const float*)d_in[10];
    const float* mla_kg = (const float*)d_in[11];
    const float* fox_qg = (const float*)d_in[12];
    const float* fox_kg = (const float*)d_in[13];
    const float* w_out = (const float*)d_in[14];
    const float* ffn_g = (const float*)d_in[15];
    const float* w_peer_q = (const float*)d_in[16];
    const float* sub_keys = (const float*)d_in[17];
    const float* peer_u = (const float*)d_in[18];
    const float* peer_v = (const float*)d_in[19];
    float* out = (float*)d_out;

    char* ws = (char*)d_ws;
    const size_t MiB = 1024 * 1024;
    bf16_t* hbuf = (bf16_t*)(ws);
    bf16_t* proj = (bf16_t*)(ws + 32 * MiB);
    bf16_t* cqn = (bf16_t*)(ws + 210 * MiB);
    bf16_t* ckvn = (bf16_t*)(ws + 218 * MiB);
    bf16_t* qa = (bf16_t*)(ws + 226 * MiB);
    bf16_t* kvraw = (bf16_t*)(ws + 274 * MiB);
    bf16_t* ka = (bf16_t*)(ws + 338 * MiB);
    float* Fc = (float*)(ws + 386 * MiB);
    bf16_t* merged = (bf16_t*)(ws + 387 * MiB);
    float* x1 = (float*)(ws + 226 * MiB);
    bf16_t* h2 = (bf16_t*)(ws + 290 * MiB);
    float* pq = (float*)(ws + 322 * MiB);
    float* scores = (float*)(ws + 32 * MiB);

    rmsnorm_rows<float><<<S, 256, 0, stream>>>(x, DM, mix_g, hbuf, DM, DM);
    gemm_naive<bf16_t, bf16_t, false, false><<<dim3((INW + 63) / 64, S / 64), 256, 0, stream>>>(hbuf, DM, w_in, INW, proj, INW, S, INW, DM, nullptr, 0);
    rmsnorm_rows<bf16_t><<<S, 256, 0, stream>>>(proj + OFF_CQ, INW, q_lat_g, cqn, 512, 512);
    rmsnorm_rows<bf16_t><<<S, 256, 0, stream>>>(proj + OFF_CKV, INW, kv_lat_g, ckvn, 512, 512);
    gemm_naive<bf16_t, bf16_t, false, false><<<dim3(3072 / 64, S / 64), 256, 0, stream>>>(cqn, 512, w_q_up, 3072, qa, 3072, S, 3072, 512, nullptr, 0);
    gemm_naive<bf16_t, bf16_t, false, false><<<dim3(4096 / 64, S / 64), 256, 0, stream>>>(ckvn, 512, w_kv_up, 4096, kvraw, 4096, S, 4096, 512, nullptr, 0);
    mla_prep<<<S * 16 / 4, 256, 0, stream>>>(qa, kvraw, proj, pos, mla_qg, mla_kg, ka);
    fox_prep<<<S * 16 / 4, 256, 0, stream>>>(proj, fox_qg, fox_kg);
    fox_cumsum<<<16, 256, 0, stream>>>(proj, b_forget, Fc);
    copy_gates<<<S, 256, 0, stream>>>(proj, merged);
    {
        constexpr int LDS_MLA = (2 * 64 * 193 + 64 * 128 + 64 * 65 + 192) * 4;
        constexpr int LDS_FOX = (2 * 64 * 129 + 64 * 128 + 64 * 65 + 192) * 4;
        static bool attr = false;
        if (!attr) {
            hipFuncSetAttribute((const void*)attn_naive<192, false>, hipFuncAttributeMaxDynamicSharedMemorySize, LDS_MLA);
            hipFuncSetAttribute((const void*)attn_naive<128, true>, hipFuncAttributeMaxDynamicSharedMemorySize, LDS_FOX);
            hipFuncSetAttribute((const void*)peer_kernel, hipFuncAttributeMaxDynamicSharedMemorySize, 65536);
            attr = true;
        }
        attn_naive<192, false><<<dim3(S / 64, 16), 256, LDS_MLA, stream>>>(qa, 3072, ka, 3072, kvraw + 128, 4096, 256, nullptr, merged, 0, b_gate, 0.07216878364870322f);
        attn_naive<128, true><<<dim3(S / 64, 16), 256, LDS_FOX, stream>>>(proj + OFF_FQ, INW, proj + OFF_FK, INW, proj + OFF_FV, INW, 128, Fc, merged, 2048, b_gate, 0.08838834764831845f);
    }
    gemm_naive<bf16_t, float, false, true><<<dim3(DM / 64, S / 64), 256, 0, stream>>>(merged, 4096, w_out, DM, x1, DM, S, DM, 4096, x, DM);
    rmsnorm_rows<float><<<S, 256, 0, stream>>>(x1, DM, ffn_g, h2, DM, DM);
    gemm_naive<bf16_t, float, false, false><<<dim3(DM / 64, S / 64), 256, 0, stream>>>(h2, DM, w_peer_q, DM, pq, DM, S, DM, DM, nullptr, 0);
    for (int hc = 0; hc < 16; ++hc)
        gemm_naive<float, float, true, false><<<dim3(2, S / 64), 256, 0, stream>>>(pq + hc * 128, DM, sub_keys + (size_t)hc * 128 * 128, 128, scores + hc * 128, DM, S, 128, 128, nullptr, 0);
    peer_kernel<<<S, 512, 65536, stream>>>(x1, h2, scores, peer_u, peer_v, out);
}
```

```cpp
#include <hip/hip_runtime.h>
#include <stdint.h>
#include <math.h>
#include <hip/hip_cooperative_groups.h>
#include <cstdio>
namespace cg = cooperative_groups;

typedef unsigned short bf16_t;

constexpr int S = 8192, DM = 2048, INW = 11344;
constexpr int OFF_CQ = 0, OFF_CKV = 512, OFF_KPE = 1024, OFF_FQ = 1088, OFF_FK = 3136, OFF_FV = 5184, OFF_FLOG = 7232, OFF_GA = 7248;
constexpr float EPS = 1e-6f;

__device__ __forceinline__ float bf2f(bf16_t v) { return __uint_as_float(((unsigned)v) << 16); }
__device__ __forceinline__ bf16_t f2bf(float f) { unsigned u = __float_as_uint(f); u += 0x7fffu + ((u >> 16) & 1u); return (bf16_t)(u >> 16); }
__device__ __forceinline__ float ldf(const float* p) { return *p; }
__device__ __forceinline__ float ldf(const bf16_t* p) { return bf2f(*p); }
__device__ __forceinline__ void stf(float* p, float v) { *p = v; }
__device__ __forceinline__ void stf(bf16_t* p, float v) { *p = f2bf(v); }

__device__ __forceinline__ float wave_sum(float v) {
#pragma unroll
    for (int o = 32; o >= 1; o >>= 1) v += __shfl_xor(v, o);
    return v;
}
__device__ __forceinline__ float wave_max(float v) {
#pragma unroll
    for (int o = 32; o >= 1; o >>= 1) v = fmaxf(v, __shfl_xor(v, o));
    return v;
}

template <typename TI>
__device__ __forceinline__ void rmsnorm_rows(float* red, int row, const TI* __restrict__ in, int ld_in, const float* __restrict__ g, bf16_t* __restrict__ out, int ld_out, int n) {
    const TI* p = in + (size_t)row * ld_in;
    float ss = 0.f;
    for (int i = threadIdx.x; i < n; i += 256) { float v = ldf(p + i); ss += v * v; }
    ss = wave_sum(ss);
    if ((threadIdx.x & 63) == 0) red[threadIdx.x >> 6] = ss;
    __syncthreads();
    ss = red[0] + red[1] + red[2] + red[3];
    const float r = rsqrtf(ss / (float)n + EPS);
    for (int i = threadIdx.x; i < n; i += 256) out[(size_t)row * ld_out + i] = f2bf(ldf(p + i) * r * g[i]);
    __syncthreads();
}

template <typename TA, typename TC, bool BT, bool RES>
__device__ __forceinline__ void gemm_naive(float* smf, int bx, int by, const TA* __restrict__ A, int lda, const float* __restrict__ B, int ldb, TC* __restrict__ C, int ldc,
                                                  int M, int N, int K, const float* __restrict__ res, int ldres) {
    float (*As)[68] = (float (*)[68])smf;
    float (*Bs)[68] = (float (*)[68])(smf + 16 * 68);
    const int tid = threadIdx.x, ty = tid >> 4, tx = tid & 15;
    const int m0 = by * 64, n0 = bx * 64;
    float acc[4][4];
#pragma unroll
    for (int i = 0; i < 4; ++i)
#pragma unroll
        for (int j = 0; j < 4; ++j) acc[i][j] = 0.f;
    for (int k0 = 0; k0 < K; k0 += 16) {
        {
            const int r = tid >> 2, kk = (tid & 3) * 4;
            const TA* ap = A + (size_t)(m0 + r) * lda + k0 + kk;
#pragma unroll
            for (int c = 0; c < 4; ++c) As[kk + c][r] = ldf(ap + c);
        }
        if (!BT) {
            const int kk = tid >> 4, nn = (tid & 15) * 4;
#pragma unroll
            for (int c = 0; c < 4; ++c) { const int n = n0 + nn + c; Bs[kk][nn + c] = (n < N) ? B[(size_t)(k0 + kk) * ldb + n] : 0.f; }
        } else {
            const int nn = tid >> 2, kk = (tid & 3) * 4; const int n = n0 + nn;
#pragma unroll
            for (int c = 0; c < 4; ++c) Bs[kk + c][nn] = (n < N) ? B[(size_t)n * ldb + k0 + kk + c] : 0.f;
        }
        __syncthreads();
#pragma unroll
        for (int k = 0; k < 16; ++k) {
            float a[4], b[4];
#pragma unroll
            for (int i = 0; i < 4; ++i) a[i] = As[k][ty * 4 + i];
#pragma unroll
            for (int j = 0; j < 4; ++j) b[j] = Bs[k][tx * 4 + j];
#pragma unroll
            for (int i = 0; i < 4; ++i)
#pragma unroll
                for (int j = 0; j < 4; ++j) acc[i][j] += a[i] * b[j];
        }
        __syncthreads();
    }
#pragma unroll
    for (int i = 0; i < 4; ++i)
#pragma unroll
        for (int j = 0; j < 4; ++j) {
            const int r = m0 + ty * 4 + i, c = n0 + tx * 4 + j;
            if (c < N) { float v = acc[i][j]; if (RES) v += res[(size_t)r * ldres + c]; stf(C + (size_t)r * ldc + c, v); }
        }
}

__device__ __forceinline__ void rope_cs(int pos, int i, float& c, float& s) {
    const double inv = exp(-(double)i * (1.0 / 32.0) * 9.210340371976184);
    double ang = (double)((float)pos * (float)inv);
    const double twopi = 6.283185307179586;
    ang -= twopi * rint(ang / twopi);
    c = cosf((float)ang); s = sinf((float)ang);
}

__device__ __forceinline__ void mla_prep(int w, bf16_t* __restrict__ qa, const bf16_t* __restrict__ kvraw, const bf16_t* __restrict__ proj, const int* __restrict__ pos,
                                                const float* __restrict__ gq, const float* __restrict__ gk, bf16_t* __restrict__ ka) {
    const int lane = threadIdx.x & 63;
    const int t = w >> 4, h = w & 15;
    float c, s; rope_cs(pos[t], lane & 31, c, s);
    {
        bf16_t* q = qa + (size_t)t * 3072 + h * 192;
        float v0 = bf2f(q[lane]), v1 = bf2f(q[lane + 64]), v2 = bf2f(q[lane + 128]);
        const float ss = wave_sum(v0 * v0 + v1 * v1 + v2 * v2);
        const float r = rsqrtf(ss / 192.f + EPS);
        v0 *= r * gq[lane]; v1 *= r * gq[lane + 64]; v2 *= r * gq[lane + 128];
        const float o = __shfl_xor(v2, 32);
        const float rr = lane < 32 ? v2 * c - o * s : o * s + v2 * c;
        q[lane] = f2bf(v0); q[lane + 64] = f2bf(v1); q[lane + 128] = f2bf(rr);
    }
    {
        const bf16_t* kn = kvraw + (size_t)t * 4096 + h * 256;
        float v0 = bf2f(kn[lane]), v1 = bf2f(kn[lane + 64]), v2 = bf2f(proj[(size_t)t * INW + OFF_KPE + lane]);
        const float ss = wave_sum(v0 * v0 + v1 * v1 + v2 * v2);
        const float r = rsqrtf(ss / 192.f + EPS);
        v0 *= r * gk[lane]; v1 *= r * gk[lane + 64]; v2 *= r * gk[lane + 128];
        const float o = __shfl_xor(v2, 32);
        const float rr = lane < 32 ? v2 * c - o * s : o * s + v2 * c;
        bf16_t* k = ka + (size_t)t * 3072 + h * 192;
        k[lane] = f2bf(v0); k[lane + 64] = f2bf(v1); k[lane + 128] = f2bf(rr);
    }
}

__device__ __forceinline__ void fox_prep(int w, bf16_t* __restrict__ proj, const float* __restrict__ gq, const float* __restrict__ gk) {
    const int lane = threadIdx.x & 63;
    const int t = w >> 4, h = w & 15;
#pragma unroll
    for (int which = 0; which < 2; ++which) {
        bf16_t* p = proj + (size_t)t * INW + (which ? OFF_FK : OFF_FQ) + h * 128;
        const float* g = which ? gk : gq;
        float v0 = bf2f(p[lane]), v1 = bf2f(p[lane + 64]);
        const float ss = wave_sum(v0 * v0 + v1 * v1);
        const float r = rsqrtf(ss / 128.f + EPS);
        p[lane] = f2bf(v0 * r * g[lane]); p[lane + 64] = f2bf(v1 * r * g[lane + 64]);
    }
}

__device__ __forceinline__ void fox_cumsum(double* part, int h, const bf16_t* __restrict__ proj, const float* __restrict__ bfor, float* __restrict__ F) {
    const int tid = threadIdx.x;
    const float b = bfor[h];
    double sum = 0.0;
    for (int i = 0; i < 32; ++i) {
        const int t = tid * 32 + i;
        const float z = bf2f(proj[(size_t)t * INW + OFF_FLOG + h]) + b;
        const float lf = fminf(z, 0.f) - log1pf(expf(-fabsf(z)));
        sum += (double)lf;
    }
    part[tid] = sum;
    __syncthreads();
    if (tid == 0) { double run = 0.0; for (int i = 0; i < 256; ++i) { const double v = part[i]; part[i] = run; run += v; } }
    __syncthreads();
    double run = part[tid];
    for (int i = 0; i < 32; ++i) {
        const int t = tid * 32 + i;
        const float z = bf2f(proj[(size_t)t * INW + OFF_FLOG + h]) + b;
        const float lf = fminf(z, 0.f) - log1pf(expf(-fabsf(z)));
        run += (double)lf; F[(size_t)h * S + t] = (float)run;
    }
    __syncthreads();
}

__device__ __forceinline__ void copy_gates(int t, const bf16_t* __restrict__ proj, bf16_t* __restrict__ merged) {
    for (int i = threadIdx.x; i < 4096; i += 256) merged[(size_t)t * 4096 + i] = proj[(size_t)t * INW + OFF_GA + i];
}

template <int DK, bool FOX>
__device__ __forceinline__ void attn_naive(float* sm, int qb, int h, const bf16_t* __restrict__ Q, int ldq, const bf16_t* __restrict__ K, int ldk, const bf16_t* __restrict__ V, int ldv, int vstride,
                                                  const float* __restrict__ F, bf16_t* __restrict__ merged, int col0, const float* __restrict__ b_gate, float scale) {
    constexpr int LQ = DK + 1;
    float* Qs = sm;
    float* Ks = Qs + 64 * LQ;
    float* Vs = Ks + 64 * LQ;
    float* Ps = Vs + 64 * 128;
    float* mrow = Ps + 64 * 65;
    float* lrow = mrow + 64;
    float* arow = lrow + 64;
    const int tid = threadIdx.x, ty = tid >> 4, tx = tid & 15;
    const int q0 = qb * 64;
    for (int idx = tid; idx < 64 * DK; idx += 256) { const int r = idx / DK, d = idx % DK; Qs[r * LQ + d] = bf2f(Q[(size_t)(q0 + r) * ldq + h * DK + d]); }
    if (tid < 64) { mrow[tid] = -INFINITY; lrow[tid] = 0.f; }
    float o[4][8];
#pragma unroll
    for (int i = 0; i < 4; ++i)
#pragma unroll
        for (int c = 0; c < 8; ++c) o[i][c] = 0.f;
    float fq[4];
#pragma unroll
    for (int i = 0; i < 4; ++i) fq[i] = FOX ? F[(size_t)h * S + q0 + ty * 4 + i] : 0.f;
    __syncthreads();
    for (int kb = 0; kb <= qb; ++kb) {
        const int k0 = kb * 64;
        for (int idx = tid; idx < 64 * DK; idx += 256) { const int r = idx / DK, d = idx % DK; Ks[r * LQ + d] = bf2f(K[(size_t)(k0 + r) * ldk + h * DK + d]); }
        for (int idx = tid; idx < 64 * 128; idx += 256) { const int r = idx >> 7, d = idx & 127; Vs[r * 128 + d] = bf2f(V[(size_t)(k0 + r) * ldv + h * vstride + d]); }
        __syncthreads();
        float sacc[4][4];
#pragma unroll
        for (int i = 0; i < 4; ++i)
#pragma unroll
            for (int j = 0; j < 4; ++j) sacc[i][j] = 0.f;
        for (int d = 0; d < DK; ++d) {
            float a[4], b[4];
#pragma unroll
            for (int i = 0; i < 4; ++i) a[i] = Qs[(ty * 4 + i) * LQ + d];
#pragma unroll
            for (int j = 0; j < 4; ++j) b[j] = Ks[(tx + 16 * j) * LQ + d];
#pragma unroll
            for (int i = 0; i < 4; ++i)
#pragma unroll
                for (int j = 0; j < 4; ++j) sacc[i][j] += a[i] * b[j];
        }
#pragma unroll
        for (int j = 0; j < 4; ++j) {
            const int kc = tx + 16 * j, kpos = k0 + kc;
            const float fk = FOX ? F[(size_t)h * S + kpos] : 0.f;
#pragma unroll
            for (int i = 0; i < 4; ++i) {
                const int qr = ty * 4 + i, qpos = q0 + qr;
                float v = sacc[i][j] * scale;
                if (FOX) v += fq[i] - fk;
                if (kpos > qpos) v = -INFINITY;
                Ps[qr * 65 + kc] = v;
            }
        }
        __syncthreads();
        {
            const int r = tid >> 2, part = tid & 3;
            float* pr = Ps + r * 65 + part * 16;
            float mx = -INFINITY;
#pragma unroll
            for (int c = 0; c < 16; ++c) mx = fmaxf(mx, pr[c]);
            mx = fmaxf(mx, __shfl_xor(mx, 1)); mx = fmaxf(mx, __shfl_xor(mx, 2));
            const float mo = mrow[r];
            const float mn = fmaxf(mo, mx);
            float sum = 0.f;
#pragma unroll
            for (int c = 0; c < 16; ++c) { const float p = expf(pr[c] - mn); pr[c] = p; sum += p; }
            sum += __shfl_xor(sum, 1); sum += __shfl_xor(sum, 2);
            const float al = expf(mo - mn);
            if (part == 0) { lrow[r] = lrow[r] * al + sum; mrow[r] = mn; arow[r] = al; }
        }
        __syncthreads();
#pragma unroll
        for (int i = 0; i < 4; ++i) { const float al = arow[ty * 4 + i];
#pragma unroll
            for (int c = 0; c < 8; ++c) o[i][c] *= al; }
        for (int k = 0; k < 64; ++k) {
            float p[4], v[8];
#pragma unroll
            for (int i = 0; i < 4; ++i) p[i] = Ps[(ty * 4 + i) * 65 + k];
#pragma unroll
            for (int c = 0; c < 8; ++c) v[c] = Vs[k * 128 + tx * 8 + c];
#pragma unroll
            for (int i = 0; i < 4; ++i)
#pragma unroll
                for (int c = 0; c < 8; ++c) o[i][c] += p[i] * v[c];
        }
        __syncthreads();
    }
#pragma unroll
    for (int i = 0; i < 4; ++i) {
        const int qr = ty * 4 + i; const float inv = 1.f / lrow[qr];
#pragma unroll
        for (int c = 0; c < 8; ++c) {
            const int col = col0 + h * 128 + tx * 8 + c;
            bf16_t* mp = merged + (size_t)(q0 + qr) * 4096 + col;
            const float gl = bf2f(*mp) + b_gate[col];
            const float gate = 1.f / (1.f + expf(-gl));
            *mp = f2bf(o[i][c] * inv * gate);
        }
    }
    __syncthreads();
}

__device__ __forceinline__ void wave_argmax(float& v, int& i) {
#pragma unroll
    for (int o = 32; o >= 1; o >>= 1) {
        const float ov = __shfl_xor(v, o); const int oi = __shfl_xor(i, o);
        if (ov > v || (ov == v && oi < i)) { v = ov; i = oi; }
    }
}

__device__ __forceinline__ void peer_token(float* red, int t, const float* __restrict__ x1, const bf16_t* __restrict__ h2, const float* __restrict__ scores,
                                                   const float* __restrict__ U, const float* __restrict__ Vt, float* __restrict__ out) {
    const int tid = threadIdx.x, lane = tid & 63;
  for (int hh = 0; hh < 2; ++hh) {
    const int h = (tid >> 6) * 2 + hh;
    const float* sc = scores + (size_t)t * 2048 + h * 256;
    float sv[2]; int si[2];
#pragma unroll
    for (int c = 0; c < 2; ++c) {
        float a0 = sc[c * 128 + lane], a1 = sc[c * 128 + 64 + lane];
        float mv = -INFINITY; int mi = 0;
        for (int k = 0; k < 16; ++k) {
            float bv; int bi;
            if (a0 >= a1) { bv = a0; bi = lane; } else { bv = a1; bi = lane + 64; }
            wave_argmax(bv, bi);
            if (bi == lane) a0 = -INFINITY;
            if (bi == lane + 64) a1 = -INFINITY;
            if (lane == k) { mv = bv; mi = bi; }
        }
        sv[c] = mv; si[c] = mi;
    }
    float cand[4];
#pragma unroll
    for (int m = 0; m < 4; ++m) cand[m] = __shfl(sv[0], (lane >> 4) + 4 * m) + __shfl(sv[1], lane & 15);
    float ts = -INFINITY; int tp = 0;
    for (int k = 0; k < 16; ++k) {
        float bv = cand[0]; int bp = lane;
#pragma unroll
        for (int m = 1; m < 4; ++m) if (cand[m] > bv) { bv = cand[m]; bp = lane + 64 * m; }
        wave_argmax(bv, bp);
#pragma unroll
        for (int m = 0; m < 4; ++m) if (bp == lane + 64 * m) cand[m] = -INFINITY;
        if (lane == k) { ts = bv; tp = bp; }
    }
    const int expert = __shfl(si[0], tp >> 4) * 128 + __shfl(si[1], tp & 15);
    const float mx = wave_max(ts);
    const float e = lane < 16 ? expf(ts - mx) : 0.f;
    const float gate = e / wave_sum(e);
    float hr[32];
#pragma unroll
    for (int j = 0; j < 8; ++j)
#pragma unroll
        for (int c = 0; c < 4; ++c) hr[j * 4 + c] = bf2f(h2[(size_t)t * DM + j * 256 + lane * 4 + c]);
    float acc[32];
#pragma unroll
    for (int i = 0; i < 32; ++i) acc[i] = 0.f;
    for (int k = 0; k < 16; ++k) {
        const int ek = __shfl(expert, k); const float gk = __shfl(gate, k);
        const float* up = U + (size_t)ek * DM;
        float dot = 0.f;
#pragma unroll
        for (int j = 0; j < 8; ++j) { const float4 u4 = *(const float4*)(up + j * 256 + lane * 4);
            dot += hr[j * 4] * u4.x + hr[j * 4 + 1] * u4.y + hr[j * 4 + 2] * u4.z + hr[j * 4 + 3] * u4.w; }
        dot = wave_sum(dot);
        const float w = gk * 0.5f * dot * (1.f + erff(dot * 0.70710678118654752f));
        const float* vp = Vt + (size_t)ek * DM;
#pragma unroll
        for (int j = 0; j < 8; ++j) { const float4 v4 = *(const float4*)(vp + j * 256 + lane * 4);
            acc[j * 4] += w * v4.x; acc[j * 4 + 1] += w * v4.y; acc[j * 4 + 2] += w * v4.z; acc[j * 4 + 3] += w * v4.w; }
    }
#pragma unroll
    for (int j = 0; j < 8; ++j)
#pragma unroll
        for (int c = 0; c < 4; ++c) red[h * 2048 + j * 256 + lane * 4 + c] = acc[j * 4 + c];
  }
    __syncthreads();
    for (int i = tid; i < 2048; i += 256) {
        float s = x1[(size_t)t * DM + i];
#pragma unroll
        for (int w = 0; w < 8; ++w) s += red[w * 2048 + i];
        out[(size_t)t * DM + i] = s;
    }
    __syncthreads();
}


struct Params {
    const float *x; const int* pos; const float *mix_g, *w_in, *b_forget, *b_gate, *q_lat_g, *w_q_up, *kv_lat_g, *w_kv_up, *mla_qg, *mla_kg, *fox_qg, *fox_kg, *w_out, *ffn_g, *w_peer_q, *sub_keys, *peer_u, *peer_v;
    float* out;
    bf16_t *hbuf, *proj, *cqn, *ckvn, *qa, *kvraw, *ka, *merged, *h2;
    float *Fc, *x1, *pq, *scores;
};

template <typename TA, typename TC, bool BT, bool RES>
__device__ __forceinline__ void gemm_all(float* smf, const TA* A, int lda, const float* B, int ldb, TC* C, int ldc, int M, int N, int K, const float* res, int ldres) {
    const int nbx = (N + 63) / 64, nby = M / 64;
    for (int it = blockIdx.x; it < nbx * nby; it += gridDim.x) gemm_naive<TA, TC, BT, RES>(smf, it % nbx, it / nbx, A, lda, B, ldb, C, ldc, M, N, K, res, ldres);
}

constexpr int LDS_BYTES = (2 * 64 * 193 + 64 * 128 + 64 * 65 + 192) * 4;

__global__ __launch_bounds__(256) void mega(Params p) {
    extern __shared__ __attribute__((aligned(16))) float smf[];
    cg::grid_group grid = cg::this_grid();
    const int nb = gridDim.x, b = blockIdx.x, gw = (b * 256 + threadIdx.x) >> 6, nw = nb * 4;
    for (int r = b; r < S; r += nb) rmsnorm_rows<float>(smf, r, p.x, DM, p.mix_g, p.hbuf, DM, DM);
    grid.sync();
    gemm_all<bf16_t, bf16_t, false, false>(smf, p.hbuf, DM, p.w_in, INW, p.proj, INW, S, INW, DM, nullptr, 0);
    grid.sync();
    for (int r = b; r < S; r += nb) { rmsnorm_rows<bf16_t>(smf, r, p.proj + OFF_CQ, INW, p.q_lat_g, p.cqn, 512, 512); rmsnorm_rows<bf16_t>(smf, r, p.proj + OFF_CKV, INW, p.kv_lat_g, p.ckvn, 512, 512); copy_gates(r, p.proj, p.merged); }
    for (int w = gw; w < S * 16; w += nw) fox_prep(w, p.proj, p.fox_qg, p.fox_kg);
    for (int h = b; h < 16; h += nb) fox_cumsum((double*)smf, h, p.proj, p.b_forget, p.Fc);
    grid.sync();
    gemm_all<bf16_t, bf16_t, false, false>(smf, p.cqn, 512, p.w_q_up, 3072, p.qa, 3072, S, 3072, 512, nullptr, 0);
    gemm_all<bf16_t, bf16_t, false, false>(smf, p.ckvn, 512, p.w_kv_up, 4096, p.kvraw, 4096, S, 4096, 512, nullptr, 0);
    grid.sync();
    for (int w = gw; w < S * 16; w += nw) mla_prep(w, p.qa, p.kvraw, p.proj, p.pos, p.mla_qg, p.mla_kg, p.ka);
    grid.sync();
    for (int it = b; it < 2 * 16 * 128; it += nb) {
        const int qb = 127 - it / 32, r = it % 32, br = r >> 4, h = r & 15;
        if (br == 0) attn_naive<192, false>(smf, qb, h, p.qa, 3072, p.ka, 3072, p.kvraw + 128, 4096, 256, nullptr, p.merged, 0, p.b_gate, 0.07216878364870322f);
        else attn_naive<128, true>(smf, qb, h, p.proj + OFF_FQ, INW, p.proj + OFF_FK, INW, p.proj + OFF_FV, INW, 128, p.Fc, p.merged, 2048, p.b_gate, 0.08838834764831845f);
    }
    grid.sync();
    gemm_all<bf16_t, float, false, true>(smf, p.merged, 4096, p.w_out, DM, p.x1, DM, S, DM, 4096, p.x, DM);
    grid.sync();
    for (int r = b; r < S; r += nb) rmsnorm_rows<float>(smf, r, p.x1, DM, p.ffn_g, p.h2, DM, DM);
    grid.sync();
    gemm_all<bf16_t, float, false, false>(smf, p.h2, DM, p.w_peer_q, DM, p.pq, DM, S, DM, DM, nullptr, 0);
    grid.sync();
    for (int hc = 0; hc < 16; ++hc)
        gemm_all<float, float, true, false>(smf, p.pq + hc * 128, DM, p.sub_keys + (size_t)hc * 128 * 128, 128, p.scores + hc * 128, DM, S, 128, 128, nullptr, 0);
    grid.sync();
    for (int t = b; t < S; t += nb) peer_token(smf, t, p.x1, p.h2, p.scores, p.peer_u, p.peer_v, p.out);
}

extern "C" void kernel_launch(void* const* d_in, const int* in_sizes, int n_in,
                              void* d_out, int out_size, void* d_ws, size_t ws_size,
                              hipStream_t stream) {
    Params p{};
    p.x = (const float*)d_in[0]; p.pos = (const int*)d_in[1]; p.mix_g = (const float*)d_in[2]; p.w_in = (const float*)d_in[3];
    p.b_forget = (const float*)d_in[4]; p.b_gate = (const float*)d_in[5]; p.q_lat_g = (const float*)d_in[6]; p.w_q_up = (const float*)d_in[7];
    p.kv_lat_g = (const float*)d_in[8]; p.w_kv_up = (const float*)d_in[9]; p.mla_qg = (const float*)d_in[10]; p.mla_kg = (const float*)d_in[11];
    p.fox_qg = (const float*)d_in[12]; p.fox_kg = (const float*)d_in[13]; p.w_out = (const float*)d_in[14]; p.ffn_g = (const float*)d_in[15];
    p.w_peer_q = (const float*)d_in[16]; p.sub_keys = (const float*)d_in[17]; p.peer_u = (const float*)d_in[18]; p.peer_v = (const float*)d_in[19];
    p.out = (float*)d_out;
    char* ws = (char*)d_ws;
    const size_t MiB = 1024 * 1024;
    p.hbuf = (bf16_t*)(ws); p.proj = (bf16_t*)(ws + 32 * MiB); p.cqn = (bf16_t*)(ws + 210 * MiB); p.ckvn = (bf16_t*)(ws + 218 * MiB);
    p.qa = (bf16_t*)(ws + 226 * MiB); p.kvraw = (bf16_t*)(ws + 274 * MiB); p.ka = (bf16_t*)(ws + 338 * MiB); p.Fc = (float*)(ws + 386 * MiB);
    p.merged = (bf16_t*)(ws + 387 * MiB);
    p.x1 = (float*)(ws + 226 * MiB); p.h2 = (bf16_t*)(ws + 290 * MiB); p.pq = (float*)(ws + 322 * MiB); p.scores = (float*)(ws + 32 * MiB);

    static int grid_blocks = 0;
    if (!grid_blocks) {
        if (hipFuncSetAttribute((const void*)mega, hipFuncAttributeMaxDynamicSharedMemorySize, LDS_BYTES) != hipSuccess) { fprintf(stderr, "hipFuncSetAttribute failed\n"); return; }
        int dev = 0, cus = 0, per_cu = 0;
        hipGetDevice(&dev);
        hipDeviceGetAttribute(&cus, hipDeviceAttributeMultiprocessorCount, dev);
        hipOccupancyMaxActiveBlocksPerMultiprocessor(&per_cu, (const void*)mega, 256, LDS_BYTES);
        if (per_cu < 1) { fprintf(stderr, "occupancy query says 0\n"); return; }
        grid_blocks = cus * per_cu;
    }
    void* args[] = {&p};
    hipError_t e = hipLaunchCooperativeKernel((const void*)mega, dim3(grid_blocks), dim3(256), args, LDS_BYTES, stream);
    if (e != hipSuccess) fprintf(stderr, "cooperative launch failed: %s (grid %d)\n", hipGetErrorString(e), grid_blocks);
}
```

```cpp
#include <hip/hip_runtime.h>
#include <hip/hip_cooperative_groups.h>
#include <stdint.h>
#include <math.h>
#include <cstdio>
namespace cg = cooperative_groups;

namespace pg8 {
#define PG8_LAS __attribute__((address_space(3)))
typedef unsigned short bf16_t;
typedef short bf16x8 __attribute__((ext_vector_type(8)));
typedef float f32x4 __attribute__((ext_vector_type(4)));
typedef unsigned u32x4 __attribute__((ext_vector_type(4)));
constexpr int BM = 256, BK = 64, HALF = 128, HTB = HALF * BK * 2  , STAGE_BYTES = 8 * HTB, NXCD = 8, WGM = 8;

__host__ __device__ __forceinline__ int lds_byte(int r, int c) { const int st = (r >> 4) * 2 + (c >> 5), rr = r & 15, cc = c & 31, ob = rr * 64 + cc * 2; return st * 1024 + (ob ^ (((ob >> 9) & 1) << 5)); }
__host__ __device__ __forceinline__ void stage_rc(int b, int& R, int& C) { const int st = b / 1024, sb = b % 1024, swz = sb ^ (((sb >> 9) & 1) << 5); R = (st >> 1) * 16 + swz / 64; C = (st & 1) * 32 + (swz % 64) / 2; }
__host__ __device__ __forceinline__ int perm32(int rho) { const int n = rho >> 4, i = rho & 15; return 8 * (i >> 2) + 4 * n + (i & 3); }

struct Unit { int pm, pn; };
struct Gemm { const bf16_t* A; const bf16_t* Bt; int M, N, K; };

struct StaticOrder {
    int nM, nN, nwg, G, c;
    __host__ __device__ void init(int M, int N, int G_, int c_) { nM = M / BM; nN = N / BM; nwg = nM * nN; G = G_; c = c_; }
    __host__ __device__ bool next(int i, Unit& u) const {
        const long L = (long)i * G + c; if (L >= nwg) return false;
        int wgid = (int)L; { const int q = nwg / NXCD, r = nwg % NXCD, xcd = wgid % NXCD, off = wgid / NXCD; wgid = (xcd < r ? xcd * (q + 1) : r * (q + 1) + (xcd - r) * q) + off; }
        const int nig = WGM * nN, gid = wgid / nig, fm = gid * WGM, gsz = (nM - fm) < WGM ? (nM - fm) : WGM;
        u.pm = fm + ((wgid % nig) % gsz); u.pn = (wgid % nig) / gsz; return true;
    }
    __device__ __forceinline__ void a_ready(const Unit&) const {}
    __device__ __forceinline__ void done(const Unit&) const {}
};

__device__ __forceinline__ unsigned cvt_pk_bf16(float lo, float hi) { unsigned r; asm volatile("v_cvt_pk_bf16_f32 %0, %1, %2" : "=v"(r) : "v"(lo), "v"(hi)); return r; }
__device__ __forceinline__ u32x4 pack8bf(const f32x4& v0, const f32x4& v1) { u32x4 w; w.x = cvt_pk_bf16(v0[0], v0[1]); w.y = cvt_pk_bf16(v0[2], v0[3]); w.z = cvt_pk_bf16(v1[0], v1[1]); w.w = cvt_pk_bf16(v1[2], v1[3]); return w; }

struct EpiStoreBf16 {
    static constexpr bool PERM = true, AFTER_DRAIN = false;
    bf16_t* O; int ldc;
    __device__ __forceinline__ void operator()(const f32x4 (&acc)[2][2][4][2], const Unit& u, int wr, int wc, int fr, int fq) const {
        const int row0 = u.pm * BM + wr * 64 + fr, col0 = u.pn * BM + wc * 32 + 8 * fq;
#pragma unroll
        for (int ai = 0; ai < 2; ++ai)
#pragma unroll
            for (int m = 0; m < 4; ++m) { bf16_t* rowp = O + (size_t)(row0 + ai * HALF + m * 16) * ldc + col0;
#pragma unroll
                for (int bj = 0; bj < 2; ++bj) *(u32x4*)(rowp + bj * HALF) = pack8bf(acc[ai][bj][m][0], acc[ai][bj][m][1]); }
    }
};
template <bool RES> struct EpiStoreF32 {
    static constexpr bool PERM = true, AFTER_DRAIN = false;
    float* O; const float* res; int ldc;
    __device__ __forceinline__ void operator()(const f32x4 (&acc)[2][2][4][2], const Unit& u, int wr, int wc, int fr, int fq) const {
        const int row0 = u.pm * BM + wr * 64 + fr, col0 = u.pn * BM + wc * 32 + 8 * fq;
#pragma unroll
        for (int ai = 0; ai < 2; ++ai)
#pragma unroll
            for (int m = 0; m < 4; ++m) { const size_t off = (size_t)(row0 + ai * HALF + m * 16) * ldc + col0;
#pragma unroll
                for (int bj = 0; bj < 2; ++bj) { f32x4 v0 = acc[ai][bj][m][0], v1 = acc[ai][bj][m][1];
                    if (RES) { v0 += *(const f32x4*)(res + off + bj * HALF); v1 += *(const f32x4*)(res + off + bj * HALF + 4); }
                    *(f32x4*)(O + off + bj * HALF) = v0; *(f32x4*)(O + off + bj * HALF + 4) = v1; } }
    }
};
struct EpiInProj {
    static constexpr bool PERM = true, AFTER_DRAIN = false;
    bf16_t *cq, *ckv, *fq, *fk, *fv, *gates, *kpe; float* lf; const float *b_gate, *b_forget;
    __device__ __forceinline__ void operator()(const f32x4 (&acc)[2][2][4][2], const Unit& u, int wr, int wc, int fr, int fq_) const {
        const int pn = u.pn, row0 = u.pm * BM + wr * 64 + fr, cw = wc * 32 + 8 * fq_;
        if (pn < 28) {
            bf16_t* base; int ldc, colt;
            if (pn < 2) { base = cq; ldc = 512; colt = pn * 256; } else if (pn < 4) { base = ckv; ldc = 512; colt = (pn - 2) * 256; }
            else if (pn < 12) { base = fq; ldc = 2048; colt = (pn - 4) * 256; } else if (pn < 20) { base = fk; ldc = 2048; colt = (pn - 12) * 256; }
            else { base = fv; ldc = 2048; colt = (pn - 20) * 256; }
#pragma unroll
            for (int ai = 0; ai < 2; ++ai)
#pragma unroll
                for (int m = 0; m < 4; ++m) { bf16_t* rowp = base + (size_t)(row0 + ai * HALF + m * 16) * ldc + colt + cw;
#pragma unroll
                    for (int bj = 0; bj < 2; ++bj) *(u32x4*)(rowp + bj * HALF) = pack8bf(acc[ai][bj][m][0], acc[ai][bj][m][1]); }
        } else if (pn < 44) {
            const int colt = (pn - 28) * 256 + cw;
#pragma unroll
            for (int bj = 0; bj < 2; ++bj) {
                const f32x4 b0 = *(const f32x4*)(b_gate + colt + bj * HALF), b1 = *(const f32x4*)(b_gate + colt + bj * HALF + 4);
#pragma unroll
                for (int ai = 0; ai < 2; ++ai)
#pragma unroll
                    for (int m = 0; m < 4; ++m) {
                        f32x4 v0 = acc[ai][bj][m][0] + b0, v1 = acc[ai][bj][m][1] + b1;
#pragma unroll
                        for (int e = 0; e < 4; ++e) { v0[e] = 1.f / (1.f + __expf(-v0[e])); v1[e] = 1.f / (1.f + __expf(-v1[e])); }
                        *(u32x4*)(gates + (size_t)(row0 + ai * HALF + m * 16) * 4096 + colt + bj * HALF) = pack8bf(v0, v1); }
            }
        } else {
            if (cw < 64) {
#pragma unroll
                for (int ai = 0; ai < 2; ++ai)
#pragma unroll
                    for (int m = 0; m < 4; ++m) *(u32x4*)(kpe + (size_t)(row0 + ai * HALF + m * 16) * 64 + cw) = pack8bf(acc[ai][0][m][0], acc[ai][0][m][1]);
            } else if (cw < 80) {
                const int h0 = cw - 64;
                const f32x4 b0 = *(const f32x4*)(b_forget + h0), b1 = *(const f32x4*)(b_forget + h0 + 4);
#pragma unroll
                for (int ai = 0; ai < 2; ++ai)
#pragma unroll
                    for (int m = 0; m < 4; ++m) { const int row = row0 + ai * HALF + m * 16;
                        f32x4 z0 = acc[ai][0][m][0] + b0, z1 = acc[ai][0][m][1] + b1;
#pragma unroll
                        for (int e = 0; e < 4; ++e) { z0[e] = fminf(z0[e], 0.f) - __logf(1.f + __expf(-fabsf(z0[e]))); z1[e] = fminf(z1[e], 0.f) - __logf(1.f + __expf(-fabsf(z1[e]))); }
                        *(f32x4*)(lf + (size_t)row * 16 + h0) = z0; *(f32x4*)(lf + (size_t)row * 16 + h0 + 4) = z1; }
            }
        }
    }
};
template <class Epi, class Sched, bool ALIGN_EPI = false, bool SP2 = false>
__device__ __forceinline__ void gemm_phase(PG8_LAS unsigned char* lds, const Gemm g, const Sched& S, const Epi& E) {
    const int tid = threadIdx.x, wid = __builtin_amdgcn_readfirstlane(tid >> 6), lane = tid & 63, wr = wid >> 2, wc = wid & 3, fr = lane & 15, fq = lane >> 4;
    const int K = g.K, nt = K / BK;
    unsigned voffA[2], voffB[2];
#pragma unroll
    for (int i = 0; i < 2; ++i) { int R, C; stage_rc(tid * 16 + i * 8192, R, C); const int Rb = Epi::PERM ? ((R & ~31) + perm32(R & 31)) : R;
        voffA[i] = (unsigned)(R * K + C) * 2u; voffB[i] = (unsigned)(Rb * K + C) * 2u; }
    const size_t kstep = (size_t)(BK * 2);
    const size_t hstep = (size_t)HALF * K * 2;
    const size_t tstep = 2 * hstep;
    const unsigned ldsw = (unsigned)wid * 1024u;
    const int aoff = lds_byte(wr * 64 + fr, fq * 8), boff = lds_byte(wc * 32 + fr, fq * 8);
#define PG8_SA(b, h) (((b) * 2 + (h)) * HTB)
#define PG8_SB(b, h) ((4 + (b) * 2 + (h)) * HTB)
#define PG8_STAGE(bufoff, gbase, voff) do { _Pragma("unroll") for (int _i = 0; _i < 2; ++_i) \
        __builtin_amdgcn_global_load_lds((const unsigned*)((const char*)(gbase) + (voff)[_i]), (PG8_LAS unsigned*)(lds + (bufoff) + ldsw + _i * 8192), 16, 0, 0); } while (0)
#define PG8_LDA(dst, b, h) do { _Pragma("unroll") for (int m = 0; m < 4; ++m) _Pragma("unroll") for (int k = 0; k < 2; ++k) dst[m][k] = *(const PG8_LAS bf16x8*)(lds + PG8_SA(b, h) + aoff + m * 2048 + k * 1024); } while (0)
#define PG8_LDB(dst, b, h) do { _Pragma("unroll") for (int n = 0; n < 2; ++n) _Pragma("unroll") for (int k = 0; k < 2; ++k) dst[n][k] = *(const PG8_LAS bf16x8*)(lds + PG8_SB(b, h) + boff + n * 2048 + k * 1024); } while (0)
#define PG8_MMA(ai, bj, At, Bt) do { __builtin_amdgcn_s_setprio(1); _Pragma("unroll") for (int m = 0; m < 4; ++m) _Pragma("unroll") for (int n = 0; n < 2; ++n) _Pragma("unroll") for (int k = 0; k < 2; ++k) \
        acc[ai][bj][m][n] = __builtin_amdgcn_mfma_f32_16x16x32_bf16(Bt[n][k], At[m][k], acc[ai][bj][m][n], 0, 0, 0); __builtin_amdgcn_s_setprio(0); } while (0)
#define PG8_WAIT_V(n) asm volatile("s_waitcnt vmcnt(" #n ")" ::: "memory")
#define PG8_WAIT_L(n) asm volatile("s_waitcnt lgkmcnt(" #n ")" ::: "memory")
#define PG8_BAR __builtin_amdgcn_s_barrier()
#define PG8_SCHED __builtin_amdgcn_sched_barrier(0)
    Unit cur, nxt; int ui = 0;
    if (!S.next(0, cur)) return;
    f32x4 acc[2][2][4][2];
#pragma unroll
    for (int a = 0; a < 2; ++a)
#pragma unroll
        for (int b = 0; b < 2; ++b)
#pragma unroll
            for (int m = 0; m < 4; ++m)
#pragma unroll
                for (int n = 0; n < 2; ++n) acc[a][b][m][n] = (f32x4){0.f, 0.f, 0.f, 0.f};
    bf16x8 At[4][2], B0[2][2], B1[2][2];
    const char* cA = (const char*)g.A + (size_t)cur.pm * tstep; const char* cB = (const char*)g.Bt + (size_t)cur.pn * tstep;
    S.a_ready(cur);
    if constexpr (SP2) {
        PG8_STAGE(PG8_SB(0, 0), cB, voffB); PG8_STAGE(PG8_SB(0, 1), cB + hstep, voffB); PG8_STAGE(PG8_SA(0, 0), cA, voffA); PG8_STAGE(PG8_SA(0, 1), cA + hstep, voffA);
        if (wr == 1) PG8_BAR;
        PG8_WAIT_V(2); PG8_BAR;
        PG8_STAGE(PG8_SB(1, 0), cB + kstep, voffB); PG8_STAGE(PG8_SA(1, 0), cA + kstep, voffA); PG8_STAGE(PG8_SB(1, 1), cB + hstep + kstep, voffB);
        PG8_WAIT_V(6); PG8_BAR;
    } else {
        PG8_STAGE(PG8_SB(0, 0), cB, voffB); PG8_STAGE(PG8_SA(0, 0), cA, voffA); PG8_STAGE(PG8_SB(0, 1), cB + hstep, voffB); PG8_STAGE(PG8_SA(0, 1), cA + hstep, voffA);
        if (wr == 1) PG8_BAR;
        PG8_WAIT_V(4); PG8_BAR;
        PG8_STAGE(PG8_SB(1, 0), cB + kstep, voffB); PG8_STAGE(PG8_SA(1, 0), cA + kstep, voffA); PG8_STAGE(PG8_SB(1, 1), cB + hstep + kstep, voffB);
        PG8_WAIT_V(6); PG8_BAR;
    }
    for (;;) {
        const bool has_next = S.next(ui + 1, nxt);
        const char* nA = has_next ? (const char*)g.A + (size_t)nxt.pm * tstep : cA; const char* nB = has_next ? (const char*)g.Bt + (size_t)nxt.pn * tstep : cB;
        for (int t = 0; t < nt; t += 2) {
            const bool last = (t == nt - 2);
            const char* a1 = cA + (size_t)(t + 1) * kstep;
            const char* a2 = last ? nA : cA + (size_t)(t + 2) * kstep; const char* b2 = last ? nB : cB + (size_t)(t + 2) * kstep;
            const char* a3 = a2 + kstep; const char* b3 = b2 + kstep;
            if (last && has_next) S.a_ready(nxt);
            if constexpr (SP2) {
            PG8_LDB(B0, 0, 0); PG8_LDB(B1, 0, 1); PG8_SCHED; PG8_LDA(At, 0, 0); PG8_STAGE(PG8_SA(1, 1), a1 + hstep, voffA);
            PG8_WAIT_V(8); PG8_WAIT_L(0); PG8_BAR; PG8_MMA(0, 0, At, B0); PG8_MMA(0, 1, At, B1); PG8_BAR; PG8_SCHED;
            PG8_LDA(At, 0, 1); PG8_STAGE(PG8_SB(0, 0), b2, voffB); PG8_STAGE(PG8_SB(0, 1), b2 + hstep, voffB); PG8_STAGE(PG8_SA(0, 0), a2, voffA);
            PG8_WAIT_V(8); PG8_WAIT_L(0); PG8_BAR; PG8_MMA(1, 0, At, B0); PG8_MMA(1, 1, At, B1); PG8_BAR; PG8_SCHED;
            PG8_LDB(B0, 1, 0); PG8_LDB(B1, 1, 1); PG8_SCHED; PG8_LDA(At, 1, 0); PG8_STAGE(PG8_SA(0, 1), a2 + hstep, voffA);
            PG8_WAIT_V(8); PG8_WAIT_L(0); PG8_BAR; PG8_MMA(0, 0, At, B0); PG8_MMA(0, 1, At, B1); PG8_BAR; PG8_SCHED;
            PG8_LDA(At, 1, 1); PG8_STAGE(PG8_SB(1, 0), b3, voffB); PG8_STAGE(PG8_SB(1, 1), b3 + hstep, voffB); PG8_STAGE(PG8_SA(1, 0), a3, voffA);
            PG8_WAIT_V(8); PG8_WAIT_L(0); PG8_BAR; PG8_MMA(1, 0, At, B0); PG8_MMA(1, 1, At, B1); PG8_BAR; PG8_SCHED;
            } else {
            PG8_LDB(B0, 0, 0); PG8_SCHED; PG8_LDA(At, 0, 0); PG8_STAGE(PG8_SA(1, 1), a1 + hstep, voffA);
            PG8_WAIT_L(8); PG8_BAR; PG8_WAIT_L(0); PG8_MMA(0, 0, At, B0); PG8_BAR; PG8_SCHED;
            PG8_LDB(B1, 0, 1); PG8_STAGE(PG8_SB(0, 0), b2, voffB);
            PG8_BAR; PG8_WAIT_L(0); PG8_MMA(0, 1, At, B1); PG8_BAR;
            PG8_LDA(At, 0, 1); PG8_STAGE(PG8_SA(0, 0), a2, voffA);
            PG8_BAR; PG8_WAIT_L(0); PG8_MMA(1, 0, At, B0); PG8_BAR; PG8_SCHED;
            PG8_STAGE(PG8_SB(0, 1), b2 + hstep, voffB);
            PG8_WAIT_V(6); PG8_BAR; PG8_MMA(1, 1, At, B1); PG8_BAR;
            PG8_LDB(B0, 1, 0); PG8_SCHED; PG8_LDA(At, 1, 0); PG8_STAGE(PG8_SA(0, 1), a2 + hstep, voffA);
            PG8_WAIT_L(8); PG8_BAR; PG8_WAIT_L(0); PG8_MMA(0, 0, At, B0); PG8_BAR; PG8_SCHED;
            PG8_LDB(B1, 1, 1); PG8_STAGE(PG8_SB(1, 0), b3, voffB);
            PG8_BAR; PG8_WAIT_L(0); PG8_MMA(0, 1, At, B1); PG8_BAR;
            PG8_LDA(At, 1, 1); PG8_STAGE(PG8_SA(1, 0), a3, voffA);
            PG8_BAR; PG8_WAIT_L(0); PG8_MMA(1, 0, At, B0); PG8_BAR; PG8_SCHED;
            PG8_STAGE(PG8_SB(1, 1), b3 + hstep, voffB);
            PG8_WAIT_V(6); PG8_BAR; PG8_MMA(1, 1, At, B1); PG8_BAR;
            }
        }
        if constexpr (ALIGN_EPI) { if (wr == 0) PG8_BAR; }
        if constexpr (!Epi::AFTER_DRAIN) { E(acc, cur, wr, wc, fr, fq); S.done(cur); }
        if (!has_next) break;
#pragma unroll
        for (int a = 0; a < 2; ++a)
#pragma unroll
            for (int b = 0; b < 2; ++b)
#pragma unroll
                for (int m = 0; m < 4; ++m)
#pragma unroll
                    for (int n = 0; n < 2; ++n) acc[a][b][m][n] = (f32x4){0.f, 0.f, 0.f, 0.f};
        cur = nxt; cA = nA; cB = nB; ++ui;
        if constexpr (ALIGN_EPI) { if (wr == 1) PG8_BAR; }
    }
    PG8_WAIT_V(0);
    if constexpr (!ALIGN_EPI) { if (wr == 0) PG8_BAR; }
    PG8_BAR;
    if constexpr (Epi::AFTER_DRAIN) { E.fused(acc, cur, wr, wc, fr, fq, lds, wid, lane); S.done(cur); }
#undef PG8_SA
#undef PG8_SB
#undef PG8_STAGE
#undef PG8_LDA
#undef PG8_LDB
#undef PG8_MMA
#undef PG8_WAIT_V
#undef PG8_WAIT_L
#undef PG8_BAR
#undef PG8_SCHED
}
}
using pg8::bf16_t; using pg8::f32x4; using pg8::u32x4;
#define LAS __attribute__((address_space(3)))
constexpr int S = 8192, DM = 2048, INW = 11344, INWP = 11520;
constexpr float EPS = 1e-6f;
constexpr size_t MiB = 1u << 20;

__device__ __forceinline__ float bf2f(bf16_t v) { return __uint_as_float(((unsigned)v) << 16); }
__device__ __forceinline__ bf16_t f2bf(float f) { unsigned u = __float_as_uint(f); u += 0x7fffu + ((u >> 16) & 1u); return (bf16_t)(u >> 16); }
__device__ __forceinline__ unsigned pk2(float lo, float hi) { return (unsigned)f2bf(lo) | ((unsigned)f2bf(hi) << 16); }
__device__ __forceinline__ float wave_sum(float v) {
#pragma unroll
    for (int o = 32; o >= 1; o >>= 1) v += __shfl_xor(v, o);
    return v;
}
__device__ __forceinline__ float wave_max(float v) {
#pragma unroll
    for (int o = 32; o >= 1; o >>= 1) v = fmaxf(v, __shfl_xor(v, o));
    return v;
}

struct Params {
    const float* x; const int* pos; const float *mix_g, *w_in, *b_forget, *b_gate, *q_lat_g, *w_q_up, *kv_lat_g, *w_kv_up, *mla_qg, *mla_kg, *fox_qg, *fox_kg, *w_out, *ffn_g, *w_peer_q, *sub_keys, *peer_u, *peer_v;
    float* out;
    bf16_t *WqT, *WkvT, *WoT, *WpT, *WinT;
    bf16_t *h, *cq, *ckv, *fq, *fk, *fv, *merged, *kpe, *qa, *kvraw, *ka;
    float *lf, *F, *x1, *scores;
};

struct DstId { __device__ __forceinline__ int operator()(int n) const { return n; } };
struct DstWin { __device__ __forceinline__ int operator()(int n) const {
    if (n < 1024) return n; if (n < 1088) return 11264 + (n - 1024); if (n < 7232) return n - 64; if (n < 7248) return 11264 + 64 + (n - 7232); return n - 80; } };
template <class Dst>
__device__ __forceinline__ void transpose_item(const float* __restrict__ W, int K, int N, bf16_t* __restrict__ WT, Dst dst, float* scr, int item, int lane) {
    const int nblk = (N + 31) / 32, kb = item / nblk, nb = item % nblk, k0 = 64 * kb, n0 = 32 * nb;
    { const int n = n0 + (lane & 31);
#pragma unroll 8
      for (int i = 0; i < 32; ++i) { const int kk = 2 * i + (lane >> 5); scr[kk * 33 + (lane & 31)] = (n < N) ? W[(size_t)(k0 + kk) * N + n] : 0.f; } }
    asm volatile("s_waitcnt lgkmcnt(0)" ::: "memory");
    const int c = lane & 7;
#pragma unroll
    for (int j = 0; j < 4; ++j) { const int nl = (lane >> 3) + 8 * j, n = n0 + nl; const float* s = scr + (8 * c) * 33 + nl;
        u32x4 o; o.x = pk2(s[0 * 33], s[1 * 33]); o.y = pk2(s[2 * 33], s[3 * 33]); o.z = pk2(s[4 * 33], s[5 * 33]); o.w = pk2(s[6 * 33], s[7 * 33]);
        if (n < N) *(u32x4*)(WT + (size_t)dst(n) * K + k0 + 8 * c) = o; }
    asm volatile("s_waitcnt lgkmcnt(0)" ::: "memory");
}
__device__ __forceinline__ void wfold_item(const float* __restrict__ wq, const float* __restrict__ keys, bf16_t* __restrict__ WpT, float* sm, int item) {
    const int tid = threadIdx.x, hc = item >> 5, d0 = (item & 31) * 64;
    float* keysL = sm; float* wqL = sm + 128 * 129;
    for (int idx = tid; idx < 128 * 128; idx += 512) keysL[(idx >> 7) * 129 + (idx & 127)] = keys[(size_t)hc * 16384 + idx];
    for (int idx = tid; idx < 64 * 128; idx += 512) wqL[(idx >> 7) * 129 + (idx & 127)] = wq[(size_t)(d0 + (idx >> 7)) * 2048 + hc * 128 + (idx & 127)];
    __syncthreads();
    const int n = tid & 127, dq = tid >> 7;
    float acc[16];
#pragma unroll
    for (int i = 0; i < 16; ++i) acc[i] = 0.f;
    for (int j = 0; j < 128; ++j) { const float kv = keysL[n * 129 + j];
#pragma unroll
        for (int i = 0; i < 16; ++i) acc[i] += kv * wqL[(dq * 16 + i) * 129 + j]; }
    u32x4 o0, o1;
    o0.x = pk2(acc[0], acc[1]); o0.y = pk2(acc[2], acc[3]); o0.z = pk2(acc[4], acc[5]); o0.w = pk2(acc[6], acc[7]);
    o1.x = pk2(acc[8], acc[9]); o1.y = pk2(acc[10], acc[11]); o1.z = pk2(acc[12], acc[13]); o1.w = pk2(acc[14], acc[15]);
    bf16_t* dstp = WpT + (size_t)(hc * 128 + n) * 2048 + d0 + dq * 16;
    *(u32x4*)dstp = o0; *(u32x4*)(dstp + 8) = o1;
    __syncthreads();
}
__device__ __forceinline__ void rms_row2048(const float* __restrict__ xr, const float* __restrict__ g, bf16_t* __restrict__ orow, int lane) {
    f32x4 v[8]; float ss = 0.f;
#pragma unroll
    for (int j = 0; j < 8; ++j) { v[j] = *(const f32x4*)(xr + j * 256 + lane * 4); ss += (v[j][0] * v[j][0] + v[j][1] * v[j][1]) + (v[j][2] * v[j][2] + v[j][3] * v[j][3]); }
    const float r = rsqrtf(wave_sum(ss) * (1.f / 2048.f) + EPS);
#pragma unroll
    for (int j = 0; j < 8; ++j) { const f32x4 gg = *(const f32x4*)(g + j * 256 + lane * 4);
        uint2 o; o.x = pk2(v[j][0] * r * gg[0], v[j][1] * r * gg[1]); o.y = pk2(v[j][2] * r * gg[2], v[j][3] * r * gg[3]);
        *(uint2*)(orow + j * 256 + lane * 4) = o; }
}
__device__ __forceinline__ void rms_row512_inplace(bf16_t* __restrict__ row, const float* __restrict__ g, int lane) {
    u32x4 w = *(const u32x4*)(row + lane * 8); float v[8];
#pragma unroll
    for (int i = 0; i < 4; ++i) { v[2 * i] = __uint_as_float(w[i] << 16); v[2 * i + 1] = __uint_as_float(w[i] & 0xffff0000u); }
    float ss = 0.f;
#pragma unroll
    for (int i = 0; i < 8; ++i) ss += v[i] * v[i];
    const float r = rsqrtf(wave_sum(ss) * (1.f / 512.f) + EPS);
    u32x4 o;
#pragma unroll
    for (int i = 0; i < 4; ++i) o[i] = pk2(v[2 * i] * r * g[lane * 8 + 2 * i], v[2 * i + 1] * r * g[lane * 8 + 2 * i + 1]);
    *(u32x4*)(row + lane * 8) = o;
}
__device__ __forceinline__ void fox_prep(int w, bf16_t* __restrict__ fq, bf16_t* __restrict__ fk, const float* __restrict__ gq, const float* __restrict__ gk, int lane) {
    const int t = w >> 4, h = w & 15;
#pragma unroll
    for (int which = 0; which < 2; ++which) {
        bf16_t* p = (which ? fk : fq) + (size_t)t * 2048 + h * 128; const float* g = which ? gk : gq;
        const float v0 = bf2f(p[lane]), v1 = bf2f(p[lane + 64]);
        const float r = rsqrtf(wave_sum(v0 * v0 + v1 * v1) * (1.f / 128.f) + EPS);
        p[lane] = f2bf(v0 * r * g[lane]); p[lane + 64] = f2bf(v1 * r * g[lane + 64]);
    }
}
__device__ __forceinline__ void fox_cumsum(double* part, int h, const float* __restrict__ lf, float* __restrict__ F) {
    const int tid = threadIdx.x; double sum = 0.0;
    for (int i = 0; i < 16; ++i) sum += (double)lf[(size_t)(tid * 16 + i) * 16 + h];
    part[tid] = sum;
    __syncthreads();
    if (tid == 0) { double run = 0.0; for (int i = 0; i < 512; ++i) { const double v = part[i]; part[i] = run; run += v; } }
    __syncthreads();
    double run = part[tid];
    for (int i = 0; i < 16; ++i) { run += (double)lf[(size_t)(tid * 16 + i) * 16 + h]; F[(size_t)h * S + tid * 16 + i] = (float)run; }
    __syncthreads();
}
__device__ __forceinline__ void rope_cs(int pos, int i, float& c, float& s) {
    const double inv = exp(-(double)i * (1.0 / 32.0) * 9.210340371976184);
    double ang = (double)((float)pos * (float)inv);
    const double twopi = 6.283185307179586;
    ang -= twopi * rint(ang / twopi);
    c = cosf((float)ang); s = sinf((float)ang);
}
__device__ __forceinline__ void mla_prep(int w, bf16_t* __restrict__ qa, const bf16_t* __restrict__ kvraw, const bf16_t* __restrict__ kpe, const int* __restrict__ pos,
                                         const float* __restrict__ gq, const float* __restrict__ gk, bf16_t* __restrict__ ka, int lane) {
    const int t = w >> 4, h = w & 15;
    float c, s; rope_cs(pos[t], lane & 31, c, s);
    {
        bf16_t* q = qa + (size_t)t * 3072 + h * 192;
        float v0 = bf2f(q[lane]), v1 = bf2f(q[lane + 64]), v2 = bf2f(q[lane + 128]);
        const float r = rsqrtf(wave_sum(v0 * v0 + v1 * v1 + v2 * v2) * (1.f / 192.f) + EPS);
        v0 *= r * gq[lane]; v1 *= r * gq[lane + 64]; v2 *= r * gq[lane + 128];
        const float o = __shfl_xor(v2, 32);
        const float rr = lane < 32 ? v2 * c - o * s : o * s + v2 * c;
        q[lane] = f2bf(v0); q[lane + 64] = f2bf(v1); q[lane + 128] = f2bf(rr);
    }
    {
        const bf16_t* kn = kvraw + (size_t)t * 4096 + h * 256;
        float v0 = bf2f(kn[lane]), v1 = bf2f(kn[lane + 64]), v2 = bf2f(kpe[(size_t)t * 64 + lane]);
        const float r = rsqrtf(wave_sum(v0 * v0 + v1 * v1 + v2 * v2) * (1.f / 192.f) + EPS);
        v0 *= r * gk[lane]; v1 *= r * gk[lane + 64]; v2 *= r * gk[lane + 128];
        const float o = __shfl_xor(v2, 32);
        const float rr = lane < 32 ? v2 * c - o * s : o * s + v2 * c;
        bf16_t* k = ka + (size_t)t * 3072 + h * 192;
        k[lane] = f2bf(v0); k[lane + 64] = f2bf(v1); k[lane + 128] = f2bf(rr);
    }
}

template <int DK, bool FOX>
__device__ __forceinline__ void attn_naive(float* sm, int qb, int h, const bf16_t* __restrict__ Q, int ldq, const bf16_t* __restrict__ K, int ldk, const bf16_t* __restrict__ V, int ldv, int vstride,
                                           const float* __restrict__ F, bf16_t* __restrict__ merged, int col0, float scale) {
    constexpr int LQ = DK + 1;
    float* Qs = sm; float* Ks = Qs + 64 * LQ; float* Vs = Ks + 64 * LQ; float* Ps = Vs + 64 * 128; float* mrow = Ps + 64 * 65; float* lrow = mrow + 64; float* arow = lrow + 64;
    const int tid = threadIdx.x, tl = tid & 255, half = tid >> 8, ty = tl >> 4, tx = tl & 15;
    const int q0 = qb * 64;
    for (int idx = tid; idx < 64 * DK; idx += 512) { const int r = idx / DK, d = idx % DK; Qs[r * LQ + d] = bf2f(Q[(size_t)(q0 + r) * ldq + h * DK + d]); }
    if (tid < 64) { mrow[tid] = -INFINITY; lrow[tid] = 0.f; }
    float o[4][4];
#pragma unroll
    for (int i = 0; i < 4; ++i)
#pragma unroll
        for (int c = 0; c < 4; ++c) o[i][c] = 0.f;
    float fqv[4];
#pragma unroll
    for (int i = 0; i < 4; ++i) fqv[i] = FOX ? F[(size_t)h * S + q0 + ty * 4 + i] : 0.f;
    __syncthreads();
    for (int kb = 0; kb <= qb; ++kb) {
        const int k0 = kb * 64;
        for (int idx = tid; idx < 64 * DK; idx += 512) { const int r = idx / DK, d = idx % DK; Ks[r * LQ + d] = bf2f(K[(size_t)(k0 + r) * ldk + h * DK + d]); }
        for (int idx = tid; idx < 64 * 128; idx += 512) { const int r = idx >> 7, d = idx & 127; Vs[r * 128 + d] = bf2f(V[(size_t)(k0 + r) * ldv + h * vstride + d]); }
        __syncthreads();
        float sacc[4][2];
#pragma unroll
        for (int i = 0; i < 4; ++i) { sacc[i][0] = 0.f; sacc[i][1] = 0.f; }
        for (int d = 0; d < DK; ++d) {
            float a[4], b[2];
#pragma unroll
            for (int i = 0; i < 4; ++i) a[i] = Qs[(ty * 4 + i) * LQ + d];
#pragma unroll
            for (int j = 0; j < 2; ++j) b[j] = Ks[(half * 32 + tx + 16 * j) * LQ + d];
#pragma unroll
            for (int i = 0; i < 4; ++i) { sacc[i][0] += a[i] * b[0]; sacc[i][1] += a[i] * b[1]; }
        }
#pragma unroll
        for (int j = 0; j < 2; ++j) {
            const int kc = half * 32 + tx + 16 * j, kpos = k0 + kc;
            const float fkv = FOX ? F[(size_t)h * S + kpos] : 0.f;
#pragma unroll
            for (int i = 0; i < 4; ++i) {
                const int qr = ty * 4 + i, qpos = q0 + qr;
                float v = sacc[i][j] * scale;
                if (FOX) v += fqv[i] - fkv;
                if (kpos > qpos) v = -INFINITY;
                Ps[qr * 65 + kc] = v;
            }
        }
        __syncthreads();
        {
            const int r = tid >> 3, part = tid & 7;
            float* pr = Ps + r * 65 + part * 8;
            float mx = -INFINITY;
#pragma unroll
            for (int c = 0; c < 8; ++c) mx = fmaxf(mx, pr[c]);
            mx = fmaxf(mx, __shfl_xor(mx, 1)); mx = fmaxf(mx, __shfl_xor(mx, 2)); mx = fmaxf(mx, __shfl_xor(mx, 4));
            const float mo = mrow[r];
            const float mn = fmaxf(mo, mx);
            float sum = 0.f;
#pragma unroll
            for (int c = 0; c < 8; ++c) { const float p = __expf(pr[c] - mn); pr[c] = p; sum += p; }
            sum += __shfl_xor(sum, 1); sum += __shfl_xor(sum, 2); sum += __shfl_xor(sum, 4);
            const float al = __expf(mo - mn);
            if (part == 0) { lrow[r] = lrow[r] * al + sum; mrow[r] = mn; arow[r] = al; }
        }
        __syncthreads();
#pragma unroll
        for (int i = 0; i < 4; ++i) { const float al = arow[ty * 4 + i];
#pragma unroll
            for (int c = 0; c < 4; ++c) o[i][c] *= al; }
        for (int k = 0; k < 64; ++k) {
            float p[4], v[4];
#pragma unroll
            for (int i = 0; i < 4; ++i) p[i] = Ps[(ty * 4 + i) * 65 + k];
#pragma unroll
            for (int c = 0; c < 4; ++c) v[c] = Vs[k * 128 + half * 64 + tx * 4 + c];
#pragma unroll
            for (int i = 0; i < 4; ++i)
#pragma unroll
                for (int c = 0; c < 4; ++c) o[i][c] += p[i] * v[c];
        }
        __syncthreads();
    }
#pragma unroll
    for (int i = 0; i < 4; ++i) {
        const int qr = ty * 4 + i; const float inv = 1.f / lrow[qr];
#pragma unroll
        for (int c = 0; c < 4; ++c) {
            bf16_t* mp = merged + (size_t)(q0 + qr) * 4096 + col0 + h * 128 + half * 64 + tx * 4 + c;
            *mp = f2bf(o[i][c] * inv * bf2f(*mp));
        }
    }
    __syncthreads();
}

__device__ __forceinline__ void wave_argmax(float& v, int& i) {
#pragma unroll
    for (int o = 32; o >= 1; o >>= 1) {
        const float ov = __shfl_xor(v, o); const int oi = __shfl_xor(i, o);
        if (ov > v || (ov == v && oi < i)) { v = ov; i = oi; }
    }
}
__device__ __forceinline__ void peer_token(float* red, int t, const float* __restrict__ x1, const bf16_t* __restrict__ h2, const float* __restrict__ scores,
                                           const float* __restrict__ U, const float* __restrict__ Vt, float* __restrict__ out) {
    const int tid = threadIdx.x, h = tid >> 6, lane = tid & 63;
    const float* sc = scores + (size_t)t * 2048 + h * 256;
    float sv[2]; int si[2];
#pragma unroll
    for (int c = 0; c < 2; ++c) {
        float a0 = sc[c * 128 + lane], a1 = sc[c * 128 + 64 + lane];
        float mv = -INFINITY; int mi = 0;
        for (int k = 0; k < 16; ++k) {
            float bv; int bi;
            if (a0 >= a1) { bv = a0; bi = lane; } else { bv = a1; bi = lane + 64; }
            wave_argmax(bv, bi);
            if (bi == lane) a0 = -INFINITY;
            if (bi == lane + 64) a1 = -INFINITY;
            if (lane == k) { mv = bv; mi = bi; }
        }
        sv[c] = mv; si[c] = mi;
    }
    float cand[4];
#pragma unroll
    for (int m = 0; m < 4; ++m) cand[m] = __shfl(sv[0], (lane >> 4) + 4 * m) + __shfl(sv[1], lane & 15);
    float ts = -INFINITY; int tp = 0;
    for (int k = 0; k < 16; ++k) {
        float bv = cand[0]; int bp = lane;
#pragma unroll
        for (int m = 1; m < 4; ++m) if (cand[m] > bv) { bv = cand[m]; bp = lane + 64 * m; }
        wave_argmax(bv, bp);
#pragma unroll
        for (int m = 0; m < 4; ++m) if (bp == lane + 64 * m) cand[m] = -INFINITY;
        if (lane == k) { ts = bv; tp = bp; }
    }
    const int expert = __shfl(si[0], tp >> 4) * 128 + __shfl(si[1], tp & 15);
    const float mx = wave_max(ts);
    const float e = lane < 16 ? __expf(ts - mx) : 0.f;
    const float gate = e / wave_sum(e);
    float hr[32];
#pragma unroll
    for (int j = 0; j < 8; ++j) { const uint2 w = *(const uint2*)(h2 + (size_t)t * DM + j * 256 + lane * 4);
        hr[j * 4] = __uint_as_float(w.x << 16); hr[j * 4 + 1] = __uint_as_float(w.x & 0xffff0000u); hr[j * 4 + 2] = __uint_as_float(w.y << 16); hr[j * 4 + 3] = __uint_as_float(w.y & 0xffff0000u); }
    float acc[32];
#pragma unroll
    for (int i = 0; i < 32; ++i) acc[i] = 0.f;
    for (int k = 0; k < 16; ++k) {
        const int ek = __shfl(expert, k); const float gk = __shfl(gate, k);
        const float* up = U + (size_t)ek * DM;
        float dot = 0.f;
#pragma unroll
        for (int j = 0; j < 8; ++j) { const float4 u4 = *(const float4*)(up + j * 256 + lane * 4);
            dot += hr[j * 4] * u4.x + hr[j * 4 + 1] * u4.y + hr[j * 4 + 2] * u4.z + hr[j * 4 + 3] * u4.w; }
        dot = wave_sum(dot);
        const float w = gk * 0.5f * dot * (1.f + erff(dot * 0.70710678118654752f));
        const float* vp = Vt + (size_t)ek * DM;
#pragma unroll
        for (int j = 0; j < 8; ++j) { const float4 v4 = *(const float4*)(vp + j * 256 + lane * 4);
            acc[j * 4] += w * v4.x; acc[j * 4 + 1] += w * v4.y; acc[j * 4 + 2] += w * v4.z; acc[j * 4 + 3] += w * v4.w; }
    }
#pragma unroll
    for (int j = 0; j < 8; ++j) *(float4*)(red + h * 2048 + j * 256 + lane * 4) = make_float4(acc[j * 4], acc[j * 4 + 1], acc[j * 4 + 2], acc[j * 4 + 3]);
    __syncthreads();
    { const int i = tid * 4;
      float4 s = *(const float4*)(x1 + (size_t)t * DM + i);
#pragma unroll
      for (int w = 0; w < 8; ++w) { const float4 r = *(const float4*)(red + w * 2048 + i); s.x += r.x; s.y += r.y; s.z += r.z; s.w += r.w; }
      *(float4*)(out + (size_t)t * DM + i) = s; }
    __syncthreads();
}

constexpr int LDS_BYTES = 149504;
__global__ __launch_bounds__(512, 2) void mega(Params p) {
    extern __shared__ __attribute__((aligned(16))) unsigned char smem[];
    cg::grid_group grid = cg::this_grid();
    float* smf = (float*)smem;
    LAS unsigned char* lds = (LAS unsigned char*)smem;
    const int tid = threadIdx.x, lane = tid & 63, wave = __builtin_amdgcn_readfirstlane(tid >> 6);
    const int G = gridDim.x, b = blockIdx.x, gw = b * 8 + wave, NGW = G * 8;

    {
        float* scr = smf + wave * 4096;
        constexpr int I_IN = 32 * 355, I_Q = 8 * 96, I_KV = 8 * 128, I_O = 64 * 64;
        for (int it = gw; it < I_IN + I_Q + I_KV + I_O; it += NGW) {
            int r = it;
            if (r < I_IN) { transpose_item(p.w_in, 2048, INW, p.WinT, DstWin(), scr, r, lane); continue; } r -= I_IN;
            if (r < I_Q) { transpose_item(p.w_q_up, 512, 3072, p.WqT, DstId(), scr, r, lane); continue; } r -= I_Q;
            if (r < I_KV) { transpose_item(p.w_kv_up, 512, 4096, p.WkvT, DstId(), scr, r, lane); continue; } r -= I_KV;
            transpose_item(p.w_out, 4096, 2048, p.WoT, DstId(), scr, r, lane);
        }
        for (int m = gw; m < S; m += NGW) rms_row2048(p.x + (size_t)m * DM, p.mix_g, p.h + (size_t)m * DM, lane);
        __syncthreads();
        for (int it = b; it < 512; it += G) wfold_item(p.w_peer_q, p.sub_keys, p.WpT, smf, it);
    }
    grid.sync();
    {
        pg8::Gemm g{p.h, p.WinT, S, INWP, DM}; pg8::StaticOrder so; so.init(S, INWP, G, b);
        pg8::EpiInProj E{p.cq, p.ckv, p.fq, p.fk, p.fv, p.merged, p.kpe, p.lf, p.b_gate, p.b_forget};
        pg8::gemm_phase<pg8::EpiInProj, pg8::StaticOrder, true, true>(lds, g, so, E);
    }
    grid.sync();
    for (int t = gw; t < S; t += NGW) { rms_row512_inplace(p.cq + (size_t)t * 512, p.q_lat_g, lane); rms_row512_inplace(p.ckv + (size_t)t * 512, p.kv_lat_g, lane); }
    for (int w = gw; w < S * 16; w += NGW) fox_prep(w, p.fq, p.fk, p.fox_qg, p.fox_kg, lane);
    for (int hh = b; hh < 16; hh += G) fox_cumsum((double*)smem, hh, p.lf, p.F);
    grid.sync();
    {
        pg8::Gemm g{p.cq, p.WqT, S, 3072, 512}; pg8::StaticOrder so; so.init(S, 3072, G, b);
        pg8::EpiStoreBf16 E{p.qa, 3072};
        pg8::gemm_phase<pg8::EpiStoreBf16, pg8::StaticOrder, true, true>(lds, g, so, E);
    }
    {
        pg8::Gemm g{p.ckv, p.WkvT, S, 4096, 512}; pg8::StaticOrder so; so.init(S, 4096, G, b);
        pg8::EpiStoreBf16 E{p.kvraw, 4096};
        pg8::gemm_phase<pg8::EpiStoreBf16, pg8::StaticOrder, true, true>(lds, g, so, E);
    }
    grid.sync();
    for (int w = gw; w < S * 16; w += NGW) mla_prep(w, p.qa, p.kvraw, p.kpe, p.pos, p.mla_qg, p.mla_kg, p.ka, lane);
    grid.sync();
    for (int it = b; it < 2 * 16 * 128; it += G) {
        const int qb = 127 - it / 32, r = it % 32, br = r >> 4, hh = r & 15;
        if (br == 0) attn_naive<192, false>(smf, qb, hh, p.qa, 3072, p.ka, 3072, p.kvraw + 128, 4096, 256, nullptr, p.merged, 0, 0.07216878364870322f);
        else attn_naive<128, true>(smf, qb, hh, p.fq, 2048, p.fk, 2048, p.fv, 2048, 128, p.F, p.merged, 2048, 0.08838834764831845f);
    }
    grid.sync();
    {
        pg8::Gemm g{p.merged, p.WoT, S, 2048, 4096}; pg8::StaticOrder so; so.init(S, 2048, G, b);
        pg8::EpiStoreF32<true> E{p.x1, p.x, 2048};
        pg8::gemm_phase<pg8::EpiStoreF32<true>, pg8::StaticOrder, true, true>(lds, g, so, E);
    }
    grid.sync();
    for (int m = gw; m < S; m += NGW) rms_row2048(p.x1 + (size_t)m * DM, p.ffn_g, p.h + (size_t)m * DM, lane);
    grid.sync();
    {
        pg8::Gemm g{p.h, p.WpT, S, 2048, 2048}; pg8::StaticOrder so; so.init(S, 2048, G, b);
        pg8::EpiStoreF32<false> E{p.scores, nullptr, 2048};
        pg8::gemm_phase<pg8::EpiStoreF32<false>, pg8::StaticOrder, true, true>(lds, g, so, E);
    }
    grid.sync();
    for (int t = b; t < S; t += G) peer_token(smf, t, p.x1, p.h, p.scores, p.peer_u, p.peer_v, p.out);
}

extern "C" void kernel_launch(void* const* d_in, const int* in_sizes, int n_in,
                              void* d_out, int out_size, void* d_ws, size_t ws_size,
                              hipStream_t stream) {
    if (ws_size < 512 * MiB) { fprintf(stderr, "kernel_launch: workspace too small (%zu)\n", ws_size); return; }
    Params p{};
    p.x = (const float*)d_in[0]; p.pos = (const int*)d_in[1]; p.mix_g = (const float*)d_in[2]; p.w_in = (const float*)d_in[3];
    p.b_forget = (const float*)d_in[4]; p.b_gate = (const float*)d_in[5]; p.q_lat_g = (const float*)d_in[6]; p.w_q_up = (const float*)d_in[7];
    p.kv_lat_g = (const float*)d_in[8]; p.w_kv_up = (const float*)d_in[9]; p.mla_qg = (const float*)d_in[10]; p.mla_kg = (const float*)d_in[11];
    p.fox_qg = (const float*)d_in[12]; p.fox_kg = (const float*)d_in[13]; p.w_out = (const float*)d_in[14]; p.ffn_g = (const float*)d_in[15];
    p.w_peer_q = (const float*)d_in[16]; p.sub_keys = (const float*)d_in[17]; p.peer_u = (const float*)d_in[18]; p.peer_v = (const float*)d_in[19];
    p.out = (float*)d_out;
    char* ws = (char*)d_ws;
    p.WqT = (bf16_t*)(ws + 1 * MiB); p.WkvT = (bf16_t*)(ws + 5 * MiB); p.WoT = (bf16_t*)(ws + 9 * MiB); p.WpT = (bf16_t*)(ws + 25 * MiB); p.WinT = (bf16_t*)(ws + 33 * MiB);
    p.h = (bf16_t*)(ws + 78 * MiB); p.cq = (bf16_t*)(ws + 110 * MiB); p.ckv = (bf16_t*)(ws + 118 * MiB);
    p.fq = (bf16_t*)(ws + 126 * MiB); p.fk = (bf16_t*)(ws + 158 * MiB); p.fv = (bf16_t*)(ws + 190 * MiB); p.merged = (bf16_t*)(ws + 222 * MiB);
    p.kpe = (bf16_t*)(ws + 286 * MiB); p.lf = (float*)(ws + 287 * MiB); p.F = (float*)(ws + 287 * MiB + 512 * 1024);
    p.qa = (bf16_t*)(ws + 288 * MiB); p.kvraw = (bf16_t*)(ws + 336 * MiB); p.ka = (bf16_t*)(ws + 400 * MiB); p.x1 = (float*)(ws + 448 * MiB);
    p.scores = (float*)(ws + 288 * MiB);

    static int grid_blocks = 0;
    if (!grid_blocks) {
        if (hipFuncSetAttribute((const void*)mega, hipFuncAttributeMaxDynamicSharedMemorySize, LDS_BYTES) != hipSuccess) { fprintf(stderr, "hipFuncSetAttribute failed\n"); return; }
        int dev = 0, cus = 0, per_cu = 0;
        (void)hipGetDevice(&dev);
        (void)hipDeviceGetAttribute(&cus, hipDeviceAttributeMultiprocessorCount, dev);
        (void)hipOccupancyMaxActiveBlocksPerMultiprocessor(&per_cu, (const void*)mega, 512, LDS_BYTES);
        if (per_cu < 1 || cus < 1) { fprintf(stderr, "occupancy query says %d blocks/CU on %d CUs\n", per_cu, cus); return; }
        grid_blocks = cus;
    }
    void* args[] = {&p};
    hipError_t e = hipLaunchCooperativeKernel((const void*)mega, dim3(grid_blocks), dim3(512), args, LDS_BYTES, stream);
    if (e != hipSuccess) fprintf(stderr, "cooperative launch failed: %s (grid %d)\n", hipGetErrorString(e), grid_blocks);
}
```

```cpp
#include <hip/hip_runtime.h>
#include <hip/hip_cooperative_groups.h>
#include <stdint.h>
#include <math.h>
#include <cstdio>
namespace cg = cooperative_groups;

namespace pg8 {
#define PG8_LAS __attribute__((address_space(3)))
typedef unsigned short bf16_t;
typedef short bf16x8 __attribute__((ext_vector_type(8)));
typedef float f32x4 __attribute__((ext_vector_type(4)));
typedef unsigned u32x4 __attribute__((ext_vector_type(4)));
constexpr int BM = 256, BK = 64, HALF = 128, HTB = HALF * BK * 2  , STAGE_BYTES = 8 * HTB, NXCD = 8, WGM = 8;

__host__ __device__ __forceinline__ int lds_byte(int r, int c) { const int st = (r >> 4) * 2 + (c >> 5), rr = r & 15, cc = c & 31, ob = rr * 64 + cc * 2; return st * 1024 + (ob ^ (((ob >> 9) & 1) << 5)); }
__host__ __device__ __forceinline__ void stage_rc(int b, int& R, int& C) { const int st = b / 1024, sb = b % 1024, swz = sb ^ (((sb >> 9) & 1) << 5); R = (st >> 1) * 16 + swz / 64; C = (st & 1) * 32 + (swz % 64) / 2; }
__host__ __device__ __forceinline__ int perm32(int rho) { const int n = rho >> 4, i = rho & 15; return 8 * (i >> 2) + 4 * n + (i & 3); }

struct Unit { int pm, pn; };
struct Gemm { const bf16_t* A; const bf16_t* Bt; int M, N, K; };

struct StaticOrder {
    int nM, nN, nwg, G, c;
    __host__ __device__ void init(int M, int N, int G_, int c_) { nM = M / BM; nN = N / BM; nwg = nM * nN; G = G_; c = c_; }
    __host__ __device__ bool next(int i, Unit& u) const {
        const long L = (long)i * G + c; if (L >= nwg) return false;
        int wgid = (int)L; { const int q = nwg / NXCD, r = nwg % NXCD, xcd = wgid % NXCD, off = wgid / NXCD; wgid = (xcd < r ? xcd * (q + 1) : r * (q + 1) + (xcd - r) * q) + off; }
        const int nig = WGM * nN, gid = wgid / nig, fm = gid * WGM, gsz = (nM - fm) < WGM ? (nM - fm) : WGM;
        u.pm = fm + ((wgid % nig) % gsz); u.pn = (wgid % nig) / gsz; return true;
    }
    __device__ __forceinline__ void a_ready(const Unit&) const {}
    __device__ __forceinline__ void done(const Unit&) const {}
};

__device__ __forceinline__ unsigned cvt_pk_bf16(float lo, float hi) { unsigned r; asm volatile("v_cvt_pk_bf16_f32 %0, %1, %2" : "=v"(r) : "v"(lo), "v"(hi)); return r; }
__device__ __forceinline__ u32x4 pack8bf(const f32x4& v0, const f32x4& v1) { u32x4 w; w.x = cvt_pk_bf16(v0[0], v0[1]); w.y = cvt_pk_bf16(v0[2], v0[3]); w.z = cvt_pk_bf16(v1[0], v1[1]); w.w = cvt_pk_bf16(v1[2], v1[3]); return w; }

struct EpiStoreBf16 {
    static constexpr bool PERM = true, AFTER_DRAIN = false;
    bf16_t* O; int ldc;
    __device__ __forceinline__ void operator()(const f32x4 (&acc)[2][2][4][2], const Unit& u, int wr, int wc, int fr, int fq) const {
        const int row0 = u.pm * BM + wr * 64 + fr, col0 = u.pn * BM + wc * 32 + 8 * fq;
#pragma unroll
        for (int ai = 0; ai < 2; ++ai)
#pragma unroll
            for (int m = 0; m < 4; ++m) { bf16_t* rowp = O + (size_t)(row0 + ai * HALF + m * 16) * ldc + col0;
#pragma unroll
                for (int bj = 0; bj < 2; ++bj) *(u32x4*)(rowp + bj * HALF) = pack8bf(acc[ai][bj][m][0], acc[ai][bj][m][1]); }
    }
};
template <bool RES> struct EpiStoreF32 {
    static constexpr bool PERM = true, AFTER_DRAIN = false;
    float* O; const float* res; int ldc;
    __device__ __forceinline__ void operator()(const f32x4 (&acc)[2][2][4][2], const Unit& u, int wr, int wc, int fr, int fq) const {
        const int row0 = u.pm * BM + wr * 64 + fr, col0 = u.pn * BM + wc * 32 + 8 * fq;
#pragma unroll
        for (int ai = 0; ai < 2; ++ai)
#pragma unroll
            for (int m = 0; m < 4; ++m) { const size_t off = (size_t)(row0 + ai * HALF + m * 16) * ldc + col0;
#pragma unroll
                for (int bj = 0; bj < 2; ++bj) { f32x4 v0 = acc[ai][bj][m][0], v1 = acc[ai][bj][m][1];
                    if (RES) { v0 += *(const f32x4*)(res + off + bj * HALF); v1 += *(const f32x4*)(res + off + bj * HALF + 4); }
                    *(f32x4*)(O + off + bj * HALF) = v0; *(f32x4*)(O + off + bj * HALF + 4) = v1; } }
    }
};
struct EpiInProj {
    static constexpr bool PERM = true, AFTER_DRAIN = false;
    bf16_t *cq, *ckv, *fq, *fk, *fv, *gates, *kpe; float* lf; const float *b_gate, *b_forget;
    __device__ __forceinline__ void operator()(const f32x4 (&acc)[2][2][4][2], const Unit& u, int wr, int wc, int fr, int fq_) const {
        const int pn = u.pn, row0 = u.pm * BM + wr * 64 + fr, cw = wc * 32 + 8 * fq_;
        if (pn < 28) {
            bf16_t* base; int ldc, colt;
            if (pn < 2) { base = cq; ldc = 512; colt = pn * 256; } else if (pn < 4) { base = ckv; ldc = 512; colt = (pn - 2) * 256; }
            else if (pn < 12) { base = fq; ldc = 2048; colt = (pn - 4) * 256; } else if (pn < 20) { base = fk; ldc = 2048; colt = (pn - 12) * 256; }
            else { base = fv; ldc = 2048; colt = (pn - 20) * 256; }
#pragma unroll
            for (int ai = 0; ai < 2; ++ai)
#pragma unroll
                for (int m = 0; m < 4; ++m) { bf16_t* rowp = base + (size_t)(row0 + ai * HALF + m * 16) * ldc + colt + cw;
#pragma unroll
                    for (int bj = 0; bj < 2; ++bj) *(u32x4*)(rowp + bj * HALF) = pack8bf(acc[ai][bj][m][0], acc[ai][bj][m][1]); }
        } else if (pn < 44) {
            const int colt = (pn - 28) * 256 + cw;
#pragma unroll
            for (int bj = 0; bj < 2; ++bj) {
                const f32x4 b0 = *(const f32x4*)(b_gate + colt + bj * HALF), b1 = *(const f32x4*)(b_gate + colt + bj * HALF + 4);
#pragma unroll
                for (int ai = 0; ai < 2; ++ai)
#pragma unroll
                    for (int m = 0; m < 4; ++m) {
                        f32x4 v0 = acc[ai][bj][m][0] + b0, v1 = acc[ai][bj][m][1] + b1;
#pragma unroll
                        for (int e = 0; e < 4; ++e) { v0[e] = 1.f / (1.f + __expf(-v0[e])); v1[e] = 1.f / (1.f + __expf(-v1[e])); }
                        *(u32x4*)(gates + (size_t)(row0 + ai * HALF + m * 16) * 4096 + colt + bj * HALF) = pack8bf(v0, v1); }
            }
        } else {
            if (cw < 64) {
#pragma unroll
                for (int ai = 0; ai < 2; ++ai)
#pragma unroll
                    for (int m = 0; m < 4; ++m) *(u32x4*)(kpe + (size_t)(row0 + ai * HALF + m * 16) * 64 + cw) = pack8bf(acc[ai][0][m][0], acc[ai][0][m][1]);
            } else if (cw < 80) {
                const int h0 = cw - 64;
                const f32x4 b0 = *(const f32x4*)(b_forget + h0), b1 = *(const f32x4*)(b_forget + h0 + 4);
#pragma unroll
                for (int ai = 0; ai < 2; ++ai)
#pragma unroll
                    for (int m = 0; m < 4; ++m) { const int row = row0 + ai * HALF + m * 16;
                        f32x4 z0 = acc[ai][0][m][0] + b0, z1 = acc[ai][0][m][1] + b1;
#pragma unroll
                        for (int e = 0; e < 4; ++e) { z0[e] = fminf(z0[e], 0.f) - __logf(1.f + __expf(-fabsf(z0[e]))); z1[e] = fminf(z1[e], 0.f) - __logf(1.f + __expf(-fabsf(z1[e]))); }
                        *(f32x4*)(lf + (size_t)row * 16 + h0) = z0; *(f32x4*)(lf + (size_t)row * 16 + h0 + 4) = z1; }
            }
        }
    }
};
template <class Epi, class Sched, bool ALIGN_EPI = false, bool SP2 = false>
__device__ __forceinline__ void gemm_phase(PG8_LAS unsigned char* lds, const Gemm g, const Sched& S, const Epi& E) {
    const int tid = threadIdx.x, wid = __builtin_amdgcn_readfirstlane(tid >> 6), lane = tid & 63, wr = wid >> 2, wc = wid & 3, fr = lane & 15, fq = lane >> 4;
    const int K = g.K, nt = K / BK;
    unsigned voffA[2], voffB[2];
#pragma unroll
    for (int i = 0; i < 2; ++i) { int R, C; stage_rc(tid * 16 + i * 8192, R, C); const int Rb = Epi::PERM ? ((R & ~31) + perm32(R & 31)) : R;
        voffA[i] = (unsigned)(R * K + C) * 2u; voffB[i] = (unsigned)(Rb * K + C) * 2u; }
    const size_t kstep = (size_t)(BK * 2);
    const size_t hstep = (size_t)HALF * K * 2;
    const size_t tstep = 2 * hstep;
    const unsigned ldsw = (unsigned)wid * 1024u;
    const int aoff = lds_byte(wr * 64 + fr, fq * 8), boff = lds_byte(wc * 32 + fr, fq * 8);
#define PG8_SA(b, h) (((b) * 2 + (h)) * HTB)
#define PG8_SB(b, h) ((4 + (b) * 2 + (h)) * HTB)
#define PG8_STAGE(bufoff, gbase, voff) do { _Pragma("unroll") for (int _i = 0; _i < 2; ++_i) \
        __builtin_amdgcn_global_load_lds((const unsigned*)((const char*)(gbase) + (voff)[_i]), (PG8_LAS unsigned*)(lds + (bufoff) + ldsw + _i * 8192), 16, 0, 0); } while (0)
#define PG8_LDA(dst, b, h) do { _Pragma("unroll") for (int m = 0; m < 4; ++m) _Pragma("unroll") for (int k = 0; k < 2; ++k) dst[m][k] = *(const PG8_LAS bf16x8*)(lds + PG8_SA(b, h) + aoff + m * 2048 + k * 1024); } while (0)
#define PG8_LDB(dst, b, h) do { _Pragma("unroll") for (int n = 0; n < 2; ++n) _Pragma("unroll") for (int k = 0; k < 2; ++k) dst[n][k] = *(const PG8_LAS bf16x8*)(lds + PG8_SB(b, h) + boff + n * 2048 + k * 1024); } while (0)
#define PG8_MMA(ai, bj, At, Bt) do { __builtin_amdgcn_s_setprio(1); _Pragma("unroll") for (int m = 0; m < 4; ++m) _Pragma("unroll") for (int n = 0; n < 2; ++n) _Pragma("unroll") for (int k = 0; k < 2; ++k) \
        acc[ai][bj][m][n] = __builtin_amdgcn_mfma_f32_16x16x32_bf16(Bt[n][k], At[m][k], acc[ai][bj][m][n], 0, 0, 0); __builtin_amdgcn_s_setprio(0); } while (0)
#define PG8_WAIT_V(n) asm volatile("s_waitcnt vmcnt(" #n ")" ::: "memory")
#define PG8_WAIT_L(n) asm volatile("s_waitcnt lgkmcnt(" #n ")" ::: "memory")
#define PG8_BAR __builtin_amdgcn_s_barrier()
#define PG8_SCHED __builtin_amdgcn_sched_barrier(0)
    Unit cur, nxt; int ui = 0;
    if (!S.next(0, cur)) return;
    f32x4 acc[2][2][4][2];
#pragma unroll
    for (int a = 0; a < 2; ++a)
#pragma unroll
        for (int b = 0; b < 2; ++b)
#pragma unroll
            for (int m = 0; m < 4; ++m)
#pragma unroll
                for (int n = 0; n < 2; ++n) acc[a][b][m][n] = (f32x4){0.f, 0.f, 0.f, 0.f};
    bf16x8 At[4][2], B0[2][2], B1[2][2];
    const char* cA = (const char*)g.A + (size_t)cur.pm * tstep; const char* cB = (const char*)g.Bt + (size_t)cur.pn * tstep;
    S.a_ready(cur);
    if constexpr (SP2) {
        PG8_STAGE(PG8_SB(0, 0), cB, voffB); PG8_STAGE(PG8_SB(0, 1), cB + hstep, voffB); PG8_STAGE(PG8_SA(0, 0), cA, voffA); PG8_STAGE(PG8_SA(0, 1), cA + hstep, voffA);
        if (wr == 1) PG8_BAR;
        PG8_WAIT_V(2); PG8_BAR;
        PG8_STAGE(PG8_SB(1, 0), cB + kstep, voffB); PG8_STAGE(PG8_SA(1, 0), cA + kstep, voffA); PG8_STAGE(PG8_SB(1, 1), cB + hstep + kstep, voffB);
        PG8_WAIT_V(6); PG8_BAR;
    } else {
        PG8_STAGE(PG8_SB(0, 0), cB, voffB); PG8_STAGE(PG8_SA(0, 0), cA, voffA); PG8_STAGE(PG8_SB(0, 1), cB + hstep, voffB); PG8_STAGE(PG8_SA(0, 1), cA + hstep, voffA);
        if (wr == 1) PG8_BAR;
        PG8_WAIT_V(4); PG8_BAR;
        PG8_STAGE(PG8_SB(1, 0), cB + kstep, voffB); PG8_STAGE(PG8_SA(1, 0), cA + kstep, voffA); PG8_STAGE(PG8_SB(1, 1), cB + hstep + kstep, voffB);
        PG8_WAIT_V(6); PG8_BAR;
    }
    for (;;) {
        const bool has_next = S.next(ui + 1, nxt);
        const char* nA = has_next ? (const char*)g.A + (size_t)nxt.pm * tstep : cA; const char* nB = has_next ? (const char*)g.Bt + (size_t)nxt.pn * tstep : cB;
        for (int t = 0; t < nt; t += 2) {
            const bool last = (t == nt - 2);
            const char* a1 = cA + (size_t)(t + 1) * kstep;
            const char* a2 = last ? nA : cA + (size_t)(t + 2) * kstep; const char* b2 = last ? nB : cB + (size_t)(t + 2) * kstep;
            const char* a3 = a2 + kstep; const char* b3 = b2 + kstep;
            if (last && has_next) S.a_ready(nxt);
            if constexpr (SP2) {
            PG8_LDB(B0, 0, 0); PG8_LDB(B1, 0, 1); PG8_SCHED; PG8_LDA(At, 0, 0); PG8_STAGE(PG8_SA(1, 1), a1 + hstep, voffA);
            PG8_WAIT_V(8); PG8_WAIT_L(0); PG8_BAR; PG8_MMA(0, 0, At, B0); PG8_MMA(0, 1, At, B1); PG8_BAR; PG8_SCHED;
            PG8_LDA(At, 0, 1); PG8_STAGE(PG8_SB(0, 0), b2, voffB); PG8_STAGE(PG8_SB(0, 1), b2 + hstep, voffB); PG8_STAGE(PG8_SA(0, 0), a2, voffA);
            PG8_WAIT_V(8); PG8_WAIT_L(0); PG8_BAR; PG8_MMA(1, 0, At, B0); PG8_MMA(1, 1, At, B1); PG8_BAR; PG8_SCHED;
            PG8_LDB(B0, 1, 0); PG8_LDB(B1, 1, 1); PG8_SCHED; PG8_LDA(At, 1, 0); PG8_STAGE(PG8_SA(0, 1), a2 + hstep, voffA);
            PG8_WAIT_V(8); PG8_WAIT_L(0); PG8_BAR; PG8_MMA(0, 0, At, B0); PG8_MMA(0, 1, At, B1); PG8_BAR; PG8_SCHED;
            PG8_LDA(At, 1, 1); PG8_STAGE(PG8_SB(1, 0), b3, voffB); PG8_STAGE(PG8_SB(1, 1), b3 + hstep, voffB); PG8_STAGE(PG8_SA(1, 0), a3, voffA);
            PG8_WAIT_V(8); PG8_WAIT_L(0); PG8_BAR; PG8_MMA(1, 0, At, B0); PG8_MMA(1, 1, At, B1); PG8_BAR; PG8_SCHED;
            } else {
            PG8_LDB(B0, 0, 0); PG8_SCHED; PG8_LDA(At, 0, 0); PG8_STAGE(PG8_SA(1, 1), a1 + hstep, voffA);
            PG8_WAIT_L(8); PG8_BAR; PG8_WAIT_L(0); PG8_MMA(0, 0, At, B0); PG8_BAR; PG8_SCHED;
            PG8_LDB(B1, 0, 1); PG8_STAGE(PG8_SB(0, 0), b2, voffB);
            PG8_BAR; PG8_WAIT_L(0); PG8_MMA(0, 1, At, B1); PG8_BAR;
            PG8_LDA(At, 0, 1); PG8_STAGE(PG8_SA(0, 0), a2, voffA);
            PG8_BAR; PG8_WAIT_L(0); PG8_MMA(1, 0, At, B0); PG8_BAR; PG8_SCHED;
            PG8_STAGE(PG8_SB(0, 1), b2 + hstep, voffB);
            PG8_WAIT_V(6); PG8_BAR; PG8_MMA(1, 1, At, B1); PG8_BAR;
            PG8_LDB(B0, 1, 0); PG8_SCHED; PG8_LDA(At, 1, 0); PG8_STAGE(PG8_SA(0, 1), a2 + hstep, voffA);
            PG8_WAIT_L(8); PG8_BAR; PG8_WAIT_L(0); PG8_MMA(0, 0, At, B0); PG8_BAR; PG8_SCHED;
            PG8_LDB(B1, 1, 1); PG8_STAGE(PG8_SB(1, 0), b3, voffB);
            PG8_BAR; PG8_WAIT_L(0); PG8_MMA(0, 1, At, B1); PG8_BAR;
            PG8_LDA(At, 1, 1); PG8_STAGE(PG8_SA(1, 0), a3, voffA);
            PG8_BAR; PG8_WAIT_L(0); PG8_MMA(1, 0, At, B0); PG8_BAR; PG8_SCHED;
            PG8_STAGE(PG8_SB(1, 1), b3 + hstep, voffB);
            PG8_WAIT_V(6); PG8_BAR; PG8_MMA(1, 1, At, B1); PG8_BAR;
            }
        }
        if constexpr (ALIGN_EPI) { if (wr == 0) PG8_BAR; }
        if constexpr (!Epi::AFTER_DRAIN) { E(acc, cur, wr, wc, fr, fq); S.done(cur); }
        if (!has_next) break;
#pragma unroll
        for (int a = 0; a < 2; ++a)
#pragma unroll
            for (int b = 0; b < 2; ++b)
#pragma unroll
                for (int m = 0; m < 4; ++m)
#pragma unroll
                    for (int n = 0; n < 2; ++n) acc[a][b][m][n] = (f32x4){0.f, 0.f, 0.f, 0.f};
        cur = nxt; cA = nA; cB = nB; ++ui;
        if constexpr (ALIGN_EPI) { if (wr == 1) PG8_BAR; }
    }
    PG8_WAIT_V(0);
    if constexpr (!ALIGN_EPI) { if (wr == 0) PG8_BAR; }
    PG8_BAR;
    if constexpr (Epi::AFTER_DRAIN) { E.fused(acc, cur, wr, wc, fr, fq, lds, wid, lane); S.done(cur); }
#undef PG8_SA
#undef PG8_SB
#undef PG8_STAGE
#undef PG8_LDA
#undef PG8_LDB
#undef PG8_MMA
#undef PG8_WAIT_V
#undef PG8_WAIT_L
#undef PG8_BAR
#undef PG8_SCHED
}
}
namespace att {
typedef unsigned short bf16_t;
typedef short bf16x8 __attribute__((ext_vector_type(8)));
typedef short s16x4 __attribute__((ext_vector_type(4)));
typedef float f32x16 __attribute__((ext_vector_type(16)));
typedef float f32x4 __attribute__((ext_vector_type(4)));
typedef unsigned u32x4 __attribute__((ext_vector_type(4)));
#define ALAS __attribute__((address_space(3)))
#define ASBAR() __builtin_amdgcn_sched_barrier(0)
constexpr int SHM_V = 16384;
template <int DK> struct Lay { static constexpr int ROWB = DK * 2, SHM_K = 64 * ROWB, OFF_K = 2 * SHM_V, OFF_F = OFF_K + 2 * SHM_K, OFF_WS = OFF_F + 512, TOTAL = OFF_WS + 8 * 256; };

__device__ __forceinline__ int v_st(int k, int c) { const int kk = (k & ~0xC) | ((k & 4) << 1) | ((k & 8) >> 1); return ((kk >> 3) * 4 + (c >> 5)) * 512 + ((kk & 7) * 32 + (c & 31)) * 2; }
__device__ __forceinline__ int v_rd_base(int lane) { return ((lane & 3) << 3) | (((lane >> 2) & 3) << 6) | (((lane >> 4) & 1) << 5) | (((lane >> 5) & 1) << 8); }
__device__ __forceinline__ int crow(int r, int hi) { return (r & 3) + 8 * (r >> 2) + 4 * hi; }
__device__ __forceinline__ unsigned cvtpk(float lo, float hi) { unsigned r; asm volatile("v_cvt_pk_bf16_f32 %0, %1, %2" : "=v"(r) : "v"(lo), "v"(hi)); return r; }

template <int DK, bool FOX>
__device__ __forceinline__ void attn_block(unsigned char* smem, const bf16_t* __restrict__ Q, int ldq, const bf16_t* __restrict__ K, int ldk, const bf16_t* __restrict__ V, int ldv,
                                           const float* __restrict__ Fh, bf16_t* __restrict__ gout  , int qbk) {
    typedef Lay<DK> LY;
    constexpr int ND = DK / 16, NKC = DK / 8, NKI = (64 * NKC) / 512;
    int tid = threadIdx.x; asm volatile("" : "+v"(tid));
    const int wid = __builtin_amdgcn_readfirstlane(tid >> 6), lane = tid & 63, r32 = lane & 31, hi = lane >> 5;
    const int q0 = qbk * 256, qlo = q0 + wid * 32, qm = qlo + r32 - 4 * hi;
    const int NT = 4 * qbk + 4;
    ALAS unsigned char* lds = (ALAS unsigned char*)smem;
    ALAS float* F_lds = (ALAS float*)(lds + LY::OFF_F);
    ALAS float* wsl = (ALAS float*)(lds + LY::OFF_WS) + wid * 64;
    bf16x8 qr[ND];
#pragma unroll
    for (int d0 = 0; d0 < ND; ++d0) qr[d0] = *(const bf16x8*)(Q + (size_t)(qlo + r32) * ldq + d0 * 16 + hi * 8);
    const float fq = FOX ? Fh[qlo + r32] : 0.f;
    int kgo[NKI], klo[NKI];
#pragma unroll
    for (int i = 0; i < NKI; ++i) { const int idx = tid + 512 * i, row = idx / NKC, ch = idx % NKC; kgo[i] = row * ldk + ch * 8; klo[i] = row * LY::ROWB + ((ch ^ ((row >> 1) & 7)) << 4); }
    const int sr = tid >> 4, sc = (tid & 15) * 8, vst0 = v_st(sr, sc), vst1 = v_st(32 + sr, sc);
    const int vgo0 = sr * ldv + sc, vgo1 = (32 + sr) * ldv + sc;
    const int vb0 = (int)(uintptr_t)smem + v_rd_base(lane);
    int kbase[4];
#pragma unroll
    for (int dd = 0; dd < 4; ++dd) kbase[dd] = LY::OFF_K + r32 * LY::ROWB + (((((dd << 1) | hi) ^ ((r32 >> 1) & 7))) << 4);
    bf16x8 stk[NKI], stv0, stv1; float stf = 0.f;
#define ATT_LOAD(kb) do { _Pragma("unroll") for (int i = 0; i < NKI; ++i) stk[i] = *(const bf16x8*)(K + (size_t)(kb) * ldk + kgo[i]); \
        stv0 = *(const bf16x8*)(V + (size_t)(kb) * ldv + vgo0); stv1 = *(const bf16x8*)(V + (size_t)(kb) * ldv + vgo1); if (FOX && tid < 64) stf = Fh[(kb) + tid]; } while (0)
#define ATT_WRITE(bf) do { _Pragma("unroll") for (int i = 0; i < NKI; ++i) *(ALAS bf16x8*)(lds + LY::OFF_K + (bf) * LY::SHM_K + klo[i]) = stk[i]; \
        *(ALAS bf16x8*)(lds + (bf) * SHM_V + vst0) = stv0; *(ALAS bf16x8*)(lds + (bf) * SHM_V + vst1) = stv1; if (FOX && tid < 64) F_lds[(bf) * 64 + tid] = stf; } while (0)
    ATT_LOAD(0); ATT_WRITE(0);
    float m_reg = -1e30f, l_reg = 0.f; f32x16 o[4];
#pragma unroll
    for (int d = 0; d < 4; ++d)
#pragma unroll
        for (int r = 0; r < 16; ++r) o[d][r] = 0.f;
    for (int t = 0; t < NT; ++t) {
        const int buf = t & 1, kb = t * 64;
        __syncthreads();
        if (t + 1 < NT) ATT_LOAD(kb + 64);
        f32x16 p0, p1;
        if (FOX) {
#pragma unroll
            for (int g = 0; g < 4; ++g) { const f32x4 f0 = *(const ALAS f32x4*)(F_lds + buf * 64 + 8 * g + 4 * hi), f1 = *(const ALAS f32x4*)(F_lds + buf * 64 + 32 + 8 * g + 4 * hi);
#pragma unroll
                for (int e = 0; e < 4; ++e) { p0[4 * g + e] = fq - f0[e]; p1[4 * g + e] = fq - f1[e]; } }
        } else {
#pragma unroll
            for (int r = 0; r < 16; ++r) { p0[r] = 0.f; p1[r] = 0.f; }
        }
#pragma unroll
        for (int d0 = 0; d0 < ND; ++d0) {
            ALAS const unsigned char* a = lds + buf * LY::SHM_K + kbase[d0 & 3] + (d0 >> 2) * 128;
            const bf16x8 b0 = *(const ALAS bf16x8*)a;
            const bf16x8 b1 = *(const ALAS bf16x8*)(a + 32 * LY::ROWB);
            p0 = __builtin_amdgcn_mfma_f32_32x32x16_bf16(b0, qr[d0], p0, 0, 0, 0);
            p1 = __builtin_amdgcn_mfma_f32_32x32x16_bf16(b1, qr[d0], p1, 0, 0, 0);
        }
        if (kb + 63 > qlo) {
            const float NEG = -__builtin_inff(); const int dq = qm - kb;
#pragma unroll
            for (int r = 0; r < 16; ++r) { const int c = (r & 3) + 8 * (r >> 2); if (dq - c < 0) p0[r] = NEG; if (dq - c - 32 < 0) p1[r] = NEG; }
        }
        float pmax = p0[0];
#pragma unroll
        for (int r = 1; r < 16; ++r) pmax = fmaxf(pmax, p0[r]);
#pragma unroll
        for (int r = 0; r < 16; ++r) pmax = fmaxf(pmax, p1[r]);
        { auto rr = __builtin_amdgcn_permlane32_swap(__float_as_uint(pmax), __float_as_uint(pmax), false, false);
          pmax = fmaxf(__uint_as_float(rr[0]), __uint_as_float(rr[1])); }
        const float mn = fmaxf(m_reg, pmax);
        const float alpha = __builtin_amdgcn_exp2f(m_reg - mn);
        m_reg = mn;
        float ps = 0.f;
#pragma unroll
        for (int r = 0; r < 16; ++r) { p0[r] = __builtin_amdgcn_exp2f(p0[r] - mn); ps += p0[r]; }
#pragma unroll
        for (int r = 0; r < 16; ++r) { p1[r] = __builtin_amdgcn_exp2f(p1[r] - mn); ps += p1[r]; }
        { auto rr = __builtin_amdgcn_permlane32_swap(__float_as_uint(ps), __float_as_uint(ps), false, false);
          ps = __uint_as_float(rr[0]) + __uint_as_float(rr[1]); }
        l_reg = l_reg * alpha + ps;
        bf16x8 pa0, pa1, pa2, pa3;
#define ATT_PK4(P, B_, OUT) do { unsigned a0 = cvtpk(P[B_+0], P[B_+1]), a1 = cvtpk(P[B_+2], P[B_+3]); unsigned b0_ = cvtpk(P[B_+4], P[B_+5]), b1_ = cvtpk(P[B_+6], P[B_+7]); \
        auto r0 = __builtin_amdgcn_permlane32_swap(a0, b0_, false, false); auto r1 = __builtin_amdgcn_permlane32_swap(a1, b1_, false, false); \
        u32x4 w = {r0[0], r1[0], r0[1], r1[1]}; OUT = *reinterpret_cast<bf16x8*>(&w); } while (0)
        ATT_PK4(p0, 0, pa0); ATT_PK4(p0, 8, pa1); ATT_PK4(p1, 0, pa2); ATT_PK4(p1, 8, pa3);
        if (__any(alpha < 1.f)) {
            if (hi == 0) wsl[r32] = alpha;
            asm volatile("s_waitcnt lgkmcnt(0)" ::: "memory");
#pragma unroll
            for (int g = 0; g < 4; ++g) { const f32x4 al = *(const ALAS f32x4*)(wsl + 8 * g + 4 * hi);
#pragma unroll
                for (int d = 0; d < 4; ++d)
#pragma unroll
                    for (int e = 0; e < 4; ++e) o[d][4 * g + e] *= al[e]; }
        }
#define ATT_TRRD(dst, off) asm volatile("ds_read_b64_tr_b16 %0, %1 offset:%2" : "=&v"(dst) : "v"(vbb), "i"(off) : "memory")
#define ATT_PV(d0) do { s16x4 l0, l1, l2, l3, h0, h1, h2, h3; constexpr int b_ = (d0) * 512; \
        ATT_TRRD(l0, b_); ATT_TRRD(h0, b_ + 2048); ATT_TRRD(l1, b_ + 4096); ATT_TRRD(h1, b_ + 6144); ATT_TRRD(l2, b_ + 8192); ATT_TRRD(h2, b_ + 10240); ATT_TRRD(l3, b_ + 12288); ATT_TRRD(h3, b_ + 14336); \
        asm volatile("s_waitcnt lgkmcnt(0)" ::: "memory"); ASBAR(); \
        o[d0] = __builtin_amdgcn_mfma_f32_32x32x16_bf16(pa0, (bf16x8){l0[0], l0[1], l0[2], l0[3], h0[0], h0[1], h0[2], h0[3]}, o[d0], 0, 0, 0); \
        o[d0] = __builtin_amdgcn_mfma_f32_32x32x16_bf16(pa1, (bf16x8){l1[0], l1[1], l1[2], l1[3], h1[0], h1[1], h1[2], h1[3]}, o[d0], 0, 0, 0); \
        o[d0] = __builtin_amdgcn_mfma_f32_32x32x16_bf16(pa2, (bf16x8){l2[0], l2[1], l2[2], l2[3], h2[0], h2[1], h2[2], h2[3]}, o[d0], 0, 0, 0); \
        o[d0] = __builtin_amdgcn_mfma_f32_32x32x16_bf16(pa3, (bf16x8){l3[0], l3[1], l3[2], l3[3], h3[0], h3[1], h3[2], h3[3]}, o[d0], 0, 0, 0); } while (0)
        { const int vbb = vb0 + buf * SHM_V; ATT_PV(0); ATT_PV(1); ATT_PV(2); ATT_PV(3); }
        if (t + 1 < NT) ATT_WRITE(buf ^ 1);
    }
    if (hi == 0) wsl[r32] = l_reg;
    asm volatile("s_waitcnt lgkmcnt(0)" ::: "memory");
#pragma unroll
    for (int r = 0; r < 16; ++r) {
        const int orow = crow(r, hi); const float rli = __builtin_amdgcn_rcpf(wsl[orow]);
        bf16_t* rowp = gout + (size_t)(qlo + orow) * 4096;
#pragma unroll
        for (int d0 = 0; d0 < 4; ++d0) {
            const float v = o[d0][r] * rli; const float vn = __shfl_xor(v, 1);
            if ((r32 & 1) == 0) { unsigned* gp = (unsigned*)(rowp + d0 * 32 + r32); const unsigned g = *gp;
                *gp = cvtpk(v * __uint_as_float(g << 16), vn * __uint_as_float(g & 0xffff0000u)); }
        }
    }
    __syncthreads();
#undef ATT_LOAD
#undef ATT_WRITE
#undef ATT_PK4
#undef ATT_TRRD
#undef ATT_PV
}
}
using pg8::bf16_t; using pg8::f32x4; using pg8::u32x4;
#define LAS __attribute__((address_space(3)))
constexpr int S = 8192, DM = 2048, INW = 11344, INWP = 11520;
constexpr float EPS = 1e-6f;
constexpr size_t MiB = 1u << 20;

__device__ __forceinline__ float bf2f(bf16_t v) { return __uint_as_float(((unsigned)v) << 16); }
__device__ __forceinline__ bf16_t f2bf(float f) { unsigned u = __float_as_uint(f); u += 0x7fffu + ((u >> 16) & 1u); return (bf16_t)(u >> 16); }
__device__ __forceinline__ unsigned pk2(float lo, float hi) { return (unsigned)f2bf(lo) | ((unsigned)f2bf(hi) << 16); }
__device__ __forceinline__ float wave_sum(float v) {
#pragma unroll
    for (int o = 32; o >= 1; o >>= 1) v += __shfl_xor(v, o);
    return v;
}
__device__ __forceinline__ float wave_max(float v) {
#pragma unroll
    for (int o = 32; o >= 1; o >>= 1) v = fmaxf(v, __shfl_xor(v, o));
    return v;
}

__device__ __forceinline__ int opaque_tid() { int t = threadIdx.x; asm volatile("" : "+v"(t)); return t; }

struct Params {
    const float* x; const int* pos; const float *mix_g, *w_in, *b_forget, *b_gate, *q_lat_g, *w_q_up, *kv_lat_g, *w_kv_up, *mla_qg, *mla_kg, *fox_qg, *fox_kg, *w_out, *ffn_g, *w_peer_q, *sub_keys, *peer_u, *peer_v;
    float* out;
    bf16_t *WqT, *WkvT, *WoT, *WpT, *WinT;
    bf16_t *h, *cq, *ckv, *fq, *fk, *fv, *merged, *kpe, *qa, *kvraw, *ka;
    float *lf, *F, *x1, *scores;
};

struct DstId { __device__ __forceinline__ int operator()(int n) const { return n; } };
struct DstWin { __device__ __forceinline__ int operator()(int n) const {
    if (n < 1024) return n; if (n < 1088) return 11264 + (n - 1024); if (n < 7232) return n - 64; if (n < 7248) return 11264 + 64 + (n - 7232); return n - 80; } };
template <class Dst>
__device__ __forceinline__ void transpose_item(const float* __restrict__ W, int K, int N, bf16_t* __restrict__ WT, Dst dst, float* scr, int item, int lane) {
    const int nblk = (N + 31) / 32, kb = item / nblk, nb = item % nblk, k0 = 64 * kb, n0 = 32 * nb;
    { const int n = n0 + (lane & 31);
#pragma unroll 8
      for (int i = 0; i < 32; ++i) { const int kk = 2 * i + (lane >> 5); scr[kk * 33 + (lane & 31)] = (n < N) ? W[(size_t)(k0 + kk) * N + n] : 0.f; } }
    asm volatile("s_waitcnt lgkmcnt(0)" ::: "memory");
    const int c = lane & 7;
#pragma unroll
    for (int j = 0; j < 4; ++j) { const int nl = (lane >> 3) + 8 * j, n = n0 + nl; const float* s = scr + (8 * c) * 33 + nl;
        u32x4 o; o.x = pk2(s[0 * 33], s[1 * 33]); o.y = pk2(s[2 * 33], s[3 * 33]); o.z = pk2(s[4 * 33], s[5 * 33]); o.w = pk2(s[6 * 33], s[7 * 33]);
        if (n < N) *(u32x4*)(WT + (size_t)dst(n) * K + k0 + 8 * c) = o; }
    asm volatile("s_waitcnt lgkmcnt(0)" ::: "memory");
}
__device__ __forceinline__ void wfold_item(const float* __restrict__ wq, const float* __restrict__ keys, bf16_t* __restrict__ WpT, float* sm, int item) {
    const int tid = opaque_tid(), hc = item >> 5, d0 = (item & 31) * 64;
    float* keysL = sm; float* wqL = sm + 128 * 129;
    for (int idx = tid; idx < 128 * 128; idx += 512) keysL[(idx >> 7) * 129 + (idx & 127)] = keys[(size_t)hc * 16384 + idx];
    for (int idx = tid; idx < 64 * 128; idx += 512) wqL[(idx >> 7) * 129 + (idx & 127)] = wq[(size_t)(d0 + (idx >> 7)) * 2048 + hc * 128 + (idx & 127)];
    __syncthreads();
    const int n = tid & 127, dq = tid >> 7;
    float acc[16];
#pragma unroll
    for (int i = 0; i < 16; ++i) acc[i] = 0.f;
    for (int j = 0; j < 128; ++j) { const float kv = keysL[n * 129 + j];
#pragma unroll
        for (int i = 0; i < 16; ++i) acc[i] += kv * wqL[(dq * 16 + i) * 129 + j]; }
    u32x4 o0, o1;
    o0.x = pk2(acc[0], acc[1]); o0.y = pk2(acc[2], acc[3]); o0.z = pk2(acc[4], acc[5]); o0.w = pk2(acc[6], acc[7]);
    o1.x = pk2(acc[8], acc[9]); o1.y = pk2(acc[10], acc[11]); o1.z = pk2(acc[12], acc[13]); o1.w = pk2(acc[14], acc[15]);
    bf16_t* dstp = WpT + (size_t)(hc * 128 + n) * 2048 + d0 + dq * 16;
    *(u32x4*)dstp = o0; *(u32x4*)(dstp + 8) = o1;
    __syncthreads();
}
__device__ __forceinline__ void rms_row2048(const float* __restrict__ xr, const float* __restrict__ g, bf16_t* __restrict__ orow, int lane) {
    f32x4 v[8]; float ss = 0.f;
#pragma unroll
    for (int j = 0; j < 8; ++j) { v[j] = *(const f32x4*)(xr + j * 256 + lane * 4); ss += (v[j][0] * v[j][0] + v[j][1] * v[j][1]) + (v[j][2] * v[j][2] + v[j][3] * v[j][3]); }
    const float r = rsqrtf(wave_sum(ss) * (1.f / 2048.f) + EPS);
#pragma unroll
    for (int j = 0; j < 8; ++j) { const f32x4 gg = *(const f32x4*)(g + j * 256 + lane * 4);
        uint2 o; o.x = pk2(v[j][0] * r * gg[0], v[j][1] * r * gg[1]); o.y = pk2(v[j][2] * r * gg[2], v[j][3] * r * gg[3]);
        *(uint2*)(orow + j * 256 + lane * 4) = o; }
}
__device__ __forceinline__ void rms_row512_inplace(bf16_t* __restrict__ row, const float* __restrict__ g, int lane) {
    u32x4 w = *(const u32x4*)(row + lane * 8); float v[8];
#pragma unroll
    for (int i = 0; i < 4; ++i) { v[2 * i] = __uint_as_float(w[i] << 16); v[2 * i + 1] = __uint_as_float(w[i] & 0xffff0000u); }
    float ss = 0.f;
#pragma unroll
    for (int i = 0; i < 8; ++i) ss += v[i] * v[i];
    const float r = rsqrtf(wave_sum(ss) * (1.f / 512.f) + EPS);
    u32x4 o;
#pragma unroll
    for (int i = 0; i < 4; ++i) o[i] = pk2(v[2 * i] * r * g[lane * 8 + 2 * i], v[2 * i + 1] * r * g[lane * 8 + 2 * i + 1]);
    *(u32x4*)(row + lane * 8) = o;
}
__device__ __forceinline__ void fox_prep(int w, bf16_t* __restrict__ fq, bf16_t* __restrict__ fk, const float* __restrict__ gq, const float* __restrict__ gk, int lane) {
    const int t = w >> 4, h = w & 15;
#pragma unroll
    for (int which = 0; which < 2; ++which) {
        bf16_t* p = (which ? fk : fq) + (size_t)t * 2048 + h * 128; const float* g = which ? gk : gq;
        const float v0 = bf2f(p[lane]), v1 = bf2f(p[lane + 64]);
        const float r = rsqrtf(wave_sum(v0 * v0 + v1 * v1) * (1.f / 128.f) + EPS);
        const float qs = which ? 1.f : 0.12751743f;
        p[lane] = f2bf(v0 * r * g[lane] * qs); p[lane + 64] = f2bf(v1 * r * g[lane + 64] * qs);
    }
}
__device__ __forceinline__ void fox_cumsum(double* part, int h, const float* __restrict__ lf, float* __restrict__ F) {
    const int tid = opaque_tid(); double sum = 0.0;
    for (int i = 0; i < 16; ++i) sum += (double)lf[(size_t)(tid * 16 + i) * 16 + h];
    part[tid] = sum;
    __syncthreads();
    if (tid == 0) { double run = 0.0; for (int i = 0; i < 512; ++i) { const double v = part[i]; part[i] = run; run += v; } }
    __syncthreads();
    double run = part[tid];
    for (int i = 0; i < 16; ++i) { run += (double)lf[(size_t)(tid * 16 + i) * 16 + h]; F[(size_t)h * S + tid * 16 + i] = (float)(run * 1.4426950408889634); }
    __syncthreads();
}
__device__ __forceinline__ void rope_cs(int pos, int i, float& c, float& s) {
    const double inv = exp(-(double)i * (1.0 / 32.0) * 9.210340371976184);
    double ang = (double)((float)pos * (float)inv);
    const double twopi = 6.283185307179586;
    ang -= twopi * rint(ang / twopi);
    c = cosf((float)ang); s = sinf((float)ang);
}
__device__ __forceinline__ void mla_prep(int w, bf16_t* __restrict__ qa, const bf16_t* __restrict__ kvraw, const bf16_t* __restrict__ kpe, const int* __restrict__ pos,
                                         const float* __restrict__ gq, const float* __restrict__ gk, bf16_t* __restrict__ ka, int lane) {
    const int t = w >> 4, h = w & 15;
    float c, s; rope_cs(pos[t], lane & 31, c, s);
    {
        bf16_t* q = qa + (size_t)t * 3072 + h * 192;
        float v0 = bf2f(q[lane]), v1 = bf2f(q[lane + 64]), v2 = bf2f(q[lane + 128]);
        const float r = rsqrtf(wave_sum(v0 * v0 + v1 * v1 + v2 * v2) * (1.f / 192.f) + EPS);
        v0 *= r * gq[lane]; v1 *= r * gq[lane + 64]; v2 *= r * gq[lane + 128];
        const float o = __shfl_xor(v2, 32);
        const float rr = lane < 32 ? v2 * c - o * s : o * s + v2 * c;
        q[lane] = f2bf(v0 * 0.10411754f); q[lane + 64] = f2bf(v1 * 0.10411754f); q[lane + 128] = f2bf(rr * 0.10411754f);
    }
    {
        const bf16_t* kn = kvraw + (size_t)t * 4096 + h * 256;
        float v0 = bf2f(kn[lane]), v1 = bf2f(kn[lane + 64]), v2 = bf2f(kpe[(size_t)t * 64 + lane]);
        const float r = rsqrtf(wave_sum(v0 * v0 + v1 * v1 + v2 * v2) * (1.f / 192.f) + EPS);
        v0 *= r * gk[lane]; v1 *= r * gk[lane + 64]; v2 *= r * gk[lane + 128];
        const float o = __shfl_xor(v2, 32);
        const float rr = lane < 32 ? v2 * c - o * s : o * s + v2 * c;
        bf16_t* k = ka + (size_t)t * 3072 + h * 192;
        k[lane] = f2bf(v0); k[lane + 64] = f2bf(v1); k[lane + 128] = f2bf(rr);
    }
}

__device__ __forceinline__ void wave_argmax(float& v, int& i) {
#pragma unroll
    for (int o = 32; o >= 1; o >>= 1) {
        const float ov = __shfl_xor(v, o); const int oi = __shfl_xor(i, o);
        if (ov > v || (ov == v && oi < i)) { v = ov; i = oi; }
    }
}
__device__ __forceinline__ void peer_token(float* red, int t, const float* __restrict__ x1, const bf16_t* __restrict__ h2, const float* __restrict__ scores,
                                           const float* __restrict__ U, const float* __restrict__ Vt, float* __restrict__ out) {
    const int tid = opaque_tid(), h = tid >> 6, lane = tid & 63;
    const float* sc = scores + (size_t)t * 2048 + h * 256;
    float sv[2]; int si[2];
#pragma unroll
    for (int c = 0; c < 2; ++c) {
        float a0 = sc[c * 128 + lane], a1 = sc[c * 128 + 64 + lane];
        float mv = -INFINITY; int mi = 0;
        for (int k = 0; k < 16; ++k) {
            float bv; int bi;
            if (a0 >= a1) { bv = a0; bi = lane; } else { bv = a1; bi = lane + 64; }
            wave_argmax(bv, bi);
            if (bi == lane) a0 = -INFINITY;
            if (bi == lane + 64) a1 = -INFINITY;
            if (lane == k) { mv = bv; mi = bi; }
        }
        sv[c] = mv; si[c] = mi;
    }
    float cand[4];
#pragma unroll
    for (int m = 0; m < 4; ++m) cand[m] = __shfl(sv[0], (lane >> 4) + 4 * m) + __shfl(sv[1], lane & 15);
    float ts = -INFINITY; int tp = 0;
    for (int k = 0; k < 16; ++k) {
        float bv = cand[0]; int bp = lane;
#pragma unroll
        for (int m = 1; m < 4; ++m) if (cand[m] > bv) { bv = cand[m]; bp = lane + 64 * m; }
        wave_argmax(bv, bp);
#pragma unroll
        for (int m = 0; m < 4; ++m) if (bp == lane + 64 * m) cand[m] = -INFINITY;
        if (lane == k) { ts = bv; tp = bp; }
    }
    const int expert = __shfl(si[0], tp >> 4) * 128 + __shfl(si[1], tp & 15);
    const float mx = wave_max(ts);
    const float e = lane < 16 ? __expf(ts - mx) : 0.f;
    const float gate = e / wave_sum(e);
    float hr[32];
#pragma unroll
    for (int j = 0; j < 8; ++j) { const uint2 w = *(const uint2*)(h2 + (size_t)t * DM + j * 256 + lane * 4);
        hr[j * 4] = __uint_as_float(w.x << 16); hr[j * 4 + 1] = __uint_as_float(w.x & 0xffff0000u); hr[j * 4 + 2] = __uint_as_float(w.y << 16); hr[j * 4 + 3] = __uint_as_float(w.y & 0xffff0000u); }
    float acc[32];
#pragma unroll
    for (int i = 0; i < 32; ++i) acc[i] = 0.f;
    for (int k = 0; k < 16; ++k) {
        const int ek = __shfl(expert, k); const float gk = __shfl(gate, k);
        const float* up = U + (size_t)ek * DM;
        float dot = 0.f;
#pragma unroll
        for (int j = 0; j < 8; ++j) { const float4 u4 = *(const float4*)(up + j * 256 + lane * 4);
            dot += hr[j * 4] * u4.x + hr[j * 4 + 1] * u4.y + hr[j * 4 + 2] * u4.z + hr[j * 4 + 3] * u4.w; }
        dot = wave_sum(dot);
        const float w = gk * 0.5f * dot * (1.f + erff(dot * 0.70710678118654752f));
        const float* vp = Vt + (size_t)ek * DM;
#pragma unroll
        for (int j = 0; j < 8; ++j) { const float4 v4 = *(const float4*)(vp + j * 256 + lane * 4);
            acc[j * 4] += w * v4.x; acc[j * 4 + 1] += w * v4.y; acc[j * 4 + 2] += w * v4.z; acc[j * 4 + 3] += w * v4.w; }
    }
#pragma unroll
    for (int j = 0; j < 8; ++j) *(float4*)(red + h * 2048 + j * 256 + lane * 4) = make_float4(acc[j * 4], acc[j * 4 + 1], acc[j * 4 + 2], acc[j * 4 + 3]);
    __syncthreads();
    { const int i = tid * 4;
      float4 s = *(const float4*)(x1 + (size_t)t * DM + i);
#pragma unroll
      for (int w = 0; w < 8; ++w) { const float4 r = *(const float4*)(red + w * 2048 + i); s.x += r.x; s.y += r.y; s.z += r.z; s.w += r.w; }
      *(float4*)(out + (size_t)t * DM + i) = s; }
    __syncthreads();
}

constexpr int LDS_BYTES = 147456;
__global__ __launch_bounds__(512, 2) void mega(Params p) {
    extern __shared__ __attribute__((aligned(16))) unsigned char smem[];
    cg::grid_group grid = cg::this_grid();
    float* smf = (float*)smem;
    LAS unsigned char* lds = (LAS unsigned char*)smem;
    const int G = gridDim.x, b = blockIdx.x, NGW = G * 8;
#define PHASE_IDS() const int tid = opaque_tid(), lane = tid & 63, wave = __builtin_amdgcn_readfirstlane(tid >> 6), gw = b * 8 + wave; (void)lane; (void)gw

    {
        PHASE_IDS();
        float* scr = smf + wave * 4096;
        constexpr int I_IN = 32 * 355, I_Q = 8 * 96, I_KV = 8 * 128, I_O = 64 * 64;
        for (int it = gw; it < I_IN + I_Q + I_KV + I_O; it += NGW) {
            int r = it;
            if (r < I_IN) { transpose_item(p.w_in, 2048, INW, p.WinT, DstWin(), scr, r, lane); continue; } r -= I_IN;
            if (r < I_Q) { transpose_item(p.w_q_up, 512, 3072, p.WqT, DstId(), scr, r, lane); continue; } r -= I_Q;
            if (r < I_KV) { transpose_item(p.w_kv_up, 512, 4096, p.WkvT, DstId(), scr, r, lane); continue; } r -= I_KV;
            transpose_item(p.w_out, 4096, 2048, p.WoT, DstId(), scr, r, lane);
        }
        for (int m = gw; m < S; m += NGW) rms_row2048(p.x + (size_t)m * DM, p.mix_g, p.h + (size_t)m * DM, lane);
        __syncthreads();
        for (int it = b; it < 512; it += G) wfold_item(p.w_peer_q, p.sub_keys, p.WpT, smf, it);
    }
    grid.sync();
    {
        pg8::Gemm g{p.h, p.WinT, S, INWP, DM}; pg8::StaticOrder so; so.init(S, INWP, G, b);
        pg8::EpiInProj E{p.cq, p.ckv, p.fq, p.fk, p.fv, p.merged, p.kpe, p.lf, p.b_gate, p.b_forget};
        pg8::gemm_phase<pg8::EpiInProj, pg8::StaticOrder, true, true>(lds, g, so, E);
    }
    grid.sync();
    {
    PHASE_IDS();
    for (int t = gw; t < S; t += NGW) { rms_row512_inplace(p.cq + (size_t)t * 512, p.q_lat_g, lane); rms_row512_inplace(p.ckv + (size_t)t * 512, p.kv_lat_g, lane); }
    for (int w = gw; w < S * 16; w += NGW) fox_prep(w, p.fq, p.fk, p.fox_qg, p.fox_kg, lane);
    for (int hh = b; hh < 16; hh += G) fox_cumsum((double*)smem, hh, p.lf, p.F);
    }
    grid.sync();
    {
        pg8::Gemm g{p.cq, p.WqT, S, 3072, 512}; pg8::StaticOrder so; so.init(S, 3072, G, b);
        pg8::EpiStoreBf16 E{p.qa, 3072};
        pg8::gemm_phase<pg8::EpiStoreBf16, pg8::StaticOrder, true, true>(lds, g, so, E);
    }
    {
        pg8::Gemm g{p.ckv, p.WkvT, S, 4096, 512}; pg8::StaticOrder so; so.init(S, 4096, G, b);
        pg8::EpiStoreBf16 E{p.kvraw, 4096};
        pg8::gemm_phase<pg8::EpiStoreBf16, pg8::StaticOrder, true, true>(lds, g, so, E);
    }
    grid.sync();
    { PHASE_IDS(); for (int w = gw; w < S * 16; w += NGW) mla_prep(w, p.qa, p.kvraw, p.kpe, p.pos, p.mla_qg, p.mla_kg, p.ka, lane); }
    grid.sync();
    for (int L = b; L < 1024; L += G) {
        const int i = L >> 8, vc = L & 255, vcx = (vc & 7) * 32 + (vc >> 3), hh = vcx >> 4, x = vcx & 15, qbk = (i & 1) ? x : 31 - x;
        if (i < 2) att::attn_block<192, false>(smem, p.qa + hh * 192, 3072, p.ka + hh * 192, 3072, p.kvraw + hh * 256 + 128, 4096, nullptr, p.merged + hh * 128, qbk);
        else att::attn_block<128, true>(smem, p.fq + hh * 128, 2048, p.fk + hh * 128, 2048, p.fv + hh * 128, 2048, p.F + (size_t)hh * S, p.merged + 2048 + hh * 128, qbk);
    }
    grid.sync();
    {
        pg8::Gemm g{p.merged, p.WoT, S, 2048, 4096}; pg8::StaticOrder so; so.init(S, 2048, G, b);
        pg8::EpiStoreF32<true> E{p.x1, p.x, 2048};
        pg8::gemm_phase<pg8::EpiStoreF32<true>, pg8::StaticOrder, true, true>(lds, g, so, E);
    }
    grid.sync();
    { PHASE_IDS(); for (int m = gw; m < S; m += NGW) rms_row2048(p.x1 + (size_t)m * DM, p.ffn_g, p.h + (size_t)m * DM, lane); }
    grid.sync();
    {
        pg8::Gemm g{p.h, p.WpT, S, 2048, 2048}; pg8::StaticOrder so; so.init(S, 2048, G, b);
        pg8::EpiStoreF32<false> E{p.scores, nullptr, 2048};
        pg8::gemm_phase<pg8::EpiStoreF32<false>, pg8::StaticOrder, true, true>(lds, g, so, E);
    }
    grid.sync();
    for (int t = b; t < S; t += G) peer_token(smf, t, p.x1, p.h, p.scores, p.peer_u, p.peer_v, p.out);
}

extern "C" void kernel_launch(void* const* d_in, const int* in_sizes, int n_in,
                              void* d_out, int out_size, void* d_ws, size_t ws_size,
                              hipStream_t stream) {
    if (ws_size < 512 * MiB) { fprintf(stderr, "kernel_launch: workspace too small (%zu)\n", ws_size); return; }
    Params p{};
    p.x = (const float*)d_in[0]; p.pos = (const int*)d_in[1]; p.mix_g = (const float*)d_in[2]; p.w_in = (const float*)d_in[3];
    p.b_forget = (const float*)d_in[4]; p.b_gate = (const float*)d_in[5]; p.q_lat_g = (const float*)d_in[6]; p.w_q_up = (const float*)d_in[7];
    p.kv_lat_g = (const float*)d_in[8]; p.w_kv_up = (const float*)d_in[9]; p.mla_qg = (const float*)d_in[10]; p.mla_kg = (const float*)d_in[11];
    p.fox_qg = (const float*)d_in[12]; p.fox_kg = (const float*)d_in[13]; p.w_out = (const float*)d_in[14]; p.ffn_g = (const float*)d_in[15];
    p.w_peer_q = (const float*)d_in[16]; p.sub_keys = (const float*)d_in[17]; p.peer_u = (const float*)d_in[18]; p.peer_v = (const float*)d_in[19];
    p.out = (float*)d_out;
    char* ws = (char*)d_ws;
    p.WqT = (bf16_t*)(ws + 1 * MiB); p.WkvT = (bf16_t*)(ws + 5 * MiB); p.WoT = (bf16_t*)(ws + 9 * MiB); p.WpT = (bf16_t*)(ws + 25 * MiB); p.WinT = (bf16_t*)(ws + 33 * MiB);
    p.h = (bf16_t*)(ws + 78 * MiB); p.cq = (bf16_t*)(ws + 110 * MiB); p.ckv = (bf16_t*)(ws + 118 * MiB);
    p.fq = (bf16_t*)(ws + 126 * MiB); p.fk = (bf16_t*)(ws + 158 * MiB); p.fv = (bf16_t*)(ws + 190 * MiB); p.merged = (bf16_t*)(ws + 222 * MiB);
    p.kpe = (bf16_t*)(ws + 286 * MiB); p.lf = (float*)(ws + 287 * MiB); p.F = (float*)(ws + 287 * MiB + 512 * 1024);
    p.qa = (bf16_t*)(ws + 288 * MiB); p.kvraw = (bf16_t*)(ws + 336 * MiB); p.ka = (bf16_t*)(ws + 400 * MiB); p.x1 = (float*)(ws + 448 * MiB);
    p.scores = (float*)(ws + 288 * MiB);

    static int grid_blocks = 0;
    if (!grid_blocks) {
        if (hipFuncSetAttribute((const void*)mega, hipFuncAttributeMaxDynamicSharedMemorySize, LDS_BYTES) != hipSuccess) { fprintf(stderr, "hipFuncSetAttribute failed\n"); return; }
        int dev = 0, cus = 0, per_cu = 0;
        (void)hipGetDevice(&dev);
        (void)hipDeviceGetAttribute(&cus, hipDeviceAttributeMultiprocessorCount, dev);
        (void)hipOccupancyMaxActiveBlocksPerMultiprocessor(&per_cu, (const void*)mega, 512, LDS_BYTES);
        if (per_cu < 1 || cus < 1) { fprintf(stderr, "occupancy query says %d blocks/CU on %d CUs\n", per_cu, cus); return; }
        grid_blocks = cus;
    }
    void* args[] = {&p};
    hipError_t e = hipLaunchCooperativeKernel((const void*)mega, dim3(grid_blocks), dim3(512), args, LDS_BYTES, stream);
    if (e != hipSuccess) fprintf(stderr, "cooperative launch failed: %s (grid %d)\n", hipGetErrorString(e), grid_blocks);
}
```

```cpp
#include <hip/hip_runtime.h>
#include <hip/hip_cooperative_groups.h>
#include <stdint.h>
#include <math.h>
#include <cstdio>
namespace cg = cooperative_groups;

namespace pg8 {
#define PG8_LAS __attribute__((address_space(3)))
typedef unsigned short bf16_t;
typedef short bf16x8 __attribute__((ext_vector_type(8)));
typedef float f32x4 __attribute__((ext_vector_type(4)));
typedef unsigned u32x4 __attribute__((ext_vector_type(4)));
constexpr int BM = 256, BK = 64, HALF = 128, HTB = HALF * BK * 2  , STAGE_BYTES = 8 * HTB, NXCD = 8, WGM = 8;

__host__ __device__ __forceinline__ int lds_byte(int r, int c) { const int st = (r >> 4) * 2 + (c >> 5), rr = r & 15, cc = c & 31, ob = rr * 64 + cc * 2; return st * 1024 + (ob ^ (((ob >> 9) & 1) << 5)); }
__host__ __device__ __forceinline__ void stage_rc(int b, int& R, int& C) { const int st = b / 1024, sb = b % 1024, swz = sb ^ (((sb >> 9) & 1) << 5); R = (st >> 1) * 16 + swz / 64; C = (st & 1) * 32 + (swz % 64) / 2; }
__host__ __device__ __forceinline__ int perm32(int rho) { const int n = rho >> 4, i = rho & 15; return 8 * (i >> 2) + 4 * n + (i & 3); }

struct Unit { int pm, pn; };
struct Gemm { const bf16_t* A; const bf16_t* Bt; int M, N, K; };

struct StaticOrder {
    int nM, nN, nwg, G, c;
    __host__ __device__ void init(int M, int N, int G_, int c_) { nM = M / BM; nN = N / BM; nwg = nM * nN; G = G_; c = c_; }
    __host__ __device__ bool next(int i, Unit& u) const {
        const long L = (long)i * G + c; if (L >= nwg) return false;
        int wgid = (int)L; { const int q = nwg / NXCD, r = nwg % NXCD, xcd = wgid % NXCD, off = wgid / NXCD; wgid = (xcd < r ? xcd * (q + 1) : r * (q + 1) + (xcd - r) * q) + off; }
        const int nig = WGM * nN, gid = wgid / nig, fm = gid * WGM, gsz = (nM - fm) < WGM ? (nM - fm) : WGM;
        u.pm = fm + ((wgid % nig) % gsz); u.pn = (wgid % nig) / gsz; return true;
    }
    __device__ __forceinline__ void a_ready(const Unit&) const {}
    __device__ __forceinline__ void done(const Unit&) const {}
};

__device__ __forceinline__ unsigned cvt_pk_bf16(float lo, float hi) { unsigned r; asm volatile("v_cvt_pk_bf16_f32 %0, %1, %2" : "=v"(r) : "v"(lo), "v"(hi)); return r; }
__device__ __forceinline__ u32x4 pack8bf(const f32x4& v0, const f32x4& v1) { u32x4 w; w.x = cvt_pk_bf16(v0[0], v0[1]); w.y = cvt_pk_bf16(v0[2], v0[3]); w.z = cvt_pk_bf16(v1[0], v1[1]); w.w = cvt_pk_bf16(v1[2], v1[3]); return w; }

struct EpiStoreBf16 {
    static constexpr bool PERM = true, AFTER_DRAIN = false;
    bf16_t* O; int ldc;
    __device__ __forceinline__ void operator()(const f32x4 (&acc)[2][2][4][2], const Unit& u, int wr, int wc, int fr, int fq) const {
        const int row0 = u.pm * BM + wr * 64 + fr, col0 = u.pn * BM + wc * 32 + 8 * fq;
#pragma unroll
        for (int ai = 0; ai < 2; ++ai)
#pragma unroll
            for (int m = 0; m < 4; ++m) { bf16_t* rowp = O + (size_t)(row0 + ai * HALF + m * 16) * ldc + col0;
#pragma unroll
                for (int bj = 0; bj < 2; ++bj) *(u32x4*)(rowp + bj * HALF) = pack8bf(acc[ai][bj][m][0], acc[ai][bj][m][1]); }
    }
};
template <bool RES> struct EpiStoreF32 {
    static constexpr bool PERM = true, AFTER_DRAIN = false;
    float* O; const float* res; int ldc;
    __device__ __forceinline__ void operator()(const f32x4 (&acc)[2][2][4][2], const Unit& u, int wr, int wc, int fr, int fq) const {
        const int row0 = u.pm * BM + wr * 64 + fr, col0 = u.pn * BM + wc * 32 + 8 * fq;
#pragma unroll
        for (int ai = 0; ai < 2; ++ai)
#pragma unroll
            for (int m = 0; m < 4; ++m) { const size_t off = (size_t)(row0 + ai * HALF + m * 16) * ldc + col0;
#pragma unroll
                for (int bj = 0; bj < 2; ++bj) { f32x4 v0 = acc[ai][bj][m][0], v1 = acc[ai][bj][m][1];
                    if (RES) { v0 += *(const f32x4*)(res + off + bj * HALF); v1 += *(const f32x4*)(res + off + bj * HALF + 4); }
                    *(f32x4*)(O + off + bj * HALF) = v0; *(f32x4*)(O + off + bj * HALF + 4) = v1; } }
    }
};
struct EpiInProj {
    static constexpr bool PERM = true, AFTER_DRAIN = false;
    bf16_t *cq, *ckv, *fq, *fk, *fv, *gates, *kpe; float* lf; const float *b_gate, *b_forget;
    __device__ __forceinline__ void operator()(const f32x4 (&acc)[2][2][4][2], const Unit& u, int wr, int wc, int fr, int fq_) const {
        const int pn = u.pn, row0 = u.pm * BM + wr * 64 + fr, cw = wc * 32 + 8 * fq_;
        if (pn < 28) {
            bf16_t* base; int ldc, colt;
            if (pn < 2) { base = cq; ldc = 512; colt = pn * 256; } else if (pn < 4) { base = ckv; ldc = 512; colt = (pn - 2) * 256; }
            else if (pn < 12) { base = fq; ldc = 2048; colt = (pn - 4) * 256; } else if (pn < 20) { base = fk; ldc = 2048; colt = (pn - 12) * 256; }
            else { base = fv; ldc = 2048; colt = (pn - 20) * 256; }
#pragma unroll
            for (int ai = 0; ai < 2; ++ai)
#pragma unroll
                for (int m = 0; m < 4; ++m) { bf16_t* rowp = base + (size_t)(row0 + ai * HALF + m * 16) * ldc + colt + cw;
#pragma unroll
                    for (int bj = 0; bj < 2; ++bj) *(u32x4*)(rowp + bj * HALF) = pack8bf(acc[ai][bj][m][0], acc[ai][bj][m][1]); }
        } else if (pn < 44) {
            const int colt = (pn - 28) * 256 + cw;
#pragma unroll
            for (int bj = 0; bj < 2; ++bj) {
                const f32x4 b0 = *(const f32x4*)(b_gate + colt + bj * HALF), b1 = *(const f32x4*)(b_gate + colt + bj * HALF + 4);
#pragma unroll
                for (int ai = 0; ai < 2; ++ai)
#pragma unroll
                    for (int m = 0; m < 4; ++m) {
                        f32x4 v0 = acc[ai][bj][m][0] + b0, v1 = acc[ai][bj][m][1] + b1;
#pragma unroll
                        for (int e = 0; e < 4; ++e) { v0[e] = 1.f / (1.f + __expf(-v0[e])); v1[e] = 1.f / (1.f + __expf(-v1[e])); }
                        *(u32x4*)(gates + (size_t)(row0 + ai * HALF + m * 16) * 4096 + colt + bj * HALF) = pack8bf(v0, v1); }
            }
        } else {
            if (cw < 64) {
#pragma unroll
                for (int ai = 0; ai < 2; ++ai)
#pragma unroll
                    for (int m = 0; m < 4; ++m) *(u32x4*)(kpe + (size_t)(row0 + ai * HALF + m * 16) * 64 + cw) = pack8bf(acc[ai][0][m][0], acc[ai][0][m][1]);
            } else if (cw < 80) {
                const int h0 = cw - 64;
                const f32x4 b0 = *(const f32x4*)(b_forget + h0), b1 = *(const f32x4*)(b_forget + h0 + 4);
#pragma unroll
                for (int ai = 0; ai < 2; ++ai)
#pragma unroll
                    for (int m = 0; m < 4; ++m) { const int row = row0 + ai * HALF + m * 16;
                        f32x4 z0 = acc[ai][0][m][0] + b0, z1 = acc[ai][0][m][1] + b1;
#pragma unroll
                        for (int e = 0; e < 4; ++e) { z0[e] = fminf(z0[e], 0.f) - __logf(1.f + __expf(-fabsf(z0[e]))); z1[e] = fminf(z1[e], 0.f) - __logf(1.f + __expf(-fabsf(z1[e]))); }
                        *(f32x4*)(lf + (size_t)row * 16 + h0) = z0; *(f32x4*)(lf + (size_t)row * 16 + h0 + 4) = z1; }
            }
        }
    }
};
template <class Epi, class Sched, bool ALIGN_EPI = false, bool SP2 = false>
__device__ __forceinline__ void gemm_phase(PG8_LAS unsigned char* lds, const Gemm g, const Sched& S, const Epi& E) {
    const int tid = threadIdx.x, wid = __builtin_amdgcn_readfirstlane(tid >> 6), lane = tid & 63, wr = wid >> 2, wc = wid & 3, fr = lane & 15, fq = lane >> 4;
    const int K = g.K, nt = K / BK;
    unsigned voffA[2], voffB[2];
#pragma unroll
    for (int i = 0; i < 2; ++i) { int R, C; stage_rc(tid * 16 + i * 8192, R, C); const int Rb = Epi::PERM ? ((R & ~31) + perm32(R & 31)) : R;
        voffA[i] = (unsigned)(R * K + C) * 2u; voffB[i] = (unsigned)(Rb * K + C) * 2u; }
    const size_t kstep = (size_t)(BK * 2);
    const size_t hstep = (size_t)HALF * K * 2;
    const size_t tstep = 2 * hstep;
    const unsigned ldsw = (unsigned)wid * 1024u;
    const int aoff = lds_byte(wr * 64 + fr, fq * 8), boff = lds_byte(wc * 32 + fr, fq * 8);
#define PG8_SA(b, h) (((b) * 2 + (h)) * HTB)
#define PG8_SB(b, h) ((4 + (b) * 2 + (h)) * HTB)
#define PG8_STAGE(bufoff, gbase, voff) do { _Pragma("unroll") for (int _i = 0; _i < 2; ++_i) \
        __builtin_amdgcn_global_load_lds((const unsigned*)((const char*)(gbase) + (voff)[_i]), (PG8_LAS unsigned*)(lds + (bufoff) + ldsw + _i * 8192), 16, 0, 0); } while (0)
#define PG8_LDA(dst, b, h) do { _Pragma("unroll") for (int m = 0; m < 4; ++m) _Pragma("unroll") for (int k = 0; k < 2; ++k) dst[m][k] = *(const PG8_LAS bf16x8*)(lds + PG8_SA(b, h) + aoff + m * 2048 + k * 1024); } while (0)
#define PG8_LDB(dst, b, h) do { _Pragma("unroll") for (int n = 0; n < 2; ++n) _Pragma("unroll") for (int k = 0; k < 2; ++k) dst[n][k] = *(const PG8_LAS bf16x8*)(lds + PG8_SB(b, h) + boff + n * 2048 + k * 1024); } while (0)
#define PG8_MMA(ai, bj, At, Bt) do { __builtin_amdgcn_s_setprio(1); _Pragma("unroll") for (int m = 0; m < 4; ++m) _Pragma("unroll") for (int n = 0; n < 2; ++n) _Pragma("unroll") for (int k = 0; k < 2; ++k) \
        acc[ai][bj][m][n] = __builtin_amdgcn_mfma_f32_16x16x32_bf16(Bt[n][k], At[m][k], acc[ai][bj][m][n], 0, 0, 0); __builtin_amdgcn_s_setprio(0); } while (0)
#define PG8_WAIT_V(n) asm volatile("s_waitcnt vmcnt(" #n ")" ::: "memory")
#define PG8_WAIT_L(n) asm volatile("s_waitcnt lgkmcnt(" #n ")" ::: "memory")
#define PG8_BAR __builtin_amdgcn_s_barrier()
#define PG8_SCHED __builtin_amdgcn_sched_barrier(0)
    Unit cur, nxt; int ui = 0;
    if (!S.next(0, cur)) return;
    f32x4 acc[2][2][4][2];
#pragma unroll
    for (int a = 0; a < 2; ++a)
#pragma unroll
        for (int b = 0; b < 2; ++b)
#pragma unroll
            for (int m = 0; m < 4; ++m)
#pragma unroll
                for (int n = 0; n < 2; ++n) acc[a][b][m][n] = (f32x4){0.f, 0.f, 0.f, 0.f};
    bf16x8 At[4][2], B0[2][2], B1[2][2];
    const char* cA = (const char*)g.A + (size_t)cur.pm * tstep; const char* cB = (const char*)g.Bt + (size_t)cur.pn * tstep;
    S.a_ready(cur);
    if constexpr (SP2) {
        PG8_STAGE(PG8_SB(0, 0), cB, voffB); PG8_STAGE(PG8_SB(0, 1), cB + hstep, voffB); PG8_STAGE(PG8_SA(0, 0), cA, voffA); PG8_STAGE(PG8_SA(0, 1), cA + hstep, voffA);
        if (wr == 1) PG8_BAR;
        PG8_WAIT_V(2); PG8_BAR;
        PG8_STAGE(PG8_SB(1, 0), cB + kstep, voffB); PG8_STAGE(PG8_SA(1, 0), cA + kstep, voffA); PG8_STAGE(PG8_SB(1, 1), cB + hstep + kstep, voffB);
        PG8_WAIT_V(6); PG8_BAR;
    } else {
        PG8_STAGE(PG8_SB(0, 0), cB, voffB); PG8_STAGE(PG8_SA(0, 0), cA, voffA); PG8_STAGE(PG8_SB(0, 1), cB + hstep, voffB); PG8_STAGE(PG8_SA(0, 1), cA + hstep, voffA);
        if (wr == 1) PG8_BAR;
        PG8_WAIT_V(4); PG8_BAR;
        PG8_STAGE(PG8_SB(1, 0), cB + kstep, voffB); PG8_STAGE(PG8_SA(1, 0), cA + kstep, voffA); PG8_STAGE(PG8_SB(1, 1), cB + hstep + kstep, voffB);
        PG8_WAIT_V(6); PG8_BAR;
    }
    for (;;) {
        const bool has_next = S.next(ui + 1, nxt);
        const char* nA = has_next ? (const char*)g.A + (size_t)nxt.pm * tstep : cA; const char* nB = has_next ? (const char*)g.Bt + (size_t)nxt.pn * tstep : cB;
        for (int t = 0; t < nt; t += 2) {
            const bool last = (t == nt - 2);
            const char* a1 = cA + (size_t)(t + 1) * kstep;
            const char* a2 = last ? nA : cA + (size_t)(t + 2) * kstep; const char* b2 = last ? nB : cB + (size_t)(t + 2) * kstep;
            const char* a3 = a2 + kstep; const char* b3 = b2 + kstep;
            if (last && has_next) S.a_ready(nxt);
            if constexpr (SP2) {
            PG8_LDB(B0, 0, 0); PG8_LDB(B1, 0, 1); PG8_SCHED; PG8_LDA(At, 0, 0); PG8_STAGE(PG8_SA(1, 1), a1 + hstep, voffA);
            PG8_WAIT_V(8); PG8_WAIT_L(0); PG8_BAR; PG8_MMA(0, 0, At, B0); PG8_MMA(0, 1, At, B1); PG8_BAR; PG8_SCHED;
            PG8_LDA(At, 0, 1); PG8_STAGE(PG8_SB(0, 0), b2, voffB); PG8_STAGE(PG8_SB(0, 1), b2 + hstep, voffB); PG8_STAGE(PG8_SA(0, 0), a2, voffA);
            PG8_WAIT_V(8); PG8_WAIT_L(0); PG8_BAR; PG8_MMA(1, 0, At, B0); PG8_MMA(1, 1, At, B1); PG8_BAR; PG8_SCHED;
            PG8_LDB(B0, 1, 0); PG8_LDB(B1, 1, 1); PG8_SCHED; PG8_LDA(At, 1, 0); PG8_STAGE(PG8_SA(0, 1), a2 + hstep, voffA);
            PG8_WAIT_V(8); PG8_WAIT_L(0); PG8_BAR; PG8_MMA(0, 0, At, B0); PG8_MMA(0, 1, At, B1); PG8_BAR; PG8_SCHED;
            PG8_LDA(At, 1, 1); PG8_STAGE(PG8_SB(1, 0), b3, voffB); PG8_STAGE(PG8_SB(1, 1), b3 + hstep, voffB); PG8_STAGE(PG8_SA(1, 0), a3, voffA);
            PG8_WAIT_V(8); PG8_WAIT_L(0); PG8_BAR; PG8_MMA(1, 0, At, B0); PG8_MMA(1, 1, At, B1); PG8_BAR; PG8_SCHED;
            } else {
            PG8_LDB(B0, 0, 0); PG8_SCHED; PG8_LDA(At, 0, 0); PG8_STAGE(PG8_SA(1, 1), a1 + hstep, voffA);
            PG8_WAIT_L(8); PG8_BAR; PG8_WAIT_L(0); PG8_MMA(0, 0, At, B0); PG8_BAR; PG8_SCHED;
            PG8_LDB(B1, 0, 1); PG8_STAGE(PG8_SB(0, 0), b2, voffB);
            PG8_BAR; PG8_WAIT_L(0); PG8_MMA(0, 1, At, B1); PG8_BAR;
            PG8_LDA(At, 0, 1); PG8_STAGE(PG8_SA(0, 0), a2, voffA);
            PG8_BAR; PG8_WAIT_L(0); PG8_MMA(1, 0, At, B0); PG8_BAR; PG8_SCHED;
            PG8_STAGE(PG8_SB(0, 1), b2 + hstep, voffB);
            PG8_WAIT_V(6); PG8_BAR; PG8_MMA(1, 1, At, B1); PG8_BAR;
            PG8_LDB(B0, 1, 0); PG8_SCHED; PG8_LDA(At, 1, 0); PG8_STAGE(PG8_SA(0, 1), a2 + hstep, voffA);
            PG8_WAIT_L(8); PG8_BAR; PG8_WAIT_L(0); PG8_MMA(0, 0, At, B0); PG8_BAR; PG8_SCHED;
            PG8_LDB(B1, 1, 1); PG8_STAGE(PG8_SB(1, 0), b3, voffB);
            PG8_BAR; PG8_WAIT_L(0); PG8_MMA(0, 1, At, B1); PG8_BAR;
            PG8_LDA(At, 1, 1); PG8_STAGE(PG8_SA(1, 0), a3, voffA);
            PG8_BAR; PG8_WAIT_L(0); PG8_MMA(1, 0, At, B0); PG8_BAR; PG8_SCHED;
            PG8_STAGE(PG8_SB(1, 1), b3 + hstep, voffB);
            PG8_WAIT_V(6); PG8_BAR; PG8_MMA(1, 1, At, B1); PG8_BAR;
            }
        }
        if constexpr (ALIGN_EPI) { if (wr == 0) PG8_BAR; }
        if constexpr (!Epi::AFTER_DRAIN) { E(acc, cur, wr, wc, fr, fq); S.done(cur); }
        if (!has_next) break;
#pragma unroll
        for (int a = 0; a < 2; ++a)
#pragma unroll
            for (int b = 0; b < 2; ++b)
#pragma unroll
                for (int m = 0; m < 4; ++m)
#pragma unroll
                    for (int n = 0; n < 2; ++n) acc[a][b][m][n] = (f32x4){0.f, 0.f, 0.f, 0.f};
        cur = nxt; cA = nA; cB = nB; ++ui;
        if constexpr (ALIGN_EPI) { if (wr == 1) PG8_BAR; }
    }
    PG8_WAIT_V(0);
    if constexpr (!ALIGN_EPI) { if (wr == 0) PG8_BAR; }
    PG8_BAR;
    if constexpr (Epi::AFTER_DRAIN) { E.fused(acc, cur, wr, wc, fr, fq, lds, wid, lane); S.done(cur); }
#undef PG8_SA
#undef PG8_SB
#undef PG8_STAGE
#undef PG8_LDA
#undef PG8_LDB
#undef PG8_MMA
#undef PG8_WAIT_V
#undef PG8_WAIT_L
#undef PG8_BAR
#undef PG8_SCHED
}
}
namespace att {
typedef unsigned short bf16_t;
typedef short bf16x8 __attribute__((ext_vector_type(8)));
typedef short s16x4 __attribute__((ext_vector_type(4)));
typedef float f32x16 __attribute__((ext_vector_type(16)));
typedef float f32x4 __attribute__((ext_vector_type(4)));
typedef unsigned u32x4 __attribute__((ext_vector_type(4)));
#define ALAS __attribute__((address_space(3)))
#define ASBAR() __builtin_amdgcn_sched_barrier(0)
constexpr int SHM_V = 16384;
template <int DK> struct Lay { static constexpr int ROWB = DK * 2, SHM_K = 64 * ROWB, OFF_K = 2 * SHM_V, OFF_F = OFF_K + 2 * SHM_K, OFF_WS = OFF_F + 512, TOTAL = OFF_WS + 8 * 256; };

__device__ __forceinline__ int v_st(int k, int c) { const int kk = (k & ~0xC) | ((k & 4) << 1) | ((k & 8) >> 1); return ((kk >> 3) * 4 + (c >> 5)) * 512 + ((kk & 7) * 32 + (c & 31)) * 2; }
__device__ __forceinline__ int v_rd_base(int lane) { return ((lane & 3) << 3) | (((lane >> 2) & 3) << 6) | (((lane >> 4) & 1) << 5) | (((lane >> 5) & 1) << 8); }
__device__ __forceinline__ int crow(int r, int hi) { return (r & 3) + 8 * (r >> 2) + 4 * hi; }
__device__ __forceinline__ unsigned cvtpk(float lo, float hi) { unsigned r; asm volatile("v_cvt_pk_bf16_f32 %0, %1, %2" : "=v"(r) : "v"(lo), "v"(hi)); return r; }

template <int DK, bool FOX>
__device__ __forceinline__ void attn_block(unsigned char* smem, const bf16_t* __restrict__ Q, int ldq, const bf16_t* __restrict__ K, int ldk, const bf16_t* __restrict__ V, int ldv,
                                           const float* __restrict__ Fh, bf16_t* __restrict__ gout  , int qbk) {
    typedef Lay<DK> LY;
    constexpr int ND = DK / 16, NKC = DK / 8, NKI = (64 * NKC) / 512;
    int tid = threadIdx.x; asm volatile("" : "+v"(tid));
    const int wid = __builtin_amdgcn_readfirstlane(tid >> 6), lane = tid & 63, r32 = lane & 31, hi = lane >> 5;
    const int q0 = qbk * 256, qlo = q0 + wid * 32, qm = qlo + r32 - 4 * hi;
    const int NT = 4 * qbk + 4;
    ALAS unsigned char* lds = (ALAS unsigned char*)smem;
    ALAS float* F_lds = (ALAS float*)(lds + LY::OFF_F);
    ALAS float* wsl = (ALAS float*)(lds + LY::OFF_WS) + wid * 64;
    bf16x8 qr[ND];
#pragma unroll
    for (int d0 = 0; d0 < ND; ++d0) qr[d0] = *(const bf16x8*)(Q + (size_t)(qlo + r32) * ldq + d0 * 16 + hi * 8);
    const float fq = FOX ? Fh[qlo + r32] : 0.f;
    int kgo[NKI], klo[NKI];
#pragma unroll
    for (int i = 0; i < NKI; ++i) { const int idx = tid + 512 * i, row = idx / NKC, ch = idx % NKC; kgo[i] = row * ldk + ch * 8; klo[i] = row * LY::ROWB + ((ch ^ ((row >> 1) & 7)) << 4); }
    const int sr = tid >> 4, sc = (tid & 15) * 8, vst0 = v_st(sr, sc), vst1 = v_st(32 + sr, sc);
    const int vgo0 = sr * ldv + sc, vgo1 = (32 + sr) * ldv + sc;
    const int vb0 = (int)(uintptr_t)smem + v_rd_base(lane);
    int kbase[4];
#pragma unroll
    for (int dd = 0; dd < 4; ++dd) kbase[dd] = LY::OFF_K + r32 * LY::ROWB + (((((dd << 1) | hi) ^ ((r32 >> 1) & 7))) << 4);
    bf16x8 stk[NKI], stv0, stv1; float stf = 0.f;
#define ATT_LOAD(kb) do { _Pragma("unroll") for (int i = 0; i < NKI; ++i) stk[i] = *(const bf16x8*)(K + (size_t)(kb) * ldk + kgo[i]); \
        stv0 = *(const bf16x8*)(V + (size_t)(kb) * ldv + vgo0); stv1 = *(const bf16x8*)(V + (size_t)(kb) * ldv + vgo1); if (FOX && tid < 64) stf = Fh[(kb) + tid]; } while (0)
#define ATT_WRITE(bf) do { _Pragma("unroll") for (int i = 0; i < NKI; ++i) *(ALAS bf16x8*)(lds + LY::OFF_K + (bf) * LY::SHM_K + klo[i]) = stk[i]; \
        *(ALAS bf16x8*)(lds + (bf) * SHM_V + vst0) = stv0; *(ALAS bf16x8*)(lds + (bf) * SHM_V + vst1) = stv1; if (FOX && tid < 64) F_lds[(bf) * 64 + tid] = stf; } while (0)
    ATT_LOAD(0); ATT_WRITE(0);
    float m_reg = -1e30f, l_reg = 0.f; f32x16 o[4];
#pragma unroll
    for (int d = 0; d < 4; ++d)
#pragma unroll
        for (int r = 0; r < 16; ++r) o[d][r] = 0.f;
    for (int t = 0; t < NT; ++t) {
        const int buf = t & 1, kb = t * 64;
        __syncthreads();
        if (t + 1 < NT) ATT_LOAD(kb + 64);
        f32x16 p0, p1;
        if (FOX) {
#pragma unroll
            for (int g = 0; g < 4; ++g) { const f32x4 f0 = *(const ALAS f32x4*)(F_lds + buf * 64 + 8 * g + 4 * hi), f1 = *(const ALAS f32x4*)(F_lds + buf * 64 + 32 + 8 * g + 4 * hi);
#pragma unroll
                for (int e = 0; e < 4; ++e) { p0[4 * g + e] = fq - f0[e]; p1[4 * g + e] = fq - f1[e]; } }
        } else {
#pragma unroll
            for (int r = 0; r < 16; ++r) { p0[r] = 0.f; p1[r] = 0.f; }
        }
#pragma unroll
        for (int d0 = 0; d0 < ND; ++d0) {
            ALAS const unsigned char* a = lds + buf * LY::SHM_K + kbase[d0 & 3] + (d0 >> 2) * 128;
            const bf16x8 b0 = *(const ALAS bf16x8*)a;
            const bf16x8 b1 = *(const ALAS bf16x8*)(a + 32 * LY::ROWB);
            p0 = __builtin_amdgcn_mfma_f32_32x32x16_bf16(b0, qr[d0], p0, 0, 0, 0);
            p1 = __builtin_amdgcn_mfma_f32_32x32x16_bf16(b1, qr[d0], p1, 0, 0, 0);
        }
        if (kb + 63 > qlo) {
            const float NEG = -__builtin_inff(); const int dq = qm - kb;
#pragma unroll
            for (int r = 0; r < 16; ++r) { const int c = (r & 3) + 8 * (r >> 2); if (dq - c < 0) p0[r] = NEG; if (dq - c - 32 < 0) p1[r] = NEG; }
        }
        float pmax = p0[0];
#pragma unroll
        for (int r = 1; r < 16; ++r) pmax = fmaxf(pmax, p0[r]);
#pragma unroll
        for (int r = 0; r < 16; ++r) pmax = fmaxf(pmax, p1[r]);
        { auto rr = __builtin_amdgcn_permlane32_swap(__float_as_uint(pmax), __float_as_uint(pmax), false, false);
          pmax = fmaxf(__uint_as_float(rr[0]), __uint_as_float(rr[1])); }
        const float mn = fmaxf(m_reg, pmax);
        const float alpha = __builtin_amdgcn_exp2f(m_reg - mn);
        m_reg = mn;
        float ps = 0.f;
#pragma unroll
        for (int r = 0; r < 16; ++r) { p0[r] = __builtin_amdgcn_exp2f(p0[r] - mn); ps += p0[r]; }
#pragma unroll
        for (int r = 0; r < 16; ++r) { p1[r] = __builtin_amdgcn_exp2f(p1[r] - mn); ps += p1[r]; }
        { auto rr = __builtin_amdgcn_permlane32_swap(__float_as_uint(ps), __float_as_uint(ps), false, false);
          ps = __uint_as_float(rr[0]) + __uint_as_float(rr[1]); }
        l_reg = l_reg * alpha + ps;
        bf16x8 pa0, pa1, pa2, pa3;
#define ATT_PK4(P, B_, OUT) do { unsigned a0 = cvtpk(P[B_+0], P[B_+1]), a1 = cvtpk(P[B_+2], P[B_+3]); unsigned b0_ = cvtpk(P[B_+4], P[B_+5]), b1_ = cvtpk(P[B_+6], P[B_+7]); \
        auto r0 = __builtin_amdgcn_permlane32_swap(a0, b0_, false, false); auto r1 = __builtin_amdgcn_permlane32_swap(a1, b1_, false, false); \
        u32x4 w = {r0[0], r1[0], r0[1], r1[1]}; OUT = *reinterpret_cast<bf16x8*>(&w); } while (0)
        ATT_PK4(p0, 0, pa0); ATT_PK4(p0, 8, pa1); ATT_PK4(p1, 0, pa2); ATT_PK4(p1, 8, pa3);
        if (__any(alpha < 1.f)) {
            if (hi == 0) wsl[r32] = alpha;
            asm volatile("s_waitcnt lgkmcnt(0)" ::: "memory");
#pragma unroll
            for (int g = 0; g < 4; ++g) { const f32x4 al = *(const ALAS f32x4*)(wsl + 8 * g + 4 * hi);
#pragma unroll
                for (int d = 0; d < 4; ++d)
#pragma unroll
                    for (int e = 0; e < 4; ++e) o[d][4 * g + e] *= al[e]; }
        }
#define ATT_TRRD(dst, off) asm volatile("ds_read_b64_tr_b16 %0, %1 offset:%2" : "=&v"(dst) : "v"(vbb), "i"(off) : "memory")
#define ATT_PV(d0) do { s16x4 l0, l1, l2, l3, h0, h1, h2, h3; constexpr int b_ = (d0) * 512; \
        ATT_TRRD(l0, b_); ATT_TRRD(h0, b_ + 2048); ATT_TRRD(l1, b_ + 4096); ATT_TRRD(h1, b_ + 6144); ATT_TRRD(l2, b_ + 8192); ATT_TRRD(h2, b_ + 10240); ATT_TRRD(l3, b_ + 12288); ATT_TRRD(h3, b_ + 14336); \
        asm volatile("s_waitcnt lgkmcnt(0)" ::: "memory"); ASBAR(); \
        o[d0] = __builtin_amdgcn_mfma_f32_32x32x16_bf16(pa0, (bf16x8){l0[0], l0[1], l0[2], l0[3], h0[0], h0[1], h0[2], h0[3]}, o[d0], 0, 0, 0); \
        o[d0] = __builtin_amdgcn_mfma_f32_32x32x16_bf16(pa1, (bf16x8){l1[0], l1[1], l1[2], l1[3], h1[0], h1[1], h1[2], h1[3]}, o[d0], 0, 0, 0); \
        o[d0] = __builtin_amdgcn_mfma_f32_32x32x16_bf16(pa2, (bf16x8){l2[0], l2[1], l2[2], l2[3], h2[0], h2[1], h2[2], h2[3]}, o[d0], 0, 0, 0); \
        o[d0] = __builtin_amdgcn_mfma_f32_32x32x16_bf16(pa3, (bf16x8){l3[0], l3[1], l3[2], l3[3], h3[0], h3[1], h3[2], h3[3]}, o[d0], 0, 0, 0); } while (0)
        { const int vbb = vb0 + buf * SHM_V; ATT_PV(0); ATT_PV(1); ATT_PV(2); ATT_PV(3); }
        if (t + 1 < NT) ATT_WRITE(buf ^ 1);
    }
    if (hi == 0) wsl[r32] = l_reg;
    asm volatile("s_waitcnt lgkmcnt(0)" ::: "memory");
#pragma unroll
    for (int r = 0; r < 16; ++r) {
        const int orow = crow(r, hi); const float rli = __builtin_amdgcn_rcpf(wsl[orow]);
        bf16_t* rowp = gout + (size_t)(qlo + orow) * 4096;
#pragma unroll
        for (int d0 = 0; d0 < 4; ++d0) {
            const float v = o[d0][r] * rli; const float vn = __shfl_xor(v, 1);
            if ((r32 & 1) == 0) { unsigned* gp = (unsigned*)(rowp + d0 * 32 + r32); const unsigned g = *gp;
                *gp = cvtpk(v * __uint_as_float(g << 16), vn * __uint_as_float(g & 0xffff0000u)); }
        }
    }
    __syncthreads();
#undef ATT_LOAD
#undef ATT_WRITE
#undef ATT_PK4
#undef ATT_TRRD
#undef ATT_PV
}
}
using pg8::bf16_t; using pg8::f32x4; using pg8::u32x4;
#define LAS __attribute__((address_space(3)))
constexpr int S = 8192, DM = 2048, INW = 11344, INWP = 11520;
constexpr float EPS = 1e-6f;
constexpr size_t MiB = 1u << 20;

__device__ __forceinline__ float bf2f(bf16_t v) { return __uint_as_float(((unsigned)v) << 16); }
__device__ __forceinline__ bf16_t f2bf(float f) { unsigned u = __float_as_uint(f); u += 0x7fffu + ((u >> 16) & 1u); return (bf16_t)(u >> 16); }
__device__ __forceinline__ unsigned pk2(float lo, float hi) { return (unsigned)f2bf(lo) | ((unsigned)f2bf(hi) << 16); }
__device__ __forceinline__ float wave_sum(float v) {
#pragma unroll
    for (int o = 32; o >= 1; o >>= 1) v += __shfl_xor(v, o);
    return v;
}
__device__ __forceinline__ float wave_max(float v) {
#pragma unroll
    for (int o = 32; o >= 1; o >>= 1) v = fmaxf(v, __shfl_xor(v, o));
    return v;
}

__device__ __forceinline__ int opaque_tid() { int t = threadIdx.x; asm volatile("" : "+v"(t)); return t; }

struct Params {
    const float* x; const int* pos; const float *mix_g, *w_in, *b_forget, *b_gate, *q_lat_g, *w_q_up, *kv_lat_g, *w_kv_up, *mla_qg, *mla_kg, *fox_qg, *fox_kg, *w_out, *ffn_g, *w_peer_q, *sub_keys, *peer_u, *peer_v;
    float* out;
    bf16_t *WqT, *WkvT, *WoT, *WpT, *WinT;
    bf16_t *h, *cq, *ckv, *fq, *fk, *fv, *merged, *kpe, *qa, *kvraw, *ka;
    float *lf, *F, *x1, *scores;
    bf16_t *U16, *V16;
};

struct DstId { __device__ __forceinline__ int operator()(int n) const { return n; } };
struct DstWin { __device__ __forceinline__ int operator()(int n) const {
    if (n < 1024) return n; if (n < 1088) return 11264 + (n - 1024); if (n < 7232) return n - 64; if (n < 7248) return 11264 + 64 + (n - 7232); return n - 80; } };
template <class Dst>
__device__ __forceinline__ void transpose_item(const float* __restrict__ W, int K, int N, bf16_t* __restrict__ WT, Dst dst, float* scr, int item, int lane) {
    const int nblk = (N + 31) / 32, kb = item / nblk, nb = item % nblk, k0 = 64 * kb, n0 = 32 * nb;
    { const int n = n0 + (lane & 31);
#pragma unroll 8
      for (int i = 0; i < 32; ++i) { const int kk = 2 * i + (lane >> 5); scr[kk * 33 + (lane & 31)] = (n < N) ? W[(size_t)(k0 + kk) * N + n] : 0.f; } }
    asm volatile("s_waitcnt lgkmcnt(0)" ::: "memory");
    const int c = lane & 7;
#pragma unroll
    for (int j = 0; j < 4; ++j) { const int nl = (lane >> 3) + 8 * j, n = n0 + nl; const float* s = scr + (8 * c) * 33 + nl;
        u32x4 o; o.x = pk2(s[0 * 33], s[1 * 33]); o.y = pk2(s[2 * 33], s[3 * 33]); o.z = pk2(s[4 * 33], s[5 * 33]); o.w = pk2(s[6 * 33], s[7 * 33]);
        if (n < N) *(u32x4*)(WT + (size_t)dst(n) * K + k0 + 8 * c) = o; }
    asm volatile("s_waitcnt lgkmcnt(0)" ::: "memory");
}
__device__ __forceinline__ void wfold_item(const float* __restrict__ wq, const float* __restrict__ keys, bf16_t* __restrict__ WpT, float* sm, int item) {
    const int tid = opaque_tid(), hc = item >> 5, d0 = (item & 31) * 64;
    float* keysL = sm; float* wqL = sm + 128 * 129;
    for (int idx = tid; idx < 128 * 128; idx += 512) keysL[(idx >> 7) * 129 + (idx & 127)] = keys[(size_t)hc * 16384 + idx];
    for (int idx = tid; idx < 64 * 128; idx += 512) wqL[(idx >> 7) * 129 + (idx & 127)] = wq[(size_t)(d0 + (idx >> 7)) * 2048 + hc * 128 + (idx & 127)];
    __syncthreads();
    const int n = tid & 127, dq = tid >> 7;
    float acc[16];
#pragma unroll
    for (int i = 0; i < 16; ++i) acc[i] = 0.f;
    for (int j = 0; j < 128; ++j) { const float kv = keysL[n * 129 + j];
#pragma unroll
        for (int i = 0; i < 16; ++i) acc[i] += kv * wqL[(dq * 16 + i) * 129 + j]; }
    u32x4 o0, o1;
    o0.x = pk2(acc[0], acc[1]); o0.y = pk2(acc[2], acc[3]); o0.z = pk2(acc[4], acc[5]); o0.w = pk2(acc[6], acc[7]);
    o1.x = pk2(acc[8], acc[9]); o1.y = pk2(acc[10], acc[11]); o1.z = pk2(acc[12], acc[13]); o1.w = pk2(acc[14], acc[15]);
    bf16_t* dstp = WpT + (size_t)(hc * 128 + n) * 2048 + d0 + dq * 16;
    *(u32x4*)dstp = o0; *(u32x4*)(dstp + 8) = o1;
    __syncthreads();
}
__device__ __forceinline__ void rms_row2048(const float* __restrict__ xr, const float* __restrict__ g, bf16_t* __restrict__ orow, int lane) {
    f32x4 v[8]; float ss = 0.f;
#pragma unroll
    for (int j = 0; j < 8; ++j) { v[j] = *(const f32x4*)(xr + j * 256 + lane * 4); ss += (v[j][0] * v[j][0] + v[j][1] * v[j][1]) + (v[j][2] * v[j][2] + v[j][3] * v[j][3]); }
    const float r = rsqrtf(wave_sum(ss) * (1.f / 2048.f) + EPS);
#pragma unroll
    for (int j = 0; j < 8; ++j) { const f32x4 gg = *(const f32x4*)(g + j * 256 + lane * 4);
        uint2 o; o.x = pk2(v[j][0] * r * gg[0], v[j][1] * r * gg[1]); o.y = pk2(v[j][2] * r * gg[2], v[j][3] * r * gg[3]);
        *(uint2*)(orow + j * 256 + lane * 4) = o; }
}
__device__ __forceinline__ void rms_row512_inplace(bf16_t* __restrict__ row, const float* __restrict__ g, int lane) {
    u32x4 w = *(const u32x4*)(row + lane * 8); float v[8];
#pragma unroll
    for (int i = 0; i < 4; ++i) { v[2 * i] = __uint_as_float(w[i] << 16); v[2 * i + 1] = __uint_as_float(w[i] & 0xffff0000u); }
    float ss = 0.f;
#pragma unroll
    for (int i = 0; i < 8; ++i) ss += v[i] * v[i];
    const float r = rsqrtf(wave_sum(ss) * (1.f / 512.f) + EPS);
    u32x4 o;
#pragma unroll
    for (int i = 0; i < 4; ++i) o[i] = pk2(v[2 * i] * r * g[lane * 8 + 2 * i], v[2 * i + 1] * r * g[lane * 8 + 2 * i + 1]);
    *(u32x4*)(row + lane * 8) = o;
}
__device__ __forceinline__ void fox_prep(int w, bf16_t* __restrict__ fq, bf16_t* __restrict__ fk, const float* __restrict__ gq, const float* __restrict__ gk, int lane) {
    const int t = w >> 4, h = w & 15;
#pragma unroll
    for (int which = 0; which < 2; ++which) {
        bf16_t* p = (which ? fk : fq) + (size_t)t * 2048 + h * 128; const float* g = which ? gk : gq;
        const float v0 = bf2f(p[lane]), v1 = bf2f(p[lane + 64]);
        const float r = rsqrtf(wave_sum(v0 * v0 + v1 * v1) * (1.f / 128.f) + EPS);
        const float qs = which ? 1.f : 0.12751743f;
        p[lane] = f2bf(v0 * r * g[lane] * qs); p[lane + 64] = f2bf(v1 * r * g[lane + 64] * qs);
    }
}
__device__ __forceinline__ void fox_cumsum(double* part, int h, const float* __restrict__ lf, float* __restrict__ F) {
    const int tid = opaque_tid(); double sum = 0.0;
    for (int i = 0; i < 16; ++i) sum += (double)lf[(size_t)(tid * 16 + i) * 16 + h];
    part[tid] = sum;
    __syncthreads();
    if (tid == 0) { double run = 0.0; for (int i = 0; i < 512; ++i) { const double v = part[i]; part[i] = run; run += v; } }
    __syncthreads();
    double run = part[tid];
    for (int i = 0; i < 16; ++i) { run += (double)lf[(size_t)(tid * 16 + i) * 16 + h]; F[(size_t)h * S + tid * 16 + i] = (float)(run * 1.4426950408889634); }
    __syncthreads();
}
__device__ __forceinline__ void rope_cs(int pos, int i, float& c, float& s) {
    const double inv = exp(-(double)i * (1.0 / 32.0) * 9.210340371976184);
    double ang = (double)((float)pos * (float)inv);
    const double twopi = 6.283185307179586;
    ang -= twopi * rint(ang / twopi);
    c = cosf((float)ang); s = sinf((float)ang);
}
__device__ __forceinline__ void mla_prep(int w, bf16_t* __restrict__ qa, const bf16_t* __restrict__ kvraw, const bf16_t* __restrict__ kpe, const int* __restrict__ pos,
                                         const float* __restrict__ gq, const float* __restrict__ gk, bf16_t* __restrict__ ka, int lane) {
    const int t = w >> 4, h = w & 15;
    float c, s; rope_cs(pos[t], lane & 31, c, s);
    {
        bf16_t* q = qa + (size_t)t * 3072 + h * 192;
        float v0 = bf2f(q[lane]), v1 = bf2f(q[lane + 64]), v2 = bf2f(q[lane + 128]);
        const float r = rsqrtf(wave_sum(v0 * v0 + v1 * v1 + v2 * v2) * (1.f / 192.f) + EPS);
        v0 *= r * gq[lane]; v1 *= r * gq[lane + 64]; v2 *= r * gq[lane + 128];
        const float o = __shfl_xor(v2, 32);
        const float rr = lane < 32 ? v2 * c - o * s : o * s + v2 * c;
        q[lane] = f2bf(v0 * 0.10411754f); q[lane + 64] = f2bf(v1 * 0.10411754f); q[lane + 128] = f2bf(rr * 0.10411754f);
    }
    {
        const bf16_t* kn = kvraw + (size_t)t * 4096 + h * 256;
        float v0 = bf2f(kn[lane]), v1 = bf2f(kn[lane + 64]), v2 = bf2f(kpe[(size_t)t * 64 + lane]);
        const float r = rsqrtf(wave_sum(v0 * v0 + v1 * v1 + v2 * v2) * (1.f / 192.f) + EPS);
        v0 *= r * gk[lane]; v1 *= r * gk[lane + 64]; v2 *= r * gk[lane + 128];
        const float o = __shfl_xor(v2, 32);
        const float rr = lane < 32 ? v2 * c - o * s : o * s + v2 * c;
        bf16_t* k = ka + (size_t)t * 3072 + h * 192;
        k[lane] = f2bf(v0); k[lane + 64] = f2bf(v1); k[lane + 128] = f2bf(rr);
    }
}

__device__ __forceinline__ void cvt_rows_bf16(const float* __restrict__ src, bf16_t* __restrict__ dst, size_t n, int gw, int NGW, int lane) {
    const size_t nchunk = n / 512;
    for (size_t c = gw; c < nchunk; c += NGW) { const size_t o = c * 512 + lane * 8;
        const f32x4 a = *(const f32x4*)(src + o), b2 = *(const f32x4*)(src + o + 4);
        u32x4 w; w.x = pk2(a[0], a[1]); w.y = pk2(a[2], a[3]); w.z = pk2(b2[0], b2[1]); w.w = pk2(b2[2], b2[3]);
        *(u32x4*)(dst + o) = w; }
}
typedef __bf16 bf16x2_t __attribute__((ext_vector_type(2)));
__device__ __forceinline__ float dot2bf(unsigned a, unsigned b, float c) { return __builtin_amdgcn_fdot2_f32_bf16(__builtin_bit_cast(bf16x2_t, a), __builtin_bit_cast(bf16x2_t, b), c, false); }
#define PEER_INS(top, x) do { float x_ = (x); _Pragma("unroll") for (int i_ = 0; i_ < 16; ++i_) { const float hi_ = fmaxf(top[i_], x_); x_ = fminf(top[i_], x_); top[i_] = hi_; } } while (0)
__device__ __forceinline__ void peer_group(unsigned char* smem, int g, const float* __restrict__ scores, const bf16_t* __restrict__ h2, const float* __restrict__ x1,
                                           const bf16_t* __restrict__ U16, const bf16_t* __restrict__ V16, float* __restrict__ out) {
    const int tid = opaque_tid(), lane = tid & 63, wave = __builtin_amdgcn_readfirstlane(tid >> 6);
    float* topL = (float*)smem;
    int* selE = (int*)(smem + 32768);
    float* selG = (float*)(smem + 49152);
    {
        const int tl = tid >> 4, hc = tid & 15;
        const float* sp = scores + (size_t)(g * 32 + tl) * 2048 + hc * 128;
        float top[16];
#pragma unroll
        for (int i = 0; i < 16; ++i) top[i] = -INFINITY;
#pragma unroll 2
        for (int n0 = 0; n0 < 128; n0 += 4) { const f32x4 v = *(const f32x4*)(sp + n0);
#pragma unroll
            for (int e = 0; e < 4; ++e) PEER_INS(top, __uint_as_float((__float_as_uint(v[e]) & ~0x7Fu) | (unsigned)(n0 + e))); }
        float* tp = topL + (tl * 16 + hc) * 16;
#pragma unroll
        for (int i = 0; i < 16; i += 4) *(f32x4*)(tp + i) = (f32x4){top[i], top[i + 1], top[i + 2], top[i + 3]};
    }
    __syncthreads();
    if (tid < 256) {
        const int tl = tid >> 3, h = tid & 7;
        const float* t1 = topL + (tl * 16 + 2 * h) * 16; const float* t2 = t1 + 16;
        float s1[16], s2[16];
#pragma unroll
        for (int i = 0; i < 16; i += 4) { const f32x4 a = *(const f32x4*)(t1 + i), b2 = *(const f32x4*)(t2 + i);
            s1[i] = a[0]; s1[i + 1] = a[1]; s1[i + 2] = a[2]; s1[i + 3] = a[3]; s2[i] = b2[0]; s2[i + 1] = b2[1]; s2[i + 2] = b2[2]; s2[i + 3] = b2[3]; }
        float ts[16];
#pragma unroll
        for (int i = 0; i < 16; ++i) ts[i] = -INFINITY;
#pragma unroll
        for (int i = 0; i < 16; ++i)
#pragma unroll
            for (int j = 0; j < 16; ++j)
                if ((i + 1) * (j + 1) <= 16) PEER_INS(ts, __uint_as_float((__float_as_uint(s1[i] + s2[j]) & ~0xFFu) | (unsigned)(i * 16 + j)));
        float ex[16], sum = 0.f;
#pragma unroll
        for (int k = 0; k < 16; ++k) { ex[k] = __expf(ts[k] - ts[0]); sum += ex[k]; }
        const float inv = 1.f / sum;
#pragma unroll
        for (int k = 0; k < 16; ++k) { const unsigned pos = __float_as_uint(ts[k]) & 0xFFu;
            const int i1 = (int)(__float_as_uint(t1[pos >> 4]) & 0x7Fu), i2 = (int)(__float_as_uint(t2[pos & 15]) & 0x7Fu);
            selE[tl * 128 + h * 16 + k] = i1 * 128 + i2; selG[tl * 128 + h * 16 + k] = ex[k] * inv; }
    }
    __syncthreads();
    for (int ti = 0; ti < 4; ++ti) {
        const int tl = wave * 4 + ti; const size_t t = (size_t)g * 32 + tl;
        u32x4 hq[4];
#pragma unroll
        for (int j = 0; j < 4; ++j) hq[j] = *(const u32x4*)(h2 + t * DM + j * 512 + lane * 8);
        float acc[32];
#pragma unroll
        for (int i = 0; i < 32; ++i) acc[i] = 0.f;
        for (int bb = 0; bb < 32; ++bb) {
            int e[4]; float gt[4];
#pragma unroll
            for (int q = 0; q < 4; ++q) { e[q] = __builtin_amdgcn_readfirstlane(selE[tl * 128 + bb * 4 + q]); gt[q] = selG[tl * 128 + bb * 4 + q]; }
            u32x4 ur[4][4], vr[4][4];
#pragma unroll
            for (int q = 0; q < 4; ++q)
#pragma unroll
                for (int j = 0; j < 4; ++j) ur[q][j] = *(const u32x4*)(U16 + (size_t)e[q] * DM + j * 512 + lane * 8);
#pragma unroll
            for (int q = 0; q < 4; ++q)
#pragma unroll
                for (int j = 0; j < 4; ++j) vr[q][j] = *(const u32x4*)(V16 + (size_t)e[q] * DM + j * 512 + lane * 8);
            float d[4];
#pragma unroll
            for (int q = 0; q < 4; ++q) { float a = 0.f;
#pragma unroll
                for (int j = 0; j < 4; ++j)
#pragma unroll
                    for (int c = 0; c < 4; ++c) a = dot2bf(hq[j][c], ur[q][j][c], a);
                d[q] = a; }
            const bool b5 = (lane & 32) != 0, b4 = (lane & 16) != 0;
            const float r0 = __shfl_xor(b5 ? d[0] : d[2], 32), r1 = __shfl_xor(b5 ? d[1] : d[3], 32);
            const float k0 = (b5 ? d[2] : d[0]) + r0, k1 = (b5 ? d[3] : d[1]) + r1;
            float c1 = (b4 ? k1 : k0) + __shfl_xor(b4 ? k0 : k1, 16);
            c1 += __shfl_xor(c1, 8); c1 += __shfl_xor(c1, 4); c1 += __shfl_xor(c1, 2); c1 += __shfl_xor(c1, 1);
#pragma unroll
            for (int q = 0; q < 4; ++q) {
                const float a = __uint_as_float((unsigned)__builtin_amdgcn_readlane((int)__float_as_uint(c1), 16 * q));
                const float w = gt[q] * 0.5f * a * (1.f + erff(a * 0.70710678118654752f));
#pragma unroll
                for (int j = 0; j < 4; ++j)
#pragma unroll
                    for (int c = 0; c < 4; ++c) { const unsigned x = vr[q][j][c];
                        acc[j * 8 + 2 * c] += w * __uint_as_float(x << 16); acc[j * 8 + 2 * c + 1] += w * __uint_as_float(x & 0xffff0000u); }
            }
        }
#pragma unroll
        for (int j = 0; j < 4; ++j) { const size_t o = t * DM + j * 512 + lane * 8;
            const f32x4 a = *(const f32x4*)(x1 + o), b2 = *(const f32x4*)(x1 + o + 4);
            *(f32x4*)(out + o) = (f32x4){a[0] + acc[j * 8], a[1] + acc[j * 8 + 1], a[2] + acc[j * 8 + 2], a[3] + acc[j * 8 + 3]};
            *(f32x4*)(out + o + 4) = (f32x4){b2[0] + acc[j * 8 + 4], b2[1] + acc[j * 8 + 5], b2[2] + acc[j * 8 + 6], b2[3] + acc[j * 8 + 7]}; }
    }
    __syncthreads();
}

constexpr int LDS_BYTES = 147456;
__global__ __launch_bounds__(512, 2) void mega(Params p) {
    extern __shared__ __attribute__((aligned(16))) unsigned char smem[];
    cg::grid_group grid = cg::this_grid();
    float* smf = (float*)smem;
    LAS unsigned char* lds = (LAS unsigned char*)smem;
    const int G = gridDim.x, b = blockIdx.x, NGW = G * 8;
#define PHASE_IDS() const int tid = opaque_tid(), lane = tid & 63, wave = __builtin_amdgcn_readfirstlane(tid >> 6), gw = b * 8 + wave; (void)lane; (void)gw

    {
        PHASE_IDS();
        float* scr = smf + wave * 4096;
        constexpr int I_IN = 32 * 355, I_Q = 8 * 96, I_KV = 8 * 128, I_O = 64 * 64;
        for (int it = gw; it < I_IN + I_Q + I_KV + I_O; it += NGW) {
            int r = it;
            if (r < I_IN) { transpose_item(p.w_in, 2048, INW, p.WinT, DstWin(), scr, r, lane); continue; } r -= I_IN;
            if (r < I_Q) { transpose_item(p.w_q_up, 512, 3072, p.WqT, DstId(), scr, r, lane); continue; } r -= I_Q;
            if (r < I_KV) { transpose_item(p.w_kv_up, 512, 4096, p.WkvT, DstId(), scr, r, lane); continue; } r -= I_KV;
            transpose_item(p.w_out, 4096, 2048, p.WoT, DstId(), scr, r, lane);
        }
        for (int m = gw; m < S; m += NGW) rms_row2048(p.x + (size_t)m * DM, p.mix_g, p.h + (size_t)m * DM, lane);
        __syncthreads();
        for (int it = b; it < 512; it += G) wfold_item(p.w_peer_q, p.sub_keys, p.WpT, smf, it);
    }
    grid.sync();
    {
        pg8::Gemm g{p.h, p.WinT, S, INWP, DM}; pg8::StaticOrder so; so.init(S, INWP, G, b);
        pg8::EpiInProj E{p.cq, p.ckv, p.fq, p.fk, p.fv, p.merged, p.kpe, p.lf, p.b_gate, p.b_forget};
        pg8::gemm_phase<pg8::EpiInProj, pg8::StaticOrder, true, true>(lds, g, so, E);
    }
    grid.sync();
    {
    PHASE_IDS();
    for (int t = gw; t < S; t += NGW) { rms_row512_inplace(p.cq + (size_t)t * 512, p.q_lat_g, lane); rms_row512_inplace(p.ckv + (size_t)t * 512, p.kv_lat_g, lane); }
    for (int w = gw; w < S * 16; w += NGW) fox_prep(w, p.fq, p.fk, p.fox_qg, p.fox_kg, lane);
    for (int hh = b; hh < 16; hh += G) fox_cumsum((double*)smem, hh, p.lf, p.F);
    }
    grid.sync();
    {
        pg8::Gemm g{p.cq, p.WqT, S, 3072, 512}; pg8::StaticOrder so; so.init(S, 3072, G, b);
        pg8::EpiStoreBf16 E{p.qa, 3072};
        pg8::gemm_phase<pg8::EpiStoreBf16, pg8::StaticOrder, true, true>(lds, g, so, E);
    }
    {
        pg8::Gemm g{p.ckv, p.WkvT, S, 4096, 512}; pg8::StaticOrder so; so.init(S, 4096, G, b);
        pg8::EpiStoreBf16 E{p.kvraw, 4096};
        pg8::gemm_phase<pg8::EpiStoreBf16, pg8::StaticOrder, true, true>(lds, g, so, E);
    }
    grid.sync();
    { PHASE_IDS(); for (int w = gw; w < S * 16; w += NGW) mla_prep(w, p.qa, p.kvraw, p.kpe, p.pos, p.mla_qg, p.mla_kg, p.ka, lane); }
    grid.sync();
    for (int L = b; L < 1024; L += G) {
        const int i = L >> 8, vc = L & 255, vcx = (vc & 7) * 32 + (vc >> 3), hh = vcx >> 4, x = vcx & 15, qbk = (i & 1) ? x : 31 - x;
        if (i < 2) att::attn_block<192, false>(smem, p.qa + hh * 192, 3072, p.ka + hh * 192, 3072, p.kvraw + hh * 256 + 128, 4096, nullptr, p.merged + hh * 128, qbk);
        else att::attn_block<128, true>(smem, p.fq + hh * 128, 2048, p.fk + hh * 128, 2048, p.fv + hh * 128, 2048, p.F + (size_t)hh * S, p.merged + 2048 + hh * 128, qbk);
    }
    grid.sync();
    {
        pg8::Gemm g{p.merged, p.WoT, S, 2048, 4096}; pg8::StaticOrder so; so.init(S, 2048, G, b);
        pg8::EpiStoreF32<true> E{p.x1, p.x, 2048};
        pg8::gemm_phase<pg8::EpiStoreF32<true>, pg8::StaticOrder, true, true>(lds, g, so, E);
    }
    grid.sync();
    { PHASE_IDS(); for (int m = gw; m < S; m += NGW) rms_row2048(p.x1 + (size_t)m * DM, p.ffn_g, p.h + (size_t)m * DM, lane);
      cvt_rows_bf16(p.peer_u, p.U16, (size_t)16384 * 2048, gw, NGW, lane); cvt_rows_bf16(p.peer_v, p.V16, (size_t)16384 * 2048, gw, NGW, lane); }
    grid.sync();
    {
        pg8::Gemm g{p.h, p.WpT, S, 2048, 2048}; pg8::StaticOrder so; so.init(S, 2048, G, b);
        pg8::EpiStoreF32<false> E{p.scores, nullptr, 2048};
        pg8::gemm_phase<pg8::EpiStoreF32<false>, pg8::StaticOrder, true, true>(lds, g, so, E);
    }
    grid.sync();
    for (int g = b; g < S / 32; g += G) peer_group(smem, g, p.scores, p.h, p.x1, p.U16, p.V16, p.out);
}

extern "C" void kernel_launch(void* const* d_in, const int* in_sizes, int n_in,
                              void* d_out, int out_size, void* d_ws, size_t ws_size,
                              hipStream_t stream) {
    if (ws_size < 512 * MiB) { fprintf(stderr, "kernel_launch: workspace too small (%zu)\n", ws_size); return; }
    Params p{};
    p.x = (const float*)d_in[0]; p.pos = (const int*)d_in[1]; p.mix_g = (const float*)d_in[2]; p.w_in = (const float*)d_in[3];
    p.b_forget = (const float*)d_in[4]; p.b_gate = (const float*)d_in[5]; p.q_lat_g = (const float*)d_in[6]; p.w_q_up = (const float*)d_in[7];
    p.kv_lat_g = (const float*)d_in[8]; p.w_kv_up = (const float*)d_in[9]; p.mla_qg = (const float*)d_in[10]; p.mla_kg = (const float*)d_in[11];
    p.fox_qg = (const float*)d_in[12]; p.fox_kg = (const float*)d_in[13]; p.w_out = (const float*)d_in[14]; p.ffn_g = (const float*)d_in[15];
    p.w_peer_q = (const float*)d_in[16]; p.sub_keys = (const float*)d_in[17]; p.peer_u = (const float*)d_in[18]; p.peer_v = (const float*)d_in[19];
    p.out = (float*)d_out;
    char* ws = (char*)d_ws;
    p.WqT = (bf16_t*)(ws + 1 * MiB); p.WkvT = (bf16_t*)(ws + 5 * MiB); p.WoT = (bf16_t*)(ws + 9 * MiB); p.WpT = (bf16_t*)(ws + 25 * MiB); p.WinT = (bf16_t*)(ws + 33 * MiB);
    p.h = (bf16_t*)(ws + 78 * MiB); p.cq = (bf16_t*)(ws + 110 * MiB); p.ckv = (bf16_t*)(ws + 118 * MiB);
    p.fq = (bf16_t*)(ws + 126 * MiB); p.fk = (bf16_t*)(ws + 158 * MiB); p.fv = (bf16_t*)(ws + 190 * MiB); p.merged = (bf16_t*)(ws + 222 * MiB);
    p.kpe = (bf16_t*)(ws + 286 * MiB); p.lf = (float*)(ws + 287 * MiB); p.F = (float*)(ws + 287 * MiB + 512 * 1024);
    p.qa = (bf16_t*)(ws + 288 * MiB); p.kvraw = (bf16_t*)(ws + 336 * MiB); p.ka = (bf16_t*)(ws + 400 * MiB); p.x1 = (float*)(ws + 448 * MiB);
    p.scores = (float*)(ws + 222 * MiB);
    p.U16 = (bf16_t*)(ws + 126 * MiB); p.V16 = (bf16_t*)(ws + 336 * MiB);

    static int grid_blocks = 0;
    if (!grid_blocks) {
        if (hipFuncSetAttribute((const void*)mega, hipFuncAttributeMaxDynamicSharedMemorySize, LDS_BYTES) != hipSuccess) { fprintf(stderr, "hipFuncSetAttribute failed\n"); return; }
        int dev = 0, cus = 0, per_cu = 0;
        (void)hipGetDevice(&dev);
        (void)hipDeviceGetAttribute(&cus, hipDeviceAttributeMultiprocessorCount, dev);
        (void)hipOccupancyMaxActiveBlocksPerMultiprocessor(&per_cu, (const void*)mega, 512, LDS_BYTES);
        if (per_cu < 1 || cus < 1) { fprintf(stderr, "occupancy query says %d blocks/CU on %d CUs\n", per_cu, cus); return; }
        grid_blocks = cus;
    }
    void* args[] = {&p};
    hipError_t e = hipLaunchCooperativeKernel((const void*)mega, dim3(grid_blocks), dim3(512), args, LDS_BYTES, stream);
    if (e != hipSuccess) fprintf(stderr, "cooperative launch failed: %s (grid %d)\n", hipGetErrorString(e), grid_blocks);
}
```

```cpp
#include <hip/hip_runtime.h>
#include <hip/hip_cooperative_groups.h>
#include <stdint.h>
#include <math.h>
#include <cstdio>
namespace cg = cooperative_groups;

namespace pg8 {
#define PG8_LAS __attribute__((address_space(3)))
typedef unsigned short bf16_t;
typedef short bf16x8 __attribute__((ext_vector_type(8)));
typedef float f32x4 __attribute__((ext_vector_type(4)));
typedef unsigned u32x4 __attribute__((ext_vector_type(4)));
constexpr int BM = 256, BK = 64, HALF = 128, HTB = HALF * BK * 2  , STAGE_BYTES = 8 * HTB, NXCD = 8, WGM = 8;

__host__ __device__ __forceinline__ int lds_byte(int r, int c) { const int st = (r >> 4) * 2 + (c >> 5), rr = r & 15, cc = c & 31, ob = rr * 64 + cc * 2; return st * 1024 + (ob ^ (((ob >> 9) & 1) << 5)); }
__host__ __device__ __forceinline__ void stage_rc(int b, int& R, int& C) { const int st = b / 1024, sb = b % 1024, swz = sb ^ (((sb >> 9) & 1) << 5); R = (st >> 1) * 16 + swz / 64; C = (st & 1) * 32 + (swz % 64) / 2; }
__host__ __device__ __forceinline__ int perm32(int rho) { const int n = rho >> 4, i = rho & 15; return 8 * (i >> 2) + 4 * n + (i & 3); }

struct Unit { int pm, pn; };
struct Gemm { const bf16_t* A; const bf16_t* Bt; int M, N, K; };

struct StaticOrder {
    int nM, nN, nwg, G, c;
    __host__ __device__ void init(int M, int N, int G_, int c_) { nM = M / BM; nN = N / BM; nwg = nM * nN; G = G_; c = c_; }
    __host__ __device__ bool next(int i, Unit& u) const {
        const long L = (long)i * G + c; if (L >= nwg) return false;
        int wgid = (int)L; { const int q = nwg / NXCD, r = nwg % NXCD, xcd = wgid % NXCD, off = wgid / NXCD; wgid = (xcd < r ? xcd * (q + 1) : r * (q + 1) + (xcd - r) * q) + off; }
        const int nig = WGM * nN, gid = wgid / nig, fm = gid * WGM, gsz = (nM - fm) < WGM ? (nM - fm) : WGM;
        u.pm = fm + ((wgid % nig) % gsz); u.pn = (wgid % nig) / gsz; return true;
    }
    __device__ __forceinline__ void a_ready(const Unit&) const {}
    __device__ __forceinline__ void done(const Unit&) const {}
};

__device__ __forceinline__ unsigned cvt_pk_bf16(float lo, float hi) { unsigned r; asm volatile("v_cvt_pk_bf16_f32 %0, %1, %2" : "=v"(r) : "v"(lo), "v"(hi)); return r; }
__device__ __forceinline__ u32x4 pack8bf(const f32x4& v0, const f32x4& v1) { u32x4 w; w.x = cvt_pk_bf16(v0[0], v0[1]); w.y = cvt_pk_bf16(v0[2], v0[3]); w.z = cvt_pk_bf16(v1[0], v1[1]); w.w = cvt_pk_bf16(v1[2], v1[3]); return w; }

struct EpiStoreBf16 {
    static constexpr bool PERM = true, AFTER_DRAIN = false;
    bf16_t* O; int ldc;
    __device__ __forceinline__ void operator()(const f32x4 (&acc)[2][2][4][2], const Unit& u, int wr, int wc, int fr, int fq) const {
        const int row0 = u.pm * BM + wr * 64 + fr, col0 = u.pn * BM + wc * 32 + 8 * fq;
#pragma unroll
        for (int ai = 0; ai < 2; ++ai)
#pragma unroll
            for (int m = 0; m < 4; ++m) { bf16_t* rowp = O + (size_t)(row0 + ai * HALF + m * 16) * ldc + col0;
#pragma unroll
                for (int bj = 0; bj < 2; ++bj) *(u32x4*)(rowp + bj * HALF) = pack8bf(acc[ai][bj][m][0], acc[ai][bj][m][1]); }
    }
};
template <bool RES> struct EpiStoreF32 {
    static constexpr bool PERM = true, AFTER_DRAIN = false;
    float* O; const float* res; int ldc;
    __device__ __forceinline__ void operator()(const f32x4 (&acc)[2][2][4][2], const Unit& u, int wr, int wc, int fr, int fq) const {
        const int row0 = u.pm * BM + wr * 64 + fr, col0 = u.pn * BM + wc * 32 + 8 * fq;
#pragma unroll
        for (int ai = 0; ai < 2; ++ai)
#pragma unroll
            for (int m = 0; m < 4; ++m) { const size_t off = (size_t)(row0 + ai * HALF + m * 16) * ldc + col0;
#pragma unroll
                for (int bj = 0; bj < 2; ++bj) { f32x4 v0 = acc[ai][bj][m][0], v1 = acc[ai][bj][m][1];
                    if (RES) { v0 += *(const f32x4*)(res + off + bj * HALF); v1 += *(const f32x4*)(res + off + bj * HALF + 4); }
                    *(f32x4*)(O + off + bj * HALF) = v0; *(f32x4*)(O + off + bj * HALF + 4) = v1; } }
    }
};
struct EpiInProj {
    static constexpr bool PERM = true, AFTER_DRAIN = false;
    bf16_t *cq, *ckv, *fq, *fk, *fv, *gates, *kpe; float* lf; const float *b_gate, *b_forget;
    __device__ __forceinline__ void operator()(const f32x4 (&acc)[2][2][4][2], const Unit& u, int wr, int wc, int fr, int fq_) const {
        const int pn = u.pn, row0 = u.pm * BM + wr * 64 + fr, cw = wc * 32 + 8 * fq_;
        if (pn < 28) {
            bf16_t* base; int ldc, colt;
            if (pn < 2) { base = cq; ldc = 512; colt = pn * 256; } else if (pn < 4) { base = ckv; ldc = 512; colt = (pn - 2) * 256; }
            else if (pn < 12) { base = fq; ldc = 2048; colt = (pn - 4) * 256; } else if (pn < 20) { base = fk; ldc = 2048; colt = (pn - 12) * 256; }
            else { base = fv; ldc = 2048; colt = (pn - 20) * 256; }
#pragma unroll
            for (int ai = 0; ai < 2; ++ai)
#pragma unroll
                for (int m = 0; m < 4; ++m) { bf16_t* rowp = base + (size_t)(row0 + ai * HALF + m * 16) * ldc + colt + cw;
#pragma unroll
                    for (int bj = 0; bj < 2; ++bj) *(u32x4*)(rowp + bj * HALF) = pack8bf(acc[ai][bj][m][0], acc[ai][bj][m][1]); }
        } else if (pn < 44) {
            const int colt = (pn - 28) * 256 + cw;
#pragma unroll
            for (int bj = 0; bj < 2; ++bj) {
                const f32x4 b0 = *(const f32x4*)(b_gate + colt + bj * HALF), b1 = *(const f32x4*)(b_gate + colt + bj * HALF + 4);
#pragma unroll
                for (int ai = 0; ai < 2; ++ai)
#pragma unroll
                    for (int m = 0; m < 4; ++m) {
                        f32x4 v0 = acc[ai][bj][m][0] + b0, v1 = acc[ai][bj][m][1] + b1;
#pragma unroll
                        for (int e = 0; e < 4; ++e) { v0[e] = 1.f / (1.f + __expf(-v0[e])); v1[e] = 1.f / (1.f + __expf(-v1[e])); }
                        *(u32x4*)(gates + (size_t)(row0 + ai * HALF + m * 16) * 4096 + colt + bj * HALF) = pack8bf(v0, v1); }
            }
        } else {
            if (cw < 64) {
#pragma unroll
                for (int ai = 0; ai < 2; ++ai)
#pragma unroll
                    for (int m = 0; m < 4; ++m) *(u32x4*)(kpe + (size_t)(row0 + ai * HALF + m * 16) * 64 + cw) = pack8bf(acc[ai][0][m][0], acc[ai][0][m][1]);
            } else if (cw < 80) {
                const int h0 = cw - 64;
                const f32x4 b0 = *(const f32x4*)(b_forget + h0), b1 = *(const f32x4*)(b_forget + h0 + 4);
#pragma unroll
                for (int ai = 0; ai < 2; ++ai)
#pragma unroll
                    for (int m = 0; m < 4; ++m) { const int row = row0 + ai * HALF + m * 16;
                        f32x4 z0 = acc[ai][0][m][0] + b0, z1 = acc[ai][0][m][1] + b1;
#pragma unroll
                        for (int e = 0; e < 4; ++e) { z0[e] = fminf(z0[e], 0.f) - __logf(1.f + __expf(-fabsf(z0[e]))); z1[e] = fminf(z1[e], 0.f) - __logf(1.f + __expf(-fabsf(z1[e]))); }
                        *(f32x4*)(lf + (size_t)row * 16 + h0) = z0; *(f32x4*)(lf + (size_t)row * 16 + h0 + 4) = z1; }
            }
        }
    }
};
template <class Epi, class Sched, bool ALIGN_EPI = false, bool SP2 = false>
__device__ __forceinline__ void gemm_phase(PG8_LAS unsigned char* lds, const Gemm g, const Sched& S, const Epi& E) {
    const int tid = threadIdx.x, wid = __builtin_amdgcn_readfirstlane(tid >> 6), lane = tid & 63, wr = wid >> 2, wc = wid & 3, fr = lane & 15, fq = lane >> 4;
    const int K = g.K, nt = K / BK;
    unsigned voffA[2], voffB[2];
#pragma unroll
    for (int i = 0; i < 2; ++i) { int R, C; stage_rc(tid * 16 + i * 8192, R, C); const int Rb = Epi::PERM ? ((R & ~31) + perm32(R & 31)) : R;
        voffA[i] = (unsigned)(R * K + C) * 2u; voffB[i] = (unsigned)(Rb * K + C) * 2u; }
    const size_t kstep = (size_t)(BK * 2);
    const size_t hstep = (size_t)HALF * K * 2;
    const size_t tstep = 2 * hstep;
    const unsigned ldsw = (unsigned)wid * 1024u;
    const int aoff = lds_byte(wr * 64 + fr, fq * 8), boff = lds_byte(wc * 32 + fr, fq * 8);
#define PG8_SA(b, h) (((b) * 2 + (h)) * HTB)
#define PG8_SB(b, h) ((4 + (b) * 2 + (h)) * HTB)
#define PG8_STAGE(bufoff, gbase, voff) do { _Pragma("unroll") for (int _i = 0; _i < 2; ++_i) \
        __builtin_amdgcn_global_load_lds((const unsigned*)((const char*)(gbase) + (voff)[_i]), (PG8_LAS unsigned*)(lds + (bufoff) + ldsw + _i * 8192), 16, 0, 0); } while (0)
#define PG8_LDA(dst, b, h) do { _Pragma("unroll") for (int m = 0; m < 4; ++m) _Pragma("unroll") for (int k = 0; k < 2; ++k) dst[m][k] = *(const PG8_LAS bf16x8*)(lds + PG8_SA(b, h) + aoff + m * 2048 + k * 1024); } while (0)
#define PG8_LDB(dst, b, h) do { _Pragma("unroll") for (int n = 0; n < 2; ++n) _Pragma("unroll") for (int k = 0; k < 2; ++k) dst[n][k] = *(const PG8_LAS bf16x8*)(lds + PG8_SB(b, h) + boff + n * 2048 + k * 1024); } while (0)
#define PG8_MMA(ai, bj, At, Bt) do { __builtin_amdgcn_s_setprio(1); _Pragma("unroll") for (int m = 0; m < 4; ++m) _Pragma("unroll") for (int n = 0; n < 2; ++n) _Pragma("unroll") for (int k = 0; k < 2; ++k) \
        acc[ai][bj][m][n] = __builtin_amdgcn_mfma_f32_16x16x32_bf16(Bt[n][k], At[m][k], acc[ai][bj][m][n], 0, 0, 0); __builtin_amdgcn_s_setprio(0); } while (0)
#define PG8_WAIT_V(n) asm volatile("s_waitcnt vmcnt(" #n ")" ::: "memory")
#define PG8_WAIT_L(n) asm volatile("s_waitcnt lgkmcnt(" #n ")" ::: "memory")
#define PG8_BAR __builtin_amdgcn_s_barrier()
#define PG8_SCHED __builtin_amdgcn_sched_barrier(0)
    Unit cur, nxt; int ui = 0;
    if (!S.next(0, cur)) return;
    f32x4 acc[2][2][4][2];
#pragma unroll
    for (int a = 0; a < 2; ++a)
#pragma unroll
        for (int b = 0; b < 2; ++b)
#pragma unroll
            for (int m = 0; m < 4; ++m)
#pragma unroll
                for (int n = 0; n < 2; ++n) acc[a][b][m][n] = (f32x4){0.f, 0.f, 0.f, 0.f};
    bf16x8 At[4][2], B0[2][2], B1[2][2];
    const char* cA = (const char*)g.A + (size_t)cur.pm * tstep; const char* cB = (const char*)g.Bt + (size_t)cur.pn * tstep;
    S.a_ready(cur);
    if constexpr (SP2) {
        PG8_STAGE(PG8_SB(0, 0), cB, voffB); PG8_STAGE(PG8_SB(0, 1), cB + hstep, voffB); PG8_STAGE(PG8_SA(0, 0), cA, voffA); PG8_STAGE(PG8_SA(0, 1), cA + hstep, voffA);
        if (wr == 1) PG8_BAR;
        PG8_WAIT_V(2); PG8_BAR;
        PG8_STAGE(PG8_SB(1, 0), cB + kstep, voffB); PG8_STAGE(PG8_SA(1, 0), cA + kstep, voffA); PG8_STAGE(PG8_SB(1, 1), cB + hstep + kstep, voffB);
        PG8_WAIT_V(6); PG8_BAR;
    } else {
        PG8_STAGE(PG8_SB(0, 0), cB, voffB); PG8_STAGE(PG8_SA(0, 0), cA, voffA); PG8_STAGE(PG8_SB(0, 1), cB + hstep, voffB); PG8_STAGE(PG8_SA(0, 1), cA + hstep, voffA);
        if (wr == 1) PG8_BAR;
        PG8_WAIT_V(4); PG8_BAR;
        PG8_STAGE(PG8_SB(1, 0), cB + kstep, voffB); PG8_STAGE(PG8_SA(1, 0), cA + kstep, voffA); PG8_STAGE(PG8_SB(1, 1), cB + hstep + kstep, voffB);
        PG8_WAIT_V(6); PG8_BAR;
    }
    for (;;) {
        const bool has_next = S.next(ui + 1, nxt);
        const char* nA = has_next ? (const char*)g.A + (size_t)nxt.pm * tstep : cA; const char* nB = has_next ? (const char*)g.Bt + (size_t)nxt.pn * tstep : cB;
        for (int t = 0; t < nt; t += 2) {
            const bool last = (t == nt - 2);
            const char* a1 = cA + (size_t)(t + 1) * kstep;
            const char* a2 = last ? nA : cA + (size_t)(t + 2) * kstep; const char* b2 = last ? nB : cB + (size_t)(t + 2) * kstep;
            const char* a3 = a2 + kstep; const char* b3 = b2 + kstep;
            if (last && has_next) S.a_ready(nxt);
            if constexpr (SP2) {
            PG8_LDB(B0, 0, 0); PG8_LDB(B1, 0, 1); PG8_SCHED; PG8_LDA(At, 0, 0); PG8_STAGE(PG8_SA(1, 1), a1 + hstep, voffA);
            PG8_WAIT_V(8); PG8_WAIT_L(0); PG8_BAR; PG8_MMA(0, 0, At, B0); PG8_MMA(0, 1, At, B1); PG8_BAR; PG8_SCHED;
            PG8_LDA(At, 0, 1); PG8_STAGE(PG8_SB(0, 0), b2, voffB); PG8_STAGE(PG8_SB(0, 1), b2 + hstep, voffB); PG8_STAGE(PG8_SA(0, 0), a2, voffA);
            PG8_WAIT_V(8); PG8_WAIT_L(0); PG8_BAR; PG8_MMA(1, 0, At, B0); PG8_MMA(1, 1, At, B1); PG8_BAR; PG8_SCHED;
            PG8_LDB(B0, 1, 0); PG8_LDB(B1, 1, 1); PG8_SCHED; PG8_LDA(At, 1, 0); PG8_STAGE(PG8_SA(0, 1), a2 + hstep, voffA);
            PG8_WAIT_V(8); PG8_WAIT_L(0); PG8_BAR; PG8_MMA(0, 0, At, B0); PG8_MMA(0, 1, At, B1); PG8_BAR; PG8_SCHED;
            PG8_LDA(At, 1, 1); PG8_STAGE(PG8_SB(1, 0), b3, voffB); PG8_STAGE(PG8_SB(1, 1), b3 + hstep, voffB); PG8_STAGE(PG8_SA(1, 0), a3, voffA);
            PG8_WAIT_V(8); PG8_WAIT_L(0); PG8_BAR; PG8_MMA(1, 0, At, B0); PG8_MMA(1, 1, At, B1); PG8_BAR; PG8_SCHED;
            } else {
            PG8_LDB(B0, 0, 0); PG8_SCHED; PG8_LDA(At, 0, 0); PG8_STAGE(PG8_SA(1, 1), a1 + hstep, voffA);
            PG8_WAIT_L(8); PG8_BAR; PG8_WAIT_L(0); PG8_MMA(0, 0, At, B0); PG8_BAR; PG8_SCHED;
            PG8_LDB(B1, 0, 1); PG8_STAGE(PG8_SB(0, 0), b2, voffB);
            PG8_BAR; PG8_WAIT_L(0); PG8_MMA(0, 1, At, B1); PG8_BAR;
            PG8_LDA(At, 0, 1); PG8_STAGE(PG8_SA(0, 0), a2, voffA);
            PG8_BAR; PG8_WAIT_L(0); PG8_MMA(1, 0, At, B0); PG8_BAR; PG8_SCHED;
            PG8_STAGE(PG8_SB(0, 1), b2 + hstep, voffB);
            PG8_WAIT_V(6); PG8_BAR; PG8_MMA(1, 1, At, B1); PG8_BAR;
            PG8_LDB(B0, 1, 0); PG8_SCHED; PG8_LDA(At, 1, 0); PG8_STAGE(PG8_SA(0, 1), a2 + hstep, voffA);
            PG8_WAIT_L(8); PG8_BAR; PG8_WAIT_L(0); PG8_MMA(0, 0, At, B0); PG8_BAR; PG8_SCHED;
            PG8_LDB(B1, 1, 1); PG8_STAGE(PG8_SB(1, 0), b3, voffB);
            PG8_BAR; PG8_WAIT_L(0); PG8_MMA(0, 1, At, B1); PG8_BAR;
            PG8_LDA(At, 1, 1); PG8_STAGE(PG8_SA(1, 0), a3, voffA);
            PG8_BAR; PG8_WAIT_L(0); PG8_MMA(1, 0, At, B0); PG8_BAR; PG8_SCHED;
            PG8_STAGE(PG8_SB(1, 1), b3 + hstep, voffB);
            PG8_WAIT_V(6); PG8_BAR; PG8_MMA(1, 1, At, B1); PG8_BAR;
            }
        }
        if constexpr (ALIGN_EPI) { if (wr == 0) PG8_BAR; }
        if constexpr (!Epi::AFTER_DRAIN) { E(acc, cur, wr, wc, fr, fq); S.done(cur); }
        if (!has_next) break;
#pragma unroll
        for (int a = 0; a < 2; ++a)
#pragma unroll
            for (int b = 0; b < 2; ++b)
#pragma unroll
                for (int m = 0; m < 4; ++m)
#pragma unroll
                    for (int n = 0; n < 2; ++n) acc[a][b][m][n] = (f32x4){0.f, 0.f, 0.f, 0.f};
        cur = nxt; cA = nA; cB = nB; ++ui;
        if constexpr (ALIGN_EPI) { if (wr == 1) PG8_BAR; }
    }
    PG8_WAIT_V(0);
    if constexpr (!ALIGN_EPI) { if (wr == 0) PG8_BAR; }
    PG8_BAR;
    if constexpr (Epi::AFTER_DRAIN) { E.fused(acc, cur, wr, wc, fr, fq, lds, wid, lane); S.done(cur); }
#undef PG8_SA
#undef PG8_SB
#undef PG8_STAGE
#undef PG8_LDA
#undef PG8_LDB
#undef PG8_MMA
#undef PG8_WAIT_V
#undef PG8_WAIT_L
#undef PG8_BAR
#undef PG8_SCHED
}
}
namespace att {
typedef unsigned short bf16_t;
typedef short bf16x8 __attribute__((ext_vector_type(8)));
typedef short s16x4 __attribute__((ext_vector_type(4)));
typedef float f32x16 __attribute__((ext_vector_type(16)));
typedef float f32x4 __attribute__((ext_vector_type(4)));
typedef unsigned u32x4 __attribute__((ext_vector_type(4)));
#define ALAS __attribute__((address_space(3)))
#define ASBAR() __builtin_amdgcn_sched_barrier(0)
constexpr int SHM_V = 16384;
template <int DK> struct Lay { static constexpr int ROWB = DK * 2, SHM_K = 64 * ROWB, OFF_K = 2 * SHM_V, OFF_F = OFF_K + 2 * SHM_K, OFF_WS = OFF_F + 512, TOTAL = OFF_WS + 8 * 256; };

__device__ __forceinline__ int v_st(int k, int c) { const int kk = (k & ~0xC) | ((k & 4) << 1) | ((k & 8) >> 1); return ((kk >> 3) * 4 + (c >> 5)) * 512 + ((kk & 7) * 32 + (c & 31)) * 2; }
__device__ __forceinline__ int v_rd_base(int lane) { return ((lane & 3) << 3) | (((lane >> 2) & 3) << 6) | (((lane >> 4) & 1) << 5) | (((lane >> 5) & 1) << 8); }
__device__ __forceinline__ int crow(int r, int hi) { return (r & 3) + 8 * (r >> 2) + 4 * hi; }
__device__ __forceinline__ unsigned cvtpk(float lo, float hi) { unsigned r; asm volatile("v_cvt_pk_bf16_f32 %0, %1, %2" : "=v"(r) : "v"(lo), "v"(hi)); return r; }

template <int DK, bool FOX>
__device__ __forceinline__ void attn_block(unsigned char* smem, const bf16_t* __restrict__ Q, int ldq, const bf16_t* __restrict__ K, int ldk, const bf16_t* __restrict__ V, int ldv,
                                           const float* __restrict__ Fh, const bf16_t* __restrict__ gate, bf16_t* __restrict__ gout  , int qbk) {
    typedef Lay<DK> LY;
    constexpr int ND = DK / 16, NKC = DK / 8, NKI = (64 * NKC) / 512;
    int tid = threadIdx.x; asm volatile("" : "+v"(tid));
    const int wid = __builtin_amdgcn_readfirstlane(tid >> 6), lane = tid & 63, r32 = lane & 31, hi = lane >> 5;
    const int q0 = qbk * 256, qlo = q0 + wid * 32, qm = qlo + r32 - 4 * hi;
    const int NT = 4 * qbk + 4;
    ALAS unsigned char* lds = (ALAS unsigned char*)smem;
    ALAS float* F_lds = (ALAS float*)(lds + LY::OFF_F);
    ALAS float* wsl = (ALAS float*)(lds + LY::OFF_WS) + wid * 64;
    bf16x8 qr[ND];
#pragma unroll
    for (int d0 = 0; d0 < ND; ++d0) qr[d0] = *(const bf16x8*)(Q + (size_t)(qlo + r32) * ldq + d0 * 16 + hi * 8);
    const float fq = FOX ? Fh[qlo + r32] : 0.f;
    int kgo[NKI], klo[NKI];
#pragma unroll
    for (int i = 0; i < NKI; ++i) { const int idx = tid + 512 * i, row = idx / NKC, ch = idx % NKC; kgo[i] = row * ldk + ch * 8; klo[i] = row * LY::ROWB + ((ch ^ ((row >> 1) & 7)) << 4); }
    const int sr = tid >> 4, sc = (tid & 15) * 8, vst0 = v_st(sr, sc), vst1 = v_st(32 + sr, sc);
    const int vgo0 = sr * ldv + sc, vgo1 = (32 + sr) * ldv + sc;
    const int vb0 = (int)(uintptr_t)smem + v_rd_base(lane);
    int kbase[4];
#pragma unroll
    for (int dd = 0; dd < 4; ++dd) kbase[dd] = LY::OFF_K + r32 * LY::ROWB + (((((dd << 1) | hi) ^ ((r32 >> 1) & 7))) << 4);
    bf16x8 stk[NKI], stv0, stv1; float stf = 0.f;
#define ATT_LOAD(kb) do { _Pragma("unroll") for (int i = 0; i < NKI; ++i) stk[i] = *(const bf16x8*)(K + (size_t)(kb) * ldk + kgo[i]); \
        stv0 = *(const bf16x8*)(V + (size_t)(kb) * ldv + vgo0); stv1 = *(const bf16x8*)(V + (size_t)(kb) * ldv + vgo1); if (FOX && tid < 64) stf = Fh[(kb) + tid]; } while (0)
#define ATT_WRITE(bf) do { _Pragma("unroll") for (int i = 0; i < NKI; ++i) *(ALAS bf16x8*)(lds + LY::OFF_K + (bf) * LY::SHM_K + klo[i]) = stk[i]; \
        *(ALAS bf16x8*)(lds + (bf) * SHM_V + vst0) = stv0; *(ALAS bf16x8*)(lds + (bf) * SHM_V + vst1) = stv1; if (FOX && tid < 64) F_lds[(bf) * 64 + tid] = stf; } while (0)
    ATT_LOAD(0); ATT_WRITE(0);
    float m_reg = -1e30f, l_reg = 0.f; f32x16 o[4];
#pragma unroll
    for (int d = 0; d < 4; ++d)
#pragma unroll
        for (int r = 0; r < 16; ++r) o[d][r] = 0.f;
    for (int t = 0; t < NT; ++t) {
        const int buf = t & 1, kb = t * 64;
        __syncthreads();
        if (t + 1 < NT) ATT_LOAD(kb + 64);
        f32x16 p0, p1;
        if (FOX) {
#pragma unroll
            for (int g = 0; g < 4; ++g) { const f32x4 f0 = *(const ALAS f32x4*)(F_lds + buf * 64 + 8 * g + 4 * hi), f1 = *(const ALAS f32x4*)(F_lds + buf * 64 + 32 + 8 * g + 4 * hi);
#pragma unroll
                for (int e = 0; e < 4; ++e) { p0[4 * g + e] = fq - f0[e]; p1[4 * g + e] = fq - f1[e]; } }
        } else {
#pragma unroll
            for (int r = 0; r < 16; ++r) { p0[r] = 0.f; p1[r] = 0.f; }
        }
#pragma unroll
        for (int d0 = 0; d0 < ND; ++d0) {
            ALAS const unsigned char* a = lds + buf * LY::SHM_K + kbase[d0 & 3] + (d0 >> 2) * 128;
            const bf16x8 b0 = *(const ALAS bf16x8*)a;
            const bf16x8 b1 = *(const ALAS bf16x8*)(a + 32 * LY::ROWB);
            p0 = __builtin_amdgcn_mfma_f32_32x32x16_bf16(b0, qr[d0], p0, 0, 0, 0);
            p1 = __builtin_amdgcn_mfma_f32_32x32x16_bf16(b1, qr[d0], p1, 0, 0, 0);
        }
        if (kb + 63 > qlo) {
            const float NEG = -__builtin_inff(); const int dq = qm - kb;
#pragma unroll
            for (int r = 0; r < 16; ++r) { const int c = (r & 3) + 8 * (r >> 2); if (dq - c < 0) p0[r] = NEG; if (dq - c - 32 < 0) p1[r] = NEG; }
        }
        float pmax = p0[0];
#pragma unroll
        for (int r = 1; r < 16; ++r) pmax = fmaxf(pmax, p0[r]);
#pragma unroll
        for (int r = 0; r < 16; ++r) pmax = fmaxf(pmax, p1[r]);
        { auto rr = __builtin_amdgcn_permlane32_swap(__float_as_uint(pmax), __float_as_uint(pmax), false, false);
          pmax = fmaxf(__uint_as_float(rr[0]), __uint_as_float(rr[1])); }
        const float mn = fmaxf(m_reg, pmax);
        const float alpha = __builtin_amdgcn_exp2f(m_reg - mn);
        m_reg = mn;
        float ps = 0.f;
#pragma unroll
        for (int r = 0; r < 16; ++r) { p0[r] = __builtin_amdgcn_exp2f(p0[r] - mn); ps += p0[r]; }
#pragma unroll
        for (int r = 0; r < 16; ++r) { p1[r] = __builtin_amdgcn_exp2f(p1[r] - mn); ps += p1[r]; }
        { auto rr = __builtin_amdgcn_permlane32_swap(__float_as_uint(ps), __float_as_uint(ps), false, false);
          ps = __uint_as_float(rr[0]) + __uint_as_float(rr[1]); }
        l_reg = l_reg * alpha + ps;
        bf16x8 pa0, pa1, pa2, pa3;
#define ATT_PK4(P, B_, OUT) do { unsigned a0 = cvtpk(P[B_+0], P[B_+1]), a1 = cvtpk(P[B_+2], P[B_+3]); unsigned b0_ = cvtpk(P[B_+4], P[B_+5]), b1_ = cvtpk(P[B_+6], P[B_+7]); \
        auto r0 = __builtin_amdgcn_permlane32_swap(a0, b0_, false, false); auto r1 = __builtin_amdgcn_permlane32_swap(a1, b1_, false, false); \
        u32x4 w = {r0[0], r1[0], r0[1], r1[1]}; OUT = *reinterpret_cast<bf16x8*>(&w); } while (0)
        ATT_PK4(p0, 0, pa0); ATT_PK4(p0, 8, pa1); ATT_PK4(p1, 0, pa2); ATT_PK4(p1, 8, pa3);
        if (__any(alpha < 1.f)) {
            if (hi == 0) wsl[r32] = alpha;
            asm volatile("s_waitcnt lgkmcnt(0)" ::: "memory");
#pragma unroll
            for (int g = 0; g < 4; ++g) { const f32x4 al = *(const ALAS f32x4*)(wsl + 8 * g + 4 * hi);
#pragma unroll
                for (int d = 0; d < 4; ++d)
#pragma unroll
                    for (int e = 0; e < 4; ++e) o[d][4 * g + e] *= al[e]; }
        }
#define ATT_TRRD(dst, off) asm volatile("ds_read_b64_tr_b16 %0, %1 offset:%2" : "=&v"(dst) : "v"(vbb), "i"(off) : "memory")
#define ATT_PV(d0) do { s16x4 l0, l1, l2, l3, h0, h1, h2, h3; constexpr int b_ = (d0) * 512; \
        ATT_TRRD(l0, b_); ATT_TRRD(h0, b_ + 2048); ATT_TRRD(l1, b_ + 4096); ATT_TRRD(h1, b_ + 6144); ATT_TRRD(l2, b_ + 8192); ATT_TRRD(h2, b_ + 10240); ATT_TRRD(l3, b_ + 12288); ATT_TRRD(h3, b_ + 14336); \
        asm volatile("s_waitcnt lgkmcnt(0)" ::: "memory"); ASBAR(); \
        o[d0] = __builtin_amdgcn_mfma_f32_32x32x16_bf16(pa0, (bf16x8){l0[0], l0[1], l0[2], l0[3], h0[0], h0[1], h0[2], h0[3]}, o[d0], 0, 0, 0); \
        o[d0] = __builtin_amdgcn_mfma_f32_32x32x16_bf16(pa1, (bf16x8){l1[0], l1[1], l1[2], l1[3], h1[0], h1[1], h1[2], h1[3]}, o[d0], 0, 0, 0); \
        o[d0] = __builtin_amdgcn_mfma_f32_32x32x16_bf16(pa2, (bf16x8){l2[0], l2[1], l2[2], l2[3], h2[0], h2[1], h2[2], h2[3]}, o[d0], 0, 0, 0); \
        o[d0] = __builtin_amdgcn_mfma_f32_32x32x16_bf16(pa3, (bf16x8){l3[0], l3[1], l3[2], l3[3], h3[0], h3[1], h3[2], h3[3]}, o[d0], 0, 0, 0); } while (0)
        { const int vbb = vb0 + buf * SHM_V; ATT_PV(0); ATT_PV(1); ATT_PV(2); ATT_PV(3); }
        if (t + 1 < NT) ATT_WRITE(buf ^ 1);
    }
    if (hi == 0) wsl[r32] = l_reg;
    asm volatile("s_waitcnt lgkmcnt(0)" ::: "memory");
#pragma unroll
    for (int r = 0; r < 16; ++r) {
        const int orow = crow(r, hi); const float rli = __builtin_amdgcn_rcpf(wsl[orow]);
        bf16_t* rowp = gout + (size_t)(qlo + orow) * 4096; const bf16_t* growp = gate + (size_t)(qlo + orow) * 4096;
#pragma unroll
        for (int d0 = 0; d0 < 4; ++d0) {
            const float v = o[d0][r] * rli; const float vn = __shfl_xor(v, 1);
            if ((r32 & 1) == 0) { unsigned* gp = (unsigned*)(rowp + d0 * 32 + r32); const unsigned g = *(const unsigned*)(growp + d0 * 32 + r32);
                *gp = cvtpk(v * __uint_as_float(g << 16), vn * __uint_as_float(g & 0xffff0000u)); }
        }
    }
    __syncthreads();
#undef ATT_LOAD
#undef ATT_WRITE
#undef ATT_PK4
#undef ATT_TRRD
#undef ATT_PV
}
}
using pg8::bf16_t; using pg8::f32x4; using pg8::u32x4;
#define LAS __attribute__((address_space(3)))
constexpr int S = 8192, DM = 2048, INW = 11344, INWP = 11520;
constexpr float EPS = 1e-6f;
constexpr size_t MiB = 1u << 20;

__device__ __forceinline__ float bf2f(bf16_t v) { return __uint_as_float(((unsigned)v) << 16); }
__device__ __forceinline__ bf16_t f2bf(float f) { unsigned u = __float_as_uint(f); u += 0x7fffu + ((u >> 16) & 1u); return (bf16_t)(u >> 16); }
__device__ __forceinline__ unsigned pk2(float lo, float hi) { return (unsigned)f2bf(lo) | ((unsigned)f2bf(hi) << 16); }
__device__ __forceinline__ float wave_sum(float v) {
#pragma unroll
    for (int o = 32; o >= 1; o >>= 1) v += __shfl_xor(v, o);
    return v;
}
__device__ __forceinline__ float wave_max(float v) {
#pragma unroll
    for (int o = 32; o >= 1; o >>= 1) v = fmaxf(v, __shfl_xor(v, o));
    return v;
}

__device__ __forceinline__ int opaque_tid() { int t = threadIdx.x; asm volatile("" : "+v"(t)); return t; }

struct Params {
    const float* x; const int* pos; const float *mix_g, *w_in, *b_forget, *b_gate, *q_lat_g, *w_q_up, *kv_lat_g, *w_kv_up, *mla_qg, *mla_kg, *fox_qg, *fox_kg, *w_out, *ffn_g, *w_peer_q, *sub_keys, *peer_u, *peer_v;
    float* out;
    bf16_t *WqT, *WkvT, *WoT, *WpT, *WinT;
    bf16_t *h, *cq, *ckv, *fq, *fk, *fv, *merged, *kpe, *qa, *kvraw, *ka;
    float *lf, *F, *x1, *scores;
    bf16_t *U16, *V16, *attout;
    unsigned* ctl;
};

struct DstId { __device__ __forceinline__ int operator()(int n) const { return n; } };
struct DstWin { __device__ __forceinline__ int operator()(int n) const {
    if (n < 1024) return n; if (n < 1088) return 11264 + (n - 1024); if (n < 7232) return n - 64; if (n < 7248) return 11264 + 64 + (n - 7232); return n - 80; } };
template <class Dst>
__device__ __forceinline__ void transpose_item(const float* __restrict__ W, int K, int N, bf16_t* __restrict__ WT, Dst dst, float* scr, int item, int lane) {
    const int nblk = (N + 31) / 32, kb = item / nblk, nb = item % nblk, k0 = 64 * kb, n0 = 32 * nb;
    { const int n = n0 + (lane & 31);
#pragma unroll 8
      for (int i = 0; i < 32; ++i) { const int kk = 2 * i + (lane >> 5); scr[kk * 33 + (lane & 31)] = (n < N) ? W[(size_t)(k0 + kk) * N + n] : 0.f; } }
    asm volatile("s_waitcnt lgkmcnt(0)" ::: "memory");
    const int c = lane & 7;
#pragma unroll
    for (int j = 0; j < 4; ++j) { const int nl = (lane >> 3) + 8 * j, n = n0 + nl; const float* s = scr + (8 * c) * 33 + nl;
        u32x4 o; o.x = pk2(s[0 * 33], s[1 * 33]); o.y = pk2(s[2 * 33], s[3 * 33]); o.z = pk2(s[4 * 33], s[5 * 33]); o.w = pk2(s[6 * 33], s[7 * 33]);
        if (n < N) *(u32x4*)(WT + (size_t)dst(n) * K + k0 + 8 * c) = o; }
    asm volatile("s_waitcnt lgkmcnt(0)" ::: "memory");
}
__device__ __forceinline__ void wfold_item(const float* __restrict__ wq, const float* __restrict__ keys, bf16_t* __restrict__ WpT, float* sm, int item) {
    const int tid = opaque_tid(), hc = item >> 5, d0 = (item & 31) * 64;
    float* keysL = sm; float* wqL = sm + 128 * 129;
    for (int idx = tid; idx < 128 * 128; idx += 512) keysL[(idx >> 7) * 129 + (idx & 127)] = keys[(size_t)hc * 16384 + idx];
    for (int idx = tid; idx < 64 * 128; idx += 512) wqL[(idx >> 7) * 129 + (idx & 127)] = wq[(size_t)(d0 + (idx >> 7)) * 2048 + hc * 128 + (idx & 127)];
    __syncthreads();
    const int n = tid & 127, dq = tid >> 7;
    float acc[16];
#pragma unroll
    for (int i = 0; i < 16; ++i) acc[i] = 0.f;
    for (int j = 0; j < 128; ++j) { const float kv = keysL[n * 129 + j];
#pragma unroll
        for (int i = 0; i < 16; ++i) acc[i] += kv * wqL[(dq * 16 + i) * 129 + j]; }
    u32x4 o0, o1;
    o0.x = pk2(acc[0], acc[1]); o0.y = pk2(acc[2], acc[3]); o0.z = pk2(acc[4], acc[5]); o0.w = pk2(acc[6], acc[7]);
    o1.x = pk2(acc[8], acc[9]); o1.y = pk2(acc[10], acc[11]); o1.z = pk2(acc[12], acc[13]); o1.w = pk2(acc[14], acc[15]);
    bf16_t* dstp = WpT + (size_t)(hc * 128 + n) * 2048 + d0 + dq * 16;
    *(u32x4*)dstp = o0; *(u32x4*)(dstp + 8) = o1;
    __syncthreads();
}
__device__ __forceinline__ void rms_row2048(const float* __restrict__ xr, const float* __restrict__ g, bf16_t* __restrict__ orow, int lane) {
    f32x4 v[8]; float ss = 0.f;
#pragma unroll
    for (int j = 0; j < 8; ++j) { v[j] = *(const f32x4*)(xr + j * 256 + lane * 4); ss += (v[j][0] * v[j][0] + v[j][1] * v[j][1]) + (v[j][2] * v[j][2] + v[j][3] * v[j][3]); }
    const float r = rsqrtf(wave_sum(ss) * (1.f / 2048.f) + EPS);
#pragma unroll
    for (int j = 0; j < 8; ++j) { const f32x4 gg = *(const f32x4*)(g + j * 256 + lane * 4);
        uint2 o; o.x = pk2(v[j][0] * r * gg[0], v[j][1] * r * gg[1]); o.y = pk2(v[j][2] * r * gg[2], v[j][3] * r * gg[3]);
        *(uint2*)(orow + j * 256 + lane * 4) = o; }
}
__device__ __forceinline__ void rms_row512_inplace(bf16_t* __restrict__ row, const float* __restrict__ g, int lane) {
    u32x4 w = *(const u32x4*)(row + lane * 8); float v[8];
#pragma unroll
    for (int i = 0; i < 4; ++i) { v[2 * i] = __uint_as_float(w[i] << 16); v[2 * i + 1] = __uint_as_float(w[i] & 0xffff0000u); }
    float ss = 0.f;
#pragma unroll
    for (int i = 0; i < 8; ++i) ss += v[i] * v[i];
    const float r = rsqrtf(wave_sum(ss) * (1.f / 512.f) + EPS);
    u32x4 o;
#pragma unroll
    for (int i = 0; i < 4; ++i) o[i] = pk2(v[2 * i] * r * g[lane * 8 + 2 * i], v[2 * i + 1] * r * g[lane * 8 + 2 * i + 1]);
    *(u32x4*)(row + lane * 8) = o;
}
__device__ __forceinline__ void fox_prep(int w, bf16_t* __restrict__ fq, bf16_t* __restrict__ fk, const float* __restrict__ gq, const float* __restrict__ gk, int lane) {
    const int t = w >> 4, h = w & 15;
#pragma unroll
    for (int which = 0; which < 2; ++which) {
        bf16_t* p = (which ? fk : fq) + (size_t)t * 2048 + h * 128; const float* g = which ? gk : gq;
        const float v0 = bf2f(p[lane]), v1 = bf2f(p[lane + 64]);
        const float r = rsqrtf(wave_sum(v0 * v0 + v1 * v1) * (1.f / 128.f) + EPS);
        const float qs = which ? 1.f : 0.12751743f;
        p[lane] = f2bf(v0 * r * g[lane] * qs); p[lane + 64] = f2bf(v1 * r * g[lane + 64] * qs);
    }
}
__device__ __forceinline__ void fox_cumsum(double* part, int h, const float* __restrict__ lf, float* __restrict__ F) {
    const int tid = opaque_tid(); double sum = 0.0;
    for (int i = 0; i < 16; ++i) sum += (double)lf[(size_t)(tid * 16 + i) * 16 + h];
    part[tid] = sum;
    __syncthreads();
    if (tid == 0) { double run = 0.0; for (int i = 0; i < 512; ++i) { const double v = part[i]; part[i] = run; run += v; } }
    __syncthreads();
    double run = part[tid];
    for (int i = 0; i < 16; ++i) { run += (double)lf[(size_t)(tid * 16 + i) * 16 + h]; F[(size_t)h * S + tid * 16 + i] = (float)(run * 1.4426950408889634); }
    __syncthreads();
}
__device__ __forceinline__ void rope_cs(int pos, int i, float& c, float& s) {
    const double inv = exp(-(double)i * (1.0 / 32.0) * 9.210340371976184);
    double ang = (double)((float)pos * (float)inv);
    const double twopi = 6.283185307179586;
    ang -= twopi * rint(ang / twopi);
    c = cosf((float)ang); s = sinf((float)ang);
}
__device__ __forceinline__ void mla_prep(int w, bf16_t* __restrict__ qa, const bf16_t* __restrict__ kvraw, const bf16_t* __restrict__ kpe, const int* __restrict__ pos,
                                         const float* __restrict__ gq, const float* __restrict__ gk, bf16_t* __restrict__ ka, int lane) {
    const int t = w >> 4, h = w & 15;
    float c, s; rope_cs(pos[t], lane & 31, c, s);
    {
        bf16_t* q = qa + (size_t)t * 3072 + h * 192;
        float v0 = bf2f(q[lane]), v1 = bf2f(q[lane + 64]), v2 = bf2f(q[lane + 128]);
        const float r = rsqrtf(wave_sum(v0 * v0 + v1 * v1 + v2 * v2) * (1.f / 192.f) + EPS);
        v0 *= r * gq[lane]; v1 *= r * gq[lane + 64]; v2 *= r * gq[lane + 128];
        const float o = __shfl_xor(v2, 32);
        const float rr = lane < 32 ? v2 * c - o * s : o * s + v2 * c;
        q[lane] = f2bf(v0 * 0.10411754f); q[lane + 64] = f2bf(v1 * 0.10411754f); q[lane + 128] = f2bf(rr * 0.10411754f);
    }
    {
        const bf16_t* kn = kvraw + (size_t)t * 4096 + h * 256;
        float v0 = bf2f(kn[lane]), v1 = bf2f(kn[lane + 64]), v2 = bf2f(kpe[(size_t)t * 64 + lane]);
        const float r = rsqrtf(wave_sum(v0 * v0 + v1 * v1 + v2 * v2) * (1.f / 192.f) + EPS);
        v0 *= r * gk[lane]; v1 *= r * gk[lane + 64]; v2 *= r * gk[lane + 128];
        const float o = __shfl_xor(v2, 32);
        const float rr = lane < 32 ? v2 * c - o * s : o * s + v2 * c;
        bf16_t* k = ka + (size_t)t * 3072 + h * 192;
        k[lane] = f2bf(v0); k[lane + 64] = f2bf(v1); k[lane + 128] = f2bf(rr);
    }
}

__device__ __forceinline__ void cvt_rows_bf16(const float* __restrict__ src, bf16_t* __restrict__ dst, size_t n, int gw, int NGW, int lane) {
    const size_t nchunk = n / 512;
    for (size_t c = gw; c < nchunk; c += NGW) { const size_t o = c * 512 + lane * 8;
        const f32x4 a = *(const f32x4*)(src + o), b2 = *(const f32x4*)(src + o + 4);
        u32x4 w; w.x = pk2(a[0], a[1]); w.y = pk2(a[2], a[3]); w.z = pk2(b2[0], b2[1]); w.w = pk2(b2[2], b2[3]);
        *(u32x4*)(dst + o) = w; }
}
typedef __bf16 bf16x2_t __attribute__((ext_vector_type(2)));
__device__ __forceinline__ float dot2bf(unsigned a, unsigned b, float c) { return __builtin_amdgcn_fdot2_f32_bf16(__builtin_bit_cast(bf16x2_t, a), __builtin_bit_cast(bf16x2_t, b), c, false); }
#define PEER_INS(top, x) do { float x_ = (x); _Pragma("unroll") for (int i_ = 0; i_ < 16; ++i_) { const float hi_ = fmaxf(top[i_], x_); x_ = fminf(top[i_], x_); top[i_] = hi_; } } while (0)
__device__ __forceinline__ void peer_group(unsigned char* smem, int g, const float* __restrict__ scores, const bf16_t* __restrict__ h2, const float* __restrict__ x1,
                                           const bf16_t* __restrict__ U16, const bf16_t* __restrict__ V16, float* __restrict__ out) {
    const int tid = opaque_tid(), lane = tid & 63, wave = __builtin_amdgcn_readfirstlane(tid >> 6);
    float* topL = (float*)smem;
    int* selE = (int*)(smem + 32768);
    float* selG = (float*)(smem + 49152);
    {
        const int tl = tid >> 4, hc = tid & 15;
        const float* sp = scores + (size_t)(g * 32 + tl) * 2048 + hc * 128;
        float top[16];
#pragma unroll
        for (int i = 0; i < 16; ++i) top[i] = -INFINITY;
#pragma unroll 2
        for (int n0 = 0; n0 < 128; n0 += 4) { const f32x4 v = *(const f32x4*)(sp + n0);
#pragma unroll
            for (int e = 0; e < 4; ++e) PEER_INS(top, __uint_as_float((__float_as_uint(v[e]) & ~0x7Fu) | (unsigned)(n0 + e))); }
        float* tp = topL + (tl * 16 + hc) * 16;
#pragma unroll
        for (int i = 0; i < 16; i += 4) *(f32x4*)(tp + i) = (f32x4){top[i], top[i + 1], top[i + 2], top[i + 3]};
    }
    __syncthreads();
    if (tid < 256) {
        const int tl = tid >> 3, h = tid & 7;
        const float* t1 = topL + (tl * 16 + 2 * h) * 16; const float* t2 = t1 + 16;
        float s1[16], s2[16];
#pragma unroll
        for (int i = 0; i < 16; i += 4) { const f32x4 a = *(const f32x4*)(t1 + i), b2 = *(const f32x4*)(t2 + i);
            s1[i] = a[0]; s1[i + 1] = a[1]; s1[i + 2] = a[2]; s1[i + 3] = a[3]; s2[i] = b2[0]; s2[i + 1] = b2[1]; s2[i + 2] = b2[2]; s2[i + 3] = b2[3]; }
        float ts[16];
#pragma unroll
        for (int i = 0; i < 16; ++i) ts[i] = -INFINITY;
#pragma unroll
        for (int i = 0; i < 16; ++i)
#pragma unroll
            for (int j = 0; j < 16; ++j)
                if ((i + 1) * (j + 1) <= 16) PEER_INS(ts, __uint_as_float((__float_as_uint(s1[i] + s2[j]) & ~0xFFu) | (unsigned)(i * 16 + j)));
        float ex[16], sum = 0.f;
#pragma unroll
        for (int k = 0; k < 16; ++k) { ex[k] = __expf(ts[k] - ts[0]); sum += ex[k]; }
        const float inv = 1.f / sum;
#pragma unroll
        for (int k = 0; k < 16; ++k) { const unsigned pos = __float_as_uint(ts[k]) & 0xFFu;
            const int i1 = (int)(__float_as_uint(t1[pos >> 4]) & 0x7Fu), i2 = (int)(__float_as_uint(t2[pos & 15]) & 0x7Fu);
            selE[tl * 128 + h * 16 + k] = i1 * 128 + i2; selG[tl * 128 + h * 16 + k] = ex[k] * inv; }
    }
    __syncthreads();
    for (int ti = 0; ti < 4; ++ti) {
        const int tl = wave * 4 + ti; const size_t t = (size_t)g * 32 + tl;
        u32x4 hq[4];
#pragma unroll
        for (int j = 0; j < 4; ++j) hq[j] = *(const u32x4*)(h2 + t * DM + j * 512 + lane * 8);
        float acc[32];
#pragma unroll
        for (int i = 0; i < 32; ++i) acc[i] = 0.f;
        for (int bb = 0; bb < 32; ++bb) {
            int e[4]; float gt[4];
#pragma unroll
            for (int q = 0; q < 4; ++q) { e[q] = __builtin_amdgcn_readfirstlane(selE[tl * 128 + bb * 4 + q]); gt[q] = selG[tl * 128 + bb * 4 + q]; }
            u32x4 ur[4][4], vr[4][4];
#pragma unroll
            for (int q = 0; q < 4; ++q)
#pragma unroll
                for (int j = 0; j < 4; ++j) ur[q][j] = *(const u32x4*)(U16 + (size_t)e[q] * DM + j * 512 + lane * 8);
#pragma unroll
            for (int q = 0; q < 4; ++q)
#pragma unroll
                for (int j = 0; j < 4; ++j) vr[q][j] = *(const u32x4*)(V16 + (size_t)e[q] * DM + j * 512 + lane * 8);
            float d[4];
#pragma unroll
            for (int q = 0; q < 4; ++q) { float a = 0.f;
#pragma unroll
                for (int j = 0; j < 4; ++j)
#pragma unroll
                    for (int c = 0; c < 4; ++c) a = dot2bf(hq[j][c], ur[q][j][c], a);
                d[q] = a; }
            const bool b5 = (lane & 32) != 0, b4 = (lane & 16) != 0;
            const float r0 = __shfl_xor(b5 ? d[0] : d[2], 32), r1 = __shfl_xor(b5 ? d[1] : d[3], 32);
            const float k0 = (b5 ? d[2] : d[0]) + r0, k1 = (b5 ? d[3] : d[1]) + r1;
            float c1 = (b4 ? k1 : k0) + __shfl_xor(b4 ? k0 : k1, 16);
            c1 += __shfl_xor(c1, 8); c1 += __shfl_xor(c1, 4); c1 += __shfl_xor(c1, 2); c1 += __shfl_xor(c1, 1);
#pragma unroll
            for (int q = 0; q < 4; ++q) {
                const float a = __uint_as_float((unsigned)__builtin_amdgcn_readlane((int)__float_as_uint(c1), 16 * q));
                const float w = gt[q] * 0.5f * a * (1.f + erff(a * 0.70710678118654752f));
#pragma unroll
                for (int j = 0; j < 4; ++j)
#pragma unroll
                    for (int c = 0; c < 4; ++c) { const unsigned x = vr[q][j][c];
                        acc[j * 8 + 2 * c] += w * __uint_as_float(x << 16); acc[j * 8 + 2 * c + 1] += w * __uint_as_float(x & 0xffff0000u); }
            }
        }
#pragma unroll
        for (int j = 0; j < 4; ++j) { const size_t o = t * DM + j * 512 + lane * 8;
            const f32x4 a = *(const f32x4*)(x1 + o), b2 = *(const f32x4*)(x1 + o + 4);
            *(f32x4*)(out + o) = (f32x4){a[0] + acc[j * 8], a[1] + acc[j * 8 + 1], a[2] + acc[j * 8 + 2], a[3] + acc[j * 8 + 3]};
            *(f32x4*)(out + o + 4) = (f32x4){b2[0] + acc[j * 8 + 4], b2[1] + acc[j * 8 + 5], b2[2] + acc[j * 8 + 6], b2[3] + acc[j * 8 + 7]}; }
    }
    __syncthreads();
}

#define XB_TMO      128
#define XB_XCNT(j)  (256  + 64 * (j))
#define XB_XSUB(j)  (1280 + 64 * (j))
#define XB_XGEN(j)  (2304 + 64 * (j))
#define XB_TOP      3328
#define XB_TOPGEN   3392
#define XCD_BAR_WORDS 3456
#define XB_SPIN_CAP (1u << 18)

__device__ __forceinline__ unsigned xb_ld(unsigned* p)              { return __hip_atomic_load(p, __ATOMIC_RELAXED, __HIP_MEMORY_SCOPE_AGENT); }
__device__ __forceinline__ unsigned xb_add(unsigned* p, unsigned v) { return __hip_atomic_fetch_add(p, v, __ATOMIC_RELAXED, __HIP_MEMORY_SCOPE_AGENT); }
__device__ __forceinline__ unsigned xb_xcc_id() { return (unsigned)__builtin_amdgcn_s_getreg((3 << 11) | 20) & 0xFu; }
#define XB_SPIN(cond, bar) do { unsigned _sp = 0; while (cond) { __builtin_amdgcn_s_sleep(1); \
    if ((++_sp & 255u) == 0u) { if (xb_ld(&(bar)[XB_TMO])) break; if (_sp > XB_SPIN_CAP) { atomicAdd(&(bar)[XB_TMO], 1u); break; } } } } while (0)

struct XcdBarrier {
    unsigned* bar; unsigned x;
    volatile LAS unsigned* st;
};

__device__ __forceinline__ XcdBarrier xcd_barrier_post(unsigned* bar, volatile LAS unsigned* st) {
    XcdBarrier b; b.bar = bar; b.x = xb_xcc_id(); b.st = st;
    if (threadIdx.x == 0) (void)xb_add(&bar[XB_XCNT(b.x)], 1u);
    return b;
}
__device__ __forceinline__ void xcd_barrier_complete(unsigned* bar, unsigned x, unsigned& nloc, unsigned& nx) {
    const unsigned G = gridDim.x * gridDim.y * gridDim.z;
    unsigned sum, cnt, mine, sp = 0u;
    for (;;) {
        sum = 0u; cnt = 0u; mine = 0u;
#pragma unroll
        for (unsigned j = 0; j < 16; ++j) { const unsigned c = xb_ld(&bar[XB_XCNT(j)]); sum += c; cnt += (c > 0u) ? 1u : 0u; mine = (j == x) ? c : mine; }
        if (sum == G) break;
        __builtin_amdgcn_s_sleep(1);
        if ((++sp & 255u) == 0u) { if (xb_ld(&bar[XB_TMO])) break; if (sp > XB_SPIN_CAP) { atomicAdd(&bar[XB_TMO], 1u); break; } }
    }
    nloc = mine > 0u ? mine : 1u; nx = cnt > 0u ? cnt : 1u;
}

__device__ __forceinline__ void xcd_barrier(const XcdBarrier& b) {
    asm volatile("s_waitcnt vmcnt(0)" ::: "memory");
    __syncthreads();
    if (threadIdx.x == 0) {
        unsigned* bar = b.bar;
        __builtin_amdgcn_s_waitcnt(0);
        unsigned nloc = b.st[0], nx = b.st[1];
        if (nloc == 0u) { xcd_barrier_complete(bar, b.x, nloc, nx); b.st[0] = nloc; b.st[1] = nx; }
        const unsigned old = xb_add(&bar[XB_XSUB(b.x)], 1u);
        const unsigned gen = old / nloc;
        if (old + 1u == (gen + 1u) * nloc) {
            __builtin_amdgcn_fence(__ATOMIC_RELEASE, "agent");
            asm volatile("s_waitcnt vmcnt(0)" ::: "memory");
            const unsigned og = xb_add(&bar[XB_TOP], 1u);
            const unsigned tg = og / nx;
            if (og + 1u == (tg + 1u) * nx) xb_add(&bar[XB_TOPGEN], 1u);
            else XB_SPIN(xb_ld(&bar[XB_TOPGEN]) == tg, bar);
            __builtin_amdgcn_fence(__ATOMIC_ACQUIRE, "agent");
            xb_add(&bar[XB_XGEN(b.x)], 1u);
            asm volatile("s_waitcnt vmcnt(0)" ::: "memory");
        } else {
            XB_SPIN(xb_ld(&bar[XB_XGEN(b.x)]) == gen, bar);
            __builtin_amdgcn_fence(__ATOMIC_ACQUIRE, "agent");
            asm volatile("s_waitcnt vmcnt(0)" ::: "memory");
        }
    }
    __syncthreads();
}

#define PROBE_DOUBLE 0
#define REP(k) for (int rep_ = 0; rep_ < ((PROBE_DOUBLE == (k)) ? 2 : 1); ++rep_)
constexpr int LDS_BYTES = 147456;
__global__ __launch_bounds__(512, 2) void mega(Params p) {
    extern __shared__ __attribute__((aligned(16))) unsigned char smem[];
    { volatile LAS unsigned* st0 = (volatile LAS unsigned*)((LAS unsigned char*)smem + 131072); if (threadIdx.x < 2) st0[threadIdx.x] = 0u; }
    __syncthreads();
    const XcdBarrier bar = xcd_barrier_post(p.ctl, (volatile LAS unsigned*)((LAS unsigned char*)smem + 131072));
    float* smf = (float*)smem;
    LAS unsigned char* lds = (LAS unsigned char*)smem;
    const int G = gridDim.x, b = blockIdx.x, NGW = G * 8;
#define PHASE_IDS() const int tid = opaque_tid(), lane = tid & 63, wave = __builtin_amdgcn_readfirstlane(tid >> 6), gw = b * 8 + wave; (void)lane; (void)gw

    REP(7) {
        PHASE_IDS();
        float* scr = smf + wave * 4096;
        constexpr int I_IN = 32 * 355, I_Q = 8 * 96, I_KV = 8 * 128, I_O = 64 * 64;
        for (int it = gw; it < I_IN + I_Q + I_KV + I_O; it += NGW) {
            int r = it;
            if (r < I_IN) { transpose_item(p.w_in, 2048, INW, p.WinT, DstWin(), scr, r, lane); continue; } r -= I_IN;
            if (r < I_Q) { transpose_item(p.w_q_up, 512, 3072, p.WqT, DstId(), scr, r, lane); continue; } r -= I_Q;
            if (r < I_KV) { transpose_item(p.w_kv_up, 512, 4096, p.WkvT, DstId(), scr, r, lane); continue; } r -= I_KV;
            transpose_item(p.w_out, 4096, 2048, p.WoT, DstId(), scr, r, lane);
        }
        for (int m = gw; m < S; m += NGW) rms_row2048(p.x + (size_t)m * DM, p.mix_g, p.h + (size_t)m * DM, lane);
        __syncthreads();
        for (int it = b; it < 512; it += G) wfold_item(p.w_peer_q, p.sub_keys, p.WpT, smf, it);
    }
    xcd_barrier(bar);
    REP(1) {
        pg8::Gemm g{p.h, p.WinT, S, INWP, DM}; pg8::StaticOrder so; so.init(S, INWP, G, b);
        pg8::EpiInProj E{p.cq, p.ckv, p.fq, p.fk, p.fv, p.merged, p.kpe, p.lf, p.b_gate, p.b_forget};
        pg8::gemm_phase<pg8::EpiInProj, pg8::StaticOrder, true, true>(lds, g, so, E);
    }
    xcd_barrier(bar);
    {
    PHASE_IDS();
    for (int t = gw; t < S; t += NGW) { rms_row512_inplace(p.cq + (size_t)t * 512, p.q_lat_g, lane); rms_row512_inplace(p.ckv + (size_t)t * 512, p.kv_lat_g, lane); }
    for (int w = gw; w < S * 16; w += NGW) fox_prep(w, p.fq, p.fk, p.fox_qg, p.fox_kg, lane);
    for (int hh = b; hh < 16; hh += G) fox_cumsum((double*)smem, hh, p.lf, p.F);
    }
    xcd_barrier(bar);
    REP(2) {
        pg8::Gemm g{p.cq, p.WqT, S, 3072, 512}; pg8::StaticOrder so; so.init(S, 3072, G, b);
        pg8::EpiStoreBf16 E{p.qa, 3072};
        pg8::gemm_phase<pg8::EpiStoreBf16, pg8::StaticOrder, true, true>(lds, g, so, E);
    }
    {
        pg8::Gemm g{p.ckv, p.WkvT, S, 4096, 512}; pg8::StaticOrder so; so.init(S, 4096, G, b);
        pg8::EpiStoreBf16 E{p.kvraw, 4096};
        pg8::gemm_phase<pg8::EpiStoreBf16, pg8::StaticOrder, true, true>(lds, g, so, E);
    }
    xcd_barrier(bar);
    { PHASE_IDS(); for (int w = gw; w < S * 16; w += NGW) mla_prep(w, p.qa, p.kvraw, p.kpe, p.pos, p.mla_qg, p.mla_kg, p.ka, lane); }
    xcd_barrier(bar);
    REP(3) for (int L = b; L < 1024; L += G) {
        const int i = L >> 8, vc = L & 255, vcx = (vc & 7) * 32 + (vc >> 3), hh = vcx >> 4, x = vcx & 15, qbk = (i & 1) ? x : 31 - x;
        if (i < 2) att::attn_block<192, false>(smem, p.qa + hh * 192, 3072, p.ka + hh * 192, 3072, p.kvraw + hh * 256 + 128, 4096, nullptr, p.merged + hh * 128, p.attout + hh * 128, qbk);
        else att::attn_block<128, true>(smem, p.fq + hh * 128, 2048, p.fk + hh * 128, 2048, p.fv + hh * 128, 2048, p.F + (size_t)hh * S, p.merged + 2048 + hh * 128, p.attout + 2048 + hh * 128, qbk);
    }
    xcd_barrier(bar);
    REP(4) {
        pg8::Gemm g{p.attout, p.WoT, S, 2048, 4096}; pg8::StaticOrder so; so.init(S, 2048, G, b);
        pg8::EpiStoreF32<true> E{p.x1, p.x, 2048};
        pg8::gemm_phase<pg8::EpiStoreF32<true>, pg8::StaticOrder, true, true>(lds, g, so, E);
    }
    xcd_barrier(bar);
    { PHASE_IDS(); for (int m = gw; m < S; m += NGW) rms_row2048(p.x1 + (size_t)m * DM, p.ffn_g, p.h + (size_t)m * DM, lane);
      cvt_rows_bf16(p.peer_u, p.U16, (size_t)16384 * 2048, gw, NGW, lane); cvt_rows_bf16(p.peer_v, p.V16, (size_t)16384 * 2048, gw, NGW, lane); }
    xcd_barrier(bar);
    REP(5) {
        pg8::Gemm g{p.h, p.WpT, S, 2048, 2048}; pg8::StaticOrder so; so.init(S, 2048, G, b);
        pg8::EpiStoreF32<false> E{p.scores, nullptr, 2048};
        pg8::gemm_phase<pg8::EpiStoreF32<false>, pg8::StaticOrder, true, true>(lds, g, so, E);
    }
    xcd_barrier(bar);
    REP(6) for (int g = b; g < S / 32; g += G) peer_group(smem, g, p.scores, p.h, p.x1, p.U16, p.V16, p.out);
}

extern "C" void kernel_launch(void* const* d_in, const int* in_sizes, int n_in,
                              void* d_out, int out_size, void* d_ws, size_t ws_size,
                              hipStream_t stream) {
    if (ws_size < 512 * MiB) { fprintf(stderr, "kernel_launch: workspace too small (%zu)\n", ws_size); return; }
    Params p{};
    p.x = (const float*)d_in[0]; p.pos = (const int*)d_in[1]; p.mix_g = (const float*)d_in[2]; p.w_in = (const float*)d_in[3];
    p.b_forget = (const float*)d_in[4]; p.b_gate = (const float*)d_in[5]; p.q_lat_g = (const float*)d_in[6]; p.w_q_up = (const float*)d_in[7];
    p.kv_lat_g = (const float*)d_in[8]; p.w_kv_up = (const float*)d_in[9]; p.mla_qg = (const float*)d_in[10]; p.mla_kg = (const float*)d_in[11];
    p.fox_qg = (const float*)d_in[12]; p.fox_kg = (const float*)d_in[13]; p.w_out = (const float*)d_in[14]; p.ffn_g = (const float*)d_in[15];
    p.w_peer_q = (const float*)d_in[16]; p.sub_keys = (const float*)d_in[17]; p.peer_u = (const float*)d_in[18]; p.peer_v = (const float*)d_in[19];
    p.out = (float*)d_out;
    char* ws = (char*)d_ws;
    p.WqT = (bf16_t*)(ws + 1 * MiB); p.WkvT = (bf16_t*)(ws + 5 * MiB); p.WoT = (bf16_t*)(ws + 9 * MiB); p.WpT = (bf16_t*)(ws + 25 * MiB); p.WinT = (bf16_t*)(ws + 33 * MiB);
    p.h = (bf16_t*)(ws + 78 * MiB); p.cq = (bf16_t*)(ws + 110 * MiB); p.ckv = (bf16_t*)(ws + 118 * MiB);
    p.fq = (bf16_t*)(ws + 126 * MiB); p.fk = (bf16_t*)(ws + 158 * MiB); p.fv = (bf16_t*)(ws + 190 * MiB); p.merged = (bf16_t*)(ws + 222 * MiB);
    p.kpe = (bf16_t*)(ws + 286 * MiB); p.lf = (float*)(ws + 287 * MiB); p.F = (float*)(ws + 287 * MiB + 512 * 1024);
    p.qa = (bf16_t*)(ws + 288 * MiB); p.kvraw = (bf16_t*)(ws + 336 * MiB); p.ka = (bf16_t*)(ws + 400 * MiB); p.x1 = (float*)(ws + 448 * MiB);
    p.scores = (float*)(ws + 222 * MiB);
    p.ctl = (unsigned*)ws;
    p.attout = (bf16_t*)(ws + 33 * MiB);
    p.U16 = (bf16_t*)(ws + 126 * MiB); p.V16 = (bf16_t*)(ws + 336 * MiB);

    static int grid_blocks = 0;
    if (!grid_blocks) {
        if (hipFuncSetAttribute((const void*)mega, hipFuncAttributeMaxDynamicSharedMemorySize, LDS_BYTES) != hipSuccess) { fprintf(stderr, "hipFuncSetAttribute failed\n"); return; }
        int dev = 0, cus = 0, per_cu = 0;
        (void)hipGetDevice(&dev);
        (void)hipDeviceGetAttribute(&cus, hipDeviceAttributeMultiprocessorCount, dev);
        (void)hipOccupancyMaxActiveBlocksPerMultiprocessor(&per_cu, (const void*)mega, 512, LDS_BYTES);
        if (per_cu < 1 || cus < 1) { fprintf(stderr, "occupancy query says %d blocks/CU on %d CUs\n", per_cu, cus); return; }
        grid_blocks = cus;
    }
    if (hipMemsetAsync(d_ws, 0, 16384, stream) != hipSuccess) { fprintf(stderr, "memset of the barrier words failed\n"); return; }
    void* args[] = {&p};
    hipError_t e = hipLaunchCooperativeKernel((const void*)mega, dim3(grid_blocks), dim3(512), args, LDS_BYTES, stream);
    if (e != hipSuccess) fprintf(stderr, "cooperative launch failed: %s (grid %d)\n", hipGetErrorString(e), grid_blocks);
}
```

```cpp
#include <hip/hip_runtime.h>
#include <hip/hip_cooperative_groups.h>
#include <stdint.h>
#include <math.h>
#include <cstdio>
namespace cg = cooperative_groups;

namespace pg8 {
#define PG8_LAS __attribute__((address_space(3)))
typedef unsigned short bf16_t;
typedef short bf16x8 __attribute__((ext_vector_type(8)));
typedef float f32x4 __attribute__((ext_vector_type(4)));
typedef unsigned u32x4 __attribute__((ext_vector_type(4)));
constexpr int BM = 256, BK = 64, HALF = 128, HTB = HALF * BK * 2  , STAGE_BYTES = 8 * HTB, NXCD = 8, WGM = 8;

__host__ __device__ __forceinline__ int lds_byte(int r, int c) { const int st = (r >> 4) * 2 + (c >> 5), rr = r & 15, cc = c & 31, ob = rr * 64 + cc * 2; return st * 1024 + (ob ^ (((ob >> 9) & 1) << 5)); }
__host__ __device__ __forceinline__ void stage_rc(int b, int& R, int& C) { const int st = b / 1024, sb = b % 1024, swz = sb ^ (((sb >> 9) & 1) << 5); R = (st >> 1) * 16 + swz / 64; C = (st & 1) * 32 + (swz % 64) / 2; }
__host__ __device__ __forceinline__ int perm32(int rho) { const int n = rho >> 4, i = rho & 15; return 8 * (i >> 2) + 4 * n + (i & 3); }

struct Unit { int pm, pn; };
struct Gemm { const bf16_t* A; const bf16_t* Bt; int M, N, K; };

struct StaticOrder {
    int nM, nN, nwg, G, c;
    __host__ __device__ void init(int M, int N, int G_, int c_) { nM = M / BM; nN = N / BM; nwg = nM * nN; G = G_; c = c_; }
    __host__ __device__ bool next(int i, Unit& u) const {
        const long L = (long)i * G + c; if (L >= nwg) return false;
        int wgid = (int)L; { const int q = nwg / NXCD, r = nwg % NXCD, xcd = wgid % NXCD, off = wgid / NXCD; wgid = (xcd < r ? xcd * (q + 1) : r * (q + 1) + (xcd - r) * q) + off; }
        const int nig = WGM * nN, gid = wgid / nig, fm = gid * WGM, gsz = (nM - fm) < WGM ? (nM - fm) : WGM;
        u.pm = fm + ((wgid % nig) % gsz); u.pn = (wgid % nig) / gsz; return true;
    }
    __device__ __forceinline__ void a_ready(const Unit&) const {}
    __device__ __forceinline__ void done(const Unit&) const {}
};

__device__ __forceinline__ unsigned cvt_pk_bf16(float lo, float hi) { unsigned r; asm volatile("v_cvt_pk_bf16_f32 %0, %1, %2" : "=v"(r) : "v"(lo), "v"(hi)); return r; }
__device__ __forceinline__ u32x4 pack8bf(const f32x4& v0, const f32x4& v1) { u32x4 w; w.x = cvt_pk_bf16(v0[0], v0[1]); w.y = cvt_pk_bf16(v0[2], v0[3]); w.z = cvt_pk_bf16(v1[0], v1[1]); w.w = cvt_pk_bf16(v1[2], v1[3]); return w; }

struct EpiStoreBf16 {
    static constexpr bool PERM = true, AFTER_DRAIN = false;
    bf16_t* O; int ldc;
    __device__ __forceinline__ void operator()(const f32x4 (&acc)[2][2][4][2], const Unit& u, int wr, int wc, int fr, int fq) const {
        const int row0 = u.pm * BM + wr * 64 + fr, col0 = u.pn * BM + wc * 32 + 8 * fq;
#pragma unroll
        for (int ai = 0; ai < 2; ++ai)
#pragma unroll
            for (int m = 0; m < 4; ++m) { bf16_t* rowp = O + (size_t)(row0 + ai * HALF + m * 16) * ldc + col0;
#pragma unroll
                for (int bj = 0; bj < 2; ++bj) *(u32x4*)(rowp + bj * HALF) = pack8bf(acc[ai][bj][m][0], acc[ai][bj][m][1]); }
    }
};
template <bool RES> struct EpiStoreF32 {
    static constexpr bool PERM = true, AFTER_DRAIN = false;
    float* O; const float* res; int ldc;
    __device__ __forceinline__ void operator()(const f32x4 (&acc)[2][2][4][2], const Unit& u, int wr, int wc, int fr, int fq) const {
        const int row0 = u.pm * BM + wr * 64 + fr, col0 = u.pn * BM + wc * 32 + 8 * fq;
#pragma unroll
        for (int ai = 0; ai < 2; ++ai)
#pragma unroll
            for (int m = 0; m < 4; ++m) { const size_t off = (size_t)(row0 + ai * HALF + m * 16) * ldc + col0;
#pragma unroll
                for (int bj = 0; bj < 2; ++bj) { f32x4 v0 = acc[ai][bj][m][0], v1 = acc[ai][bj][m][1];
                    if (RES) { v0 += *(const f32x4*)(res + off + bj * HALF); v1 += *(const f32x4*)(res + off + bj * HALF + 4); }
                    *(f32x4*)(O + off + bj * HALF) = v0; *(f32x4*)(O + off + bj * HALF + 4) = v1; } }
    }
};
struct EpiInProj {
    static constexpr bool PERM = true, AFTER_DRAIN = false;
    bf16_t *cq, *ckv, *fq, *fk, *fv, *gates, *kpe; float* lf; const float *b_gate, *b_forget;
    __device__ __forceinline__ void operator()(const f32x4 (&acc)[2][2][4][2], const Unit& u, int wr, int wc, int fr, int fq_) const {
        const int pn = u.pn, row0 = u.pm * BM + wr * 64 + fr, cw = wc * 32 + 8 * fq_;
        if (pn < 28) {
            bf16_t* base; int ldc, colt;
            if (pn < 2) { base = cq; ldc = 512; colt = pn * 256; } else if (pn < 4) { base = ckv; ldc = 512; colt = (pn - 2) * 256; }
            else if (pn < 12) { base = fq; ldc = 2048; colt = (pn - 4) * 256; } else if (pn < 20) { base = fk; ldc = 2048; colt = (pn - 12) * 256; }
            else { base = fv; ldc = 2048; colt = (pn - 20) * 256; }
#pragma unroll
            for (int ai = 0; ai < 2; ++ai)
#pragma unroll
                for (int m = 0; m < 4; ++m) { bf16_t* rowp = base + (size_t)(row0 + ai * HALF + m * 16) * ldc + colt + cw;
#pragma unroll
                    for (int bj = 0; bj < 2; ++bj) *(u32x4*)(rowp + bj * HALF) = pack8bf(acc[ai][bj][m][0], acc[ai][bj][m][1]); }
        } else if (pn < 44) {
            const int colt = (pn - 28) * 256 + cw;
#pragma unroll
            for (int bj = 0; bj < 2; ++bj) {
                const f32x4 b0 = *(const f32x4*)(b_gate + colt + bj * HALF), b1 = *(const f32x4*)(b_gate + colt + bj * HALF + 4);
#pragma unroll
                for (int ai = 0; ai < 2; ++ai)
#pragma unroll
                    for (int m = 0; m < 4; ++m) {
                        f32x4 v0 = acc[ai][bj][m][0] + b0, v1 = acc[ai][bj][m][1] + b1;
#pragma unroll
                        for (int e = 0; e < 4; ++e) { v0[e] = 1.f / (1.f + __expf(-v0[e])); v1[e] = 1.f / (1.f + __expf(-v1[e])); }
                        *(u32x4*)(gates + (size_t)(row0 + ai * HALF + m * 16) * 4096 + colt + bj * HALF) = pack8bf(v0, v1); }
            }
        } else {
            if (cw < 64) {
#pragma unroll
                for (int ai = 0; ai < 2; ++ai)
#pragma unroll
                    for (int m = 0; m < 4; ++m) *(u32x4*)(kpe + (size_t)(row0 + ai * HALF + m * 16) * 64 + cw) = pack8bf(acc[ai][0][m][0], acc[ai][0][m][1]);
            } else if (cw < 80) {
                const int h0 = cw - 64;
                const f32x4 b0 = *(const f32x4*)(b_forget + h0), b1 = *(const f32x4*)(b_forget + h0 + 4);
#pragma unroll
                for (int ai = 0; ai < 2; ++ai)
#pragma unroll
                    for (int m = 0; m < 4; ++m) { const int row = row0 + ai * HALF + m * 16;
                        f32x4 z0 = acc[ai][0][m][0] + b0, z1 = acc[ai][0][m][1] + b1;
#pragma unroll
                        for (int e = 0; e < 4; ++e) { z0[e] = fminf(z0[e], 0.f) - __logf(1.f + __expf(-fabsf(z0[e]))); z1[e] = fminf(z1[e], 0.f) - __logf(1.f + __expf(-fabsf(z1[e]))); }
                        *(f32x4*)(lf + (size_t)row * 16 + h0) = z0; *(f32x4*)(lf + (size_t)row * 16 + h0 + 4) = z1; }
            }
        }
    }
};
template <class Epi, class Sched, bool ALIGN_EPI = false, bool SP2 = false>
__device__ __forceinline__ void gemm_phase(PG8_LAS unsigned char* lds, const Gemm g, const Sched& S, const Epi& E) {
    const int tid = threadIdx.x, wid = __builtin_amdgcn_readfirstlane(tid >> 6), lane = tid & 63, wr = wid >> 2, wc = wid & 3, fr = lane & 15, fq = lane >> 4;
    const int K = g.K, nt = K / BK;
    unsigned voffA[2], voffB[2];
#pragma unroll
    for (int i = 0; i < 2; ++i) { int R, C; stage_rc(tid * 16 + i * 8192, R, C); const int Rb = Epi::PERM ? ((R & ~31) + perm32(R & 31)) : R;
        voffA[i] = (unsigned)(R * K + C) * 2u; voffB[i] = (unsigned)(Rb * K + C) * 2u; }
    const size_t kstep = (size_t)(BK * 2);
    const size_t hstep = (size_t)HALF * K * 2;
    const size_t tstep = 2 * hstep;
    const unsigned ldsw = (unsigned)wid * 1024u;
    const int aoff = lds_byte(wr * 64 + fr, fq * 8), boff = lds_byte(wc * 32 + fr, fq * 8);
#define PG8_SA(b, h) (((b) * 2 + (h)) * HTB)
#define PG8_SB(b, h) ((4 + (b) * 2 + (h)) * HTB)
#define PG8_STAGE(bufoff, gbase, voff) do { _Pragma("unroll") for (int _i = 0; _i < 2; ++_i) \
        __builtin_amdgcn_global_load_lds((const unsigned*)((const char*)(gbase) + (voff)[_i]), (PG8_LAS unsigned*)(lds + (bufoff) + ldsw + _i * 8192), 16, 0, 0); } while (0)
#define PG8_LDA(dst, b, h) do { _Pragma("unroll") for (int m = 0; m < 4; ++m) _Pragma("unroll") for (int k = 0; k < 2; ++k) dst[m][k] = *(const PG8_LAS bf16x8*)(lds + PG8_SA(b, h) + aoff + m * 2048 + k * 1024); } while (0)
#define PG8_LDB(dst, b, h) do { _Pragma("unroll") for (int n = 0; n < 2; ++n) _Pragma("unroll") for (int k = 0; k < 2; ++k) dst[n][k] = *(const PG8_LAS bf16x8*)(lds + PG8_SB(b, h) + boff + n * 2048 + k * 1024); } while (0)
#define PG8_MMA(ai, bj, At, Bt) do { __builtin_amdgcn_s_setprio(1); _Pragma("unroll") for (int m = 0; m < 4; ++m) _Pragma("unroll") for (int n = 0; n < 2; ++n) _Pragma("unroll") for (int k = 0; k < 2; ++k) \
        acc[ai][bj][m][n] = __builtin_amdgcn_mfma_f32_16x16x32_bf16(Bt[n][k], At[m][k], acc[ai][bj][m][n], 0, 0, 0); __builtin_amdgcn_s_setprio(0); } while (0)
#define PG8_WAIT_V(n) asm volatile("s_waitcnt vmcnt(" #n ")" ::: "memory")
#define PG8_WAIT_L(n) asm volatile("s_waitcnt lgkmcnt(" #n ")" ::: "memory")
#define PG8_BAR __builtin_amdgcn_s_barrier()
#define PG8_SCHED __builtin_amdgcn_sched_barrier(0)
    Unit cur, nxt; int ui = 0;
    if (!S.next(0, cur)) return;
    f32x4 acc[2][2][4][2];
#pragma unroll
    for (int a = 0; a < 2; ++a)
#pragma unroll
        for (int b = 0; b < 2; ++b)
#pragma unroll
            for (int m = 0; m < 4; ++m)
#pragma unroll
                for (int n = 0; n < 2; ++n) acc[a][b][m][n] = (f32x4){0.f, 0.f, 0.f, 0.f};
    bf16x8 At[4][2], B0[2][2], B1[2][2];
    const char* cA = (const char*)g.A + (size_t)cur.pm * tstep; const char* cB = (const char*)g.Bt + (size_t)cur.pn * tstep;
    S.a_ready(cur);
    if constexpr (SP2) {
        PG8_STAGE(PG8_SB(0, 0), cB, voffB); PG8_STAGE(PG8_SB(0, 1), cB + hstep, voffB); PG8_STAGE(PG8_SA(0, 0), cA, voffA); PG8_STAGE(PG8_SA(0, 1), cA + hstep, voffA);
        if (wr == 1) PG8_BAR;
        PG8_WAIT_V(2); PG8_BAR;
        PG8_STAGE(PG8_SB(1, 0), cB + kstep, voffB); PG8_STAGE(PG8_SA(1, 0), cA + kstep, voffA); PG8_STAGE(PG8_SB(1, 1), cB + hstep + kstep, voffB);
        PG8_WAIT_V(6); PG8_BAR;
    } else {
        PG8_STAGE(PG8_SB(0, 0), cB, voffB); PG8_STAGE(PG8_SA(0, 0), cA, voffA); PG8_STAGE(PG8_SB(0, 1), cB + hstep, voffB); PG8_STAGE(PG8_SA(0, 1), cA + hstep, voffA);
        if (wr == 1) PG8_BAR;
        PG8_WAIT_V(4); PG8_BAR;
        PG8_STAGE(PG8_SB(1, 0), cB + kstep, voffB); PG8_STAGE(PG8_SA(1, 0), cA + kstep, voffA); PG8_STAGE(PG8_SB(1, 1), cB + hstep + kstep, voffB);
        PG8_WAIT_V(6); PG8_BAR;
    }
    for (;;) {
        const bool has_next = S.next(ui + 1, nxt);
        const char* nA = has_next ? (const char*)g.A + (size_t)nxt.pm * tstep : cA; const char* nB = has_next ? (const char*)g.Bt + (size_t)nxt.pn * tstep : cB;
        for (int t = 0; t < nt; t += 2) {
            const bool last = (t == nt - 2);
            const char* a1 = cA + (size_t)(t + 1) * kstep;
            const char* a2 = last ? nA : cA + (size_t)(t + 2) * kstep; const char* b2 = last ? nB : cB + (size_t)(t + 2) * kstep;
            const char* a3 = a2 + kstep; const char* b3 = b2 + kstep;
            if (last && has_next) S.a_ready(nxt);
            if constexpr (SP2) {
            PG8_LDB(B0, 0, 0); PG8_LDB(B1, 0, 1); PG8_SCHED; PG8_LDA(At, 0, 0); PG8_STAGE(PG8_SA(1, 1), a1 + hstep, voffA);
            PG8_WAIT_V(8); PG8_WAIT_L(0); PG8_BAR; PG8_MMA(0, 0, At, B0); PG8_MMA(0, 1, At, B1); PG8_BAR; PG8_SCHED;
            PG8_LDA(At, 0, 1); PG8_STAGE(PG8_SB(0, 0), b2, voffB); PG8_STAGE(PG8_SB(0, 1), b2 + hstep, voffB); PG8_STAGE(PG8_SA(0, 0), a2, voffA);
            PG8_WAIT_V(8); PG8_WAIT_L(0); PG8_BAR; PG8_MMA(1, 0, At, B0); PG8_MMA(1, 1, At, B1); PG8_BAR; PG8_SCHED;
            PG8_LDB(B0, 1, 0); PG8_LDB(B1, 1, 1); PG8_SCHED; PG8_LDA(At, 1, 0); PG8_STAGE(PG8_SA(0, 1), a2 + hstep, voffA);
            PG8_WAIT_V(8); PG8_WAIT_L(0); PG8_BAR; PG8_MMA(0, 0, At, B0); PG8_MMA(0, 1, At, B1); PG8_BAR; PG8_SCHED;
            PG8_LDA(At, 1, 1); PG8_STAGE(PG8_SB(1, 0), b3, voffB); PG8_STAGE(PG8_SB(1, 1), b3 + hstep, voffB); PG8_STAGE(PG8_SA(1, 0), a3, voffA);
            PG8_WAIT_V(8); PG8_WAIT_L(0); PG8_BAR; PG8_MMA(1, 0, At, B0); PG8_MMA(1, 1, At, B1); PG8_BAR; PG8_SCHED;
            } else {
            PG8_LDB(B0, 0, 0); PG8_SCHED; PG8_LDA(At, 0, 0); PG8_STAGE(PG8_SA(1, 1), a1 + hstep, voffA);
            PG8_WAIT_L(8); PG8_BAR; PG8_WAIT_L(0); PG8_MMA(0, 0, At, B0); PG8_BAR; PG8_SCHED;
            PG8_LDB(B1, 0, 1); PG8_STAGE(PG8_SB(0, 0), b2, voffB);
            PG8_BAR; PG8_WAIT_L(0); PG8_MMA(0, 1, At, B1); PG8_BAR;
            PG8_LDA(At, 0, 1); PG8_STAGE(PG8_SA(0, 0), a2, voffA);
            PG8_BAR; PG8_WAIT_L(0); PG8_MMA(1, 0, At, B0); PG8_BAR; PG8_SCHED;
            PG8_STAGE(PG8_SB(0, 1), b2 + hstep, voffB);
            PG8_WAIT_V(6); PG8_BAR; PG8_MMA(1, 1, At, B1); PG8_BAR;
            PG8_LDB(B0, 1, 0); PG8_SCHED; PG8_LDA(At, 1, 0); PG8_STAGE(PG8_SA(0, 1), a2 + hstep, voffA);
            PG8_WAIT_L(8); PG8_BAR; PG8_WAIT_L(0); PG8_MMA(0, 0, At, B0); PG8_BAR; PG8_SCHED;
            PG8_LDB(B1, 1, 1); PG8_STAGE(PG8_SB(1, 0), b3, voffB);
            PG8_BAR; PG8_WAIT_L(0); PG8_MMA(0, 1, At, B1); PG8_BAR;
            PG8_LDA(At, 1, 1); PG8_STAGE(PG8_SA(1, 0), a3, voffA);
            PG8_BAR; PG8_WAIT_L(0); PG8_MMA(1, 0, At, B0); PG8_BAR; PG8_SCHED;
            PG8_STAGE(PG8_SB(1, 1), b3 + hstep, voffB);
            PG8_WAIT_V(6); PG8_BAR; PG8_MMA(1, 1, At, B1); PG8_BAR;
            }
        }
        if constexpr (ALIGN_EPI) { if (wr == 0) PG8_BAR; }
        if constexpr (!Epi::AFTER_DRAIN) { E(acc, cur, wr, wc, fr, fq); S.done(cur); }
        if (!has_next) break;
#pragma unroll
        for (int a = 0; a < 2; ++a)
#pragma unroll
            for (int b = 0; b < 2; ++b)
#pragma unroll
                for (int m = 0; m < 4; ++m)
#pragma unroll
                    for (int n = 0; n < 2; ++n) acc[a][b][m][n] = (f32x4){0.f, 0.f, 0.f, 0.f};
        cur = nxt; cA = nA; cB = nB; ++ui;
        if constexpr (ALIGN_EPI) { if (wr == 1) PG8_BAR; }
    }
    PG8_WAIT_V(0);
    if constexpr (!ALIGN_EPI) { if (wr == 0) PG8_BAR; }
    PG8_BAR;
    if constexpr (Epi::AFTER_DRAIN) { E.fused(acc, cur, wr, wc, fr, fq, lds, wid, lane); S.done(cur); }
#undef PG8_SA
#undef PG8_SB
#undef PG8_STAGE
#undef PG8_LDA
#undef PG8_LDB
#undef PG8_MMA
#undef PG8_WAIT_V
#undef PG8_WAIT_L
#undef PG8_BAR
#undef PG8_SCHED
}
}
namespace att {
typedef unsigned short bf16_t;
typedef short bf16x8 __attribute__((ext_vector_type(8)));
typedef short s16x4 __attribute__((ext_vector_type(4)));
typedef float f32x16 __attribute__((ext_vector_type(16)));
typedef float f32x4 __attribute__((ext_vector_type(4)));
typedef unsigned u32x4 __attribute__((ext_vector_type(4)));
#define ALAS __attribute__((address_space(3)))
#define ASBAR() __builtin_amdgcn_sched_barrier(0)
constexpr int SHM_V = 16384;
template <int DK> struct Lay { static constexpr int ROWB = DK * 2, SHM_K = 64 * ROWB, OFF_K = 2 * SHM_V, OFF_F = OFF_K + 2 * SHM_K, OFF_WS = OFF_F + 512, TOTAL = OFF_WS + 8 * 256; };

__device__ __forceinline__ int v_st(int k, int c) { const int kk = (k & ~0xC) | ((k & 4) << 1) | ((k & 8) >> 1); return ((kk >> 3) * 4 + (c >> 5)) * 512 + ((kk & 7) * 32 + (c & 31)) * 2; }
__device__ __forceinline__ int v_rd_base(int lane) { return ((lane & 3) << 3) | (((lane >> 2) & 3) << 6) | (((lane >> 4) & 1) << 5) | (((lane >> 5) & 1) << 8); }
__device__ __forceinline__ int crow(int r, int hi) { return (r & 3) + 8 * (r >> 2) + 4 * hi; }
__device__ __forceinline__ unsigned cvtpk(float lo, float hi) { unsigned r; asm volatile("v_cvt_pk_bf16_f32 %0, %1, %2" : "=v"(r) : "v"(lo), "v"(hi)); return r; }

template <int DK, bool FOX>
__device__ __forceinline__ void attn_block(unsigned char* smem, const bf16_t* __restrict__ Q, int ldq, const bf16_t* __restrict__ K, int ldk, const bf16_t* __restrict__ V, int ldv,
                                           const float* __restrict__ Fh, const bf16_t* __restrict__ gate, bf16_t* __restrict__ gout  , int qbk, float qk_bound  ) {
    typedef Lay<DK> LY;
    constexpr int ND = DK / 16, NKC = DK / 8, NKI = (64 * NKC) / 512;
    int tid = threadIdx.x; asm volatile("" : "+v"(tid));
    const int wid = __builtin_amdgcn_readfirstlane(tid >> 6), lane = tid & 63, r32 = lane & 31, hi = lane >> 5;
    const int q0 = qbk * 256, qlo = q0 + wid * 32, qm = qlo + r32 - 4 * hi;
    const int NT = 4 * qbk + 4;
    ALAS unsigned char* lds = (ALAS unsigned char*)smem;
    ALAS float* F_lds = (ALAS float*)(lds + LY::OFF_F);
    ALAS float* wsl = (ALAS float*)(lds + LY::OFF_WS) + wid * 64;
    bf16x8 qr[ND];
#pragma unroll
    for (int d0 = 0; d0 < ND; ++d0) qr[d0] = *(const bf16x8*)(Q + (size_t)(qlo + r32) * ldq + d0 * 16 + hi * 8);
    const float fq = FOX ? Fh[qlo + r32] : 0.f;
    int kgo[NKI], klo[NKI];
#pragma unroll
    for (int i = 0; i < NKI; ++i) { const int idx = tid + 512 * i, row = idx / NKC, ch = idx % NKC; kgo[i] = row * ldk + ch * 8; klo[i] = row * LY::ROWB + ((ch ^ ((row >> 1) & 7)) << 4); }
    const int sr = tid >> 4, sc = (tid & 15) * 8, vst0 = v_st(sr, sc), vst1 = v_st(32 + sr, sc);
    const int vgo0 = sr * ldv + sc, vgo1 = (32 + sr) * ldv + sc;
    const int vb0 = (int)(uintptr_t)smem + v_rd_base(lane);
    int kbase[4];
#pragma unroll
    for (int dd = 0; dd < 4; ++dd) kbase[dd] = LY::OFF_K + r32 * LY::ROWB + (((((dd << 1) | hi) ^ ((r32 >> 1) & 7))) << 4);
    bf16x8 stk[NKI], stv0, stv1; float stf = 0.f;
#define ATT_LOAD(kb) do { _Pragma("unroll") for (int i = 0; i < NKI; ++i) stk[i] = *(const bf16x8*)(K + (size_t)(kb) * ldk + kgo[i]); \
        stv0 = *(const bf16x8*)(V + (size_t)(kb) * ldv + vgo0); stv1 = *(const bf16x8*)(V + (size_t)(kb) * ldv + vgo1); if (FOX && tid < 64) stf = Fh[(kb) + tid]; } while (0)
#define ATT_WRITE(bf) do { _Pragma("unroll") for (int i = 0; i < NKI; ++i) *(ALAS bf16x8*)(lds + LY::OFF_K + (bf) * LY::SHM_K + klo[i]) = stk[i]; \
        *(ALAS bf16x8*)(lds + (bf) * SHM_V + vst0) = stv0; *(ALAS bf16x8*)(lds + (bf) * SHM_V + vst1) = stv1; if (FOX && tid < 64) F_lds[(bf) * 64 + tid] = stf; } while (0)
    int t_start = 0;
    if (FOX) { const float thr = 2.02f * qk_bound + 40.f, f0 = Fh[q0];
        const int j0 = lane, j1 = lane + 64;
        const bool c0 = (j0 < 4 * qbk) && (Fh[j0 * 64 + 63] - f0 >= thr), c1 = (j1 < 4 * qbk) && (Fh[(j1 < 4 * qbk ? j1 : 0) * 64 + 63] - f0 >= thr);
        t_start = __builtin_popcountll(__ballot(c0)) + __builtin_popcountll(__ballot(c1));
        t_start = __builtin_amdgcn_readfirstlane(t_start); }
    ATT_LOAD(t_start * 64); ATT_WRITE(t_start & 1);
    float m_reg = -1e30f, l_reg = 0.f; f32x16 o[4];
#pragma unroll
    for (int d = 0; d < 4; ++d)
#pragma unroll
        for (int r = 0; r < 16; ++r) o[d][r] = 0.f;
    for (int t = t_start; t < NT; ++t) {
        const int buf = t & 1, kb = t * 64;
        __syncthreads();
        if (t + 1 < NT) ATT_LOAD(kb + 64);
        f32x16 p0, p1;
        if (FOX) {
#pragma unroll
            for (int g = 0; g < 4; ++g) { const f32x4 f0 = *(const ALAS f32x4*)(F_lds + buf * 64 + 8 * g + 4 * hi), f1 = *(const ALAS f32x4*)(F_lds + buf * 64 + 32 + 8 * g + 4 * hi);
#pragma unroll
                for (int e = 0; e < 4; ++e) { p0[4 * g + e] = fq - f0[e]; p1[4 * g + e] = fq - f1[e]; } }
        } else {
#pragma unroll
            for (int r = 0; r < 16; ++r) { p0[r] = 0.f; p1[r] = 0.f; }
        }
#pragma unroll
        for (int d0 = 0; d0 < ND; ++d0) {
            ALAS const unsigned char* a = lds + buf * LY::SHM_K + kbase[d0 & 3] + (d0 >> 2) * 128;
            const bf16x8 b0 = *(const ALAS bf16x8*)a;
            const bf16x8 b1 = *(const ALAS bf16x8*)(a + 32 * LY::ROWB);
            p0 = __builtin_amdgcn_mfma_f32_32x32x16_bf16(b0, qr[d0], p0, 0, 0, 0);
            p1 = __builtin_amdgcn_mfma_f32_32x32x16_bf16(b1, qr[d0], p1, 0, 0, 0);
        }
        if (kb + 63 > qlo) {
            const float NEG = -__builtin_inff(); const int dq = qm - kb;
#pragma unroll
            for (int r = 0; r < 16; ++r) { const int c = (r & 3) + 8 * (r >> 2); if (dq - c < 0) p0[r] = NEG; if (dq - c - 32 < 0) p1[r] = NEG; }
        }
        float pmax = p0[0];
#pragma unroll
        for (int r = 1; r < 16; ++r) pmax = fmaxf(pmax, p0[r]);
#pragma unroll
        for (int r = 0; r < 16; ++r) pmax = fmaxf(pmax, p1[r]);
        { auto rr = __builtin_amdgcn_permlane32_swap(__float_as_uint(pmax), __float_as_uint(pmax), false, false);
          pmax = fmaxf(__uint_as_float(rr[0]), __uint_as_float(rr[1])); }
        const float mn = fmaxf(m_reg, pmax);
        const float alpha = __builtin_amdgcn_exp2f(m_reg - mn);
        m_reg = mn;
        float ps = 0.f;
#pragma unroll
        for (int r = 0; r < 16; ++r) { p0[r] = __builtin_amdgcn_exp2f(p0[r] - mn); ps += p0[r]; }
#pragma unroll
        for (int r = 0; r < 16; ++r) { p1[r] = __builtin_amdgcn_exp2f(p1[r] - mn); ps += p1[r]; }
        { auto rr = __builtin_amdgcn_permlane32_swap(__float_as_uint(ps), __float_as_uint(ps), false, false);
          ps = __uint_as_float(rr[0]) + __uint_as_float(rr[1]); }
        l_reg = l_reg * alpha + ps;
        bf16x8 pa0, pa1, pa2, pa3;
#define ATT_PK4(P, B_, OUT) do { unsigned a0 = cvtpk(P[B_+0], P[B_+1]), a1 = cvtpk(P[B_+2], P[B_+3]); unsigned b0_ = cvtpk(P[B_+4], P[B_+5]), b1_ = cvtpk(P[B_+6], P[B_+7]); \
        auto r0 = __builtin_amdgcn_permlane32_swap(a0, b0_, false, false); auto r1 = __builtin_amdgcn_permlane32_swap(a1, b1_, false, false); \
        u32x4 w = {r0[0], r1[0], r0[1], r1[1]}; OUT = *reinterpret_cast<bf16x8*>(&w); } while (0)
        ATT_PK4(p0, 0, pa0); ATT_PK4(p0, 8, pa1); ATT_PK4(p1, 0, pa2); ATT_PK4(p1, 8, pa3);
        if (__any(alpha < 1.f)) {
            if (hi == 0) wsl[r32] = alpha;
            asm volatile("s_waitcnt lgkmcnt(0)" ::: "memory");
#pragma unroll
            for (int g = 0; g < 4; ++g) { const f32x4 al = *(const ALAS f32x4*)(wsl + 8 * g + 4 * hi);
#pragma unroll
                for (int d = 0; d < 4; ++d)
#pragma unroll
                    for (int e = 0; e < 4; ++e) o[d][4 * g + e] *= al[e]; }
        }
#define ATT_TRRD(dst, off) asm volatile("ds_read_b64_tr_b16 %0, %1 offset:%2" : "=&v"(dst) : "v"(vbb), "i"(off) : "memory")
#define ATT_PV(d0) do { s16x4 l0, l1, l2, l3, h0, h1, h2, h3; constexpr int b_ = (d0) * 512; \
        ATT_TRRD(l0, b_); ATT_TRRD(h0, b_ + 2048); ATT_TRRD(l1, b_ + 4096); ATT_TRRD(h1, b_ + 6144); ATT_TRRD(l2, b_ + 8192); ATT_TRRD(h2, b_ + 10240); ATT_TRRD(l3, b_ + 12288); ATT_TRRD(h3, b_ + 14336); \
        asm volatile("s_waitcnt lgkmcnt(0)" ::: "memory"); ASBAR(); \
        o[d0] = __builtin_amdgcn_mfma_f32_32x32x16_bf16(pa0, (bf16x8){l0[0], l0[1], l0[2], l0[3], h0[0], h0[1], h0[2], h0[3]}, o[d0], 0, 0, 0); \
        o[d0] = __builtin_amdgcn_mfma_f32_32x32x16_bf16(pa1, (bf16x8){l1[0], l1[1], l1[2], l1[3], h1[0], h1[1], h1[2], h1[3]}, o[d0], 0, 0, 0); \
        o[d0] = __builtin_amdgcn_mfma_f32_32x32x16_bf16(pa2, (bf16x8){l2[0], l2[1], l2[2], l2[3], h2[0], h2[1], h2[2], h2[3]}, o[d0], 0, 0, 0); \
        o[d0] = __builtin_amdgcn_mfma_f32_32x32x16_bf16(pa3, (bf16x8){l3[0], l3[1], l3[2], l3[3], h3[0], h3[1], h3[2], h3[3]}, o[d0], 0, 0, 0); } while (0)
        { const int vbb = vb0 + buf * SHM_V; ATT_PV(0); ATT_PV(1); ATT_PV(2); ATT_PV(3); }
        if (t + 1 < NT) ATT_WRITE(buf ^ 1);
    }
    if (hi == 0) wsl[r32] = l_reg;
    asm volatile("s_waitcnt lgkmcnt(0)" ::: "memory");
#pragma unroll
    for (int r = 0; r < 16; ++r) {
        const int orow = crow(r, hi); const float rli = __builtin_amdgcn_rcpf(wsl[orow]);
        bf16_t* rowp = gout + (size_t)(qlo + orow) * 4096; const bf16_t* growp = gate + (size_t)(qlo + orow) * 4096;
#pragma unroll
        for (int d0 = 0; d0 < 4; ++d0) {
            const float v = o[d0][r] * rli; const float vn = __shfl_xor(v, 1);
            if ((r32 & 1) == 0) { unsigned* gp = (unsigned*)(rowp + d0 * 32 + r32); const unsigned g = *(const unsigned*)(growp + d0 * 32 + r32);
                *gp = cvtpk(v * __uint_as_float(g << 16), vn * __uint_as_float(g & 0xffff0000u)); }
        }
    }
    __syncthreads();
#undef ATT_LOAD
#undef ATT_WRITE
#undef ATT_PK4
#undef ATT_TRRD
#undef ATT_PV
}
}
using pg8::bf16_t; using pg8::f32x4; using pg8::u32x4;
#define LAS __attribute__((address_space(3)))
constexpr int S = 8192, DM = 2048, INW = 11344, INWP = 11520;
constexpr float EPS = 1e-6f;
constexpr size_t MiB = 1u << 20;

__device__ __forceinline__ float bf2f(bf16_t v) { return __uint_as_float(((unsigned)v) << 16); }
__device__ __forceinline__ bf16_t f2bf(float f) { unsigned u = __float_as_uint(f); u += 0x7fffu + ((u >> 16) & 1u); return (bf16_t)(u >> 16); }
__device__ __forceinline__ unsigned pk2(float lo, float hi) { return (unsigned)f2bf(lo) | ((unsigned)f2bf(hi) << 16); }
__device__ __forceinline__ float wave_sum(float v) {
#pragma unroll
    for (int o = 32; o >= 1; o >>= 1) v += __shfl_xor(v, o);
    return v;
}
__device__ __forceinline__ float wave_max(float v) {
#pragma unroll
    for (int o = 32; o >= 1; o >>= 1) v = fmaxf(v, __shfl_xor(v, o));
    return v;
}

__device__ __forceinline__ int opaque_tid() { int t = threadIdx.x; asm volatile("" : "+v"(t)); return t; }

struct Params {
    const float* x; const int* pos; const float *mix_g, *w_in, *b_forget, *b_gate, *q_lat_g, *w_q_up, *kv_lat_g, *w_kv_up, *mla_qg, *mla_kg, *fox_qg, *fox_kg, *w_out, *ffn_g, *w_peer_q, *sub_keys, *peer_u, *peer_v;
    float* out;
    bf16_t *WqT, *WkvT, *WoT, *WpT, *WinT;
    bf16_t *h, *cq, *ckv, *fq, *fk, *fv, *merged, *kpe, *qa, *kvraw, *ka;
    float *lf, *F, *x1, *scores;
    bf16_t *U16, *V16, *attout;
    unsigned* ctl;
    float *qn, *kn, *kall, *qmaxB;
};

struct DstId { __device__ __forceinline__ int operator()(int n) const { return n; } };
struct DstWin { __device__ __forceinline__ int operator()(int n) const {
    if (n < 1024) return n; if (n < 1088) return 11264 + (n - 1024); if (n < 7232) return n - 64; if (n < 7248) return 11264 + 64 + (n - 7232); return n - 80; } };
template <class Dst>
__device__ __forceinline__ void transpose_item(const float* __restrict__ W, int K, int N, bf16_t* __restrict__ WT, Dst dst, float* scr, int item, int lane) {
    const int nblk = (N + 31) / 32, kb = item / nblk, nb = item % nblk, k0 = 64 * kb, n0 = 32 * nb;
    { const int n = n0 + (lane & 31);
#pragma unroll 8
      for (int i = 0; i < 32; ++i) { const int kk = 2 * i + (lane >> 5); scr[kk * 33 + (lane & 31)] = (n < N) ? W[(size_t)(k0 + kk) * N + n] : 0.f; } }
    asm volatile("s_waitcnt lgkmcnt(0)" ::: "memory");
    const int c = lane & 7;
#pragma unroll
    for (int j = 0; j < 4; ++j) { const int nl = (lane >> 3) + 8 * j, n = n0 + nl; const float* s = scr + (8 * c) * 33 + nl;
        u32x4 o; o.x = pk2(s[0 * 33], s[1 * 33]); o.y = pk2(s[2 * 33], s[3 * 33]); o.z = pk2(s[4 * 33], s[5 * 33]); o.w = pk2(s[6 * 33], s[7 * 33]);
        if (n < N) *(u32x4*)(WT + (size_t)dst(n) * K + k0 + 8 * c) = o; }
    asm volatile("s_waitcnt lgkmcnt(0)" ::: "memory");
}
__device__ __forceinline__ void wfold_item(const float* __restrict__ wq, const float* __restrict__ keys, bf16_t* __restrict__ WpT, float* sm, int item) {
    const int tid = opaque_tid(), hc = item >> 5, d0 = (item & 31) * 64;
    float* keysL = sm; float* wqL = sm + 128 * 129;
    for (int idx = tid; idx < 128 * 128; idx += 512) keysL[(idx >> 7) * 129 + (idx & 127)] = keys[(size_t)hc * 16384 + idx];
    for (int idx = tid; idx < 64 * 128; idx += 512) wqL[(idx >> 7) * 129 + (idx & 127)] = wq[(size_t)(d0 + (idx >> 7)) * 2048 + hc * 128 + (idx & 127)];
    __syncthreads();
    const int n = tid & 127, dq = tid >> 7;
    float acc[16];
#pragma unroll
    for (int i = 0; i < 16; ++i) acc[i] = 0.f;
    for (int j = 0; j < 128; ++j) { const float kv = keysL[n * 129 + j];
#pragma unroll
        for (int i = 0; i < 16; ++i) acc[i] += kv * wqL[(dq * 16 + i) * 129 + j]; }
    u32x4 o0, o1;
    o0.x = pk2(acc[0], acc[1]); o0.y = pk2(acc[2], acc[3]); o0.z = pk2(acc[4], acc[5]); o0.w = pk2(acc[6], acc[7]);
    o1.x = pk2(acc[8], acc[9]); o1.y = pk2(acc[10], acc[11]); o1.z = pk2(acc[12], acc[13]); o1.w = pk2(acc[14], acc[15]);
    bf16_t* dstp = WpT + (size_t)(hc * 128 + n) * 2048 + d0 + dq * 16;
    *(u32x4*)dstp = o0; *(u32x4*)(dstp + 8) = o1;
    __syncthreads();
}
__device__ __forceinline__ void rms_row2048(const float* __restrict__ xr, const float* __restrict__ g, bf16_t* __restrict__ orow, int lane) {
    f32x4 v[8]; float ss = 0.f;
#pragma unroll
    for (int j = 0; j < 8; ++j) { v[j] = *(const f32x4*)(xr + j * 256 + lane * 4); ss += (v[j][0] * v[j][0] + v[j][1] * v[j][1]) + (v[j][2] * v[j][2] + v[j][3] * v[j][3]); }
    const float r = rsqrtf(wave_sum(ss) * (1.f / 2048.f) + EPS);
#pragma unroll
    for (int j = 0; j < 8; ++j) { const f32x4 gg = *(const f32x4*)(g + j * 256 + lane * 4);
        uint2 o; o.x = pk2(v[j][0] * r * gg[0], v[j][1] * r * gg[1]); o.y = pk2(v[j][2] * r * gg[2], v[j][3] * r * gg[3]);
        *(uint2*)(orow + j * 256 + lane * 4) = o; }
}
__device__ __forceinline__ void rms_row512_inplace(bf16_t* __restrict__ row, const float* __restrict__ g, int lane) {
    u32x4 w = *(const u32x4*)(row + lane * 8); float v[8];
#pragma unroll
    for (int i = 0; i < 4; ++i) { v[2 * i] = __uint_as_float(w[i] << 16); v[2 * i + 1] = __uint_as_float(w[i] & 0xffff0000u); }
    float ss = 0.f;
#pragma unroll
    for (int i = 0; i < 8; ++i) ss += v[i] * v[i];
    const float r = rsqrtf(wave_sum(ss) * (1.f / 512.f) + EPS);
    u32x4 o;
#pragma unroll
    for (int i = 0; i < 4; ++i) o[i] = pk2(v[2 * i] * r * g[lane * 8 + 2 * i], v[2 * i + 1] * r * g[lane * 8 + 2 * i + 1]);
    *(u32x4*)(row + lane * 8) = o;
}
__device__ __forceinline__ void fox_prep(int w, bf16_t* __restrict__ fq, bf16_t* __restrict__ fk, const float* __restrict__ gq, const float* __restrict__ gk,
                                         float* __restrict__ qn, float* __restrict__ kn, int lane) {
    const int t = w >> 4, h = w & 15;
#pragma unroll
    for (int which = 0; which < 2; ++which) {
        bf16_t* p = (which ? fk : fq) + (size_t)t * 2048 + h * 128; const float* g = which ? gk : gq;
        const float v0 = bf2f(p[lane]), v1 = bf2f(p[lane + 64]);
        const float r = rsqrtf(wave_sum(v0 * v0 + v1 * v1) * (1.f / 128.f) + EPS);
        const float qs = which ? 1.f : 0.12751743f;
        const float o0 = v0 * r * g[lane] * qs, o1 = v1 * r * g[lane + 64] * qs;
        p[lane] = f2bf(o0); p[lane + 64] = f2bf(o1);
        const float nn = sqrtf(wave_sum(o0 * o0 + o1 * o1));
        if (lane == 0) (which ? kn : qn)[(size_t)h * S + t] = nn;
    }
}
__device__ __forceinline__ void fox_stats(float* red, int h, const float* __restrict__ qn, const float* __restrict__ kn, float* __restrict__ kall, float* __restrict__ qmaxB) {
    const int tid = opaque_tid(), lane = tid & 63, wave = tid >> 6;
    float km = 0.f;
    for (int i = tid; i < S; i += 512) km = fmaxf(km, kn[(size_t)h * S + i]);
    km = wave_max(km);
    if (lane == 0) red[wave] = km;
    for (int qb = wave; qb < 32; qb += 8) { float qm = 0.f;
        for (int i = lane; i < 256; i += 64) qm = fmaxf(qm, qn[(size_t)h * S + qb * 256 + i]);
        qm = wave_max(qm); if (lane == 0) qmaxB[h * 32 + qb] = qm; }
    __syncthreads();
    if (tid == 0) { float m = red[0]; for (int i = 1; i < 8; ++i) m = fmaxf(m, red[i]); kall[h] = m; }
    __syncthreads();
}
__device__ __forceinline__ void fox_cumsum(double* part, int h, const float* __restrict__ lf, float* __restrict__ F) {
    const int tid = opaque_tid(); double sum = 0.0;
    for (int i = 0; i < 16; ++i) sum += (double)lf[(size_t)(tid * 16 + i) * 16 + h];
    part[tid] = sum;
    __syncthreads();
    if (tid == 0) { double run = 0.0; for (int i = 0; i < 512; ++i) { const double v = part[i]; part[i] = run; run += v; } }
    __syncthreads();
    double run = part[tid];
    for (int i = 0; i < 16; ++i) { run += (double)lf[(size_t)(tid * 16 + i) * 16 + h]; F[(size_t)h * S + tid * 16 + i] = (float)(run * 1.4426950408889634); }
    __syncthreads();
}
__device__ __forceinline__ void rope_cs(int pos, int i, float& c, float& s) {
    const double inv = exp(-(double)i * (1.0 / 32.0) * 9.210340371976184);
    double ang = (double)((float)pos * (float)inv);
    const double twopi = 6.283185307179586;
    ang -= twopi * rint(ang / twopi);
    c = cosf((float)ang); s = sinf((float)ang);
}
__device__ __forceinline__ void mla_prep(int w, bf16_t* __restrict__ qa, const bf16_t* __restrict__ kvraw, const bf16_t* __restrict__ kpe, const int* __restrict__ pos,
                                         const float* __restrict__ gq, const float* __restrict__ gk, bf16_t* __restrict__ ka, int lane) {
    const int t = w >> 4, h = w & 15;
    float c, s; rope_cs(pos[t], lane & 31, c, s);
    {
        bf16_t* q = qa + (size_t)t * 3072 + h * 192;
        float v0 = bf2f(q[lane]), v1 = bf2f(q[lane + 64]), v2 = bf2f(q[lane + 128]);
        const float r = rsqrtf(wave_sum(v0 * v0 + v1 * v1 + v2 * v2) * (1.f / 192.f) + EPS);
        v0 *= r * gq[lane]; v1 *= r * gq[lane + 64]; v2 *= r * gq[lane + 128];
        const float o = __shfl_xor(v2, 32);
        const float rr = lane < 32 ? v2 * c - o * s : o * s + v2 * c;
        q[lane] = f2bf(v0 * 0.10411754f); q[lane + 64] = f2bf(v1 * 0.10411754f); q[lane + 128] = f2bf(rr * 0.10411754f);
    }
    {
        const bf16_t* kn = kvraw + (size_t)t * 4096 + h * 256;
        float v0 = bf2f(kn[lane]), v1 = bf2f(kn[lane + 64]), v2 = bf2f(kpe[(size_t)t * 64 + lane]);
        const float r = rsqrtf(wave_sum(v0 * v0 + v1 * v1 + v2 * v2) * (1.f / 192.f) + EPS);
        v0 *= r * gk[lane]; v1 *= r * gk[lane + 64]; v2 *= r * gk[lane + 128];
        const float o = __shfl_xor(v2, 32);
        const float rr = lane < 32 ? v2 * c - o * s : o * s + v2 * c;
        bf16_t* k = ka + (size_t)t * 3072 + h * 192;
        k[lane] = f2bf(v0); k[lane + 64] = f2bf(v1); k[lane + 128] = f2bf(rr);
    }
}

__device__ __forceinline__ void cvt_rows_bf16(const float* __restrict__ src, bf16_t* __restrict__ dst, size_t n, int gw, int NGW, int lane) {
    const size_t nchunk = n / 512;
    for (size_t c = gw; c < nchunk; c += NGW) { const size_t o = c * 512 + lane * 8;
        const f32x4 a = *(const f32x4*)(src + o), b2 = *(const f32x4*)(src + o + 4);
        u32x4 w; w.x = pk2(a[0], a[1]); w.y = pk2(a[2], a[3]); w.z = pk2(b2[0], b2[1]); w.w = pk2(b2[2], b2[3]);
        *(u32x4*)(dst + o) = w; }
}
typedef __bf16 bf16x2_t __attribute__((ext_vector_type(2)));
__device__ __forceinline__ float dot2bf(unsigned a, unsigned b, float c) { return __builtin_amdgcn_fdot2_f32_bf16(__builtin_bit_cast(bf16x2_t, a), __builtin_bit_cast(bf16x2_t, b), c, false); }
#define PEER_INS(top, x) do { float x_ = (x); _Pragma("unroll") for (int i_ = 0; i_ < 16; ++i_) { const float hi_ = fmaxf(top[i_], x_); x_ = fminf(top[i_], x_); top[i_] = hi_; } } while (0)
__device__ __forceinline__ void peer_group(unsigned char* smem, int g, const float* __restrict__ scores, const bf16_t* __restrict__ h2, const float* __restrict__ x1,
                                           const bf16_t* __restrict__ U16, const bf16_t* __restrict__ V16, float* __restrict__ out) {
    const int tid = opaque_tid(), lane = tid & 63, wave = __builtin_amdgcn_readfirstlane(tid >> 6);
    float* topL = (float*)smem;
    int* selE = (int*)(smem + 32768);
    float* selG = (float*)(smem + 49152);
    {
        const int tl = tid >> 4, hc = tid & 15;
        const float* sp = scores + (size_t)(g * 32 + tl) * 2048 + hc * 128;
        float top[16];
#pragma unroll
        for (int i = 0; i < 16; ++i) top[i] = -INFINITY;
#pragma unroll 2
        for (int n0 = 0; n0 < 128; n0 += 4) { const f32x4 v = *(const f32x4*)(sp + n0);
#pragma unroll
            for (int e = 0; e < 4; ++e) PEER_INS(top, __uint_as_float((__float_as_uint(v[e]) & ~0x7Fu) | (unsigned)(n0 + e))); }
        float* tp = topL + (tl * 16 + hc) * 16;
#pragma unroll
        for (int i = 0; i < 16; i += 4) *(f32x4*)(tp + i) = (f32x4){top[i], top[i + 1], top[i + 2], top[i + 3]};
    }
    __syncthreads();
    if (tid < 256) {
        const int tl = tid >> 3, h = tid & 7;
        const float* t1 = topL + (tl * 16 + 2 * h) * 16; const float* t2 = t1 + 16;
        float s1[16], s2[16];
#pragma unroll
        for (int i = 0; i < 16; i += 4) { const f32x4 a = *(const f32x4*)(t1 + i), b2 = *(const f32x4*)(t2 + i);
            s1[i] = a[0]; s1[i + 1] = a[1]; s1[i + 2] = a[2]; s1[i + 3] = a[3]; s2[i] = b2[0]; s2[i + 1] = b2[1]; s2[i + 2] = b2[2]; s2[i + 3] = b2[3]; }
        float ts[16];
#pragma unroll
        for (int i = 0; i < 16; ++i) ts[i] = -INFINITY;
#pragma unroll
        for (int i = 0; i < 16; ++i)
#pragma unroll
            for (int j = 0; j < 16; ++j)
                if ((i + 1) * (j + 1) <= 16) PEER_INS(ts, __uint_as_float((__float_as_uint(s1[i] + s2[j]) & ~0xFFu) | (unsigned)(i * 16 + j)));
        float ex[16], sum = 0.f;
#pragma unroll
        for (int k = 0; k < 16; ++k) { ex[k] = __expf(ts[k] - ts[0]); sum += ex[k]; }
        const float inv = 1.f / sum;
#pragma unroll
        for (int k = 0; k < 16; ++k) { const unsigned pos = __float_as_uint(ts[k]) & 0xFFu;
            const int i1 = (int)(__float_as_uint(t1[pos >> 4]) & 0x7Fu), i2 = (int)(__float_as_uint(t2[pos & 15]) & 0x7Fu);
            selE[tl * 128 + h * 16 + k] = i1 * 128 + i2; selG[tl * 128 + h * 16 + k] = ex[k] * inv; }
    }
    __syncthreads();
    for (int ti = 0; ti < 4; ++ti) {
        const int tl = wave * 4 + ti; const size_t t = (size_t)g * 32 + tl;
        u32x4 hq[4];
#pragma unroll
        for (int j = 0; j < 4; ++j) hq[j] = *(const u32x4*)(h2 + t * DM + j * 512 + lane * 8);
        float acc[32];
#pragma unroll
        for (int i = 0; i < 32; ++i) acc[i] = 0.f;
        for (int bb = 0; bb < 32; ++bb) {
            int e[4]; float gt[4];
#pragma unroll
            for (int q = 0; q < 4; ++q) { e[q] = __builtin_amdgcn_readfirstlane(selE[tl * 128 + bb * 4 + q]); gt[q] = selG[tl * 128 + bb * 4 + q]; }
            u32x4 ur[4][4], vr[4][4];
#pragma unroll
            for (int q = 0; q < 4; ++q)
#pragma unroll
                for (int j = 0; j < 4; ++j) ur[q][j] = *(const u32x4*)(U16 + (size_t)e[q] * DM + j * 512 + lane * 8);
#pragma unroll
            for (int q = 0; q < 4; ++q)
#pragma unroll
                for (int j = 0; j < 4; ++j) vr[q][j] = *(const u32x4*)(V16 + (size_t)e[q] * DM + j * 512 + lane * 8);
            float d[4];
#pragma unroll
            for (int q = 0; q < 4; ++q) { float a = 0.f;
#pragma unroll
                for (int j = 0; j < 4; ++j)
#pragma unroll
                    for (int c = 0; c < 4; ++c) a = dot2bf(hq[j][c], ur[q][j][c], a);
                d[q] = a; }
            const bool b5 = (lane & 32) != 0, b4 = (lane & 16) != 0;
            const float r0 = __shfl_xor(b5 ? d[0] : d[2], 32), r1 = __shfl_xor(b5 ? d[1] : d[3], 32);
            const float k0 = (b5 ? d[2] : d[0]) + r0, k1 = (b5 ? d[3] : d[1]) + r1;
            float c1 = (b4 ? k1 : k0) + __shfl_xor(b4 ? k0 : k1, 16);
            c1 += __shfl_xor(c1, 8); c1 += __shfl_xor(c1, 4); c1 += __shfl_xor(c1, 2); c1 += __shfl_xor(c1, 1);
#pragma unroll
            for (int q = 0; q < 4; ++q) {
                const float a = __uint_as_float((unsigned)__builtin_amdgcn_readlane((int)__float_as_uint(c1), 16 * q));
                const float w = gt[q] * 0.5f * a * (1.f + erff(a * 0.70710678118654752f));
#pragma unroll
                for (int j = 0; j < 4; ++j)
#pragma unroll
                    for (int c = 0; c < 4; ++c) { const unsigned x = vr[q][j][c];
                        acc[j * 8 + 2 * c] += w * __uint_as_float(x << 16); acc[j * 8 + 2 * c + 1] += w * __uint_as_float(x & 0xffff0000u); }
            }
        }
#pragma unroll
        for (int j = 0; j < 4; ++j) { const size_t o = t * DM + j * 512 + lane * 8;
            const f32x4 a = *(const f32x4*)(x1 + o), b2 = *(const f32x4*)(x1 + o + 4);
            *(f32x4*)(out + o) = (f32x4){a[0] + acc[j * 8], a[1] + acc[j * 8 + 1], a[2] + acc[j * 8 + 2], a[3] + acc[j * 8 + 3]};
            *(f32x4*)(out + o + 4) = (f32x4){b2[0] + acc[j * 8 + 4], b2[1] + acc[j * 8 + 5], b2[2] + acc[j * 8 + 6], b2[3] + acc[j * 8 + 7]}; }
    }
    __syncthreads();
}

#define XB_TMO      128
#define XB_XCNT(j)  (256  + 64 * (j))
#define XB_XSUB(j)  (1280 + 64 * (j))
#define XB_XGEN(j)  (2304 + 64 * (j))
#define XB_TOP      3328
#define XB_TOPGEN   3392
#define XCD_BAR_WORDS 3456
#define XB_SPIN_CAP (1u << 18)

__device__ __forceinline__ unsigned xb_ld(unsigned* p)              { return __hip_atomic_load(p, __ATOMIC_RELAXED, __HIP_MEMORY_SCOPE_AGENT); }
__device__ __forceinline__ unsigned xb_add(unsigned* p, unsigned v) { return __hip_atomic_fetch_add(p, v, __ATOMIC_RELAXED, __HIP_MEMORY_SCOPE_AGENT); }
__device__ __forceinline__ unsigned xb_xcc_id() { return (unsigned)__builtin_amdgcn_s_getreg((3 << 11) | 20) & 0xFu; }
#define XB_SPIN(cond, bar) do { unsigned _sp = 0; while (cond) { __builtin_amdgcn_s_sleep(1); \
    if ((++_sp & 255u) == 0u) { if (xb_ld(&(bar)[XB_TMO])) break; if (_sp > XB_SPIN_CAP) { atomicAdd(&(bar)[XB_TMO], 1u); break; } } } } while (0)

struct XcdBarrier {
    unsigned* bar; unsigned x;
    volatile LAS unsigned* st;
};

__device__ __forceinline__ XcdBarrier xcd_barrier_post(unsigned* bar, volatile LAS unsigned* st) {
    XcdBarrier b; b.bar = bar; b.x = xb_xcc_id(); b.st = st;
    if (threadIdx.x == 0) (void)xb_add(&bar[XB_XCNT(b.x)], 1u);
    return b;
}
__device__ __forceinline__ void xcd_barrier_complete(unsigned* bar, unsigned x, unsigned& nloc, unsigned& nx) {
    const unsigned G = gridDim.x * gridDim.y * gridDim.z;
    unsigned sum, cnt, mine, sp = 0u;
    for (;;) {
        sum = 0u; cnt = 0u; mine = 0u;
#pragma unroll
        for (unsigned j = 0; j < 16; ++j) { const unsigned c = xb_ld(&bar[XB_XCNT(j)]); sum += c; cnt += (c > 0u) ? 1u : 0u; mine = (j == x) ? c : mine; }
        if (sum == G) break;
        __builtin_amdgcn_s_sleep(1);
        if ((++sp & 255u) == 0u) { if (xb_ld(&bar[XB_TMO])) break; if (sp > XB_SPIN_CAP) { atomicAdd(&bar[XB_TMO], 1u); break; } }
    }
    nloc = mine > 0u ? mine : 1u; nx = cnt > 0u ? cnt : 1u;
}

__device__ __forceinline__ void xcd_barrier(const XcdBarrier& b) {
    asm volatile("s_waitcnt vmcnt(0)" ::: "memory");
    __syncthreads();
    if (threadIdx.x == 0) {
        unsigned* bar = b.bar;
        __builtin_amdgcn_s_waitcnt(0);
        unsigned nloc = b.st[0], nx = b.st[1];
        if (nloc == 0u) { xcd_barrier_complete(bar, b.x, nloc, nx); b.st[0] = nloc; b.st[1] = nx; }
        const unsigned old = xb_add(&bar[XB_XSUB(b.x)], 1u);
        const unsigned gen = old / nloc;
        if (old + 1u == (gen + 1u) * nloc) {
            __builtin_amdgcn_fence(__ATOMIC_RELEASE, "agent");
            asm volatile("s_waitcnt vmcnt(0)" ::: "memory");
            const unsigned og = xb_add(&bar[XB_TOP], 1u);
            const unsigned tg = og / nx;
            if (og + 1u == (tg + 1u) * nx) xb_add(&bar[XB_TOPGEN], 1u);
            else XB_SPIN(xb_ld(&bar[XB_TOPGEN]) == tg, bar);
            __builtin_amdgcn_fence(__ATOMIC_ACQUIRE, "agent");
            xb_add(&bar[XB_XGEN(b.x)], 1u);
            asm volatile("s_waitcnt vmcnt(0)" ::: "memory");
        } else {
            XB_SPIN(xb_ld(&bar[XB_XGEN(b.x)]) == gen, bar);
            __builtin_amdgcn_fence(__ATOMIC_ACQUIRE, "agent");
            asm volatile("s_waitcnt vmcnt(0)" ::: "memory");
        }
    }
    __syncthreads();
}

#define PROBE_DOUBLE 0
#define REP(k) for (int rep_ = 0; rep_ < ((PROBE_DOUBLE == (k)) ? 2 : 1); ++rep_)
constexpr int LDS_BYTES = 147456;
__global__ __launch_bounds__(512, 2) void mega(Params p) {
    extern __shared__ __attribute__((aligned(16))) unsigned char smem[];
    { volatile LAS unsigned* st0 = (volatile LAS unsigned*)((LAS unsigned char*)smem + 131072); if (threadIdx.x < 2) st0[threadIdx.x] = 0u; }
    __syncthreads();
    const XcdBarrier bar = xcd_barrier_post(p.ctl, (volatile LAS unsigned*)((LAS unsigned char*)smem + 131072));
    float* smf = (float*)smem;
    LAS unsigned char* lds = (LAS unsigned char*)smem;
    const int G = gridDim.x, b = blockIdx.x, NGW = G * 8;
#define PHASE_IDS() const int tid = opaque_tid(), lane = tid & 63, wave = __builtin_amdgcn_readfirstlane(tid >> 6), gw = b * 8 + wave; (void)lane; (void)gw

    REP(7) {
        PHASE_IDS();
        float* scr = smf + wave * 4096;
        constexpr int I_IN = 32 * 355, I_Q = 8 * 96, I_KV = 8 * 128, I_O = 64 * 64;
        for (int it = gw; it < I_IN + I_Q + I_KV + I_O; it += NGW) {
            int r = it;
            if (r < I_IN) { transpose_item(p.w_in, 2048, INW, p.WinT, DstWin(), scr, r, lane); continue; } r -= I_IN;
            if (r < I_Q) { transpose_item(p.w_q_up, 512, 3072, p.WqT, DstId(), scr, r, lane); continue; } r -= I_Q;
            if (r < I_KV) { transpose_item(p.w_kv_up, 512, 4096, p.WkvT, DstId(), scr, r, lane); continue; } r -= I_KV;
            transpose_item(p.w_out, 4096, 2048, p.WoT, DstId(), scr, r, lane);
        }
        for (int m = gw; m < S; m += NGW) rms_row2048(p.x + (size_t)m * DM, p.mix_g, p.h + (size_t)m * DM, lane);
        __syncthreads();
        for (int it = b; it < 512; it += G) wfold_item(p.w_peer_q, p.sub_keys, p.WpT, smf, it);
    }
    xcd_barrier(bar);
    REP(1) {
        pg8::Gemm g{p.h, p.WinT, S, INWP, DM}; pg8::StaticOrder so; so.init(S, INWP, G, b);
        pg8::EpiInProj E{p.cq, p.ckv, p.fq, p.fk, p.fv, p.merged, p.kpe, p.lf, p.b_gate, p.b_forget};
        pg8::gemm_phase<pg8::EpiInProj, pg8::StaticOrder, true, true>(lds, g, so, E);
    }
    xcd_barrier(bar);
    {
    PHASE_IDS();
    for (int t = gw; t < S; t += NGW) { rms_row512_inplace(p.cq + (size_t)t * 512, p.q_lat_g, lane); rms_row512_inplace(p.ckv + (size_t)t * 512, p.kv_lat_g, lane); }
    for (int w = gw; w < S * 16; w += NGW) fox_prep(w, p.fq, p.fk, p.fox_qg, p.fox_kg, p.qn, p.kn, lane);
    for (int hh = b; hh < 16; hh += G) fox_cumsum((double*)smem, hh, p.lf, p.F);
    }
    xcd_barrier(bar);
    REP(2) {
        pg8::Gemm g{p.cq, p.WqT, S, 3072, 512}; pg8::StaticOrder so; so.init(S, 3072, G, b);
        pg8::EpiStoreBf16 E{p.qa, 3072};
        pg8::gemm_phase<pg8::EpiStoreBf16, pg8::StaticOrder, true, true>(lds, g, so, E);
    }
    {
        pg8::Gemm g{p.ckv, p.WkvT, S, 4096, 512}; pg8::StaticOrder so; so.init(S, 4096, G, b);
        pg8::EpiStoreBf16 E{p.kvraw, 4096};
        pg8::gemm_phase<pg8::EpiStoreBf16, pg8::StaticOrder, true, true>(lds, g, so, E);
    }
    xcd_barrier(bar);
    for (int hh = b; hh < 16; hh += G) fox_stats(smf, hh, p.qn, p.kn, p.kall, p.qmaxB);
    { PHASE_IDS(); for (int w = gw; w < S * 16; w += NGW) mla_prep(w, p.qa, p.kvraw, p.kpe, p.pos, p.mla_qg, p.mla_kg, p.ka, lane); }
    xcd_barrier(bar);
    REP(3) for (int L = b; L < 1024; L += G) {
        const int i = L >> 8, vc = L & 255, vcx = (vc & 7) * 32 + (vc >> 3), hh = vcx >> 4, x = vcx & 15, qbk = (i & 1) ? x : 31 - x;
        if (i < 2) att::attn_block<192, false>(smem, p.qa + hh * 192, 3072, p.ka + hh * 192, 3072, p.kvraw + hh * 256 + 128, 4096, nullptr, p.merged + hh * 128, p.attout + hh * 128, qbk, 0.f);
        else att::attn_block<128, true>(smem, p.fq + hh * 128, 2048, p.fk + hh * 128, 2048, p.fv + hh * 128, 2048, p.F + (size_t)hh * S, p.merged + 2048 + hh * 128, p.attout + 2048 + hh * 128, qbk, p.kall[hh] * p.qmaxB[hh * 32 + qbk]);
    }
    xcd_barrier(bar);
    REP(4) {
        pg8::Gemm g{p.attout, p.WoT, S, 2048, 4096}; pg8::StaticOrder so; so.init(S, 2048, G, b);
        pg8::EpiStoreF32<true> E{p.x1, p.x, 2048};
        pg8::gemm_phase<pg8::EpiStoreF32<true>, pg8::StaticOrder, true, true>(lds, g, so, E);
    }
    xcd_barrier(bar);
    { PHASE_IDS(); for (int m = gw; m < S; m += NGW) rms_row2048(p.x1 + (size_t)m * DM, p.ffn_g, p.h + (size_t)m * DM, lane);
      cvt_rows_bf16(p.peer_u, p.U16, (size_t)16384 * 2048, gw, NGW, lane); cvt_rows_bf16(p.peer_v, p.V16, (size_t)16384 * 2048, gw, NGW, lane); }
    xcd_barrier(bar);
    REP(5) {
        pg8::Gemm g{p.h, p.WpT, S, 2048, 2048}; pg8::StaticOrder so; so.init(S, 2048, G, b);
        pg8::EpiStoreF32<false> E{p.scores, nullptr, 2048};
        pg8::gemm_phase<pg8::EpiStoreF32<false>, pg8::StaticOrder, true, true>(lds, g, so, E);
    }
    xcd_barrier(bar);
    REP(6) for (int g = b; g < S / 32; g += G) peer_group(smem, g, p.scores, p.h, p.x1, p.U16, p.V16, p.out);
}

extern "C" void kernel_launch(void* const* d_in, const int* in_sizes, int n_in,
                              void* d_out, int out_size, void* d_ws, size_t ws_size,
                              hipStream_t stream) {
    if (ws_size < 512 * MiB) { fprintf(stderr, "kernel_launch: workspace too small (%zu)\n", ws_size); return; }
    Params p{};
    p.x = (const float*)d_in[0]; p.pos = (const int*)d_in[1]; p.mix_g = (const float*)d_in[2]; p.w_in = (const float*)d_in[3];
    p.b_forget = (const float*)d_in[4]; p.b_gate = (const float*)d_in[5]; p.q_lat_g = (const float*)d_in[6]; p.w_q_up = (const float*)d_in[7];
    p.kv_lat_g = (const float*)d_in[8]; p.w_kv_up = (const float*)d_in[9]; p.mla_qg = (const float*)d_in[10]; p.mla_kg = (const float*)d_in[11];
    p.fox_qg = (const float*)d_in[12]; p.fox_kg = (const float*)d_in[13]; p.w_out = (const float*)d_in[14]; p.ffn_g = (const float*)d_in[15];
    p.w_peer_q = (const float*)d_in[16]; p.sub_keys = (const float*)d_in[17]; p.peer_u = (const float*)d_in[18]; p.peer_v = (const float*)d_in[19];
    p.out = (float*)d_out;
    char* ws = (char*)d_ws;
    p.WqT = (bf16_t*)(ws + 1 * MiB); p.WkvT = (bf16_t*)(ws + 5 * MiB); p.WoT = (bf16_t*)(ws + 9 * MiB); p.WpT = (bf16_t*)(ws + 25 * MiB); p.WinT = (bf16_t*)(ws + 33 * MiB);
    p.h = (bf16_t*)(ws + 78 * MiB); p.cq = (bf16_t*)(ws + 110 * MiB); p.ckv = (bf16_t*)(ws + 118 * MiB);
    p.fq = (bf16_t*)(ws + 126 * MiB); p.fk = (bf16_t*)(ws + 158 * MiB); p.fv = (bf16_t*)(ws + 190 * MiB); p.merged = (bf16_t*)(ws + 222 * MiB);
    p.kpe = (bf16_t*)(ws + 286 * MiB); p.lf = (float*)(ws + 287 * MiB); p.F = (float*)(ws + 287 * MiB + 512 * 1024);
    p.qa = (bf16_t*)(ws + 288 * MiB); p.kvraw = (bf16_t*)(ws + 336 * MiB); p.ka = (bf16_t*)(ws + 400 * MiB); p.x1 = (float*)(ws + 448 * MiB);
    p.scores = (float*)(ws + 222 * MiB);
    p.ctl = (unsigned*)ws;
    p.qn = (float*)(ws + 4 * MiB); p.kn = (float*)(ws + 4 * MiB + 512 * 1024); p.kall = (float*)(ws + 32 * 1024); p.qmaxB = (float*)(ws + 36 * 1024);
    p.attout = (bf16_t*)(ws + 33 * MiB);
    p.U16 = (bf16_t*)(ws + 126 * MiB); p.V16 = (bf16_t*)(ws + 336 * MiB);

    static int grid_blocks = 0;
    if (!grid_blocks) {
        if (hipFuncSetAttribute((const void*)mega, hipFuncAttributeMaxDynamicSharedMemorySize, LDS_BYTES) != hipSuccess) { fprintf(stderr, "hipFuncSetAttribute failed\n"); return; }
        int dev = 0, cus = 0, per_cu = 0;
        (void)hipGetDevice(&dev);
        (void)hipDeviceGetAttribute(&cus, hipDeviceAttributeMultiprocessorCount, dev);
        (void)hipOccupancyMaxActiveBlocksPerMultiprocessor(&per_cu, (const void*)mega, 512, LDS_BYTES);
        if (per_cu < 1 || cus < 1) { fprintf(stderr, "occupancy query says %d blocks/CU on %d CUs\n", per_cu, cus); return; }
        grid_blocks = cus;
    }
    if (hipMemsetAsync(d_ws, 0, 16384, stream) != hipSuccess) { fprintf(stderr, "memset of the barrier words failed\n"); return; }
    void* args[] = {&p};
    hipError_t e = hipLaunchCooperativeKernel((const void*)mega, dim3(grid_blocks), dim3(512), args, LDS_BYTES, stream);
    if (e != hipSuccess) fprintf(stderr, "cooperative launch failed: %s (grid %d)\n", hipGetErrorString(e), grid_blocks);
}
```

```cpp
#include <hip/hip_runtime.h>
#include <hip/hip_cooperative_groups.h>
#include <stdint.h>
#include <math.h>
#include <cstdio>
namespace cg = cooperative_groups;

namespace pg8 {
#define PG8_LAS __attribute__((address_space(3)))
typedef unsigned short bf16_t;
typedef short bf16x8 __attribute__((ext_vector_type(8)));
typedef float f32x4 __attribute__((ext_vector_type(4)));
typedef unsigned u32x4 __attribute__((ext_vector_type(4)));
constexpr int BM = 256, BK = 64, HALF = 128, HTB = HALF * BK * 2  , STAGE_BYTES = 8 * HTB, NXCD = 8, WGM = 8;

__host__ __device__ __forceinline__ int lds_byte(int r, int c) { const int st = (r >> 4) * 2 + (c >> 5), rr = r & 15, cc = c & 31, ob = rr * 64 + cc * 2; return st * 1024 + (ob ^ (((ob >> 9) & 1) << 5)); }
__host__ __device__ __forceinline__ void stage_rc(int b, int& R, int& C) { const int st = b / 1024, sb = b % 1024, swz = sb ^ (((sb >> 9) & 1) << 5); R = (st >> 1) * 16 + swz / 64; C = (st & 1) * 32 + (swz % 64) / 2; }
__host__ __device__ __forceinline__ int perm32(int rho) { const int n = rho >> 4, i = rho & 15; return 8 * (i >> 2) + 4 * n + (i & 3); }

struct Unit { int pm, pn; };
struct Gemm { const bf16_t* A; const bf16_t* Bt; int M, N, K; };

struct StaticOrder {
    int nM, nN, nwg, G, c;
    __host__ __device__ void init(int M, int N, int G_, int c_) { nM = M / BM; nN = N / BM; nwg = nM * nN; G = G_; c = c_; }
    __host__ __device__ bool next(int i, Unit& u) const {
        const long L = (long)i * G + c; if (L >= nwg) return false;
        int wgid = (int)L; { const int q = nwg / NXCD, r = nwg % NXCD, xcd = wgid % NXCD, off = wgid / NXCD; wgid = (xcd < r ? xcd * (q + 1) : r * (q + 1) + (xcd - r) * q) + off; }
        const int nig = WGM * nN, gid = wgid / nig, fm = gid * WGM, gsz = (nM - fm) < WGM ? (nM - fm) : WGM;
        u.pm = fm + ((wgid % nig) % gsz); u.pn = (wgid % nig) / gsz; return true;
    }
    __device__ __forceinline__ void a_ready(const Unit&) const {}
    __device__ __forceinline__ void done(const Unit&) const {}
};

__device__ __forceinline__ unsigned cvt_pk_bf16(float lo, float hi) { unsigned r; asm volatile("v_cvt_pk_bf16_f32 %0, %1, %2" : "=v"(r) : "v"(lo), "v"(hi)); return r; }
__device__ __forceinline__ u32x4 pack8bf(const f32x4& v0, const f32x4& v1) { u32x4 w; w.x = cvt_pk_bf16(v0[0], v0[1]); w.y = cvt_pk_bf16(v0[2], v0[3]); w.z = cvt_pk_bf16(v1[0], v1[1]); w.w = cvt_pk_bf16(v1[2], v1[3]); return w; }

struct EpiStoreBf16 {
    static constexpr bool PERM = true, AFTER_DRAIN = false;
    bf16_t* O; int ldc;
    __device__ __forceinline__ void operator()(const f32x4 (&acc)[2][2][4][2], const Unit& u, int wr, int wc, int fr, int fq) const {
        const int row0 = u.pm * BM + wr * 64 + fr, col0 = u.pn * BM + wc * 32 + 8 * fq;
#pragma unroll
        for (int ai = 0; ai < 2; ++ai)
#pragma unroll
            for (int m = 0; m < 4; ++m) { bf16_t* rowp = O + (size_t)(row0 + ai * HALF + m * 16) * ldc + col0;
#pragma unroll
                for (int bj = 0; bj < 2; ++bj) *(u32x4*)(rowp + bj * HALF) = pack8bf(acc[ai][bj][m][0], acc[ai][bj][m][1]); }
    }
};
template <bool RES> struct EpiStoreF32 {
    static constexpr bool PERM = true, AFTER_DRAIN = false;
    float* O; const float* res; int ldc;
    __device__ __forceinline__ void operator()(const f32x4 (&acc)[2][2][4][2], const Unit& u, int wr, int wc, int fr, int fq) const {
        const int row0 = u.pm * BM + wr * 64 + fr, col0 = u.pn * BM + wc * 32 + 8 * fq;
#pragma unroll
        for (int ai = 0; ai < 2; ++ai)
#pragma unroll
            for (int m = 0; m < 4; ++m) { const size_t off = (size_t)(row0 + ai * HALF + m * 16) * ldc + col0;
#pragma unroll
                for (int bj = 0; bj < 2; ++bj) { f32x4 v0 = acc[ai][bj][m][0], v1 = acc[ai][bj][m][1];
                    if (RES) { v0 += *(const f32x4*)(res + off + bj * HALF); v1 += *(const f32x4*)(res + off + bj * HALF + 4); }
                    *(f32x4*)(O + off + bj * HALF) = v0; *(f32x4*)(O + off + bj * HALF + 4) = v1; } }
    }
};
struct EpiInProj {
    static constexpr bool PERM = true, AFTER_DRAIN = false;
    bf16_t *cq, *ckv, *fq, *fk, *fv, *gates, *kpe; float* lf; const float *b_gate, *b_forget;
    __device__ __forceinline__ void operator()(const f32x4 (&acc)[2][2][4][2], const Unit& u, int wr, int wc, int fr, int fq_) const {
        const int pn = u.pn, row0 = u.pm * BM + wr * 64 + fr, cw = wc * 32 + 8 * fq_;
        if (pn < 28) {
            bf16_t* base; int ldc, colt;
            if (pn < 2) { base = cq; ldc = 512; colt = pn * 256; } else if (pn < 4) { base = ckv; ldc = 512; colt = (pn - 2) * 256; }
            else if (pn < 12) { base = fq; ldc = 2048; colt = (pn - 4) * 256; } else if (pn < 20) { base = fk; ldc = 2048; colt = (pn - 12) * 256; }
            else { base = fv; ldc = 2048; colt = (pn - 20) * 256; }
#pragma unroll
            for (int ai = 0; ai < 2; ++ai)
#pragma unroll
                for (int m = 0; m < 4; ++m) { bf16_t* rowp = base + (size_t)(row0 + ai * HALF + m * 16) * ldc + colt + cw;
#pragma unroll
                    for (int bj = 0; bj < 2; ++bj) *(u32x4*)(rowp + bj * HALF) = pack8bf(acc[ai][bj][m][0], acc[ai][bj][m][1]); }
        } else if (pn < 44) {
            const int colt = (pn - 28) * 256 + cw;
#pragma unroll
            for (int bj = 0; bj < 2; ++bj) {
                const f32x4 b0 = *(const f32x4*)(b_gate + colt + bj * HALF), b1 = *(const f32x4*)(b_gate + colt + bj * HALF + 4);
#pragma unroll
                for (int ai = 0; ai < 2; ++ai)
#pragma unroll
                    for (int m = 0; m < 4; ++m) {
                        f32x4 v0 = acc[ai][bj][m][0] + b0, v1 = acc[ai][bj][m][1] + b1;
#pragma unroll
                        for (int e = 0; e < 4; ++e) { v0[e] = 1.f / (1.f + __expf(-v0[e])); v1[e] = 1.f / (1.f + __expf(-v1[e])); }
                        *(u32x4*)(gates + (size_t)(row0 + ai * HALF + m * 16) * 4096 + colt + bj * HALF) = pack8bf(v0, v1); }
            }
        } else {
            if (cw < 64) {
#pragma unroll
                for (int ai = 0; ai < 2; ++ai)
#pragma unroll
                    for (int m = 0; m < 4; ++m) *(u32x4*)(kpe + (size_t)(row0 + ai * HALF + m * 16) * 64 + cw) = pack8bf(acc[ai][0][m][0], acc[ai][0][m][1]);
            } else if (cw < 80) {
                const int h0 = cw - 64;
                const f32x4 b0 = *(const f32x4*)(b_forget + h0), b1 = *(const f32x4*)(b_forget + h0 + 4);
#pragma unroll
                for (int ai = 0; ai < 2; ++ai)
#pragma unroll
                    for (int m = 0; m < 4; ++m) { const int row = row0 + ai * HALF + m * 16;
                        f32x4 z0 = acc[ai][0][m][0] + b0, z1 = acc[ai][0][m][1] + b1;
#pragma unroll
                        for (int e = 0; e < 4; ++e) { z0[e] = fminf(z0[e], 0.f) - __logf(1.f + __expf(-fabsf(z0[e]))); z1[e] = fminf(z1[e], 0.f) - __logf(1.f + __expf(-fabsf(z1[e]))); }
                        *(f32x4*)(lf + (size_t)row * 16 + h0) = z0; *(f32x4*)(lf + (size_t)row * 16 + h0 + 4) = z1; }
            }
        }
    }
};
template <class Epi, class Sched, bool ALIGN_EPI = false, bool SP2 = false>
__device__ __forceinline__ void gemm_phase(PG8_LAS unsigned char* lds, const Gemm g, const Sched& S, const Epi& E) {
    const int tid = threadIdx.x, wid = __builtin_amdgcn_readfirstlane(tid >> 6), lane = tid & 63, wr = wid >> 2, wc = wid & 3, fr = lane & 15, fq = lane >> 4;
    const int K = g.K, nt = K / BK;
    unsigned voffA[2], voffB[2];
#pragma unroll
    for (int i = 0; i < 2; ++i) { int R, C; stage_rc(tid * 16 + i * 8192, R, C); const int Rb = Epi::PERM ? ((R & ~31) + perm32(R & 31)) : R;
        voffA[i] = (unsigned)(R * K + C) * 2u; voffB[i] = (unsigned)(Rb * K + C) * 2u; }
    const size_t kstep = (size_t)(BK * 2);
    const size_t hstep = (size_t)HALF * K * 2;
    const size_t tstep = 2 * hstep;
    const unsigned ldsw = (unsigned)wid * 1024u;
    const int aoff = lds_byte(wr * 64 + fr, fq * 8), boff = lds_byte(wc * 32 + fr, fq * 8);
#define PG8_SA(b, h) (((b) * 2 + (h)) * HTB)
#define PG8_SB(b, h) ((4 + (b) * 2 + (h)) * HTB)
#define PG8_STAGE(bufoff, gbase, voff) do { _Pragma("unroll") for (int _i = 0; _i < 2; ++_i) \
        __builtin_amdgcn_global_load_lds((const unsigned*)((const char*)(gbase) + (voff)[_i]), (PG8_LAS unsigned*)(lds + (bufoff) + ldsw + _i * 8192), 16, 0, 0); } while (0)
#define PG8_LDA(dst, b, h) do { _Pragma("unroll") for (int m = 0; m < 4; ++m) _Pragma("unroll") for (int k = 0; k < 2; ++k) dst[m][k] = *(const PG8_LAS bf16x8*)(lds + PG8_SA(b, h) + aoff + m * 2048 + k * 1024); } while (0)
#define PG8_LDB(dst, b, h) do { _Pragma("unroll") for (int n = 0; n < 2; ++n) _Pragma("unroll") for (int k = 0; k < 2; ++k) dst[n][k] = *(const PG8_LAS bf16x8*)(lds + PG8_SB(b, h) + boff + n * 2048 + k * 1024); } while (0)
#define PG8_MMA(ai, bj, At, Bt) do { __builtin_amdgcn_s_setprio(1); _Pragma("unroll") for (int m = 0; m < 4; ++m) _Pragma("unroll") for (int n = 0; n < 2; ++n) _Pragma("unroll") for (int k = 0; k < 2; ++k) \
        acc[ai][bj][m][n] = __builtin_amdgcn_mfma_f32_16x16x32_bf16(Bt[n][k], At[m][k], acc[ai][bj][m][n], 0, 0, 0); __builtin_amdgcn_s_setprio(0); } while (0)
#define PG8_WAIT_V(n) asm volatile("s_waitcnt vmcnt(" #n ")" ::: "memory")
#define PG8_WAIT_L(n) asm volatile("s_waitcnt lgkmcnt(" #n ")" ::: "memory")
#define PG8_BAR __builtin_amdgcn_s_barrier()
#define PG8_SCHED __builtin_amdgcn_sched_barrier(0)
    Unit cur, nxt; int ui = 0;
    if (!S.next(0, cur)) return;
    f32x4 acc[2][2][4][2];
#pragma unroll
    for (int a = 0; a < 2; ++a)
#pragma unroll
        for (int b = 0; b < 2; ++b)
#pragma unroll
            for (int m = 0; m < 4; ++m)
#pragma unroll
                for (int n = 0; n < 2; ++n) acc[a][b][m][n] = (f32x4){0.f, 0.f, 0.f, 0.f};
    bf16x8 At[4][2], B0[2][2], B1[2][2];
    const char* cA = (const char*)g.A + (size_t)cur.pm * tstep; const char* cB = (const char*)g.Bt + (size_t)cur.pn * tstep;
    S.a_ready(cur);
    if constexpr (SP2) {
        PG8_STAGE(PG8_SB(0, 0), cB, voffB); PG8_STAGE(PG8_SB(0, 1), cB + hstep, voffB); PG8_STAGE(PG8_SA(0, 0), cA, voffA); PG8_STAGE(PG8_SA(0, 1), cA + hstep, voffA);
        if (wr == 1) PG8_BAR;
        PG8_WAIT_V(2); PG8_BAR;
        PG8_STAGE(PG8_SB(1, 0), cB + kstep, voffB); PG8_STAGE(PG8_SA(1, 0), cA + kstep, voffA); PG8_STAGE(PG8_SB(1, 1), cB + hstep + kstep, voffB);
        PG8_WAIT_V(6); PG8_BAR;
    } else {
        PG8_STAGE(PG8_SB(0, 0), cB, voffB); PG8_STAGE(PG8_SA(0, 0), cA, voffA); PG8_STAGE(PG8_SB(0, 1), cB + hstep, voffB); PG8_STAGE(PG8_SA(0, 1), cA + hstep, voffA);
        if (wr == 1) PG8_BAR;
        PG8_WAIT_V(4); PG8_BAR;
        PG8_STAGE(PG8_SB(1, 0), cB + kstep, voffB); PG8_STAGE(PG8_SA(1, 0), cA + kstep, voffA); PG8_STAGE(PG8_SB(1, 1), cB + hstep + kstep, voffB);
        PG8_WAIT_V(6); PG8_BAR;
    }
    for (;;) {
        const bool has_next = S.next(ui + 1, nxt);
        const char* nA = has_next ? (const char*)g.A + (size_t)nxt.pm * tstep : cA; const char* nB = has_next ? (const char*)g.Bt + (size_t)nxt.pn * tstep : cB;
        for (int t = 0; t < nt; t += 2) {
            const bool last = (t == nt - 2);
            const char* a1 = cA + (size_t)(t + 1) * kstep;
            const char* a2 = last ? nA : cA + (size_t)(t + 2) * kstep; const char* b2 = last ? nB : cB + (size_t)(t + 2) * kstep;
            const char* a3 = a2 + kstep; const char* b3 = b2 + kstep;
            if (last && has_next) S.a_ready(nxt);
            if constexpr (SP2) {
            PG8_LDB(B0, 0, 0); PG8_LDB(B1, 0, 1); PG8_SCHED; PG8_LDA(At, 0, 0); PG8_STAGE(PG8_SA(1, 1), a1 + hstep, voffA);
            PG8_WAIT_V(8); PG8_WAIT_L(0); PG8_BAR; PG8_MMA(0, 0, At, B0); PG8_MMA(0, 1, At, B1); PG8_BAR; PG8_SCHED;
            PG8_LDA(At, 0, 1); PG8_STAGE(PG8_SB(0, 0), b2, voffB); PG8_STAGE(PG8_SB(0, 1), b2 + hstep, voffB); PG8_STAGE(PG8_SA(0, 0), a2, voffA);
            PG8_WAIT_V(8); PG8_WAIT_L(0); PG8_BAR; PG8_MMA(1, 0, At, B0); PG8_MMA(1, 1, At, B1); PG8_BAR; PG8_SCHED;
            PG8_LDB(B0, 1, 0); PG8_LDB(B1, 1, 1); PG8_SCHED; PG8_LDA(At, 1, 0); PG8_STAGE(PG8_SA(0, 1), a2 + hstep, voffA);
            PG8_WAIT_V(8); PG8_WAIT_L(0); PG8_BAR; PG8_MMA(0, 0, At, B0); PG8_MMA(0, 1, At, B1); PG8_BAR; PG8_SCHED;
            PG8_LDA(At, 1, 1); PG8_STAGE(PG8_SB(1, 0), b3, voffB); PG8_STAGE(PG8_SB(1, 1), b3 + hstep, voffB); PG8_STAGE(PG8_SA(1, 0), a3, voffA);
            PG8_WAIT_V(8); PG8_WAIT_L(0); PG8_BAR; PG8_MMA(1, 0, At, B0); PG8_MMA(1, 1, At, B1); PG8_BAR; PG8_SCHED;
            } else {
            PG8_LDB(B0, 0, 0); PG8_SCHED; PG8_LDA(At, 0, 0); PG8_STAGE(PG8_SA(1, 1), a1 + hstep, voffA);
            PG8_WAIT_L(8); PG8_BAR; PG8_WAIT_L(0); PG8_MMA(0, 0, At, B0); PG8_BAR; PG8_SCHED;
            PG8_LDB(B1, 0, 1); PG8_STAGE(PG8_SB(0, 0), b2, voffB);
            PG8_BAR; PG8_WAIT_L(0); PG8_MMA(0, 1, At, B1); PG8_BAR;
            PG8_LDA(At, 0, 1); PG8_STAGE(PG8_SA(0, 0), a2, voffA);
            PG8_BAR; PG8_WAIT_L(0); PG8_MMA(1, 0, At, B0); PG8_BAR; PG8_SCHED;
            PG8_STAGE(PG8_SB(0, 1), b2 + hstep, voffB);
            PG8_WAIT_V(6); PG8_BAR; PG8_MMA(1, 1, At, B1); PG8_BAR;
            PG8_LDB(B0, 1, 0); PG8_SCHED; PG8_LDA(At, 1, 0); PG8_STAGE(PG8_SA(0, 1), a2 + hstep, voffA);
            PG8_WAIT_L(8); PG8_BAR; PG8_WAIT_L(0); PG8_MMA(0, 0, At, B0); PG8_BAR; PG8_SCHED;
            PG8_LDB(B1, 1, 1); PG8_STAGE(PG8_SB(1, 0), b3, voffB);
            PG8_BAR; PG8_WAIT_L(0); PG8_MMA(0, 1, At, B1); PG8_BAR;
            PG8_LDA(At, 1, 1); PG8_STAGE(PG8_SA(1, 0), a3, voffA);
            PG8_BAR; PG8_WAIT_L(0); PG8_MMA(1, 0, At, B0); PG8_BAR; PG8_SCHED;
            PG8_STAGE(PG8_SB(1, 1), b3 + hstep, voffB);
            PG8_WAIT_V(6); PG8_BAR; PG8_MMA(1, 1, At, B1); PG8_BAR;
            }
        }
        if constexpr (ALIGN_EPI) { if (wr == 0) PG8_BAR; }
        if constexpr (!Epi::AFTER_DRAIN) { E(acc, cur, wr, wc, fr, fq); S.done(cur); }
        if (!has_next) break;
#pragma unroll
        for (int a = 0; a < 2; ++a)
#pragma unroll
            for (int b = 0; b < 2; ++b)
#pragma unroll
                for (int m = 0; m < 4; ++m)
#pragma unroll
                    for (int n = 0; n < 2; ++n) acc[a][b][m][n] = (f32x4){0.f, 0.f, 0.f, 0.f};
        cur = nxt; cA = nA; cB = nB; ++ui;
        if constexpr (ALIGN_EPI) { if (wr == 1) PG8_BAR; }
    }
    PG8_WAIT_V(0);
    if constexpr (!ALIGN_EPI) { if (wr == 0) PG8_BAR; }
    PG8_BAR;
    if constexpr (Epi::AFTER_DRAIN) { E.fused(acc, cur, wr, wc, fr, fq, lds, wid, lane); S.done(cur); }
#undef PG8_SA
#undef PG8_SB
#undef PG8_STAGE
#undef PG8_LDA
#undef PG8_LDB
#undef PG8_MMA
#undef PG8_WAIT_V
#undef PG8_WAIT_L
#undef PG8_BAR
#undef PG8_SCHED
}
}
namespace att {
typedef unsigned short bf16_t;
typedef short bf16x8 __attribute__((ext_vector_type(8)));
typedef short s16x4 __attribute__((ext_vector_type(4)));
typedef float f32x16 __attribute__((ext_vector_type(16)));
typedef float f32x4 __attribute__((ext_vector_type(4)));
typedef unsigned u32x4 __attribute__((ext_vector_type(4)));
#define ALAS __attribute__((address_space(3)))
#define ASBAR() __builtin_amdgcn_sched_barrier(0)
constexpr int SHM_V = 16384;
template <int DK> struct Lay { static constexpr int ROWB = DK * 2, SHM_K = 64 * ROWB, OFF_K = 2 * SHM_V, OFF_F = OFF_K + 2 * SHM_K, OFF_WS = OFF_F + 512, TOTAL = OFF_WS + 8 * 256; };

__device__ __forceinline__ int v_st(int k, int c) { const int kk = (k & ~0xC) | ((k & 4) << 1) | ((k & 8) >> 1); return ((kk >> 3) * 4 + (c >> 5)) * 512 + ((kk & 7) * 32 + (c & 31)) * 2; }
__device__ __forceinline__ int v_rd_base(int lane) { return ((lane & 3) << 3) | (((lane >> 2) & 3) << 6) | (((lane >> 4) & 1) << 5) | (((lane >> 5) & 1) << 8); }
__device__ __forceinline__ int crow(int r, int hi) { return (r & 3) + 8 * (r >> 2) + 4 * hi; }
__device__ __forceinline__ unsigned cvtpk(float lo, float hi) { unsigned r; asm volatile("v_cvt_pk_bf16_f32 %0, %1, %2" : "=v"(r) : "v"(lo), "v"(hi)); return r; }

template <int DK, bool FOX>
__device__ __forceinline__ void attn_block(unsigned char* smem, const bf16_t* __restrict__ Q, int ldq, const bf16_t* __restrict__ K, int ldk, const bf16_t* __restrict__ V, int ldv,
                                           const float* __restrict__ Fh, const bf16_t* __restrict__ gate, bf16_t* __restrict__ gout  , int qbk, float qk_bound  ) {
    typedef Lay<DK> LY;
    constexpr int ND = DK / 16, NKC = DK / 8, NKI = (64 * NKC) / 512;
    int tid = threadIdx.x; asm volatile("" : "+v"(tid));
    const int wid = __builtin_amdgcn_readfirstlane(tid >> 6), lane = tid & 63, r32 = lane & 31, hi = lane >> 5;
    const int q0 = qbk * 256, qlo = q0 + wid * 32, qm = qlo + r32 - 4 * hi;
    const int NT = 4 * qbk + 4;
    ALAS unsigned char* lds = (ALAS unsigned char*)smem;
    ALAS float* F_lds = (ALAS float*)(lds + LY::OFF_F);
    ALAS float* wsl = (ALAS float*)(lds + LY::OFF_WS) + wid * 64;
    bf16x8 qr[ND];
#pragma unroll
    for (int d0 = 0; d0 < ND; ++d0) qr[d0] = *(const bf16x8*)(Q + (size_t)(qlo + r32) * ldq + d0 * 16 + hi * 8);
    const float fq = FOX ? Fh[qlo + r32] : 0.f;
    int kgo[NKI], klo[NKI];
#pragma unroll
    for (int i = 0; i < NKI; ++i) { const int idx = tid + 512 * i, row = idx / NKC, ch = idx % NKC; kgo[i] = row * ldk + ch * 8; klo[i] = row * LY::ROWB + ((ch ^ ((row >> 1) & 7)) << 4); }
    const int sr = tid >> 4, sc = (tid & 15) * 8, vst0 = v_st(sr, sc), vst1 = v_st(32 + sr, sc);
    const int vgo0 = sr * ldv + sc, vgo1 = (32 + sr) * ldv + sc;
    const int vb0 = (int)(uintptr_t)smem + v_rd_base(lane);
    int kbase[4];
#pragma unroll
    for (int dd = 0; dd < 4; ++dd) kbase[dd] = LY::OFF_K + r32 * LY::ROWB + (((((dd << 1) | hi) ^ ((r32 >> 1) & 7))) << 4);
    bf16x8 stk[NKI], stv0, stv1; float stf = 0.f;
#define ATT_LOAD(kb) do { _Pragma("unroll") for (int i = 0; i < NKI; ++i) stk[i] = *(const bf16x8*)(K + (size_t)(kb) * ldk + kgo[i]); \
        stv0 = *(const bf16x8*)(V + (size_t)(kb) * ldv + vgo0); stv1 = *(const bf16x8*)(V + (size_t)(kb) * ldv + vgo1); if (FOX && tid < 64) stf = Fh[(kb) + tid]; } while (0)
#define ATT_WRITE(bf) do { _Pragma("unroll") for (int i = 0; i < NKI; ++i) *(ALAS bf16x8*)(lds + LY::OFF_K + (bf) * LY::SHM_K + klo[i]) = stk[i]; \
        *(ALAS bf16x8*)(lds + (bf) * SHM_V + vst0) = stv0; *(ALAS bf16x8*)(lds + (bf) * SHM_V + vst1) = stv1; if (FOX && tid < 64) F_lds[(bf) * 64 + tid] = stf; } while (0)
    int t_start = 0;
    if (FOX) { const float thr = 2.02f * qk_bound + 40.f, f0 = Fh[q0];
        const int j0 = lane, j1 = lane + 64;
        const bool c0 = (j0 < 4 * qbk) && (Fh[j0 * 64 + 63] - f0 >= thr), c1 = (j1 < 4 * qbk) && (Fh[(j1 < 4 * qbk ? j1 : 0) * 64 + 63] - f0 >= thr);
        t_start = __builtin_popcountll(__ballot(c0)) + __builtin_popcountll(__ballot(c1));
        t_start = __builtin_amdgcn_readfirstlane(t_start); }
    ATT_LOAD(t_start * 64); ATT_WRITE(t_start & 1);
    float m_reg = -1e30f, l_reg = 0.f; f32x16 o[4];
#pragma unroll
    for (int d = 0; d < 4; ++d)
#pragma unroll
        for (int r = 0; r < 16; ++r) o[d][r] = 0.f;
    for (int t = t_start; t < NT; ++t) {
        const int buf = t & 1, kb = t * 64;
        __syncthreads();
        if (t + 1 < NT) ATT_LOAD(kb + 64);
        f32x16 p0, p1;
        if (FOX) {
#pragma unroll
            for (int g = 0; g < 4; ++g) { const f32x4 f0 = *(const ALAS f32x4*)(F_lds + buf * 64 + 8 * g + 4 * hi), f1 = *(const ALAS f32x4*)(F_lds + buf * 64 + 32 + 8 * g + 4 * hi);
#pragma unroll
                for (int e = 0; e < 4; ++e) { p0[4 * g + e] = fq - f0[e]; p1[4 * g + e] = fq - f1[e]; } }
        } else {
#pragma unroll
            for (int r = 0; r < 16; ++r) { p0[r] = 0.f; p1[r] = 0.f; }
        }
#pragma unroll
        for (int d0 = 0; d0 < ND; ++d0) {
            ALAS const unsigned char* a = lds + buf * LY::SHM_K + kbase[d0 & 3] + (d0 >> 2) * 128;
            const bf16x8 b0 = *(const ALAS bf16x8*)a;
            const bf16x8 b1 = *(const ALAS bf16x8*)(a + 32 * LY::ROWB);
            p0 = __builtin_amdgcn_mfma_f32_32x32x16_bf16(b0, qr[d0], p0, 0, 0, 0);
            p1 = __builtin_amdgcn_mfma_f32_32x32x16_bf16(b1, qr[d0], p1, 0, 0, 0);
        }
        if (kb + 63 > qlo) {
            const float NEG = -__builtin_inff(); const int dq = qm - kb;
#pragma unroll
            for (int r = 0; r < 16; ++r) { const int c = (r & 3) + 8 * (r >> 2); if (dq - c < 0) p0[r] = NEG; if (dq - c - 32 < 0) p1[r] = NEG; }
        }
        float pmax = p0[0];
#pragma unroll
        for (int r = 1; r < 16; ++r) pmax = fmaxf(pmax, p0[r]);
#pragma unroll
        for (int r = 0; r < 16; ++r) pmax = fmaxf(pmax, p1[r]);
        { auto rr = __builtin_amdgcn_permlane32_swap(__float_as_uint(pmax), __float_as_uint(pmax), false, false);
          pmax = fmaxf(__uint_as_float(rr[0]), __uint_as_float(rr[1])); }
        const float mn = fmaxf(m_reg, pmax);
        const float alpha = __builtin_amdgcn_exp2f(m_reg - mn);
        m_reg = mn;
        float ps = 0.f;
#pragma unroll
        for (int r = 0; r < 16; ++r) { p0[r] = __builtin_amdgcn_exp2f(p0[r] - mn); ps += p0[r]; }
#pragma unroll
        for (int r = 0; r < 16; ++r) { p1[r] = __builtin_amdgcn_exp2f(p1[r] - mn); ps += p1[r]; }
        { auto rr = __builtin_amdgcn_permlane32_swap(__float_as_uint(ps), __float_as_uint(ps), false, false);
          ps = __uint_as_float(rr[0]) + __uint_as_float(rr[1]); }
        l_reg = l_reg * alpha + ps;
        bf16x8 pa0, pa1, pa2, pa3;
#define ATT_PK4(P, B_, OUT) do { unsigned a0 = cvtpk(P[B_+0], P[B_+1]), a1 = cvtpk(P[B_+2], P[B_+3]); unsigned b0_ = cvtpk(P[B_+4], P[B_+5]), b1_ = cvtpk(P[B_+6], P[B_+7]); \
        auto r0 = __builtin_amdgcn_permlane32_swap(a0, b0_, false, false); auto r1 = __builtin_amdgcn_permlane32_swap(a1, b1_, false, false); \
        u32x4 w = {r0[0], r1[0], r0[1], r1[1]}; OUT = *reinterpret_cast<bf16x8*>(&w); } while (0)
        ATT_PK4(p0, 0, pa0); ATT_PK4(p0, 8, pa1); ATT_PK4(p1, 0, pa2); ATT_PK4(p1, 8, pa3);
        if (__any(alpha < 1.f)) {
            if (hi == 0) wsl[r32] = alpha;
            asm volatile("s_waitcnt lgkmcnt(0)" ::: "memory");
#pragma unroll
            for (int g = 0; g < 4; ++g) { const f32x4 al = *(const ALAS f32x4*)(wsl + 8 * g + 4 * hi);
#pragma unroll
                for (int d = 0; d < 4; ++d)
#pragma unroll
                    for (int e = 0; e < 4; ++e) o[d][4 * g + e] *= al[e]; }
        }
#define ATT_TRRD(dst, off) asm volatile("ds_read_b64_tr_b16 %0, %1 offset:%2" : "=&v"(dst) : "v"(vbb), "i"(off) : "memory")
#define ATT_PV(d0) do { s16x4 l0, l1, l2, l3, h0, h1, h2, h3; constexpr int b_ = (d0) * 512; \
        ATT_TRRD(l0, b_); ATT_TRRD(h0, b_ + 2048); ATT_TRRD(l1, b_ + 4096); ATT_TRRD(h1, b_ + 6144); ATT_TRRD(l2, b_ + 8192); ATT_TRRD(h2, b_ + 10240); ATT_TRRD(l3, b_ + 12288); ATT_TRRD(h3, b_ + 14336); \
        asm volatile("s_waitcnt lgkmcnt(0)" ::: "memory"); ASBAR(); \
        o[d0] = __builtin_amdgcn_mfma_f32_32x32x16_bf16(pa0, (bf16x8){l0[0], l0[1], l0[2], l0[3], h0[0], h0[1], h0[2], h0[3]}, o[d0], 0, 0, 0); \
        o[d0] = __builtin_amdgcn_mfma_f32_32x32x16_bf16(pa1, (bf16x8){l1[0], l1[1], l1[2], l1[3], h1[0], h1[1], h1[2], h1[3]}, o[d0], 0, 0, 0); \
        o[d0] = __builtin_amdgcn_mfma_f32_32x32x16_bf16(pa2, (bf16x8){l2[0], l2[1], l2[2], l2[3], h2[0], h2[1], h2[2], h2[3]}, o[d0], 0, 0, 0); \
        o[d0] = __builtin_amdgcn_mfma_f32_32x32x16_bf16(pa3, (bf16x8){l3[0], l3[1], l3[2], l3[3], h3[0], h3[1], h3[2], h3[3]}, o[d0], 0, 0, 0); } while (0)
        { const int vbb = vb0 + buf * SHM_V; ATT_PV(0); ATT_PV(1); ATT_PV(2); ATT_PV(3); }
        if (t + 1 < NT) ATT_WRITE(buf ^ 1);
    }
    if (hi == 0) wsl[r32] = l_reg;
    asm volatile("s_waitcnt lgkmcnt(0)" ::: "memory");
#pragma unroll
    for (int r = 0; r < 16; ++r) {
        const int orow = crow(r, hi); const float rli = __builtin_amdgcn_rcpf(wsl[orow]);
        bf16_t* rowp = gout + (size_t)(qlo + orow) * 4096; const bf16_t* growp = gate + (size_t)(qlo + orow) * 4096;
#pragma unroll
        for (int d0 = 0; d0 < 4; ++d0) {
            const float v = o[d0][r] * rli; const float vn = __shfl_xor(v, 1);
            if ((r32 & 1) == 0) { unsigned* gp = (unsigned*)(rowp + d0 * 32 + r32); const unsigned g = *(const unsigned*)(growp + d0 * 32 + r32);
                *gp = cvtpk(v * __uint_as_float(g << 16), vn * __uint_as_float(g & 0xffff0000u)); }
        }
    }
    __syncthreads();
#undef ATT_LOAD
#undef ATT_WRITE
#undef ATT_PK4
#undef ATT_TRRD
#undef ATT_PV
}
}
using pg8::bf16_t; using pg8::f32x4; using pg8::u32x4;
#define LAS __attribute__((address_space(3)))
constexpr int S = 8192, DM = 2048, INW = 11344, INWP = 11520;
constexpr float EPS = 1e-6f;
constexpr size_t MiB = 1u << 20;

__device__ __forceinline__ float bf2f(bf16_t v) { return __uint_as_float(((unsigned)v) << 16); }
__device__ __forceinline__ bf16_t f2bf(float f) { unsigned u = __float_as_uint(f); u += 0x7fffu + ((u >> 16) & 1u); return (bf16_t)(u >> 16); }
__device__ __forceinline__ unsigned pk2(float lo, float hi) { return (unsigned)f2bf(lo) | ((unsigned)f2bf(hi) << 16); }
__device__ __forceinline__ float wave_sum(float v) {
#pragma unroll
    for (int o = 32; o >= 1; o >>= 1) v += __shfl_xor(v, o);
    return v;
}
__device__ __forceinline__ float wave_max(float v) {
#pragma unroll
    for (int o = 32; o >= 1; o >>= 1) v = fmaxf(v, __shfl_xor(v, o));
    return v;
}

__device__ __forceinline__ int opaque_tid() { int t = threadIdx.x; asm volatile("" : "+v"(t)); return t; }

struct Params {
    const float* x; const int* pos; const float *mix_g, *w_in, *b_forget, *b_gate, *q_lat_g, *w_q_up, *kv_lat_g, *w_kv_up, *mla_qg, *mla_kg, *fox_qg, *fox_kg, *w_out, *ffn_g, *w_peer_q, *sub_keys, *peer_u, *peer_v;
    float* out;
    bf16_t *WqT, *WkvT, *WoT, *WpT, *WinT;
    bf16_t *h, *cq, *ckv, *fq, *fk, *fv, *merged, *kpe, *qa, *kvraw, *ka;
    float *lf, *F, *x1, *scores;
    unsigned char *U8, *V8; bf16_t* attout;
    unsigned* ctl;
    float *qn, *kn, *kall, *qmaxB;
};

struct DstId { __device__ __forceinline__ int operator()(int n) const { return n; } };
struct DstWin { __device__ __forceinline__ int operator()(int n) const {
    if (n < 1024) return n; if (n < 1088) return 11264 + (n - 1024); if (n < 7232) return n - 64; if (n < 7248) return 11264 + 64 + (n - 7232); return n - 80; } };
template <class Dst>
__device__ __forceinline__ void transpose_item(const float* __restrict__ W, int K, int N, bf16_t* __restrict__ WT, Dst dst, float* scr, int item, int lane) {
    const int nblk = (N + 31) / 32, kb = item / nblk, nb = item % nblk, k0 = 64 * kb, n0 = 32 * nb;
    { const int n = n0 + (lane & 31);
#pragma unroll 8
      for (int i = 0; i < 32; ++i) { const int kk = 2 * i + (lane >> 5); scr[kk * 33 + (lane & 31)] = (n < N) ? W[(size_t)(k0 + kk) * N + n] : 0.f; } }
    asm volatile("s_waitcnt lgkmcnt(0)" ::: "memory");
    const int c = lane & 7;
#pragma unroll
    for (int j = 0; j < 4; ++j) { const int nl = (lane >> 3) + 8 * j, n = n0 + nl; const float* s = scr + (8 * c) * 33 + nl;
        u32x4 o; o.x = pk2(s[0 * 33], s[1 * 33]); o.y = pk2(s[2 * 33], s[3 * 33]); o.z = pk2(s[4 * 33], s[5 * 33]); o.w = pk2(s[6 * 33], s[7 * 33]);
        if (n < N) *(u32x4*)(WT + (size_t)dst(n) * K + k0 + 8 * c) = o; }
    asm volatile("s_waitcnt lgkmcnt(0)" ::: "memory");
}
__device__ __forceinline__ void wfold_item(const float* __restrict__ wq, const float* __restrict__ keys, bf16_t* __restrict__ WpT, float* sm, int item) {
    const int tid = opaque_tid(), hc = item >> 5, d0 = (item & 31) * 64;
    float* keysL = sm; float* wqL = sm + 128 * 129;
    for (int idx = tid; idx < 128 * 128; idx += 512) keysL[(idx >> 7) * 129 + (idx & 127)] = keys[(size_t)hc * 16384 + idx];
    for (int idx = tid; idx < 64 * 128; idx += 512) wqL[(idx >> 7) * 129 + (idx & 127)] = wq[(size_t)(d0 + (idx >> 7)) * 2048 + hc * 128 + (idx & 127)];
    __syncthreads();
    const int n = tid & 127, dq = tid >> 7;
    float acc[16];
#pragma unroll
    for (int i = 0; i < 16; ++i) acc[i] = 0.f;
    for (int j = 0; j < 128; ++j) { const float kv = keysL[n * 129 + j];
#pragma unroll
        for (int i = 0; i < 16; ++i) acc[i] += kv * wqL[(dq * 16 + i) * 129 + j]; }
    u32x4 o0, o1;
    o0.x = pk2(acc[0], acc[1]); o0.y = pk2(acc[2], acc[3]); o0.z = pk2(acc[4], acc[5]); o0.w = pk2(acc[6], acc[7]);
    o1.x = pk2(acc[8], acc[9]); o1.y = pk2(acc[10], acc[11]); o1.z = pk2(acc[12], acc[13]); o1.w = pk2(acc[14], acc[15]);
    bf16_t* dstp = WpT + (size_t)(hc * 128 + n) * 2048 + d0 + dq * 16;
    *(u32x4*)dstp = o0; *(u32x4*)(dstp + 8) = o1;
    __syncthreads();
}
__device__ __forceinline__ void rms_row2048(const float* __restrict__ xr, const float* __restrict__ g, bf16_t* __restrict__ orow, int lane) {
    f32x4 v[8]; float ss = 0.f;
#pragma unroll
    for (int j = 0; j < 8; ++j) { v[j] = *(const f32x4*)(xr + j * 256 + lane * 4); ss += (v[j][0] * v[j][0] + v[j][1] * v[j][1]) + (v[j][2] * v[j][2] + v[j][3] * v[j][3]); }
    const float r = rsqrtf(wave_sum(ss) * (1.f / 2048.f) + EPS);
#pragma unroll
    for (int j = 0; j < 8; ++j) { const f32x4 gg = *(const f32x4*)(g + j * 256 + lane * 4);
        uint2 o; o.x = pk2(v[j][0] * r * gg[0], v[j][1] * r * gg[1]); o.y = pk2(v[j][2] * r * gg[2], v[j][3] * r * gg[3]);
        *(uint2*)(orow + j * 256 + lane * 4) = o; }
}
__device__ __forceinline__ void rms_row512_inplace(bf16_t* __restrict__ row, const float* __restrict__ g, int lane) {
    u32x4 w = *(const u32x4*)(row + lane * 8); float v[8];
#pragma unroll
    for (int i = 0; i < 4; ++i) { v[2 * i] = __uint_as_float(w[i] << 16); v[2 * i + 1] = __uint_as_float(w[i] & 0xffff0000u); }
    float ss = 0.f;
#pragma unroll
    for (int i = 0; i < 8; ++i) ss += v[i] * v[i];
    const float r = rsqrtf(wave_sum(ss) * (1.f / 512.f) + EPS);
    u32x4 o;
#pragma unroll
    for (int i = 0; i < 4; ++i) o[i] = pk2(v[2 * i] * r * g[lane * 8 + 2 * i], v[2 * i + 1] * r * g[lane * 8 + 2 * i + 1]);
    *(u32x4*)(row + lane * 8) = o;
}
__device__ __forceinline__ void fox_prep(int w, bf16_t* __restrict__ fq, bf16_t* __restrict__ fk, const float* __restrict__ gq, const float* __restrict__ gk,
                                         float* __restrict__ qn, float* __restrict__ kn, int lane) {
    const int t = w >> 4, h = w & 15;
#pragma unroll
    for (int which = 0; which < 2; ++which) {
        bf16_t* p = (which ? fk : fq) + (size_t)t * 2048 + h * 128; const float* g = which ? gk : gq;
        const float v0 = bf2f(p[lane]), v1 = bf2f(p[lane + 64]);
        const float r = rsqrtf(wave_sum(v0 * v0 + v1 * v1) * (1.f / 128.f) + EPS);
        const float qs = which ? 1.f : 0.12751743f;
        const float o0 = v0 * r * g[lane] * qs, o1 = v1 * r * g[lane + 64] * qs;
        p[lane] = f2bf(o0); p[lane + 64] = f2bf(o1);
        const float nn = sqrtf(wave_sum(o0 * o0 + o1 * o1));
        if (lane == 0) (which ? kn : qn)[(size_t)h * S + t] = nn;
    }
}
__device__ __forceinline__ void fox_stats(float* red, int h, const float* __restrict__ qn, const float* __restrict__ kn, float* __restrict__ kall, float* __restrict__ qmaxB) {
    const int tid = opaque_tid(), lane = tid & 63, wave = tid >> 6;
    float km = 0.f;
    for (int i = tid; i < S; i += 512) km = fmaxf(km, kn[(size_t)h * S + i]);
    km = wave_max(km);
    if (lane == 0) red[wave] = km;
    for (int qb = wave; qb < 32; qb += 8) { float qm = 0.f;
        for (int i = lane; i < 256; i += 64) qm = fmaxf(qm, qn[(size_t)h * S + qb * 256 + i]);
        qm = wave_max(qm); if (lane == 0) qmaxB[h * 32 + qb] = qm; }
    __syncthreads();
    if (tid == 0) { float m = red[0]; for (int i = 1; i < 8; ++i) m = fmaxf(m, red[i]); kall[h] = m; }
    __syncthreads();
}
__device__ __forceinline__ void fox_cumsum(double* part, int h, const float* __restrict__ lf, float* __restrict__ F) {
    const int tid = opaque_tid(); double sum = 0.0;
    for (int i = 0; i < 16; ++i) sum += (double)lf[(size_t)(tid * 16 + i) * 16 + h];
    part[tid] = sum;
    __syncthreads();
    if (tid == 0) { double run = 0.0; for (int i = 0; i < 512; ++i) { const double v = part[i]; part[i] = run; run += v; } }
    __syncthreads();
    double run = part[tid];
    for (int i = 0; i < 16; ++i) { run += (double)lf[(size_t)(tid * 16 + i) * 16 + h]; F[(size_t)h * S + tid * 16 + i] = (float)(run * 1.4426950408889634); }
    __syncthreads();
}
__device__ __forceinline__ void rope_cs(int pos, int i, float& c, float& s) {
    const double inv = exp(-(double)i * (1.0 / 32.0) * 9.210340371976184);
    double ang = (double)((float)pos * (float)inv);
    const double twopi = 6.283185307179586;
    ang -= twopi * rint(ang / twopi);
    c = cosf((float)ang); s = sinf((float)ang);
}
__device__ __forceinline__ void mla_prep(int w, bf16_t* __restrict__ qa, const bf16_t* __restrict__ kvraw, const bf16_t* __restrict__ kpe, const int* __restrict__ pos,
                                         const float* __restrict__ gq, const float* __restrict__ gk, bf16_t* __restrict__ ka, int lane) {
    const int t = w >> 4, h = w & 15;
    float c, s; rope_cs(pos[t], lane & 31, c, s);
    {
        bf16_t* q = qa + (size_t)t * 3072 + h * 192;
        float v0 = bf2f(q[lane]), v1 = bf2f(q[lane + 64]), v2 = bf2f(q[lane + 128]);
        const float r = rsqrtf(wave_sum(v0 * v0 + v1 * v1 + v2 * v2) * (1.f / 192.f) + EPS);
        v0 *= r * gq[lane]; v1 *= r * gq[lane + 64]; v2 *= r * gq[lane + 128];
        const float o = __shfl_xor(v2, 32);
        const float rr = lane < 32 ? v2 * c - o * s : o * s + v2 * c;
        q[lane] = f2bf(v0 * 0.10411754f); q[lane + 64] = f2bf(v1 * 0.10411754f); q[lane + 128] = f2bf(rr * 0.10411754f);
    }
    {
        const bf16_t* kn = kvraw + (size_t)t * 4096 + h * 256;
        float v0 = bf2f(kn[lane]), v1 = bf2f(kn[lane + 64]), v2 = bf2f(kpe[(size_t)t * 64 + lane]);
        const float r = rsqrtf(wave_sum(v0 * v0 + v1 * v1 + v2 * v2) * (1.f / 192.f) + EPS);
        v0 *= r * gk[lane]; v1 *= r * gk[lane + 64]; v2 *= r * gk[lane + 128];
        const float o = __shfl_xor(v2, 32);
        const float rr = lane < 32 ? v2 * c - o * s : o * s + v2 * c;
        bf16_t* k = ka + (size_t)t * 3072 + h * 192;
        k[lane] = f2bf(v0); k[lane + 64] = f2bf(v1); k[lane + 128] = f2bf(rr);
    }
}

typedef float f32x2 __attribute__((ext_vector_type(2)));
__device__ __forceinline__ unsigned pk4_fp8(float a, float b, float c, float d) {
    int w = __builtin_amdgcn_cvt_pk_fp8_f32(fminf(fmaxf(a, -448.f), 448.f), fminf(fmaxf(b, -448.f), 448.f), 0, false);
    w = __builtin_amdgcn_cvt_pk_fp8_f32(fminf(fmaxf(c, -448.f), 448.f), fminf(fmaxf(d, -448.f), 448.f), w, true); return (unsigned)w; }
__device__ __forceinline__ void cvt_rows_fp8(const float* __restrict__ src, unsigned char* __restrict__ dst, size_t n, float scale, int gw, int NGW, int lane) {
    const size_t nchunk = n / 1024;
    for (size_t c = gw; c < nchunk; c += NGW) { const size_t o = c * 1024 + lane * 16;
        f32x4 a[4];
#pragma unroll
        for (int q = 0; q < 4; ++q) a[q] = *(const f32x4*)(src + o + 4 * q) * scale;
        u32x4 w; w.x = pk4_fp8(a[0][0], a[0][1], a[0][2], a[0][3]); w.y = pk4_fp8(a[1][0], a[1][1], a[1][2], a[1][3]);
        w.z = pk4_fp8(a[2][0], a[2][1], a[2][2], a[2][3]); w.w = pk4_fp8(a[3][0], a[3][1], a[3][2], a[3][3]);
        *(u32x4*)(dst + o) = w; }
}
constexpr float U_SCALE = 64.f, V_SCALE = 4.f;
typedef __bf16 bf16x2_t __attribute__((ext_vector_type(2)));
__device__ __forceinline__ float dot2bf(unsigned a, unsigned b, float c) { return __builtin_amdgcn_fdot2_f32_bf16(__builtin_bit_cast(bf16x2_t, a), __builtin_bit_cast(bf16x2_t, b), c, false); }
#define PEER_INS(top, x) do { float x_ = (x); _Pragma("unroll") for (int i_ = 0; i_ < 16; ++i_) { const float hi_ = fmaxf(top[i_], x_); x_ = fminf(top[i_], x_); top[i_] = hi_; } } while (0)
__device__ __forceinline__ void peer_group(unsigned char* smem, int g, const float* __restrict__ scores, const bf16_t* __restrict__ h2, const float* __restrict__ x1,
                                           const unsigned char* __restrict__ U8, const unsigned char* __restrict__ V8, float* __restrict__ out) {
    const int tid = opaque_tid(), lane = tid & 63, wave = __builtin_amdgcn_readfirstlane(tid >> 6);
    float* topL = (float*)smem;
    int* selE = (int*)(smem + 32768);
    float* selG = (float*)(smem + 49152);
    {
        const int tl = tid >> 4, hc = tid & 15;
        const float* sp = scores + (size_t)(g * 32 + tl) * 2048 + hc * 128;
        float top[16];
#pragma unroll
        for (int i = 0; i < 16; ++i) top[i] = -INFINITY;
#pragma unroll 2
        for (int n0 = 0; n0 < 128; n0 += 4) { const f32x4 v = *(const f32x4*)(sp + n0);
#pragma unroll
            for (int e = 0; e < 4; ++e) PEER_INS(top, __uint_as_float((__float_as_uint(v[e]) & ~0x7Fu) | (unsigned)(n0 + e))); }
        float* tp = topL + (tl * 16 + hc) * 16;
#pragma unroll
        for (int i = 0; i < 16; i += 4) *(f32x4*)(tp + i) = (f32x4){top[i], top[i + 1], top[i + 2], top[i + 3]};
    }
    __syncthreads();
    if (tid < 256) {
        const int tl = tid >> 3, h = tid & 7;
        const float* t1 = topL + (tl * 16 + 2 * h) * 16; const float* t2 = t1 + 16;
        float s1[16], s2[16];
#pragma unroll
        for (int i = 0; i < 16; i += 4) { const f32x4 a = *(const f32x4*)(t1 + i), b2 = *(const f32x4*)(t2 + i);
            s1[i] = a[0]; s1[i + 1] = a[1]; s1[i + 2] = a[2]; s1[i + 3] = a[3]; s2[i] = b2[0]; s2[i + 1] = b2[1]; s2[i + 2] = b2[2]; s2[i + 3] = b2[3]; }
        float ts[16];
#pragma unroll
        for (int i = 0; i < 16; ++i) ts[i] = -INFINITY;
#pragma unroll
        for (int i = 0; i < 16; ++i)
#pragma unroll
            for (int j = 0; j < 16; ++j)
                if ((i + 1) * (j + 1) <= 16) PEER_INS(ts, __uint_as_float((__float_as_uint(s1[i] + s2[j]) & ~0xFFu) | (unsigned)(i * 16 + j)));
        float ex[16], sum = 0.f;
#pragma unroll
        for (int k = 0; k < 16; ++k) { ex[k] = __expf(ts[k] - ts[0]); sum += ex[k]; }
        const float inv = 1.f / sum;
#pragma unroll
        for (int k = 0; k < 16; ++k) { const unsigned pos = __float_as_uint(ts[k]) & 0xFFu;
            const int i1 = (int)(__float_as_uint(t1[pos >> 4]) & 0x7Fu), i2 = (int)(__float_as_uint(t2[pos & 15]) & 0x7Fu);
            selE[tl * 128 + h * 16 + k] = i1 * 128 + i2; selG[tl * 128 + h * 16 + k] = ex[k] * inv; }
    }
    __syncthreads();
    for (int ti = 0; ti < 4; ++ti) {
        const int tl = wave * 4 + ti; const size_t t = (size_t)g * 32 + tl;
        f32x2 hp[16];
#pragma unroll
        for (int j = 0; j < 2; ++j)
#pragma unroll
            for (int q = 0; q < 2; ++q) { const u32x4 w = *(const u32x4*)(h2 + t * DM + j * 1024 + lane * 16 + q * 8);
#pragma unroll
                for (int c = 0; c < 4; ++c) hp[j * 8 + q * 4 + c] = (f32x2){__uint_as_float(w[c] << 16), __uint_as_float(w[c] & 0xffff0000u)}; }
        f32x2 acc[16];
#pragma unroll
        for (int i = 0; i < 16; ++i) acc[i] = (f32x2){0.f, 0.f};
        for (int bb = 0; bb < 16; ++bb) {
            int e[8]; float gt[8];
#pragma unroll
            for (int q = 0; q < 8; ++q) { e[q] = __builtin_amdgcn_readfirstlane(selE[tl * 128 + bb * 8 + q]); gt[q] = selG[tl * 128 + bb * 8 + q]; }
            u32x4 ur[8][2], vr[8][2];
#pragma unroll
            for (int q = 0; q < 8; ++q)
#pragma unroll
                for (int j = 0; j < 2; ++j) ur[q][j] = *(const u32x4*)(U8 + (size_t)e[q] * DM + j * 1024 + lane * 16);
#pragma unroll
            for (int q = 0; q < 8; ++q)
#pragma unroll
                for (int j = 0; j < 2; ++j) vr[q][j] = *(const u32x4*)(V8 + (size_t)e[q] * DM + j * 1024 + lane * 16);
            float d[8];
#pragma unroll
            for (int q = 0; q < 8; ++q) { f32x2 a2 = (f32x2){0.f, 0.f};
#pragma unroll
                for (int j = 0; j < 2; ++j)
#pragma unroll
                    for (int c = 0; c < 4; ++c) { const int w = (int)ur[q][j][c];
                        a2 = __builtin_elementwise_fma(hp[j * 8 + 2 * c], __builtin_amdgcn_cvt_pk_f32_fp8(w, false), a2);
                        a2 = __builtin_elementwise_fma(hp[j * 8 + 2 * c + 1], __builtin_amdgcn_cvt_pk_f32_fp8(w, true), a2); }
                d[q] = a2.x + a2.y; }
            const bool b5 = (lane & 32) != 0, b4 = (lane & 16) != 0, b3 = (lane & 8) != 0;
            float k4[4];
#pragma unroll
            for (int i = 0; i < 4; ++i) k4[i] = (b5 ? d[4 + i] : d[i]) + __shfl_xor(b5 ? d[i] : d[4 + i], 32);
            float k2[2];
#pragma unroll
            for (int i = 0; i < 2; ++i) k2[i] = (b4 ? k4[2 + i] : k4[i]) + __shfl_xor(b4 ? k4[i] : k4[2 + i], 16);
            float c1 = (b3 ? k2[1] : k2[0]) + __shfl_xor(b3 ? k2[0] : k2[1], 8);
            c1 += __shfl_xor(c1, 4); c1 += __shfl_xor(c1, 2); c1 += __shfl_xor(c1, 1);
#pragma unroll
            for (int q = 0; q < 8; ++q) {
                const float a = __uint_as_float((unsigned)__builtin_amdgcn_readlane((int)__float_as_uint(c1), 8 * q)) * (1.f / U_SCALE);
                const float w = gt[q] * 0.5f * a * (1.f + erff(a * 0.70710678118654752f)) * (1.f / V_SCALE);
                const f32x2 w2 = (f32x2){w, w};
#pragma unroll
                for (int j = 0; j < 2; ++j)
#pragma unroll
                    for (int c = 0; c < 4; ++c) { const int x = (int)vr[q][j][c];
                        acc[j * 8 + 2 * c] = __builtin_elementwise_fma(w2, __builtin_amdgcn_cvt_pk_f32_fp8(x, false), acc[j * 8 + 2 * c]);
                        acc[j * 8 + 2 * c + 1] = __builtin_elementwise_fma(w2, __builtin_amdgcn_cvt_pk_f32_fp8(x, true), acc[j * 8 + 2 * c + 1]); }
            }
        }
#pragma unroll
        for (int j = 0; j < 2; ++j)
#pragma unroll
            for (int q = 0; q < 4; ++q) { const size_t o = t * DM + j * 1024 + lane * 16 + q * 4;
                const f32x4 a = *(const f32x4*)(x1 + o);
                *(f32x4*)(out + o) = (f32x4){a[0] + acc[j * 8 + 2 * q].x, a[1] + acc[j * 8 + 2 * q].y, a[2] + acc[j * 8 + 2 * q + 1].x, a[3] + acc[j * 8 + 2 * q + 1].y}; }
    }
    __syncthreads();
}

#define XB_TMO      128
#define XB_XCNT(j)  (256  + 64 * (j))
#define XB_XSUB(j)  (1280 + 64 * (j))
#define XB_XGEN(j)  (2304 + 64 * (j))
#define XB_TOP      3328
#define XB_TOPGEN   3392
#define XCD_BAR_WORDS 3456
#define XB_SPIN_CAP (1u << 18)

__device__ __forceinline__ unsigned xb_ld(unsigned* p)              { return __hip_atomic_load(p, __ATOMIC_RELAXED, __HIP_MEMORY_SCOPE_AGENT); }
__device__ __forceinline__ unsigned xb_add(unsigned* p, unsigned v) { return __hip_atomic_fetch_add(p, v, __ATOMIC_RELAXED, __HIP_MEMORY_SCOPE_AGENT); }
__device__ __forceinline__ unsigned xb_xcc_id() { return (unsigned)__builtin_amdgcn_s_getreg((3 << 11) | 20) & 0xFu; }
#define XB_SPIN(cond, bar) do { unsigned _sp = 0; while (cond) { __builtin_amdgcn_s_sleep(1); \
    if ((++_sp & 255u) == 0u) { if (xb_ld(&(bar)[XB_TMO])) break; if (_sp > XB_SPIN_CAP) { atomicAdd(&(bar)[XB_TMO], 1u); break; } } } } while (0)

struct XcdBarrier {
    unsigned* bar; unsigned x;
    volatile LAS unsigned* st;
};

__device__ __forceinline__ XcdBarrier xcd_barrier_post(unsigned* bar, volatile LAS unsigned* st) {
    XcdBarrier b; b.bar = bar; b.x = xb_xcc_id(); b.st = st;
    if (threadIdx.x == 0) (void)xb_add(&bar[XB_XCNT(b.x)], 1u);
    return b;
}
__device__ __forceinline__ void xcd_barrier_complete(unsigned* bar, unsigned x, unsigned& nloc, unsigned& nx) {
    const unsigned G = gridDim.x * gridDim.y * gridDim.z;
    unsigned sum, cnt, mine, sp = 0u;
    for (;;) {
        sum = 0u; cnt = 0u; mine = 0u;
#pragma unroll
        for (unsigned j = 0; j < 16; ++j) { const unsigned c = xb_ld(&bar[XB_XCNT(j)]); sum += c; cnt += (c > 0u) ? 1u : 0u; mine = (j == x) ? c : mine; }
        if (sum == G) break;
        __builtin_amdgcn_s_sleep(1);
        if ((++sp & 255u) == 0u) { if (xb_ld(&bar[XB_TMO])) break; if (sp > XB_SPIN_CAP) { atomicAdd(&bar[XB_TMO], 1u); break; } }
    }
    nloc = mine > 0u ? mine : 1u; nx = cnt > 0u ? cnt : 1u;
}

__device__ __forceinline__ void xcd_barrier(const XcdBarrier& b) {
    asm volatile("s_waitcnt vmcnt(0)" ::: "memory");
    __syncthreads();
    if (threadIdx.x == 0) {
        unsigned* bar = b.bar;
        __builtin_amdgcn_s_waitcnt(0);
        unsigned nloc = b.st[0], nx = b.st[1];
        if (nloc == 0u) { xcd_barrier_complete(bar, b.x, nloc, nx); b.st[0] = nloc; b.st[1] = nx; }
        const unsigned old = xb_add(&bar[XB_XSUB(b.x)], 1u);
        const unsigned gen = old / nloc;
        if (old + 1u == (gen + 1u) * nloc) {
            __builtin_amdgcn_fence(__ATOMIC_RELEASE, "agent");
            asm volatile("s_waitcnt vmcnt(0)" ::: "memory");
            const unsigned og = xb_add(&bar[XB_TOP], 1u);
            const unsigned tg = og / nx;
            if (og + 1u == (tg + 1u) * nx) xb_add(&bar[XB_TOPGEN], 1u);
            else XB_SPIN(xb_ld(&bar[XB_TOPGEN]) == tg, bar);
            __builtin_amdgcn_fence(__ATOMIC_ACQUIRE, "agent");
            xb_add(&bar[XB_XGEN(b.x)], 1u);
            asm volatile("s_waitcnt vmcnt(0)" ::: "memory");
        } else {
            XB_SPIN(xb_ld(&bar[XB_XGEN(b.x)]) == gen, bar);
            __builtin_amdgcn_fence(__ATOMIC_ACQUIRE, "agent");
            asm volatile("s_waitcnt vmcnt(0)" ::: "memory");
        }
    }
    __syncthreads();
}

#define PROBE_DOUBLE 0
#define REP(k) for (int rep_ = 0; rep_ < ((PROBE_DOUBLE == (k)) ? 2 : 1); ++rep_)
constexpr int LDS_BYTES = 147456;
__global__ __launch_bounds__(512, 2) void mega(Params p) {
    extern __shared__ __attribute__((aligned(16))) unsigned char smem[];
    { volatile LAS unsigned* st0 = (volatile LAS unsigned*)((LAS unsigned char*)smem + 131072); if (threadIdx.x < 2) st0[threadIdx.x] = 0u; }
    __syncthreads();
    const XcdBarrier bar = xcd_barrier_post(p.ctl, (volatile LAS unsigned*)((LAS unsigned char*)smem + 131072));
    float* smf = (float*)smem;
    LAS unsigned char* lds = (LAS unsigned char*)smem;
    const int G = gridDim.x, b = blockIdx.x, NGW = G * 8;
#define PHASE_IDS() const int tid = opaque_tid(), lane = tid & 63, wave = __builtin_amdgcn_readfirstlane(tid >> 6), gw = b * 8 + wave; (void)lane; (void)gw

    REP(7) {
        PHASE_IDS();
        float* scr = smf + wave * 4096;
        constexpr int I_IN = 32 * 355, I_Q = 8 * 96, I_KV = 8 * 128, I_O = 64 * 64;
        for (int it = gw; it < I_IN + I_Q + I_KV + I_O; it += NGW) {
            int r = it;
            if (r < I_IN) { transpose_item(p.w_in, 2048, INW, p.WinT, DstWin(), scr, r, lane); continue; } r -= I_IN;
            if (r < I_Q) { transpose_item(p.w_q_up, 512, 3072, p.WqT, DstId(), scr, r, lane); continue; } r -= I_Q;
            if (r < I_KV) { transpose_item(p.w_kv_up, 512, 4096, p.WkvT, DstId(), scr, r, lane); continue; } r -= I_KV;
            transpose_item(p.w_out, 4096, 2048, p.WoT, DstId(), scr, r, lane);
        }
        for (int m = gw; m < S; m += NGW) rms_row2048(p.x + (size_t)m * DM, p.mix_g, p.h + (size_t)m * DM, lane);
        __syncthreads();
        for (int it = b; it < 512; it += G) wfold_item(p.w_peer_q, p.sub_keys, p.WpT, smf, it);
    }
    xcd_barrier(bar);
    REP(1) {
        pg8::Gemm g{p.h, p.WinT, S, INWP, DM}; pg8::StaticOrder so; so.init(S, INWP, G, b);
        pg8::EpiInProj E{p.cq, p.ckv, p.fq, p.fk, p.fv, p.merged, p.kpe, p.lf, p.b_gate, p.b_forget};
        pg8::gemm_phase<pg8::EpiInProj, pg8::StaticOrder, true, true>(lds, g, so, E);
    }
    xcd_barrier(bar);
    {
    PHASE_IDS();
    for (int t = gw; t < S; t += NGW) { rms_row512_inplace(p.cq + (size_t)t * 512, p.q_lat_g, lane); rms_row512_inplace(p.ckv + (size_t)t * 512, p.kv_lat_g, lane); }
    for (int w = gw; w < S * 16; w += NGW) fox_prep(w, p.fq, p.fk, p.fox_qg, p.fox_kg, p.qn, p.kn, lane);
    for (int hh = b; hh < 16; hh += G) fox_cumsum((double*)smem, hh, p.lf, p.F);
    }
    xcd_barrier(bar);
    REP(2) {
        pg8::Gemm g{p.cq, p.WqT, S, 3072, 512}; pg8::StaticOrder so; so.init(S, 3072, G, b);
        pg8::EpiStoreBf16 E{p.qa, 3072};
        pg8::gemm_phase<pg8::EpiStoreBf16, pg8::StaticOrder, true, true>(lds, g, so, E);
    }
    {
        pg8::Gemm g{p.ckv, p.WkvT, S, 4096, 512}; pg8::StaticOrder so; so.init(S, 4096, G, b);
        pg8::EpiStoreBf16 E{p.kvraw, 4096};
        pg8::gemm_phase<pg8::EpiStoreBf16, pg8::StaticOrder, true, true>(lds, g, so, E);
    }
    xcd_barrier(bar);
    for (int hh = b; hh < 16; hh += G) fox_stats(smf, hh, p.qn, p.kn, p.kall, p.qmaxB);
    { PHASE_IDS(); for (int w = gw; w < S * 16; w += NGW) mla_prep(w, p.qa, p.kvraw, p.kpe, p.pos, p.mla_qg, p.mla_kg, p.ka, lane); }
    xcd_barrier(bar);
    REP(3) for (int L = b; L < 1024; L += G) {
        const int i = L >> 8, vc = L & 255, vcx = (vc & 7) * 32 + (vc >> 3), hh = vcx >> 4, x = vcx & 15, qbk = (i & 1) ? x : 31 - x;
        if (i < 2) att::attn_block<192, false>(smem, p.qa + hh * 192, 3072, p.ka + hh * 192, 3072, p.kvraw + hh * 256 + 128, 4096, nullptr, p.merged + hh * 128, p.attout + hh * 128, qbk, 0.f);
        else att::attn_block<128, true>(smem, p.fq + hh * 128, 2048, p.fk + hh * 128, 2048, p.fv + hh * 128, 2048, p.F + (size_t)hh * S, p.merged + 2048 + hh * 128, p.attout + 2048 + hh * 128, qbk, p.kall[hh] * p.qmaxB[hh * 32 + qbk]);
    }
    xcd_barrier(bar);
    REP(4) {
        pg8::Gemm g{p.attout, p.WoT, S, 2048, 4096}; pg8::StaticOrder so; so.init(S, 2048, G, b);
        pg8::EpiStoreF32<true> E{p.x1, p.x, 2048};
        pg8::gemm_phase<pg8::EpiStoreF32<true>, pg8::StaticOrder, true, true>(lds, g, so, E);
    }
    xcd_barrier(bar);
    { PHASE_IDS(); for (int m = gw; m < S; m += NGW) rms_row2048(p.x1 + (size_t)m * DM, p.ffn_g, p.h + (size_t)m * DM, lane);
      cvt_rows_fp8(p.peer_u, p.U8, (size_t)16384 * 2048, U_SCALE, gw, NGW, lane); cvt_rows_fp8(p.peer_v, p.V8, (size_t)16384 * 2048, V_SCALE, gw, NGW, lane); }
    xcd_barrier(bar);
    REP(5) {
        pg8::Gemm g{p.h, p.WpT, S, 2048, 2048}; pg8::StaticOrder so; so.init(S, 2048, G, b);
        pg8::EpiStoreF32<false> E{p.scores, nullptr, 2048};
        pg8::gemm_phase<pg8::EpiStoreF32<false>, pg8::StaticOrder, true, true>(lds, g, so, E);
    }
    xcd_barrier(bar);
    REP(6) for (int g = b; g < S / 32; g += G) peer_group(smem, g, p.scores, p.h, p.x1, p.U8, p.V8, p.out);
}

extern "C" void kernel_launch(void* const* d_in, const int* in_sizes, int n_in,
                              void* d_out, int out_size, void* d_ws, size_t ws_size,
                              hipStream_t stream) {
    if (ws_size < 512 * MiB) { fprintf(stderr, "kernel_launch: workspace too small (%zu)\n", ws_size); return; }
    Params p{};
    p.x = (const float*)d_in[0]; p.pos = (const int*)d_in[1]; p.mix_g = (const float*)d_in[2]; p.w_in = (const float*)d_in[3];
    p.b_forget = (const float*)d_in[4]; p.b_gate = (const float*)d_in[5]; p.q_lat_g = (const float*)d_in[6]; p.w_q_up = (const float*)d_in[7];
    p.kv_lat_g = (const float*)d_in[8]; p.w_kv_up = (const float*)d_in[9]; p.mla_qg = (const float*)d_in[10]; p.mla_kg = (const float*)d_in[11];
    p.fox_qg = (const float*)d_in[12]; p.fox_kg = (const float*)d_in[13]; p.w_out = (const float*)d_in[14]; p.ffn_g = (const float*)d_in[15];
    p.w_peer_q = (const float*)d_in[16]; p.sub_keys = (const float*)d_in[17]; p.peer_u = (const float*)d_in[18]; p.peer_v = (const float*)d_in[19];
    p.out = (float*)d_out;
    char* ws = (char*)d_ws;
    p.WqT = (bf16_t*)(ws + 1 * MiB); p.WkvT = (bf16_t*)(ws + 5 * MiB); p.WoT = (bf16_t*)(ws + 9 * MiB); p.WpT = (bf16_t*)(ws + 25 * MiB); p.WinT = (bf16_t*)(ws + 33 * MiB);
    p.h = (bf16_t*)(ws + 78 * MiB); p.cq = (bf16_t*)(ws + 110 * MiB); p.ckv = (bf16_t*)(ws + 118 * MiB);
    p.fq = (bf16_t*)(ws + 126 * MiB); p.fk = (bf16_t*)(ws + 158 * MiB); p.fv = (bf16_t*)(ws + 190 * MiB); p.merged = (bf16_t*)(ws + 222 * MiB);
    p.kpe = (bf16_t*)(ws + 286 * MiB); p.lf = (float*)(ws + 287 * MiB); p.F = (float*)(ws + 287 * MiB + 512 * 1024);
    p.qa = (bf16_t*)(ws + 288 * MiB); p.kvraw = (bf16_t*)(ws + 336 * MiB); p.ka = (bf16_t*)(ws + 400 * MiB); p.x1 = (float*)(ws + 448 * MiB);
    p.scores = (float*)(ws + 222 * MiB);
    p.ctl = (unsigned*)ws;
    p.qn = (float*)(ws + 4 * MiB); p.kn = (float*)(ws + 4 * MiB + 512 * 1024); p.kall = (float*)(ws + 32 * 1024); p.qmaxB = (float*)(ws + 36 * 1024);
    p.attout = (bf16_t*)(ws + 33 * MiB);
    p.U8 = (unsigned char*)(ws + 126 * MiB); p.V8 = (unsigned char*)(ws + 158 * MiB);

    static int grid_blocks = 0;
    if (!grid_blocks) {
        if (hipFuncSetAttribute((const void*)mega, hipFuncAttributeMaxDynamicSharedMemorySize, LDS_BYTES) != hipSuccess) { fprintf(stderr, "hipFuncSetAttribute failed\n"); return; }
        int dev = 0, cus = 0, per_cu = 0;
        (void)hipGetDevice(&dev);
        (void)hipDeviceGetAttribute(&cus, hipDeviceAttributeMultiprocessorCount, dev);
        (void)hipOccupancyMaxActiveBlocksPerMultiprocessor(&per_cu, (const void*)mega, 512, LDS_BYTES);
        if (per_cu < 1 || cus < 1) { fprintf(stderr, "occupancy query says %d blocks/CU on %d CUs\n", per_cu, cus); return; }
        grid_blocks = cus;
    }
    if (hipMemsetAsync(d_ws, 0, 16384, stream) != hipSuccess) { fprintf(stderr, "memset of the barrier words failed\n"); return; }
    void* args[] = {&p};
    hipError_t e = hipLaunchCooperativeKernel((const void*)mega, dim3(grid_blocks), dim3(512), args, LDS_BYTES, stream);
    if (e != hipSuccess) fprintf(stderr, "cooperative launch failed: %s (grid %d)\n", hipGetErrorString(e), grid_blocks);
}
```

```cpp
#include <hip/hip_runtime.h>
#include <hip/hip_cooperative_groups.h>
#include <stdint.h>
#include <math.h>
#include <cstdio>
namespace cg = cooperative_groups;

namespace pg8 {
#define PG8_LAS __attribute__((address_space(3)))
typedef unsigned short bf16_t;
typedef short bf16x8 __attribute__((ext_vector_type(8)));
typedef float f32x4 __attribute__((ext_vector_type(4)));
typedef unsigned u32x4 __attribute__((ext_vector_type(4)));
constexpr int BM = 256, BK = 64, HALF = 128, HTB = HALF * BK * 2  , STAGE_BYTES = 8 * HTB, NXCD = 8, WGM = 8;

__host__ __device__ __forceinline__ int lds_byte(int r, int c) { const int st = (r >> 4) * 2 + (c >> 5), rr = r & 15, cc = c & 31, ob = rr * 64 + cc * 2; return st * 1024 + (ob ^ (((ob >> 9) & 1) << 5)); }
__host__ __device__ __forceinline__ void stage_rc(int b, int& R, int& C) { const int st = b / 1024, sb = b % 1024, swz = sb ^ (((sb >> 9) & 1) << 5); R = (st >> 1) * 16 + swz / 64; C = (st & 1) * 32 + (swz % 64) / 2; }
__host__ __device__ __forceinline__ int perm32(int rho) { const int n = rho >> 4, i = rho & 15; return 8 * (i >> 2) + 4 * n + (i & 3); }

struct Unit { int pm, pn; };
struct Gemm { const bf16_t* A; const bf16_t* Bt; int M, N, K; };

struct StaticOrder {
    int nM, nN, nwg, G, c;
    __host__ __device__ void init(int M, int N, int G_, int c_) { nM = M / BM; nN = N / BM; nwg = nM * nN; G = G_; c = c_; }
    __host__ __device__ bool next(int i, Unit& u) const {
        const long L = (long)i * G + c; if (L >= nwg) return false;
        int wgid = (int)L; { const int q = nwg / NXCD, r = nwg % NXCD, xcd = wgid % NXCD, off = wgid / NXCD; wgid = (xcd < r ? xcd * (q + 1) : r * (q + 1) + (xcd - r) * q) + off; }
        const int nig = WGM * nN, gid = wgid / nig, fm = gid * WGM, gsz = (nM - fm) < WGM ? (nM - fm) : WGM;
        u.pm = fm + ((wgid % nig) % gsz); u.pn = (wgid % nig) / gsz; return true;
    }
    __device__ __forceinline__ void a_ready(const Unit&) const {}
    __device__ __forceinline__ void done(const Unit&) const {}
};

__device__ __forceinline__ unsigned cvt_pk_bf16(float lo, float hi) { unsigned r; asm volatile("v_cvt_pk_bf16_f32 %0, %1, %2" : "=v"(r) : "v"(lo), "v"(hi)); return r; }
__device__ __forceinline__ u32x4 pack8bf(const f32x4& v0, const f32x4& v1) { u32x4 w; w.x = cvt_pk_bf16(v0[0], v0[1]); w.y = cvt_pk_bf16(v0[2], v0[3]); w.z = cvt_pk_bf16(v1[0], v1[1]); w.w = cvt_pk_bf16(v1[2], v1[3]); return w; }

struct EpiStoreBf16 {
    static constexpr bool PERM = true, AFTER_DRAIN = false;
    bf16_t* O; int ldc;
    __device__ __forceinline__ void operator()(const f32x4 (&acc)[2][2][4][2], const Unit& u, int wr, int wc, int fr, int fq) const {
        const int row0 = u.pm * BM + wr * 64 + fr, col0 = u.pn * BM + wc * 32 + 8 * fq;
#pragma unroll
        for (int ai = 0; ai < 2; ++ai)
#pragma unroll
            for (int m = 0; m < 4; ++m) { bf16_t* rowp = O + (size_t)(row0 + ai * HALF + m * 16) * ldc + col0;
#pragma unroll
                for (int bj = 0; bj < 2; ++bj) *(u32x4*)(rowp + bj * HALF) = pack8bf(acc[ai][bj][m][0], acc[ai][bj][m][1]); }
    }
};
template <bool RES> struct EpiStoreF32 {
    static constexpr bool PERM = true, AFTER_DRAIN = false;
    float* O; const float* res; int ldc;
    __device__ __forceinline__ void operator()(const f32x4 (&acc)[2][2][4][2], const Unit& u, int wr, int wc, int fr, int fq) const {
        const int row0 = u.pm * BM + wr * 64 + fr, col0 = u.pn * BM + wc * 32 + 8 * fq;
#pragma unroll
        for (int ai = 0; ai < 2; ++ai)
#pragma unroll
            for (int m = 0; m < 4; ++m) { const size_t off = (size_t)(row0 + ai * HALF + m * 16) * ldc + col0;
#pragma unroll
                for (int bj = 0; bj < 2; ++bj) { f32x4 v0 = acc[ai][bj][m][0], v1 = acc[ai][bj][m][1];
                    if (RES) { v0 += *(const f32x4*)(res + off + bj * HALF); v1 += *(const f32x4*)(res + off + bj * HALF + 4); }
                    *(f32x4*)(O + off + bj * HALF) = v0; *(f32x4*)(O + off + bj * HALF + 4) = v1; } }
    }
};
struct EpiInProj {
    static constexpr bool PERM = true, AFTER_DRAIN = false;
    bf16_t *cq, *ckv, *fq, *fk, *fv, *gates, *kpe; float* lf; const float *b_gate, *b_forget;
    __device__ __forceinline__ void operator()(const f32x4 (&acc)[2][2][4][2], const Unit& u, int wr, int wc, int fr, int fq_) const {
        const int pn = u.pn, row0 = u.pm * BM + wr * 64 + fr, cw = wc * 32 + 8 * fq_;
        if (pn < 28) {
            bf16_t* base; int ldc, colt;
            if (pn < 2) { base = cq; ldc = 512; colt = pn * 256; } else if (pn < 4) { base = ckv; ldc = 512; colt = (pn - 2) * 256; }
            else if (pn < 12) { base = fq; ldc = 2048; colt = (pn - 4) * 256; } else if (pn < 20) { base = fk; ldc = 2048; colt = (pn - 12) * 256; }
            else { base = fv; ldc = 2048; colt = (pn - 20) * 256; }
#pragma unroll
            for (int ai = 0; ai < 2; ++ai)
#pragma unroll
                for (int m = 0; m < 4; ++m) { bf16_t* rowp = base + (size_t)(row0 + ai * HALF + m * 16) * ldc + colt + cw;
#pragma unroll
                    for (int bj = 0; bj < 2; ++bj) *(u32x4*)(rowp + bj * HALF) = pack8bf(acc[ai][bj][m][0], acc[ai][bj][m][1]); }
        } else if (pn < 44) {
            const int colt = (pn - 28) * 256 + cw;
#pragma unroll
            for (int bj = 0; bj < 2; ++bj) {
                const f32x4 b0 = *(const f32x4*)(b_gate + colt + bj * HALF), b1 = *(const f32x4*)(b_gate + colt + bj * HALF + 4);
#pragma unroll
                for (int ai = 0; ai < 2; ++ai)
#pragma unroll
                    for (int m = 0; m < 4; ++m) {
                        f32x4 v0 = acc[ai][bj][m][0] + b0, v1 = acc[ai][bj][m][1] + b1;
#pragma unroll
                        for (int e = 0; e < 4; ++e) { v0[e] = 1.f / (1.f + __expf(-v0[e])); v1[e] = 1.f / (1.f + __expf(-v1[e])); }
                        *(u32x4*)(gates + (size_t)(row0 + ai * HALF + m * 16) * 4096 + colt + bj * HALF) = pack8bf(v0, v1); }
            }
        } else {
            if (cw < 64) {
#pragma unroll
                for (int ai = 0; ai < 2; ++ai)
#pragma unroll
                    for (int m = 0; m < 4; ++m) *(u32x4*)(kpe + (size_t)(row0 + ai * HALF + m * 16) * 64 + cw) = pack8bf(acc[ai][0][m][0], acc[ai][0][m][1]);
            } else if (cw < 80) {
                const int h0 = cw - 64;
                const f32x4 b0 = *(const f32x4*)(b_forget + h0), b1 = *(const f32x4*)(b_forget + h0 + 4);
#pragma unroll
                for (int ai = 0; ai < 2; ++ai)
#pragma unroll
                    for (int m = 0; m < 4; ++m) { const int row = row0 + ai * HALF + m * 16;
                        f32x4 z0 = acc[ai][0][m][0] + b0, z1 = acc[ai][0][m][1] + b1;
#pragma unroll
                        for (int e = 0; e < 4; ++e) { z0[e] = fminf(z0[e], 0.f) - __logf(1.f + __expf(-fabsf(z0[e]))); z1[e] = fminf(z1[e], 0.f) - __logf(1.f + __expf(-fabsf(z1[e]))); }
                        *(f32x4*)(lf + (size_t)row * 16 + h0) = z0; *(f32x4*)(lf + (size_t)row * 16 + h0 + 4) = z1; }
            }
        }
    }
};
template <class Epi, class Sched, bool ALIGN_EPI = false, bool SP2 = false>
__device__ __forceinline__ void gemm_phase(PG8_LAS unsigned char* lds, const Gemm g, const Sched& S, const Epi& E) {
    const int tid = threadIdx.x, wid = __builtin_amdgcn_readfirstlane(tid >> 6), lane = tid & 63, wr = wid >> 2, wc = wid & 3, fr = lane & 15, fq = lane >> 4;
    const int K = g.K, nt = K / BK;
    unsigned voffA[2], voffB[2];
#pragma unroll
    for (int i = 0; i < 2; ++i) { int R, C; stage_rc(tid * 16 + i * 8192, R, C); const int Rb = Epi::PERM ? ((R & ~31) + perm32(R & 31)) : R;
        voffA[i] = (unsigned)(R * K + C) * 2u; voffB[i] = (unsigned)(Rb * K + C) * 2u; }
    const size_t kstep = (size_t)(BK * 2);
    const size_t hstep = (size_t)HALF * K * 2;
    const size_t tstep = 2 * hstep;
    const unsigned ldsw = (unsigned)wid * 1024u;
    const int aoff = lds_byte(wr * 64 + fr, fq * 8), boff = lds_byte(wc * 32 + fr, fq * 8);
#define PG8_SA(b, h) (((b) * 2 + (h)) * HTB)
#define PG8_SB(b, h) ((4 + (b) * 2 + (h)) * HTB)
#define PG8_STAGE(bufoff, gbase, voff) do { _Pragma("unroll") for (int _i = 0; _i < 2; ++_i) \
        __builtin_amdgcn_global_load_lds((const unsigned*)((const char*)(gbase) + (voff)[_i]), (PG8_LAS unsigned*)(lds + (bufoff) + ldsw + _i * 8192), 16, 0, 0); } while (0)
#define PG8_LDA(dst, b, h) do { _Pragma("unroll") for (int m = 0; m < 4; ++m) _Pragma("unroll") for (int k = 0; k < 2; ++k) dst[m][k] = *(const PG8_LAS bf16x8*)(lds + PG8_SA(b, h) + aoff + m * 2048 + k * 1024); } while (0)
#define PG8_LDB(dst, b, h) do { _Pragma("unroll") for (int n = 0; n < 2; ++n) _Pragma("unroll") for (int k = 0; k < 2; ++k) dst[n][k] = *(const PG8_LAS bf16x8*)(lds + PG8_SB(b, h) + boff + n * 2048 + k * 1024); } while (0)
#define PG8_MMA(ai, bj, At, Bt) do { __builtin_amdgcn_s_setprio(1); _Pragma("unroll") for (int m = 0; m < 4; ++m) _Pragma("unroll") for (int n = 0; n < 2; ++n) _Pragma("unroll") for (int k = 0; k < 2; ++k) \
        acc[ai][bj][m][n] = __builtin_amdgcn_mfma_f32_16x16x32_bf16(Bt[n][k], At[m][k], acc[ai][bj][m][n], 0, 0, 0); __builtin_amdgcn_s_setprio(0); } while (0)
#define PG8_WAIT_V(n) asm volatile("s_waitcnt vmcnt(" #n ")" ::: "memory")
#define PG8_WAIT_L(n) asm volatile("s_waitcnt lgkmcnt(" #n ")" ::: "memory")
#define PG8_BAR __builtin_amdgcn_s_barrier()
#define PG8_SCHED __builtin_amdgcn_sched_barrier(0)
    Unit cur, nxt; int ui = 0;
    if (!S.next(0, cur)) return;
    f32x4 acc[2][2][4][2];
#pragma unroll
    for (int a = 0; a < 2; ++a)
#pragma unroll
        for (int b = 0; b < 2; ++b)
#pragma unroll
            for (int m = 0; m < 4; ++m)
#pragma unroll
                for (int n = 0; n < 2; ++n) acc[a][b][m][n] = (f32x4){0.f, 0.f, 0.f, 0.f};
    bf16x8 At[4][2], B0[2][2], B1[2][2];
    const char* cA = (const char*)g.A + (size_t)cur.pm * tstep; const char* cB = (const char*)g.Bt + (size_t)cur.pn * tstep;
    S.a_ready(cur);
    if constexpr (SP2) {
        PG8_STAGE(PG8_SB(0, 0), cB, voffB); PG8_STAGE(PG8_SB(0, 1), cB + hstep, voffB); PG8_STAGE(PG8_SA(0, 0), cA, voffA); PG8_STAGE(PG8_SA(0, 1), cA + hstep, voffA);
        if (wr == 1) PG8_BAR;
        PG8_WAIT_V(2); PG8_BAR;
        PG8_STAGE(PG8_SB(1, 0), cB + kstep, voffB); PG8_STAGE(PG8_SA(1, 0), cA + kstep, voffA); PG8_STAGE(PG8_SB(1, 1), cB + hstep + kstep, voffB);
        PG8_WAIT_V(6); PG8_BAR;
    } else {
        PG8_STAGE(PG8_SB(0, 0), cB, voffB); PG8_STAGE(PG8_SA(0, 0), cA, voffA); PG8_STAGE(PG8_SB(0, 1), cB + hstep, voffB); PG8_STAGE(PG8_SA(0, 1), cA + hstep, voffA);
        if (wr == 1) PG8_BAR;
        PG8_WAIT_V(4); PG8_BAR;
        PG8_STAGE(PG8_SB(1, 0), cB + kstep, voffB); PG8_STAGE(PG8_SA(1, 0), cA + kstep, voffA); PG8_STAGE(PG8_SB(1, 1), cB + hstep + kstep, voffB);
        PG8_WAIT_V(6); PG8_BAR;
    }
    for (;;) {
        const bool has_next = S.next(ui + 1, nxt);
        const char* nA = has_next ? (const char*)g.A + (size_t)nxt.pm * tstep : cA; const char* nB = has_next ? (const char*)g.Bt + (size_t)nxt.pn * tstep : cB;
        for (int t = 0; t < nt; t += 2) {
            const bool last = (t == nt - 2);
            const char* a1 = cA + (size_t)(t + 1) * kstep;
            const char* a2 = last ? nA : cA + (size_t)(t + 2) * kstep; const char* b2 = last ? nB : cB + (size_t)(t + 2) * kstep;
            const char* a3 = a2 + kstep; const char* b3 = b2 + kstep;
            if (last && has_next) S.a_ready(nxt);
            if constexpr (SP2) {
            PG8_LDB(B0, 0, 0); PG8_LDB(B1, 0, 1); PG8_SCHED; PG8_LDA(At, 0, 0); PG8_STAGE(PG8_SA(1, 1), a1 + hstep, voffA);
            PG8_WAIT_V(8); PG8_WAIT_L(0); PG8_BAR; PG8_MMA(0, 0, At, B0); PG8_MMA(0, 1, At, B1); PG8_BAR; PG8_SCHED;
            PG8_LDA(At, 0, 1); PG8_STAGE(PG8_SB(0, 0), b2, voffB); PG8_STAGE(PG8_SB(0, 1), b2 + hstep, voffB); PG8_STAGE(PG8_SA(0, 0), a2, voffA);
            PG8_WAIT_V(8); PG8_WAIT_L(0); PG8_BAR; PG8_MMA(1, 0, At, B0); PG8_MMA(1, 1, At, B1); PG8_BAR; PG8_SCHED;
            PG8_LDB(B0, 1, 0); PG8_LDB(B1, 1, 1); PG8_SCHED; PG8_LDA(At, 1, 0); PG8_STAGE(PG8_SA(0, 1), a2 + hstep, voffA);
            PG8_WAIT_V(8); PG8_WAIT_L(0); PG8_BAR; PG8_MMA(0, 0, At, B0); PG8_MMA(0, 1, At, B1); PG8_BAR; PG8_SCHED;
            PG8_LDA(At, 1, 1); PG8_STAGE(PG8_SB(1, 0), b3, voffB); PG8_STAGE(PG8_SB(1, 1), b3 + hstep, voffB); PG8_STAGE(PG8_SA(1, 0), a3, voffA);
            PG8_WAIT_V(8); PG8_WAIT_L(0); PG8_BAR; PG8_MMA(1, 0, At, B0); PG8_MMA(1, 1, At, B1); PG8_BAR; PG8_SCHED;
            } else {
            PG8_LDB(B0, 0, 0); PG8_SCHED; PG8_LDA(At, 0, 0); PG8_STAGE(PG8_SA(1, 1), a1 + hstep, voffA);
            PG8_WAIT_L(8); PG8_BAR; PG8_WAIT_L(0); PG8_MMA(0, 0, At, B0); PG8_BAR; PG8_SCHED;
            PG8_LDB(B1, 0, 1); PG8_STAGE(PG8_SB(0, 0), b2, voffB);
            PG8_BAR; PG8_WAIT_L(0); PG8_MMA(0, 1, At, B1); PG8_BAR;
            PG8_LDA(At, 0, 1); PG8_STAGE(PG8_SA(0, 0), a2, voffA);
            PG8_BAR; PG8_WAIT_L(0); PG8_MMA(1, 0, At, B0); PG8_BAR; PG8_SCHED;
            PG8_STAGE(PG8_SB(0, 1), b2 + hstep, voffB);
            PG8_WAIT_V(6); PG8_BAR; PG8_MMA(1, 1, At, B1); PG8_BAR;
            PG8_LDB(B0, 1, 0); PG8_SCHED; PG8_LDA(At, 1, 0); PG8_STAGE(PG8_SA(0, 1), a2 + hstep, voffA);
            PG8_WAIT_L(8); PG8_BAR; PG8_WAIT_L(0); PG8_MMA(0, 0, At, B0); PG8_BAR; PG8_SCHED;
            PG8_LDB(B1, 1, 1); PG8_STAGE(PG8_SB(1, 0), b3, voffB);
            PG8_BAR; PG8_WAIT_L(0); PG8_MMA(0, 1, At, B1); PG8_BAR;
            PG8_LDA(At, 1, 1); PG8_STAGE(PG8_SA(1, 0), a3, voffA);
            PG8_BAR; PG8_WAIT_L(0); PG8_MMA(1, 0, At, B0); PG8_BAR; PG8_SCHED;
            PG8_STAGE(PG8_SB(1, 1), b3 + hstep, voffB);
            PG8_WAIT_V(6); PG8_BAR; PG8_MMA(1, 1, At, B1); PG8_BAR;
            }
        }
        if constexpr (ALIGN_EPI) { if (wr == 0) PG8_BAR; }
        if constexpr (!Epi::AFTER_DRAIN) { E(acc, cur, wr, wc, fr, fq); S.done(cur); }
        if (!has_next) break;
#pragma unroll
        for (int a = 0; a < 2; ++a)
#pragma unroll
            for (int b = 0; b < 2; ++b)
#pragma unroll
                for (int m = 0; m < 4; ++m)
#pragma unroll
                    for (int n = 0; n < 2; ++n) acc[a][b][m][n] = (f32x4){0.f, 0.f, 0.f, 0.f};
        cur = nxt; cA = nA; cB = nB; ++ui;
        if constexpr (ALIGN_EPI) { if (wr == 1) PG8_BAR; }
    }
    PG8_WAIT_V(0);
    if constexpr (!ALIGN_EPI) { if (wr == 0) PG8_BAR; }
    PG8_BAR;
    if constexpr (Epi::AFTER_DRAIN) { E.fused(acc, cur, wr, wc, fr, fq, lds, wid, lane); S.done(cur); }
#undef PG8_SA
#undef PG8_SB
#undef PG8_STAGE
#undef PG8_LDA
#undef PG8_LDB
#undef PG8_MMA
#undef PG8_WAIT_V
#undef PG8_WAIT_L
#undef PG8_BAR
#undef PG8_SCHED
}
}
namespace att {
typedef unsigned short bf16_t;
typedef short bf16x8 __attribute__((ext_vector_type(8)));
typedef short s16x4 __attribute__((ext_vector_type(4)));
typedef float f32x16 __attribute__((ext_vector_type(16)));
typedef float f32x4 __attribute__((ext_vector_type(4)));
typedef unsigned u32x4 __attribute__((ext_vector_type(4)));
#define ALAS __attribute__((address_space(3)))
#define ASBAR() __builtin_amdgcn_sched_barrier(0)
constexpr int SHM_V = 16384;
template <int DK> struct Lay { static constexpr int ROWB = DK * 2, SHM_K = 64 * ROWB, OFF_K = 2 * SHM_V, OFF_F = OFF_K + 2 * SHM_K, OFF_WS = OFF_F + 512, TOTAL = OFF_WS + 8 * 256; };

__device__ __forceinline__ int v_st(int k, int c) { const int kk = (k & ~0xC) | ((k & 4) << 1) | ((k & 8) >> 1); return ((kk >> 3) * 4 + (c >> 5)) * 512 + ((kk & 7) * 32 + (c & 31)) * 2; }
__device__ __forceinline__ int v_rd_base(int lane) { return ((lane & 3) << 3) | (((lane >> 2) & 3) << 6) | (((lane >> 4) & 1) << 5) | (((lane >> 5) & 1) << 8); }
__device__ __forceinline__ int crow(int r, int hi) { return (r & 3) + 8 * (r >> 2) + 4 * hi; }
__device__ __forceinline__ unsigned cvtpk(float lo, float hi) { unsigned r; asm volatile("v_cvt_pk_bf16_f32 %0, %1, %2" : "=v"(r) : "v"(lo), "v"(hi)); return r; }

__device__ __forceinline__ float wave_max_f(float v) {
#pragma unroll
    for (int o = 32; o >= 1; o >>= 1) v = fmaxf(v, __shfl_xor(v, o));
    return v;
}
template <int DK, bool FOX>
__device__ __forceinline__ void attn_block(unsigned char* smem, const bf16_t* __restrict__ Q, int ldq, const bf16_t* __restrict__ K, int ldk, const bf16_t* __restrict__ V, int ldv,
                                           const float* __restrict__ Fh, const bf16_t* __restrict__ gate, bf16_t* __restrict__ gout  , int qbk, const float* __restrict__ gq, const float* __restrict__ gk  ) {
    typedef Lay<DK> LY;
    constexpr int ND = DK / 16, NKC = DK / 8, NKI = (64 * NKC) / 512;
    int tid = threadIdx.x; asm volatile("" : "+v"(tid));
    const int wid = __builtin_amdgcn_readfirstlane(tid >> 6), lane = tid & 63, r32 = lane & 31, hi = lane >> 5;
    const int q0 = qbk * 256, qlo = q0 + wid * 32, qm = qlo + r32 - 4 * hi;
    const int NT = 4 * qbk + 4;
    ALAS unsigned char* lds = (ALAS unsigned char*)smem;
    ALAS float* F_lds = (ALAS float*)(lds + LY::OFF_F);
    ALAS float* wsl = (ALAS float*)(lds + LY::OFF_WS) + wid * 64;
    bf16x8 qr[ND];
#pragma unroll
    for (int d0 = 0; d0 < ND; ++d0) qr[d0] = *(const bf16x8*)(Q + (size_t)(qlo + r32) * ldq + d0 * 16 + hi * 8);
    const float fq = FOX ? Fh[qlo + r32] : 0.f;
    int kgo[NKI], klo[NKI];
#pragma unroll
    for (int i = 0; i < NKI; ++i) { const int idx = tid + 512 * i, row = idx / NKC, ch = idx % NKC; kgo[i] = row * ldk + ch * 8; klo[i] = row * LY::ROWB + ((ch ^ ((row >> 1) & 7)) << 4); }
    const int sr = tid >> 4, sc = (tid & 15) * 8, vst0 = v_st(sr, sc), vst1 = v_st(32 + sr, sc);
    const int vgo0 = sr * ldv + sc, vgo1 = (32 + sr) * ldv + sc;
    const int vb0 = (int)(uintptr_t)smem + v_rd_base(lane);
    int kbase[4];
#pragma unroll
    for (int dd = 0; dd < 4; ++dd) kbase[dd] = LY::OFF_K + r32 * LY::ROWB + (((((dd << 1) | hi) ^ ((r32 >> 1) & 7))) << 4);
    bf16x8 stk[NKI], stv0, stv1; float stf = 0.f;
#define ATT_LOAD(kb) do { _Pragma("unroll") for (int i = 0; i < NKI; ++i) stk[i] = *(const bf16x8*)(K + (size_t)(kb) * ldk + kgo[i]); \
        stv0 = *(const bf16x8*)(V + (size_t)(kb) * ldv + vgo0); stv1 = *(const bf16x8*)(V + (size_t)(kb) * ldv + vgo1); if (FOX && tid < 64) stf = Fh[(kb) + tid]; } while (0)
#define ATT_WRITE(bf) do { _Pragma("unroll") for (int i = 0; i < NKI; ++i) *(ALAS bf16x8*)(lds + LY::OFF_K + (bf) * LY::SHM_K + klo[i]) = stk[i]; \
        *(ALAS bf16x8*)(lds + (bf) * SHM_V + vst0) = stv0; *(ALAS bf16x8*)(lds + (bf) * SHM_V + vst1) = stv1; if (FOX && tid < 64) F_lds[(bf) * 64 + tid] = stf; } while (0)
    int t_start = 0;
    if (FOX) {
        const float gqm = wave_max_f(fmaxf(fabsf(gq[lane]), fabsf(gq[lane + 64]))), gkm = wave_max_f(fmaxf(fabsf(gk[lane]), fabsf(gk[lane + 64])));
        const float qk_bound = 0.12751743f * 128.f * gqm * gkm;
        const float thr = 2.02f * qk_bound + 40.f, f0 = Fh[q0];
        const int j0 = lane, j1 = lane + 64;
        const bool c0 = (j0 < 4 * qbk) && (Fh[j0 * 64 + 63] - f0 >= thr), c1 = (j1 < 4 * qbk) && (Fh[(j1 < 4 * qbk ? j1 : 0) * 64 + 63] - f0 >= thr);
        t_start = __builtin_popcountll(__ballot(c0)) + __builtin_popcountll(__ballot(c1));
        t_start = __builtin_amdgcn_readfirstlane(t_start); }
    ATT_LOAD(t_start * 64); ATT_WRITE(t_start & 1);
    float m_reg = -1e30f, l_reg = 0.f; f32x16 o[4];
#pragma unroll
    for (int d = 0; d < 4; ++d)
#pragma unroll
        for (int r = 0; r < 16; ++r) o[d][r] = 0.f;
    for (int t = t_start; t < NT; ++t) {
        const int buf = t & 1, kb = t * 64;
        __syncthreads();
        if (t + 1 < NT) ATT_LOAD(kb + 64);
        f32x16 p0, p1;
        if (FOX) {
#pragma unroll
            for (int g = 0; g < 4; ++g) { const f32x4 f0 = *(const ALAS f32x4*)(F_lds + buf * 64 + 8 * g + 4 * hi), f1 = *(const ALAS f32x4*)(F_lds + buf * 64 + 32 + 8 * g + 4 * hi);
#pragma unroll
                for (int e = 0; e < 4; ++e) { p0[4 * g + e] = fq - f0[e]; p1[4 * g + e] = fq - f1[e]; } }
        } else {
#pragma unroll
            for (int r = 0; r < 16; ++r) { p0[r] = 0.f; p1[r] = 0.f; }
        }
#pragma unroll
        for (int d0 = 0; d0 < ND; ++d0) {
            ALAS const unsigned char* a = lds + buf * LY::SHM_K + kbase[d0 & 3] + (d0 >> 2) * 128;
            const bf16x8 b0 = *(const ALAS bf16x8*)a;
            const bf16x8 b1 = *(const ALAS bf16x8*)(a + 32 * LY::ROWB);
            p0 = __builtin_amdgcn_mfma_f32_32x32x16_bf16(b0, qr[d0], p0, 0, 0, 0);
            p1 = __builtin_amdgcn_mfma_f32_32x32x16_bf16(b1, qr[d0], p1, 0, 0, 0);
        }
        if (kb + 63 > qlo) {
            const float NEG = -__builtin_inff(); const int dq = qm - kb;
#pragma unroll
            for (int r = 0; r < 16; ++r) { const int c = (r & 3) + 8 * (r >> 2); if (dq - c < 0) p0[r] = NEG; if (dq - c - 32 < 0) p1[r] = NEG; }
        }
        float pmax = p0[0];
#pragma unroll
        for (int r = 1; r < 16; ++r) pmax = fmaxf(pmax, p0[r]);
#pragma unroll
        for (int r = 0; r < 16; ++r) pmax = fmaxf(pmax, p1[r]);
        { auto rr = __builtin_amdgcn_permlane32_swap(__float_as_uint(pmax), __float_as_uint(pmax), false, false);
          pmax = fmaxf(__uint_as_float(rr[0]), __uint_as_float(rr[1])); }
        float mn, alpha;
        if (__builtin_expect(__all(pmax - m_reg <= 8.f), 1)) { mn = m_reg; alpha = 1.f; }
        else { mn = fmaxf(m_reg, pmax); alpha = __builtin_amdgcn_exp2f(m_reg - mn); m_reg = mn; }
        float ps = 0.f;
#pragma unroll
        for (int r = 0; r < 16; ++r) { p0[r] = __builtin_amdgcn_exp2f(p0[r] - mn); ps += p0[r]; }
#pragma unroll
        for (int r = 0; r < 16; ++r) { p1[r] = __builtin_amdgcn_exp2f(p1[r] - mn); ps += p1[r]; }
        { auto rr = __builtin_amdgcn_permlane32_swap(__float_as_uint(ps), __float_as_uint(ps), false, false);
          ps = __uint_as_float(rr[0]) + __uint_as_float(rr[1]); }
        l_reg = l_reg * alpha + ps;
        bf16x8 pa0, pa1, pa2, pa3;
#define ATT_PK4(P, B_, OUT) do { unsigned a0 = cvtpk(P[B_+0], P[B_+1]), a1 = cvtpk(P[B_+2], P[B_+3]); unsigned b0_ = cvtpk(P[B_+4], P[B_+5]), b1_ = cvtpk(P[B_+6], P[B_+7]); \
        auto r0 = __builtin_amdgcn_permlane32_swap(a0, b0_, false, false); auto r1 = __builtin_amdgcn_permlane32_swap(a1, b1_, false, false); \
        u32x4 w = {r0[0], r1[0], r0[1], r1[1]}; OUT = *reinterpret_cast<bf16x8*>(&w); } while (0)
        ATT_PK4(p0, 0, pa0); ATT_PK4(p0, 8, pa1); ATT_PK4(p1, 0, pa2); ATT_PK4(p1, 8, pa3);
        if (__any(alpha < 1.f)) {
            if (hi == 0) wsl[r32] = alpha;
            asm volatile("s_waitcnt lgkmcnt(0)" ::: "memory");
#pragma unroll
            for (int g = 0; g < 4; ++g) { const f32x4 al = *(const ALAS f32x4*)(wsl + 8 * g + 4 * hi);
#pragma unroll
                for (int d = 0; d < 4; ++d)
#pragma unroll
                    for (int e = 0; e < 4; ++e) o[d][4 * g + e] *= al[e]; }
        }
#define ATT_TRRD(dst, off) asm volatile("ds_read_b64_tr_b16 %0, %1 offset:%2" : "=&v"(dst) : "v"(vbb), "i"(off) : "memory")
#define ATT_PV(d0) do { s16x4 l0, l1, l2, l3, h0, h1, h2, h3; constexpr int b_ = (d0) * 512; \
        ATT_TRRD(l0, b_); ATT_TRRD(h0, b_ + 2048); ATT_TRRD(l1, b_ + 4096); ATT_TRRD(h1, b_ + 6144); ATT_TRRD(l2, b_ + 8192); ATT_TRRD(h2, b_ + 10240); ATT_TRRD(l3, b_ + 12288); ATT_TRRD(h3, b_ + 14336); \
        asm volatile("s_waitcnt lgkmcnt(0)" ::: "memory"); ASBAR(); \
        o[d0] = __builtin_amdgcn_mfma_f32_32x32x16_bf16(pa0, (bf16x8){l0[0], l0[1], l0[2], l0[3], h0[0], h0[1], h0[2], h0[3]}, o[d0], 0, 0, 0); \
        o[d0] = __builtin_amdgcn_mfma_f32_32x32x16_bf16(pa1, (bf16x8){l1[0], l1[1], l1[2], l1[3], h1[0], h1[1], h1[2], h1[3]}, o[d0], 0, 0, 0); \
        o[d0] = __builtin_amdgcn_mfma_f32_32x32x16_bf16(pa2, (bf16x8){l2[0], l2[1], l2[2], l2[3], h2[0], h2[1], h2[2], h2[3]}, o[d0], 0, 0, 0); \
        o[d0] = __builtin_amdgcn_mfma_f32_32x32x16_bf16(pa3, (bf16x8){l3[0], l3[1], l3[2], l3[3], h3[0], h3[1], h3[2], h3[3]}, o[d0], 0, 0, 0); } while (0)
        { const int vbb = vb0 + buf * SHM_V; ATT_PV(0); ATT_PV(1); ATT_PV(2); ATT_PV(3); }
        if (t + 1 < NT) ATT_WRITE(buf ^ 1);
    }
    if (hi == 0) wsl[r32] = l_reg;
    asm volatile("s_waitcnt lgkmcnt(0)" ::: "memory");
#pragma unroll
    for (int r = 0; r < 16; ++r) {
        const int orow = crow(r, hi); const float rli = __builtin_amdgcn_rcpf(wsl[orow]);
        bf16_t* rowp = gout + (size_t)(qlo + orow) * 4096; const bf16_t* growp = gate + (size_t)(qlo + orow) * 4096;
#pragma unroll
        for (int d0 = 0; d0 < 4; ++d0) {
            const float v = o[d0][r] * rli; const float vn = __shfl_xor(v, 1);
            if ((r32 & 1) == 0) { unsigned* gp = (unsigned*)(rowp + d0 * 32 + r32); const unsigned g = *(const unsigned*)(growp + d0 * 32 + r32);
                *gp = cvtpk(v * __uint_as_float(g << 16), vn * __uint_as_float(g & 0xffff0000u)); }
        }
    }
    __syncthreads();
#undef ATT_LOAD
#undef ATT_WRITE
#undef ATT_PK4
#undef ATT_TRRD
#undef ATT_PV
}
}
using pg8::bf16_t; using pg8::f32x4; using pg8::u32x4;
#define LAS __attribute__((address_space(3)))
constexpr int S = 8192, DM = 2048, INW = 11344, INWP = 11520;
constexpr float EPS = 1e-6f;
constexpr size_t MiB = 1u << 20;

__device__ __forceinline__ float bf2f(bf16_t v) { return __uint_as_float(((unsigned)v) << 16); }
__device__ __forceinline__ bf16_t f2bf(float f) { unsigned u = __float_as_uint(f); u += 0x7fffu + ((u >> 16) & 1u); return (bf16_t)(u >> 16); }
__device__ __forceinline__ unsigned pk2(float lo, float hi) { return (unsigned)f2bf(lo) | ((unsigned)f2bf(hi) << 16); }
__device__ __forceinline__ float wave_sum(float v) {
#pragma unroll
    for (int o = 32; o >= 1; o >>= 1) v += __shfl_xor(v, o);
    return v;
}
__device__ __forceinline__ float wave_max(float v) {
#pragma unroll
    for (int o = 32; o >= 1; o >>= 1) v = fmaxf(v, __shfl_xor(v, o));
    return v;
}

__device__ __forceinline__ int opaque_tid() { int t = threadIdx.x; asm volatile("" : "+v"(t)); return t; }

struct Params {
    const float* x; const int* pos; const float *mix_g, *w_in, *b_forget, *b_gate, *q_lat_g, *w_q_up, *kv_lat_g, *w_kv_up, *mla_qg, *mla_kg, *fox_qg, *fox_kg, *w_out, *ffn_g, *w_peer_q, *sub_keys, *peer_u, *peer_v;
    float* out;
    bf16_t *WqT, *WkvT, *WoT, *WpT, *WinT;
    bf16_t *h, *cq, *ckv, *fq, *fk, *fv, *merged, *kpe, *qa, *kvraw, *ka;
    float *lf, *F, *x1, *scores;
    unsigned char *U8, *V8; bf16_t* attout;
    unsigned* ctl;
    float2* ropeT;
};

struct DstId { __device__ __forceinline__ int operator()(int n) const { return n; } };
struct DstWin { __device__ __forceinline__ int operator()(int n) const {
    if (n < 1024) return n; if (n < 1088) return 11264 + (n - 1024); if (n < 7232) return n - 64; if (n < 7248) return 11264 + 64 + (n - 7232); return n - 80; } };
template <class Dst>
__device__ __forceinline__ void transpose_item(const float* __restrict__ W, int K, int N, bf16_t* __restrict__ WT, Dst dst, float* scr, int item, int lane) {
    const int nblk = (N + 31) / 32, kb = item / nblk, nb = item % nblk, k0 = 64 * kb, n0 = 32 * nb;
    { const int n = n0 + (lane & 31);
#pragma unroll 8
      for (int i = 0; i < 32; ++i) { const int kk = 2 * i + (lane >> 5); scr[kk * 33 + (lane & 31)] = (n < N) ? W[(size_t)(k0 + kk) * N + n] : 0.f; } }
    asm volatile("s_waitcnt lgkmcnt(0)" ::: "memory");
    const int c = lane & 7;
#pragma unroll
    for (int j = 0; j < 4; ++j) { const int nl = (lane >> 3) + 8 * j, n = n0 + nl; const float* s = scr + (8 * c) * 33 + nl;
        u32x4 o; o.x = pk2(s[0 * 33], s[1 * 33]); o.y = pk2(s[2 * 33], s[3 * 33]); o.z = pk2(s[4 * 33], s[5 * 33]); o.w = pk2(s[6 * 33], s[7 * 33]);
        if (n < N) *(u32x4*)(WT + (size_t)dst(n) * K + k0 + 8 * c) = o; }
    asm volatile("s_waitcnt lgkmcnt(0)" ::: "memory");
}
__device__ __forceinline__ void wfold_item(const float* __restrict__ wq, const float* __restrict__ keys, bf16_t* __restrict__ WpT, float* sm, int item) {
    const int tid = opaque_tid(), hc = item >> 5, d0 = (item & 31) * 64;
    float* keysL = sm; float* wqL = sm + 128 * 129;
    for (int idx = tid; idx < 128 * 128; idx += 512) keysL[(idx >> 7) * 129 + (idx & 127)] = keys[(size_t)hc * 16384 + idx];
    for (int idx = tid; idx < 64 * 128; idx += 512) wqL[(idx >> 7) * 129 + (idx & 127)] = wq[(size_t)(d0 + (idx >> 7)) * 2048 + hc * 128 + (idx & 127)];
    __syncthreads();
    const int n = tid & 127, dq = tid >> 7;
    float acc[16];
#pragma unroll
    for (int i = 0; i < 16; ++i) acc[i] = 0.f;
    for (int j = 0; j < 128; ++j) { const float kv = keysL[n * 129 + j];
#pragma unroll
        for (int i = 0; i < 16; ++i) acc[i] += kv * wqL[(dq * 16 + i) * 129 + j]; }
    u32x4 o0, o1;
    o0.x = pk2(acc[0], acc[1]); o0.y = pk2(acc[2], acc[3]); o0.z = pk2(acc[4], acc[5]); o0.w = pk2(acc[6], acc[7]);
    o1.x = pk2(acc[8], acc[9]); o1.y = pk2(acc[10], acc[11]); o1.z = pk2(acc[12], acc[13]); o1.w = pk2(acc[14], acc[15]);
    bf16_t* dstp = WpT + (size_t)(hc * 128 + n) * 2048 + d0 + dq * 16;
    *(u32x4*)dstp = o0; *(u32x4*)(dstp + 8) = o1;
    __syncthreads();
}
__device__ __forceinline__ void rms_row2048(const float* __restrict__ xr, const float* __restrict__ g, bf16_t* __restrict__ orow, int lane) {
    f32x4 v[8]; float ss = 0.f;
#pragma unroll
    for (int j = 0; j < 8; ++j) { v[j] = *(const f32x4*)(xr + j * 256 + lane * 4); ss += (v[j][0] * v[j][0] + v[j][1] * v[j][1]) + (v[j][2] * v[j][2] + v[j][3] * v[j][3]); }
    const float r = rsqrtf(wave_sum(ss) * (1.f / 2048.f) + EPS);
#pragma unroll
    for (int j = 0; j < 8; ++j) { const f32x4 gg = *(const f32x4*)(g + j * 256 + lane * 4);
        uint2 o; o.x = pk2(v[j][0] * r * gg[0], v[j][1] * r * gg[1]); o.y = pk2(v[j][2] * r * gg[2], v[j][3] * r * gg[3]);
        *(uint2*)(orow + j * 256 + lane * 4) = o; }
}
__device__ __forceinline__ void rms_row512_inplace(bf16_t* __restrict__ row, const float* __restrict__ g, int lane) {
    u32x4 w = *(const u32x4*)(row + lane * 8); float v[8];
#pragma unroll
    for (int i = 0; i < 4; ++i) { v[2 * i] = __uint_as_float(w[i] << 16); v[2 * i + 1] = __uint_as_float(w[i] & 0xffff0000u); }
    float ss = 0.f;
#pragma unroll
    for (int i = 0; i < 8; ++i) ss += v[i] * v[i];
    const float r = rsqrtf(wave_sum(ss) * (1.f / 512.f) + EPS);
    u32x4 o;
#pragma unroll
    for (int i = 0; i < 4; ++i) o[i] = pk2(v[2 * i] * r * g[lane * 8 + 2 * i], v[2 * i + 1] * r * g[lane * 8 + 2 * i + 1]);
    *(u32x4*)(row + lane * 8) = o;
}
__device__ __forceinline__ void fox_prep(int w, bf16_t* __restrict__ fq, bf16_t* __restrict__ fk, const float* __restrict__ gq, const float* __restrict__ gk, int lane) {
    const int t = w >> 4, h = w & 15;
#pragma unroll
    for (int which = 0; which < 2; ++which) {
        bf16_t* p = (which ? fk : fq) + (size_t)t * 2048 + h * 128; const float* g = which ? gk : gq;
        const float v0 = bf2f(p[lane]), v1 = bf2f(p[lane + 64]);
        const float r = rsqrtf(wave_sum(v0 * v0 + v1 * v1) * (1.f / 128.f) + EPS);
        const float qs = which ? 1.f : 0.12751743f;
        p[lane] = f2bf(v0 * r * g[lane] * qs); p[lane + 64] = f2bf(v1 * r * g[lane + 64] * qs);
    }
}
__device__ __forceinline__ void fox_cumsum(double* part, int h, const float* __restrict__ lf, float* __restrict__ F) {
    const int tid = opaque_tid(), lane = tid & 63, wave = tid >> 6;
    float v[16]; double sum = 0.0;
#pragma unroll
    for (int i = 0; i < 16; ++i) { v[i] = lf[(size_t)(tid * 16 + i) * 16 + h]; sum += (double)v[i]; }
    double inc = sum;
#pragma unroll
    for (int o = 1; o < 64; o <<= 1) { const double n = __shfl_up(inc, o); if (lane >= o) inc += n; }
    if (lane == 63) part[wave] = inc;
    __syncthreads();
    double base = 0.0;
    for (int w = 0; w < wave; ++w) base += part[w];
    double run = base + inc - sum;
#pragma unroll
    for (int i = 0; i < 16; ++i) { run += (double)v[i]; F[(size_t)h * S + tid * 16 + i] = (float)(run * 1.4426950408889634); }
    __syncthreads();
}
__device__ __forceinline__ void rope_table(const int* __restrict__ pos, float2* __restrict__ ropeT, int gtid, int nthreads) {
    for (int idx = gtid; idx < S * 32; idx += nthreads) { const int t = idx >> 5, i = idx & 31;
        const double inv = exp(-(double)i * (1.0 / 32.0) * 9.210340371976184);
        double ang = (double)((float)pos[t] * (float)inv);
        const double twopi = 6.283185307179586;
        ang -= twopi * rint(ang / twopi);
        ropeT[idx] = make_float2(cosf((float)ang), sinf((float)ang)); }
}
__device__ __forceinline__ void mla_prep(int w, bf16_t* __restrict__ qa, const bf16_t* __restrict__ kvraw, const bf16_t* __restrict__ kpe, const float2* __restrict__ ropeT,
                                         const float* __restrict__ gq, const float* __restrict__ gk, bf16_t* __restrict__ ka, int lane) {
    const int t = w >> 4, h = w & 15;
    const float2 cs = ropeT[t * 32 + (lane & 31)]; const float c = cs.x, s = cs.y;
    {
        bf16_t* q = qa + (size_t)t * 3072 + h * 192;
        float v0 = bf2f(q[lane]), v1 = bf2f(q[lane + 64]), v2 = bf2f(q[lane + 128]);
        const float r = rsqrtf(wave_sum(v0 * v0 + v1 * v1 + v2 * v2) * (1.f / 192.f) + EPS);
        v0 *= r * gq[lane]; v1 *= r * gq[lane + 64]; v2 *= r * gq[lane + 128];
        const float o = __shfl_xor(v2, 32);
        const float rr = lane < 32 ? v2 * c - o * s : o * s + v2 * c;
        q[lane] = f2bf(v0 * 0.10411754f); q[lane + 64] = f2bf(v1 * 0.10411754f); q[lane + 128] = f2bf(rr * 0.10411754f);
    }
    {
        const bf16_t* kn = kvraw + (size_t)t * 4096 + h * 256;
        float v0 = bf2f(kn[lane]), v1 = bf2f(kn[lane + 64]), v2 = bf2f(kpe[(size_t)t * 64 + lane]);
        const float r = rsqrtf(wave_sum(v0 * v0 + v1 * v1 + v2 * v2) * (1.f / 192.f) + EPS);
        v0 *= r * gk[lane]; v1 *= r * gk[lane + 64]; v2 *= r * gk[lane + 128];
        const float o = __shfl_xor(v2, 32);
        const float rr = lane < 32 ? v2 * c - o * s : o * s + v2 * c;
        bf16_t* k = ka + (size_t)t * 3072 + h * 192;
        k[lane] = f2bf(v0); k[lane + 64] = f2bf(v1); k[lane + 128] = f2bf(rr);
    }
}

typedef float f32x2 __attribute__((ext_vector_type(2)));
__device__ __forceinline__ unsigned pk4_fp8(float a, float b, float c, float d) {
    int w = __builtin_amdgcn_cvt_pk_fp8_f32(fminf(fmaxf(a, -448.f), 448.f), fminf(fmaxf(b, -448.f), 448.f), 0, false);
    w = __builtin_amdgcn_cvt_pk_fp8_f32(fminf(fmaxf(c, -448.f), 448.f), fminf(fmaxf(d, -448.f), 448.f), w, true); return (unsigned)w; }
__device__ __forceinline__ void cvt_rows_fp8(const float* __restrict__ src, unsigned char* __restrict__ dst, size_t n, float scale, int gw, int NGW, int lane) {
    const size_t nchunk = n / 1024;
    for (size_t c = gw; c < nchunk; c += NGW) { const size_t o = c * 1024 + lane * 16;
        f32x4 a[4];
#pragma unroll
        for (int q = 0; q < 4; ++q) a[q] = *(const f32x4*)(src + o + 4 * q) * scale;
        u32x4 w; w.x = pk4_fp8(a[0][0], a[0][1], a[0][2], a[0][3]); w.y = pk4_fp8(a[1][0], a[1][1], a[1][2], a[1][3]);
        w.z = pk4_fp8(a[2][0], a[2][1], a[2][2], a[2][3]); w.w = pk4_fp8(a[3][0], a[3][1], a[3][2], a[3][3]);
        *(u32x4*)(dst + o) = w; }
}
constexpr float U_SCALE = 64.f, V_SCALE = 4.f;
typedef __bf16 bf16x2_t __attribute__((ext_vector_type(2)));
__device__ __forceinline__ float dot2bf(unsigned a, unsigned b, float c) { return __builtin_amdgcn_fdot2_f32_bf16(__builtin_bit_cast(bf16x2_t, a), __builtin_bit_cast(bf16x2_t, b), c, false); }
#define PEER_INS(top, x) do { float x_ = (x); _Pragma("unroll") for (int i_ = 0; i_ < 16; ++i_) { const float hi_ = fmaxf(top[i_], x_); x_ = fminf(top[i_], x_); top[i_] = hi_; } } while (0)
__device__ __forceinline__ void peer_group(unsigned char* smem, int g, const float* __restrict__ scores, const bf16_t* __restrict__ h2, const float* __restrict__ x1,
                                           const unsigned char* __restrict__ U8, const unsigned char* __restrict__ V8, float* __restrict__ out) {
    const int tid = opaque_tid(), lane = tid & 63, wave = __builtin_amdgcn_readfirstlane(tid >> 6);
    float* topL = (float*)smem;
    int* selE = (int*)(smem + 32768);
    float* selG = (float*)(smem + 49152);
    {
        const int tl = tid >> 4, hc = tid & 15;
        const float* sp = scores + (size_t)(g * 32 + tl) * 2048 + hc * 128;
        float top[16];
#pragma unroll
        for (int i = 0; i < 16; ++i) top[i] = -INFINITY;
#pragma unroll 2
        for (int n0 = 0; n0 < 128; n0 += 4) { const f32x4 v = *(const f32x4*)(sp + n0);
#pragma unroll
            for (int e = 0; e < 4; ++e) PEER_INS(top, __uint_as_float((__float_as_uint(v[e]) & ~0x7Fu) | (unsigned)(n0 + e))); }
        float* tp = topL + (tl * 16 + hc) * 16;
#pragma unroll
        for (int i = 0; i < 16; i += 4) *(f32x4*)(tp + i) = (f32x4){top[i], top[i + 1], top[i + 2], top[i + 3]};
    }
    __syncthreads();
    if (tid < 256) {
        const int tl = tid >> 3, h = tid & 7;
        const float* t1 = topL + (tl * 16 + 2 * h) * 16; const float* t2 = t1 + 16;
        float s1[16], s2[16];
#pragma unroll
        for (int i = 0; i < 16; i += 4) { const f32x4 a = *(const f32x4*)(t1 + i), b2 = *(const f32x4*)(t2 + i);
            s1[i] = a[0]; s1[i + 1] = a[1]; s1[i + 2] = a[2]; s1[i + 3] = a[3]; s2[i] = b2[0]; s2[i + 1] = b2[1]; s2[i + 2] = b2[2]; s2[i + 3] = b2[3]; }
        float ts[16];
#pragma unroll
        for (int i = 0; i < 16; ++i) ts[i] = -INFINITY;
#pragma unroll
        for (int i = 0; i < 16; ++i)
#pragma unroll
            for (int j = 0; j < 16; ++j)
                if ((i + 1) * (j + 1) <= 16) PEER_INS(ts, __uint_as_float((__float_as_uint(s1[i] + s2[j]) & ~0xFFu) | (unsigned)(i * 16 + j)));
        float ex[16], sum = 0.f;
#pragma unroll
        for (int k = 0; k < 16; ++k) { ex[k] = __expf(ts[k] - ts[0]); sum += ex[k]; }
        const float inv = 1.f / sum;
#pragma unroll
        for (int k = 0; k < 16; ++k) { const unsigned pos = __float_as_uint(ts[k]) & 0xFFu;
            const int i1 = (int)(__float_as_uint(t1[pos >> 4]) & 0x7Fu), i2 = (int)(__float_as_uint(t2[pos & 15]) & 0x7Fu);
            selE[tl * 128 + h * 16 + k] = i1 * 128 + i2; selG[tl * 128 + h * 16 + k] = ex[k] * inv; }
    }
    __syncthreads();
    for (int ti = 0; ti < 4; ++ti) {
        const int tl = wave * 4 + ti; const size_t t = (size_t)g * 32 + tl;
        f32x2 hp[16];
#pragma unroll
        for (int j = 0; j < 2; ++j)
#pragma unroll
            for (int q = 0; q < 2; ++q) { const u32x4 w = *(const u32x4*)(h2 + t * DM + j * 1024 + lane * 16 + q * 8);
#pragma unroll
                for (int c = 0; c < 4; ++c) hp[j * 8 + q * 4 + c] = (f32x2){__uint_as_float(w[c] << 16), __uint_as_float(w[c] & 0xffff0000u)}; }
        f32x2 acc[16];
#pragma unroll
        for (int i = 0; i < 16; ++i) acc[i] = (f32x2){0.f, 0.f};
        for (int bb = 0; bb < 16; ++bb) {
            int e[8]; float gt[8];
#pragma unroll
            for (int q = 0; q < 8; ++q) { e[q] = __builtin_amdgcn_readfirstlane(selE[tl * 128 + bb * 8 + q]); gt[q] = selG[tl * 128 + bb * 8 + q]; }
            u32x4 ur[8][2], vr[8][2];
#pragma unroll
            for (int q = 0; q < 8; ++q)
#pragma unroll
                for (int j = 0; j < 2; ++j) ur[q][j] = *(const u32x4*)(U8 + (size_t)e[q] * DM + j * 1024 + lane * 16);
#pragma unroll
            for (int q = 0; q < 8; ++q)
#pragma unroll
                for (int j = 0; j < 2; ++j) vr[q][j] = *(const u32x4*)(V8 + (size_t)e[q] * DM + j * 1024 + lane * 16);
            float d[8];
#pragma unroll
            for (int q = 0; q < 8; ++q) { f32x2 a2 = (f32x2){0.f, 0.f};
#pragma unroll
                for (int j = 0; j < 2; ++j)
#pragma unroll
                    for (int c = 0; c < 4; ++c) { const int w = (int)ur[q][j][c];
                        a2 = __builtin_elementwise_fma(hp[j * 8 + 2 * c], __builtin_amdgcn_cvt_pk_f32_fp8(w, false), a2);
                        a2 = __builtin_elementwise_fma(hp[j * 8 + 2 * c + 1], __builtin_amdgcn_cvt_pk_f32_fp8(w, true), a2); }
                d[q] = a2.x + a2.y; }
            const bool b5 = (lane & 32) != 0, b4 = (lane & 16) != 0, b3 = (lane & 8) != 0;
            float k4[4];
#pragma unroll
            for (int i = 0; i < 4; ++i) k4[i] = (b5 ? d[4 + i] : d[i]) + __shfl_xor(b5 ? d[i] : d[4 + i], 32);
            float k2[2];
#pragma unroll
            for (int i = 0; i < 2; ++i) k2[i] = (b4 ? k4[2 + i] : k4[i]) + __shfl_xor(b4 ? k4[i] : k4[2 + i], 16);
            float c1 = (b3 ? k2[1] : k2[0]) + __shfl_xor(b3 ? k2[0] : k2[1], 8);
            c1 += __shfl_xor(c1, 4); c1 += __shfl_xor(c1, 2); c1 += __shfl_xor(c1, 1);
#pragma unroll
            for (int q = 0; q < 8; ++q) {
                const float a = __uint_as_float((unsigned)__builtin_amdgcn_readlane((int)__float_as_uint(c1), 8 * q)) * (1.f / U_SCALE);
                const float w = gt[q] * 0.5f * a * (1.f + erff(a * 0.70710678118654752f)) * (1.f / V_SCALE);
                const f32x2 w2 = (f32x2){w, w};
#pragma unroll
                for (int j = 0; j < 2; ++j)
#pragma unroll
                    for (int c = 0; c < 4; ++c) { const int x = (int)vr[q][j][c];
                        acc[j * 8 + 2 * c] = __builtin_elementwise_fma(w2, __builtin_amdgcn_cvt_pk_f32_fp8(x, false), acc[j * 8 + 2 * c]);
                        acc[j * 8 + 2 * c + 1] = __builtin_elementwise_fma(w2, __builtin_amdgcn_cvt_pk_f32_fp8(x, true), acc[j * 8 + 2 * c + 1]); }
            }
        }
#pragma unroll
        for (int j = 0; j < 2; ++j)
#pragma unroll
            for (int q = 0; q < 4; ++q) { const size_t o = t * DM + j * 1024 + lane * 16 + q * 4;
                const f32x4 a = *(const f32x4*)(x1 + o);
                *(f32x4*)(out + o) = (f32x4){a[0] + acc[j * 8 + 2 * q].x, a[1] + acc[j * 8 + 2 * q].y, a[2] + acc[j * 8 + 2 * q + 1].x, a[3] + acc[j * 8 + 2 * q + 1].y}; }
    }
    __syncthreads();
}

#define XB_TMO      128
#define XB_XCNT(j)  (256  + 64 * (j))
#define XB_XSUB(j)  (1280 + 64 * (j))
#define XB_XGEN(j)  (2304 + 64 * (j))
#define XB_TOP      3328
#define XB_TOPGEN   3392
#define XCD_BAR_WORDS 3456
#define XB_SPIN_CAP (1u << 18)

__device__ __forceinline__ unsigned xb_ld(unsigned* p)              { return __hip_atomic_load(p, __ATOMIC_RELAXED, __HIP_MEMORY_SCOPE_AGENT); }
__device__ __forceinline__ unsigned xb_add(unsigned* p, unsigned v) { return __hip_atomic_fetch_add(p, v, __ATOMIC_RELAXED, __HIP_MEMORY_SCOPE_AGENT); }
__device__ __forceinline__ unsigned xb_xcc_id() { return (unsigned)__builtin_amdgcn_s_getreg((3 << 11) | 20) & 0xFu; }
#define XB_SPIN(cond, bar) do { unsigned _sp = 0; while (cond) { __builtin_amdgcn_s_sleep(1); \
    if ((++_sp & 255u) == 0u) { if (xb_ld(&(bar)[XB_TMO])) break; if (_sp > XB_SPIN_CAP) { atomicAdd(&(bar)[XB_TMO], 1u); break; } } } } while (0)

struct XcdBarrier {
    unsigned* bar; unsigned x;
    volatile LAS unsigned* st;
};

__device__ __forceinline__ XcdBarrier xcd_barrier_post(unsigned* bar, volatile LAS unsigned* st) {
    XcdBarrier b; b.bar = bar; b.x = xb_xcc_id(); b.st = st;
    if (threadIdx.x == 0) (void)xb_add(&bar[XB_XCNT(b.x)], 1u);
    return b;
}
__device__ __forceinline__ void xcd_barrier_complete(unsigned* bar, unsigned x, unsigned& nloc, unsigned& nx) {
    const unsigned G = gridDim.x * gridDim.y * gridDim.z;
    unsigned sum, cnt, mine, sp = 0u;
    for (;;) {
        sum = 0u; cnt = 0u; mine = 0u;
#pragma unroll
        for (unsigned j = 0; j < 16; ++j) { const unsigned c = xb_ld(&bar[XB_XCNT(j)]); sum += c; cnt += (c > 0u) ? 1u : 0u; mine = (j == x) ? c : mine; }
        if (sum == G) break;
        __builtin_amdgcn_s_sleep(1);
        if ((++sp & 255u) == 0u) { if (xb_ld(&bar[XB_TMO])) break; if (sp > XB_SPIN_CAP) { atomicAdd(&bar[XB_TMO], 1u); break; } }
    }
    nloc = mine > 0u ? mine : 1u; nx = cnt > 0u ? cnt : 1u;
}

__device__ __forceinline__ void xcd_barrier(const XcdBarrier& b) {
    asm volatile("s_waitcnt vmcnt(0)" ::: "memory");
    __syncthreads();
    if (threadIdx.x == 0) {
        unsigned* bar = b.bar;
        __builtin_amdgcn_s_waitcnt(0);
        unsigned nloc = b.st[0], nx = b.st[1];
        if (nloc == 0u) { xcd_barrier_complete(bar, b.x, nloc, nx); b.st[0] = nloc; b.st[1] = nx; }
        const unsigned old = xb_add(&bar[XB_XSUB(b.x)], 1u);
        const unsigned gen = old / nloc;
        if (old + 1u == (gen + 1u) * nloc) {
            __builtin_amdgcn_fence(__ATOMIC_RELEASE, "agent");
            asm volatile("s_waitcnt vmcnt(0)" ::: "memory");
            const unsigned og = xb_add(&bar[XB_TOP], 1u);
            const unsigned tg = og / nx;
            if (og + 1u == (tg + 1u) * nx) xb_add(&bar[XB_TOPGEN], 1u);
            else XB_SPIN(xb_ld(&bar[XB_TOPGEN]) == tg, bar);
            __builtin_amdgcn_fence(__ATOMIC_ACQUIRE, "agent");
            xb_add(&bar[XB_XGEN(b.x)], 1u);
            asm volatile("s_waitcnt vmcnt(0)" ::: "memory");
        } else {
            XB_SPIN(xb_ld(&bar[XB_XGEN(b.x)]) == gen, bar);
            __builtin_amdgcn_fence(__ATOMIC_ACQUIRE, "agent");
            asm volatile("s_waitcnt vmcnt(0)" ::: "memory");
        }
    }
    __syncthreads();
}

#define PROBE_DOUBLE 0
#define REP(k) for (int rep_ = 0; rep_ < ((PROBE_DOUBLE == (k)) ? 2 : 1); ++rep_)
constexpr int LDS_BYTES = 147456;
__global__ __launch_bounds__(512, 2) void mega(Params p) {
    extern __shared__ __attribute__((aligned(16))) unsigned char smem[];
    { volatile LAS unsigned* st0 = (volatile LAS unsigned*)((LAS unsigned char*)smem + 131072); if (threadIdx.x < 2) st0[threadIdx.x] = 0u; }
    __syncthreads();
    const XcdBarrier bar = xcd_barrier_post(p.ctl, (volatile LAS unsigned*)((LAS unsigned char*)smem + 131072));
    float* smf = (float*)smem;
    LAS unsigned char* lds = (LAS unsigned char*)smem;
    const int G = gridDim.x, b = blockIdx.x, NGW = G * 8;
#define PHASE_IDS() const int tid = opaque_tid(), lane = tid & 63, wave = __builtin_amdgcn_readfirstlane(tid >> 6), gw = b * 8 + wave; (void)lane; (void)gw

    REP(7) {
        PHASE_IDS();
        float* scr = smf + wave * 4096;
        constexpr int I_IN = 32 * 355, I_Q = 8 * 96, I_KV = 8 * 128, I_O = 64 * 64;
        for (int it = gw; it < I_IN + I_Q + I_KV + I_O; it += NGW) {
            int r = it;
            if (r < I_IN) { transpose_item(p.w_in, 2048, INW, p.WinT, DstWin(), scr, r, lane); continue; } r -= I_IN;
            if (r < I_Q) { transpose_item(p.w_q_up, 512, 3072, p.WqT, DstId(), scr, r, lane); continue; } r -= I_Q;
            if (r < I_KV) { transpose_item(p.w_kv_up, 512, 4096, p.WkvT, DstId(), scr, r, lane); continue; } r -= I_KV;
            transpose_item(p.w_out, 4096, 2048, p.WoT, DstId(), scr, r, lane);
        }
        for (int m = gw; m < S; m += NGW) rms_row2048(p.x + (size_t)m * DM, p.mix_g, p.h + (size_t)m * DM, lane);
        __syncthreads();
        for (int it = b; it < 512; it += G) wfold_item(p.w_peer_q, p.sub_keys, p.WpT, smf, it);
    }
    xcd_barrier(bar);
    REP(1) {
        pg8::Gemm g{p.h, p.WinT, S, INWP, DM}; pg8::StaticOrder so; so.init(S, INWP, G, b);
        pg8::EpiInProj E{p.cq, p.ckv, p.fq, p.fk, p.fv, p.merged, p.kpe, p.lf, p.b_gate, p.b_forget};
        pg8::gemm_phase<pg8::EpiInProj, pg8::StaticOrder, true, true>(lds, g, so, E);
    }
    xcd_barrier(bar);
    {
    PHASE_IDS();
    for (int t = gw; t < S; t += NGW) { rms_row512_inplace(p.cq + (size_t)t * 512, p.q_lat_g, lane); rms_row512_inplace(p.ckv + (size_t)t * 512, p.kv_lat_g, lane); }
    for (int w = gw; w < S * 16; w += NGW) fox_prep(w, p.fq, p.fk, p.fox_qg, p.fox_kg, lane);
    rope_table(p.pos, p.ropeT, b * 512 + tid, G * 512);
    for (int hh = b; hh < 16; hh += G) fox_cumsum((double*)smem, hh, p.lf, p.F);
    }
    xcd_barrier(bar);
    REP(2) {
        pg8::Gemm g{p.cq, p.WqT, S, 3072, 512}; pg8::StaticOrder so; so.init(S, 3072, G, b);
        pg8::EpiStoreBf16 E{p.qa, 3072};
        pg8::gemm_phase<pg8::EpiStoreBf16, pg8::StaticOrder, true, true>(lds, g, so, E);
    }
    {
        pg8::Gemm g{p.ckv, p.WkvT, S, 4096, 512}; pg8::StaticOrder so; so.init(S, 4096, G, b);
        pg8::EpiStoreBf16 E{p.kvraw, 4096};
        pg8::gemm_phase<pg8::EpiStoreBf16, pg8::StaticOrder, true, true>(lds, g, so, E);
    }
    xcd_barrier(bar);
    { PHASE_IDS(); for (int w = gw; w < S * 16; w += NGW) mla_prep(w, p.qa, p.kvraw, p.kpe, p.ropeT, p.mla_qg, p.mla_kg, p.ka, lane); }
    xcd_barrier(bar);
    REP(3) for (int L = b; L < 1024; L += G) {
        const int i = L >> 8, vc = L & 255, vcx = (vc & 7) * 32 + (vc >> 3), hh = vcx >> 4, x = vcx & 15, qbk = (i & 1) ? x : 31 - x;
        if (i < 2) att::attn_block<192, false>(smem, p.qa + hh * 192, 3072, p.ka + hh * 192, 3072, p.kvraw + hh * 256 + 128, 4096, nullptr, p.merged + hh * 128, p.attout + hh * 128, qbk, nullptr, nullptr);
        else att::attn_block<128, true>(smem, p.fq + hh * 128, 2048, p.fk + hh * 128, 2048, p.fv + hh * 128, 2048, p.F + (size_t)hh * S, p.merged + 2048 + hh * 128, p.attout + 2048 + hh * 128, qbk, p.fox_qg, p.fox_kg);
    }
    xcd_barrier(bar);
    REP(4) {
        pg8::Gemm g{p.attout, p.WoT, S, 2048, 4096}; pg8::StaticOrder so; so.init(S, 2048, G, b);
        pg8::EpiStoreF32<true> E{p.x1, p.x, 2048};
        pg8::gemm_phase<pg8::EpiStoreF32<true>, pg8::StaticOrder, true, true>(lds, g, so, E);
    }
    xcd_barrier(bar);
    { PHASE_IDS(); for (int m = gw; m < S; m += NGW) rms_row2048(p.x1 + (size_t)m * DM, p.ffn_g, p.h + (size_t)m * DM, lane);
      cvt_rows_fp8(p.peer_u, p.U8, (size_t)16384 * 2048, U_SCALE, gw, NGW, lane); cvt_rows_fp8(p.peer_v, p.V8, (size_t)16384 * 2048, V_SCALE, gw, NGW, lane); }
    xcd_barrier(bar);
    REP(5) {
        pg8::Gemm g{p.h, p.WpT, S, 2048, 2048}; pg8::StaticOrder so; so.init(S, 2048, G, b);
        pg8::EpiStoreF32<false> E{p.scores, nullptr, 2048};
        pg8::gemm_phase<pg8::EpiStoreF32<false>, pg8::StaticOrder, true, true>(lds, g, so, E);
    }
    xcd_barrier(bar);
    REP(6) for (int g = b; g < S / 32; g += G) peer_group(smem, g, p.scores, p.h, p.x1, p.U8, p.V8, p.out);
}

extern "C" void kernel_launch(void* const* d_in, const int* in_sizes, int n_in,
                              void* d_out, int out_size, void* d_ws, size_t ws_size,
                              hipStream_t stream) {
    if (ws_size < 512 * MiB) { fprintf(stderr, "kernel_launch: workspace too small (%zu)\n", ws_size); return; }
    Params p{};
    p.x = (const float*)d_in[0]; p.pos = (const int*)d_in[1]; p.mix_g = (const float*)d_in[2]; p.w_in = (const float*)d_in[3];
    p.b_forget = (const float*)d_in[4]; p.b_gate = (const float*)d_in[5]; p.q_lat_g = (const float*)d_in[6]; p.w_q_up = (const float*)d_in[7];
    p.kv_lat_g = (const float*)d_in[8]; p.w_kv_up = (const float*)d_in[9]; p.mla_qg = (const float*)d_in[10]; p.mla_kg = (const float*)d_in[11];
    p.fox_qg = (const float*)d_in[12]; p.fox_kg = (const float*)d_in[13]; p.w_out = (const float*)d_in[14]; p.ffn_g = (const float*)d_in[15];
    p.w_peer_q = (const float*)d_in[16]; p.sub_keys = (const float*)d_in[17]; p.peer_u = (const float*)d_in[18]; p.peer_v = (const float*)d_in[19];
    p.out = (float*)d_out;
    char* ws = (char*)d_ws;
    p.WqT = (bf16_t*)(ws + 1 * MiB); p.WkvT = (bf16_t*)(ws + 5 * MiB); p.WoT = (bf16_t*)(ws + 9 * MiB); p.WpT = (bf16_t*)(ws + 25 * MiB); p.WinT = (bf16_t*)(ws + 33 * MiB);
    p.h = (bf16_t*)(ws + 78 * MiB); p.cq = (bf16_t*)(ws + 110 * MiB); p.ckv = (bf16_t*)(ws + 118 * MiB);
    p.fq = (bf16_t*)(ws + 126 * MiB); p.fk = (bf16_t*)(ws + 158 * MiB); p.fv = (bf16_t*)(ws + 190 * MiB); p.merged = (bf16_t*)(ws + 222 * MiB);
    p.kpe = (bf16_t*)(ws + 286 * MiB); p.lf = (float*)(ws + 287 * MiB); p.F = (float*)(ws + 287 * MiB + 512 * 1024);
    p.qa = (bf16_t*)(ws + 288 * MiB); p.kvraw = (bf16_t*)(ws + 336 * MiB); p.ka = (bf16_t*)(ws + 400 * MiB); p.x1 = (float*)(ws + 448 * MiB);
    p.scores = (float*)(ws + 222 * MiB);
    p.ctl = (unsigned*)ws;
    p.ropeT = (float2*)(ws + 33 * MiB);
    p.attout = (bf16_t*)(ws + 33 * MiB);
    p.U8 = (unsigned char*)(ws + 126 * MiB); p.V8 = (unsigned char*)(ws + 158 * MiB);

    static int grid_blocks = 0;
    if (!grid_blocks) {
        if (hipFuncSetAttribute((const void*)mega, hipFuncAttributeMaxDynamicSharedMemorySize, LDS_BYTES) != hipSuccess) { fprintf(stderr, "hipFuncSetAttribute failed\n"); return; }
        int dev = 0, cus = 0, per_cu = 0;
        (void)hipGetDevice(&dev);
        (void)hipDeviceGetAttribute(&cus, hipDeviceAttributeMultiprocessorCount, dev);
        (void)hipOccupancyMaxActiveBlocksPerMultiprocessor(&per_cu, (const void*)mega, 512, LDS_BYTES);
        if (per_cu < 1 || cus < 1) { fprintf(stderr, "occupancy query says %d blocks/CU on %d CUs\n", per_cu, cus); return; }
        grid_blocks = cus;
    }
    if (hipMemsetAsync(d_ws, 0, 16384, stream) != hipSuccess) { fprintf(stderr, "memset of the barrier words failed\n"); return; }
    void* args[] = {&p};
    hipError_t e = hipLaunchCooperativeKernel((const void*)mega, dim3(grid_blocks), dim3(512), args, LDS_BYTES, stream);
    if (e != hipSuccess) fprintf(stderr, "cooperative launch failed: %s (grid %d)\n", hipGetErrorString(e), grid_blocks);
}
```

```cpp
#include <hip/hip_runtime.h>
#include <hip/hip_cooperative_groups.h>
#include <stdint.h>
#include <math.h>
#include <cstdio>
namespace cg = cooperative_groups;

namespace pg8 {
#define PG8_LAS __attribute__((address_space(3)))
typedef unsigned short bf16_t;
typedef short bf16x8 __attribute__((ext_vector_type(8)));
typedef float f32x4 __attribute__((ext_vector_type(4)));
typedef unsigned u32x4 __attribute__((ext_vector_type(4)));
constexpr int BM = 256, BK = 64, HALF = 128, HTB = HALF * BK * 2  , STAGE_BYTES = 8 * HTB, NXCD = 8, WGM = 8;

__host__ __device__ __forceinline__ int lds_byte(int r, int c) { const int st = (r >> 4) * 2 + (c >> 5), rr = r & 15, cc = c & 31, ob = rr * 64 + cc * 2; return st * 1024 + (ob ^ (((ob >> 9) & 1) << 5)); }
__host__ __device__ __forceinline__ void stage_rc(int b, int& R, int& C) { const int st = b / 1024, sb = b % 1024, swz = sb ^ (((sb >> 9) & 1) << 5); R = (st >> 1) * 16 + swz / 64; C = (st & 1) * 32 + (swz % 64) / 2; }
__host__ __device__ __forceinline__ int perm32(int rho) { const int n = rho >> 4, i = rho & 15; return 8 * (i >> 2) + 4 * n + (i & 3); }

struct Unit { int pm, pn; };
struct Gemm { const bf16_t* A; const bf16_t* Bt; int M, N, K; };

struct StaticOrder {
    int nM, nN, nwg, G, c;
    __host__ __device__ void init(int M, int N, int G_, int c_) { nM = M / BM; nN = N / BM; nwg = nM * nN; G = G_; c = c_; }
    __host__ __device__ bool next(int i, Unit& u) const {
        const long L = (long)i * G + c; if (L >= nwg) return false;
        int wgid = (int)L; { const int q = nwg / NXCD, r = nwg % NXCD, xcd = wgid % NXCD, off = wgid / NXCD; wgid = (xcd < r ? xcd * (q + 1) : r * (q + 1) + (xcd - r) * q) + off; }
        const int nig = WGM * nN, gid = wgid / nig, fm = gid * WGM, gsz = (nM - fm) < WGM ? (nM - fm) : WGM;
        u.pm = fm + ((wgid % nig) % gsz); u.pn = (wgid % nig) / gsz; return true;
    }
    __device__ __forceinline__ void a_ready(const Unit&) const {}
    __device__ __forceinline__ void done(const Unit&) const {}
};

__device__ __forceinline__ unsigned cvt_pk_bf16(float lo, float hi) { unsigned r; asm volatile("v_cvt_pk_bf16_f32 %0, %1, %2" : "=v"(r) : "v"(lo), "v"(hi)); return r; }
__device__ __forceinline__ u32x4 pack8bf(const f32x4& v0, const f32x4& v1) { u32x4 w; w.x = cvt_pk_bf16(v0[0], v0[1]); w.y = cvt_pk_bf16(v0[2], v0[3]); w.z = cvt_pk_bf16(v1[0], v1[1]); w.w = cvt_pk_bf16(v1[2], v1[3]); return w; }

struct EpiStoreBf16 {
    static constexpr bool PERM = true, AFTER_DRAIN = false;
    bf16_t* O; int ldc;
    __device__ __forceinline__ void operator()(const f32x4 (&acc)[2][2][4][2], const Unit& u, int wr, int wc, int fr, int fq) const {
        const int row0 = u.pm * BM + wr * 64 + fr, col0 = u.pn * BM + wc * 32 + 8 * fq;
#pragma unroll
        for (int ai = 0; ai < 2; ++ai)
#pragma unroll
            for (int m = 0; m < 4; ++m) { bf16_t* rowp = O + (size_t)(row0 + ai * HALF + m * 16) * ldc + col0;
#pragma unroll
                for (int bj = 0; bj < 2; ++bj) *(u32x4*)(rowp + bj * HALF) = pack8bf(acc[ai][bj][m][0], acc[ai][bj][m][1]); }
    }
};
template <bool RES> struct EpiStoreF32 {
    static constexpr bool PERM = true, AFTER_DRAIN = false;
    float* O; const float* res; int ldc;
    __device__ __forceinline__ void operator()(const f32x4 (&acc)[2][2][4][2], const Unit& u, int wr, int wc, int fr, int fq) const {
        const int row0 = u.pm * BM + wr * 64 + fr, col0 = u.pn * BM + wc * 32 + 8 * fq;
#pragma unroll
        for (int ai = 0; ai < 2; ++ai)
#pragma unroll
            for (int m = 0; m < 4; ++m) { const size_t off = (size_t)(row0 + ai * HALF + m * 16) * ldc + col0;
#pragma unroll
                for (int bj = 0; bj < 2; ++bj) { f32x4 v0 = acc[ai][bj][m][0], v1 = acc[ai][bj][m][1];
                    if (RES) { v0 += *(const f32x4*)(res + off + bj * HALF); v1 += *(const f32x4*)(res + off + bj * HALF + 4); }
                    *(f32x4*)(O + off + bj * HALF) = v0; *(f32x4*)(O + off + bj * HALF + 4) = v1; } }
    }
};
struct EpiInProj {
    static constexpr bool PERM = true, AFTER_DRAIN = false;
    bf16_t *cq, *ckv, *fq, *fk, *fv, *gates, *kpe; float* lf; const float *b_gate, *b_forget;
    __device__ __forceinline__ void operator()(const f32x4 (&acc)[2][2][4][2], const Unit& u, int wr, int wc, int fr, int fq_) const {
        const int pn = u.pn, row0 = u.pm * BM + wr * 64 + fr, cw = wc * 32 + 8 * fq_;
        if (pn < 28) {
            bf16_t* base; int ldc, colt;
            if (pn < 2) { base = cq; ldc = 512; colt = pn * 256; } else if (pn < 4) { base = ckv; ldc = 512; colt = (pn - 2) * 256; }
            else if (pn < 12) { base = fq; ldc = 2048; colt = (pn - 4) * 256; } else if (pn < 20) { base = fk; ldc = 2048; colt = (pn - 12) * 256; }
            else { base = fv; ldc = 2048; colt = (pn - 20) * 256; }
#pragma unroll
            for (int ai = 0; ai < 2; ++ai)
#pragma unroll
                for (int m = 0; m < 4; ++m) { bf16_t* rowp = base + (size_t)(row0 + ai * HALF + m * 16) * ldc + colt + cw;
#pragma unroll
                    for (int bj = 0; bj < 2; ++bj) *(u32x4*)(rowp + bj * HALF) = pack8bf(acc[ai][bj][m][0], acc[ai][bj][m][1]); }
        } else if (pn < 44) {
            const int colt = (pn - 28) * 256 + cw;
#pragma unroll
            for (int bj = 0; bj < 2; ++bj) {
                const f32x4 b0 = *(const f32x4*)(b_gate + colt + bj * HALF), b1 = *(const f32x4*)(b_gate + colt + bj * HALF + 4);
#pragma unroll
                for (int ai = 0; ai < 2; ++ai)
#pragma unroll
                    for (int m = 0; m < 4; ++m) {
                        f32x4 v0 = acc[ai][bj][m][0] + b0, v1 = acc[ai][bj][m][1] + b1;
#pragma unroll
                        for (int e = 0; e < 4; ++e) { v0[e] = 1.f / (1.f + __expf(-v0[e])); v1[e] = 1.f / (1.f + __expf(-v1[e])); }
                        *(u32x4*)(gates + (size_t)(row0 + ai * HALF + m * 16) * 4096 + colt + bj * HALF) = pack8bf(v0, v1); }
            }
        } else {
            if (cw < 64) {
#pragma unroll
                for (int ai = 0; ai < 2; ++ai)
#pragma unroll
                    for (int m = 0; m < 4; ++m) *(u32x4*)(kpe + (size_t)(row0 + ai * HALF + m * 16) * 64 + cw) = pack8bf(acc[ai][0][m][0], acc[ai][0][m][1]);
            } else if (cw < 80) {
                const int h0 = cw - 64;
                const f32x4 b0 = *(const f32x4*)(b_forget + h0), b1 = *(const f32x4*)(b_forget + h0 + 4);
#pragma unroll
                for (int ai = 0; ai < 2; ++ai)
#pragma unroll
                    for (int m = 0; m < 4; ++m) { const int row = row0 + ai * HALF + m * 16;
                        f32x4 z0 = acc[ai][0][m][0] + b0, z1 = acc[ai][0][m][1] + b1;
#pragma unroll
                        for (int e = 0; e < 4; ++e) { z0[e] = fminf(z0[e], 0.f) - __logf(1.f + __expf(-fabsf(z0[e]))); z1[e] = fminf(z1[e], 0.f) - __logf(1.f + __expf(-fabsf(z1[e]))); }
                        *(f32x4*)(lf + (size_t)row * 16 + h0) = z0; *(f32x4*)(lf + (size_t)row * 16 + h0 + 4) = z1; }
            }
        }
    }
};
template <class Epi, class Sched, bool ALIGN_EPI = false, bool SP2 = false>
__device__ __forceinline__ void gemm_phase(PG8_LAS unsigned char* lds, const Gemm g, const Sched& S, const Epi& E) {
    const int tid = threadIdx.x, wid = __builtin_amdgcn_readfirstlane(tid >> 6), lane = tid & 63, wr = wid >> 2, wc = wid & 3, fr = lane & 15, fq = lane >> 4;
    const int K = g.K, nt = K / BK;
    unsigned voffA[2], voffB[2];
#pragma unroll
    for (int i = 0; i < 2; ++i) { int R, C; stage_rc(tid * 16 + i * 8192, R, C); const int Rb = Epi::PERM ? ((R & ~31) + perm32(R & 31)) : R;
        voffA[i] = (unsigned)(R * K + C) * 2u; voffB[i] = (unsigned)(Rb * K + C) * 2u; }
    const size_t kstep = (size_t)(BK * 2);
    const size_t hstep = (size_t)HALF * K * 2;
    const size_t tstep = 2 * hstep;
    const unsigned ldsw = (unsigned)wid * 1024u;
    const int aoff = lds_byte(wr * 64 + fr, fq * 8), boff = lds_byte(wc * 32 + fr, fq * 8);
#define PG8_SA(b, h) (((b) * 2 + (h)) * HTB)
#define PG8_SB(b, h) ((4 + (b) * 2 + (h)) * HTB)
#define PG8_STAGE(bufoff, gbase, voff) do { _Pragma("unroll") for (int _i = 0; _i < 2; ++_i) \
        __builtin_amdgcn_global_load_lds((const unsigned*)((const char*)(gbase) + (voff)[_i]), (PG8_LAS unsigned*)(lds + (bufoff) + ldsw + _i * 8192), 16, 0, 0); } while (0)
#define PG8_LDA(dst, b, h) do { _Pragma("unroll") for (int m = 0; m < 4; ++m) _Pragma("unroll") for (int k = 0; k < 2; ++k) dst[m][k] = *(const PG8_LAS bf16x8*)(lds + PG8_SA(b, h) + aoff + m * 2048 + k * 1024); } while (0)
#define PG8_LDB(dst, b, h) do { _Pragma("unroll") for (int n = 0; n < 2; ++n) _Pragma("unroll") for (int k = 0; k < 2; ++k) dst[n][k] = *(const PG8_LAS bf16x8*)(lds + PG8_SB(b, h) + boff + n * 2048 + k * 1024); } while (0)
#define PG8_MMA(ai, bj, At, Bt) do { __builtin_amdgcn_s_setprio(1); _Pragma("unroll") for (int m = 0; m < 4; ++m) _Pragma("unroll") for (int n = 0; n < 2; ++n) _Pragma("unroll") for (int k = 0; k < 2; ++k) \
        acc[ai][bj][m][n] = __builtin_amdgcn_mfma_f32_16x16x32_bf16(Bt[n][k], At[m][k], acc[ai][bj][m][n], 0, 0, 0); __builtin_amdgcn_s_setprio(0); } while (0)
#define PG8_WAIT_V(n) asm volatile("s_waitcnt vmcnt(" #n ")" ::: "memory")
#define PG8_WAIT_L(n) asm volatile("s_waitcnt lgkmcnt(" #n ")" ::: "memory")
#define PG8_BAR __builtin_amdgcn_s_barrier()
#define PG8_SCHED __builtin_amdgcn_sched_barrier(0)
    Unit cur, nxt; int ui = 0;
    if (!S.next(0, cur)) return;
    f32x4 acc[2][2][4][2];
#pragma unroll
    for (int a = 0; a < 2; ++a)
#pragma unroll
        for (int b = 0; b < 2; ++b)
#pragma unroll
            for (int m = 0; m < 4; ++m)
#pragma unroll
                for (int n = 0; n < 2; ++n) acc[a][b][m][n] = (f32x4){0.f, 0.f, 0.f, 0.f};
    bf16x8 At[4][2], B0[2][2], B1[2][2];
    const char* cA = (const char*)g.A + (size_t)cur.pm * tstep; const char* cB = (const char*)g.Bt + (size_t)cur.pn * tstep;
    S.a_ready(cur);
    if constexpr (SP2) {
        PG8_STAGE(PG8_SB(0, 0), cB, voffB); PG8_STAGE(PG8_SB(0, 1), cB + hstep, voffB); PG8_STAGE(PG8_SA(0, 0), cA, voffA); PG8_STAGE(PG8_SA(0, 1), cA + hstep, voffA);
        if (wr == 1) PG8_BAR;
        PG8_WAIT_V(2); PG8_BAR;
        PG8_STAGE(PG8_SB(1, 0), cB + kstep, voffB); PG8_STAGE(PG8_SA(1, 0), cA + kstep, voffA); PG8_STAGE(PG8_SB(1, 1), cB + hstep + kstep, voffB);
        PG8_WAIT_V(6); PG8_BAR;
    } else {
        PG8_STAGE(PG8_SB(0, 0), cB, voffB); PG8_STAGE(PG8_SA(0, 0), cA, voffA); PG8_STAGE(PG8_SB(0, 1), cB + hstep, voffB); PG8_STAGE(PG8_SA(0, 1), cA + hstep, voffA);
        if (wr == 1) PG8_BAR;
        PG8_WAIT_V(4); PG8_BAR;
        PG8_STAGE(PG8_SB(1, 0), cB + kstep, voffB); PG8_STAGE(PG8_SA(1, 0), cA + kstep, voffA); PG8_STAGE(PG8_SB(1, 1), cB + hstep + kstep, voffB);
        PG8_WAIT_V(6); PG8_BAR;
    }
    for (;;) {
        const bool has_next = S.next(ui + 1, nxt);
        const char* nA = has_next ? (const char*)g.A + (size_t)nxt.pm * tstep : cA; const char* nB = has_next ? (const char*)g.Bt + (size_t)nxt.pn * tstep : cB;
        for (int t = 0; t < nt; t += 2) {
            const bool last = (t == nt - 2);
            const char* a1 = cA + (size_t)(t + 1) * kstep;
            const char* a2 = last ? nA : cA + (size_t)(t + 2) * kstep; const char* b2 = last ? nB : cB + (size_t)(t + 2) * kstep;
            const char* a3 = a2 + kstep; const char* b3 = b2 + kstep;
            if (last && has_next) S.a_ready(nxt);
            if constexpr (SP2) {
            PG8_LDB(B0, 0, 0); PG8_LDB(B1, 0, 1); PG8_SCHED; PG8_LDA(At, 0, 0); PG8_STAGE(PG8_SA(1, 1), a1 + hstep, voffA);
            PG8_WAIT_V(8); PG8_WAIT_L(0); PG8_BAR; PG8_MMA(0, 0, At, B0); PG8_MMA(0, 1, At, B1); PG8_BAR; PG8_SCHED;
            PG8_LDA(At, 0, 1); PG8_STAGE(PG8_SB(0, 0), b2, voffB); PG8_STAGE(PG8_SB(0, 1), b2 + hstep, voffB); PG8_STAGE(PG8_SA(0, 0), a2, voffA);
            PG8_WAIT_V(8); PG8_WAIT_L(0); PG8_BAR; PG8_MMA(1, 0, At, B0); PG8_MMA(1, 1, At, B1); PG8_BAR; PG8_SCHED;
            PG8_LDB(B0, 1, 0); PG8_LDB(B1, 1, 1); PG8_SCHED; PG8_LDA(At, 1, 0); PG8_STAGE(PG8_SA(0, 1), a2 + hstep, voffA);
            PG8_WAIT_V(8); PG8_WAIT_L(0); PG8_BAR; PG8_MMA(0, 0, At, B0); PG8_MMA(0, 1, At, B1); PG8_BAR; PG8_SCHED;
            PG8_LDA(At, 1, 1); PG8_STAGE(PG8_SB(1, 0), b3, voffB); PG8_STAGE(PG8_SB(1, 1), b3 + hstep, voffB); PG8_STAGE(PG8_SA(1, 0), a3, voffA);
            PG8_WAIT_V(8); PG8_WAIT_L(0); PG8_BAR; PG8_MMA(1, 0, At, B0); PG8_MMA(1, 1, At, B1); PG8_BAR; PG8_SCHED;
            } else {
            PG8_LDB(B0, 0, 0); PG8_SCHED; PG8_LDA(At, 0, 0); PG8_STAGE(PG8_SA(1, 1), a1 + hstep, voffA);
            PG8_WAIT_L(8); PG8_BAR; PG8_WAIT_L(0); PG8_MMA(0, 0, At, B0); PG8_BAR; PG8_SCHED;
            PG8_LDB(B1, 0, 1); PG8_STAGE(PG8_SB(0, 0), b2, voffB);
            PG8_BAR; PG8_WAIT_L(0); PG8_MMA(0, 1, At, B1); PG8_BAR;
            PG8_LDA(At, 0, 1); PG8_STAGE(PG8_SA(0, 0), a2, voffA);
            PG8_BAR; PG8_WAIT_L(0); PG8_MMA(1, 0, At, B0); PG8_BAR; PG8_SCHED;
            PG8_STAGE(PG8_SB(0, 1), b2 + hstep, voffB);
            PG8_WAIT_V(6); PG8_BAR; PG8_MMA(1, 1, At, B1); PG8_BAR;
            PG8_LDB(B0, 1, 0); PG8_SCHED; PG8_LDA(At, 1, 0); PG8_STAGE(PG8_SA(0, 1), a2 + hstep, voffA);
            PG8_WAIT_L(8); PG8_BAR; PG8_WAIT_L(0); PG8_MMA(0, 0, At, B0); PG8_BAR; PG8_SCHED;
            PG8_LDB(B1, 1, 1); PG8_STAGE(PG8_SB(1, 0), b3, voffB);
            PG8_BAR; PG8_WAIT_L(0); PG8_MMA(0, 1, At, B1); PG8_BAR;
            PG8_LDA(At, 1, 1); PG8_STAGE(PG8_SA(1, 0), a3, voffA);
            PG8_BAR; PG8_WAIT_L(0); PG8_MMA(1, 0, At, B0); PG8_BAR; PG8_SCHED;
            PG8_STAGE(PG8_SB(1, 1), b3 + hstep, voffB);
            PG8_WAIT_V(6); PG8_BAR; PG8_MMA(1, 1, At, B1); PG8_BAR;
            }
        }
        if constexpr (ALIGN_EPI) { if (wr == 0) PG8_BAR; }
        if constexpr (!Epi::AFTER_DRAIN) { E(acc, cur, wr, wc, fr, fq); S.done(cur); }
        if (!has_next) break;
#pragma unroll
        for (int a = 0; a < 2; ++a)
#pragma unroll
            for (int b = 0; b < 2; ++b)
#pragma unroll
                for (int m = 0; m < 4; ++m)
#pragma unroll
                    for (int n = 0; n < 2; ++n) acc[a][b][m][n] = (f32x4){0.f, 0.f, 0.f, 0.f};
        cur = nxt; cA = nA; cB = nB; ++ui;
        if constexpr (ALIGN_EPI) { if (wr == 1) PG8_BAR; }
    }
    PG8_WAIT_V(0);
    if constexpr (!ALIGN_EPI) { if (wr == 0) PG8_BAR; }
    PG8_BAR;
    if constexpr (Epi::AFTER_DRAIN) { E.fused(acc, cur, wr, wc, fr, fq, lds, wid, lane); S.done(cur); }
#undef PG8_SA
#undef PG8_SB
#undef PG8_STAGE
#undef PG8_LDA
#undef PG8_LDB
#undef PG8_MMA
#undef PG8_WAIT_V
#undef PG8_WAIT_L
#undef PG8_BAR
#undef PG8_SCHED
}
}
namespace att {
typedef unsigned short bf16_t;
typedef short bf16x8 __attribute__((ext_vector_type(8)));
typedef short s16x4 __attribute__((ext_vector_type(4)));
typedef float f32x16 __attribute__((ext_vector_type(16)));
typedef float f32x4 __attribute__((ext_vector_type(4)));
typedef unsigned u32x4 __attribute__((ext_vector_type(4)));
#define ALAS __attribute__((address_space(3)))
#define ASBAR() __builtin_amdgcn_sched_barrier(0)
constexpr int SHM_V = 16384;
template <int DK> struct Lay { static constexpr int ROWB = DK * 2, SHM_K = 64 * ROWB, OFF_K = 2 * SHM_V, OFF_F = OFF_K + 2 * SHM_K, OFF_WS = OFF_F + 512, TOTAL = OFF_WS + 8 * 256; };

__device__ __forceinline__ int v_st(int k, int c) { const int kk = (k & ~0xC) | ((k & 4) << 1) | ((k & 8) >> 1); return ((kk >> 3) * 4 + (c >> 5)) * 512 + ((kk & 7) * 32 + (c & 31)) * 2; }
__device__ __forceinline__ int v_rd_base(int lane) { return ((lane & 3) << 3) | (((lane >> 2) & 3) << 6) | (((lane >> 4) & 1) << 5) | (((lane >> 5) & 1) << 8); }
__device__ __forceinline__ int crow(int r, int hi) { return (r & 3) + 8 * (r >> 2) + 4 * hi; }
__device__ __forceinline__ unsigned cvtpk(float lo, float hi) { unsigned r; asm volatile("v_cvt_pk_bf16_f32 %0, %1, %2" : "=v"(r) : "v"(lo), "v"(hi)); return r; }

__device__ __forceinline__ float wave_max_f(float v) {
#pragma unroll
    for (int o = 32; o >= 1; o >>= 1) v = fmaxf(v, __shfl_xor(v, o));
    return v;
}
template <int DK, bool FOX>
__device__ __forceinline__ void attn_block(unsigned char* smem, const bf16_t* __restrict__ Q, int ldq, const bf16_t* __restrict__ K, int ldk, const bf16_t* __restrict__ V, int ldv,
                                           const float* __restrict__ Fh, const bf16_t* __restrict__ gate, bf16_t* __restrict__ gout  , int qbk, const float* __restrict__ gq, const float* __restrict__ gk  ) {
    typedef Lay<DK> LY;
    constexpr int ND = DK / 16, NKC = DK / 8, NKI = (64 * NKC) / 512;
    int tid = threadIdx.x; asm volatile("" : "+v"(tid));
    const int wid = __builtin_amdgcn_readfirstlane(tid >> 6), lane = tid & 63, r32 = lane & 31, hi = lane >> 5;
    const int q0 = qbk * 256, qlo = q0 + wid * 32, qm = qlo + r32 - 4 * hi;
    const int NT = 4 * qbk + 4;
    ALAS unsigned char* lds = (ALAS unsigned char*)smem;
    ALAS float* F_lds = (ALAS float*)(lds + LY::OFF_F);
    ALAS float* wsl = (ALAS float*)(lds + LY::OFF_WS) + wid * 64;
    bf16x8 qr[ND];
#pragma unroll
    for (int d0 = 0; d0 < ND; ++d0) qr[d0] = *(const bf16x8*)(Q + (size_t)(qlo + r32) * ldq + d0 * 16 + hi * 8);
    const float fq = FOX ? Fh[qlo + r32] : 0.f;
    int kgo[NKI], klo[NKI];
#pragma unroll
    for (int i = 0; i < NKI; ++i) { const int idx = tid + 512 * i, row = idx / NKC, ch = idx % NKC; kgo[i] = row * ldk + ch * 8; klo[i] = row * LY::ROWB + ((ch ^ ((row >> 1) & 7)) << 4); }
    const int sr = tid >> 4, sc = (tid & 15) * 8, vst0 = v_st(sr, sc), vst1 = v_st(32 + sr, sc);
    const int vgo0 = sr * ldv + sc, vgo1 = (32 + sr) * ldv + sc;
    const int vb0 = (int)(uintptr_t)smem + v_rd_base(lane);
    int kbase[4];
#pragma unroll
    for (int dd = 0; dd < 4; ++dd) kbase[dd] = LY::OFF_K + r32 * LY::ROWB + (((((dd << 1) | hi) ^ ((r32 >> 1) & 7))) << 4);
    bf16x8 stk[NKI], stv0, stv1; float stf = 0.f;
#define ATT_LOAD(kb) do { _Pragma("unroll") for (int i = 0; i < NKI; ++i) stk[i] = *(const bf16x8*)(K + (size_t)(kb) * ldk + kgo[i]); \
        stv0 = *(const bf16x8*)(V + (size_t)(kb) * ldv + vgo0); stv1 = *(const bf16x8*)(V + (size_t)(kb) * ldv + vgo1); if (FOX && tid < 64) stf = Fh[(kb) + tid]; } while (0)
#define ATT_WRITE(bf) do { _Pragma("unroll") for (int i = 0; i < NKI; ++i) *(ALAS bf16x8*)(lds + LY::OFF_K + (bf) * LY::SHM_K + klo[i]) = stk[i]; \
        *(ALAS bf16x8*)(lds + (bf) * SHM_V + vst0) = stv0; *(ALAS bf16x8*)(lds + (bf) * SHM_V + vst1) = stv1; if (FOX && tid < 64) F_lds[(bf) * 64 + tid] = stf; } while (0)
    int t_start = 0;
    if (FOX) {
        const float gqm = wave_max_f(fmaxf(fabsf(gq[lane]), fabsf(gq[lane + 64]))), gkm = wave_max_f(fmaxf(fabsf(gk[lane]), fabsf(gk[lane + 64])));
        const float qk_bound = 0.12751743f * 128.f * gqm * gkm;
        const float thr = 2.02f * qk_bound + 40.f, f0 = Fh[q0];
        const int j0 = lane, j1 = lane + 64;
        const bool c0 = (j0 < 4 * qbk) && (Fh[j0 * 64 + 63] - f0 >= thr), c1 = (j1 < 4 * qbk) && (Fh[(j1 < 4 * qbk ? j1 : 0) * 64 + 63] - f0 >= thr);
        t_start = __builtin_popcountll(__ballot(c0)) + __builtin_popcountll(__ballot(c1));
        t_start = __builtin_amdgcn_readfirstlane(t_start); }
    ATT_LOAD(t_start * 64); ATT_WRITE(t_start & 1);
    float m_reg = -1e30f, l_reg = 0.f; f32x16 o[4];
#pragma unroll
    for (int d = 0; d < 4; ++d)
#pragma unroll
        for (int r = 0; r < 16; ++r) o[d][r] = 0.f;
    for (int t = t_start; t < NT; ++t) {
        const int buf = t & 1, kb = t * 64;
        __syncthreads();
        if (t + 1 < NT) ATT_LOAD(kb + 64);
        f32x16 p0, p1;
        if (FOX) {
#pragma unroll
            for (int g = 0; g < 4; ++g) { const f32x4 f0 = *(const ALAS f32x4*)(F_lds + buf * 64 + 8 * g + 4 * hi), f1 = *(const ALAS f32x4*)(F_lds + buf * 64 + 32 + 8 * g + 4 * hi);
#pragma unroll
                for (int e = 0; e < 4; ++e) { p0[4 * g + e] = fq - f0[e]; p1[4 * g + e] = fq - f1[e]; } }
        } else {
#pragma unroll
            for (int r = 0; r < 16; ++r) { p0[r] = 0.f; p1[r] = 0.f; }
        }
        __builtin_amdgcn_s_setprio(1);
#pragma unroll
        for (int d0 = 0; d0 < ND; ++d0) {
            ALAS const unsigned char* a = lds + buf * LY::SHM_K + kbase[d0 & 3] + (d0 >> 2) * 128;
            const bf16x8 b0 = *(const ALAS bf16x8*)a;
            const bf16x8 b1 = *(const ALAS bf16x8*)(a + 32 * LY::ROWB);
            p0 = __builtin_amdgcn_mfma_f32_32x32x16_bf16(b0, qr[d0], p0, 0, 0, 0);
            p1 = __builtin_amdgcn_mfma_f32_32x32x16_bf16(b1, qr[d0], p1, 0, 0, 0);
        }
        __builtin_amdgcn_s_setprio(0);
        if (kb + 63 > qlo) {
            const float NEG = -__builtin_inff(); const int dq = qm - kb;
#pragma unroll
            for (int r = 0; r < 16; ++r) { const int c = (r & 3) + 8 * (r >> 2); if (dq - c < 0) p0[r] = NEG; if (dq - c - 32 < 0) p1[r] = NEG; }
        }
        float pmax = p0[0];
#pragma unroll
        for (int r = 1; r < 16; ++r) pmax = fmaxf(pmax, p0[r]);
#pragma unroll
        for (int r = 0; r < 16; ++r) pmax = fmaxf(pmax, p1[r]);
        { auto rr = __builtin_amdgcn_permlane32_swap(__float_as_uint(pmax), __float_as_uint(pmax), false, false);
          pmax = fmaxf(__uint_as_float(rr[0]), __uint_as_float(rr[1])); }
        float mn, alpha;
        if (__builtin_expect(__all(pmax - m_reg <= 8.f), 1)) { mn = m_reg; alpha = 1.f; }
        else { mn = fmaxf(m_reg, pmax); alpha = __builtin_amdgcn_exp2f(m_reg - mn); m_reg = mn; }
        float ps = 0.f;
#pragma unroll
        for (int r = 0; r < 16; ++r) { p0[r] = __builtin_amdgcn_exp2f(p0[r] - mn); ps += p0[r]; }
#pragma unroll
        for (int r = 0; r < 16; ++r) { p1[r] = __builtin_amdgcn_exp2f(p1[r] - mn); ps += p1[r]; }
        { auto rr = __builtin_amdgcn_permlane32_swap(__float_as_uint(ps), __float_as_uint(ps), false, false);
          ps = __uint_as_float(rr[0]) + __uint_as_float(rr[1]); }
        l_reg = l_reg * alpha + ps;
        bf16x8 pa0, pa1, pa2, pa3;
#define ATT_PK4(P, B_, OUT) do { unsigned a0 = cvtpk(P[B_+0], P[B_+1]), a1 = cvtpk(P[B_+2], P[B_+3]); unsigned b0_ = cvtpk(P[B_+4], P[B_+5]), b1_ = cvtpk(P[B_+6], P[B_+7]); \
        auto r0 = __builtin_amdgcn_permlane32_swap(a0, b0_, false, false); auto r1 = __builtin_amdgcn_permlane32_swap(a1, b1_, false, false); \
        u32x4 w = {r0[0], r1[0], r0[1], r1[1]}; OUT = *reinterpret_cast<bf16x8*>(&w); } while (0)
        ATT_PK4(p0, 0, pa0); ATT_PK4(p0, 8, pa1); ATT_PK4(p1, 0, pa2); ATT_PK4(p1, 8, pa3);
        if (__any(alpha < 1.f)) {
            if (hi == 0) wsl[r32] = alpha;
            asm volatile("s_waitcnt lgkmcnt(0)" ::: "memory");
#pragma unroll
            for (int g = 0; g < 4; ++g) { const f32x4 al = *(const ALAS f32x4*)(wsl + 8 * g + 4 * hi);
#pragma unroll
                for (int d = 0; d < 4; ++d)
#pragma unroll
                    for (int e = 0; e < 4; ++e) o[d][4 * g + e] *= al[e]; }
        }
#define ATT_TRRD(dst, off) asm volatile("ds_read_b64_tr_b16 %0, %1 offset:%2" : "=&v"(dst) : "v"(vbb), "i"(off) : "memory")
#define ATT_PV(d0) do { s16x4 l0, l1, l2, l3, h0, h1, h2, h3; constexpr int b_ = (d0) * 512; \
        ATT_TRRD(l0, b_); ATT_TRRD(h0, b_ + 2048); ATT_TRRD(l1, b_ + 4096); ATT_TRRD(h1, b_ + 6144); ATT_TRRD(l2, b_ + 8192); ATT_TRRD(h2, b_ + 10240); ATT_TRRD(l3, b_ + 12288); ATT_TRRD(h3, b_ + 14336); \
        asm volatile("s_waitcnt lgkmcnt(0)" ::: "memory"); ASBAR(); \
        o[d0] = __builtin_amdgcn_mfma_f32_32x32x16_bf16(pa0, (bf16x8){l0[0], l0[1], l0[2], l0[3], h0[0], h0[1], h0[2], h0[3]}, o[d0], 0, 0, 0); \
        o[d0] = __builtin_amdgcn_mfma_f32_32x32x16_bf16(pa1, (bf16x8){l1[0], l1[1], l1[2], l1[3], h1[0], h1[1], h1[2], h1[3]}, o[d0], 0, 0, 0); \
        o[d0] = __builtin_amdgcn_mfma_f32_32x32x16_bf16(pa2, (bf16x8){l2[0], l2[1], l2[2], l2[3], h2[0], h2[1], h2[2], h2[3]}, o[d0], 0, 0, 0); \
        o[d0] = __builtin_amdgcn_mfma_f32_32x32x16_bf16(pa3, (bf16x8){l3[0], l3[1], l3[2], l3[3], h3[0], h3[1], h3[2], h3[3]}, o[d0], 0, 0, 0); } while (0)
        { const int vbb = vb0 + buf * SHM_V; __builtin_amdgcn_s_setprio(1); ATT_PV(0); ATT_PV(1); ATT_PV(2); ATT_PV(3); __builtin_amdgcn_s_setprio(0); }
        if (t + 1 < NT) ATT_WRITE(buf ^ 1);
    }
    if (hi == 0) wsl[r32] = l_reg;
    asm volatile("s_waitcnt lgkmcnt(0)" ::: "memory");
#pragma unroll
    for (int r = 0; r < 16; ++r) {
        const int orow = crow(r, hi); const float rli = __builtin_amdgcn_rcpf(wsl[orow]);
        bf16_t* rowp = gout + (size_t)(qlo + orow) * 4096; const bf16_t* growp = gate + (size_t)(qlo + orow) * 4096;
#pragma unroll
        for (int d0 = 0; d0 < 4; ++d0) {
            const float v = o[d0][r] * rli; const float vn = __shfl_xor(v, 1);
            if ((r32 & 1) == 0) { unsigned* gp = (unsigned*)(rowp + d0 * 32 + r32); const unsigned g = *(const unsigned*)(growp + d0 * 32 + r32);
                *gp = cvtpk(v * __uint_as_float(g << 16), vn * __uint_as_float(g & 0xffff0000u)); }
        }
    }
    __syncthreads();
#undef ATT_LOAD
#undef ATT_WRITE
#undef ATT_PK4
#undef ATT_TRRD
#undef ATT_PV
}
}
using pg8::bf16_t; using pg8::f32x4; using pg8::u32x4;
#define LAS __attribute__((address_space(3)))
constexpr int S = 8192, DM = 2048, INW = 11344, INWP = 11520;
constexpr float EPS = 1e-6f;
constexpr size_t MiB = 1u << 20;

__device__ __forceinline__ float bf2f(bf16_t v) { return __uint_as_float(((unsigned)v) << 16); }
__device__ __forceinline__ bf16_t f2bf(float f) { unsigned u = __float_as_uint(f); u += 0x7fffu + ((u >> 16) & 1u); return (bf16_t)(u >> 16); }
__device__ __forceinline__ unsigned pk2(float lo, float hi) { return (unsigned)f2bf(lo) | ((unsigned)f2bf(hi) << 16); }
__device__ __forceinline__ float wave_sum(float v) {
#pragma unroll
    for (int o = 32; o >= 1; o >>= 1) v += __shfl_xor(v, o);
    return v;
}
__device__ __forceinline__ float wave_max(float v) {
#pragma unroll
    for (int o = 32; o >= 1; o >>= 1) v = fmaxf(v, __shfl_xor(v, o));
    return v;
}

__device__ __forceinline__ int opaque_tid() { int t = threadIdx.x; asm volatile("" : "+v"(t)); return t; }

struct Params {
    const float* x; const int* pos; const float *mix_g, *w_in, *b_forget, *b_gate, *q_lat_g, *w_q_up, *kv_lat_g, *w_kv_up, *mla_qg, *mla_kg, *fox_qg, *fox_kg, *w_out, *ffn_g, *w_peer_q, *sub_keys, *peer_u, *peer_v;
    float* out;
    bf16_t *WqT, *WkvT, *WoT, *WpT, *WinT;
    bf16_t *h, *cq, *ckv, *fq, *fk, *fv, *merged, *kpe, *qa, *kvraw, *ka;
    float *lf, *F, *x1, *scores;
    unsigned char *U8, *V8; bf16_t* attout;
    unsigned* ctl;
    float2* ropeT;
};

struct DstId { __device__ __forceinline__ int operator()(int n) const { return n; } };
struct DstWin { __device__ __forceinline__ int operator()(int n) const {
    if (n < 1024) return n; if (n < 1088) return 11264 + (n - 1024); if (n < 7232) return n - 64; if (n < 7248) return 11264 + 64 + (n - 7232); return n - 80; } };
template <class Dst>
__device__ __forceinline__ void transpose_item(const float* __restrict__ W, int K, int N, bf16_t* __restrict__ WT, Dst dst, float* scr, int item, int lane, const float* __restrict__ gk = nullptr) {
    const int nblk = (N + 31) / 32, kb = item / nblk, nb = item % nblk, k0 = 64 * kb, n0 = 32 * nb;
    { const int rr = lane >> 3, c4 = (lane & 7) * 4; const bool ok = (n0 + c4) < N;
      f32x4 v[8];
#pragma unroll
      for (int i = 0; i < 8; ++i) v[i] = ok ? *(const f32x4*)(W + (size_t)(k0 + 8 * i + rr) * N + n0 + c4) : (f32x4){0.f, 0.f, 0.f, 0.f};
      if (gk) {
#pragma unroll
          for (int i = 0; i < 8; ++i) v[i] *= gk[k0 + 8 * i + rr]; }
#pragma unroll
      for (int i = 0; i < 8; ++i) { float* sp = scr + (8 * i + rr) * 33 + c4; sp[0] = v[i][0]; sp[1] = v[i][1]; sp[2] = v[i][2]; sp[3] = v[i][3]; } }
    asm volatile("s_waitcnt lgkmcnt(0)" ::: "memory");
    const int c = lane & 7;
#pragma unroll
    for (int j = 0; j < 4; ++j) { const int nl = (lane >> 3) + 8 * j, n = n0 + nl; const float* s = scr + (8 * c) * 33 + nl;
        u32x4 o; o.x = pk2(s[0 * 33], s[1 * 33]); o.y = pk2(s[2 * 33], s[3 * 33]); o.z = pk2(s[4 * 33], s[5 * 33]); o.w = pk2(s[6 * 33], s[7 * 33]);
        if (n < N) *(u32x4*)(WT + (size_t)dst(n) * K + k0 + 8 * c) = o; }
    asm volatile("s_waitcnt lgkmcnt(0)" ::: "memory");
}
__device__ __forceinline__ void wfold_item(const float* __restrict__ wq, const float* __restrict__ keys, bf16_t* __restrict__ WpT, float* sm, int item) {
    const int tid = opaque_tid(), hc = item >> 5, d0 = (item & 31) * 64;
    float* keysL = sm; float* wqL = sm + 128 * 132;
    for (int idx = tid; idx < 128 * 32; idx += 512) { const int r = idx >> 5, c4 = (idx & 31) * 4; *(f32x4*)(keysL + r * 132 + c4) = *(const f32x4*)(keys + (size_t)hc * 16384 + r * 128 + c4); }
    for (int idx = tid; idx < 64 * 32; idx += 512) { const int r = idx >> 5, c4 = (idx & 31) * 4; *(f32x4*)(wqL + r * 132 + c4) = *(const f32x4*)(wq + (size_t)(d0 + r) * 2048 + hc * 128 + c4); }
    __syncthreads();
    const int n2 = (tid & 63) * 2, dg = tid >> 6;
    float acc[2][8];
#pragma unroll
    for (int a = 0; a < 2; ++a)
#pragma unroll
        for (int i = 0; i < 8; ++i) acc[a][i] = 0.f;
#pragma unroll 2
    for (int j4 = 0; j4 < 32; ++j4) {
        const f32x4 k0v = *(const f32x4*)(keysL + n2 * 132 + 4 * j4), k1v = *(const f32x4*)(keysL + (n2 + 1) * 132 + 4 * j4);
#pragma unroll
        for (int i = 0; i < 8; ++i) { const f32x4 w = *(const f32x4*)(wqL + (dg * 8 + i) * 132 + 4 * j4);
            acc[0][i] += (k0v[0] * w[0] + k0v[1] * w[1]) + (k0v[2] * w[2] + k0v[3] * w[3]);
            acc[1][i] += (k1v[0] * w[0] + k1v[1] * w[1]) + (k1v[2] * w[2] + k1v[3] * w[3]); }
    }
#pragma unroll
    for (int a = 0; a < 2; ++a) { u32x4 o; o.x = pk2(acc[a][0], acc[a][1]); o.y = pk2(acc[a][2], acc[a][3]); o.z = pk2(acc[a][4], acc[a][5]); o.w = pk2(acc[a][6], acc[a][7]);
        *(u32x4*)(WpT + (size_t)(hc * 128 + n2 + a) * 2048 + d0 + dg * 8) = o; }
    __syncthreads();
}
__device__ __forceinline__ void rms_row2048(const float* __restrict__ xr, const float* __restrict__ g, bf16_t* __restrict__ orow, int lane) {
    f32x4 v[8]; float ss = 0.f;
#pragma unroll
    for (int j = 0; j < 8; ++j) { v[j] = *(const f32x4*)(xr + j * 256 + lane * 4); ss += (v[j][0] * v[j][0] + v[j][1] * v[j][1]) + (v[j][2] * v[j][2] + v[j][3] * v[j][3]); }
    const float r = rsqrtf(wave_sum(ss) * (1.f / 2048.f) + EPS);
#pragma unroll
    for (int j = 0; j < 8; ++j) { const f32x4 gg = *(const f32x4*)(g + j * 256 + lane * 4);
        uint2 o; o.x = pk2(v[j][0] * r * gg[0], v[j][1] * r * gg[1]); o.y = pk2(v[j][2] * r * gg[2], v[j][3] * r * gg[3]);
        *(uint2*)(orow + j * 256 + lane * 4) = o; }
}
__device__ __forceinline__ void rms_row512_inplace(bf16_t* __restrict__ row, const float* __restrict__ g, int lane) {
    u32x4 w = *(const u32x4*)(row + lane * 8); float v[8];
#pragma unroll
    for (int i = 0; i < 4; ++i) { v[2 * i] = __uint_as_float(w[i] << 16); v[2 * i + 1] = __uint_as_float(w[i] & 0xffff0000u); }
    float ss = 0.f;
#pragma unroll
    for (int i = 0; i < 8; ++i) ss += v[i] * v[i];
    const float r = rsqrtf(wave_sum(ss) * (1.f / 512.f) + EPS);
    u32x4 o;
#pragma unroll
    for (int i = 0; i < 4; ++i) o[i] = pk2(v[2 * i] * r * g[lane * 8 + 2 * i], v[2 * i + 1] * r * g[lane * 8 + 2 * i + 1]);
    *(u32x4*)(row + lane * 8) = o;
}
__device__ __forceinline__ void fox_prep(int w, bf16_t* __restrict__ fq, bf16_t* __restrict__ fk, const float* __restrict__ gq, const float* __restrict__ gk, int lane) {
    const int t = w >> 4, h = w & 15;
#pragma unroll
    for (int which = 0; which < 2; ++which) {
        bf16_t* p = (which ? fk : fq) + (size_t)t * 2048 + h * 128; const float* g = which ? gk : gq;
        const float v0 = bf2f(p[lane]), v1 = bf2f(p[lane + 64]);
        const float r = rsqrtf(wave_sum(v0 * v0 + v1 * v1) * (1.f / 128.f) + EPS);
        const float qs = which ? 1.f : 0.12751743f;
        p[lane] = f2bf(v0 * r * g[lane] * qs); p[lane + 64] = f2bf(v1 * r * g[lane + 64] * qs);
    }
}
__device__ __forceinline__ void fox_cumsum(double* part, int h, const float* __restrict__ lf, float* __restrict__ F) {
    const int tid = opaque_tid(), lane = tid & 63, wave = tid >> 6;
    float v[16]; double sum = 0.0;
#pragma unroll
    for (int i = 0; i < 16; ++i) { v[i] = lf[(size_t)(tid * 16 + i) * 16 + h]; sum += (double)v[i]; }
    double inc = sum;
#pragma unroll
    for (int o = 1; o < 64; o <<= 1) { const double n = __shfl_up(inc, o); if (lane >= o) inc += n; }
    if (lane == 63) part[wave] = inc;
    __syncthreads();
    double base = 0.0;
    for (int w = 0; w < wave; ++w) base += part[w];
    double run = base + inc - sum;
#pragma unroll
    for (int i = 0; i < 16; ++i) { run += (double)v[i]; F[(size_t)h * S + tid * 16 + i] = (float)(run * 1.4426950408889634); }
    __syncthreads();
}
__device__ __forceinline__ void rope_table(const int* __restrict__ pos, float2* __restrict__ ropeT, int gtid, int nthreads) {
    for (int idx = gtid; idx < S * 32; idx += nthreads) { const int t = idx >> 5, i = idx & 31;
        const double inv = exp(-(double)i * (1.0 / 32.0) * 9.210340371976184);
        double ang = (double)((float)pos[t] * (float)inv);
        const double twopi = 6.283185307179586;
        ang -= twopi * rint(ang / twopi);
        ropeT[idx] = make_float2(cosf((float)ang), sinf((float)ang)); }
}
__device__ __forceinline__ void mla_prep(int w, bf16_t* __restrict__ qa, const bf16_t* __restrict__ kvraw, const bf16_t* __restrict__ kpe, const float2* __restrict__ ropeT,
                                         const float* __restrict__ gq, const float* __restrict__ gk, bf16_t* __restrict__ ka, int lane) {
    const int t = w >> 4, h = w & 15;
    const float2 cs = ropeT[t * 32 + (lane & 31)]; const float c = cs.x, s = cs.y;
    {
        bf16_t* q = qa + (size_t)t * 3072 + h * 192;
        float v0 = bf2f(q[lane]), v1 = bf2f(q[lane + 64]), v2 = bf2f(q[lane + 128]);
        const float r = rsqrtf(wave_sum(v0 * v0 + v1 * v1 + v2 * v2) * (1.f / 192.f) + EPS);
        v0 *= r * gq[lane]; v1 *= r * gq[lane + 64]; v2 *= r * gq[lane + 128];
        const float o = __shfl_xor(v2, 32);
        const float rr = lane < 32 ? v2 * c - o * s : o * s + v2 * c;
        q[lane] = f2bf(v0 * 0.10411754f); q[lane + 64] = f2bf(v1 * 0.10411754f); q[lane + 128] = f2bf(rr * 0.10411754f);
    }
    {
        const bf16_t* kn = kvraw + (size_t)t * 4096 + h * 256;
        float v0 = bf2f(kn[lane]), v1 = bf2f(kn[lane + 64]), v2 = bf2f(kpe[(size_t)t * 64 + lane]);
        const float r = rsqrtf(wave_sum(v0 * v0 + v1 * v1 + v2 * v2) * (1.f / 192.f) + EPS);
        v0 *= r * gk[lane]; v1 *= r * gk[lane + 64]; v2 *= r * gk[lane + 128];
        const float o = __shfl_xor(v2, 32);
        const float rr = lane < 32 ? v2 * c - o * s : o * s + v2 * c;
        bf16_t* k = ka + (size_t)t * 3072 + h * 192;
        k[lane] = f2bf(v0); k[lane + 64] = f2bf(v1); k[lane + 128] = f2bf(rr);
    }
}

typedef float f32x2 __attribute__((ext_vector_type(2)));
__device__ __forceinline__ unsigned pk4_fp8(float a, float b, float c, float d) {
    int w = __builtin_amdgcn_cvt_pk_fp8_f32(fminf(fmaxf(a, -448.f), 448.f), fminf(fmaxf(b, -448.f), 448.f), 0, false);
    w = __builtin_amdgcn_cvt_pk_fp8_f32(fminf(fmaxf(c, -448.f), 448.f), fminf(fmaxf(d, -448.f), 448.f), w, true); return (unsigned)w; }
__device__ __forceinline__ void cvt_rows_fp8(const float* __restrict__ src, unsigned char* __restrict__ dst, size_t n, float scale, int gw, int NGW, int lane) {
    const size_t nchunk = n / 1024;
    for (size_t c = gw; c < nchunk; c += NGW) { const size_t o = c * 1024 + lane * 16;
        f32x4 a[4];
#pragma unroll
        for (int q = 0; q < 4; ++q) a[q] = *(const f32x4*)(src + o + 4 * q) * scale;
        u32x4 w; w.x = pk4_fp8(a[0][0], a[0][1], a[0][2], a[0][3]); w.y = pk4_fp8(a[1][0], a[1][1], a[1][2], a[1][3]);
        w.z = pk4_fp8(a[2][0], a[2][1], a[2][2], a[2][3]); w.w = pk4_fp8(a[3][0], a[3][1], a[3][2], a[3][3]);
        *(u32x4*)(dst + o) = w; }
}
constexpr float U_SCALE = 64.f, V_SCALE = 4.f;
typedef __bf16 bf16x2_t __attribute__((ext_vector_type(2)));
__device__ __forceinline__ float dot2bf(unsigned a, unsigned b, float c) { return __builtin_amdgcn_fdot2_f32_bf16(__builtin_bit_cast(bf16x2_t, a), __builtin_bit_cast(bf16x2_t, b), c, false); }
#define PEER_INS(top, x) do { float x_ = (x); _Pragma("unroll") for (int i_ = 0; i_ < 16; ++i_) { const float hi_ = fmaxf(top[i_], x_); x_ = fminf(top[i_], x_); top[i_] = hi_; } } while (0)
__device__ __forceinline__ void peer_group(unsigned char* smem, int g, const float* __restrict__ scores, const bf16_t* __restrict__ h2, const float* __restrict__ x1,
                                           const unsigned char* __restrict__ U8, const unsigned char* __restrict__ V8, float* __restrict__ out) {
    const int tid = opaque_tid(), lane = tid & 63, wave = __builtin_amdgcn_readfirstlane(tid >> 6);
    float* topL = (float*)smem;
    int* selE = (int*)(smem + 32768);
    float* selG = (float*)(smem + 49152);
    {
        const int tl = tid >> 4, hc = tid & 15;
        const float* sp = scores + (size_t)(g * 32 + tl) * 2048 + hc * 128;
        float top[16];
#pragma unroll
        for (int i = 0; i < 16; ++i) top[i] = -INFINITY;
#pragma unroll 2
        for (int n0 = 0; n0 < 128; n0 += 4) { const f32x4 v = *(const f32x4*)(sp + n0);
#pragma unroll
            for (int e = 0; e < 4; ++e) PEER_INS(top, __uint_as_float((__float_as_uint(v[e]) & ~0x7Fu) | (unsigned)(n0 + e))); }
        float* tp = topL + (tl * 16 + hc) * 16;
#pragma unroll
        for (int i = 0; i < 16; i += 4) *(f32x4*)(tp + i) = (f32x4){top[i], top[i + 1], top[i + 2], top[i + 3]};
    }
    __syncthreads();
    if (tid < 256) {
        const int tl = tid >> 3, h = tid & 7;
        const float* t1 = topL + (tl * 16 + 2 * h) * 16; const float* t2 = t1 + 16;
        float s1[16], s2[16];
#pragma unroll
        for (int i = 0; i < 16; i += 4) { const f32x4 a = *(const f32x4*)(t1 + i), b2 = *(const f32x4*)(t2 + i);
            s1[i] = a[0]; s1[i + 1] = a[1]; s1[i + 2] = a[2]; s1[i + 3] = a[3]; s2[i] = b2[0]; s2[i + 1] = b2[1]; s2[i + 2] = b2[2]; s2[i + 3] = b2[3]; }
        float ts[16];
#pragma unroll
        for (int i = 0; i < 16; ++i) ts[i] = -INFINITY;
#pragma unroll
        for (int i = 0; i < 16; ++i)
#pragma unroll
            for (int j = 0; j < 16; ++j)
                if ((i + 1) * (j + 1) <= 16) PEER_INS(ts, __uint_as_float((__float_as_uint(s1[i] + s2[j]) & ~0xFFu) | (unsigned)(i * 16 + j)));
        float ex[16], sum = 0.f;
#pragma unroll
        for (int k = 0; k < 16; ++k) { ex[k] = __expf(ts[k] - ts[0]); sum += ex[k]; }
        const float inv = 1.f / sum;
#pragma unroll
        for (int k = 0; k < 16; ++k) { const unsigned pos = __float_as_uint(ts[k]) & 0xFFu;
            const int i1 = (int)(__float_as_uint(t1[pos >> 4]) & 0x7Fu), i2 = (int)(__float_as_uint(t2[pos & 15]) & 0x7Fu);
            selE[tl * 128 + h * 16 + k] = i1 * 128 + i2; selG[tl * 128 + h * 16 + k] = ex[k] * inv; }
    }
    __syncthreads();
    for (int ti = 0; ti < 4; ++ti) {
        const int tl = wave * 4 + ti; const size_t t = (size_t)g * 32 + tl;
        f32x2 hp[16];
#pragma unroll
        for (int j = 0; j < 2; ++j)
#pragma unroll
            for (int q = 0; q < 2; ++q) { const u32x4 w = *(const u32x4*)(h2 + t * DM + j * 1024 + lane * 16 + q * 8);
#pragma unroll
                for (int c = 0; c < 4; ++c) hp[j * 8 + q * 4 + c] = (f32x2){__uint_as_float(w[c] << 16), __uint_as_float(w[c] & 0xffff0000u)}; }
        f32x2 acc[16];
#pragma unroll
        for (int i = 0; i < 16; ++i) acc[i] = (f32x2){0.f, 0.f};
        for (int bb = 0; bb < 16; ++bb) {
            int e[8]; float gt[8];
#pragma unroll
            for (int q = 0; q < 8; ++q) { e[q] = __builtin_amdgcn_readfirstlane(selE[tl * 128 + bb * 8 + q]); gt[q] = selG[tl * 128 + bb * 8 + q]; }
            u32x4 ur[8][2], vr[8][2];
#pragma unroll
            for (int q = 0; q < 8; ++q)
#pragma unroll
                for (int j = 0; j < 2; ++j) ur[q][j] = *(const u32x4*)(U8 + (size_t)e[q] * DM + j * 1024 + lane * 16);
#pragma unroll
            for (int q = 0; q < 8; ++q)
#pragma unroll
                for (int j = 0; j < 2; ++j) vr[q][j] = *(const u32x4*)(V8 + (size_t)e[q] * DM + j * 1024 + lane * 16);
            float d[8];
#pragma unroll
            for (int q = 0; q < 8; ++q) { f32x2 a2 = (f32x2){0.f, 0.f};
#pragma unroll
                for (int j = 0; j < 2; ++j)
#pragma unroll
                    for (int c = 0; c < 4; ++c) { const int w = (int)ur[q][j][c];
                        a2 = __builtin_elementwise_fma(hp[j * 8 + 2 * c], __builtin_amdgcn_cvt_pk_f32_fp8(w, false), a2);
                        a2 = __builtin_elementwise_fma(hp[j * 8 + 2 * c + 1], __builtin_amdgcn_cvt_pk_f32_fp8(w, true), a2); }
                d[q] = a2.x + a2.y; }
            const bool b5 = (lane & 32) != 0, b4 = (lane & 16) != 0, b3 = (lane & 8) != 0;
            float k4[4];
#pragma unroll
            for (int i = 0; i < 4; ++i) k4[i] = (b5 ? d[4 + i] : d[i]) + __shfl_xor(b5 ? d[i] : d[4 + i], 32);
            float k2[2];
#pragma unroll
            for (int i = 0; i < 2; ++i) k2[i] = (b4 ? k4[2 + i] : k4[i]) + __shfl_xor(b4 ? k4[i] : k4[2 + i], 16);
            float c1 = (b3 ? k2[1] : k2[0]) + __shfl_xor(b3 ? k2[0] : k2[1], 8);
            c1 += __shfl_xor(c1, 4); c1 += __shfl_xor(c1, 2); c1 += __shfl_xor(c1, 1);
#pragma unroll
            for (int q = 0; q < 8; ++q) {
                const float a = __uint_as_float((unsigned)__builtin_amdgcn_readlane((int)__float_as_uint(c1), 8 * q)) * (1.f / U_SCALE);
                const float w = gt[q] * 0.5f * a * (1.f + erff(a * 0.70710678118654752f)) * (1.f / V_SCALE);
                const f32x2 w2 = (f32x2){w, w};
#pragma unroll
                for (int j = 0; j < 2; ++j)
#pragma unroll
                    for (int c = 0; c < 4; ++c) { const int x = (int)vr[q][j][c];
                        acc[j * 8 + 2 * c] = __builtin_elementwise_fma(w2, __builtin_amdgcn_cvt_pk_f32_fp8(x, false), acc[j * 8 + 2 * c]);
                        acc[j * 8 + 2 * c + 1] = __builtin_elementwise_fma(w2, __builtin_amdgcn_cvt_pk_f32_fp8(x, true), acc[j * 8 + 2 * c + 1]); }
            }
        }
#pragma unroll
        for (int j = 0; j < 2; ++j)
#pragma unroll
            for (int q = 0; q < 4; ++q) { const size_t o = t * DM + j * 1024 + lane * 16 + q * 4;
                const f32x4 a = *(const f32x4*)(x1 + o);
                *(f32x4*)(out + o) = (f32x4){a[0] + acc[j * 8 + 2 * q].x, a[1] + acc[j * 8 + 2 * q].y, a[2] + acc[j * 8 + 2 * q + 1].x, a[3] + acc[j * 8 + 2 * q + 1].y}; }
    }
    __syncthreads();
}

#define XB_TMO      128
#define XB_XCNT(j)  (256  + 64 * (j))
#define XB_XSUB(j)  (1280 + 64 * (j))
#define XB_XGEN(j)  (2304 + 64 * (j))
#define XB_TOP      3328
#define XB_TOPGEN   3392
#define XCD_BAR_WORDS 3456
#define XB_SPIN_CAP (1u << 18)

__device__ __forceinline__ unsigned xb_ld(unsigned* p)              { return __hip_atomic_load(p, __ATOMIC_RELAXED, __HIP_MEMORY_SCOPE_AGENT); }
__device__ __forceinline__ unsigned xb_add(unsigned* p, unsigned v) { return __hip_atomic_fetch_add(p, v, __ATOMIC_RELAXED, __HIP_MEMORY_SCOPE_AGENT); }
__device__ __forceinline__ unsigned xb_xcc_id() { return (unsigned)__builtin_amdgcn_s_getreg((3 << 11) | 20) & 0xFu; }
#define XB_SPIN(cond, bar) do { unsigned _sp = 0; while (cond) { __builtin_amdgcn_s_sleep(1); \
    if ((++_sp & 255u) == 0u) { if (xb_ld(&(bar)[XB_TMO])) break; if (_sp > XB_SPIN_CAP) { atomicAdd(&(bar)[XB_TMO], 1u); break; } } } } while (0)

struct XcdBarrier {
    unsigned* bar; unsigned x;
    volatile LAS unsigned* st;
};

__device__ __forceinline__ XcdBarrier xcd_barrier_post(unsigned* bar, volatile LAS unsigned* st) {
    XcdBarrier b; b.bar = bar; b.x = xb_xcc_id(); b.st = st;
    if (threadIdx.x == 0) (void)xb_add(&bar[XB_XCNT(b.x)], 1u);
    return b;
}
__device__ __forceinline__ void xcd_barrier_complete(unsigned* bar, unsigned x, unsigned& nloc, unsigned& nx) {
    const unsigned G = gridDim.x * gridDim.y * gridDim.z;
    unsigned sum, cnt, mine, sp = 0u;
    for (;;) {
        sum = 0u; cnt = 0u; mine = 0u;
#pragma unroll
        for (unsigned j = 0; j < 16; ++j) { const unsigned c = xb_ld(&bar[XB_XCNT(j)]); sum += c; cnt += (c > 0u) ? 1u : 0u; mine = (j == x) ? c : mine; }
        if (sum == G) break;
        __builtin_amdgcn_s_sleep(1);
        if ((++sp & 255u) == 0u) { if (xb_ld(&bar[XB_TMO])) break; if (sp > XB_SPIN_CAP) { atomicAdd(&bar[XB_TMO], 1u); break; } }
    }
    nloc = mine > 0u ? mine : 1u; nx = cnt > 0u ? cnt : 1u;
}

__device__ __forceinline__ void xcd_barrier(const XcdBarrier& b) {
    asm volatile("s_waitcnt vmcnt(0)" ::: "memory");
    __syncthreads();
    if (threadIdx.x == 0) {
        unsigned* bar = b.bar;
        __builtin_amdgcn_s_waitcnt(0);
        unsigned nloc = b.st[0], nx = b.st[1];
        if (nloc == 0u) { xcd_barrier_complete(bar, b.x, nloc, nx); b.st[0] = nloc; b.st[1] = nx; }
        const unsigned old = xb_add(&bar[XB_XSUB(b.x)], 1u);
        const unsigned gen = old / nloc;
        if (old + 1u == (gen + 1u) * nloc) {
            __builtin_amdgcn_fence(__ATOMIC_RELEASE, "agent");
            asm volatile("s_waitcnt vmcnt(0)" ::: "memory");
            const unsigned og = xb_add(&bar[XB_TOP], 1u);
            const unsigned tg = og / nx;
            if (og + 1u == (tg + 1u) * nx) xb_add(&bar[XB_TOPGEN], 1u);
            else XB_SPIN(xb_ld(&bar[XB_TOPGEN]) == tg, bar);
            __builtin_amdgcn_fence(__ATOMIC_ACQUIRE, "agent");
            xb_add(&bar[XB_XGEN(b.x)], 1u);
            asm volatile("s_waitcnt vmcnt(0)" ::: "memory");
        } else {
            XB_SPIN(xb_ld(&bar[XB_XGEN(b.x)]) == gen, bar);
            __builtin_amdgcn_fence(__ATOMIC_ACQUIRE, "agent");
            asm volatile("s_waitcnt vmcnt(0)" ::: "memory");
        }
    }
    __syncthreads();
}

#define PROBE_DOUBLE 0
#define REP(k) for (int rep_ = 0; rep_ < ((PROBE_DOUBLE == (k)) ? 2 : 1); ++rep_)
constexpr int LDS_BYTES = 147456;
__global__ __launch_bounds__(512, 2) void mega(Params p) {
    extern __shared__ __attribute__((aligned(16))) unsigned char smem[];
    { volatile LAS unsigned* st0 = (volatile LAS unsigned*)((LAS unsigned char*)smem + 131072); if (threadIdx.x < 2) st0[threadIdx.x] = 0u; }
    __syncthreads();
    const XcdBarrier bar = xcd_barrier_post(p.ctl, (volatile LAS unsigned*)((LAS unsigned char*)smem + 131072));
    float* smf = (float*)smem;
    LAS unsigned char* lds = (LAS unsigned char*)smem;
    const int G = gridDim.x, b = blockIdx.x, NGW = G * 8;
#define PHASE_IDS() const int tid = opaque_tid(), lane = tid & 63, wave = __builtin_amdgcn_readfirstlane(tid >> 6), gw = b * 8 + wave; (void)lane; (void)gw

    REP(7) {
        PHASE_IDS();
        float* scr = smf + wave * 4096;
        constexpr int I_IN = 32 * 355, I_Q = 8 * 96, I_KV = 8 * 128, I_O = 64 * 64;
        for (int it = gw; it < I_IN + I_Q + I_KV + I_O; it += NGW) {
            int r = it;
            if (r < I_IN) { transpose_item(p.w_in, 2048, INW, p.WinT, DstWin(), scr, r, lane); continue; } r -= I_IN;
            if (r < I_Q) { transpose_item(p.w_q_up, 512, 3072, p.WqT, DstId(), scr, r, lane); continue; } r -= I_Q;
            if (r < I_KV) { transpose_item(p.w_kv_up, 512, 4096, p.WkvT, DstId(), scr, r, lane); continue; } r -= I_KV;
            transpose_item(p.w_out, 4096, 2048, p.WoT, DstId(), scr, r, lane);
        }
        for (int m = gw; m < S; m += NGW) rms_row2048(p.x + (size_t)m * DM, p.mix_g, p.h + (size_t)m * DM, lane);
        __syncthreads();
        for (int it = b; it < 512; it += G) wfold_item(p.w_peer_q, p.sub_keys, p.WpT, smf, it);
    }
    xcd_barrier(bar);
    REP(1) {
        pg8::Gemm g{p.h, p.WinT, S, INWP, DM}; pg8::StaticOrder so; so.init(S, INWP, G, b);
        pg8::EpiInProj E{p.cq, p.ckv, p.fq, p.fk, p.fv, p.merged, p.kpe, p.lf, p.b_gate, p.b_forget};
        pg8::gemm_phase<pg8::EpiInProj, pg8::StaticOrder, true, true>(lds, g, so, E);
    }
    xcd_barrier(bar);
    {
    PHASE_IDS();
    for (int t = gw; t < S; t += NGW) { rms_row512_inplace(p.cq + (size_t)t * 512, p.q_lat_g, lane); rms_row512_inplace(p.ckv + (size_t)t * 512, p.kv_lat_g, lane); }
    for (int w = gw; w < S * 16; w += NGW) fox_prep(w, p.fq, p.fk, p.fox_qg, p.fox_kg, lane);
    rope_table(p.pos, p.ropeT, b * 512 + tid, G * 512);
    for (int hh = b; hh < 16; hh += G) fox_cumsum((double*)smem, hh, p.lf, p.F);
    }
    xcd_barrier(bar);
    REP(2) {
        pg8::Gemm g{p.cq, p.WqT, S, 3072, 512}; pg8::StaticOrder so; so.init(S, 3072, G, b);
        pg8::EpiStoreBf16 E{p.qa, 3072};
        pg8::gemm_phase<pg8::EpiStoreBf16, pg8::StaticOrder, true, true>(lds, g, so, E);
    }
    {
        pg8::Gemm g{p.ckv, p.WkvT, S, 4096, 512}; pg8::StaticOrder so; so.init(S, 4096, G, b);
        pg8::EpiStoreBf16 E{p.kvraw, 4096};
        pg8::gemm_phase<pg8::EpiStoreBf16, pg8::StaticOrder, true, true>(lds, g, so, E);
    }
    xcd_barrier(bar);
    { PHASE_IDS(); for (int w = gw; w < S * 16; w += NGW) mla_prep(w, p.qa, p.kvraw, p.kpe, p.ropeT, p.mla_qg, p.mla_kg, p.ka, lane); }
    xcd_barrier(bar);
    REP(3) for (int L = b; L < 1024; L += G) {
        const int i = L >> 8, vc = L & 255, vcx = (vc & 7) * 32 + (vc >> 3), hh = vcx >> 4, x = vcx & 15, qbk = (i & 1) ? x : 31 - x;
        if (i < 2) att::attn_block<192, false>(smem, p.qa + hh * 192, 3072, p.ka + hh * 192, 3072, p.kvraw + hh * 256 + 128, 4096, nullptr, p.merged + hh * 128, p.attout + hh * 128, qbk, nullptr, nullptr);
        else att::attn_block<128, true>(smem, p.fq + hh * 128, 2048, p.fk + hh * 128, 2048, p.fv + hh * 128, 2048, p.F + (size_t)hh * S, p.merged + 2048 + hh * 128, p.attout + 2048 + hh * 128, qbk, p.fox_qg, p.fox_kg);
    }
    xcd_barrier(bar);
    REP(4) {
        pg8::Gemm g{p.attout, p.WoT, S, 2048, 4096}; pg8::StaticOrder so; so.init(S, 2048, G, b);
        pg8::EpiStoreF32<true> E{p.x1, p.x, 2048};
        pg8::gemm_phase<pg8::EpiStoreF32<true>, pg8::StaticOrder, true, true>(lds, g, so, E);
    }
    xcd_barrier(bar);
    { PHASE_IDS(); for (int m = gw; m < S; m += NGW) rms_row2048(p.x1 + (size_t)m * DM, p.ffn_g, p.h + (size_t)m * DM, lane);
      cvt_rows_fp8(p.peer_u, p.U8, (size_t)16384 * 2048, U_SCALE, gw, NGW, lane); cvt_rows_fp8(p.peer_v, p.V8, (size_t)16384 * 2048, V_SCALE, gw, NGW, lane); }
    xcd_barrier(bar);
    REP(5) {
        pg8::Gemm g{p.h, p.WpT, S, 2048, 2048}; pg8::StaticOrder so; so.init(S, 2048, G, b);
        pg8::EpiStoreF32<false> E{p.scores, nullptr, 2048};
        pg8::gemm_phase<pg8::EpiStoreF32<false>, pg8::StaticOrder, true, true>(lds, g, so, E);
    }
    xcd_barrier(bar);
    REP(6) for (int g = b; g < S / 32; g += G) peer_group(smem, g, p.scores, p.h, p.x1, p.U8, p.V8, p.out);
}

extern "C" void kernel_launch(void* const* d_in, const int* in_sizes, int n_in,
                              void* d_out, int out_size, void* d_ws, size_t ws_size,
                              hipStream_t stream) {
    if (ws_size < 512 * MiB) { fprintf(stderr, "kernel_launch: workspace too small (%zu)\n", ws_size); return; }
    Params p{};
    p.x = (const float*)d_in[0]; p.pos = (const int*)d_in[1]; p.mix_g = (const float*)d_in[2]; p.w_in = (const float*)d_in[3];
    p.b_forget = (const float*)d_in[4]; p.b_gate = (const float*)d_in[5]; p.q_lat_g = (const float*)d_in[6]; p.w_q_up = (const float*)d_in[7];
    p.kv_lat_g = (const float*)d_in[8]; p.w_kv_up = (const float*)d_in[9]; p.mla_qg = (const float*)d_in[10]; p.mla_kg = (const float*)d_in[11];
    p.fox_qg = (const float*)d_in[12]; p.fox_kg = (const float*)d_in[13]; p.w_out = (const float*)d_in[14]; p.ffn_g = (const float*)d_in[15];
    p.w_peer_q = (const float*)d_in[16]; p.sub_keys = (const float*)d_in[17]; p.peer_u = (const float*)d_in[18]; p.peer_v = (const float*)d_in[19];
    p.out = (float*)d_out;
    char* ws = (char*)d_ws;
    p.WqT = (bf16_t*)(ws + 1 * MiB); p.WkvT = (bf16_t*)(ws + 5 * MiB); p.WoT = (bf16_t*)(ws + 9 * MiB); p.WpT = (bf16_t*)(ws + 25 * MiB); p.WinT = (bf16_t*)(ws + 33 * MiB);
    p.h = (bf16_t*)(ws + 78 * MiB); p.cq = (bf16_t*)(ws + 110 * MiB); p.ckv = (bf16_t*)(ws + 118 * MiB);
    p.fq = (bf16_t*)(ws + 126 * MiB); p.fk = (bf16_t*)(ws + 158 * MiB); p.fv = (bf16_t*)(ws + 190 * MiB); p.merged = (bf16_t*)(ws + 222 * MiB);
    p.kpe = (bf16_t*)(ws + 286 * MiB); p.lf = (float*)(ws + 287 * MiB); p.F = (float*)(ws + 287 * MiB + 512 * 1024);
    p.qa = (bf16_t*)(ws + 288 * MiB); p.kvraw = (bf16_t*)(ws + 336 * MiB); p.ka = (bf16_t*)(ws + 400 * MiB); p.x1 = (float*)(ws + 448 * MiB);
    p.scores = (float*)(ws + 222 * MiB);
    p.ctl = (unsigned*)ws;
    p.ropeT = (float2*)(ws + 33 * MiB);
    p.attout = (bf16_t*)(ws + 33 * MiB);
    p.U8 = (unsigned char*)(ws + 126 * MiB); p.V8 = (unsigned char*)(ws + 158 * MiB);

    static int grid_blocks = 0;
    if (!grid_blocks) {
        if (hipFuncSetAttribute((const void*)mega, hipFuncAttributeMaxDynamicSharedMemorySize, LDS_BYTES) != hipSuccess) { fprintf(stderr, "hipFuncSetAttribute failed\n"); return; }
        int dev = 0, cus = 0, per_cu = 0;
        (void)hipGetDevice(&dev);
        (void)hipDeviceGetAttribute(&cus, hipDeviceAttributeMultiprocessorCount, dev);
        (void)hipOccupancyMaxActiveBlocksPerMultiprocessor(&per_cu, (const void*)mega, 512, LDS_BYTES);
        if (per_cu < 1 || cus < 1) { fprintf(stderr, "occupancy query says %d blocks/CU on %d CUs\n", per_cu, cus); return; }
        grid_blocks = cus;
    }
    if (hipMemsetAsync(d_ws, 0, 16384, stream) != hipSuccess) { fprintf(stderr, "memset of the barrier words failed\n"); return; }
    void* args[] = {&p};
    hipError_t e = hipLaunchCooperativeKernel((const void*)mega, dim3(grid_blocks), dim3(512), args, LDS_BYTES, stream);
    if (e != hipSuccess) fprintf(stderr, "cooperative launch failed: %s (grid %d)\n", hipGetErrorString(e), grid_blocks);
}
```

```cpp
#include <hip/hip_runtime.h>
#include <hip/hip_cooperative_groups.h>
#include <stdint.h>
#include <math.h>
#include <cstdio>
namespace cg = cooperative_groups;

namespace pg8 {
#define PG8_LAS __attribute__((address_space(3)))
typedef unsigned short bf16_t;
typedef short bf16x8 __attribute__((ext_vector_type(8)));
typedef float f32x4 __attribute__((ext_vector_type(4)));
typedef unsigned u32x4 __attribute__((ext_vector_type(4)));
constexpr int BM = 256, BK = 64, HALF = 128, HTB = HALF * BK * 2  , STAGE_BYTES = 8 * HTB, NXCD = 8, WGM = 8;

__host__ __device__ __forceinline__ int lds_byte(int r, int c) { const int st = (r >> 4) * 2 + (c >> 5), rr = r & 15, cc = c & 31, ob = rr * 64 + cc * 2; return st * 1024 + (ob ^ (((ob >> 9) & 1) << 5)); }
__host__ __device__ __forceinline__ void stage_rc(int b, int& R, int& C) { const int st = b / 1024, sb = b % 1024, swz = sb ^ (((sb >> 9) & 1) << 5); R = (st >> 1) * 16 + swz / 64; C = (st & 1) * 32 + (swz % 64) / 2; }
__host__ __device__ __forceinline__ int perm32(int rho) { const int n = rho >> 4, i = rho & 15; return 8 * (i >> 2) + 4 * n + (i & 3); }

struct Unit { int pm, pn; };
struct Gemm { const bf16_t* A; const bf16_t* Bt; int M, N, K; };

struct StaticOrder {
    int nM, nN, nwg, G, c;
    __host__ __device__ void init(int M, int N, int G_, int c_) { nM = M / BM; nN = N / BM; nwg = nM * nN; G = G_; c = c_; }
    __host__ __device__ bool next(int i, Unit& u) const {
        const long L = (long)i * G + c; if (L >= nwg) return false;
        int wgid = (int)L; { const int q = nwg / NXCD, r = nwg % NXCD, xcd = wgid % NXCD, off = wgid / NXCD; wgid = (xcd < r ? xcd * (q + 1) : r * (q + 1) + (xcd - r) * q) + off; }
        const int nig = WGM * nN, gid = wgid / nig, fm = gid * WGM, gsz = (nM - fm) < WGM ? (nM - fm) : WGM;
        u.pm = fm + ((wgid % nig) % gsz); u.pn = (wgid % nig) / gsz; return true;
    }
    __device__ __forceinline__ void a_ready(const Unit&) const {}
    __device__ __forceinline__ void done(const Unit&) const {}
};

__device__ __forceinline__ unsigned cvt_pk_bf16(float lo, float hi) { unsigned r; asm volatile("v_cvt_pk_bf16_f32 %0, %1, %2" : "=v"(r) : "v"(lo), "v"(hi)); return r; }
__device__ __forceinline__ u32x4 pack8bf(const f32x4& v0, const f32x4& v1) { u32x4 w; w.x = cvt_pk_bf16(v0[0], v0[1]); w.y = cvt_pk_bf16(v0[2], v0[3]); w.z = cvt_pk_bf16(v1[0], v1[1]); w.w = cvt_pk_bf16(v1[2], v1[3]); return w; }

struct EpiStoreBf16 {
    static constexpr bool PERM = true, AFTER_DRAIN = false;
    bf16_t* O; int ldc;
    __device__ __forceinline__ void operator()(const f32x4 (&acc)[2][2][4][2], const Unit& u, int wr, int wc, int fr, int fq) const {
        const int row0 = u.pm * BM + wr * 64 + fr, col0 = u.pn * BM + wc * 32 + 8 * fq;
#pragma unroll
        for (int ai = 0; ai < 2; ++ai)
#pragma unroll
            for (int m = 0; m < 4; ++m) { bf16_t* rowp = O + (size_t)(row0 + ai * HALF + m * 16) * ldc + col0;
#pragma unroll
                for (int bj = 0; bj < 2; ++bj) *(u32x4*)(rowp + bj * HALF) = pack8bf(acc[ai][bj][m][0], acc[ai][bj][m][1]); }
    }
};
template <bool RES> struct EpiStoreF32 {
    static constexpr bool PERM = true, AFTER_DRAIN = false;
    float* O; const float* res; int ldc;
    __device__ __forceinline__ void operator()(const f32x4 (&acc)[2][2][4][2], const Unit& u, int wr, int wc, int fr, int fq) const {
        const int row0 = u.pm * BM + wr * 64 + fr, col0 = u.pn * BM + wc * 32 + 8 * fq;
#pragma unroll
        for (int ai = 0; ai < 2; ++ai)
#pragma unroll
            for (int m = 0; m < 4; ++m) { const size_t off = (size_t)(row0 + ai * HALF + m * 16) * ldc + col0;
#pragma unroll
                for (int bj = 0; bj < 2; ++bj) { f32x4 v0 = acc[ai][bj][m][0], v1 = acc[ai][bj][m][1];
                    if (RES) { v0 += *(const f32x4*)(res + off + bj * HALF); v1 += *(const f32x4*)(res + off + bj * HALF + 4); }
                    *(f32x4*)(O + off + bj * HALF) = v0; *(f32x4*)(O + off + bj * HALF + 4) = v1; } }
    }
};
#define EPI_LDSBAR() do { asm volatile("s_waitcnt lgkmcnt(0)" ::: "memory"); __builtin_amdgcn_s_barrier(); asm volatile("" ::: "memory"); } while (0)
struct EpiInProj {
    static constexpr bool PERM = true, AFTER_DRAIN = false;
    bf16_t *cq, *ckv, *fq, *fk, *fv, *gates, *kpe; float* lf; const float *b_gate, *b_forget; float* ssq; const float *gfq, *gfk; PG8_LAS float* xs;
    __device__ __forceinline__ void operator()(const f32x4 (&acc)[2][2][4][2], const Unit& u, int wr, int wc, int fr, int fq_) const {
        const int pn = u.pn, row0 = u.pm * BM + wr * 64 + fr, cw = wc * 32 + 8 * fq_;
        if (pn < 4) {
            bf16_t* base = pn < 2 ? cq : ckv; const int colt = (pn & 1) * 256;
#pragma unroll
            for (int ai = 0; ai < 2; ++ai)
#pragma unroll
                for (int m = 0; m < 4; ++m) { const int row = row0 + ai * HALF + m * 16; bf16_t* rowp = base + (size_t)row * 512 + colt + cw; float s = 0.f;
#pragma unroll
                    for (int bj = 0; bj < 2; ++bj) { const f32x4 v0 = acc[ai][bj][m][0], v1 = acc[ai][bj][m][1];
                        s += (v0[0] * v0[0] + v0[1] * v0[1]) + (v0[2] * v0[2] + v0[3] * v0[3]) + (v1[0] * v1[0] + v1[1] * v1[1]) + (v1[2] * v1[2] + v1[3] * v1[3]);
                        *(u32x4*)(rowp + bj * HALF) = pack8bf(v0, v1); }
                    s += __shfl_xor(s, 16); s += __shfl_xor(s, 32);
                    if (fq_ == 0) ssq[((size_t)pn * 8192 + row) * 4 + wc] = s; }
        } else if (pn < 20) {
            const bool isq = pn < 12; bf16_t* base = isq ? fq : fk; const int colt = (pn - (isq ? 4 : 12)) * 256; const float* g = isq ? gfq : gfk;
            const float qs = isq ? 0.12751743f : 1.f;
#pragma unroll
            for (int ai = 0; ai < 2; ++ai)
#pragma unroll
                for (int m = 0; m < 4; ++m)
#pragma unroll
                    for (int bj = 0; bj < 2; ++bj) { const f32x4 v0 = acc[ai][bj][m][0], v1 = acc[ai][bj][m][1];
                        float s = (v0[0] * v0[0] + v0[1] * v0[1]) + (v0[2] * v0[2] + v0[3] * v0[3]) + (v1[0] * v1[0] + v1[1] * v1[1]) + (v1[2] * v1[2] + v1[3] * v1[3]);
                        s += __shfl_xor(s, 16); s += __shfl_xor(s, 32);
                        if (fq_ == 0) xs[((ai * HALF + wr * 64 + m * 16 + fr) * 2 + bj) * 4 + wc] = s; }
            EPI_LDSBAR();
            const f32x4 g0 = *(const f32x4*)(g + cw) * qs, g1 = *(const f32x4*)(g + cw + 4) * qs;
#pragma unroll
            for (int ai = 0; ai < 2; ++ai)
#pragma unroll
                for (int m = 0; m < 4; ++m) { bf16_t* rowp = base + (size_t)(row0 + ai * HALF + m * 16) * 2048 + colt + cw;
#pragma unroll
                    for (int bj = 0; bj < 2; ++bj) { const f32x4 t4 = *(const PG8_LAS f32x4*)(xs + ((ai * HALF + wr * 64 + m * 16 + fr) * 2 + bj) * 4);
                        const float r = rsqrtf(((t4[0] + t4[1]) + (t4[2] + t4[3])) * (1.f / 128.f) + 1e-6f);
                        *(u32x4*)(rowp + bj * HALF) = pack8bf(acc[ai][bj][m][0] * g0 * r, acc[ai][bj][m][1] * g1 * r); } }
        } else if (pn < 28) {
            const int colt = (pn - 20) * 256;
#pragma unroll
            for (int ai = 0; ai < 2; ++ai)
#pragma unroll
                for (int m = 0; m < 4; ++m) { bf16_t* rowp = fv + (size_t)(row0 + ai * HALF + m * 16) * 2048 + colt + cw;
#pragma unroll
                    for (int bj = 0; bj < 2; ++bj) *(u32x4*)(rowp + bj * HALF) = pack8bf(acc[ai][bj][m][0], acc[ai][bj][m][1]); }
        } else if (pn < 44) {
            const int colt = (pn - 28) * 256 + cw;
#pragma unroll
            for (int bj = 0; bj < 2; ++bj) {
                const f32x4 b0 = *(const f32x4*)(b_gate + colt + bj * HALF), b1 = *(const f32x4*)(b_gate + colt + bj * HALF + 4);
#pragma unroll
                for (int ai = 0; ai < 2; ++ai)
#pragma unroll
                    for (int m = 0; m < 4; ++m) {
                        f32x4 v0 = acc[ai][bj][m][0] + b0, v1 = acc[ai][bj][m][1] + b1;
#pragma unroll
                        for (int e = 0; e < 4; ++e) { v0[e] = 1.f / (1.f + __expf(-v0[e])); v1[e] = 1.f / (1.f + __expf(-v1[e])); }
                        *(u32x4*)(gates + (size_t)(row0 + ai * HALF + m * 16) * 4096 + colt + bj * HALF) = pack8bf(v0, v1); }
            }
        } else {
            if (cw < 64) {
#pragma unroll
                for (int ai = 0; ai < 2; ++ai)
#pragma unroll
                    for (int m = 0; m < 4; ++m) *(u32x4*)(kpe + (size_t)(row0 + ai * HALF + m * 16) * 64 + cw) = pack8bf(acc[ai][0][m][0], acc[ai][0][m][1]);
            } else if (cw < 80) {
                const int h0 = cw - 64;
                const f32x4 b0 = *(const f32x4*)(b_forget + h0), b1 = *(const f32x4*)(b_forget + h0 + 4);
#pragma unroll
                for (int ai = 0; ai < 2; ++ai)
#pragma unroll
                    for (int m = 0; m < 4; ++m) { const int row = row0 + ai * HALF + m * 16;
                        f32x4 z0 = acc[ai][0][m][0] + b0, z1 = acc[ai][0][m][1] + b1;
#pragma unroll
                        for (int e = 0; e < 4; ++e) { z0[e] = fminf(z0[e], 0.f) - __logf(1.f + __expf(-fabsf(z0[e]))); z1[e] = fminf(z1[e], 0.f) - __logf(1.f + __expf(-fabsf(z1[e]))); }
                        *(f32x4*)(lf + (size_t)row * 16 + h0) = z0; *(f32x4*)(lf + (size_t)row * 16 + h0 + 4) = z1; }
            }
        }
    }
};
__device__ __forceinline__ float lat_rinv(const float* ssq, int part0, int row) {
    const f32x4 a = *(const f32x4*)(ssq + ((size_t)part0 * 8192 + row) * 4), b = *(const f32x4*)(ssq + ((size_t)(part0 + 1) * 8192 + row) * 4);
    return rsqrtf((((a[0] + a[1]) + (a[2] + a[3])) + ((b[0] + b[1]) + (b[2] + b[3]))) * (1.f / 512.f) + 1e-6f);
}
struct EpiQ {
    static constexpr bool PERM = true, AFTER_DRAIN = false;
    bf16_t* qa; const float* ssq; const float* gq; const float2* ropeT; PG8_LAS float* xs;
    __device__ __forceinline__ void operator()(const f32x4 (&acc)[2][2][4][2], const Unit& u, int wr, int wc, int fr, int fq_) const {
        const int h = u.pn, row0 = u.pm * BM + wr * 64 + fr, cw = wc * 32 + 8 * fq_;
        float rl[2][4];
#pragma unroll
        for (int ai = 0; ai < 2; ++ai)
#pragma unroll
            for (int m = 0; m < 4; ++m) { rl[ai][m] = lat_rinv(ssq, 0, row0 + ai * HALF + m * 16); float s = 0.f;
#pragma unroll
                for (int bj = 0; bj < 2; ++bj) { const f32x4 v0 = acc[ai][bj][m][0], v1 = acc[ai][bj][m][1];
                    s += (v0[0] * v0[0] + v0[1] * v0[1]) + (v0[2] * v0[2] + v0[3] * v0[3]) + (v1[0] * v1[0] + v1[1] * v1[1]) + (v1[2] * v1[2] + v1[3] * v1[3]); }
                s *= rl[ai][m] * rl[ai][m];
                s += __shfl_xor(s, 16); s += __shfl_xor(s, 32);
                if (fq_ == 0) xs[(ai * HALF + wr * 64 + m * 16 + fr) * 4 + wc] = s; }
        EPI_LDSBAR();
        const float qs = 0.10411754f;
        const f32x4 g0 = *(const f32x4*)(gq + cw) * qs, g1 = *(const f32x4*)(gq + cw + 4) * qs;
        const int pp = 16 * (wc & 1) + 4 * fq_;
        const f32x4 ga = *(const f32x4*)(gq + 128 + pp) * qs, gb = *(const f32x4*)(gq + 160 + pp) * qs;
#pragma unroll
        for (int ai = 0; ai < 2; ++ai)
#pragma unroll
            for (int m = 0; m < 4; ++m) { const int row = row0 + ai * HALF + m * 16;
                const f32x4 t4 = *(const PG8_LAS f32x4*)(xs + (ai * HALF + wr * 64 + m * 16 + fr) * 4);
                const float r = rsqrtf(((t4[0] + t4[1]) + (t4[2] + t4[3])) * (1.f / 192.f) + 1e-6f) * rl[ai][m];
                bf16_t* rowp = qa + (size_t)row * 3072 + h * 192;
                *(u32x4*)(rowp + cw) = pack8bf(acc[ai][0][m][0] * g0 * r, acc[ai][0][m][1] * g1 * r);
                if (wc < 2) { const f32x4 c01 = *(const f32x4*)(ropeT + (size_t)row * 32 + pp), c23 = *(const f32x4*)(ropeT + (size_t)row * 32 + pp + 2);
                    const f32x4 z0 = acc[ai][1][m][0] * r, z1 = acc[ai][1][m][1] * r;
                    const float a0 = z0[0] * ga[0], b0 = z0[1] * gb[0], a1 = z0[2] * ga[1], b1 = z0[3] * gb[1], a2 = z1[0] * ga[2], b2 = z1[1] * gb[2], a3 = z1[2] * ga[3], b3 = z1[3] * gb[3];
                    const f32x4 o0 = {a0 * c01[0] - b0 * c01[1], a0 * c01[1] + b0 * c01[0], a1 * c01[2] - b1 * c01[3], a1 * c01[3] + b1 * c01[2]};
                    const f32x4 o1 = {a2 * c23[0] - b2 * c23[1], a2 * c23[1] + b2 * c23[0], a3 * c23[2] - b3 * c23[3], a3 * c23[3] + b3 * c23[2]};
                    *(u32x4*)(rowp + 128 + cw) = pack8bf(o0, o1); } }
    }
};
struct EpiKV {
    static constexpr bool PERM = true, AFTER_DRAIN = false;
    bf16_t *ka, *va; const bf16_t* kpe; const float* ssq; const float* gk; const float2* ropeT; PG8_LAS float* xs;
    __device__ __forceinline__ void operator()(const f32x4 (&acc)[2][2][4][2], const Unit& u, int wr, int wc, int fr, int fq_) const {
        const int h = u.pn, row0 = u.pm * BM + wr * 64 + fr, cw = wc * 32 + 8 * fq_;
        float rl[2][4]; f32x4 kp[2][4];
#pragma unroll
        for (int ai = 0; ai < 2; ++ai)
#pragma unroll
            for (int m = 0; m < 4; ++m) { const int row = row0 + ai * HALF + m * 16; rl[ai][m] = lat_rinv(ssq, 2, row);
                const uint2 w = *(const uint2*)(kpe + (size_t)row * 64 + 16 * wc + 4 * fq_);
                kp[ai][m] = (f32x4){__uint_as_float(w.x << 16), __uint_as_float(w.x & 0xffff0000u), __uint_as_float(w.y << 16), __uint_as_float(w.y & 0xffff0000u)};
                const f32x4 v0 = acc[ai][0][m][0], v1 = acc[ai][0][m][1];
                float s = ((v0[0] * v0[0] + v0[1] * v0[1]) + (v0[2] * v0[2] + v0[3] * v0[3]) + (v1[0] * v1[0] + v1[1] * v1[1]) + (v1[2] * v1[2] + v1[3] * v1[3])) * (rl[ai][m] * rl[ai][m]);
                s += (kp[ai][m][0] * kp[ai][m][0] + kp[ai][m][1] * kp[ai][m][1]) + (kp[ai][m][2] * kp[ai][m][2] + kp[ai][m][3] * kp[ai][m][3]);
                s += __shfl_xor(s, 16); s += __shfl_xor(s, 32);
                if (fq_ == 0) xs[(ai * HALF + wr * 64 + m * 16 + fr) * 4 + wc] = s;
                *(u32x4*)(va + (size_t)row * 2048 + h * 128 + cw) = pack8bf(acc[ai][1][m][0] * rl[ai][m], acc[ai][1][m][1] * rl[ai][m]); }
        EPI_LDSBAR();
        const f32x4 g0 = *(const f32x4*)(gk + cw), g1 = *(const f32x4*)(gk + cw + 4);
        const int pp = 8 * wc + 2 * fq_;
        const float ga0 = gk[128 + pp], ga1 = gk[128 + pp + 1], gb0 = gk[160 + pp], gb1 = gk[160 + pp + 1];
#pragma unroll
        for (int ai = 0; ai < 2; ++ai)
#pragma unroll
            for (int m = 0; m < 4; ++m) { const int row = row0 + ai * HALF + m * 16;
                const f32x4 t4 = *(const PG8_LAS f32x4*)(xs + (ai * HALF + wr * 64 + m * 16 + fr) * 4);
                const float r = rsqrtf(((t4[0] + t4[1]) + (t4[2] + t4[3])) * (1.f / 192.f) + 1e-6f), rn = r * rl[ai][m];
                bf16_t* rowp = ka + (size_t)row * 3072 + h * 192;
                *(u32x4*)(rowp + cw) = pack8bf(acc[ai][0][m][0] * g0 * rn, acc[ai][0][m][1] * g1 * rn);
                const f32x4 cs = *(const f32x4*)(ropeT + (size_t)row * 32 + pp);
                const float a0 = kp[ai][m][0] * r * ga0, b0 = kp[ai][m][1] * r * gb0, a1 = kp[ai][m][2] * r * ga1, b1 = kp[ai][m][3] * r * gb1;
                uint2 o; o.x = cvt_pk_bf16(a0 * cs[0] - b0 * cs[1], a0 * cs[1] + b0 * cs[0]); o.y = cvt_pk_bf16(a1 * cs[2] - b1 * cs[3], a1 * cs[3] + b1 * cs[2]);
                *(uint2*)(rowp + 128 + 16 * wc + 4 * fq_) = o; }
    }
};
template <class Epi, class Sched, bool ALIGN_EPI = false, bool SP2 = false>
__device__ __forceinline__ void gemm_phase(PG8_LAS unsigned char* lds, const Gemm g, const Sched& S, const Epi& E) {
    int tid = threadIdx.x; asm volatile("" : "+v"(tid));
    const int wid = __builtin_amdgcn_readfirstlane(tid >> 6), lane = tid & 63, wr = wid >> 2, wc = wid & 3, fr = lane & 15, fq = lane >> 4;
    const int K = g.K, nt = K / BK;
    unsigned voffA[2], voffB[2];
#pragma unroll
    for (int i = 0; i < 2; ++i) { int R, C; stage_rc(tid * 16 + i * 8192, R, C); const int Rb = Epi::PERM ? ((R & ~31) + perm32(R & 31)) : R;
        voffA[i] = (unsigned)(R * K + C) * 2u; voffB[i] = (unsigned)(Rb * K + C) * 2u; }
    const size_t kstep = (size_t)(BK * 2);
    const size_t hstep = (size_t)HALF * K * 2;
    const size_t tstep = 2 * hstep;
    const unsigned ldsw = (unsigned)wid * 1024u;
    const int aoff = lds_byte(wr * 64 + fr, fq * 8), boff = lds_byte(wc * 32 + fr, fq * 8);
#define PG8_SA(b, h) (((b) * 2 + (h)) * HTB)
#define PG8_SB(b, h) ((4 + (b) * 2 + (h)) * HTB)
#define PG8_STAGE(bufoff, gbase, voff) do { _Pragma("unroll") for (int _i = 0; _i < 2; ++_i) \
        __builtin_amdgcn_global_load_lds((const unsigned*)((const char*)(gbase) + (voff)[_i]), (PG8_LAS unsigned*)(lds + (bufoff) + ldsw + _i * 8192), 16, 0, 0); } while (0)
#define PG8_LDA(dst, b, h) do { _Pragma("unroll") for (int m = 0; m < 4; ++m) _Pragma("unroll") for (int k = 0; k < 2; ++k) dst[m][k] = *(const PG8_LAS bf16x8*)(lds + PG8_SA(b, h) + aoff + m * 2048 + k * 1024); } while (0)
#define PG8_LDB(dst, b, h) do { _Pragma("unroll") for (int n = 0; n < 2; ++n) _Pragma("unroll") for (int k = 0; k < 2; ++k) dst[n][k] = *(const PG8_LAS bf16x8*)(lds + PG8_SB(b, h) + boff + n * 2048 + k * 1024); } while (0)
#define PG8_MMA(ai, bj, At, Bt) do { __builtin_amdgcn_s_setprio(1); _Pragma("unroll") for (int m = 0; m < 4; ++m) _Pragma("unroll") for (int n = 0; n < 2; ++n) _Pragma("unroll") for (int k = 0; k < 2; ++k) \
        acc[ai][bj][m][n] = __builtin_amdgcn_mfma_f32_16x16x32_bf16(Bt[n][k], At[m][k], acc[ai][bj][m][n], 0, 0, 0); __builtin_amdgcn_s_setprio(0); } while (0)
#define PG8_WAIT_V(n) asm volatile("s_waitcnt vmcnt(" #n ")" ::: "memory")
#define PG8_WAIT_L(n) asm volatile("s_waitcnt lgkmcnt(" #n ")" ::: "memory")
#define PG8_BAR __builtin_amdgcn_s_barrier()
#define PG8_SCHED __builtin_amdgcn_sched_barrier(0)
    Unit cur, nxt; int ui = 0;
    if (!S.next(0, cur)) return;
    f32x4 acc[2][2][4][2];
#pragma unroll
    for (int a = 0; a < 2; ++a)
#pragma unroll
        for (int b = 0; b < 2; ++b)
#pragma unroll
            for (int m = 0; m < 4; ++m)
#pragma unroll
                for (int n = 0; n < 2; ++n) acc[a][b][m][n] = (f32x4){0.f, 0.f, 0.f, 0.f};
    bf16x8 At[4][2], B0[2][2], B1[2][2];
    const char* cA = (const char*)g.A + (size_t)cur.pm * tstep; const char* cB = (const char*)g.Bt + (size_t)cur.pn * tstep;
    S.a_ready(cur);
    if constexpr (SP2) {
        PG8_STAGE(PG8_SB(0, 0), cB, voffB); PG8_STAGE(PG8_SB(0, 1), cB + hstep, voffB); PG8_STAGE(PG8_SA(0, 0), cA, voffA); PG8_STAGE(PG8_SA(0, 1), cA + hstep, voffA);
        if (wr == 1) PG8_BAR;
        PG8_WAIT_V(2); PG8_BAR;
        PG8_STAGE(PG8_SB(1, 0), cB + kstep, voffB); PG8_STAGE(PG8_SA(1, 0), cA + kstep, voffA); PG8_STAGE(PG8_SB(1, 1), cB + hstep + kstep, voffB);
        PG8_WAIT_V(6); PG8_BAR;
    } else {
        PG8_STAGE(PG8_SB(0, 0), cB, voffB); PG8_STAGE(PG8_SA(0, 0), cA, voffA); PG8_STAGE(PG8_SB(0, 1), cB + hstep, voffB); PG8_STAGE(PG8_SA(0, 1), cA + hstep, voffA);
        if (wr == 1) PG8_BAR;
        PG8_WAIT_V(4); PG8_BAR;
        PG8_STAGE(PG8_SB(1, 0), cB + kstep, voffB); PG8_STAGE(PG8_SA(1, 0), cA + kstep, voffA); PG8_STAGE(PG8_SB(1, 1), cB + hstep + kstep, voffB);
        PG8_WAIT_V(6); PG8_BAR;
    }
    for (;;) {
        const bool has_next = S.next(ui + 1, nxt);
        const char* nA = has_next ? (const char*)g.A + (size_t)nxt.pm * tstep : cA; const char* nB = has_next ? (const char*)g.Bt + (size_t)nxt.pn * tstep : cB;
        for (int t = 0; t < nt; t += 2) {
            const bool last = (t == nt - 2);
            const char* a1 = cA + (size_t)(t + 1) * kstep;
            const char* a2 = last ? nA : cA + (size_t)(t + 2) * kstep; const char* b2 = last ? nB : cB + (size_t)(t + 2) * kstep;
            const char* a3 = a2 + kstep; const char* b3 = b2 + kstep;
            if (last && has_next) S.a_ready(nxt);
            if constexpr (SP2) {
            PG8_LDB(B0, 0, 0); PG8_LDB(B1, 0, 1); PG8_SCHED; PG8_LDA(At, 0, 0); PG8_STAGE(PG8_SA(1, 1), a1 + hstep, voffA);
            PG8_WAIT_V(8); PG8_WAIT_L(0); PG8_BAR; PG8_MMA(0, 0, At, B0); PG8_MMA(0, 1, At, B1); PG8_BAR; PG8_SCHED;
            PG8_LDA(At, 0, 1); PG8_STAGE(PG8_SB(0, 0), b2, voffB); PG8_STAGE(PG8_SB(0, 1), b2 + hstep, voffB); PG8_STAGE(PG8_SA(0, 0), a2, voffA);
            PG8_WAIT_V(8); PG8_WAIT_L(0); PG8_BAR; PG8_MMA(1, 0, At, B0); PG8_MMA(1, 1, At, B1); PG8_BAR; PG8_SCHED;
            PG8_LDB(B0, 1, 0); PG8_LDB(B1, 1, 1); PG8_SCHED; PG8_LDA(At, 1, 0); PG8_STAGE(PG8_SA(0, 1), a2 + hstep, voffA);
            PG8_WAIT_V(8); PG8_WAIT_L(0); PG8_BAR; PG8_MMA(0, 0, At, B0); PG8_MMA(0, 1, At, B1); PG8_BAR; PG8_SCHED;
            PG8_LDA(At, 1, 1); PG8_STAGE(PG8_SB(1, 0), b3, voffB); PG8_STAGE(PG8_SB(1, 1), b3 + hstep, voffB); PG8_STAGE(PG8_SA(1, 0), a3, voffA);
            PG8_WAIT_V(8); PG8_WAIT_L(0); PG8_BAR; PG8_MMA(1, 0, At, B0); PG8_MMA(1, 1, At, B1); PG8_BAR; PG8_SCHED;
            } else {
            PG8_LDB(B0, 0, 0); PG8_SCHED; PG8_LDA(At, 0, 0); PG8_STAGE(PG8_SA(1, 1), a1 + hstep, voffA);
            PG8_WAIT_L(8); PG8_BAR; PG8_WAIT_L(0); PG8_MMA(0, 0, At, B0); PG8_BAR; PG8_SCHED;
            PG8_LDB(B1, 0, 1); PG8_STAGE(PG8_SB(0, 0), b2, voffB);
            PG8_BAR; PG8_WAIT_L(0); PG8_MMA(0, 1, At, B1); PG8_BAR;
            PG8_LDA(At, 0, 1); PG8_STAGE(PG8_SA(0, 0), a2, voffA);
            PG8_BAR; PG8_WAIT_L(0); PG8_MMA(1, 0, At, B0); PG8_BAR; PG8_SCHED;
            PG8_STAGE(PG8_SB(0, 1), b2 + hstep, voffB);
            PG8_WAIT_V(6); PG8_BAR; PG8_MMA(1, 1, At, B1); PG8_BAR;
            PG8_LDB(B0, 1, 0); PG8_SCHED; PG8_LDA(At, 1, 0); PG8_STAGE(PG8_SA(0, 1), a2 + hstep, voffA);
            PG8_WAIT_L(8); PG8_BAR; PG8_WAIT_L(0); PG8_MMA(0, 0, At, B0); PG8_BAR; PG8_SCHED;
            PG8_LDB(B1, 1, 1); PG8_STAGE(PG8_SB(1, 0), b3, voffB);
            PG8_BAR; PG8_WAIT_L(0); PG8_MMA(0, 1, At, B1); PG8_BAR;
            PG8_LDA(At, 1, 1); PG8_STAGE(PG8_SA(1, 0), a3, voffA);
            PG8_BAR; PG8_WAIT_L(0); PG8_MMA(1, 0, At, B0); PG8_BAR; PG8_SCHED;
            PG8_STAGE(PG8_SB(1, 1), b3 + hstep, voffB);
            PG8_WAIT_V(6); PG8_BAR; PG8_MMA(1, 1, At, B1); PG8_BAR;
            }
        }
        if constexpr (ALIGN_EPI) { if (wr == 0) PG8_BAR; }
        if constexpr (!Epi::AFTER_DRAIN) { E(acc, cur, wr, wc, fr, fq); S.done(cur); }
        if (!has_next) break;
#pragma unroll
        for (int a = 0; a < 2; ++a)
#pragma unroll
            for (int b = 0; b < 2; ++b)
#pragma unroll
                for (int m = 0; m < 4; ++m)
#pragma unroll
                    for (int n = 0; n < 2; ++n) acc[a][b][m][n] = (f32x4){0.f, 0.f, 0.f, 0.f};
        cur = nxt; cA = nA; cB = nB; ++ui;
        if constexpr (ALIGN_EPI) { if (wr == 1) PG8_BAR; }
    }
    PG8_WAIT_V(0);
    if constexpr (!ALIGN_EPI) { if (wr == 0) PG8_BAR; }
    PG8_BAR;
    if constexpr (Epi::AFTER_DRAIN) { E.fused(acc, cur, wr, wc, fr, fq, lds, wid, lane); S.done(cur); }
#undef PG8_SA
#undef PG8_SB
#undef PG8_STAGE
#undef PG8_LDA
#undef PG8_LDB
#undef PG8_MMA
#undef PG8_WAIT_V
#undef PG8_WAIT_L
#undef PG8_BAR
#undef PG8_SCHED
}
}
namespace att {
typedef unsigned short bf16_t;
typedef short bf16x8 __attribute__((ext_vector_type(8)));
typedef short s16x4 __attribute__((ext_vector_type(4)));
typedef float f32x16 __attribute__((ext_vector_type(16)));
typedef float f32x4 __attribute__((ext_vector_type(4)));
typedef unsigned u32x4 __attribute__((ext_vector_type(4)));
#define ALAS __attribute__((address_space(3)))
#define ASBAR() __builtin_amdgcn_sched_barrier(0)
constexpr int SHM_V = 16384;
template <int DK> struct Lay { static constexpr int ROWB = DK * 2, SHM_K = 64 * ROWB, OFF_K = 2 * SHM_V, OFF_F = OFF_K + 2 * SHM_K, OFF_WS = OFF_F + 512, TOTAL = OFF_WS + 8 * 256; };

__device__ __forceinline__ int v_st(int k, int c) { const int kk = (k & ~0xC) | ((k & 4) << 1) | ((k & 8) >> 1); return ((kk >> 3) * 4 + (c >> 5)) * 512 + ((kk & 7) * 32 + (c & 31)) * 2; }
__device__ __forceinline__ int v_rd_base(int lane) { return ((lane & 3) << 3) | (((lane >> 2) & 3) << 6) | (((lane >> 4) & 1) << 5) | (((lane >> 5) & 1) << 8); }
__device__ __forceinline__ int crow(int r, int hi) { return (r & 3) + 8 * (r >> 2) + 4 * hi; }
__device__ __forceinline__ unsigned cvtpk(float lo, float hi) { unsigned r; asm volatile("v_cvt_pk_bf16_f32 %0, %1, %2" : "=v"(r) : "v"(lo), "v"(hi)); return r; }

__device__ __forceinline__ float wave_max_f(float v) {
#pragma unroll
    for (int o = 32; o >= 1; o >>= 1) v = fmaxf(v, __shfl_xor(v, o));
    return v;
}
template <int DK, bool FOX>
__device__ __forceinline__ void attn_block(unsigned char* smem, const bf16_t* __restrict__ Q, int ldq, const bf16_t* __restrict__ K, int ldk, const bf16_t* __restrict__ V, int ldv,
                                           const float* __restrict__ Fh, const bf16_t* __restrict__ gate, bf16_t* __restrict__ gout  , int qbk, const float* __restrict__ gq, const float* __restrict__ gk  ) {
    typedef Lay<DK> LY;
    constexpr int ND = DK / 16, NKC = DK / 8, NKI = (64 * NKC) / 512;
    int tid = threadIdx.x; asm volatile("" : "+v"(tid));
    const int wid = __builtin_amdgcn_readfirstlane(tid >> 6), lane = tid & 63, r32 = lane & 31, hi = lane >> 5;
    const int q0 = qbk * 256, qlo = q0 + wid * 32, qm = qlo + r32 - 4 * hi;
    const int NT = 4 * qbk + 4;
    ALAS unsigned char* lds = (ALAS unsigned char*)smem;
    ALAS float* F_lds = (ALAS float*)(lds + LY::OFF_F);
    ALAS float* wsl = (ALAS float*)(lds + LY::OFF_WS) + wid * 64;
    bf16x8 qr[ND];
#pragma unroll
    for (int d0 = 0; d0 < ND; ++d0) qr[d0] = *(const bf16x8*)(Q + (size_t)(qlo + r32) * ldq + d0 * 16 + hi * 8);
    const float fq = FOX ? Fh[qlo + r32] : 0.f;
    int kgo[NKI], klo[NKI];
#pragma unroll
    for (int i = 0; i < NKI; ++i) { const int idx = tid + 512 * i, row = idx / NKC, ch = idx % NKC; kgo[i] = row * ldk + ch * 8; klo[i] = row * LY::ROWB + ((ch ^ ((row >> 1) & 7)) << 4); }
    const int sr = tid >> 4, sc = (tid & 15) * 8, vst0 = v_st(sr, sc), vst1 = v_st(32 + sr, sc);
    const int vgo0 = sr * ldv + sc, vgo1 = (32 + sr) * ldv + sc;
    const int vb0 = (int)(uintptr_t)smem + v_rd_base(lane);
    int kbase[4];
#pragma unroll
    for (int dd = 0; dd < 4; ++dd) kbase[dd] = LY::OFF_K + r32 * LY::ROWB + (((((dd << 1) | hi) ^ ((r32 >> 1) & 7))) << 4);
    bf16x8 stk[NKI], stv0, stv1; float stf = 0.f;
#define ATT_LOAD(kb) do { _Pragma("unroll") for (int i = 0; i < NKI; ++i) stk[i] = *(const bf16x8*)(K + (size_t)(kb) * ldk + kgo[i]); \
        stv0 = *(const bf16x8*)(V + (size_t)(kb) * ldv + vgo0); stv1 = *(const bf16x8*)(V + (size_t)(kb) * ldv + vgo1); if (FOX && tid < 64) stf = Fh[(kb) + tid]; } while (0)
#define ATT_WRITE(bf) do { _Pragma("unroll") for (int i = 0; i < NKI; ++i) *(ALAS bf16x8*)(lds + LY::OFF_K + (bf) * LY::SHM_K + klo[i]) = stk[i]; \
        *(ALAS bf16x8*)(lds + (bf) * SHM_V + vst0) = stv0; *(ALAS bf16x8*)(lds + (bf) * SHM_V + vst1) = stv1; if (FOX && tid < 64) F_lds[(bf) * 64 + tid] = stf; } while (0)
    int t_start = 0;
    if (FOX) {
        const float gqm = wave_max_f(fmaxf(fabsf(gq[lane]), fabsf(gq[lane + 64]))), gkm = wave_max_f(fmaxf(fabsf(gk[lane]), fabsf(gk[lane + 64])));
        const float qk_bound = 0.12751743f * 128.f * gqm * gkm;
        const float thr = 2.02f * qk_bound + 40.f, f0 = Fh[q0];
        const int j0 = lane, j1 = lane + 64;
        const bool c0 = (j0 < 4 * qbk) && (Fh[j0 * 64 + 63] - f0 >= thr), c1 = (j1 < 4 * qbk) && (Fh[(j1 < 4 * qbk ? j1 : 0) * 64 + 63] - f0 >= thr);
        t_start = __builtin_popcountll(__ballot(c0)) + __builtin_popcountll(__ballot(c1));
        t_start = __builtin_amdgcn_readfirstlane(t_start); }
    ATT_LOAD(t_start * 64); ATT_WRITE(t_start & 1);
    float m_reg = -1e30f, l_reg = 0.f; f32x16 o[4];
#pragma unroll
    for (int d = 0; d < 4; ++d)
#pragma unroll
        for (int r = 0; r < 16; ++r) o[d][r] = 0.f;
    for (int t = t_start; t < NT; ++t) {
        const int buf = t & 1, kb = t * 64;
        __syncthreads();
        if (t + 1 < NT) ATT_LOAD(kb + 64);
        f32x16 p0, p1;
        if (FOX) {
#pragma unroll
            for (int g = 0; g < 4; ++g) { const f32x4 f0 = *(const ALAS f32x4*)(F_lds + buf * 64 + 8 * g + 4 * hi), f1 = *(const ALAS f32x4*)(F_lds + buf * 64 + 32 + 8 * g + 4 * hi);
#pragma unroll
                for (int e = 0; e < 4; ++e) { p0[4 * g + e] = fq - f0[e]; p1[4 * g + e] = fq - f1[e]; } }
        } else {
#pragma unroll
            for (int r = 0; r < 16; ++r) { p0[r] = 0.f; p1[r] = 0.f; }
        }
        __builtin_amdgcn_s_setprio(1);
#pragma unroll
        for (int d0 = 0; d0 < ND; ++d0) {
            ALAS const unsigned char* a = lds + buf * LY::SHM_K + kbase[d0 & 3] + (d0 >> 2) * 128;
            const bf16x8 b0 = *(const ALAS bf16x8*)a;
            const bf16x8 b1 = *(const ALAS bf16x8*)(a + 32 * LY::ROWB);
            p0 = __builtin_amdgcn_mfma_f32_32x32x16_bf16(b0, qr[d0], p0, 0, 0, 0);
            p1 = __builtin_amdgcn_mfma_f32_32x32x16_bf16(b1, qr[d0], p1, 0, 0, 0);
        }
        __builtin_amdgcn_s_setprio(0);
        if (kb + 63 > qlo) {
            const float NEG = -__builtin_inff(); const int dq = qm - kb;
#pragma unroll
            for (int r = 0; r < 16; ++r) { const int c = (r & 3) + 8 * (r >> 2); if (dq - c < 0) p0[r] = NEG; if (dq - c - 32 < 0) p1[r] = NEG; }
        }
        float pmax = p0[0];
#pragma unroll
        for (int r = 1; r < 16; ++r) pmax = fmaxf(pmax, p0[r]);
#pragma unroll
        for (int r = 0; r < 16; ++r) pmax = fmaxf(pmax, p1[r]);
        { auto rr = __builtin_amdgcn_permlane32_swap(__float_as_uint(pmax), __float_as_uint(pmax), false, false);
          pmax = fmaxf(__uint_as_float(rr[0]), __uint_as_float(rr[1])); }
        float mn, alpha;
        if (__builtin_expect(__all(pmax - m_reg <= 8.f), 1)) { mn = m_reg; alpha = 1.f; }
        else { mn = fmaxf(m_reg, pmax); alpha = __builtin_amdgcn_exp2f(m_reg - mn); m_reg = mn; }
        float ps = 0.f;
#pragma unroll
        for (int r = 0; r < 16; ++r) { p0[r] = __builtin_amdgcn_exp2f(p0[r] - mn); ps += p0[r]; }
#pragma unroll
        for (int r = 0; r < 16; ++r) { p1[r] = __builtin_amdgcn_exp2f(p1[r] - mn); ps += p1[r]; }
        { auto rr = __builtin_amdgcn_permlane32_swap(__float_as_uint(ps), __float_as_uint(ps), false, false);
          ps = __uint_as_float(rr[0]) + __uint_as_float(rr[1]); }
        l_reg = l_reg * alpha + ps;
        bf16x8 pa0, pa1, pa2, pa3;
#define ATT_PK4(P, B_, OUT) do { unsigned a0 = cvtpk(P[B_+0], P[B_+1]), a1 = cvtpk(P[B_+2], P[B_+3]); unsigned b0_ = cvtpk(P[B_+4], P[B_+5]), b1_ = cvtpk(P[B_+6], P[B_+7]); \
        auto r0 = __builtin_amdgcn_permlane32_swap(a0, b0_, false, false); auto r1 = __builtin_amdgcn_permlane32_swap(a1, b1_, false, false); \
        u32x4 w = {r0[0], r1[0], r0[1], r1[1]}; OUT = *reinterpret_cast<bf16x8*>(&w); } while (0)
        ATT_PK4(p0, 0, pa0); ATT_PK4(p0, 8, pa1); ATT_PK4(p1, 0, pa2); ATT_PK4(p1, 8, pa3);
        if (__any(alpha < 1.f)) {
            if (hi == 0) wsl[r32] = alpha;
            asm volatile("s_waitcnt lgkmcnt(0)" ::: "memory");
#pragma unroll
            for (int g = 0; g < 4; ++g) { const f32x4 al = *(const ALAS f32x4*)(wsl + 8 * g + 4 * hi);
#pragma unroll
                for (int d = 0; d < 4; ++d)
#pragma unroll
                    for (int e = 0; e < 4; ++e) o[d][4 * g + e] *= al[e]; }
        }
#define ATT_TRRD(dst, off) asm volatile("ds_read_b64_tr_b16 %0, %1 offset:%2" : "=&v"(dst) : "v"(vbb), "i"(off) : "memory")
#define ATT_PV(d0) do { s16x4 l0, l1, l2, l3, h0, h1, h2, h3; constexpr int b_ = (d0) * 512; \
        ATT_TRRD(l0, b_); ATT_TRRD(h0, b_ + 2048); ATT_TRRD(l1, b_ + 4096); ATT_TRRD(h1, b_ + 6144); ATT_TRRD(l2, b_ + 8192); ATT_TRRD(h2, b_ + 10240); ATT_TRRD(l3, b_ + 12288); ATT_TRRD(h3, b_ + 14336); \
        asm volatile("s_waitcnt lgkmcnt(0)" ::: "memory"); ASBAR(); \
        o[d0] = __builtin_amdgcn_mfma_f32_32x32x16_bf16(pa0, (bf16x8){l0[0], l0[1], l0[2], l0[3], h0[0], h0[1], h0[2], h0[3]}, o[d0], 0, 0, 0); \
        o[d0] = __builtin_amdgcn_mfma_f32_32x32x16_bf16(pa1, (bf16x8){l1[0], l1[1], l1[2], l1[3], h1[0], h1[1], h1[2], h1[3]}, o[d0], 0, 0, 0); \
        o[d0] = __builtin_amdgcn_mfma_f32_32x32x16_bf16(pa2, (bf16x8){l2[0], l2[1], l2[2], l2[3], h2[0], h2[1], h2[2], h2[3]}, o[d0], 0, 0, 0); \
        o[d0] = __builtin_amdgcn_mfma_f32_32x32x16_bf16(pa3, (bf16x8){l3[0], l3[1], l3[2], l3[3], h3[0], h3[1], h3[2], h3[3]}, o[d0], 0, 0, 0); } while (0)
        { const int vbb = vb0 + buf * SHM_V; __builtin_amdgcn_s_setprio(1); ATT_PV(0); ATT_PV(1); ATT_PV(2); ATT_PV(3); __builtin_amdgcn_s_setprio(0); }
        if (t + 1 < NT) ATT_WRITE(buf ^ 1);
    }
    if (hi == 0) wsl[r32] = l_reg;
    asm volatile("s_waitcnt lgkmcnt(0)" ::: "memory");
#pragma unroll
    for (int r = 0; r < 16; ++r) {
        const int orow = crow(r, hi); const float rli = __builtin_amdgcn_rcpf(wsl[orow]);
        bf16_t* rowp = gout + (size_t)(qlo + orow) * 4096; const bf16_t* growp = gate + (size_t)(qlo + orow) * 4096;
#pragma unroll
        for (int d0 = 0; d0 < 4; ++d0) {
            const float v = o[d0][r] * rli; const float vn = __shfl_xor(v, 1);
            if ((r32 & 1) == 0) { unsigned* gp = (unsigned*)(rowp + d0 * 32 + r32); const unsigned g = *(const unsigned*)(growp + d0 * 32 + r32);
                *gp = cvtpk(v * __uint_as_float(g << 16), vn * __uint_as_float(g & 0xffff0000u)); }
        }
    }
    __syncthreads();
#undef ATT_LOAD
#undef ATT_WRITE
#undef ATT_PK4
#undef ATT_TRRD
#undef ATT_PV
}
}
using pg8::bf16_t; using pg8::f32x4; using pg8::u32x4;
#define LAS __attribute__((address_space(3)))
constexpr int S = 8192, DM = 2048, INW = 11344, INWP = 11520;
constexpr float EPS = 1e-6f;
constexpr size_t MiB = 1u << 20;

__device__ __forceinline__ float bf2f(bf16_t v) { return __uint_as_float(((unsigned)v) << 16); }
__device__ __forceinline__ bf16_t f2bf(float f) { unsigned u = __float_as_uint(f); u += 0x7fffu + ((u >> 16) & 1u); return (bf16_t)(u >> 16); }
__device__ __forceinline__ unsigned pk2(float lo, float hi) { return (unsigned)f2bf(lo) | ((unsigned)f2bf(hi) << 16); }
__device__ __forceinline__ float wave_sum(float v) {
#pragma unroll
    for (int o = 32; o >= 1; o >>= 1) v += __shfl_xor(v, o);
    return v;
}
__device__ __forceinline__ float wave_max(float v) {
#pragma unroll
    for (int o = 32; o >= 1; o >>= 1) v = fmaxf(v, __shfl_xor(v, o));
    return v;
}

__device__ __forceinline__ int opaque_tid() { int t = threadIdx.x; asm volatile("" : "+v"(t)); return t; }

struct Params {
    const float* x; const int* pos; const float *mix_g, *w_in, *b_forget, *b_gate, *q_lat_g, *w_q_up, *kv_lat_g, *w_kv_up, *mla_qg, *mla_kg, *fox_qg, *fox_kg, *w_out, *ffn_g, *w_peer_q, *sub_keys, *peer_u, *peer_v;
    float* out;
    bf16_t *WqT, *WkvT, *WoT, *WpT, *WinT;
    bf16_t *h, *cq, *ckv, *fq, *fk, *fv, *merged, *kpe, *qa, *va, *ka;
    float *lf, *F, *x1, *scores;
    unsigned char *U8, *V8; bf16_t* attout;
    unsigned* ctl;
    float2* ropeT; float* ssq;
};

struct DstId { __device__ __forceinline__ int operator()(int n) const { return n; } };
struct DstWin { __device__ __forceinline__ int operator()(int n) const {
    if (n < 1024) return n; if (n < 1088) { const int r = n - 1024; return 11264 + 2 * (r & 31) + (r >> 5); } if (n < 7232) return n - 64; if (n < 7248) return 11264 + 64 + (n - 7232); return n - 80; } };
struct DstQ { __device__ __forceinline__ int operator()(int n) const {
    const int h = n / 192, d = n - h * 192; if (d < 128) return h * 256 + d; const int r = d - 128; return h * 256 + 128 + 2 * (r & 31) + (r >> 5); } };
template <class Dst>
__device__ __forceinline__ void transpose_item(const float* __restrict__ W, int K, int N, bf16_t* __restrict__ WT, Dst dst, float* scr, int item, int lane, const float* __restrict__ gk = nullptr) {
    const int nblk = (N + 31) / 32, kb = item / nblk, nb = item % nblk, k0 = 64 * kb, n0 = 32 * nb;
    { const int rr = lane >> 3, c4 = (lane & 7) * 4; const bool ok = (n0 + c4) < N;
      f32x4 v[8];
#pragma unroll
      for (int i = 0; i < 8; ++i) v[i] = ok ? *(const f32x4*)(W + (size_t)(k0 + 8 * i + rr) * N + n0 + c4) : (f32x4){0.f, 0.f, 0.f, 0.f};
      if (gk) {
#pragma unroll
          for (int i = 0; i < 8; ++i) v[i] *= gk[k0 + 8 * i + rr]; }
#pragma unroll
      for (int i = 0; i < 8; ++i) { float* sp = scr + (8 * i + rr) * 33 + c4; sp[0] = v[i][0]; sp[1] = v[i][1]; sp[2] = v[i][2]; sp[3] = v[i][3]; } }
    asm volatile("s_waitcnt lgkmcnt(0)" ::: "memory");
    const int c = lane & 7;
#pragma unroll
    for (int j = 0; j < 4; ++j) { const int nl = (lane >> 3) + 8 * j, n = n0 + nl; const float* s = scr + (8 * c) * 33 + nl;
        u32x4 o; o.x = pk2(s[0 * 33], s[1 * 33]); o.y = pk2(s[2 * 33], s[3 * 33]); o.z = pk2(s[4 * 33], s[5 * 33]); o.w = pk2(s[6 * 33], s[7 * 33]);
        if (n < N) *(u32x4*)(WT + (size_t)dst(n) * K + k0 + 8 * c) = o; }
    asm volatile("s_waitcnt lgkmcnt(0)" ::: "memory");
}
__device__ __forceinline__ void wfold_item(const float* __restrict__ wq, const float* __restrict__ keys, bf16_t* __restrict__ WpT, float* sm, int item) {
    const int tid = opaque_tid(), hc = item >> 5, d0 = (item & 31) * 64;
    float* keysL = sm; float* wqL = sm + 128 * 132;
    for (int idx = tid; idx < 128 * 32; idx += 512) { const int r = idx >> 5, c4 = (idx & 31) * 4; *(f32x4*)(keysL + r * 132 + c4) = *(const f32x4*)(keys + (size_t)hc * 16384 + r * 128 + c4); }
    for (int idx = tid; idx < 64 * 32; idx += 512) { const int r = idx >> 5, c4 = (idx & 31) * 4; *(f32x4*)(wqL + r * 132 + c4) = *(const f32x4*)(wq + (size_t)(d0 + r) * 2048 + hc * 128 + c4); }
    __syncthreads();
    const int n2 = (tid & 63) * 2, dg = tid >> 6;
    float acc[2][8];
#pragma unroll
    for (int a = 0; a < 2; ++a)
#pragma unroll
        for (int i = 0; i < 8; ++i) acc[a][i] = 0.f;
#pragma unroll 2
    for (int j4 = 0; j4 < 32; ++j4) {
        const f32x4 k0v = *(const f32x4*)(keysL + n2 * 132 + 4 * j4), k1v = *(const f32x4*)(keysL + (n2 + 1) * 132 + 4 * j4);
#pragma unroll
        for (int i = 0; i < 8; ++i) { const f32x4 w = *(const f32x4*)(wqL + (dg * 8 + i) * 132 + 4 * j4);
            acc[0][i] += (k0v[0] * w[0] + k0v[1] * w[1]) + (k0v[2] * w[2] + k0v[3] * w[3]);
            acc[1][i] += (k1v[0] * w[0] + k1v[1] * w[1]) + (k1v[2] * w[2] + k1v[3] * w[3]); }
    }
#pragma unroll
    for (int a = 0; a < 2; ++a) { u32x4 o; o.x = pk2(acc[a][0], acc[a][1]); o.y = pk2(acc[a][2], acc[a][3]); o.z = pk2(acc[a][4], acc[a][5]); o.w = pk2(acc[a][6], acc[a][7]);
        *(u32x4*)(WpT + (size_t)(hc * 128 + n2 + a) * 2048 + d0 + dg * 8) = o; }
    __syncthreads();
}
__device__ __forceinline__ void rms_row2048(const float* __restrict__ xr, const float* __restrict__ g, bf16_t* __restrict__ orow, int lane) {
    f32x4 v[8]; float ss = 0.f;
#pragma unroll
    for (int j = 0; j < 8; ++j) { v[j] = *(const f32x4*)(xr + j * 256 + lane * 4); ss += (v[j][0] * v[j][0] + v[j][1] * v[j][1]) + (v[j][2] * v[j][2] + v[j][3] * v[j][3]); }
    const float r = rsqrtf(wave_sum(ss) * (1.f / 2048.f) + EPS);
#pragma unroll
    for (int j = 0; j < 8; ++j) { const f32x4 gg = *(const f32x4*)(g + j * 256 + lane * 4);
        uint2 o; o.x = pk2(v[j][0] * r * gg[0], v[j][1] * r * gg[1]); o.y = pk2(v[j][2] * r * gg[2], v[j][3] * r * gg[3]);
        *(uint2*)(orow + j * 256 + lane * 4) = o; }
}
__device__ __forceinline__ void fox_cumsum(double* part, int h, const float* __restrict__ lf, float* __restrict__ F) {
    const int tid = opaque_tid(), lane = tid & 63, wave = tid >> 6;
    float v[16]; double sum = 0.0;
#pragma unroll
    for (int i = 0; i < 16; ++i) { v[i] = lf[(size_t)(tid * 16 + i) * 16 + h]; sum += (double)v[i]; }
    double inc = sum;
#pragma unroll
    for (int o = 1; o < 64; o <<= 1) { const double n = __shfl_up(inc, o); if (lane >= o) inc += n; }
    if (lane == 63) part[wave] = inc;
    __syncthreads();
    double base = 0.0;
    for (int w = 0; w < wave; ++w) base += part[w];
    double run = base + inc - sum;
#pragma unroll
    for (int i = 0; i < 16; ++i) { run += (double)v[i]; F[(size_t)h * S + tid * 16 + i] = (float)(run * 1.4426950408889634); }
    __syncthreads();
}
__device__ __forceinline__ void rope_table(const int* __restrict__ pos, float2* __restrict__ ropeT, int gtid, int nthreads) {
    for (int idx = gtid; idx < S * 32; idx += nthreads) { const int t = idx >> 5, i = idx & 31;
        const double inv = exp(-(double)i * (1.0 / 32.0) * 9.210340371976184);
        double ang = (double)((float)pos[t] * (float)inv);
        const double twopi = 6.283185307179586;
        ang -= twopi * rint(ang / twopi);
        ropeT[idx] = make_float2(cosf((float)ang), sinf((float)ang)); }
}
typedef float f32x2 __attribute__((ext_vector_type(2)));
__device__ __forceinline__ unsigned pk4_fp8(float a, float b, float c, float d) {
    int w = __builtin_amdgcn_cvt_pk_fp8_f32(fminf(fmaxf(a, -448.f), 448.f), fminf(fmaxf(b, -448.f), 448.f), 0, false);
    w = __builtin_amdgcn_cvt_pk_fp8_f32(fminf(fmaxf(c, -448.f), 448.f), fminf(fmaxf(d, -448.f), 448.f), w, true); return (unsigned)w; }
__device__ __forceinline__ void cvt_rows_fp8(const float* __restrict__ src, unsigned char* __restrict__ dst, size_t n, float scale, int gw, int NGW, int lane) {
    const size_t nchunk = n / 1024;
    for (size_t c = gw; c < nchunk; c += NGW) { const size_t o = c * 1024 + lane * 16;
        f32x4 a[4];
#pragma unroll
        for (int q = 0; q < 4; ++q) a[q] = *(const f32x4*)(src + o + 4 * q) * scale;
        u32x4 w; w.x = pk4_fp8(a[0][0], a[0][1], a[0][2], a[0][3]); w.y = pk4_fp8(a[1][0], a[1][1], a[1][2], a[1][3]);
        w.z = pk4_fp8(a[2][0], a[2][1], a[2][2], a[2][3]); w.w = pk4_fp8(a[3][0], a[3][1], a[3][2], a[3][3]);
        *(u32x4*)(dst + o) = w; }
}
constexpr float U_SCALE = 64.f, V_SCALE = 4.f;
typedef __bf16 bf16x2_t __attribute__((ext_vector_type(2)));
__device__ __forceinline__ float dot2bf(unsigned a, unsigned b, float c) { return __builtin_amdgcn_fdot2_f32_bf16(__builtin_bit_cast(bf16x2_t, a), __builtin_bit_cast(bf16x2_t, b), c, false); }
#define PEER_INS(top, x) do { float x_ = (x); _Pragma("unroll") for (int i_ = 0; i_ < 16; ++i_) { const float hi_ = fmaxf(top[i_], x_); x_ = fminf(top[i_], x_); top[i_] = hi_; } } while (0)
__device__ __forceinline__ void peer_group(unsigned char* smem, int g, const float* __restrict__ scores, const bf16_t* __restrict__ h2, const float* __restrict__ x1,
                                           const unsigned char* __restrict__ U8, const unsigned char* __restrict__ V8, float* __restrict__ out) {
    const int tid = opaque_tid(), lane = tid & 63, wave = __builtin_amdgcn_readfirstlane(tid >> 6);
    float* topL = (float*)smem;
    int* selE = (int*)(smem + 32768);
    float* selG = (float*)(smem + 49152);
    {
        const int tl = tid >> 4, hc = tid & 15;
        const float* sp = scores + (size_t)(g * 32 + tl) * 2048 + hc * 128;
        float top[16];
#pragma unroll
        for (int i = 0; i < 16; ++i) top[i] = -INFINITY;
#pragma unroll 2
        for (int n0 = 0; n0 < 128; n0 += 4) { const f32x4 v = *(const f32x4*)(sp + n0);
#pragma unroll
            for (int e = 0; e < 4; ++e) PEER_INS(top, __uint_as_float((__float_as_uint(v[e]) & ~0x7Fu) | (unsigned)(n0 + e))); }
        float* tp = topL + (tl * 16 + hc) * 16;
#pragma unroll
        for (int i = 0; i < 16; i += 4) *(f32x4*)(tp + i) = (f32x4){top[i], top[i + 1], top[i + 2], top[i + 3]};
    }
    __syncthreads();
    if (tid < 256) {
        const int tl = tid >> 3, h = tid & 7;
        const float* t1 = topL + (tl * 16 + 2 * h) * 16; const float* t2 = t1 + 16;
        float s1[16], s2[16];
#pragma unroll
        for (int i = 0; i < 16; i += 4) { const f32x4 a = *(const f32x4*)(t1 + i), b2 = *(const f32x4*)(t2 + i);
            s1[i] = a[0]; s1[i + 1] = a[1]; s1[i + 2] = a[2]; s1[i + 3] = a[3]; s2[i] = b2[0]; s2[i + 1] = b2[1]; s2[i + 2] = b2[2]; s2[i + 3] = b2[3]; }
        float ts[16];
#pragma unroll
        for (int i = 0; i < 16; ++i) ts[i] = -INFINITY;
#pragma unroll
        for (int i = 0; i < 16; ++i)
#pragma unroll
            for (int j = 0; j < 16; ++j)
                if ((i + 1) * (j + 1) <= 16) PEER_INS(ts, __uint_as_float((__float_as_uint(s1[i] + s2[j]) & ~0xFFu) | (unsigned)(i * 16 + j)));
        float ex[16], sum = 0.f;
#pragma unroll
        for (int k = 0; k < 16; ++k) { ex[k] = __expf(ts[k] - ts[0]); sum += ex[k]; }
        const float inv = 1.f / sum;
#pragma unroll
        for (int k = 0; k < 16; ++k) { const unsigned pos = __float_as_uint(ts[k]) & 0xFFu;
            const int i1 = (int)(__float_as_uint(t1[pos >> 4]) & 0x7Fu), i2 = (int)(__float_as_uint(t2[pos & 15]) & 0x7Fu);
            selE[tl * 128 + h * 16 + k] = i1 * 128 + i2; selG[tl * 128 + h * 16 + k] = ex[k] * inv; }
    }
    __syncthreads();
    for (int ti = 0; ti < 4; ++ti) {
        const int tl = wave * 4 + ti; const size_t t = (size_t)g * 32 + tl;
        f32x2 hp[16];
#pragma unroll
        for (int j = 0; j < 2; ++j)
#pragma unroll
            for (int q = 0; q < 2; ++q) { const u32x4 w = *(const u32x4*)(h2 + t * DM + j * 1024 + lane * 16 + q * 8);
#pragma unroll
                for (int c = 0; c < 4; ++c) hp[j * 8 + q * 4 + c] = (f32x2){__uint_as_float(w[c] << 16), __uint_as_float(w[c] & 0xffff0000u)}; }
        f32x2 acc[16];
#pragma unroll
        for (int i = 0; i < 16; ++i) acc[i] = (f32x2){0.f, 0.f};
        for (int bb = 0; bb < 16; ++bb) {
            int e[8]; float gt[8];
#pragma unroll
            for (int q = 0; q < 8; ++q) { e[q] = __builtin_amdgcn_readfirstlane(selE[tl * 128 + bb * 8 + q]); gt[q] = selG[tl * 128 + bb * 8 + q]; }
            u32x4 ur[8][2], vr[8][2];
#pragma unroll
            for (int q = 0; q < 8; ++q)
#pragma unroll
                for (int j = 0; j < 2; ++j) ur[q][j] = *(const u32x4*)(U8 + (size_t)e[q] * DM + j * 1024 + lane * 16);
#pragma unroll
            for (int q = 0; q < 8; ++q)
#pragma unroll
                for (int j = 0; j < 2; ++j) vr[q][j] = *(const u32x4*)(V8 + (size_t)e[q] * DM + j * 1024 + lane * 16);
            float d[8];
#pragma unroll
            for (int q = 0; q < 8; ++q) { f32x2 a2 = (f32x2){0.f, 0.f};
#pragma unroll
                for (int j = 0; j < 2; ++j)
#pragma unroll
                    for (int c = 0; c < 4; ++c) { const int w = (int)ur[q][j][c];
                        a2 = __builtin_elementwise_fma(hp[j * 8 + 2 * c], __builtin_amdgcn_cvt_pk_f32_fp8(w, false), a2);
                        a2 = __builtin_elementwise_fma(hp[j * 8 + 2 * c + 1], __builtin_amdgcn_cvt_pk_f32_fp8(w, true), a2); }
                d[q] = a2.x + a2.y; }
            const bool b5 = (lane & 32) != 0, b4 = (lane & 16) != 0, b3 = (lane & 8) != 0;
            float k4[4];
#pragma unroll
            for (int i = 0; i < 4; ++i) k4[i] = (b5 ? d[4 + i] : d[i]) + __shfl_xor(b5 ? d[i] : d[4 + i], 32);
            float k2[2];
#pragma unroll
            for (int i = 0; i < 2; ++i) k2[i] = (b4 ? k4[2 + i] : k4[i]) + __shfl_xor(b4 ? k4[i] : k4[2 + i], 16);
            float c1 = (b3 ? k2[1] : k2[0]) + __shfl_xor(b3 ? k2[0] : k2[1], 8);
            c1 += __shfl_xor(c1, 4); c1 += __shfl_xor(c1, 2); c1 += __shfl_xor(c1, 1);
#pragma unroll
            for (int q = 0; q < 8; ++q) {
                const float a = __uint_as_float((unsigned)__builtin_amdgcn_readlane((int)__float_as_uint(c1), 8 * q)) * (1.f / U_SCALE);
                const float w = gt[q] * 0.5f * a * (1.f + erff(a * 0.70710678118654752f)) * (1.f / V_SCALE);
                const f32x2 w2 = (f32x2){w, w};
#pragma unroll
                for (int j = 0; j < 2; ++j)
#pragma unroll
                    for (int c = 0; c < 4; ++c) { const int x = (int)vr[q][j][c];
                        acc[j * 8 + 2 * c] = __builtin_elementwise_fma(w2, __builtin_amdgcn_cvt_pk_f32_fp8(x, false), acc[j * 8 + 2 * c]);
                        acc[j * 8 + 2 * c + 1] = __builtin_elementwise_fma(w2, __builtin_amdgcn_cvt_pk_f32_fp8(x, true), acc[j * 8 + 2 * c + 1]); }
            }
        }
#pragma unroll
        for (int j = 0; j < 2; ++j)
#pragma unroll
            for (int q = 0; q < 4; ++q) { const size_t o = t * DM + j * 1024 + lane * 16 + q * 4;
                const f32x4 a = *(const f32x4*)(x1 + o);
                *(f32x4*)(out + o) = (f32x4){a[0] + acc[j * 8 + 2 * q].x, a[1] + acc[j * 8 + 2 * q].y, a[2] + acc[j * 8 + 2 * q + 1].x, a[3] + acc[j * 8 + 2 * q + 1].y}; }
    }
    __syncthreads();
}

#define XB_TMO      128
#define XB_XCNT(j)  (256  + 64 * (j))
#define XB_XSUB(j)  (1280 + 64 * (j))
#define XB_XGEN(j)  (2304 + 64 * (j))
#define XB_TOP      3328
#define XB_TOPGEN   3392
#define XCD_BAR_WORDS 3456
#define XB_SPIN_CAP (1u << 18)

__device__ __forceinline__ unsigned xb_ld(unsigned* p)              { return __hip_atomic_load(p, __ATOMIC_RELAXED, __HIP_MEMORY_SCOPE_AGENT); }
__device__ __forceinline__ unsigned xb_add(unsigned* p, unsigned v) { return __hip_atomic_fetch_add(p, v, __ATOMIC_RELAXED, __HIP_MEMORY_SCOPE_AGENT); }
__device__ __forceinline__ unsigned xb_xcc_id() { return (unsigned)__builtin_amdgcn_s_getreg((3 << 11) | 20) & 0xFu; }
#define XB_SPIN(cond, bar) do { unsigned _sp = 0; while (cond) { __builtin_amdgcn_s_sleep(1); \
    if ((++_sp & 255u) == 0u) { if (xb_ld(&(bar)[XB_TMO])) break; if (_sp > XB_SPIN_CAP) { atomicAdd(&(bar)[XB_TMO], 1u); break; } } } } while (0)

struct XcdBarrier {
    unsigned* bar; unsigned x;
    volatile LAS unsigned* st;
};

__device__ __forceinline__ XcdBarrier xcd_barrier_post(unsigned* bar, volatile LAS unsigned* st) {
    XcdBarrier b; b.bar = bar; b.x = xb_xcc_id(); b.st = st;
    if (threadIdx.x == 0) (void)xb_add(&bar[XB_XCNT(b.x)], 1u);
    return b;
}
__device__ __forceinline__ void xcd_barrier_complete(unsigned* bar, unsigned x, unsigned& nloc, unsigned& nx) {
    const unsigned G = gridDim.x * gridDim.y * gridDim.z;
    unsigned sum, cnt, mine, sp = 0u;
    for (;;) {
        sum = 0u; cnt = 0u; mine = 0u;
#pragma unroll
        for (unsigned j = 0; j < 16; ++j) { const unsigned c = xb_ld(&bar[XB_XCNT(j)]); sum += c; cnt += (c > 0u) ? 1u : 0u; mine = (j == x) ? c : mine; }
        if (sum == G) break;
        __builtin_amdgcn_s_sleep(1);
        if ((++sp & 255u) == 0u) { if (xb_ld(&bar[XB_TMO])) break; if (sp > XB_SPIN_CAP) { atomicAdd(&bar[XB_TMO], 1u); break; } }
    }
    nloc = mine > 0u ? mine : 1u; nx = cnt > 0u ? cnt : 1u;
}

__device__ __forceinline__ void xcd_barrier(const XcdBarrier& b) {
    asm volatile("s_waitcnt vmcnt(0)" ::: "memory");
    __syncthreads();
    if (threadIdx.x == 0) {
        unsigned* bar = b.bar;
        __builtin_amdgcn_s_waitcnt(0);
        unsigned nloc = b.st[0], nx = b.st[1];
        if (nloc == 0u) { xcd_barrier_complete(bar, b.x, nloc, nx); b.st[0] = nloc; b.st[1] = nx; }
        const unsigned old = xb_add(&bar[XB_XSUB(b.x)], 1u);
        const unsigned gen = old / nloc;
        if (old + 1u == (gen + 1u) * nloc) {
            __builtin_amdgcn_fence(__ATOMIC_RELEASE, "agent");
            asm volatile("s_waitcnt vmcnt(0)" ::: "memory");
            const unsigned og = xb_add(&bar[XB_TOP], 1u);
            const unsigned tg = og / nx;
            if (og + 1u == (tg + 1u) * nx) xb_add(&bar[XB_TOPGEN], 1u);
            else XB_SPIN(xb_ld(&bar[XB_TOPGEN]) == tg, bar);
            __builtin_amdgcn_fence(__ATOMIC_ACQUIRE, "agent");
            xb_add(&bar[XB_XGEN(b.x)], 1u);
            asm volatile("s_waitcnt vmcnt(0)" ::: "memory");
        } else {
            XB_SPIN(xb_ld(&bar[XB_XGEN(b.x)]) == gen, bar);
            __builtin_amdgcn_fence(__ATOMIC_ACQUIRE, "agent");
            asm volatile("s_waitcnt vmcnt(0)" ::: "memory");
        }
    }
    __syncthreads();
}

#define PROBE_DOUBLE 0
#define REP(k) for (int rep_ = 0; rep_ < ((PROBE_DOUBLE == (k)) ? 2 : 1); ++rep_)
constexpr int LDS_BYTES = 147456;
__global__ __launch_bounds__(512, 2) void mega(Params p) {
    extern __shared__ __attribute__((aligned(16))) unsigned char smem[];
    { volatile LAS unsigned* st0 = (volatile LAS unsigned*)((LAS unsigned char*)smem + 131072); if (threadIdx.x < 2) st0[threadIdx.x] = 0u; }
    __syncthreads();
    const XcdBarrier bar = xcd_barrier_post(p.ctl, (volatile LAS unsigned*)((LAS unsigned char*)smem + 131072));
    float* smf = (float*)smem;
    LAS unsigned char* lds = (LAS unsigned char*)smem;
    const int G = gridDim.x, b = blockIdx.x, NGW = G * 8;
#define PHASE_IDS() const int tid = opaque_tid(), lane = tid & 63, wave = __builtin_amdgcn_readfirstlane(tid >> 6), gw = b * 8 + wave; (void)lane; (void)gw

    REP(7) {
        PHASE_IDS();
        float* scr = smf + wave * 4096;
        constexpr int dummy_ = 0; (void)dummy_;
        constexpr int I_IN = 32 * 355, I_Q = 8 * 96, I_KV = 8 * 128, I_O = 64 * 64;
        for (int it = gw; it < I_IN + I_Q + I_KV + I_O; it += NGW) {
            int r = it;
            if (r < I_IN) { transpose_item(p.w_in, 2048, INW, p.WinT, DstWin(), scr, r, lane); continue; } r -= I_IN;
            if (r < I_Q) { transpose_item(p.w_q_up, 512, 3072, p.WqT, DstQ(), scr, r, lane, p.q_lat_g); continue; } r -= I_Q;
            if (r < I_KV) { transpose_item(p.w_kv_up, 512, 4096, p.WkvT, DstId(), scr, r, lane, p.kv_lat_g); continue; } r -= I_KV;
            transpose_item(p.w_out, 4096, 2048, p.WoT, DstId(), scr, r, lane);
        }
        for (int m = gw; m < S; m += NGW) rms_row2048(p.x + (size_t)m * DM, p.mix_g, p.h + (size_t)m * DM, lane);
        for (int idx = b * 512 + tid; idx < 16 * 64 * 64; idx += G * 512) { const int hh = idx >> 12, rr = (idx >> 6) & 63, c8 = idx & 63;
            *(u32x4*)(p.WqT + (size_t)(hh * 256 + 192 + rr) * 512 + c8 * 8) = (u32x4){0u, 0u, 0u, 0u}; }
        rope_table(p.pos, p.ropeT, b * 512 + tid, G * 512);
        __syncthreads();
        for (int it = b; it < 512; it += G) wfold_item(p.w_peer_q, p.sub_keys, p.WpT, smf, it);
    }
    xcd_barrier(bar);
    REP(1) {
        pg8::Gemm g{p.h, p.WinT, S, INWP, DM}; pg8::StaticOrder so; so.init(S, INWP, G, b);
        pg8::EpiInProj E{p.cq, p.ckv, p.fq, p.fk, p.fv, p.merged, p.kpe, p.lf, p.b_gate, p.b_forget, p.ssq, p.fox_qg, p.fox_kg, (LAS float*)(lds + 131072 + 64)};
        pg8::gemm_phase<pg8::EpiInProj, pg8::StaticOrder, true, true>(lds, g, so, E);
    }
    xcd_barrier(bar);
    for (int hh = b; hh < 16; hh += G) fox_cumsum((double*)smem, hh, p.lf, p.F);
    REP(2) {
        pg8::Gemm g{p.cq, p.WqT, S, 4096, 512}; pg8::StaticOrder so; so.init(S, 4096, G, b);
        pg8::EpiQ E{p.qa, p.ssq, p.mla_qg, p.ropeT, (LAS float*)(lds + 131072 + 64)};
        pg8::gemm_phase<pg8::EpiQ, pg8::StaticOrder, true, true>(lds, g, so, E);
    }
    {
        pg8::Gemm g{p.ckv, p.WkvT, S, 4096, 512}; pg8::StaticOrder so; so.init(S, 4096, G, b);
        pg8::EpiKV E{p.ka, p.va, p.kpe, p.ssq, p.mla_kg, p.ropeT, (LAS float*)(lds + 131072 + 64)};
        pg8::gemm_phase<pg8::EpiKV, pg8::StaticOrder, true, true>(lds, g, so, E);
    }
    xcd_barrier(bar);
    REP(3) for (int L = b; L < 1024; L += G) {
        const int i = L >> 8, vc = L & 255, vcx = (vc & 7) * 32 + (vc >> 3), hh = vcx >> 4, x = vcx & 15, qbk = (i & 1) ? x : 31 - x;
        if (i < 2) att::attn_block<192, false>(smem, p.qa + hh * 192, 3072, p.ka + hh * 192, 3072, p.va + hh * 128, 2048, nullptr, p.merged + hh * 128, p.attout + hh * 128, qbk, nullptr, nullptr);
        else att::attn_block<128, true>(smem, p.fq + hh * 128, 2048, p.fk + hh * 128, 2048, p.fv + hh * 128, 2048, p.F + (size_t)hh * S, p.merged + 2048 + hh * 128, p.attout + 2048 + hh * 128, qbk, p.fox_qg, p.fox_kg);
    }
    xcd_barrier(bar);
    REP(4) {
        pg8::Gemm g{p.attout, p.WoT, S, 2048, 4096}; pg8::StaticOrder so; so.init(S, 2048, G, b);
        pg8::EpiStoreF32<true> E{p.x1, p.x, 2048};
        pg8::gemm_phase<pg8::EpiStoreF32<true>, pg8::StaticOrder, true, true>(lds, g, so, E);
    }
    xcd_barrier(bar);
    { PHASE_IDS(); for (int m = gw; m < S; m += NGW) rms_row2048(p.x1 + (size_t)m * DM, p.ffn_g, p.h + (size_t)m * DM, lane);
      cvt_rows_fp8(p.peer_u, p.U8, (size_t)16384 * 2048, U_SCALE, gw, NGW, lane); cvt_rows_fp8(p.peer_v, p.V8, (size_t)16384 * 2048, V_SCALE, gw, NGW, lane); }
    xcd_barrier(bar);
    REP(5) {
        pg8::Gemm g{p.h, p.WpT, S, 2048, 2048}; pg8::StaticOrder so; so.init(S, 2048, G, b);
        pg8::EpiStoreF32<false> E{p.scores, nullptr, 2048};
        pg8::gemm_phase<pg8::EpiStoreF32<false>, pg8::StaticOrder, true, true>(lds, g, so, E);
    }
    xcd_barrier(bar);
    REP(6) for (int g = b; g < S / 32; g += G) peer_group(smem, g, p.scores, p.h, p.x1, p.U8, p.V8, p.out);
}

extern "C" void kernel_launch(void* const* d_in, const int* in_sizes, int n_in,
                              void* d_out, int out_size, void* d_ws, size_t ws_size,
                              hipStream_t stream) {
    if (ws_size < 512 * MiB) { fprintf(stderr, "kernel_launch: workspace too small (%zu)\n", ws_size); return; }
    Params p{};
    p.x = (const float*)d_in[0]; p.pos = (const int*)d_in[1]; p.mix_g = (const float*)d_in[2]; p.w_in = (const float*)d_in[3];
    p.b_forget = (const float*)d_in[4]; p.b_gate = (const float*)d_in[5]; p.q_lat_g = (const float*)d_in[6]; p.w_q_up = (const float*)d_in[7];
    p.kv_lat_g = (const float*)d_in[8]; p.w_kv_up = (const float*)d_in[9]; p.mla_qg = (const float*)d_in[10]; p.mla_kg = (const float*)d_in[11];
    p.fox_qg = (const float*)d_in[12]; p.fox_kg = (const float*)d_in[13]; p.w_out = (const float*)d_in[14]; p.ffn_g = (const float*)d_in[15];
    p.w_peer_q = (const float*)d_in[16]; p.sub_keys = (const float*)d_in[17]; p.peer_u = (const float*)d_in[18]; p.peer_v = (const float*)d_in[19];
    p.out = (float*)d_out;
    char* ws = (char*)d_ws;
    p.WqT = (bf16_t*)(ws + 1 * MiB); p.WkvT = (bf16_t*)(ws + 5 * MiB); p.WoT = (bf16_t*)(ws + 9 * MiB); p.WpT = (bf16_t*)(ws + 25 * MiB); p.WinT = (bf16_t*)(ws + 33 * MiB);
    p.h = (bf16_t*)(ws + 78 * MiB); p.cq = (bf16_t*)(ws + 110 * MiB); p.ckv = (bf16_t*)(ws + 118 * MiB);
    p.fq = (bf16_t*)(ws + 126 * MiB); p.fk = (bf16_t*)(ws + 158 * MiB); p.fv = (bf16_t*)(ws + 190 * MiB); p.merged = (bf16_t*)(ws + 222 * MiB);
    p.kpe = (bf16_t*)(ws + 286 * MiB); p.lf = (float*)(ws + 287 * MiB); p.F = (float*)(ws + 287 * MiB + 512 * 1024);
    p.qa = (bf16_t*)(ws + 288 * MiB); p.va = (bf16_t*)(ws + 336 * MiB); p.ka = (bf16_t*)(ws + 400 * MiB); p.x1 = (float*)(ws + 448 * MiB);
    p.scores = (float*)(ws + 222 * MiB);
    p.ctl = (unsigned*)ws;
    p.ropeT = (float2*)(ws + 448 * MiB);
    p.ssq = (float*)(ws + 64 * 1024);
    p.attout = (bf16_t*)(ws + 33 * MiB);
    p.U8 = (unsigned char*)(ws + 126 * MiB); p.V8 = (unsigned char*)(ws + 158 * MiB);

    static int grid_blocks = 0;
    if (!grid_blocks) {
        if (hipFuncSetAttribute((const void*)mega, hipFuncAttributeMaxDynamicSharedMemorySize, LDS_BYTES) != hipSuccess) { fprintf(stderr, "hipFuncSetAttribute failed\n"); return; }
        int dev = 0, cus = 0, per_cu = 0;
        (void)hipGetDevice(&dev);
        (void)hipDeviceGetAttribute(&cus, hipDeviceAttributeMultiprocessorCount, dev);
        (void)hipOccupancyMaxActiveBlocksPerMultiprocessor(&per_cu, (const void*)mega, 512, LDS_BYTES);
        if (per_cu < 1 || cus < 1) { fprintf(stderr, "occupancy query says %d blocks/CU on %d CUs\n", per_cu, cus); return; }
        grid_blocks = cus;
    }
    if (hipMemsetAsync(d_ws, 0, 16384, stream) != hipSuccess) { fprintf(stderr, "memset of the barrier words failed\n"); return; }
    void* args[] = {&p};
    hipError_t e = hipLaunchCooperativeKernel((const void*)mega, dim3(grid_blocks), dim3(512), args, LDS_BYTES, stream);
    if (e != hipSuccess) fprintf(stderr, "cooperative launch failed: %s (grid %d)\n", hipGetErrorString(e), grid_blocks);
}
```

```cpp
#include <hip/hip_runtime.h>
#include <hip/hip_cooperative_groups.h>
#include <stdint.h>
#include <math.h>
#include <cstdio>
namespace cg = cooperative_groups;

namespace pg8 {
#define PG8_LAS __attribute__((address_space(3)))
typedef unsigned short bf16_t;
typedef short bf16x8 __attribute__((ext_vector_type(8)));
typedef float f32x4 __attribute__((ext_vector_type(4)));
typedef unsigned u32x4 __attribute__((ext_vector_type(4)));
constexpr int BM = 256, BK = 64, HALF = 128, HTB = HALF * BK * 2  , STAGE_BYTES = 8 * HTB, NXCD = 8, WGM = 8;

__host__ __device__ __forceinline__ int lds_byte(int r, int c) { const int st = (r >> 4) * 2 + (c >> 5), rr = r & 15, cc = c & 31, ob = rr * 64 + cc * 2; return st * 1024 + (ob ^ (((ob >> 9) & 1) << 5)); }
__host__ __device__ __forceinline__ void stage_rc(int b, int& R, int& C) { const int st = b / 1024, sb = b % 1024, swz = sb ^ (((sb >> 9) & 1) << 5); R = (st >> 1) * 16 + swz / 64; C = (st & 1) * 32 + (swz % 64) / 2; }
__host__ __device__ __forceinline__ int perm32(int rho) { const int n = rho >> 4, i = rho & 15; return 8 * (i >> 2) + 4 * n + (i & 3); }

struct Unit { int pm, pn; };
struct Gemm { const bf16_t* A; const bf16_t* Bt; int M, N, K; };

struct StaticOrder {
    int nM, nN, nwg, G, c;
    __host__ __device__ void init(int M, int N, int G_, int c_) { nM = M / BM; nN = N / BM; nwg = nM * nN; G = G_; c = c_; }
    __host__ __device__ bool next(int i, Unit& u) const {
        const long L = (long)i * G + c; if (L >= nwg) return false;
        int wgid = (int)L; { const int q = nwg / NXCD, r = nwg % NXCD, xcd = wgid % NXCD, off = wgid / NXCD; wgid = (xcd < r ? xcd * (q + 1) : r * (q + 1) + (xcd - r) * q) + off; }
        const int nig = WGM * nN, gid = wgid / nig, fm = gid * WGM, gsz = (nM - fm) < WGM ? (nM - fm) : WGM;
        u.pm = fm + ((wgid % nig) % gsz); u.pn = (wgid % nig) / gsz; return true;
    }
    __device__ __forceinline__ void a_ready(const Unit&) const {}
    __device__ __forceinline__ void done(const Unit&) const {}
};

__device__ __forceinline__ unsigned cvt_pk_bf16(float lo, float hi) { unsigned r; asm volatile("v_cvt_pk_bf16_f32 %0, %1, %2" : "=v"(r) : "v"(lo), "v"(hi)); return r; }
__device__ __forceinline__ u32x4 pack8bf(const f32x4& v0, const f32x4& v1) { u32x4 w; w.x = cvt_pk_bf16(v0[0], v0[1]); w.y = cvt_pk_bf16(v0[2], v0[3]); w.z = cvt_pk_bf16(v1[0], v1[1]); w.w = cvt_pk_bf16(v1[2], v1[3]); return w; }

struct EpiStoreBf16 {
    static constexpr bool PERM = true, AFTER_DRAIN = false;
    bf16_t* O; int ldc;
    __device__ __forceinline__ void operator()(const f32x4 (&acc)[2][2][4][2], const Unit& u, int wr, int wc, int fr, int fq) const {
        const int row0 = u.pm * BM + wr * 64 + fr, col0 = u.pn * BM + wc * 32 + 8 * fq;
#pragma unroll
        for (int ai = 0; ai < 2; ++ai)
#pragma unroll
            for (int m = 0; m < 4; ++m) { bf16_t* rowp = O + (size_t)(row0 + ai * HALF + m * 16) * ldc + col0;
#pragma unroll
                for (int bj = 0; bj < 2; ++bj) *(u32x4*)(rowp + bj * HALF) = pack8bf(acc[ai][bj][m][0], acc[ai][bj][m][1]); }
    }
};
template <bool RES> struct EpiStoreF32 {
    static constexpr bool PERM = true, AFTER_DRAIN = false;
    float* O; const float* res; int ldc;
    __device__ __forceinline__ void operator()(const f32x4 (&acc)[2][2][4][2], const Unit& u, int wr, int wc, int fr, int fq) const {
        const int row0 = u.pm * BM + wr * 64 + fr, col0 = u.pn * BM + wc * 32 + 8 * fq;
#pragma unroll
        for (int ai = 0; ai < 2; ++ai)
#pragma unroll
            for (int m = 0; m < 4; ++m) { const size_t off = (size_t)(row0 + ai * HALF + m * 16) * ldc + col0;
#pragma unroll
                for (int bj = 0; bj < 2; ++bj) { f32x4 v0 = acc[ai][bj][m][0], v1 = acc[ai][bj][m][1];
                    if (RES) { v0 += *(const f32x4*)(res + off + bj * HALF); v1 += *(const f32x4*)(res + off + bj * HALF + 4); }
                    *(f32x4*)(O + off + bj * HALF) = v0; *(f32x4*)(O + off + bj * HALF + 4) = v1; } }
    }
};
#define EPI_LDSBAR() do { asm volatile("s_waitcnt lgkmcnt(0)" ::: "memory"); __builtin_amdgcn_s_barrier(); asm volatile("" ::: "memory"); } while (0)
struct EpiInProj {
    static constexpr bool PERM = true, AFTER_DRAIN = false;
    bf16_t *cq, *ckv, *fq, *fk, *fv, *gates, *kpe; float* lf; const float *b_gate, *b_forget; float* ssq; const float *gfq, *gfk; PG8_LAS float* xs;
    __device__ __forceinline__ void operator()(const f32x4 (&acc)[2][2][4][2], const Unit& u, int wr, int wc, int fr, int fq_) const {
        const int pn = u.pn, row0 = u.pm * BM + wr * 64 + fr, cw = wc * 32 + 8 * fq_;
        if (pn < 4) {
            bf16_t* base = pn < 2 ? cq : ckv; const int colt = (pn & 1) * 256;
#pragma unroll
            for (int ai = 0; ai < 2; ++ai)
#pragma unroll
                for (int m = 0; m < 4; ++m) { const int row = row0 + ai * HALF + m * 16; bf16_t* rowp = base + (size_t)row * 512 + colt + cw; float s = 0.f;
#pragma unroll
                    for (int bj = 0; bj < 2; ++bj) { const f32x4 v0 = acc[ai][bj][m][0], v1 = acc[ai][bj][m][1];
                        s += (v0[0] * v0[0] + v0[1] * v0[1]) + (v0[2] * v0[2] + v0[3] * v0[3]) + (v1[0] * v1[0] + v1[1] * v1[1]) + (v1[2] * v1[2] + v1[3] * v1[3]);
                        *(u32x4*)(rowp + bj * HALF) = pack8bf(v0, v1); }
                    s += __shfl_xor(s, 16); s += __shfl_xor(s, 32);
                    if (fq_ == 0) ssq[((size_t)pn * 8192 + row) * 4 + wc] = s; }
        } else if (pn < 20) {
            const bool isq = pn < 12; bf16_t* base = isq ? fq : fk; const int colt = (pn - (isq ? 4 : 12)) * 256; const float* g = isq ? gfq : gfk;
            const float qs = isq ? 0.12751743f : 1.f;
#pragma unroll
            for (int ai = 0; ai < 2; ++ai)
#pragma unroll
                for (int m = 0; m < 4; ++m)
#pragma unroll
                    for (int bj = 0; bj < 2; ++bj) { const f32x4 v0 = acc[ai][bj][m][0], v1 = acc[ai][bj][m][1];
                        float s = (v0[0] * v0[0] + v0[1] * v0[1]) + (v0[2] * v0[2] + v0[3] * v0[3]) + (v1[0] * v1[0] + v1[1] * v1[1]) + (v1[2] * v1[2] + v1[3] * v1[3]);
                        s += __shfl_xor(s, 16); s += __shfl_xor(s, 32);
                        if (fq_ == 0) xs[((ai * HALF + wr * 64 + m * 16 + fr) * 2 + bj) * 4 + wc] = s; }
            EPI_LDSBAR();
            const f32x4 g0 = *(const f32x4*)(g + cw) * qs, g1 = *(const f32x4*)(g + cw + 4) * qs;
#pragma unroll
            for (int ai = 0; ai < 2; ++ai)
#pragma unroll
                for (int m = 0; m < 4; ++m) { bf16_t* rowp = base + (size_t)(row0 + ai * HALF + m * 16) * 2048 + colt + cw;
#pragma unroll
                    for (int bj = 0; bj < 2; ++bj) { const f32x4 t4 = *(const PG8_LAS f32x4*)(xs + ((ai * HALF + wr * 64 + m * 16 + fr) * 2 + bj) * 4);
                        const float r = rsqrtf(((t4[0] + t4[1]) + (t4[2] + t4[3])) * (1.f / 128.f) + 1e-6f);
                        *(u32x4*)(rowp + bj * HALF) = pack8bf(acc[ai][bj][m][0] * g0 * r, acc[ai][bj][m][1] * g1 * r); } }
        } else if (pn < 28) {
            const int colt = (pn - 20) * 256;
#pragma unroll
            for (int ai = 0; ai < 2; ++ai)
#pragma unroll
                for (int m = 0; m < 4; ++m) { bf16_t* rowp = fv + (size_t)(row0 + ai * HALF + m * 16) * 2048 + colt + cw;
#pragma unroll
                    for (int bj = 0; bj < 2; ++bj) *(u32x4*)(rowp + bj * HALF) = pack8bf(acc[ai][bj][m][0], acc[ai][bj][m][1]); }
        } else if (pn < 44) {
            const int colt = (pn - 28) * 256 + cw;
#pragma unroll
            for (int bj = 0; bj < 2; ++bj) {
                const f32x4 b0 = *(const f32x4*)(b_gate + colt + bj * HALF), b1 = *(const f32x4*)(b_gate + colt + bj * HALF + 4);
#pragma unroll
                for (int ai = 0; ai < 2; ++ai)
#pragma unroll
                    for (int m = 0; m < 4; ++m) {
                        f32x4 v0 = acc[ai][bj][m][0] + b0, v1 = acc[ai][bj][m][1] + b1;
#pragma unroll
                        for (int e = 0; e < 4; ++e) { v0[e] = 1.f / (1.f + __expf(-v0[e])); v1[e] = 1.f / (1.f + __expf(-v1[e])); }
                        *(u32x4*)(gates + (size_t)(row0 + ai * HALF + m * 16) * 4096 + colt + bj * HALF) = pack8bf(v0, v1); }
            }
        } else {
            if (cw < 64) {
#pragma unroll
                for (int ai = 0; ai < 2; ++ai)
#pragma unroll
                    for (int m = 0; m < 4; ++m) *(u32x4*)(kpe + (size_t)(row0 + ai * HALF + m * 16) * 64 + cw) = pack8bf(acc[ai][0][m][0], acc[ai][0][m][1]);
            } else if (cw < 80) {
                const int h0 = cw - 64;
                const f32x4 b0 = *(const f32x4*)(b_forget + h0), b1 = *(const f32x4*)(b_forget + h0 + 4);
#pragma unroll
                for (int ai = 0; ai < 2; ++ai)
#pragma unroll
                    for (int m = 0; m < 4; ++m) { const int row = row0 + ai * HALF + m * 16;
                        f32x4 z0 = acc[ai][0][m][0] + b0, z1 = acc[ai][0][m][1] + b1;
#pragma unroll
                        for (int e = 0; e < 4; ++e) { z0[e] = fminf(z0[e], 0.f) - __logf(1.f + __expf(-fabsf(z0[e]))); z1[e] = fminf(z1[e], 0.f) - __logf(1.f + __expf(-fabsf(z1[e]))); }
                        *(f32x4*)(lf + (size_t)row * 16 + h0) = z0; *(f32x4*)(lf + (size_t)row * 16 + h0 + 4) = z1; }
            }
        }
    }
};
__device__ __forceinline__ float lat_rinv(const float* ssq, int part0, int row) {
    const f32x4 a = *(const f32x4*)(ssq + ((size_t)part0 * 8192 + row) * 4), b = *(const f32x4*)(ssq + ((size_t)(part0 + 1) * 8192 + row) * 4);
    return rsqrtf((((a[0] + a[1]) + (a[2] + a[3])) + ((b[0] + b[1]) + (b[2] + b[3]))) * (1.f / 512.f) + 1e-6f);
}
struct EpiQ {
    static constexpr bool PERM = true, AFTER_DRAIN = false;
    bf16_t* qa; const float* ssq; const float* gq; const float2* ropeT; PG8_LAS float* xs;
    __device__ __forceinline__ void operator()(const f32x4 (&acc)[2][2][4][2], const Unit& u, int wr, int wc, int fr, int fq_) const {
        const int h = u.pn, row0 = u.pm * BM + wr * 64 + fr, cw = wc * 32 + 8 * fq_;
        float rl[2][4];
#pragma unroll
        for (int ai = 0; ai < 2; ++ai)
#pragma unroll
            for (int m = 0; m < 4; ++m) { rl[ai][m] = lat_rinv(ssq, 0, row0 + ai * HALF + m * 16); float s = 0.f;
#pragma unroll
                for (int bj = 0; bj < 2; ++bj) { const f32x4 v0 = acc[ai][bj][m][0], v1 = acc[ai][bj][m][1];
                    s += (v0[0] * v0[0] + v0[1] * v0[1]) + (v0[2] * v0[2] + v0[3] * v0[3]) + (v1[0] * v1[0] + v1[1] * v1[1]) + (v1[2] * v1[2] + v1[3] * v1[3]); }
                s *= rl[ai][m] * rl[ai][m];
                s += __shfl_xor(s, 16); s += __shfl_xor(s, 32);
                if (fq_ == 0) xs[(ai * HALF + wr * 64 + m * 16 + fr) * 4 + wc] = s; }
        EPI_LDSBAR();
        const float qs = 0.10411754f;
        const f32x4 g0 = *(const f32x4*)(gq + cw) * qs, g1 = *(const f32x4*)(gq + cw + 4) * qs;
        const int pp = 16 * (wc & 1) + 4 * fq_;
        const f32x4 ga = *(const f32x4*)(gq + 128 + pp) * qs, gb = *(const f32x4*)(gq + 160 + pp) * qs;
#pragma unroll
        for (int ai = 0; ai < 2; ++ai)
#pragma unroll
            for (int m = 0; m < 4; ++m) { const int row = row0 + ai * HALF + m * 16;
                const f32x4 t4 = *(const PG8_LAS f32x4*)(xs + (ai * HALF + wr * 64 + m * 16 + fr) * 4);
                const float r = rsqrtf(((t4[0] + t4[1]) + (t4[2] + t4[3])) * (1.f / 192.f) + 1e-6f) * rl[ai][m];
                bf16_t* rowp = qa + (size_t)row * 3072 + h * 192;
                *(u32x4*)(rowp + cw) = pack8bf(acc[ai][0][m][0] * g0 * r, acc[ai][0][m][1] * g1 * r);
                if (wc < 2) { const f32x4 c01 = *(const f32x4*)(ropeT + (size_t)row * 32 + pp), c23 = *(const f32x4*)(ropeT + (size_t)row * 32 + pp + 2);
                    const f32x4 z0 = acc[ai][1][m][0] * r, z1 = acc[ai][1][m][1] * r;
                    const float a0 = z0[0] * ga[0], b0 = z0[1] * gb[0], a1 = z0[2] * ga[1], b1 = z0[3] * gb[1], a2 = z1[0] * ga[2], b2 = z1[1] * gb[2], a3 = z1[2] * ga[3], b3 = z1[3] * gb[3];
                    const f32x4 o0 = {a0 * c01[0] - b0 * c01[1], a0 * c01[1] + b0 * c01[0], a1 * c01[2] - b1 * c01[3], a1 * c01[3] + b1 * c01[2]};
                    const f32x4 o1 = {a2 * c23[0] - b2 * c23[1], a2 * c23[1] + b2 * c23[0], a3 * c23[2] - b3 * c23[3], a3 * c23[3] + b3 * c23[2]};
                    *(u32x4*)(rowp + 128 + cw) = pack8bf(o0, o1); } }
    }
};
struct EpiKV {
    static constexpr bool PERM = true, AFTER_DRAIN = false;
    bf16_t *ka, *va; const bf16_t* kpe; const float* ssq; const float* gk; const float2* ropeT; PG8_LAS float* xs;
    __device__ __forceinline__ void operator()(const f32x4 (&acc)[2][2][4][2], const Unit& u, int wr, int wc, int fr, int fq_) const {
        const int h = u.pn, row0 = u.pm * BM + wr * 64 + fr, cw = wc * 32 + 8 * fq_;
        float rl[2][4]; f32x4 kp[2][4];
#pragma unroll
        for (int ai = 0; ai < 2; ++ai)
#pragma unroll
            for (int m = 0; m < 4; ++m) { const int row = row0 + ai * HALF + m * 16; rl[ai][m] = lat_rinv(ssq, 2, row);
                const uint2 w = *(const uint2*)(kpe + (size_t)row * 64 + 16 * wc + 4 * fq_);
                kp[ai][m] = (f32x4){__uint_as_float(w.x << 16), __uint_as_float(w.x & 0xffff0000u), __uint_as_float(w.y << 16), __uint_as_float(w.y & 0xffff0000u)};
                const f32x4 v0 = acc[ai][0][m][0], v1 = acc[ai][0][m][1];
                float s = ((v0[0] * v0[0] + v0[1] * v0[1]) + (v0[2] * v0[2] + v0[3] * v0[3]) + (v1[0] * v1[0] + v1[1] * v1[1]) + (v1[2] * v1[2] + v1[3] * v1[3])) * (rl[ai][m] * rl[ai][m]);
                s += (kp[ai][m][0] * kp[ai][m][0] + kp[ai][m][1] * kp[ai][m][1]) + (kp[ai][m][2] * kp[ai][m][2] + kp[ai][m][3] * kp[ai][m][3]);
                s += __shfl_xor(s, 16); s += __shfl_xor(s, 32);
                if (fq_ == 0) xs[(ai * HALF + wr * 64 + m * 16 + fr) * 4 + wc] = s;
                *(u32x4*)(va + (size_t)row * 2048 + h * 128 + cw) = pack8bf(acc[ai][1][m][0] * rl[ai][m], acc[ai][1][m][1] * rl[ai][m]); }
        EPI_LDSBAR();
        const f32x4 g0 = *(const f32x4*)(gk + cw), g1 = *(const f32x4*)(gk + cw + 4);
        const int pp = 8 * wc + 2 * fq_;
        const float ga0 = gk[128 + pp], ga1 = gk[128 + pp + 1], gb0 = gk[160 + pp], gb1 = gk[160 + pp + 1];
#pragma unroll
        for (int ai = 0; ai < 2; ++ai)
#pragma unroll
            for (int m = 0; m < 4; ++m) { const int row = row0 + ai * HALF + m * 16;
                const f32x4 t4 = *(const PG8_LAS f32x4*)(xs + (ai * HALF + wr * 64 + m * 16 + fr) * 4);
                const float r = rsqrtf(((t4[0] + t4[1]) + (t4[2] + t4[3])) * (1.f / 192.f) + 1e-6f), rn = r * rl[ai][m];
                bf16_t* rowp = ka + (size_t)row * 3072 + h * 192;
                *(u32x4*)(rowp + cw) = pack8bf(acc[ai][0][m][0] * g0 * rn, acc[ai][0][m][1] * g1 * rn);
                const f32x4 cs = *(const f32x4*)(ropeT + (size_t)row * 32 + pp);
                const float a0 = kp[ai][m][0] * r * ga0, b0 = kp[ai][m][1] * r * gb0, a1 = kp[ai][m][2] * r * ga1, b1 = kp[ai][m][3] * r * gb1;
                uint2 o; o.x = cvt_pk_bf16(a0 * cs[0] - b0 * cs[1], a0 * cs[1] + b0 * cs[0]); o.y = cvt_pk_bf16(a1 * cs[2] - b1 * cs[3], a1 * cs[3] + b1 * cs[2]);
                *(uint2*)(rowp + 128 + 16 * wc + 4 * fq_) = o; }
    }
};
template <class Epi, class Sched, bool ALIGN_EPI = false, bool SP2 = false>
__device__ __forceinline__ void gemm_phase(PG8_LAS unsigned char* lds, const Gemm g, const Sched& S, const Epi& E) {
    int tid = threadIdx.x; asm volatile("" : "+v"(tid));
    const int wid = __builtin_amdgcn_readfirstlane(tid >> 6), lane = tid & 63, wr = wid >> 2, wc = wid & 3, fr = lane & 15, fq = lane >> 4;
    const int K = g.K, nt = K / BK;
    unsigned voffA[2], voffB[2];
#pragma unroll
    for (int i = 0; i < 2; ++i) { int R, C; stage_rc(tid * 16 + i * 8192, R, C); const int Rb = Epi::PERM ? ((R & ~31) + perm32(R & 31)) : R;
        voffA[i] = (unsigned)(R * K + C) * 2u; voffB[i] = (unsigned)(Rb * K + C) * 2u; }
    const size_t kstep = (size_t)(BK * 2);
    const size_t hstep = (size_t)HALF * K * 2;
    const size_t tstep = 2 * hstep;
    const unsigned ldsw = (unsigned)wid * 1024u;
    const int aoff = lds_byte(wr * 64 + fr, fq * 8), boff = lds_byte(wc * 32 + fr, fq * 8);
#define PG8_SA(b, h) (((b) * 2 + (h)) * HTB)
#define PG8_SB(b, h) ((4 + (b) * 2 + (h)) * HTB)
#define PG8_STAGE(bufoff, gbase, voff) do { _Pragma("unroll") for (int _i = 0; _i < 2; ++_i) \
        __builtin_amdgcn_global_load_lds((const unsigned*)((const char*)(gbase) + (voff)[_i]), (PG8_LAS unsigned*)(lds + (bufoff) + ldsw + _i * 8192), 16, 0, 0); } while (0)
#define PG8_LDA(dst, b, h) do { _Pragma("unroll") for (int m = 0; m < 4; ++m) _Pragma("unroll") for (int k = 0; k < 2; ++k) dst[m][k] = *(const PG8_LAS bf16x8*)(lds + PG8_SA(b, h) + aoff + m * 2048 + k * 1024); } while (0)
#define PG8_LDB(dst, b, h) do { _Pragma("unroll") for (int n = 0; n < 2; ++n) _Pragma("unroll") for (int k = 0; k < 2; ++k) dst[n][k] = *(const PG8_LAS bf16x8*)(lds + PG8_SB(b, h) + boff + n * 2048 + k * 1024); } while (0)
#define PG8_MMA(ai, bj, At, Bt) do { __builtin_amdgcn_s_setprio(1); _Pragma("unroll") for (int m = 0; m < 4; ++m) _Pragma("unroll") for (int n = 0; n < 2; ++n) _Pragma("unroll") for (int k = 0; k < 2; ++k) \
        acc[ai][bj][m][n] = __builtin_amdgcn_mfma_f32_16x16x32_bf16(Bt[n][k], At[m][k], acc[ai][bj][m][n], 0, 0, 0); __builtin_amdgcn_s_setprio(0); } while (0)
#define PG8_WAIT_V(n) asm volatile("s_waitcnt vmcnt(" #n ")" ::: "memory")
#define PG8_WAIT_L(n) asm volatile("s_waitcnt lgkmcnt(" #n ")" ::: "memory")
#define PG8_BAR __builtin_amdgcn_s_barrier()
#define PG8_SCHED __builtin_amdgcn_sched_barrier(0)
    Unit cur, nxt; int ui = 0;
    if (!S.next(0, cur)) return;
    f32x4 acc[2][2][4][2];
#pragma unroll
    for (int a = 0; a < 2; ++a)
#pragma unroll
        for (int b = 0; b < 2; ++b)
#pragma unroll
            for (int m = 0; m < 4; ++m)
#pragma unroll
                for (int n = 0; n < 2; ++n) acc[a][b][m][n] = (f32x4){0.f, 0.f, 0.f, 0.f};
    bf16x8 At[4][2], B0[2][2], B1[2][2];
    const char* cA = (const char*)g.A + (size_t)cur.pm * tstep; const char* cB = (const char*)g.Bt + (size_t)cur.pn * tstep;
    S.a_ready(cur);
    if constexpr (SP2) {
        PG8_STAGE(PG8_SB(0, 0), cB, voffB); PG8_STAGE(PG8_SB(0, 1), cB + hstep, voffB); PG8_STAGE(PG8_SA(0, 0), cA, voffA); PG8_STAGE(PG8_SA(0, 1), cA + hstep, voffA);
        if (wr == 1) PG8_BAR;
        PG8_WAIT_V(2); PG8_BAR;
        PG8_STAGE(PG8_SB(1, 0), cB + kstep, voffB); PG8_STAGE(PG8_SA(1, 0), cA + kstep, voffA); PG8_STAGE(PG8_SB(1, 1), cB + hstep + kstep, voffB);
        PG8_WAIT_V(6); PG8_BAR;
    } else {
        PG8_STAGE(PG8_SB(0, 0), cB, voffB); PG8_STAGE(PG8_SA(0, 0), cA, voffA); PG8_STAGE(PG8_SB(0, 1), cB + hstep, voffB); PG8_STAGE(PG8_SA(0, 1), cA + hstep, voffA);
        if (wr == 1) PG8_BAR;
        PG8_WAIT_V(4); PG8_BAR;
        PG8_STAGE(PG8_SB(1, 0), cB + kstep, voffB); PG8_STAGE(PG8_SA(1, 0), cA + kstep, voffA); PG8_STAGE(PG8_SB(1, 1), cB + hstep + kstep, voffB);
        PG8_WAIT_V(6); PG8_BAR;
    }
    for (;;) {
        const bool has_next = S.next(ui + 1, nxt);
        const char* nA = has_next ? (const char*)g.A + (size_t)nxt.pm * tstep : cA; const char* nB = has_next ? (const char*)g.Bt + (size_t)nxt.pn * tstep : cB;
        for (int t = 0; t < nt; t += 2) {
            const bool last = (t == nt - 2);
            const char* a1 = cA + (size_t)(t + 1) * kstep;
            const char* a2 = last ? nA : cA + (size_t)(t + 2) * kstep; const char* b2 = last ? nB : cB + (size_t)(t + 2) * kstep;
            const char* a3 = a2 + kstep; const char* b3 = b2 + kstep;
            if (last && has_next) S.a_ready(nxt);
            if constexpr (SP2) {
            PG8_LDB(B0, 0, 0); PG8_LDB(B1, 0, 1); PG8_SCHED; PG8_LDA(At, 0, 0); PG8_STAGE(PG8_SA(1, 1), a1 + hstep, voffA);
            PG8_WAIT_V(8); PG8_WAIT_L(0); PG8_BAR; PG8_MMA(0, 0, At, B0); PG8_MMA(0, 1, At, B1); PG8_BAR; PG8_SCHED;
            PG8_LDA(At, 0, 1); PG8_STAGE(PG8_SB(0, 0), b2, voffB); PG8_STAGE(PG8_SB(0, 1), b2 + hstep, voffB); PG8_STAGE(PG8_SA(0, 0), a2, voffA);
            PG8_WAIT_V(8); PG8_WAIT_L(0); PG8_BAR; PG8_MMA(1, 0, At, B0); PG8_MMA(1, 1, At, B1); PG8_BAR; PG8_SCHED;
            PG8_LDB(B0, 1, 0); PG8_LDB(B1, 1, 1); PG8_SCHED; PG8_LDA(At, 1, 0); PG8_STAGE(PG8_SA(0, 1), a2 + hstep, voffA);
            PG8_WAIT_V(8); PG8_WAIT_L(0); PG8_BAR; PG8_MMA(0, 0, At, B0); PG8_MMA(0, 1, At, B1); PG8_BAR; PG8_SCHED;
            PG8_LDA(At, 1, 1); PG8_STAGE(PG8_SB(1, 0), b3, voffB); PG8_STAGE(PG8_SB(1, 1), b3 + hstep, voffB); PG8_STAGE(PG8_SA(1, 0), a3, voffA);
            PG8_WAIT_V(8); PG8_WAIT_L(0); PG8_BAR; PG8_MMA(1, 0, At, B0); PG8_MMA(1, 1, At, B1); PG8_BAR; PG8_SCHED;
            } else {
            PG8_LDB(B0, 0, 0); PG8_SCHED; PG8_LDA(At, 0, 0); PG8_STAGE(PG8_SA(1, 1), a1 + hstep, voffA);
            PG8_WAIT_L(8); PG8_BAR; PG8_WAIT_L(0); PG8_MMA(0, 0, At, B0); PG8_BAR; PG8_SCHED;
            PG8_LDB(B1, 0, 1); PG8_STAGE(PG8_SB(0, 0), b2, voffB);
            PG8_BAR; PG8_WAIT_L(0); PG8_MMA(0, 1, At, B1); PG8_BAR;
            PG8_LDA(At, 0, 1); PG8_STAGE(PG8_SA(0, 0), a2, voffA);
            PG8_BAR; PG8_WAIT_L(0); PG8_MMA(1, 0, At, B0); PG8_BAR; PG8_SCHED;
            PG8_STAGE(PG8_SB(0, 1), b2 + hstep, voffB);
            PG8_WAIT_V(6); PG8_BAR; PG8_MMA(1, 1, At, B1); PG8_BAR;
            PG8_LDB(B0, 1, 0); PG8_SCHED; PG8_LDA(At, 1, 0); PG8_STAGE(PG8_SA(0, 1), a2 + hstep, voffA);
            PG8_WAIT_L(8); PG8_BAR; PG8_WAIT_L(0); PG8_MMA(0, 0, At, B0); PG8_BAR; PG8_SCHED;
            PG8_LDB(B1, 1, 1); PG8_STAGE(PG8_SB(1, 0), b3, voffB);
            PG8_BAR; PG8_WAIT_L(0); PG8_MMA(0, 1, At, B1); PG8_BAR;
            PG8_LDA(At, 1, 1); PG8_STAGE(PG8_SA(1, 0), a3, voffA);
            PG8_BAR; PG8_WAIT_L(0); PG8_MMA(1, 0, At, B0); PG8_BAR; PG8_SCHED;
            PG8_STAGE(PG8_SB(1, 1), b3 + hstep, voffB);
            PG8_WAIT_V(6); PG8_BAR; PG8_MMA(1, 1, At, B1); PG8_BAR;
            }
        }
        if constexpr (ALIGN_EPI) { if (wr == 0) PG8_BAR; }
        if constexpr (!Epi::AFTER_DRAIN) { E(acc, cur, wr, wc, fr, fq); S.done(cur); }
        if (!has_next) break;
#pragma unroll
        for (int a = 0; a < 2; ++a)
#pragma unroll
            for (int b = 0; b < 2; ++b)
#pragma unroll
                for (int m = 0; m < 4; ++m)
#pragma unroll
                    for (int n = 0; n < 2; ++n) acc[a][b][m][n] = (f32x4){0.f, 0.f, 0.f, 0.f};
        cur = nxt; cA = nA; cB = nB; ++ui;
        if constexpr (ALIGN_EPI) { if (wr == 1) PG8_BAR; }
    }
    PG8_WAIT_V(0);
    if constexpr (!ALIGN_EPI) { if (wr == 0) PG8_BAR; }
    PG8_BAR;
    if constexpr (Epi::AFTER_DRAIN) { E.fused(acc, cur, wr, wc, fr, fq, lds, wid, lane); S.done(cur); }
#undef PG8_SA
#undef PG8_SB
#undef PG8_STAGE
#undef PG8_LDA
#undef PG8_LDB
#undef PG8_MMA
#undef PG8_WAIT_V
#undef PG8_WAIT_L
#undef PG8_BAR
#undef PG8_SCHED
}
}
namespace att {
typedef unsigned short bf16_t;
typedef short bf16x8 __attribute__((ext_vector_type(8)));
typedef short s16x4 __attribute__((ext_vector_type(4)));
typedef float f32x16 __attribute__((ext_vector_type(16)));
typedef float f32x4 __attribute__((ext_vector_type(4)));
typedef unsigned u32x4 __attribute__((ext_vector_type(4)));
#define ALAS __attribute__((address_space(3)))
#define ASBAR() __builtin_amdgcn_sched_barrier(0)
constexpr int SHM_V = 16384;
template <int DK> struct Lay { static constexpr int ROWB = DK * 2, SHM_K = 64 * ROWB, OFF_K = 2 * SHM_V, OFF_F = OFF_K + 2 * SHM_K, OFF_WS = OFF_F + 512, TOTAL = OFF_WS + 8 * 256; };

__device__ __forceinline__ int v_st(int k, int c) { const int kk = (k & ~0xC) | ((k & 4) << 1) | ((k & 8) >> 1); return ((kk >> 3) * 4 + (c >> 5)) * 512 + ((kk & 7) * 32 + (c & 31)) * 2; }
__device__ __forceinline__ int v_rd_base(int lane) { return ((lane & 3) << 3) | (((lane >> 2) & 3) << 6) | (((lane >> 4) & 1) << 5) | (((lane >> 5) & 1) << 8); }
__device__ __forceinline__ int crow(int r, int hi) { return (r & 3) + 8 * (r >> 2) + 4 * hi; }
__device__ __forceinline__ unsigned cvtpk(float lo, float hi) { unsigned r; asm volatile("v_cvt_pk_bf16_f32 %0, %1, %2" : "=v"(r) : "v"(lo), "v"(hi)); return r; }

__device__ __forceinline__ float wave_max_f(float v) {
#pragma unroll
    for (int o = 32; o >= 1; o >>= 1) v = fmaxf(v, __shfl_xor(v, o));
    return v;
}
template <int DK, bool FOX>
__device__ __forceinline__ void attn_block(unsigned char* smem, const bf16_t* __restrict__ Q, int ldq, const bf16_t* __restrict__ K, int ldk, const bf16_t* __restrict__ V, int ldv,
                                           const float* __restrict__ Fh, const bf16_t* __restrict__ gate, bf16_t* __restrict__ gout  , int qbk, const float* __restrict__ gq, const float* __restrict__ gk  ) {
    typedef Lay<DK> LY;
    constexpr int ND = DK / 16, NKC = DK / 8, NKI = (64 * NKC) / 512;
    int tid = threadIdx.x; asm volatile("" : "+v"(tid));
    const int wid = __builtin_amdgcn_readfirstlane(tid >> 6), lane = tid & 63, r32 = lane & 31, hi = lane >> 5;
    const int q0 = qbk * 256, qlo = q0 + wid * 32, qm = qlo + r32 - 4 * hi;
    const int NT = 4 * qbk + 4;
    ALAS unsigned char* lds = (ALAS unsigned char*)smem;
    ALAS float* F_lds = (ALAS float*)(lds + LY::OFF_F);
    ALAS float* wsl = (ALAS float*)(lds + LY::OFF_WS) + wid * 64;
    bf16x8 qr[ND];
#pragma unroll
    for (int d0 = 0; d0 < ND; ++d0) qr[d0] = *(const bf16x8*)(Q + (size_t)(qlo + r32) * ldq + d0 * 16 + hi * 8);
    const float fq = FOX ? Fh[qlo + r32] : 0.f;
    int kgo[NKI], klo[NKI];
#pragma unroll
    for (int i = 0; i < NKI; ++i) { const int idx = tid + 512 * i, row = idx / NKC, ch = idx % NKC; kgo[i] = row * ldk + ch * 8; klo[i] = row * LY::ROWB + ((ch ^ ((row >> 1) & 7)) << 4); }
    const int sr = tid >> 4, sc = (tid & 15) * 8, vst0 = v_st(sr, sc), vst1 = v_st(32 + sr, sc);
    const int vgo0 = sr * ldv + sc, vgo1 = (32 + sr) * ldv + sc;
    const int vb0 = (int)(uintptr_t)smem + v_rd_base(lane);
    int kbase[4];
#pragma unroll
    for (int dd = 0; dd < 4; ++dd) kbase[dd] = LY::OFF_K + r32 * LY::ROWB + (((((dd << 1) | hi) ^ ((r32 >> 1) & 7))) << 4);
    bf16x8 stk[NKI], stv0, stv1; float stf = 0.f;
#define ATT_LOAD(kb) do { _Pragma("unroll") for (int i = 0; i < NKI; ++i) stk[i] = *(const bf16x8*)(K + (size_t)(kb) * ldk + kgo[i]); \
        stv0 = *(const bf16x8*)(V + (size_t)(kb) * ldv + vgo0); stv1 = *(const bf16x8*)(V + (size_t)(kb) * ldv + vgo1); if (FOX && tid < 64) stf = Fh[(kb) + tid]; } while (0)
#define ATT_WRITE(bf) do { _Pragma("unroll") for (int i = 0; i < NKI; ++i) *(ALAS bf16x8*)(lds + LY::OFF_K + (bf) * LY::SHM_K + klo[i]) = stk[i]; \
        *(ALAS bf16x8*)(lds + (bf) * SHM_V + vst0) = stv0; *(ALAS bf16x8*)(lds + (bf) * SHM_V + vst1) = stv1; if (FOX && tid < 64) F_lds[(bf) * 64 + tid] = stf; } while (0)
    int t_start = 0;
    if (FOX) {
        const float gqm = wave_max_f(fmaxf(fabsf(gq[lane]), fabsf(gq[lane + 64]))), gkm = wave_max_f(fmaxf(fabsf(gk[lane]), fabsf(gk[lane + 64])));
        const float qk_bound = 0.12751743f * 128.f * gqm * gkm;
        const float thr = 2.02f * qk_bound + 40.f, f0 = Fh[q0];
        const int j0 = lane, j1 = lane + 64;
        const bool c0 = (j0 < 4 * qbk) && (Fh[j0 * 64 + 63] - f0 >= thr), c1 = (j1 < 4 * qbk) && (Fh[(j1 < 4 * qbk ? j1 : 0) * 64 + 63] - f0 >= thr);
        t_start = __builtin_popcountll(__ballot(c0)) + __builtin_popcountll(__ballot(c1));
        t_start = __builtin_amdgcn_readfirstlane(t_start); }
    ATT_LOAD(t_start * 64); ATT_WRITE(t_start & 1);
    float m_reg = -1e30f, l_reg = 0.f; f32x16 o[4];
#pragma unroll
    for (int d = 0; d < 4; ++d)
#pragma unroll
        for (int r = 0; r < 16; ++r) o[d][r] = 0.f;
    for (int t = t_start; t < NT; ++t) {
        const int buf = t & 1, kb = t * 64;
        __syncthreads();
        if (t + 1 < NT) ATT_LOAD(kb + 64);
        f32x16 p0, p1;
        if (FOX) {
#pragma unroll
            for (int g = 0; g < 4; ++g) { const f32x4 f0 = *(const ALAS f32x4*)(F_lds + buf * 64 + 8 * g + 4 * hi), f1 = *(const ALAS f32x4*)(F_lds + buf * 64 + 32 + 8 * g + 4 * hi);
#pragma unroll
                for (int e = 0; e < 4; ++e) { p0[4 * g + e] = fq - f0[e]; p1[4 * g + e] = fq - f1[e]; } }
        } else {
#pragma unroll
            for (int r = 0; r < 16; ++r) { p0[r] = 0.f; p1[r] = 0.f; }
        }
        __builtin_amdgcn_s_setprio(1);
#pragma unroll
        for (int d0 = 0; d0 < ND; ++d0) {
            ALAS const unsigned char* a = lds + buf * LY::SHM_K + kbase[d0 & 3] + (d0 >> 2) * 128;
            const bf16x8 b0 = *(const ALAS bf16x8*)a;
            const bf16x8 b1 = *(const ALAS bf16x8*)(a + 32 * LY::ROWB);
            p0 = __builtin_amdgcn_mfma_f32_32x32x16_bf16(b0, qr[d0], p0, 0, 0, 0);
            p1 = __builtin_amdgcn_mfma_f32_32x32x16_bf16(b1, qr[d0], p1, 0, 0, 0);
        }
        __builtin_amdgcn_s_setprio(0);
        if (kb + 63 > qlo) {
            const float NEG = -__builtin_inff(); const int dq = qm - kb;
#pragma unroll
            for (int r = 0; r < 16; ++r) { const int c = (r & 3) + 8 * (r >> 2); if (dq - c < 0) p0[r] = NEG; if (dq - c - 32 < 0) p1[r] = NEG; }
        }
        float pmax = p0[0];
#pragma unroll
        for (int r = 1; r < 16; ++r) pmax = fmaxf(pmax, p0[r]);
#pragma unroll
        for (int r = 0; r < 16; ++r) pmax = fmaxf(pmax, p1[r]);
        { auto rr = __builtin_amdgcn_permlane32_swap(__float_as_uint(pmax), __float_as_uint(pmax), false, false);
          pmax = fmaxf(__uint_as_float(rr[0]), __uint_as_float(rr[1])); }
        float mn, alpha;
        if (__builtin_expect(__all(pmax - m_reg <= 8.f), 1)) { mn = m_reg; alpha = 1.f; }
        else { mn = fmaxf(m_reg, pmax); alpha = __builtin_amdgcn_exp2f(m_reg - mn); m_reg = mn; }
        float ps = 0.f;
#pragma unroll
        for (int r = 0; r < 16; ++r) { p0[r] = __builtin_amdgcn_exp2f(p0[r] - mn); ps += p0[r]; }
#pragma unroll
        for (int r = 0; r < 16; ++r) { p1[r] = __builtin_amdgcn_exp2f(p1[r] - mn); ps += p1[r]; }
        { auto rr = __builtin_amdgcn_permlane32_swap(__float_as_uint(ps), __float_as_uint(ps), false, false);
          ps = __uint_as_float(rr[0]) + __uint_as_float(rr[1]); }
        l_reg = l_reg * alpha + ps;
        bf16x8 pa0, pa1, pa2, pa3;
#define ATT_PK4(P, B_, OUT) do { unsigned a0 = cvtpk(P[B_+0], P[B_+1]), a1 = cvtpk(P[B_+2], P[B_+3]); unsigned b0_ = cvtpk(P[B_+4], P[B_+5]), b1_ = cvtpk(P[B_+6], P[B_+7]); \
        auto r0 = __builtin_amdgcn_permlane32_swap(a0, b0_, false, false); auto r1 = __builtin_amdgcn_permlane32_swap(a1, b1_, false, false); \
        u32x4 w = {r0[0], r1[0], r0[1], r1[1]}; OUT = *reinterpret_cast<bf16x8*>(&w); } while (0)
        ATT_PK4(p0, 0, pa0); ATT_PK4(p0, 8, pa1); ATT_PK4(p1, 0, pa2); ATT_PK4(p1, 8, pa3);
        if (__any(alpha < 1.f)) {
            if (hi == 0) wsl[r32] = alpha;
            asm volatile("s_waitcnt lgkmcnt(0)" ::: "memory");
#pragma unroll
            for (int g = 0; g < 4; ++g) { const f32x4 al = *(const ALAS f32x4*)(wsl + 8 * g + 4 * hi);
#pragma unroll
                for (int d = 0; d < 4; ++d)
#pragma unroll
                    for (int e = 0; e < 4; ++e) o[d][4 * g + e] *= al[e]; }
        }
#define ATT_TRRD(dst, off) asm volatile("ds_read_b64_tr_b16 %0, %1 offset:%2" : "=&v"(dst) : "v"(vbb), "i"(off) : "memory")
#define ATT_PV(d0) do { s16x4 l0, l1, l2, l3, h0, h1, h2, h3; constexpr int b_ = (d0) * 512; \
        ATT_TRRD(l0, b_); ATT_TRRD(h0, b_ + 2048); ATT_TRRD(l1, b_ + 4096); ATT_TRRD(h1, b_ + 6144); ATT_TRRD(l2, b_ + 8192); ATT_TRRD(h2, b_ + 10240); ATT_TRRD(l3, b_ + 12288); ATT_TRRD(h3, b_ + 14336); \
        asm volatile("s_waitcnt lgkmcnt(0)" ::: "memory"); ASBAR(); \
        o[d0] = __builtin_amdgcn_mfma_f32_32x32x16_bf16(pa0, (bf16x8){l0[0], l0[1], l0[2], l0[3], h0[0], h0[1], h0[2], h0[3]}, o[d0], 0, 0, 0); \
        o[d0] = __builtin_amdgcn_mfma_f32_32x32x16_bf16(pa1, (bf16x8){l1[0], l1[1], l1[2], l1[3], h1[0], h1[1], h1[2], h1[3]}, o[d0], 0, 0, 0); \
        o[d0] = __builtin_amdgcn_mfma_f32_32x32x16_bf16(pa2, (bf16x8){l2[0], l2[1], l2[2], l2[3], h2[0], h2[1], h2[2], h2[3]}, o[d0], 0, 0, 0); \
        o[d0] = __builtin_amdgcn_mfma_f32_32x32x16_bf16(pa3, (bf16x8){l3[0], l3[1], l3[2], l3[3], h3[0], h3[1], h3[2], h3[3]}, o[d0], 0, 0, 0); } while (0)
        { const int vbb = vb0 + buf * SHM_V; __builtin_amdgcn_s_setprio(1); ATT_PV(0); ATT_PV(1); ATT_PV(2); ATT_PV(3); __builtin_amdgcn_s_setprio(0); }
        if (t + 1 < NT) ATT_WRITE(buf ^ 1);
    }
    if (hi == 0) wsl[r32] = l_reg;
    asm volatile("s_waitcnt lgkmcnt(0)" ::: "memory");
#pragma unroll
    for (int r = 0; r < 16; ++r) {
        const int orow = crow(r, hi); const float rli = __builtin_amdgcn_rcpf(wsl[orow]);
        bf16_t* rowp = gout + (size_t)(qlo + orow) * 4096; const bf16_t* growp = gate + (size_t)(qlo + orow) * 4096;
#pragma unroll
        for (int d0 = 0; d0 < 4; ++d0) {
            const float v = o[d0][r] * rli; const float vn = __shfl_xor(v, 1);
            if ((r32 & 1) == 0) { unsigned* gp = (unsigned*)(rowp + d0 * 32 + r32); const unsigned g = *(const unsigned*)(growp + d0 * 32 + r32);
                *gp = cvtpk(v * __uint_as_float(g << 16), vn * __uint_as_float(g & 0xffff0000u)); }
        }
    }
    __syncthreads();
#undef ATT_LOAD
#undef ATT_WRITE
#undef ATT_PK4
#undef ATT_TRRD
#undef ATT_PV
}
}
using pg8::bf16_t; using pg8::f32x4; using pg8::u32x4;
#define LAS __attribute__((address_space(3)))
constexpr int S = 8192, DM = 2048, INW = 11344, INWP = 11520;
constexpr float EPS = 1e-6f;
constexpr size_t MiB = 1u << 20;

__device__ __forceinline__ float bf2f(bf16_t v) { return __uint_as_float(((unsigned)v) << 16); }
__device__ __forceinline__ bf16_t f2bf(float f) { unsigned u = __float_as_uint(f); u += 0x7fffu + ((u >> 16) & 1u); return (bf16_t)(u >> 16); }
__device__ __forceinline__ unsigned pk2(float lo, float hi) { return (unsigned)f2bf(lo) | ((unsigned)f2bf(hi) << 16); }
__device__ __forceinline__ float wave_sum(float v) {
#pragma unroll
    for (int o = 32; o >= 1; o >>= 1) v += __shfl_xor(v, o);
    return v;
}
__device__ __forceinline__ float wave_max(float v) {
#pragma unroll
    for (int o = 32; o >= 1; o >>= 1) v = fmaxf(v, __shfl_xor(v, o));
    return v;
}

__device__ __forceinline__ int opaque_tid() { int t = threadIdx.x; asm volatile("" : "+v"(t)); return t; }

struct Params {
    const float* x; const int* pos; const float *mix_g, *w_in, *b_forget, *b_gate, *q_lat_g, *w_q_up, *kv_lat_g, *w_kv_up, *mla_qg, *mla_kg, *fox_qg, *fox_kg, *w_out, *ffn_g, *w_peer_q, *sub_keys, *peer_u, *peer_v;
    float* out;
    bf16_t *WqT, *WkvT, *WoT, *WpT, *WinT;
    bf16_t *h, *cq, *ckv, *fq, *fk, *fv, *merged, *kpe, *qa, *va, *ka;
    float *lf, *F, *x1, *scores;
    unsigned char *U8, *V8; bf16_t* attout;
    unsigned* ctl;
    float2* ropeT; float* ssq;
};

struct DstId { __device__ __forceinline__ int operator()(int n) const { return n; } };
struct DstWin { __device__ __forceinline__ int operator()(int n) const {
    if (n < 1024) return n; if (n < 1088) { const int r = n - 1024; return 11264 + 2 * (r & 31) + (r >> 5); } if (n < 7232) return n - 64; if (n < 7248) return 11264 + 64 + (n - 7232); return n - 80; } };
struct DstQ { __device__ __forceinline__ int operator()(int n) const {
    const int h = n / 192, d = n - h * 192; if (d < 128) return h * 256 + d; const int r = d - 128; return h * 256 + 128 + 2 * (r & 31) + (r >> 5); } };
template <class Dst>
__device__ __forceinline__ void transpose_item(const float* __restrict__ W, int K, int N, bf16_t* __restrict__ WT, Dst dst, float* scr, int item, int lane, const float* __restrict__ gk = nullptr) {
    const int nblk = (N + 31) / 32, kb = item / nblk, nb = item % nblk, k0 = 64 * kb, n0 = 32 * nb;
    { const int rr = lane >> 3, c4 = (lane & 7) * 4; const bool ok = (n0 + c4) < N;
      f32x4 v[8];
#pragma unroll
      for (int i = 0; i < 8; ++i) v[i] = ok ? *(const f32x4*)(W + (size_t)(k0 + 8 * i + rr) * N + n0 + c4) : (f32x4){0.f, 0.f, 0.f, 0.f};
      if (gk) {
#pragma unroll
          for (int i = 0; i < 8; ++i) v[i] *= gk[k0 + 8 * i + rr]; }
#pragma unroll
      for (int i = 0; i < 8; ++i) { float* sp = scr + (8 * i + rr) * 33 + c4; sp[0] = v[i][0]; sp[1] = v[i][1]; sp[2] = v[i][2]; sp[3] = v[i][3]; } }
    asm volatile("s_waitcnt lgkmcnt(0)" ::: "memory");
    const int c = lane & 7;
#pragma unroll
    for (int j = 0; j < 4; ++j) { const int nl = (lane >> 3) + 8 * j, n = n0 + nl; const float* s = scr + (8 * c) * 33 + nl;
        u32x4 o; o.x = pk2(s[0 * 33], s[1 * 33]); o.y = pk2(s[2 * 33], s[3 * 33]); o.z = pk2(s[4 * 33], s[5 * 33]); o.w = pk2(s[6 * 33], s[7 * 33]);
        if (n < N) *(u32x4*)(WT + (size_t)dst(n) * K + k0 + 8 * c) = o; }
    asm volatile("s_waitcnt lgkmcnt(0)" ::: "memory");
}
__device__ __forceinline__ void wfold_item(const float* __restrict__ wq, const float* __restrict__ keys, bf16_t* __restrict__ WpT, float* sm, int item) {
    const int tid = opaque_tid(), hc = item >> 5, d0 = (item & 31) * 64;
    float* keysL = sm; float* wqL = sm + 128 * 132;
    for (int idx = tid; idx < 128 * 32; idx += 512) { const int r = idx >> 5, c4 = (idx & 31) * 4; *(f32x4*)(keysL + r * 132 + c4) = *(const f32x4*)(keys + (size_t)hc * 16384 + r * 128 + c4); }
    for (int idx = tid; idx < 64 * 32; idx += 512) { const int r = idx >> 5, c4 = (idx & 31) * 4; *(f32x4*)(wqL + r * 132 + c4) = *(const f32x4*)(wq + (size_t)(d0 + r) * 2048 + hc * 128 + c4); }
    __syncthreads();
    const int n2 = (tid & 63) * 2, dg = tid >> 6;
    float acc[2][8];
#pragma unroll
    for (int a = 0; a < 2; ++a)
#pragma unroll
        for (int i = 0; i < 8; ++i) acc[a][i] = 0.f;
#pragma unroll 2
    for (int j4 = 0; j4 < 32; ++j4) {
        const f32x4 k0v = *(const f32x4*)(keysL + n2 * 132 + 4 * j4), k1v = *(const f32x4*)(keysL + (n2 + 1) * 132 + 4 * j4);
#pragma unroll
        for (int i = 0; i < 8; ++i) { const f32x4 w = *(const f32x4*)(wqL + (dg * 8 + i) * 132 + 4 * j4);
            acc[0][i] += (k0v[0] * w[0] + k0v[1] * w[1]) + (k0v[2] * w[2] + k0v[3] * w[3]);
            acc[1][i] += (k1v[0] * w[0] + k1v[1] * w[1]) + (k1v[2] * w[2] + k1v[3] * w[3]); }
    }
#pragma unroll
    for (int a = 0; a < 2; ++a) { u32x4 o; o.x = pk2(acc[a][0], acc[a][1]); o.y = pk2(acc[a][2], acc[a][3]); o.z = pk2(acc[a][4], acc[a][5]); o.w = pk2(acc[a][6], acc[a][7]);
        *(u32x4*)(WpT + (size_t)(hc * 128 + n2 + a) * 2048 + d0 + dg * 8) = o; }
    __syncthreads();
}
__device__ __forceinline__ void rms_row2048(const float* __restrict__ xr, const float* __restrict__ g, bf16_t* __restrict__ orow, int lane) {
    f32x4 v[8]; float ss = 0.f;
#pragma unroll
    for (int j = 0; j < 8; ++j) { v[j] = *(const f32x4*)(xr + j * 256 + lane * 4); ss += (v[j][0] * v[j][0] + v[j][1] * v[j][1]) + (v[j][2] * v[j][2] + v[j][3] * v[j][3]); }
    const float r = rsqrtf(wave_sum(ss) * (1.f / 2048.f) + EPS);
#pragma unroll
    for (int j = 0; j < 8; ++j) { const f32x4 gg = *(const f32x4*)(g + j * 256 + lane * 4);
        uint2 o; o.x = pk2(v[j][0] * r * gg[0], v[j][1] * r * gg[1]); o.y = pk2(v[j][2] * r * gg[2], v[j][3] * r * gg[3]);
        *(uint2*)(orow + j * 256 + lane * 4) = o; }
}
__device__ __forceinline__ void fox_cumsum(double* part, int h, const float* __restrict__ lf, float* __restrict__ F) {
    const int tid = opaque_tid(), lane = tid & 63, wave = tid >> 6;
    float v[16]; double sum = 0.0;
#pragma unroll
    for (int i = 0; i < 16; ++i) { v[i] = lf[(size_t)(tid * 16 + i) * 16 + h]; sum += (double)v[i]; }
    double inc = sum;
#pragma unroll
    for (int o = 1; o < 64; o <<= 1) { const double n = __shfl_up(inc, o); if (lane >= o) inc += n; }
    if (lane == 63) part[wave] = inc;
    __syncthreads();
    double base = 0.0;
    for (int w = 0; w < wave; ++w) base += part[w];
    double run = base + inc - sum;
#pragma unroll
    for (int i = 0; i < 16; ++i) { run += (double)v[i]; F[(size_t)h * S + tid * 16 + i] = (float)(run * 1.4426950408889634); }
    __syncthreads();
}
__device__ __forceinline__ void rope_table(const int* __restrict__ pos, float2* __restrict__ ropeT, int gtid, int nthreads) {
    for (int idx = gtid; idx < S * 32; idx += nthreads) { const int t = idx >> 5, i = idx & 31;
        const double inv = exp(-(double)i * (1.0 / 32.0) * 9.210340371976184);
        double ang = (double)((float)pos[t] * (float)inv);
        const double twopi = 6.283185307179586;
        ang -= twopi * rint(ang / twopi);
        ropeT[idx] = make_float2(cosf((float)ang), sinf((float)ang)); }
}
typedef float f32x2 __attribute__((ext_vector_type(2)));
__device__ __forceinline__ unsigned pk4_fp8(float a, float b, float c, float d) {
    int w = __builtin_amdgcn_cvt_pk_fp8_f32(fminf(fmaxf(a, -448.f), 448.f), fminf(fmaxf(b, -448.f), 448.f), 0, false);
    w = __builtin_amdgcn_cvt_pk_fp8_f32(fminf(fmaxf(c, -448.f), 448.f), fminf(fmaxf(d, -448.f), 448.f), w, true); return (unsigned)w; }
__device__ __forceinline__ void cvt_rows_fp8(const float* __restrict__ src, unsigned char* __restrict__ dst, size_t n, float scale, int gw, int NGW, int lane) {
    const size_t nchunk = n / 1024;
    for (size_t c = gw; c < nchunk; c += NGW) { const size_t o = c * 1024 + lane * 16;
        f32x4 a[4];
#pragma unroll
        for (int q = 0; q < 4; ++q) a[q] = *(const f32x4*)(src + o + 4 * q) * scale;
        u32x4 w; w.x = pk4_fp8(a[0][0], a[0][1], a[0][2], a[0][3]); w.y = pk4_fp8(a[1][0], a[1][1], a[1][2], a[1][3]);
        w.z = pk4_fp8(a[2][0], a[2][1], a[2][2], a[2][3]); w.w = pk4_fp8(a[3][0], a[3][1], a[3][2], a[3][3]);
        *(u32x4*)(dst + o) = w; }
}
constexpr float U_SCALE = 64.f, V_SCALE = 4.f;
typedef __bf16 bf16x2_t __attribute__((ext_vector_type(2)));
__device__ __forceinline__ float dot2bf(unsigned a, unsigned b, float c) { return __builtin_amdgcn_fdot2_f32_bf16(__builtin_bit_cast(bf16x2_t, a), __builtin_bit_cast(bf16x2_t, b), c, false); }
#define PEER_INS(top, x) do { float x_ = (x); _Pragma("unroll") for (int i_ = 0; i_ < 16; ++i_) { const float hi_ = fmaxf(top[i_], x_); x_ = fminf(top[i_], x_); top[i_] = hi_; } } while (0)
__device__ __forceinline__ void peer_group(unsigned char* smem, int g, const float* __restrict__ scores, const bf16_t* __restrict__ h2, const float* __restrict__ x1,
                                           const unsigned char* __restrict__ U8, const unsigned char* __restrict__ V8, float* __restrict__ out) {
    const int tid = opaque_tid(), lane = tid & 63, wave = __builtin_amdgcn_readfirstlane(tid >> 6);
    float* topL = (float*)smem;
    int* selE = (int*)(smem + 32768);
    float* selG = (float*)(smem + 49152);
    {
        const int tl = tid >> 4, hc = tid & 15;
        const float* sp = scores + (size_t)(g * 32 + tl) * 2048 + hc * 128;
        float top[16];
#pragma unroll
        for (int i = 0; i < 16; ++i) top[i] = -INFINITY;
#pragma unroll 2
        for (int n0 = 0; n0 < 128; n0 += 4) { const f32x4 v = *(const f32x4*)(sp + n0);
#pragma unroll
            for (int e = 0; e < 4; ++e) PEER_INS(top, __uint_as_float((__float_as_uint(v[e]) & ~0x7Fu) | (unsigned)(n0 + e))); }
        float* tp = topL + (tl * 16 + hc) * 16;
#pragma unroll
        for (int i = 0; i < 16; i += 4) *(f32x4*)(tp + i) = (f32x4){top[i], top[i + 1], top[i + 2], top[i + 3]};
    }
    __syncthreads();
    if (tid < 256) {
        const int tl = tid >> 3, h = tid & 7;
        const float* t1 = topL + (tl * 16 + 2 * h) * 16; const float* t2 = t1 + 16;
        float s1[16], s2[16];
#pragma unroll
        for (int i = 0; i < 16; i += 4) { const f32x4 a = *(const f32x4*)(t1 + i), b2 = *(const f32x4*)(t2 + i);
            s1[i] = a[0]; s1[i + 1] = a[1]; s1[i + 2] = a[2]; s1[i + 3] = a[3]; s2[i] = b2[0]; s2[i + 1] = b2[1]; s2[i + 2] = b2[2]; s2[i + 3] = b2[3]; }
        float ts[16];
#pragma unroll
        for (int i = 0; i < 16; ++i) ts[i] = -INFINITY;
#pragma unroll
        for (int i = 0; i < 16; ++i)
#pragma unroll
            for (int j = 0; j < 16; ++j)
                if ((i + 1) * (j + 1) <= 16) PEER_INS(ts, __uint_as_float((__float_as_uint(s1[i] + s2[j]) & ~0xFFu) | (unsigned)(i * 16 + j)));
        float ex[16], sum = 0.f;
#pragma unroll
        for (int k = 0; k < 16; ++k) { ex[k] = __expf(ts[k] - ts[0]); sum += ex[k]; }
        const float inv = 1.f / sum;
#pragma unroll
        for (int k = 0; k < 16; ++k) { const unsigned pos = __float_as_uint(ts[k]) & 0xFFu;
            const int i1 = (int)(__float_as_uint(t1[pos >> 4]) & 0x7Fu), i2 = (int)(__float_as_uint(t2[pos & 15]) & 0x7Fu);
            selE[tl * 128 + h * 16 + k] = i1 * 128 + i2; selG[tl * 128 + h * 16 + k] = ex[k] * inv; }
    }
    __syncthreads();
    const int grp = lane >> 4, l16 = lane & 15, tl = wave * 4 + grp;
    unsigned* sortK = (unsigned*)(smem + 65536) + tl * 128;
    float* wS = (float*)(smem + 81920) + tl * 128;
    unsigned* hist = (unsigned*)(smem + 98304) + wave * 512 + grp * 64;
    {
#pragma unroll
        for (int i = 0; i < 4; ++i) hist[l16 * 4 + i] = 0u;
        asm volatile("s_waitcnt lgkmcnt(0)" ::: "memory");
        unsigned ek[8], rk[8];
#pragma unroll
        for (int j = 0; j < 8; ++j) { ek[j] = (unsigned)selE[tl * 128 + l16 + 16 * j]; rk[j] = atomicAdd(&hist[ek[j] >> 8], 1u); }
        asm volatile("s_waitcnt lgkmcnt(0)" ::: "memory");
        unsigned c[4], tot = 0u;
#pragma unroll
        for (int i = 0; i < 4; ++i) { c[i] = hist[l16 * 4 + i]; tot += c[i]; }
        unsigned inc = tot;
#pragma unroll
        for (int o = 1; o < 16; o <<= 1) { const unsigned n = __shfl_up(inc, o, 16); if (l16 >= o) inc += n; }
        unsigned run = inc - tot;
#pragma unroll
        for (int i = 0; i < 4; ++i) { hist[256 + l16 * 4 + i] = run; run += c[i]; }
        asm volatile("s_waitcnt lgkmcnt(0)" ::: "memory");
#pragma unroll
        for (int j = 0; j < 8; ++j) sortK[hist[256 + (ek[j] >> 8)] + rk[j]] = (ek[j] << 7) | (unsigned)(l16 + 16 * j);
    }
    __syncthreads();
    const size_t tok = (size_t)g * 32 + tl;
    {
        f32x2 hp[64];
#pragma unroll
        for (int j = 0; j < 8; ++j)
#pragma unroll
            for (int q = 0; q < 2; ++q) { const u32x4 w = *(const u32x4*)(h2 + tok * DM + j * 256 + l16 * 16 + q * 8);
#pragma unroll
                for (int c = 0; c < 4; ++c) hp[j * 8 + q * 4 + c] = (f32x2){__uint_as_float(w[c] << 16), __uint_as_float(w[c] & 0xffff0000u)}; }
        for (int it = 0; it < 128; it += 2) {
            const unsigned key0 = sortK[it], key1 = sortK[it + 1];
            u32x4 ur[2][8];
#pragma unroll
            for (int j = 0; j < 8; ++j) ur[0][j] = *(const u32x4*)(U8 + (size_t)(key0 >> 7) * DM + j * 256 + l16 * 16);
#pragma unroll
            for (int j = 0; j < 8; ++j) ur[1][j] = *(const u32x4*)(U8 + (size_t)(key1 >> 7) * DM + j * 256 + l16 * 16);
#pragma unroll
            for (int p = 0; p < 2; ++p) { f32x2 a2 = (f32x2){0.f, 0.f}, b2 = (f32x2){0.f, 0.f};
#pragma unroll
                for (int j = 0; j < 8; ++j)
#pragma unroll
                    for (int c = 0; c < 4; ++c) { const int w = (int)ur[p][j][c];
                        a2 = __builtin_elementwise_fma(hp[j * 8 + 2 * c], __builtin_amdgcn_cvt_pk_f32_fp8(w, false), a2);
                        b2 = __builtin_elementwise_fma(hp[j * 8 + 2 * c + 1], __builtin_amdgcn_cvt_pk_f32_fp8(w, true), b2); }
                float d = (a2.x + a2.y) + (b2.x + b2.y);
                d += __shfl_xor(d, 8); d += __shfl_xor(d, 4); d += __shfl_xor(d, 2); d += __shfl_xor(d, 1);
                const float a = d * (1.f / U_SCALE); const unsigned key = p ? key1 : key0;
                const float w = selG[tl * 128 + (key & 127u)] * 0.5f * a * (1.f + erff(a * 0.70710678118654752f)) * (1.f / V_SCALE);
                if (l16 == 0) wS[it + p] = w; }
        }
    }
    __syncthreads();
    {
        f32x2 acc[64];
#pragma unroll
        for (int c = 0; c < 64; ++c) acc[c] = (f32x2){0.f, 0.f};
        for (int it = 0; it < 128; it += 2) {
            const unsigned key0 = sortK[it], key1 = sortK[it + 1];
            u32x4 vr[2][8];
#pragma unroll
            for (int j = 0; j < 8; ++j) vr[0][j] = *(const u32x4*)(V8 + (size_t)(key0 >> 7) * DM + j * 256 + l16 * 16);
#pragma unroll
            for (int j = 0; j < 8; ++j) vr[1][j] = *(const u32x4*)(V8 + (size_t)(key1 >> 7) * DM + j * 256 + l16 * 16);
#pragma unroll
            for (int p = 0; p < 2; ++p) { const float w = wS[it + p]; const f32x2 w2 = (f32x2){w, w};
#pragma unroll
                for (int j = 0; j < 8; ++j)
#pragma unroll
                    for (int c = 0; c < 4; ++c) { const int x = (int)vr[p][j][c];
                        acc[j * 8 + 2 * c] = __builtin_elementwise_fma(w2, __builtin_amdgcn_cvt_pk_f32_fp8(x, false), acc[j * 8 + 2 * c]);
                        acc[j * 8 + 2 * c + 1] = __builtin_elementwise_fma(w2, __builtin_amdgcn_cvt_pk_f32_fp8(x, true), acc[j * 8 + 2 * c + 1]); } }
        }
#pragma unroll
        for (int j = 0; j < 8; ++j)
#pragma unroll
            for (int q = 0; q < 4; ++q) { const size_t o = tok * DM + j * 256 + l16 * 16 + q * 4;
                const f32x4 a = *(const f32x4*)(x1 + o);
                *(f32x4*)(out + o) = (f32x4){a[0] + acc[j * 8 + 2 * q].x, a[1] + acc[j * 8 + 2 * q].y, a[2] + acc[j * 8 + 2 * q + 1].x, a[3] + acc[j * 8 + 2 * q + 1].y}; }
    }
    __syncthreads();
}

#define XB_TMO      128
#define XB_XCNT(j)  (256  + 64 * (j))
#define XB_XSUB(j)  (1280 + 64 * (j))
#define XB_XGEN(j)  (2304 + 64 * (j))
#define XB_TOP      3328
#define XB_TOPGEN   3392
#define XCD_BAR_WORDS 3456
#define XB_SPIN_CAP (1u << 18)

__device__ __forceinline__ unsigned xb_ld(unsigned* p)              { return __hip_atomic_load(p, __ATOMIC_RELAXED, __HIP_MEMORY_SCOPE_AGENT); }
__device__ __forceinline__ unsigned xb_add(unsigned* p, unsigned v) { return __hip_atomic_fetch_add(p, v, __ATOMIC_RELAXED, __HIP_MEMORY_SCOPE_AGENT); }
__device__ __forceinline__ unsigned xb_xcc_id() { return (unsigned)__builtin_amdgcn_s_getreg((3 << 11) | 20) & 0xFu; }
#define XB_SPIN(cond, bar) do { unsigned _sp = 0; while (cond) { __builtin_amdgcn_s_sleep(1); \
    if ((++_sp & 255u) == 0u) { if (xb_ld(&(bar)[XB_TMO])) break; if (_sp > XB_SPIN_CAP) { atomicAdd(&(bar)[XB_TMO], 1u); break; } } } } while (0)

struct XcdBarrier {
    unsigned* bar; unsigned x;
    volatile LAS unsigned* st;
};

__device__ __forceinline__ XcdBarrier xcd_barrier_post(unsigned* bar, volatile LAS unsigned* st) {
    XcdBarrier b; b.bar = bar; b.x = xb_xcc_id(); b.st = st;
    if (threadIdx.x == 0) (void)xb_add(&bar[XB_XCNT(b.x)], 1u);
    return b;
}
__device__ __forceinline__ void xcd_barrier_complete(unsigned* bar, unsigned x, unsigned& nloc, unsigned& nx) {
    const unsigned G = gridDim.x * gridDim.y * gridDim.z;
    unsigned sum, cnt, mine, sp = 0u;
    for (;;) {
        sum = 0u; cnt = 0u; mine = 0u;
#pragma unroll
        for (unsigned j = 0; j < 16; ++j) { const unsigned c = xb_ld(&bar[XB_XCNT(j)]); sum += c; cnt += (c > 0u) ? 1u : 0u; mine = (j == x) ? c : mine; }
        if (sum == G) break;
        __builtin_amdgcn_s_sleep(1);
        if ((++sp & 255u) == 0u) { if (xb_ld(&bar[XB_TMO])) break; if (sp > XB_SPIN_CAP) { atomicAdd(&bar[XB_TMO], 1u); break; } }
    }
    nloc = mine > 0u ? mine : 1u; nx = cnt > 0u ? cnt : 1u;
}

__device__ __forceinline__ void xcd_barrier(const XcdBarrier& b) {
    asm volatile("s_waitcnt vmcnt(0)" ::: "memory");
    __syncthreads();
    if (threadIdx.x == 0) {
        unsigned* bar = b.bar;
        __builtin_amdgcn_s_waitcnt(0);
        unsigned nloc = b.st[0], nx = b.st[1];
        if (nloc == 0u) { xcd_barrier_complete(bar, b.x, nloc, nx); b.st[0] = nloc; b.st[1] = nx; }
        const unsigned old = xb_add(&bar[XB_XSUB(b.x)], 1u);
        const unsigned gen = old / nloc;
        if (old + 1u == (gen + 1u) * nloc) {
            __builtin_amdgcn_fence(__ATOMIC_RELEASE, "agent");
            asm volatile("s_waitcnt vmcnt(0)" ::: "memory");
            const unsigned og = xb_add(&bar[XB_TOP], 1u);
            const unsigned tg = og / nx;
            if (og + 1u == (tg + 1u) * nx) xb_add(&bar[XB_TOPGEN], 1u);
            else XB_SPIN(xb_ld(&bar[XB_TOPGEN]) == tg, bar);
            __builtin_amdgcn_fence(__ATOMIC_ACQUIRE, "agent");
            xb_add(&bar[XB_XGEN(b.x)], 1u);
            asm volatile("s_waitcnt vmcnt(0)" ::: "memory");
        } else {
            XB_SPIN(xb_ld(&bar[XB_XGEN(b.x)]) == gen, bar);
            __builtin_amdgcn_fence(__ATOMIC_ACQUIRE, "agent");
            asm volatile("s_waitcnt vmcnt(0)" ::: "memory");
        }
    }
    __syncthreads();
}

#define PROBE_DOUBLE 0
#define REP(k) for (int rep_ = 0; rep_ < ((PROBE_DOUBLE == (k)) ? 2 : 1); ++rep_)
constexpr int LDS_BYTES = 147456;
__global__ __launch_bounds__(512, 2) void mega(Params p) {
    extern __shared__ __attribute__((aligned(16))) unsigned char smem[];
    { volatile LAS unsigned* st0 = (volatile LAS unsigned*)((LAS unsigned char*)smem + 131072); if (threadIdx.x < 2) st0[threadIdx.x] = 0u; }
    __syncthreads();
    const XcdBarrier bar = xcd_barrier_post(p.ctl, (volatile LAS unsigned*)((LAS unsigned char*)smem + 131072));
    float* smf = (float*)smem;
    LAS unsigned char* lds = (LAS unsigned char*)smem;
    const int G = gridDim.x, b = blockIdx.x, NGW = G * 8;
#define PHASE_IDS() const int tid = opaque_tid(), lane = tid & 63, wave = __builtin_amdgcn_readfirstlane(tid >> 6), gw = b * 8 + wave; (void)lane; (void)gw

    REP(7) {
        PHASE_IDS();
        float* scr = smf + wave * 4096;
        constexpr int dummy_ = 0; (void)dummy_;
        constexpr int I_IN = 32 * 355, I_Q = 8 * 96, I_KV = 8 * 128, I_O = 64 * 64;
        for (int it = gw; it < I_IN + I_Q + I_KV + I_O; it += NGW) {
            int r = it;
            if (r < I_IN) { transpose_item(p.w_in, 2048, INW, p.WinT, DstWin(), scr, r, lane); continue; } r -= I_IN;
            if (r < I_Q) { transpose_item(p.w_q_up, 512, 3072, p.WqT, DstQ(), scr, r, lane, p.q_lat_g); continue; } r -= I_Q;
            if (r < I_KV) { transpose_item(p.w_kv_up, 512, 4096, p.WkvT, DstId(), scr, r, lane, p.kv_lat_g); continue; } r -= I_KV;
            transpose_item(p.w_out, 4096, 2048, p.WoT, DstId(), scr, r, lane);
        }
        for (int m = gw; m < S; m += NGW) rms_row2048(p.x + (size_t)m * DM, p.mix_g, p.h + (size_t)m * DM, lane);
        for (int idx = b * 512 + tid; idx < 16 * 64 * 64; idx += G * 512) { const int hh = idx >> 12, rr = (idx >> 6) & 63, c8 = idx & 63;
            *(u32x4*)(p.WqT + (size_t)(hh * 256 + 192 + rr) * 512 + c8 * 8) = (u32x4){0u, 0u, 0u, 0u}; }
        rope_table(p.pos, p.ropeT, b * 512 + tid, G * 512);
        __syncthreads();
        for (int it = b; it < 512; it += G) wfold_item(p.w_peer_q, p.sub_keys, p.WpT, smf, it);
    }
    xcd_barrier(bar);
    REP(1) {
        pg8::Gemm g{p.h, p.WinT, S, INWP, DM}; pg8::StaticOrder so; so.init(S, INWP, G, b);
        pg8::EpiInProj E{p.cq, p.ckv, p.fq, p.fk, p.fv, p.merged, p.kpe, p.lf, p.b_gate, p.b_forget, p.ssq, p.fox_qg, p.fox_kg, (LAS float*)(lds + 131072 + 64)};
        pg8::gemm_phase<pg8::EpiInProj, pg8::StaticOrder, true, true>(lds, g, so, E);
    }
    xcd_barrier(bar);
    for (int hh = b; hh < 16; hh += G) fox_cumsum((double*)smem, hh, p.lf, p.F);
    REP(2) {
        pg8::Gemm g{p.cq, p.WqT, S, 4096, 512}; pg8::StaticOrder so; so.init(S, 4096, G, b);
        pg8::EpiQ E{p.qa, p.ssq, p.mla_qg, p.ropeT, (LAS float*)(lds + 131072 + 64)};
        pg8::gemm_phase<pg8::EpiQ, pg8::StaticOrder, true, true>(lds, g, so, E);
    }
    {
        pg8::Gemm g{p.ckv, p.WkvT, S, 4096, 512}; pg8::StaticOrder so; so.init(S, 4096, G, b);
        pg8::EpiKV E{p.ka, p.va, p.kpe, p.ssq, p.mla_kg, p.ropeT, (LAS float*)(lds + 131072 + 64)};
        pg8::gemm_phase<pg8::EpiKV, pg8::StaticOrder, true, true>(lds, g, so, E);
    }
    xcd_barrier(bar);
    REP(3) for (int L = b; L < 1024; L += G) {
        const int i = L >> 8, vc = L & 255, vcx = (vc & 7) * 32 + (vc >> 3), hh = vcx >> 4, x = vcx & 15, qbk = (i & 1) ? x : 31 - x;
        if (i < 2) att::attn_block<192, false>(smem, p.qa + hh * 192, 3072, p.ka + hh * 192, 3072, p.va + hh * 128, 2048, nullptr, p.merged + hh * 128, p.attout + hh * 128, qbk, nullptr, nullptr);
        else att::attn_block<128, true>(smem, p.fq + hh * 128, 2048, p.fk + hh * 128, 2048, p.fv + hh * 128, 2048, p.F + (size_t)hh * S, p.merged + 2048 + hh * 128, p.attout + 2048 + hh * 128, qbk, p.fox_qg, p.fox_kg);
    }
    xcd_barrier(bar);
    REP(4) {
        pg8::Gemm g{p.attout, p.WoT, S, 2048, 4096}; pg8::StaticOrder so; so.init(S, 2048, G, b);
        pg8::EpiStoreF32<true> E{p.x1, p.x, 2048};
        pg8::gemm_phase<pg8::EpiStoreF32<true>, pg8::StaticOrder, true, true>(lds, g, so, E);
    }
    xcd_barrier(bar);
    { PHASE_IDS(); for (int m = gw; m < S; m += NGW) rms_row2048(p.x1 + (size_t)m * DM, p.ffn_g, p.h + (size_t)m * DM, lane);
      cvt_rows_fp8(p.peer_u, p.U8, (size_t)16384 * 2048, U_SCALE, gw, NGW, lane); cvt_rows_fp8(p.peer_v, p.V8, (size_t)16384 * 2048, V_SCALE, gw, NGW, lane); }
    xcd_barrier(bar);
    REP(5) {
        pg8::Gemm g{p.h, p.WpT, S, 2048, 2048}; pg8::StaticOrder so; so.init(S, 2048, G, b);
        pg8::EpiStoreF32<false> E{p.scores, nullptr, 2048};
        pg8::gemm_phase<pg8::EpiStoreF32<false>, pg8::StaticOrder, true, true>(lds, g, so, E);
    }
    xcd_barrier(bar);
    REP(6) for (int g = b; g < S / 32; g += G) peer_group(smem, g, p.scores, p.h, p.x1, p.U8, p.V8, p.out);
}

extern "C" void kernel_launch(void* const* d_in, const int* in_sizes, int n_in,
                              void* d_out, int out_size, void* d_ws, size_t ws_size,
                              hipStream_t stream) {
    if (ws_size < 512 * MiB) { fprintf(stderr, "kernel_launch: workspace too small (%zu)\n", ws_size); return; }
    Params p{};
    p.x = (const float*)d_in[0]; p.pos = (const int*)d_in[1]; p.mix_g = (const float*)d_in[2]; p.w_in = (const float*)d_in[3];
    p.b_forget = (const float*)d_in[4]; p.b_gate = (const float*)d_in[5]; p.q_lat_g = (const float*)d_in[6]; p.w_q_up = (const float*)d_in[7];
    p.kv_lat_g = (const float*)d_in[8]; p.w_kv_up = (const float*)d_in[9]; p.mla_qg = (const float*)d_in[10]; p.mla_kg = (const float*)d_in[11];
    p.fox_qg = (const float*)d_in[12]; p.fox_kg = (const float*)d_in[13]; p.w_out = (const float*)d_in[14]; p.ffn_g = (const float*)d_in[15];
    p.w_peer_q = (const float*)d_in[16]; p.sub_keys = (const float*)d_in[17]; p.peer_u = (const float*)d_in[18]; p.peer_v = (const float*)d_in[19];
    p.out = (float*)d_out;
    char* ws = (char*)d_ws;
    p.WqT = (bf16_t*)(ws + 1 * MiB); p.WkvT = (bf16_t*)(ws + 5 * MiB); p.WoT = (bf16_t*)(ws + 9 * MiB); p.WpT = (bf16_t*)(ws + 25 * MiB); p.WinT = (bf16_t*)(ws + 33 * MiB);
    p.h = (bf16_t*)(ws + 78 * MiB); p.cq = (bf16_t*)(ws + 110 * MiB); p.ckv = (bf16_t*)(ws + 118 * MiB);
    p.fq = (bf16_t*)(ws + 126 * MiB); p.fk = (bf16_t*)(ws + 158 * MiB); p.fv = (bf16_t*)(ws + 190 * MiB); p.merged = (bf16_t*)(ws + 222 * MiB);
    p.kpe = (bf16_t*)(ws + 286 * MiB); p.lf = (float*)(ws + 287 * MiB); p.F = (float*)(ws + 287 * MiB + 512 * 1024);
    p.qa = (bf16_t*)(ws + 288 * MiB); p.va = (bf16_t*)(ws + 336 * MiB); p.ka = (bf16_t*)(ws + 400 * MiB); p.x1 = (float*)(ws + 448 * MiB);
    p.scores = (float*)(ws + 222 * MiB);
    p.ctl = (unsigned*)ws;
    p.ropeT = (float2*)(ws + 448 * MiB);
    p.ssq = (float*)(ws + 64 * 1024);
    p.attout = (bf16_t*)(ws + 33 * MiB);
    p.U8 = (unsigned char*)(ws + 126 * MiB); p.V8 = (unsigned char*)(ws + 158 * MiB);

    static int grid_blocks = 0;
    if (!grid_blocks) {
        if (hipFuncSetAttribute((const void*)mega, hipFuncAttributeMaxDynamicSharedMemorySize, LDS_BYTES) != hipSuccess) { fprintf(stderr, "hipFuncSetAttribute failed\n"); return; }
        int dev = 0, cus = 0, per_cu = 0;
        (void)hipGetDevice(&dev);
        (void)hipDeviceGetAttribute(&cus, hipDeviceAttributeMultiprocessorCount, dev);
        (void)hipOccupancyMaxActiveBlocksPerMultiprocessor(&per_cu, (const void*)mega, 512, LDS_BYTES);
        if (per_cu < 1 || cus < 1) { fprintf(stderr, "occupancy query says %d blocks/CU on %d CUs\n", per_cu, cus); return; }
        grid_blocks = cus;
    }
    if (hipMemsetAsync(d_ws, 0, 16384, stream) != hipSuccess) { fprintf(stderr, "memset of the barrier words failed\n"); return; }
    void* args[] = {&p};
    hipError_t e = hipLaunchCooperativeKernel((const void*)mega, dim3(grid_blocks), dim3(512), args, LDS_BYTES, stream);
    if (e != hipSuccess) fprintf(stderr, "cooperative launch failed: %s (grid %d)\n", hipGetErrorString(e), grid_blocks);
}
```

```cpp
#include <hip/hip_runtime.h>
#include <hip/hip_cooperative_groups.h>
#include <stdint.h>
#include <math.h>
#include <cstdio>
namespace cg = cooperative_groups;

namespace pg8 {
#define PG8_LAS __attribute__((address_space(3)))
typedef unsigned short bf16_t;
typedef short bf16x8 __attribute__((ext_vector_type(8)));
typedef float f32x4 __attribute__((ext_vector_type(4)));
typedef unsigned u32x4 __attribute__((ext_vector_type(4)));
constexpr int BM = 256, BK = 64, HALF = 128, HTB = HALF * BK * 2  , STAGE_BYTES = 8 * HTB, NXCD = 8, WGM = 8;

__host__ __device__ __forceinline__ int lds_byte(int r, int c) { const int st = (r >> 4) * 2 + (c >> 5), rr = r & 15, cc = c & 31, ob = rr * 64 + cc * 2; return st * 1024 + (ob ^ (((ob >> 9) & 1) << 5)); }
__host__ __device__ __forceinline__ void stage_rc(int b, int& R, int& C) { const int st = b / 1024, sb = b % 1024, swz = sb ^ (((sb >> 9) & 1) << 5); R = (st >> 1) * 16 + swz / 64; C = (st & 1) * 32 + (swz % 64) / 2; }
__host__ __device__ __forceinline__ int perm32(int rho) { const int n = rho >> 4, i = rho & 15; return 8 * (i >> 2) + 4 * n + (i & 3); }

struct Unit { int pm, pn; };
struct Gemm { const bf16_t* A; const bf16_t* Bt; int M, N, K; };

struct StaticOrder {
    int nM, nN, nwg, G, c;
    __host__ __device__ void init(int M, int N, int G_, int c_) { nM = M / BM; nN = N / BM; nwg = nM * nN; G = G_; c = c_; }
    __host__ __device__ bool next(int i, Unit& u) const {
        const long L = (long)i * G + c; if (L >= nwg) return false;
        int wgid = (int)L; { const int q = nwg / NXCD, r = nwg % NXCD, xcd = wgid % NXCD, off = wgid / NXCD; wgid = (xcd < r ? xcd * (q + 1) : r * (q + 1) + (xcd - r) * q) + off; }
        const int nig = WGM * nN, gid = wgid / nig, fm = gid * WGM, gsz = (nM - fm) < WGM ? (nM - fm) : WGM;
        u.pm = fm + ((wgid % nig) % gsz); u.pn = (wgid % nig) / gsz; return true;
    }
    __device__ __forceinline__ void a_ready(const Unit&) const {}
    __device__ __forceinline__ void done(const Unit&) const {}
};

__device__ __forceinline__ unsigned cvt_pk_bf16(float lo, float hi) { unsigned r; asm volatile("v_cvt_pk_bf16_f32 %0, %1, %2" : "=v"(r) : "v"(lo), "v"(hi)); return r; }
__device__ __forceinline__ u32x4 pack8bf(const f32x4& v0, const f32x4& v1) { u32x4 w; w.x = cvt_pk_bf16(v0[0], v0[1]); w.y = cvt_pk_bf16(v0[2], v0[3]); w.z = cvt_pk_bf16(v1[0], v1[1]); w.w = cvt_pk_bf16(v1[2], v1[3]); return w; }

struct EpiStoreBf16 {
    static constexpr bool PERM = true, AFTER_DRAIN = false;
    bf16_t* O; int ldc;
    __device__ __forceinline__ void operator()(const f32x4 (&acc)[2][2][4][2], const Unit& u, int wr, int wc, int fr, int fq) const {
        const int row0 = u.pm * BM + wr * 64 + fr, col0 = u.pn * BM + wc * 32 + 8 * fq;
#pragma unroll
        for (int ai = 0; ai < 2; ++ai)
#pragma unroll
            for (int m = 0; m < 4; ++m) { bf16_t* rowp = O + (size_t)(row0 + ai * HALF + m * 16) * ldc + col0;
#pragma unroll
                for (int bj = 0; bj < 2; ++bj) *(u32x4*)(rowp + bj * HALF) = pack8bf(acc[ai][bj][m][0], acc[ai][bj][m][1]); }
    }
};
template <bool RES> struct EpiStoreF32 {
    static constexpr bool PERM = true, AFTER_DRAIN = false;
    float* O; const float* res; int ldc;
    __device__ __forceinline__ void operator()(const f32x4 (&acc)[2][2][4][2], const Unit& u, int wr, int wc, int fr, int fq) const {
        const int row0 = u.pm * BM + wr * 64 + fr, col0 = u.pn * BM + wc * 32 + 8 * fq;
#pragma unroll
        for (int ai = 0; ai < 2; ++ai)
#pragma unroll
            for (int m = 0; m < 4; ++m) { const size_t off = (size_t)(row0 + ai * HALF + m * 16) * ldc + col0;
#pragma unroll
                for (int bj = 0; bj < 2; ++bj) { f32x4 v0 = acc[ai][bj][m][0], v1 = acc[ai][bj][m][1];
                    if (RES) { v0 += *(const f32x4*)(res + off + bj * HALF); v1 += *(const f32x4*)(res + off + bj * HALF + 4); }
                    *(f32x4*)(O + off + bj * HALF) = v0; *(f32x4*)(O + off + bj * HALF + 4) = v1; } }
    }
};
#define EPI_LDSBAR() do { asm volatile("s_waitcnt lgkmcnt(0)" ::: "memory"); __builtin_amdgcn_s_barrier(); asm volatile("" ::: "memory"); } while (0)
struct EpiInProj {
    static constexpr bool PERM = true, AFTER_DRAIN = false;
    bf16_t *cq, *ckv, *fq, *fk, *fv, *gates, *kpe; float* lf; const float *b_gate, *b_forget; float* ssq; const float *gfq, *gfk; PG8_LAS float* xs;
    __device__ __forceinline__ void operator()(const f32x4 (&acc)[2][2][4][2], const Unit& u, int wr, int wc, int fr, int fq_) const {
        const int pn = u.pn, row0 = u.pm * BM + wr * 64 + fr, cw = wc * 32 + 8 * fq_;
        if (pn < 4) {
            bf16_t* base = pn < 2 ? cq : ckv; const int colt = (pn & 1) * 256;
#pragma unroll
            for (int ai = 0; ai < 2; ++ai)
#pragma unroll
                for (int m = 0; m < 4; ++m) { const int row = row0 + ai * HALF + m * 16; bf16_t* rowp = base + (size_t)row * 512 + colt + cw; float s = 0.f;
#pragma unroll
                    for (int bj = 0; bj < 2; ++bj) { const f32x4 v0 = acc[ai][bj][m][0], v1 = acc[ai][bj][m][1];
                        s += (v0[0] * v0[0] + v0[1] * v0[1]) + (v0[2] * v0[2] + v0[3] * v0[3]) + (v1[0] * v1[0] + v1[1] * v1[1]) + (v1[2] * v1[2] + v1[3] * v1[3]);
                        *(u32x4*)(rowp + bj * HALF) = pack8bf(v0, v1); }
                    s += __shfl_xor(s, 16); s += __shfl_xor(s, 32);
                    if (fq_ == 0) ssq[((size_t)pn * 8192 + row) * 4 + wc] = s; }
        } else if (pn < 20) {
            const bool isq = pn < 12; bf16_t* base = isq ? fq : fk; const int colt = (pn - (isq ? 4 : 12)) * 256; const float* g = isq ? gfq : gfk;
            const float qs = isq ? 0.12751743f : 1.f;
#pragma unroll
            for (int ai = 0; ai < 2; ++ai)
#pragma unroll
                for (int m = 0; m < 4; ++m)
#pragma unroll
                    for (int bj = 0; bj < 2; ++bj) { const f32x4 v0 = acc[ai][bj][m][0], v1 = acc[ai][bj][m][1];
                        float s = (v0[0] * v0[0] + v0[1] * v0[1]) + (v0[2] * v0[2] + v0[3] * v0[3]) + (v1[0] * v1[0] + v1[1] * v1[1]) + (v1[2] * v1[2] + v1[3] * v1[3]);
                        s += __shfl_xor(s, 16); s += __shfl_xor(s, 32);
                        if (fq_ == 0) xs[((ai * HALF + wr * 64 + m * 16 + fr) * 2 + bj) * 4 + wc] = s; }
            EPI_LDSBAR();
            const f32x4 g0 = *(const f32x4*)(g + cw) * qs, g1 = *(const f32x4*)(g + cw + 4) * qs;
#pragma unroll
            for (int ai = 0; ai < 2; ++ai)
#pragma unroll
                for (int m = 0; m < 4; ++m) { bf16_t* rowp = base + (size_t)(row0 + ai * HALF + m * 16) * 2048 + colt + cw;
#pragma unroll
                    for (int bj = 0; bj < 2; ++bj) { const f32x4 t4 = *(const PG8_LAS f32x4*)(xs + ((ai * HALF + wr * 64 + m * 16 + fr) * 2 + bj) * 4);
                        const float r = rsqrtf(((t4[0] + t4[1]) + (t4[2] + t4[3])) * (1.f / 128.f) + 1e-6f);
                        *(u32x4*)(rowp + bj * HALF) = pack8bf(acc[ai][bj][m][0] * g0 * r, acc[ai][bj][m][1] * g1 * r); } }
        } else if (pn < 28) {
            const int colt = (pn - 20) * 256;
#pragma unroll
            for (int ai = 0; ai < 2; ++ai)
#pragma unroll
                for (int m = 0; m < 4; ++m) { bf16_t* rowp = fv + (size_t)(row0 + ai * HALF + m * 16) * 2048 + colt + cw;
#pragma unroll
                    for (int bj = 0; bj < 2; ++bj) *(u32x4*)(rowp + bj * HALF) = pack8bf(acc[ai][bj][m][0], acc[ai][bj][m][1]); }
        } else if (pn < 44) {
            const int colt = (pn - 28) * 256 + cw;
#pragma unroll
            for (int bj = 0; bj < 2; ++bj) {
                const f32x4 b0 = *(const f32x4*)(b_gate + colt + bj * HALF), b1 = *(const f32x4*)(b_gate + colt + bj * HALF + 4);
#pragma unroll
                for (int ai = 0; ai < 2; ++ai)
#pragma unroll
                    for (int m = 0; m < 4; ++m) {
                        f32x4 v0 = acc[ai][bj][m][0] + b0, v1 = acc[ai][bj][m][1] + b1;
#pragma unroll
                        for (int e = 0; e < 4; ++e) { v0[e] = 1.f / (1.f + __expf(-v0[e])); v1[e] = 1.f / (1.f + __expf(-v1[e])); }
                        *(u32x4*)(gates + (size_t)(row0 + ai * HALF + m * 16) * 4096 + colt + bj * HALF) = pack8bf(v0, v1); }
            }
        } else {
            if (cw < 64) {
#pragma unroll
                for (int ai = 0; ai < 2; ++ai)
#pragma unroll
                    for (int m = 0; m < 4; ++m) *(u32x4*)(kpe + (size_t)(row0 + ai * HALF + m * 16) * 64 + cw) = pack8bf(acc[ai][0][m][0], acc[ai][0][m][1]);
            } else if (cw < 80) {
                const int h0 = cw - 64;
                const f32x4 b0 = *(const f32x4*)(b_forget + h0), b1 = *(const f32x4*)(b_forget + h0 + 4);
#pragma unroll
                for (int ai = 0; ai < 2; ++ai)
#pragma unroll
                    for (int m = 0; m < 4; ++m) { const int row = row0 + ai * HALF + m * 16;
                        f32x4 z0 = acc[ai][0][m][0] + b0, z1 = acc[ai][0][m][1] + b1;
#pragma unroll
                        for (int e = 0; e < 4; ++e) { z0[e] = fminf(z0[e], 0.f) - __logf(1.f + __expf(-fabsf(z0[e]))); z1[e] = fminf(z1[e], 0.f) - __logf(1.f + __expf(-fabsf(z1[e]))); }
                        *(f32x4*)(lf + (size_t)row * 16 + h0) = z0; *(f32x4*)(lf + (size_t)row * 16 + h0 + 4) = z1; }
            }
        }
    }
};
__device__ __forceinline__ float lat_rinv(const float* ssq, int part0, int row) {
    const f32x4 a = *(const f32x4*)(ssq + ((size_t)part0 * 8192 + row) * 4), b = *(const f32x4*)(ssq + ((size_t)(part0 + 1) * 8192 + row) * 4);
    return rsqrtf((((a[0] + a[1]) + (a[2] + a[3])) + ((b[0] + b[1]) + (b[2] + b[3]))) * (1.f / 512.f) + 1e-6f);
}
struct EpiQ {
    static constexpr bool PERM = true, AFTER_DRAIN = false;
    bf16_t* qa; const float* ssq; const float* gq; const float2* ropeT; PG8_LAS float* xs;
    __device__ __forceinline__ void operator()(const f32x4 (&acc)[2][2][4][2], const Unit& u, int wr, int wc, int fr, int fq_) const {
        const int h = u.pn, row0 = u.pm * BM + wr * 64 + fr, cw = wc * 32 + 8 * fq_;
        float rl[2][4];
#pragma unroll
        for (int ai = 0; ai < 2; ++ai)
#pragma unroll
            for (int m = 0; m < 4; ++m) { rl[ai][m] = lat_rinv(ssq, 0, row0 + ai * HALF + m * 16); float s = 0.f;
#pragma unroll
                for (int bj = 0; bj < 2; ++bj) { const f32x4 v0 = acc[ai][bj][m][0], v1 = acc[ai][bj][m][1];
                    s += (v0[0] * v0[0] + v0[1] * v0[1]) + (v0[2] * v0[2] + v0[3] * v0[3]) + (v1[0] * v1[0] + v1[1] * v1[1]) + (v1[2] * v1[2] + v1[3] * v1[3]); }
                s *= rl[ai][m] * rl[ai][m];
                s += __shfl_xor(s, 16); s += __shfl_xor(s, 32);
                if (fq_ == 0) xs[(ai * HALF + wr * 64 + m * 16 + fr) * 4 + wc] = s; }
        EPI_LDSBAR();
        const float qs = 0.10411754f;
        const f32x4 g0 = *(const f32x4*)(gq + cw) * qs, g1 = *(const f32x4*)(gq + cw + 4) * qs;
        const int pp = 16 * (wc & 1) + 4 * fq_;
        const f32x4 ga = *(const f32x4*)(gq + 128 + pp) * qs, gb = *(const f32x4*)(gq + 160 + pp) * qs;
#pragma unroll
        for (int ai = 0; ai < 2; ++ai)
#pragma unroll
            for (int m = 0; m < 4; ++m) { const int row = row0 + ai * HALF + m * 16;
                const f32x4 t4 = *(const PG8_LAS f32x4*)(xs + (ai * HALF + wr * 64 + m * 16 + fr) * 4);
                const float r = rsqrtf(((t4[0] + t4[1]) + (t4[2] + t4[3])) * (1.f / 192.f) + 1e-6f) * rl[ai][m];
                bf16_t* rowp = qa + (size_t)row * 3072 + h * 192;
                *(u32x4*)(rowp + cw) = pack8bf(acc[ai][0][m][0] * g0 * r, acc[ai][0][m][1] * g1 * r);
                if (wc < 2) { const f32x4 c01 = *(const f32x4*)(ropeT + (size_t)row * 32 + pp), c23 = *(const f32x4*)(ropeT + (size_t)row * 32 + pp + 2);
                    const f32x4 z0 = acc[ai][1][m][0] * r, z1 = acc[ai][1][m][1] * r;
                    const float a0 = z0[0] * ga[0], b0 = z0[1] * gb[0], a1 = z0[2] * ga[1], b1 = z0[3] * gb[1], a2 = z1[0] * ga[2], b2 = z1[1] * gb[2], a3 = z1[2] * ga[3], b3 = z1[3] * gb[3];
                    const f32x4 o0 = {a0 * c01[0] - b0 * c01[1], a0 * c01[1] + b0 * c01[0], a1 * c01[2] - b1 * c01[3], a1 * c01[3] + b1 * c01[2]};
                    const f32x4 o1 = {a2 * c23[0] - b2 * c23[1], a2 * c23[1] + b2 * c23[0], a3 * c23[2] - b3 * c23[3], a3 * c23[3] + b3 * c23[2]};
                    *(u32x4*)(rowp + 128 + cw) = pack8bf(o0, o1); } }
    }
};
struct EpiKV {
    static constexpr bool PERM = true, AFTER_DRAIN = false;
    bf16_t *ka, *va; const bf16_t* kpe; const float* ssq; const float* gk; const float2* ropeT; PG8_LAS float* xs;
    __device__ __forceinline__ void operator()(const f32x4 (&acc)[2][2][4][2], const Unit& u, int wr, int wc, int fr, int fq_) const {
        const int h = u.pn, row0 = u.pm * BM + wr * 64 + fr, cw = wc * 32 + 8 * fq_;
        float rl[2][4]; f32x4 kp[2][4];
#pragma unroll
        for (int ai = 0; ai < 2; ++ai)
#pragma unroll
            for (int m = 0; m < 4; ++m) { const int row = row0 + ai * HALF + m * 16; rl[ai][m] = lat_rinv(ssq, 2, row);
                const uint2 w = *(const uint2*)(kpe + (size_t)row * 64 + 16 * wc + 4 * fq_);
                kp[ai][m] = (f32x4){__uint_as_float(w.x << 16), __uint_as_float(w.x & 0xffff0000u), __uint_as_float(w.y << 16), __uint_as_float(w.y & 0xffff0000u)};
                const f32x4 v0 = acc[ai][0][m][0], v1 = acc[ai][0][m][1];
                float s = ((v0[0] * v0[0] + v0[1] * v0[1]) + (v0[2] * v0[2] + v0[3] * v0[3]) + (v1[0] * v1[0] + v1[1] * v1[1]) + (v1[2] * v1[2] + v1[3] * v1[3])) * (rl[ai][m] * rl[ai][m]);
                s += (kp[ai][m][0] * kp[ai][m][0] + kp[ai][m][1] * kp[ai][m][1]) + (kp[ai][m][2] * kp[ai][m][2] + kp[ai][m][3] * kp[ai][m][3]);
                s += __shfl_xor(s, 16); s += __shfl_xor(s, 32);
                if (fq_ == 0) xs[(ai * HALF + wr * 64 + m * 16 + fr) * 4 + wc] = s;
                *(u32x4*)(va + (size_t)row * 2048 + h * 128 + cw) = pack8bf(acc[ai][1][m][0] * rl[ai][m], acc[ai][1][m][1] * rl[ai][m]); }
        EPI_LDSBAR();
        const f32x4 g0 = *(const f32x4*)(gk + cw), g1 = *(const f32x4*)(gk + cw + 4);
        const int pp = 8 * wc + 2 * fq_;
        const float ga0 = gk[128 + pp], ga1 = gk[128 + pp + 1], gb0 = gk[160 + pp], gb1 = gk[160 + pp + 1];
#pragma unroll
        for (int ai = 0; ai < 2; ++ai)
#pragma unroll
            for (int m = 0; m < 4; ++m) { const int row = row0 + ai * HALF + m * 16;
                const f32x4 t4 = *(const PG8_LAS f32x4*)(xs + (ai * HALF + wr * 64 + m * 16 + fr) * 4);
                const float r = rsqrtf(((t4[0] + t4[1]) + (t4[2] + t4[3])) * (1.f / 192.f) + 1e-6f), rn = r * rl[ai][m];
                bf16_t* rowp = ka + (size_t)row * 3072 + h * 192;
                *(u32x4*)(rowp + cw) = pack8bf(acc[ai][0][m][0] * g0 * rn, acc[ai][0][m][1] * g1 * rn);
                const f32x4 cs = *(const f32x4*)(ropeT + (size_t)row * 32 + pp);
                const float a0 = kp[ai][m][0] * r * ga0, b0 = kp[ai][m][1] * r * gb0, a1 = kp[ai][m][2] * r * ga1, b1 = kp[ai][m][3] * r * gb1;
                uint2 o; o.x = cvt_pk_bf16(a0 * cs[0] - b0 * cs[1], a0 * cs[1] + b0 * cs[0]); o.y = cvt_pk_bf16(a1 * cs[2] - b1 * cs[3], a1 * cs[3] + b1 * cs[2]);
                *(uint2*)(rowp + 128 + 16 * wc + 4 * fq_) = o; }
    }
};
template <class Epi, class Sched, bool ALIGN_EPI = false, bool SP2 = false>
__device__ __forceinline__ void gemm_phase(PG8_LAS unsigned char* lds, const Gemm g, const Sched& S, const Epi& E) {
    int tid = threadIdx.x; asm volatile("" : "+v"(tid));
    const int wid = __builtin_amdgcn_readfirstlane(tid >> 6), lane = tid & 63, wr = wid >> 2, wc = wid & 3, fr = lane & 15, fq = lane >> 4;
    const int K = g.K, nt = K / BK;
    unsigned voffA[2], voffB[2];
#pragma unroll
    for (int i = 0; i < 2; ++i) { int R, C; stage_rc(tid * 16 + i * 8192, R, C); const int Rb = Epi::PERM ? ((R & ~31) + perm32(R & 31)) : R;
        voffA[i] = (unsigned)(R * K + C) * 2u; voffB[i] = (unsigned)(Rb * K + C) * 2u; }
    const size_t kstep = (size_t)(BK * 2);
    const size_t hstep = (size_t)HALF * K * 2;
    const size_t tstep = 2 * hstep;
    const unsigned ldsw = (unsigned)wid * 1024u;
    const int aoff = lds_byte(wr * 64 + fr, fq * 8), boff = lds_byte(wc * 32 + fr, fq * 8);
#define PG8_SA(b, h) (((b) * 2 + (h)) * HTB)
#define PG8_SB(b, h) ((4 + (b) * 2 + (h)) * HTB)
#define PG8_STAGE(bufoff, gbase, voff) do { _Pragma("unroll") for (int _i = 0; _i < 2; ++_i) \
        __builtin_amdgcn_global_load_lds((const unsigned*)((const char*)(gbase) + (voff)[_i]), (PG8_LAS unsigned*)(lds + (bufoff) + ldsw + _i * 8192), 16, 0, 0); } while (0)
#define PG8_LDA(dst, b, h) do { _Pragma("unroll") for (int m = 0; m < 4; ++m) _Pragma("unroll") for (int k = 0; k < 2; ++k) dst[m][k] = *(const PG8_LAS bf16x8*)(lds + PG8_SA(b, h) + aoff + m * 2048 + k * 1024); } while (0)
#define PG8_LDB(dst, b, h) do { _Pragma("unroll") for (int n = 0; n < 2; ++n) _Pragma("unroll") for (int k = 0; k < 2; ++k) dst[n][k] = *(const PG8_LAS bf16x8*)(lds + PG8_SB(b, h) + boff + n * 2048 + k * 1024); } while (0)
#define PG8_MMA(ai, bj, At, Bt) do { __builtin_amdgcn_s_setprio(1); _Pragma("unroll") for (int m = 0; m < 4; ++m) _Pragma("unroll") for (int n = 0; n < 2; ++n) _Pragma("unroll") for (int k = 0; k < 2; ++k) \
        acc[ai][bj][m][n] = __builtin_amdgcn_mfma_f32_16x16x32_bf16(Bt[n][k], At[m][k], acc[ai][bj][m][n], 0, 0, 0); __builtin_amdgcn_s_setprio(0); } while (0)
#define PG8_WAIT_V(n) asm volatile("s_waitcnt vmcnt(" #n ")" ::: "memory")
#define PG8_WAIT_L(n) asm volatile("s_waitcnt lgkmcnt(" #n ")" ::: "memory")
#define PG8_BAR __builtin_amdgcn_s_barrier()
#define PG8_SCHED __builtin_amdgcn_sched_barrier(0)
    Unit cur, nxt; int ui = 0;
    if (!S.next(0, cur)) return;
    f32x4 acc[2][2][4][2];
#pragma unroll
    for (int a = 0; a < 2; ++a)
#pragma unroll
        for (int b = 0; b < 2; ++b)
#pragma unroll
            for (int m = 0; m < 4; ++m)
#pragma unroll
                for (int n = 0; n < 2; ++n) acc[a][b][m][n] = (f32x4){0.f, 0.f, 0.f, 0.f};
    bf16x8 At[4][2], B0[2][2], B1[2][2];
    const char* cA = (const char*)g.A + (size_t)cur.pm * tstep; const char* cB = (const char*)g.Bt + (size_t)cur.pn * tstep;
    S.a_ready(cur);
    if constexpr (SP2) {
        PG8_STAGE(PG8_SB(0, 0), cB, voffB); PG8_STAGE(PG8_SB(0, 1), cB + hstep, voffB); PG8_STAGE(PG8_SA(0, 0), cA, voffA); PG8_STAGE(PG8_SA(0, 1), cA + hstep, voffA);
        if (wr == 1) PG8_BAR;
        PG8_WAIT_V(2); PG8_BAR;
        PG8_STAGE(PG8_SB(1, 0), cB + kstep, voffB); PG8_STAGE(PG8_SA(1, 0), cA + kstep, voffA); PG8_STAGE(PG8_SB(1, 1), cB + hstep + kstep, voffB);
        PG8_WAIT_V(6); PG8_BAR;
    } else {
        PG8_STAGE(PG8_SB(0, 0), cB, voffB); PG8_STAGE(PG8_SA(0, 0), cA, voffA); PG8_STAGE(PG8_SB(0, 1), cB + hstep, voffB); PG8_STAGE(PG8_SA(0, 1), cA + hstep, voffA);
        if (wr == 1) PG8_BAR;
        PG8_WAIT_V(4); PG8_BAR;
        PG8_STAGE(PG8_SB(1, 0), cB + kstep, voffB); PG8_STAGE(PG8_SA(1, 0), cA + kstep, voffA); PG8_STAGE(PG8_SB(1, 1), cB + hstep + kstep, voffB);
        PG8_WAIT_V(6); PG8_BAR;
    }
    for (;;) {
        const bool has_next = S.next(ui + 1, nxt);
        const char* nA = has_next ? (const char*)g.A + (size_t)nxt.pm * tstep : cA; const char* nB = has_next ? (const char*)g.Bt + (size_t)nxt.pn * tstep : cB;
        for (int t = 0; t < nt; t += 2) {
            const bool last = (t == nt - 2);
            const char* a1 = cA + (size_t)(t + 1) * kstep;
            const char* a2 = last ? nA : cA + (size_t)(t + 2) * kstep; const char* b2 = last ? nB : cB + (size_t)(t + 2) * kstep;
            const char* a3 = a2 + kstep; const char* b3 = b2 + kstep;
            if (last && has_next) S.a_ready(nxt);
            if constexpr (SP2) {
            PG8_LDB(B0, 0, 0); PG8_LDB(B1, 0, 1); PG8_SCHED; PG8_LDA(At, 0, 0); PG8_STAGE(PG8_SA(1, 1), a1 + hstep, voffA);
            PG8_WAIT_V(8); PG8_WAIT_L(0); PG8_BAR; PG8_MMA(0, 0, At, B0); PG8_MMA(0, 1, At, B1); PG8_BAR; PG8_SCHED;
            PG8_LDA(At, 0, 1); PG8_STAGE(PG8_SB(0, 0), b2, voffB); PG8_STAGE(PG8_SB(0, 1), b2 + hstep, voffB); PG8_STAGE(PG8_SA(0, 0), a2, voffA);
            PG8_WAIT_V(8); PG8_WAIT_L(0); PG8_BAR; PG8_MMA(1, 0, At, B0); PG8_MMA(1, 1, At, B1); PG8_BAR; PG8_SCHED;
            PG8_LDB(B0, 1, 0); PG8_LDB(B1, 1, 1); PG8_SCHED; PG8_LDA(At, 1, 0); PG8_STAGE(PG8_SA(0, 1), a2 + hstep, voffA);
            PG8_WAIT_V(8); PG8_WAIT_L(0); PG8_BAR; PG8_MMA(0, 0, At, B0); PG8_MMA(0, 1, At, B1); PG8_BAR; PG8_SCHED;
            PG8_LDA(At, 1, 1); PG8_STAGE(PG8_SB(1, 0), b3, voffB); PG8_STAGE(PG8_SB(1, 1), b3 + hstep, voffB); PG8_STAGE(PG8_SA(1, 0), a3, voffA);
            PG8_WAIT_V(8); PG8_WAIT_L(0); PG8_BAR; PG8_MMA(1, 0, At, B0); PG8_MMA(1, 1, At, B1); PG8_BAR; PG8_SCHED;
            } else {
            PG8_LDB(B0, 0, 0); PG8_SCHED; PG8_LDA(At, 0, 0); PG8_STAGE(PG8_SA(1, 1), a1 + hstep, voffA);
            PG8_WAIT_L(8); PG8_BAR; PG8_WAIT_L(0); PG8_MMA(0, 0, At, B0); PG8_BAR; PG8_SCHED;
            PG8_LDB(B1, 0, 1); PG8_STAGE(PG8_SB(0, 0), b2, voffB);
            PG8_BAR; PG8_WAIT_L(0); PG8_MMA(0, 1, At, B1); PG8_BAR;
            PG8_LDA(At, 0, 1); PG8_STAGE(PG8_SA(0, 0), a2, voffA);
            PG8_BAR; PG8_WAIT_L(0); PG8_MMA(1, 0, At, B0); PG8_BAR; PG8_SCHED;
            PG8_STAGE(PG8_SB(0, 1), b2 + hstep, voffB);
            PG8_WAIT_V(6); PG8_BAR; PG8_MMA(1, 1, At, B1); PG8_BAR;
            PG8_LDB(B0, 1, 0); PG8_SCHED; PG8_LDA(At, 1, 0); PG8_STAGE(PG8_SA(0, 1), a2 + hstep, voffA);
            PG8_WAIT_L(8); PG8_BAR; PG8_WAIT_L(0); PG8_MMA(0, 0, At, B0); PG8_BAR; PG8_SCHED;
            PG8_LDB(B1, 1, 1); PG8_STAGE(PG8_SB(1, 0), b3, voffB);
            PG8_BAR; PG8_WAIT_L(0); PG8_MMA(0, 1, At, B1); PG8_BAR;
            PG8_LDA(At, 1, 1); PG8_STAGE(PG8_SA(1, 0), a3, voffA);
            PG8_BAR; PG8_WAIT_L(0); PG8_MMA(1, 0, At, B0); PG8_BAR; PG8_SCHED;
            PG8_STAGE(PG8_SB(1, 1), b3 + hstep, voffB);
            PG8_WAIT_V(6); PG8_BAR; PG8_MMA(1, 1, At, B1); PG8_BAR;
            }
        }
        if constexpr (ALIGN_EPI) { if (wr == 0) PG8_BAR; }
        if constexpr (!Epi::AFTER_DRAIN) { E(acc, cur, wr, wc, fr, fq); S.done(cur); }
        if (!has_next) break;
#pragma unroll
        for (int a = 0; a < 2; ++a)
#pragma unroll
            for (int b = 0; b < 2; ++b)
#pragma unroll
                for (int m = 0; m < 4; ++m)
#pragma unroll
                    for (int n = 0; n < 2; ++n) acc[a][b][m][n] = (f32x4){0.f, 0.f, 0.f, 0.f};
        cur = nxt; cA = nA; cB = nB; ++ui;
        if constexpr (ALIGN_EPI) { if (wr == 1) PG8_BAR; }
    }
    PG8_WAIT_V(0);
    if constexpr (!ALIGN_EPI) { if (wr == 0) PG8_BAR; }
    PG8_BAR;
    if constexpr (Epi::AFTER_DRAIN) { E.fused(acc, cur, wr, wc, fr, fq, lds, wid, lane); S.done(cur); }
#undef PG8_SA
#undef PG8_SB
#undef PG8_STAGE
#undef PG8_LDA
#undef PG8_LDB
#undef PG8_MMA
#undef PG8_WAIT_V
#undef PG8_WAIT_L
#undef PG8_BAR
#undef PG8_SCHED
}
}
namespace att {
typedef unsigned short bf16_t;
typedef short bf16x8 __attribute__((ext_vector_type(8)));
typedef short s16x4 __attribute__((ext_vector_type(4)));
typedef float f32x16 __attribute__((ext_vector_type(16)));
typedef float f32x4 __attribute__((ext_vector_type(4)));
typedef unsigned u32x4 __attribute__((ext_vector_type(4)));
#define ALAS __attribute__((address_space(3)))
#define ASBAR() __builtin_amdgcn_sched_barrier(0)
constexpr int SHM_V = 16384;
template <int DK> struct Lay { static constexpr int ROWB = DK * 2, SHM_K = 64 * ROWB, OFF_K = 2 * SHM_V, OFF_F = OFF_K + 2 * SHM_K, OFF_WS = OFF_F + 512, TOTAL = OFF_WS + 8 * 256; };

__device__ __forceinline__ int v_st(int k, int c) { const int kk = (k & ~0xC) | ((k & 4) << 1) | ((k & 8) >> 1); return ((kk >> 3) * 4 + (c >> 5)) * 512 + ((kk & 7) * 32 + (c & 31)) * 2; }
__device__ __forceinline__ int v_rd_base(int lane) { return ((lane & 3) << 3) | (((lane >> 2) & 3) << 6) | (((lane >> 4) & 1) << 5) | (((lane >> 5) & 1) << 8); }
__device__ __forceinline__ int crow(int r, int hi) { return (r & 3) + 8 * (r >> 2) + 4 * hi; }
__device__ __forceinline__ unsigned cvtpk(float lo, float hi) { unsigned r; asm volatile("v_cvt_pk_bf16_f32 %0, %1, %2" : "=v"(r) : "v"(lo), "v"(hi)); return r; }

__device__ __forceinline__ float wave_max_f(float v) {
#pragma unroll
    for (int o = 32; o >= 1; o >>= 1) v = fmaxf(v, __shfl_xor(v, o));
    return v;
}
template <int DK, bool FOX>
__device__ __forceinline__ void attn_block(unsigned char* smem, const bf16_t* __restrict__ Q, int ldq, const bf16_t* __restrict__ K, int ldk, const bf16_t* __restrict__ V, int ldv,
                                           const float* __restrict__ Fh, const bf16_t* __restrict__ gate, bf16_t* __restrict__ gout  , int qbk, const float* __restrict__ gq, const float* __restrict__ gk  ) {
    typedef Lay<DK> LY;
    constexpr int ND = DK / 16, NKC = DK / 8, NKI = (64 * NKC) / 512;
    int tid = threadIdx.x; asm volatile("" : "+v"(tid));
    const int wid = __builtin_amdgcn_readfirstlane(tid >> 6), lane = tid & 63, r32 = lane & 31, hi = lane >> 5;
    const int q0 = qbk * 256, qlo = q0 + wid * 32, qm = qlo + r32 - 4 * hi;
    const int NT = 4 * qbk + 4;
    ALAS unsigned char* lds = (ALAS unsigned char*)smem;
    ALAS float* F_lds = (ALAS float*)(lds + LY::OFF_F);
    ALAS float* wsl = (ALAS float*)(lds + LY::OFF_WS) + wid * 64;
    bf16x8 qr[ND];
#pragma unroll
    for (int d0 = 0; d0 < ND; ++d0) qr[d0] = *(const bf16x8*)(Q + (size_t)(qlo + r32) * ldq + d0 * 16 + hi * 8);
    const float fq = FOX ? Fh[qlo + r32] : 0.f;
    int kgo[NKI], klo[NKI];
#pragma unroll
    for (int i = 0; i < NKI; ++i) { const int idx = tid + 512 * i, row = idx / NKC, ch = idx % NKC; kgo[i] = row * ldk + ch * 8; klo[i] = row * LY::ROWB + ((ch ^ ((row >> 1) & 7)) << 4); }
    const int sr = tid >> 4, sc = (tid & 15) * 8, vst0 = v_st(sr, sc), vst1 = v_st(32 + sr, sc);
    const int vgo0 = sr * ldv + sc, vgo1 = (32 + sr) * ldv + sc;
    const int vb0 = (int)(uintptr_t)smem + v_rd_base(lane);
    int kbase[4];
#pragma unroll
    for (int dd = 0; dd < 4; ++dd) kbase[dd] = LY::OFF_K + r32 * LY::ROWB + (((((dd << 1) | hi) ^ ((r32 >> 1) & 7))) << 4);
    bf16x8 stk[NKI], stv0, stv1; float stf = 0.f;
#define ATT_LOAD(kb) do { _Pragma("unroll") for (int i = 0; i < NKI; ++i) stk[i] = *(const bf16x8*)(K + (size_t)(kb) * ldk + kgo[i]); \
        stv0 = *(const bf16x8*)(V + (size_t)(kb) * ldv + vgo0); stv1 = *(const bf16x8*)(V + (size_t)(kb) * ldv + vgo1); if (FOX && tid < 64) stf = Fh[(kb) + tid]; } while (0)
#define ATT_WRITE(bf) do { _Pragma("unroll") for (int i = 0; i < NKI; ++i) *(ALAS bf16x8*)(lds + LY::OFF_K + (bf) * LY::SHM_K + klo[i]) = stk[i]; \
        *(ALAS bf16x8*)(lds + (bf) * SHM_V + vst0) = stv0; *(ALAS bf16x8*)(lds + (bf) * SHM_V + vst1) = stv1; if (FOX && tid < 64) F_lds[(bf) * 64 + tid] = stf; } while (0)
    int t_start = 0;
    if (FOX) {
        const float gqm = wave_max_f(fmaxf(fabsf(gq[lane]), fabsf(gq[lane + 64]))), gkm = wave_max_f(fmaxf(fabsf(gk[lane]), fabsf(gk[lane + 64])));
        const float qk_bound = 0.12751743f * 128.f * gqm * gkm;
        const float thr = 2.02f * qk_bound + 40.f, f0 = Fh[q0];
        const int j0 = lane, j1 = lane + 64;
        const bool c0 = (j0 < 4 * qbk) && (Fh[j0 * 64 + 63] - f0 >= thr), c1 = (j1 < 4 * qbk) && (Fh[(j1 < 4 * qbk ? j1 : 0) * 64 + 63] - f0 >= thr);
        t_start = __builtin_popcountll(__ballot(c0)) + __builtin_popcountll(__ballot(c1));
        t_start = __builtin_amdgcn_readfirstlane(t_start); }
    ATT_LOAD(t_start * 64); ATT_WRITE(t_start & 1);
    float m_reg = -1e30f, l_reg = 0.f; f32x16 o[4];
#pragma unroll
    for (int d = 0; d < 4; ++d)
#pragma unroll
        for (int r = 0; r < 16; ++r) o[d][r] = 0.f;
    for (int t = t_start; t < NT; ++t) {
        const int buf = t & 1, kb = t * 64;
        __syncthreads();
        if (t + 1 < NT) ATT_LOAD(kb + 64);
        f32x16 p0, p1;
        if (FOX) {
#pragma unroll
            for (int g = 0; g < 4; ++g) { const f32x4 f0 = *(const ALAS f32x4*)(F_lds + buf * 64 + 8 * g + 4 * hi), f1 = *(const ALAS f32x4*)(F_lds + buf * 64 + 32 + 8 * g + 4 * hi);
#pragma unroll
                for (int e = 0; e < 4; ++e) { p0[4 * g + e] = fq - f0[e]; p1[4 * g + e] = fq - f1[e]; } }
        } else {
#pragma unroll
            for (int r = 0; r < 16; ++r) { p0[r] = 0.f; p1[r] = 0.f; }
        }
        __builtin_amdgcn_s_setprio(1);
#pragma unroll
        for (int d0 = 0; d0 < ND; ++d0) {
            ALAS const unsigned char* a = lds + buf * LY::SHM_K + kbase[d0 & 3] + (d0 >> 2) * 128;
            const bf16x8 b0 = *(const ALAS bf16x8*)a;
            const bf16x8 b1 = *(const ALAS bf16x8*)(a + 32 * LY::ROWB);
            p0 = __builtin_amdgcn_mfma_f32_32x32x16_bf16(b0, qr[d0], p0, 0, 0, 0);
            p1 = __builtin_amdgcn_mfma_f32_32x32x16_bf16(b1, qr[d0], p1, 0, 0, 0);
        }
        __builtin_amdgcn_s_setprio(0);
        if (kb + 63 > qlo) {
            const float NEG = -__builtin_inff(); const int dq = qm - kb;
#pragma unroll
            for (int r = 0; r < 16; ++r) { const int c = (r & 3) + 8 * (r >> 2); if (dq - c < 0) p0[r] = NEG; if (dq - c - 32 < 0) p1[r] = NEG; }
        }
        float pmax = p0[0];
#pragma unroll
        for (int r = 1; r < 16; ++r) pmax = fmaxf(pmax, p0[r]);
#pragma unroll
        for (int r = 0; r < 16; ++r) pmax = fmaxf(pmax, p1[r]);
        { auto rr = __builtin_amdgcn_permlane32_swap(__float_as_uint(pmax), __float_as_uint(pmax), false, false);
          pmax = fmaxf(__uint_as_float(rr[0]), __uint_as_float(rr[1])); }
        float mn, alpha;
        if (__builtin_expect(__all(pmax - m_reg <= 8.f), 1)) { mn = m_reg; alpha = 1.f; }
        else { mn = fmaxf(m_reg, pmax); alpha = __builtin_amdgcn_exp2f(m_reg - mn); m_reg = mn; }
        float ps = 0.f;
#pragma unroll
        for (int r = 0; r < 16; ++r) { p0[r] = __builtin_amdgcn_exp2f(p0[r] - mn); ps += p0[r]; }
#pragma unroll
        for (int r = 0; r < 16; ++r) { p1[r] = __builtin_amdgcn_exp2f(p1[r] - mn); ps += p1[r]; }
        { auto rr = __builtin_amdgcn_permlane32_swap(__float_as_uint(ps), __float_as_uint(ps), false, false);
          ps = __uint_as_float(rr[0]) + __uint_as_float(rr[1]); }
        l_reg = l_reg * alpha + ps;
        bf16x8 pa0, pa1, pa2, pa3;
#define ATT_PK4(P, B_, OUT) do { unsigned a0 = cvtpk(P[B_+0], P[B_+1]), a1 = cvtpk(P[B_+2], P[B_+3]); unsigned b0_ = cvtpk(P[B_+4], P[B_+5]), b1_ = cvtpk(P[B_+6], P[B_+7]); \
        auto r0 = __builtin_amdgcn_permlane32_swap(a0, b0_, false, false); auto r1 = __builtin_amdgcn_permlane32_swap(a1, b1_, false, false); \
        u32x4 w = {r0[0], r1[0], r0[1], r1[1]}; OUT = *reinterpret_cast<bf16x8*>(&w); } while (0)
        ATT_PK4(p0, 0, pa0); ATT_PK4(p0, 8, pa1); ATT_PK4(p1, 0, pa2); ATT_PK4(p1, 8, pa3);
        if (__any(alpha < 1.f)) {
            if (hi == 0) wsl[r32] = alpha;
            asm volatile("s_waitcnt lgkmcnt(0)" ::: "memory");
#pragma unroll
            for (int g = 0; g < 4; ++g) { const f32x4 al = *(const ALAS f32x4*)(wsl + 8 * g + 4 * hi);
#pragma unroll
                for (int d = 0; d < 4; ++d)
#pragma unroll
                    for (int e = 0; e < 4; ++e) o[d][4 * g + e] *= al[e]; }
        }
#define ATT_TRRD(dst, off) asm volatile("ds_read_b64_tr_b16 %0, %1 offset:%2" : "=&v"(dst) : "v"(vbb), "i"(off) : "memory")
#define ATT_PV(d0) do { s16x4 l0, l1, l2, l3, h0, h1, h2, h3; constexpr int b_ = (d0) * 512; \
        ATT_TRRD(l0, b_); ATT_TRRD(h0, b_ + 2048); ATT_TRRD(l1, b_ + 4096); ATT_TRRD(h1, b_ + 6144); ATT_TRRD(l2, b_ + 8192); ATT_TRRD(h2, b_ + 10240); ATT_TRRD(l3, b_ + 12288); ATT_TRRD(h3, b_ + 14336); \
        asm volatile("s_waitcnt lgkmcnt(0)" ::: "memory"); ASBAR(); \
        o[d0] = __builtin_amdgcn_mfma_f32_32x32x16_bf16(pa0, (bf16x8){l0[0], l0[1], l0[2], l0[3], h0[0], h0[1], h0[2], h0[3]}, o[d0], 0, 0, 0); \
        o[d0] = __builtin_amdgcn_mfma_f32_32x32x16_bf16(pa1, (bf16x8){l1[0], l1[1], l1[2], l1[3], h1[0], h1[1], h1[2], h1[3]}, o[d0], 0, 0, 0); \
        o[d0] = __builtin_amdgcn_mfma_f32_32x32x16_bf16(pa2, (bf16x8){l2[0], l2[1], l2[2], l2[3], h2[0], h2[1], h2[2], h2[3]}, o[d0], 0, 0, 0); \
        o[d0] = __builtin_amdgcn_mfma_f32_32x32x16_bf16(pa3, (bf16x8){l3[0], l3[1], l3[2], l3[3], h3[0], h3[1], h3[2], h3[3]}, o[d0], 0, 0, 0); } while (0)
        { const int vbb = vb0 + buf * SHM_V; __builtin_amdgcn_s_setprio(1); ATT_PV(0); ATT_PV(1); ATT_PV(2); ATT_PV(3); __builtin_amdgcn_s_setprio(0); }
        if (t + 1 < NT) ATT_WRITE(buf ^ 1);
    }
    if (hi == 0) wsl[r32] = l_reg;
    asm volatile("s_waitcnt lgkmcnt(0)" ::: "memory");
#pragma unroll
    for (int r = 0; r < 16; ++r) {
        const int orow = crow(r, hi); const float rli = __builtin_amdgcn_rcpf(wsl[orow]);
        bf16_t* rowp = gout + (size_t)(qlo + orow) * 4096; const bf16_t* growp = gate + (size_t)(qlo + orow) * 4096;
#pragma unroll
        for (int d0 = 0; d0 < 4; ++d0) {
            const float v = o[d0][r] * rli; const float vn = __shfl_xor(v, 1);
            if ((r32 & 1) == 0) { unsigned* gp = (unsigned*)(rowp + d0 * 32 + r32); const unsigned g = *(const unsigned*)(growp + d0 * 32 + r32);
                *gp = cvtpk(v * __uint_as_float(g << 16), vn * __uint_as_float(g & 0xffff0000u)); }
        }
    }
    __syncthreads();
#undef ATT_LOAD
#undef ATT_WRITE
#undef ATT_PK4
#undef ATT_TRRD
#undef ATT_PV
}
}
using pg8::bf16_t; using pg8::f32x4; using pg8::u32x4;
#define LAS __attribute__((address_space(3)))
constexpr int S = 8192, DM = 2048, INW = 11344, INWP = 11520;
constexpr float EPS = 1e-6f;
constexpr size_t MiB = 1u << 20;

__device__ __forceinline__ float bf2f(bf16_t v) { return __uint_as_float(((unsigned)v) << 16); }
__device__ __forceinline__ bf16_t f2bf(float f) { unsigned u = __float_as_uint(f); u += 0x7fffu + ((u >> 16) & 1u); return (bf16_t)(u >> 16); }
__device__ __forceinline__ unsigned pk2(float lo, float hi) { return (unsigned)f2bf(lo) | ((unsigned)f2bf(hi) << 16); }
__device__ __forceinline__ float wave_sum(float v) {
#pragma unroll
    for (int o = 32; o >= 1; o >>= 1) v += __shfl_xor(v, o);
    return v;
}
__device__ __forceinline__ float wave_max(float v) {
#pragma unroll
    for (int o = 32; o >= 1; o >>= 1) v = fmaxf(v, __shfl_xor(v, o));
    return v;
}

__device__ __forceinline__ int opaque_tid() { int t = threadIdx.x; asm volatile("" : "+v"(t)); return t; }

struct Params {
    const float* x; const int* pos; const float *mix_g, *w_in, *b_forget, *b_gate, *q_lat_g, *w_q_up, *kv_lat_g, *w_kv_up, *mla_qg, *mla_kg, *fox_qg, *fox_kg, *w_out, *ffn_g, *w_peer_q, *sub_keys, *peer_u, *peer_v;
    float* out;
    bf16_t *WqT, *WkvT, *WoT, *WpT, *WinT;
    bf16_t *h, *cq, *ckv, *fq, *fk, *fv, *merged, *kpe, *qa, *va, *ka;
    float *lf, *F, *x1, *scores;
    unsigned char *U8, *V8; bf16_t* attout;
    unsigned* ctl;
    float2* ropeT; float* ssq;
};

struct DstId { __device__ __forceinline__ int operator()(int n) const { return n; } };
struct DstWin { __device__ __forceinline__ int operator()(int n) const {
    if (n < 1024) return n; if (n < 1088) { const int r = n - 1024; return 11264 + 2 * (r & 31) + (r >> 5); } if (n < 7232) return n - 64; if (n < 7248) return 11264 + 64 + (n - 7232); return n - 80; } };
struct DstQ { __device__ __forceinline__ int operator()(int n) const {
    const int h = n / 192, d = n - h * 192; if (d < 128) return h * 256 + d; const int r = d - 128; return h * 256 + 128 + 2 * (r & 31) + (r >> 5); } };
template <class Dst>
__device__ __forceinline__ void transpose_item(const float* __restrict__ W, int K, int N, bf16_t* __restrict__ WT, Dst dst, float* scr, int item, int lane, const float* __restrict__ gk = nullptr) {
    const int nblk = (N + 31) / 32, kb = item / nblk, nb = item % nblk, k0 = 64 * kb, n0 = 32 * nb;
    { const int rr = lane >> 3, c4 = (lane & 7) * 4; const bool ok = (n0 + c4) < N;
      f32x4 v[8];
#pragma unroll
      for (int i = 0; i < 8; ++i) v[i] = ok ? *(const f32x4*)(W + (size_t)(k0 + 8 * i + rr) * N + n0 + c4) : (f32x4){0.f, 0.f, 0.f, 0.f};
      if (gk) {
#pragma unroll
          for (int i = 0; i < 8; ++i) v[i] *= gk[k0 + 8 * i + rr]; }
#pragma unroll
      for (int i = 0; i < 8; ++i) { float* sp = scr + (8 * i + rr) * 33 + c4; sp[0] = v[i][0]; sp[1] = v[i][1]; sp[2] = v[i][2]; sp[3] = v[i][3]; } }
    asm volatile("s_waitcnt lgkmcnt(0)" ::: "memory");
    const int c = lane & 7;
#pragma unroll
    for (int j = 0; j < 4; ++j) { const int nl = (lane >> 3) + 8 * j, n = n0 + nl; const float* s = scr + (8 * c) * 33 + nl;
        u32x4 o; o.x = pk2(s[0 * 33], s[1 * 33]); o.y = pk2(s[2 * 33], s[3 * 33]); o.z = pk2(s[4 * 33], s[5 * 33]); o.w = pk2(s[6 * 33], s[7 * 33]);
        if (n < N) *(u32x4*)(WT + (size_t)dst(n) * K + k0 + 8 * c) = o; }
    asm volatile("s_waitcnt lgkmcnt(0)" ::: "memory");
}
__device__ __forceinline__ void wfold_item(const float* __restrict__ wq, const float* __restrict__ keys, bf16_t* __restrict__ WpT, float* sm, int item) {
    const int tid = opaque_tid(), hc = item >> 5, d0 = (item & 31) * 64;
    float* keysL = sm; float* wqL = sm + 128 * 132;
    for (int idx = tid; idx < 128 * 32; idx += 512) { const int r = idx >> 5, c4 = (idx & 31) * 4; *(f32x4*)(keysL + r * 132 + c4) = *(const f32x4*)(keys + (size_t)hc * 16384 + r * 128 + c4); }
    for (int idx = tid; idx < 64 * 32; idx += 512) { const int r = idx >> 5, c4 = (idx & 31) * 4; *(f32x4*)(wqL + r * 132 + c4) = *(const f32x4*)(wq + (size_t)(d0 + r) * 2048 + hc * 128 + c4); }
    __syncthreads();
    const int n2 = (tid & 63) * 2, dg = tid >> 6;
    float acc[2][8];
#pragma unroll
    for (int a = 0; a < 2; ++a)
#pragma unroll
        for (int i = 0; i < 8; ++i) acc[a][i] = 0.f;
#pragma unroll 2
    for (int j4 = 0; j4 < 32; ++j4) {
        const f32x4 k0v = *(const f32x4*)(keysL + n2 * 132 + 4 * j4), k1v = *(const f32x4*)(keysL + (n2 + 1) * 132 + 4 * j4);
#pragma unroll
        for (int i = 0; i < 8; ++i) { const f32x4 w = *(const f32x4*)(wqL + (dg * 8 + i) * 132 + 4 * j4);
            acc[0][i] += (k0v[0] * w[0] + k0v[1] * w[1]) + (k0v[2] * w[2] + k0v[3] * w[3]);
            acc[1][i] += (k1v[0] * w[0] + k1v[1] * w[1]) + (k1v[2] * w[2] + k1v[3] * w[3]); }
    }
#pragma unroll
    for (int a = 0; a < 2; ++a) { u32x4 o; o.x = pk2(acc[a][0], acc[a][1]); o.y = pk2(acc[a][2], acc[a][3]); o.z = pk2(acc[a][4], acc[a][5]); o.w = pk2(acc[a][6], acc[a][7]);
        *(u32x4*)(WpT + (size_t)(hc * 128 + n2 + a) * 2048 + d0 + dg * 8) = o; }
    __syncthreads();
}
__device__ __forceinline__ void rms_row2048(const float* __restrict__ xr, const float* __restrict__ g, bf16_t* __restrict__ orow, int lane) {
    f32x4 v[8]; float ss = 0.f;
#pragma unroll
    for (int j = 0; j < 8; ++j) { v[j] = *(const f32x4*)(xr + j * 256 + lane * 4); ss += (v[j][0] * v[j][0] + v[j][1] * v[j][1]) + (v[j][2] * v[j][2] + v[j][3] * v[j][3]); }
    const float r = rsqrtf(wave_sum(ss) * (1.f / 2048.f) + EPS);
#pragma unroll
    for (int j = 0; j < 8; ++j) { const f32x4 gg = *(const f32x4*)(g + j * 256 + lane * 4);
        uint2 o; o.x = pk2(v[j][0] * r * gg[0], v[j][1] * r * gg[1]); o.y = pk2(v[j][2] * r * gg[2], v[j][3] * r * gg[3]);
        *(uint2*)(orow + j * 256 + lane * 4) = o; }
}
__device__ __forceinline__ void fox_cumsum(double* part, int h, const float* __restrict__ lf, float* __restrict__ F) {
    const int tid = opaque_tid(), lane = tid & 63, wave = tid >> 6;
    float v[16]; double sum = 0.0;
#pragma unroll
    for (int i = 0; i < 16; ++i) { v[i] = lf[(size_t)(tid * 16 + i) * 16 + h]; sum += (double)v[i]; }
    double inc = sum;
#pragma unroll
    for (int o = 1; o < 64; o <<= 1) { const double n = __shfl_up(inc, o); if (lane >= o) inc += n; }
    if (lane == 63) part[wave] = inc;
    __syncthreads();
    double base = 0.0;
    for (int w = 0; w < wave; ++w) base += part[w];
    double run = base + inc - sum;
#pragma unroll
    for (int i = 0; i < 16; ++i) { run += (double)v[i]; F[(size_t)h * S + tid * 16 + i] = (float)(run * 1.4426950408889634); }
    __syncthreads();
}
__device__ __forceinline__ void rope_table(const int* __restrict__ pos, float2* __restrict__ ropeT, int gtid, int nthreads) {
    for (int idx = gtid; idx < S * 32; idx += nthreads) { const int t = idx >> 5, i = idx & 31;
        const double inv = exp(-(double)i * (1.0 / 32.0) * 9.210340371976184);
        double ang = (double)((float)pos[t] * (float)inv);
        const double twopi = 6.283185307179586;
        ang -= twopi * rint(ang / twopi);
        ropeT[idx] = make_float2(cosf((float)ang), sinf((float)ang)); }
}
typedef float f32x2 __attribute__((ext_vector_type(2)));
__device__ __forceinline__ unsigned pk4_fp8(float a, float b, float c, float d) {
    int w = __builtin_amdgcn_cvt_pk_fp8_f32(fminf(fmaxf(a, -448.f), 448.f), fminf(fmaxf(b, -448.f), 448.f), 0, false);
    w = __builtin_amdgcn_cvt_pk_fp8_f32(fminf(fmaxf(c, -448.f), 448.f), fminf(fmaxf(d, -448.f), 448.f), w, true); return (unsigned)w; }
__device__ __forceinline__ void cvt_rows_fp8(const float* __restrict__ src, unsigned char* __restrict__ dst, size_t n, float scale, int gw, int NGW, int lane) {
    const size_t nchunk = n / 1024;
    for (size_t c = gw; c < nchunk; c += NGW) { const size_t o = c * 1024 + lane * 16;
        f32x4 a[4];
#pragma unroll
        for (int q = 0; q < 4; ++q) a[q] = *(const f32x4*)(src + o + 4 * q) * scale;
        u32x4 w; w.x = pk4_fp8(a[0][0], a[0][1], a[0][2], a[0][3]); w.y = pk4_fp8(a[1][0], a[1][1], a[1][2], a[1][3]);
        w.z = pk4_fp8(a[2][0], a[2][1], a[2][2], a[2][3]); w.w = pk4_fp8(a[3][0], a[3][1], a[3][2], a[3][3]);
        *(u32x4*)(dst + o) = w; }
}
constexpr float U_SCALE = 64.f, V_SCALE = 4.f;
typedef __bf16 bf16x2_t __attribute__((ext_vector_type(2)));
__device__ __forceinline__ float dot2bf(unsigned a, unsigned b, float c) { return __builtin_amdgcn_fdot2_f32_bf16(__builtin_bit_cast(bf16x2_t, a), __builtin_bit_cast(bf16x2_t, b), c, false); }
#define PEER_INS(top, x) do { float x_ = (x); _Pragma("unroll") for (int i_ = 0; i_ < 16; ++i_) { const float hi_ = fmaxf(top[i_], x_); x_ = fminf(top[i_], x_); top[i_] = hi_; } } while (0)
__device__ __forceinline__ void peer_group(unsigned char* smem, int g, const float* __restrict__ scores, const bf16_t* __restrict__ h2, const float* __restrict__ x1,
                                           const unsigned char* __restrict__ U8, const unsigned char* __restrict__ V8, float* __restrict__ out) {
    const int tid = opaque_tid(), lane = tid & 63, wave = __builtin_amdgcn_readfirstlane(tid >> 6);
    float* topL = (float*)smem;
    int* selE = (int*)(smem + 32768);
    float* selG = (float*)(smem + 49152);
    {
        const int tl = tid >> 4, hc = tid & 15;
        const float* sp = scores + (size_t)(g * 32 + tl) * 2048 + hc * 128;
        float top[16];
#pragma unroll
        for (int i = 0; i < 16; ++i) top[i] = -INFINITY;
#pragma unroll 2
        for (int n0 = 0; n0 < 128; n0 += 4) { const f32x4 v = *(const f32x4*)(sp + n0);
#pragma unroll
            for (int e = 0; e < 4; ++e) PEER_INS(top, __uint_as_float((__float_as_uint(v[e]) & ~0x7Fu) | (unsigned)(n0 + e))); }
        float* tp = topL + (tl * 16 + hc) * 16;
#pragma unroll
        for (int i = 0; i < 16; i += 4) *(f32x4*)(tp + i) = (f32x4){top[i], top[i + 1], top[i + 2], top[i + 3]};
    }
    __syncthreads();
    if (tid < 256) {
        const int tl = tid >> 3, h = tid & 7;
        const float* t1 = topL + (tl * 16 + 2 * h) * 16; const float* t2 = t1 + 16;
        float s1[16], s2[16];
#pragma unroll
        for (int i = 0; i < 16; i += 4) { const f32x4 a = *(const f32x4*)(t1 + i), b2 = *(const f32x4*)(t2 + i);
            s1[i] = a[0]; s1[i + 1] = a[1]; s1[i + 2] = a[2]; s1[i + 3] = a[3]; s2[i] = b2[0]; s2[i + 1] = b2[1]; s2[i + 2] = b2[2]; s2[i + 3] = b2[3]; }
        float ts[16];
#pragma unroll
        for (int i = 0; i < 16; ++i) ts[i] = -INFINITY;
#pragma unroll
        for (int i = 0; i < 16; ++i)
#pragma unroll
            for (int j = 0; j < 16; ++j)
                if ((i + 1) * (j + 1) <= 16) PEER_INS(ts, __uint_as_float((__float_as_uint(s1[i] + s2[j]) & ~0xFFu) | (unsigned)(i * 16 + j)));
        float ex[16], sum = 0.f;
#pragma unroll
        for (int k = 0; k < 16; ++k) { ex[k] = __expf(ts[k] - ts[0]); sum += ex[k]; }
        const float inv = 1.f / sum;
#pragma unroll
        for (int k = 0; k < 16; ++k) { const unsigned pos = __float_as_uint(ts[k]) & 0xFFu;
            const int i1 = (int)(__float_as_uint(t1[pos >> 4]) & 0x7Fu), i2 = (int)(__float_as_uint(t2[pos & 15]) & 0x7Fu);
            selE[tl * 128 + h * 16 + k] = i1 * 128 + i2; selG[tl * 128 + h * 16 + k] = ex[k] * inv; }
    }
    __syncthreads();
    const int grp = lane >> 4, l16 = lane & 15, tl = wave * 4 + grp;
    unsigned* sortK = (unsigned*)(smem + 65536) + tl * 128;
    float* wS = (float*)(smem + 81920) + tl * 128;
    unsigned* hist = (unsigned*)(smem + 98304) + wave * 512 + grp * 64;
    {
#pragma unroll
        for (int i = 0; i < 4; ++i) hist[l16 * 4 + i] = 0u;
        asm volatile("s_waitcnt lgkmcnt(0)" ::: "memory");
        unsigned ek[8], rk[8];
#pragma unroll
        for (int j = 0; j < 8; ++j) { ek[j] = (unsigned)selE[tl * 128 + l16 + 16 * j]; rk[j] = atomicAdd(&hist[ek[j] >> 8], 1u); }
        asm volatile("s_waitcnt lgkmcnt(0)" ::: "memory");
        unsigned c[4], tot = 0u;
#pragma unroll
        for (int i = 0; i < 4; ++i) { c[i] = hist[l16 * 4 + i]; tot += c[i]; }
        unsigned inc = tot;
#pragma unroll
        for (int o = 1; o < 16; o <<= 1) { const unsigned n = __shfl_up(inc, o, 16); if (l16 >= o) inc += n; }
        unsigned run = inc - tot;
#pragma unroll
        for (int i = 0; i < 4; ++i) { hist[256 + l16 * 4 + i] = run; run += c[i]; }
        asm volatile("s_waitcnt lgkmcnt(0)" ::: "memory");
#pragma unroll
        for (int j = 0; j < 8; ++j) sortK[hist[256 + (ek[j] >> 8)] + rk[j]] = (ek[j] << 7) | (unsigned)(l16 + 16 * j);
    }
    __syncthreads();
    const size_t tok = (size_t)g * 32 + tl;
    {
        f32x2 hp[64];
#pragma unroll
        for (int j = 0; j < 8; ++j)
#pragma unroll
            for (int q = 0; q < 2; ++q) { const u32x4 w = *(const u32x4*)(h2 + tok * DM + j * 256 + l16 * 16 + q * 8);
#pragma unroll
                for (int c = 0; c < 4; ++c) hp[j * 8 + q * 4 + c] = (f32x2){__uint_as_float(w[c] << 16), __uint_as_float(w[c] & 0xffff0000u)}; }
        for (int it = 0; it < 128; it += 2) {
            if ((it & 7) == 0 && it) __syncthreads();
            const unsigned key0 = sortK[it], key1 = sortK[it + 1];
            u32x4 ur[2][8];
#pragma unroll
            for (int j = 0; j < 8; ++j) ur[0][j] = *(const u32x4*)(U8 + (size_t)(key0 >> 7) * DM + j * 256 + l16 * 16);
#pragma unroll
            for (int j = 0; j < 8; ++j) ur[1][j] = *(const u32x4*)(U8 + (size_t)(key1 >> 7) * DM + j * 256 + l16 * 16);
#pragma unroll
            for (int p = 0; p < 2; ++p) { f32x2 a2 = (f32x2){0.f, 0.f}, b2 = (f32x2){0.f, 0.f};
#pragma unroll
                for (int j = 0; j < 8; ++j)
#pragma unroll
                    for (int c = 0; c < 4; ++c) { const int w = (int)ur[p][j][c];
                        a2 = __builtin_elementwise_fma(hp[j * 8 + 2 * c], __builtin_amdgcn_cvt_pk_f32_fp8(w, false), a2);
                        b2 = __builtin_elementwise_fma(hp[j * 8 + 2 * c + 1], __builtin_amdgcn_cvt_pk_f32_fp8(w, true), b2); }
                float d = (a2.x + a2.y) + (b2.x + b2.y);
                d += __shfl_xor(d, 8); d += __shfl_xor(d, 4); d += __shfl_xor(d, 2); d += __shfl_xor(d, 1);
                const float a = d * (1.f / U_SCALE); const unsigned key = p ? key1 : key0;
                const float w = selG[tl * 128 + (key & 127u)] * 0.5f * a * (1.f + erff(a * 0.70710678118654752f)) * (1.f / V_SCALE);
                if (l16 == 0) wS[it + p] = w; }
        }
    }
    __syncthreads();
    {
        f32x2 acc[64];
#pragma unroll
        for (int c = 0; c < 64; ++c) acc[c] = (f32x2){0.f, 0.f};
        for (int it = 0; it < 128; it += 2) {
            if ((it & 7) == 0 && it) __syncthreads();
            const unsigned key0 = sortK[it], key1 = sortK[it + 1];
            u32x4 vr[2][8];
#pragma unroll
            for (int j = 0; j < 8; ++j) vr[0][j] = *(const u32x4*)(V8 + (size_t)(key0 >> 7) * DM + j * 256 + l16 * 16);
#pragma unroll
            for (int j = 0; j < 8; ++j) vr[1][j] = *(const u32x4*)(V8 + (size_t)(key1 >> 7) * DM + j * 256 + l16 * 16);
#pragma unroll
            for (int p = 0; p < 2; ++p) { const float w = wS[it + p]; const f32x2 w2 = (f32x2){w, w};
#pragma unroll
                for (int j = 0; j < 8; ++j)
#pragma unroll
                    for (int c = 0; c < 4; ++c) { const int x = (int)vr[p][j][c];
                        acc[j * 8 + 2 * c] = __builtin_elementwise_fma(w2, __builtin_amdgcn_cvt_pk_f32_fp8(x, false), acc[j * 8 + 2 * c]);
                        acc[j * 8 + 2 * c + 1] = __builtin_elementwise_fma(w2, __builtin_amdgcn_cvt_pk_f32_fp8(x, true), acc[j * 8 + 2 * c + 1]); } }
        }
#pragma unroll
        for (int j = 0; j < 8; ++j)
#pragma unroll
            for (int q = 0; q < 4; ++q) { const size_t o = tok * DM + j * 256 + l16 * 16 + q * 4;
                const f32x4 a = *(const f32x4*)(x1 + o);
                *(f32x4*)(out + o) = (f32x4){a[0] + acc[j * 8 + 2 * q].x, a[1] + acc[j * 8 + 2 * q].y, a[2] + acc[j * 8 + 2 * q + 1].x, a[3] + acc[j * 8 + 2 * q + 1].y}; }
    }
    __syncthreads();
}

#define XB_TMO      128
#define XB_XCNT(j)  (256  + 64 * (j))
#define XB_XSUB(j)  (1280 + 64 * (j))
#define XB_XGEN(j)  (2304 + 64 * (j))
#define XB_TOP      3328
#define XB_TOPGEN   3392
#define XCD_BAR_WORDS 3456
#define XB_SPIN_CAP (1u << 18)

__device__ __forceinline__ unsigned xb_ld(unsigned* p)              { return __hip_atomic_load(p, __ATOMIC_RELAXED, __HIP_MEMORY_SCOPE_AGENT); }
__device__ __forceinline__ unsigned xb_add(unsigned* p, unsigned v) { return __hip_atomic_fetch_add(p, v, __ATOMIC_RELAXED, __HIP_MEMORY_SCOPE_AGENT); }
__device__ __forceinline__ unsigned xb_xcc_id() { return (unsigned)__builtin_amdgcn_s_getreg((3 << 11) | 20) & 0xFu; }
#define XB_SPIN(cond, bar) do { unsigned _sp = 0; while (cond) { __builtin_amdgcn_s_sleep(1); \
    if ((++_sp & 255u) == 0u) { if (xb_ld(&(bar)[XB_TMO])) break; if (_sp > XB_SPIN_CAP) { atomicAdd(&(bar)[XB_TMO], 1u); break; } } } } while (0)

struct XcdBarrier {
    unsigned* bar; unsigned x;
    volatile LAS unsigned* st;
};

__device__ __forceinline__ XcdBarrier xcd_barrier_post(unsigned* bar, volatile LAS unsigned* st) {
    XcdBarrier b; b.bar = bar; b.x = xb_xcc_id(); b.st = st;
    if (threadIdx.x == 0) (void)xb_add(&bar[XB_XCNT(b.x)], 1u);
    return b;
}
__device__ __forceinline__ void xcd_barrier_complete(unsigned* bar, unsigned x, unsigned& nloc, unsigned& nx) {
    const unsigned G = gridDim.x * gridDim.y * gridDim.z;
    unsigned sum, cnt, mine, sp = 0u;
    for (;;) {
        sum = 0u; cnt = 0u; mine = 0u;
#pragma unroll
        for (unsigned j = 0; j < 16; ++j) { const unsigned c = xb_ld(&bar[XB_XCNT(j)]); sum += c; cnt += (c > 0u) ? 1u : 0u; mine = (j == x) ? c : mine; }
        if (sum == G) break;
        __builtin_amdgcn_s_sleep(1);
        if ((++sp & 255u) == 0u) { if (xb_ld(&bar[XB_TMO])) break; if (sp > XB_SPIN_CAP) { atomicAdd(&bar[XB_TMO], 1u); break; } }
    }
    nloc = mine > 0u ? mine : 1u; nx = cnt > 0u ? cnt : 1u;
}

__device__ __forceinline__ void xcd_barrier(const XcdBarrier& b) {
    asm volatile("s_waitcnt vmcnt(0)" ::: "memory");
    __syncthreads();
    if (threadIdx.x == 0) {
        unsigned* bar = b.bar;
        __builtin_amdgcn_s_waitcnt(0);
        unsigned nloc = b.st[0], nx = b.st[1];
        if (nloc == 0u) { xcd_barrier_complete(bar, b.x, nloc, nx); b.st[0] = nloc; b.st[1] = nx; }
        const unsigned old = xb_add(&bar[XB_XSUB(b.x)], 1u);
        const unsigned gen = old / nloc;
        if (old + 1u == (gen + 1u) * nloc) {
            __builtin_amdgcn_fence(__ATOMIC_RELEASE, "agent");
            asm volatile("s_waitcnt vmcnt(0)" ::: "memory");
            const unsigned og = xb_add(&bar[XB_TOP], 1u);
            const unsigned tg = og / nx;
            if (og + 1u == (tg + 1u) * nx) xb_add(&bar[XB_TOPGEN], 1u);
            else XB_SPIN(xb_ld(&bar[XB_TOPGEN]) == tg, bar);
            __builtin_amdgcn_fence(__ATOMIC_ACQUIRE, "agent");
            xb_add(&bar[XB_XGEN(b.x)], 1u);
            asm volatile("s_waitcnt vmcnt(0)" ::: "memory");
        } else {
            XB_SPIN(xb_ld(&bar[XB_XGEN(b.x)]) == gen, bar);
            __builtin_amdgcn_fence(__ATOMIC_ACQUIRE, "agent");
            asm volatile("s_waitcnt vmcnt(0)" ::: "memory");
        }
    }
    __syncthreads();
}

#define PROBE_DOUBLE 0
#define REP(k) for (int rep_ = 0; rep_ < ((PROBE_DOUBLE == (k)) ? 2 : 1); ++rep_)
constexpr int LDS_BYTES = 147456;
__global__ __launch_bounds__(512, 2) void mega(Params p) {
    extern __shared__ __attribute__((aligned(16))) unsigned char smem[];
    { volatile LAS unsigned* st0 = (volatile LAS unsigned*)((LAS unsigned char*)smem + 131072); if (threadIdx.x < 2) st0[threadIdx.x] = 0u; }
    __syncthreads();
    const XcdBarrier bar = xcd_barrier_post(p.ctl, (volatile LAS unsigned*)((LAS unsigned char*)smem + 131072));
    float* smf = (float*)smem;
    LAS unsigned char* lds = (LAS unsigned char*)smem;
    const int G = gridDim.x, b = blockIdx.x, NGW = G * 8;
#define PHASE_IDS() const int tid = opaque_tid(), lane = tid & 63, wave = __builtin_amdgcn_readfirstlane(tid >> 6), gw = b * 8 + wave; (void)lane; (void)gw

    REP(7) {
        PHASE_IDS();
        float* scr = smf + wave * 4096;
        constexpr int dummy_ = 0; (void)dummy_;
        constexpr int I_IN = 32 * 355, I_Q = 8 * 96, I_KV = 8 * 128, I_O = 64 * 64;
        for (int it = gw; it < I_IN + I_Q + I_KV + I_O; it += NGW) {
            int r = it;
            if (r < I_IN) { transpose_item(p.w_in, 2048, INW, p.WinT, DstWin(), scr, r, lane); continue; } r -= I_IN;
            if (r < I_Q) { transpose_item(p.w_q_up, 512, 3072, p.WqT, DstQ(), scr, r, lane, p.q_lat_g); continue; } r -= I_Q;
            if (r < I_KV) { transpose_item(p.w_kv_up, 512, 4096, p.WkvT, DstId(), scr, r, lane, p.kv_lat_g); continue; } r -= I_KV;
            transpose_item(p.w_out, 4096, 2048, p.WoT, DstId(), scr, r, lane);
        }
        for (int m = gw; m < S; m += NGW) rms_row2048(p.x + (size_t)m * DM, p.mix_g, p.h + (size_t)m * DM, lane);
        for (int idx = b * 512 + tid; idx < 16 * 64 * 64; idx += G * 512) { const int hh = idx >> 12, rr = (idx >> 6) & 63, c8 = idx & 63;
            *(u32x4*)(p.WqT + (size_t)(hh * 256 + 192 + rr) * 512 + c8 * 8) = (u32x4){0u, 0u, 0u, 0u}; }
        rope_table(p.pos, p.ropeT, b * 512 + tid, G * 512);
        __syncthreads();
        for (int it = b; it < 512; it += G) wfold_item(p.w_peer_q, p.sub_keys, p.WpT, smf, it);
    }
    xcd_barrier(bar);
    REP(1) {
        pg8::Gemm g{p.h, p.WinT, S, INWP, DM}; pg8::StaticOrder so; so.init(S, INWP, G, b);
        pg8::EpiInProj E{p.cq, p.ckv, p.fq, p.fk, p.fv, p.merged, p.kpe, p.lf, p.b_gate, p.b_forget, p.ssq, p.fox_qg, p.fox_kg, (LAS float*)(lds + 131072 + 64)};
        pg8::gemm_phase<pg8::EpiInProj, pg8::StaticOrder, true, true>(lds, g, so, E);
    }
    xcd_barrier(bar);
    for (int hh = b; hh < 16; hh += G) fox_cumsum((double*)smem, hh, p.lf, p.F);
    REP(2) {
        pg8::Gemm g{p.cq, p.WqT, S, 4096, 512}; pg8::StaticOrder so; so.init(S, 4096, G, b);
        pg8::EpiQ E{p.qa, p.ssq, p.mla_qg, p.ropeT, (LAS float*)(lds + 131072 + 64)};
        pg8::gemm_phase<pg8::EpiQ, pg8::StaticOrder, true, true>(lds, g, so, E);
    }
    {
        pg8::Gemm g{p.ckv, p.WkvT, S, 4096, 512}; pg8::StaticOrder so; so.init(S, 4096, G, b);
        pg8::EpiKV E{p.ka, p.va, p.kpe, p.ssq, p.mla_kg, p.ropeT, (LAS float*)(lds + 131072 + 64)};
        pg8::gemm_phase<pg8::EpiKV, pg8::StaticOrder, true, true>(lds, g, so, E);
    }
    xcd_barrier(bar);
    REP(3) for (int L = b; L < 1024; L += G) {
        const int i = L >> 8, vc = L & 255, vcx = (vc & 7) * 32 + (vc >> 3), hh = vcx >> 4, x = vcx & 15, qbk = (i & 1) ? x : 31 - x;
        if (i < 2) att::attn_block<192, false>(smem, p.qa + hh * 192, 3072, p.ka + hh * 192, 3072, p.va + hh * 128, 2048, nullptr, p.merged + hh * 128, p.attout + hh * 128, qbk, nullptr, nullptr);
        else att::attn_block<128, true>(smem, p.fq + hh * 128, 2048, p.fk + hh * 128, 2048, p.fv + hh * 128, 2048, p.F + (size_t)hh * S, p.merged + 2048 + hh * 128, p.attout + 2048 + hh * 128, qbk, p.fox_qg, p.fox_kg);
    }
    xcd_barrier(bar);
    REP(4) {
        pg8::Gemm g{p.attout, p.WoT, S, 2048, 4096}; pg8::StaticOrder so; so.init(S, 2048, G, b);
        pg8::EpiStoreF32<true> E{p.x1, p.x, 2048};
        pg8::gemm_phase<pg8::EpiStoreF32<true>, pg8::StaticOrder, true, true>(lds, g, so, E);
    }
    xcd_barrier(bar);
    { PHASE_IDS(); for (int m = gw; m < S; m += NGW) rms_row2048(p.x1 + (size_t)m * DM, p.ffn_g, p.h + (size_t)m * DM, lane);
      cvt_rows_fp8(p.peer_u, p.U8, (size_t)16384 * 2048, U_SCALE, gw, NGW, lane); cvt_rows_fp8(p.peer_v, p.V8, (size_t)16384 * 2048, V_SCALE, gw, NGW, lane); }
    xcd_barrier(bar);
    REP(5) {
        pg8::Gemm g{p.h, p.WpT, S, 2048, 2048}; pg8::StaticOrder so; so.init(S, 2048, G, b);
        pg8::EpiStoreF32<false> E{p.scores, nullptr, 2048};
        pg8::gemm_phase<pg8::EpiStoreF32<false>, pg8::StaticOrder, true, true>(lds, g, so, E);
    }
    xcd_barrier(bar);
    REP(6) for (int g = b; g < S / 32; g += G) peer_group(smem, g, p.scores, p.h, p.x1, p.U8, p.V8, p.out);
}

extern "C" void kernel_launch(void* const* d_in, const int* in_sizes, int n_in,
                              void* d_out, int out_size, void* d_ws, size_t ws_size,
                              hipStream_t stream) {
    if (ws_size < 512 * MiB) { fprintf(stderr, "kernel_launch: workspace too small (%zu)\n", ws_size); return; }
    Params p{};
    p.x = (const float*)d_in[0]; p.pos = (const int*)d_in[1]; p.mix_g = (const float*)d_in[2]; p.w_in = (const float*)d_in[3];
    p.b_forget = (const float*)d_in[4]; p.b_gate = (const float*)d_in[5]; p.q_lat_g = (const float*)d_in[6]; p.w_q_up = (const float*)d_in[7];
    p.kv_lat_g = (const float*)d_in[8]; p.w_kv_up = (const float*)d_in[9]; p.mla_qg = (const float*)d_in[10]; p.mla_kg = (const float*)d_in[11];
    p.fox_qg = (const float*)d_in[12]; p.fox_kg = (const float*)d_in[13]; p.w_out = (const float*)d_in[14]; p.ffn_g = (const float*)d_in[15];
    p.w_peer_q = (const float*)d_in[16]; p.sub_keys = (const float*)d_in[17]; p.peer_u = (const float*)d_in[18]; p.peer_v = (const float*)d_in[19];
    p.out = (float*)d_out;
    char* ws = (char*)d_ws;
    p.WqT = (bf16_t*)(ws + 1 * MiB); p.WkvT = (bf16_t*)(ws + 5 * MiB); p.WoT = (bf16_t*)(ws + 9 * MiB); p.WpT = (bf16_t*)(ws + 25 * MiB); p.WinT = (bf16_t*)(ws + 33 * MiB);
    p.h = (bf16_t*)(ws + 78 * MiB); p.cq = (bf16_t*)(ws + 110 * MiB); p.ckv = (bf16_t*)(ws + 118 * MiB);
    p.fq = (bf16_t*)(ws + 126 * MiB); p.fk = (bf16_t*)(ws + 158 * MiB); p.fv = (bf16_t*)(ws + 190 * MiB); p.merged = (bf16_t*)(ws + 222 * MiB);
    p.kpe = (bf16_t*)(ws + 286 * MiB); p.lf = (float*)(ws + 287 * MiB); p.F = (float*)(ws + 287 * MiB + 512 * 1024);
    p.qa = (bf16_t*)(ws + 288 * MiB); p.va = (bf16_t*)(ws + 336 * MiB); p.ka = (bf16_t*)(ws + 400 * MiB); p.x1 = (float*)(ws + 448 * MiB);
    p.scores = (float*)(ws + 222 * MiB);
    p.ctl = (unsigned*)ws;
    p.ropeT = (float2*)(ws + 448 * MiB);
    p.ssq = (float*)(ws + 64 * 1024);
    p.attout = (bf16_t*)(ws + 33 * MiB);
    p.U8 = (unsigned char*)(ws + 126 * MiB); p.V8 = (unsigned char*)(ws + 158 * MiB);

    static int grid_blocks = 0;
    if (!grid_blocks) {
        if (hipFuncSetAttribute((const void*)mega, hipFuncAttributeMaxDynamicSharedMemorySize, LDS_BYTES) != hipSuccess) { fprintf(stderr, "hipFuncSetAttribute failed\n"); return; }
        int dev = 0, cus = 0, per_cu = 0;
        (void)hipGetDevice(&dev);
        (void)hipDeviceGetAttribute(&cus, hipDeviceAttributeMultiprocessorCount, dev);
        (void)hipOccupancyMaxActiveBlocksPerMultiprocessor(&per_cu, (const void*)mega, 512, LDS_BYTES);
        if (per_cu < 1 || cus < 1) { fprintf(stderr, "occupancy query says %d blocks/CU on %d CUs\n", per_cu, cus); return; }
        grid_blocks = cus;
    }
    if (hipMemsetAsync(d_ws, 0, 16384, stream) != hipSuccess) { fprintf(stderr, "memset of the barrier words failed\n"); return; }
    void* args[] = {&p};
    hipError_t e = hipLaunchCooperativeKernel((const void*)mega, dim3(grid_blocks), dim3(512), args, LDS_BYTES, stream);
    if (e != hipSuccess) fprintf(stderr, "cooperative launch failed: %s (grid %d)\n", hipGetErrorString(e), grid_blocks);
}
```

```cpp
#include <hip/hip_runtime.h>
#include <hip/hip_cooperative_groups.h>
#include <stdint.h>
#include <math.h>
#include <cstdio>
namespace cg = cooperative_groups;

namespace pg8 {
#define PG8_LAS __attribute__((address_space(3)))
typedef unsigned short bf16_t;
typedef short bf16x8 __attribute__((ext_vector_type(8)));
typedef float f32x4 __attribute__((ext_vector_type(4)));
typedef unsigned u32x4 __attribute__((ext_vector_type(4)));
constexpr int BM = 256, BK = 64, HALF = 128, HTB = HALF * BK * 2  , STAGE_BYTES = 8 * HTB, NXCD = 8, WGM = 8;

__host__ __device__ __forceinline__ int lds_byte(int r, int c) { const int st = (r >> 4) * 2 + (c >> 5), rr = r & 15, cc = c & 31, ob = rr * 64 + cc * 2; return st * 1024 + (ob ^ (((ob >> 9) & 1) << 5)); }
__host__ __device__ __forceinline__ void stage_rc(int b, int& R, int& C) { const int st = b / 1024, sb = b % 1024, swz = sb ^ (((sb >> 9) & 1) << 5); R = (st >> 1) * 16 + swz / 64; C = (st & 1) * 32 + (swz % 64) / 2; }
__host__ __device__ __forceinline__ int perm32(int rho) { const int n = rho >> 4, i = rho & 15; return 8 * (i >> 2) + 4 * n + (i & 3); }

struct Unit { int pm, pn; };
struct Gemm { const bf16_t* A; const bf16_t* Bt; int M, N, K; };

struct StaticOrder {
    int nM, nN, nwg, G, c;
    __host__ __device__ void init(int M, int N, int G_, int c_) { nM = M / BM; nN = N / BM; nwg = nM * nN; G = G_; c = c_; }
    __host__ __device__ bool next(int i, Unit& u) const {
        const long L = (long)i * G + c; if (L >= nwg) return false;
        int wgid = (int)L; { const int q = nwg / NXCD, r = nwg % NXCD, xcd = wgid % NXCD, off = wgid / NXCD; wgid = (xcd < r ? xcd * (q + 1) : r * (q + 1) + (xcd - r) * q) + off; }
        const int nig = WGM * nN, gid = wgid / nig, fm = gid * WGM, gsz = (nM - fm) < WGM ? (nM - fm) : WGM;
        u.pm = fm + ((wgid % nig) % gsz); u.pn = (wgid % nig) / gsz; return true;
    }
    __device__ __forceinline__ void a_ready(const Unit&) const {}
    __device__ __forceinline__ void done(const Unit&) const {}
};

__device__ __forceinline__ unsigned cvt_pk_bf16(float lo, float hi) { unsigned r; asm volatile("v_cvt_pk_bf16_f32 %0, %1, %2" : "=v"(r) : "v"(lo), "v"(hi)); return r; }
__device__ __forceinline__ u32x4 pack8bf(const f32x4& v0, const f32x4& v1) { u32x4 w; w.x = cvt_pk_bf16(v0[0], v0[1]); w.y = cvt_pk_bf16(v0[2], v0[3]); w.z = cvt_pk_bf16(v1[0], v1[1]); w.w = cvt_pk_bf16(v1[2], v1[3]); return w; }

struct EpiStoreBf16 {
    static constexpr bool PERM = true, AFTER_DRAIN = false;
    bf16_t* O; int ldc;
    __device__ __forceinline__ void operator()(const f32x4 (&acc)[2][2][4][2], const Unit& u, int wr, int wc, int fr, int fq) const {
        const int row0 = u.pm * BM + wr * 64 + fr, col0 = u.pn * BM + wc * 32 + 8 * fq;
#pragma unroll
        for (int ai = 0; ai < 2; ++ai)
#pragma unroll
            for (int m = 0; m < 4; ++m) { bf16_t* rowp = O + (size_t)(row0 + ai * HALF + m * 16) * ldc + col0;
#pragma unroll
                for (int bj = 0; bj < 2; ++bj) *(u32x4*)(rowp + bj * HALF) = pack8bf(acc[ai][bj][m][0], acc[ai][bj][m][1]); }
    }
};
template <bool RES> struct EpiStoreF32 {
    static constexpr bool PERM = true, AFTER_DRAIN = false;
    float* O; const float* res; int ldc;
    __device__ __forceinline__ void operator()(const f32x4 (&acc)[2][2][4][2], const Unit& u, int wr, int wc, int fr, int fq) const {
        const int row0 = u.pm * BM + wr * 64 + fr, col0 = u.pn * BM + wc * 32 + 8 * fq;
#pragma unroll
        for (int ai = 0; ai < 2; ++ai)
#pragma unroll
            for (int m = 0; m < 4; ++m) { const size_t off = (size_t)(row0 + ai * HALF + m * 16) * ldc + col0;
#pragma unroll
                for (int bj = 0; bj < 2; ++bj) { f32x4 v0 = acc[ai][bj][m][0], v1 = acc[ai][bj][m][1];
                    if (RES) { v0 += *(const f32x4*)(res + off + bj * HALF); v1 += *(const f32x4*)(res + off + bj * HALF + 4); }
                    *(f32x4*)(O + off + bj * HALF) = v0; *(f32x4*)(O + off + bj * HALF + 4) = v1; } }
    }
};
#define EPI_LDSBAR() do { asm volatile("s_waitcnt lgkmcnt(0)" ::: "memory"); __builtin_amdgcn_s_barrier(); asm volatile("" ::: "memory"); } while (0)
struct EpiInProj {
    static constexpr bool PERM = true, AFTER_DRAIN = false;
    bf16_t *cq, *ckv, *fq, *fk, *fv, *gates, *kpe; float* lf; const float *b_gate, *b_forget; float* ssq; const float *gfq, *gfk; PG8_LAS float* xs;
    __device__ __forceinline__ void operator()(const f32x4 (&acc)[2][2][4][2], const Unit& u, int wr, int wc, int fr, int fq_) const {
        const int pn = u.pn, row0 = u.pm * BM + wr * 64 + fr, cw = wc * 32 + 8 * fq_;
        if (pn < 4) {
            bf16_t* base = pn < 2 ? cq : ckv; const int colt = (pn & 1) * 256;
#pragma unroll
            for (int ai = 0; ai < 2; ++ai)
#pragma unroll
                for (int m = 0; m < 4; ++m) { const int row = row0 + ai * HALF + m * 16; bf16_t* rowp = base + (size_t)row * 512 + colt + cw; float s = 0.f;
#pragma unroll
                    for (int bj = 0; bj < 2; ++bj) { const f32x4 v0 = acc[ai][bj][m][0], v1 = acc[ai][bj][m][1];
                        s += (v0[0] * v0[0] + v0[1] * v0[1]) + (v0[2] * v0[2] + v0[3] * v0[3]) + (v1[0] * v1[0] + v1[1] * v1[1]) + (v1[2] * v1[2] + v1[3] * v1[3]);
                        *(u32x4*)(rowp + bj * HALF) = pack8bf(v0, v1); }
                    s += __shfl_xor(s, 16); s += __shfl_xor(s, 32);
                    if (fq_ == 0) ssq[((size_t)pn * 8192 + row) * 4 + wc] = s; }
        } else if (pn < 20) {
            const bool isq = pn < 12; bf16_t* base = isq ? fq : fk; const int colt = (pn - (isq ? 4 : 12)) * 256; const float* g = isq ? gfq : gfk;
            const float qs = isq ? 0.12751743f : 1.f;
#pragma unroll
            for (int ai = 0; ai < 2; ++ai)
#pragma unroll
                for (int m = 0; m < 4; ++m)
#pragma unroll
                    for (int bj = 0; bj < 2; ++bj) { const f32x4 v0 = acc[ai][bj][m][0], v1 = acc[ai][bj][m][1];
                        float s = (v0[0] * v0[0] + v0[1] * v0[1]) + (v0[2] * v0[2] + v0[3] * v0[3]) + (v1[0] * v1[0] + v1[1] * v1[1]) + (v1[2] * v1[2] + v1[3] * v1[3]);
                        s += __shfl_xor(s, 16); s += __shfl_xor(s, 32);
                        if (fq_ == 0) xs[((ai * HALF + wr * 64 + m * 16 + fr) * 2 + bj) * 4 + wc] = s; }
            EPI_LDSBAR();
            const f32x4 g0 = *(const f32x4*)(g + cw) * qs, g1 = *(const f32x4*)(g + cw + 4) * qs;
#pragma unroll
            for (int ai = 0; ai < 2; ++ai)
#pragma unroll
                for (int m = 0; m < 4; ++m) { bf16_t* rowp = base + (size_t)(row0 + ai * HALF + m * 16) * 2048 + colt + cw;
#pragma unroll
                    for (int bj = 0; bj < 2; ++bj) { const f32x4 t4 = *(const PG8_LAS f32x4*)(xs + ((ai * HALF + wr * 64 + m * 16 + fr) * 2 + bj) * 4);
                        const float r = rsqrtf(((t4[0] + t4[1]) + (t4[2] + t4[3])) * (1.f / 128.f) + 1e-6f);
                        *(u32x4*)(rowp + bj * HALF) = pack8bf(acc[ai][bj][m][0] * g0 * r, acc[ai][bj][m][1] * g1 * r); } }
        } else if (pn < 28) {
            const int colt = (pn - 20) * 256;
#pragma unroll
            for (int ai = 0; ai < 2; ++ai)
#pragma unroll
                for (int m = 0; m < 4; ++m) { bf16_t* rowp = fv + (size_t)(row0 + ai * HALF + m * 16) * 2048 + colt + cw;
#pragma unroll
                    for (int bj = 0; bj < 2; ++bj) *(u32x4*)(rowp + bj * HALF) = pack8bf(acc[ai][bj][m][0], acc[ai][bj][m][1]); }
        } else if (pn < 44) {
            const int colt = (pn - 28) * 256 + cw;
#pragma unroll
            for (int bj = 0; bj < 2; ++bj) {
                const f32x4 b0 = *(const f32x4*)(b_gate + colt + bj * HALF), b1 = *(const f32x4*)(b_gate + colt + bj * HALF + 4);
#pragma unroll
                for (int ai = 0; ai < 2; ++ai)
#pragma unroll
                    for (int m = 0; m < 4; ++m) {
                        f32x4 v0 = acc[ai][bj][m][0] + b0, v1 = acc[ai][bj][m][1] + b1;
#pragma unroll
                        for (int e = 0; e < 4; ++e) { v0[e] = 1.f / (1.f + __expf(-v0[e])); v1[e] = 1.f / (1.f + __expf(-v1[e])); }
                        *(u32x4*)(gates + (size_t)(row0 + ai * HALF + m * 16) * 4096 + colt + bj * HALF) = pack8bf(v0, v1); }
            }
        } else {
            if (cw < 64) {
#pragma unroll
                for (int ai = 0; ai < 2; ++ai)
#pragma unroll
                    for (int m = 0; m < 4; ++m) *(u32x4*)(kpe + (size_t)(row0 + ai * HALF + m * 16) * 64 + cw) = pack8bf(acc[ai][0][m][0], acc[ai][0][m][1]);
            } else if (cw < 80) {
                const int h0 = cw - 64;
                const f32x4 b0 = *(const f32x4*)(b_forget + h0), b1 = *(const f32x4*)(b_forget + h0 + 4);
#pragma unroll
                for (int ai = 0; ai < 2; ++ai)
#pragma unroll
                    for (int m = 0; m < 4; ++m) { const int row = row0 + ai * HALF + m * 16;
                        f32x4 z0 = acc[ai][0][m][0] + b0, z1 = acc[ai][0][m][1] + b1;
#pragma unroll
                        for (int e = 0; e < 4; ++e) { z0[e] = fminf(z0[e], 0.f) - __logf(1.f + __expf(-fabsf(z0[e]))); z1[e] = fminf(z1[e], 0.f) - __logf(1.f + __expf(-fabsf(z1[e]))); }
                        *(f32x4*)(lf + (size_t)row * 16 + h0) = z0; *(f32x4*)(lf + (size_t)row * 16 + h0 + 4) = z1; }
            }
        }
    }
};
__device__ __forceinline__ float lat_rinv(const float* ssq, int part0, int row) {
    const f32x4 a = *(const f32x4*)(ssq + ((size_t)part0 * 8192 + row) * 4), b = *(const f32x4*)(ssq + ((size_t)(part0 + 1) * 8192 + row) * 4);
    return rsqrtf((((a[0] + a[1]) + (a[2] + a[3])) + ((b[0] + b[1]) + (b[2] + b[3]))) * (1.f / 512.f) + 1e-6f);
}
struct EpiQ {
    static constexpr bool PERM = true, AFTER_DRAIN = false;
    bf16_t* qa; const float* ssq; const float* gq; const float2* ropeT; PG8_LAS float* xs;
    __device__ __forceinline__ void operator()(const f32x4 (&acc)[2][2][4][2], const Unit& u, int wr, int wc, int fr, int fq_) const {
        const int h = u.pn, row0 = u.pm * BM + wr * 64 + fr, cw = wc * 32 + 8 * fq_;
        float rl[2][4];
#pragma unroll
        for (int ai = 0; ai < 2; ++ai)
#pragma unroll
            for (int m = 0; m < 4; ++m) { rl[ai][m] = lat_rinv(ssq, 0, row0 + ai * HALF + m * 16); float s = 0.f;
#pragma unroll
                for (int bj = 0; bj < 2; ++bj) { const f32x4 v0 = acc[ai][bj][m][0], v1 = acc[ai][bj][m][1];
                    s += (v0[0] * v0[0] + v0[1] * v0[1]) + (v0[2] * v0[2] + v0[3] * v0[3]) + (v1[0] * v1[0] + v1[1] * v1[1]) + (v1[2] * v1[2] + v1[3] * v1[3]); }
                s *= rl[ai][m] * rl[ai][m];
                s += __shfl_xor(s, 16); s += __shfl_xor(s, 32);
                if (fq_ == 0) xs[(ai * HALF + wr * 64 + m * 16 + fr) * 4 + wc] = s; }
        EPI_LDSBAR();
        const float qs = 0.10411754f;
        const f32x4 g0 = *(const f32x4*)(gq + cw) * qs, g1 = *(const f32x4*)(gq + cw + 4) * qs;
        const int pp = 16 * (wc & 1) + 4 * fq_;
        const f32x4 ga = *(const f32x4*)(gq + 128 + pp) * qs, gb = *(const f32x4*)(gq + 160 + pp) * qs;
#pragma unroll
        for (int ai = 0; ai < 2; ++ai)
#pragma unroll
            for (int m = 0; m < 4; ++m) { const int row = row0 + ai * HALF + m * 16;
                const f32x4 t4 = *(const PG8_LAS f32x4*)(xs + (ai * HALF + wr * 64 + m * 16 + fr) * 4);
                const float r = rsqrtf(((t4[0] + t4[1]) + (t4[2] + t4[3])) * (1.f / 192.f) + 1e-6f) * rl[ai][m];
                bf16_t* rowp = qa + (size_t)row * 3072 + h * 192;
                *(u32x4*)(rowp + cw) = pack8bf(acc[ai][0][m][0] * g0 * r, acc[ai][0][m][1] * g1 * r);
                if (wc < 2) { const f32x4 c01 = *(const f32x4*)(ropeT + (size_t)row * 32 + pp), c23 = *(const f32x4*)(ropeT + (size_t)row * 32 + pp + 2);
                    const f32x4 z0 = acc[ai][1][m][0] * r, z1 = acc[ai][1][m][1] * r;
                    const float a0 = z0[0] * ga[0], b0 = z0[1] * gb[0], a1 = z0[2] * ga[1], b1 = z0[3] * gb[1], a2 = z1[0] * ga[2], b2 = z1[1] * gb[2], a3 = z1[2] * ga[3], b3 = z1[3] * gb[3];
                    const f32x4 o0 = {a0 * c01[0] - b0 * c01[1], a0 * c01[1] + b0 * c01[0], a1 * c01[2] - b1 * c01[3], a1 * c01[3] + b1 * c01[2]};
                    const f32x4 o1 = {a2 * c23[0] - b2 * c23[1], a2 * c23[1] + b2 * c23[0], a3 * c23[2] - b3 * c23[3], a3 * c23[3] + b3 * c23[2]};
                    *(u32x4*)(rowp + 128 + cw) = pack8bf(o0, o1); } }
    }
};
struct EpiKV {
    static constexpr bool PERM = true, AFTER_DRAIN = false;
    bf16_t *ka, *va; const bf16_t* kpe; const float* ssq; const float* gk; const float2* ropeT; PG8_LAS float* xs;
    __device__ __forceinline__ void operator()(const f32x4 (&acc)[2][2][4][2], const Unit& u, int wr, int wc, int fr, int fq_) const {
        const int h = u.pn, row0 = u.pm * BM + wr * 64 + fr, cw = wc * 32 + 8 * fq_;
        float rl[2][4]; f32x4 kp[2][4];
#pragma unroll
        for (int ai = 0; ai < 2; ++ai)
#pragma unroll
            for (int m = 0; m < 4; ++m) { const int row = row0 + ai * HALF + m * 16; rl[ai][m] = lat_rinv(ssq, 2, row);
                const uint2 w = *(const uint2*)(kpe + (size_t)row * 64 + 16 * wc + 4 * fq_);
                kp[ai][m] = (f32x4){__uint_as_float(w.x << 16), __uint_as_float(w.x & 0xffff0000u), __uint_as_float(w.y << 16), __uint_as_float(w.y & 0xffff0000u)};
                const f32x4 v0 = acc[ai][0][m][0], v1 = acc[ai][0][m][1];
                float s = ((v0[0] * v0[0] + v0[1] * v0[1]) + (v0[2] * v0[2] + v0[3] * v0[3]) + (v1[0] * v1[0] + v1[1] * v1[1]) + (v1[2] * v1[2] + v1[3] * v1[3])) * (rl[ai][m] * rl[ai][m]);
                s += (kp[ai][m][0] * kp[ai][m][0] + kp[ai][m][1] * kp[ai][m][1]) + (kp[ai][m][2] * kp[ai][m][2] + kp[ai][m][3] * kp[ai][m][3]);
                s += __shfl_xor(s, 16); s += __shfl_xor(s, 32);
                if (fq_ == 0) xs[(ai * HALF + wr * 64 + m * 16 + fr) * 4 + wc] = s;
                *(u32x4*)(va + (size_t)row * 2048 + h * 128 + cw) = pack8bf(acc[ai][1][m][0] * rl[ai][m], acc[ai][1][m][1] * rl[ai][m]); }
        EPI_LDSBAR();
        const f32x4 g0 = *(const f32x4*)(gk + cw), g1 = *(const f32x4*)(gk + cw + 4);
        const int pp = 8 * wc + 2 * fq_;
        const float ga0 = gk[128 + pp], ga1 = gk[128 + pp + 1], gb0 = gk[160 + pp], gb1 = gk[160 + pp + 1];
#pragma unroll
        for (int ai = 0; ai < 2; ++ai)
#pragma unroll
            for (int m = 0; m < 4; ++m) { const int row = row0 + ai * HALF + m * 16;
                const f32x4 t4 = *(const PG8_LAS f32x4*)(xs + (ai * HALF + wr * 64 + m * 16 + fr) * 4);
                const float r = rsqrtf(((t4[0] + t4[1]) + (t4[2] + t4[3])) * (1.f / 192.f) + 1e-6f), rn = r * rl[ai][m];
                bf16_t* rowp = ka + (size_t)row * 3072 + h * 192;
                *(u32x4*)(rowp + cw) = pack8bf(acc[ai][0][m][0] * g0 * rn, acc[ai][0][m][1] * g1 * rn);
                const f32x4 cs = *(const f32x4*)(ropeT + (size_t)row * 32 + pp);
                const float a0 = kp[ai][m][0] * r * ga0, b0 = kp[ai][m][1] * r * gb0, a1 = kp[ai][m][2] * r * ga1, b1 = kp[ai][m][3] * r * gb1;
                uint2 o; o.x = cvt_pk_bf16(a0 * cs[0] - b0 * cs[1], a0 * cs[1] + b0 * cs[0]); o.y = cvt_pk_bf16(a1 * cs[2] - b1 * cs[3], a1 * cs[3] + b1 * cs[2]);
                *(uint2*)(rowp + 128 + 16 * wc + 4 * fq_) = o; }
    }
};

struct EpiX1 {
    static constexpr bool PERM = true, AFTER_DRAIN = false;
    float* x1; const float* x; bf16_t* xg; const float* g; float* ssq2;
    __device__ __forceinline__ void operator()(const f32x4 (&acc)[2][2][4][2], const Unit& u, int wr, int wc, int fr, int fq_) const {
        const int row0 = u.pm * BM + wr * 64 + fr, col0 = u.pn * BM + wc * 32 + 8 * fq_;
        f32x4 gg[2][2];
#pragma unroll
        for (int bj = 0; bj < 2; ++bj) { gg[bj][0] = *(const f32x4*)(g + col0 + bj * HALF); gg[bj][1] = *(const f32x4*)(g + col0 + bj * HALF + 4); }
#pragma unroll
        for (int ai = 0; ai < 2; ++ai)
#pragma unroll
            for (int m = 0; m < 4; ++m) { const int row = row0 + ai * HALF + m * 16; const size_t off = (size_t)row * 2048 + col0; float s = 0.f;
#pragma unroll
                for (int bj = 0; bj < 2; ++bj) { const f32x4 v0 = acc[ai][bj][m][0] + *(const f32x4*)(x + off + bj * HALF), v1 = acc[ai][bj][m][1] + *(const f32x4*)(x + off + bj * HALF + 4);
                    *(f32x4*)(x1 + off + bj * HALF) = v0; *(f32x4*)(x1 + off + bj * HALF + 4) = v1;
                    s += (v0[0] * v0[0] + v0[1] * v0[1]) + (v0[2] * v0[2] + v0[3] * v0[3]) + (v1[0] * v1[0] + v1[1] * v1[1]) + (v1[2] * v1[2] + v1[3] * v1[3]);
                    *(u32x4*)(xg + off + bj * HALF) = pack8bf(v0 * gg[bj][0], v1 * gg[bj][1]); }
                s += __shfl_xor(s, 16); s += __shfl_xor(s, 32);
                if (fq_ == 0) ssq2[((size_t)u.pn * 8192 + row) * 4 + wc] = s; }
    }
};
__device__ __forceinline__ float ffn_rinv(const float* ssq2, int row) {
    float t = 0.f;
#pragma unroll
    for (int pn = 0; pn < 8; ++pn) { const f32x4 a = *(const f32x4*)(ssq2 + ((size_t)pn * 8192 + row) * 4); t += (a[0] + a[1]) + (a[2] + a[3]); }
    return rsqrtf(t * (1.f / 2048.f) + 1e-6f);
}
struct EpiScores {
    static constexpr bool PERM = true, AFTER_DRAIN = false;
    float* O; const float* ssq2;
    __device__ __forceinline__ void operator()(const f32x4 (&acc)[2][2][4][2], const Unit& u, int wr, int wc, int fr, int fq_) const {
        const int row0 = u.pm * BM + wr * 64 + fr, col0 = u.pn * BM + wc * 32 + 8 * fq_;
#pragma unroll
        for (int ai = 0; ai < 2; ++ai)
#pragma unroll
            for (int m = 0; m < 4; ++m) { const int row = row0 + ai * HALF + m * 16; const float r = ffn_rinv(ssq2, row); const size_t off = (size_t)row * 2048 + col0;
#pragma unroll
                for (int bj = 0; bj < 2; ++bj) { *(f32x4*)(O + off + bj * HALF) = acc[ai][bj][m][0] * r; *(f32x4*)(O + off + bj * HALF + 4) = acc[ai][bj][m][1] * r; } }
    }
};
template <class Epi, class Sched, bool ALIGN_EPI = false, bool SP2 = false>
__device__ __forceinline__ void gemm_phase(PG8_LAS unsigned char* lds, const Gemm g, const Sched& S, const Epi& E) {
    int tid = threadIdx.x; asm volatile("" : "+v"(tid));
    const int wid = __builtin_amdgcn_readfirstlane(tid >> 6), lane = tid & 63, wr = wid >> 2, wc = wid & 3, fr = lane & 15, fq = lane >> 4;
    const int K = g.K, nt = K / BK;
    unsigned voffA[2], voffB[2];
#pragma unroll
    for (int i = 0; i < 2; ++i) { int R, C; stage_rc(tid * 16 + i * 8192, R, C); const int Rb = Epi::PERM ? ((R & ~31) + perm32(R & 31)) : R;
        voffA[i] = (unsigned)(R * K + C) * 2u; voffB[i] = (unsigned)(Rb * K + C) * 2u; }
    const size_t kstep = (size_t)(BK * 2);
    const size_t hstep = (size_t)HALF * K * 2;
    const size_t tstep = 2 * hstep;
    const unsigned ldsw = (unsigned)wid * 1024u;
    const int aoff = lds_byte(wr * 64 + fr, fq * 8), boff = lds_byte(wc * 32 + fr, fq * 8);
#define PG8_SA(b, h) (((b) * 2 + (h)) * HTB)
#define PG8_SB(b, h) ((4 + (b) * 2 + (h)) * HTB)
#define PG8_STAGE(bufoff, gbase, voff) do { _Pragma("unroll") for (int _i = 0; _i < 2; ++_i) \
        __builtin_amdgcn_global_load_lds((const unsigned*)((const char*)(gbase) + (voff)[_i]), (PG8_LAS unsigned*)(lds + (bufoff) + ldsw + _i * 8192), 16, 0, 0); } while (0)
#define PG8_LDA(dst, b, h) do { _Pragma("unroll") for (int m = 0; m < 4; ++m) _Pragma("unroll") for (int k = 0; k < 2; ++k) dst[m][k] = *(const PG8_LAS bf16x8*)(lds + PG8_SA(b, h) + aoff + m * 2048 + k * 1024); } while (0)
#define PG8_LDB(dst, b, h) do { _Pragma("unroll") for (int n = 0; n < 2; ++n) _Pragma("unroll") for (int k = 0; k < 2; ++k) dst[n][k] = *(const PG8_LAS bf16x8*)(lds + PG8_SB(b, h) + boff + n * 2048 + k * 1024); } while (0)
#define PG8_MMA(ai, bj, At, Bt) do { __builtin_amdgcn_s_setprio(1); _Pragma("unroll") for (int m = 0; m < 4; ++m) _Pragma("unroll") for (int n = 0; n < 2; ++n) _Pragma("unroll") for (int k = 0; k < 2; ++k) \
        acc[ai][bj][m][n] = __builtin_amdgcn_mfma_f32_16x16x32_bf16(Bt[n][k], At[m][k], acc[ai][bj][m][n], 0, 0, 0); __builtin_amdgcn_s_setprio(0); } while (0)
#define PG8_WAIT_V(n) asm volatile("s_waitcnt vmcnt(" #n ")" ::: "memory")
#define PG8_WAIT_L(n) asm volatile("s_waitcnt lgkmcnt(" #n ")" ::: "memory")
#define PG8_BAR __builtin_amdgcn_s_barrier()
#define PG8_SCHED __builtin_amdgcn_sched_barrier(0)
    Unit cur, nxt; int ui = 0;
    if (!S.next(0, cur)) return;
    f32x4 acc[2][2][4][2];
#pragma unroll
    for (int a = 0; a < 2; ++a)
#pragma unroll
        for (int b = 0; b < 2; ++b)
#pragma unroll
            for (int m = 0; m < 4; ++m)
#pragma unroll
                for (int n = 0; n < 2; ++n) acc[a][b][m][n] = (f32x4){0.f, 0.f, 0.f, 0.f};
    bf16x8 At[4][2], B0[2][2], B1[2][2];
    const char* cA = (const char*)g.A + (size_t)cur.pm * tstep; const char* cB = (const char*)g.Bt + (size_t)cur.pn * tstep;
    S.a_ready(cur);
    if constexpr (SP2) {
        PG8_STAGE(PG8_SB(0, 0), cB, voffB); PG8_STAGE(PG8_SB(0, 1), cB + hstep, voffB); PG8_STAGE(PG8_SA(0, 0), cA, voffA); PG8_STAGE(PG8_SA(0, 1), cA + hstep, voffA);
        if (wr == 1) PG8_BAR;
        PG8_WAIT_V(2); PG8_BAR;
        PG8_STAGE(PG8_SB(1, 0), cB + kstep, voffB); PG8_STAGE(PG8_SA(1, 0), cA + kstep, voffA); PG8_STAGE(PG8_SB(1, 1), cB + hstep + kstep, voffB);
        PG8_WAIT_V(6); PG8_BAR;
    } else {
        PG8_STAGE(PG8_SB(0, 0), cB, voffB); PG8_STAGE(PG8_SA(0, 0), cA, voffA); PG8_STAGE(PG8_SB(0, 1), cB + hstep, voffB); PG8_STAGE(PG8_SA(0, 1), cA + hstep, voffA);
        if (wr == 1) PG8_BAR;
        PG8_WAIT_V(4); PG8_BAR;
        PG8_STAGE(PG8_SB(1, 0), cB + kstep, voffB); PG8_STAGE(PG8_SA(1, 0), cA + kstep, voffA); PG8_STAGE(PG8_SB(1, 1), cB + hstep + kstep, voffB);
        PG8_WAIT_V(6); PG8_BAR;
    }
    for (;;) {
        const bool has_next = S.next(ui + 1, nxt);
        const char* nA = has_next ? (const char*)g.A + (size_t)nxt.pm * tstep : cA; const char* nB = has_next ? (const char*)g.Bt + (size_t)nxt.pn * tstep : cB;
        for (int t = 0; t < nt; t += 2) {
            const bool last = (t == nt - 2);
            const char* a1 = cA + (size_t)(t + 1) * kstep;
            const char* a2 = last ? nA : cA + (size_t)(t + 2) * kstep; const char* b2 = last ? nB : cB + (size_t)(t + 2) * kstep;
            const char* a3 = a2 + kstep; const char* b3 = b2 + kstep;
            if (last && has_next) S.a_ready(nxt);
            if constexpr (SP2) {
            PG8_LDB(B0, 0, 0); PG8_LDB(B1, 0, 1); PG8_SCHED; PG8_LDA(At, 0, 0); PG8_STAGE(PG8_SA(1, 1), a1 + hstep, voffA);
            PG8_WAIT_V(8); PG8_WAIT_L(0); PG8_BAR; PG8_MMA(0, 0, At, B0); PG8_MMA(0, 1, At, B1); PG8_BAR; PG8_SCHED;
            PG8_LDA(At, 0, 1); PG8_STAGE(PG8_SB(0, 0), b2, voffB); PG8_STAGE(PG8_SB(0, 1), b2 + hstep, voffB); PG8_STAGE(PG8_SA(0, 0), a2, voffA);
            PG8_WAIT_V(8); PG8_WAIT_L(0); PG8_BAR; PG8_MMA(1, 0, At, B0); PG8_MMA(1, 1, At, B1); PG8_BAR; PG8_SCHED;
            PG8_LDB(B0, 1, 0); PG8_LDB(B1, 1, 1); PG8_SCHED; PG8_LDA(At, 1, 0); PG8_STAGE(PG8_SA(0, 1), a2 + hstep, voffA);
            PG8_WAIT_V(8); PG8_WAIT_L(0); PG8_BAR; PG8_MMA(0, 0, At, B0); PG8_MMA(0, 1, At, B1); PG8_BAR; PG8_SCHED;
            PG8_LDA(At, 1, 1); PG8_STAGE(PG8_SB(1, 0), b3, voffB); PG8_STAGE(PG8_SB(1, 1), b3 + hstep, voffB); PG8_STAGE(PG8_SA(1, 0), a3, voffA);
            PG8_WAIT_V(8); PG8_WAIT_L(0); PG8_BAR; PG8_MMA(1, 0, At, B0); PG8_MMA(1, 1, At, B1); PG8_BAR; PG8_SCHED;
            } else {
            PG8_LDB(B0, 0, 0); PG8_SCHED; PG8_LDA(At, 0, 0); PG8_STAGE(PG8_SA(1, 1), a1 + hstep, voffA);
            PG8_WAIT_L(8); PG8_BAR; PG8_WAIT_L(0); PG8_MMA(0, 0, At, B0); PG8_BAR; PG8_SCHED;
            PG8_LDB(B1, 0, 1); PG8_STAGE(PG8_SB(0, 0), b2, voffB);
            PG8_BAR; PG8_WAIT_L(0); PG8_MMA(0, 1, At, B1); PG8_BAR;
            PG8_LDA(At, 0, 1); PG8_STAGE(PG8_SA(0, 0), a2, voffA);
            PG8_BAR; PG8_WAIT_L(0); PG8_MMA(1, 0, At, B0); PG8_BAR; PG8_SCHED;
            PG8_STAGE(PG8_SB(0, 1), b2 + hstep, voffB);
            PG8_WAIT_V(6); PG8_BAR; PG8_MMA(1, 1, At, B1); PG8_BAR;
            PG8_LDB(B0, 1, 0); PG8_SCHED; PG8_LDA(At, 1, 0); PG8_STAGE(PG8_SA(0, 1), a2 + hstep, voffA);
            PG8_WAIT_L(8); PG8_BAR; PG8_WAIT_L(0); PG8_MMA(0, 0, At, B0); PG8_BAR; PG8_SCHED;
            PG8_LDB(B1, 1, 1); PG8_STAGE(PG8_SB(1, 0), b3, voffB);
            PG8_BAR; PG8_WAIT_L(0); PG8_MMA(0, 1, At, B1); PG8_BAR;
            PG8_LDA(At, 1, 1); PG8_STAGE(PG8_SA(1, 0), a3, voffA);
            PG8_BAR; PG8_WAIT_L(0); PG8_MMA(1, 0, At, B0); PG8_BAR; PG8_SCHED;
            PG8_STAGE(PG8_SB(1, 1), b3 + hstep, voffB);
            PG8_WAIT_V(6); PG8_BAR; PG8_MMA(1, 1, At, B1); PG8_BAR;
            }
        }
        if constexpr (ALIGN_EPI) { if (wr == 0) PG8_BAR; }
        if constexpr (!Epi::AFTER_DRAIN) { E(acc, cur, wr, wc, fr, fq); S.done(cur); }
        if (!has_next) break;
#pragma unroll
        for (int a = 0; a < 2; ++a)
#pragma unroll
            for (int b = 0; b < 2; ++b)
#pragma unroll
                for (int m = 0; m < 4; ++m)
#pragma unroll
                    for (int n = 0; n < 2; ++n) acc[a][b][m][n] = (f32x4){0.f, 0.f, 0.f, 0.f};
        cur = nxt; cA = nA; cB = nB; ++ui;
        if constexpr (ALIGN_EPI) { if (wr == 1) PG8_BAR; }
    }
    PG8_WAIT_V(0);
    if constexpr (!ALIGN_EPI) { if (wr == 0) PG8_BAR; }
    PG8_BAR;
    if constexpr (Epi::AFTER_DRAIN) { E.fused(acc, cur, wr, wc, fr, fq, lds, wid, lane); S.done(cur); }
#undef PG8_SA
#undef PG8_SB
#undef PG8_STAGE
#undef PG8_LDA
#undef PG8_LDB
#undef PG8_MMA
#undef PG8_WAIT_V
#undef PG8_WAIT_L
#undef PG8_BAR
#undef PG8_SCHED
}
}
namespace att {
typedef unsigned short bf16_t;
typedef short bf16x8 __attribute__((ext_vector_type(8)));
typedef short s16x4 __attribute__((ext_vector_type(4)));
typedef float f32x16 __attribute__((ext_vector_type(16)));
typedef float f32x4 __attribute__((ext_vector_type(4)));
typedef unsigned u32x4 __attribute__((ext_vector_type(4)));
#define ALAS __attribute__((address_space(3)))
#define ASBAR() __builtin_amdgcn_sched_barrier(0)
constexpr int SHM_V = 16384;
template <int DK> struct Lay { static constexpr int ROWB = DK * 2, SHM_K = 64 * ROWB, OFF_K = 2 * SHM_V, OFF_F = OFF_K + 2 * SHM_K, OFF_WS = OFF_F + 512, TOTAL = OFF_WS + 8 * 256; };

__device__ __forceinline__ int v_st(int k, int c) { const int kk = (k & ~0xC) | ((k & 4) << 1) | ((k & 8) >> 1); return ((kk >> 3) * 4 + (c >> 5)) * 512 + ((kk & 7) * 32 + (c & 31)) * 2; }
__device__ __forceinline__ int v_rd_base(int lane) { return ((lane & 3) << 3) | (((lane >> 2) & 3) << 6) | (((lane >> 4) & 1) << 5) | (((lane >> 5) & 1) << 8); }
__device__ __forceinline__ int crow(int r, int hi) { return (r & 3) + 8 * (r >> 2) + 4 * hi; }
__device__ __forceinline__ unsigned cvtpk(float lo, float hi) { unsigned r; asm volatile("v_cvt_pk_bf16_f32 %0, %1, %2" : "=v"(r) : "v"(lo), "v"(hi)); return r; }

__device__ __forceinline__ float wave_max_f(float v) {
#pragma unroll
    for (int o = 32; o >= 1; o >>= 1) v = fmaxf(v, __shfl_xor(v, o));
    return v;
}
template <int DK, bool FOX>
__device__ __forceinline__ void attn_block(unsigned char* smem, const bf16_t* __restrict__ Q, int ldq, const bf16_t* __restrict__ K, int ldk, const bf16_t* __restrict__ V, int ldv,
                                           const float* __restrict__ Fh, const bf16_t* __restrict__ gate, bf16_t* __restrict__ gout  , int qbk, const float* __restrict__ gq, const float* __restrict__ gk  ,
                                           const float* __restrict__ side_u, const float* __restrict__ side_v, unsigned char* __restrict__ side_u8, unsigned char* __restrict__ side_v8, int& side_next) {
    typedef Lay<DK> LY;
    constexpr int ND = DK / 16, NKC = DK / 8, NKI = (64 * NKC) / 512;
    int tid = threadIdx.x; asm volatile("" : "+v"(tid));
    const int wid = __builtin_amdgcn_readfirstlane(tid >> 6), lane = tid & 63, r32 = lane & 31, hi = lane >> 5;
    const int q0 = qbk * 256, qlo = q0 + wid * 32, qm = qlo + r32 - 4 * hi;
    const int NT = 4 * qbk + 4;
    ALAS unsigned char* lds = (ALAS unsigned char*)smem;
    ALAS float* F_lds = (ALAS float*)(lds + LY::OFF_F);
    ALAS float* wsl = (ALAS float*)(lds + LY::OFF_WS) + wid * 64;
    bf16x8 qr[ND];
#pragma unroll
    for (int d0 = 0; d0 < ND; ++d0) qr[d0] = *(const bf16x8*)(Q + (size_t)(qlo + r32) * ldq + d0 * 16 + hi * 8);
    const float fq = FOX ? Fh[qlo + r32] : 0.f;
    int kgo[NKI], vgo[2];
#pragma unroll
    for (int i = 0; i < NKI; ++i) { const int pp = (wid * NKI + i) * 64 + lane, row = pp / NKC, cpos = pp % NKC, ch = cpos ^ ((row >> 1) & 7); kgo[i] = row * ldk + ch * 8; }
#pragma unroll
    for (int i = 0; i < 2; ++i) { const int o = ((wid * 2 + i) * 64 + lane) * 16, st = o >> 9, e = (o & 511) >> 1, kk = (st >> 2) * 8 + (e >> 5), c = (st & 3) * 32 + (e & 31);
        const int k = (kk & ~0xC) | ((kk & 4) << 1) | ((kk & 8) >> 1); vgo[i] = k * ldv + c; }
    const int vb0 = (int)(uintptr_t)smem + v_rd_base(lane);
    int kbase[4];
#pragma unroll
    for (int dd = 0; dd < 4; ++dd) kbase[dd] = LY::OFF_K + r32 * LY::ROWB + (((((dd << 1) | hi) ^ ((r32 >> 1) & 7))) << 4);
    float stf = 0.f;
#define ATT_GLDS(kb, bf) do { _Pragma("unroll") for (int i = 0; i < NKI; ++i) \
            __builtin_amdgcn_global_load_lds((const unsigned*)(K + (size_t)(kb) * ldk + kgo[i]), (ALAS unsigned*)(lds + LY::OFF_K + (bf) * LY::SHM_K + (wid * NKI + i) * 1024), 16, 0, 0); \
        _Pragma("unroll") for (int i = 0; i < 2; ++i) \
            __builtin_amdgcn_global_load_lds((const unsigned*)(V + (size_t)(kb) * ldv + vgo[i]), (ALAS unsigned*)(lds + (bf) * SHM_V + (wid * 2 + i) * 1024), 16, 0, 0); \
        if (FOX && tid < 64) stf = Fh[(kb) + tid]; } while (0)
#define ATT_WRITEF(bf) do { if (FOX && tid < 64) F_lds[(bf) * 64 + tid] = stf; } while (0)
    int t_start = 0;
    if (FOX) {
        const float gqm = wave_max_f(fmaxf(fabsf(gq[lane]), fabsf(gq[lane + 64]))), gkm = wave_max_f(fmaxf(fabsf(gk[lane]), fabsf(gk[lane + 64])));
        const float qk_bound = 0.12751743f * 128.f * gqm * gkm;
        const float thr = 2.02f * qk_bound + 40.f, f0 = Fh[q0];
        const int j0 = lane, j1 = lane + 64;
        const bool c0 = (j0 < 4 * qbk) && (Fh[j0 * 64 + 63] - f0 >= thr), c1 = (j1 < 4 * qbk) && (Fh[(j1 < 4 * qbk ? j1 : 0) * 64 + 63] - f0 >= thr);
        t_start = __builtin_popcountll(__ballot(c0)) + __builtin_popcountll(__ballot(c1));
        t_start = __builtin_amdgcn_readfirstlane(t_start); }
    ATT_GLDS(t_start * 64, t_start & 1); ATT_WRITEF(t_start & 1);
    float m_reg = -1e30f, l_reg = 0.f; f32x16 o[4];
#pragma unroll
    for (int d = 0; d < 4; ++d)
#pragma unroll
        for (int r = 0; r < 16; ++r) o[d][r] = 0.f;
    for (int t = t_start; t < NT; ++t) {
        const int buf = t & 1, kb = t * 64;
        asm volatile("s_waitcnt vmcnt(0)" ::: "memory");
        __syncthreads();
        if (t + 1 < NT) ATT_GLDS(kb + 64, buf ^ 1);
        const bool side = side_next < 64; f32x4 sd0, sd1; size_t sd_off = 0;
        if (side) { const bool isv = side_next >= 32; sd_off = ((size_t)(blockIdx.x * 32 + (side_next & 31)) * 512 + tid) * 8;
            const float* sp = (isv ? side_v : side_u) + sd_off; sd0 = *(const f32x4*)sp; sd1 = *(const f32x4*)(sp + 4); }
        f32x16 p0, p1;
        if (FOX) {
#pragma unroll
            for (int g = 0; g < 4; ++g) { const f32x4 f0 = *(const ALAS f32x4*)(F_lds + buf * 64 + 8 * g + 4 * hi), f1 = *(const ALAS f32x4*)(F_lds + buf * 64 + 32 + 8 * g + 4 * hi);
#pragma unroll
                for (int e = 0; e < 4; ++e) { p0[4 * g + e] = fq - f0[e]; p1[4 * g + e] = fq - f1[e]; } }
        } else {
#pragma unroll
            for (int r = 0; r < 16; ++r) { p0[r] = 0.f; p1[r] = 0.f; }
        }
        __builtin_amdgcn_s_setprio(1);
#pragma unroll
        for (int d0 = 0; d0 < ND; ++d0) {
            ALAS const unsigned char* a = lds + buf * LY::SHM_K + kbase[d0 & 3] + (d0 >> 2) * 128;
            const bf16x8 b0 = *(const ALAS bf16x8*)a;
            const bf16x8 b1 = *(const ALAS bf16x8*)(a + 32 * LY::ROWB);
            p0 = __builtin_amdgcn_mfma_f32_32x32x16_bf16(b0, qr[d0], p0, 0, 0, 0);
            p1 = __builtin_amdgcn_mfma_f32_32x32x16_bf16(b1, qr[d0], p1, 0, 0, 0);
        }
        __builtin_amdgcn_s_setprio(0);
        if (kb + 63 > qlo) {
            const float NEG = -__builtin_inff(); const int dq = qm - kb;
#pragma unroll
            for (int r = 0; r < 16; ++r) { const int c = (r & 3) + 8 * (r >> 2); if (dq - c < 0) p0[r] = NEG; if (dq - c - 32 < 0) p1[r] = NEG; }
        }
        float pmax = p0[0];
#pragma unroll
        for (int r = 1; r < 16; ++r) pmax = fmaxf(pmax, p0[r]);
#pragma unroll
        for (int r = 0; r < 16; ++r) pmax = fmaxf(pmax, p1[r]);
        { auto rr = __builtin_amdgcn_permlane32_swap(__float_as_uint(pmax), __float_as_uint(pmax), false, false);
          pmax = fmaxf(__uint_as_float(rr[0]), __uint_as_float(rr[1])); }
        float mn, alpha;
        if (__builtin_expect(__all(pmax - m_reg <= 8.f), 1)) { mn = m_reg; alpha = 1.f; }
        else { mn = fmaxf(m_reg, pmax); alpha = __builtin_amdgcn_exp2f(m_reg - mn); m_reg = mn; }
        float ps = 0.f;
#pragma unroll
        for (int r = 0; r < 16; ++r) { p0[r] = __builtin_amdgcn_exp2f(p0[r] - mn); ps += p0[r]; }
#pragma unroll
        for (int r = 0; r < 16; ++r) { p1[r] = __builtin_amdgcn_exp2f(p1[r] - mn); ps += p1[r]; }
        { auto rr = __builtin_amdgcn_permlane32_swap(__float_as_uint(ps), __float_as_uint(ps), false, false);
          ps = __uint_as_float(rr[0]) + __uint_as_float(rr[1]); }
        l_reg = l_reg * alpha + ps;
        bf16x8 pa0, pa1, pa2, pa3;
#define ATT_PK4(P, B_, OUT) do { unsigned a0 = cvtpk(P[B_+0], P[B_+1]), a1 = cvtpk(P[B_+2], P[B_+3]); unsigned b0_ = cvtpk(P[B_+4], P[B_+5]), b1_ = cvtpk(P[B_+6], P[B_+7]); \
        auto r0 = __builtin_amdgcn_permlane32_swap(a0, b0_, false, false); auto r1 = __builtin_amdgcn_permlane32_swap(a1, b1_, false, false); \
        u32x4 w = {r0[0], r1[0], r0[1], r1[1]}; OUT = *reinterpret_cast<bf16x8*>(&w); } while (0)
        ATT_PK4(p0, 0, pa0); ATT_PK4(p0, 8, pa1); ATT_PK4(p1, 0, pa2); ATT_PK4(p1, 8, pa3);
        if (__any(alpha < 1.f)) {
            if (hi == 0) wsl[r32] = alpha;
            asm volatile("s_waitcnt lgkmcnt(0)" ::: "memory");
#pragma unroll
            for (int g = 0; g < 4; ++g) { const f32x4 al = *(const ALAS f32x4*)(wsl + 8 * g + 4 * hi);
#pragma unroll
                for (int d = 0; d < 4; ++d)
#pragma unroll
                    for (int e = 0; e < 4; ++e) o[d][4 * g + e] *= al[e]; }
        }
#define ATT_TRRD(dst, off) asm volatile("ds_read_b64_tr_b16 %0, %1 offset:%2" : "=&v"(dst) : "v"(vbb), "i"(off) : "memory")
#define ATT_PV(d0) do { s16x4 l0, l1, l2, l3, h0, h1, h2, h3; constexpr int b_ = (d0) * 512; \
        ATT_TRRD(l0, b_); ATT_TRRD(h0, b_ + 2048); ATT_TRRD(l1, b_ + 4096); ATT_TRRD(h1, b_ + 6144); ATT_TRRD(l2, b_ + 8192); ATT_TRRD(h2, b_ + 10240); ATT_TRRD(l3, b_ + 12288); ATT_TRRD(h3, b_ + 14336); \
        asm volatile("s_waitcnt lgkmcnt(0)" ::: "memory"); ASBAR(); \
        o[d0] = __builtin_amdgcn_mfma_f32_32x32x16_bf16(pa0, (bf16x8){l0[0], l0[1], l0[2], l0[3], h0[0], h0[1], h0[2], h0[3]}, o[d0], 0, 0, 0); \
        o[d0] = __builtin_amdgcn_mfma_f32_32x32x16_bf16(pa1, (bf16x8){l1[0], l1[1], l1[2], l1[3], h1[0], h1[1], h1[2], h1[3]}, o[d0], 0, 0, 0); \
        o[d0] = __builtin_amdgcn_mfma_f32_32x32x16_bf16(pa2, (bf16x8){l2[0], l2[1], l2[2], l2[3], h2[0], h2[1], h2[2], h2[3]}, o[d0], 0, 0, 0); \
        o[d0] = __builtin_amdgcn_mfma_f32_32x32x16_bf16(pa3, (bf16x8){l3[0], l3[1], l3[2], l3[3], h3[0], h3[1], h3[2], h3[3]}, o[d0], 0, 0, 0); } while (0)
        { const int vbb = vb0 + buf * SHM_V; __builtin_amdgcn_s_setprio(1); ATT_PV(0); ATT_PV(1); ATT_PV(2); ATT_PV(3); __builtin_amdgcn_s_setprio(0); }
        if (t + 1 < NT) ATT_WRITEF(buf ^ 1);
        if (side) { const bool isv = side_next >= 32; const float sc = isv ? 4.f : 64.f;
            auto pk = [](float a, float b, float c, float d) { int w = __builtin_amdgcn_cvt_pk_fp8_f32(fminf(fmaxf(a, -448.f), 448.f), fminf(fmaxf(b, -448.f), 448.f), 0, false);
                return (unsigned)__builtin_amdgcn_cvt_pk_fp8_f32(fminf(fmaxf(c, -448.f), 448.f), fminf(fmaxf(d, -448.f), 448.f), w, true); };
            uint2 o; o.x = pk(sd0[0] * sc, sd0[1] * sc, sd0[2] * sc, sd0[3] * sc); o.y = pk(sd1[0] * sc, sd1[1] * sc, sd1[2] * sc, sd1[3] * sc);
            *(uint2*)((isv ? side_v8 : side_u8) + sd_off) = o; ++side_next; }
    }
    if (hi == 0) wsl[r32] = l_reg;
    asm volatile("s_waitcnt lgkmcnt(0)" ::: "memory");
#pragma unroll
    for (int r = 0; r < 16; ++r) {
        const int orow = crow(r, hi); const float rli = __builtin_amdgcn_rcpf(wsl[orow]);
        bf16_t* rowp = gout + (size_t)(qlo + orow) * 4096; const bf16_t* growp = gate + (size_t)(qlo + orow) * 4096;
#pragma unroll
        for (int d0 = 0; d0 < 4; ++d0) {
            const float v = o[d0][r] * rli; const float vn = __shfl_xor(v, 1);
            if ((r32 & 1) == 0) { unsigned* gp = (unsigned*)(rowp + d0 * 32 + r32); const unsigned g = *(const unsigned*)(growp + d0 * 32 + r32);
                *gp = cvtpk(v * __uint_as_float(g << 16), vn * __uint_as_float(g & 0xffff0000u)); }
        }
    }
    __syncthreads();
#undef ATT_GLDS
#undef ATT_WRITEF
#undef ATT_PK4
#undef ATT_TRRD
#undef ATT_PV
}
}
using pg8::bf16_t; using pg8::f32x4; using pg8::u32x4;
#define LAS __attribute__((address_space(3)))
constexpr int S = 8192, DM = 2048, INW = 11344, INWP = 11520;
constexpr float EPS = 1e-6f;
constexpr size_t MiB = 1u << 20;

__device__ __forceinline__ float bf2f(bf16_t v) { return __uint_as_float(((unsigned)v) << 16); }
__device__ __forceinline__ bf16_t f2bf(float f) { unsigned u = __float_as_uint(f); u += 0x7fffu + ((u >> 16) & 1u); return (bf16_t)(u >> 16); }
__device__ __forceinline__ unsigned pk2(float lo, float hi) { return (unsigned)f2bf(lo) | ((unsigned)f2bf(hi) << 16); }
__device__ __forceinline__ float wave_sum(float v) {
#pragma unroll
    for (int o = 32; o >= 1; o >>= 1) v += __shfl_xor(v, o);
    return v;
}
__device__ __forceinline__ float wave_max(float v) {
#pragma unroll
    for (int o = 32; o >= 1; o >>= 1) v = fmaxf(v, __shfl_xor(v, o));
    return v;
}

__device__ __forceinline__ int opaque_tid() { int t = threadIdx.x; asm volatile("" : "+v"(t)); return t; }

struct Params {
    const float* x; const int* pos; const float *mix_g, *w_in, *b_forget, *b_gate, *q_lat_g, *w_q_up, *kv_lat_g, *w_kv_up, *mla_qg, *mla_kg, *fox_qg, *fox_kg, *w_out, *ffn_g, *w_peer_q, *sub_keys, *peer_u, *peer_v;
    float* out;
    bf16_t *WqT, *WkvT, *WoT, *WpT, *WinT;
    bf16_t *h, *cq, *ckv, *fq, *fk, *fv, *merged, *kpe, *qa, *va, *ka;
    float *lf, *F, *x1, *scores;
    unsigned char *U8, *V8; bf16_t* attout;
    unsigned* ctl;
    float2* ropeT; float* ssq; float* ssq2; bf16_t* xg;
};

struct DstId { __device__ __forceinline__ int operator()(int n) const { return n; } };
struct DstWin { __device__ __forceinline__ int operator()(int n) const {
    if (n < 1024) return n; if (n < 1088) { const int r = n - 1024; return 11264 + 2 * (r & 31) + (r >> 5); } if (n < 7232) return n - 64; if (n < 7248) return 11264 + 64 + (n - 7232); return n - 80; } };
struct DstQ { __device__ __forceinline__ int operator()(int n) const {
    const int h = n / 192, d = n - h * 192; if (d < 128) return h * 256 + d; const int r = d - 128; return h * 256 + 128 + 2 * (r & 31) + (r >> 5); } };
template <class Dst>
__device__ __forceinline__ void transpose_item(const float* __restrict__ W, int K, int N, bf16_t* __restrict__ WT, Dst dst, float* scr, int item, int lane, const float* __restrict__ gk = nullptr) {
    const int nblk = (N + 31) / 32, kb = item / nblk, nb = item % nblk, k0 = 64 * kb, n0 = 32 * nb;
    { const int rr = lane >> 3, c4 = (lane & 7) * 4; const bool ok = (n0 + c4) < N;
      f32x4 v[8];
#pragma unroll
      for (int i = 0; i < 8; ++i) v[i] = ok ? *(const f32x4*)(W + (size_t)(k0 + 8 * i + rr) * N + n0 + c4) : (f32x4){0.f, 0.f, 0.f, 0.f};
      if (gk) {
#pragma unroll
          for (int i = 0; i < 8; ++i) v[i] *= gk[k0 + 8 * i + rr]; }
#pragma unroll
      for (int i = 0; i < 8; ++i) { float* sp = scr + (8 * i + rr) * 33 + c4; sp[0] = v[i][0]; sp[1] = v[i][1]; sp[2] = v[i][2]; sp[3] = v[i][3]; } }
    asm volatile("s_waitcnt lgkmcnt(0)" ::: "memory");
    const int c = lane & 7;
#pragma unroll
    for (int j = 0; j < 4; ++j) { const int nl = (lane >> 3) + 8 * j, n = n0 + nl; const float* s = scr + (8 * c) * 33 + nl;
        u32x4 o; o.x = pk2(s[0 * 33], s[1 * 33]); o.y = pk2(s[2 * 33], s[3 * 33]); o.z = pk2(s[4 * 33], s[5 * 33]); o.w = pk2(s[6 * 33], s[7 * 33]);
        if (n < N) *(u32x4*)(WT + (size_t)dst(n) * K + k0 + 8 * c) = o; }
    asm volatile("s_waitcnt lgkmcnt(0)" ::: "memory");
}
__device__ __forceinline__ void wfold_item(const float* __restrict__ wq, const float* __restrict__ keys, bf16_t* __restrict__ WpT, float* sm, int item) {
    const int tid = opaque_tid(), hc = item >> 5, d0 = (item & 31) * 64;
    float* keysL = sm; float* wqL = sm + 128 * 132;
    for (int idx = tid; idx < 128 * 32; idx += 512) { const int r = idx >> 5, c4 = (idx & 31) * 4; *(f32x4*)(keysL + r * 132 + c4) = *(const f32x4*)(keys + (size_t)hc * 16384 + r * 128 + c4); }
    for (int idx = tid; idx < 64 * 32; idx += 512) { const int r = idx >> 5, c4 = (idx & 31) * 4; *(f32x4*)(wqL + r * 132 + c4) = *(const f32x4*)(wq + (size_t)(d0 + r) * 2048 + hc * 128 + c4); }
    __syncthreads();
    const int n2 = (tid & 63) * 2, dg = tid >> 6;
    float acc[2][8];
#pragma unroll
    for (int a = 0; a < 2; ++a)
#pragma unroll
        for (int i = 0; i < 8; ++i) acc[a][i] = 0.f;
#pragma unroll 2
    for (int j4 = 0; j4 < 32; ++j4) {
        const f32x4 k0v = *(const f32x4*)(keysL + n2 * 132 + 4 * j4), k1v = *(const f32x4*)(keysL + (n2 + 1) * 132 + 4 * j4);
#pragma unroll
        for (int i = 0; i < 8; ++i) { const f32x4 w = *(const f32x4*)(wqL + (dg * 8 + i) * 132 + 4 * j4);
            acc[0][i] += (k0v[0] * w[0] + k0v[1] * w[1]) + (k0v[2] * w[2] + k0v[3] * w[3]);
            acc[1][i] += (k1v[0] * w[0] + k1v[1] * w[1]) + (k1v[2] * w[2] + k1v[3] * w[3]); }
    }
#pragma unroll
    for (int a = 0; a < 2; ++a) { u32x4 o; o.x = pk2(acc[a][0], acc[a][1]); o.y = pk2(acc[a][2], acc[a][3]); o.z = pk2(acc[a][4], acc[a][5]); o.w = pk2(acc[a][6], acc[a][7]);
        *(u32x4*)(WpT + (size_t)(hc * 128 + n2 + a) * 2048 + d0 + dg * 8) = o; }
    __syncthreads();
}
__device__ __forceinline__ void rms_row2048(const float* __restrict__ xr, const float* __restrict__ g, bf16_t* __restrict__ orow, int lane) {
    f32x4 v[8]; float ss = 0.f;
#pragma unroll
    for (int j = 0; j < 8; ++j) { v[j] = *(const f32x4*)(xr + j * 256 + lane * 4); ss += (v[j][0] * v[j][0] + v[j][1] * v[j][1]) + (v[j][2] * v[j][2] + v[j][3] * v[j][3]); }
    const float r = rsqrtf(wave_sum(ss) * (1.f / 2048.f) + EPS);
#pragma unroll
    for (int j = 0; j < 8; ++j) { const f32x4 gg = *(const f32x4*)(g + j * 256 + lane * 4);
        uint2 o; o.x = pk2(v[j][0] * r * gg[0], v[j][1] * r * gg[1]); o.y = pk2(v[j][2] * r * gg[2], v[j][3] * r * gg[3]);
        *(uint2*)(orow + j * 256 + lane * 4) = o; }
}
__device__ __forceinline__ void fox_cumsum(double* part, int h, const float* __restrict__ lf, float* __restrict__ F) {
    const int tid = opaque_tid(), lane = tid & 63, wave = tid >> 6;
    float v[16]; double sum = 0.0;
#pragma unroll
    for (int i = 0; i < 16; ++i) { v[i] = lf[(size_t)(tid * 16 + i) * 16 + h]; sum += (double)v[i]; }
    double inc = sum;
#pragma unroll
    for (int o = 1; o < 64; o <<= 1) { const double n = __shfl_up(inc, o); if (lane >= o) inc += n; }
    if (lane == 63) part[wave] = inc;
    __syncthreads();
    double base = 0.0;
    for (int w = 0; w < wave; ++w) base += part[w];
    double run = base + inc - sum;
#pragma unroll
    for (int i = 0; i < 16; ++i) { run += (double)v[i]; F[(size_t)h * S + tid * 16 + i] = (float)(run * 1.4426950408889634); }
    __syncthreads();
}
__device__ __forceinline__ void rope_table(const int* __restrict__ pos, float2* __restrict__ ropeT, int gtid, int nthreads) {
    for (int idx = gtid; idx < S * 32; idx += nthreads) { const int t = idx >> 5, i = idx & 31;
        const double inv = exp(-(double)i * (1.0 / 32.0) * 9.210340371976184);
        double ang = (double)((float)pos[t] * (float)inv);
        const double twopi = 6.283185307179586;
        ang -= twopi * rint(ang / twopi);
        ropeT[idx] = make_float2(cosf((float)ang), sinf((float)ang)); }
}
typedef float f32x2 __attribute__((ext_vector_type(2)));
__device__ __forceinline__ unsigned pk4_fp8(float a, float b, float c, float d) {
    int w = __builtin_amdgcn_cvt_pk_fp8_f32(fminf(fmaxf(a, -448.f), 448.f), fminf(fmaxf(b, -448.f), 448.f), 0, false);
    w = __builtin_amdgcn_cvt_pk_fp8_f32(fminf(fmaxf(c, -448.f), 448.f), fminf(fmaxf(d, -448.f), 448.f), w, true); return (unsigned)w; }
__device__ __forceinline__ void cvt_rows_fp8(const float* __restrict__ src, unsigned char* __restrict__ dst, size_t n, float scale, int gw, int NGW, int lane) {
    const size_t nchunk = n / 1024;
    for (size_t c = gw; c < nchunk; c += NGW) { const size_t o = c * 1024 + lane * 16;
        f32x4 a[4];
#pragma unroll
        for (int q = 0; q < 4; ++q) a[q] = *(const f32x4*)(src + o + 4 * q) * scale;
        u32x4 w; w.x = pk4_fp8(a[0][0], a[0][1], a[0][2], a[0][3]); w.y = pk4_fp8(a[1][0], a[1][1], a[1][2], a[1][3]);
        w.z = pk4_fp8(a[2][0], a[2][1], a[2][2], a[2][3]); w.w = pk4_fp8(a[3][0], a[3][1], a[3][2], a[3][3]);
        *(u32x4*)(dst + o) = w; }
}
constexpr float U_SCALE = 64.f, V_SCALE = 4.f;
typedef __bf16 bf16x2_t __attribute__((ext_vector_type(2)));
__device__ __forceinline__ float dot2bf(unsigned a, unsigned b, float c) { return __builtin_amdgcn_fdot2_f32_bf16(__builtin_bit_cast(bf16x2_t, a), __builtin_bit_cast(bf16x2_t, b), c, false); }
#define PEER_INS(top, x) do { float x_ = (x); _Pragma("unroll") for (int i_ = 0; i_ < 16; ++i_) { const float hi_ = fmaxf(top[i_], x_); x_ = fminf(top[i_], x_); top[i_] = hi_; } } while (0)
__device__ __forceinline__ void peer_group(unsigned char* smem, int g, const float* __restrict__ scores, const bf16_t* __restrict__ h2  , const float* __restrict__ ssq2, const float* __restrict__ x1,
                                           const unsigned char* __restrict__ U8, const unsigned char* __restrict__ V8, float* __restrict__ out) {
    const int tid = opaque_tid(), lane = tid & 63, wave = __builtin_amdgcn_readfirstlane(tid >> 6);
    float* topL = (float*)smem;
    int* selE = (int*)(smem + 32768);
    float* selG = (float*)(smem + 49152);
    {
        const int tl = tid >> 4, hc = tid & 15;
        const float* sp = scores + (size_t)(g * 32 + tl) * 2048 + hc * 128;
        float top[16];
#pragma unroll
        for (int i = 0; i < 16; ++i) top[i] = -INFINITY;
#pragma unroll 2
        for (int n0 = 0; n0 < 128; n0 += 4) { const f32x4 v = *(const f32x4*)(sp + n0);
#pragma unroll
            for (int e = 0; e < 4; ++e) PEER_INS(top, __uint_as_float((__float_as_uint(v[e]) & ~0x7Fu) | (unsigned)(n0 + e))); }
        float* tp = topL + (tl * 16 + hc) * 16;
#pragma unroll
        for (int i = 0; i < 16; i += 4) *(f32x4*)(tp + i) = (f32x4){top[i], top[i + 1], top[i + 2], top[i + 3]};
    }
    __syncthreads();
    if (tid < 256) {
        const int tl = tid >> 3, h = tid & 7;
        const float* t1 = topL + (tl * 16 + 2 * h) * 16; const float* t2 = t1 + 16;
        float s1[16], s2[16];
#pragma unroll
        for (int i = 0; i < 16; i += 4) { const f32x4 a = *(const f32x4*)(t1 + i), b2 = *(const f32x4*)(t2 + i);
            s1[i] = a[0]; s1[i + 1] = a[1]; s1[i + 2] = a[2]; s1[i + 3] = a[3]; s2[i] = b2[0]; s2[i + 1] = b2[1]; s2[i + 2] = b2[2]; s2[i + 3] = b2[3]; }
        float ts[16];
#pragma unroll
        for (int i = 0; i < 16; ++i) ts[i] = -INFINITY;
#pragma unroll
        for (int i = 0; i < 16; ++i)
#pragma unroll
            for (int j = 0; j < 16; ++j)
                if ((i + 1) * (j + 1) <= 16) PEER_INS(ts, __uint_as_float((__float_as_uint(s1[i] + s2[j]) & ~0xFFu) | (unsigned)(i * 16 + j)));
        float ex[16], sum = 0.f;
#pragma unroll
        for (int k = 0; k < 16; ++k) { ex[k] = __expf(ts[k] - ts[0]); sum += ex[k]; }
        const float inv = 1.f / sum;
#pragma unroll
        for (int k = 0; k < 16; ++k) { const unsigned pos = __float_as_uint(ts[k]) & 0xFFu;
            const int i1 = (int)(__float_as_uint(t1[pos >> 4]) & 0x7Fu), i2 = (int)(__float_as_uint(t2[pos & 15]) & 0x7Fu);
            selE[tl * 128 + h * 16 + k] = i1 * 128 + i2; selG[tl * 128 + h * 16 + k] = ex[k] * inv; }
    }
    __syncthreads();
    const int grp = lane >> 4, l16 = lane & 15, tl = wave * 4 + grp;
    unsigned* sortK = (unsigned*)(smem + 65536) + tl * 128;
    float* wS = (float*)(smem + 81920) + tl * 128;
    unsigned* hist = (unsigned*)(smem + 98304) + wave * 512 + grp * 64;
    {
#pragma unroll
        for (int i = 0; i < 4; ++i) hist[l16 * 4 + i] = 0u;
        asm volatile("s_waitcnt lgkmcnt(0)" ::: "memory");
        unsigned ek[8], rk[8];
#pragma unroll
        for (int j = 0; j < 8; ++j) { ek[j] = (unsigned)selE[tl * 128 + l16 + 16 * j]; rk[j] = atomicAdd(&hist[ek[j] >> 8], 1u); }
        asm volatile("s_waitcnt lgkmcnt(0)" ::: "memory");
        unsigned c[4], tot = 0u;
#pragma unroll
        for (int i = 0; i < 4; ++i) { c[i] = hist[l16 * 4 + i]; tot += c[i]; }
        unsigned inc = tot;
#pragma unroll
        for (int o = 1; o < 16; o <<= 1) { const unsigned n = __shfl_up(inc, o, 16); if (l16 >= o) inc += n; }
        unsigned run = inc - tot;
#pragma unroll
        for (int i = 0; i < 4; ++i) { hist[256 + l16 * 4 + i] = run; run += c[i]; }
        asm volatile("s_waitcnt lgkmcnt(0)" ::: "memory");
#pragma unroll
        for (int j = 0; j < 8; ++j) sortK[hist[256 + (ek[j] >> 8)] + rk[j]] = (ek[j] << 7) | (unsigned)(l16 + 16 * j);
    }
    __syncthreads();
    const size_t tok = (size_t)g * 32 + tl;
    float rinv_tok;
    { float t = 0.f; if (l16 < 8) { const f32x4 a = *(const f32x4*)(ssq2 + ((size_t)l16 * 8192 + tok) * 4); t = (a[0] + a[1]) + (a[2] + a[3]); }
      t += __shfl_xor(t, 8); t += __shfl_xor(t, 4); t += __shfl_xor(t, 2); t += __shfl_xor(t, 1); rinv_tok = rsqrtf(t * (1.f / 2048.f) + 1e-6f); }
    {
        f32x2 hp[64];
#pragma unroll
        for (int j = 0; j < 8; ++j)
#pragma unroll
            for (int q = 0; q < 2; ++q) { const u32x4 w = *(const u32x4*)(h2 + tok * DM + j * 256 + l16 * 16 + q * 8);
#pragma unroll
                for (int c = 0; c < 4; ++c) hp[j * 8 + q * 4 + c] = (f32x2){__uint_as_float(w[c] << 16), __uint_as_float(w[c] & 0xffff0000u)}; }
        for (int it = 0; it < 128; it += 2) {
            if ((it & 7) == 0 && it) __syncthreads();
            const unsigned key0 = sortK[it], key1 = sortK[it + 1];
            u32x4 ur[2][8];
#pragma unroll
            for (int j = 0; j < 8; ++j) ur[0][j] = *(const u32x4*)(U8 + (size_t)(key0 >> 7) * DM + j * 256 + l16 * 16);
#pragma unroll
            for (int j = 0; j < 8; ++j) ur[1][j] = *(const u32x4*)(U8 + (size_t)(key1 >> 7) * DM + j * 256 + l16 * 16);
#pragma unroll
            for (int p = 0; p < 2; ++p) { f32x2 a2 = (f32x2){0.f, 0.f}, b2 = (f32x2){0.f, 0.f};
#pragma unroll
                for (int j = 0; j < 8; ++j)
#pragma unroll
                    for (int c = 0; c < 4; ++c) { const int w = (int)ur[p][j][c];
                        a2 = __builtin_elementwise_fma(hp[j * 8 + 2 * c], __builtin_amdgcn_cvt_pk_f32_fp8(w, false), a2);
                        b2 = __builtin_elementwise_fma(hp[j * 8 + 2 * c + 1], __builtin_amdgcn_cvt_pk_f32_fp8(w, true), b2); }
                float d = (a2.x + a2.y) + (b2.x + b2.y);
                d += __shfl_xor(d, 8); d += __shfl_xor(d, 4); d += __shfl_xor(d, 2); d += __shfl_xor(d, 1);
                const float a = d * (rinv_tok * (1.f / U_SCALE)); const unsigned key = p ? key1 : key0;
                const float w = selG[tl * 128 + (key & 127u)] * 0.5f * a * (1.f + erff(a * 0.70710678118654752f)) * (1.f / V_SCALE);
                if (l16 == 0) wS[it + p] = w; }
        }
    }
    __syncthreads();
    {
        f32x2 acc[64];
#pragma unroll
        for (int c = 0; c < 64; ++c) acc[c] = (f32x2){0.f, 0.f};
        for (int it = 0; it < 128; it += 2) {
            if ((it & 7) == 0 && it) __syncthreads();
            const unsigned key0 = sortK[it], key1 = sortK[it + 1];
            u32x4 vr[2][8];
#pragma unroll
            for (int j = 0; j < 8; ++j) vr[0][j] = *(const u32x4*)(V8 + (size_t)(key0 >> 7) * DM + j * 256 + l16 * 16);
#pragma unroll
            for (int j = 0; j < 8; ++j) vr[1][j] = *(const u32x4*)(V8 + (size_t)(key1 >> 7) * DM + j * 256 + l16 * 16);
#pragma unroll
            for (int p = 0; p < 2; ++p) { const float w = wS[it + p]; const f32x2 w2 = (f32x2){w, w};
#pragma unroll
                for (int j = 0; j < 8; ++j)
#pragma unroll
                    for (int c = 0; c < 4; ++c) { const int x = (int)vr[p][j][c];
                        acc[j * 8 + 2 * c] = __builtin_elementwise_fma(w2, __builtin_amdgcn_cvt_pk_f32_fp8(x, false), acc[j * 8 + 2 * c]);
                        acc[j * 8 + 2 * c + 1] = __builtin_elementwise_fma(w2, __builtin_amdgcn_cvt_pk_f32_fp8(x, true), acc[j * 8 + 2 * c + 1]); } }
        }
#pragma unroll
        for (int j = 0; j < 8; ++j)
#pragma unroll
            for (int q = 0; q < 4; ++q) { const size_t o = tok * DM + j * 256 + l16 * 16 + q * 4;
                const f32x4 a = *(const f32x4*)(x1 + o);
                *(f32x4*)(out + o) = (f32x4){a[0] + acc[j * 8 + 2 * q].x, a[1] + acc[j * 8 + 2 * q].y, a[2] + acc[j * 8 + 2 * q + 1].x, a[3] + acc[j * 8 + 2 * q + 1].y}; }
    }
    __syncthreads();
}

#define XB_TMO      128
#define XB_XCNT(j)  (256  + 64 * (j))
#define XB_XSUB(j)  (1280 + 64 * (j))
#define XB_XGEN(j)  (2304 + 64 * (j))
#define XB_TOP      3328
#define XB_TOPGEN   3392
#define XCD_BAR_WORDS 3456
#define XB_SPIN_CAP (1u << 18)

__device__ __forceinline__ unsigned xb_ld(unsigned* p)              { return __hip_atomic_load(p, __ATOMIC_RELAXED, __HIP_MEMORY_SCOPE_AGENT); }
__device__ __forceinline__ unsigned xb_add(unsigned* p, unsigned v) { return __hip_atomic_fetch_add(p, v, __ATOMIC_RELAXED, __HIP_MEMORY_SCOPE_AGENT); }
__device__ __forceinline__ unsigned xb_xcc_id() { return (unsigned)__builtin_amdgcn_s_getreg((3 << 11) | 20) & 0xFu; }
#define XB_SPIN(cond, bar) do { unsigned _sp = 0; while (cond) { __builtin_amdgcn_s_sleep(1); \
    if ((++_sp & 255u) == 0u) { if (xb_ld(&(bar)[XB_TMO])) break; if (_sp > XB_SPIN_CAP) { atomicAdd(&(bar)[XB_TMO], 1u); break; } } } } while (0)

struct XcdBarrier {
    unsigned* bar; unsigned x;
    volatile LAS unsigned* st;
};

__device__ __forceinline__ XcdBarrier xcd_barrier_post(unsigned* bar, volatile LAS unsigned* st) {
    XcdBarrier b; b.bar = bar; b.x = xb_xcc_id(); b.st = st;
    if (threadIdx.x == 0) (void)xb_add(&bar[XB_XCNT(b.x)], 1u);
    return b;
}
__device__ __forceinline__ void xcd_barrier_complete(unsigned* bar, unsigned x, unsigned& nloc, unsigned& nx) {
    const unsigned G = gridDim.x * gridDim.y * gridDim.z;
    unsigned sum, cnt, mine, sp = 0u;
    for (;;) {
        sum = 0u; cnt = 0u; mine = 0u;
#pragma unroll
        for (unsigned j = 0; j < 16; ++j) { const unsigned c = xb_ld(&bar[XB_XCNT(j)]); sum += c; cnt += (c > 0u) ? 1u : 0u; mine = (j == x) ? c : mine; }
        if (sum == G) break;
        __builtin_amdgcn_s_sleep(1);
        if ((++sp & 255u) == 0u) { if (xb_ld(&bar[XB_TMO])) break; if (sp > XB_SPIN_CAP) { atomicAdd(&bar[XB_TMO], 1u); break; } }
    }
    nloc = mine > 0u ? mine : 1u; nx = cnt > 0u ? cnt : 1u;
}

__device__ __forceinline__ void xcd_barrier(const XcdBarrier& b) {
    asm volatile("s_waitcnt vmcnt(0)" ::: "memory");
    __syncthreads();
    if (threadIdx.x == 0) {
        unsigned* bar = b.bar;
        __builtin_amdgcn_s_waitcnt(0);
        unsigned nloc = b.st[0], nx = b.st[1];
        if (nloc == 0u) { xcd_barrier_complete(bar, b.x, nloc, nx); b.st[0] = nloc; b.st[1] = nx; }
        const unsigned old = xb_add(&bar[XB_XSUB(b.x)], 1u);
        const unsigned gen = old / nloc;
        if (old + 1u == (gen + 1u) * nloc) {
            __builtin_amdgcn_fence(__ATOMIC_RELEASE, "agent");
            asm volatile("s_waitcnt vmcnt(0)" ::: "memory");
            const unsigned og = xb_add(&bar[XB_TOP], 1u);
            const unsigned tg = og / nx;
            if (og + 1u == (tg + 1u) * nx) xb_add(&bar[XB_TOPGEN], 1u);
            else XB_SPIN(xb_ld(&bar[XB_TOPGEN]) == tg, bar);
            __builtin_amdgcn_fence(__ATOMIC_ACQUIRE, "agent");
            xb_add(&bar[XB_XGEN(b.x)], 1u);
            asm volatile("s_waitcnt vmcnt(0)" ::: "memory");
        } else {
            XB_SPIN(xb_ld(&bar[XB_XGEN(b.x)]) == gen, bar);
            __builtin_amdgcn_fence(__ATOMIC_ACQUIRE, "agent");
            asm volatile("s_waitcnt vmcnt(0)" ::: "memory");
        }
    }
    __syncthreads();
}

#define PROBE_DOUBLE 0
#define REP(k) for (int rep_ = 0; rep_ < ((PROBE_DOUBLE == (k)) ? 2 : 1); ++rep_)
constexpr int LDS_BYTES = 147456;
__global__ __launch_bounds__(512, 2) void mega(Params p) {
    extern __shared__ __attribute__((aligned(16))) unsigned char smem[];
    { volatile LAS unsigned* st0 = (volatile LAS unsigned*)((LAS unsigned char*)smem + 131072); if (threadIdx.x < 2) st0[threadIdx.x] = 0u; }
    __syncthreads();
    const XcdBarrier bar = xcd_barrier_post(p.ctl, (volatile LAS unsigned*)((LAS unsigned char*)smem + 131072));
    float* smf = (float*)smem;
    LAS unsigned char* lds = (LAS unsigned char*)smem;
    const int G = gridDim.x, b = blockIdx.x, NGW = G * 8;
#define PHASE_IDS() const int tid = opaque_tid(), lane = tid & 63, wave = __builtin_amdgcn_readfirstlane(tid >> 6), gw = b * 8 + wave; (void)lane; (void)gw

    REP(7) {
        PHASE_IDS();
        float* scr = smf + wave * 4096;
        constexpr int dummy_ = 0; (void)dummy_;
        constexpr int I_IN = 32 * 355, I_Q = 8 * 96, I_KV = 8 * 128, I_O = 64 * 64;
        for (int it = gw; it < I_IN + I_Q + I_KV + I_O; it += NGW) {
            int r = it;
            if (r < I_IN) { transpose_item(p.w_in, 2048, INW, p.WinT, DstWin(), scr, r, lane); continue; } r -= I_IN;
            if (r < I_Q) { transpose_item(p.w_q_up, 512, 3072, p.WqT, DstQ(), scr, r, lane, p.q_lat_g); continue; } r -= I_Q;
            if (r < I_KV) { transpose_item(p.w_kv_up, 512, 4096, p.WkvT, DstId(), scr, r, lane, p.kv_lat_g); continue; } r -= I_KV;
            transpose_item(p.w_out, 4096, 2048, p.WoT, DstId(), scr, r, lane);
        }
        for (int m = gw; m < S; m += NGW) rms_row2048(p.x + (size_t)m * DM, p.mix_g, p.h + (size_t)m * DM, lane);
        for (int idx = b * 512 + tid; idx < 16 * 64 * 64; idx += G * 512) { const int hh = idx >> 12, rr = (idx >> 6) & 63, c8 = idx & 63;
            *(u32x4*)(p.WqT + (size_t)(hh * 256 + 192 + rr) * 512 + c8 * 8) = (u32x4){0u, 0u, 0u, 0u}; }
        rope_table(p.pos, p.ropeT, b * 512 + tid, G * 512);
        __syncthreads();
        for (int it = b; it < 512; it += G) wfold_item(p.w_peer_q, p.sub_keys, p.WpT, smf, it);
    }
    xcd_barrier(bar);
    REP(1) {
        pg8::Gemm g{p.h, p.WinT, S, INWP, DM}; pg8::StaticOrder so; so.init(S, INWP, G, b);
        pg8::EpiInProj E{p.cq, p.ckv, p.fq, p.fk, p.fv, p.merged, p.kpe, p.lf, p.b_gate, p.b_forget, p.ssq, p.fox_qg, p.fox_kg, (LAS float*)(lds + 131072 + 64)};
        pg8::gemm_phase<pg8::EpiInProj, pg8::StaticOrder, true, true>(lds, g, so, E);
    }
    xcd_barrier(bar);
    for (int hh = b; hh < 16; hh += G) fox_cumsum((double*)smem, hh, p.lf, p.F);
    REP(2) {
        pg8::Gemm g{p.cq, p.WqT, S, 4096, 512}; pg8::StaticOrder so; so.init(S, 4096, G, b);
        pg8::EpiQ E{p.qa, p.ssq, p.mla_qg, p.ropeT, (LAS float*)(lds + 131072 + 64)};
        pg8::gemm_phase<pg8::EpiQ, pg8::StaticOrder, true, true>(lds, g, so, E);
    }
    {
        pg8::Gemm g{p.ckv, p.WkvT, S, 4096, 512}; pg8::StaticOrder so; so.init(S, 4096, G, b);
        pg8::EpiKV E{p.ka, p.va, p.kpe, p.ssq, p.mla_kg, p.ropeT, (LAS float*)(lds + 131072 + 64)};
        pg8::gemm_phase<pg8::EpiKV, pg8::StaticOrder, true, true>(lds, g, so, E);
    }
    xcd_barrier(bar);
    int side_next = 0;
    REP(3) for (int L = b; L < 1024; L += G) {
        const int i = L >> 8, vc = L & 255, vcx = (vc & 7) * 32 + (vc >> 3), hh = vcx >> 4, x = vcx & 15, qbk = (i & 1) ? x : 31 - x;
        if (i < 2) att::attn_block<192, false>(smem, p.qa + hh * 192, 3072, p.ka + hh * 192, 3072, p.va + hh * 128, 2048, nullptr, p.merged + hh * 128, p.attout + hh * 128, qbk, nullptr, nullptr, p.peer_u, p.peer_v, p.U8, p.V8, side_next);
        else att::attn_block<128, true>(smem, p.fq + hh * 128, 2048, p.fk + hh * 128, 2048, p.fv + hh * 128, 2048, p.F + (size_t)hh * S, p.merged + 2048 + hh * 128, p.attout + 2048 + hh * 128, qbk, p.fox_qg, p.fox_kg, p.peer_u, p.peer_v, p.U8, p.V8, side_next);
    }
    if (G == 256) { PHASE_IDS(); (void)wave;
        for (; side_next < 64; ++side_next) { const bool isv = side_next >= 32; const size_t off = ((size_t)(b * 32 + (side_next & 31)) * 512 + tid) * 8;
            const float* sp = (isv ? p.peer_v : p.peer_u) + off; const float sc = isv ? V_SCALE : U_SCALE; const f32x4 a0 = *(const f32x4*)sp * sc, a1 = *(const f32x4*)(sp + 4) * sc;
            uint2 o; o.x = pk4_fp8(a0[0], a0[1], a0[2], a0[3]); o.y = pk4_fp8(a1[0], a1[1], a1[2], a1[3]); *(uint2*)((isv ? p.V8 : p.U8) + off) = o; } }
    else { PHASE_IDS(); cvt_rows_fp8(p.peer_u, p.U8, (size_t)16384 * 2048, U_SCALE, gw, NGW, lane); cvt_rows_fp8(p.peer_v, p.V8, (size_t)16384 * 2048, V_SCALE, gw, NGW, lane); }
    xcd_barrier(bar);
    REP(4) {
        pg8::Gemm g{p.attout, p.WoT, S, 2048, 4096}; pg8::StaticOrder so; so.init(S, 2048, G, b);
        pg8::EpiX1 E{p.x1, p.x, p.xg, p.ffn_g, p.ssq2};
        pg8::gemm_phase<pg8::EpiX1, pg8::StaticOrder, true, true>(lds, g, so, E);
    }
    xcd_barrier(bar);
    REP(5) {
        pg8::Gemm g{p.xg, p.WpT, S, 2048, 2048}; pg8::StaticOrder so; so.init(S, 2048, G, b);
        pg8::EpiScores E{p.scores, p.ssq2};
        pg8::gemm_phase<pg8::EpiScores, pg8::StaticOrder, true, true>(lds, g, so, E);
    }
    xcd_barrier(bar);
    REP(6) for (int g = b; g < S / 32; g += G) peer_group(smem, g, p.scores, p.xg, p.ssq2, p.x1, p.U8, p.V8, p.out);
}

extern "C" void kernel_launch(void* const* d_in, const int* in_sizes, int n_in,
                              void* d_out, int out_size, void* d_ws, size_t ws_size,
                              hipStream_t stream) {
    if (ws_size < 512 * MiB) { fprintf(stderr, "kernel_launch: workspace too small (%zu)\n", ws_size); return; }
    Params p{};
    p.x = (const float*)d_in[0]; p.pos = (const int*)d_in[1]; p.mix_g = (const float*)d_in[2]; p.w_in = (const float*)d_in[3];
    p.b_forget = (const float*)d_in[4]; p.b_gate = (const float*)d_in[5]; p.q_lat_g = (const float*)d_in[6]; p.w_q_up = (const float*)d_in[7];
    p.kv_lat_g = (const float*)d_in[8]; p.w_kv_up = (const float*)d_in[9]; p.mla_qg = (const float*)d_in[10]; p.mla_kg = (const float*)d_in[11];
    p.fox_qg = (const float*)d_in[12]; p.fox_kg = (const float*)d_in[13]; p.w_out = (const float*)d_in[14]; p.ffn_g = (const float*)d_in[15];
    p.w_peer_q = (const float*)d_in[16]; p.sub_keys = (const float*)d_in[17]; p.peer_u = (const float*)d_in[18]; p.peer_v = (const float*)d_in[19];
    p.out = (float*)d_out;
    char* ws = (char*)d_ws;
    p.WqT = (bf16_t*)(ws + 1 * MiB); p.WkvT = (bf16_t*)(ws + 5 * MiB); p.WoT = (bf16_t*)(ws + 9 * MiB); p.WpT = (bf16_t*)(ws + 25 * MiB); p.WinT = (bf16_t*)(ws + 33 * MiB);
    p.h = (bf16_t*)(ws + 78 * MiB); p.cq = (bf16_t*)(ws + 110 * MiB); p.ckv = (bf16_t*)(ws + 118 * MiB);
    p.fq = (bf16_t*)(ws + 126 * MiB); p.fk = (bf16_t*)(ws + 158 * MiB); p.fv = (bf16_t*)(ws + 190 * MiB); p.merged = (bf16_t*)(ws + 222 * MiB);
    p.kpe = (bf16_t*)(ws + 286 * MiB); p.lf = (float*)(ws + 287 * MiB); p.F = (float*)(ws + 287 * MiB + 512 * 1024);
    p.qa = (bf16_t*)(ws + 288 * MiB); p.va = (bf16_t*)(ws + 336 * MiB); p.ka = (bf16_t*)(ws + 400 * MiB); p.x1 = (float*)(ws + 126 * MiB);
    p.scores = (float*)(ws + 222 * MiB);
    p.ctl = (unsigned*)ws;
    p.ropeT = (float2*)(ws + 448 * MiB);
    p.ssq = (float*)(ws + 64 * 1024);
    p.attout = (bf16_t*)(ws + 33 * MiB);
    p.U8 = (unsigned char*)(ws + 450 * MiB); p.V8 = (unsigned char*)(ws + 368 * MiB);
    p.xg = (bf16_t*)(ws + 190 * MiB);
    p.ssq2 = (float*)(ws + 482 * MiB);

    static int grid_blocks = 0;
    if (!grid_blocks) {
        if (hipFuncSetAttribute((const void*)mega, hipFuncAttributeMaxDynamicSharedMemorySize, LDS_BYTES) != hipSuccess) { fprintf(stderr, "hipFuncSetAttribute failed\n"); return; }
        int dev = 0, cus = 0, per_cu = 0;
        (void)hipGetDevice(&dev);
        (void)hipDeviceGetAttribute(&cus, hipDeviceAttributeMultiprocessorCount, dev);
        (void)hipOccupancyMaxActiveBlocksPerMultiprocessor(&per_cu, (const void*)mega, 512, LDS_BYTES);
        if (per_cu < 1 || cus < 1) { fprintf(stderr, "occupancy query says %d blocks/CU on %d CUs\n", per_cu, cus); return; }
        grid_blocks = cus;
    }
    if (hipMemsetAsync(d_ws, 0, 16384, stream) != hipSuccess) { fprintf(stderr, "memset of the barrier words failed\n"); return; }
    void* args[] = {&p};
    hipError_t e = hipLaunchCooperativeKernel((const void*)mega, dim3(grid_blocks), dim3(512), args, LDS_BYTES, stream);
    if (e != hipSuccess) fprintf(stderr, "cooperative launch failed: %s (grid %d)\n", hipGetErrorString(e), grid_blocks);
}
```

```cpp
#include <hip/hip_runtime.h>
#include <hip/hip_cooperative_groups.h>
#include <stdint.h>
#include <math.h>
#include <cstdio>
namespace cg = cooperative_groups;

namespace pg8 {
#define PG8_LAS __attribute__((address_space(3)))
typedef unsigned short bf16_t;
typedef short bf16x8 __attribute__((ext_vector_type(8)));
typedef float f32x4 __attribute__((ext_vector_type(4)));
typedef unsigned u32x4 __attribute__((ext_vector_type(4)));
constexpr int BM = 256, BK = 64, HALF = 128, HTB = HALF * BK * 2  , STAGE_BYTES = 8 * HTB, NXCD = 8, WGM = 8;

__host__ __device__ __forceinline__ int lds_byte(int r, int c) { const int st = (r >> 4) * 2 + (c >> 5), rr = r & 15, cc = c & 31, ob = rr * 64 + cc * 2; return st * 1024 + (ob ^ (((ob >> 9) & 1) << 5)); }
__host__ __device__ __forceinline__ void stage_rc(int b, int& R, int& C) { const int st = b / 1024, sb = b % 1024, swz = sb ^ (((sb >> 9) & 1) << 5); R = (st >> 1) * 16 + swz / 64; C = (st & 1) * 32 + (swz % 64) / 2; }
__host__ __device__ __forceinline__ int perm32(int rho) { const int n = rho >> 4, i = rho & 15; return 8 * (i >> 2) + 4 * n + (i & 3); }

struct Unit { int pm, pn; };
struct Gemm { const bf16_t* A; const bf16_t* Bt; int M, N, K; };

struct StaticOrder {
    int nM, nN, nwg, G, c;
    __host__ __device__ void init(int M, int N, int G_, int c_) { nM = M / BM; nN = N / BM; nwg = nM * nN; G = G_; c = c_; }
    __host__ __device__ bool next(int i, Unit& u) const {
        const long L = (long)i * G + c; if (L >= nwg) return false;
        int wgid = (int)L; { const int q = nwg / NXCD, r = nwg % NXCD, xcd = wgid % NXCD, off = wgid / NXCD; wgid = (xcd < r ? xcd * (q + 1) : r * (q + 1) + (xcd - r) * q) + off; }
        const int nig = WGM * nN, gid = wgid / nig, fm = gid * WGM, gsz = (nM - fm) < WGM ? (nM - fm) : WGM;
        u.pm = fm + ((wgid % nig) % gsz); u.pn = (wgid % nig) / gsz; return true;
    }
    __device__ __forceinline__ void a_ready(const Unit&) const {}
    __device__ __forceinline__ void done(const Unit&) const {}
};

__device__ __forceinline__ unsigned cvt_pk_bf16(float lo, float hi) { unsigned r; asm volatile("v_cvt_pk_bf16_f32 %0, %1, %2" : "=v"(r) : "v"(lo), "v"(hi)); return r; }
__device__ __forceinline__ u32x4 pack8bf(const f32x4& v0, const f32x4& v1) { u32x4 w; w.x = cvt_pk_bf16(v0[0], v0[1]); w.y = cvt_pk_bf16(v0[2], v0[3]); w.z = cvt_pk_bf16(v1[0], v1[1]); w.w = cvt_pk_bf16(v1[2], v1[3]); return w; }

struct EpiStoreBf16 {
    static constexpr bool PERM = true, AFTER_DRAIN = false;
    bf16_t* O; int ldc;
    __device__ __forceinline__ void operator()(const f32x4 (&acc)[2][2][4][2], const Unit& u, int wr, int wc, int fr, int fq) const {
        const int row0 = u.pm * BM + wr * 64 + fr, col0 = u.pn * BM + wc * 32 + 8 * fq;
#pragma unroll
        for (int ai = 0; ai < 2; ++ai)
#pragma unroll
            for (int m = 0; m < 4; ++m) { bf16_t* rowp = O + (size_t)(row0 + ai * HALF + m * 16) * ldc + col0;
#pragma unroll
                for (int bj = 0; bj < 2; ++bj) *(u32x4*)(rowp + bj * HALF) = pack8bf(acc[ai][bj][m][0], acc[ai][bj][m][1]); }
    }
};
template <bool RES> struct EpiStoreF32 {
    static constexpr bool PERM = true, AFTER_DRAIN = false;
    float* O; const float* res; int ldc;
    __device__ __forceinline__ void operator()(const f32x4 (&acc)[2][2][4][2], const Unit& u, int wr, int wc, int fr, int fq) const {
        const int row0 = u.pm * BM + wr * 64 + fr, col0 = u.pn * BM + wc * 32 + 8 * fq;
#pragma unroll
        for (int ai = 0; ai < 2; ++ai)
#pragma unroll
            for (int m = 0; m < 4; ++m) { const size_t off = (size_t)(row0 + ai * HALF + m * 16) * ldc + col0;
#pragma unroll
                for (int bj = 0; bj < 2; ++bj) { f32x4 v0 = acc[ai][bj][m][0], v1 = acc[ai][bj][m][1];
                    if (RES) { v0 += *(const f32x4*)(res + off + bj * HALF); v1 += *(const f32x4*)(res + off + bj * HALF + 4); }
                    *(f32x4*)(O + off + bj * HALF) = v0; *(f32x4*)(O + off + bj * HALF + 4) = v1; } }
    }
};
#define EPI_LDSBAR() do { asm volatile("s_waitcnt lgkmcnt(0)" ::: "memory"); __builtin_amdgcn_s_barrier(); asm volatile("" ::: "memory"); } while (0)
struct EpiInProj {
    static constexpr bool PERM = true, AFTER_DRAIN = false;
    bf16_t *cq, *ckv, *fq, *fk, *fv, *gates, *kpe; float* lf; const float *b_gate, *b_forget; float* ssq; const float *gfq, *gfk; PG8_LAS float* xs;
    __device__ __forceinline__ void operator()(const f32x4 (&acc)[2][2][4][2], const Unit& u, int wr, int wc, int fr, int fq_) const {
        const int pn = u.pn, row0 = u.pm * BM + wr * 64 + fr, cw = wc * 32 + 8 * fq_;
        if (pn < 4) {
            bf16_t* base = pn < 2 ? cq : ckv; const int colt = (pn & 1) * 256;
#pragma unroll
            for (int ai = 0; ai < 2; ++ai)
#pragma unroll
                for (int m = 0; m < 4; ++m) { const int row = row0 + ai * HALF + m * 16; bf16_t* rowp = base + (size_t)row * 512 + colt + cw; float s = 0.f;
#pragma unroll
                    for (int bj = 0; bj < 2; ++bj) { const f32x4 v0 = acc[ai][bj][m][0], v1 = acc[ai][bj][m][1];
                        s += (v0[0] * v0[0] + v0[1] * v0[1]) + (v0[2] * v0[2] + v0[3] * v0[3]) + (v1[0] * v1[0] + v1[1] * v1[1]) + (v1[2] * v1[2] + v1[3] * v1[3]);
                        *(u32x4*)(rowp + bj * HALF) = pack8bf(v0, v1); }
                    s += __shfl_xor(s, 16); s += __shfl_xor(s, 32);
                    if (fq_ == 0) ssq[((size_t)pn * 8192 + row) * 4 + wc] = s; }
        } else if (pn < 20) {
            const bool isq = pn < 12; bf16_t* base = isq ? fq : fk; const int colt = (pn - (isq ? 4 : 12)) * 256; const float* g = isq ? gfq : gfk;
            const float qs = isq ? 0.12751743f : 1.f;
#pragma unroll
            for (int ai = 0; ai < 2; ++ai)
#pragma unroll
                for (int m = 0; m < 4; ++m)
#pragma unroll
                    for (int bj = 0; bj < 2; ++bj) { const f32x4 v0 = acc[ai][bj][m][0], v1 = acc[ai][bj][m][1];
                        float s = (v0[0] * v0[0] + v0[1] * v0[1]) + (v0[2] * v0[2] + v0[3] * v0[3]) + (v1[0] * v1[0] + v1[1] * v1[1]) + (v1[2] * v1[2] + v1[3] * v1[3]);
                        s += __shfl_xor(s, 16); s += __shfl_xor(s, 32);
                        if (fq_ == 0) xs[((ai * HALF + wr * 64 + m * 16 + fr) * 2 + bj) * 4 + wc] = s; }
            EPI_LDSBAR();
            const f32x4 g0 = *(const f32x4*)(g + cw) * qs, g1 = *(const f32x4*)(g + cw + 4) * qs;
#pragma unroll
            for (int ai = 0; ai < 2; ++ai)
#pragma unroll
                for (int m = 0; m < 4; ++m) { bf16_t* rowp = base + (size_t)(row0 + ai * HALF + m * 16) * 2048 + colt + cw;
#pragma unroll
                    for (int bj = 0; bj < 2; ++bj) { const f32x4 t4 = *(const PG8_LAS f32x4*)(xs + ((ai * HALF + wr * 64 + m * 16 + fr) * 2 + bj) * 4);
                        const float r = rsqrtf(((t4[0] + t4[1]) + (t4[2] + t4[3])) * (1.f / 128.f) + 1e-6f);
                        *(u32x4*)(rowp + bj * HALF) = pack8bf(acc[ai][bj][m][0] * g0 * r, acc[ai][bj][m][1] * g1 * r); } }
        } else if (pn < 28) {
            const int colt = (pn - 20) * 256;
#pragma unroll
            for (int ai = 0; ai < 2; ++ai)
#pragma unroll
                for (int m = 0; m < 4; ++m) { bf16_t* rowp = fv + (size_t)(row0 + ai * HALF + m * 16) * 2048 + colt + cw;
#pragma unroll
                    for (int bj = 0; bj < 2; ++bj) *(u32x4*)(rowp + bj * HALF) = pack8bf(acc[ai][bj][m][0], acc[ai][bj][m][1]); }
        } else if (pn < 44) {
            const int colt = (pn - 28) * 256 + cw;
#pragma unroll
            for (int bj = 0; bj < 2; ++bj) {
                const f32x4 b0 = *(const f32x4*)(b_gate + colt + bj * HALF), b1 = *(const f32x4*)(b_gate + colt + bj * HALF + 4);
#pragma unroll
                for (int ai = 0; ai < 2; ++ai)
#pragma unroll
                    for (int m = 0; m < 4; ++m) {
                        f32x4 v0 = acc[ai][bj][m][0] + b0, v1 = acc[ai][bj][m][1] + b1;
#pragma unroll
                        for (int e = 0; e < 4; ++e) { v0[e] = 1.f / (1.f + __expf(-v0[e])); v1[e] = 1.f / (1.f + __expf(-v1[e])); }
                        *(u32x4*)(gates + (size_t)(row0 + ai * HALF + m * 16) * 4096 + colt + bj * HALF) = pack8bf(v0, v1); }
            }
        } else {
            if (cw < 64) {
#pragma unroll
                for (int ai = 0; ai < 2; ++ai)
#pragma unroll
                    for (int m = 0; m < 4; ++m) *(u32x4*)(kpe + (size_t)(row0 + ai * HALF + m * 16) * 64 + cw) = pack8bf(acc[ai][0][m][0], acc[ai][0][m][1]);
            } else if (cw < 80) {
                const int h0 = cw - 64;
                const f32x4 b0 = *(const f32x4*)(b_forget + h0), b1 = *(const f32x4*)(b_forget + h0 + 4);
#pragma unroll
                for (int ai = 0; ai < 2; ++ai)
#pragma unroll
                    for (int m = 0; m < 4; ++m) { const int row = row0 + ai * HALF + m * 16;
                        f32x4 z0 = acc[ai][0][m][0] + b0, z1 = acc[ai][0][m][1] + b1;
#pragma unroll
                        for (int e = 0; e < 4; ++e) { z0[e] = fminf(z0[e], 0.f) - __logf(1.f + __expf(-fabsf(z0[e]))); z1[e] = fminf(z1[e], 0.f) - __logf(1.f + __expf(-fabsf(z1[e]))); }
                        *(f32x4*)(lf + (size_t)row * 16 + h0) = z0; *(f32x4*)(lf + (size_t)row * 16 + h0 + 4) = z1; }
            }
        }
    }
};
__device__ __forceinline__ float lat_rinv(const float* ssq, int part0, int row) {
    const f32x4 a = *(const f32x4*)(ssq + ((size_t)part0 * 8192 + row) * 4), b = *(const f32x4*)(ssq + ((size_t)(part0 + 1) * 8192 + row) * 4);
    return rsqrtf((((a[0] + a[1]) + (a[2] + a[3])) + ((b[0] + b[1]) + (b[2] + b[3]))) * (1.f / 512.f) + 1e-6f);
}
struct EpiQ {
    static constexpr bool PERM = true, AFTER_DRAIN = false;
    bf16_t* qa; const float* ssq; const float* gq; const float2* ropeT; PG8_LAS float* xs;
    __device__ __forceinline__ void operator()(const f32x4 (&acc)[2][2][4][2], const Unit& u, int wr, int wc, int fr, int fq_) const {
        const int h = u.pn, row0 = u.pm * BM + wr * 64 + fr, cw = wc * 32 + 8 * fq_;
        float rl[2][4];
#pragma unroll
        for (int ai = 0; ai < 2; ++ai)
#pragma unroll
            for (int m = 0; m < 4; ++m) { rl[ai][m] = lat_rinv(ssq, 0, row0 + ai * HALF + m * 16); float s = 0.f;
#pragma unroll
                for (int bj = 0; bj < 2; ++bj) { const f32x4 v0 = acc[ai][bj][m][0], v1 = acc[ai][bj][m][1];
                    s += (v0[0] * v0[0] + v0[1] * v0[1]) + (v0[2] * v0[2] + v0[3] * v0[3]) + (v1[0] * v1[0] + v1[1] * v1[1]) + (v1[2] * v1[2] + v1[3] * v1[3]); }
                s *= rl[ai][m] * rl[ai][m];
                s += __shfl_xor(s, 16); s += __shfl_xor(s, 32);
                if (fq_ == 0) xs[(ai * HALF + wr * 64 + m * 16 + fr) * 4 + wc] = s; }
        EPI_LDSBAR();
        const float qs = 0.10411754f;
        const f32x4 g0 = *(const f32x4*)(gq + cw) * qs, g1 = *(const f32x4*)(gq + cw + 4) * qs;
        const int pp = 16 * (wc & 1) + 4 * fq_;
        const f32x4 ga = *(const f32x4*)(gq + 128 + pp) * qs, gb = *(const f32x4*)(gq + 160 + pp) * qs;
#pragma unroll
        for (int ai = 0; ai < 2; ++ai)
#pragma unroll
            for (int m = 0; m < 4; ++m) { const int row = row0 + ai * HALF + m * 16;
                const f32x4 t4 = *(const PG8_LAS f32x4*)(xs + (ai * HALF + wr * 64 + m * 16 + fr) * 4);
                const float r = rsqrtf(((t4[0] + t4[1]) + (t4[2] + t4[3])) * (1.f / 192.f) + 1e-6f) * rl[ai][m];
                bf16_t* rowp = qa + (size_t)row * 3072 + h * 192;
                *(u32x4*)(rowp + cw) = pack8bf(acc[ai][0][m][0] * g0 * r, acc[ai][0][m][1] * g1 * r);
                if (wc < 2) { const f32x4 c01 = *(const f32x4*)(ropeT + (size_t)row * 32 + pp), c23 = *(const f32x4*)(ropeT + (size_t)row * 32 + pp + 2);
                    const f32x4 z0 = acc[ai][1][m][0] * r, z1 = acc[ai][1][m][1] * r;
                    const float a0 = z0[0] * ga[0], b0 = z0[1] * gb[0], a1 = z0[2] * ga[1], b1 = z0[3] * gb[1], a2 = z1[0] * ga[2], b2 = z1[1] * gb[2], a3 = z1[2] * ga[3], b3 = z1[3] * gb[3];
                    const f32x4 o0 = {a0 * c01[0] - b0 * c01[1], a0 * c01[1] + b0 * c01[0], a1 * c01[2] - b1 * c01[3], a1 * c01[3] + b1 * c01[2]};
                    const f32x4 o1 = {a2 * c23[0] - b2 * c23[1], a2 * c23[1] + b2 * c23[0], a3 * c23[2] - b3 * c23[3], a3 * c23[3] + b3 * c23[2]};
                    *(u32x4*)(rowp + 128 + cw) = pack8bf(o0, o1); } }
    }
};
struct EpiKV {
    static constexpr bool PERM = true, AFTER_DRAIN = false;
    bf16_t *ka, *va; const bf16_t* kpe; const float* ssq; const float* gk; const float2* ropeT; PG8_LAS float* xs;
    __device__ __forceinline__ void operator()(const f32x4 (&acc)[2][2][4][2], const Unit& u, int wr, int wc, int fr, int fq_) const {
        const int h = u.pn, row0 = u.pm * BM + wr * 64 + fr, cw = wc * 32 + 8 * fq_;
        float rl[2][4]; f32x4 kp[2][4];
#pragma unroll
        for (int ai = 0; ai < 2; ++ai)
#pragma unroll
            for (int m = 0; m < 4; ++m) { const int row = row0 + ai * HALF + m * 16; rl[ai][m] = lat_rinv(ssq, 2, row);
                const uint2 w = *(const uint2*)(kpe + (size_t)row * 64 + 16 * wc + 4 * fq_);
                kp[ai][m] = (f32x4){__uint_as_float(w.x << 16), __uint_as_float(w.x & 0xffff0000u), __uint_as_float(w.y << 16), __uint_as_float(w.y & 0xffff0000u)};
                const f32x4 v0 = acc[ai][0][m][0], v1 = acc[ai][0][m][1];
                float s = ((v0[0] * v0[0] + v0[1] * v0[1]) + (v0[2] * v0[2] + v0[3] * v0[3]) + (v1[0] * v1[0] + v1[1] * v1[1]) + (v1[2] * v1[2] + v1[3] * v1[3])) * (rl[ai][m] * rl[ai][m]);
                s += (kp[ai][m][0] * kp[ai][m][0] + kp[ai][m][1] * kp[ai][m][1]) + (kp[ai][m][2] * kp[ai][m][2] + kp[ai][m][3] * kp[ai][m][3]);
                s += __shfl_xor(s, 16); s += __shfl_xor(s, 32);
                if (fq_ == 0) xs[(ai * HALF + wr * 64 + m * 16 + fr) * 4 + wc] = s;
                *(u32x4*)(va + (size_t)row * 2048 + h * 128 + cw) = pack8bf(acc[ai][1][m][0] * rl[ai][m], acc[ai][1][m][1] * rl[ai][m]); }
        EPI_LDSBAR();
        const f32x4 g0 = *(const f32x4*)(gk + cw), g1 = *(const f32x4*)(gk + cw + 4);
        const int pp = 8 * wc + 2 * fq_;
        const float ga0 = gk[128 + pp], ga1 = gk[128 + pp + 1], gb0 = gk[160 + pp], gb1 = gk[160 + pp + 1];
#pragma unroll
        for (int ai = 0; ai < 2; ++ai)
#pragma unroll
            for (int m = 0; m < 4; ++m) { const int row = row0 + ai * HALF + m * 16;
                const f32x4 t4 = *(const PG8_LAS f32x4*)(xs + (ai * HALF + wr * 64 + m * 16 + fr) * 4);
                const float r = rsqrtf(((t4[0] + t4[1]) + (t4[2] + t4[3])) * (1.f / 192.f) + 1e-6f), rn = r * rl[ai][m];
                bf16_t* rowp = ka + (size_t)row * 3072 + h * 192;
                *(u32x4*)(rowp + cw) = pack8bf(acc[ai][0][m][0] * g0 * rn, acc[ai][0][m][1] * g1 * rn);
                const f32x4 cs = *(const f32x4*)(ropeT + (size_t)row * 32 + pp);
                const float a0 = kp[ai][m][0] * r * ga0, b0 = kp[ai][m][1] * r * gb0, a1 = kp[ai][m][2] * r * ga1, b1 = kp[ai][m][3] * r * gb1;
                uint2 o; o.x = cvt_pk_bf16(a0 * cs[0] - b0 * cs[1], a0 * cs[1] + b0 * cs[0]); o.y = cvt_pk_bf16(a1 * cs[2] - b1 * cs[3], a1 * cs[3] + b1 * cs[2]);
                *(uint2*)(rowp + 128 + 16 * wc + 4 * fq_) = o; }
    }
};

struct EpiX1 {
    static constexpr bool PERM = true, AFTER_DRAIN = false;
    float* x1; const float* x; bf16_t* xg; const float* g; float* ssq2;
    __device__ __forceinline__ void operator()(const f32x4 (&acc)[2][2][4][2], const Unit& u, int wr, int wc, int fr, int fq_) const {
        const int row0 = u.pm * BM + wr * 64 + fr, col0 = u.pn * BM + wc * 32 + 8 * fq_;
        f32x4 gg[2][2];
#pragma unroll
        for (int bj = 0; bj < 2; ++bj) { gg[bj][0] = *(const f32x4*)(g + col0 + bj * HALF); gg[bj][1] = *(const f32x4*)(g + col0 + bj * HALF + 4); }
#pragma unroll
        for (int ai = 0; ai < 2; ++ai)
#pragma unroll
            for (int m = 0; m < 4; ++m) { const int row = row0 + ai * HALF + m * 16; const size_t off = (size_t)row * 2048 + col0; float s = 0.f;
#pragma unroll
                for (int bj = 0; bj < 2; ++bj) { const f32x4 v0 = acc[ai][bj][m][0] + *(const f32x4*)(x + off + bj * HALF), v1 = acc[ai][bj][m][1] + *(const f32x4*)(x + off + bj * HALF + 4);
                    *(f32x4*)(x1 + off + bj * HALF) = v0; *(f32x4*)(x1 + off + bj * HALF + 4) = v1;
                    s += (v0[0] * v0[0] + v0[1] * v0[1]) + (v0[2] * v0[2] + v0[3] * v0[3]) + (v1[0] * v1[0] + v1[1] * v1[1]) + (v1[2] * v1[2] + v1[3] * v1[3]);
                    *(u32x4*)(xg + off + bj * HALF) = pack8bf(v0 * gg[bj][0], v1 * gg[bj][1]); }
                s += __shfl_xor(s, 16); s += __shfl_xor(s, 32);
                if (fq_ == 0) ssq2[((size_t)u.pn * 8192 + row) * 4 + wc] = s; }
    }
};
__device__ __forceinline__ float ffn_rinv(const float* ssq2, int row) {
    float t = 0.f;
#pragma unroll
    for (int pn = 0; pn < 8; ++pn) { const f32x4 a = *(const f32x4*)(ssq2 + ((size_t)pn * 8192 + row) * 4); t += (a[0] + a[1]) + (a[2] + a[3]); }
    return rsqrtf(t * (1.f / 2048.f) + 1e-6f);
}
struct EpiScores {
    static constexpr bool PERM = true, AFTER_DRAIN = false;
    float* O; const float* ssq2;
    __device__ __forceinline__ void operator()(const f32x4 (&acc)[2][2][4][2], const Unit& u, int wr, int wc, int fr, int fq_) const {
        const int row0 = u.pm * BM + wr * 64 + fr, col0 = u.pn * BM + wc * 32 + 8 * fq_;
#pragma unroll
        for (int ai = 0; ai < 2; ++ai)
#pragma unroll
            for (int m = 0; m < 4; ++m) { const int row = row0 + ai * HALF + m * 16; const float r = ffn_rinv(ssq2, row); const size_t off = (size_t)row * 2048 + col0;
#pragma unroll
                for (int bj = 0; bj < 2; ++bj) { *(f32x4*)(O + off + bj * HALF) = acc[ai][bj][m][0] * r; *(f32x4*)(O + off + bj * HALF + 4) = acc[ai][bj][m][1] * r; } }
    }
};
template <class Epi, class Sched, bool ALIGN_EPI = false, bool SP2 = false>
__device__ __forceinline__ void gemm_phase(PG8_LAS unsigned char* lds, const Gemm g, const Sched& S, const Epi& E) {
    int tid = threadIdx.x; asm volatile("" : "+v"(tid));
    const int wid = __builtin_amdgcn_readfirstlane(tid >> 6), lane = tid & 63, wr = wid >> 2, wc = wid & 3, fr = lane & 15, fq = lane >> 4;
    const int K = g.K, nt = K / BK;
    unsigned voffA[2], voffB[2];
#pragma unroll
    for (int i = 0; i < 2; ++i) { int R, C; stage_rc(tid * 16 + i * 8192, R, C); const int Rb = Epi::PERM ? ((R & ~31) + perm32(R & 31)) : R;
        voffA[i] = (unsigned)(R * K + C) * 2u; voffB[i] = (unsigned)(Rb * K + C) * 2u; }
    const size_t kstep = (size_t)(BK * 2);
    const size_t hstep = (size_t)HALF * K * 2;
    const size_t tstep = 2 * hstep;
    const unsigned ldsw = (unsigned)wid * 1024u;
    const int aoff = lds_byte(wr * 64 + fr, fq * 8), boff = lds_byte(wc * 32 + fr, fq * 8);
#define PG8_SA(b, h) (((b) * 2 + (h)) * HTB)
#define PG8_SB(b, h) ((4 + (b) * 2 + (h)) * HTB)
#define PG8_STAGE(bufoff, gbase, voff) do { _Pragma("unroll") for (int _i = 0; _i < 2; ++_i) \
        __builtin_amdgcn_global_load_lds((const unsigned*)((const char*)(gbase) + (voff)[_i]), (PG8_LAS unsigned*)(lds + (bufoff) + ldsw + _i * 8192), 16, 0, 0); } while (0)
#define PG8_LDA(dst, b, h) do { _Pragma("unroll") for (int m = 0; m < 4; ++m) _Pragma("unroll") for (int k = 0; k < 2; ++k) dst[m][k] = *(const PG8_LAS bf16x8*)(lds + PG8_SA(b, h) + aoff + m * 2048 + k * 1024); } while (0)
#define PG8_LDB(dst, b, h) do { _Pragma("unroll") for (int n = 0; n < 2; ++n) _Pragma("unroll") for (int k = 0; k < 2; ++k) dst[n][k] = *(const PG8_LAS bf16x8*)(lds + PG8_SB(b, h) + boff + n * 2048 + k * 1024); } while (0)
#define PG8_MMA(ai, bj, At, Bt) do { __builtin_amdgcn_s_setprio(1); _Pragma("unroll") for (int m = 0; m < 4; ++m) _Pragma("unroll") for (int n = 0; n < 2; ++n) _Pragma("unroll") for (int k = 0; k < 2; ++k) \
        acc[ai][bj][m][n] = __builtin_amdgcn_mfma_f32_16x16x32_bf16(Bt[n][k], At[m][k], acc[ai][bj][m][n], 0, 0, 0); __builtin_amdgcn_s_setprio(0); } while (0)
#define PG8_WAIT_V(n) asm volatile("s_waitcnt vmcnt(" #n ")" ::: "memory")
#define PG8_WAIT_L(n) asm volatile("s_waitcnt lgkmcnt(" #n ")" ::: "memory")
#define PG8_BAR __builtin_amdgcn_s_barrier()
#define PG8_SCHED __builtin_amdgcn_sched_barrier(0)
    Unit cur, nxt; int ui = 0;
    if (!S.next(0, cur)) return;
    f32x4 acc[2][2][4][2];
#pragma unroll
    for (int a = 0; a < 2; ++a)
#pragma unroll
        for (int b = 0; b < 2; ++b)
#pragma unroll
            for (int m = 0; m < 4; ++m)
#pragma unroll
                for (int n = 0; n < 2; ++n) acc[a][b][m][n] = (f32x4){0.f, 0.f, 0.f, 0.f};
    bf16x8 At[4][2], B0[2][2], B1[2][2];
    const char* cA = (const char*)g.A + (size_t)cur.pm * tstep; const char* cB = (const char*)g.Bt + (size_t)cur.pn * tstep;
    S.a_ready(cur);
    if constexpr (SP2) {
        PG8_STAGE(PG8_SB(0, 0), cB, voffB); PG8_STAGE(PG8_SB(0, 1), cB + hstep, voffB); PG8_STAGE(PG8_SA(0, 0), cA, voffA); PG8_STAGE(PG8_SA(0, 1), cA + hstep, voffA);
        if (wr == 1) PG8_BAR;
        PG8_WAIT_V(2); PG8_BAR;
        PG8_STAGE(PG8_SB(1, 0), cB + kstep, voffB); PG8_STAGE(PG8_SA(1, 0), cA + kstep, voffA); PG8_STAGE(PG8_SB(1, 1), cB + hstep + kstep, voffB);
        PG8_WAIT_V(6); PG8_BAR;
    } else {
        PG8_STAGE(PG8_SB(0, 0), cB, voffB); PG8_STAGE(PG8_SA(0, 0), cA, voffA); PG8_STAGE(PG8_SB(0, 1), cB + hstep, voffB); PG8_STAGE(PG8_SA(0, 1), cA + hstep, voffA);
        if (wr == 1) PG8_BAR;
        PG8_WAIT_V(4); PG8_BAR;
        PG8_STAGE(PG8_SB(1, 0), cB + kstep, voffB); PG8_STAGE(PG8_SA(1, 0), cA + kstep, voffA); PG8_STAGE(PG8_SB(1, 1), cB + hstep + kstep, voffB);
        PG8_WAIT_V(6); PG8_BAR;
    }
    for (;;) {
        const bool has_next = S.next(ui + 1, nxt);
        const char* nA = has_next ? (const char*)g.A + (size_t)nxt.pm * tstep : cA; const char* nB = has_next ? (const char*)g.Bt + (size_t)nxt.pn * tstep : cB;
        for (int t = 0; t < nt; t += 2) {
            const bool last = (t == nt - 2);
            const char* a1 = cA + (size_t)(t + 1) * kstep;
            const char* a2 = last ? nA : cA + (size_t)(t + 2) * kstep; const char* b2 = last ? nB : cB + (size_t)(t + 2) * kstep;
            const char* a3 = a2 + kstep; const char* b3 = b2 + kstep;
            if (last && has_next) S.a_ready(nxt);
            if constexpr (SP2) {
            PG8_LDB(B0, 0, 0); PG8_LDB(B1, 0, 1); PG8_SCHED; PG8_LDA(At, 0, 0); PG8_STAGE(PG8_SA(1, 1), a1 + hstep, voffA);
            PG8_WAIT_V(8); PG8_WAIT_L(0); PG8_BAR; PG8_MMA(0, 0, At, B0); PG8_MMA(0, 1, At, B1); PG8_BAR; PG8_SCHED;
            PG8_LDA(At, 0, 1); PG8_STAGE(PG8_SB(0, 0), b2, voffB); PG8_STAGE(PG8_SB(0, 1), b2 + hstep, voffB); PG8_STAGE(PG8_SA(0, 0), a2, voffA);
            PG8_WAIT_V(8); PG8_WAIT_L(0); PG8_BAR; PG8_MMA(1, 0, At, B0); PG8_MMA(1, 1, At, B1); PG8_BAR; PG8_SCHED;
            PG8_LDB(B0, 1, 0); PG8_LDB(B1, 1, 1); PG8_SCHED; PG8_LDA(At, 1, 0); PG8_STAGE(PG8_SA(0, 1), a2 + hstep, voffA);
            PG8_WAIT_V(8); PG8_WAIT_L(0); PG8_BAR; PG8_MMA(0, 0, At, B0); PG8_MMA(0, 1, At, B1); PG8_BAR; PG8_SCHED;
            PG8_LDA(At, 1, 1); PG8_STAGE(PG8_SB(1, 0), b3, voffB); PG8_STAGE(PG8_SB(1, 1), b3 + hstep, voffB); PG8_STAGE(PG8_SA(1, 0), a3, voffA);
            PG8_WAIT_V(8); PG8_WAIT_L(0); PG8_BAR; PG8_MMA(1, 0, At, B0); PG8_MMA(1, 1, At, B1); PG8_BAR; PG8_SCHED;
            } else {
            PG8_LDB(B0, 0, 0); PG8_SCHED; PG8_LDA(At, 0, 0); PG8_STAGE(PG8_SA(1, 1), a1 + hstep, voffA);
            PG8_WAIT_L(8); PG8_BAR; PG8_WAIT_L(0); PG8_MMA(0, 0, At, B0); PG8_BAR; PG8_SCHED;
            PG8_LDB(B1, 0, 1); PG8_STAGE(PG8_SB(0, 0), b2, voffB);
            PG8_BAR; PG8_WAIT_L(0); PG8_MMA(0, 1, At, B1); PG8_BAR;
            PG8_LDA(At, 0, 1); PG8_STAGE(PG8_SA(0, 0), a2, voffA);
            PG8_BAR; PG8_WAIT_L(0); PG8_MMA(1, 0, At, B0); PG8_BAR; PG8_SCHED;
            PG8_STAGE(PG8_SB(0, 1), b2 + hstep, voffB);
            PG8_WAIT_V(6); PG8_BAR; PG8_MMA(1, 1, At, B1); PG8_BAR;
            PG8_LDB(B0, 1, 0); PG8_SCHED; PG8_LDA(At, 1, 0); PG8_STAGE(PG8_SA(0, 1), a2 + hstep, voffA);
            PG8_WAIT_L(8); PG8_BAR; PG8_WAIT_L(0); PG8_MMA(0, 0, At, B0); PG8_BAR; PG8_SCHED;
            PG8_LDB(B1, 1, 1); PG8_STAGE(PG8_SB(1, 0), b3, voffB);
            PG8_BAR; PG8_WAIT_L(0); PG8_MMA(0, 1, At, B1); PG8_BAR;
            PG8_LDA(At, 1, 1); PG8_STAGE(PG8_SA(1, 0), a3, voffA);
            PG8_BAR; PG8_WAIT_L(0); PG8_MMA(1, 0, At, B0); PG8_BAR; PG8_SCHED;
            PG8_STAGE(PG8_SB(1, 1), b3 + hstep, voffB);
            PG8_WAIT_V(6); PG8_BAR; PG8_MMA(1, 1, At, B1); PG8_BAR;
            }
        }
        if constexpr (ALIGN_EPI) { if (wr == 0) PG8_BAR; }
        if constexpr (!Epi::AFTER_DRAIN) { E(acc, cur, wr, wc, fr, fq); S.done(cur); }
        if (!has_next) break;
#pragma unroll
        for (int a = 0; a < 2; ++a)
#pragma unroll
            for (int b = 0; b < 2; ++b)
#pragma unroll
                for (int m = 0; m < 4; ++m)
#pragma unroll
                    for (int n = 0; n < 2; ++n) acc[a][b][m][n] = (f32x4){0.f, 0.f, 0.f, 0.f};
        cur = nxt; cA = nA; cB = nB; ++ui;
        if constexpr (ALIGN_EPI) { if (wr == 1) PG8_BAR; }
    }
    PG8_WAIT_V(0);
    if constexpr (!ALIGN_EPI) { if (wr == 0) PG8_BAR; }
    PG8_BAR;
    if constexpr (Epi::AFTER_DRAIN) { E.fused(acc, cur, wr, wc, fr, fq, lds, wid, lane); S.done(cur); }
#undef PG8_SA
#undef PG8_SB
#undef PG8_STAGE
#undef PG8_LDA
#undef PG8_LDB
#undef PG8_MMA
#undef PG8_WAIT_V
#undef PG8_WAIT_L
#undef PG8_BAR
#undef PG8_SCHED
}
}
namespace att {
typedef unsigned short bf16_t;
typedef short bf16x8 __attribute__((ext_vector_type(8)));
typedef short s16x4 __attribute__((ext_vector_type(4)));
typedef float f32x16 __attribute__((ext_vector_type(16)));
typedef float f32x4 __attribute__((ext_vector_type(4)));
typedef unsigned u32x4 __attribute__((ext_vector_type(4)));
#define ALAS __attribute__((address_space(3)))
#define ASBAR() __builtin_amdgcn_sched_barrier(0)
constexpr int SHM_V = 16384;
template <int DK> struct Lay { static constexpr int ROWB = DK * 2, SHM_K = 64 * ROWB, OFF_K = 2 * SHM_V, OFF_F = OFF_K + 2 * SHM_K, OFF_WS = OFF_F + 512, TOTAL = OFF_WS + 8 * 256; };

__device__ __forceinline__ int v_st(int k, int c) { const int kk = (k & ~0xC) | ((k & 4) << 1) | ((k & 8) >> 1); return ((kk >> 3) * 4 + (c >> 5)) * 512 + ((kk & 7) * 32 + (c & 31)) * 2; }
__device__ __forceinline__ int v_rd_base(int lane) { return ((lane & 3) << 3) | (((lane >> 2) & 3) << 6) | (((lane >> 4) & 1) << 5) | (((lane >> 5) & 1) << 8); }
__device__ __forceinline__ int crow(int r, int hi) { return (r & 3) + 8 * (r >> 2) + 4 * hi; }
__device__ __forceinline__ unsigned cvtpk(float lo, float hi) { unsigned r; asm volatile("v_cvt_pk_bf16_f32 %0, %1, %2" : "=v"(r) : "v"(lo), "v"(hi)); return r; }

__device__ __forceinline__ float wave_max_f(float v) {
#pragma unroll
    for (int o = 32; o >= 1; o >>= 1) v = fmaxf(v, __shfl_xor(v, o));
    return v;
}
template <int DK, bool FOX>
__device__ __forceinline__ void attn_block(unsigned char* smem, const bf16_t* __restrict__ Q, int ldq, const bf16_t* __restrict__ K, int ldk, const bf16_t* __restrict__ V, int ldv,
                                           const float* __restrict__ Fh, const bf16_t* __restrict__ gate, bf16_t* __restrict__ gout  , int qbk, const float* __restrict__ gq, const float* __restrict__ gk  ,
                                           const float* __restrict__ side_u, const float* __restrict__ side_v, unsigned char* __restrict__ side_u8, unsigned char* __restrict__ side_v8, int& side_next) {
    typedef Lay<DK> LY;
    constexpr int ND = DK / 16, NKC = DK / 8, NKI = (64 * NKC) / 512;
    int tid = threadIdx.x; asm volatile("" : "+v"(tid));
    const int wid = __builtin_amdgcn_readfirstlane(tid >> 6), lane = tid & 63, r32 = lane & 31, hi = lane >> 5;
    const int q0 = qbk * 256, qlo = q0 + wid * 32, qm = qlo + r32 - 4 * hi;
    const int NT = 4 * qbk + 4;
    ALAS unsigned char* lds = (ALAS unsigned char*)smem;
    ALAS float* F_lds = (ALAS float*)(lds + LY::OFF_F);
    ALAS float* wsl = (ALAS float*)(lds + LY::OFF_WS) + wid * 64;
    bf16x8 qr[ND];
#pragma unroll
    for (int d0 = 0; d0 < ND; ++d0) qr[d0] = *(const bf16x8*)(Q + (size_t)(qlo + r32) * ldq + d0 * 16 + hi * 8);
    const float fq = FOX ? Fh[qlo + r32] : 0.f;
    int kgo[NKI], vgo[2];
#pragma unroll
    for (int i = 0; i < NKI; ++i) { const int pp = (wid * NKI + i) * 64 + lane, row = pp / NKC, cpos = pp % NKC, ch = cpos ^ ((row >> 1) & 7); kgo[i] = row * ldk + ch * 8; }
#pragma unroll
    for (int i = 0; i < 2; ++i) { const int o = ((wid * 2 + i) * 64 + lane) * 16, st = o >> 9, e = (o & 511) >> 1, kk = (st >> 2) * 8 + (e >> 5), c = (st & 3) * 32 + (e & 31);
        const int k = (kk & ~0xC) | ((kk & 4) << 1) | ((kk & 8) >> 1); vgo[i] = k * ldv + c; }
    const int vb0 = (int)(uintptr_t)smem + v_rd_base(lane);
    int kbase[4];
#pragma unroll
    for (int dd = 0; dd < 4; ++dd) kbase[dd] = LY::OFF_K + r32 * LY::ROWB + (((((dd << 1) | hi) ^ ((r32 >> 1) & 7))) << 4);
    float stf = 0.f;
#define ATT_GLDS(kb, bf) do { _Pragma("unroll") for (int i = 0; i < NKI; ++i) \
            __builtin_amdgcn_global_load_lds((const unsigned*)(K + (size_t)(kb) * ldk + kgo[i]), (ALAS unsigned*)(lds + LY::OFF_K + (bf) * LY::SHM_K + (wid * NKI + i) * 1024), 16, 0, 0); \
        _Pragma("unroll") for (int i = 0; i < 2; ++i) \
            __builtin_amdgcn_global_load_lds((const unsigned*)(V + (size_t)(kb) * ldv + vgo[i]), (ALAS unsigned*)(lds + (bf) * SHM_V + (wid * 2 + i) * 1024), 16, 0, 0); \
        if (FOX && tid < 64) stf = Fh[(kb) + tid]; } while (0)
#define ATT_WRITEF(bf) do { if (FOX && tid < 64) F_lds[(bf) * 64 + tid] = stf; } while (0)
    int t_start = 0;
    if (FOX) {
        const float gqm = wave_max_f(fmaxf(fabsf(gq[lane]), fabsf(gq[lane + 64]))), gkm = wave_max_f(fmaxf(fabsf(gk[lane]), fabsf(gk[lane + 64])));
        const float qk_bound = 0.12751743f * 128.f * gqm * gkm;
        const float thr = 2.02f * qk_bound + 40.f, f0 = Fh[q0];
        const int j0 = lane, j1 = lane + 64;
        const bool c0 = (j0 < 4 * qbk) && (Fh[j0 * 64 + 63] - f0 >= thr), c1 = (j1 < 4 * qbk) && (Fh[(j1 < 4 * qbk ? j1 : 0) * 64 + 63] - f0 >= thr);
        t_start = __builtin_popcountll(__ballot(c0)) + __builtin_popcountll(__ballot(c1));
        t_start = __builtin_amdgcn_readfirstlane(t_start); }
    ATT_GLDS(t_start * 64, t_start & 1); ATT_WRITEF(t_start & 1);
    float m_reg = -1e30f, l_reg = 0.f; f32x16 o[4];
#pragma unroll
    for (int d = 0; d < 4; ++d)
#pragma unroll
        for (int r = 0; r < 16; ++r) o[d][r] = 0.f;
    for (int t = t_start; t < NT; ++t) {
        const int buf = t & 1, kb = t * 64;
        asm volatile("s_waitcnt vmcnt(0)" ::: "memory");
        __syncthreads();
        if (t + 1 < NT) ATT_GLDS(kb + 64, buf ^ 1);
        const bool side = side_next < 64; f32x4 sd0, sd1; size_t sd_off = 0;
        if (side) { const bool isv = side_next >= 32; sd_off = ((size_t)(blockIdx.x * 32 + (side_next & 31)) * 512 + tid) * 8;
            const float* sp = (isv ? side_v : side_u) + sd_off; sd0 = *(const f32x4*)sp; sd1 = *(const f32x4*)(sp + 4); }
        f32x16 p0, p1;
        if (FOX) {
#pragma unroll
            for (int g = 0; g < 4; ++g) { const f32x4 f0 = *(const ALAS f32x4*)(F_lds + buf * 64 + 8 * g + 4 * hi), f1 = *(const ALAS f32x4*)(F_lds + buf * 64 + 32 + 8 * g + 4 * hi);
#pragma unroll
                for (int e = 0; e < 4; ++e) { p0[4 * g + e] = fq - f0[e]; p1[4 * g + e] = fq - f1[e]; } }
        } else {
#pragma unroll
            for (int r = 0; r < 16; ++r) { p0[r] = 0.f; p1[r] = 0.f; }
        }
        __builtin_amdgcn_s_setprio(1);
#pragma unroll
        for (int d0 = 0; d0 < ND; ++d0) {
            ALAS const unsigned char* a = lds + buf * LY::SHM_K + kbase[d0 & 3] + (d0 >> 2) * 128;
            const bf16x8 b0 = *(const ALAS bf16x8*)a;
            const bf16x8 b1 = *(const ALAS bf16x8*)(a + 32 * LY::ROWB);
            p0 = __builtin_amdgcn_mfma_f32_32x32x16_bf16(b0, qr[d0], p0, 0, 0, 0);
            p1 = __builtin_amdgcn_mfma_f32_32x32x16_bf16(b1, qr[d0], p1, 0, 0, 0);
        }
        __builtin_amdgcn_s_setprio(0);
        if (kb + 63 > qlo) {
            const float NEG = -__builtin_inff(); const int dq = qm - kb;
#pragma unroll
            for (int r = 0; r < 16; ++r) { const int c = (r & 3) + 8 * (r >> 2); if (dq - c < 0) p0[r] = NEG; if (dq - c - 32 < 0) p1[r] = NEG; }
        }
        float pmax = p0[0];
#pragma unroll
        for (int r = 1; r < 16; ++r) pmax = fmaxf(pmax, p0[r]);
#pragma unroll
        for (int r = 0; r < 16; ++r) pmax = fmaxf(pmax, p1[r]);
        { auto rr = __builtin_amdgcn_permlane32_swap(__float_as_uint(pmax), __float_as_uint(pmax), false, false);
          pmax = fmaxf(__uint_as_float(rr[0]), __uint_as_float(rr[1])); }
        float mn, alpha;
        if (__builtin_expect(__all(pmax - m_reg <= 8.f), 1)) { mn = m_reg; alpha = 1.f; }
        else { mn = fmaxf(m_reg, pmax); alpha = __builtin_amdgcn_exp2f(m_reg - mn); m_reg = mn; }
        float ps = 0.f;
#pragma unroll
        for (int r = 0; r < 16; ++r) { p0[r] = __builtin_amdgcn_exp2f(p0[r] - mn); ps += p0[r]; }
#pragma unroll
        for (int r = 0; r < 16; ++r) { p1[r] = __builtin_amdgcn_exp2f(p1[r] - mn); ps += p1[r]; }
        { auto rr = __builtin_amdgcn_permlane32_swap(__float_as_uint(ps), __float_as_uint(ps), false, false);
          ps = __uint_as_float(rr[0]) + __uint_as_float(rr[1]); }
        l_reg = l_reg * alpha + ps;
        bf16x8 pa0, pa1, pa2, pa3;
#define ATT_PK4(P, B_, OUT) do { unsigned a0 = cvtpk(P[B_+0], P[B_+1]), a1 = cvtpk(P[B_+2], P[B_+3]); unsigned b0_ = cvtpk(P[B_+4], P[B_+5]), b1_ = cvtpk(P[B_+6], P[B_+7]); \
        auto r0 = __builtin_amdgcn_permlane32_swap(a0, b0_, false, false); auto r1 = __builtin_amdgcn_permlane32_swap(a1, b1_, false, false); \
        u32x4 w = {r0[0], r1[0], r0[1], r1[1]}; OUT = *reinterpret_cast<bf16x8*>(&w); } while (0)
        ATT_PK4(p0, 0, pa0); ATT_PK4(p0, 8, pa1); ATT_PK4(p1, 0, pa2); ATT_PK4(p1, 8, pa3);
        if (__any(alpha < 1.f)) {
            if (hi == 0) wsl[r32] = alpha;
            asm volatile("s_waitcnt lgkmcnt(0)" ::: "memory");
#pragma unroll
            for (int g = 0; g < 4; ++g) { const f32x4 al = *(const ALAS f32x4*)(wsl + 8 * g + 4 * hi);
#pragma unroll
                for (int d = 0; d < 4; ++d)
#pragma unroll
                    for (int e = 0; e < 4; ++e) o[d][4 * g + e] *= al[e]; }
        }
#define ATT_TRRD(dst, off) asm volatile("ds_read_b64_tr_b16 %0, %1 offset:%2" : "=&v"(dst) : "v"(vbb), "i"(off) : "memory")
#define ATT_PV(d0) do { s16x4 l0, l1, l2, l3, h0, h1, h2, h3; constexpr int b_ = (d0) * 512; \
        ATT_TRRD(l0, b_); ATT_TRRD(h0, b_ + 2048); ATT_TRRD(l1, b_ + 4096); ATT_TRRD(h1, b_ + 6144); ATT_TRRD(l2, b_ + 8192); ATT_TRRD(h2, b_ + 10240); ATT_TRRD(l3, b_ + 12288); ATT_TRRD(h3, b_ + 14336); \
        asm volatile("s_waitcnt lgkmcnt(0)" ::: "memory"); ASBAR(); \
        o[d0] = __builtin_amdgcn_mfma_f32_32x32x16_bf16(pa0, (bf16x8){l0[0], l0[1], l0[2], l0[3], h0[0], h0[1], h0[2], h0[3]}, o[d0], 0, 0, 0); \
        o[d0] = __builtin_amdgcn_mfma_f32_32x32x16_bf16(pa1, (bf16x8){l1[0], l1[1], l1[2], l1[3], h1[0], h1[1], h1[2], h1[3]}, o[d0], 0, 0, 0); \
        o[d0] = __builtin_amdgcn_mfma_f32_32x32x16_bf16(pa2, (bf16x8){l2[0], l2[1], l2[2], l2[3], h2[0], h2[1], h2[2], h2[3]}, o[d0], 0, 0, 0); \
        o[d0] = __builtin_amdgcn_mfma_f32_32x32x16_bf16(pa3, (bf16x8){l3[0], l3[1], l3[2], l3[3], h3[0], h3[1], h3[2], h3[3]}, o[d0], 0, 0, 0); } while (0)
        { const int vbb = vb0 + buf * SHM_V; __builtin_amdgcn_s_setprio(1); ATT_PV(0); ATT_PV(1); ATT_PV(2); ATT_PV(3); __builtin_amdgcn_s_setprio(0); }
        if (t + 1 < NT) ATT_WRITEF(buf ^ 1);
        if (side) { const bool isv = side_next >= 32; const float sc = isv ? 4.f : 64.f;
            auto pk = [](float a, float b, float c, float d) { int w = __builtin_amdgcn_cvt_pk_fp8_f32(fminf(fmaxf(a, -448.f), 448.f), fminf(fmaxf(b, -448.f), 448.f), 0, false);
                return (unsigned)__builtin_amdgcn_cvt_pk_fp8_f32(fminf(fmaxf(c, -448.f), 448.f), fminf(fmaxf(d, -448.f), 448.f), w, true); };
            uint2 o; o.x = pk(sd0[0] * sc, sd0[1] * sc, sd0[2] * sc, sd0[3] * sc); o.y = pk(sd1[0] * sc, sd1[1] * sc, sd1[2] * sc, sd1[3] * sc);
            *(uint2*)((isv ? side_v8 : side_u8) + sd_off) = o; ++side_next; }
    }
    if (hi == 0) wsl[r32] = l_reg;
    asm volatile("s_waitcnt lgkmcnt(0)" ::: "memory");
#pragma unroll
    for (int r = 0; r < 16; ++r) {
        const int orow = crow(r, hi); const float rli = __builtin_amdgcn_rcpf(wsl[orow]);
        bf16_t* rowp = gout + (size_t)(qlo + orow) * 4096; const bf16_t* growp = gate + (size_t)(qlo + orow) * 4096;
#pragma unroll
        for (int d0 = 0; d0 < 4; ++d0) {
            const float v = o[d0][r] * rli; const float vn = __shfl_xor(v, 1);
            if ((r32 & 1) == 0) { unsigned* gp = (unsigned*)(rowp + d0 * 32 + r32); const unsigned g = *(const unsigned*)(growp + d0 * 32 + r32);
                *gp = cvtpk(v * __uint_as_float(g << 16), vn * __uint_as_float(g & 0xffff0000u)); }
        }
    }
    __syncthreads();
#undef ATT_GLDS
#undef ATT_WRITEF
#undef ATT_PK4
#undef ATT_TRRD
#undef ATT_PV
}
}
using pg8::bf16_t; using pg8::f32x4; using pg8::u32x4;
#define LAS __attribute__((address_space(3)))
constexpr int S = 8192, DM = 2048, INW = 11344, INWP = 11520;
constexpr float EPS = 1e-6f;
constexpr size_t MiB = 1u << 20;

__device__ __forceinline__ float bf2f(bf16_t v) { return __uint_as_float(((unsigned)v) << 16); }
__device__ __forceinline__ bf16_t f2bf(float f) { unsigned u = __float_as_uint(f); u += 0x7fffu + ((u >> 16) & 1u); return (bf16_t)(u >> 16); }
__device__ __forceinline__ unsigned pk2(float lo, float hi) { return (unsigned)f2bf(lo) | ((unsigned)f2bf(hi) << 16); }
__device__ __forceinline__ float wave_sum(float v) {
#pragma unroll
    for (int o = 32; o >= 1; o >>= 1) v += __shfl_xor(v, o);
    return v;
}
__device__ __forceinline__ float wave_max(float v) {
#pragma unroll
    for (int o = 32; o >= 1; o >>= 1) v = fmaxf(v, __shfl_xor(v, o));
    return v;
}

__device__ __forceinline__ int opaque_tid() { int t = threadIdx.x; asm volatile("" : "+v"(t)); return t; }

struct Params {
    const float* x; const int* pos; const float *mix_g, *w_in, *b_forget, *b_gate, *q_lat_g, *w_q_up, *kv_lat_g, *w_kv_up, *mla_qg, *mla_kg, *fox_qg, *fox_kg, *w_out, *ffn_g, *w_peer_q, *sub_keys, *peer_u, *peer_v;
    float* out;
    bf16_t *WqT, *WkvT, *WoT, *WpT, *WinT;
    bf16_t *h, *cq, *ckv, *fq, *fk, *fv, *merged, *kpe, *qa, *va, *ka;
    float *lf, *F, *x1, *scores;
    unsigned char *U8, *V8; bf16_t* attout;
    unsigned* ctl;
    float2* ropeT; float* ssq; float* ssq2; bf16_t* xg;
};

struct DstId { __device__ __forceinline__ int operator()(int n) const { return n; } };
struct DstWin { __device__ __forceinline__ int operator()(int n) const {
    if (n < 1024) return n; if (n < 1088) { const int r = n - 1024; return 11264 + 2 * (r & 31) + (r >> 5); } if (n < 7232) return n - 64; if (n < 7248) return 11264 + 64 + (n - 7232); return n - 80; } };
struct DstQ { __device__ __forceinline__ int operator()(int n) const {
    const int h = n / 192, d = n - h * 192; if (d < 128) return h * 256 + d; const int r = d - 128; return h * 256 + 128 + 2 * (r & 31) + (r >> 5); } };
template <class Dst>
__device__ __forceinline__ void transpose_item(const float* __restrict__ W, int K, int N, bf16_t* __restrict__ WT, Dst dst, float* scr, int item, int lane, const float* __restrict__ gk = nullptr) {
    const int nblk = (N + 31) / 32, kb = item / nblk, nb = item % nblk, k0 = 64 * kb, n0 = 32 * nb;
    { const int rr = lane >> 3, c4 = (lane & 7) * 4; const bool ok = (n0 + c4) < N;
      f32x4 v[8];
#pragma unroll
      for (int i = 0; i < 8; ++i) v[i] = ok ? *(const f32x4*)(W + (size_t)(k0 + 8 * i + rr) * N + n0 + c4) : (f32x4){0.f, 0.f, 0.f, 0.f};
      if (gk) {
#pragma unroll
          for (int i = 0; i < 8; ++i) v[i] *= gk[k0 + 8 * i + rr]; }
#pragma unroll
      for (int i = 0; i < 8; ++i) { float* sp = scr + (8 * i + rr) * 33 + c4; sp[0] = v[i][0]; sp[1] = v[i][1]; sp[2] = v[i][2]; sp[3] = v[i][3]; } }
    asm volatile("s_waitcnt lgkmcnt(0)" ::: "memory");
    const int c = lane & 7;
#pragma unroll
    for (int j = 0; j < 4; ++j) { const int nl = (lane >> 3) + 8 * j, n = n0 + nl; const float* s = scr + (8 * c) * 33 + nl;
        u32x4 o; o.x = pk2(s[0 * 33], s[1 * 33]); o.y = pk2(s[2 * 33], s[3 * 33]); o.z = pk2(s[4 * 33], s[5 * 33]); o.w = pk2(s[6 * 33], s[7 * 33]);
        if (n < N) *(u32x4*)(WT + (size_t)dst(n) * K + k0 + 8 * c) = o; }
    asm volatile("s_waitcnt lgkmcnt(0)" ::: "memory");
}
__device__ __forceinline__ void wfold_item(const float* __restrict__ wq, const float* __restrict__ keys, bf16_t* __restrict__ WpT, float* sm, int item) {
    const int tid = opaque_tid(), hc = item >> 5, d0 = (item & 31) * 64;
    float* keysL = sm; float* wqL = sm + 128 * 132;
    for (int idx = tid; idx < 128 * 32; idx += 512) { const int r = idx >> 5, c4 = (idx & 31) * 4; *(f32x4*)(keysL + r * 132 + c4) = *(const f32x4*)(keys + (size_t)hc * 16384 + r * 128 + c4); }
    for (int idx = tid; idx < 64 * 32; idx += 512) { const int r = idx >> 5, c4 = (idx & 31) * 4; *(f32x4*)(wqL + r * 132 + c4) = *(const f32x4*)(wq + (size_t)(d0 + r) * 2048 + hc * 128 + c4); }
    __syncthreads();
    const int n2 = (tid & 63) * 2, dg = tid >> 6;
    float acc[2][8];
#pragma unroll
    for (int a = 0; a < 2; ++a)
#pragma unroll
        for (int i = 0; i < 8; ++i) acc[a][i] = 0.f;
#pragma unroll 2
    for (int j4 = 0; j4 < 32; ++j4) {
        const f32x4 k0v = *(const f32x4*)(keysL + n2 * 132 + 4 * j4), k1v = *(const f32x4*)(keysL + (n2 + 1) * 132 + 4 * j4);
#pragma unroll
        for (int i = 0; i < 8; ++i) { const f32x4 w = *(const f32x4*)(wqL + (dg * 8 + i) * 132 + 4 * j4);
            acc[0][i] += (k0v[0] * w[0] + k0v[1] * w[1]) + (k0v[2] * w[2] + k0v[3] * w[3]);
            acc[1][i] += (k1v[0] * w[0] + k1v[1] * w[1]) + (k1v[2] * w[2] + k1v[3] * w[3]); }
    }
#pragma unroll
    for (int a = 0; a < 2; ++a) { u32x4 o; o.x = pk2(acc[a][0], acc[a][1]); o.y = pk2(acc[a][2], acc[a][3]); o.z = pk2(acc[a][4], acc[a][5]); o.w = pk2(acc[a][6], acc[a][7]);
        *(u32x4*)(WpT + (size_t)(hc * 128 + n2 + a) * 2048 + d0 + dg * 8) = o; }
    __syncthreads();
}
__device__ __forceinline__ void rms_row2048(const float* __restrict__ xr, const float* __restrict__ g, bf16_t* __restrict__ orow, int lane) {
    f32x4 v[8]; float ss = 0.f;
#pragma unroll
    for (int j = 0; j < 8; ++j) { v[j] = *(const f32x4*)(xr + j * 256 + lane * 4); ss += (v[j][0] * v[j][0] + v[j][1] * v[j][1]) + (v[j][2] * v[j][2] + v[j][3] * v[j][3]); }
    const float r = rsqrtf(wave_sum(ss) * (1.f / 2048.f) + EPS);
#pragma unroll
    for (int j = 0; j < 8; ++j) { const f32x4 gg = *(const f32x4*)(g + j * 256 + lane * 4);
        uint2 o; o.x = pk2(v[j][0] * r * gg[0], v[j][1] * r * gg[1]); o.y = pk2(v[j][2] * r * gg[2], v[j][3] * r * gg[3]);
        *(uint2*)(orow + j * 256 + lane * 4) = o; }
}
__device__ __forceinline__ void fox_cumsum(double* part, int h, const float* __restrict__ lf, float* __restrict__ F) {
    const int tid = opaque_tid(), lane = tid & 63, wave = tid >> 6;
    float v[16]; double sum = 0.0;
#pragma unroll
    for (int i = 0; i < 16; ++i) { v[i] = lf[(size_t)(tid * 16 + i) * 16 + h]; sum += (double)v[i]; }
    double inc = sum;
#pragma unroll
    for (int o = 1; o < 64; o <<= 1) { const double n = __shfl_up(inc, o); if (lane >= o) inc += n; }
    if (lane == 63) part[wave] = inc;
    __syncthreads();
    double base = 0.0;
    for (int w = 0; w < wave; ++w) base += part[w];
    double run = base + inc - sum;
#pragma unroll
    for (int i = 0; i < 16; ++i) { run += (double)v[i]; F[(size_t)h * S + tid * 16 + i] = (float)(run * 1.4426950408889634); }
    __syncthreads();
}
__device__ __forceinline__ void rope_table(const int* __restrict__ pos, float2* __restrict__ ropeT, int gtid, int nthreads) {
    for (int idx = gtid; idx < S * 32; idx += nthreads) { const int t = idx >> 5, i = idx & 31;
        const double inv = exp(-(double)i * (1.0 / 32.0) * 9.210340371976184);
        double ang = (double)((float)pos[t] * (float)inv);
        const double twopi = 6.283185307179586;
        ang -= twopi * rint(ang / twopi);
        ropeT[idx] = make_float2(cosf((float)ang), sinf((float)ang)); }
}
typedef float f32x2 __attribute__((ext_vector_type(2)));
__device__ __forceinline__ unsigned pk4_fp8(float a, float b, float c, float d) {
    int w = __builtin_amdgcn_cvt_pk_fp8_f32(fminf(fmaxf(a, -448.f), 448.f), fminf(fmaxf(b, -448.f), 448.f), 0, false);
    w = __builtin_amdgcn_cvt_pk_fp8_f32(fminf(fmaxf(c, -448.f), 448.f), fminf(fmaxf(d, -448.f), 448.f), w, true); return (unsigned)w; }
__device__ __forceinline__ void cvt_rows_fp8(const float* __restrict__ src, unsigned char* __restrict__ dst, size_t n, float scale, int gw, int NGW, int lane) {
    const size_t nchunk = n / 1024;
    for (size_t c = gw; c < nchunk; c += NGW) { const size_t o = c * 1024 + lane * 16;
        f32x4 a[4];
#pragma unroll
        for (int q = 0; q < 4; ++q) a[q] = *(const f32x4*)(src + o + 4 * q) * scale;
        u32x4 w; w.x = pk4_fp8(a[0][0], a[0][1], a[0][2], a[0][3]); w.y = pk4_fp8(a[1][0], a[1][1], a[1][2], a[1][3]);
        w.z = pk4_fp8(a[2][0], a[2][1], a[2][2], a[2][3]); w.w = pk4_fp8(a[3][0], a[3][1], a[3][2], a[3][3]);
        *(u32x4*)(dst + o) = w; }
}
constexpr float U_SCALE = 64.f, V_SCALE = 4.f;
typedef __bf16 bf16x2_t __attribute__((ext_vector_type(2)));
__device__ __forceinline__ float dot2bf(unsigned a, unsigned b, float c) { return __builtin_amdgcn_fdot2_f32_bf16(__builtin_bit_cast(bf16x2_t, a), __builtin_bit_cast(bf16x2_t, b), c, false); }
#define PEER_INS(top, x) do { float x_ = (x); _Pragma("unroll") for (int i_ = 0; i_ < 16; ++i_) { const float hi_ = fmaxf(top[i_], x_); x_ = fminf(top[i_], x_); top[i_] = hi_; } } while (0)
__device__ __forceinline__ void peer_group(unsigned char* smem, int g, const float* __restrict__ scores, const bf16_t* __restrict__ h2  , const float* __restrict__ ssq2, const float* __restrict__ x1,
                                           const unsigned char* __restrict__ U8, const unsigned char* __restrict__ V8, float* __restrict__ out) {
    const int tid = opaque_tid(), lane = tid & 63, wave = __builtin_amdgcn_readfirstlane(tid >> 6);
    float* topL = (float*)smem;
    int* selE = (int*)(smem + 32768);
    float* selG = (float*)(smem + 49152);
    {
        const int tl = tid >> 4, hc = tid & 15;
        const float* sp = scores + (size_t)(g * 32 + tl) * 2048 + hc * 128;
        float top[16];
#pragma unroll
        for (int i = 0; i < 16; ++i) top[i] = -INFINITY;
#pragma unroll 2
        for (int n0 = 0; n0 < 128; n0 += 4) { const f32x4 v = *(const f32x4*)(sp + n0);
#pragma unroll
            for (int e = 0; e < 4; ++e) PEER_INS(top, __uint_as_float((__float_as_uint(v[e]) & ~0x7Fu) | (unsigned)(n0 + e))); }
        float* tp = topL + (tl * 16 + hc) * 16;
#pragma unroll
        for (int i = 0; i < 16; i += 4) *(f32x4*)(tp + i) = (f32x4){top[i], top[i + 1], top[i + 2], top[i + 3]};
    }
    __syncthreads();
    if (tid < 256) {
        const int tl = tid >> 3, h = tid & 7;
        const float* t1 = topL + (tl * 16 + 2 * h) * 16; const float* t2 = t1 + 16;
        float s1[16], s2[16];
#pragma unroll
        for (int i = 0; i < 16; i += 4) { const f32x4 a = *(const f32x4*)(t1 + i), b2 = *(const f32x4*)(t2 + i);
            s1[i] = a[0]; s1[i + 1] = a[1]; s1[i + 2] = a[2]; s1[i + 3] = a[3]; s2[i] = b2[0]; s2[i + 1] = b2[1]; s2[i + 2] = b2[2]; s2[i + 3] = b2[3]; }
        float ts[16];
#pragma unroll
        for (int i = 0; i < 16; ++i) ts[i] = -INFINITY;
#pragma unroll
        for (int i = 0; i < 16; ++i)
#pragma unroll
            for (int j = 0; j < 16; ++j)
                if ((i + 1) * (j + 1) <= 16) PEER_INS(ts, __uint_as_float((__float_as_uint(s1[i] + s2[j]) & ~0xFFu) | (unsigned)(i * 16 + j)));
        float ex[16], sum = 0.f;
#pragma unroll
        for (int k = 0; k < 16; ++k) { ex[k] = __expf(ts[k] - ts[0]); sum += ex[k]; }
        const float inv = 1.f / sum;
#pragma unroll
        for (int k = 0; k < 16; ++k) { const unsigned pos = __float_as_uint(ts[k]) & 0xFFu;
            const int i1 = (int)(__float_as_uint(t1[pos >> 4]) & 0x7Fu), i2 = (int)(__float_as_uint(t2[pos & 15]) & 0x7Fu);
            selE[tl * 128 + h * 16 + k] = i1 * 128 + i2; selG[tl * 128 + h * 16 + k] = ex[k] * inv; }
    }
    __syncthreads();
    const int grp = lane >> 4, l16 = lane & 15, tl = wave * 4 + grp;
    unsigned* sortK = (unsigned*)(smem + 65536) + tl * 128;
    float* wS = (float*)(smem + 81920) + tl * 128;
    unsigned* hist = (unsigned*)(smem + 98304) + wave * 512 + grp * 64;
    {
#pragma unroll
        for (int i = 0; i < 4; ++i) hist[l16 * 4 + i] = 0u;
        asm volatile("s_waitcnt lgkmcnt(0)" ::: "memory");
        unsigned ek[8], rk[8];
#pragma unroll
        for (int j = 0; j < 8; ++j) { ek[j] = (unsigned)selE[tl * 128 + l16 + 16 * j]; rk[j] = atomicAdd(&hist[ek[j] >> 8], 1u); }
        asm volatile("s_waitcnt lgkmcnt(0)" ::: "memory");
        unsigned c[4], tot = 0u;
#pragma unroll
        for (int i = 0; i < 4; ++i) { c[i] = hist[l16 * 4 + i]; tot += c[i]; }
        unsigned inc = tot;
#pragma unroll
        for (int o = 1; o < 16; o <<= 1) { const unsigned n = __shfl_up(inc, o, 16); if (l16 >= o) inc += n; }
        unsigned run = inc - tot;
#pragma unroll
        for (int i = 0; i < 4; ++i) { hist[256 + l16 * 4 + i] = run; run += c[i]; }
        asm volatile("s_waitcnt lgkmcnt(0)" ::: "memory");
#pragma unroll
        for (int j = 0; j < 8; ++j) sortK[hist[256 + (ek[j] >> 8)] + rk[j]] = (ek[j] << 7) | (unsigned)(l16 + 16 * j);
    }
    __syncthreads();
    const size_t tok = (size_t)g * 32 + tl;
    float rinv_tok;
    { float t = 0.f; if (l16 < 8) { const f32x4 a = *(const f32x4*)(ssq2 + ((size_t)l16 * 8192 + tok) * 4); t = (a[0] + a[1]) + (a[2] + a[3]); }
      t += __shfl_xor(t, 8); t += __shfl_xor(t, 4); t += __shfl_xor(t, 2); t += __shfl_xor(t, 1); rinv_tok = rsqrtf(t * (1.f / 2048.f) + 1e-6f); }
#pragma unroll 1
    for (int hf = 0; hf < 2; ++hf) {
        f32x2 hp[32];
#pragma unroll
        for (int j = 0; j < 4; ++j)
#pragma unroll
            for (int q = 0; q < 2; ++q) { const u32x4 w = *(const u32x4*)(h2 + tok * DM + hf * 1024 + j * 256 + l16 * 16 + q * 8);
#pragma unroll
                for (int c = 0; c < 4; ++c) hp[j * 8 + q * 4 + c] = (f32x2){__uint_as_float(w[c] << 16), __uint_as_float(w[c] & 0xffff0000u)}; }
        for (int it = 0; it < 128; it += 4) {
            if ((it & 7) == 0 && it) __syncthreads();
            unsigned key[4]; u32x4 ur[4][4];
#pragma unroll
            for (int p = 0; p < 4; ++p) { key[p] = sortK[it + p];
#pragma unroll
                for (int j = 0; j < 4; ++j) ur[p][j] = *(const u32x4*)(U8 + (size_t)(key[p] >> 7) * DM + hf * 1024 + j * 256 + l16 * 16); }
#pragma unroll
            for (int p = 0; p < 4; ++p) { f32x2 a2 = (f32x2){0.f, 0.f}, b2 = (f32x2){0.f, 0.f};
#pragma unroll
                for (int j = 0; j < 4; ++j)
#pragma unroll
                    for (int c = 0; c < 4; ++c) { const int w = (int)ur[p][j][c];
                        a2 = __builtin_elementwise_fma(hp[j * 8 + 2 * c], __builtin_amdgcn_cvt_pk_f32_fp8(w, false), a2);
                        b2 = __builtin_elementwise_fma(hp[j * 8 + 2 * c + 1], __builtin_amdgcn_cvt_pk_f32_fp8(w, true), b2); }
                float d = (a2.x + a2.y) + (b2.x + b2.y);
                d += __shfl_xor(d, 8); d += __shfl_xor(d, 4); d += __shfl_xor(d, 2); d += __shfl_xor(d, 1);
                if (hf == 0) { if (l16 == 0) wS[it + p] = d; }
                else { const float a = (wS[it + p] + d) * (rinv_tok * (1.f / U_SCALE));
                    const float w = selG[tl * 128 + (key[p] & 127u)] * 0.5f * a * (1.f + erff(a * 0.70710678118654752f)) * (1.f / V_SCALE);
                    if (l16 == 0) wS[it + p] = w; } }
        }
        __syncthreads();
    }
#pragma unroll 1
    for (int hf = 0; hf < 2; ++hf) {
        f32x2 acc[32];
#pragma unroll
        for (int c = 0; c < 32; ++c) acc[c] = (f32x2){0.f, 0.f};
        for (int it = 0; it < 128; it += 4) {
            if ((it & 7) == 0 && it) __syncthreads();
            unsigned key[4]; u32x4 vr[4][4];
#pragma unroll
            for (int p = 0; p < 4; ++p) { key[p] = sortK[it + p];
#pragma unroll
                for (int j = 0; j < 4; ++j) vr[p][j] = *(const u32x4*)(V8 + (size_t)(key[p] >> 7) * DM + hf * 1024 + j * 256 + l16 * 16); }
#pragma unroll
            for (int p = 0; p < 4; ++p) { const float w = wS[it + p]; const f32x2 w2 = (f32x2){w, w};
#pragma unroll
                for (int j = 0; j < 4; ++j)
#pragma unroll
                    for (int c = 0; c < 4; ++c) { const int x = (int)vr[p][j][c];
                        acc[j * 8 + 2 * c] = __builtin_elementwise_fma(w2, __builtin_amdgcn_cvt_pk_f32_fp8(x, false), acc[j * 8 + 2 * c]);
                        acc[j * 8 + 2 * c + 1] = __builtin_elementwise_fma(w2, __builtin_amdgcn_cvt_pk_f32_fp8(x, true), acc[j * 8 + 2 * c + 1]); } }
        }
#pragma unroll
        for (int j = 0; j < 4; ++j)
#pragma unroll
            for (int q = 0; q < 4; ++q) { const size_t o = tok * DM + hf * 1024 + j * 256 + l16 * 16 + q * 4;
                const f32x4 a = *(const f32x4*)(x1 + o);
                *(f32x4*)(out + o) = (f32x4){a[0] + acc[j * 8 + 2 * q].x, a[1] + acc[j * 8 + 2 * q].y, a[2] + acc[j * 8 + 2 * q + 1].x, a[3] + acc[j * 8 + 2 * q + 1].y}; }
        __syncthreads();
    }
    __syncthreads();
}

#define XB_TMO      128
#define XB_XCNT(j)  (256  + 64 * (j))
#define XB_XSUB(j)  (1280 + 64 * (j))
#define XB_XGEN(j)  (2304 + 64 * (j))
#define XB_TOP      3328
#define XB_TOPGEN   3392
#define XCD_BAR_WORDS 3456
#define XB_SPIN_CAP (1u << 18)

__device__ __forceinline__ unsigned xb_ld(unsigned* p)              { return __hip_atomic_load(p, __ATOMIC_RELAXED, __HIP_MEMORY_SCOPE_AGENT); }
__device__ __forceinline__ unsigned xb_add(unsigned* p, unsigned v) { return __hip_atomic_fetch_add(p, v, __ATOMIC_RELAXED, __HIP_MEMORY_SCOPE_AGENT); }
__device__ __forceinline__ unsigned xb_xcc_id() { return (unsigned)__builtin_amdgcn_s_getreg((3 << 11) | 20) & 0xFu; }
#define XB_SPIN(cond, bar) do { unsigned _sp = 0; while (cond) { __builtin_amdgcn_s_sleep(1); \
    if ((++_sp & 255u) == 0u) { if (xb_ld(&(bar)[XB_TMO])) break; if (_sp > XB_SPIN_CAP) { atomicAdd(&(bar)[XB_TMO], 1u); break; } } } } while (0)

struct XcdBarrier {
    unsigned* bar; unsigned x;
    volatile LAS unsigned* st;
};

__device__ __forceinline__ XcdBarrier xcd_barrier_post(unsigned* bar, volatile LAS unsigned* st) {
    XcdBarrier b; b.bar = bar; b.x = xb_xcc_id(); b.st = st;
    if (threadIdx.x == 0) (void)xb_add(&bar[XB_XCNT(b.x)], 1u);
    return b;
}
__device__ __forceinline__ void xcd_barrier_complete(unsigned* bar, unsigned x, unsigned& nloc, unsigned& nx) {
    const unsigned G = gridDim.x * gridDim.y * gridDim.z;
    unsigned sum, cnt, mine, sp = 0u;
    for (;;) {
        sum = 0u; cnt = 0u; mine = 0u;
#pragma unroll
        for (unsigned j = 0; j < 16; ++j) { const unsigned c = xb_ld(&bar[XB_XCNT(j)]); sum += c; cnt += (c > 0u) ? 1u : 0u; mine = (j == x) ? c : mine; }
        if (sum == G) break;
        __builtin_amdgcn_s_sleep(1);
        if ((++sp & 255u) == 0u) { if (xb_ld(&bar[XB_TMO])) break; if (sp > XB_SPIN_CAP) { atomicAdd(&bar[XB_TMO], 1u); break; } }
    }
    nloc = mine > 0u ? mine : 1u; nx = cnt > 0u ? cnt : 1u;
}

__device__ __forceinline__ void xcd_barrier(const XcdBarrier& b) {
    asm volatile("s_waitcnt vmcnt(0)" ::: "memory");
    __syncthreads();
    if (threadIdx.x == 0) {
        unsigned* bar = b.bar;
        __builtin_amdgcn_s_waitcnt(0);
        unsigned nloc = b.st[0], nx = b.st[1];
        if (nloc == 0u) { xcd_barrier_complete(bar, b.x, nloc, nx); b.st[0] = nloc; b.st[1] = nx; }
        const unsigned old = xb_add(&bar[XB_XSUB(b.x)], 1u);
        const unsigned gen = old / nloc;
        if (old + 1u == (gen + 1u) * nloc) {
            __builtin_amdgcn_fence(__ATOMIC_RELEASE, "agent");
            asm volatile("s_waitcnt vmcnt(0)" ::: "memory");
            const unsigned og = xb_add(&bar[XB_TOP], 1u);
            const unsigned tg = og / nx;
            if (og + 1u == (tg + 1u) * nx) xb_add(&bar[XB_TOPGEN], 1u);
            else XB_SPIN(xb_ld(&bar[XB_TOPGEN]) == tg, bar);
            __builtin_amdgcn_fence(__ATOMIC_ACQUIRE, "agent");
            xb_add(&bar[XB_XGEN(b.x)], 1u);
            asm volatile("s_waitcnt vmcnt(0)" ::: "memory");
        } else {
            XB_SPIN(xb_ld(&bar[XB_XGEN(b.x)]) == gen, bar);
            __builtin_amdgcn_fence(__ATOMIC_ACQUIRE, "agent");
            asm volatile("s_waitcnt vmcnt(0)" ::: "memory");
        }
    }
    __syncthreads();
}

#define PROBE_DOUBLE 0
#define REP(k) for (int rep_ = 0; rep_ < ((PROBE_DOUBLE == (k)) ? 2 : 1); ++rep_)
constexpr int LDS_BYTES = 147456;
__global__ __launch_bounds__(512, 2) void mega(Params p) {
    extern __shared__ __attribute__((aligned(16))) unsigned char smem[];
    { volatile LAS unsigned* st0 = (volatile LAS unsigned*)((LAS unsigned char*)smem + 131072); if (threadIdx.x < 2) st0[threadIdx.x] = 0u; }
    __syncthreads();
    const XcdBarrier bar = xcd_barrier_post(p.ctl, (volatile LAS unsigned*)((LAS unsigned char*)smem + 131072));
    float* smf = (float*)smem;
    LAS unsigned char* lds = (LAS unsigned char*)smem;
    const int G = gridDim.x, b = blockIdx.x, NGW = G * 8;
#define PHASE_IDS() const int tid = opaque_tid(), lane = tid & 63, wave = __builtin_amdgcn_readfirstlane(tid >> 6), gw = b * 8 + wave; (void)lane; (void)gw

    REP(7) {
        PHASE_IDS();
        float* scr = smf + wave * 4096;
        constexpr int dummy_ = 0; (void)dummy_;
        constexpr int I_IN = 32 * 355, I_Q = 8 * 96, I_KV = 8 * 128, I_O = 64 * 64;
        for (int it = gw; it < I_IN + I_Q + I_KV + I_O; it += NGW) {
            int r = it;
            if (r < I_IN) { transpose_item(p.w_in, 2048, INW, p.WinT, DstWin(), scr, r, lane); continue; } r -= I_IN;
            if (r < I_Q) { transpose_item(p.w_q_up, 512, 3072, p.WqT, DstQ(), scr, r, lane, p.q_lat_g); continue; } r -= I_Q;
            if (r < I_KV) { transpose_item(p.w_kv_up, 512, 4096, p.WkvT, DstId(), scr, r, lane, p.kv_lat_g); continue; } r -= I_KV;
            transpose_item(p.w_out, 4096, 2048, p.WoT, DstId(), scr, r, lane);
        }
        for (int m = gw; m < S; m += NGW) rms_row2048(p.x + (size_t)m * DM, p.mix_g, p.h + (size_t)m * DM, lane);
        for (int idx = b * 512 + tid; idx < 16 * 64 * 64; idx += G * 512) { const int hh = idx >> 12, rr = (idx >> 6) & 63, c8 = idx & 63;
            *(u32x4*)(p.WqT + (size_t)(hh * 256 + 192 + rr) * 512 + c8 * 8) = (u32x4){0u, 0u, 0u, 0u}; }
        rope_table(p.pos, p.ropeT, b * 512 + tid, G * 512);
        __syncthreads();
        for (int it = b; it < 512; it += G) wfold_item(p.w_peer_q, p.sub_keys, p.WpT, smf, it);
    }
    xcd_barrier(bar);
    REP(1) {
        pg8::Gemm g{p.h, p.WinT, S, INWP, DM}; pg8::StaticOrder so; so.init(S, INWP, G, b);
        pg8::EpiInProj E{p.cq, p.ckv, p.fq, p.fk, p.fv, p.merged, p.kpe, p.lf, p.b_gate, p.b_forget, p.ssq, p.fox_qg, p.fox_kg, (LAS float*)(lds + 131072 + 64)};
        pg8::gemm_phase<pg8::EpiInProj, pg8::StaticOrder, true, true>(lds, g, so, E);
    }
    xcd_barrier(bar);
    for (int hh = b; hh < 16; hh += G) fox_cumsum((double*)smem, hh, p.lf, p.F);
    REP(2) {
        pg8::Gemm g{p.cq, p.WqT, S, 4096, 512}; pg8::StaticOrder so; so.init(S, 4096, G, b);
        pg8::EpiQ E{p.qa, p.ssq, p.mla_qg, p.ropeT, (LAS float*)(lds + 131072 + 64)};
        pg8::gemm_phase<pg8::EpiQ, pg8::StaticOrder, true, true>(lds, g, so, E);
    }
    {
        pg8::Gemm g{p.ckv, p.WkvT, S, 4096, 512}; pg8::StaticOrder so; so.init(S, 4096, G, b);
        pg8::EpiKV E{p.ka, p.va, p.kpe, p.ssq, p.mla_kg, p.ropeT, (LAS float*)(lds + 131072 + 64)};
        pg8::gemm_phase<pg8::EpiKV, pg8::StaticOrder, true, true>(lds, g, so, E);
    }
    xcd_barrier(bar);
    int side_next = 0;
    REP(3) for (int L = b; L < 1024; L += G) {
        const int i = L >> 8, vc = L & 255, vcx = (vc & 7) * 32 + (vc >> 3), hh = vcx >> 4, x = vcx & 15, qbk = (i & 1) ? x : 31 - x;
        if (i < 2) att::attn_block<192, false>(smem, p.qa + hh * 192, 3072, p.ka + hh * 192, 3072, p.va + hh * 128, 2048, nullptr, p.merged + hh * 128, p.attout + hh * 128, qbk, nullptr, nullptr, p.peer_u, p.peer_v, p.U8, p.V8, side_next);
        else att::attn_block<128, true>(smem, p.fq + hh * 128, 2048, p.fk + hh * 128, 2048, p.fv + hh * 128, 2048, p.F + (size_t)hh * S, p.merged + 2048 + hh * 128, p.attout + 2048 + hh * 128, qbk, p.fox_qg, p.fox_kg, p.peer_u, p.peer_v, p.U8, p.V8, side_next);
    }
    if (G == 256) { PHASE_IDS(); (void)wave;
        for (; side_next < 64; ++side_next) { const bool isv = side_next >= 32; const size_t off = ((size_t)(b * 32 + (side_next & 31)) * 512 + tid) * 8;
            const float* sp = (isv ? p.peer_v : p.peer_u) + off; const float sc = isv ? V_SCALE : U_SCALE; const f32x4 a0 = *(const f32x4*)sp * sc, a1 = *(const f32x4*)(sp + 4) * sc;
            uint2 o; o.x = pk4_fp8(a0[0], a0[1], a0[2], a0[3]); o.y = pk4_fp8(a1[0], a1[1], a1[2], a1[3]); *(uint2*)((isv ? p.V8 : p.U8) + off) = o; } }
    else { PHASE_IDS(); cvt_rows_fp8(p.peer_u, p.U8, (size_t)16384 * 2048, U_SCALE, gw, NGW, lane); cvt_rows_fp8(p.peer_v, p.V8, (size_t)16384 * 2048, V_SCALE, gw, NGW, lane); }
    xcd_barrier(bar);
    REP(4) {
        pg8::Gemm g{p.attout, p.WoT, S, 2048, 4096}; pg8::StaticOrder so; so.init(S, 2048, G, b);
        pg8::EpiX1 E{p.x1, p.x, p.xg, p.ffn_g, p.ssq2};
        pg8::gemm_phase<pg8::EpiX1, pg8::StaticOrder, true, true>(lds, g, so, E);
    }
    xcd_barrier(bar);
    REP(5) {
        pg8::Gemm g{p.xg, p.WpT, S, 2048, 2048}; pg8::StaticOrder so; so.init(S, 2048, G, b);
        pg8::EpiScores E{p.scores, p.ssq2};
        pg8::gemm_phase<pg8::EpiScores, pg8::StaticOrder, true, true>(lds, g, so, E);
    }
    xcd_barrier(bar);
    REP(6) for (int g = b; g < S / 32; g += G) peer_group(smem, g, p.scores, p.xg, p.ssq2, p.x1, p.U8, p.V8, p.out);
}

extern "C" void kernel_launch(void* const* d_in, const int* in_sizes, int n_in,
                              void* d_out, int out_size, void* d_ws, size_t ws_size,
                              hipStream_t stream) {
    if (ws_size < 512 * MiB) { fprintf(stderr, "kernel_launch: workspace too small (%zu)\n", ws_size); return; }
    Params p{};
    p.x = (const float*)d_in[0]; p.pos = (const int*)d_in[1]; p.mix_g = (const float*)d_in[2]; p.w_in = (const float*)d_in[3];
    p.b_forget = (const float*)d_in[4]; p.b_gate = (const float*)d_in[5]; p.q_lat_g = (const float*)d_in[6]; p.w_q_up = (const float*)d_in[7];
    p.kv_lat_g = (const float*)d_in[8]; p.w_kv_up = (const float*)d_in[9]; p.mla_qg = (const float*)d_in[10]; p.mla_kg = (const float*)d_in[11];
    p.fox_qg = (const float*)d_in[12]; p.fox_kg = (const float*)d_in[13]; p.w_out = (const float*)d_in[14]; p.ffn_g = (const float*)d_in[15];
    p.w_peer_q = (const float*)d_in[16]; p.sub_keys = (const float*)d_in[17]; p.peer_u = (const float*)d_in[18]; p.peer_v = (const float*)d_in[19];
    p.out = (float*)d_out;
    char* ws = (char*)d_ws;
    p.WqT = (bf16_t*)(ws + 1 * MiB); p.WkvT = (bf16_t*)(ws + 5 * MiB); p.WoT = (bf16_t*)(ws + 9 * MiB); p.WpT = (bf16_t*)(ws + 25 * MiB); p.WinT = (bf16_t*)(ws + 33 * MiB);
    p.h = (bf16_t*)(ws + 78 * MiB); p.cq = (bf16_t*)(ws + 110 * MiB); p.ckv = (bf16_t*)(ws + 118 * MiB);
    p.fq = (bf16_t*)(ws + 126 * MiB); p.fk = (bf16_t*)(ws + 158 * MiB); p.fv = (bf16_t*)(ws + 190 * MiB); p.merged = (bf16_t*)(ws + 222 * MiB);
    p.kpe = (bf16_t*)(ws + 286 * MiB); p.lf = (float*)(ws + 287 * MiB); p.F = (float*)(ws + 287 * MiB + 512 * 1024);
    p.qa = (bf16_t*)(ws + 288 * MiB); p.va = (bf16_t*)(ws + 336 * MiB); p.ka = (bf16_t*)(ws + 400 * MiB); p.x1 = (float*)(ws + 126 * MiB);
    p.scores = (float*)(ws + 222 * MiB);
    p.ctl = (unsigned*)ws;
    p.ropeT = (float2*)(ws + 448 * MiB);
    p.ssq = (float*)(ws + 64 * 1024);
    p.attout = (bf16_t*)(ws + 33 * MiB);
    p.U8 = (unsigned char*)(ws + 450 * MiB); p.V8 = (unsigned char*)(ws + 368 * MiB);
    p.xg = (bf16_t*)(ws + 190 * MiB);
    p.ssq2 = (float*)(ws + 482 * MiB);

    static int grid_blocks = 0;
    if (!grid_blocks) {
        if (hipFuncSetAttribute((const void*)mega, hipFuncAttributeMaxDynamicSharedMemorySize, LDS_BYTES) != hipSuccess) { fprintf(stderr, "hipFuncSetAttribute failed\n"); return; }
        int dev = 0, cus = 0, per_cu = 0;
        (void)hipGetDevice(&dev);
        (void)hipDeviceGetAttribute(&cus, hipDeviceAttributeMultiprocessorCount, dev);
        (void)hipOccupancyMaxActiveBlocksPerMultiprocessor(&per_cu, (const void*)mega, 512, LDS_BYTES);
        if (per_cu < 1 || cus < 1) { fprintf(stderr, "occupancy query says %d blocks/CU on %d CUs\n", per_cu, cus); return; }
        grid_blocks = cus;
    }
    if (hipMemsetAsync(d_ws, 0, 16384, stream) != hipSuccess) { fprintf(stderr, "memset of the barrier words failed\n"); return; }
    void* args[] = {&p};
    hipError_t e = hipLaunchCooperativeKernel((const void*)mega, dim3(grid_blocks), dim3(512), args, LDS_BYTES, stream);
    if (e != hipSuccess) fprintf(stderr, "cooperative launch failed: %s (grid %d)\n", hipGetErrorString(e), grid_blocks);
}
```

```cpp
#include <hip/hip_runtime.h>
#include <hip/hip_cooperative_groups.h>
#include <stdint.h>
#include <math.h>
#include <cstdio>
namespace cg = cooperative_groups;

namespace pg8 {
#define PG8_LAS __attribute__((address_space(3)))
typedef unsigned short bf16_t;
typedef short bf16x8 __attribute__((ext_vector_type(8)));
typedef float f32x4 __attribute__((ext_vector_type(4)));
typedef unsigned u32x4 __attribute__((ext_vector_type(4)));
constexpr int BM = 256, BK = 64, HALF = 128, HTB = HALF * BK * 2  , STAGE_BYTES = 8 * HTB, NXCD = 8, WGM = 8;

__host__ __device__ __forceinline__ int lds_byte(int r, int c) { const int st = (r >> 4) * 2 + (c >> 5), rr = r & 15, cc = c & 31, ob = rr * 64 + cc * 2; return st * 1024 + (ob ^ (((ob >> 9) & 1) << 5)); }
__host__ __device__ __forceinline__ void stage_rc(int b, int& R, int& C) { const int st = b / 1024, sb = b % 1024, swz = sb ^ (((sb >> 9) & 1) << 5); R = (st >> 1) * 16 + swz / 64; C = (st & 1) * 32 + (swz % 64) / 2; }
__host__ __device__ __forceinline__ int perm32(int rho) { const int n = rho >> 4, i = rho & 15; return 8 * (i >> 2) + 4 * n + (i & 3); }

struct Unit { int pm, pn; };
struct Gemm { const bf16_t* A; const bf16_t* Bt; int M, N, K; };

struct StaticOrder {
    int nM, nN, nwg, G, c;
    __host__ __device__ void init(int M, int N, int G_, int c_) { nM = M / BM; nN = N / BM; nwg = nM * nN; G = G_; c = c_; }
    __host__ __device__ bool next(int i, Unit& u) const {
        const long L = (long)i * G + c; if (L >= nwg) return false;
        int wgid = (int)L; { const int q = nwg / NXCD, r = nwg % NXCD, xcd = wgid % NXCD, off = wgid / NXCD; wgid = (xcd < r ? xcd * (q + 1) : r * (q + 1) + (xcd - r) * q) + off; }
        const int nig = WGM * nN, gid = wgid / nig, fm = gid * WGM, gsz = (nM - fm) < WGM ? (nM - fm) : WGM;
        u.pm = fm + ((wgid % nig) % gsz); u.pn = (wgid % nig) / gsz; return true;
    }
    __device__ __forceinline__ void a_ready(const Unit&) const {}
    __device__ __forceinline__ void done(const Unit&) const {}
};

__device__ __forceinline__ unsigned cvt_pk_bf16(float lo, float hi) { unsigned r; asm volatile("v_cvt_pk_bf16_f32 %0, %1, %2" : "=v"(r) : "v"(lo), "v"(hi)); return r; }
__device__ __forceinline__ u32x4 pack8bf(const f32x4& v0, const f32x4& v1) { u32x4 w; w.x = cvt_pk_bf16(v0[0], v0[1]); w.y = cvt_pk_bf16(v0[2], v0[3]); w.z = cvt_pk_bf16(v1[0], v1[1]); w.w = cvt_pk_bf16(v1[2], v1[3]); return w; }

struct EpiStoreBf16 {
    static constexpr bool PERM = true, AFTER_DRAIN = false;
    bf16_t* O; int ldc;
    __device__ __forceinline__ void operator()(const f32x4 (&acc)[2][2][4][2], const Unit& u, int wr, int wc, int fr, int fq) const {
        const int row0 = u.pm * BM + wr * 64 + fr, col0 = u.pn * BM + wc * 32 + 8 * fq;
#pragma unroll
        for (int ai = 0; ai < 2; ++ai)
#pragma unroll
            for (int m = 0; m < 4; ++m) { bf16_t* rowp = O + (size_t)(row0 + ai * HALF + m * 16) * ldc + col0;
#pragma unroll
                for (int bj = 0; bj < 2; ++bj) *(u32x4*)(rowp + bj * HALF) = pack8bf(acc[ai][bj][m][0], acc[ai][bj][m][1]); }
    }
};
template <bool RES> struct EpiStoreF32 {
    static constexpr bool PERM = true, AFTER_DRAIN = false;
    float* O; const float* res; int ldc;
    __device__ __forceinline__ void operator()(const f32x4 (&acc)[2][2][4][2], const Unit& u, int wr, int wc, int fr, int fq) const {
        const int row0 = u.pm * BM + wr * 64 + fr, col0 = u.pn * BM + wc * 32 + 8 * fq;
#pragma unroll
        for (int ai = 0; ai < 2; ++ai)
#pragma unroll
            for (int m = 0; m < 4; ++m) { const size_t off = (size_t)(row0 + ai * HALF + m * 16) * ldc + col0;
#pragma unroll
                for (int bj = 0; bj < 2; ++bj) { f32x4 v0 = acc[ai][bj][m][0], v1 = acc[ai][bj][m][1];
                    if (RES) { v0 += *(const f32x4*)(res + off + bj * HALF); v1 += *(const f32x4*)(res + off + bj * HALF + 4); }
                    *(f32x4*)(O + off + bj * HALF) = v0; *(f32x4*)(O + off + bj * HALF + 4) = v1; } }
    }
};
#define EPI_LDSBAR() do { asm volatile("s_waitcnt lgkmcnt(0)" ::: "memory"); __builtin_amdgcn_s_barrier(); asm volatile("" ::: "memory"); } while (0)
struct EpiInProj {
    static constexpr bool PERM = true, AFTER_DRAIN = false;
    bf16_t *cq, *ckv, *fq, *fk, *fv, *gates, *kpe; float* lf; const float *b_gate, *b_forget; float* ssq; const float *gfq, *gfk; PG8_LAS float* xs;
    __device__ __forceinline__ void operator()(const f32x4 (&acc)[2][2][4][2], const Unit& u, int wr, int wc, int fr, int fq_) const {
        const int pn = u.pn, row0 = u.pm * BM + wr * 64 + fr, cw = wc * 32 + 8 * fq_;
        if (pn < 4) {
            bf16_t* base = pn < 2 ? cq : ckv; const int colt = (pn & 1) * 256;
#pragma unroll
            for (int ai = 0; ai < 2; ++ai)
#pragma unroll
                for (int m = 0; m < 4; ++m) { const int row = row0 + ai * HALF + m * 16; bf16_t* rowp = base + (size_t)row * 512 + colt + cw; float s = 0.f;
#pragma unroll
                    for (int bj = 0; bj < 2; ++bj) { const f32x4 v0 = acc[ai][bj][m][0], v1 = acc[ai][bj][m][1];
                        s += (v0[0] * v0[0] + v0[1] * v0[1]) + (v0[2] * v0[2] + v0[3] * v0[3]) + (v1[0] * v1[0] + v1[1] * v1[1]) + (v1[2] * v1[2] + v1[3] * v1[3]);
                        *(u32x4*)(rowp + bj * HALF) = pack8bf(v0, v1); }
                    s += __shfl_xor(s, 16); s += __shfl_xor(s, 32);
                    if (fq_ == 0) ssq[((size_t)pn * 8192 + row) * 4 + wc] = s; }
        } else if (pn < 20) {
            const bool isq = pn < 12; bf16_t* base = isq ? fq : fk; const int colt = (pn - (isq ? 4 : 12)) * 256; const float* g = isq ? gfq : gfk;
            const float qs = isq ? 0.12751743f : 1.f;
#pragma unroll
            for (int ai = 0; ai < 2; ++ai)
#pragma unroll
                for (int m = 0; m < 4; ++m)
#pragma unroll
                    for (int bj = 0; bj < 2; ++bj) { const f32x4 v0 = acc[ai][bj][m][0], v1 = acc[ai][bj][m][1];
                        float s = (v0[0] * v0[0] + v0[1] * v0[1]) + (v0[2] * v0[2] + v0[3] * v0[3]) + (v1[0] * v1[0] + v1[1] * v1[1]) + (v1[2] * v1[2] + v1[3] * v1[3]);
                        s += __shfl_xor(s, 16); s += __shfl_xor(s, 32);
                        if (fq_ == 0) xs[((ai * HALF + wr * 64 + m * 16 + fr) * 2 + bj) * 4 + wc] = s; }
            EPI_LDSBAR();
            const f32x4 g0 = *(const f32x4*)(g + cw) * qs, g1 = *(const f32x4*)(g + cw + 4) * qs;
#pragma unroll
            for (int ai = 0; ai < 2; ++ai)
#pragma unroll
                for (int m = 0; m < 4; ++m) { bf16_t* rowp = base + (size_t)(row0 + ai * HALF + m * 16) * 2048 + colt + cw;
#pragma unroll
                    for (int bj = 0; bj < 2; ++bj) { const f32x4 t4 = *(const PG8_LAS f32x4*)(xs + ((ai * HALF + wr * 64 + m * 16 + fr) * 2 + bj) * 4);
                        const float r = rsqrtf(((t4[0] + t4[1]) + (t4[2] + t4[3])) * (1.f / 128.f) + 1e-6f);
                        *(u32x4*)(rowp + bj * HALF) = pack8bf(acc[ai][bj][m][0] * g0 * r, acc[ai][bj][m][1] * g1 * r); } }
        } else if (pn < 28) {
            const int colt = (pn - 20) * 256;
#pragma unroll
            for (int ai = 0; ai < 2; ++ai)
#pragma unroll
                for (int m = 0; m < 4; ++m) { bf16_t* rowp = fv + (size_t)(row0 + ai * HALF + m * 16) * 2048 + colt + cw;
#pragma unroll
                    for (int bj = 0; bj < 2; ++bj) *(u32x4*)(rowp + bj * HALF) = pack8bf(acc[ai][bj][m][0], acc[ai][bj][m][1]); }
        } else if (pn < 44) {
            const int colt = (pn - 28) * 256 + cw;
#pragma unroll
            for (int bj = 0; bj < 2; ++bj) {
                const f32x4 b0 = *(const f32x4*)(b_gate + colt + bj * HALF), b1 = *(const f32x4*)(b_gate + colt + bj * HALF + 4);
#pragma unroll
                for (int ai = 0; ai < 2; ++ai)
#pragma unroll
                    for (int m = 0; m < 4; ++m) {
                        f32x4 v0 = acc[ai][bj][m][0] + b0, v1 = acc[ai][bj][m][1] + b1;
#pragma unroll
                        for (int e = 0; e < 4; ++e) { v0[e] = 1.f / (1.f + __expf(-v0[e])); v1[e] = 1.f / (1.f + __expf(-v1[e])); }
                        *(u32x4*)(gates + (size_t)(row0 + ai * HALF + m * 16) * 4096 + colt + bj * HALF) = pack8bf(v0, v1); }
            }
        } else {
            if (cw < 64) {
#pragma unroll
                for (int ai = 0; ai < 2; ++ai)
#pragma unroll
                    for (int m = 0; m < 4; ++m) *(u32x4*)(kpe + (size_t)(row0 + ai * HALF + m * 16) * 64 + cw) = pack8bf(acc[ai][0][m][0], acc[ai][0][m][1]);
            } else if (cw < 80) {
                const int h0 = cw - 64;
                const f32x4 b0 = *(const f32x4*)(b_forget + h0), b1 = *(const f32x4*)(b_forget + h0 + 4);
#pragma unroll
                for (int ai = 0; ai < 2; ++ai)
#pragma unroll
                    for (int m = 0; m < 4; ++m) { const int row = row0 + ai * HALF + m * 16;
                        f32x4 z0 = acc[ai][0][m][0] + b0, z1 = acc[ai][0][m][1] + b1;
#pragma unroll
                        for (int e = 0; e < 4; ++e) { z0[e] = fminf(z0[e], 0.f) - __logf(1.f + __expf(-fabsf(z0[e]))); z1[e] = fminf(z1[e], 0.f) - __logf(1.f + __expf(-fabsf(z1[e]))); }
                        *(f32x4*)(lf + (size_t)row * 16 + h0) = z0; *(f32x4*)(lf + (size_t)row * 16 + h0 + 4) = z1; }
            }
        }
    }
};
__device__ __forceinline__ float lat_rinv(const float* ssq, int part0, int row) {
    const f32x4 a = *(const f32x4*)(ssq + ((size_t)part0 * 8192 + row) * 4), b = *(const f32x4*)(ssq + ((size_t)(part0 + 1) * 8192 + row) * 4);
    return rsqrtf((((a[0] + a[1]) + (a[2] + a[3])) + ((b[0] + b[1]) + (b[2] + b[3]))) * (1.f / 512.f) + 1e-6f);
}
struct EpiQ {
    static constexpr bool PERM = true, AFTER_DRAIN = false;
    bf16_t* qa; const float* ssq; const float* gq; const float2* ropeT; PG8_LAS float* xs;
    __device__ __forceinline__ void operator()(const f32x4 (&acc)[2][2][4][2], const Unit& u, int wr, int wc, int fr, int fq_) const {
        const int h = u.pn, row0 = u.pm * BM + wr * 64 + fr, cw = wc * 32 + 8 * fq_;
        float rl[2][4];
#pragma unroll
        for (int ai = 0; ai < 2; ++ai)
#pragma unroll
            for (int m = 0; m < 4; ++m) { rl[ai][m] = lat_rinv(ssq, 0, row0 + ai * HALF + m * 16); float s = 0.f;
#pragma unroll
                for (int bj = 0; bj < 2; ++bj) { const f32x4 v0 = acc[ai][bj][m][0], v1 = acc[ai][bj][m][1];
                    s += (v0[0] * v0[0] + v0[1] * v0[1]) + (v0[2] * v0[2] + v0[3] * v0[3]) + (v1[0] * v1[0] + v1[1] * v1[1]) + (v1[2] * v1[2] + v1[3] * v1[3]); }
                s *= rl[ai][m] * rl[ai][m];
                s += __shfl_xor(s, 16); s += __shfl_xor(s, 32);
                if (fq_ == 0) xs[(ai * HALF + wr * 64 + m * 16 + fr) * 4 + wc] = s; }
        EPI_LDSBAR();
        const float qs = 0.10411754f;
        const f32x4 g0 = *(const f32x4*)(gq + cw) * qs, g1 = *(const f32x4*)(gq + cw + 4) * qs;
        const int pp = 16 * (wc & 1) + 4 * fq_;
        const f32x4 ga = *(const f32x4*)(gq + 128 + pp) * qs, gb = *(const f32x4*)(gq + 160 + pp) * qs;
#pragma unroll
        for (int ai = 0; ai < 2; ++ai)
#pragma unroll
            for (int m = 0; m < 4; ++m) { const int row = row0 + ai * HALF + m * 16;
                const f32x4 t4 = *(const PG8_LAS f32x4*)(xs + (ai * HALF + wr * 64 + m * 16 + fr) * 4);
                const float r = rsqrtf(((t4[0] + t4[1]) + (t4[2] + t4[3])) * (1.f / 192.f) + 1e-6f) * rl[ai][m];
                bf16_t* rowp = qa + (size_t)row * 3072 + h * 192;
                *(u32x4*)(rowp + cw) = pack8bf(acc[ai][0][m][0] * g0 * r, acc[ai][0][m][1] * g1 * r);
                if (wc < 2) { const f32x4 c01 = *(const f32x4*)(ropeT + (size_t)row * 32 + pp), c23 = *(const f32x4*)(ropeT + (size_t)row * 32 + pp + 2);
                    const f32x4 z0 = acc[ai][1][m][0] * r, z1 = acc[ai][1][m][1] * r;
                    const float a0 = z0[0] * ga[0], b0 = z0[1] * gb[0], a1 = z0[2] * ga[1], b1 = z0[3] * gb[1], a2 = z1[0] * ga[2], b2 = z1[1] * gb[2], a3 = z1[2] * ga[3], b3 = z1[3] * gb[3];
                    const f32x4 o0 = {a0 * c01[0] - b0 * c01[1], a0 * c01[1] + b0 * c01[0], a1 * c01[2] - b1 * c01[3], a1 * c01[3] + b1 * c01[2]};
                    const f32x4 o1 = {a2 * c23[0] - b2 * c23[1], a2 * c23[1] + b2 * c23[0], a3 * c23[2] - b3 * c23[3], a3 * c23[3] + b3 * c23[2]};
                    *(u32x4*)(rowp + 128 + cw) = pack8bf(o0, o1); } }
    }
};
struct EpiKV {
    static constexpr bool PERM = true, AFTER_DRAIN = false;
    bf16_t *ka, *va; const bf16_t* kpe; const float* ssq; const float* gk; const float2* ropeT; PG8_LAS float* xs;
    __device__ __forceinline__ void operator()(const f32x4 (&acc)[2][2][4][2], const Unit& u, int wr, int wc, int fr, int fq_) const {
        const int h = u.pn, row0 = u.pm * BM + wr * 64 + fr, cw = wc * 32 + 8 * fq_;
        float rl[2][4]; f32x4 kp[2][4];
#pragma unroll
        for (int ai = 0; ai < 2; ++ai)
#pragma unroll
            for (int m = 0; m < 4; ++m) { const int row = row0 + ai * HALF + m * 16; rl[ai][m] = lat_rinv(ssq, 2, row);
                const uint2 w = *(const uint2*)(kpe + (size_t)row * 64 + 16 * wc + 4 * fq_);
                kp[ai][m] = (f32x4){__uint_as_float(w.x << 16), __uint_as_float(w.x & 0xffff0000u), __uint_as_float(w.y << 16), __uint_as_float(w.y & 0xffff0000u)};
                const f32x4 v0 = acc[ai][0][m][0], v1 = acc[ai][0][m][1];
                float s = ((v0[0] * v0[0] + v0[1] * v0[1]) + (v0[2] * v0[2] + v0[3] * v0[3]) + (v1[0] * v1[0] + v1[1] * v1[1]) + (v1[2] * v1[2] + v1[3] * v1[3])) * (rl[ai][m] * rl[ai][m]);
                s += (kp[ai][m][0] * kp[ai][m][0] + kp[ai][m][1] * kp[ai][m][1]) + (kp[ai][m][2] * kp[ai][m][2] + kp[ai][m][3] * kp[ai][m][3]);
                s += __shfl_xor(s, 16); s += __shfl_xor(s, 32);
                if (fq_ == 0) xs[(ai * HALF + wr * 64 + m * 16 + fr) * 4 + wc] = s;
                *(u32x4*)(va + (size_t)row * 2048 + h * 128 + cw) = pack8bf(acc[ai][1][m][0] * rl[ai][m], acc[ai][1][m][1] * rl[ai][m]); }
        EPI_LDSBAR();
        const f32x4 g0 = *(const f32x4*)(gk + cw), g1 = *(const f32x4*)(gk + cw + 4);
        const int pp = 8 * wc + 2 * fq_;
        const float ga0 = gk[128 + pp], ga1 = gk[128 + pp + 1], gb0 = gk[160 + pp], gb1 = gk[160 + pp + 1];
#pragma unroll
        for (int ai = 0; ai < 2; ++ai)
#pragma unroll
            for (int m = 0; m < 4; ++m) { const int row = row0 + ai * HALF + m * 16;
                const f32x4 t4 = *(const PG8_LAS f32x4*)(xs + (ai * HALF + wr * 64 + m * 16 + fr) * 4);
                const float r = rsqrtf(((t4[0] + t4[1]) + (t4[2] + t4[3])) * (1.f / 192.f) + 1e-6f), rn = r * rl[ai][m];
                bf16_t* rowp = ka + (size_t)row * 3072 + h * 192;
                *(u32x4*)(rowp + cw) = pack8bf(acc[ai][0][m][0] * g0 * rn, acc[ai][0][m][1] * g1 * rn);
                const f32x4 cs = *(const f32x4*)(ropeT + (size_t)row * 32 + pp);
                const float a0 = kp[ai][m][0] * r * ga0, b0 = kp[ai][m][1] * r * gb0, a1 = kp[ai][m][2] * r * ga1, b1 = kp[ai][m][3] * r * gb1;
                uint2 o; o.x = cvt_pk_bf16(a0 * cs[0] - b0 * cs[1], a0 * cs[1] + b0 * cs[0]); o.y = cvt_pk_bf16(a1 * cs[2] - b1 * cs[3], a1 * cs[3] + b1 * cs[2]);
                *(uint2*)(rowp + 128 + 16 * wc + 4 * fq_) = o; }
    }
};

struct EpiX1 {
    static constexpr bool PERM = true, AFTER_DRAIN = false;
    float* x1; const float* x; bf16_t* xg; const float* g; float* ssq2;
    __device__ __forceinline__ void operator()(const f32x4 (&acc)[2][2][4][2], const Unit& u, int wr, int wc, int fr, int fq_) const {
        const int row0 = u.pm * BM + wr * 64 + fr, col0 = u.pn * BM + wc * 32 + 8 * fq_;
        f32x4 gg[2][2];
#pragma unroll
        for (int bj = 0; bj < 2; ++bj) { gg[bj][0] = *(const f32x4*)(g + col0 + bj * HALF); gg[bj][1] = *(const f32x4*)(g + col0 + bj * HALF + 4); }
#pragma unroll
        for (int ai = 0; ai < 2; ++ai)
#pragma unroll
            for (int m = 0; m < 4; ++m) { const int row = row0 + ai * HALF + m * 16; const size_t off = (size_t)row * 2048 + col0; float s = 0.f;
#pragma unroll
                for (int bj = 0; bj < 2; ++bj) { const f32x4 v0 = acc[ai][bj][m][0] + *(const f32x4*)(x + off + bj * HALF), v1 = acc[ai][bj][m][1] + *(const f32x4*)(x + off + bj * HALF + 4);
                    *(f32x4*)(x1 + off + bj * HALF) = v0; *(f32x4*)(x1 + off + bj * HALF + 4) = v1;
                    s += (v0[0] * v0[0] + v0[1] * v0[1]) + (v0[2] * v0[2] + v0[3] * v0[3]) + (v1[0] * v1[0] + v1[1] * v1[1]) + (v1[2] * v1[2] + v1[3] * v1[3]);
                    *(u32x4*)(xg + off + bj * HALF) = pack8bf(v0 * gg[bj][0], v1 * gg[bj][1]); }
                s += __shfl_xor(s, 16); s += __shfl_xor(s, 32);
                if (fq_ == 0) ssq2[((size_t)u.pn * 8192 + row) * 4 + wc] = s; }
    }
};
__device__ __forceinline__ float ffn_rinv(const float* ssq2, int row) {
    float t = 0.f;
#pragma unroll
    for (int pn = 0; pn < 8; ++pn) { const f32x4 a = *(const f32x4*)(ssq2 + ((size_t)pn * 8192 + row) * 4); t += (a[0] + a[1]) + (a[2] + a[3]); }
    return rsqrtf(t * (1.f / 2048.f) + 1e-6f);
}
struct EpiScores {
    static constexpr bool PERM = true, AFTER_DRAIN = false;
    float* O; const float* ssq2;
    __device__ __forceinline__ void operator()(const f32x4 (&acc)[2][2][4][2], const Unit& u, int wr, int wc, int fr, int fq_) const {
        const int row0 = u.pm * BM + wr * 64 + fr, col0 = u.pn * BM + wc * 32 + 8 * fq_;
#pragma unroll
        for (int ai = 0; ai < 2; ++ai)
#pragma unroll
            for (int m = 0; m < 4; ++m) { const int row = row0 + ai * HALF + m * 16; const float r = ffn_rinv(ssq2, row); const size_t off = (size_t)row * 2048 + col0;
#pragma unroll
                for (int bj = 0; bj < 2; ++bj) { *(f32x4*)(O + off + bj * HALF) = acc[ai][bj][m][0] * r; *(f32x4*)(O + off + bj * HALF + 4) = acc[ai][bj][m][1] * r; } }
    }
};
template <class Epi, class Sched, bool ALIGN_EPI = false, bool SP2 = false>
__device__ __forceinline__ void gemm_phase(PG8_LAS unsigned char* lds, const Gemm g, const Sched& S, const Epi& E) {
    int tid = threadIdx.x; asm volatile("" : "+v"(tid));
    const int wid = __builtin_amdgcn_readfirstlane(tid >> 6), lane = tid & 63, wr = wid >> 2, wc = wid & 3, fr = lane & 15, fq = lane >> 4;
    const int K = g.K, nt = K / BK;
    unsigned voffA[2], voffB[2];
#pragma unroll
    for (int i = 0; i < 2; ++i) { int R, C; stage_rc(tid * 16 + i * 8192, R, C); const int Rb = Epi::PERM ? ((R & ~31) + perm32(R & 31)) : R;
        voffA[i] = (unsigned)(R * K + C) * 2u; voffB[i] = (unsigned)(Rb * K + C) * 2u; }
    const size_t kstep = (size_t)(BK * 2);
    const size_t hstep = (size_t)HALF * K * 2;
    const size_t tstep = 2 * hstep;
    const unsigned ldsw = (unsigned)wid * 1024u;
    const int aoff = lds_byte(wr * 64 + fr, fq * 8), boff = lds_byte(wc * 32 + fr, fq * 8);
#define PG8_SA(b, h) (((b) * 2 + (h)) * HTB)
#define PG8_SB(b, h) ((4 + (b) * 2 + (h)) * HTB)
#define PG8_STAGE(bufoff, gbase, voff) do { _Pragma("unroll") for (int _i = 0; _i < 2; ++_i) \
        __builtin_amdgcn_global_load_lds((const unsigned*)((const char*)(gbase) + (voff)[_i]), (PG8_LAS unsigned*)(lds + (bufoff) + ldsw + _i * 8192), 16, 0, 0); } while (0)
#define PG8_LDA(dst, b, h) do { _Pragma("unroll") for (int m = 0; m < 4; ++m) _Pragma("unroll") for (int k = 0; k < 2; ++k) dst[m][k] = *(const PG8_LAS bf16x8*)(lds + PG8_SA(b, h) + aoff + m * 2048 + k * 1024); } while (0)
#define PG8_LDB(dst, b, h) do { _Pragma("unroll") for (int n = 0; n < 2; ++n) _Pragma("unroll") for (int k = 0; k < 2; ++k) dst[n][k] = *(const PG8_LAS bf16x8*)(lds + PG8_SB(b, h) + boff + n * 2048 + k * 1024); } while (0)
#define PG8_MMA(ai, bj, At, Bt) do { __builtin_amdgcn_s_setprio(1); _Pragma("unroll") for (int m = 0; m < 4; ++m) _Pragma("unroll") for (int n = 0; n < 2; ++n) _Pragma("unroll") for (int k = 0; k < 2; ++k) \
        acc[ai][bj][m][n] = __builtin_amdgcn_mfma_f32_16x16x32_bf16(Bt[n][k], At[m][k], acc[ai][bj][m][n], 0, 0, 0); __builtin_amdgcn_s_setprio(0); } while (0)
#define PG8_WAIT_V(n) asm volatile("s_waitcnt vmcnt(" #n ")" ::: "memory")
#define PG8_WAIT_L(n) asm volatile("s_waitcnt lgkmcnt(" #n ")" ::: "memory")
#define PG8_BAR __builtin_amdgcn_s_barrier()
#define PG8_SCHED __builtin_amdgcn_sched_barrier(0)
    Unit cur, nxt; int ui = 0;
    if (!S.next(0, cur)) return;
    f32x4 acc[2][2][4][2];
#pragma unroll
    for (int a = 0; a < 2; ++a)
#pragma unroll
        for (int b = 0; b < 2; ++b)
#pragma unroll
            for (int m = 0; m < 4; ++m)
#pragma unroll
                for (int n = 0; n < 2; ++n) acc[a][b][m][n] = (f32x4){0.f, 0.f, 0.f, 0.f};
    bf16x8 At[4][2], B0[2][2], B1[2][2];
    const char* cA = (const char*)g.A + (size_t)cur.pm * tstep; const char* cB = (const char*)g.Bt + (size_t)cur.pn * tstep;
    S.a_ready(cur);
    if constexpr (SP2) {
        PG8_STAGE(PG8_SB(0, 0), cB, voffB); PG8_STAGE(PG8_SB(0, 1), cB + hstep, voffB); PG8_STAGE(PG8_SA(0, 0), cA, voffA); PG8_STAGE(PG8_SA(0, 1), cA + hstep, voffA);
        if (wr == 1) PG8_BAR;
        PG8_WAIT_V(2); PG8_BAR;
        PG8_STAGE(PG8_SB(1, 0), cB + kstep, voffB); PG8_STAGE(PG8_SA(1, 0), cA + kstep, voffA); PG8_STAGE(PG8_SB(1, 1), cB + hstep + kstep, voffB);
        PG8_WAIT_V(6); PG8_BAR;
    } else {
        PG8_STAGE(PG8_SB(0, 0), cB, voffB); PG8_STAGE(PG8_SA(0, 0), cA, voffA); PG8_STAGE(PG8_SB(0, 1), cB + hstep, voffB); PG8_STAGE(PG8_SA(0, 1), cA + hstep, voffA);
        if (wr == 1) PG8_BAR;
        PG8_WAIT_V(4); PG8_BAR;
        PG8_STAGE(PG8_SB(1, 0), cB + kstep, voffB); PG8_STAGE(PG8_SA(1, 0), cA + kstep, voffA); PG8_STAGE(PG8_SB(1, 1), cB + hstep + kstep, voffB);
        PG8_WAIT_V(6); PG8_BAR;
    }
    for (;;) {
        const bool has_next = S.next(ui + 1, nxt);
        const char* nA = has_next ? (const char*)g.A + (size_t)nxt.pm * tstep : cA; const char* nB = has_next ? (const char*)g.Bt + (size_t)nxt.pn * tstep : cB;
        for (int t = 0; t < nt; t += 2) {
            const bool last = (t == nt - 2);
            const char* a1 = cA + (size_t)(t + 1) * kstep;
            const char* a2 = last ? nA : cA + (size_t)(t + 2) * kstep; const char* b2 = last ? nB : cB + (size_t)(t + 2) * kstep;
            const char* a3 = a2 + kstep; const char* b3 = b2 + kstep;
            if (last && has_next) S.a_ready(nxt);
            if constexpr (SP2) {
            PG8_LDB(B0, 0, 0); PG8_LDB(B1, 0, 1); PG8_SCHED; PG8_LDA(At, 0, 0); PG8_STAGE(PG8_SA(1, 1), a1 + hstep, voffA);
            PG8_WAIT_V(8); PG8_WAIT_L(0); PG8_BAR; PG8_MMA(0, 0, At, B0); PG8_MMA(0, 1, At, B1); PG8_BAR; PG8_SCHED;
            PG8_LDA(At, 0, 1); PG8_STAGE(PG8_SB(0, 0), b2, voffB); PG8_STAGE(PG8_SB(0, 1), b2 + hstep, voffB); PG8_STAGE(PG8_SA(0, 0), a2, voffA);
            PG8_WAIT_V(8); PG8_WAIT_L(0); PG8_BAR; PG8_MMA(1, 0, At, B0); PG8_MMA(1, 1, At, B1); PG8_BAR; PG8_SCHED;
            PG8_LDB(B0, 1, 0); PG8_LDB(B1, 1, 1); PG8_SCHED; PG8_LDA(At, 1, 0); PG8_STAGE(PG8_SA(0, 1), a2 + hstep, voffA);
            PG8_WAIT_V(8); PG8_WAIT_L(0); PG8_BAR; PG8_MMA(0, 0, At, B0); PG8_MMA(0, 1, At, B1); PG8_BAR; PG8_SCHED;
            PG8_LDA(At, 1, 1); PG8_STAGE(PG8_SB(1, 0), b3, voffB); PG8_STAGE(PG8_SB(1, 1), b3 + hstep, voffB); PG8_STAGE(PG8_SA(1, 0), a3, voffA);
            PG8_WAIT_V(8); PG8_WAIT_L(0); PG8_BAR; PG8_MMA(1, 0, At, B0); PG8_MMA(1, 1, At, B1); PG8_BAR; PG8_SCHED;
            } else {
            PG8_LDB(B0, 0, 0); PG8_SCHED; PG8_LDA(At, 0, 0); PG8_STAGE(PG8_SA(1, 1), a1 + hstep, voffA);
            PG8_WAIT_L(8); PG8_BAR; PG8_WAIT_L(0); PG8_MMA(0, 0, At, B0); PG8_BAR; PG8_SCHED;
            PG8_LDB(B1, 0, 1); PG8_STAGE(PG8_SB(0, 0), b2, voffB);
            PG8_BAR; PG8_WAIT_L(0); PG8_MMA(0, 1, At, B1); PG8_BAR;
            PG8_LDA(At, 0, 1); PG8_STAGE(PG8_SA(0, 0), a2, voffA);
            PG8_BAR; PG8_WAIT_L(0); PG8_MMA(1, 0, At, B0); PG8_BAR; PG8_SCHED;
            PG8_STAGE(PG8_SB(0, 1), b2 + hstep, voffB);
            PG8_WAIT_V(6); PG8_BAR; PG8_MMA(1, 1, At, B1); PG8_BAR;
            PG8_LDB(B0, 1, 0); PG8_SCHED; PG8_LDA(At, 1, 0); PG8_STAGE(PG8_SA(0, 1), a2 + hstep, voffA);
            PG8_WAIT_L(8); PG8_BAR; PG8_WAIT_L(0); PG8_MMA(0, 0, At, B0); PG8_BAR; PG8_SCHED;
            PG8_LDB(B1, 1, 1); PG8_STAGE(PG8_SB(1, 0), b3, voffB);
            PG8_BAR; PG8_WAIT_L(0); PG8_MMA(0, 1, At, B1); PG8_BAR;
            PG8_LDA(At, 1, 1); PG8_STAGE(PG8_SA(1, 0), a3, voffA);
            PG8_BAR; PG8_WAIT_L(0); PG8_MMA(1, 0, At, B0); PG8_BAR; PG8_SCHED;
            PG8_STAGE(PG8_SB(1, 1), b3 + hstep, voffB);
            PG8_WAIT_V(6); PG8_BAR; PG8_MMA(1, 1, At, B1); PG8_BAR;
            }
        }
        if constexpr (ALIGN_EPI) { if (wr == 0) PG8_BAR; }
        if constexpr (!Epi::AFTER_DRAIN) { E(acc, cur, wr, wc, fr, fq); S.done(cur); }
        if (!has_next) break;
#pragma unroll
        for (int a = 0; a < 2; ++a)
#pragma unroll
            for (int b = 0; b < 2; ++b)
#pragma unroll
                for (int m = 0; m < 4; ++m)
#pragma unroll
                    for (int n = 0; n < 2; ++n) acc[a][b][m][n] = (f32x4){0.f, 0.f, 0.f, 0.f};
        cur = nxt; cA = nA; cB = nB; ++ui;
        if constexpr (ALIGN_EPI) { if (wr == 1) PG8_BAR; }
    }
    PG8_WAIT_V(0);
    if constexpr (!ALIGN_EPI) { if (wr == 0) PG8_BAR; }
    PG8_BAR;
    if constexpr (Epi::AFTER_DRAIN) { E.fused(acc, cur, wr, wc, fr, fq, lds, wid, lane); S.done(cur); }
#undef PG8_SA
#undef PG8_SB
#undef PG8_STAGE
#undef PG8_LDA
#undef PG8_LDB
#undef PG8_MMA
#undef PG8_WAIT_V
#undef PG8_WAIT_L
#undef PG8_BAR
#undef PG8_SCHED
}
}
namespace att {
typedef unsigned short bf16_t;
typedef short bf16x8 __attribute__((ext_vector_type(8)));
typedef short s16x4 __attribute__((ext_vector_type(4)));
typedef float f32x16 __attribute__((ext_vector_type(16)));
typedef float f32x4 __attribute__((ext_vector_type(4)));
typedef unsigned u32x4 __attribute__((ext_vector_type(4)));
#define ALAS __attribute__((address_space(3)))
#define ASBAR() __builtin_amdgcn_sched_barrier(0)
constexpr int SHM_V = 16384;
template <int DK> struct Lay { static constexpr int ROWB = DK * 2, SHM_K = 64 * ROWB, OFF_K = 2 * SHM_V, OFF_F = OFF_K + 2 * SHM_K, OFF_WS = OFF_F + 512, TOTAL = OFF_WS + 8 * 256; };

__device__ __forceinline__ int v_st(int k, int c) { const int kk = (k & ~0xC) | ((k & 4) << 1) | ((k & 8) >> 1); return ((kk >> 3) * 4 + (c >> 5)) * 512 + ((kk & 7) * 32 + (c & 31)) * 2; }
__device__ __forceinline__ int v_rd_base(int lane) { return ((lane & 3) << 3) | (((lane >> 2) & 3) << 6) | (((lane >> 4) & 1) << 5) | (((lane >> 5) & 1) << 8); }
__device__ __forceinline__ int crow(int r, int hi) { return (r & 3) + 8 * (r >> 2) + 4 * hi; }
__device__ __forceinline__ unsigned cvtpk(float lo, float hi) { unsigned r; asm volatile("v_cvt_pk_bf16_f32 %0, %1, %2" : "=v"(r) : "v"(lo), "v"(hi)); return r; }

__device__ __forceinline__ float wave_max_f(float v) {
#pragma unroll
    for (int o = 32; o >= 1; o >>= 1) v = fmaxf(v, __shfl_xor(v, o));
    return v;
}
__device__ __forceinline__ float att_max3(float a, float b, float c) { float r; asm("v_max3_f32 %0, %1, %2, %3" : "=v"(r) : "v"(a), "v"(b), "v"(c)); return r; }
template <int DK, bool FOX>
__device__ __forceinline__ void attn_block(unsigned char* smem, const bf16_t* __restrict__ Q, int ldq, const bf16_t* __restrict__ K, int ldk, const bf16_t* __restrict__ V, int ldv,
                                           const float* __restrict__ Fh, const bf16_t* __restrict__ gate, bf16_t* __restrict__ gout  , int qbk, const float* __restrict__ gq, const float* __restrict__ gk  ,
                                           const float* __restrict__ side_u, const float* __restrict__ side_v, unsigned char* __restrict__ side_u8, unsigned char* __restrict__ side_v8, int& side_next) {
    typedef Lay<DK> LY;
    constexpr int ND = DK / 16, NKC = DK / 8, NKI = (64 * NKC) / 512;
    int tid = threadIdx.x; asm volatile("" : "+v"(tid));
    const int wid = __builtin_amdgcn_readfirstlane(tid >> 6), lane = tid & 63, r32 = lane & 31, hi = lane >> 5;
    const int q0 = qbk * 256, qlo = q0 + wid * 32, qm = qlo + r32 - 4 * hi;
    const int NT = 4 * qbk + 4;
    ALAS unsigned char* lds = (ALAS unsigned char*)smem;
    ALAS float* F_lds = (ALAS float*)(lds + LY::OFF_F);
    ALAS float* wsl = (ALAS float*)(lds + LY::OFF_WS) + wid * 64;
    bf16x8 qr[ND];
#pragma unroll
    for (int d0 = 0; d0 < ND; ++d0) qr[d0] = *(const bf16x8*)(Q + (size_t)(qlo + r32) * ldq + d0 * 16 + hi * 8);
    const float fq = FOX ? Fh[qlo + r32] : 0.f;
    int kgo[NKI], vgo[2];
#pragma unroll
    for (int i = 0; i < NKI; ++i) { const int pp = (wid * NKI + i) * 64 + lane, row = pp / NKC, cpos = pp % NKC, ch = cpos ^ ((row >> 1) & 7); kgo[i] = row * ldk + ch * 8; }
#pragma unroll
    for (int i = 0; i < 2; ++i) { const int o = ((wid * 2 + i) * 64 + lane) * 16, st = o >> 9, e = (o & 511) >> 1, kk = (st >> 2) * 8 + (e >> 5), c = (st & 3) * 32 + (e & 31);
        const int k = (kk & ~0xC) | ((kk & 4) << 1) | ((kk & 8) >> 1); vgo[i] = k * ldv + c; }
    const int vb0 = (int)(uintptr_t)smem + v_rd_base(lane);
    int kbase[4];
#pragma unroll
    for (int dd = 0; dd < 4; ++dd) kbase[dd] = LY::OFF_K + r32 * LY::ROWB + (((((dd << 1) | hi) ^ ((r32 >> 1) & 7))) << 4);
    float stf = 0.f;
#define ATT_GLDS(kb, bf) do { _Pragma("unroll") for (int i = 0; i < NKI; ++i) \
            __builtin_amdgcn_global_load_lds((const unsigned*)(K + (size_t)(kb) * ldk + kgo[i]), (ALAS unsigned*)(lds + LY::OFF_K + (bf) * LY::SHM_K + (wid * NKI + i) * 1024), 16, 0, 0); \
        _Pragma("unroll") for (int i = 0; i < 2; ++i) \
            __builtin_amdgcn_global_load_lds((const unsigned*)(V + (size_t)(kb) * ldv + vgo[i]), (ALAS unsigned*)(lds + (bf) * SHM_V + (wid * 2 + i) * 1024), 16, 0, 0); \
        if (FOX && tid < 64) stf = Fh[(kb) + tid]; } while (0)
#define ATT_WRITEF(bf) do { if (FOX && tid < 64) F_lds[(bf) * 64 + tid] = stf; } while (0)
    int t_start = 0; float m_init = 0.f;
    if (FOX) {
        const float gqm = wave_max_f(fmaxf(fabsf(gq[lane]), fabsf(gq[lane + 64]))), gkm = wave_max_f(fmaxf(fabsf(gk[lane]), fabsf(gk[lane + 64])));
        const float qk_bound = 0.12751743f * 128.f * gqm * gkm;
        const float thr = 2.02f * qk_bound + 40.f, f0 = Fh[q0]; m_init = -thr;
        const int j0 = lane, j1 = lane + 64;
        const bool c0 = (j0 < 4 * qbk) && (Fh[j0 * 64 + 63] - f0 >= thr), c1 = (j1 < 4 * qbk) && (Fh[(j1 < 4 * qbk ? j1 : 0) * 64 + 63] - f0 >= thr);
        t_start = __builtin_popcountll(__ballot(c0)) + __builtin_popcountll(__ballot(c1));
        t_start = __builtin_amdgcn_readfirstlane(t_start); }
    ATT_GLDS(t_start * 64, t_start & 1); ATT_WRITEF(t_start & 1);
    float m_reg = FOX ? m_init : 0.f, l_reg = 0.f; f32x16 o[4];
#pragma unroll
    for (int d = 0; d < 4; ++d)
#pragma unroll
        for (int r = 0; r < 16; ++r) o[d][r] = 0.f;
    for (int t = t_start; t < NT; ++t) {
        const int buf = t & 1, kb = t * 64;
        asm volatile("s_waitcnt vmcnt(0)" ::: "memory");
        __syncthreads();
        if (t + 1 < NT) ATT_GLDS(kb + 64, buf ^ 1);
        const bool side = side_next < 64; f32x4 sd0, sd1; size_t sd_off = 0;
        if (side) { const bool isv = side_next >= 32; sd_off = ((size_t)(blockIdx.x * 32 + (side_next & 31)) * 512 + tid) * 8;
            const float* sp = (isv ? side_v : side_u) + sd_off; sd0 = *(const f32x4*)sp; sd1 = *(const f32x4*)(sp + 4); }
        f32x16 p0, p1;
        if (FOX) { const float fqm = fq - m_reg;
#pragma unroll
            for (int g = 0; g < 4; ++g) { const f32x4 f0 = *(const ALAS f32x4*)(F_lds + buf * 64 + 8 * g + 4 * hi), f1 = *(const ALAS f32x4*)(F_lds + buf * 64 + 32 + 8 * g + 4 * hi);
#pragma unroll
                for (int e = 0; e < 4; ++e) { p0[4 * g + e] = fqm - f0[e]; p1[4 * g + e] = fqm - f1[e]; } }
        } else { const float nm = -m_reg;
#pragma unroll
            for (int r = 0; r < 16; ++r) { p0[r] = nm; p1[r] = nm; }
        }
        __builtin_amdgcn_s_setprio(1);
#pragma unroll
        for (int d0 = 0; d0 < ND; ++d0) {
            ALAS const unsigned char* a = lds + buf * LY::SHM_K + kbase[d0 & 3] + (d0 >> 2) * 128;
            const bf16x8 b0 = *(const ALAS bf16x8*)a;
            const bf16x8 b1 = *(const ALAS bf16x8*)(a + 32 * LY::ROWB);
            p0 = __builtin_amdgcn_mfma_f32_32x32x16_bf16(b0, qr[d0], p0, 0, 0, 0);
            p1 = __builtin_amdgcn_mfma_f32_32x32x16_bf16(b1, qr[d0], p1, 0, 0, 0);
        }
        __builtin_amdgcn_s_setprio(0);
        if (kb + 63 > qlo) {
            const float NEG = -__builtin_inff(); const int dq = qm - kb;
#pragma unroll
            for (int r = 0; r < 16; ++r) { const int c = (r & 3) + 8 * (r >> 2); if (dq - c < 0) p0[r] = NEG; if (dq - c - 32 < 0) p1[r] = NEG; }
        }
        float pmax;
        { float a = att_max3(p0[0], p0[1], p1[0]), b = att_max3(p0[2], p0[3], p1[1]); a = att_max3(a, p1[2], p1[3]);
#pragma unroll
          for (int r = 4; r < 16; r += 4) { a = att_max3(a, p0[r], p0[r + 1]); b = att_max3(b, p0[r + 2], p0[r + 3]); a = att_max3(a, p1[r], p1[r + 1]); b = att_max3(b, p1[r + 2], p1[r + 3]); }
          pmax = fmaxf(a, b); }
        { auto rr = __builtin_amdgcn_permlane32_swap(__float_as_uint(pmax), __float_as_uint(pmax), false, false);
          pmax = fmaxf(__uint_as_float(rr[0]), __uint_as_float(rr[1])); }
        float alpha = 1.f;
        if (!__builtin_expect(__all(pmax <= 8.f), 1)) { const float dm = fmaxf(pmax, 0.f); alpha = __builtin_amdgcn_exp2f(-dm); m_reg += dm;
#pragma unroll
            for (int r = 0; r < 16; ++r) { p0[r] -= dm; p1[r] -= dm; } }
        float ps = 0.f;
#pragma unroll
        for (int r = 0; r < 16; ++r) { p0[r] = __builtin_amdgcn_exp2f(p0[r]); ps += p0[r]; }
#pragma unroll
        for (int r = 0; r < 16; ++r) { p1[r] = __builtin_amdgcn_exp2f(p1[r]); ps += p1[r]; }
        { auto rr = __builtin_amdgcn_permlane32_swap(__float_as_uint(ps), __float_as_uint(ps), false, false);
          ps = __uint_as_float(rr[0]) + __uint_as_float(rr[1]); }
        l_reg = l_reg * alpha + ps;
        bf16x8 pa0, pa1, pa2, pa3;
#define ATT_PK4(P, B_, OUT) do { unsigned a0 = cvtpk(P[B_+0], P[B_+1]), a1 = cvtpk(P[B_+2], P[B_+3]); unsigned b0_ = cvtpk(P[B_+4], P[B_+5]), b1_ = cvtpk(P[B_+6], P[B_+7]); \
        auto r0 = __builtin_amdgcn_permlane32_swap(a0, b0_, false, false); auto r1 = __builtin_amdgcn_permlane32_swap(a1, b1_, false, false); \
        u32x4 w = {r0[0], r1[0], r0[1], r1[1]}; OUT = *reinterpret_cast<bf16x8*>(&w); } while (0)
        ATT_PK4(p0, 0, pa0); ATT_PK4(p0, 8, pa1); ATT_PK4(p1, 0, pa2); ATT_PK4(p1, 8, pa3);
        if (__any(alpha < 1.f)) {
            if (hi == 0) wsl[r32] = alpha;
            asm volatile("s_waitcnt lgkmcnt(0)" ::: "memory");
#pragma unroll
            for (int g = 0; g < 4; ++g) { const f32x4 al = *(const ALAS f32x4*)(wsl + 8 * g + 4 * hi);
#pragma unroll
                for (int d = 0; d < 4; ++d)
#pragma unroll
                    for (int e = 0; e < 4; ++e) o[d][4 * g + e] *= al[e]; }
        }
#define ATT_TRRD(dst, off) asm volatile("ds_read_b64_tr_b16 %0, %1 offset:%2" : "=&v"(dst) : "v"(vbb), "i"(off) : "memory")
#define ATT_PV(d0) do { s16x4 l0, l1, l2, l3, h0, h1, h2, h3; constexpr int b_ = (d0) * 512; \
        ATT_TRRD(l0, b_); ATT_TRRD(h0, b_ + 2048); ATT_TRRD(l1, b_ + 4096); ATT_TRRD(h1, b_ + 6144); ATT_TRRD(l2, b_ + 8192); ATT_TRRD(h2, b_ + 10240); ATT_TRRD(l3, b_ + 12288); ATT_TRRD(h3, b_ + 14336); \
        asm volatile("s_waitcnt lgkmcnt(0)" ::: "memory"); ASBAR(); \
        o[d0] = __builtin_amdgcn_mfma_f32_32x32x16_bf16(pa0, (bf16x8){l0[0], l0[1], l0[2], l0[3], h0[0], h0[1], h0[2], h0[3]}, o[d0], 0, 0, 0); \
        o[d0] = __builtin_amdgcn_mfma_f32_32x32x16_bf16(pa1, (bf16x8){l1[0], l1[1], l1[2], l1[3], h1[0], h1[1], h1[2], h1[3]}, o[d0], 0, 0, 0); \
        o[d0] = __builtin_amdgcn_mfma_f32_32x32x16_bf16(pa2, (bf16x8){l2[0], l2[1], l2[2], l2[3], h2[0], h2[1], h2[2], h2[3]}, o[d0], 0, 0, 0); \
        o[d0] = __builtin_amdgcn_mfma_f32_32x32x16_bf16(pa3, (bf16x8){l3[0], l3[1], l3[2], l3[3], h3[0], h3[1], h3[2], h3[3]}, o[d0], 0, 0, 0); } while (0)
        { const int vbb = vb0 + buf * SHM_V; __builtin_amdgcn_s_setprio(1); ATT_PV(0); ATT_PV(1); ATT_PV(2); ATT_PV(3); __builtin_amdgcn_s_setprio(0); }
        if (t + 1 < NT) ATT_WRITEF(buf ^ 1);
        if (side) { const bool isv = side_next >= 32; const float sc = isv ? 4.f : 64.f;
            auto pk = [](float a, float b, float c, float d) { int w = __builtin_amdgcn_cvt_pk_fp8_f32(fminf(fmaxf(a, -448.f), 448.f), fminf(fmaxf(b, -448.f), 448.f), 0, false);
                return (unsigned)__builtin_amdgcn_cvt_pk_fp8_f32(fminf(fmaxf(c, -448.f), 448.f), fminf(fmaxf(d, -448.f), 448.f), w, true); };
            uint2 o; o.x = pk(sd0[0] * sc, sd0[1] * sc, sd0[2] * sc, sd0[3] * sc); o.y = pk(sd1[0] * sc, sd1[1] * sc, sd1[2] * sc, sd1[3] * sc);
            *(uint2*)((isv ? side_v8 : side_u8) + sd_off) = o; ++side_next; }
    }
    if (hi == 0) wsl[r32] = l_reg;
    asm volatile("s_waitcnt lgkmcnt(0)" ::: "memory");
#pragma unroll
    for (int r = 0; r < 16; ++r) {
        const int orow = crow(r, hi); const float rli = __builtin_amdgcn_rcpf(wsl[orow]);
        bf16_t* rowp = gout + (size_t)(qlo + orow) * 4096; const bf16_t* growp = gate + (size_t)(qlo + orow) * 4096;
#pragma unroll
        for (int d0 = 0; d0 < 4; ++d0) {
            const float v = o[d0][r] * rli; const float vn = __shfl_xor(v, 1);
            if ((r32 & 1) == 0) { unsigned* gp = (unsigned*)(rowp + d0 * 32 + r32); const unsigned g = *(const unsigned*)(growp + d0 * 32 + r32);
                *gp = cvtpk(v * __uint_as_float(g << 16), vn * __uint_as_float(g & 0xffff0000u)); }
        }
    }
    __syncthreads();
#undef ATT_GLDS
#undef ATT_WRITEF
#undef ATT_PK4
#undef ATT_TRRD
#undef ATT_PV
}
}
using pg8::bf16_t; using pg8::f32x4; using pg8::u32x4;
#define LAS __attribute__((address_space(3)))
constexpr int S = 8192, DM = 2048, INW = 11344, INWP = 11520;
constexpr float EPS = 1e-6f;
constexpr size_t MiB = 1u << 20;

__device__ __forceinline__ float bf2f(bf16_t v) { return __uint_as_float(((unsigned)v) << 16); }
__device__ __forceinline__ bf16_t f2bf(float f) { unsigned u = __float_as_uint(f); u += 0x7fffu + ((u >> 16) & 1u); return (bf16_t)(u >> 16); }
__device__ __forceinline__ unsigned pk2(float lo, float hi) { return (unsigned)f2bf(lo) | ((unsigned)f2bf(hi) << 16); }
__device__ __forceinline__ float wave_sum(float v) {
#pragma unroll
    for (int o = 32; o >= 1; o >>= 1) v += __shfl_xor(v, o);
    return v;
}
__device__ __forceinline__ float wave_max(float v) {
#pragma unroll
    for (int o = 32; o >= 1; o >>= 1) v = fmaxf(v, __shfl_xor(v, o));
    return v;
}

__device__ __forceinline__ int opaque_tid() { int t = threadIdx.x; asm volatile("" : "+v"(t)); return t; }

struct Params {
    const float* x; const int* pos; const float *mix_g, *w_in, *b_forget, *b_gate, *q_lat_g, *w_q_up, *kv_lat_g, *w_kv_up, *mla_qg, *mla_kg, *fox_qg, *fox_kg, *w_out, *ffn_g, *w_peer_q, *sub_keys, *peer_u, *peer_v;
    float* out;
    bf16_t *WqT, *WkvT, *WoT, *WpT, *WinT;
    bf16_t *h, *cq, *ckv, *fq, *fk, *fv, *merged, *kpe, *qa, *va, *ka;
    float *lf, *F, *x1, *scores;
    unsigned char *U8, *V8; bf16_t* attout;
    unsigned* ctl;
    float2* ropeT; float* ssq; float* ssq2; bf16_t* xg;
};

struct DstId { __device__ __forceinline__ int operator()(int n) const { return n; } };
struct DstWin { __device__ __forceinline__ int operator()(int n) const {
    if (n < 1024) return n; if (n < 1088) { const int r = n - 1024; return 11264 + 2 * (r & 31) + (r >> 5); } if (n < 7232) return n - 64; if (n < 7248) return 11264 + 64 + (n - 7232); return n - 80; } };
struct DstQ { __device__ __forceinline__ int operator()(int n) const {
    const int h = n / 192, d = n - h * 192; if (d < 128) return h * 256 + d; const int r = d - 128; return h * 256 + 128 + 2 * (r & 31) + (r >> 5); } };
template <class Dst>
__device__ __forceinline__ void transpose_item(const float* __restrict__ W, int K, int N, bf16_t* __restrict__ WT, Dst dst, float* scr, int item, int lane, const float* __restrict__ gk = nullptr) {
    const int nblk = (N + 31) / 32, kb = item / nblk, nb = item % nblk, k0 = 64 * kb, n0 = 32 * nb;
    { const int rr = lane >> 3, c4 = (lane & 7) * 4; const bool ok = (n0 + c4) < N;
      f32x4 v[8];
#pragma unroll
      for (int i = 0; i < 8; ++i) v[i] = ok ? *(const f32x4*)(W + (size_t)(k0 + 8 * i + rr) * N + n0 + c4) : (f32x4){0.f, 0.f, 0.f, 0.f};
      if (gk) {
#pragma unroll
          for (int i = 0; i < 8; ++i) v[i] *= gk[k0 + 8 * i + rr]; }
#pragma unroll
      for (int i = 0; i < 8; ++i) { float* sp = scr + (8 * i + rr) * 33 + c4; sp[0] = v[i][0]; sp[1] = v[i][1]; sp[2] = v[i][2]; sp[3] = v[i][3]; } }
    asm volatile("s_waitcnt lgkmcnt(0)" ::: "memory");
    const int c = lane & 7;
#pragma unroll
    for (int j = 0; j < 4; ++j) { const int nl = (lane >> 3) + 8 * j, n = n0 + nl; const float* s = scr + (8 * c) * 33 + nl;
        u32x4 o; o.x = pk2(s[0 * 33], s[1 * 33]); o.y = pk2(s[2 * 33], s[3 * 33]); o.z = pk2(s[4 * 33], s[5 * 33]); o.w = pk2(s[6 * 33], s[7 * 33]);
        if (n < N) *(u32x4*)(WT + (size_t)dst(n) * K + k0 + 8 * c) = o; }
    asm volatile("s_waitcnt lgkmcnt(0)" ::: "memory");
}
__device__ __forceinline__ void wfold_item(const float* __restrict__ wq, const float* __restrict__ keys, bf16_t* __restrict__ WpT, float* sm, int item) {
    const int tid = opaque_tid(), hc = item >> 5, d0 = (item & 31) * 64;
    float* keysL = sm; float* wqL = sm + 128 * 132;
    for (int idx = tid; idx < 128 * 32; idx += 512) { const int r = idx >> 5, c4 = (idx & 31) * 4; *(f32x4*)(keysL + r * 132 + c4) = *(const f32x4*)(keys + (size_t)hc * 16384 + r * 128 + c4); }
    for (int idx = tid; idx < 64 * 32; idx += 512) { const int r = idx >> 5, c4 = (idx & 31) * 4; *(f32x4*)(wqL + r * 132 + c4) = *(const f32x4*)(wq + (size_t)(d0 + r) * 2048 + hc * 128 + c4); }
    __syncthreads();
    const int n2 = (tid & 63) * 2, dg = tid >> 6;
    float acc[2][8];
#pragma unroll
    for (int a = 0; a < 2; ++a)
#pragma unroll
        for (int i = 0; i < 8; ++i) acc[a][i] = 0.f;
#pragma unroll 2
    for (int j4 = 0; j4 < 32; ++j4) {
        const f32x4 k0v = *(const f32x4*)(keysL + n2 * 132 + 4 * j4), k1v = *(const f32x4*)(keysL + (n2 + 1) * 132 + 4 * j4);
#pragma unroll
        for (int i = 0; i < 8; ++i) { const f32x4 w = *(const f32x4*)(wqL + (dg * 8 + i) * 132 + 4 * j4);
            acc[0][i] += (k0v[0] * w[0] + k0v[1] * w[1]) + (k0v[2] * w[2] + k0v[3] * w[3]);
            acc[1][i] += (k1v[0] * w[0] + k1v[1] * w[1]) + (k1v[2] * w[2] + k1v[3] * w[3]); }
    }
#pragma unroll
    for (int a = 0; a < 2; ++a) { u32x4 o; o.x = pk2(acc[a][0], acc[a][1]); o.y = pk2(acc[a][2], acc[a][3]); o.z = pk2(acc[a][4], acc[a][5]); o.w = pk2(acc[a][6], acc[a][7]);
        *(u32x4*)(WpT + (size_t)(hc * 128 + n2 + a) * 2048 + d0 + dg * 8) = o; }
    __syncthreads();
}
__device__ __forceinline__ void rms_row2048(const float* __restrict__ xr, const float* __restrict__ g, bf16_t* __restrict__ orow, int lane) {
    f32x4 v[8]; float ss = 0.f;
#pragma unroll
    for (int j = 0; j < 8; ++j) { v[j] = *(const f32x4*)(xr + j * 256 + lane * 4); ss += (v[j][0] * v[j][0] + v[j][1] * v[j][1]) + (v[j][2] * v[j][2] + v[j][3] * v[j][3]); }
    const float r = rsqrtf(wave_sum(ss) * (1.f / 2048.f) + EPS);
#pragma unroll
    for (int j = 0; j < 8; ++j) { const f32x4 gg = *(const f32x4*)(g + j * 256 + lane * 4);
        uint2 o; o.x = pk2(v[j][0] * r * gg[0], v[j][1] * r * gg[1]); o.y = pk2(v[j][2] * r * gg[2], v[j][3] * r * gg[3]);
        *(uint2*)(orow + j * 256 + lane * 4) = o; }
}
__device__ __forceinline__ void fox_cumsum(double* part, int h, const float* __restrict__ lf, float* __restrict__ F) {
    const int tid = opaque_tid(), lane = tid & 63, wave = tid >> 6;
    float v[16]; double sum = 0.0;
#pragma unroll
    for (int i = 0; i < 16; ++i) { v[i] = lf[(size_t)(tid * 16 + i) * 16 + h]; sum += (double)v[i]; }
    double inc = sum;
#pragma unroll
    for (int o = 1; o < 64; o <<= 1) { const double n = __shfl_up(inc, o); if (lane >= o) inc += n; }
    if (lane == 63) part[wave] = inc;
    __syncthreads();
    double base = 0.0;
    for (int w = 0; w < wave; ++w) base += part[w];
    double run = base + inc - sum;
#pragma unroll
    for (int i = 0; i < 16; ++i) { run += (double)v[i]; F[(size_t)h * S + tid * 16 + i] = (float)(run * 1.4426950408889634); }
    __syncthreads();
}
__device__ __forceinline__ void rope_table(const int* __restrict__ pos, float2* __restrict__ ropeT, int gtid, int nthreads) {
    for (int idx = gtid; idx < S * 32; idx += nthreads) { const int t = idx >> 5, i = idx & 31;
        const double inv = exp(-(double)i * (1.0 / 32.0) * 9.210340371976184);
        double ang = (double)((float)pos[t] * (float)inv);
        const double twopi = 6.283185307179586;
        ang -= twopi * rint(ang / twopi);
        ropeT[idx] = make_float2(cosf((float)ang), sinf((float)ang)); }
}
typedef float f32x2 __attribute__((ext_vector_type(2)));
__device__ __forceinline__ unsigned pk4_fp8(float a, float b, float c, float d) {
    int w = __builtin_amdgcn_cvt_pk_fp8_f32(fminf(fmaxf(a, -448.f), 448.f), fminf(fmaxf(b, -448.f), 448.f), 0, false);
    w = __builtin_amdgcn_cvt_pk_fp8_f32(fminf(fmaxf(c, -448.f), 448.f), fminf(fmaxf(d, -448.f), 448.f), w, true); return (unsigned)w; }
__device__ __forceinline__ void cvt_rows_fp8(const float* __restrict__ src, unsigned char* __restrict__ dst, size_t n, float scale, int gw, int NGW, int lane) {
    const size_t nchunk = n / 1024;
    for (size_t c = gw; c < nchunk; c += NGW) { const size_t o = c * 1024 + lane * 16;
        f32x4 a[4];
#pragma unroll
        for (int q = 0; q < 4; ++q) a[q] = *(const f32x4*)(src + o + 4 * q) * scale;
        u32x4 w; w.x = pk4_fp8(a[0][0], a[0][1], a[0][2], a[0][3]); w.y = pk4_fp8(a[1][0], a[1][1], a[1][2], a[1][3]);
        w.z = pk4_fp8(a[2][0], a[2][1], a[2][2], a[2][3]); w.w = pk4_fp8(a[3][0], a[3][1], a[3][2], a[3][3]);
        *(u32x4*)(dst + o) = w; }
}
constexpr float U_SCALE = 64.f, V_SCALE = 4.f;
typedef __bf16 bf16x2_t __attribute__((ext_vector_type(2)));
__device__ __forceinline__ float dot2bf(unsigned a, unsigned b, float c) { return __builtin_amdgcn_fdot2_f32_bf16(__builtin_bit_cast(bf16x2_t, a), __builtin_bit_cast(bf16x2_t, b), c, false); }
#define PEER_INS(top, x) do { float x_ = (x); _Pragma("unroll") for (int i_ = 0; i_ < 16; ++i_) { const float hi_ = fmaxf(top[i_], x_); x_ = fminf(top[i_], x_); top[i_] = hi_; } } while (0)
__device__ __forceinline__ void peer_group(unsigned char* smem, int g, const float* __restrict__ scores, const bf16_t* __restrict__ h2  , const float* __restrict__ ssq2, const float* __restrict__ x1,
                                           const unsigned char* __restrict__ U8, const unsigned char* __restrict__ V8, float* __restrict__ out) {
    const int tid = opaque_tid(), lane = tid & 63, wave = __builtin_amdgcn_readfirstlane(tid >> 6);
    float* topL = (float*)smem;
    int* selE = (int*)(smem + 32768);
    float* selG = (float*)(smem + 49152);
    {
        const int tl = tid >> 4, hc = tid & 15;
        const float* sp = scores + (size_t)(g * 32 + tl) * 2048 + hc * 128;
        float top[16];
#pragma unroll
        for (int i = 0; i < 16; ++i) top[i] = -INFINITY;
#pragma unroll 2
        for (int n0 = 0; n0 < 128; n0 += 4) { const f32x4 v = *(const f32x4*)(sp + n0);
#pragma unroll
            for (int e = 0; e < 4; ++e) PEER_INS(top, __uint_as_float((__float_as_uint(v[e]) & ~0x7Fu) | (unsigned)(n0 + e))); }
        float* tp = topL + (tl * 16 + hc) * 16;
#pragma unroll
        for (int i = 0; i < 16; i += 4) *(f32x4*)(tp + i) = (f32x4){top[i], top[i + 1], top[i + 2], top[i + 3]};
    }
    __syncthreads();
    if (tid < 256) {
        const int tl = tid >> 3, h = tid & 7;
        const float* t1 = topL + (tl * 16 + 2 * h) * 16; const float* t2 = t1 + 16;
        float s1[16], s2[16];
#pragma unroll
        for (int i = 0; i < 16; i += 4) { const f32x4 a = *(const f32x4*)(t1 + i), b2 = *(const f32x4*)(t2 + i);
            s1[i] = a[0]; s1[i + 1] = a[1]; s1[i + 2] = a[2]; s1[i + 3] = a[3]; s2[i] = b2[0]; s2[i + 1] = b2[1]; s2[i + 2] = b2[2]; s2[i + 3] = b2[3]; }
        float ts[16];
#pragma unroll
        for (int i = 0; i < 16; ++i) ts[i] = -INFINITY;
#pragma unroll
        for (int i = 0; i < 16; ++i)
#pragma unroll
            for (int j = 0; j < 16; ++j)
                if ((i + 1) * (j + 1) <= 16) PEER_INS(ts, __uint_as_float((__float_as_uint(s1[i] + s2[j]) & ~0xFFu) | (unsigned)(i * 16 + j)));
        float ex[16], sum = 0.f;
#pragma unroll
        for (int k = 0; k < 16; ++k) { ex[k] = __expf(ts[k] - ts[0]); sum += ex[k]; }
        const float inv = 1.f / sum;
#pragma unroll
        for (int k = 0; k < 16; ++k) { const unsigned pos = __float_as_uint(ts[k]) & 0xFFu;
            const int i1 = (int)(__float_as_uint(t1[pos >> 4]) & 0x7Fu), i2 = (int)(__float_as_uint(t2[pos & 15]) & 0x7Fu);
            selE[tl * 128 + h * 16 + k] = i1 * 128 + i2; selG[tl * 128 + h * 16 + k] = ex[k] * inv; }
    }
    __syncthreads();
    const int grp = lane >> 4, l16 = lane & 15, tl = wave * 4 + grp;
    unsigned* sortK = (unsigned*)(smem + 65536) + tl * 128;
    float* wS = (float*)(smem + 81920) + tl * 128;
    unsigned* hist = (unsigned*)(smem + 98304) + wave * 512 + grp * 64;
    {
#pragma unroll
        for (int i = 0; i < 4; ++i) hist[l16 * 4 + i] = 0u;
        asm volatile("s_waitcnt lgkmcnt(0)" ::: "memory");
        unsigned ek[8], rk[8];
#pragma unroll
        for (int j = 0; j < 8; ++j) { ek[j] = (unsigned)selE[tl * 128 + l16 + 16 * j]; rk[j] = atomicAdd(&hist[ek[j] >> 8], 1u); }
        asm volatile("s_waitcnt lgkmcnt(0)" ::: "memory");
        unsigned c[4], tot = 0u;
#pragma unroll
        for (int i = 0; i < 4; ++i) { c[i] = hist[l16 * 4 + i]; tot += c[i]; }
        unsigned inc = tot;
#pragma unroll
        for (int o = 1; o < 16; o <<= 1) { const unsigned n = __shfl_up(inc, o, 16); if (l16 >= o) inc += n; }
        unsigned run = inc - tot;
#pragma unroll
        for (int i = 0; i < 4; ++i) { hist[256 + l16 * 4 + i] = run; run += c[i]; }
        asm volatile("s_waitcnt lgkmcnt(0)" ::: "memory");
#pragma unroll
        for (int j = 0; j < 8; ++j) sortK[hist[256 + (ek[j] >> 8)] + rk[j]] = (ek[j] << 7) | (unsigned)(l16 + 16 * j);
    }
    __syncthreads();
    const size_t tok = (size_t)g * 32 + tl;
    float rinv_tok;
    { float t = 0.f; if (l16 < 8) { const f32x4 a = *(const f32x4*)(ssq2 + ((size_t)l16 * 8192 + tok) * 4); t = (a[0] + a[1]) + (a[2] + a[3]); }
      t += __shfl_xor(t, 8); t += __shfl_xor(t, 4); t += __shfl_xor(t, 2); t += __shfl_xor(t, 1); rinv_tok = rsqrtf(t * (1.f / 2048.f) + 1e-6f); }
#pragma unroll 1
    for (int hf = 0; hf < 2; ++hf) {
        f32x2 hp[32];
#pragma unroll
        for (int j = 0; j < 4; ++j)
#pragma unroll
            for (int q = 0; q < 2; ++q) { const u32x4 w = *(const u32x4*)(h2 + tok * DM + hf * 1024 + j * 256 + l16 * 16 + q * 8);
#pragma unroll
                for (int c = 0; c < 4; ++c) hp[j * 8 + q * 4 + c] = (f32x2){__uint_as_float(w[c] << 16), __uint_as_float(w[c] & 0xffff0000u)}; }
        for (int it = 0; it < 128; it += 4) {
            if ((it & 7) == 0 && it) __syncthreads();
            unsigned key[4]; u32x4 ur[4][4];
#pragma unroll
            for (int p = 0; p < 4; ++p) { key[p] = sortK[it + p];
#pragma unroll
                for (int j = 0; j < 4; ++j) ur[p][j] = *(const u32x4*)(U8 + (size_t)(key[p] >> 7) * DM + hf * 1024 + j * 256 + l16 * 16); }
#pragma unroll
            for (int p = 0; p < 4; ++p) { f32x2 a2 = (f32x2){0.f, 0.f}, b2 = (f32x2){0.f, 0.f};
#pragma unroll
                for (int j = 0; j < 4; ++j)
#pragma unroll
                    for (int c = 0; c < 4; ++c) { const int w = (int)ur[p][j][c];
                        a2 = __builtin_elementwise_fma(hp[j * 8 + 2 * c], __builtin_amdgcn_cvt_pk_f32_fp8(w, false), a2);
                        b2 = __builtin_elementwise_fma(hp[j * 8 + 2 * c + 1], __builtin_amdgcn_cvt_pk_f32_fp8(w, true), b2); }
                float d = (a2.x + a2.y) + (b2.x + b2.y);
                d += __shfl_xor(d, 8); d += __shfl_xor(d, 4); d += __shfl_xor(d, 2); d += __shfl_xor(d, 1);
                if (hf == 0) { if (l16 == 0) wS[it + p] = d; }
                else { const float a = (wS[it + p] + d) * (rinv_tok * (1.f / U_SCALE));
                    const float w = selG[tl * 128 + (key[p] & 127u)] * 0.5f * a * (1.f + erff(a * 0.70710678118654752f)) * (1.f / V_SCALE);
                    if (l16 == 0) wS[it + p] = w; } }
        }
        __syncthreads();
    }
#pragma unroll 1
    for (int hf = 0; hf < 2; ++hf) {
        f32x2 acc[32];
#pragma unroll
        for (int c = 0; c < 32; ++c) acc[c] = (f32x2){0.f, 0.f};
        for (int it = 0; it < 128; it += 4) {
            if ((it & 7) == 0 && it) __syncthreads();
            unsigned key[4]; u32x4 vr[4][4];
#pragma unroll
            for (int p = 0; p < 4; ++p) { key[p] = sortK[it + p];
#pragma unroll
                for (int j = 0; j < 4; ++j) vr[p][j] = *(const u32x4*)(V8 + (size_t)(key[p] >> 7) * DM + hf * 1024 + j * 256 + l16 * 16); }
#pragma unroll
            for (int p = 0; p < 4; ++p) { const float w = wS[it + p]; const f32x2 w2 = (f32x2){w, w};
#pragma unroll
                for (int j = 0; j < 4; ++j)
#pragma unroll
                    for (int c = 0; c < 4; ++c) { const int x = (int)vr[p][j][c];
                        acc[j * 8 + 2 * c] = __builtin_elementwise_fma(w2, __builtin_amdgcn_cvt_pk_f32_fp8(x, false), acc[j * 8 + 2 * c]);
                        acc[j * 8 + 2 * c + 1] = __builtin_elementwise_fma(w2, __builtin_amdgcn_cvt_pk_f32_fp8(x, true), acc[j * 8 + 2 * c + 1]); } }
        }
#pragma unroll
        for (int j = 0; j < 4; ++j)
#pragma unroll
            for (int q = 0; q < 4; ++q) { const size_t o = tok * DM + hf * 1024 + j * 256 + l16 * 16 + q * 4;
                const f32x4 a = *(const f32x4*)(x1 + o);
                *(f32x4*)(out + o) = (f32x4){a[0] + acc[j * 8 + 2 * q].x, a[1] + acc[j * 8 + 2 * q].y, a[2] + acc[j * 8 + 2 * q + 1].x, a[3] + acc[j * 8 + 2 * q + 1].y}; }
        __syncthreads();
    }
    __syncthreads();
}

#define XB_TMO      128
#define XB_XCNT(j)  (256  + 64 * (j))
#define XB_XSUB(j)  (1280 + 64 * (j))
#define XB_XGEN(j)  (2304 + 64 * (j))
#define XB_TOP      3328
#define XB_TOPGEN   3392
#define XCD_BAR_WORDS 3456
#define XB_SPIN_CAP (1u << 18)

__device__ __forceinline__ unsigned xb_ld(unsigned* p)              { return __hip_atomic_load(p, __ATOMIC_RELAXED, __HIP_MEMORY_SCOPE_AGENT); }
__device__ __forceinline__ unsigned xb_add(unsigned* p, unsigned v) { return __hip_atomic_fetch_add(p, v, __ATOMIC_RELAXED, __HIP_MEMORY_SCOPE_AGENT); }
__device__ __forceinline__ unsigned xb_xcc_id() { return (unsigned)__builtin_amdgcn_s_getreg((3 << 11) | 20) & 0xFu; }
#define XB_SPIN(cond, bar) do { unsigned _sp = 0; while (cond) { __builtin_amdgcn_s_sleep(1); \
    if ((++_sp & 255u) == 0u) { if (xb_ld(&(bar)[XB_TMO])) break; if (_sp > XB_SPIN_CAP) { atomicAdd(&(bar)[XB_TMO], 1u); break; } } } } while (0)

struct XcdBarrier {
    unsigned* bar; unsigned x;
    volatile LAS unsigned* st;
};

__device__ __forceinline__ XcdBarrier xcd_barrier_post(unsigned* bar, volatile LAS unsigned* st) {
    XcdBarrier b; b.bar = bar; b.x = xb_xcc_id(); b.st = st;
    if (threadIdx.x == 0) (void)xb_add(&bar[XB_XCNT(b.x)], 1u);
    return b;
}
__device__ __forceinline__ void xcd_barrier_complete(unsigned* bar, unsigned x, unsigned& nloc, unsigned& nx) {
    const unsigned G = gridDim.x * gridDim.y * gridDim.z;
    unsigned sum, cnt, mine, sp = 0u;
    for (;;) {
        sum = 0u; cnt = 0u; mine = 0u;
#pragma unroll
        for (unsigned j = 0; j < 16; ++j) { const unsigned c = xb_ld(&bar[XB_XCNT(j)]); sum += c; cnt += (c > 0u) ? 1u : 0u; mine = (j == x) ? c : mine; }
        if (sum == G) break;
        __builtin_amdgcn_s_sleep(1);
        if ((++sp & 255u) == 0u) { if (xb_ld(&bar[XB_TMO])) break; if (sp > XB_SPIN_CAP) { atomicAdd(&bar[XB_TMO], 1u); break; } }
    }
    nloc = mine > 0u ? mine : 1u; nx = cnt > 0u ? cnt : 1u;
}

__device__ __forceinline__ void xcd_barrier(const XcdBarrier& b) {
    asm volatile("s_waitcnt vmcnt(0)" ::: "memory");
    __syncthreads();
    if (threadIdx.x == 0) {
        unsigned* bar = b.bar;
        __builtin_amdgcn_s_waitcnt(0);
        unsigned nloc = b.st[0], nx = b.st[1];
        if (nloc == 0u) { xcd_barrier_complete(bar, b.x, nloc, nx); b.st[0] = nloc; b.st[1] = nx; }
        const unsigned old = xb_add(&bar[XB_XSUB(b.x)], 1u);
        const unsigned gen = old / nloc;
        if (old + 1u == (gen + 1u) * nloc) {
            __builtin_amdgcn_fence(__ATOMIC_RELEASE, "agent");
            asm volatile("s_waitcnt vmcnt(0)" ::: "memory");
            const unsigned og = xb_add(&bar[XB_TOP], 1u);
            const unsigned tg = og / nx;
            if (og + 1u == (tg + 1u) * nx) xb_add(&bar[XB_TOPGEN], 1u);
            else XB_SPIN(xb_ld(&bar[XB_TOPGEN]) == tg, bar);
            __builtin_amdgcn_fence(__ATOMIC_ACQUIRE, "agent");
            xb_add(&bar[XB_XGEN(b.x)], 1u);
            asm volatile("s_waitcnt vmcnt(0)" ::: "memory");
        } else {
            XB_SPIN(xb_ld(&bar[XB_XGEN(b.x)]) == gen, bar);
            __builtin_amdgcn_fence(__ATOMIC_ACQUIRE, "agent");
            asm volatile("s_waitcnt vmcnt(0)" ::: "memory");
        }
    }
    __syncthreads();
}

#define PROBE_DOUBLE 0
#define REP(k) for (int rep_ = 0; rep_ < ((PROBE_DOUBLE == (k)) ? 2 : 1); ++rep_)
constexpr int LDS_BYTES = 147456;
__global__ __launch_bounds__(512, 2) void mega(Params p) {
    extern __shared__ __attribute__((aligned(16))) unsigned char smem[];
    { volatile LAS unsigned* st0 = (volatile LAS unsigned*)((LAS unsigned char*)smem + 131072); if (threadIdx.x < 2) st0[threadIdx.x] = 0u; }
    __syncthreads();
    const XcdBarrier bar = xcd_barrier_post(p.ctl, (volatile LAS unsigned*)((LAS unsigned char*)smem + 131072));
    float* smf = (float*)smem;
    LAS unsigned char* lds = (LAS unsigned char*)smem;
    const int G = gridDim.x, b = blockIdx.x, NGW = G * 8;
#define PHASE_IDS() const int tid = opaque_tid(), lane = tid & 63, wave = __builtin_amdgcn_readfirstlane(tid >> 6), gw = b * 8 + wave; (void)lane; (void)gw

    REP(7) {
        PHASE_IDS();
        float* scr = smf + wave * 4096;
        constexpr int dummy_ = 0; (void)dummy_;
        constexpr int I_IN = 32 * 355, I_Q = 8 * 96, I_KV = 8 * 128, I_O = 64 * 64;
        for (int it = gw; it < I_IN + I_Q + I_KV + I_O; it += NGW) {
            int r = it;
            if (r < I_IN) { transpose_item(p.w_in, 2048, INW, p.WinT, DstWin(), scr, r, lane); continue; } r -= I_IN;
            if (r < I_Q) { transpose_item(p.w_q_up, 512, 3072, p.WqT, DstQ(), scr, r, lane, p.q_lat_g); continue; } r -= I_Q;
            if (r < I_KV) { transpose_item(p.w_kv_up, 512, 4096, p.WkvT, DstId(), scr, r, lane, p.kv_lat_g); continue; } r -= I_KV;
            transpose_item(p.w_out, 4096, 2048, p.WoT, DstId(), scr, r, lane);
        }
        for (int m = gw; m < S; m += NGW) rms_row2048(p.x + (size_t)m * DM, p.mix_g, p.h + (size_t)m * DM, lane);
        for (int idx = b * 512 + tid; idx < 16 * 64 * 64; idx += G * 512) { const int hh = idx >> 12, rr = (idx >> 6) & 63, c8 = idx & 63;
            *(u32x4*)(p.WqT + (size_t)(hh * 256 + 192 + rr) * 512 + c8 * 8) = (u32x4){0u, 0u, 0u, 0u}; }
        rope_table(p.pos, p.ropeT, b * 512 + tid, G * 512);
        __syncthreads();
        for (int it = b; it < 512; it += G) wfold_item(p.w_peer_q, p.sub_keys, p.WpT, smf, it);
    }
    xcd_barrier(bar);
    REP(1) {
        pg8::Gemm g{p.h, p.WinT, S, INWP, DM}; pg8::StaticOrder so; so.init(S, INWP, G, b);
        pg8::EpiInProj E{p.cq, p.ckv, p.fq, p.fk, p.fv, p.merged, p.kpe, p.lf, p.b_gate, p.b_forget, p.ssq, p.fox_qg, p.fox_kg, (LAS float*)(lds + 131072 + 64)};
        pg8::gemm_phase<pg8::EpiInProj, pg8::StaticOrder, true, true>(lds, g, so, E);
    }
    xcd_barrier(bar);
    for (int hh = b; hh < 16; hh += G) fox_cumsum((double*)smem, hh, p.lf, p.F);
    REP(2) {
        pg8::Gemm g{p.cq, p.WqT, S, 4096, 512}; pg8::StaticOrder so; so.init(S, 4096, G, b);
        pg8::EpiQ E{p.qa, p.ssq, p.mla_qg, p.ropeT, (LAS float*)(lds + 131072 + 64)};
        pg8::gemm_phase<pg8::EpiQ, pg8::StaticOrder, true, true>(lds, g, so, E);
    }
    {
        pg8::Gemm g{p.ckv, p.WkvT, S, 4096, 512}; pg8::StaticOrder so; so.init(S, 4096, G, b);
        pg8::EpiKV E{p.ka, p.va, p.kpe, p.ssq, p.mla_kg, p.ropeT, (LAS float*)(lds + 131072 + 64)};
        pg8::gemm_phase<pg8::EpiKV, pg8::StaticOrder, true, true>(lds, g, so, E);
    }
    xcd_barrier(bar);
    int side_next = 0;
    REP(3) for (int L = b; L < 1024; L += G) {
        const int i = L >> 8, vc = L & 255, vcx = (vc & 7) * 32 + (vc >> 3), hh = vcx >> 4, x = vcx & 15, qbk = (i & 1) ? x : 31 - x;
        if (i < 2) att::attn_block<192, false>(smem, p.qa + hh * 192, 3072, p.ka + hh * 192, 3072, p.va + hh * 128, 2048, nullptr, p.merged + hh * 128, p.attout + hh * 128, qbk, nullptr, nullptr, p.peer_u, p.peer_v, p.U8, p.V8, side_next);
        else att::attn_block<128, true>(smem, p.fq + hh * 128, 2048, p.fk + hh * 128, 2048, p.fv + hh * 128, 2048, p.F + (size_t)hh * S, p.merged + 2048 + hh * 128, p.attout + 2048 + hh * 128, qbk, p.fox_qg, p.fox_kg, p.peer_u, p.peer_v, p.U8, p.V8, side_next);
    }
    if (G == 256) { PHASE_IDS(); (void)wave;
        for (; side_next < 64; ++side_next) { const bool isv = side_next >= 32; const size_t off = ((size_t)(b * 32 + (side_next & 31)) * 512 + tid) * 8;
            const float* sp = (isv ? p.peer_v : p.peer_u) + off; const float sc = isv ? V_SCALE : U_SCALE; const f32x4 a0 = *(const f32x4*)sp * sc, a1 = *(const f32x4*)(sp + 4) * sc;
            uint2 o; o.x = pk4_fp8(a0[0], a0[1], a0[2], a0[3]); o.y = pk4_fp8(a1[0], a1[1], a1[2], a1[3]); *(uint2*)((isv ? p.V8 : p.U8) + off) = o; } }
    else { PHASE_IDS(); cvt_rows_fp8(p.peer_u, p.U8, (size_t)16384 * 2048, U_SCALE, gw, NGW, lane); cvt_rows_fp8(p.peer_v, p.V8, (size_t)16384 * 2048, V_SCALE, gw, NGW, lane); }
    xcd_barrier(bar);
    REP(4) {
        pg8::Gemm g{p.attout, p.WoT, S, 2048, 4096}; pg8::StaticOrder so; so.init(S, 2048, G, b);
        pg8::EpiX1 E{p.x1, p.x, p.xg, p.ffn_g, p.ssq2};
        pg8::gemm_phase<pg8::EpiX1, pg8::StaticOrder, true, true>(lds, g, so, E);
    }
    xcd_barrier(bar);
    REP(5) {
        pg8::Gemm g{p.xg, p.WpT, S, 2048, 2048}; pg8::StaticOrder so; so.init(S, 2048, G, b);
        pg8::EpiScores E{p.scores, p.ssq2};
        pg8::gemm_phase<pg8::EpiScores, pg8::StaticOrder, true, true>(lds, g, so, E);
    }
    xcd_barrier(bar);
    REP(6) for (int g = b; g < S / 32; g += G) peer_group(smem, g, p.scores, p.xg, p.ssq2, p.x1, p.U8, p.V8, p.out);
}

extern "C" void kernel_launch(void* const* d_in, const int* in_sizes, int n_in,
                              void* d_out, int out_size, void* d_ws, size_t ws_size,
                              hipStream_t stream) {
    if (ws_size < 512 * MiB) { fprintf(stderr, "kernel_launch: workspace too small (%zu)\n", ws_size); return; }
    Params p{};
    p.x = (const float*)d_in[0]; p.pos = (const int*)d_in[1]; p.mix_g = (const float*)d_in[2]; p.w_in = (const float*)d_in[3];
    p.b_forget = (const float*)d_in[4]; p.b_gate = (const float*)d_in[5]; p.q_lat_g = (const float*)d_in[6]; p.w_q_up = (const float*)d_in[7];
    p.kv_lat_g = (const float*)d_in[8]; p.w_kv_up = (const float*)d_in[9]; p.mla_qg = (const float*)d_in[10]; p.mla_kg = (const float*)d_in[11];
    p.fox_qg = (const float*)d_in[12]; p.fox_kg = (const float*)d_in[13]; p.w_out = (const float*)d_in[14]; p.ffn_g = (const float*)d_in[15];
    p.w_peer_q = (const float*)d_in[16]; p.sub_keys = (const float*)d_in[17]; p.peer_u = (const float*)d_in[18]; p.peer_v = (const float*)d_in[19];
    p.out = (float*)d_out;
    char* ws = (char*)d_ws;
    p.WqT = (bf16_t*)(ws + 1 * MiB); p.WkvT = (bf16_t*)(ws + 5 * MiB); p.WoT = (bf16_t*)(ws + 9 * MiB); p.WpT = (bf16_t*)(ws + 25 * MiB); p.WinT = (bf16_t*)(ws + 33 * MiB);
    p.h = (bf16_t*)(ws + 78 * MiB); p.cq = (bf16_t*)(ws + 110 * MiB); p.ckv = (bf16_t*)(ws + 118 * MiB);
    p.fq = (bf16_t*)(ws + 126 * MiB); p.fk = (bf16_t*)(ws + 158 * MiB); p.fv = (bf16_t*)(ws + 190 * MiB); p.merged = (bf16_t*)(ws + 222 * MiB);
    p.kpe = (bf16_t*)(ws + 286 * MiB); p.lf = (float*)(ws + 287 * MiB); p.F = (float*)(ws + 287 * MiB + 512 * 1024);
    p.qa = (bf16_t*)(ws + 288 * MiB); p.va = (bf16_t*)(ws + 336 * MiB); p.ka = (bf16_t*)(ws + 400 * MiB); p.x1 = (float*)(ws + 126 * MiB);
    p.scores = (float*)(ws + 222 * MiB);
    p.ctl = (unsigned*)ws;
    p.ropeT = (float2*)(ws + 448 * MiB);
    p.ssq = (float*)(ws + 64 * 1024);
    p.attout = (bf16_t*)(ws + 33 * MiB);
    p.U8 = (unsigned char*)(ws + 450 * MiB); p.V8 = (unsigned char*)(ws + 368 * MiB);
    p.xg = (bf16_t*)(ws + 190 * MiB);
    p.ssq2 = (float*)(ws + 482 * MiB);

    static int grid_blocks = 0;
    if (!grid_blocks) {
        if (hipFuncSetAttribute((const void*)mega, hipFuncAttributeMaxDynamicSharedMemorySize, LDS_BYTES) != hipSuccess) { fprintf(stderr, "hipFuncSetAttribute failed\n"); return; }
        int dev = 0, cus = 0, per_cu = 0;
        (void)hipGetDevice(&dev);
        (void)hipDeviceGetAttribute(&cus, hipDeviceAttributeMultiprocessorCount, dev);
        (void)hipOccupancyMaxActiveBlocksPerMultiprocessor(&per_cu, (const void*)mega, 512, LDS_BYTES);
        if (per_cu < 1 || cus < 1) { fprintf(stderr, "occupancy query says %d blocks/CU on %d CUs\n", per_cu, cus); return; }
        grid_blocks = cus;
    }
    if (hipMemsetAsync(d_ws, 0, 16384, stream) != hipSuccess) { fprintf(stderr, "memset of the barrier words failed\n"); return; }
    void* args[] = {&p};
    hipError_t e = hipLaunchCooperativeKernel((const void*)mega, dim3(grid_blocks), dim3(512), args, LDS_BYTES, stream);
    if (e != hipSuccess) fprintf(stderr, "cooperative launch failed: %s (grid %d)\n", hipGetErrorString(e), grid_blocks);
}
```

```cpp
#include <hip/hip_runtime.h>
#include <hip/hip_cooperative_groups.h>
#include <stdint.h>
#include <math.h>
#include <cstdio>
namespace cg = cooperative_groups;

namespace pg8 {
#define PG8_LAS __attribute__((address_space(3)))
typedef unsigned short bf16_t;
typedef short bf16x8 __attribute__((ext_vector_type(8)));
typedef float f32x4 __attribute__((ext_vector_type(4)));
typedef unsigned u32x4 __attribute__((ext_vector_type(4)));
constexpr int BM = 256, BK = 64, HALF = 128, HTB = HALF * BK * 2  , STAGE_BYTES = 8 * HTB, NXCD = 8, WGM = 8;

__host__ __device__ __forceinline__ int lds_byte(int r, int c) { const int st = (r >> 4) * 2 + (c >> 5), rr = r & 15, cc = c & 31, ob = rr * 64 + cc * 2; return st * 1024 + (ob ^ (((ob >> 9) & 1) << 5)); }
__host__ __device__ __forceinline__ void stage_rc(int b, int& R, int& C) { const int st = b / 1024, sb = b % 1024, swz = sb ^ (((sb >> 9) & 1) << 5); R = (st >> 1) * 16 + swz / 64; C = (st & 1) * 32 + (swz % 64) / 2; }
__host__ __device__ __forceinline__ int perm32(int rho) { const int n = rho >> 4, i = rho & 15; return 8 * (i >> 2) + 4 * n + (i & 3); }

struct Unit { int pm, pn; };
struct Gemm { const bf16_t* A; const bf16_t* Bt; int M, N, K; };

struct StaticOrder {
    int nM, nN, nwg, G, c;
    __host__ __device__ void init(int M, int N, int G_, int c_) { nM = M / BM; nN = N / BM; nwg = nM * nN; G = G_; c = c_; }
    __host__ __device__ bool next(int i, Unit& u) const {
        const long L = (long)i * G + c; if (L >= nwg) return false;
        int wgid = (int)L; { const int q = nwg / NXCD, r = nwg % NXCD, xcd = wgid % NXCD, off = wgid / NXCD; wgid = (xcd < r ? xcd * (q + 1) : r * (q + 1) + (xcd - r) * q) + off; }
        const int nig = WGM * nN, gid = wgid / nig, fm = gid * WGM, gsz = (nM - fm) < WGM ? (nM - fm) : WGM;
        u.pm = fm + ((wgid % nig) % gsz); u.pn = (wgid % nig) / gsz; return true;
    }
    __device__ __forceinline__ void a_ready(const Unit&) const {}
    __device__ __forceinline__ void done(const Unit&) const {}
};

typedef float cvt_pk_bf16_f32x2 __attribute__((ext_vector_type(2))); typedef __bf16 cvt_pk_bf16_bf16x2 __attribute__((ext_vector_type(2)));
__device__ __forceinline__ unsigned cvt_pk_bf16(float lo, float hi) { const cvt_pk_bf16_f32x2 v = {lo, hi}; const cvt_pk_bf16_bf16x2 b = __builtin_convertvector(v, cvt_pk_bf16_bf16x2); return __builtin_bit_cast(unsigned, b); }
__device__ __forceinline__ u32x4 pack8bf(const f32x4& v0, const f32x4& v1) { u32x4 w; w.x = cvt_pk_bf16(v0[0], v0[1]); w.y = cvt_pk_bf16(v0[2], v0[3]); w.z = cvt_pk_bf16(v1[0], v1[1]); w.w = cvt_pk_bf16(v1[2], v1[3]); return w; }

struct EpiStoreBf16 {
    static constexpr bool PERM = true, AFTER_DRAIN = false;
    bf16_t* O; int ldc;
    __device__ __forceinline__ void operator()(const f32x4 (&acc)[2][2][4][2], const Unit& u, int wr, int wc, int fr, int fq) const {
        const int row0 = u.pm * BM + wr * 64 + fr, col0 = u.pn * BM + wc * 32 + 8 * fq;
#pragma unroll
        for (int ai = 0; ai < 2; ++ai)
#pragma unroll
            for (int m = 0; m < 4; ++m) { bf16_t* rowp = O + (size_t)(row0 + ai * HALF + m * 16) * ldc + col0;
#pragma unroll
                for (int bj = 0; bj < 2; ++bj) *(u32x4*)(rowp + bj * HALF) = pack8bf(acc[ai][bj][m][0], acc[ai][bj][m][1]); }
    }
};
template <bool RES> struct EpiStoreF32 {
    static constexpr bool PERM = true, AFTER_DRAIN = false;
    float* O; const float* res; int ldc;
    __device__ __forceinline__ void operator()(const f32x4 (&acc)[2][2][4][2], const Unit& u, int wr, int wc, int fr, int fq) const {
        const int row0 = u.pm * BM + wr * 64 + fr, col0 = u.pn * BM + wc * 32 + 8 * fq;
#pragma unroll
        for (int ai = 0; ai < 2; ++ai)
#pragma unroll
            for (int m = 0; m < 4; ++m) { const size_t off = (size_t)(row0 + ai * HALF + m * 16) * ldc + col0;
#pragma unroll
                for (int bj = 0; bj < 2; ++bj) { f32x4 v0 = acc[ai][bj][m][0], v1 = acc[ai][bj][m][1];
                    if (RES) { v0 += *(const f32x4*)(res + off + bj * HALF); v1 += *(const f32x4*)(res + off + bj * HALF + 4); }
                    *(f32x4*)(O + off + bj * HALF) = v0; *(f32x4*)(O + off + bj * HALF + 4) = v1; } }
    }
};
#define EPI_LDSBAR() do { asm volatile("s_waitcnt lgkmcnt(0)" ::: "memory"); __builtin_amdgcn_s_barrier(); asm volatile("" ::: "memory"); } while (0)
struct EpiInProj {
    static constexpr bool PERM = true, AFTER_DRAIN = false;
    bf16_t *cq, *ckv, *fq, *fk, *fv, *gates, *kpe; float* lf; const float *b_gate, *b_forget; float* ssq; const float *gfq, *gfk; PG8_LAS float* xs;
    __device__ __forceinline__ void operator()(const f32x4 (&acc)[2][2][4][2], const Unit& u, int wr, int wc, int fr, int fq_) const {
        const int pn = u.pn, row0 = u.pm * BM + wr * 64 + fr, cw = wc * 32 + 8 * fq_;
        if (pn < 4) {
            bf16_t* base = pn < 2 ? cq : ckv; const int colt = (pn & 1) * 256;
#pragma unroll
            for (int ai = 0; ai < 2; ++ai)
#pragma unroll
                for (int m = 0; m < 4; ++m) { const int row = row0 + ai * HALF + m * 16; bf16_t* rowp = base + (size_t)row * 512 + colt + cw; float s = 0.f;
#pragma unroll
                    for (int bj = 0; bj < 2; ++bj) { const f32x4 v0 = acc[ai][bj][m][0], v1 = acc[ai][bj][m][1];
                        s += (v0[0] * v0[0] + v0[1] * v0[1]) + (v0[2] * v0[2] + v0[3] * v0[3]) + (v1[0] * v1[0] + v1[1] * v1[1]) + (v1[2] * v1[2] + v1[3] * v1[3]);
                        *(u32x4*)(rowp + bj * HALF) = pack8bf(v0, v1); }
                    s += __shfl_xor(s, 16); s += __shfl_xor(s, 32);
                    if (fq_ == 0) ssq[((size_t)pn * 8192 + row) * 4 + wc] = s; }
        } else if (pn < 20) {
            const bool isq = pn < 12; bf16_t* base = isq ? fq : fk; const int colt = (pn - (isq ? 4 : 12)) * 256; const float* g = isq ? gfq : gfk;
            const float qs = isq ? 0.12751743f : 1.f;
#pragma unroll
            for (int ai = 0; ai < 2; ++ai)
#pragma unroll
                for (int m = 0; m < 4; ++m)
#pragma unroll
                    for (int bj = 0; bj < 2; ++bj) { const f32x4 v0 = acc[ai][bj][m][0], v1 = acc[ai][bj][m][1];
                        float s = (v0[0] * v0[0] + v0[1] * v0[1]) + (v0[2] * v0[2] + v0[3] * v0[3]) + (v1[0] * v1[0] + v1[1] * v1[1]) + (v1[2] * v1[2] + v1[3] * v1[3]);
                        s += __shfl_xor(s, 16); s += __shfl_xor(s, 32);
                        if (fq_ == 0) xs[((ai * HALF + wr * 64 + m * 16 + fr) * 2 + bj) * 4 + wc] = s; }
            EPI_LDSBAR();
            const f32x4 g0 = *(const f32x4*)(g + cw) * qs, g1 = *(const f32x4*)(g + cw + 4) * qs;
#pragma unroll
            for (int ai = 0; ai < 2; ++ai)
#pragma unroll
                for (int m = 0; m < 4; ++m) { bf16_t* rowp = base + (size_t)(row0 + ai * HALF + m * 16) * 2048 + colt + cw;
#pragma unroll
                    for (int bj = 0; bj < 2; ++bj) { const f32x4 t4 = *(const PG8_LAS f32x4*)(xs + ((ai * HALF + wr * 64 + m * 16 + fr) * 2 + bj) * 4);
                        const float r = rsqrtf(((t4[0] + t4[1]) + (t4[2] + t4[3])) * (1.f / 128.f) + 1e-6f);
                        *(u32x4*)(rowp + bj * HALF) = pack8bf(acc[ai][bj][m][0] * g0 * r, acc[ai][bj][m][1] * g1 * r); } }
        } else if (pn < 28) {
            const int colt = (pn - 20) * 256;
#pragma unroll
            for (int ai = 0; ai < 2; ++ai)
#pragma unroll
                for (int m = 0; m < 4; ++m) { bf16_t* rowp = fv + (size_t)(row0 + ai * HALF + m * 16) * 2048 + colt + cw;
#pragma unroll
                    for (int bj = 0; bj < 2; ++bj) *(u32x4*)(rowp + bj * HALF) = pack8bf(acc[ai][bj][m][0], acc[ai][bj][m][1]); }
        } else if (pn < 44) {
            const int colt = (pn - 28) * 256 + cw;
#pragma unroll
            for (int bj = 0; bj < 2; ++bj) {
                const f32x4 b0 = *(const f32x4*)(b_gate + colt + bj * HALF), b1 = *(const f32x4*)(b_gate + colt + bj * HALF + 4);
#pragma unroll
                for (int ai = 0; ai < 2; ++ai)
#pragma unroll
                    for (int m = 0; m < 4; ++m) {
                        f32x4 v0 = acc[ai][bj][m][0] + b0, v1 = acc[ai][bj][m][1] + b1;
#pragma unroll
                        for (int e = 0; e < 4; ++e) { v0[e] = __builtin_amdgcn_rcpf(1.f + __expf(-v0[e])); v1[e] = __builtin_amdgcn_rcpf(1.f + __expf(-v1[e])); }
                        *(u32x4*)(gates + (size_t)(row0 + ai * HALF + m * 16) * 4096 + colt + bj * HALF) = pack8bf(v0, v1); }
            }
        } else {
            if (cw < 64) {
#pragma unroll
                for (int ai = 0; ai < 2; ++ai)
#pragma unroll
                    for (int m = 0; m < 4; ++m) *(u32x4*)(kpe + (size_t)(row0 + ai * HALF + m * 16) * 64 + cw) = pack8bf(acc[ai][0][m][0], acc[ai][0][m][1]);
            } else if (cw < 80) {
                const int h0 = cw - 64;
                const f32x4 b0 = *(const f32x4*)(b_forget + h0), b1 = *(const f32x4*)(b_forget + h0 + 4);
#pragma unroll
                for (int ai = 0; ai < 2; ++ai)
#pragma unroll
                    for (int m = 0; m < 4; ++m) { const int row = row0 + ai * HALF + m * 16;
                        f32x4 z0 = acc[ai][0][m][0] + b0, z1 = acc[ai][0][m][1] + b1;
#pragma unroll
                        for (int e = 0; e < 4; ++e) { z0[e] = fminf(z0[e], 0.f) - __logf(1.f + __expf(-fabsf(z0[e]))); z1[e] = fminf(z1[e], 0.f) - __logf(1.f + __expf(-fabsf(z1[e]))); }
                        *(f32x4*)(lf + (size_t)row * 16 + h0) = z0; *(f32x4*)(lf + (size_t)row * 16 + h0 + 4) = z1; }
            }
        }
    }
};
__device__ __forceinline__ float lat_rinv(const float* ssq, int part0, int row) {
    const f32x4 a = *(const f32x4*)(ssq + ((size_t)part0 * 8192 + row) * 4), b = *(const f32x4*)(ssq + ((size_t)(part0 + 1) * 8192 + row) * 4);
    return rsqrtf((((a[0] + a[1]) + (a[2] + a[3])) + ((b[0] + b[1]) + (b[2] + b[3]))) * (1.f / 512.f) + 1e-6f);
}
struct EpiQ {
    static constexpr bool PERM = true, AFTER_DRAIN = false;
    bf16_t* qa; const float* ssq; const float* gq; const float2* ropeT; PG8_LAS float* xs;
    __device__ __forceinline__ void operator()(const f32x4 (&acc)[2][2][4][2], const Unit& u, int wr, int wc, int fr, int fq_) const {
        const int h = u.pn, row0 = u.pm * BM + wr * 64 + fr, cw = wc * 32 + 8 * fq_;
        float rl[2][4];
#pragma unroll
        for (int ai = 0; ai < 2; ++ai)
#pragma unroll
            for (int m = 0; m < 4; ++m) { rl[ai][m] = lat_rinv(ssq, 0, row0 + ai * HALF + m * 16); float s = 0.f;
#pragma unroll
                for (int bj = 0; bj < 2; ++bj) { const f32x4 v0 = acc[ai][bj][m][0], v1 = acc[ai][bj][m][1];
                    s += (v0[0] * v0[0] + v0[1] * v0[1]) + (v0[2] * v0[2] + v0[3] * v0[3]) + (v1[0] * v1[0] + v1[1] * v1[1]) + (v1[2] * v1[2] + v1[3] * v1[3]); }
                s *= rl[ai][m] * rl[ai][m];
                s += __shfl_xor(s, 16); s += __shfl_xor(s, 32);
                if (fq_ == 0) xs[(ai * HALF + wr * 64 + m * 16 + fr) * 4 + wc] = s; }
        EPI_LDSBAR();
        const float qs = 0.10411754f;
        const f32x4 g0 = *(const f32x4*)(gq + cw) * qs, g1 = *(const f32x4*)(gq + cw + 4) * qs;
        const int pp = 16 * (wc & 1) + 4 * fq_;
        const f32x4 ga = *(const f32x4*)(gq + 128 + pp) * qs, gb = *(const f32x4*)(gq + 160 + pp) * qs;
#pragma unroll
        for (int ai = 0; ai < 2; ++ai)
#pragma unroll
            for (int m = 0; m < 4; ++m) { const int row = row0 + ai * HALF + m * 16;
                const f32x4 t4 = *(const PG8_LAS f32x4*)(xs + (ai * HALF + wr * 64 + m * 16 + fr) * 4);
                const float r = rsqrtf(((t4[0] + t4[1]) + (t4[2] + t4[3])) * (1.f / 192.f) + 1e-6f) * rl[ai][m];
                bf16_t* rowp = qa + (size_t)row * 3072 + h * 192;
                *(u32x4*)(rowp + cw) = pack8bf(acc[ai][0][m][0] * g0 * r, acc[ai][0][m][1] * g1 * r);
                if (wc < 2) { const f32x4 c01 = *(const f32x4*)(ropeT + (size_t)row * 32 + pp), c23 = *(const f32x4*)(ropeT + (size_t)row * 32 + pp + 2);
                    const f32x4 z0 = acc[ai][1][m][0] * r, z1 = acc[ai][1][m][1] * r;
                    const float a0 = z0[0] * ga[0], b0 = z0[1] * gb[0], a1 = z0[2] * ga[1], b1 = z0[3] * gb[1], a2 = z1[0] * ga[2], b2 = z1[1] * gb[2], a3 = z1[2] * ga[3], b3 = z1[3] * gb[3];
                    const f32x4 o0 = {a0 * c01[0] - b0 * c01[1], a0 * c01[1] + b0 * c01[0], a1 * c01[2] - b1 * c01[3], a1 * c01[3] + b1 * c01[2]};
                    const f32x4 o1 = {a2 * c23[0] - b2 * c23[1], a2 * c23[1] + b2 * c23[0], a3 * c23[2] - b3 * c23[3], a3 * c23[3] + b3 * c23[2]};
                    *(u32x4*)(rowp + 128 + cw) = pack8bf(o0, o1); } }
    }
};
struct EpiKV {
    static constexpr bool PERM = true, AFTER_DRAIN = false;
    bf16_t *ka, *va; const bf16_t* kpe; const float* ssq; const float* gk; const float2* ropeT; PG8_LAS float* xs;
    __device__ __forceinline__ void operator()(const f32x4 (&acc)[2][2][4][2], const Unit& u, int wr, int wc, int fr, int fq_) const {
        const int h = u.pn, row0 = u.pm * BM + wr * 64 + fr, cw = wc * 32 + 8 * fq_;
        float rl[2][4]; f32x4 kp[2][4];
#pragma unroll
        for (int ai = 0; ai < 2; ++ai)
#pragma unroll
            for (int m = 0; m < 4; ++m) { const int row = row0 + ai * HALF + m * 16; rl[ai][m] = lat_rinv(ssq, 2, row);
                const uint2 w = *(const uint2*)(kpe + (size_t)row * 64 + 16 * wc + 4 * fq_);
                kp[ai][m] = (f32x4){__uint_as_float(w.x << 16), __uint_as_float(w.x & 0xffff0000u), __uint_as_float(w.y << 16), __uint_as_float(w.y & 0xffff0000u)};
                const f32x4 v0 = acc[ai][0][m][0], v1 = acc[ai][0][m][1];
                float s = ((v0[0] * v0[0] + v0[1] * v0[1]) + (v0[2] * v0[2] + v0[3] * v0[3]) + (v1[0] * v1[0] + v1[1] * v1[1]) + (v1[2] * v1[2] + v1[3] * v1[3])) * (rl[ai][m] * rl[ai][m]);
                s += (kp[ai][m][0] * kp[ai][m][0] + kp[ai][m][1] * kp[ai][m][1]) + (kp[ai][m][2] * kp[ai][m][2] + kp[ai][m][3] * kp[ai][m][3]);
                s += __shfl_xor(s, 16); s += __shfl_xor(s, 32);
                if (fq_ == 0) xs[(ai * HALF + wr * 64 + m * 16 + fr) * 4 + wc] = s;
                *(u32x4*)(va + (size_t)row * 2048 + h * 128 + cw) = pack8bf(acc[ai][1][m][0] * rl[ai][m], acc[ai][1][m][1] * rl[ai][m]); }
        EPI_LDSBAR();
        const f32x4 g0 = *(const f32x4*)(gk + cw), g1 = *(const f32x4*)(gk + cw + 4);
        const int pp = 8 * wc + 2 * fq_;
        const float ga0 = gk[128 + pp], ga1 = gk[128 + pp + 1], gb0 = gk[160 + pp], gb1 = gk[160 + pp + 1];
#pragma unroll
        for (int ai = 0; ai < 2; ++ai)
#pragma unroll
            for (int m = 0; m < 4; ++m) { const int row = row0 + ai * HALF + m * 16;
                const f32x4 t4 = *(const PG8_LAS f32x4*)(xs + (ai * HALF + wr * 64 + m * 16 + fr) * 4);
                const float r = rsqrtf(((t4[0] + t4[1]) + (t4[2] + t4[3])) * (1.f / 192.f) + 1e-6f), rn = r * rl[ai][m];
                bf16_t* rowp = ka + (size_t)row * 3072 + h * 192;
                *(u32x4*)(rowp + cw) = pack8bf(acc[ai][0][m][0] * g0 * rn, acc[ai][0][m][1] * g1 * rn);
                const f32x4 cs = *(const f32x4*)(ropeT + (size_t)row * 32 + pp);
                const float a0 = kp[ai][m][0] * r * ga0, b0 = kp[ai][m][1] * r * gb0, a1 = kp[ai][m][2] * r * ga1, b1 = kp[ai][m][3] * r * gb1;
                uint2 o; o.x = cvt_pk_bf16(a0 * cs[0] - b0 * cs[1], a0 * cs[1] + b0 * cs[0]); o.y = cvt_pk_bf16(a1 * cs[2] - b1 * cs[3], a1 * cs[3] + b1 * cs[2]);
                *(uint2*)(rowp + 128 + 16 * wc + 4 * fq_) = o; }
    }
};

struct EpiX1 {
    static constexpr bool PERM = true, AFTER_DRAIN = false;
    float* x1; const float* x; bf16_t* xg; const float* g; float* ssq2;
    __device__ __forceinline__ void operator()(const f32x4 (&acc)[2][2][4][2], const Unit& u, int wr, int wc, int fr, int fq_) const {
        const int row0 = u.pm * BM + wr * 64 + fr, col0 = u.pn * BM + wc * 32 + 8 * fq_;
        f32x4 gg[2][2];
#pragma unroll
        for (int bj = 0; bj < 2; ++bj) { gg[bj][0] = *(const f32x4*)(g + col0 + bj * HALF); gg[bj][1] = *(const f32x4*)(g + col0 + bj * HALF + 4); }
#pragma unroll
        for (int ai = 0; ai < 2; ++ai)
#pragma unroll
            for (int m = 0; m < 4; ++m) { const int row = row0 + ai * HALF + m * 16; const size_t off = (size_t)row * 2048 + col0; float s = 0.f;
#pragma unroll
                for (int bj = 0; bj < 2; ++bj) { const f32x4 v0 = acc[ai][bj][m][0] + *(const f32x4*)(x + off + bj * HALF), v1 = acc[ai][bj][m][1] + *(const f32x4*)(x + off + bj * HALF + 4);
                    *(f32x4*)(x1 + off + bj * HALF) = v0; *(f32x4*)(x1 + off + bj * HALF + 4) = v1;
                    s += (v0[0] * v0[0] + v0[1] * v0[1]) + (v0[2] * v0[2] + v0[3] * v0[3]) + (v1[0] * v1[0] + v1[1] * v1[1]) + (v1[2] * v1[2] + v1[3] * v1[3]);
                    *(u32x4*)(xg + off + bj * HALF) = pack8bf(v0 * gg[bj][0], v1 * gg[bj][1]); }
                s += __shfl_xor(s, 16); s += __shfl_xor(s, 32);
                if (fq_ == 0) ssq2[((size_t)u.pn * 8192 + row) * 4 + wc] = s; }
    }
};
__device__ __forceinline__ float ffn_rinv(const float* ssq2, int row) {
    float t = 0.f;
#pragma unroll
    for (int pn = 0; pn < 8; ++pn) { const f32x4 a = *(const f32x4*)(ssq2 + ((size_t)pn * 8192 + row) * 4); t += (a[0] + a[1]) + (a[2] + a[3]); }
    return rsqrtf(t * (1.f / 2048.f) + 1e-6f);
}
struct EpiScores {
    static constexpr bool PERM = true, AFTER_DRAIN = false;
    float* O; const float* ssq2;
    __device__ __forceinline__ void operator()(const f32x4 (&acc)[2][2][4][2], const Unit& u, int wr, int wc, int fr, int fq_) const {
        const int row0 = u.pm * BM + wr * 64 + fr, col0 = u.pn * BM + wc * 32 + 8 * fq_;
#pragma unroll
        for (int ai = 0; ai < 2; ++ai)
#pragma unroll
            for (int m = 0; m < 4; ++m) { const int row = row0 + ai * HALF + m * 16; const float r = ffn_rinv(ssq2, row); const size_t off = (size_t)row * 2048 + col0;
#pragma unroll
                for (int bj = 0; bj < 2; ++bj) { *(f32x4*)(O + off + bj * HALF) = acc[ai][bj][m][0] * r; *(f32x4*)(O + off + bj * HALF + 4) = acc[ai][bj][m][1] * r; } }
    }
};
template <class Epi, class Sched, bool ALIGN_EPI = false, bool SP2 = false>
__device__ __forceinline__ void gemm_phase(PG8_LAS unsigned char* lds, const Gemm g, const Sched& S, const Epi& E) {
    int tid = threadIdx.x; asm volatile("" : "+v"(tid));
    const int wid = __builtin_amdgcn_readfirstlane(tid >> 6), lane = tid & 63, wr = wid >> 2, wc = wid & 3, fr = lane & 15, fq = lane >> 4;
    const int K = g.K, nt = K / BK;
    unsigned voffA[2], voffB[2];
#pragma unroll
    for (int i = 0; i < 2; ++i) { int R, C; stage_rc(tid * 16 + i * 8192, R, C); const int Rb = Epi::PERM ? ((R & ~31) + perm32(R & 31)) : R;
        voffA[i] = (unsigned)(R * K + C) * 2u; voffB[i] = (unsigned)(Rb * K + C) * 2u; }
    const size_t kstep = (size_t)(BK * 2);
    const size_t hstep = (size_t)HALF * K * 2;
    const size_t tstep = 2 * hstep;
    const unsigned ldsw = (unsigned)wid * 1024u;
    const int aoff = lds_byte(wr * 64 + fr, fq * 8), boff = lds_byte(wc * 32 + fr, fq * 8);
#define PG8_SA(b, h) (((b) * 2 + (h)) * HTB)
#define PG8_SB(b, h) ((4 + (b) * 2 + (h)) * HTB)
#define PG8_STAGE(bufoff, gbase, voff) do { _Pragma("unroll") for (int _i = 0; _i < 2; ++_i) \
        __builtin_amdgcn_global_load_lds((const unsigned*)((const char*)(gbase) + (voff)[_i]), (PG8_LAS unsigned*)(lds + (bufoff) + ldsw + _i * 8192), 16, 0, 0); } while (0)
#define PG8_LDA(dst, b, h) do { _Pragma("unroll") for (int m = 0; m < 4; ++m) _Pragma("unroll") for (int k = 0; k < 2; ++k) dst[m][k] = *(const PG8_LAS bf16x8*)(lds + PG8_SA(b, h) + aoff + m * 2048 + k * 1024); } while (0)
#define PG8_LDB(dst, b, h) do { _Pragma("unroll") for (int n = 0; n < 2; ++n) _Pragma("unroll") for (int k = 0; k < 2; ++k) dst[n][k] = *(const PG8_LAS bf16x8*)(lds + PG8_SB(b, h) + boff + n * 2048 + k * 1024); } while (0)
#define PG8_MMA(ai, bj, At, Bt) do { __builtin_amdgcn_s_setprio(1); _Pragma("unroll") for (int m = 0; m < 4; ++m) _Pragma("unroll") for (int n = 0; n < 2; ++n) _Pragma("unroll") for (int k = 0; k < 2; ++k) \
        acc[ai][bj][m][n] = __builtin_amdgcn_mfma_f32_16x16x32_bf16(Bt[n][k], At[m][k], acc[ai][bj][m][n], 0, 0, 0); __builtin_amdgcn_s_setprio(0); } while (0)
#define PG8_WAIT_V(n) asm volatile("s_waitcnt vmcnt(" #n ")" ::: "memory")
#define PG8_WAIT_L(n) asm volatile("s_waitcnt lgkmcnt(" #n ")" ::: "memory")
#define PG8_BAR __builtin_amdgcn_s_barrier()
#define PG8_SCHED __builtin_amdgcn_sched_barrier(0)
    Unit cur, nxt; int ui = 0;
    if (!S.next(0, cur)) return;
    f32x4 acc[2][2][4][2];
#pragma unroll
    for (int a = 0; a < 2; ++a)
#pragma unroll
        for (int b = 0; b < 2; ++b)
#pragma unroll
            for (int m = 0; m < 4; ++m)
#pragma unroll
                for (int n = 0; n < 2; ++n) acc[a][b][m][n] = (f32x4){0.f, 0.f, 0.f, 0.f};
    bf16x8 At[4][2], B0[2][2], B1[2][2];
    const char* cA = (const char*)g.A + (size_t)cur.pm * tstep; const char* cB = (const char*)g.Bt + (size_t)cur.pn * tstep;
    S.a_ready(cur);
    if constexpr (SP2) {
        PG8_STAGE(PG8_SB(0, 0), cB, voffB); PG8_STAGE(PG8_SB(0, 1), cB + hstep, voffB); PG8_STAGE(PG8_SA(0, 0), cA, voffA); PG8_STAGE(PG8_SA(0, 1), cA + hstep, voffA);
        if (wr == 1) PG8_BAR;
        PG8_WAIT_V(2); PG8_BAR;
        PG8_STAGE(PG8_SB(1, 0), cB + kstep, voffB); PG8_STAGE(PG8_SA(1, 0), cA + kstep, voffA); PG8_STAGE(PG8_SB(1, 1), cB + hstep + kstep, voffB);
        PG8_WAIT_V(6); PG8_BAR;
    } else {
        PG8_STAGE(PG8_SB(0, 0), cB, voffB); PG8_STAGE(PG8_SA(0, 0), cA, voffA); PG8_STAGE(PG8_SB(0, 1), cB + hstep, voffB); PG8_STAGE(PG8_SA(0, 1), cA + hstep, voffA);
        if (wr == 1) PG8_BAR;
        PG8_WAIT_V(4); PG8_BAR;
        PG8_STAGE(PG8_SB(1, 0), cB + kstep, voffB); PG8_STAGE(PG8_SA(1, 0), cA + kstep, voffA); PG8_STAGE(PG8_SB(1, 1), cB + hstep + kstep, voffB);
        PG8_WAIT_V(6); PG8_BAR;
    }
    for (;;) {
        const bool has_next = S.next(ui + 1, nxt);
        const char* nA = has_next ? (const char*)g.A + (size_t)nxt.pm * tstep : cA; const char* nB = has_next ? (const char*)g.Bt + (size_t)nxt.pn * tstep : cB;
        for (int t = 0; t < nt; t += 2) {
            const bool last = (t == nt - 2);
            const char* a1 = cA + (size_t)(t + 1) * kstep;
            const char* a2 = last ? nA : cA + (size_t)(t + 2) * kstep; const char* b2 = last ? nB : cB + (size_t)(t + 2) * kstep;
            const char* a3 = a2 + kstep; const char* b3 = b2 + kstep;
            if (last && has_next) S.a_ready(nxt);
            if constexpr (SP2) {
            PG8_LDB(B0, 0, 0); PG8_LDB(B1, 0, 1); PG8_SCHED; PG8_LDA(At, 0, 0); PG8_STAGE(PG8_SA(1, 1), a1 + hstep, voffA);
            PG8_WAIT_V(8); PG8_WAIT_L(0); PG8_BAR; PG8_MMA(0, 0, At, B0); PG8_MMA(0, 1, At, B1); PG8_BAR; PG8_SCHED;
            PG8_LDA(At, 0, 1); PG8_STAGE(PG8_SB(0, 0), b2, voffB); PG8_STAGE(PG8_SB(0, 1), b2 + hstep, voffB); PG8_STAGE(PG8_SA(0, 0), a2, voffA);
            PG8_WAIT_V(8); PG8_WAIT_L(0); PG8_BAR; PG8_MMA(1, 0, At, B0); PG8_MMA(1, 1, At, B1); PG8_BAR; PG8_SCHED;
            PG8_LDB(B0, 1, 0); PG8_LDB(B1, 1, 1); PG8_SCHED; PG8_LDA(At, 1, 0); PG8_STAGE(PG8_SA(0, 1), a2 + hstep, voffA);
            PG8_WAIT_V(8); PG8_WAIT_L(0); PG8_BAR; PG8_MMA(0, 0, At, B0); PG8_MMA(0, 1, At, B1); PG8_BAR; PG8_SCHED;
            PG8_LDA(At, 1, 1); PG8_STAGE(PG8_SB(1, 0), b3, voffB); PG8_STAGE(PG8_SB(1, 1), b3 + hstep, voffB); PG8_STAGE(PG8_SA(1, 0), a3, voffA);
            PG8_WAIT_V(8); PG8_WAIT_L(0); PG8_BAR; PG8_MMA(1, 0, At, B0); PG8_MMA(1, 1, At, B1); PG8_BAR; PG8_SCHED;
            } else {
            PG8_LDB(B0, 0, 0); PG8_SCHED; PG8_LDA(At, 0, 0); PG8_STAGE(PG8_SA(1, 1), a1 + hstep, voffA);
            PG8_WAIT_L(8); PG8_BAR; PG8_WAIT_L(0); PG8_MMA(0, 0, At, B0); PG8_BAR; PG8_SCHED;
            PG8_LDB(B1, 0, 1); PG8_STAGE(PG8_SB(0, 0), b2, voffB);
            PG8_BAR; PG8_WAIT_L(0); PG8_MMA(0, 1, At, B1); PG8_BAR;
            PG8_LDA(At, 0, 1); PG8_STAGE(PG8_SA(0, 0), a2, voffA);
            PG8_BAR; PG8_WAIT_L(0); PG8_MMA(1, 0, At, B0); PG8_BAR; PG8_SCHED;
            PG8_STAGE(PG8_SB(0, 1), b2 + hstep, voffB);
            PG8_WAIT_V(6); PG8_BAR; PG8_MMA(1, 1, At, B1); PG8_BAR;
            PG8_LDB(B0, 1, 0); PG8_SCHED; PG8_LDA(At, 1, 0); PG8_STAGE(PG8_SA(0, 1), a2 + hstep, voffA);
            PG8_WAIT_L(8); PG8_BAR; PG8_WAIT_L(0); PG8_MMA(0, 0, At, B0); PG8_BAR; PG8_SCHED;
            PG8_LDB(B1, 1, 1); PG8_STAGE(PG8_SB(1, 0), b3, voffB);
            PG8_BAR; PG8_WAIT_L(0); PG8_MMA(0, 1, At, B1); PG8_BAR;
            PG8_LDA(At, 1, 1); PG8_STAGE(PG8_SA(1, 0), a3, voffA);
            PG8_BAR; PG8_WAIT_L(0); PG8_MMA(1, 0, At, B0); PG8_BAR; PG8_SCHED;
            PG8_STAGE(PG8_SB(1, 1), b3 + hstep, voffB);
            PG8_WAIT_V(6); PG8_BAR; PG8_MMA(1, 1, At, B1); PG8_BAR;
            }
        }
        if constexpr (ALIGN_EPI) { if (wr == 0) PG8_BAR; }
        if constexpr (!Epi::AFTER_DRAIN) { E(acc, cur, wr, wc, fr, fq); S.done(cur); }
        if (!has_next) break;
#pragma unroll
        for (int a = 0; a < 2; ++a)
#pragma unroll
            for (int b = 0; b < 2; ++b)
#pragma unroll
                for (int m = 0; m < 4; ++m)
#pragma unroll
                    for (int n = 0; n < 2; ++n) acc[a][b][m][n] = (f32x4){0.f, 0.f, 0.f, 0.f};
        cur = nxt; cA = nA; cB = nB; ++ui;
        if constexpr (ALIGN_EPI) { if (wr == 1) PG8_BAR; }
    }
    PG8_WAIT_V(0);
    if constexpr (!ALIGN_EPI) { if (wr == 0) PG8_BAR; }
    PG8_BAR;
    if constexpr (Epi::AFTER_DRAIN) { E.fused(acc, cur, wr, wc, fr, fq, lds, wid, lane); S.done(cur); }
#undef PG8_SA
#undef PG8_SB
#undef PG8_STAGE
#undef PG8_LDA
#undef PG8_LDB
#undef PG8_MMA
#undef PG8_WAIT_V
#undef PG8_WAIT_L
#undef PG8_BAR
#undef PG8_SCHED
}
}
namespace att {
typedef unsigned short bf16_t;
typedef short bf16x8 __attribute__((ext_vector_type(8)));
typedef short s16x4 __attribute__((ext_vector_type(4)));
typedef float f32x16 __attribute__((ext_vector_type(16)));
typedef float f32x4 __attribute__((ext_vector_type(4)));
typedef unsigned u32x4 __attribute__((ext_vector_type(4)));
#define ALAS __attribute__((address_space(3)))
#define ASBAR() __builtin_amdgcn_sched_barrier(0)
constexpr int SHM_V = 16384;
template <int DK> struct Lay { static constexpr int ROWB = DK * 2, SHM_K = 64 * ROWB, OFF_K = 2 * SHM_V, OFF_F = OFF_K + 2 * SHM_K, OFF_WS = OFF_F + 512, TOTAL = OFF_WS + 8 * 256; };

__device__ __forceinline__ int v_st(int k, int c) { const int kk = (k & ~0xC) | ((k & 4) << 1) | ((k & 8) >> 1); return ((kk >> 3) * 4 + (c >> 5)) * 512 + ((kk & 7) * 32 + (c & 31)) * 2; }
__device__ __forceinline__ int v_rd_base(int lane) { return ((lane & 3) << 3) | (((lane >> 2) & 3) << 6) | (((lane >> 4) & 1) << 5) | (((lane >> 5) & 1) << 8); }
__device__ __forceinline__ int crow(int r, int hi) { return (r & 3) + 8 * (r >> 2) + 4 * hi; }
typedef float cvtpk_f32x2 __attribute__((ext_vector_type(2))); typedef __bf16 cvtpk_bf16x2 __attribute__((ext_vector_type(2)));
__device__ __forceinline__ unsigned cvtpk(float lo, float hi) { const cvtpk_f32x2 v = {lo, hi}; const cvtpk_bf16x2 b = __builtin_convertvector(v, cvtpk_bf16x2); return __builtin_bit_cast(unsigned, b); }

__device__ __forceinline__ float wave_max_f(float v) {
#pragma unroll
    for (int o = 32; o >= 1; o >>= 1) v = fmaxf(v, __shfl_xor(v, o));
    return v;
}
__device__ __forceinline__ float att_max3(float a, float b, float c) { return __builtin_fmaxf(__builtin_fmaxf(a, b), c); }
template <int DK, bool FOX>
__device__ __forceinline__ void attn_block(unsigned char* smem, const bf16_t* __restrict__ Q, int ldq, const bf16_t* __restrict__ K, int ldk, const bf16_t* __restrict__ V, int ldv,
                                           const float* __restrict__ Fh, const bf16_t* __restrict__ gate, bf16_t* __restrict__ gout  , int qbk, const float* __restrict__ gq, const float* __restrict__ gk  ,
                                           const float* __restrict__ side_u, const float* __restrict__ side_v, unsigned char* __restrict__ side_u8, unsigned char* __restrict__ side_v8, int& side_next) {
    typedef Lay<DK> LY;
    constexpr int ND = DK / 16, NKC = DK / 8, NKI = (64 * NKC) / 512;
    int tid = threadIdx.x; asm volatile("" : "+v"(tid));
    const int wid = __builtin_amdgcn_readfirstlane(tid >> 6), lane = tid & 63, r32 = lane & 31, hi = lane >> 5;
    const int q0 = qbk * 256, qlo = q0 + wid * 32, qm = qlo + r32 - 4 * hi;
    const int NT = 4 * qbk + 4;
    ALAS unsigned char* lds = (ALAS unsigned char*)smem;
    ALAS float* F_lds = (ALAS float*)(lds + LY::OFF_F);
    ALAS float* wsl = (ALAS float*)(lds + LY::OFF_WS) + wid * 64;
    bf16x8 qr[ND];
#pragma unroll
    for (int d0 = 0; d0 < ND; ++d0) qr[d0] = *(const bf16x8*)(Q + (size_t)(qlo + r32) * ldq + d0 * 16 + hi * 8);
    const float fq = FOX ? Fh[qlo + r32] : 0.f;
    int kgo[NKI], vgo[2];
#pragma unroll
    for (int i = 0; i < NKI; ++i) { const int pp = (wid * NKI + i) * 64 + lane, row = pp / NKC, cpos = pp % NKC, ch = cpos ^ ((row >> 1) & 7); kgo[i] = row * ldk + ch * 8; }
#pragma unroll
    for (int i = 0; i < 2; ++i) { const int o = ((wid * 2 + i) * 64 + lane) * 16, st = o >> 9, e = (o & 511) >> 1, kk = (st >> 2) * 8 + (e >> 5), c = (st & 3) * 32 + (e & 31);
        const int k = (kk & ~0xC) | ((kk & 4) << 1) | ((kk & 8) >> 1); vgo[i] = k * ldv + c; }
    const int vb0 = (int)(uintptr_t)smem + v_rd_base(lane);
    int kbase[4];
#pragma unroll
    for (int dd = 0; dd < 4; ++dd) kbase[dd] = LY::OFF_K + r32 * LY::ROWB + (((((dd << 1) | hi) ^ ((r32 >> 1) & 7))) << 4);
    float stf = 0.f;
#define ATT_GLDS(kb, bf) do { _Pragma("unroll") for (int i = 0; i < NKI; ++i) \
            __builtin_amdgcn_global_load_lds((const unsigned*)(K + (size_t)(kb) * ldk + kgo[i]), (ALAS unsigned*)(lds + LY::OFF_K + (bf) * LY::SHM_K + (wid * NKI + i) * 1024), 16, 0, 0); \
        _Pragma("unroll") for (int i = 0; i < 2; ++i) \
            __builtin_amdgcn_global_load_lds((const unsigned*)(V + (size_t)(kb) * ldv + vgo[i]), (ALAS unsigned*)(lds + (bf) * SHM_V + (wid * 2 + i) * 1024), 16, 0, 0); \
        if (FOX && tid < 64) stf = Fh[(kb) + tid]; } while (0)
#define ATT_WRITEF(bf) do { if (FOX && tid < 64) F_lds[(bf) * 64 + tid] = stf; } while (0)
    int t_start = 0; float m_init = 0.f;
    if (FOX) {
        const float gqm = wave_max_f(fmaxf(fabsf(gq[lane]), fabsf(gq[lane + 64]))), gkm = wave_max_f(fmaxf(fabsf(gk[lane]), fabsf(gk[lane + 64])));
        const float qk_bound = 0.12751743f * 128.f * gqm * gkm;
        const float thr = 2.02f * qk_bound + 40.f, f0 = Fh[q0]; m_init = -thr;
        const int j0 = lane, j1 = lane + 64;
        const bool c0 = (j0 < 4 * qbk) && (Fh[j0 * 64 + 63] - f0 >= thr), c1 = (j1 < 4 * qbk) && (Fh[(j1 < 4 * qbk ? j1 : 0) * 64 + 63] - f0 >= thr);
        t_start = __builtin_popcountll(__ballot(c0)) + __builtin_popcountll(__ballot(c1));
        t_start = __builtin_amdgcn_readfirstlane(t_start); }
    ATT_GLDS(t_start * 64, t_start & 1); ATT_WRITEF(t_start & 1);
    float m_reg = FOX ? m_init : 0.f, l_reg = 0.f; f32x16 o[4];
#pragma unroll
    for (int d = 0; d < 4; ++d)
#pragma unroll
        for (int r = 0; r < 16; ++r) o[d][r] = 0.f;
    for (int t = t_start; t < NT; ++t) {
        const int buf = t & 1, kb = t * 64;
        asm volatile("s_waitcnt vmcnt(0)" ::: "memory");
        __syncthreads();
        if (t + 1 < NT) ATT_GLDS(kb + 64, buf ^ 1);
        const bool side = side_next < 64; f32x4 sd0, sd1; size_t sd_off = 0;
        if (side) { const bool isv = side_next >= 32; sd_off = ((size_t)(blockIdx.x * 32 + (side_next & 31)) * 512 + tid) * 8;
            const float* sp = (isv ? side_v : side_u) + sd_off; sd0 = *(const f32x4*)sp; sd1 = *(const f32x4*)(sp + 4); }
        f32x16 p0, p1;
        if (FOX) { const float fqm = fq - m_reg;
#pragma unroll
            for (int g = 0; g < 4; ++g) { const f32x4 f0 = *(const ALAS f32x4*)(F_lds + buf * 64 + 8 * g + 4 * hi), f1 = *(const ALAS f32x4*)(F_lds + buf * 64 + 32 + 8 * g + 4 * hi);
#pragma unroll
                for (int e = 0; e < 4; ++e) { p0[4 * g + e] = fqm - f0[e]; p1[4 * g + e] = fqm - f1[e]; } }
        } else { const float nm = -m_reg;
#pragma unroll
            for (int r = 0; r < 16; ++r) { p0[r] = nm; p1[r] = nm; }
        }
        __builtin_amdgcn_s_setprio(1);
#pragma unroll
        for (int d0 = 0; d0 < ND; ++d0) {
            ALAS const unsigned char* a = lds + buf * LY::SHM_K + kbase[d0 & 3] + (d0 >> 2) * 128;
            const bf16x8 b0 = *(const ALAS bf16x8*)a;
            const bf16x8 b1 = *(const ALAS bf16x8*)(a + 32 * LY::ROWB);
            p0 = __builtin_amdgcn_mfma_f32_32x32x16_bf16(b0, qr[d0], p0, 0, 0, 0);
            p1 = __builtin_amdgcn_mfma_f32_32x32x16_bf16(b1, qr[d0], p1, 0, 0, 0);
        }
        __builtin_amdgcn_s_setprio(0);
        if (kb + 63 > qlo) {
            const float NEG = -__builtin_inff(); const int dq = qm - kb;
#pragma unroll
            for (int r = 0; r < 16; ++r) { const int c = (r & 3) + 8 * (r >> 2); if (dq - c < 0) p0[r] = NEG; if (dq - c - 32 < 0) p1[r] = NEG; }
        }
        float pmax;
        { float a = att_max3(p0[0], p0[1], p1[0]), b = att_max3(p0[2], p0[3], p1[1]); a = att_max3(a, p1[2], p1[3]);
#pragma unroll
          for (int r = 4; r < 16; r += 4) { a = att_max3(a, p0[r], p0[r + 1]); b = att_max3(b, p0[r + 2], p0[r + 3]); a = att_max3(a, p1[r], p1[r + 1]); b = att_max3(b, p1[r + 2], p1[r + 3]); }
          pmax = fmaxf(a, b); }
        { auto rr = __builtin_amdgcn_permlane32_swap(__float_as_uint(pmax), __float_as_uint(pmax), false, false);
          pmax = fmaxf(__uint_as_float(rr[0]), __uint_as_float(rr[1])); }
        float alpha = 1.f;
        if (!__builtin_expect(__all(pmax <= 8.f), 1)) { const float dm = fmaxf(pmax, 0.f); alpha = __builtin_amdgcn_exp2f(-dm); m_reg += dm;
#pragma unroll
            for (int r = 0; r < 16; ++r) { p0[r] -= dm; p1[r] -= dm; } }
        float ps = 0.f;
#pragma unroll
        for (int r = 0; r < 16; ++r) { p0[r] = __builtin_amdgcn_exp2f(p0[r]); ps += p0[r]; }
#pragma unroll
        for (int r = 0; r < 16; ++r) { p1[r] = __builtin_amdgcn_exp2f(p1[r]); ps += p1[r]; }
        { auto rr = __builtin_amdgcn_permlane32_swap(__float_as_uint(ps), __float_as_uint(ps), false, false);
          ps = __uint_as_float(rr[0]) + __uint_as_float(rr[1]); }
        l_reg = l_reg * alpha + ps;
        bf16x8 pa0, pa1, pa2, pa3;
#define ATT_PK4(P, B_, OUT) do { unsigned a0 = cvtpk(P[B_+0], P[B_+1]), a1 = cvtpk(P[B_+2], P[B_+3]); unsigned b0_ = cvtpk(P[B_+4], P[B_+5]), b1_ = cvtpk(P[B_+6], P[B_+7]); \
        auto r0 = __builtin_amdgcn_permlane32_swap(a0, b0_, false, false); auto r1 = __builtin_amdgcn_permlane32_swap(a1, b1_, false, false); \
        u32x4 w = {r0[0], r1[0], r0[1], r1[1]}; OUT = *reinterpret_cast<bf16x8*>(&w); } while (0)
        ATT_PK4(p0, 0, pa0); ATT_PK4(p0, 8, pa1); ATT_PK4(p1, 0, pa2); ATT_PK4(p1, 8, pa3);
        if (__any(alpha < 1.f)) {
            if (hi == 0) wsl[r32] = alpha;
            asm volatile("s_waitcnt lgkmcnt(0)" ::: "memory");
#pragma unroll
            for (int g = 0; g < 4; ++g) { const f32x4 al = *(const ALAS f32x4*)(wsl + 8 * g + 4 * hi);
#pragma unroll
                for (int d = 0; d < 4; ++d)
#pragma unroll
                    for (int e = 0; e < 4; ++e) o[d][4 * g + e] *= al[e]; }
        }
#define ATT_TRRD(dst, off) asm volatile("ds_read_b64_tr_b16 %0, %1 offset:%2" : "=&v"(dst) : "v"(vbb), "i"(off) : "memory")
#define ATT_PV(d0) do { s16x4 l0, l1, l2, l3, h0, h1, h2, h3; constexpr int b_ = (d0) * 512; \
        ATT_TRRD(l0, b_); ATT_TRRD(h0, b_ + 2048); ATT_TRRD(l1, b_ + 4096); ATT_TRRD(h1, b_ + 6144); ATT_TRRD(l2, b_ + 8192); ATT_TRRD(h2, b_ + 10240); ATT_TRRD(l3, b_ + 12288); ATT_TRRD(h3, b_ + 14336); \
        asm volatile("s_waitcnt lgkmcnt(0)" ::: "memory"); ASBAR(); \
        o[d0] = __builtin_amdgcn_mfma_f32_32x32x16_bf16(pa0, (bf16x8){l0[0], l0[1], l0[2], l0[3], h0[0], h0[1], h0[2], h0[3]}, o[d0], 0, 0, 0); \
        o[d0] = __builtin_amdgcn_mfma_f32_32x32x16_bf16(pa1, (bf16x8){l1[0], l1[1], l1[2], l1[3], h1[0], h1[1], h1[2], h1[3]}, o[d0], 0, 0, 0); \
        o[d0] = __builtin_amdgcn_mfma_f32_32x32x16_bf16(pa2, (bf16x8){l2[0], l2[1], l2[2], l2[3], h2[0], h2[1], h2[2], h2[3]}, o[d0], 0, 0, 0); \
        o[d0] = __builtin_amdgcn_mfma_f32_32x32x16_bf16(pa3, (bf16x8){l3[0], l3[1], l3[2], l3[3], h3[0], h3[1], h3[2], h3[3]}, o[d0], 0, 0, 0); } while (0)
        { const int vbb = vb0 + buf * SHM_V; __builtin_amdgcn_s_setprio(1); ATT_PV(0); ATT_PV(1); ATT_PV(2); ATT_PV(3); __builtin_amdgcn_s_setprio(0); }
        if (t + 1 < NT) ATT_WRITEF(buf ^ 1);
        if (side) { const bool isv = side_next >= 32; const float sc = isv ? 4.f : 64.f;
            auto pk = [](float a, float b, float c, float d) { int w = __builtin_amdgcn_cvt_pk_fp8_f32(fminf(fmaxf(a, -448.f), 448.f), fminf(fmaxf(b, -448.f), 448.f), 0, false);
                return (unsigned)__builtin_amdgcn_cvt_pk_fp8_f32(fminf(fmaxf(c, -448.f), 448.f), fminf(fmaxf(d, -448.f), 448.f), w, true); };
            uint2 o; o.x = pk(sd0[0] * sc, sd0[1] * sc, sd0[2] * sc, sd0[3] * sc); o.y = pk(sd1[0] * sc, sd1[1] * sc, sd1[2] * sc, sd1[3] * sc);
            *(uint2*)((isv ? side_v8 : side_u8) + sd_off) = o; ++side_next; }
    }
    if (hi == 0) wsl[r32] = l_reg;
    asm volatile("s_waitcnt lgkmcnt(0)" ::: "memory");
#pragma unroll
    for (int r = 0; r < 16; ++r) {
        const int orow = crow(r, hi); const float rli = __builtin_amdgcn_rcpf(wsl[orow]);
        bf16_t* rowp = gout + (size_t)(qlo + orow) * 4096; const bf16_t* growp = gate + (size_t)(qlo + orow) * 4096;
#pragma unroll
        for (int d0 = 0; d0 < 4; ++d0) {
            const float v = o[d0][r] * rli; const float vn = __shfl_xor(v, 1);
            if ((r32 & 1) == 0) { unsigned* gp = (unsigned*)(rowp + d0 * 32 + r32); const unsigned g = *(const unsigned*)(growp + d0 * 32 + r32);
                *gp = cvtpk(v * __uint_as_float(g << 16), vn * __uint_as_float(g & 0xffff0000u)); }
        }
    }
    __syncthreads();
#undef ATT_GLDS
#undef ATT_WRITEF
#undef ATT_PK4
#undef ATT_TRRD
#undef ATT_PV
}
}
using pg8::bf16_t; using pg8::f32x4; using pg8::u32x4;
#define LAS __attribute__((address_space(3)))
constexpr int S = 8192, DM = 2048, INW = 11344, INWP = 11520;
constexpr float EPS = 1e-6f;
constexpr size_t MiB = 1u << 20;

__device__ __forceinline__ float bf2f(bf16_t v) { return __uint_as_float(((unsigned)v) << 16); }
__device__ __forceinline__ bf16_t f2bf(float f) { unsigned u = __float_as_uint(f); u += 0x7fffu + ((u >> 16) & 1u); return (bf16_t)(u >> 16); }
__device__ __forceinline__ unsigned pk2(float lo, float hi) { return (unsigned)f2bf(lo) | ((unsigned)f2bf(hi) << 16); }
__device__ __forceinline__ float wave_sum(float v) {
#pragma unroll
    for (int o = 32; o >= 1; o >>= 1) v += __shfl_xor(v, o);
    return v;
}
__device__ __forceinline__ float wave_max(float v) {
#pragma unroll
    for (int o = 32; o >= 1; o >>= 1) v = fmaxf(v, __shfl_xor(v, o));
    return v;
}

__device__ __forceinline__ int opaque_tid() { int t = threadIdx.x; asm volatile("" : "+v"(t)); return t; }

struct Params {
    const float* x; const int* pos; const float *mix_g, *w_in, *b_forget, *b_gate, *q_lat_g, *w_q_up, *kv_lat_g, *w_kv_up, *mla_qg, *mla_kg, *fox_qg, *fox_kg, *w_out, *ffn_g, *w_peer_q, *sub_keys, *peer_u, *peer_v;
    float* out;
    bf16_t *WqT, *WkvT, *WoT, *WpT, *WinT;
    bf16_t *h, *cq, *ckv, *fq, *fk, *fv, *merged, *kpe, *qa, *va, *ka;
    float *lf, *F, *x1, *scores;
    unsigned char *U8, *V8; bf16_t* attout;
    unsigned* ctl;
    float2* ropeT; float* ssq; float* ssq2; bf16_t* xg;
};

struct DstId { __device__ __forceinline__ int operator()(int n) const { return n; } };
struct DstWin { __device__ __forceinline__ int operator()(int n) const {
    if (n < 1024) return n; if (n < 1088) { const int r = n - 1024; return 11264 + 2 * (r & 31) + (r >> 5); } if (n < 7232) return n - 64; if (n < 7248) return 11264 + 64 + (n - 7232); return n - 80; } };
struct DstQ { __device__ __forceinline__ int operator()(int n) const {
    const int h = n / 192, d = n - h * 192; if (d < 128) return h * 256 + d; const int r = d - 128; return h * 256 + 128 + 2 * (r & 31) + (r >> 5); } };
template <class Dst>
__device__ __forceinline__ void transpose_item(const float* __restrict__ W, int K, int N, bf16_t* __restrict__ WT, Dst dst, float* scr, int item, int lane, const float* __restrict__ gk = nullptr) {
    const int nblk = (N + 31) / 32, kb = item / nblk, nb = item % nblk, k0 = 64 * kb, n0 = 32 * nb;
    { const int rr = lane >> 3, c4 = (lane & 7) * 4; const bool ok = (n0 + c4) < N;
      f32x4 v[8];
#pragma unroll
      for (int i = 0; i < 8; ++i) v[i] = ok ? *(const f32x4*)(W + (size_t)(k0 + 8 * i + rr) * N + n0 + c4) : (f32x4){0.f, 0.f, 0.f, 0.f};
      if (gk) {
#pragma unroll
          for (int i = 0; i < 8; ++i) v[i] *= gk[k0 + 8 * i + rr]; }
#pragma unroll
      for (int i = 0; i < 8; ++i) { float* sp = scr + (8 * i + rr) * 33 + c4; sp[0] = v[i][0]; sp[1] = v[i][1]; sp[2] = v[i][2]; sp[3] = v[i][3]; } }
    asm volatile("s_waitcnt lgkmcnt(0)" ::: "memory");
    const int c = lane & 7;
#pragma unroll
    for (int j = 0; j < 4; ++j) { const int nl = (lane >> 3) + 8 * j, n = n0 + nl; const float* s = scr + (8 * c) * 33 + nl;
        u32x4 o; o.x = pk2(s[0 * 33], s[1 * 33]); o.y = pk2(s[2 * 33], s[3 * 33]); o.z = pk2(s[4 * 33], s[5 * 33]); o.w = pk2(s[6 * 33], s[7 * 33]);
        if (n < N) *(u32x4*)(WT + (size_t)dst(n) * K + k0 + 8 * c) = o; }
    asm volatile("s_waitcnt lgkmcnt(0)" ::: "memory");
}
__device__ __forceinline__ void wfold_item(const float* __restrict__ wq, const float* __restrict__ keys, bf16_t* __restrict__ WpT, float* sm, int item) {
    const int tid = opaque_tid(), hc = item >> 5, d0 = (item & 31) * 64;
    float* keysL = sm; float* wqL = sm + 128 * 132;
    for (int idx = tid; idx < 128 * 32; idx += 512) { const int r = idx >> 5, c4 = (idx & 31) * 4; *(f32x4*)(keysL + r * 132 + c4) = *(const f32x4*)(keys + (size_t)hc * 16384 + r * 128 + c4); }
    for (int idx = tid; idx < 64 * 32; idx += 512) { const int r = idx >> 5, c4 = (idx & 31) * 4; *(f32x4*)(wqL + r * 132 + c4) = *(const f32x4*)(wq + (size_t)(d0 + r) * 2048 + hc * 128 + c4); }
    __syncthreads();
    const int n2 = (tid & 63) * 2, dg = tid >> 6;
    float acc[2][8];
#pragma unroll
    for (int a = 0; a < 2; ++a)
#pragma unroll
        for (int i = 0; i < 8; ++i) acc[a][i] = 0.f;
#pragma unroll 2
    for (int j4 = 0; j4 < 32; ++j4) {
        const f32x4 k0v = *(const f32x4*)(keysL + n2 * 132 + 4 * j4), k1v = *(const f32x4*)(keysL + (n2 + 1) * 132 + 4 * j4);
#pragma unroll
        for (int i = 0; i < 8; ++i) { const f32x4 w = *(const f32x4*)(wqL + (dg * 8 + i) * 132 + 4 * j4);
            acc[0][i] += (k0v[0] * w[0] + k0v[1] * w[1]) + (k0v[2] * w[2] + k0v[3] * w[3]);
            acc[1][i] += (k1v[0] * w[0] + k1v[1] * w[1]) + (k1v[2] * w[2] + k1v[3] * w[3]); }
    }
#pragma unroll
    for (int a = 0; a < 2; ++a) { u32x4 o; o.x = pk2(acc[a][0], acc[a][1]); o.y = pk2(acc[a][2], acc[a][3]); o.z = pk2(acc[a][4], acc[a][5]); o.w = pk2(acc[a][6], acc[a][7]);
        *(u32x4*)(WpT + (size_t)(hc * 128 + n2 + a) * 2048 + d0 + dg * 8) = o; }
    __syncthreads();
}
__device__ __forceinline__ void rms_row2048(const float* __restrict__ xr, const float* __restrict__ g, bf16_t* __restrict__ orow, int lane) {
    f32x4 v[8]; float ss = 0.f;
#pragma unroll
    for (int j = 0; j < 8; ++j) { v[j] = *(const f32x4*)(xr + j * 256 + lane * 4); ss += (v[j][0] * v[j][0] + v[j][1] * v[j][1]) + (v[j][2] * v[j][2] + v[j][3] * v[j][3]); }
    const float r = rsqrtf(wave_sum(ss) * (1.f / 2048.f) + EPS);
#pragma unroll
    for (int j = 0; j < 8; ++j) { const f32x4 gg = *(const f32x4*)(g + j * 256 + lane * 4);
        uint2 o; o.x = pk2(v[j][0] * r * gg[0], v[j][1] * r * gg[1]); o.y = pk2(v[j][2] * r * gg[2], v[j][3] * r * gg[3]);
        *(uint2*)(orow + j * 256 + lane * 4) = o; }
}
__device__ __forceinline__ void fox_cumsum(double* part, int h, const float* __restrict__ lf, float* __restrict__ F) {
    const int tid = opaque_tid(), lane = tid & 63, wave = tid >> 6;
    float v[16]; double sum = 0.0;
#pragma unroll
    for (int i = 0; i < 16; ++i) { v[i] = lf[(size_t)(tid * 16 + i) * 16 + h]; sum += (double)v[i]; }
    double inc = sum;
#pragma unroll
    for (int o = 1; o < 64; o <<= 1) { const double n = __shfl_up(inc, o); if (lane >= o) inc += n; }
    if (lane == 63) part[wave] = inc;
    __syncthreads();
    double base = 0.0;
    for (int w = 0; w < wave; ++w) base += part[w];
    double run = base + inc - sum;
#pragma unroll
    for (int i = 0; i < 16; ++i) { run += (double)v[i]; F[(size_t)h * S + tid * 16 + i] = (float)(run * 1.4426950408889634); }
    __syncthreads();
}
__device__ __forceinline__ void rope_table(const int* __restrict__ pos, float2* __restrict__ ropeT, int gtid, int nthreads) {
    for (int idx = gtid; idx < S * 32; idx += nthreads) { const int t = idx >> 5, i = idx & 31;
        const double inv = exp(-(double)i * (1.0 / 32.0) * 9.210340371976184);
        double ang = (double)((float)pos[t] * (float)inv);
        const double twopi = 6.283185307179586;
        ang -= twopi * rint(ang / twopi);
        ropeT[idx] = make_float2(cosf((float)ang), sinf((float)ang)); }
}
typedef float f32x2 __attribute__((ext_vector_type(2)));
__device__ __forceinline__ unsigned pk4_fp8(float a, float b, float c, float d) {
    int w = __builtin_amdgcn_cvt_pk_fp8_f32(fminf(fmaxf(a, -448.f), 448.f), fminf(fmaxf(b, -448.f), 448.f), 0, false);
    w = __builtin_amdgcn_cvt_pk_fp8_f32(fminf(fmaxf(c, -448.f), 448.f), fminf(fmaxf(d, -448.f), 448.f), w, true); return (unsigned)w; }
__device__ __forceinline__ void cvt_rows_fp8(const float* __restrict__ src, unsigned char* __restrict__ dst, size_t n, float scale, int gw, int NGW, int lane) {
    const size_t nchunk = n / 1024;
    for (size_t c = gw; c < nchunk; c += NGW) { const size_t o = c * 1024 + lane * 16;
        f32x4 a[4];
#pragma unroll
        for (int q = 0; q < 4; ++q) a[q] = *(const f32x4*)(src + o + 4 * q) * scale;
        u32x4 w; w.x = pk4_fp8(a[0][0], a[0][1], a[0][2], a[0][3]); w.y = pk4_fp8(a[1][0], a[1][1], a[1][2], a[1][3]);
        w.z = pk4_fp8(a[2][0], a[2][1], a[2][2], a[2][3]); w.w = pk4_fp8(a[3][0], a[3][1], a[3][2], a[3][3]);
        *(u32x4*)(dst + o) = w; }
}
constexpr float U_SCALE = 64.f, V_SCALE = 4.f;
typedef __bf16 bf16x2_t __attribute__((ext_vector_type(2)));
__device__ __forceinline__ float dot2bf(unsigned a, unsigned b, float c) { return __builtin_amdgcn_fdot2_f32_bf16(__builtin_bit_cast(bf16x2_t, a), __builtin_bit_cast(bf16x2_t, b), c, false); }
#define PEER_INS(top, x) do { float x_ = (x); _Pragma("unroll") for (int i_ = 0; i_ < 16; ++i_) { const float hi_ = fmaxf(top[i_], x_); x_ = fminf(top[i_], x_); top[i_] = hi_; } } while (0)
__device__ __forceinline__ void peer_group(unsigned char* smem, int g, const float* __restrict__ scores, const bf16_t* __restrict__ h2  , const float* __restrict__ ssq2, const float* __restrict__ x1,
                                           const unsigned char* __restrict__ U8, const unsigned char* __restrict__ V8, float* __restrict__ out) {
    const int tid = opaque_tid(), lane = tid & 63, wave = __builtin_amdgcn_readfirstlane(tid >> 6);
    float* topL = (float*)smem;
    int* selE = (int*)(smem + 32768);
    float* selG = (float*)(smem + 49152);
    {
        const int tl = tid >> 4, hc = tid & 15;
        const float* sp = scores + (size_t)(g * 32 + tl) * 2048 + hc * 128;
        float top[16];
#pragma unroll
        for (int i = 0; i < 16; ++i) top[i] = -INFINITY;
#pragma unroll 2
        for (int n0 = 0; n0 < 128; n0 += 4) { const f32x4 v = *(const f32x4*)(sp + n0);
#pragma unroll
            for (int e = 0; e < 4; ++e) PEER_INS(top, __uint_as_float((__float_as_uint(v[e]) & ~0x7Fu) | (unsigned)(n0 + e))); }
        float* tp = topL + (tl * 16 + hc) * 16;
#pragma unroll
        for (int i = 0; i < 16; i += 4) *(f32x4*)(tp + i) = (f32x4){top[i], top[i + 1], top[i + 2], top[i + 3]};
    }
    __syncthreads();
    if (tid < 256) {
        const int tl = tid >> 3, h = tid & 7;
        const float* t1 = topL + (tl * 16 + 2 * h) * 16; const float* t2 = t1 + 16;
        float s1[16], s2[16];
#pragma unroll
        for (int i = 0; i < 16; i += 4) { const f32x4 a = *(const f32x4*)(t1 + i), b2 = *(const f32x4*)(t2 + i);
            s1[i] = a[0]; s1[i + 1] = a[1]; s1[i + 2] = a[2]; s1[i + 3] = a[3]; s2[i] = b2[0]; s2[i + 1] = b2[1]; s2[i + 2] = b2[2]; s2[i + 3] = b2[3]; }
        float ts[16];
#pragma unroll
        for (int i = 0; i < 16; ++i) ts[i] = -INFINITY;
#pragma unroll
        for (int i = 0; i < 16; ++i)
#pragma unroll
            for (int j = 0; j < 16; ++j)
                if ((i + 1) * (j + 1) <= 16) PEER_INS(ts, __uint_as_float((__float_as_uint(s1[i] + s2[j]) & ~0xFFu) | (unsigned)(i * 16 + j)));
        float ex[16], sum = 0.f;
#pragma unroll
        for (int k = 0; k < 16; ++k) { ex[k] = __expf(ts[k] - ts[0]); sum += ex[k]; }
        const float inv = 1.f / sum;
#pragma unroll
        for (int k = 0; k < 16; ++k) { const unsigned pos = __float_as_uint(ts[k]) & 0xFFu;
            const int i1 = (int)(__float_as_uint(t1[pos >> 4]) & 0x7Fu), i2 = (int)(__float_as_uint(t2[pos & 15]) & 0x7Fu);
            selE[tl * 128 + h * 16 + k] = i1 * 128 + i2; selG[tl * 128 + h * 16 + k] = ex[k] * inv; }
    }
    __syncthreads();
    const int grp = lane >> 4, l16 = lane & 15, tl = wave * 4 + grp;
    unsigned* sortK = (unsigned*)(smem + 65536) + tl * 128;
    float* wS = (float*)(smem + 81920) + tl * 128;
    unsigned* hist = (unsigned*)(smem + 98304) + wave * 512 + grp * 64;
    {
#pragma unroll
        for (int i = 0; i < 4; ++i) hist[l16 * 4 + i] = 0u;
        asm volatile("s_waitcnt lgkmcnt(0)" ::: "memory");
        unsigned ek[8], rk[8];
#pragma unroll
        for (int j = 0; j < 8; ++j) { ek[j] = (unsigned)selE[tl * 128 + l16 + 16 * j]; rk[j] = atomicAdd(&hist[ek[j] >> 8], 1u); }
        asm volatile("s_waitcnt lgkmcnt(0)" ::: "memory");
        unsigned c[4], tot = 0u;
#pragma unroll
        for (int i = 0; i < 4; ++i) { c[i] = hist[l16 * 4 + i]; tot += c[i]; }
        unsigned inc = tot;
#pragma unroll
        for (int o = 1; o < 16; o <<= 1) { const unsigned n = __shfl_up(inc, o, 16); if (l16 >= o) inc += n; }
        unsigned run = inc - tot;
#pragma unroll
        for (int i = 0; i < 4; ++i) { hist[256 + l16 * 4 + i] = run; run += c[i]; }
        asm volatile("s_waitcnt lgkmcnt(0)" ::: "memory");
#pragma unroll
        for (int j = 0; j < 8; ++j) sortK[hist[256 + (ek[j] >> 8)] + rk[j]] = (ek[j] << 7) | (unsigned)(l16 + 16 * j);
    }
    __syncthreads();
    const size_t tok = (size_t)g * 32 + tl;
    float rinv_tok;
    { float t = 0.f; if (l16 < 8) { const f32x4 a = *(const f32x4*)(ssq2 + ((size_t)l16 * 8192 + tok) * 4); t = (a[0] + a[1]) + (a[2] + a[3]); }
      t += __shfl_xor(t, 8); t += __shfl_xor(t, 4); t += __shfl_xor(t, 2); t += __shfl_xor(t, 1); rinv_tok = rsqrtf(t * (1.f / 2048.f) + 1e-6f); }
#pragma unroll 1
    for (int hf = 0; hf < 2; ++hf) {
        f32x2 hp[32];
#pragma unroll
        for (int j = 0; j < 4; ++j)
#pragma unroll
            for (int q = 0; q < 2; ++q) { const u32x4 w = *(const u32x4*)(h2 + tok * DM + hf * 1024 + j * 256 + l16 * 16 + q * 8);
#pragma unroll
                for (int c = 0; c < 4; ++c) hp[j * 8 + q * 4 + c] = (f32x2){__uint_as_float(w[c] << 16), __uint_as_float(w[c] & 0xffff0000u)}; }
        for (int it = 0; it < 128; it += 4) {
            if ((it & 7) == 0 && it) __syncthreads();
            unsigned key[4]; u32x4 ur[4][4];
#pragma unroll
            for (int p = 0; p < 4; ++p) { key[p] = sortK[it + p];
#pragma unroll
                for (int j = 0; j < 4; ++j) ur[p][j] = *(const u32x4*)(U8 + (size_t)(key[p] >> 7) * DM + hf * 1024 + j * 256 + l16 * 16); }
#pragma unroll
            for (int p = 0; p < 4; ++p) { f32x2 a2 = (f32x2){0.f, 0.f}, b2 = (f32x2){0.f, 0.f};
#pragma unroll
                for (int j = 0; j < 4; ++j)
#pragma unroll
                    for (int c = 0; c < 4; ++c) { const int w = (int)ur[p][j][c];
                        a2 = __builtin_elementwise_fma(hp[j * 8 + 2 * c], __builtin_amdgcn_cvt_pk_f32_fp8(w, false), a2);
                        b2 = __builtin_elementwise_fma(hp[j * 8 + 2 * c + 1], __builtin_amdgcn_cvt_pk_f32_fp8(w, true), b2); }
                float d = (a2.x + a2.y) + (b2.x + b2.y);
                d += __shfl_xor(d, 8); d += __shfl_xor(d, 4); d += __shfl_xor(d, 2); d += __shfl_xor(d, 1);
                if (hf == 0) { if (l16 == 0) wS[it + p] = d; }
                else { const float a = (wS[it + p] + d) * (rinv_tok * (1.f / U_SCALE));
                    const float w = selG[tl * 128 + (key[p] & 127u)] * 0.5f * a * (1.f + erff(a * 0.70710678118654752f)) * (1.f / V_SCALE);
                    if (l16 == 0) wS[it + p] = w; } }
        }
        __syncthreads();
    }
#pragma unroll 1
    for (int hf = 0; hf < 2; ++hf) {
        f32x2 acc[32];
#pragma unroll
        for (int c = 0; c < 32; ++c) acc[c] = (f32x2){0.f, 0.f};
        for (int it = 0; it < 128; it += 4) {
            if ((it & 7) == 0 && it) __syncthreads();
            unsigned key[4]; u32x4 vr[4][4];
#pragma unroll
            for (int p = 0; p < 4; ++p) { key[p] = sortK[it + p];
#pragma unroll
                for (int j = 0; j < 4; ++j) vr[p][j] = *(const u32x4*)(V8 + (size_t)(key[p] >> 7) * DM + hf * 1024 + j * 256 + l16 * 16); }
#pragma unroll
            for (int p = 0; p < 4; ++p) { const float w = wS[it + p]; const f32x2 w2 = (f32x2){w, w};
#pragma unroll
                for (int j = 0; j < 4; ++j)
#pragma unroll
                    for (int c = 0; c < 4; ++c) { const int x = (int)vr[p][j][c];
                        acc[j * 8 + 2 * c] = __builtin_elementwise_fma(w2, __builtin_amdgcn_cvt_pk_f32_fp8(x, false), acc[j * 8 + 2 * c]);
                        acc[j * 8 + 2 * c + 1] = __builtin_elementwise_fma(w2, __builtin_amdgcn_cvt_pk_f32_fp8(x, true), acc[j * 8 + 2 * c + 1]); } }
        }
#pragma unroll
        for (int j = 0; j < 4; ++j)
#pragma unroll
            for (int q = 0; q < 4; ++q) { const size_t o = tok * DM + hf * 1024 + j * 256 + l16 * 16 + q * 4;
                const f32x4 a = *(const f32x4*)(x1 + o);
                *(f32x4*)(out + o) = (f32x4){a[0] + acc[j * 8 + 2 * q].x, a[1] + acc[j * 8 + 2 * q].y, a[2] + acc[j * 8 + 2 * q + 1].x, a[3] + acc[j * 8 + 2 * q + 1].y}; }
        __syncthreads();
    }
    __syncthreads();
}

#define XB_TMO      128
#define XB_XCNT(j)  (256  + 64 * (j))
#define XB_XSUB(j)  (1280 + 64 * (j))
#define XB_XGEN(j)  (2304 + 64 * (j))
#define XB_TOP      3328
#define XB_TOPGEN   3392
#define XCD_BAR_WORDS 3456
#define XB_SPIN_CAP (1u << 18)

__device__ __forceinline__ unsigned xb_ld(unsigned* p)              { return __hip_atomic_load(p, __ATOMIC_RELAXED, __HIP_MEMORY_SCOPE_AGENT); }
__device__ __forceinline__ unsigned xb_add(unsigned* p, unsigned v) { return __hip_atomic_fetch_add(p, v, __ATOMIC_RELAXED, __HIP_MEMORY_SCOPE_AGENT); }
__device__ __forceinline__ unsigned xb_xcc_id() { return (unsigned)__builtin_amdgcn_s_getreg((3 << 11) | 20) & 0xFu; }
#define XB_SPIN(cond, bar) do { unsigned _sp = 0; while (cond) { __builtin_amdgcn_s_sleep(1); \
    if ((++_sp & 255u) == 0u) { if (xb_ld(&(bar)[XB_TMO])) break; if (_sp > XB_SPIN_CAP) { atomicAdd(&(bar)[XB_TMO], 1u); break; } } } } while (0)

struct XcdBarrier {
    unsigned* bar; unsigned x;
    volatile LAS unsigned* st;
};

__device__ __forceinline__ XcdBarrier xcd_barrier_post(unsigned* bar, volatile LAS unsigned* st) {
    XcdBarrier b; b.bar = bar; b.x = xb_xcc_id(); b.st = st;
    if (threadIdx.x == 0) (void)xb_add(&bar[XB_XCNT(b.x)], 1u);
    return b;
}
__device__ __forceinline__ void xcd_barrier_complete(unsigned* bar, unsigned x, unsigned& nloc, unsigned& nx) {
    const unsigned G = gridDim.x * gridDim.y * gridDim.z;
    unsigned sum, cnt, mine, sp = 0u;
    for (;;) {
        sum = 0u; cnt = 0u; mine = 0u;
#pragma unroll
        for (unsigned j = 0; j < 16; ++j) { const unsigned c = xb_ld(&bar[XB_XCNT(j)]); sum += c; cnt += (c > 0u) ? 1u : 0u; mine = (j == x) ? c : mine; }
        if (sum == G) break;
        __builtin_amdgcn_s_sleep(1);
        if ((++sp & 255u) == 0u) { if (xb_ld(&bar[XB_TMO])) break; if (sp > XB_SPIN_CAP) { atomicAdd(&bar[XB_TMO], 1u); break; } }
    }
    nloc = mine > 0u ? mine : 1u; nx = cnt > 0u ? cnt : 1u;
}

__device__ __forceinline__ void xcd_barrier(const XcdBarrier& b) {
    asm volatile("s_waitcnt vmcnt(0)" ::: "memory");
    __syncthreads();
    if (threadIdx.x == 0) {
        unsigned* bar = b.bar;
        __builtin_amdgcn_s_waitcnt(0);
        unsigned nloc = b.st[0], nx = b.st[1];
        if (nloc == 0u) { xcd_barrier_complete(bar, b.x, nloc, nx); b.st[0] = nloc; b.st[1] = nx; }
        const unsigned old = xb_add(&bar[XB_XSUB(b.x)], 1u);
        const unsigned gen = old / nloc;
        if (old + 1u == (gen + 1u) * nloc) {
            __builtin_amdgcn_fence(__ATOMIC_RELEASE, "agent");
            asm volatile("s_waitcnt vmcnt(0)" ::: "memory");
            const unsigned og = xb_add(&bar[XB_TOP], 1u);
            const unsigned tg = og / nx;
            if (og + 1u == (tg + 1u) * nx) xb_add(&bar[XB_TOPGEN], 1u);
            else XB_SPIN(xb_ld(&bar[XB_TOPGEN]) == tg, bar);
            __builtin_amdgcn_fence(__ATOMIC_ACQUIRE, "agent");
            xb_add(&bar[XB_XGEN(b.x)], 1u);
            asm volatile("s_waitcnt vmcnt(0)" ::: "memory");
        } else {
            XB_SPIN(xb_ld(&bar[XB_XGEN(b.x)]) == gen, bar);
            __builtin_amdgcn_fence(__ATOMIC_ACQUIRE, "agent");
            asm volatile("s_waitcnt vmcnt(0)" ::: "memory");
        }
    }
    __syncthreads();
}

#define PROBE_DOUBLE 0
#define REP(k) for (int rep_ = 0; rep_ < ((PROBE_DOUBLE == (k)) ? 2 : 1); ++rep_)
constexpr int LDS_BYTES = 147456;
__global__ __launch_bounds__(512, 2) void mega(Params p) {
    extern __shared__ __attribute__((aligned(16))) unsigned char smem[];
    { volatile LAS unsigned* st0 = (volatile LAS unsigned*)((LAS unsigned char*)smem + 131072); if (threadIdx.x < 2) st0[threadIdx.x] = 0u; }
    __syncthreads();
    const XcdBarrier bar = xcd_barrier_post(p.ctl, (volatile LAS unsigned*)((LAS unsigned char*)smem + 131072));
    float* smf = (float*)smem;
    LAS unsigned char* lds = (LAS unsigned char*)smem;
    const int G = gridDim.x, b = blockIdx.x, NGW = G * 8;
#define PHASE_IDS() const int tid = opaque_tid(), lane = tid & 63, wave = __builtin_amdgcn_readfirstlane(tid >> 6), gw = b * 8 + wave; (void)lane; (void)gw

    REP(7) {
        PHASE_IDS();
        float* scr = smf + wave * 4096;
        constexpr int dummy_ = 0; (void)dummy_;
        constexpr int I_IN = 32 * 355, I_Q = 8 * 96, I_KV = 8 * 128, I_O = 64 * 64;
        for (int it = gw; it < I_IN + I_Q + I_KV + I_O; it += NGW) {
            int r = it;
            if (r < I_IN) { transpose_item(p.w_in, 2048, INW, p.WinT, DstWin(), scr, r, lane); continue; } r -= I_IN;
            if (r < I_Q) { transpose_item(p.w_q_up, 512, 3072, p.WqT, DstQ(), scr, r, lane, p.q_lat_g); continue; } r -= I_Q;
            if (r < I_KV) { transpose_item(p.w_kv_up, 512, 4096, p.WkvT, DstId(), scr, r, lane, p.kv_lat_g); continue; } r -= I_KV;
            transpose_item(p.w_out, 4096, 2048, p.WoT, DstId(), scr, r, lane);
        }
        for (int m = gw; m < S; m += NGW) rms_row2048(p.x + (size_t)m * DM, p.mix_g, p.h + (size_t)m * DM, lane);
        for (int idx = b * 512 + tid; idx < 16 * 64 * 64; idx += G * 512) { const int hh = idx >> 12, rr = (idx >> 6) & 63, c8 = idx & 63;
            *(u32x4*)(p.WqT + (size_t)(hh * 256 + 192 + rr) * 512 + c8 * 8) = (u32x4){0u, 0u, 0u, 0u}; }
        rope_table(p.pos, p.ropeT, b * 512 + tid, G * 512);
        __syncthreads();
        for (int it = b; it < 512; it += G) wfold_item(p.w_peer_q, p.sub_keys, p.WpT, smf, it);
    }
    xcd_barrier(bar);
    REP(1) {
        pg8::Gemm g{p.h, p.WinT, S, INWP, DM}; pg8::StaticOrder so; so.init(S, INWP, G, b);
        pg8::EpiInProj E{p.cq, p.ckv, p.fq, p.fk, p.fv, p.merged, p.kpe, p.lf, p.b_gate, p.b_forget, p.ssq, p.fox_qg, p.fox_kg, (LAS float*)(lds + 131072 + 64)};
        pg8::gemm_phase<pg8::EpiInProj, pg8::StaticOrder, true, true>(lds, g, so, E);
    }
    xcd_barrier(bar);
    for (int hh = b; hh < 16; hh += G) fox_cumsum((double*)smem, hh, p.lf, p.F);
    REP(2) {
        pg8::Gemm g{p.cq, p.WqT, S, 4096, 512}; pg8::StaticOrder so; so.init(S, 4096, G, b);
        pg8::EpiQ E{p.qa, p.ssq, p.mla_qg, p.ropeT, (LAS float*)(lds + 131072 + 64)};
        pg8::gemm_phase<pg8::EpiQ, pg8::StaticOrder, true, true>(lds, g, so, E);
    }
    {
        pg8::Gemm g{p.ckv, p.WkvT, S, 4096, 512}; pg8::StaticOrder so; so.init(S, 4096, G, b);
        pg8::EpiKV E{p.ka, p.va, p.kpe, p.ssq, p.mla_kg, p.ropeT, (LAS float*)(lds + 131072 + 64)};
        pg8::gemm_phase<pg8::EpiKV, pg8::StaticOrder, true, true>(lds, g, so, E);
    }
    xcd_barrier(bar);
    int side_next = 0;
    REP(3) for (int L = b; L < 1024; L += G) {
        const int i = L >> 8, vc = L & 255, vcx = (vc & 7) * 32 + (vc >> 3), hh = vcx >> 4, x = vcx & 15, qbk = (i & 1) ? x : 31 - x;
        if (i < 2) att::attn_block<192, false>(smem, p.qa + hh * 192, 3072, p.ka + hh * 192, 3072, p.va + hh * 128, 2048, nullptr, p.merged + hh * 128, p.attout + hh * 128, qbk, nullptr, nullptr, p.peer_u, p.peer_v, p.U8, p.V8, side_next);
        else att::attn_block<128, true>(smem, p.fq + hh * 128, 2048, p.fk + hh * 128, 2048, p.fv + hh * 128, 2048, p.F + (size_t)hh * S, p.merged + 2048 + hh * 128, p.attout + 2048 + hh * 128, qbk, p.fox_qg, p.fox_kg, p.peer_u, p.peer_v, p.U8, p.V8, side_next);
    }
    if (G == 256) { PHASE_IDS(); (void)wave;
        for (; side_next < 64; ++side_next) { const bool isv = side_next >= 32; const size_t off = ((size_t)(b * 32 + (side_next & 31)) * 512 + tid) * 8;
            const float* sp = (isv ? p.peer_v : p.peer_u) + off; const float sc = isv ? V_SCALE : U_SCALE; const f32x4 a0 = *(const f32x4*)sp * sc, a1 = *(const f32x4*)(sp + 4) * sc;
            uint2 o; o.x = pk4_fp8(a0[0], a0[1], a0[2], a0[3]); o.y = pk4_fp8(a1[0], a1[1], a1[2], a1[3]); *(uint2*)((isv ? p.V8 : p.U8) + off) = o; } }
    else { PHASE_IDS(); cvt_rows_fp8(p.peer_u, p.U8, (size_t)16384 * 2048, U_SCALE, gw, NGW, lane); cvt_rows_fp8(p.peer_v, p.V8, (size_t)16384 * 2048, V_SCALE, gw, NGW, lane); }
    xcd_barrier(bar);
    REP(4) {
        pg8::Gemm g{p.attout, p.WoT, S, 2048, 4096}; pg8::StaticOrder so; so.init(S, 2048, G, b);
        pg8::EpiX1 E{p.x1, p.x, p.xg, p.ffn_g, p.ssq2};
        pg8::gemm_phase<pg8::EpiX1, pg8::StaticOrder, true, true>(lds, g, so, E);
    }
    xcd_barrier(bar);
    REP(5) {
        pg8::Gemm g{p.xg, p.WpT, S, 2048, 2048}; pg8::StaticOrder so; so.init(S, 2048, G, b);
        pg8::EpiScores E{p.scores, p.ssq2};
        pg8::gemm_phase<pg8::EpiScores, pg8::StaticOrder, true, true>(lds, g, so, E);
    }
    xcd_barrier(bar);
    REP(6) for (int g = b; g < S / 32; g += G) peer_group(smem, g, p.scores, p.xg, p.ssq2, p.x1, p.U8, p.V8, p.out);
}

extern "C" void kernel_launch(void* const* d_in, const int* in_sizes, int n_in,
                              void* d_out, int out_size, void* d_ws, size_t ws_size,
                              hipStream_t stream) {
    if (ws_size < 512 * MiB) { fprintf(stderr, "kernel_launch: workspace too small (%zu)\n", ws_size); return; }
    Params p{};
    p.x = (const float*)d_in[0]; p.pos = (const int*)d_in[1]; p.mix_g = (const float*)d_in[2]; p.w_in = (const float*)d_in[3];
    p.b_forget = (const float*)d_in[4]; p.b_gate = (const float*)d_in[5]; p.q_lat_g = (const float*)d_in[6]; p.w_q_up = (const float*)d_in[7];
    p.kv_lat_g = (const float*)d_in[8]; p.w_kv_up = (const float*)d_in[9]; p.mla_qg = (const float*)d_in[10]; p.mla_kg = (const float*)d_in[11];
    p.fox_qg = (const float*)d_in[12]; p.fox_kg = (const float*)d_in[13]; p.w_out = (const float*)d_in[14]; p.ffn_g = (const float*)d_in[15];
    p.w_peer_q = (const float*)d_in[16]; p.sub_keys = (const float*)d_in[17]; p.peer_u = (const float*)d_in[18]; p.peer_v = (const float*)d_in[19];
    p.out = (float*)d_out;
    char* ws = (char*)d_ws;
    p.WqT = (bf16_t*)(ws + 1 * MiB); p.WkvT = (bf16_t*)(ws + 5 * MiB); p.WoT = (bf16_t*)(ws + 9 * MiB); p.WpT = (bf16_t*)(ws + 25 * MiB); p.WinT = (bf16_t*)(ws + 33 * MiB);
    p.h = (bf16_t*)(ws + 78 * MiB); p.cq = (bf16_t*)(ws + 110 * MiB); p.ckv = (bf16_t*)(ws + 118 * MiB);
    p.fq = (bf16_t*)(ws + 126 * MiB); p.fk = (bf16_t*)(ws + 158 * MiB); p.fv = (bf16_t*)(ws + 190 * MiB); p.merged = (bf16_t*)(ws + 222 * MiB);
    p.kpe = (bf16_t*)(ws + 286 * MiB); p.lf = (float*)(ws + 287 * MiB); p.F = (float*)(ws + 287 * MiB + 512 * 1024);
    p.qa = (bf16_t*)(ws + 288 * MiB); p.va = (bf16_t*)(ws + 336 * MiB); p.ka = (bf16_t*)(ws + 400 * MiB); p.x1 = (float*)(ws + 126 * MiB);
    p.scores = (float*)(ws + 222 * MiB);
    p.ctl = (unsigned*)ws;
    p.ropeT = (float2*)(ws + 448 * MiB);
    p.ssq = (float*)(ws + 64 * 1024);
    p.attout = (bf16_t*)(ws + 33 * MiB);
    p.U8 = (unsigned char*)(ws + 450 * MiB); p.V8 = (unsigned char*)(ws + 368 * MiB);
    p.xg = (bf16_t*)(ws + 190 * MiB);
    p.ssq2 = (float*)(ws + 482 * MiB);

    static int grid_blocks = 0;
    if (!grid_blocks) {
        if (hipFuncSetAttribute((const void*)mega, hipFuncAttributeMaxDynamicSharedMemorySize, LDS_BYTES) != hipSuccess) { fprintf(stderr, "hipFuncSetAttribute failed\n"); return; }
        int dev = 0, cus = 0, per_cu = 0;
        (void)hipGetDevice(&dev);
        (void)hipDeviceGetAttribute(&cus, hipDeviceAttributeMultiprocessorCount, dev);
        (void)hipOccupancyMaxActiveBlocksPerMultiprocessor(&per_cu, (const void*)mega, 512, LDS_BYTES);
        if (per_cu < 1 || cus < 1) { fprintf(stderr, "occupancy query says %d blocks/CU on %d CUs\n", per_cu, cus); return; }
        grid_blocks = cus;
    }
    if (hipMemsetAsync(d_ws, 0, 16384, stream) != hipSuccess) { fprintf(stderr, "memset of the barrier words failed\n"); return; }
    void* args[] = {&p};
    hipError_t e = hipLaunchCooperativeKernel((const void*)mega, dim3(grid_blocks), dim3(512), args, LDS_BYTES, stream);
    if (e != hipSuccess) fprintf(stderr, "cooperative launch failed: %s (grid %d)\n", hipGetErrorString(e), grid_blocks);
}
```

```cpp
#include <hip/hip_runtime.h>
#include <hip/hip_cooperative_groups.h>
#include <stdint.h>
#include <math.h>
#include <cstdio>
namespace cg = cooperative_groups;

namespace pg8 {
#define PG8_LAS __attribute__((address_space(3)))
typedef unsigned short bf16_t;
typedef short bf16x8 __attribute__((ext_vector_type(8)));
typedef float f32x4 __attribute__((ext_vector_type(4)));
typedef unsigned u32x4 __attribute__((ext_vector_type(4)));
constexpr int BM = 256, BK = 64, HALF = 128, HTB = HALF * BK * 2  , STAGE_BYTES = 8 * HTB, NXCD = 8, WGM = 8;

__host__ __device__ __forceinline__ int lds_byte(int r, int c) { const int st = (r >> 4) * 2 + (c >> 5), rr = r & 15, cc = c & 31, ob = rr * 64 + cc * 2; return st * 1024 + (ob ^ (((ob >> 9) & 1) << 5)); }
__host__ __device__ __forceinline__ void stage_rc(int b, int& R, int& C) { const int st = b / 1024, sb = b % 1024, swz = sb ^ (((sb >> 9) & 1) << 5); R = (st >> 1) * 16 + swz / 64; C = (st & 1) * 32 + (swz % 64) / 2; }
__host__ __device__ __forceinline__ int perm32(int rho) { const int n = rho >> 4, i = rho & 15; return 8 * (i >> 2) + 4 * n + (i & 3); }

struct Unit { int pm, pn; };
struct Gemm { const bf16_t* A; const bf16_t* Bt; int M, N, K; };

struct StaticOrder {
    int nM, nN, nwg, G, c;
    __host__ __device__ void init(int M, int N, int G_, int c_) { nM = M / BM; nN = N / BM; nwg = nM * nN; G = G_; c = c_; }
    __host__ __device__ bool next(int i, Unit& u) const {
        const long L = (long)i * G + c; if (L >= nwg) return false;
        int wgid = (int)L; { const int q = nwg / NXCD, r = nwg % NXCD, xcd = wgid % NXCD, off = wgid / NXCD; wgid = (xcd < r ? xcd * (q + 1) : r * (q + 1) + (xcd - r) * q) + off; }
        const int nig = WGM * nN, gid = wgid / nig, fm = gid * WGM, gsz = (nM - fm) < WGM ? (nM - fm) : WGM;
        u.pm = fm + ((wgid % nig) % gsz); u.pn = (wgid % nig) / gsz; return true;
    }
    __device__ __forceinline__ void a_ready(const Unit&) const {}
    __device__ __forceinline__ void done(const Unit&) const {}
};

typedef float cvt_pk_bf16_f32x2 __attribute__((ext_vector_type(2))); typedef __bf16 cvt_pk_bf16_bf16x2 __attribute__((ext_vector_type(2)));
__device__ __forceinline__ unsigned cvt_pk_bf16(float lo, float hi) { const cvt_pk_bf16_f32x2 v = {lo, hi}; const cvt_pk_bf16_bf16x2 b = __builtin_convertvector(v, cvt_pk_bf16_bf16x2); return __builtin_bit_cast(unsigned, b); }
__device__ __forceinline__ u32x4 pack8bf(const f32x4& v0, const f32x4& v1) { u32x4 w; w.x = cvt_pk_bf16(v0[0], v0[1]); w.y = cvt_pk_bf16(v0[2], v0[3]); w.z = cvt_pk_bf16(v1[0], v1[1]); w.w = cvt_pk_bf16(v1[2], v1[3]); return w; }

struct EpiStoreBf16 {
    static constexpr bool PERM = true, AFTER_DRAIN = false;
    bf16_t* O; int ldc;
    __device__ __forceinline__ void operator()(const f32x4 (&acc)[2][2][4][2], const Unit& u, int wr, int wc, int fr, int fq) const {
        const int row0 = u.pm * BM + wr * 64 + fr, col0 = u.pn * BM + wc * 32 + 8 * fq;
#pragma unroll
        for (int ai = 0; ai < 2; ++ai)
#pragma unroll
            for (int m = 0; m < 4; ++m) { bf16_t* rowp = O + (size_t)(row0 + ai * HALF + m * 16) * ldc + col0;
#pragma unroll
                for (int bj = 0; bj < 2; ++bj) *(u32x4*)(rowp + bj * HALF) = pack8bf(acc[ai][bj][m][0], acc[ai][bj][m][1]); }
    }
};
template <bool RES> struct EpiStoreF32 {
    static constexpr bool PERM = true, AFTER_DRAIN = false;
    float* O; const float* res; int ldc;
    __device__ __forceinline__ void operator()(const f32x4 (&acc)[2][2][4][2], const Unit& u, int wr, int wc, int fr, int fq) const {
        const int row0 = u.pm * BM + wr * 64 + fr, col0 = u.pn * BM + wc * 32 + 8 * fq;
#pragma unroll
        for (int ai = 0; ai < 2; ++ai)
#pragma unroll
            for (int m = 0; m < 4; ++m) { const size_t off = (size_t)(row0 + ai * HALF + m * 16) * ldc + col0;
#pragma unroll
                for (int bj = 0; bj < 2; ++bj) { f32x4 v0 = acc[ai][bj][m][0], v1 = acc[ai][bj][m][1];
                    if (RES) { v0 += *(const f32x4*)(res + off + bj * HALF); v1 += *(const f32x4*)(res + off + bj * HALF + 4); }
                    *(f32x4*)(O + off + bj * HALF) = v0; *(f32x4*)(O + off + bj * HALF + 4) = v1; } }
    }
};
#define EPI_LDSBAR() do { asm volatile("s_waitcnt lgkmcnt(0)" ::: "memory"); __builtin_amdgcn_s_barrier(); asm volatile("" ::: "memory"); } while (0)
struct EpiInProj {
    static constexpr bool PERM = true, AFTER_DRAIN = false;
    bf16_t *cq, *ckv, *fq, *fk, *fv, *gates, *kpe; float* lf; const float *b_gate, *b_forget; float* ssq; const float *gfq, *gfk; PG8_LAS float* xs;
    __device__ __forceinline__ void operator()(const f32x4 (&acc)[2][2][4][2], const Unit& u, int wr, int wc, int fr, int fq_) const {
        const int pn = u.pn, row0 = u.pm * BM + wr * 64 + fr, cw = wc * 32 + 8 * fq_;
        if (pn < 4) {
            bf16_t* base = pn < 2 ? cq : ckv; const int colt = (pn & 1) * 256;
#pragma unroll
            for (int ai = 0; ai < 2; ++ai)
#pragma unroll
                for (int m = 0; m < 4; ++m) { const int row = row0 + ai * HALF + m * 16; bf16_t* rowp = base + (size_t)row * 512 + colt + cw; float s = 0.f;
#pragma unroll
                    for (int bj = 0; bj < 2; ++bj) { const f32x4 v0 = acc[ai][bj][m][0], v1 = acc[ai][bj][m][1];
                        s += (v0[0] * v0[0] + v0[1] * v0[1]) + (v0[2] * v0[2] + v0[3] * v0[3]) + (v1[0] * v1[0] + v1[1] * v1[1]) + (v1[2] * v1[2] + v1[3] * v1[3]);
                        *(u32x4*)(rowp + bj * HALF) = pack8bf(v0, v1); }
                    s += __shfl_xor(s, 16); s += __shfl_xor(s, 32);
                    if (fq_ == 0) ssq[((size_t)pn * 8192 + row) * 4 + wc] = s; }
        } else if (pn < 20) {
            const bool isq = pn < 12; bf16_t* base = isq ? fq : fk; const int colt = (pn - (isq ? 4 : 12)) * 256; const float* g = isq ? gfq : gfk;
            const float qs = isq ? 0.12751743f : 1.f;
#pragma unroll
            for (int ai = 0; ai < 2; ++ai)
#pragma unroll
                for (int m = 0; m < 4; ++m)
#pragma unroll
                    for (int bj = 0; bj < 2; ++bj) { const f32x4 v0 = acc[ai][bj][m][0], v1 = acc[ai][bj][m][1];
                        float s = (v0[0] * v0[0] + v0[1] * v0[1]) + (v0[2] * v0[2] + v0[3] * v0[3]) + (v1[0] * v1[0] + v1[1] * v1[1]) + (v1[2] * v1[2] + v1[3] * v1[3]);
                        s += __shfl_xor(s, 16); s += __shfl_xor(s, 32);
                        if (fq_ == 0) xs[((ai * HALF + wr * 64 + m * 16 + fr) * 2 + bj) * 4 + wc] = s; }
            EPI_LDSBAR();
            const f32x4 g0 = *(const f32x4*)(g + cw) * qs, g1 = *(const f32x4*)(g + cw + 4) * qs;
#pragma unroll
            for (int ai = 0; ai < 2; ++ai)
#pragma unroll
                for (int m = 0; m < 4; ++m) { bf16_t* rowp = base + (size_t)(row0 + ai * HALF + m * 16) * 2048 + colt + cw;
#pragma unroll
                    for (int bj = 0; bj < 2; ++bj) { const f32x4 t4 = *(const PG8_LAS f32x4*)(xs + ((ai * HALF + wr * 64 + m * 16 + fr) * 2 + bj) * 4);
                        const float r = rsqrtf(((t4[0] + t4[1]) + (t4[2] + t4[3])) * (1.f / 128.f) + 1e-6f);
                        *(u32x4*)(rowp + bj * HALF) = pack8bf(acc[ai][bj][m][0] * g0 * r, acc[ai][bj][m][1] * g1 * r); } }
        } else if (pn < 28) {
            const int colt = (pn - 20) * 256;
#pragma unroll
            for (int ai = 0; ai < 2; ++ai)
#pragma unroll
                for (int m = 0; m < 4; ++m) { bf16_t* rowp = fv + (size_t)(row0 + ai * HALF + m * 16) * 2048 + colt + cw;
#pragma unroll
                    for (int bj = 0; bj < 2; ++bj) *(u32x4*)(rowp + bj * HALF) = pack8bf(acc[ai][bj][m][0], acc[ai][bj][m][1]); }
        } else if (pn < 44) {
            const int colt = (pn - 28) * 256 + cw;
#pragma unroll
            for (int bj = 0; bj < 2; ++bj) {
                const f32x4 b0 = *(const f32x4*)(b_gate + colt + bj * HALF), b1 = *(const f32x4*)(b_gate + colt + bj * HALF + 4);
#pragma unroll
                for (int ai = 0; ai < 2; ++ai)
#pragma unroll
                    for (int m = 0; m < 4; ++m) {
                        f32x4 v0 = acc[ai][bj][m][0] + b0, v1 = acc[ai][bj][m][1] + b1;
#pragma unroll
                        for (int e = 0; e < 4; ++e) { v0[e] = __builtin_amdgcn_rcpf(1.f + __expf(-v0[e])); v1[e] = __builtin_amdgcn_rcpf(1.f + __expf(-v1[e])); }
                        *(u32x4*)(gates + (size_t)(row0 + ai * HALF + m * 16) * 4096 + colt + bj * HALF) = pack8bf(v0, v1); }
            }
        } else {
            if (cw < 64) {
#pragma unroll
                for (int ai = 0; ai < 2; ++ai)
#pragma unroll
                    for (int m = 0; m < 4; ++m) *(u32x4*)(kpe + (size_t)(row0 + ai * HALF + m * 16) * 64 + cw) = pack8bf(acc[ai][0][m][0], acc[ai][0][m][1]);
            } else if (cw < 80) {
                const int h0 = cw - 64;
                const f32x4 b0 = *(const f32x4*)(b_forget + h0), b1 = *(const f32x4*)(b_forget + h0 + 4);
#pragma unroll
                for (int ai = 0; ai < 2; ++ai)
#pragma unroll
                    for (int m = 0; m < 4; ++m) { const int row = row0 + ai * HALF + m * 16;
                        f32x4 z0 = acc[ai][0][m][0] + b0, z1 = acc[ai][0][m][1] + b1;
#pragma unroll
                        for (int e = 0; e < 4; ++e) { z0[e] = fminf(z0[e], 0.f) - __logf(1.f + __expf(-fabsf(z0[e]))); z1[e] = fminf(z1[e], 0.f) - __logf(1.f + __expf(-fabsf(z1[e]))); }
                        *(f32x4*)(lf + (size_t)row * 16 + h0) = z0; *(f32x4*)(lf + (size_t)row * 16 + h0 + 4) = z1; }
            }
        }
    }
};
__device__ __forceinline__ float lat_rinv(const float* ssq, int part0, int row) {
    const f32x4 a = *(const f32x4*)(ssq + ((size_t)part0 * 8192 + row) * 4), b = *(const f32x4*)(ssq + ((size_t)(part0 + 1) * 8192 + row) * 4);
    return rsqrtf((((a[0] + a[1]) + (a[2] + a[3])) + ((b[0] + b[1]) + (b[2] + b[3]))) * (1.f / 512.f) + 1e-6f);
}
struct EpiQ {
    static constexpr bool PERM = true, AFTER_DRAIN = false;
    bf16_t* qa; const float* ssq; const float* gq; const float2* ropeT; PG8_LAS float* xs;
    __device__ __forceinline__ void operator()(const f32x4 (&acc)[2][2][4][2], const Unit& u, int wr, int wc, int fr, int fq_) const {
        const int h = u.pn, row0 = u.pm * BM + wr * 64 + fr, cw = wc * 32 + 8 * fq_;
        float rl[2][4];
#pragma unroll
        for (int ai = 0; ai < 2; ++ai)
#pragma unroll
            for (int m = 0; m < 4; ++m) { rl[ai][m] = lat_rinv(ssq, 0, row0 + ai * HALF + m * 16); float s = 0.f;
#pragma unroll
                for (int bj = 0; bj < 2; ++bj) { const f32x4 v0 = acc[ai][bj][m][0], v1 = acc[ai][bj][m][1];
                    s += (v0[0] * v0[0] + v0[1] * v0[1]) + (v0[2] * v0[2] + v0[3] * v0[3]) + (v1[0] * v1[0] + v1[1] * v1[1]) + (v1[2] * v1[2] + v1[3] * v1[3]); }
                s *= rl[ai][m] * rl[ai][m];
                s += __shfl_xor(s, 16); s += __shfl_xor(s, 32);
                if (fq_ == 0) xs[(ai * HALF + wr * 64 + m * 16 + fr) * 4 + wc] = s; }
        EPI_LDSBAR();
        const float qs = 0.10411754f;
        const f32x4 g0 = *(const f32x4*)(gq + cw) * qs, g1 = *(const f32x4*)(gq + cw + 4) * qs;
        const int pp = 16 * (wc & 1) + 4 * fq_;
        const f32x4 ga = *(const f32x4*)(gq + 128 + pp) * qs, gb = *(const f32x4*)(gq + 160 + pp) * qs;
#pragma unroll
        for (int ai = 0; ai < 2; ++ai)
#pragma unroll
            for (int m = 0; m < 4; ++m) { const int row = row0 + ai * HALF + m * 16;
                const f32x4 t4 = *(const PG8_LAS f32x4*)(xs + (ai * HALF + wr * 64 + m * 16 + fr) * 4);
                const float r = rsqrtf(((t4[0] + t4[1]) + (t4[2] + t4[3])) * (1.f / 192.f) + 1e-6f) * rl[ai][m];
                bf16_t* rowp = qa + (size_t)row * 3072 + h * 192;
                *(u32x4*)(rowp + cw) = pack8bf(acc[ai][0][m][0] * g0 * r, acc[ai][0][m][1] * g1 * r);
                if (wc < 2) { const f32x4 c01 = *(const f32x4*)(ropeT + (size_t)row * 32 + pp), c23 = *(const f32x4*)(ropeT + (size_t)row * 32 + pp + 2);
                    const f32x4 z0 = acc[ai][1][m][0] * r, z1 = acc[ai][1][m][1] * r;
                    const float a0 = z0[0] * ga[0], b0 = z0[1] * gb[0], a1 = z0[2] * ga[1], b1 = z0[3] * gb[1], a2 = z1[0] * ga[2], b2 = z1[1] * gb[2], a3 = z1[2] * ga[3], b3 = z1[3] * gb[3];
                    const f32x4 o0 = {a0 * c01[0] - b0 * c01[1], a0 * c01[1] + b0 * c01[0], a1 * c01[2] - b1 * c01[3], a1 * c01[3] + b1 * c01[2]};
                    const f32x4 o1 = {a2 * c23[0] - b2 * c23[1], a2 * c23[1] + b2 * c23[0], a3 * c23[2] - b3 * c23[3], a3 * c23[3] + b3 * c23[2]};
                    *(u32x4*)(rowp + 128 + cw) = pack8bf(o0, o1); } }
    }
};
struct EpiKV {
    static constexpr bool PERM = true, AFTER_DRAIN = false;
    bf16_t *ka, *va; const bf16_t* kpe; const float* ssq; const float* gk; const float2* ropeT; PG8_LAS float* xs;
    __device__ __forceinline__ void operator()(const f32x4 (&acc)[2][2][4][2], const Unit& u, int wr, int wc, int fr, int fq_) const {
        const int h = u.pn, row0 = u.pm * BM + wr * 64 + fr, cw = wc * 32 + 8 * fq_;
        float rl[2][4]; f32x4 kp[2][4];
#pragma unroll
        for (int ai = 0; ai < 2; ++ai)
#pragma unroll
            for (int m = 0; m < 4; ++m) { const int row = row0 + ai * HALF + m * 16; rl[ai][m] = lat_rinv(ssq, 2, row);
                const uint2 w = *(const uint2*)(kpe + (size_t)row * 64 + 16 * wc + 4 * fq_);
                kp[ai][m] = (f32x4){__uint_as_float(w.x << 16), __uint_as_float(w.x & 0xffff0000u), __uint_as_float(w.y << 16), __uint_as_float(w.y & 0xffff0000u)};
                const f32x4 v0 = acc[ai][0][m][0], v1 = acc[ai][0][m][1];
                float s = ((v0[0] * v0[0] + v0[1] * v0[1]) + (v0[2] * v0[2] + v0[3] * v0[3]) + (v1[0] * v1[0] + v1[1] * v1[1]) + (v1[2] * v1[2] + v1[3] * v1[3])) * (rl[ai][m] * rl[ai][m]);
                s += (kp[ai][m][0] * kp[ai][m][0] + kp[ai][m][1] * kp[ai][m][1]) + (kp[ai][m][2] * kp[ai][m][2] + kp[ai][m][3] * kp[ai][m][3]);
                s += __shfl_xor(s, 16); s += __shfl_xor(s, 32);
                if (fq_ == 0) xs[(ai * HALF + wr * 64 + m * 16 + fr) * 4 + wc] = s;
                *(u32x4*)(va + (size_t)row * 2048 + h * 128 + cw) = pack8bf(acc[ai][1][m][0] * rl[ai][m], acc[ai][1][m][1] * rl[ai][m]); }
        EPI_LDSBAR();
        const f32x4 g0 = *(const f32x4*)(gk + cw), g1 = *(const f32x4*)(gk + cw + 4);
        const int pp = 8 * wc + 2 * fq_;
        const float ga0 = gk[128 + pp], ga1 = gk[128 + pp + 1], gb0 = gk[160 + pp], gb1 = gk[160 + pp + 1];
#pragma unroll
        for (int ai = 0; ai < 2; ++ai)
#pragma unroll
            for (int m = 0; m < 4; ++m) { const int row = row0 + ai * HALF + m * 16;
                const f32x4 t4 = *(const PG8_LAS f32x4*)(xs + (ai * HALF + wr * 64 + m * 16 + fr) * 4);
                const float r = rsqrtf(((t4[0] + t4[1]) + (t4[2] + t4[3])) * (1.f / 192.f) + 1e-6f), rn = r * rl[ai][m];
                bf16_t* rowp = ka + (size_t)row * 3072 + h * 192;
                *(u32x4*)(rowp + cw) = pack8bf(acc[ai][0][m][0] * g0 * rn, acc[ai][0][m][1] * g1 * rn);
                const f32x4 cs = *(const f32x4*)(ropeT + (size_t)row * 32 + pp);
                const float a0 = kp[ai][m][0] * r * ga0, b0 = kp[ai][m][1] * r * gb0, a1 = kp[ai][m][2] * r * ga1, b1 = kp[ai][m][3] * r * gb1;
                uint2 o; o.x = cvt_pk_bf16(a0 * cs[0] - b0 * cs[1], a0 * cs[1] + b0 * cs[0]); o.y = cvt_pk_bf16(a1 * cs[2] - b1 * cs[3], a1 * cs[3] + b1 * cs[2]);
                *(uint2*)(rowp + 128 + 16 * wc + 4 * fq_) = o; }
    }
};

struct EpiX1 {
    static constexpr bool PERM = true, AFTER_DRAIN = false;
    float* x1; const float* x; bf16_t* xg; const float* g; float* ssq2;
    __device__ __forceinline__ void operator()(const f32x4 (&acc)[2][2][4][2], const Unit& u, int wr, int wc, int fr, int fq_) const {
        const int row0 = u.pm * BM + wr * 64 + fr, col0 = u.pn * BM + wc * 32 + 8 * fq_;
        f32x4 gg[2][2];
#pragma unroll
        for (int bj = 0; bj < 2; ++bj) { gg[bj][0] = *(const f32x4*)(g + col0 + bj * HALF); gg[bj][1] = *(const f32x4*)(g + col0 + bj * HALF + 4); }
#pragma unroll
        for (int ai = 0; ai < 2; ++ai)
#pragma unroll
            for (int m = 0; m < 4; ++m) { const int row = row0 + ai * HALF + m * 16; const size_t off = (size_t)row * 2048 + col0; float s = 0.f;
#pragma unroll
                for (int bj = 0; bj < 2; ++bj) { const f32x4 v0 = acc[ai][bj][m][0] + *(const f32x4*)(x + off + bj * HALF), v1 = acc[ai][bj][m][1] + *(const f32x4*)(x + off + bj * HALF + 4);
                    *(f32x4*)(x1 + off + bj * HALF) = v0; *(f32x4*)(x1 + off + bj * HALF + 4) = v1;
                    s += (v0[0] * v0[0] + v0[1] * v0[1]) + (v0[2] * v0[2] + v0[3] * v0[3]) + (v1[0] * v1[0] + v1[1] * v1[1]) + (v1[2] * v1[2] + v1[3] * v1[3]);
                    *(u32x4*)(xg + off + bj * HALF) = pack8bf(v0 * gg[bj][0], v1 * gg[bj][1]); }
                s += __shfl_xor(s, 16); s += __shfl_xor(s, 32);
                if (fq_ == 0) ssq2[((size_t)u.pn * 8192 + row) * 4 + wc] = s; }
    }
};
__device__ __forceinline__ float ffn_rinv(const float* ssq2, int row) {
    float t = 0.f;
#pragma unroll
    for (int pn = 0; pn < 8; ++pn) { const f32x4 a = *(const f32x4*)(ssq2 + ((size_t)pn * 8192 + row) * 4); t += (a[0] + a[1]) + (a[2] + a[3]); }
    return rsqrtf(t * (1.f / 2048.f) + 1e-6f);
}
struct EpiScores {
    static constexpr bool PERM = true, AFTER_DRAIN = false;
    float* O; const float* ssq2;
    __device__ __forceinline__ void operator()(const f32x4 (&acc)[2][2][4][2], const Unit& u, int wr, int wc, int fr, int fq_) const {
        const int row0 = u.pm * BM + wr * 64 + fr, col0 = u.pn * BM + wc * 32 + 8 * fq_;
#pragma unroll
        for (int ai = 0; ai < 2; ++ai)
#pragma unroll
            for (int m = 0; m < 4; ++m) { const int row = row0 + ai * HALF + m * 16; const float r = ffn_rinv(ssq2, row); const size_t off = (size_t)row * 2048 + col0;
#pragma unroll
                for (int bj = 0; bj < 2; ++bj) { *(f32x4*)(O + off + bj * HALF) = acc[ai][bj][m][0] * r; *(f32x4*)(O + off + bj * HALF + 4) = acc[ai][bj][m][1] * r; } }
    }
};
template <class Epi, class Sched, bool ALIGN_EPI = false, bool SP2 = false>
__device__ __forceinline__ void gemm_phase(PG8_LAS unsigned char* lds, const Gemm g, const Sched& S, const Epi& E) {
    int tid = threadIdx.x; asm volatile("" : "+v"(tid));
    const int wid = __builtin_amdgcn_readfirstlane(tid >> 6), lane = tid & 63, wr = wid >> 2, wc = wid & 3, fr = lane & 15, fq = lane >> 4;
    const int K = g.K, nt = K / BK;
    unsigned voffA[2], voffB[2];
#pragma unroll
    for (int i = 0; i < 2; ++i) { int R, C; stage_rc(tid * 16 + i * 8192, R, C); const int Rb = Epi::PERM ? ((R & ~31) + perm32(R & 31)) : R;
        voffA[i] = (unsigned)(R * K + C) * 2u; voffB[i] = (unsigned)(Rb * K + C) * 2u; }
    const size_t kstep = (size_t)(BK * 2);
    const size_t hstep = (size_t)HALF * K * 2;
    const size_t tstep = 2 * hstep;
    const unsigned ldsw = (unsigned)wid * 1024u;
    const int aoff = lds_byte(wr * 64 + fr, fq * 8), boff = lds_byte(wc * 32 + fr, fq * 8);
#define PG8_SA(b, h) (((b) * 2 + (h)) * HTB)
#define PG8_SB(b, h) ((4 + (b) * 2 + (h)) * HTB)
#define PG8_STAGE(bufoff, gbase, voff) do { _Pragma("unroll") for (int _i = 0; _i < 2; ++_i) \
        __builtin_amdgcn_global_load_lds((const unsigned*)((const char*)(gbase) + (voff)[_i]), (PG8_LAS unsigned*)(lds + (bufoff) + ldsw + _i * 8192), 16, 0, 0); } while (0)
#define PG8_LDA(dst, b, h) do { _Pragma("unroll") for (int m = 0; m < 4; ++m) _Pragma("unroll") for (int k = 0; k < 2; ++k) dst[m][k] = *(const PG8_LAS bf16x8*)(lds + PG8_SA(b, h) + aoff + m * 2048 + k * 1024); } while (0)
#define PG8_LDB(dst, b, h) do { _Pragma("unroll") for (int n = 0; n < 2; ++n) _Pragma("unroll") for (int k = 0; k < 2; ++k) dst[n][k] = *(const PG8_LAS bf16x8*)(lds + PG8_SB(b, h) + boff + n * 2048 + k * 1024); } while (0)
#define PG8_MMA(ai, bj, At, Bt) do { __builtin_amdgcn_s_setprio(1); _Pragma("unroll") for (int m = 0; m < 4; ++m) _Pragma("unroll") for (int n = 0; n < 2; ++n) _Pragma("unroll") for (int k = 0; k < 2; ++k) \
        acc[ai][bj][m][n] = __builtin_amdgcn_mfma_f32_16x16x32_bf16(Bt[n][k], At[m][k], acc[ai][bj][m][n], 0, 0, 0); __builtin_amdgcn_s_setprio(0); } while (0)
#define PG8_WAIT_V(n) asm volatile("s_waitcnt vmcnt(" #n ")" ::: "memory")
#define PG8_WAIT_L(n) asm volatile("s_waitcnt lgkmcnt(" #n ")" ::: "memory")
#define PG8_BAR __builtin_amdgcn_s_barrier()
#define PG8_SCHED __builtin_amdgcn_sched_barrier(0)
    Unit cur, nxt; int ui = 0;
    if (!S.next(0, cur)) return;
    f32x4 acc[2][2][4][2];
#pragma unroll
    for (int a = 0; a < 2; ++a)
#pragma unroll
        for (int b = 0; b < 2; ++b)
#pragma unroll
            for (int m = 0; m < 4; ++m)
#pragma unroll
                for (int n = 0; n < 2; ++n) acc[a][b][m][n] = (f32x4){0.f, 0.f, 0.f, 0.f};
    bf16x8 At[4][2], B0[2][2], B1[2][2];
    const char* cA = (const char*)g.A + (size_t)cur.pm * tstep; const char* cB = (const char*)g.Bt + (size_t)cur.pn * tstep;
    S.a_ready(cur);
    if constexpr (SP2) {
        PG8_STAGE(PG8_SB(0, 0), cB, voffB); PG8_STAGE(PG8_SB(0, 1), cB + hstep, voffB); PG8_STAGE(PG8_SA(0, 0), cA, voffA); PG8_STAGE(PG8_SA(0, 1), cA + hstep, voffA);
        if (wr == 1) PG8_BAR;
        PG8_WAIT_V(2); PG8_BAR;
        PG8_STAGE(PG8_SB(1, 0), cB + kstep, voffB); PG8_STAGE(PG8_SA(1, 0), cA + kstep, voffA); PG8_STAGE(PG8_SB(1, 1), cB + hstep + kstep, voffB);
        PG8_WAIT_V(6); PG8_BAR;
    } else {
        PG8_STAGE(PG8_SB(0, 0), cB, voffB); PG8_STAGE(PG8_SA(0, 0), cA, voffA); PG8_STAGE(PG8_SB(0, 1), cB + hstep, voffB); PG8_STAGE(PG8_SA(0, 1), cA + hstep, voffA);
        if (wr == 1) PG8_BAR;
        PG8_WAIT_V(4); PG8_BAR;
        PG8_STAGE(PG8_SB(1, 0), cB + kstep, voffB); PG8_STAGE(PG8_SA(1, 0), cA + kstep, voffA); PG8_STAGE(PG8_SB(1, 1), cB + hstep + kstep, voffB);
        PG8_WAIT_V(6); PG8_BAR;
    }
    for (;;) {
        const bool has_next = S.next(ui + 1, nxt);
        const char* nA = has_next ? (const char*)g.A + (size_t)nxt.pm * tstep : cA; const char* nB = has_next ? (const char*)g.Bt + (size_t)nxt.pn * tstep : cB;
        for (int t = 0; t < nt; t += 2) {
            const bool last = (t == nt - 2);
            const char* a1 = cA + (size_t)(t + 1) * kstep;
            const char* a2 = last ? nA : cA + (size_t)(t + 2) * kstep; const char* b2 = last ? nB : cB + (size_t)(t + 2) * kstep;
            const char* a3 = a2 + kstep; const char* b3 = b2 + kstep;
            if (last && has_next) S.a_ready(nxt);
            if constexpr (SP2) {
            PG8_LDB(B0, 0, 0); PG8_LDB(B1, 0, 1); PG8_SCHED; PG8_LDA(At, 0, 0); PG8_STAGE(PG8_SA(1, 1), a1 + hstep, voffA);
            PG8_WAIT_V(8); PG8_WAIT_L(0); PG8_BAR; PG8_MMA(0, 0, At, B0); PG8_MMA(0, 1, At, B1); PG8_BAR; PG8_SCHED;
            PG8_LDA(At, 0, 1); PG8_STAGE(PG8_SB(0, 0), b2, voffB); PG8_STAGE(PG8_SB(0, 1), b2 + hstep, voffB); PG8_STAGE(PG8_SA(0, 0), a2, voffA);
            PG8_WAIT_V(8); PG8_WAIT_L(0); PG8_BAR; PG8_MMA(1, 0, At, B0); PG8_MMA(1, 1, At, B1); PG8_BAR; PG8_SCHED;
            PG8_LDB(B0, 1, 0); PG8_LDB(B1, 1, 1); PG8_SCHED; PG8_LDA(At, 1, 0); PG8_STAGE(PG8_SA(0, 1), a2 + hstep, voffA);
            PG8_WAIT_V(8); PG8_WAIT_L(0); PG8_BAR; PG8_MMA(0, 0, At, B0); PG8_MMA(0, 1, At, B1); PG8_BAR; PG8_SCHED;
            PG8_LDA(At, 1, 1); PG8_STAGE(PG8_SB(1, 0), b3, voffB); PG8_STAGE(PG8_SB(1, 1), b3 + hstep, voffB); PG8_STAGE(PG8_SA(1, 0), a3, voffA);
            PG8_WAIT_V(8); PG8_WAIT_L(0); PG8_BAR; PG8_MMA(1, 0, At, B0); PG8_MMA(1, 1, At, B1); PG8_BAR; PG8_SCHED;
            } else {
            PG8_LDB(B0, 0, 0); PG8_SCHED; PG8_LDA(At, 0, 0); PG8_STAGE(PG8_SA(1, 1), a1 + hstep, voffA);
            PG8_WAIT_L(8); PG8_BAR; PG8_WAIT_L(0); PG8_MMA(0, 0, At, B0); PG8_BAR; PG8_SCHED;
            PG8_LDB(B1, 0, 1); PG8_STAGE(PG8_SB(0, 0), b2, voffB);
            PG8_BAR; PG8_WAIT_L(0); PG8_MMA(0, 1, At, B1); PG8_BAR;
            PG8_LDA(At, 0, 1); PG8_STAGE(PG8_SA(0, 0), a2, voffA);
            PG8_BAR; PG8_WAIT_L(0); PG8_MMA(1, 0, At, B0); PG8_BAR; PG8_SCHED;
            PG8_STAGE(PG8_SB(0, 1), b2 + hstep, voffB);
            PG8_WAIT_V(6); PG8_BAR; PG8_MMA(1, 1, At, B1); PG8_BAR;
            PG8_LDB(B0, 1, 0); PG8_SCHED; PG8_LDA(At, 1, 0); PG8_STAGE(PG8_SA(0, 1), a2 + hstep, voffA);
            PG8_WAIT_L(8); PG8_BAR; PG8_WAIT_L(0); PG8_MMA(0, 0, At, B0); PG8_BAR; PG8_SCHED;
            PG8_LDB(B1, 1, 1); PG8_STAGE(PG8_SB(1, 0), b3, voffB);
            PG8_BAR; PG8_WAIT_L(0); PG8_MMA(0, 1, At, B1); PG8_BAR;
            PG8_LDA(At, 1, 1); PG8_STAGE(PG8_SA(1, 0), a3, voffA);
            PG8_BAR; PG8_WAIT_L(0); PG8_MMA(1, 0, At, B0); PG8_BAR; PG8_SCHED;
            PG8_STAGE(PG8_SB(1, 1), b3 + hstep, voffB);
            PG8_WAIT_V(6); PG8_BAR; PG8_MMA(1, 1, At, B1); PG8_BAR;
            }
        }
        if constexpr (ALIGN_EPI) { if (wr == 0) PG8_BAR; }
        if constexpr (!Epi::AFTER_DRAIN) { E(acc, cur, wr, wc, fr, fq); S.done(cur); }
        if (!has_next) break;
#pragma unroll
        for (int a = 0; a < 2; ++a)
#pragma unroll
            for (int b = 0; b < 2; ++b)
#pragma unroll
                for (int m = 0; m < 4; ++m)
#pragma unroll
                    for (int n = 0; n < 2; ++n) acc[a][b][m][n] = (f32x4){0.f, 0.f, 0.f, 0.f};
        cur = nxt; cA = nA; cB = nB; ++ui;
        if constexpr (ALIGN_EPI) { if (wr == 1) PG8_BAR; }
    }
    PG8_WAIT_V(0);
    if constexpr (!ALIGN_EPI) { if (wr == 0) PG8_BAR; }
    PG8_BAR;
    if constexpr (Epi::AFTER_DRAIN) { E.fused(acc, cur, wr, wc, fr, fq, lds, wid, lane); S.done(cur); }
#undef PG8_SA
#undef PG8_SB
#undef PG8_STAGE
#undef PG8_LDA
#undef PG8_LDB
#undef PG8_MMA
#undef PG8_WAIT_V
#undef PG8_WAIT_L
#undef PG8_BAR
#undef PG8_SCHED
}
}
namespace att {
typedef unsigned short bf16_t;
typedef short bf16x8 __attribute__((ext_vector_type(8)));
typedef short s16x4 __attribute__((ext_vector_type(4)));
typedef float f32x16 __attribute__((ext_vector_type(16)));
typedef float f32x4 __attribute__((ext_vector_type(4)));
typedef unsigned u32x4 __attribute__((ext_vector_type(4)));
#define ALAS __attribute__((address_space(3)))
#define ASBAR() __builtin_amdgcn_sched_barrier(0)
constexpr int SHM_V = 16384;
template <int DK> struct Lay { static constexpr int ROWB = DK * 2, SHM_K = 64 * ROWB, OFF_K = 2 * SHM_V, OFF_F = OFF_K + 2 * SHM_K, OFF_WS = OFF_F + 512, TOTAL = OFF_WS + 8 * 256; };

__device__ __forceinline__ int v_st(int k, int c) { const int kk = (k & ~0xC) | ((k & 4) << 1) | ((k & 8) >> 1); return ((kk >> 3) * 4 + (c >> 5)) * 512 + ((kk & 7) * 32 + (c & 31)) * 2; }
__device__ __forceinline__ int v_rd_base(int lane) { return ((lane & 3) << 3) | (((lane >> 2) & 3) << 6) | (((lane >> 4) & 1) << 5) | (((lane >> 5) & 1) << 8); }
__device__ __forceinline__ int crow(int r, int hi) { return (r & 3) + 8 * (r >> 2) + 4 * hi; }
typedef float cvtpk_f32x2 __attribute__((ext_vector_type(2))); typedef __bf16 cvtpk_bf16x2 __attribute__((ext_vector_type(2)));
__device__ __forceinline__ unsigned cvtpk(float lo, float hi) { const cvtpk_f32x2 v = {lo, hi}; const cvtpk_bf16x2 b = __builtin_convertvector(v, cvtpk_bf16x2); return __builtin_bit_cast(unsigned, b); }

__device__ __forceinline__ float wave_max_f(float v) {
#pragma unroll
    for (int o = 32; o >= 1; o >>= 1) v = fmaxf(v, __shfl_xor(v, o));
    return v;
}
__device__ __forceinline__ float att_max3(float a, float b, float c) { return __builtin_fmaxf(__builtin_fmaxf(a, b), c); }
template <int DK, bool FOX>
__device__ __forceinline__ void attn_block(unsigned char* smem, const bf16_t* __restrict__ Q, int ldq, const bf16_t* __restrict__ K, int ldk, const bf16_t* __restrict__ V, int ldv,
                                           const float* __restrict__ Fh, const bf16_t* __restrict__ gate, bf16_t* __restrict__ gout  , int qbk, const float* __restrict__ gq, const float* __restrict__ gk  ,
                                           const float* __restrict__ side_u, const float* __restrict__ side_v, unsigned char* __restrict__ side_u8, unsigned char* __restrict__ side_v8, int& side_next) {
    typedef Lay<DK> LY;
    constexpr int ND = DK / 16, NKC = DK / 8, NKI = (64 * NKC) / 512;
    int tid = threadIdx.x; asm volatile("" : "+v"(tid));
    const int wid = __builtin_amdgcn_readfirstlane(tid >> 6), lane = tid & 63, r32 = lane & 31, hi = lane >> 5;
    const int q0 = qbk * 256, qlo = q0 + wid * 32, qm = qlo + r32 - 4 * hi;
    const int NT = 4 * qbk + 4;
    ALAS unsigned char* lds = (ALAS unsigned char*)smem;
    ALAS float* F_lds = (ALAS float*)(lds + LY::OFF_F);
    ALAS float* wsl = (ALAS float*)(lds + LY::OFF_WS) + wid * 64;
    bf16x8 qr[ND];
#pragma unroll
    for (int d0 = 0; d0 < ND; ++d0) qr[d0] = *(const bf16x8*)(Q + (size_t)(qlo + r32) * ldq + d0 * 16 + hi * 8);
    const float fq = FOX ? Fh[qlo + r32] : 0.f;
    int kgo[NKI], vgo[2];
#pragma unroll
    for (int i = 0; i < NKI; ++i) { const int pp = (wid * NKI + i) * 64 + lane, row = pp / NKC, cpos = pp % NKC, ch = cpos ^ ((row >> 1) & 7); kgo[i] = row * ldk + ch * 8; }
#pragma unroll
    for (int i = 0; i < 2; ++i) { const int o = ((wid * 2 + i) * 64 + lane) * 16, st = o >> 9, e = (o & 511) >> 1, kk = (st >> 2) * 8 + (e >> 5), c = (st & 3) * 32 + (e & 31);
        const int k = (kk & ~0xC) | ((kk & 4) << 1) | ((kk & 8) >> 1); vgo[i] = k * ldv + c; }
    const int vb0 = (int)(uintptr_t)smem + v_rd_base(lane);
    int kbase[4];
#pragma unroll
    for (int dd = 0; dd < 4; ++dd) kbase[dd] = LY::OFF_K + r32 * LY::ROWB + (((((dd << 1) | hi) ^ ((r32 >> 1) & 7))) << 4);
    float stf = 0.f;
#define ATT_GLDS(kb, bf) do { _Pragma("unroll") for (int i = 0; i < NKI; ++i) \
            __builtin_amdgcn_global_load_lds((const unsigned*)(K + (size_t)(kb) * ldk + kgo[i]), (ALAS unsigned*)(lds + LY::OFF_K + (bf) * LY::SHM_K + (wid * NKI + i) * 1024), 16, 0, 0); \
        _Pragma("unroll") for (int i = 0; i < 2; ++i) \
            __builtin_amdgcn_global_load_lds((const unsigned*)(V + (size_t)(kb) * ldv + vgo[i]), (ALAS unsigned*)(lds + (bf) * SHM_V + (wid * 2 + i) * 1024), 16, 0, 0); \
        if (FOX && tid < 64) stf = Fh[(kb) + tid]; } while (0)
#define ATT_WRITEF(bf) do { if (FOX && tid < 64) F_lds[(bf) * 64 + tid] = stf; } while (0)
    int t_start = 0; float m_init = 0.f;
    if (FOX) {
        const float gqm = wave_max_f(fmaxf(fabsf(gq[lane]), fabsf(gq[lane + 64]))), gkm = wave_max_f(fmaxf(fabsf(gk[lane]), fabsf(gk[lane + 64])));
        const float qk_bound = 0.12751743f * 128.f * gqm * gkm;
        const float thr = 2.02f * qk_bound + 40.f, f0 = Fh[q0]; m_init = -thr;
        const int j0 = lane, j1 = lane + 64;
        const bool c0 = (j0 < 4 * qbk) && (Fh[j0 * 64 + 63] - f0 >= thr), c1 = (j1 < 4 * qbk) && (Fh[(j1 < 4 * qbk ? j1 : 0) * 64 + 63] - f0 >= thr);
        t_start = __builtin_popcountll(__ballot(c0)) + __builtin_popcountll(__ballot(c1));
        t_start = __builtin_amdgcn_readfirstlane(t_start); }
    ATT_GLDS(t_start * 64, t_start & 1); ATT_WRITEF(t_start & 1);
    float m_reg = FOX ? m_init : 0.f, l_reg = 0.f; f32x16 o[4];
#pragma unroll
    for (int d = 0; d < 4; ++d)
#pragma unroll
        for (int r = 0; r < 16; ++r) o[d][r] = 0.f;
    for (int t = t_start; t < NT; ++t) {
        const int buf = t & 1, kb = t * 64;
        asm volatile("s_waitcnt vmcnt(0)" ::: "memory");
        __syncthreads();
        if (t + 1 < NT) ATT_GLDS(kb + 64, buf ^ 1);
        const bool side = side_next < 64; f32x4 sd0, sd1; size_t sd_off = 0;
        if (side) { const bool isv = side_next >= 32; sd_off = ((size_t)(blockIdx.x * 32 + (side_next & 31)) * 512 + tid) * 8;
            const float* sp = (isv ? side_v : side_u) + sd_off; sd0 = *(const f32x4*)sp; sd1 = *(const f32x4*)(sp + 4); }
        f32x16 p0, p1;
        if (FOX) { const float fqm = fq - m_reg;
#pragma unroll
            for (int g = 0; g < 4; ++g) { const f32x4 f0 = *(const ALAS f32x4*)(F_lds + buf * 64 + 8 * g + 4 * hi), f1 = *(const ALAS f32x4*)(F_lds + buf * 64 + 32 + 8 * g + 4 * hi);
#pragma unroll
                for (int e = 0; e < 4; ++e) { p0[4 * g + e] = fqm - f0[e]; p1[4 * g + e] = fqm - f1[e]; } }
        } else { const float nm = -m_reg;
#pragma unroll
            for (int r = 0; r < 16; ++r) { p0[r] = nm; p1[r] = nm; }
        }
#pragma unroll
        for (int d0 = 0; d0 < ND; ++d0) {
            ALAS const unsigned char* a = lds + buf * LY::SHM_K + kbase[d0 & 3] + (d0 >> 2) * 128;
            const bf16x8 b0 = *(const ALAS bf16x8*)a;
            const bf16x8 b1 = *(const ALAS bf16x8*)(a + 32 * LY::ROWB);
            p0 = __builtin_amdgcn_mfma_f32_32x32x16_bf16(b0, qr[d0], p0, 0, 0, 0);
            p1 = __builtin_amdgcn_mfma_f32_32x32x16_bf16(b1, qr[d0], p1, 0, 0, 0);
        }
        if (kb + 63 > qlo) {
            const float NEG = -__builtin_inff(); const int dq = qm - kb;
#pragma unroll
            for (int r = 0; r < 16; ++r) { const int c = (r & 3) + 8 * (r >> 2); if (dq - c < 0) p0[r] = NEG; if (dq - c - 32 < 0) p1[r] = NEG; }
        }
        float pmax;
        { float a = att_max3(p0[0], p0[1], p1[0]), b = att_max3(p0[2], p0[3], p1[1]); a = att_max3(a, p1[2], p1[3]);
#pragma unroll
          for (int r = 4; r < 16; r += 4) { a = att_max3(a, p0[r], p0[r + 1]); b = att_max3(b, p0[r + 2], p0[r + 3]); a = att_max3(a, p1[r], p1[r + 1]); b = att_max3(b, p1[r + 2], p1[r + 3]); }
          pmax = fmaxf(a, b); }
        { auto rr = __builtin_amdgcn_permlane32_swap(__float_as_uint(pmax), __float_as_uint(pmax), false, false);
          pmax = fmaxf(__uint_as_float(rr[0]), __uint_as_float(rr[1])); }
        float alpha = 1.f;
        if (!__builtin_expect(__all(pmax <= 8.f), 1)) { const float dm = fmaxf(pmax, 0.f); alpha = __builtin_amdgcn_exp2f(-dm); m_reg += dm;
#pragma unroll
            for (int r = 0; r < 16; ++r) { p0[r] -= dm; p1[r] -= dm; } }
        float ps = 0.f;
#pragma unroll
        for (int r = 0; r < 16; ++r) { p0[r] = __builtin_amdgcn_exp2f(p0[r]); ps += p0[r]; }
#pragma unroll
        for (int r = 0; r < 16; ++r) { p1[r] = __builtin_amdgcn_exp2f(p1[r]); ps += p1[r]; }
        { auto rr = __builtin_amdgcn_permlane32_swap(__float_as_uint(ps), __float_as_uint(ps), false, false);
          ps = __uint_as_float(rr[0]) + __uint_as_float(rr[1]); }
        l_reg = l_reg * alpha + ps;
        bf16x8 pa0, pa1, pa2, pa3;
#define ATT_PK4(P, B_, OUT) do { unsigned a0 = cvtpk(P[B_+0], P[B_+1]), a1 = cvtpk(P[B_+2], P[B_+3]); unsigned b0_ = cvtpk(P[B_+4], P[B_+5]), b1_ = cvtpk(P[B_+6], P[B_+7]); \
        auto r0 = __builtin_amdgcn_permlane32_swap(a0, b0_, false, false); auto r1 = __builtin_amdgcn_permlane32_swap(a1, b1_, false, false); \
        u32x4 w = {r0[0], r1[0], r0[1], r1[1]}; OUT = *reinterpret_cast<bf16x8*>(&w); } while (0)
        ATT_PK4(p0, 0, pa0); ATT_PK4(p0, 8, pa1); ATT_PK4(p1, 0, pa2); ATT_PK4(p1, 8, pa3);
        if (__any(alpha < 1.f)) {
            if (hi == 0) wsl[r32] = alpha;
            asm volatile("s_waitcnt lgkmcnt(0)" ::: "memory");
#pragma unroll
            for (int g = 0; g < 4; ++g) { const f32x4 al = *(const ALAS f32x4*)(wsl + 8 * g + 4 * hi);
#pragma unroll
                for (int d = 0; d < 4; ++d)
#pragma unroll
                    for (int e = 0; e < 4; ++e) o[d][4 * g + e] *= al[e]; }
        }
#define ATT_TRRD(dst, off) asm volatile("ds_read_b64_tr_b16 %0, %1 offset:%2" : "=&v"(dst) : "v"(vbb), "i"(off) : "memory")
#define ATT_PV(d0) do { s16x4 l0, l1, l2, l3, h0, h1, h2, h3; constexpr int b_ = (d0) * 512; \
        ATT_TRRD(l0, b_); ATT_TRRD(h0, b_ + 2048); ATT_TRRD(l1, b_ + 4096); ATT_TRRD(h1, b_ + 6144); ATT_TRRD(l2, b_ + 8192); ATT_TRRD(h2, b_ + 10240); ATT_TRRD(l3, b_ + 12288); ATT_TRRD(h3, b_ + 14336); \
        asm volatile("s_waitcnt lgkmcnt(0)" ::: "memory"); ASBAR(); \
        o[d0] = __builtin_amdgcn_mfma_f32_32x32x16_bf16(pa0, (bf16x8){l0[0], l0[1], l0[2], l0[3], h0[0], h0[1], h0[2], h0[3]}, o[d0], 0, 0, 0); \
        o[d0] = __builtin_amdgcn_mfma_f32_32x32x16_bf16(pa1, (bf16x8){l1[0], l1[1], l1[2], l1[3], h1[0], h1[1], h1[2], h1[3]}, o[d0], 0, 0, 0); \
        o[d0] = __builtin_amdgcn_mfma_f32_32x32x16_bf16(pa2, (bf16x8){l2[0], l2[1], l2[2], l2[3], h2[0], h2[1], h2[2], h2[3]}, o[d0], 0, 0, 0); \
        o[d0] = __builtin_amdgcn_mfma_f32_32x32x16_bf16(pa3, (bf16x8){l3[0], l3[1], l3[2], l3[3], h3[0], h3[1], h3[2], h3[3]}, o[d0], 0, 0, 0); } while (0)
        { const int vbb = vb0 + buf * SHM_V; ATT_PV(0); ATT_PV(1); ATT_PV(2); ATT_PV(3); }
        if (t + 1 < NT) ATT_WRITEF(buf ^ 1);
        if (side) { const bool isv = side_next >= 32; const float sc = isv ? 4.f : 64.f;
            auto pk = [](float a, float b, float c, float d) { int w = __builtin_amdgcn_cvt_pk_fp8_f32(fminf(fmaxf(a, -448.f), 448.f), fminf(fmaxf(b, -448.f), 448.f), 0, false);
                return (unsigned)__builtin_amdgcn_cvt_pk_fp8_f32(fminf(fmaxf(c, -448.f), 448.f), fminf(fmaxf(d, -448.f), 448.f), w, true); };
            uint2 o; o.x = pk(sd0[0] * sc, sd0[1] * sc, sd0[2] * sc, sd0[3] * sc); o.y = pk(sd1[0] * sc, sd1[1] * sc, sd1[2] * sc, sd1[3] * sc);
            *(uint2*)((isv ? side_v8 : side_u8) + sd_off) = o; ++side_next; }
    }
    if (hi == 0) wsl[r32] = l_reg;
    asm volatile("s_waitcnt lgkmcnt(0)" ::: "memory");
#pragma unroll
    for (int r = 0; r < 16; ++r) {
        const int orow = crow(r, hi); const float rli = __builtin_amdgcn_rcpf(wsl[orow]);
        bf16_t* rowp = gout + (size_t)(qlo + orow) * 4096; const bf16_t* growp = gate + (size_t)(qlo + orow) * 4096;
#pragma unroll
        for (int d0 = 0; d0 < 4; ++d0) {
            const float v = o[d0][r] * rli; const float vn = __shfl_xor(v, 1);
            if ((r32 & 1) == 0) { unsigned* gp = (unsigned*)(rowp + d0 * 32 + r32); const unsigned g = *(const unsigned*)(growp + d0 * 32 + r32);
                *gp = cvtpk(v * __uint_as_float(g << 16), vn * __uint_as_float(g & 0xffff0000u)); }
        }
    }
    __syncthreads();
#undef ATT_GLDS
#undef ATT_WRITEF
#undef ATT_PK4
#undef ATT_TRRD
#undef ATT_PV
}
}
using pg8::bf16_t; using pg8::f32x4; using pg8::u32x4;
#define LAS __attribute__((address_space(3)))
constexpr int S = 8192, DM = 2048, INW = 11344, INWP = 11520;
constexpr float EPS = 1e-6f;
constexpr size_t MiB = 1u << 20;

__device__ __forceinline__ float bf2f(bf16_t v) { return __uint_as_float(((unsigned)v) << 16); }
__device__ __forceinline__ bf16_t f2bf(float f) { unsigned u = __float_as_uint(f); u += 0x7fffu + ((u >> 16) & 1u); return (bf16_t)(u >> 16); }
__device__ __forceinline__ unsigned pk2(float lo, float hi) { return (unsigned)f2bf(lo) | ((unsigned)f2bf(hi) << 16); }
__device__ __forceinline__ float wave_sum(float v) {
#pragma unroll
    for (int o = 32; o >= 1; o >>= 1) v += __shfl_xor(v, o);
    return v;
}
__device__ __forceinline__ float wave_max(float v) {
#pragma unroll
    for (int o = 32; o >= 1; o >>= 1) v = fmaxf(v, __shfl_xor(v, o));
    return v;
}

__device__ __forceinline__ int opaque_tid() { int t = threadIdx.x; asm volatile("" : "+v"(t)); return t; }

struct Params {
    const float* x; const int* pos; const float *mix_g, *w_in, *b_forget, *b_gate, *q_lat_g, *w_q_up, *kv_lat_g, *w_kv_up, *mla_qg, *mla_kg, *fox_qg, *fox_kg, *w_out, *ffn_g, *w_peer_q, *sub_keys, *peer_u, *peer_v;
    float* out;
    bf16_t *WqT, *WkvT, *WoT, *WpT, *WinT;
    bf16_t *h, *cq, *ckv, *fq, *fk, *fv, *merged, *kpe, *qa, *va, *ka;
    float *lf, *F, *x1, *scores;
    unsigned char *U8, *V8; bf16_t* attout;
    unsigned* ctl;
    float2* ropeT; float* ssq; float* ssq2; bf16_t* xg;
};

struct DstId { __device__ __forceinline__ int operator()(int n) const { return n; } };
struct DstWin { __device__ __forceinline__ int operator()(int n) const {
    if (n < 1024) return n; if (n < 1088) { const int r = n - 1024; return 11264 + 2 * (r & 31) + (r >> 5); } if (n < 7232) return n - 64; if (n < 7248) return 11264 + 64 + (n - 7232); return n - 80; } };
struct DstQ { __device__ __forceinline__ int operator()(int n) const {
    const int h = n / 192, d = n - h * 192; if (d < 128) return h * 256 + d; const int r = d - 128; return h * 256 + 128 + 2 * (r & 31) + (r >> 5); } };
template <class Dst>
__device__ __forceinline__ void transpose_item(const float* __restrict__ W, int K, int N, bf16_t* __restrict__ WT, Dst dst, float* scr, int item, int lane, const float* __restrict__ gk = nullptr) {
    const int nblk = (N + 31) / 32, kb = item / nblk, nb = item % nblk, k0 = 64 * kb, n0 = 32 * nb;
    { const int rr = lane >> 3, c4 = (lane & 7) * 4; const bool ok = (n0 + c4) < N;
      f32x4 v[8];
#pragma unroll
      for (int i = 0; i < 8; ++i) v[i] = ok ? *(const f32x4*)(W + (size_t)(k0 + 8 * i + rr) * N + n0 + c4) : (f32x4){0.f, 0.f, 0.f, 0.f};
      if (gk) {
#pragma unroll
          for (int i = 0; i < 8; ++i) v[i] *= gk[k0 + 8 * i + rr]; }
#pragma unroll
      for (int i = 0; i < 8; ++i) { float* sp = scr + (8 * i + rr) * 33 + c4; sp[0] = v[i][0]; sp[1] = v[i][1]; sp[2] = v[i][2]; sp[3] = v[i][3]; } }
    asm volatile("s_waitcnt lgkmcnt(0)" ::: "memory");
    const int c = lane & 7;
#pragma unroll
    for (int j = 0; j < 4; ++j) { const int nl = (lane >> 3) + 8 * j, n = n0 + nl; const float* s = scr + (8 * c) * 33 + nl;
        u32x4 o; o.x = pk2(s[0 * 33], s[1 * 33]); o.y = pk2(s[2 * 33], s[3 * 33]); o.z = pk2(s[4 * 33], s[5 * 33]); o.w = pk2(s[6 * 33], s[7 * 33]);
        if (n < N) *(u32x4*)(WT + (size_t)dst(n) * K + k0 + 8 * c) = o; }
    asm volatile("s_waitcnt lgkmcnt(0)" ::: "memory");
}
__device__ __forceinline__ void wfold_item(const float* __restrict__ wq, const float* __restrict__ keys, bf16_t* __restrict__ WpT, float* sm, int item) {
    const int tid = opaque_tid(), hc = item >> 5, d0 = (item & 31) * 64;
    float* keysL = sm; float* wqL = sm + 128 * 132;
    for (int idx = tid; idx < 128 * 32; idx += 512) { const int r = idx >> 5, c4 = (idx & 31) * 4; *(f32x4*)(keysL + r * 132 + c4) = *(const f32x4*)(keys + (size_t)hc * 16384 + r * 128 + c4); }
    for (int idx = tid; idx < 64 * 32; idx += 512) { const int r = idx >> 5, c4 = (idx & 31) * 4; *(f32x4*)(wqL + r * 132 + c4) = *(const f32x4*)(wq + (size_t)(d0 + r) * 2048 + hc * 128 + c4); }
    __syncthreads();
    const int n2 = (tid & 63) * 2, dg = tid >> 6;
    float acc[2][8];
#pragma unroll
    for (int a = 0; a < 2; ++a)
#pragma unroll
        for (int i = 0; i < 8; ++i) acc[a][i] = 0.f;
#pragma unroll 2
    for (int j4 = 0; j4 < 32; ++j4) {
        const f32x4 k0v = *(const f32x4*)(keysL + n2 * 132 + 4 * j4), k1v = *(const f32x4*)(keysL + (n2 + 1) * 132 + 4 * j4);
#pragma unroll
        for (int i = 0; i < 8; ++i) { const f32x4 w = *(const f32x4*)(wqL + (dg * 8 + i) * 132 + 4 * j4);
            acc[0][i] += (k0v[0] * w[0] + k0v[1] * w[1]) + (k0v[2] * w[2] + k0v[3] * w[3]);
            acc[1][i] += (k1v[0] * w[0] + k1v[1] * w[1]) + (k1v[2] * w[2] + k1v[3] * w[3]); }
    }
#pragma unroll
    for (int a = 0; a < 2; ++a) { u32x4 o; o.x = pk2(acc[a][0], acc[a][1]); o.y = pk2(acc[a][2], acc[a][3]); o.z = pk2(acc[a][4], acc[a][5]); o.w = pk2(acc[a][6], acc[a][7]);
        *(u32x4*)(WpT + (size_t)(hc * 128 + n2 + a) * 2048 + d0 + dg * 8) = o; }
    __syncthreads();
}
__device__ __forceinline__ void rms_row2048(const float* __restrict__ xr, const float* __restrict__ g, bf16_t* __restrict__ orow, int lane) {
    f32x4 v[8]; float ss = 0.f;
#pragma unroll
    for (int j = 0; j < 8; ++j) { v[j] = *(const f32x4*)(xr + j * 256 + lane * 4); ss += (v[j][0] * v[j][0] + v[j][1] * v[j][1]) + (v[j][2] * v[j][2] + v[j][3] * v[j][3]); }
    const float r = rsqrtf(wave_sum(ss) * (1.f / 2048.f) + EPS);
#pragma unroll
    for (int j = 0; j < 8; ++j) { const f32x4 gg = *(const f32x4*)(g + j * 256 + lane * 4);
        uint2 o; o.x = pk2(v[j][0] * r * gg[0], v[j][1] * r * gg[1]); o.y = pk2(v[j][2] * r * gg[2], v[j][3] * r * gg[3]);
        *(uint2*)(orow + j * 256 + lane * 4) = o; }
}
__device__ __forceinline__ void fox_cumsum(double* part, int h, const float* __restrict__ lf, float* __restrict__ F) {
    const int tid = opaque_tid(), lane = tid & 63, wave = tid >> 6;
    float v[16]; double sum = 0.0;
#pragma unroll
    for (int i = 0; i < 16; ++i) { v[i] = lf[(size_t)(tid * 16 + i) * 16 + h]; sum += (double)v[i]; }
    double inc = sum;
#pragma unroll
    for (int o = 1; o < 64; o <<= 1) { const double n = __shfl_up(inc, o); if (lane >= o) inc += n; }
    if (lane == 63) part[wave] = inc;
    __syncthreads();
    double base = 0.0;
    for (int w = 0; w < wave; ++w) base += part[w];
    double run = base + inc - sum;
#pragma unroll
    for (int i = 0; i < 16; ++i) { run += (double)v[i]; F[(size_t)h * S + tid * 16 + i] = (float)(run * 1.4426950408889634); }
    __syncthreads();
}
__device__ __forceinline__ void rope_table(const int* __restrict__ pos, float2* __restrict__ ropeT, int gtid, int nthreads) {
    for (int idx = gtid; idx < S * 32; idx += nthreads) { const int t = idx >> 5, i = idx & 31;
        const double inv = exp(-(double)i * (1.0 / 32.0) * 9.210340371976184);
        double ang = (double)((float)pos[t] * (float)inv);
        const double twopi = 6.283185307179586;
        ang -= twopi * rint(ang / twopi);
        ropeT[idx] = make_float2(cosf((float)ang), sinf((float)ang)); }
}
typedef float f32x2 __attribute__((ext_vector_type(2)));
__device__ __forceinline__ unsigned pk4_fp8(float a, float b, float c, float d) {
    int w = __builtin_amdgcn_cvt_pk_fp8_f32(fminf(fmaxf(a, -448.f), 448.f), fminf(fmaxf(b, -448.f), 448.f), 0, false);
    w = __builtin_amdgcn_cvt_pk_fp8_f32(fminf(fmaxf(c, -448.f), 448.f), fminf(fmaxf(d, -448.f), 448.f), w, true); return (unsigned)w; }
__device__ __forceinline__ void cvt_rows_fp8(const float* __restrict__ src, unsigned char* __restrict__ dst, size_t n, float scale, int gw, int NGW, int lane) {
    const size_t nchunk = n / 1024;
    for (size_t c = gw; c < nchunk; c += NGW) { const size_t o = c * 1024 + lane * 16;
        f32x4 a[4];
#pragma unroll
        for (int q = 0; q < 4; ++q) a[q] = *(const f32x4*)(src + o + 4 * q) * scale;
        u32x4 w; w.x = pk4_fp8(a[0][0], a[0][1], a[0][2], a[0][3]); w.y = pk4_fp8(a[1][0], a[1][1], a[1][2], a[1][3]);
        w.z = pk4_fp8(a[2][0], a[2][1], a[2][2], a[2][3]); w.w = pk4_fp8(a[3][0], a[3][1], a[3][2], a[3][3]);
        *(u32x4*)(dst + o) = w; }
}
constexpr float U_SCALE = 64.f, V_SCALE = 4.f;
typedef __bf16 bf16x2_t __attribute__((ext_vector_type(2)));
__device__ __forceinline__ float dot2bf(unsigned a, unsigned b, float c) { return __builtin_amdgcn_fdot2_f32_bf16(__builtin_bit_cast(bf16x2_t, a), __builtin_bit_cast(bf16x2_t, b), c, false); }
#define PEER_INS(top, x) do { float x_ = (x); _Pragma("unroll") for (int i_ = 0; i_ < 16; ++i_) { const float hi_ = fmaxf(top[i_], x_); x_ = fminf(top[i_], x_); top[i_] = hi_; } } while (0)
__device__ __forceinline__ void peer_group(unsigned char* smem, int g, const float* __restrict__ scores, const bf16_t* __restrict__ h2  , const float* __restrict__ ssq2, const float* __restrict__ x1,
                                           const unsigned char* __restrict__ U8, const unsigned char* __restrict__ V8, float* __restrict__ out) {
    const int tid = opaque_tid(), lane = tid & 63, wave = __builtin_amdgcn_readfirstlane(tid >> 6);
    float* topL = (float*)smem;
    int* selE = (int*)(smem + 32768);
    float* selG = (float*)(smem + 49152);
    {
        const int tl = tid >> 4, hc = tid & 15;
        const float* sp = scores + (size_t)(g * 32 + tl) * 2048 + hc * 128;
        float top[16];
#pragma unroll
        for (int i = 0; i < 16; ++i) top[i] = -INFINITY;
#pragma unroll 2
        for (int n0 = 0; n0 < 128; n0 += 4) { const f32x4 v = *(const f32x4*)(sp + n0);
#pragma unroll
            for (int e = 0; e < 4; ++e) PEER_INS(top, __uint_as_float((__float_as_uint(v[e]) & ~0x7Fu) | (unsigned)(n0 + e))); }
        float* tp = topL + (tl * 16 + hc) * 16;
#pragma unroll
        for (int i = 0; i < 16; i += 4) *(f32x4*)(tp + i) = (f32x4){top[i], top[i + 1], top[i + 2], top[i + 3]};
    }
    __syncthreads();
    if (tid < 256) {
        const int tl = tid >> 3, h = tid & 7;
        const float* t1 = topL + (tl * 16 + 2 * h) * 16; const float* t2 = t1 + 16;
        float s1[16], s2[16];
#pragma unroll
        for (int i = 0; i < 16; i += 4) { const f32x4 a = *(const f32x4*)(t1 + i), b2 = *(const f32x4*)(t2 + i);
            s1[i] = a[0]; s1[i + 1] = a[1]; s1[i + 2] = a[2]; s1[i + 3] = a[3]; s2[i] = b2[0]; s2[i + 1] = b2[1]; s2[i + 2] = b2[2]; s2[i + 3] = b2[3]; }
        float ts[16];
#pragma unroll
        for (int i = 0; i < 16; ++i) ts[i] = -INFINITY;
#pragma unroll
        for (int i = 0; i < 16; ++i)
#pragma unroll
            for (int j = 0; j < 16; ++j)
                if ((i + 1) * (j + 1) <= 16) PEER_INS(ts, __uint_as_float((__float_as_uint(s1[i] + s2[j]) & ~0xFFu) | (unsigned)(i * 16 + j)));
        float ex[16], sum = 0.f;
#pragma unroll
        for (int k = 0; k < 16; ++k) { ex[k] = __expf(ts[k] - ts[0]); sum += ex[k]; }
        const float inv = 1.f / sum;
#pragma unroll
        for (int k = 0; k < 16; ++k) { const unsigned pos = __float_as_uint(ts[k]) & 0xFFu;
            const int i1 = (int)(__float_as_uint(t1[pos >> 4]) & 0x7Fu), i2 = (int)(__float_as_uint(t2[pos & 15]) & 0x7Fu);
            selE[tl * 128 + h * 16 + k] = i1 * 128 + i2; selG[tl * 128 + h * 16 + k] = ex[k] * inv; }
    }
    __syncthreads();
    const int grp = lane >> 4, l16 = lane & 15, tl = wave * 4 + grp;
    unsigned* sortK = (unsigned*)(smem + 65536) + tl * 128;
    float* wS = (float*)(smem + 81920) + tl * 128;
    unsigned* hist = (unsigned*)(smem + 98304) + wave * 512 + grp * 64;
    {
#pragma unroll
        for (int i = 0; i < 4; ++i) hist[l16 * 4 + i] = 0u;
        asm volatile("s_waitcnt lgkmcnt(0)" ::: "memory");
        unsigned ek[8], rk[8];
#pragma unroll
        for (int j = 0; j < 8; ++j) { ek[j] = (unsigned)selE[tl * 128 + l16 + 16 * j]; rk[j] = atomicAdd(&hist[ek[j] >> 8], 1u); }
        asm volatile("s_waitcnt lgkmcnt(0)" ::: "memory");
        unsigned c[4], tot = 0u;
#pragma unroll
        for (int i = 0; i < 4; ++i) { c[i] = hist[l16 * 4 + i]; tot += c[i]; }
        unsigned inc = tot;
#pragma unroll
        for (int o = 1; o < 16; o <<= 1) { const unsigned n = __shfl_up(inc, o, 16); if (l16 >= o) inc += n; }
        unsigned run = inc - tot;
#pragma unroll
        for (int i = 0; i < 4; ++i) { hist[256 + l16 * 4 + i] = run; run += c[i]; }
        asm volatile("s_waitcnt lgkmcnt(0)" ::: "memory");
#pragma unroll
        for (int j = 0; j < 8; ++j) sortK[hist[256 + (ek[j] >> 8)] + rk[j]] = (ek[j] << 7) | (unsigned)(l16 + 16 * j);
    }
    __syncthreads();
    const size_t tok = (size_t)g * 32 + tl;
    float rinv_tok;
    { float t = 0.f; if (l16 < 8) { const f32x4 a = *(const f32x4*)(ssq2 + ((size_t)l16 * 8192 + tok) * 4); t = (a[0] + a[1]) + (a[2] + a[3]); }
      t += __shfl_xor(t, 8); t += __shfl_xor(t, 4); t += __shfl_xor(t, 2); t += __shfl_xor(t, 1); rinv_tok = rsqrtf(t * (1.f / 2048.f) + 1e-6f); }
#pragma unroll 1
    for (int hf = 0; hf < 2; ++hf) {
        f32x2 hp[32];
#pragma unroll
        for (int j = 0; j < 4; ++j)
#pragma unroll
            for (int q = 0; q < 2; ++q) { const u32x4 w = *(const u32x4*)(h2 + tok * DM + hf * 1024 + j * 256 + l16 * 16 + q * 8);
#pragma unroll
                for (int c = 0; c < 4; ++c) hp[j * 8 + q * 4 + c] = (f32x2){__uint_as_float(w[c] << 16), __uint_as_float(w[c] & 0xffff0000u)}; }
        for (int it = 0; it < 128; it += 4) {
            if ((it & 7) == 0 && it) __syncthreads();
            unsigned key[4]; u32x4 ur[4][4];
#pragma unroll
            for (int p = 0; p < 4; ++p) { key[p] = sortK[it + p];
#pragma unroll
                for (int j = 0; j < 4; ++j) ur[p][j] = *(const u32x4*)(U8 + (size_t)(key[p] >> 7) * DM + hf * 1024 + j * 256 + l16 * 16); }
#pragma unroll
            for (int p = 0; p < 4; ++p) { f32x2 a2 = (f32x2){0.f, 0.f}, b2 = (f32x2){0.f, 0.f};
#pragma unroll
                for (int j = 0; j < 4; ++j)
#pragma unroll
                    for (int c = 0; c < 4; ++c) { const int w = (int)ur[p][j][c];
                        a2 = __builtin_elementwise_fma(hp[j * 8 + 2 * c], __builtin_amdgcn_cvt_pk_f32_fp8(w, false), a2);
                        b2 = __builtin_elementwise_fma(hp[j * 8 + 2 * c + 1], __builtin_amdgcn_cvt_pk_f32_fp8(w, true), b2); }
                float d = (a2.x + a2.y) + (b2.x + b2.y);
                d += __shfl_xor(d, 8); d += __shfl_xor(d, 4); d += __shfl_xor(d, 2); d += __shfl_xor(d, 1);
                if (hf == 0) { if (l16 == 0) wS[it + p] = d; }
                else { const float a = (wS[it + p] + d) * (rinv_tok * (1.f / U_SCALE));
                    const float w = selG[tl * 128 + (key[p] & 127u)] * 0.5f * a * (1.f + erff(a * 0.70710678118654752f)) * (1.f / V_SCALE);
                    if (l16 == 0) wS[it + p] = w; } }
        }
        __syncthreads();
    }
#pragma unroll 1
    for (int hf = 0; hf < 2; ++hf) {
        f32x2 acc[32];
#pragma unroll
        for (int c = 0; c < 32; ++c) acc[c] = (f32x2){0.f, 0.f};
        for (int it = 0; it < 128; it += 4) {
            if ((it & 7) == 0 && it) __syncthreads();
            unsigned key[4]; u32x4 vr[4][4];
#pragma unroll
            for (int p = 0; p < 4; ++p) { key[p] = sortK[it + p];
#pragma unroll
                for (int j = 0; j < 4; ++j) vr[p][j] = *(const u32x4*)(V8 + (size_t)(key[p] >> 7) * DM + hf * 1024 + j * 256 + l16 * 16); }
#pragma unroll
            for (int p = 0; p < 4; ++p) { const float w = wS[it + p]; const f32x2 w2 = (f32x2){w, w};
#pragma unroll
                for (int j = 0; j < 4; ++j)
#pragma unroll
                    for (int c = 0; c < 4; ++c) { const int x = (int)vr[p][j][c];
                        acc[j * 8 + 2 * c] = __builtin_elementwise_fma(w2, __builtin_amdgcn_cvt_pk_f32_fp8(x, false), acc[j * 8 + 2 * c]);
                        acc[j * 8 + 2 * c + 1] = __builtin_elementwise_fma(w2, __builtin_amdgcn_cvt_pk_f32_fp8(x, true), acc[j * 8 + 2 * c + 1]); } }
        }
#pragma unroll
        for (int j = 0; j < 4; ++j)
#pragma unroll
            for (int q = 0; q < 4; ++q) { const size_t o = tok * DM + hf * 1024 + j * 256 + l16 * 16 + q * 4;
                const f32x4 a = *(const f32x4*)(x1 + o);
                *(f32x4*)(out + o) = (f32x4){a[0] + acc[j * 8 + 2 * q].x, a[1] + acc[j * 8 + 2 * q].y, a[2] + acc[j * 8 + 2 * q + 1].x, a[3] + acc[j * 8 + 2 * q + 1].y}; }
        __syncthreads();
    }
    __syncthreads();
}

#define XB_TMO      128
#define XB_XCNT(j)  (256  + 64 * (j))
#define XB_XSUB(j)  (1280 + 64 * (j))
#define XB_XGEN(j)  (2304 + 64 * (j))
#define XB_TOP      3328
#define XB_TOPGEN   3392
#define XCD_BAR_WORDS 3456
#define XB_SPIN_CAP (1u << 18)

__device__ __forceinline__ unsigned xb_ld(unsigned* p)              { return __hip_atomic_load(p, __ATOMIC_RELAXED, __HIP_MEMORY_SCOPE_AGENT); }
__device__ __forceinline__ unsigned xb_add(unsigned* p, unsigned v) { return __hip_atomic_fetch_add(p, v, __ATOMIC_RELAXED, __HIP_MEMORY_SCOPE_AGENT); }
__device__ __forceinline__ unsigned xb_xcc_id() { return (unsigned)__builtin_amdgcn_s_getreg((3 << 11) | 20) & 0xFu; }
#define XB_SPIN(cond, bar) do { unsigned _sp = 0; while (cond) { __builtin_amdgcn_s_sleep(1); \
    if ((++_sp & 255u) == 0u) { if (xb_ld(&(bar)[XB_TMO])) break; if (_sp > XB_SPIN_CAP) { atomicAdd(&(bar)[XB_TMO], 1u); break; } } } } while (0)

struct XcdBarrier {
    unsigned* bar; unsigned x;
    volatile LAS unsigned* st;
};

__device__ __forceinline__ XcdBarrier xcd_barrier_post(unsigned* bar, volatile LAS unsigned* st) {
    XcdBarrier b; b.bar = bar; b.x = xb_xcc_id(); b.st = st;
    if (threadIdx.x == 0) (void)xb_add(&bar[XB_XCNT(b.x)], 1u);
    return b;
}
__device__ __forceinline__ void xcd_barrier_complete(unsigned* bar, unsigned x, unsigned& nloc, unsigned& nx) {
    const unsigned G = gridDim.x * gridDim.y * gridDim.z;
    unsigned sum, cnt, mine, sp = 0u;
    for (;;) {
        sum = 0u; cnt = 0u; mine = 0u;
#pragma unroll
        for (unsigned j = 0; j < 16; ++j) { const unsigned c = xb_ld(&bar[XB_XCNT(j)]); sum += c; cnt += (c > 0u) ? 1u : 0u; mine = (j == x) ? c : mine; }
        if (sum == G) break;
        __builtin_amdgcn_s_sleep(1);
        if ((++sp & 255u) == 0u) { if (xb_ld(&bar[XB_TMO])) break; if (sp > XB_SPIN_CAP) { atomicAdd(&bar[XB_TMO], 1u); break; } }
    }
    nloc = mine > 0u ? mine : 1u; nx = cnt > 0u ? cnt : 1u;
}

__device__ __forceinline__ void xcd_barrier(const XcdBarrier& b) {
    asm volatile("s_waitcnt vmcnt(0)" ::: "memory");
    __syncthreads();
    if (threadIdx.x == 0) {
        unsigned* bar = b.bar;
        __builtin_amdgcn_s_waitcnt(0);
        unsigned nloc = b.st[0], nx = b.st[1];
        if (nloc == 0u) { xcd_barrier_complete(bar, b.x, nloc, nx); b.st[0] = nloc; b.st[1] = nx; }
        const unsigned old = xb_add(&bar[XB_XSUB(b.x)], 1u);
        const unsigned gen = old / nloc;
        if (old + 1u == (gen + 1u) * nloc) {
            __builtin_amdgcn_fence(__ATOMIC_RELEASE, "agent");
            asm volatile("s_waitcnt vmcnt(0)" ::: "memory");
            const unsigned og = xb_add(&bar[XB_TOP], 1u);
            const unsigned tg = og / nx;
            if (og + 1u == (tg + 1u) * nx) xb_add(&bar[XB_TOPGEN], 1u);
            else XB_SPIN(xb_ld(&bar[XB_TOPGEN]) == tg, bar);
            __builtin_amdgcn_fence(__ATOMIC_ACQUIRE, "agent");
            xb_add(&bar[XB_XGEN(b.x)], 1u);
            asm volatile("s_waitcnt vmcnt(0)" ::: "memory");
        } else {
            XB_SPIN(xb_ld(&bar[XB_XGEN(b.x)]) == gen, bar);
            __builtin_amdgcn_fence(__ATOMIC_ACQUIRE, "agent");
            asm volatile("s_waitcnt vmcnt(0)" ::: "memory");
        }
    }
    __syncthreads();
}

#define PROBE_DOUBLE 0
#define REP(k) for (int rep_ = 0; rep_ < ((PROBE_DOUBLE == (k)) ? 2 : 1); ++rep_)
constexpr int LDS_BYTES = 147456;
__global__ __launch_bounds__(512, 2) void mega(Params p) {
    extern __shared__ __attribute__((aligned(16))) unsigned char smem[];
    { volatile LAS unsigned* st0 = (volatile LAS unsigned*)((LAS unsigned char*)smem + 131072); if (threadIdx.x < 2) st0[threadIdx.x] = 0u; }
    __syncthreads();
    const XcdBarrier bar = xcd_barrier_post(p.ctl, (volatile LAS unsigned*)((LAS unsigned char*)smem + 131072));
    float* smf = (float*)smem;
    LAS unsigned char* lds = (LAS unsigned char*)smem;
    const int G = gridDim.x, b = blockIdx.x, NGW = G * 8;
#define PHASE_IDS() const int tid = opaque_tid(), lane = tid & 63, wave = __builtin_amdgcn_readfirstlane(tid >> 6), gw = b * 8 + wave; (void)lane; (void)gw

    REP(7) {
        PHASE_IDS();
        float* scr = smf + wave * 4096;
        constexpr int dummy_ = 0; (void)dummy_;
        constexpr int I_IN = 32 * 355, I_Q = 8 * 96, I_KV = 8 * 128, I_O = 64 * 64;
        for (int it = gw; it < I_IN + I_Q + I_KV + I_O; it += NGW) {
            int r = it;
            if (r < I_IN) { transpose_item(p.w_in, 2048, INW, p.WinT, DstWin(), scr, r, lane); continue; } r -= I_IN;
            if (r < I_Q) { transpose_item(p.w_q_up, 512, 3072, p.WqT, DstQ(), scr, r, lane, p.q_lat_g); continue; } r -= I_Q;
            if (r < I_KV) { transpose_item(p.w_kv_up, 512, 4096, p.WkvT, DstId(), scr, r, lane, p.kv_lat_g); continue; } r -= I_KV;
            transpose_item(p.w_out, 4096, 2048, p.WoT, DstId(), scr, r, lane);
        }
        for (int m = gw; m < S; m += NGW) rms_row2048(p.x + (size_t)m * DM, p.mix_g, p.h + (size_t)m * DM, lane);
        for (int idx = b * 512 + tid; idx < 16 * 64 * 64; idx += G * 512) { const int hh = idx >> 12, rr = (idx >> 6) & 63, c8 = idx & 63;
            *(u32x4*)(p.WqT + (size_t)(hh * 256 + 192 + rr) * 512 + c8 * 8) = (u32x4){0u, 0u, 0u, 0u}; }
        rope_table(p.pos, p.ropeT, b * 512 + tid, G * 512);
        __syncthreads();
        for (int it = b; it < 512; it += G) wfold_item(p.w_peer_q, p.sub_keys, p.WpT, smf, it);
    }
    xcd_barrier(bar);
    REP(1) {
        pg8::Gemm g{p.h, p.WinT, S, INWP, DM}; pg8::StaticOrder so; so.init(S, INWP, G, b);
        pg8::EpiInProj E{p.cq, p.ckv, p.fq, p.fk, p.fv, p.merged, p.kpe, p.lf, p.b_gate, p.b_forget, p.ssq, p.fox_qg, p.fox_kg, (LAS float*)(lds + 131072 + 64)};
        pg8::gemm_phase<pg8::EpiInProj, pg8::StaticOrder, true, true>(lds, g, so, E);
    }
    xcd_barrier(bar);
    for (int hh = b; hh < 16; hh += G) fox_cumsum((double*)smem, hh, p.lf, p.F);
    REP(2) {
        pg8::Gemm g{p.cq, p.WqT, S, 4096, 512}; pg8::StaticOrder so; so.init(S, 4096, G, b);
        pg8::EpiQ E{p.qa, p.ssq, p.mla_qg, p.ropeT, (LAS float*)(lds + 131072 + 64)};
        pg8::gemm_phase<pg8::EpiQ, pg8::StaticOrder, true, true>(lds, g, so, E);
    }
    {
        pg8::Gemm g{p.ckv, p.WkvT, S, 4096, 512}; pg8::StaticOrder so; so.init(S, 4096, G, b);
        pg8::EpiKV E{p.ka, p.va, p.kpe, p.ssq, p.mla_kg, p.ropeT, (LAS float*)(lds + 131072 + 64)};
        pg8::gemm_phase<pg8::EpiKV, pg8::StaticOrder, true, true>(lds, g, so, E);
    }
    xcd_barrier(bar);
    int side_next = 0;
    REP(3) for (int L = b; L < 1024; L += G) {
        const int i = L >> 8, vc = L & 255, vcx = (vc & 7) * 32 + (vc >> 3), hh = vcx >> 4, x = vcx & 15, qbk = (i & 1) ? x : 31 - x;
        if (i < 2) att::attn_block<192, false>(smem, p.qa + hh * 192, 3072, p.ka + hh * 192, 3072, p.va + hh * 128, 2048, nullptr, p.merged + hh * 128, p.attout + hh * 128, qbk, nullptr, nullptr, p.peer_u, p.peer_v, p.U8, p.V8, side_next);
        else att::attn_block<128, true>(smem, p.fq + hh * 128, 2048, p.fk + hh * 128, 2048, p.fv + hh * 128, 2048, p.F + (size_t)hh * S, p.merged + 2048 + hh * 128, p.attout + 2048 + hh * 128, qbk, p.fox_qg, p.fox_kg, p.peer_u, p.peer_v, p.U8, p.V8, side_next);
    }
    if (G == 256) { PHASE_IDS(); (void)wave;
        for (; side_next < 64; ++side_next) { const bool isv = side_next >= 32; const size_t off = ((size_t)(b * 32 + (side_next & 31)) * 512 + tid) * 8;
            const float* sp = (isv ? p.peer_v : p.peer_u) + off; const float sc = isv ? V_SCALE : U_SCALE; const f32x4 a0 = *(const f32x4*)sp * sc, a1 = *(const f32x4*)(sp + 4) * sc;
            uint2 o; o.x = pk4_fp8(a0[0], a0[1], a0[2], a0[3]); o.y = pk4_fp8(a1[0], a1[1], a1[2], a1[3]); *(uint2*)((isv ? p.V8 : p.U8) + off) = o; } }
    else { PHASE_IDS(); cvt_rows_fp8(p.peer_u, p.U8, (size_t)16384 * 2048, U_SCALE, gw, NGW, lane); cvt_rows_fp8(p.peer_v, p.V8, (size_t)16384 * 2048, V_SCALE, gw, NGW, lane); }
    xcd_barrier(bar);
    REP(4) {
        pg8::Gemm g{p.attout, p.WoT, S, 2048, 4096}; pg8::StaticOrder so; so.init(S, 2048, G, b);
        pg8::EpiX1 E{p.x1, p.x, p.xg, p.ffn_g, p.ssq2};
        pg8::gemm_phase<pg8::EpiX1, pg8::StaticOrder, true, true>(lds, g, so, E);
    }
    xcd_barrier(bar);
    REP(5) {
        pg8::Gemm g{p.xg, p.WpT, S, 2048, 2048}; pg8::StaticOrder so; so.init(S, 2048, G, b);
        pg8::EpiScores E{p.scores, p.ssq2};
        pg8::gemm_phase<pg8::EpiScores, pg8::StaticOrder, true, true>(lds, g, so, E);
    }
    xcd_barrier(bar);
    REP(6) for (int g = b; g < S / 32; g += G) peer_group(smem, g, p.scores, p.xg, p.ssq2, p.x1, p.U8, p.V8, p.out);
}

extern "C" void kernel_launch(void* const* d_in, const int* in_sizes, int n_in,
                              void* d_out, int out_size, void* d_ws, size_t ws_size,
                              hipStream_t stream) {
    if (ws_size < 512 * MiB) { fprintf(stderr, "kernel_launch: workspace too small (%zu)\n", ws_size); return; }
    Params p{};
    p.x = (const float*)d_in[0]; p.pos = (const int*)d_in[1]; p.mix_g = (const float*)d_in[2]; p.w_in = (const float*)d_in[3];
    p.b_forget = (const float*)d_in[4]; p.b_gate = (const float*)d_in[5]; p.q_lat_g = (const float*)d_in[6]; p.w_q_up = (const float*)d_in[7];
    p.kv_lat_g = (const float*)d_in[8]; p.w_kv_up = (const float*)d_in[9]; p.mla_qg = (const float*)d_in[10]; p.mla_kg = (const float*)d_in[11];
    p.fox_qg = (const float*)d_in[12]; p.fox_kg = (const float*)d_in[13]; p.w_out = (const float*)d_in[14]; p.ffn_g = (const float*)d_in[15];
    p.w_peer_q = (const float*)d_in[16]; p.sub_keys = (const float*)d_in[17]; p.peer_u = (const float*)d_in[18]; p.peer_v = (const float*)d_in[19];
    p.out = (float*)d_out;
    char* ws = (char*)d_ws;
    p.WqT = (bf16_t*)(ws + 1 * MiB); p.WkvT = (bf16_t*)(ws + 5 * MiB); p.WoT = (bf16_t*)(ws + 9 * MiB); p.WpT = (bf16_t*)(ws + 25 * MiB); p.WinT = (bf16_t*)(ws + 33 * MiB);
    p.h = (bf16_t*)(ws + 78 * MiB); p.cq = (bf16_t*)(ws + 110 * MiB); p.ckv = (bf16_t*)(ws + 118 * MiB);
    p.fq = (bf16_t*)(ws + 126 * MiB); p.fk = (bf16_t*)(ws + 158 * MiB); p.fv = (bf16_t*)(ws + 190 * MiB); p.merged = (bf16_t*)(ws + 222 * MiB);
    p.kpe = (bf16_t*)(ws + 286 * MiB); p.lf = (float*)(ws + 287 * MiB); p.F = (float*)(ws + 287 * MiB + 512 * 1024);
    p.qa = (bf16_t*)(ws + 288 * MiB); p.va = (bf16_t*)(ws + 336 * MiB); p.ka = (bf16_t*)(ws + 400 * MiB); p.x1 = (float*)(ws + 126 * MiB);
    p.scores = (float*)(ws + 222 * MiB);
    p.ctl = (unsigned*)ws;
    p.ropeT = (float2*)(ws + 448 * MiB);
    p.ssq = (float*)(ws + 64 * 1024);
    p.attout = (bf16_t*)(ws + 33 * MiB);
    p.U8 = (unsigned char*)(ws + 450 * MiB); p.V8 = (unsigned char*)(ws + 368 * MiB);
    p.xg = (bf16_t*)(ws + 190 * MiB);
    p.ssq2 = (float*)(ws + 482 * MiB);

    static int grid_blocks = 0;
    if (!grid_blocks) {
        if (hipFuncSetAttribute((const void*)mega, hipFuncAttributeMaxDynamicSharedMemorySize, LDS_BYTES) != hipSuccess) { fprintf(stderr, "hipFuncSetAttribute failed\n"); return; }
        int dev = 0, cus = 0, per_cu = 0;
        (void)hipGetDevice(&dev);
        (void)hipDeviceGetAttribute(&cus, hipDeviceAttributeMultiprocessorCount, dev);
        (void)hipOccupancyMaxActiveBlocksPerMultiprocessor(&per_cu, (const void*)mega, 512, LDS_BYTES);
        if (per_cu < 1 || cus < 1) { fprintf(stderr, "occupancy query says %d blocks/CU on %d CUs\n", per_cu, cus); return; }
        grid_blocks = cus;
    }
    if (hipMemsetAsync(d_ws, 0, 16384, stream) != hipSuccess) { fprintf(stderr, "memset of the barrier words failed\n"); return; }
    void* args[] = {&p};
    hipError_t e = hipLaunchCooperativeKernel((const void*)mega, dim3(grid_blocks), dim3(512), args, LDS_BYTES, stream);
    if (e != hipSuccess) fprintf(stderr, "cooperative launch failed: %s (grid %d)\n", hipGetErrorString(e), grid_blocks);
}
```

```cpp
#include <hip/hip_runtime.h>
#include <hip/hip_cooperative_groups.h>
#include <stdint.h>
#include <math.h>
#include <cstdio>
namespace cg = cooperative_groups;

namespace pg8 {
#define PG8_LAS __attribute__((address_space(3)))
typedef unsigned short bf16_t;
typedef short bf16x8 __attribute__((ext_vector_type(8)));
typedef float f32x4 __attribute__((ext_vector_type(4)));
typedef unsigned u32x4 __attribute__((ext_vector_type(4)));
constexpr int BM = 256, BK = 64, HALF = 128, HTB = HALF * BK * 2  , STAGE_BYTES = 8 * HTB, NXCD = 8, WGM = 8;

__host__ __device__ __forceinline__ int lds_byte(int r, int c) { const int st = (r >> 4) * 2 + (c >> 5), rr = r & 15, cc = c & 31, ob = rr * 64 + cc * 2; return st * 1024 + (ob ^ (((ob >> 9) & 1) << 5)); }
__host__ __device__ __forceinline__ void stage_rc(int b, int& R, int& C) { const int st = b / 1024, sb = b % 1024, swz = sb ^ (((sb >> 9) & 1) << 5); R = (st >> 1) * 16 + swz / 64; C = (st & 1) * 32 + (swz % 64) / 2; }
__host__ __device__ __forceinline__ int perm32(int rho) { const int n = rho >> 4, i = rho & 15; return 8 * (i >> 2) + 4 * n + (i & 3); }

struct Unit { int pm, pn; };
struct Gemm { const bf16_t* A; const bf16_t* Bt; int M, N, K; };

struct StaticOrder {
    int nM, nN, nwg, G, c;
    __host__ __device__ void init(int M, int N, int G_, int c_) { nM = M / BM; nN = N / BM; nwg = nM * nN; G = G_; c = c_; }
    __host__ __device__ bool next(int i, Unit& u) const {
        const long L = (long)i * G + c; if (L >= nwg) return false;
        int wgid = (int)L; { const int q = nwg / NXCD, r = nwg % NXCD, xcd = wgid % NXCD, off = wgid / NXCD; wgid = (xcd < r ? xcd * (q + 1) : r * (q + 1) + (xcd - r) * q) + off; }
        const int nig = WGM * nN, gid = wgid / nig, fm = gid * WGM, gsz = (nM - fm) < WGM ? (nM - fm) : WGM;
        u.pm = fm + ((wgid % nig) % gsz); u.pn = (wgid % nig) / gsz; return true;
    }
    __device__ __forceinline__ void a_ready(const Unit&) const {}
    __device__ __forceinline__ void done(const Unit&) const {}
};

typedef float cvt_pk_bf16_f32x2 __attribute__((ext_vector_type(2))); typedef __bf16 cvt_pk_bf16_bf16x2 __attribute__((ext_vector_type(2)));
__device__ __forceinline__ unsigned cvt_pk_bf16(float lo, float hi) { const cvt_pk_bf16_f32x2 v = {lo, hi}; const cvt_pk_bf16_bf16x2 b = __builtin_convertvector(v, cvt_pk_bf16_bf16x2); return __builtin_bit_cast(unsigned, b); }
__device__ __forceinline__ u32x4 pack8bf(const f32x4& v0, const f32x4& v1) { u32x4 w; w.x = cvt_pk_bf16(v0[0], v0[1]); w.y = cvt_pk_bf16(v0[2], v0[3]); w.z = cvt_pk_bf16(v1[0], v1[1]); w.w = cvt_pk_bf16(v1[2], v1[3]); return w; }

struct EpiStoreBf16 {
    static constexpr bool PERM = true, AFTER_DRAIN = false;
    bf16_t* O; int ldc;
    __device__ __forceinline__ void operator()(const f32x4 (&acc)[2][2][4][2], const Unit& u, int wr, int wc, int fr, int fq) const {
        const int row0 = u.pm * BM + wr * 64 + fr, col0 = u.pn * BM + wc * 32 + 8 * fq;
#pragma unroll
        for (int ai = 0; ai < 2; ++ai)
#pragma unroll
            for (int m = 0; m < 4; ++m) { bf16_t* rowp = O + (size_t)(row0 + ai * HALF + m * 16) * ldc + col0;
#pragma unroll
                for (int bj = 0; bj < 2; ++bj) *(u32x4*)(rowp + bj * HALF) = pack8bf(acc[ai][bj][m][0], acc[ai][bj][m][1]); }
    }
};
template <bool RES> struct EpiStoreF32 {
    static constexpr bool PERM = true, AFTER_DRAIN = false;
    float* O; const float* res; int ldc;
    __device__ __forceinline__ void operator()(const f32x4 (&acc)[2][2][4][2], const Unit& u, int wr, int wc, int fr, int fq) const {
        const int row0 = u.pm * BM + wr * 64 + fr, col0 = u.pn * BM + wc * 32 + 8 * fq;
#pragma unroll
        for (int ai = 0; ai < 2; ++ai)
#pragma unroll
            for (int m = 0; m < 4; ++m) { const size_t off = (size_t)(row0 + ai * HALF + m * 16) * ldc + col0;
#pragma unroll
                for (int bj = 0; bj < 2; ++bj) { f32x4 v0 = acc[ai][bj][m][0], v1 = acc[ai][bj][m][1];
                    if (RES) { v0 += *(const f32x4*)(res + off + bj * HALF); v1 += *(const f32x4*)(res + off + bj * HALF + 4); }
                    *(f32x4*)(O + off + bj * HALF) = v0; *(f32x4*)(O + off + bj * HALF + 4) = v1; } }
    }
};
#define EPI_LDSBAR() do { asm volatile("s_waitcnt lgkmcnt(0)" ::: "memory"); __builtin_amdgcn_s_barrier(); asm volatile("" ::: "memory"); } while (0)
struct EpiInProj {
    static constexpr bool PERM = true, AFTER_DRAIN = false;
    bf16_t *cq, *ckv, *fq, *fk, *fv, *gates, *kpe; float* lf; const float *b_gate, *b_forget; float* ssq; const float *gfq, *gfk; PG8_LAS float* xs;
    __device__ __forceinline__ void operator()(const f32x4 (&acc)[2][2][4][2], const Unit& u, int wr, int wc, int fr, int fq_) const {
        const int pn = u.pn, row0 = u.pm * BM + wr * 64 + fr, cw = wc * 32 + 8 * fq_;
        if (pn < 4) {
            bf16_t* base = pn < 2 ? cq : ckv; const int colt = (pn & 1) * 256;
#pragma unroll
            for (int ai = 0; ai < 2; ++ai)
#pragma unroll
                for (int m = 0; m < 4; ++m) { const int row = row0 + ai * HALF + m * 16; bf16_t* rowp = base + (size_t)row * 512 + colt + cw; float s = 0.f;
#pragma unroll
                    for (int bj = 0; bj < 2; ++bj) { const f32x4 v0 = acc[ai][bj][m][0], v1 = acc[ai][bj][m][1];
                        s += (v0[0] * v0[0] + v0[1] * v0[1]) + (v0[2] * v0[2] + v0[3] * v0[3]) + (v1[0] * v1[0] + v1[1] * v1[1]) + (v1[2] * v1[2] + v1[3] * v1[3]);
                        *(u32x4*)(rowp + bj * HALF) = pack8bf(v0, v1); }
                    s += __shfl_xor(s, 16); s += __shfl_xor(s, 32);
                    if (fq_ == 0) ssq[((size_t)pn * 8192 + row) * 4 + wc] = s; }
        } else if (pn < 20) {
            const bool isq = pn < 12; bf16_t* base = isq ? fq : fk; const int colt = (pn - (isq ? 4 : 12)) * 256; const float* g = isq ? gfq : gfk;
            const float qs = isq ? 0.12751743f : 1.f;
#pragma unroll
            for (int ai = 0; ai < 2; ++ai)
#pragma unroll
                for (int m = 0; m < 4; ++m)
#pragma unroll
                    for (int bj = 0; bj < 2; ++bj) { const f32x4 v0 = acc[ai][bj][m][0], v1 = acc[ai][bj][m][1];
                        float s = (v0[0] * v0[0] + v0[1] * v0[1]) + (v0[2] * v0[2] + v0[3] * v0[3]) + (v1[0] * v1[0] + v1[1] * v1[1]) + (v1[2] * v1[2] + v1[3] * v1[3]);
                        s += __shfl_xor(s, 16); s += __shfl_xor(s, 32);
                        if (fq_ == 0) xs[((ai * HALF + wr * 64 + m * 16 + fr) * 2 + bj) * 4 + wc] = s; }
            EPI_LDSBAR();
            const f32x4 g0 = *(const f32x4*)(g + cw) * qs, g1 = *(const f32x4*)(g + cw + 4) * qs;
#pragma unroll
            for (int ai = 0; ai < 2; ++ai)
#pragma unroll
                for (int m = 0; m < 4; ++m) { bf16_t* rowp = base + (size_t)(row0 + ai * HALF + m * 16) * 2048 + colt + cw;
#pragma unroll
                    for (int bj = 0; bj < 2; ++bj) { const f32x4 t4 = *(const PG8_LAS f32x4*)(xs + ((ai * HALF + wr * 64 + m * 16 + fr) * 2 + bj) * 4);
                        const float r = rsqrtf(((t4[0] + t4[1]) + (t4[2] + t4[3])) * (1.f / 128.f) + 1e-6f);
                        *(u32x4*)(rowp + bj * HALF) = pack8bf(acc[ai][bj][m][0] * g0 * r, acc[ai][bj][m][1] * g1 * r); } }
        } else if (pn < 28) {
            const int colt = (pn - 20) * 256;
#pragma unroll
            for (int ai = 0; ai < 2; ++ai)
#pragma unroll
                for (int m = 0; m < 4; ++m) { bf16_t* rowp = fv + (size_t)(row0 + ai * HALF + m * 16) * 2048 + colt + cw;
#pragma unroll
                    for (int bj = 0; bj < 2; ++bj) *(u32x4*)(rowp + bj * HALF) = pack8bf(acc[ai][bj][m][0], acc[ai][bj][m][1]); }
        } else if (pn < 44) {
            const int colt = (pn - 28) * 256 + cw;
#pragma unroll
            for (int bj = 0; bj < 2; ++bj) {
                const f32x4 b0 = *(const f32x4*)(b_gate + colt + bj * HALF), b1 = *(const f32x4*)(b_gate + colt + bj * HALF + 4);
#pragma unroll
                for (int ai = 0; ai < 2; ++ai)
#pragma unroll
                    for (int m = 0; m < 4; ++m) {
                        f32x4 v0 = acc[ai][bj][m][0] + b0, v1 = acc[ai][bj][m][1] + b1;
#pragma unroll
                        for (int e = 0; e < 4; ++e) { v0[e] = __builtin_amdgcn_rcpf(1.f + __expf(-v0[e])); v1[e] = __builtin_amdgcn_rcpf(1.f + __expf(-v1[e])); }
                        *(u32x4*)(gates + (size_t)(row0 + ai * HALF + m * 16) * 4096 + colt + bj * HALF) = pack8bf(v0, v1); }
            }
        } else {
            if (cw < 64) {
#pragma unroll
                for (int ai = 0; ai < 2; ++ai)
#pragma unroll
                    for (int m = 0; m < 4; ++m) *(u32x4*)(kpe + (size_t)(row0 + ai * HALF + m * 16) * 64 + cw) = pack8bf(acc[ai][0][m][0], acc[ai][0][m][1]);
            } else if (cw < 80) {
                const int h0 = cw - 64;
                const f32x4 b0 = *(const f32x4*)(b_forget + h0), b1 = *(const f32x4*)(b_forget + h0 + 4);
#pragma unroll
                for (int ai = 0; ai < 2; ++ai)
#pragma unroll
                    for (int m = 0; m < 4; ++m) { const int row = row0 + ai * HALF + m * 16;
                        f32x4 z0 = acc[ai][0][m][0] + b0, z1 = acc[ai][0][m][1] + b1;
#pragma unroll
                        for (int e = 0; e < 4; ++e) { z0[e] = fminf(z0[e], 0.f) - __logf(1.f + __expf(-fabsf(z0[e]))); z1[e] = fminf(z1[e], 0.f) - __logf(1.f + __expf(-fabsf(z1[e]))); }
                        *(f32x4*)(lf + (size_t)row * 16 + h0) = z0; *(f32x4*)(lf + (size_t)row * 16 + h0 + 4) = z1; }
            }
        }
    }
};
__device__ __forceinline__ float lat_rinv(const float* ssq, int part0, int row) {
    const f32x4 a = *(const f32x4*)(ssq + ((size_t)part0 * 8192 + row) * 4), b = *(const f32x4*)(ssq + ((size_t)(part0 + 1) * 8192 + row) * 4);
    return rsqrtf((((a[0] + a[1]) + (a[2] + a[3])) + ((b[0] + b[1]) + (b[2] + b[3]))) * (1.f / 512.f) + 1e-6f);
}
struct EpiQ {
    static constexpr bool PERM = true, AFTER_DRAIN = false;
    bf16_t* qa; const float* ssq; const float* gq; const float2* ropeT; PG8_LAS float* xs;
    __device__ __forceinline__ void operator()(const f32x4 (&acc)[2][2][4][2], const Unit& u, int wr, int wc, int fr, int fq_) const {
        const int h = u.pn, row0 = u.pm * BM + wr * 64 + fr, cw = wc * 32 + 8 * fq_;
        float rl[2][4];
#pragma unroll
        for (int ai = 0; ai < 2; ++ai)
#pragma unroll
            for (int m = 0; m < 4; ++m) { rl[ai][m] = lat_rinv(ssq, 0, row0 + ai * HALF + m * 16); float s = 0.f;
#pragma unroll
                for (int bj = 0; bj < 2; ++bj) { const f32x4 v0 = acc[ai][bj][m][0], v1 = acc[ai][bj][m][1];
                    s += (v0[0] * v0[0] + v0[1] * v0[1]) + (v0[2] * v0[2] + v0[3] * v0[3]) + (v1[0] * v1[0] + v1[1] * v1[1]) + (v1[2] * v1[2] + v1[3] * v1[3]); }
                s *= rl[ai][m] * rl[ai][m];
                s += __shfl_xor(s, 16); s += __shfl_xor(s, 32);
                if (fq_ == 0) xs[(ai * HALF + wr * 64 + m * 16 + fr) * 4 + wc] = s; }
        EPI_LDSBAR();
        const float qs = 0.10411754f;
        const f32x4 g0 = *(const f32x4*)(gq + cw) * qs, g1 = *(const f32x4*)(gq + cw + 4) * qs;
        const int pp = 16 * (wc & 1) + 4 * fq_;
        const f32x4 ga = *(const f32x4*)(gq + 128 + pp) * qs, gb = *(const f32x4*)(gq + 160 + pp) * qs;
#pragma unroll
        for (int ai = 0; ai < 2; ++ai)
#pragma unroll
            for (int m = 0; m < 4; ++m) { const int row = row0 + ai * HALF + m * 16;
                const f32x4 t4 = *(const PG8_LAS f32x4*)(xs + (ai * HALF + wr * 64 + m * 16 + fr) * 4);
                const float r = rsqrtf(((t4[0] + t4[1]) + (t4[2] + t4[3])) * (1.f / 192.f) + 1e-6f) * rl[ai][m];
                bf16_t* rowp = qa + (size_t)row * 3072 + h * 192;
                *(u32x4*)(rowp + cw) = pack8bf(acc[ai][0][m][0] * g0 * r, acc[ai][0][m][1] * g1 * r);
                if (wc < 2) { const f32x4 c01 = *(const f32x4*)(ropeT + (size_t)row * 32 + pp), c23 = *(const f32x4*)(ropeT + (size_t)row * 32 + pp + 2);
                    const f32x4 z0 = acc[ai][1][m][0] * r, z1 = acc[ai][1][m][1] * r;
                    const float a0 = z0[0] * ga[0], b0 = z0[1] * gb[0], a1 = z0[2] * ga[1], b1 = z0[3] * gb[1], a2 = z1[0] * ga[2], b2 = z1[1] * gb[2], a3 = z1[2] * ga[3], b3 = z1[3] * gb[3];
                    const f32x4 o0 = {a0 * c01[0] - b0 * c01[1], a0 * c01[1] + b0 * c01[0], a1 * c01[2] - b1 * c01[3], a1 * c01[3] + b1 * c01[2]};
                    const f32x4 o1 = {a2 * c23[0] - b2 * c23[1], a2 * c23[1] + b2 * c23[0], a3 * c23[2] - b3 * c23[3], a3 * c23[3] + b3 * c23[2]};
                    *(u32x4*)(rowp + 128 + cw) = pack8bf(o0, o1); } }
    }
};
struct EpiKV {
    static constexpr bool PERM = true, AFTER_DRAIN = false;
    bf16_t *ka, *va; const bf16_t* kpe; const float* ssq; const float* gk; const float2* ropeT; PG8_LAS float* xs;
    __device__ __forceinline__ void operator()(const f32x4 (&acc)[2][2][4][2], const Unit& u, int wr, int wc, int fr, int fq_) const {
        const int h = u.pn, row0 = u.pm * BM + wr * 64 + fr, cw = wc * 32 + 8 * fq_;
        float rl[2][4]; f32x4 kp[2][4];
#pragma unroll
        for (int ai = 0; ai < 2; ++ai)
#pragma unroll
            for (int m = 0; m < 4; ++m) { const int row = row0 + ai * HALF + m * 16; rl[ai][m] = lat_rinv(ssq, 2, row);
                const uint2 w = *(const uint2*)(kpe + (size_t)row * 64 + 16 * wc + 4 * fq_);
                kp[ai][m] = (f32x4){__uint_as_float(w.x << 16), __uint_as_float(w.x & 0xffff0000u), __uint_as_float(w.y << 16), __uint_as_float(w.y & 0xffff0000u)};
                const f32x4 v0 = acc[ai][0][m][0], v1 = acc[ai][0][m][1];
                float s = ((v0[0] * v0[0] + v0[1] * v0[1]) + (v0[2] * v0[2] + v0[3] * v0[3]) + (v1[0] * v1[0] + v1[1] * v1[1]) + (v1[2] * v1[2] + v1[3] * v1[3])) * (rl[ai][m] * rl[ai][m]);
                s += (kp[ai][m][0] * kp[ai][m][0] + kp[ai][m][1] * kp[ai][m][1]) + (kp[ai][m][2] * kp[ai][m][2] + kp[ai][m][3] * kp[ai][m][3]);
                s += __shfl_xor(s, 16); s += __shfl_xor(s, 32);
                if (fq_ == 0) xs[(ai * HALF + wr * 64 + m * 16 + fr) * 4 + wc] = s;
                *(u32x4*)(va + (size_t)row * 2048 + h * 128 + cw) = pack8bf(acc[ai][1][m][0] * rl[ai][m], acc[ai][1][m][1] * rl[ai][m]); }
        EPI_LDSBAR();
        const f32x4 g0 = *(const f32x4*)(gk + cw), g1 = *(const f32x4*)(gk + cw + 4);
        const int pp = 8 * wc + 2 * fq_;
        const float ga0 = gk[128 + pp], ga1 = gk[128 + pp + 1], gb0 = gk[160 + pp], gb1 = gk[160 + pp + 1];
#pragma unroll
        for (int ai = 0; ai < 2; ++ai)
#pragma unroll
            for (int m = 0; m < 4; ++m) { const int row = row0 + ai * HALF + m * 16;
                const f32x4 t4 = *(const PG8_LAS f32x4*)(xs + (ai * HALF + wr * 64 + m * 16 + fr) * 4);
                const float r = rsqrtf(((t4[0] + t4[1]) + (t4[2] + t4[3])) * (1.f / 192.f) + 1e-6f), rn = r * rl[ai][m];
                bf16_t* rowp = ka + (size_t)row * 3072 + h * 192;
                *(u32x4*)(rowp + cw) = pack8bf(acc[ai][0][m][0] * g0 * rn, acc[ai][0][m][1] * g1 * rn);
                const f32x4 cs = *(const f32x4*)(ropeT + (size_t)row * 32 + pp);
                const float a0 = kp[ai][m][0] * r * ga0, b0 = kp[ai][m][1] * r * gb0, a1 = kp[ai][m][2] * r * ga1, b1 = kp[ai][m][3] * r * gb1;
                uint2 o; o.x = cvt_pk_bf16(a0 * cs[0] - b0 * cs[1], a0 * cs[1] + b0 * cs[0]); o.y = cvt_pk_bf16(a1 * cs[2] - b1 * cs[3], a1 * cs[3] + b1 * cs[2]);
                *(uint2*)(rowp + 128 + 16 * wc + 4 * fq_) = o; }
    }
};

struct EpiX1 {
    static constexpr bool PERM = true, AFTER_DRAIN = false;
    float* x1; const float* x; bf16_t* xg; const float* g; float* ssq2;
    __device__ __forceinline__ void operator()(const f32x4 (&acc)[2][2][4][2], const Unit& u, int wr, int wc, int fr, int fq_) const {
        const int row0 = u.pm * BM + wr * 64 + fr, col0 = u.pn * BM + wc * 32 + 8 * fq_;
        f32x4 gg[2][2];
#pragma unroll
        for (int bj = 0; bj < 2; ++bj) { gg[bj][0] = *(const f32x4*)(g + col0 + bj * HALF); gg[bj][1] = *(const f32x4*)(g + col0 + bj * HALF + 4); }
#pragma unroll
        for (int ai = 0; ai < 2; ++ai)
#pragma unroll
            for (int m = 0; m < 4; ++m) { const int row = row0 + ai * HALF + m * 16; const size_t off = (size_t)row * 2048 + col0; float s = 0.f;
#pragma unroll
                for (int bj = 0; bj < 2; ++bj) { const f32x4 v0 = acc[ai][bj][m][0] + *(const f32x4*)(x + off + bj * HALF), v1 = acc[ai][bj][m][1] + *(const f32x4*)(x + off + bj * HALF + 4);
                    *(f32x4*)(x1 + off + bj * HALF) = v0; *(f32x4*)(x1 + off + bj * HALF + 4) = v1;
                    s += (v0[0] * v0[0] + v0[1] * v0[1]) + (v0[2] * v0[2] + v0[3] * v0[3]) + (v1[0] * v1[0] + v1[1] * v1[1]) + (v1[2] * v1[2] + v1[3] * v1[3]);
                    *(u32x4*)(xg + off + bj * HALF) = pack8bf(v0 * gg[bj][0], v1 * gg[bj][1]); }
                s += __shfl_xor(s, 16); s += __shfl_xor(s, 32);
                if (fq_ == 0) ssq2[((size_t)u.pn * 8192 + row) * 4 + wc] = s; }
    }
};
__device__ __forceinline__ float ffn_rinv(const float* ssq2, int row) {
    float t = 0.f;
#pragma unroll
    for (int pn = 0; pn < 8; ++pn) { const f32x4 a = *(const f32x4*)(ssq2 + ((size_t)pn * 8192 + row) * 4); t += (a[0] + a[1]) + (a[2] + a[3]); }
    return rsqrtf(t * (1.f / 2048.f) + 1e-6f);
}
struct EpiScores {
    static constexpr bool PERM = true, AFTER_DRAIN = false;
    float* O; const float* ssq2;
    __device__ __forceinline__ void operator()(const f32x4 (&acc)[2][2][4][2], const Unit& u, int wr, int wc, int fr, int fq_) const {
        const int row0 = u.pm * BM + wr * 64 + fr, col0 = u.pn * BM + wc * 32 + 8 * fq_;
#pragma unroll
        for (int ai = 0; ai < 2; ++ai)
#pragma unroll
            for (int m = 0; m < 4; ++m) { const int row = row0 + ai * HALF + m * 16; const float r = ffn_rinv(ssq2, row); const size_t off = (size_t)row * 2048 + col0;
#pragma unroll
                for (int bj = 0; bj < 2; ++bj) { *(f32x4*)(O + off + bj * HALF) = acc[ai][bj][m][0] * r; *(f32x4*)(O + off + bj * HALF + 4) = acc[ai][bj][m][1] * r; } }
    }
};
template <class Epi, class Sched, bool ALIGN_EPI = false, bool SP2 = false>
__device__ __forceinline__ void gemm_phase(PG8_LAS unsigned char* lds, const Gemm g, const Sched& S, const Epi& E) {
    int tid = threadIdx.x; asm volatile("" : "+v"(tid));
    const int wid = __builtin_amdgcn_readfirstlane(tid >> 6), lane = tid & 63, wr = wid >> 2, wc = wid & 3, fr = lane & 15, fq = lane >> 4;
    const int K = g.K, nt = K / BK;
    unsigned voffA[2], voffB[2];
#pragma unroll
    for (int i = 0; i < 2; ++i) { int R, C; stage_rc(tid * 16 + i * 8192, R, C); const int Rb = Epi::PERM ? ((R & ~31) + perm32(R & 31)) : R;
        voffA[i] = (unsigned)(R * K + C) * 2u; voffB[i] = (unsigned)(Rb * K + C) * 2u; }
    const size_t kstep = (size_t)(BK * 2);
    const size_t hstep = (size_t)HALF * K * 2;
    const size_t tstep = 2 * hstep;
    const unsigned ldsw = (unsigned)wid * 1024u;
    const int aoff = lds_byte(wr * 64 + fr, fq * 8), boff = lds_byte(wc * 32 + fr, fq * 8);
#define PG8_SA(b, h) (((b) * 2 + (h)) * HTB)
#define PG8_SB(b, h) ((4 + (b) * 2 + (h)) * HTB)
#define PG8_STAGE(bufoff, gbase, voff) do { _Pragma("unroll") for (int _i = 0; _i < 2; ++_i) \
        __builtin_amdgcn_global_load_lds((const unsigned*)((const char*)(gbase) + (voff)[_i]), (PG8_LAS unsigned*)(lds + (bufoff) + ldsw + _i * 8192), 16, 0, 0); } while (0)
#define PG8_LDA(dst, b, h) do { _Pragma("unroll") for (int m = 0; m < 4; ++m) _Pragma("unroll") for (int k = 0; k < 2; ++k) dst[m][k] = *(const PG8_LAS bf16x8*)(lds + PG8_SA(b, h) + aoff + m * 2048 + k * 1024); } while (0)
#define PG8_LDB(dst, b, h) do { _Pragma("unroll") for (int n = 0; n < 2; ++n) _Pragma("unroll") for (int k = 0; k < 2; ++k) dst[n][k] = *(const PG8_LAS bf16x8*)(lds + PG8_SB(b, h) + boff + n * 2048 + k * 1024); } while (0)
#define PG8_MMA(ai, bj, At, Bt) do { __builtin_amdgcn_s_setprio(1); _Pragma("unroll") for (int m = 0; m < 4; ++m) _Pragma("unroll") for (int n = 0; n < 2; ++n) _Pragma("unroll") for (int k = 0; k < 2; ++k) \
        acc[ai][bj][m][n] = __builtin_amdgcn_mfma_f32_16x16x32_bf16(Bt[n][k], At[m][k], acc[ai][bj][m][n], 0, 0, 0); __builtin_amdgcn_s_setprio(0); } while (0)
#define PG8_WAIT_V(n) asm volatile("s_waitcnt vmcnt(" #n ")" ::: "memory")
#define PG8_WAIT_L(n) asm volatile("s_waitcnt lgkmcnt(" #n ")" ::: "memory")
#define PG8_BAR __builtin_amdgcn_s_barrier()
#define PG8_SCHED __builtin_amdgcn_sched_barrier(0)
    Unit cur, nxt; int ui = 0;
    if (!S.next(0, cur)) return;
    f32x4 acc[2][2][4][2];
#pragma unroll
    for (int a = 0; a < 2; ++a)
#pragma unroll
        for (int b = 0; b < 2; ++b)
#pragma unroll
            for (int m = 0; m < 4; ++m)
#pragma unroll
                for (int n = 0; n < 2; ++n) acc[a][b][m][n] = (f32x4){0.f, 0.f, 0.f, 0.f};
    bf16x8 At[4][2], B0[2][2], B1[2][2];
    const char* cA = (const char*)g.A + (size_t)cur.pm * tstep; const char* cB = (const char*)g.Bt + (size_t)cur.pn * tstep;
    S.a_ready(cur);
    if constexpr (SP2) {
        PG8_STAGE(PG8_SB(0, 0), cB, voffB); PG8_STAGE(PG8_SB(0, 1), cB + hstep, voffB); PG8_STAGE(PG8_SA(0, 0), cA, voffA); PG8_STAGE(PG8_SA(0, 1), cA + hstep, voffA);
        if (wr == 1) PG8_BAR;
        PG8_WAIT_V(2); PG8_BAR;
        PG8_STAGE(PG8_SB(1, 0), cB + kstep, voffB); PG8_STAGE(PG8_SA(1, 0), cA + kstep, voffA); PG8_STAGE(PG8_SB(1, 1), cB + hstep + kstep, voffB);
        PG8_WAIT_V(6); PG8_BAR;
    } else {
        PG8_STAGE(PG8_SB(0, 0), cB, voffB); PG8_STAGE(PG8_SA(0, 0), cA, voffA); PG8_STAGE(PG8_SB(0, 1), cB + hstep, voffB); PG8_STAGE(PG8_SA(0, 1), cA + hstep, voffA);
        if (wr == 1) PG8_BAR;
        PG8_WAIT_V(4); PG8_BAR;
        PG8_STAGE(PG8_SB(1, 0), cB + kstep, voffB); PG8_STAGE(PG8_SA(1, 0), cA + kstep, voffA); PG8_STAGE(PG8_SB(1, 1), cB + hstep + kstep, voffB);
        PG8_WAIT_V(6); PG8_BAR;
    }
    for (;;) {
        const bool has_next = S.next(ui + 1, nxt);
        const char* nA = has_next ? (const char*)g.A + (size_t)nxt.pm * tstep : cA; const char* nB = has_next ? (const char*)g.Bt + (size_t)nxt.pn * tstep : cB;
        for (int t = 0; t < nt; t += 2) {
            const bool last = (t == nt - 2);
            const char* a1 = cA + (size_t)(t + 1) * kstep;
            const char* a2 = last ? nA : cA + (size_t)(t + 2) * kstep; const char* b2 = last ? nB : cB + (size_t)(t + 2) * kstep;
            const char* a3 = a2 + kstep; const char* b3 = b2 + kstep;
            if (last && has_next) S.a_ready(nxt);
            if constexpr (SP2) {
            PG8_LDB(B0, 0, 0); PG8_LDB(B1, 0, 1); PG8_SCHED; PG8_LDA(At, 0, 0); PG8_STAGE(PG8_SA(1, 1), a1 + hstep, voffA);
            PG8_WAIT_V(8); PG8_WAIT_L(0); PG8_BAR; PG8_MMA(0, 0, At, B0); PG8_MMA(0, 1, At, B1); PG8_BAR; PG8_SCHED;
            PG8_LDA(At, 0, 1); PG8_STAGE(PG8_SB(0, 0), b2, voffB); PG8_STAGE(PG8_SB(0, 1), b2 + hstep, voffB); PG8_STAGE(PG8_SA(0, 0), a2, voffA);
            PG8_WAIT_V(8); PG8_WAIT_L(0); PG8_BAR; PG8_MMA(1, 0, At, B0); PG8_MMA(1, 1, At, B1); PG8_BAR; PG8_SCHED;
            PG8_LDB(B0, 1, 0); PG8_LDB(B1, 1, 1); PG8_SCHED; PG8_LDA(At, 1, 0); PG8_STAGE(PG8_SA(0, 1), a2 + hstep, voffA);
            PG8_WAIT_V(8); PG8_WAIT_L(0); PG8_BAR; PG8_MMA(0, 0, At, B0); PG8_MMA(0, 1, At, B1); PG8_BAR; PG8_SCHED;
            PG8_LDA(At, 1, 1); PG8_STAGE(PG8_SB(1, 0), b3, voffB); PG8_STAGE(PG8_SB(1, 1), b3 + hstep, voffB); PG8_STAGE(PG8_SA(1, 0), a3, voffA);
            PG8_WAIT_V(8); PG8_WAIT_L(0); PG8_BAR; PG8_MMA(1, 0, At, B0); PG8_MMA(1, 1, At, B1); PG8_BAR; PG8_SCHED;
            } else {
            PG8_LDB(B0, 0, 0); PG8_SCHED; PG8_LDA(At, 0, 0); PG8_STAGE(PG8_SA(1, 1), a1 + hstep, voffA);
            PG8_WAIT_L(8); PG8_BAR; PG8_WAIT_L(0); PG8_MMA(0, 0, At, B0); PG8_BAR; PG8_SCHED;
            PG8_LDB(B1, 0, 1); PG8_STAGE(PG8_SB(0, 0), b2, voffB);
            PG8_BAR; PG8_WAIT_L(0); PG8_MMA(0, 1, At, B1); PG8_BAR;
            PG8_LDA(At, 0, 1); PG8_STAGE(PG8_SA(0, 0), a2, voffA);
            PG8_BAR; PG8_WAIT_L(0); PG8_MMA(1, 0, At, B0); PG8_BAR; PG8_SCHED;
            PG8_STAGE(PG8_SB(0, 1), b2 + hstep, voffB);
            PG8_WAIT_V(6); PG8_BAR; PG8_MMA(1, 1, At, B1); PG8_BAR;
            PG8_LDB(B0, 1, 0); PG8_SCHED; PG8_LDA(At, 1, 0); PG8_STAGE(PG8_SA(0, 1), a2 + hstep, voffA);
            PG8_WAIT_L(8); PG8_BAR; PG8_WAIT_L(0); PG8_MMA(0, 0, At, B0); PG8_BAR; PG8_SCHED;
            PG8_LDB(B1, 1, 1); PG8_STAGE(PG8_SB(1, 0), b3, voffB);
            PG8_BAR; PG8_WAIT_L(0); PG8_MMA(0, 1, At, B1); PG8_BAR;
            PG8_LDA(At, 1, 1); PG8_STAGE(PG8_SA(1, 0), a3, voffA);
            PG8_BAR; PG8_WAIT_L(0); PG8_MMA(1, 0, At, B0); PG8_BAR; PG8_SCHED;
            PG8_STAGE(PG8_SB(1, 1), b3 + hstep, voffB);
            PG8_WAIT_V(6); PG8_BAR; PG8_MMA(1, 1, At, B1); PG8_BAR;
            }
        }
        if constexpr (ALIGN_EPI) { if (wr == 0) PG8_BAR; }
        if constexpr (!Epi::AFTER_DRAIN) { E(acc, cur, wr, wc, fr, fq); S.done(cur); }
        if (!has_next) break;
#pragma unroll
        for (int a = 0; a < 2; ++a)
#pragma unroll
            for (int b = 0; b < 2; ++b)
#pragma unroll
                for (int m = 0; m < 4; ++m)
#pragma unroll
                    for (int n = 0; n < 2; ++n) acc[a][b][m][n] = (f32x4){0.f, 0.f, 0.f, 0.f};
        cur = nxt; cA = nA; cB = nB; ++ui;
        if constexpr (ALIGN_EPI) { if (wr == 1) PG8_BAR; }
    }
    PG8_WAIT_V(0);
    if constexpr (!ALIGN_EPI) { if (wr == 0) PG8_BAR; }
    PG8_BAR;
    if constexpr (Epi::AFTER_DRAIN) { E.fused(acc, cur, wr, wc, fr, fq, lds, wid, lane); S.done(cur); }
#undef PG8_SA
#undef PG8_SB
#undef PG8_STAGE
#undef PG8_LDA
#undef PG8_LDB
#undef PG8_MMA
#undef PG8_WAIT_V
#undef PG8_WAIT_L
#undef PG8_BAR
#undef PG8_SCHED
}
}
namespace att {
typedef unsigned short bf16_t;
typedef short bf16x8 __attribute__((ext_vector_type(8)));
typedef short s16x4 __attribute__((ext_vector_type(4)));
typedef float f32x16 __attribute__((ext_vector_type(16)));
typedef float f32x4 __attribute__((ext_vector_type(4)));
typedef unsigned u32x4 __attribute__((ext_vector_type(4)));
#define ALAS __attribute__((address_space(3)))
#define ASBAR() __builtin_amdgcn_sched_barrier(0)
constexpr int SHM_V = 16384;
template <int DK> struct Lay { static constexpr int ROWB = DK * 2, SHM_K = 64 * ROWB, OFF_K = 2 * SHM_V, OFF_F = OFF_K + 2 * SHM_K, OFF_WS = OFF_F + 512, TOTAL = OFF_WS + 8 * 256; };

__device__ __forceinline__ int v_st(int k, int c) { const int kk = (k & ~0xC) | ((k & 4) << 1) | ((k & 8) >> 1); return ((kk >> 3) * 4 + (c >> 5)) * 512 + ((kk & 7) * 32 + (c & 31)) * 2; }
__device__ __forceinline__ int v_rd_base(int lane) { return ((lane & 3) << 3) | (((lane >> 2) & 3) << 6) | (((lane >> 4) & 1) << 5) | (((lane >> 5) & 1) << 8); }
__device__ __forceinline__ int crow(int r, int hi) { return (r & 3) + 8 * (r >> 2) + 4 * hi; }
typedef float cvtpk_f32x2 __attribute__((ext_vector_type(2))); typedef __bf16 cvtpk_bf16x2 __attribute__((ext_vector_type(2)));
__device__ __forceinline__ unsigned cvtpk(float lo, float hi) { const cvtpk_f32x2 v = {lo, hi}; const cvtpk_bf16x2 b = __builtin_convertvector(v, cvtpk_bf16x2); return __builtin_bit_cast(unsigned, b); }

__device__ __forceinline__ float wave_max_f(float v) {
#pragma unroll
    for (int o = 32; o >= 1; o >>= 1) v = fmaxf(v, __shfl_xor(v, o));
    return v;
}
__device__ __forceinline__ float att_max3(float a, float b, float c) { return __builtin_fmaxf(__builtin_fmaxf(a, b), c); }
template <int DK, bool FOX>
__device__ __forceinline__ void attn_block(unsigned char* smem, const bf16_t* __restrict__ Q, int ldq, const bf16_t* __restrict__ K, int ldk, const bf16_t* __restrict__ V, int ldv,
                                           const float* __restrict__ Fh, const bf16_t* __restrict__ gate, bf16_t* __restrict__ gout  , int qbk, const float* __restrict__ gq, const float* __restrict__ gk  ,
                                           const float* __restrict__ side_u, const float* __restrict__ side_v, unsigned char* __restrict__ side_u8, unsigned char* __restrict__ side_v8, int& side_next) {
    typedef Lay<DK> LY;
    constexpr int ND = DK / 16, NKC = DK / 8, NKI = (64 * NKC) / 512;
    int tid = threadIdx.x; asm volatile("" : "+v"(tid));
    const int wid = __builtin_amdgcn_readfirstlane(tid >> 6), lane = tid & 63, r32 = lane & 31, hi = lane >> 5;
    const int q0 = qbk * 256, qlo = q0 + wid * 32, qm = qlo + r32 - 4 * hi;
    const int NT = 4 * qbk + 4;
    ALAS unsigned char* lds = (ALAS unsigned char*)smem;
    ALAS float* F_lds = (ALAS float*)(lds + LY::OFF_F);
    ALAS float* wsl = (ALAS float*)(lds + LY::OFF_WS) + wid * 64;
    bf16x8 qr[ND];
#pragma unroll
    for (int d0 = 0; d0 < ND; ++d0) qr[d0] = *(const bf16x8*)(Q + (size_t)(qlo + r32) * ldq + d0 * 16 + hi * 8);
    const float fq = FOX ? Fh[qlo + r32] : 0.f;
    int kgo[NKI], vgo[2];
#pragma unroll
    for (int i = 0; i < NKI; ++i) { const int pp = (wid * NKI + i) * 64 + lane, row = pp / NKC, cpos = pp % NKC, ch = cpos ^ ((row >> 1) & 7); kgo[i] = row * ldk + ch * 8; }
#pragma unroll
    for (int i = 0; i < 2; ++i) { const int o = ((wid * 2 + i) * 64 + lane) * 16, st = o >> 9, e = (o & 511) >> 1, kk = (st >> 2) * 8 + (e >> 5), c = (st & 3) * 32 + (e & 31);
        const int k = (kk & ~0xC) | ((kk & 4) << 1) | ((kk & 8) >> 1); vgo[i] = k * ldv + c; }
    const int vb0 = (int)(uintptr_t)smem + v_rd_base(lane);
    int kbase[4];
#pragma unroll
    for (int dd = 0; dd < 4; ++dd) kbase[dd] = LY::OFF_K + r32 * LY::ROWB + (((((dd << 1) | hi) ^ ((r32 >> 1) & 7))) << 4);
    float stf = 0.f;
#define ATT_GLDS(kb, bf) do { _Pragma("unroll") for (int i = 0; i < NKI; ++i) \
            __builtin_amdgcn_global_load_lds((const unsigned*)(K + (size_t)(kb) * ldk + kgo[i]), (ALAS unsigned*)(lds + LY::OFF_K + (bf) * LY::SHM_K + (wid * NKI + i) * 1024), 16, 0, 0); \
        _Pragma("unroll") for (int i = 0; i < 2; ++i) \
            __builtin_amdgcn_global_load_lds((const unsigned*)(V + (size_t)(kb) * ldv + vgo[i]), (ALAS unsigned*)(lds + (bf) * SHM_V + (wid * 2 + i) * 1024), 16, 0, 0); \
        if (FOX && tid < 64) stf = Fh[(kb) + tid]; } while (0)
#define ATT_WRITEF(bf) do { if (FOX && tid < 64) F_lds[(bf) * 64 + tid] = stf; } while (0)
    int t_start = 0; float m_init = 0.f;
    if (FOX) {
        const float gqm = wave_max_f(fmaxf(fabsf(gq[lane]), fabsf(gq[lane + 64]))), gkm = wave_max_f(fmaxf(fabsf(gk[lane]), fabsf(gk[lane + 64])));
        const float qk_bound = 0.12751743f * 128.f * gqm * gkm;
        const float thr = 2.02f * qk_bound + 40.f, f0 = Fh[q0]; m_init = -thr;
        const int j0 = lane, j1 = lane + 64;
        const bool c0 = (j0 < 4 * qbk) && (Fh[j0 * 64 + 63] - f0 >= thr), c1 = (j1 < 4 * qbk) && (Fh[(j1 < 4 * qbk ? j1 : 0) * 64 + 63] - f0 >= thr);
        t_start = __builtin_popcountll(__ballot(c0)) + __builtin_popcountll(__ballot(c1));
        t_start = __builtin_amdgcn_readfirstlane(t_start); }
    ATT_GLDS(t_start * 64, t_start & 1); ATT_WRITEF(t_start & 1);
    float m_reg = FOX ? m_init : 0.f, l_reg = 0.f; f32x16 o[4];
#pragma unroll
    for (int d = 0; d < 4; ++d)
#pragma unroll
        for (int r = 0; r < 16; ++r) o[d][r] = 0.f;
    for (int t = t_start; t < NT; ++t) {
        const int buf = t & 1, kb = t * 64;
        asm volatile("s_waitcnt vmcnt(0)" ::: "memory");
        __syncthreads();
        if (t + 1 < NT) ATT_GLDS(kb + 64, buf ^ 1);
        const bool side = side_next < 64; f32x4 sd0, sd1; size_t sd_off = 0;
        if (side) { const bool isv = side_next >= 32; sd_off = ((size_t)(blockIdx.x * 32 + (side_next & 31)) * 512 + tid) * 8;
            const float* sp = (isv ? side_v : side_u) + sd_off; sd0 = *(const f32x4*)sp; sd1 = *(const f32x4*)(sp + 4); }
        f32x16 p0, p1;
        if (FOX) { const float fqm = fq - m_reg;
#pragma unroll
            for (int g = 0; g < 4; ++g) { const f32x4 f0 = *(const ALAS f32x4*)(F_lds + buf * 64 + 8 * g + 4 * hi), f1 = *(const ALAS f32x4*)(F_lds + buf * 64 + 32 + 8 * g + 4 * hi);
#pragma unroll
                for (int e = 0; e < 4; ++e) { p0[4 * g + e] = fqm - f0[e]; p1[4 * g + e] = fqm - f1[e]; } }
        } else { const float nm = -m_reg;
#pragma unroll
            for (int r = 0; r < 16; ++r) { p0[r] = nm; p1[r] = nm; }
        }
        {
            constexpr int KPF = 2;
            int ka[4];
#pragma unroll
            for (int dd = 0; dd < 4; ++dd) ka[dd] = (int)(uintptr_t)smem + buf * LY::SHM_K + kbase[dd];
            bf16x8 kb0[KPF + 1], kb1[KPF + 1];
#define ATT_KRD(dst, addr, off) asm volatile("ds_read_b128 %0, %1 offset:%2" : "=&v"(dst) : "v"(addr), "i"(off) : "memory")
#pragma unroll
            for (int d0 = 0; d0 < KPF; ++d0) { ATT_KRD(kb0[d0 % (KPF + 1)], ka[d0 & 3], (d0 >> 2) * 128); ATT_KRD(kb1[d0 % (KPF + 1)], ka[d0 & 3], (d0 >> 2) * 128 + 32 * LY::ROWB); }
#pragma unroll
            for (int d0 = 0; d0 < ND; ++d0) {
                if (d0 + KPF < ND) { constexpr int dummy = 0; (void)dummy;
                    ATT_KRD(kb0[(d0 + KPF) % (KPF + 1)], ka[(d0 + KPF) & 3], ((d0 + KPF) >> 2) * 128); ATT_KRD(kb1[(d0 + KPF) % (KPF + 1)], ka[(d0 + KPF) & 3], ((d0 + KPF) >> 2) * 128 + 32 * LY::ROWB); }
                const int rem = (ND - 1 - d0) < KPF ? (ND - 1 - d0) : KPF;
                if (rem >= 2) asm volatile("s_waitcnt lgkmcnt(4)" ::: "memory");
                else if (rem == 1) asm volatile("s_waitcnt lgkmcnt(2)" ::: "memory");
                else asm volatile("s_waitcnt lgkmcnt(0)" ::: "memory");
                ASBAR();
                p0 = __builtin_amdgcn_mfma_f32_32x32x16_bf16(kb0[d0 % (KPF + 1)], qr[d0], p0, 0, 0, 0);
                p1 = __builtin_amdgcn_mfma_f32_32x32x16_bf16(kb1[d0 % (KPF + 1)], qr[d0], p1, 0, 0, 0);
            }
#undef ATT_KRD
        }
        if (kb + 63 > qlo) {
            const float NEG = -__builtin_inff(); const int dq = qm - kb;
#pragma unroll
            for (int r = 0; r < 16; ++r) { const int c = (r & 3) + 8 * (r >> 2); if (dq - c < 0) p0[r] = NEG; if (dq - c - 32 < 0) p1[r] = NEG; }
        }
        float pmax;
        { float a = att_max3(p0[0], p0[1], p1[0]), b = att_max3(p0[2], p0[3], p1[1]); a = att_max3(a, p1[2], p1[3]);
#pragma unroll
          for (int r = 4; r < 16; r += 4) { a = att_max3(a, p0[r], p0[r + 1]); b = att_max3(b, p0[r + 2], p0[r + 3]); a = att_max3(a, p1[r], p1[r + 1]); b = att_max3(b, p1[r + 2], p1[r + 3]); }
          pmax = fmaxf(a, b); }
        { auto rr = __builtin_amdgcn_permlane32_swap(__float_as_uint(pmax), __float_as_uint(pmax), false, false);
          pmax = fmaxf(__uint_as_float(rr[0]), __uint_as_float(rr[1])); }
        float alpha = 1.f;
        if (!__builtin_expect(__all(pmax <= 8.f), 1)) { const float dm = fmaxf(pmax, 0.f); alpha = __builtin_amdgcn_exp2f(-dm); m_reg += dm;
#pragma unroll
            for (int r = 0; r < 16; ++r) { p0[r] -= dm; p1[r] -= dm; } }
        float ps = 0.f;
#pragma unroll
        for (int r = 0; r < 16; ++r) { p0[r] = __builtin_amdgcn_exp2f(p0[r]); ps += p0[r]; }
#pragma unroll
        for (int r = 0; r < 16; ++r) { p1[r] = __builtin_amdgcn_exp2f(p1[r]); ps += p1[r]; }
        { auto rr = __builtin_amdgcn_permlane32_swap(__float_as_uint(ps), __float_as_uint(ps), false, false);
          ps = __uint_as_float(rr[0]) + __uint_as_float(rr[1]); }
        l_reg = l_reg * alpha + ps;
        bf16x8 pa0, pa1, pa2, pa3;
#define ATT_PK4(P, B_, OUT) do { unsigned a0 = cvtpk(P[B_+0], P[B_+1]), a1 = cvtpk(P[B_+2], P[B_+3]); unsigned b0_ = cvtpk(P[B_+4], P[B_+5]), b1_ = cvtpk(P[B_+6], P[B_+7]); \
        auto r0 = __builtin_amdgcn_permlane32_swap(a0, b0_, false, false); auto r1 = __builtin_amdgcn_permlane32_swap(a1, b1_, false, false); \
        u32x4 w = {r0[0], r1[0], r0[1], r1[1]}; OUT = *reinterpret_cast<bf16x8*>(&w); } while (0)
        ATT_PK4(p0, 0, pa0); ATT_PK4(p0, 8, pa1); ATT_PK4(p1, 0, pa2); ATT_PK4(p1, 8, pa3);
        if (__any(alpha < 1.f)) {
            if (hi == 0) wsl[r32] = alpha;
            asm volatile("s_waitcnt lgkmcnt(0)" ::: "memory");
#pragma unroll
            for (int g = 0; g < 4; ++g) { const f32x4 al = *(const ALAS f32x4*)(wsl + 8 * g + 4 * hi);
#pragma unroll
                for (int d = 0; d < 4; ++d)
#pragma unroll
                    for (int e = 0; e < 4; ++e) o[d][4 * g + e] *= al[e]; }
        }
#define ATT_TRRD(dst, off) asm volatile("ds_read_b64_tr_b16 %0, %1 offset:%2" : "=&v"(dst) : "v"(vbb), "i"(off) : "memory")
#define ATT_PV(d0) do { s16x4 l0, l1, l2, l3, h0, h1, h2, h3; constexpr int b_ = (d0) * 512; \
        ATT_TRRD(l0, b_); ATT_TRRD(h0, b_ + 2048); ATT_TRRD(l1, b_ + 4096); ATT_TRRD(h1, b_ + 6144); ATT_TRRD(l2, b_ + 8192); ATT_TRRD(h2, b_ + 10240); ATT_TRRD(l3, b_ + 12288); ATT_TRRD(h3, b_ + 14336); \
        asm volatile("s_waitcnt lgkmcnt(0)" ::: "memory"); ASBAR(); \
        o[d0] = __builtin_amdgcn_mfma_f32_32x32x16_bf16(pa0, (bf16x8){l0[0], l0[1], l0[2], l0[3], h0[0], h0[1], h0[2], h0[3]}, o[d0], 0, 0, 0); \
        o[d0] = __builtin_amdgcn_mfma_f32_32x32x16_bf16(pa1, (bf16x8){l1[0], l1[1], l1[2], l1[3], h1[0], h1[1], h1[2], h1[3]}, o[d0], 0, 0, 0); \
        o[d0] = __builtin_amdgcn_mfma_f32_32x32x16_bf16(pa2, (bf16x8){l2[0], l2[1], l2[2], l2[3], h2[0], h2[1], h2[2], h2[3]}, o[d0], 0, 0, 0); \
        o[d0] = __builtin_amdgcn_mfma_f32_32x32x16_bf16(pa3, (bf16x8){l3[0], l3[1], l3[2], l3[3], h3[0], h3[1], h3[2], h3[3]}, o[d0], 0, 0, 0); } while (0)
        { const int vbb = vb0 + buf * SHM_V; ATT_PV(0); ATT_PV(1); ATT_PV(2); ATT_PV(3); }
        if (t + 1 < NT) ATT_WRITEF(buf ^ 1);
        if (side) { const bool isv = side_next >= 32; const float sc = isv ? 4.f : 64.f;
            auto pk = [](float a, float b, float c, float d) { int w = __builtin_amdgcn_cvt_pk_fp8_f32(fminf(fmaxf(a, -448.f), 448.f), fminf(fmaxf(b, -448.f), 448.f), 0, false);
                return (unsigned)__builtin_amdgcn_cvt_pk_fp8_f32(fminf(fmaxf(c, -448.f), 448.f), fminf(fmaxf(d, -448.f), 448.f), w, true); };
            uint2 o; o.x = pk(sd0[0] * sc, sd0[1] * sc, sd0[2] * sc, sd0[3] * sc); o.y = pk(sd1[0] * sc, sd1[1] * sc, sd1[2] * sc, sd1[3] * sc);
            *(uint2*)((isv ? side_v8 : side_u8) + sd_off) = o; ++side_next; }
    }
    if (hi == 0) wsl[r32] = l_reg;
    asm volatile("s_waitcnt lgkmcnt(0)" ::: "memory");
#pragma unroll
    for (int r = 0; r < 16; ++r) {
        const int orow = crow(r, hi); const float rli = __builtin_amdgcn_rcpf(wsl[orow]);
        bf16_t* rowp = gout + (size_t)(qlo + orow) * 4096; const bf16_t* growp = gate + (size_t)(qlo + orow) * 4096;
#pragma unroll
        for (int d0 = 0; d0 < 4; ++d0) {
            const float v = o[d0][r] * rli; const float vn = __shfl_xor(v, 1);
            if ((r32 & 1) == 0) { unsigned* gp = (unsigned*)(rowp + d0 * 32 + r32); const unsigned g = *(const unsigned*)(growp + d0 * 32 + r32);
                *gp = cvtpk(v * __uint_as_float(g << 16), vn * __uint_as_float(g & 0xffff0000u)); }
        }
    }
    __syncthreads();
#undef ATT_GLDS
#undef ATT_WRITEF
#undef ATT_PK4
#undef ATT_TRRD
#undef ATT_PV
}
}
using pg8::bf16_t; using pg8::f32x4; using pg8::u32x4;
#define LAS __attribute__((address_space(3)))
constexpr int S = 8192, DM = 2048, INW = 11344, INWP = 11520;
constexpr float EPS = 1e-6f;
constexpr size_t MiB = 1u << 20;

__device__ __forceinline__ float bf2f(bf16_t v) { return __uint_as_float(((unsigned)v) << 16); }
__device__ __forceinline__ bf16_t f2bf(float f) { unsigned u = __float_as_uint(f); u += 0x7fffu + ((u >> 16) & 1u); return (bf16_t)(u >> 16); }
__device__ __forceinline__ unsigned pk2(float lo, float hi) { return (unsigned)f2bf(lo) | ((unsigned)f2bf(hi) << 16); }
__device__ __forceinline__ float wave_sum(float v) {
#pragma unroll
    for (int o = 32; o >= 1; o >>= 1) v += __shfl_xor(v, o);
    return v;
}
__device__ __forceinline__ float wave_max(float v) {
#pragma unroll
    for (int o = 32; o >= 1; o >>= 1) v = fmaxf(v, __shfl_xor(v, o));
    return v;
}

__device__ __forceinline__ int opaque_tid() { int t = threadIdx.x; asm volatile("" : "+v"(t)); return t; }

struct Params {
    const float* x; const int* pos; const float *mix_g, *w_in, *b_forget, *b_gate, *q_lat_g, *w_q_up, *kv_lat_g, *w_kv_up, *mla_qg, *mla_kg, *fox_qg, *fox_kg, *w_out, *ffn_g, *w_peer_q, *sub_keys, *peer_u, *peer_v;
    float* out;
    bf16_t *WqT, *WkvT, *WoT, *WpT, *WinT;
    bf16_t *h, *cq, *ckv, *fq, *fk, *fv, *merged, *kpe, *qa, *va, *ka;
    float *lf, *F, *x1, *scores;
    unsigned char *U8, *V8; bf16_t* attout;
    unsigned* ctl;
    float2* ropeT; float* ssq; float* ssq2; bf16_t* xg;
};

struct DstId { __device__ __forceinline__ int operator()(int n) const { return n; } };
struct DstWin { __device__ __forceinline__ int operator()(int n) const {
    if (n < 1024) return n; if (n < 1088) { const int r = n - 1024; return 11264 + 2 * (r & 31) + (r >> 5); } if (n < 7232) return n - 64; if (n < 7248) return 11264 + 64 + (n - 7232); return n - 80; } };
struct DstQ { __device__ __forceinline__ int operator()(int n) const {
    const int h = n / 192, d = n - h * 192; if (d < 128) return h * 256 + d; const int r = d - 128; return h * 256 + 128 + 2 * (r & 31) + (r >> 5); } };
template <class Dst>
__device__ __forceinline__ void transpose_item(const float* __restrict__ W, int K, int N, bf16_t* __restrict__ WT, Dst dst, float* scr, int item, int lane, const float* __restrict__ gk = nullptr) {
    const int nblk = (N + 31) / 32, kb = item / nblk, nb = item % nblk, k0 = 64 * kb, n0 = 32 * nb;
    { const int rr = lane >> 3, c4 = (lane & 7) * 4; const bool ok = (n0 + c4) < N;
      f32x4 v[8];
#pragma unroll
      for (int i = 0; i < 8; ++i) v[i] = ok ? *(const f32x4*)(W + (size_t)(k0 + 8 * i + rr) * N + n0 + c4) : (f32x4){0.f, 0.f, 0.f, 0.f};
      if (gk) {
#pragma unroll
          for (int i = 0; i < 8; ++i) v[i] *= gk[k0 + 8 * i + rr]; }
#pragma unroll
      for (int i = 0; i < 8; ++i) { float* sp = scr + (8 * i + rr) * 33 + c4; sp[0] = v[i][0]; sp[1] = v[i][1]; sp[2] = v[i][2]; sp[3] = v[i][3]; } }
    asm volatile("s_waitcnt lgkmcnt(0)" ::: "memory");
    const int c = lane & 7;
#pragma unroll
    for (int j = 0; j < 4; ++j) { const int nl = (lane >> 3) + 8 * j, n = n0 + nl; const float* s = scr + (8 * c) * 33 + nl;
        u32x4 o; o.x = pk2(s[0 * 33], s[1 * 33]); o.y = pk2(s[2 * 33], s[3 * 33]); o.z = pk2(s[4 * 33], s[5 * 33]); o.w = pk2(s[6 * 33], s[7 * 33]);
        if (n < N) *(u32x4*)(WT + (size_t)dst(n) * K + k0 + 8 * c) = o; }
    asm volatile("s_waitcnt lgkmcnt(0)" ::: "memory");
}
__device__ __forceinline__ void wfold_item(const float* __restrict__ wq, const float* __restrict__ keys, bf16_t* __restrict__ WpT, float* sm, int item) {
    const int tid = opaque_tid(), hc = item >> 5, d0 = (item & 31) * 64;
    float* keysL = sm; float* wqL = sm + 128 * 132;
    for (int idx = tid; idx < 128 * 32; idx += 512) { const int r = idx >> 5, c4 = (idx & 31) * 4; *(f32x4*)(keysL + r * 132 + c4) = *(const f32x4*)(keys + (size_t)hc * 16384 + r * 128 + c4); }
    for (int idx = tid; idx < 64 * 32; idx += 512) { const int r = idx >> 5, c4 = (idx & 31) * 4; *(f32x4*)(wqL + r * 132 + c4) = *(const f32x4*)(wq + (size_t)(d0 + r) * 2048 + hc * 128 + c4); }
    __syncthreads();
    const int n2 = (tid & 63) * 2, dg = tid >> 6;
    float acc[2][8];
#pragma unroll
    for (int a = 0; a < 2; ++a)
#pragma unroll
        for (int i = 0; i < 8; ++i) acc[a][i] = 0.f;
#pragma unroll 2
    for (int j4 = 0; j4 < 32; ++j4) {
        const f32x4 k0v = *(const f32x4*)(keysL + n2 * 132 + 4 * j4), k1v = *(const f32x4*)(keysL + (n2 + 1) * 132 + 4 * j4);
#pragma unroll
        for (int i = 0; i < 8; ++i) { const f32x4 w = *(const f32x4*)(wqL + (dg * 8 + i) * 132 + 4 * j4);
            acc[0][i] += (k0v[0] * w[0] + k0v[1] * w[1]) + (k0v[2] * w[2] + k0v[3] * w[3]);
            acc[1][i] += (k1v[0] * w[0] + k1v[1] * w[1]) + (k1v[2] * w[2] + k1v[3] * w[3]); }
    }
#pragma unroll
    for (int a = 0; a < 2; ++a) { u32x4 o; o.x = pk2(acc[a][0], acc[a][1]); o.y = pk2(acc[a][2], acc[a][3]); o.z = pk2(acc[a][4], acc[a][5]); o.w = pk2(acc[a][6], acc[a][7]);
        *(u32x4*)(WpT + (size_t)(hc * 128 + n2 + a) * 2048 + d0 + dg * 8) = o; }
    __syncthreads();
}
__device__ __forceinline__ void rms_row2048(const float* __restrict__ xr, const float* __restrict__ g, bf16_t* __restrict__ orow, int lane) {
    f32x4 v[8]; float ss = 0.f;
#pragma unroll
    for (int j = 0; j < 8; ++j) { v[j] = *(const f32x4*)(xr + j * 256 + lane * 4); ss += (v[j][0] * v[j][0] + v[j][1] * v[j][1]) + (v[j][2] * v[j][2] + v[j][3] * v[j][3]); }
    const float r = rsqrtf(wave_sum(ss) * (1.f / 2048.f) + EPS);
#pragma unroll
    for (int j = 0; j < 8; ++j) { const f32x4 gg = *(const f32x4*)(g + j * 256 + lane * 4);
        uint2 o; o.x = pk2(v[j][0] * r * gg[0], v[j][1] * r * gg[1]); o.y = pk2(v[j][2] * r * gg[2], v[j][3] * r * gg[3]);
        *(uint2*)(orow + j * 256 + lane * 4) = o; }
}
__device__ __forceinline__ void fox_cumsum(double* part, int h, const float* __restrict__ lf, float* __restrict__ F) {
    const int tid = opaque_tid(), lane = tid & 63, wave = tid >> 6;
    float v[16]; double sum = 0.0;
#pragma unroll
    for (int i = 0; i < 16; ++i) { v[i] = lf[(size_t)(tid * 16 + i) * 16 + h]; sum += (double)v[i]; }
    double inc = sum;
#pragma unroll
    for (int o = 1; o < 64; o <<= 1) { const double n = __shfl_up(inc, o); if (lane >= o) inc += n; }
    if (lane == 63) part[wave] = inc;
    __syncthreads();
    double base = 0.0;
    for (int w = 0; w < wave; ++w) base += part[w];
    double run = base + inc - sum;
#pragma unroll
    for (int i = 0; i < 16; ++i) { run += (double)v[i]; F[(size_t)h * S + tid * 16 + i] = (float)(run * 1.4426950408889634); }
    __syncthreads();
}
__device__ __forceinline__ void rope_table(const int* __restrict__ pos, float2* __restrict__ ropeT, int gtid, int nthreads) {
    for (int idx = gtid; idx < S * 32; idx += nthreads) { const int t = idx >> 5, i = idx & 31;
        const double inv = exp(-(double)i * (1.0 / 32.0) * 9.210340371976184);
        double ang = (double)((float)pos[t] * (float)inv);
        const double twopi = 6.283185307179586;
        ang -= twopi * rint(ang / twopi);
        ropeT[idx] = make_float2(cosf((float)ang), sinf((float)ang)); }
}
typedef float f32x2 __attribute__((ext_vector_type(2)));
__device__ __forceinline__ unsigned pk4_fp8(float a, float b, float c, float d) {
    int w = __builtin_amdgcn_cvt_pk_fp8_f32(fminf(fmaxf(a, -448.f), 448.f), fminf(fmaxf(b, -448.f), 448.f), 0, false);
    w = __builtin_amdgcn_cvt_pk_fp8_f32(fminf(fmaxf(c, -448.f), 448.f), fminf(fmaxf(d, -448.f), 448.f), w, true); return (unsigned)w; }
__device__ __forceinline__ void cvt_rows_fp8(const float* __restrict__ src, unsigned char* __restrict__ dst, size_t n, float scale, int gw, int NGW, int lane) {
    const size_t nchunk = n / 1024;
    for (size_t c = gw; c < nchunk; c += NGW) { const size_t o = c * 1024 + lane * 16;
        f32x4 a[4];
#pragma unroll
        for (int q = 0; q < 4; ++q) a[q] = *(const f32x4*)(src + o + 4 * q) * scale;
        u32x4 w; w.x = pk4_fp8(a[0][0], a[0][1], a[0][2], a[0][3]); w.y = pk4_fp8(a[1][0], a[1][1], a[1][2], a[1][3]);
        w.z = pk4_fp8(a[2][0], a[2][1], a[2][2], a[2][3]); w.w = pk4_fp8(a[3][0], a[3][1], a[3][2], a[3][3]);
        *(u32x4*)(dst + o) = w; }
}
constexpr float U_SCALE = 64.f, V_SCALE = 4.f;
typedef __bf16 bf16x2_t __attribute__((ext_vector_type(2)));
__device__ __forceinline__ float dot2bf(unsigned a, unsigned b, float c) { return __builtin_amdgcn_fdot2_f32_bf16(__builtin_bit_cast(bf16x2_t, a), __builtin_bit_cast(bf16x2_t, b), c, false); }
#define PEER_INS(top, x) do { float x_ = (x); _Pragma("unroll") for (int i_ = 0; i_ < 16; ++i_) { const float hi_ = fmaxf(top[i_], x_); x_ = fminf(top[i_], x_); top[i_] = hi_; } } while (0)
__device__ __forceinline__ void peer_group(unsigned char* smem, int g, const float* __restrict__ scores, const bf16_t* __restrict__ h2  , const float* __restrict__ ssq2, const float* __restrict__ x1,
                                           const unsigned char* __restrict__ U8, const unsigned char* __restrict__ V8, float* __restrict__ out) {
    const int tid = opaque_tid(), lane = tid & 63, wave = __builtin_amdgcn_readfirstlane(tid >> 6);
    float* topL = (float*)smem;
    int* selE = (int*)(smem + 32768);
    float* selG = (float*)(smem + 49152);
    {
        const int tl = tid >> 4, hc = tid & 15;
        const float* sp = scores + (size_t)(g * 32 + tl) * 2048 + hc * 128;
        float top[16];
#pragma unroll
        for (int i = 0; i < 16; ++i) top[i] = -INFINITY;
#pragma unroll 2
        for (int n0 = 0; n0 < 128; n0 += 4) { const f32x4 v = *(const f32x4*)(sp + n0);
#pragma unroll
            for (int e = 0; e < 4; ++e) PEER_INS(top, __uint_as_float((__float_as_uint(v[e]) & ~0x7Fu) | (unsigned)(n0 + e))); }
        float* tp = topL + (tl * 16 + hc) * 16;
#pragma unroll
        for (int i = 0; i < 16; i += 4) *(f32x4*)(tp + i) = (f32x4){top[i], top[i + 1], top[i + 2], top[i + 3]};
    }
    __syncthreads();
    if (tid < 256) {
        const int tl = tid >> 3, h = tid & 7;
        const float* t1 = topL + (tl * 16 + 2 * h) * 16; const float* t2 = t1 + 16;
        float s1[16], s2[16];
#pragma unroll
        for (int i = 0; i < 16; i += 4) { const f32x4 a = *(const f32x4*)(t1 + i), b2 = *(const f32x4*)(t2 + i);
            s1[i] = a[0]; s1[i + 1] = a[1]; s1[i + 2] = a[2]; s1[i + 3] = a[3]; s2[i] = b2[0]; s2[i + 1] = b2[1]; s2[i + 2] = b2[2]; s2[i + 3] = b2[3]; }
        float ts[16];
#pragma unroll
        for (int i = 0; i < 16; ++i) ts[i] = -INFINITY;
#pragma unroll
        for (int i = 0; i < 16; ++i)
#pragma unroll
            for (int j = 0; j < 16; ++j)
                if ((i + 1) * (j + 1) <= 16) PEER_INS(ts, __uint_as_float((__float_as_uint(s1[i] + s2[j]) & ~0xFFu) | (unsigned)(i * 16 + j)));
        float ex[16], sum = 0.f;
#pragma unroll
        for (int k = 0; k < 16; ++k) { ex[k] = __expf(ts[k] - ts[0]); sum += ex[k]; }
        const float inv = 1.f / sum;
#pragma unroll
        for (int k = 0; k < 16; ++k) { const unsigned pos = __float_as_uint(ts[k]) & 0xFFu;
            const int i1 = (int)(__float_as_uint(t1[pos >> 4]) & 0x7Fu), i2 = (int)(__float_as_uint(t2[pos & 15]) & 0x7Fu);
            selE[tl * 128 + h * 16 + k] = i1 * 128 + i2; selG[tl * 128 + h * 16 + k] = ex[k] * inv; }
    }
    __syncthreads();
    const int grp = lane >> 4, l16 = lane & 15, tl = wave * 4 + grp;
    unsigned* sortK = (unsigned*)(smem + 65536) + tl * 128;
    float* wS = (float*)(smem + 81920) + tl * 128;
    unsigned* hist = (unsigned*)(smem + 98304) + wave * 512 + grp * 64;
    {
#pragma unroll
        for (int i = 0; i < 4; ++i) hist[l16 * 4 + i] = 0u;
        asm volatile("s_waitcnt lgkmcnt(0)" ::: "memory");
        unsigned ek[8], rk[8];
#pragma unroll
        for (int j = 0; j < 8; ++j) { ek[j] = (unsigned)selE[tl * 128 + l16 + 16 * j]; rk[j] = atomicAdd(&hist[ek[j] >> 8], 1u); }
        asm volatile("s_waitcnt lgkmcnt(0)" ::: "memory");
        unsigned c[4], tot = 0u;
#pragma unroll
        for (int i = 0; i < 4; ++i) { c[i] = hist[l16 * 4 + i]; tot += c[i]; }
        unsigned inc = tot;
#pragma unroll
        for (int o = 1; o < 16; o <<= 1) { const unsigned n = __shfl_up(inc, o, 16); if (l16 >= o) inc += n; }
        unsigned run = inc - tot;
#pragma unroll
        for (int i = 0; i < 4; ++i) { hist[256 + l16 * 4 + i] = run; run += c[i]; }
        asm volatile("s_waitcnt lgkmcnt(0)" ::: "memory");
#pragma unroll
        for (int j = 0; j < 8; ++j) sortK[hist[256 + (ek[j] >> 8)] + rk[j]] = (ek[j] << 7) | (unsigned)(l16 + 16 * j);
    }
    __syncthreads();
    const size_t tok = (size_t)g * 32 + tl;
    float rinv_tok;
    { float t = 0.f; if (l16 < 8) { const f32x4 a = *(const f32x4*)(ssq2 + ((size_t)l16 * 8192 + tok) * 4); t = (a[0] + a[1]) + (a[2] + a[3]); }
      t += __shfl_xor(t, 8); t += __shfl_xor(t, 4); t += __shfl_xor(t, 2); t += __shfl_xor(t, 1); rinv_tok = rsqrtf(t * (1.f / 2048.f) + 1e-6f); }
#pragma unroll 1
    for (int hf = 0; hf < 2; ++hf) {
        f32x2 hp[32];
#pragma unroll
        for (int j = 0; j < 4; ++j)
#pragma unroll
            for (int q = 0; q < 2; ++q) { const u32x4 w = *(const u32x4*)(h2 + tok * DM + hf * 1024 + j * 256 + l16 * 16 + q * 8);
#pragma unroll
                for (int c = 0; c < 4; ++c) hp[j * 8 + q * 4 + c] = (f32x2){__uint_as_float(w[c] << 16), __uint_as_float(w[c] & 0xffff0000u)}; }
        for (int it = 0; it < 128; it += 4) {
            if ((it & 7) == 0 && it) __syncthreads();
            unsigned key[4]; u32x4 ur[4][4];
#pragma unroll
            for (int p = 0; p < 4; ++p) { key[p] = sortK[it + p];
#pragma unroll
                for (int j = 0; j < 4; ++j) ur[p][j] = *(const u32x4*)(U8 + (size_t)(key[p] >> 7) * DM + hf * 1024 + j * 256 + l16 * 16); }
#pragma unroll
            for (int p = 0; p < 4; ++p) { f32x2 a2 = (f32x2){0.f, 0.f}, b2 = (f32x2){0.f, 0.f};
#pragma unroll
                for (int j = 0; j < 4; ++j)
#pragma unroll
                    for (int c = 0; c < 4; ++c) { const int w = (int)ur[p][j][c];
                        a2 = __builtin_elementwise_fma(hp[j * 8 + 2 * c], __builtin_amdgcn_cvt_pk_f32_fp8(w, false), a2);
                        b2 = __builtin_elementwise_fma(hp[j * 8 + 2 * c + 1], __builtin_amdgcn_cvt_pk_f32_fp8(w, true), b2); }
                float d = (a2.x + a2.y) + (b2.x + b2.y);
                d += __shfl_xor(d, 8); d += __shfl_xor(d, 4); d += __shfl_xor(d, 2); d += __shfl_xor(d, 1);
                if (hf == 0) { if (l16 == 0) wS[it + p] = d; }
                else { const float a = (wS[it + p] + d) * (rinv_tok * (1.f / U_SCALE));
                    const float w = selG[tl * 128 + (key[p] & 127u)] * 0.5f * a * (1.f + erff(a * 0.70710678118654752f)) * (1.f / V_SCALE);
                    if (l16 == 0) wS[it + p] = w; } }
        }
        __syncthreads();
    }
#pragma unroll 1
    for (int hf = 0; hf < 2; ++hf) {
        f32x2 acc[32];
#pragma unroll
        for (int c = 0; c < 32; ++c) acc[c] = (f32x2){0.f, 0.f};
        for (int it = 0; it < 128; it += 4) {
            if ((it & 7) == 0 && it) __syncthreads();
            unsigned key[4]; u32x4 vr[4][4];
#pragma unroll
            for (int p = 0; p < 4; ++p) { key[p] = sortK[it + p];
#pragma unroll
                for (int j = 0; j < 4; ++j) vr[p][j] = *(const u32x4*)(V8 + (size_t)(key[p] >> 7) * DM + hf * 1024 + j * 256 + l16 * 16); }
#pragma unroll
            for (int p = 0; p < 4; ++p) { const float w = wS[it + p]; const f32x2 w2 = (f32x2){w, w};
#pragma unroll
                for (int j = 0; j < 4; ++j)
#pragma unroll
                    for (int c = 0; c < 4; ++c) { const int x = (int)vr[p][j][c];
                        acc[j * 8 + 2 * c] = __builtin_elementwise_fma(w2, __builtin_amdgcn_cvt_pk_f32_fp8(x, false), acc[j * 8 + 2 * c]);
                        acc[j * 8 + 2 * c + 1] = __builtin_elementwise_fma(w2, __builtin_amdgcn_cvt_pk_f32_fp8(x, true), acc[j * 8 + 2 * c + 1]); } }
        }
#pragma unroll
        for (int j = 0; j < 4; ++j)
#pragma unroll
            for (int q = 0; q < 4; ++q) { const size_t o = tok * DM + hf * 1024 + j * 256 + l16 * 16 + q * 4;
                const f32x4 a = *(const f32x4*)(x1 + o);
                *(f32x4*)(out + o) = (f32x4){a[0] + acc[j * 8 + 2 * q].x, a[1] + acc[j * 8 + 2 * q].y, a[2] + acc[j * 8 + 2 * q + 1].x, a[3] + acc[j * 8 + 2 * q + 1].y}; }
        __syncthreads();
    }
    __syncthreads();
}

#define XB_TMO      128
#define XB_XCNT(j)  (256  + 64 * (j))
#define XB_XSUB(j)  (1280 + 64 * (j))
#define XB_XGEN(j)  (2304 + 64 * (j))
#define XB_TOP      3328
#define XB_TOPGEN   3392
#define XCD_BAR_WORDS 3456
#define XB_SPIN_CAP (1u << 18)

__device__ __forceinline__ unsigned xb_ld(unsigned* p)              { return __hip_atomic_load(p, __ATOMIC_RELAXED, __HIP_MEMORY_SCOPE_AGENT); }
__device__ __forceinline__ unsigned xb_add(unsigned* p, unsigned v) { return __hip_atomic_fetch_add(p, v, __ATOMIC_RELAXED, __HIP_MEMORY_SCOPE_AGENT); }
__device__ __forceinline__ unsigned xb_xcc_id() { return (unsigned)__builtin_amdgcn_s_getreg((3 << 11) | 20) & 0xFu; }
#define XB_SPIN(cond, bar) do { unsigned _sp = 0; while (cond) { __builtin_amdgcn_s_sleep(1); \
    if ((++_sp & 255u) == 0u) { if (xb_ld(&(bar)[XB_TMO])) break; if (_sp > XB_SPIN_CAP) { atomicAdd(&(bar)[XB_TMO], 1u); break; } } } } while (0)

struct XcdBarrier {
    unsigned* bar; unsigned x;
    volatile LAS unsigned* st;
};

__device__ __forceinline__ XcdBarrier xcd_barrier_post(unsigned* bar, volatile LAS unsigned* st) {
    XcdBarrier b; b.bar = bar; b.x = xb_xcc_id(); b.st = st;
    if (threadIdx.x == 0) (void)xb_add(&bar[XB_XCNT(b.x)], 1u);
    return b;
}
__device__ __forceinline__ void xcd_barrier_complete(unsigned* bar, unsigned x, unsigned& nloc, unsigned& nx) {
    const unsigned G = gridDim.x * gridDim.y * gridDim.z;
    unsigned sum, cnt, mine, sp = 0u;
    for (;;) {
        sum = 0u; cnt = 0u; mine = 0u;
#pragma unroll
        for (unsigned j = 0; j < 16; ++j) { const unsigned c = xb_ld(&bar[XB_XCNT(j)]); sum += c; cnt += (c > 0u) ? 1u : 0u; mine = (j == x) ? c : mine; }
        if (sum == G) break;
        __builtin_amdgcn_s_sleep(1);
        if ((++sp & 255u) == 0u) { if (xb_ld(&bar[XB_TMO])) break; if (sp > XB_SPIN_CAP) { atomicAdd(&bar[XB_TMO], 1u); break; } }
    }
    nloc = mine > 0u ? mine : 1u; nx = cnt > 0u ? cnt : 1u;
}

__device__ __forceinline__ void xcd_barrier(const XcdBarrier& b) {
    asm volatile("s_waitcnt vmcnt(0)" ::: "memory");
    __syncthreads();
    if (threadIdx.x == 0) {
        unsigned* bar = b.bar;
        __builtin_amdgcn_s_waitcnt(0);
        unsigned nloc = b.st[0], nx = b.st[1];
        if (nloc == 0u) { xcd_barrier_complete(bar, b.x, nloc, nx); b.st[0] = nloc; b.st[1] = nx; }
        const unsigned old = xb_add(&bar[XB_XSUB(b.x)], 1u);
        const unsigned gen = old / nloc;
        if (old + 1u == (gen + 1u) * nloc) {
            __builtin_amdgcn_fence(__ATOMIC_RELEASE, "agent");
            asm volatile("s_waitcnt vmcnt(0)" ::: "memory");
            const unsigned og = xb_add(&bar[XB_TOP], 1u);
            const unsigned tg = og / nx;
            if (og + 1u == (tg + 1u) * nx) xb_add(&bar[XB_TOPGEN], 1u);
            else XB_SPIN(xb_ld(&bar[XB_TOPGEN]) == tg, bar);
            __builtin_amdgcn_fence(__ATOMIC_ACQUIRE, "agent");
            xb_add(&bar[XB_XGEN(b.x)], 1u);
            asm volatile("s_waitcnt vmcnt(0)" ::: "memory");
        } else {
            XB_SPIN(xb_ld(&bar[XB_XGEN(b.x)]) == gen, bar);
            __builtin_amdgcn_fence(__ATOMIC_ACQUIRE, "agent");
            asm volatile("s_waitcnt vmcnt(0)" ::: "memory");
        }
    }
    __syncthreads();
}

#define PROBE_DOUBLE 0
#define REP(k) for (int rep_ = 0; rep_ < ((PROBE_DOUBLE == (k)) ? 2 : 1); ++rep_)
constexpr int LDS_BYTES = 147456;
__global__ __launch_bounds__(512, 2) void mega(Params p) {
    extern __shared__ __attribute__((aligned(16))) unsigned char smem[];
    { volatile LAS unsigned* st0 = (volatile LAS unsigned*)((LAS unsigned char*)smem + 131072); if (threadIdx.x < 2) st0[threadIdx.x] = 0u; }
    __syncthreads();
    const XcdBarrier bar = xcd_barrier_post(p.ctl, (volatile LAS unsigned*)((LAS unsigned char*)smem + 131072));
    float* smf = (float*)smem;
    LAS unsigned char* lds = (LAS unsigned char*)smem;
    const int G = gridDim.x, b = blockIdx.x, NGW = G * 8;
#define PHASE_IDS() const int tid = opaque_tid(), lane = tid & 63, wave = __builtin_amdgcn_readfirstlane(tid >> 6), gw = b * 8 + wave; (void)lane; (void)gw

    REP(7) {
        PHASE_IDS();
        float* scr = smf + wave * 4096;
        constexpr int dummy_ = 0; (void)dummy_;
        constexpr int I_IN = 32 * 355, I_Q = 8 * 96, I_KV = 8 * 128, I_O = 64 * 64;
        for (int it = gw; it < I_IN + I_Q + I_KV + I_O; it += NGW) {
            int r = it;
            if (r < I_IN) { transpose_item(p.w_in, 2048, INW, p.WinT, DstWin(), scr, r, lane); continue; } r -= I_IN;
            if (r < I_Q) { transpose_item(p.w_q_up, 512, 3072, p.WqT, DstQ(), scr, r, lane, p.q_lat_g); continue; } r -= I_Q;
            if (r < I_KV) { transpose_item(p.w_kv_up, 512, 4096, p.WkvT, DstId(), scr, r, lane, p.kv_lat_g); continue; } r -= I_KV;
            transpose_item(p.w_out, 4096, 2048, p.WoT, DstId(), scr, r, lane);
        }
        for (int m = gw; m < S; m += NGW) rms_row2048(p.x + (size_t)m * DM, p.mix_g, p.h + (size_t)m * DM, lane);
        for (int idx = b * 512 + tid; idx < 16 * 64 * 64; idx += G * 512) { const int hh = idx >> 12, rr = (idx >> 6) & 63, c8 = idx & 63;
            *(u32x4*)(p.WqT + (size_t)(hh * 256 + 192 + rr) * 512 + c8 * 8) = (u32x4){0u, 0u, 0u, 0u}; }
        rope_table(p.pos, p.ropeT, b * 512 + tid, G * 512);
        __syncthreads();
        for (int it = b; it < 512; it += G) wfold_item(p.w_peer_q, p.sub_keys, p.WpT, smf, it);
    }
    xcd_barrier(bar);
    REP(1) {
        pg8::Gemm g{p.h, p.WinT, S, INWP, DM}; pg8::StaticOrder so; so.init(S, INWP, G, b);
        pg8::EpiInProj E{p.cq, p.ckv, p.fq, p.fk, p.fv, p.merged, p.kpe, p.lf, p.b_gate, p.b_forget, p.ssq, p.fox_qg, p.fox_kg, (LAS float*)(lds + 131072 + 64)};
        pg8::gemm_phase<pg8::EpiInProj, pg8::StaticOrder, true, true>(lds, g, so, E);
    }
    xcd_barrier(bar);
    for (int hh = b; hh < 16; hh += G) fox_cumsum((double*)smem, hh, p.lf, p.F);
    REP(2) {
        pg8::Gemm g{p.cq, p.WqT, S, 4096, 512}; pg8::StaticOrder so; so.init(S, 4096, G, b);
        pg8::EpiQ E{p.qa, p.ssq, p.mla_qg, p.ropeT, (LAS float*)(lds + 131072 + 64)};
        pg8::gemm_phase<pg8::EpiQ, pg8::StaticOrder, true, true>(lds, g, so, E);
    }
    {
        pg8::Gemm g{p.ckv, p.WkvT, S, 4096, 512}; pg8::StaticOrder so; so.init(S, 4096, G, b);
        pg8::EpiKV E{p.ka, p.va, p.kpe, p.ssq, p.mla_kg, p.ropeT, (LAS float*)(lds + 131072 + 64)};
        pg8::gemm_phase<pg8::EpiKV, pg8::StaticOrder, true, true>(lds, g, so, E);
    }
    xcd_barrier(bar);
    int side_next = 0;
    REP(3) for (int L = b; L < 1024; L += G) {
        const int i = L >> 8, vc = L & 255, vcx = (vc & 7) * 32 + (vc >> 3), hh = vcx >> 4, x = vcx & 15, qbk = (i & 1) ? x : 31 - x;
        if (i < 2) att::attn_block<192, false>(smem, p.qa + hh * 192, 3072, p.ka + hh * 192, 3072, p.va + hh * 128, 2048, nullptr, p.merged + hh * 128, p.attout + hh * 128, qbk, nullptr, nullptr, p.peer_u, p.peer_v, p.U8, p.V8, side_next);
        else att::attn_block<128, true>(smem, p.fq + hh * 128, 2048, p.fk + hh * 128, 2048, p.fv + hh * 128, 2048, p.F + (size_t)hh * S, p.merged + 2048 + hh * 128, p.attout + 2048 + hh * 128, qbk, p.fox_qg, p.fox_kg, p.peer_u, p.peer_v, p.U8, p.V8, side_next);
    }
    if (G == 256) { PHASE_IDS(); (void)wave;
        for (; side_next < 64; ++side_next) { const bool isv = side_next >= 32; const size_t off = ((size_t)(b * 32 + (side_next & 31)) * 512 + tid) * 8;
            const float* sp = (isv ? p.peer_v : p.peer_u) + off; const float sc = isv ? V_SCALE : U_SCALE; const f32x4 a0 = *(const f32x4*)sp * sc, a1 = *(const f32x4*)(sp + 4) * sc;
            uint2 o; o.x = pk4_fp8(a0[0], a0[1], a0[2], a0[3]); o.y = pk4_fp8(a1[0], a1[1], a1[2], a1[3]); *(uint2*)((isv ? p.V8 : p.U8) + off) = o; } }
    else { PHASE_IDS(); cvt_rows_fp8(p.peer_u, p.U8, (size_t)16384 * 2048, U_SCALE, gw, NGW, lane); cvt_rows_fp8(p.peer_v, p.V8, (size_t)16384 * 2048, V_SCALE, gw, NGW, lane); }
    xcd_barrier(bar);
    REP(4) {
        pg8::Gemm g{p.attout, p.WoT, S, 2048, 4096}; pg8::StaticOrder so; so.init(S, 2048, G, b);
        pg8::EpiX1 E{p.x1, p.x, p.xg, p.ffn_g, p.ssq2};
        pg8::gemm_phase<pg8::EpiX1, pg8::StaticOrder, true, true>(lds, g, so, E);
    }
    xcd_barrier(bar);
    REP(5) {
        pg8::Gemm g{p.xg, p.WpT, S, 2048, 2048}; pg8::StaticOrder so; so.init(S, 2048, G, b);
        pg8::EpiScores E{p.scores, p.ssq2};
        pg8::gemm_phase<pg8::EpiScores, pg8::StaticOrder, true, true>(lds, g, so, E);
    }
    xcd_barrier(bar);
    REP(6) for (int g = b; g < S / 32; g += G) peer_group(smem, g, p.scores, p.xg, p.ssq2, p.x1, p.U8, p.V8, p.out);
}

extern "C" void kernel_launch(void* const* d_in, const int* in_sizes, int n_in,
                              void* d_out, int out_size, void* d_ws, size_t ws_size,
                              hipStream_t stream) {
    if (ws_size < 512 * MiB) { fprintf(stderr, "kernel_launch: workspace too small (%zu)\n", ws_size); return; }
    Params p{};
    p.x = (const float*)d_in[0]; p.pos = (const int*)d_in[1]; p.mix_g = (const float*)d_in[2]; p.w_in = (const float*)d_in[3];
    p.b_forget = (const float*)d_in[4]; p.b_gate = (const float*)d_in[5]; p.q_lat_g = (const float*)d_in[6]; p.w_q_up = (const float*)d_in[7];
    p.kv_lat_g = (const float*)d_in[8]; p.w_kv_up = (const float*)d_in[9]; p.mla_qg = (const float*)d_in[10]; p.mla_kg = (const float*)d_in[11];
    p.fox_qg = (const float*)d_in[12]; p.fox_kg = (const float*)d_in[13]; p.w_out = (const float*)d_in[14]; p.ffn_g = (const float*)d_in[15];
    p.w_peer_q = (const float*)d_in[16]; p.sub_keys = (const float*)d_in[17]; p.peer_u = (const float*)d_in[18]; p.peer_v = (const float*)d_in[19];
    p.out = (float*)d_out;
    char* ws = (char*)d_ws;
    p.WqT = (bf16_t*)(ws + 1 * MiB); p.WkvT = (bf16_t*)(ws + 5 * MiB); p.WoT = (bf16_t*)(ws + 9 * MiB); p.WpT = (bf16_t*)(ws + 25 * MiB); p.WinT = (bf16_t*)(ws + 33 * MiB);
    p.h = (bf16_t*)(ws + 78 * MiB); p.cq = (bf16_t*)(ws + 110 * MiB); p.ckv = (bf16_t*)(ws + 118 * MiB);
    p.fq = (bf16_t*)(ws + 126 * MiB); p.fk = (bf16_t*)(ws + 158 * MiB); p.fv = (bf16_t*)(ws + 190 * MiB); p.merged = (bf16_t*)(ws + 222 * MiB);
    p.kpe = (bf16_t*)(ws + 286 * MiB); p.lf = (float*)(ws + 287 * MiB); p.F = (float*)(ws + 287 * MiB + 512 * 1024);
    p.qa = (bf16_t*)(ws + 288 * MiB); p.va = (bf16_t*)(ws + 336 * MiB); p.ka = (bf16_t*)(ws + 400 * MiB); p.x1 = (float*)(ws + 126 * MiB);
    p.scores = (float*)(ws + 222 * MiB);
    p.ctl = (unsigned*)ws;
    p.ropeT = (float2*)(ws + 448 * MiB);
    p.ssq = (float*)(ws + 64 * 1024);
    p.attout = (bf16_t*)(ws + 33 * MiB);
    p.U8 = (unsigned char*)(ws + 450 * MiB); p.V8 = (unsigned char*)(ws + 368 * MiB);
    p.xg = (bf16_t*)(ws + 190 * MiB);
    p.ssq2 = (float*)(ws + 482 * MiB);

    static int grid_blocks = 0;
    if (!grid_blocks) {
        if (hipFuncSetAttribute((const void*)mega, hipFuncAttributeMaxDynamicSharedMemorySize, LDS_BYTES) != hipSuccess) { fprintf(stderr, "hipFuncSetAttribute failed\n"); return; }
        int dev = 0, cus = 0, per_cu = 0;
        (void)hipGetDevice(&dev);
        (void)hipDeviceGetAttribute(&cus, hipDeviceAttributeMultiprocessorCount, dev);
        (void)hipOccupancyMaxActiveBlocksPerMultiprocessor(&per_cu, (const void*)mega, 512, LDS_BYTES);
        if (per_cu < 1 || cus < 1) { fprintf(stderr, "occupancy query says %d blocks/CU on %d CUs\n", per_cu, cus); return; }
        grid_blocks = cus;
    }
    if (hipMemsetAsync(d_ws, 0, 16384, stream) != hipSuccess) { fprintf(stderr, "memset of the barrier words failed\n"); return; }
    void* args[] = {&p};
    hipError_t e = hipLaunchCooperativeKernel((const void*)mega, dim3(grid_blocks), dim3(512), args, LDS_BYTES, stream);
    if (e != hipSuccess) fprintf(stderr, "cooperative launch failed: %s (grid %d)\n", hipGetErrorString(e), grid_blocks);
}
```

```cpp
#include <hip/hip_runtime.h>
#include <hip/hip_cooperative_groups.h>
#include <stdint.h>
#include <math.h>
#include <cstdio>
namespace cg = cooperative_groups;

namespace pg8 {
#define PG8_LAS __attribute__((address_space(3)))
typedef unsigned short bf16_t;
typedef short bf16x8 __attribute__((ext_vector_type(8)));
typedef float f32x4 __attribute__((ext_vector_type(4)));
typedef unsigned u32x4 __attribute__((ext_vector_type(4)));
constexpr int BM = 256, BK = 64, HALF = 128, HTB = HALF * BK * 2  , STAGE_BYTES = 8 * HTB, NXCD = 8, WGM = 8;

__host__ __device__ __forceinline__ int lds_byte(int r, int c) { const int st = (r >> 4) * 2 + (c >> 5), rr = r & 15, cc = c & 31, ob = rr * 64 + cc * 2; return st * 1024 + (ob ^ (((ob >> 9) & 1) << 5)); }
__host__ __device__ __forceinline__ void stage_rc(int b, int& R, int& C) { const int st = b / 1024, sb = b % 1024, swz = sb ^ (((sb >> 9) & 1) << 5); R = (st >> 1) * 16 + swz / 64; C = (st & 1) * 32 + (swz % 64) / 2; }
__host__ __device__ __forceinline__ int perm32(int rho) { const int n = rho >> 4, i = rho & 15; return 8 * (i >> 2) + 4 * n + (i & 3); }

struct Unit { int pm, pn; };
struct Gemm { const bf16_t* A; const bf16_t* Bt; int M, N, K; };

struct StaticOrder {
    int nM, nN, nwg, G, c;
    __host__ __device__ void init(int M, int N, int G_, int c_) { nM = M / BM; nN = N / BM; nwg = nM * nN; G = G_; c = c_; }
    __host__ __device__ bool next(int i, Unit& u) const {
        const long L = (long)i * G + c; if (L >= nwg) return false;
        int wgid = (int)L; { const int q = nwg / NXCD, r = nwg % NXCD, xcd = wgid % NXCD, off = wgid / NXCD; wgid = (xcd < r ? xcd * (q + 1) : r * (q + 1) + (xcd - r) * q) + off; }
        const int nig = WGM * nN, gid = wgid / nig, fm = gid * WGM, gsz = (nM - fm) < WGM ? (nM - fm) : WGM;
        u.pm = fm + ((wgid % nig) % gsz); u.pn = (wgid % nig) / gsz; return true;
    }
    __device__ __forceinline__ void a_ready(const Unit&) const {}
    __device__ __forceinline__ void done(const Unit&) const {}
};

typedef float cvt_pk_bf16_f32x2 __attribute__((ext_vector_type(2))); typedef __bf16 cvt_pk_bf16_bf16x2 __attribute__((ext_vector_type(2)));
__device__ __forceinline__ unsigned cvt_pk_bf16(float lo, float hi) { const cvt_pk_bf16_f32x2 v = {lo, hi}; const cvt_pk_bf16_bf16x2 b = __builtin_convertvector(v, cvt_pk_bf16_bf16x2); return __builtin_bit_cast(unsigned, b); }
__device__ __forceinline__ u32x4 pack8bf(const f32x4& v0, const f32x4& v1) { u32x4 w; w.x = cvt_pk_bf16(v0[0], v0[1]); w.y = cvt_pk_bf16(v0[2], v0[3]); w.z = cvt_pk_bf16(v1[0], v1[1]); w.w = cvt_pk_bf16(v1[2], v1[3]); return w; }

struct EpiStoreBf16 {
    static constexpr bool PERM = true, AFTER_DRAIN = false;
    bf16_t* O; int ldc;
    __device__ __forceinline__ void operator()(const f32x4 (&acc)[2][2][4][2], const Unit& u, int wr, int wc, int fr, int fq) const {
        const int row0 = u.pm * BM + wr * 64 + fr, col0 = u.pn * BM + wc * 32 + 8 * fq;
#pragma unroll
        for (int ai = 0; ai < 2; ++ai)
#pragma unroll
            for (int m = 0; m < 4; ++m) { bf16_t* rowp = O + (size_t)(row0 + ai * HALF + m * 16) * ldc + col0;
#pragma unroll
                for (int bj = 0; bj < 2; ++bj) *(u32x4*)(rowp + bj * HALF) = pack8bf(acc[ai][bj][m][0], acc[ai][bj][m][1]); }
    }
};
template <bool RES> struct EpiStoreF32 {
    static constexpr bool PERM = true, AFTER_DRAIN = false;
    float* O; const float* res; int ldc;
    __device__ __forceinline__ void operator()(const f32x4 (&acc)[2][2][4][2], const Unit& u, int wr, int wc, int fr, int fq) const {
        const int row0 = u.pm * BM + wr * 64 + fr, col0 = u.pn * BM + wc * 32 + 8 * fq;
#pragma unroll
        for (int ai = 0; ai < 2; ++ai)
#pragma unroll
            for (int m = 0; m < 4; ++m) { const size_t off = (size_t)(row0 + ai * HALF + m * 16) * ldc + col0;
#pragma unroll
                for (int bj = 0; bj < 2; ++bj) { f32x4 v0 = acc[ai][bj][m][0], v1 = acc[ai][bj][m][1];
                    if (RES) { v0 += *(const f32x4*)(res + off + bj * HALF); v1 += *(const f32x4*)(res + off + bj * HALF + 4); }
                    *(f32x4*)(O + off + bj * HALF) = v0; *(f32x4*)(O + off + bj * HALF + 4) = v1; } }
    }
};
#define EPI_LDSBAR() do { asm volatile("s_waitcnt lgkmcnt(0)" ::: "memory"); __builtin_amdgcn_s_barrier(); asm volatile("" ::: "memory"); } while (0)
struct EpiInProj {
    static constexpr bool PERM = true, AFTER_DRAIN = false;
    bf16_t *cq, *ckv, *fq, *fk, *fv, *gates, *kpe; float* lf; const float *b_gate, *b_forget; float* ssq; const float *gfq, *gfk; PG8_LAS float* xs;
    __device__ __forceinline__ void operator()(const f32x4 (&acc)[2][2][4][2], const Unit& u, int wr, int wc, int fr, int fq_) const {
        const int pn = u.pn, row0 = u.pm * BM + wr * 64 + fr, cw = wc * 32 + 8 * fq_;
        if (pn < 4) {
            bf16_t* base = pn < 2 ? cq : ckv; const int colt = (pn & 1) * 256;
#pragma unroll
            for (int ai = 0; ai < 2; ++ai)
#pragma unroll
                for (int m = 0; m < 4; ++m) { const int row = row0 + ai * HALF + m * 16; bf16_t* rowp = base + (size_t)row * 512 + colt + cw; float s = 0.f;
#pragma unroll
                    for (int bj = 0; bj < 2; ++bj) { const f32x4 v0 = acc[ai][bj][m][0], v1 = acc[ai][bj][m][1];
                        s += (v0[0] * v0[0] + v0[1] * v0[1]) + (v0[2] * v0[2] + v0[3] * v0[3]) + (v1[0] * v1[0] + v1[1] * v1[1]) + (v1[2] * v1[2] + v1[3] * v1[3]);
                        *(u32x4*)(rowp + bj * HALF) = pack8bf(v0, v1); }
                    s += __shfl_xor(s, 16); s += __shfl_xor(s, 32);
                    if (fq_ == 0) ssq[((size_t)pn * 8192 + row) * 4 + wc] = s; }
        } else if (pn < 20) {
            const bool isq = pn < 12; bf16_t* base = isq ? fq : fk; const int colt = (pn - (isq ? 4 : 12)) * 256; const float* g = isq ? gfq : gfk;
            const float qs = isq ? 0.12751743f : 1.f;
#pragma unroll
            for (int ai = 0; ai < 2; ++ai)
#pragma unroll
                for (int m = 0; m < 4; ++m)
#pragma unroll
                    for (int bj = 0; bj < 2; ++bj) { const f32x4 v0 = acc[ai][bj][m][0], v1 = acc[ai][bj][m][1];
                        float s = (v0[0] * v0[0] + v0[1] * v0[1]) + (v0[2] * v0[2] + v0[3] * v0[3]) + (v1[0] * v1[0] + v1[1] * v1[1]) + (v1[2] * v1[2] + v1[3] * v1[3]);
                        s += __shfl_xor(s, 16); s += __shfl_xor(s, 32);
                        if (fq_ == 0) xs[((ai * HALF + wr * 64 + m * 16 + fr) * 2 + bj) * 4 + wc] = s; }
            EPI_LDSBAR();
            const f32x4 g0 = *(const f32x4*)(g + cw) * qs, g1 = *(const f32x4*)(g + cw + 4) * qs;
#pragma unroll
            for (int ai = 0; ai < 2; ++ai)
#pragma unroll
                for (int m = 0; m < 4; ++m) { bf16_t* rowp = base + (size_t)(row0 + ai * HALF + m * 16) * 2048 + colt + cw;
#pragma unroll
                    for (int bj = 0; bj < 2; ++bj) { const f32x4 t4 = *(const PG8_LAS f32x4*)(xs + ((ai * HALF + wr * 64 + m * 16 + fr) * 2 + bj) * 4);
                        const float r = rsqrtf(((t4[0] + t4[1]) + (t4[2] + t4[3])) * (1.f / 128.f) + 1e-6f);
                        *(u32x4*)(rowp + bj * HALF) = pack8bf(acc[ai][bj][m][0] * g0 * r, acc[ai][bj][m][1] * g1 * r); } }
        } else if (pn < 28) {
            const int colt = (pn - 20) * 256;
#pragma unroll
            for (int ai = 0; ai < 2; ++ai)
#pragma unroll
                for (int m = 0; m < 4; ++m) { bf16_t* rowp = fv + (size_t)(row0 + ai * HALF + m * 16) * 2048 + colt + cw;
#pragma unroll
                    for (int bj = 0; bj < 2; ++bj) *(u32x4*)(rowp + bj * HALF) = pack8bf(acc[ai][bj][m][0], acc[ai][bj][m][1]); }
        } else if (pn < 44) {
            const int colt = (pn - 28) * 256 + cw;
#pragma unroll
            for (int bj = 0; bj < 2; ++bj) {
                const f32x4 b0 = *(const f32x4*)(b_gate + colt + bj * HALF), b1 = *(const f32x4*)(b_gate + colt + bj * HALF + 4);
#pragma unroll
                for (int ai = 0; ai < 2; ++ai)
#pragma unroll
                    for (int m = 0; m < 4; ++m) {
                        f32x4 v0 = acc[ai][bj][m][0] + b0, v1 = acc[ai][bj][m][1] + b1;
#pragma unroll
                        for (int e = 0; e < 4; ++e) { v0[e] = __builtin_amdgcn_rcpf(1.f + __expf(-v0[e])); v1[e] = __builtin_amdgcn_rcpf(1.f + __expf(-v1[e])); }
                        *(u32x4*)(gates + (size_t)(row0 + ai * HALF + m * 16) * 4096 + colt + bj * HALF) = pack8bf(v0, v1); }
            }
        } else {
            if (cw < 64) {
#pragma unroll
                for (int ai = 0; ai < 2; ++ai)
#pragma unroll
                    for (int m = 0; m < 4; ++m) *(u32x4*)(kpe + (size_t)(row0 + ai * HALF + m * 16) * 64 + cw) = pack8bf(acc[ai][0][m][0], acc[ai][0][m][1]);
            } else if (cw < 80) {
                const int h0 = cw - 64;
                const f32x4 b0 = *(const f32x4*)(b_forget + h0), b1 = *(const f32x4*)(b_forget + h0 + 4);
#pragma unroll
                for (int ai = 0; ai < 2; ++ai)
#pragma unroll
                    for (int m = 0; m < 4; ++m) { const int row = row0 + ai * HALF + m * 16;
                        f32x4 z0 = acc[ai][0][m][0] + b0, z1 = acc[ai][0][m][1] + b1;
#pragma unroll
                        for (int e = 0; e < 4; ++e) { z0[e] = fminf(z0[e], 0.f) - __logf(1.f + __expf(-fabsf(z0[e]))); z1[e] = fminf(z1[e], 0.f) - __logf(1.f + __expf(-fabsf(z1[e]))); }
                        *(f32x4*)(lf + (size_t)row * 16 + h0) = z0; *(f32x4*)(lf + (size_t)row * 16 + h0 + 4) = z1; }
            }
        }
    }
};
__device__ __forceinline__ float lat_rinv(const float* ssq, int part0, int row) {
    const f32x4 a = *(const f32x4*)(ssq + ((size_t)part0 * 8192 + row) * 4), b = *(const f32x4*)(ssq + ((size_t)(part0 + 1) * 8192 + row) * 4);
    return rsqrtf((((a[0] + a[1]) + (a[2] + a[3])) + ((b[0] + b[1]) + (b[2] + b[3]))) * (1.f / 512.f) + 1e-6f);
}
struct EpiQ {
    static constexpr bool PERM = true, AFTER_DRAIN = false;
    bf16_t* qa; const float* ssq; const float* gq; const float2* ropeT; PG8_LAS float* xs;
    __device__ __forceinline__ void operator()(const f32x4 (&acc)[2][2][4][2], const Unit& u, int wr, int wc, int fr, int fq_) const {
        const int h = u.pn, row0 = u.pm * BM + wr * 64 + fr, cw = wc * 32 + 8 * fq_;
        float rl[2][4];
#pragma unroll
        for (int ai = 0; ai < 2; ++ai)
#pragma unroll
            for (int m = 0; m < 4; ++m) { rl[ai][m] = lat_rinv(ssq, 0, row0 + ai * HALF + m * 16); float s = 0.f;
#pragma unroll
                for (int bj = 0; bj < 2; ++bj) { const f32x4 v0 = acc[ai][bj][m][0], v1 = acc[ai][bj][m][1];
                    s += (v0[0] * v0[0] + v0[1] * v0[1]) + (v0[2] * v0[2] + v0[3] * v0[3]) + (v1[0] * v1[0] + v1[1] * v1[1]) + (v1[2] * v1[2] + v1[3] * v1[3]); }
                s *= rl[ai][m] * rl[ai][m];
                s += __shfl_xor(s, 16); s += __shfl_xor(s, 32);
                if (fq_ == 0) xs[(ai * HALF + wr * 64 + m * 16 + fr) * 4 + wc] = s; }
        EPI_LDSBAR();
        const float qs = 0.10411754f;
        const f32x4 g0 = *(const f32x4*)(gq + cw) * qs, g1 = *(const f32x4*)(gq + cw + 4) * qs;
        const int pp = 16 * (wc & 1) + 4 * fq_;
        const f32x4 ga = *(const f32x4*)(gq + 128 + pp) * qs, gb = *(const f32x4*)(gq + 160 + pp) * qs;
#pragma unroll
        for (int ai = 0; ai < 2; ++ai)
#pragma unroll
            for (int m = 0; m < 4; ++m) { const int row = row0 + ai * HALF + m * 16;
                const f32x4 t4 = *(const PG8_LAS f32x4*)(xs + (ai * HALF + wr * 64 + m * 16 + fr) * 4);
                const float r = rsqrtf(((t4[0] + t4[1]) + (t4[2] + t4[3])) * (1.f / 192.f) + 1e-6f) * rl[ai][m];
                bf16_t* rowp = qa + (size_t)row * 3072 + h * 192;
                *(u32x4*)(rowp + cw) = pack8bf(acc[ai][0][m][0] * g0 * r, acc[ai][0][m][1] * g1 * r);
                if (wc < 2) { const f32x4 c01 = *(const f32x4*)(ropeT + (size_t)row * 32 + pp), c23 = *(const f32x4*)(ropeT + (size_t)row * 32 + pp + 2);
                    const f32x4 z0 = acc[ai][1][m][0] * r, z1 = acc[ai][1][m][1] * r;
                    const float a0 = z0[0] * ga[0], b0 = z0[1] * gb[0], a1 = z0[2] * ga[1], b1 = z0[3] * gb[1], a2 = z1[0] * ga[2], b2 = z1[1] * gb[2], a3 = z1[2] * ga[3], b3 = z1[3] * gb[3];
                    const f32x4 o0 = {a0 * c01[0] - b0 * c01[1], a0 * c01[1] + b0 * c01[0], a1 * c01[2] - b1 * c01[3], a1 * c01[3] + b1 * c01[2]};
                    const f32x4 o1 = {a2 * c23[0] - b2 * c23[1], a2 * c23[1] + b2 * c23[0], a3 * c23[2] - b3 * c23[3], a3 * c23[3] + b3 * c23[2]};
                    *(u32x4*)(rowp + 128 + cw) = pack8bf(o0, o1); } }
    }
};
struct EpiKV {
    static constexpr bool PERM = true, AFTER_DRAIN = false;
    bf16_t *ka, *va; const bf16_t* kpe; const float* ssq; const float* gk; const float2* ropeT; PG8_LAS float* xs;
    __device__ __forceinline__ void operator()(const f32x4 (&acc)[2][2][4][2], const Unit& u, int wr, int wc, int fr, int fq_) const {
        const int h = u.pn, row0 = u.pm * BM + wr * 64 + fr, cw = wc * 32 + 8 * fq_;
        float rl[2][4]; f32x4 kp[2][4];
#pragma unroll
        for (int ai = 0; ai < 2; ++ai)
#pragma unroll
            for (int m = 0; m < 4; ++m) { const int row = row0 + ai * HALF + m * 16; rl[ai][m] = lat_rinv(ssq, 2, row);
                const uint2 w = *(const uint2*)(kpe + (size_t)row * 64 + 16 * wc + 4 * fq_);
                kp[ai][m] = (f32x4){__uint_as_float(w.x << 16), __uint_as_float(w.x & 0xffff0000u), __uint_as_float(w.y << 16), __uint_as_float(w.y & 0xffff0000u)};
                const f32x4 v0 = acc[ai][0][m][0], v1 = acc[ai][0][m][1];
                float s = ((v0[0] * v0[0] + v0[1] * v0[1]) + (v0[2] * v0[2] + v0[3] * v0[3]) + (v1[0] * v1[0] + v1[1] * v1[1]) + (v1[2] * v1[2] + v1[3] * v1[3])) * (rl[ai][m] * rl[ai][m]);
                s += (kp[ai][m][0] * kp[ai][m][0] + kp[ai][m][1] * kp[ai][m][1]) + (kp[ai][m][2] * kp[ai][m][2] + kp[ai][m][3] * kp[ai][m][3]);
                s += __shfl_xor(s, 16); s += __shfl_xor(s, 32);
                if (fq_ == 0) xs[(ai * HALF + wr * 64 + m * 16 + fr) * 4 + wc] = s;
                *(u32x4*)(va + (size_t)row * 2048 + h * 128 + cw) = pack8bf(acc[ai][1][m][0] * rl[ai][m], acc[ai][1][m][1] * rl[ai][m]); }
        EPI_LDSBAR();
        const f32x4 g0 = *(const f32x4*)(gk + cw), g1 = *(const f32x4*)(gk + cw + 4);
        const int pp = 8 * wc + 2 * fq_;
        const float ga0 = gk[128 + pp], ga1 = gk[128 + pp + 1], gb0 = gk[160 + pp], gb1 = gk[160 + pp + 1];
#pragma unroll
        for (int ai = 0; ai < 2; ++ai)
#pragma unroll
            for (int m = 0; m < 4; ++m) { const int row = row0 + ai * HALF + m * 16;
                const f32x4 t4 = *(const PG8_LAS f32x4*)(xs + (ai * HALF + wr * 64 + m * 16 + fr) * 4);
                const float r = rsqrtf(((t4[0] + t4[1]) + (t4[2] + t4[3])) * (1.f / 192.f) + 1e-6f), rn = r * rl[ai][m];
                bf16_t* rowp = ka + (size_t)row * 3072 + h * 192;
                *(u32x4*)(rowp + cw) = pack8bf(acc[ai][0][m][0] * g0 * rn, acc[ai][0][m][1] * g1 * rn);
                const f32x4 cs = *(const f32x4*)(ropeT + (size_t)row * 32 + pp);
                const float a0 = kp[ai][m][0] * r * ga0, b0 = kp[ai][m][1] * r * gb0, a1 = kp[ai][m][2] * r * ga1, b1 = kp[ai][m][3] * r * gb1;
                uint2 o; o.x = cvt_pk_bf16(a0 * cs[0] - b0 * cs[1], a0 * cs[1] + b0 * cs[0]); o.y = cvt_pk_bf16(a1 * cs[2] - b1 * cs[3], a1 * cs[3] + b1 * cs[2]);
                *(uint2*)(rowp + 128 + 16 * wc + 4 * fq_) = o; }
    }
};

struct EpiX1 {
    static constexpr bool PERM = true, AFTER_DRAIN = false;
    float* x1; const float* x; bf16_t* xg; const float* g; float* ssq2;
    __device__ __forceinline__ void operator()(const f32x4 (&acc)[2][2][4][2], const Unit& u, int wr, int wc, int fr, int fq_) const {
        const int row0 = u.pm * BM + wr * 64 + fr, col0 = u.pn * BM + wc * 32 + 8 * fq_;
        f32x4 gg[2][2];
#pragma unroll
        for (int bj = 0; bj < 2; ++bj) { gg[bj][0] = *(const f32x4*)(g + col0 + bj * HALF); gg[bj][1] = *(const f32x4*)(g + col0 + bj * HALF + 4); }
#pragma unroll
        for (int ai = 0; ai < 2; ++ai)
#pragma unroll
            for (int m = 0; m < 4; ++m) { const int row = row0 + ai * HALF + m * 16; const size_t off = (size_t)row * 2048 + col0; float s = 0.f;
#pragma unroll
                for (int bj = 0; bj < 2; ++bj) { const f32x4 v0 = acc[ai][bj][m][0] + *(const f32x4*)(x + off + bj * HALF), v1 = acc[ai][bj][m][1] + *(const f32x4*)(x + off + bj * HALF + 4);
                    *(f32x4*)(x1 + off + bj * HALF) = v0; *(f32x4*)(x1 + off + bj * HALF + 4) = v1;
                    s += (v0[0] * v0[0] + v0[1] * v0[1]) + (v0[2] * v0[2] + v0[3] * v0[3]) + (v1[0] * v1[0] + v1[1] * v1[1]) + (v1[2] * v1[2] + v1[3] * v1[3]);
                    *(u32x4*)(xg + off + bj * HALF) = pack8bf(v0 * gg[bj][0], v1 * gg[bj][1]); }
                s += __shfl_xor(s, 16); s += __shfl_xor(s, 32);
                if (fq_ == 0) ssq2[((size_t)u.pn * 8192 + row) * 4 + wc] = s; }
    }
};
__device__ __forceinline__ float ffn_rinv(const float* ssq2, int row) {
    float t = 0.f;
#pragma unroll
    for (int pn = 0; pn < 8; ++pn) { const f32x4 a = *(const f32x4*)(ssq2 + ((size_t)pn * 8192 + row) * 4); t += (a[0] + a[1]) + (a[2] + a[3]); }
    return rsqrtf(t * (1.f / 2048.f) + 1e-6f);
}
struct EpiScores {
    static constexpr bool PERM = true, AFTER_DRAIN = false;
    float* O; const float* ssq2;
    __device__ __forceinline__ void operator()(const f32x4 (&acc)[2][2][4][2], const Unit& u, int wr, int wc, int fr, int fq_) const {
        const int row0 = u.pm * BM + wr * 64 + fr, col0 = u.pn * BM + wc * 32 + 8 * fq_;
#pragma unroll
        for (int ai = 0; ai < 2; ++ai)
#pragma unroll
            for (int m = 0; m < 4; ++m) { const int row = row0 + ai * HALF + m * 16; const float r = ffn_rinv(ssq2, row); const size_t off = (size_t)row * 2048 + col0;
#pragma unroll
                for (int bj = 0; bj < 2; ++bj) { *(f32x4*)(O + off + bj * HALF) = acc[ai][bj][m][0] * r; *(f32x4*)(O + off + bj * HALF + 4) = acc[ai][bj][m][1] * r; } }
    }
};
template <class Epi, class Sched, bool ALIGN_EPI = false, bool SP2 = false>
__device__ __forceinline__ void gemm_phase(PG8_LAS unsigned char* lds, const Gemm g, const Sched& S, const Epi& E) {
    int tid = threadIdx.x; asm volatile("" : "+v"(tid));
    const int wid = __builtin_amdgcn_readfirstlane(tid >> 6), lane = tid & 63, wr = wid >> 2, wc = wid & 3, fr = lane & 15, fq = lane >> 4;
    const int K = g.K, nt = K / BK;
    unsigned voffA[2], voffB[2];
#pragma unroll
    for (int i = 0; i < 2; ++i) { int R, C; stage_rc(tid * 16 + i * 8192, R, C); const int Rb = Epi::PERM ? ((R & ~31) + perm32(R & 31)) : R;
        voffA[i] = (unsigned)(R * K + C) * 2u; voffB[i] = (unsigned)(Rb * K + C) * 2u; }
    const size_t kstep = (size_t)(BK * 2);
    const size_t hstep = (size_t)HALF * K * 2;
    const size_t tstep = 2 * hstep;
    const unsigned ldsw = (unsigned)wid * 1024u;
    const int aoff = lds_byte(wr * 64 + fr, fq * 8), boff = lds_byte(wc * 32 + fr, fq * 8);
#define PG8_SA(b, h) (((b) * 2 + (h)) * HTB)
#define PG8_SB(b, h) ((4 + (b) * 2 + (h)) * HTB)
#define PG8_STAGE(bufoff, gbase, voff) do { _Pragma("unroll") for (int _i = 0; _i < 2; ++_i) \
        __builtin_amdgcn_global_load_lds((const unsigned*)((const char*)(gbase) + (voff)[_i]), (PG8_LAS unsigned*)(lds + (bufoff) + ldsw + _i * 8192), 16, 0, 0); } while (0)
#define PG8_LDA(dst, b, h) do { _Pragma("unroll") for (int m = 0; m < 4; ++m) _Pragma("unroll") for (int k = 0; k < 2; ++k) dst[m][k] = *(const PG8_LAS bf16x8*)(lds + PG8_SA(b, h) + aoff + m * 2048 + k * 1024); } while (0)
#define PG8_LDB(dst, b, h) do { _Pragma("unroll") for (int n = 0; n < 2; ++n) _Pragma("unroll") for (int k = 0; k < 2; ++k) dst[n][k] = *(const PG8_LAS bf16x8*)(lds + PG8_SB(b, h) + boff + n * 2048 + k * 1024); } while (0)
#define PG8_MMA(ai, bj, At, Bt) do { __builtin_amdgcn_s_setprio(1); _Pragma("unroll") for (int m = 0; m < 4; ++m) _Pragma("unroll") for (int n = 0; n < 2; ++n) _Pragma("unroll") for (int k = 0; k < 2; ++k) \
        acc[ai][bj][m][n] = __builtin_amdgcn_mfma_f32_16x16x32_bf16(Bt[n][k], At[m][k], acc[ai][bj][m][n], 0, 0, 0); __builtin_amdgcn_s_setprio(0); } while (0)
#define PG8_WAIT_V(n) asm volatile("s_waitcnt vmcnt(" #n ")" ::: "memory")
#define PG8_WAIT_L(n) asm volatile("s_waitcnt lgkmcnt(" #n ")" ::: "memory")
#define PG8_BAR __builtin_amdgcn_s_barrier()
#define PG8_SCHED __builtin_amdgcn_sched_barrier(0)
    Unit cur, nxt; int ui = 0;
    if (!S.next(0, cur)) return;
    f32x4 acc[2][2][4][2];
#pragma unroll
    for (int a = 0; a < 2; ++a)
#pragma unroll
        for (int b = 0; b < 2; ++b)
#pragma unroll
            for (int m = 0; m < 4; ++m)
#pragma unroll
                for (int n = 0; n < 2; ++n) acc[a][b][m][n] = (f32x4){0.f, 0.f, 0.f, 0.f};
    bf16x8 At[4][2], B0[2][2], B1[2][2];
    const char* cA = (const char*)g.A + (size_t)cur.pm * tstep; const char* cB = (const char*)g.Bt + (size_t)cur.pn * tstep;
    S.a_ready(cur);
    if constexpr (SP2) {
        PG8_STAGE(PG8_SB(0, 0), cB, voffB); PG8_STAGE(PG8_SB(0, 1), cB + hstep, voffB); PG8_STAGE(PG8_SA(0, 0), cA, voffA); PG8_STAGE(PG8_SA(0, 1), cA + hstep, voffA);
        if (wr == 1) PG8_BAR;
        PG8_WAIT_V(2); PG8_BAR;
        PG8_STAGE(PG8_SB(1, 0), cB + kstep, voffB); PG8_STAGE(PG8_SA(1, 0), cA + kstep, voffA); PG8_STAGE(PG8_SB(1, 1), cB + hstep + kstep, voffB);
        PG8_WAIT_V(6); PG8_BAR;
    } else {
        PG8_STAGE(PG8_SB(0, 0), cB, voffB); PG8_STAGE(PG8_SA(0, 0), cA, voffA); PG8_STAGE(PG8_SB(0, 1), cB + hstep, voffB); PG8_STAGE(PG8_SA(0, 1), cA + hstep, voffA);
        if (wr == 1) PG8_BAR;
        PG8_WAIT_V(4); PG8_BAR;
        PG8_STAGE(PG8_SB(1, 0), cB + kstep, voffB); PG8_STAGE(PG8_SA(1, 0), cA + kstep, voffA); PG8_STAGE(PG8_SB(1, 1), cB + hstep + kstep, voffB);
        PG8_WAIT_V(6); PG8_BAR;
    }
    for (;;) {
        const bool has_next = S.next(ui + 1, nxt);
        const char* nA = has_next ? (const char*)g.A + (size_t)nxt.pm * tstep : cA; const char* nB = has_next ? (const char*)g.Bt + (size_t)nxt.pn * tstep : cB;
        for (int t = 0; t < nt; t += 2) {
            const bool last = (t == nt - 2);
            const char* a1 = cA + (size_t)(t + 1) * kstep;
            const char* a2 = last ? nA : cA + (size_t)(t + 2) * kstep; const char* b2 = last ? nB : cB + (size_t)(t + 2) * kstep;
            const char* a3 = a2 + kstep; const char* b3 = b2 + kstep;
            if (last && has_next) S.a_ready(nxt);
            if constexpr (SP2) {
            PG8_LDB(B0, 0, 0); PG8_LDB(B1, 0, 1); PG8_SCHED; PG8_LDA(At, 0, 0); PG8_STAGE(PG8_SA(1, 1), a1 + hstep, voffA);
            PG8_WAIT_V(8); PG8_WAIT_L(0); PG8_BAR; PG8_MMA(0, 0, At, B0); PG8_MMA(0, 1, At, B1); PG8_BAR; PG8_SCHED;
            PG8_LDA(At, 0, 1); PG8_STAGE(PG8_SB(0, 0), b2, voffB); PG8_STAGE(PG8_SB(0, 1), b2 + hstep, voffB); PG8_STAGE(PG8_SA(0, 0), a2, voffA);
            PG8_WAIT_V(8); PG8_WAIT_L(0); PG8_BAR; PG8_MMA(1, 0, At, B0); PG8_MMA(1, 1, At, B1); PG8_BAR; PG8_SCHED;
            PG8_LDB(B0, 1, 0); PG8_LDB(B1, 1, 1); PG8_SCHED; PG8_LDA(At, 1, 0); PG8_STAGE(PG8_SA(0, 1), a2 + hstep, voffA);
            PG8_WAIT_V(8); PG8_WAIT_L(0); PG8_BAR; PG8_MMA(0, 0, At, B0); PG8_MMA(0, 1, At, B1); PG8_BAR; PG8_SCHED;
            PG8_LDA(At, 1, 1); PG8_STAGE(PG8_SB(1, 0), b3, voffB); PG8_STAGE(PG8_SB(1, 1), b3 + hstep, voffB); PG8_STAGE(PG8_SA(1, 0), a3, voffA);
            PG8_WAIT_V(8); PG8_WAIT_L(0); PG8_BAR; PG8_MMA(1, 0, At, B0); PG8_MMA(1, 1, At, B1); PG8_BAR; PG8_SCHED;
            } else {
            PG8_LDB(B0, 0, 0); PG8_SCHED; PG8_LDA(At, 0, 0); PG8_STAGE(PG8_SA(1, 1), a1 + hstep, voffA);
            PG8_WAIT_L(8); PG8_BAR; PG8_WAIT_L(0); PG8_MMA(0, 0, At, B0); PG8_BAR; PG8_SCHED;
            PG8_LDB(B1, 0, 1); PG8_STAGE(PG8_SB(0, 0), b2, voffB);
            PG8_BAR; PG8_WAIT_L(0); PG8_MMA(0, 1, At, B1); PG8_BAR;
            PG8_LDA(At, 0, 1); PG8_STAGE(PG8_SA(0, 0), a2, voffA);
            PG8_BAR; PG8_WAIT_L(0); PG8_MMA(1, 0, At, B0); PG8_BAR; PG8_SCHED;
            PG8_STAGE(PG8_SB(0, 1), b2 + hstep, voffB);
            PG8_WAIT_V(6); PG8_BAR; PG8_MMA(1, 1, At, B1); PG8_BAR;
            PG8_LDB(B0, 1, 0); PG8_SCHED; PG8_LDA(At, 1, 0); PG8_STAGE(PG8_SA(0, 1), a2 + hstep, voffA);
            PG8_WAIT_L(8); PG8_BAR; PG8_WAIT_L(0); PG8_MMA(0, 0, At, B0); PG8_BAR; PG8_SCHED;
            PG8_LDB(B1, 1, 1); PG8_STAGE(PG8_SB(1, 0), b3, voffB);
            PG8_BAR; PG8_WAIT_L(0); PG8_MMA(0, 1, At, B1); PG8_BAR;
            PG8_LDA(At, 1, 1); PG8_STAGE(PG8_SA(1, 0), a3, voffA);
            PG8_BAR; PG8_WAIT_L(0); PG8_MMA(1, 0, At, B0); PG8_BAR; PG8_SCHED;
            PG8_STAGE(PG8_SB(1, 1), b3 + hstep, voffB);
            PG8_WAIT_V(6); PG8_BAR; PG8_MMA(1, 1, At, B1); PG8_BAR;
            }
        }
        if constexpr (ALIGN_EPI) { if (wr == 0) PG8_BAR; }
        if constexpr (!Epi::AFTER_DRAIN) { E(acc, cur, wr, wc, fr, fq); S.done(cur); }
        if (!has_next) break;
#pragma unroll
        for (int a = 0; a < 2; ++a)
#pragma unroll
            for (int b = 0; b < 2; ++b)
#pragma unroll
                for (int m = 0; m < 4; ++m)
#pragma unroll
                    for (int n = 0; n < 2; ++n) acc[a][b][m][n] = (f32x4){0.f, 0.f, 0.f, 0.f};
        cur = nxt; cA = nA; cB = nB; ++ui;
        if constexpr (ALIGN_EPI) { if (wr == 1) PG8_BAR; }
    }
    PG8_WAIT_V(0);
    if constexpr (!ALIGN_EPI) { if (wr == 0) PG8_BAR; }
    PG8_BAR;
    if constexpr (Epi::AFTER_DRAIN) { E.fused(acc, cur, wr, wc, fr, fq, lds, wid, lane); S.done(cur); }
#undef PG8_SA
#undef PG8_SB
#undef PG8_STAGE
#undef PG8_LDA
#undef PG8_LDB
#undef PG8_MMA
#undef PG8_WAIT_V
#undef PG8_WAIT_L
#undef PG8_BAR
#undef PG8_SCHED
}
}
namespace att {
typedef unsigned short bf16_t;
typedef short bf16x8 __attribute__((ext_vector_type(8)));
typedef short s16x4 __attribute__((ext_vector_type(4)));
typedef float f32x16 __attribute__((ext_vector_type(16)));
typedef float f32x4 __attribute__((ext_vector_type(4)));
typedef unsigned u32x4 __attribute__((ext_vector_type(4)));
#define ALAS __attribute__((address_space(3)))
#define ASBAR() __builtin_amdgcn_sched_barrier(0)
constexpr int SHM_V = 16384;
template <int DK> struct Lay { static constexpr int ROWB = DK * 2, SHM_K = 64 * ROWB, OFF_K = 2 * SHM_V, OFF_F = OFF_K + 2 * SHM_K, OFF_WS = OFF_F + 512, TOTAL = OFF_WS + 8 * 256; };

__device__ __forceinline__ int v_st(int k, int c) { const int kk = (k & ~0xC) | ((k & 4) << 1) | ((k & 8) >> 1); return ((kk >> 3) * 4 + (c >> 5)) * 512 + ((kk & 7) * 32 + (c & 31)) * 2; }
__device__ __forceinline__ int v_rd_base(int lane) { return ((lane & 3) << 3) | (((lane >> 2) & 3) << 6) | (((lane >> 4) & 1) << 5) | (((lane >> 5) & 1) << 8); }
__device__ __forceinline__ int crow(int r, int hi) { return (r & 3) + 8 * (r >> 2) + 4 * hi; }
typedef float cvtpk_f32x2 __attribute__((ext_vector_type(2))); typedef __bf16 cvtpk_bf16x2 __attribute__((ext_vector_type(2)));
__device__ __forceinline__ unsigned cvtpk(float lo, float hi) { const cvtpk_f32x2 v = {lo, hi}; const cvtpk_bf16x2 b = __builtin_convertvector(v, cvtpk_bf16x2); return __builtin_bit_cast(unsigned, b); }

__device__ __forceinline__ float wave_max_f(float v) {
#pragma unroll
    for (int o = 32; o >= 1; o >>= 1) v = fmaxf(v, __shfl_xor(v, o));
    return v;
}
__device__ __forceinline__ float att_max3(float a, float b, float c) { return __builtin_fmaxf(__builtin_fmaxf(a, b), c); }
typedef float f32x16v __attribute__((ext_vector_type(16)));
typedef unsigned u32x6v __attribute__((ext_vector_type(6)));
constexpr int ROW6 = 1536;
__device__ __forceinline__ void fp6_put(unsigned char* __restrict__ T6, int row, int hf, int l, int g, f32x16v f0, f32x16v f1, float sc) {
    f0 *= sc; f1 *= sc;
    f32x16v ev, od;
#pragma unroll
    for (int k = 0; k < 8; ++k) { ev[k] = f0[2 * k]; od[k] = f0[2 * k + 1]; ev[8 + k] = f1[2 * k]; od[8 + k] = f1[2 * k + 1]; }
    const u32x6v w = __builtin_amdgcn_cvt_scalef32_2xpk16_fp6_f32(ev, od, 1.0f);
    unsigned char* base = T6 + (size_t)row * ROW6 + hf * 768 + l * 16;
    if (g == 0) { *(u32x4*)base = (u32x4){w[0], w[1], w[2], w[3]}; *(uint2*)(base + 256) = make_uint2(w[4], w[5]); }
    else { *(uint2*)(base + 264) = make_uint2(w[0], w[1]); *(u32x4*)(base + 512) = (u32x4){w[2], w[3], w[4], w[5]}; }
}
constexpr int SIDE_STG = 86016;
template <int DK, bool FOX>
__device__ __forceinline__ void attn_block(unsigned char* smem, const bf16_t* __restrict__ Q, int ldq, const bf16_t* __restrict__ K, int ldk, const bf16_t* __restrict__ V, int ldv,
                                           const float* __restrict__ Fh, const bf16_t* __restrict__ gate, bf16_t* __restrict__ gout  , int qbk, const float* __restrict__ gq, const float* __restrict__ gk  ,
                                           const float* __restrict__ side_u, const float* __restrict__ side_v, unsigned char* __restrict__ side_u8, unsigned char* __restrict__ side_v8, int& side_next) {
    typedef Lay<DK> LY;
    constexpr int ND = DK / 16, NKC = DK / 8, NKI = (64 * NKC) / 512;
    int tid = threadIdx.x; asm volatile("" : "+v"(tid));
    const int wid = __builtin_amdgcn_readfirstlane(tid >> 6), lane = tid & 63, r32 = lane & 31, hi = lane >> 5;
    const int q0 = qbk * 256, qlo = q0 + wid * 32, qm = qlo + r32 - 4 * hi;
    const int NT = 4 * qbk + 4;
    ALAS unsigned char* lds = (ALAS unsigned char*)smem;
    ALAS float* F_lds = (ALAS float*)(lds + LY::OFF_F);
    ALAS float* wsl = (ALAS float*)(lds + LY::OFF_WS) + wid * 64;
    bf16x8 qr[ND];
#pragma unroll
    for (int d0 = 0; d0 < ND; ++d0) qr[d0] = *(const bf16x8*)(Q + (size_t)(qlo + r32) * ldq + d0 * 16 + hi * 8);
    const float fq = FOX ? Fh[qlo + r32] : 0.f;
    int kgo[NKI], vgo[2];
#pragma unroll
    for (int i = 0; i < NKI; ++i) { const int pp = (wid * NKI + i) * 64 + lane, row = pp / NKC, cpos = pp % NKC, ch = cpos ^ ((row >> 1) & 7); kgo[i] = row * ldk + ch * 8; }
#pragma unroll
    for (int i = 0; i < 2; ++i) { const int o = ((wid * 2 + i) * 64 + lane) * 16, st = o >> 9, e = (o & 511) >> 1, kk = (st >> 2) * 8 + (e >> 5), c = (st & 3) * 32 + (e & 31);
        const int k = (kk & ~0xC) | ((kk & 4) << 1) | ((kk & 8) >> 1); vgo[i] = k * ldv + c; }
    const int vb0 = (int)(uintptr_t)smem + v_rd_base(lane);
    int kbase[4];
#pragma unroll
    for (int dd = 0; dd < 4; ++dd) kbase[dd] = LY::OFF_K + r32 * LY::ROWB + (((((dd << 1) | hi) ^ ((r32 >> 1) & 7))) << 4);
    float stf = 0.f;
#define ATT_GLDS(kb, bf) do { _Pragma("unroll") for (int i = 0; i < NKI; ++i) \
            __builtin_amdgcn_global_load_lds((const unsigned*)(K + (size_t)(kb) * ldk + kgo[i]), (ALAS unsigned*)(lds + LY::OFF_K + (bf) * LY::SHM_K + (wid * NKI + i) * 1024), 16, 0, 0); \
        _Pragma("unroll") for (int i = 0; i < 2; ++i) \
            __builtin_amdgcn_global_load_lds((const unsigned*)(V + (size_t)(kb) * ldv + vgo[i]), (ALAS unsigned*)(lds + (bf) * SHM_V + (wid * 2 + i) * 1024), 16, 0, 0); \
        if (FOX && tid < 64) stf = Fh[(kb) + tid]; } while (0)
#define ATT_WRITEF(bf) do { if (FOX && tid < 64) F_lds[(bf) * 64 + tid] = stf; } while (0)
    int t_start = 0; float m_init = 0.f;
    if (FOX) {
        const float gqm = wave_max_f(fmaxf(fabsf(gq[lane]), fabsf(gq[lane + 64]))), gkm = wave_max_f(fmaxf(fabsf(gk[lane]), fabsf(gk[lane + 64])));
        const float qk_bound = 0.12751743f * 128.f * gqm * gkm;
        const float thr = 2.02f * qk_bound + 40.f, f0 = Fh[q0]; m_init = -thr;
        const int j0 = lane, j1 = lane + 64;
        const bool c0 = (j0 < 4 * qbk) && (Fh[j0 * 64 + 63] - f0 >= thr), c1 = (j1 < 4 * qbk) && (Fh[(j1 < 4 * qbk ? j1 : 0) * 64 + 63] - f0 >= thr);
        t_start = __builtin_popcountll(__ballot(c0)) + __builtin_popcountll(__ballot(c1));
        t_start = __builtin_amdgcn_readfirstlane(t_start); }
    ATT_GLDS(t_start * 64, t_start & 1); ATT_WRITEF(t_start & 1);
    float m_reg = FOX ? m_init : 0.f, l_reg = 0.f; f32x16 o[4];
#pragma unroll
    for (int d = 0; d < 4; ++d)
#pragma unroll
        for (int r = 0; r < 16; ++r) o[d][r] = 0.f;
    int side_pend = -1;
    for (int t = t_start; t < NT; ++t) {
        const int buf = t & 1, kb = t * 64;
        asm volatile("s_waitcnt vmcnt(0)" ::: "memory");
        __syncthreads();
        if (t + 1 < NT) ATT_GLDS(kb + 64, buf ^ 1);
        if (side_pend >= 0) { const int sv = side_pend; side_pend = -1;
            if ((wid >> 2) == (sv & 1)) {
                const int c = tid & 255, rr = c >> 6, hf2 = (c >> 5) & 1, l = (c >> 1) & 15, g = c & 1;
                const ALAS float* sp = (const ALAS float*)(lds + SIDE_STG) + rr * 2048 + hf2 * 1024 + (2 * g) * 256 + l * 16;
                f32x16v f0, f1;
#pragma unroll
                for (int k = 0; k < 4; ++k) { const f32x4 a = *(const ALAS f32x4*)(sp + 4 * k), b2 = *(const ALAS f32x4*)(sp + 256 + 4 * k);
#pragma unroll
                    for (int e = 0; e < 4; ++e) { f0[4 * k + e] = a[e]; f1[4 * k + e] = b2[e]; } }
                const bool isv = sv >= 16;
                fp6_put(isv ? side_v8 : side_u8, blockIdx.x * 64 + (sv & 15) * 4 + rr, hf2, l, g, f0, f1, isv ? 4.f : 64.f); }
        } else if (side_next < 32 && t + 1 < NT) { const int sv = side_next; const bool isv = sv >= 16;
            const float* src = (isv ? side_v : side_u) + (size_t)(blockIdx.x * 64 + (sv & 15) * 4) * 2048;
#pragma unroll
            for (int i = 0; i < 4; ++i)
                __builtin_amdgcn_global_load_lds((const unsigned*)(src + ((i * 8 + wid) * 64 + lane) * 4), (ALAS unsigned*)(lds + SIDE_STG + (i * 8 + wid) * 1024), 16, 0, 0);
            side_pend = sv; ++side_next; }
        f32x16 p0, p1;
        if (FOX) { const float fqm = fq - m_reg;
#pragma unroll
            for (int g = 0; g < 4; ++g) { const f32x4 f0 = *(const ALAS f32x4*)(F_lds + buf * 64 + 8 * g + 4 * hi), f1 = *(const ALAS f32x4*)(F_lds + buf * 64 + 32 + 8 * g + 4 * hi);
#pragma unroll
                for (int e = 0; e < 4; ++e) { p0[4 * g + e] = fqm - f0[e]; p1[4 * g + e] = fqm - f1[e]; } }
        } else { const float nm = -m_reg;
#pragma unroll
            for (int r = 0; r < 16; ++r) { p0[r] = nm; p1[r] = nm; }
        }
        {
            constexpr int KPF = 2;
            int ka[4];
#pragma unroll
            for (int dd = 0; dd < 4; ++dd) ka[dd] = (int)(uintptr_t)smem + buf * LY::SHM_K + kbase[dd];
            bf16x8 kb0[KPF + 1], kb1[KPF + 1];
#define ATT_KRD(dst, addr, off) asm volatile("ds_read_b128 %0, %1 offset:%2" : "=&v"(dst) : "v"(addr), "i"(off) : "memory")
#pragma unroll
            for (int d0 = 0; d0 < KPF; ++d0) { ATT_KRD(kb0[d0 % (KPF + 1)], ka[d0 & 3], (d0 >> 2) * 128); ATT_KRD(kb1[d0 % (KPF + 1)], ka[d0 & 3], (d0 >> 2) * 128 + 32 * LY::ROWB); }
#pragma unroll
            for (int d0 = 0; d0 < ND; ++d0) {
                if (d0 + KPF < ND) { constexpr int dummy = 0; (void)dummy;
                    ATT_KRD(kb0[(d0 + KPF) % (KPF + 1)], ka[(d0 + KPF) & 3], ((d0 + KPF) >> 2) * 128); ATT_KRD(kb1[(d0 + KPF) % (KPF + 1)], ka[(d0 + KPF) & 3], ((d0 + KPF) >> 2) * 128 + 32 * LY::ROWB); }
                const int rem = (ND - 1 - d0) < KPF ? (ND - 1 - d0) : KPF;
                if (rem >= 2) asm volatile("s_waitcnt lgkmcnt(4)" ::: "memory");
                else if (rem == 1) asm volatile("s_waitcnt lgkmcnt(2)" ::: "memory");
                else asm volatile("s_waitcnt lgkmcnt(0)" ::: "memory");
                ASBAR();
                p0 = __builtin_amdgcn_mfma_f32_32x32x16_bf16(kb0[d0 % (KPF + 1)], qr[d0], p0, 0, 0, 0);
                p1 = __builtin_amdgcn_mfma_f32_32x32x16_bf16(kb1[d0 % (KPF + 1)], qr[d0], p1, 0, 0, 0);
            }
#undef ATT_KRD
        }
        if (kb + 63 > qlo) {
            const float NEG = -__builtin_inff(); const int dq = qm - kb;
#pragma unroll
            for (int r = 0; r < 16; ++r) { const int c = (r & 3) + 8 * (r >> 2); if (dq - c < 0) p0[r] = NEG; if (dq - c - 32 < 0) p1[r] = NEG; }
        }
        float pmax;
        { float a = att_max3(p0[0], p0[1], p1[0]), b = att_max3(p0[2], p0[3], p1[1]); a = att_max3(a, p1[2], p1[3]);
#pragma unroll
          for (int r = 4; r < 16; r += 4) { a = att_max3(a, p0[r], p0[r + 1]); b = att_max3(b, p0[r + 2], p0[r + 3]); a = att_max3(a, p1[r], p1[r + 1]); b = att_max3(b, p1[r + 2], p1[r + 3]); }
          pmax = fmaxf(a, b); }
        { auto rr = __builtin_amdgcn_permlane32_swap(__float_as_uint(pmax), __float_as_uint(pmax), false, false);
          pmax = fmaxf(__uint_as_float(rr[0]), __uint_as_float(rr[1])); }
        float alpha = 1.f;
        if (!__builtin_expect(__all(pmax <= 8.f), 1)) { const float dm = fmaxf(pmax, 0.f); alpha = __builtin_amdgcn_exp2f(-dm); m_reg += dm;
#pragma unroll
            for (int r = 0; r < 16; ++r) { p0[r] -= dm; p1[r] -= dm; } }
        float ps = 0.f;
#pragma unroll
        for (int r = 0; r < 16; ++r) { p0[r] = __builtin_amdgcn_exp2f(p0[r]); ps += p0[r]; }
#pragma unroll
        for (int r = 0; r < 16; ++r) { p1[r] = __builtin_amdgcn_exp2f(p1[r]); ps += p1[r]; }
        { auto rr = __builtin_amdgcn_permlane32_swap(__float_as_uint(ps), __float_as_uint(ps), false, false);
          ps = __uint_as_float(rr[0]) + __uint_as_float(rr[1]); }
        l_reg = l_reg * alpha + ps;
        bf16x8 pa0, pa1, pa2, pa3;
#define ATT_PK4(P, B_, OUT) do { unsigned a0 = cvtpk(P[B_+0], P[B_+1]), a1 = cvtpk(P[B_+2], P[B_+3]); unsigned b0_ = cvtpk(P[B_+4], P[B_+5]), b1_ = cvtpk(P[B_+6], P[B_+7]); \
        auto r0 = __builtin_amdgcn_permlane32_swap(a0, b0_, false, false); auto r1 = __builtin_amdgcn_permlane32_swap(a1, b1_, false, false); \
        u32x4 w = {r0[0], r1[0], r0[1], r1[1]}; OUT = *reinterpret_cast<bf16x8*>(&w); } while (0)
        ATT_PK4(p0, 0, pa0); ATT_PK4(p0, 8, pa1); ATT_PK4(p1, 0, pa2); ATT_PK4(p1, 8, pa3);
        if (__any(alpha < 1.f)) {
            if (hi == 0) wsl[r32] = alpha;
            asm volatile("s_waitcnt lgkmcnt(0)" ::: "memory");
#pragma unroll
            for (int g = 0; g < 4; ++g) { const f32x4 al = *(const ALAS f32x4*)(wsl + 8 * g + 4 * hi);
#pragma unroll
                for (int d = 0; d < 4; ++d)
#pragma unroll
                    for (int e = 0; e < 4; ++e) o[d][4 * g + e] *= al[e]; }
        }
#define ATT_TRRD(dst, off) asm volatile("ds_read_b64_tr_b16 %0, %1 offset:%2" : "=&v"(dst) : "v"(vbb), "i"(off) : "memory")
#define ATT_PV(d0) do { s16x4 l0, l1, l2, l3, h0, h1, h2, h3; constexpr int b_ = (d0) * 512; \
        ATT_TRRD(l0, b_); ATT_TRRD(h0, b_ + 2048); ATT_TRRD(l1, b_ + 4096); ATT_TRRD(h1, b_ + 6144); ATT_TRRD(l2, b_ + 8192); ATT_TRRD(h2, b_ + 10240); ATT_TRRD(l3, b_ + 12288); ATT_TRRD(h3, b_ + 14336); \
        asm volatile("s_waitcnt lgkmcnt(0)" ::: "memory"); ASBAR(); \
        o[d0] = __builtin_amdgcn_mfma_f32_32x32x16_bf16(pa0, (bf16x8){l0[0], l0[1], l0[2], l0[3], h0[0], h0[1], h0[2], h0[3]}, o[d0], 0, 0, 0); \
        o[d0] = __builtin_amdgcn_mfma_f32_32x32x16_bf16(pa1, (bf16x8){l1[0], l1[1], l1[2], l1[3], h1[0], h1[1], h1[2], h1[3]}, o[d0], 0, 0, 0); \
        o[d0] = __builtin_amdgcn_mfma_f32_32x32x16_bf16(pa2, (bf16x8){l2[0], l2[1], l2[2], l2[3], h2[0], h2[1], h2[2], h2[3]}, o[d0], 0, 0, 0); \
        o[d0] = __builtin_amdgcn_mfma_f32_32x32x16_bf16(pa3, (bf16x8){l3[0], l3[1], l3[2], l3[3], h3[0], h3[1], h3[2], h3[3]}, o[d0], 0, 0, 0); } while (0)
        { const int vbb = vb0 + buf * SHM_V; ATT_PV(0); ATT_PV(1); ATT_PV(2); ATT_PV(3); }
        if (t + 1 < NT) ATT_WRITEF(buf ^ 1);
    }
    if (hi == 0) wsl[r32] = l_reg;
    asm volatile("s_waitcnt lgkmcnt(0)" ::: "memory");
#pragma unroll
    for (int r = 0; r < 16; ++r) {
        const int orow = crow(r, hi); const float rli = __builtin_amdgcn_rcpf(wsl[orow]);
        bf16_t* rowp = gout + (size_t)(qlo + orow) * 4096; const bf16_t* growp = gate + (size_t)(qlo + orow) * 4096;
#pragma unroll
        for (int d0 = 0; d0 < 4; ++d0) {
            const float v = o[d0][r] * rli; const float vn = __shfl_xor(v, 1);
            if ((r32 & 1) == 0) { unsigned* gp = (unsigned*)(rowp + d0 * 32 + r32); const unsigned g = *(const unsigned*)(growp + d0 * 32 + r32);
                *gp = cvtpk(v * __uint_as_float(g << 16), vn * __uint_as_float(g & 0xffff0000u)); }
        }
    }
    __syncthreads();
#undef ATT_GLDS
#undef ATT_WRITEF
#undef ATT_PK4
#undef ATT_TRRD
#undef ATT_PV
}
}
using pg8::bf16_t; using pg8::f32x4; using pg8::u32x4;
#define LAS __attribute__((address_space(3)))
constexpr int S = 8192, DM = 2048, INW = 11344, INWP = 11520;
constexpr float EPS = 1e-6f;
constexpr size_t MiB = 1u << 20;

__device__ __forceinline__ float bf2f(bf16_t v) { return __uint_as_float(((unsigned)v) << 16); }
__device__ __forceinline__ bf16_t f2bf(float f) { unsigned u = __float_as_uint(f); u += 0x7fffu + ((u >> 16) & 1u); return (bf16_t)(u >> 16); }
__device__ __forceinline__ unsigned pk2(float lo, float hi) { return (unsigned)f2bf(lo) | ((unsigned)f2bf(hi) << 16); }
__device__ __forceinline__ float wave_sum(float v) {
#pragma unroll
    for (int o = 32; o >= 1; o >>= 1) v += __shfl_xor(v, o);
    return v;
}
__device__ __forceinline__ float wave_max(float v) {
#pragma unroll
    for (int o = 32; o >= 1; o >>= 1) v = fmaxf(v, __shfl_xor(v, o));
    return v;
}

__device__ __forceinline__ int opaque_tid() { int t = threadIdx.x; asm volatile("" : "+v"(t)); return t; }

struct Params {
    const float* x; const int* pos; const float *mix_g, *w_in, *b_forget, *b_gate, *q_lat_g, *w_q_up, *kv_lat_g, *w_kv_up, *mla_qg, *mla_kg, *fox_qg, *fox_kg, *w_out, *ffn_g, *w_peer_q, *sub_keys, *peer_u, *peer_v;
    float* out;
    bf16_t *WqT, *WkvT, *WoT, *WpT, *WinT;
    bf16_t *h, *cq, *ckv, *fq, *fk, *fv, *merged, *kpe, *qa, *va, *ka;
    float *lf, *F, *x1, *scores;
    unsigned char *U8, *V8; bf16_t* attout;
    unsigned* ctl;
    float2* ropeT; float* ssq; float* ssq2; bf16_t* xg;
};

struct DstId { __device__ __forceinline__ int operator()(int n) const { return n; } };
struct DstWin { __device__ __forceinline__ int operator()(int n) const {
    if (n < 1024) return n; if (n < 1088) { const int r = n - 1024; return 11264 + 2 * (r & 31) + (r >> 5); } if (n < 7232) return n - 64; if (n < 7248) return 11264 + 64 + (n - 7232); return n - 80; } };
struct DstQ { __device__ __forceinline__ int operator()(int n) const {
    const int h = n / 192, d = n - h * 192; if (d < 128) return h * 256 + d; const int r = d - 128; return h * 256 + 128 + 2 * (r & 31) + (r >> 5); } };
template <class Dst>
__device__ __forceinline__ void transpose_item(const float* __restrict__ W, int K, int N, bf16_t* __restrict__ WT, Dst dst, float* scr, int item, int lane, const float* __restrict__ gk = nullptr) {
    const int nblk = (N + 31) / 32, kb = item / nblk, nb = item % nblk, k0 = 64 * kb, n0 = 32 * nb;
    { const int rr = lane >> 3, c4 = (lane & 7) * 4; const bool ok = (n0 + c4) < N;
      f32x4 v[8];
#pragma unroll
      for (int i = 0; i < 8; ++i) v[i] = ok ? *(const f32x4*)(W + (size_t)(k0 + 8 * i + rr) * N + n0 + c4) : (f32x4){0.f, 0.f, 0.f, 0.f};
      if (gk) {
#pragma unroll
          for (int i = 0; i < 8; ++i) v[i] *= gk[k0 + 8 * i + rr]; }
#pragma unroll
      for (int i = 0; i < 8; ++i) { float* sp = scr + (8 * i + rr) * 33 + c4; sp[0] = v[i][0]; sp[1] = v[i][1]; sp[2] = v[i][2]; sp[3] = v[i][3]; } }
    asm volatile("s_waitcnt lgkmcnt(0)" ::: "memory");
    const int c = lane & 7;
#pragma unroll
    for (int j = 0; j < 4; ++j) { const int nl = (lane >> 3) + 8 * j, n = n0 + nl; const float* s = scr + (8 * c) * 33 + nl;
        u32x4 o; o.x = pk2(s[0 * 33], s[1 * 33]); o.y = pk2(s[2 * 33], s[3 * 33]); o.z = pk2(s[4 * 33], s[5 * 33]); o.w = pk2(s[6 * 33], s[7 * 33]);
        if (n < N) *(u32x4*)(WT + (size_t)dst(n) * K + k0 + 8 * c) = o; }
    asm volatile("s_waitcnt lgkmcnt(0)" ::: "memory");
}
__device__ __forceinline__ void wfold_item(const float* __restrict__ wq, const float* __restrict__ keys, bf16_t* __restrict__ WpT, float* sm, int item) {
    const int tid = opaque_tid(), hc = item >> 5, d0 = (item & 31) * 64;
    float* keysL = sm; float* wqL = sm + 128 * 132;
    for (int idx = tid; idx < 128 * 32; idx += 512) { const int r = idx >> 5, c4 = (idx & 31) * 4; *(f32x4*)(keysL + r * 132 + c4) = *(const f32x4*)(keys + (size_t)hc * 16384 + r * 128 + c4); }
    for (int idx = tid; idx < 64 * 32; idx += 512) { const int r = idx >> 5, c4 = (idx & 31) * 4; *(f32x4*)(wqL + r * 132 + c4) = *(const f32x4*)(wq + (size_t)(d0 + r) * 2048 + hc * 128 + c4); }
    __syncthreads();
    const int n2 = (tid & 63) * 2, dg = tid >> 6;
    float acc[2][8];
#pragma unroll
    for (int a = 0; a < 2; ++a)
#pragma unroll
        for (int i = 0; i < 8; ++i) acc[a][i] = 0.f;
#pragma unroll 2
    for (int j4 = 0; j4 < 32; ++j4) {
        const f32x4 k0v = *(const f32x4*)(keysL + n2 * 132 + 4 * j4), k1v = *(const f32x4*)(keysL + (n2 + 1) * 132 + 4 * j4);
#pragma unroll
        for (int i = 0; i < 8; ++i) { const f32x4 w = *(const f32x4*)(wqL + (dg * 8 + i) * 132 + 4 * j4);
            acc[0][i] += (k0v[0] * w[0] + k0v[1] * w[1]) + (k0v[2] * w[2] + k0v[3] * w[3]);
            acc[1][i] += (k1v[0] * w[0] + k1v[1] * w[1]) + (k1v[2] * w[2] + k1v[3] * w[3]); }
    }
#pragma unroll
    for (int a = 0; a < 2; ++a) { u32x4 o; o.x = pk2(acc[a][0], acc[a][1]); o.y = pk2(acc[a][2], acc[a][3]); o.z = pk2(acc[a][4], acc[a][5]); o.w = pk2(acc[a][6], acc[a][7]);
        *(u32x4*)(WpT + (size_t)(hc * 128 + n2 + a) * 2048 + d0 + dg * 8) = o; }
    __syncthreads();
}
__device__ __forceinline__ void rms_row2048(const float* __restrict__ xr, const float* __restrict__ g, bf16_t* __restrict__ orow, int lane) {
    f32x4 v[8]; float ss = 0.f;
#pragma unroll
    for (int j = 0; j < 8; ++j) { v[j] = *(const f32x4*)(xr + j * 256 + lane * 4); ss += (v[j][0] * v[j][0] + v[j][1] * v[j][1]) + (v[j][2] * v[j][2] + v[j][3] * v[j][3]); }
    const float r = rsqrtf(wave_sum(ss) * (1.f / 2048.f) + EPS);
#pragma unroll
    for (int j = 0; j < 8; ++j) { const f32x4 gg = *(const f32x4*)(g + j * 256 + lane * 4);
        uint2 o; o.x = pk2(v[j][0] * r * gg[0], v[j][1] * r * gg[1]); o.y = pk2(v[j][2] * r * gg[2], v[j][3] * r * gg[3]);
        *(uint2*)(orow + j * 256 + lane * 4) = o; }
}
__device__ __forceinline__ void fox_cumsum(double* part, int h, const float* __restrict__ lf, float* __restrict__ F) {
    const int tid = opaque_tid(), lane = tid & 63, wave = tid >> 6;
    float v[16]; double sum = 0.0;
#pragma unroll
    for (int i = 0; i < 16; ++i) { v[i] = lf[(size_t)(tid * 16 + i) * 16 + h]; sum += (double)v[i]; }
    double inc = sum;
#pragma unroll
    for (int o = 1; o < 64; o <<= 1) { const double n = __shfl_up(inc, o); if (lane >= o) inc += n; }
    if (lane == 63) part[wave] = inc;
    __syncthreads();
    double base = 0.0;
    for (int w = 0; w < wave; ++w) base += part[w];
    double run = base + inc - sum;
#pragma unroll
    for (int i = 0; i < 16; ++i) { run += (double)v[i]; F[(size_t)h * S + tid * 16 + i] = (float)(run * 1.4426950408889634); }
    __syncthreads();
}
__device__ __forceinline__ void rope_table(const int* __restrict__ pos, float2* __restrict__ ropeT, int gtid, int nthreads) {
    for (int idx = gtid; idx < S * 32; idx += nthreads) { const int t = idx >> 5, i = idx & 31;
        const double inv = exp(-(double)i * (1.0 / 32.0) * 9.210340371976184);
        double ang = (double)((float)pos[t] * (float)inv);
        const double twopi = 6.283185307179586;
        ang -= twopi * rint(ang / twopi);
        ropeT[idx] = make_float2(cosf((float)ang), sinf((float)ang)); }
}
typedef float f32x2 __attribute__((ext_vector_type(2)));
__device__ __forceinline__ unsigned pk4_fp8(float a, float b, float c, float d) {
    int w = __builtin_amdgcn_cvt_pk_fp8_f32(fminf(fmaxf(a, -448.f), 448.f), fminf(fmaxf(b, -448.f), 448.f), 0, false);
    w = __builtin_amdgcn_cvt_pk_fp8_f32(fminf(fmaxf(c, -448.f), 448.f), fminf(fmaxf(d, -448.f), 448.f), w, true); return (unsigned)w; }
__device__ __forceinline__ void cvt_rows_fp8(const float* __restrict__ src, unsigned char* __restrict__ dst, size_t n, float scale, int gw, int NGW, int lane) {
    const size_t nchunk = n / 1024;
    for (size_t c = gw; c < nchunk; c += NGW) { const size_t o = c * 1024 + lane * 16;
        f32x4 a[4];
#pragma unroll
        for (int q = 0; q < 4; ++q) a[q] = *(const f32x4*)(src + o + 4 * q) * scale;
        u32x4 w; w.x = pk4_fp8(a[0][0], a[0][1], a[0][2], a[0][3]); w.y = pk4_fp8(a[1][0], a[1][1], a[1][2], a[1][3]);
        w.z = pk4_fp8(a[2][0], a[2][1], a[2][2], a[2][3]); w.w = pk4_fp8(a[3][0], a[3][1], a[3][2], a[3][3]);
        *(u32x4*)(dst + o) = w; }
}
constexpr float U_SCALE = 64.f, V_SCALE = 4.f;
typedef __bf16 bf16x2_t __attribute__((ext_vector_type(2)));
__device__ __forceinline__ float dot2bf(unsigned a, unsigned b, float c) { return __builtin_amdgcn_fdot2_f32_bf16(__builtin_bit_cast(bf16x2_t, a), __builtin_bit_cast(bf16x2_t, b), c, false); }
#define PEER_INS(top, x) do { float x_ = (x); _Pragma("unroll") for (int i_ = 0; i_ < 16; ++i_) { const float hi_ = fmaxf(top[i_], x_); x_ = fminf(top[i_], x_); top[i_] = hi_; } } while (0)
__device__ __forceinline__ void fp6_cvt_rows(const float* __restrict__ src, unsigned char* __restrict__ T6, int row0, int nrows, float sc, int t, int nt) {
    for (int u = t; u < nrows * 64; u += nt) { const int rr = u >> 6, hf = (u >> 5) & 1, l = (u >> 1) & 15, g = u & 1;
        const float* s0 = src + (size_t)(row0 + rr) * 2048 + hf * 1024 + (2 * g) * 256 + l * 16;
        att::f32x16v f0, f1;
#pragma unroll
        for (int k = 0; k < 4; ++k) { const f32x4 a = *(const f32x4*)(s0 + 4 * k), b2 = *(const f32x4*)(s0 + 256 + 4 * k);
#pragma unroll
            for (int e = 0; e < 4; ++e) { f0[4 * k + e] = a[e]; f1[4 * k + e] = b2[e]; } }
        att::fp6_put(T6, row0 + rr, hf, l, g, f0, f1, sc); }
}
typedef float f32x32v __attribute__((ext_vector_type(32)));
__device__ __forceinline__ void peer_group(unsigned char* smem, int g, const float* __restrict__ scores, const bf16_t* __restrict__ h2  , const float* __restrict__ ssq2, const float* __restrict__ x1,
                                           const unsigned char* __restrict__ U8, const unsigned char* __restrict__ V8, float* __restrict__ out) {
    const int tid = opaque_tid(), lane = tid & 63, wave = __builtin_amdgcn_readfirstlane(tid >> 6);
    float* topL = (float*)smem;
    int* selE = (int*)(smem + 32768);
    float* selG = (float*)(smem + 49152);
    {
        const int tl = tid >> 4, hc = tid & 15;
        const float* sp = scores + (size_t)(g * 32 + tl) * 2048 + hc * 128;
#define PEER_CE(a, b) do { const float hi_ = fmaxf(a, b), lo_ = fminf(a, b); a = hi_; b = lo_; } while (0)
        float top[16];
#pragma unroll 1
        for (int gi = 0; gi < 8; ++gi) {
            float gr[16];
#pragma unroll
            for (int q = 0; q < 4; ++q) { const f32x4 v = *(const f32x4*)(sp + gi * 16 + q * 4);
#pragma unroll
                for (int e = 0; e < 4; ++e) gr[q * 4 + e] = __uint_as_float((__float_as_uint(v[e]) & ~0x7Fu) | (unsigned)(gi * 16 + q * 4 + e)); }
#pragma unroll
            for (int k = 2; k <= 16; k <<= 1)
#pragma unroll
                for (int j = k >> 1; j > 0; j >>= 1)
#pragma unroll
                    for (int i = 0; i < 16; ++i) { const int l = i ^ j; if (l > i) { if ((i & k) == 0) PEER_CE(gr[i], gr[l]); else PEER_CE(gr[l], gr[i]); } }
            if (gi == 0) {
#pragma unroll
                for (int i = 0; i < 16; ++i) top[i] = gr[i];
            } else {
#pragma unroll
                for (int i = 0; i < 16; ++i) top[i] = fmaxf(top[i], gr[15 - i]);
#pragma unroll
                for (int j = 8; j > 0; j >>= 1)
#pragma unroll
                    for (int i = 0; i < 16; ++i) { const int l = i ^ j; if (l > i) PEER_CE(top[i], top[l]); }
            }
        }
#undef PEER_CE
        float* tp = topL + (tl * 16 + hc) * 16;
#pragma unroll
        for (int i = 0; i < 16; i += 4) *(f32x4*)(tp + i) = (f32x4){top[i], top[i + 1], top[i + 2], top[i + 3]};
    }
    __syncthreads();
    if (tid < 256) {
        const int tl = tid >> 3, h = tid & 7;
        const float* t1 = topL + (tl * 16 + 2 * h) * 16; const float* t2 = t1 + 16;
        float s1[16], s2[16];
#pragma unroll
        for (int i = 0; i < 16; i += 4) { const f32x4 a = *(const f32x4*)(t1 + i), b2 = *(const f32x4*)(t2 + i);
            s1[i] = a[0]; s1[i + 1] = a[1]; s1[i + 2] = a[2]; s1[i + 3] = a[3]; s2[i] = b2[0]; s2[i + 1] = b2[1]; s2[i + 2] = b2[2]; s2[i + 3] = b2[3]; }
#define PEER_CE(a, b) do { const float hi_ = fmaxf(a, b), lo_ = fminf(a, b); a = hi_; b = lo_; } while (0)
#define PEER_KEY(i, j) __uint_as_float((__float_as_uint(s1[i] + s2[j]) & ~0xFFu) | (unsigned)((i) * 16 + (j)))
        float ts[16], cand[34];
#pragma unroll
        for (int j = 0; j < 16; ++j) ts[j] = PEER_KEY(0, j);
        { int n = 0;
#pragma unroll
          for (int i = 1; i < 16; ++i)
#pragma unroll
              for (int j = 0; j < 8; ++j)
                  if ((i + 1) * (j + 1) <= 16) cand[n++] = PEER_KEY(i, j); }
#pragma unroll
        for (int gi = 0; gi < 2; ++gi) { float gr[16];
#pragma unroll
            for (int i = 0; i < 16; ++i) gr[i] = cand[gi * 16 + i];
#pragma unroll
            for (int k = 2; k <= 16; k <<= 1)
#pragma unroll
                for (int j = k >> 1; j > 0; j >>= 1)
#pragma unroll
                    for (int i = 0; i < 16; ++i) { const int l = i ^ j; if (l > i) { if ((i & k) == 0) PEER_CE(gr[i], gr[l]); else PEER_CE(gr[l], gr[i]); } }
#pragma unroll
            for (int i = 0; i < 16; ++i) ts[i] = fmaxf(ts[i], gr[15 - i]);
#pragma unroll
            for (int j = 8; j > 0; j >>= 1)
#pragma unroll
                for (int i = 0; i < 16; ++i) { const int l = i ^ j; if (l > i) PEER_CE(ts[i], ts[l]); } }
        PEER_INS(ts, cand[32]); PEER_INS(ts, cand[33]);
#undef PEER_CE
#undef PEER_KEY
        float ex[16], sum = 0.f;
#pragma unroll
        for (int k = 0; k < 16; ++k) { ex[k] = __expf(ts[k] - ts[0]); sum += ex[k]; }
        const float inv = 1.f / sum;
#pragma unroll
        for (int k = 0; k < 16; ++k) { const unsigned pos = __float_as_uint(ts[k]) & 0xFFu;
            const int i1 = (int)(__float_as_uint(t1[pos >> 4]) & 0x7Fu), i2 = (int)(__float_as_uint(t2[pos & 15]) & 0x7Fu);
            selE[tl * 128 + h * 16 + k] = i1 * 128 + i2; selG[tl * 128 + h * 16 + k] = ex[k] * inv; }
    }
    __syncthreads();
    const int grp = lane >> 4, l16 = lane & 15, tl = wave * 4 + grp;
    unsigned* sortK = (unsigned*)(smem + 65536) + tl * 128;
    float* wS = (float*)(smem + 81920) + tl * 128;
    unsigned* hist = (unsigned*)(smem + 98304) + wave * 512 + grp * 64;
    {
#pragma unroll
        for (int i = 0; i < 4; ++i) hist[l16 * 4 + i] = 0u;
        asm volatile("s_waitcnt lgkmcnt(0)" ::: "memory");
        unsigned ek[8], rk[8];
#pragma unroll
        for (int j = 0; j < 8; ++j) { ek[j] = (unsigned)selE[tl * 128 + l16 + 16 * j]; rk[j] = atomicAdd(&hist[ek[j] >> 8], 1u); }
        asm volatile("s_waitcnt lgkmcnt(0)" ::: "memory");
        unsigned c[4], tot = 0u;
#pragma unroll
        for (int i = 0; i < 4; ++i) { c[i] = hist[l16 * 4 + i]; tot += c[i]; }
        unsigned inc = tot;
#pragma unroll
        for (int o = 1; o < 16; o <<= 1) { const unsigned n = __shfl_up(inc, o, 16); if (l16 >= o) inc += n; }
        unsigned run = inc - tot;
#pragma unroll
        for (int i = 0; i < 4; ++i) { hist[256 + l16 * 4 + i] = run; run += c[i]; }
        asm volatile("s_waitcnt lgkmcnt(0)" ::: "memory");
#pragma unroll
        for (int j = 0; j < 8; ++j) sortK[hist[256 + (ek[j] >> 8)] + rk[j]] = (ek[j] << 7) | (unsigned)(l16 + 16 * j);
    }
    __syncthreads();
    const size_t tok = (size_t)g * 32 + tl;
    float rinv_tok;
    { float t = 0.f; if (l16 < 8) { const f32x4 a = *(const f32x4*)(ssq2 + ((size_t)l16 * 8192 + tok) * 4); t = (a[0] + a[1]) + (a[2] + a[3]); }
      t += __shfl_xor(t, 8); t += __shfl_xor(t, 4); t += __shfl_xor(t, 2); t += __shfl_xor(t, 1); rinv_tok = rsqrtf(t * (1.f / 2048.f) + 1e-6f); }
    {
        const int m16 = lane & 15, kg = lane >> 4, pt = m16 >> 2, sub = m16 & 3, l6 = kg * 4 + sub;
        const unsigned* sKa = (const unsigned*)(smem + 65536) + (wave * 4 + pt) * 128;
        const bool diag = pt == kg;
        const size_t tokb = (size_t)g * 32 + wave * 4 + pt;
        typedef int i32x8v __attribute__((ext_vector_type(8)));
        const float xsc = 1.4f * __shfl(rinv_tok, pt * 16);
#pragma unroll 1
        for (int hf = 0; hf < 2; ++hf) {
            i32x8v xb[2];
#pragma unroll
            for (int gq = 0; gq < 2; ++gq) { att::f32x16v ev, od;
#pragma unroll
                for (int h = 0; h < 2; ++h) { const bf16_t* xp = h2 + tokb * DM + hf * 1024 + (2 * gq + h) * 256 + l6 * 16;
                    const u32x4 w0 = *(const u32x4*)xp, w1 = *(const u32x4*)(xp + 8);
#pragma unroll
                    for (int q = 0; q < 4; ++q) { ev[8 * h + q] = __uint_as_float(w0[q] << 16) * xsc; od[8 * h + q] = __uint_as_float(w0[q] & 0xffff0000u) * xsc;
                        ev[8 * h + 4 + q] = __uint_as_float(w1[q] << 16) * xsc; od[8 * h + 4 + q] = __uint_as_float(w1[q] & 0xffff0000u) * xsc; } }
                const att::u32x6v w6 = __builtin_amdgcn_cvt_scalef32_2xpk16_fp6_f32(ev, od, 1.0f);
                xb[gq] = (i32x8v){(int)w6[0], (int)w6[1], (int)w6[2], (int)w6[3], (int)w6[4], (int)w6[5], 0, 0}; }
            u32x4 urA[4][3], urB[4][3];
#define PEER_LDA(ur, it0) do { _Pragma("unroll") for (int j = 0; j < 4; ++j) { const unsigned ro = (sKa[(it0) + j] >> 7) * (unsigned)att::ROW6 + (unsigned)(hf * 768 + l6 * 16); \
                    _Pragma("unroll") for (int c = 0; c < 3; ++c) ur[j][c] = *(const u32x4*)(U8 + ro + c * 256); } } while (0)
#define PEER_CMA(ur, it0) do { float dsel = 0.f; \
                _Pragma("unroll") for (int j = 0; j < 4; ++j) { f32x4 acc = (f32x4){0.f, 0.f, 0.f, 0.f}; \
                    acc = __builtin_amdgcn_mfma_scale_f32_16x16x128_f8f6f4((i32x8v){(int)ur[j][0][0], (int)ur[j][0][1], (int)ur[j][0][2], (int)ur[j][0][3], (int)ur[j][1][0], (int)ur[j][1][1], 0, 0}, xb[0], acc, 2, 2, 0, 0x7F7F7F7F, 0, 0x7F7F7F7F); \
                    acc = __builtin_amdgcn_mfma_scale_f32_16x16x128_f8f6f4((i32x8v){(int)ur[j][1][2], (int)ur[j][1][3], (int)ur[j][2][0], (int)ur[j][2][1], (int)ur[j][2][2], (int)ur[j][2][3], 0, 0}, xb[1], acc, 2, 2, 0, 0x7F7F7F7F, 0, 0x7F7F7F7F); \
                    float d = sub == 0 ? acc[0] : sub == 1 ? acc[1] : sub == 2 ? acc[2] : acc[3]; \
                    d += __builtin_bit_cast(float, __builtin_amdgcn_update_dpp(0, __builtin_bit_cast(int, d), 0xB1, 0xF, 0xF, true)); \
                    d += __builtin_bit_cast(float, __builtin_amdgcn_update_dpp(0, __builtin_bit_cast(int, d), 0x4E, 0xF, 0xF, true)); \
                    if (sub == j) dsel = d; } \
                if (diag) { float* wSt = (float*)(smem + 81920) + (wave * 4 + pt) * 128; \
                    if (hf == 0) wSt[(it0) + sub] = dsel; \
                    else { const float a = (wSt[(it0) + sub] + dsel) * (1.f / (1.4f * U_SCALE)); \
                        wSt[(it0) + sub] = selG[(wave * 4 + pt) * 128 + (sKa[(it0) + sub] & 127u)] * 0.5f * a * (1.f + erff(a * 0.70710678118654752f)) * (1.f / V_SCALE); } } } while (0)
            PEER_LDA(urA, 0);
#pragma unroll 1
            for (int it = 0; it < 128; it += 8) {
                if (it) __builtin_amdgcn_s_barrier();
                PEER_LDA(urB, it + 4);
                PEER_CMA(urA, it);
                if (it + 8 < 128) PEER_LDA(urA, it + 8);
                PEER_CMA(urB, it + 4);
            }
#undef PEER_LDA
#undef PEER_CMA
            __syncthreads();
        }
    }
#pragma unroll 1
    for (int hf = 0; hf < 2; ++hf) {
        typedef _Float16 h16x2v __attribute__((ext_vector_type(2)));
        typedef _Float16 h16x32v __attribute__((ext_vector_type(32)));
        h16x2v acc[32];
#pragma unroll
        for (int c = 0; c < 32; ++c) acc[c] = (h16x2v){(_Float16)0.f, (_Float16)0.f};
        for (int it = 0; it < 128; it += 4) {
            if ((it & 7) == 0 && it) __syncthreads();
            unsigned key[4]; u32x4 vr[4][3];
#pragma unroll
            for (int p = 0; p < 4; ++p) { key[p] = sortK[it + p];
#pragma unroll
                for (int j = 0; j < 3; ++j) vr[p][j] = *(const u32x4*)(V8 + (size_t)(key[p] >> 7) * att::ROW6 + hf * 768 + j * 256 + l16 * 16); }
#pragma unroll
            for (int p = 0; p < 4; ++p) { const _Float16 wh = (_Float16)wS[it + p]; const h16x2v w2 = (h16x2v){wh, wh};
                const h16x32v c0 = __builtin_amdgcn_cvt_scalef32_pk32_f16_fp6((att::u32x6v){vr[p][0][0], vr[p][0][1], vr[p][0][2], vr[p][0][3], vr[p][1][0], vr[p][1][1]}, 1.0f);
#pragma unroll
                for (int k = 0; k < 16; ++k) acc[k] = __builtin_elementwise_fma(w2, (h16x2v){c0[2 * k], c0[2 * k + 1]}, acc[k]);
                const h16x32v c1 = __builtin_amdgcn_cvt_scalef32_pk32_f16_fp6((att::u32x6v){vr[p][1][2], vr[p][1][3], vr[p][2][0], vr[p][2][1], vr[p][2][2], vr[p][2][3]}, 1.0f);
#pragma unroll
                for (int k = 0; k < 16; ++k) acc[16 + k] = __builtin_elementwise_fma(w2, (h16x2v){c1[2 * k], c1[2 * k + 1]}, acc[16 + k]); }
        }
#pragma unroll
        for (int j = 0; j < 4; ++j)
#pragma unroll
            for (int q = 0; q < 4; ++q) { const size_t o = tok * DM + hf * 1024 + j * 256 + l16 * 16 + q * 4;
                const f32x4 a = *(const f32x4*)(x1 + o);
                *(f32x4*)(out + o) = (f32x4){a[0] + (float)acc[j * 8 + 2 * q][0], a[1] + (float)acc[j * 8 + 2 * q][1], a[2] + (float)acc[j * 8 + 2 * q + 1][0], a[3] + (float)acc[j * 8 + 2 * q + 1][1]}; }
        __syncthreads();
    }
    __syncthreads();
}

#define XB_TMO      128
#define XB_XCNT(j)  (256  + 64 * (j))
#define XB_XSUB(j)  (1280 + 64 * (j))
#define XB_XGEN(j)  (2304 + 64 * (j))
#define XB_TOP      3328
#define XB_TOPGEN   3392
#define XCD_BAR_WORDS 3456
#define XB_SPIN_CAP (1u << 18)

__device__ __forceinline__ unsigned xb_ld(unsigned* p)              { return __hip_atomic_load(p, __ATOMIC_RELAXED, __HIP_MEMORY_SCOPE_AGENT); }
__device__ __forceinline__ unsigned xb_add(unsigned* p, unsigned v) { return __hip_atomic_fetch_add(p, v, __ATOMIC_RELAXED, __HIP_MEMORY_SCOPE_AGENT); }
__device__ __forceinline__ unsigned xb_xcc_id() { return (unsigned)__builtin_amdgcn_s_getreg((3 << 11) | 20) & 0xFu; }
#define XB_SPIN(cond, bar) do { unsigned _sp = 0; while (cond) { __builtin_amdgcn_s_sleep(1); \
    if ((++_sp & 255u) == 0u) { if (xb_ld(&(bar)[XB_TMO])) break; if (_sp > XB_SPIN_CAP) { atomicAdd(&(bar)[XB_TMO], 1u); break; } } } } while (0)

struct XcdBarrier {
    unsigned* bar; unsigned x;
    volatile LAS unsigned* st;
};

__device__ __forceinline__ XcdBarrier xcd_barrier_post(unsigned* bar, volatile LAS unsigned* st) {
    XcdBarrier b; b.bar = bar; b.x = xb_xcc_id(); b.st = st;
    if (threadIdx.x == 0) (void)xb_add(&bar[XB_XCNT(b.x)], 1u);
    return b;
}
__device__ __forceinline__ void xcd_barrier_complete(unsigned* bar, unsigned x, unsigned& nloc, unsigned& nx) {
    const unsigned G = gridDim.x * gridDim.y * gridDim.z;
    unsigned sum, cnt, mine, sp = 0u;
    for (;;) {
        sum = 0u; cnt = 0u; mine = 0u;
#pragma unroll
        for (unsigned j = 0; j < 16; ++j) { const unsigned c = xb_ld(&bar[XB_XCNT(j)]); sum += c; cnt += (c > 0u) ? 1u : 0u; mine = (j == x) ? c : mine; }
        if (sum == G) break;
        __builtin_amdgcn_s_sleep(1);
        if ((++sp & 255u) == 0u) { if (xb_ld(&bar[XB_TMO])) break; if (sp > XB_SPIN_CAP) { atomicAdd(&bar[XB_TMO], 1u); break; } }
    }
    nloc = mine > 0u ? mine : 1u; nx = cnt > 0u ? cnt : 1u;
}

__device__ __forceinline__ void xcd_barrier(const XcdBarrier& b) {
    asm volatile("s_waitcnt vmcnt(0)" ::: "memory");
    __syncthreads();
    if (threadIdx.x == 0) {
        unsigned* bar = b.bar;
        __builtin_amdgcn_s_waitcnt(0);
        unsigned nloc = b.st[0], nx = b.st[1];
        if (nloc == 0u) { xcd_barrier_complete(bar, b.x, nloc, nx); b.st[0] = nloc; b.st[1] = nx; }
        const unsigned old = xb_add(&bar[XB_XSUB(b.x)], 1u);
        const unsigned gen = old / nloc;
        if (old + 1u == (gen + 1u) * nloc) {
            __builtin_amdgcn_fence(__ATOMIC_RELEASE, "agent");
            asm volatile("s_waitcnt vmcnt(0)" ::: "memory");
            const unsigned og = xb_add(&bar[XB_TOP], 1u);
            const unsigned tg = og / nx;
            if (og + 1u == (tg + 1u) * nx) xb_add(&bar[XB_TOPGEN], 1u);
            else XB_SPIN(xb_ld(&bar[XB_TOPGEN]) == tg, bar);
            __builtin_amdgcn_fence(__ATOMIC_ACQUIRE, "agent");
            xb_add(&bar[XB_XGEN(b.x)], 1u);
            asm volatile("s_waitcnt vmcnt(0)" ::: "memory");
        } else {
            XB_SPIN(xb_ld(&bar[XB_XGEN(b.x)]) == gen, bar);
            __builtin_amdgcn_fence(__ATOMIC_ACQUIRE, "agent");
            asm volatile("s_waitcnt vmcnt(0)" ::: "memory");
        }
    }
    __syncthreads();
}

#define PROBE_DOUBLE 0
#define REP(k) for (int rep_ = 0; rep_ < ((PROBE_DOUBLE == (k)) ? 2 : 1); ++rep_)
constexpr int LDS_BYTES = 147456;
__global__ __launch_bounds__(512, 2) void mega(Params p) {
    extern __shared__ __attribute__((aligned(16))) unsigned char smem[];
    { volatile LAS unsigned* st0 = (volatile LAS unsigned*)((LAS unsigned char*)smem + 131072); if (threadIdx.x < 2) st0[threadIdx.x] = 0u; }
    __syncthreads();
    const XcdBarrier bar = xcd_barrier_post(p.ctl, (volatile LAS unsigned*)((LAS unsigned char*)smem + 131072));
    float* smf = (float*)smem;
    LAS unsigned char* lds = (LAS unsigned char*)smem;
    const int G = gridDim.x, b = blockIdx.x, NGW = G * 8;
#define PHASE_IDS() const int tid = opaque_tid(), lane = tid & 63, wave = __builtin_amdgcn_readfirstlane(tid >> 6), gw = b * 8 + wave; (void)lane; (void)gw

    REP(7) {
        PHASE_IDS();
        float* scr = smf + wave * 4096;
        constexpr int dummy_ = 0; (void)dummy_;
        constexpr int I_IN = 32 * 355, I_Q = 8 * 96, I_KV = 8 * 128, I_O = 64 * 64;
        for (int it = gw; it < I_IN + I_Q + I_KV + I_O; it += NGW) {
            int r = it;
            if (r < I_IN) { transpose_item(p.w_in, 2048, INW, p.WinT, DstWin(), scr, r, lane); continue; } r -= I_IN;
            if (r < I_Q) { transpose_item(p.w_q_up, 512, 3072, p.WqT, DstQ(), scr, r, lane, p.q_lat_g); continue; } r -= I_Q;
            if (r < I_KV) { transpose_item(p.w_kv_up, 512, 4096, p.WkvT, DstId(), scr, r, lane, p.kv_lat_g); continue; } r -= I_KV;
            transpose_item(p.w_out, 4096, 2048, p.WoT, DstId(), scr, r, lane);
        }
        for (int m = gw; m < S; m += NGW) rms_row2048(p.x + (size_t)m * DM, p.mix_g, p.h + (size_t)m * DM, lane);
        for (int idx = b * 512 + tid; idx < 16 * 64 * 64; idx += G * 512) { const int hh = idx >> 12, rr = (idx >> 6) & 63, c8 = idx & 63;
            *(u32x4*)(p.WqT + (size_t)(hh * 256 + 192 + rr) * 512 + c8 * 8) = (u32x4){0u, 0u, 0u, 0u}; }
        rope_table(p.pos, p.ropeT, b * 512 + tid, G * 512);
        __syncthreads();
        for (int it = b; it < 512; it += G) wfold_item(p.w_peer_q, p.sub_keys, p.WpT, smf, it);
    }
    xcd_barrier(bar);
    REP(1) {
        pg8::Gemm g{p.h, p.WinT, S, INWP, DM}; pg8::StaticOrder so; so.init(S, INWP, G, b);
        pg8::EpiInProj E{p.cq, p.ckv, p.fq, p.fk, p.fv, p.merged, p.kpe, p.lf, p.b_gate, p.b_forget, p.ssq, p.fox_qg, p.fox_kg, (LAS float*)(lds + 131072 + 64)};
        pg8::gemm_phase<pg8::EpiInProj, pg8::StaticOrder, true, true>(lds, g, so, E);
    }
    xcd_barrier(bar);
    for (int hh = b; hh < 16; hh += G) fox_cumsum((double*)smem, hh, p.lf, p.F);
    REP(2) {
        pg8::Gemm g{p.cq, p.WqT, S, 4096, 512}; pg8::StaticOrder so; so.init(S, 4096, G, b);
        pg8::EpiQ E{p.qa, p.ssq, p.mla_qg, p.ropeT, (LAS float*)(lds + 131072 + 64)};
        pg8::gemm_phase<pg8::EpiQ, pg8::StaticOrder, true, true>(lds, g, so, E);
    }
    {
        pg8::Gemm g{p.ckv, p.WkvT, S, 4096, 512}; pg8::StaticOrder so; so.init(S, 4096, G, b);
        pg8::EpiKV E{p.ka, p.va, p.kpe, p.ssq, p.mla_kg, p.ropeT, (LAS float*)(lds + 131072 + 64)};
        pg8::gemm_phase<pg8::EpiKV, pg8::StaticOrder, true, true>(lds, g, so, E);
    }
    xcd_barrier(bar);
    int side_next = 0;
    REP(3) for (int L = b; L < 1024; L += G) {
        const int i = L >> 8, vc = L & 255, vcx = (vc & 7) * 32 + (vc >> 3), hh = vcx >> 4, x = vcx & 15, qbk = (i & 1) ? x : 31 - x;
        if (i < 2) att::attn_block<192, false>(smem, p.qa + hh * 192, 3072, p.ka + hh * 192, 3072, p.va + hh * 128, 2048, nullptr, p.merged + hh * 128, p.attout + hh * 128, qbk, nullptr, nullptr, p.peer_u, p.peer_v, p.U8, p.V8, side_next);
        else att::attn_block<128, true>(smem, p.fq + hh * 128, 2048, p.fk + hh * 128, 2048, p.fv + hh * 128, 2048, p.F + (size_t)hh * S, p.merged + 2048 + hh * 128, p.attout + 2048 + hh * 128, qbk, p.fox_qg, p.fox_kg, p.peer_u, p.peer_v, p.U8, p.V8, side_next);
    }
    if (G == 256) { PHASE_IDS(); (void)wave;
        for (; side_next < 32; ++side_next) { const bool isv = side_next >= 16;
            fp6_cvt_rows(isv ? p.peer_v : p.peer_u, isv ? p.V8 : p.U8, b * 64 + (side_next & 15) * 4, 4, isv ? V_SCALE : U_SCALE, tid, 512); } }
    else { PHASE_IDS(); (void)wave; fp6_cvt_rows(p.peer_u, p.U8, 0, 16384, U_SCALE, b * 512 + tid, G * 512); fp6_cvt_rows(p.peer_v, p.V8, 0, 16384, V_SCALE, b * 512 + tid, G * 512); }
    xcd_barrier(bar);
    REP(4) {
        pg8::Gemm g{p.attout, p.WoT, S, 2048, 4096}; pg8::StaticOrder so; so.init(S, 2048, G, b);
        pg8::EpiX1 E{p.x1, p.x, p.xg, p.ffn_g, p.ssq2};
        pg8::gemm_phase<pg8::EpiX1, pg8::StaticOrder, true, true>(lds, g, so, E);
    }
    xcd_barrier(bar);
    REP(5) {
        pg8::Gemm g{p.xg, p.WpT, S, 2048, 2048}; pg8::StaticOrder so; so.init(S, 2048, G, b);
        pg8::EpiScores E{p.scores, p.ssq2};
        pg8::gemm_phase<pg8::EpiScores, pg8::StaticOrder, true, true>(lds, g, so, E);
    }
    xcd_barrier(bar);
    REP(6) for (int g = b; g < S / 32; g += G) peer_group(smem, g, p.scores, p.xg, p.ssq2, p.x1, p.U8, p.V8, p.out);
}

extern "C" void kernel_launch(void* const* d_in, const int* in_sizes, int n_in,
                              void* d_out, int out_size, void* d_ws, size_t ws_size,
                              hipStream_t stream) {
    if (ws_size < 512 * MiB) { fprintf(stderr, "kernel_launch: workspace too small (%zu)\n", ws_size); return; }
    Params p{};
    p.x = (const float*)d_in[0]; p.pos = (const int*)d_in[1]; p.mix_g = (const float*)d_in[2]; p.w_in = (const float*)d_in[3];
    p.b_forget = (const float*)d_in[4]; p.b_gate = (const float*)d_in[5]; p.q_lat_g = (const float*)d_in[6]; p.w_q_up = (const float*)d_in[7];
    p.kv_lat_g = (const float*)d_in[8]; p.w_kv_up = (const float*)d_in[9]; p.mla_qg = (const float*)d_in[10]; p.mla_kg = (const float*)d_in[11];
    p.fox_qg = (const float*)d_in[12]; p.fox_kg = (const float*)d_in[13]; p.w_out = (const float*)d_in[14]; p.ffn_g = (const float*)d_in[15];
    p.w_peer_q = (const float*)d_in[16]; p.sub_keys = (const float*)d_in[17]; p.peer_u = (const float*)d_in[18]; p.peer_v = (const float*)d_in[19];
    p.out = (float*)d_out;
    char* ws = (char*)d_ws;
    p.WqT = (bf16_t*)(ws + 1 * MiB); p.WkvT = (bf16_t*)(ws + 5 * MiB); p.WoT = (bf16_t*)(ws + 9 * MiB); p.WpT = (bf16_t*)(ws + 25 * MiB); p.WinT = (bf16_t*)(ws + 33 * MiB);
    p.h = (bf16_t*)(ws + 78 * MiB); p.cq = (bf16_t*)(ws + 110 * MiB); p.ckv = (bf16_t*)(ws + 118 * MiB);
    p.fq = (bf16_t*)(ws + 126 * MiB); p.fk = (bf16_t*)(ws + 158 * MiB); p.fv = (bf16_t*)(ws + 190 * MiB); p.merged = (bf16_t*)(ws + 222 * MiB);
    p.kpe = (bf16_t*)(ws + 286 * MiB); p.lf = (float*)(ws + 287 * MiB); p.F = (float*)(ws + 287 * MiB + 512 * 1024);
    p.qa = (bf16_t*)(ws + 288 * MiB); p.va = (bf16_t*)(ws + 336 * MiB); p.ka = (bf16_t*)(ws + 400 * MiB); p.x1 = (float*)(ws + 126 * MiB);
    p.scores = (float*)(ws + 222 * MiB);
    p.ctl = (unsigned*)ws;
    p.ropeT = (float2*)(ws + 448 * MiB);
    p.ssq = (float*)(ws + 64 * 1024);
    p.attout = (bf16_t*)(ws + 33 * MiB);
    p.U8 = (unsigned char*)(ws + 450 * MiB); p.V8 = (unsigned char*)(ws + 368 * MiB);
    p.xg = (bf16_t*)(ws + 190 * MiB);
    p.ssq2 = (float*)(ws + 482 * MiB);

    static int grid_blocks = 0;
    if (!grid_blocks) {
        if (hipFuncSetAttribute((const void*)mega, hipFuncAttributeMaxDynamicSharedMemorySize, LDS_BYTES) != hipSuccess) { fprintf(stderr, "hipFuncSetAttribute failed\n"); return; }
        int dev = 0, cus = 0, per_cu = 0;
        (void)hipGetDevice(&dev);
        (void)hipDeviceGetAttribute(&cus, hipDeviceAttributeMultiprocessorCount, dev);
        (void)hipOccupancyMaxActiveBlocksPerMultiprocessor(&per_cu, (const void*)mega, 512, LDS_BYTES);
        if (per_cu < 1 || cus < 1) { fprintf(stderr, "occupancy query says %d blocks/CU on %d CUs\n", per_cu, cus); return; }
        grid_blocks = cus;
    }
    if (hipMemsetAsync(d_ws, 0, 16384, stream) != hipSuccess) { fprintf(stderr, "memset of the barrier words failed\n"); return; }
    void* args[] = {&p};
    hipError_t e = hipLaunchCooperativeKernel((const void*)mega, dim3(grid_blocks), dim3(512), args, LDS_BYTES, stream);
    if (e != hipSuccess) fprintf(stderr, "cooperative launch failed: %s (grid %d)\n", hipGetErrorString(e), grid_blocks);
}
```

```cpp
#include <hip/hip_runtime.h>
#include <hip/hip_cooperative_groups.h>
#include <stdint.h>
#include <math.h>
#include <cstdio>
namespace cg = cooperative_groups;

namespace pg8 {
#define PG8_LAS __attribute__((address_space(3)))
typedef unsigned short bf16_t;
typedef short bf16x8 __attribute__((ext_vector_type(8)));
typedef float f32x4 __attribute__((ext_vector_type(4)));
typedef unsigned u32x4 __attribute__((ext_vector_type(4)));
constexpr int BM = 256, BK = 64, HALF = 128, HTB = HALF * BK * 2  , STAGE_BYTES = 8 * HTB, NXCD = 8, WGM = 8;

__host__ __device__ __forceinline__ int lds_byte(int r, int c) { const int st = (r >> 4) * 2 + (c >> 5), rr = r & 15, cc = c & 31, ob = rr * 64 + cc * 2; return st * 1024 + (ob ^ (((ob >> 9) & 1) << 5)); }
__host__ __device__ __forceinline__ void stage_rc(int b, int& R, int& C) { const int st = b / 1024, sb = b % 1024, swz = sb ^ (((sb >> 9) & 1) << 5); R = (st >> 1) * 16 + swz / 64; C = (st & 1) * 32 + (swz % 64) / 2; }
__host__ __device__ __forceinline__ int perm32(int rho) { const int n = rho >> 4, i = rho & 15; return 8 * (i >> 2) + 4 * n + (i & 3); }

struct Unit { int pm, pn; };
struct Gemm { const bf16_t* A; const bf16_t* Bt; int M, N, K; };

struct StaticOrder {
    int nM, nN, nwg, G, c;
    __host__ __device__ void init(int M, int N, int G_, int c_) { nM = M / BM; nN = N / BM; nwg = nM * nN; G = G_; c = c_; }
    __host__ __device__ bool next(int i, Unit& u) const {
        const long L = (long)i * G + c; if (L >= nwg) return false;
        int wgid = (int)L; { const int q = nwg / NXCD, r = nwg % NXCD, xcd = wgid % NXCD, off = wgid / NXCD; wgid = (xcd < r ? xcd * (q + 1) : r * (q + 1) + (xcd - r) * q) + off; }
        const int nig = WGM * nN, gid = wgid / nig, fm = gid * WGM, gsz = (nM - fm) < WGM ? (nM - fm) : WGM;
        u.pm = fm + ((wgid % nig) % gsz); u.pn = (wgid % nig) / gsz; return true;
    }
    __device__ __forceinline__ void a_ready(const Unit&) const {}
    __device__ __forceinline__ void done(const Unit&) const {}
};

typedef float cvt_pk_bf16_f32x2 __attribute__((ext_vector_type(2))); typedef __bf16 cvt_pk_bf16_bf16x2 __attribute__((ext_vector_type(2)));
__device__ __forceinline__ unsigned cvt_pk_bf16(float lo, float hi) { const cvt_pk_bf16_f32x2 v = {lo, hi}; const cvt_pk_bf16_bf16x2 b = __builtin_convertvector(v, cvt_pk_bf16_bf16x2); return __builtin_bit_cast(unsigned, b); }
__device__ __forceinline__ u32x4 pack8bf(const f32x4& v0, const f32x4& v1) { u32x4 w; w.x = cvt_pk_bf16(v0[0], v0[1]); w.y = cvt_pk_bf16(v0[2], v0[3]); w.z = cvt_pk_bf16(v1[0], v1[1]); w.w = cvt_pk_bf16(v1[2], v1[3]); return w; }

struct EpiStoreBf16 {
    static constexpr bool PERM = true, AFTER_DRAIN = false;
    bf16_t* O; int ldc;
    __device__ __forceinline__ void operator()(const f32x4 (&acc)[2][2][4][2], const Unit& u, int wr, int wc, int fr, int fq) const {
        const int row0 = u.pm * BM + wr * 64 + fr, col0 = u.pn * BM + wc * 32 + 8 * fq;
#pragma unroll
        for (int ai = 0; ai < 2; ++ai)
#pragma unroll
            for (int m = 0; m < 4; ++m) { bf16_t* rowp = O + (size_t)(row0 + ai * HALF + m * 16) * ldc + col0;
#pragma unroll
                for (int bj = 0; bj < 2; ++bj) *(u32x4*)(rowp + bj * HALF) = pack8bf(acc[ai][bj][m][0], acc[ai][bj][m][1]); }
    }
};
template <bool RES> struct EpiStoreF32 {
    static constexpr bool PERM = true, AFTER_DRAIN = false;
    float* O; const float* res; int ldc;
    __device__ __forceinline__ void operator()(const f32x4 (&acc)[2][2][4][2], const Unit& u, int wr, int wc, int fr, int fq) const {
        const int row0 = u.pm * BM + wr * 64 + fr, col0 = u.pn * BM + wc * 32 + 8 * fq;
#pragma unroll
        for (int ai = 0; ai < 2; ++ai)
#pragma unroll
            for (int m = 0; m < 4; ++m) { const size_t off = (size_t)(row0 + ai * HALF + m * 16) * ldc + col0;
#pragma unroll
                for (int bj = 0; bj < 2; ++bj) { f32x4 v0 = acc[ai][bj][m][0], v1 = acc[ai][bj][m][1];
                    if (RES) { v0 += *(const f32x4*)(res + off + bj * HALF); v1 += *(const f32x4*)(res + off + bj * HALF + 4); }
                    *(f32x4*)(O + off + bj * HALF) = v0; *(f32x4*)(O + off + bj * HALF + 4) = v1; } }
    }
};
#define EPI_LDSBAR() do { asm volatile("s_waitcnt lgkmcnt(0)" ::: "memory"); __builtin_amdgcn_s_barrier(); asm volatile("" ::: "memory"); } while (0)
struct EpiInProj {
    static constexpr bool PERM = true, AFTER_DRAIN = false;
    bf16_t *cq, *ckv, *fq, *fk, *fv, *gates, *kpe; float* lf; const float *b_gate, *b_forget; float* ssq; const float *gfq, *gfk; PG8_LAS float* xs;
    __device__ __forceinline__ void operator()(const f32x4 (&acc)[2][2][4][2], const Unit& u, int wr, int wc, int fr, int fq_) const {
        const int pn = u.pn, row0 = u.pm * BM + wr * 64 + fr, cw = wc * 32 + 8 * fq_;
        if (pn < 4) {
            bf16_t* base = pn < 2 ? cq : ckv; const int colt = (pn & 1) * 256;
#pragma unroll
            for (int ai = 0; ai < 2; ++ai)
#pragma unroll
                for (int m = 0; m < 4; ++m) { const int row = row0 + ai * HALF + m * 16; bf16_t* rowp = base + (size_t)row * 512 + colt + cw; float s = 0.f;
#pragma unroll
                    for (int bj = 0; bj < 2; ++bj) { const f32x4 v0 = acc[ai][bj][m][0], v1 = acc[ai][bj][m][1];
                        s += (v0[0] * v0[0] + v0[1] * v0[1]) + (v0[2] * v0[2] + v0[3] * v0[3]) + (v1[0] * v1[0] + v1[1] * v1[1]) + (v1[2] * v1[2] + v1[3] * v1[3]);
                        *(u32x4*)(rowp + bj * HALF) = pack8bf(v0, v1); }
                    s += __shfl_xor(s, 16); s += __shfl_xor(s, 32);
                    if (fq_ == 0) ssq[((size_t)pn * 8192 + row) * 4 + wc] = s; }
        } else if (pn < 20) {
            const bool isq = pn < 12; bf16_t* base = isq ? fq : fk; const int colt = (pn - (isq ? 4 : 12)) * 256; const float* g = isq ? gfq : gfk;
            const float qs = isq ? 0.12751743f : 1.f;
#pragma unroll
            for (int ai = 0; ai < 2; ++ai)
#pragma unroll
                for (int m = 0; m < 4; ++m)
#pragma unroll
                    for (int bj = 0; bj < 2; ++bj) { const f32x4 v0 = acc[ai][bj][m][0], v1 = acc[ai][bj][m][1];
                        float s = (v0[0] * v0[0] + v0[1] * v0[1]) + (v0[2] * v0[2] + v0[3] * v0[3]) + (v1[0] * v1[0] + v1[1] * v1[1]) + (v1[2] * v1[2] + v1[3] * v1[3]);
                        s += __shfl_xor(s, 16); s += __shfl_xor(s, 32);
                        if (fq_ == 0) xs[((ai * HALF + wr * 64 + m * 16 + fr) * 2 + bj) * 4 + wc] = s; }
            EPI_LDSBAR();
            const f32x4 g0 = *(const f32x4*)(g + cw) * qs, g1 = *(const f32x4*)(g + cw + 4) * qs;
#pragma unroll
            for (int ai = 0; ai < 2; ++ai)
#pragma unroll
                for (int m = 0; m < 4; ++m) { bf16_t* rowp = base + (size_t)(row0 + ai * HALF + m * 16) * 2048 + colt + cw;
#pragma unroll
                    for (int bj = 0; bj < 2; ++bj) { const f32x4 t4 = *(const PG8_LAS f32x4*)(xs + ((ai * HALF + wr * 64 + m * 16 + fr) * 2 + bj) * 4);
                        const float r = rsqrtf(((t4[0] + t4[1]) + (t4[2] + t4[3])) * (1.f / 128.f) + 1e-6f);
                        *(u32x4*)(rowp + bj * HALF) = pack8bf(acc[ai][bj][m][0] * g0 * r, acc[ai][bj][m][1] * g1 * r); } }
        } else if (pn < 28) {
            const int colt = (pn - 20) * 256;
#pragma unroll
            for (int ai = 0; ai < 2; ++ai)
#pragma unroll
                for (int m = 0; m < 4; ++m) { bf16_t* rowp = fv + (size_t)(row0 + ai * HALF + m * 16) * 2048 + colt + cw;
#pragma unroll
                    for (int bj = 0; bj < 2; ++bj) *(u32x4*)(rowp + bj * HALF) = pack8bf(acc[ai][bj][m][0], acc[ai][bj][m][1]); }
        } else if (pn < 44) {
            const int colt = (pn - 28) * 256 + cw;
#pragma unroll
            for (int bj = 0; bj < 2; ++bj) {
                const f32x4 b0 = *(const f32x4*)(b_gate + colt + bj * HALF), b1 = *(const f32x4*)(b_gate + colt + bj * HALF + 4);
#pragma unroll
                for (int ai = 0; ai < 2; ++ai)
#pragma unroll
                    for (int m = 0; m < 4; ++m) {
                        f32x4 v0 = acc[ai][bj][m][0] + b0, v1 = acc[ai][bj][m][1] + b1;
#pragma unroll
                        for (int e = 0; e < 4; ++e) { v0[e] = __builtin_amdgcn_rcpf(1.f + __expf(-v0[e])); v1[e] = __builtin_amdgcn_rcpf(1.f + __expf(-v1[e])); }
                        *(u32x4*)(gates + (size_t)(row0 + ai * HALF + m * 16) * 4096 + colt + bj * HALF) = pack8bf(v0, v1); }
            }
        } else {
            if (cw < 64) {
#pragma unroll
                for (int ai = 0; ai < 2; ++ai)
#pragma unroll
                    for (int m = 0; m < 4; ++m) *(u32x4*)(kpe + (size_t)(row0 + ai * HALF + m * 16) * 64 + cw) = pack8bf(acc[ai][0][m][0], acc[ai][0][m][1]);
            } else if (cw < 80) {
                const int h0 = cw - 64;
                const f32x4 b0 = *(const f32x4*)(b_forget + h0), b1 = *(const f32x4*)(b_forget + h0 + 4);
#pragma unroll
                for (int ai = 0; ai < 2; ++ai)
#pragma unroll
                    for (int m = 0; m < 4; ++m) { const int row = row0 + ai * HALF + m * 16;
                        f32x4 z0 = acc[ai][0][m][0] + b0, z1 = acc[ai][0][m][1] + b1;
#pragma unroll
                        for (int e = 0; e < 4; ++e) { z0[e] = fminf(z0[e], 0.f) - __logf(1.f + __expf(-fabsf(z0[e]))); z1[e] = fminf(z1[e], 0.f) - __logf(1.f + __expf(-fabsf(z1[e]))); }
                        *(f32x4*)(lf + (size_t)row * 16 + h0) = z0; *(f32x4*)(lf + (size_t)row * 16 + h0 + 4) = z1; }
            }
        }
    }
};
__device__ __forceinline__ float lat_rinv(const float* ssq, int part0, int row) {
    const f32x4 a = *(const f32x4*)(ssq + ((size_t)part0 * 8192 + row) * 4), b = *(const f32x4*)(ssq + ((size_t)(part0 + 1) * 8192 + row) * 4);
    return rsqrtf((((a[0] + a[1]) + (a[2] + a[3])) + ((b[0] + b[1]) + (b[2] + b[3]))) * (1.f / 512.f) + 1e-6f);
}
struct EpiQ {
    static constexpr bool PERM = true, AFTER_DRAIN = false;
    bf16_t* qa; const float* ssq; const float* gq; const float2* ropeT; PG8_LAS float* xs;
    __device__ __forceinline__ void operator()(const f32x4 (&acc)[2][2][4][2], const Unit& u, int wr, int wc, int fr, int fq_) const {
        const int h = u.pn, row0 = u.pm * BM + wr * 64 + fr, cw = wc * 32 + 8 * fq_;
        float rl[2][4];
#pragma unroll
        for (int ai = 0; ai < 2; ++ai)
#pragma unroll
            for (int m = 0; m < 4; ++m) { rl[ai][m] = lat_rinv(ssq, 0, row0 + ai * HALF + m * 16); float s = 0.f;
#pragma unroll
                for (int bj = 0; bj < 2; ++bj) { const f32x4 v0 = acc[ai][bj][m][0], v1 = acc[ai][bj][m][1];
                    s += (v0[0] * v0[0] + v0[1] * v0[1]) + (v0[2] * v0[2] + v0[3] * v0[3]) + (v1[0] * v1[0] + v1[1] * v1[1]) + (v1[2] * v1[2] + v1[3] * v1[3]); }
                s *= rl[ai][m] * rl[ai][m];
                s += __shfl_xor(s, 16); s += __shfl_xor(s, 32);
                if (fq_ == 0) xs[(ai * HALF + wr * 64 + m * 16 + fr) * 4 + wc] = s; }
        EPI_LDSBAR();
        const float qs = 0.10411754f;
        const f32x4 g0 = *(const f32x4*)(gq + cw) * qs, g1 = *(const f32x4*)(gq + cw + 4) * qs;
        const int pp = 16 * (wc & 1) + 4 * fq_;
        const f32x4 ga = *(const f32x4*)(gq + 128 + pp) * qs, gb = *(const f32x4*)(gq + 160 + pp) * qs;
#pragma unroll
        for (int ai = 0; ai < 2; ++ai)
#pragma unroll
            for (int m = 0; m < 4; ++m) { const int row = row0 + ai * HALF + m * 16;
                const f32x4 t4 = *(const PG8_LAS f32x4*)(xs + (ai * HALF + wr * 64 + m * 16 + fr) * 4);
                const float r = rsqrtf(((t4[0] + t4[1]) + (t4[2] + t4[3])) * (1.f / 192.f) + 1e-6f) * rl[ai][m];
                bf16_t* rowp = qa + (size_t)row * 3072 + h * 192;
                *(u32x4*)(rowp + cw) = pack8bf(acc[ai][0][m][0] * g0 * r, acc[ai][0][m][1] * g1 * r);
                if (wc < 2) { const f32x4 c01 = *(const f32x4*)(ropeT + (size_t)row * 32 + pp), c23 = *(const f32x4*)(ropeT + (size_t)row * 32 + pp + 2);
                    const f32x4 z0 = acc[ai][1][m][0] * r, z1 = acc[ai][1][m][1] * r;
                    const float a0 = z0[0] * ga[0], b0 = z0[1] * gb[0], a1 = z0[2] * ga[1], b1 = z0[3] * gb[1], a2 = z1[0] * ga[2], b2 = z1[1] * gb[2], a3 = z1[2] * ga[3], b3 = z1[3] * gb[3];
                    const f32x4 o0 = {a0 * c01[0] - b0 * c01[1], a0 * c01[1] + b0 * c01[0], a1 * c01[2] - b1 * c01[3], a1 * c01[3] + b1 * c01[2]};
                    const f32x4 o1 = {a2 * c23[0] - b2 * c23[1], a2 * c23[1] + b2 * c23[0], a3 * c23[2] - b3 * c23[3], a3 * c23[3] + b3 * c23[2]};
                    *(u32x4*)(rowp + 128 + cw) = pack8bf(o0, o1); } }
    }
};
struct EpiKV {
    static constexpr bool PERM = true, AFTER_DRAIN = false;
    bf16_t *ka, *va; const bf16_t* kpe; const float* ssq; const float* gk; const float2* ropeT; PG8_LAS float* xs;
    __device__ __forceinline__ void operator()(const f32x4 (&acc)[2][2][4][2], const Unit& u, int wr, int wc, int fr, int fq_) const {
        const int h = u.pn, row0 = u.pm * BM + wr * 64 + fr, cw = wc * 32 + 8 * fq_;
        float rl[2][4]; f32x4 kp[2][4];
#pragma unroll
        for (int ai = 0; ai < 2; ++ai)
#pragma unroll
            for (int m = 0; m < 4; ++m) { const int row = row0 + ai * HALF + m * 16; rl[ai][m] = lat_rinv(ssq, 2, row);
                const uint2 w = *(const uint2*)(kpe + (size_t)row * 64 + 16 * wc + 4 * fq_);
                kp[ai][m] = (f32x4){__uint_as_float(w.x << 16), __uint_as_float(w.x & 0xffff0000u), __uint_as_float(w.y << 16), __uint_as_float(w.y & 0xffff0000u)};
                const f32x4 v0 = acc[ai][0][m][0], v1 = acc[ai][0][m][1];
                float s = ((v0[0] * v0[0] + v0[1] * v0[1]) + (v0[2] * v0[2] + v0[3] * v0[3]) + (v1[0] * v1[0] + v1[1] * v1[1]) + (v1[2] * v1[2] + v1[3] * v1[3])) * (rl[ai][m] * rl[ai][m]);
                s += (kp[ai][m][0] * kp[ai][m][0] + kp[ai][m][1] * kp[ai][m][1]) + (kp[ai][m][2] * kp[ai][m][2] + kp[ai][m][3] * kp[ai][m][3]);
                s += __shfl_xor(s, 16); s += __shfl_xor(s, 32);
                if (fq_ == 0) xs[(ai * HALF + wr * 64 + m * 16 + fr) * 4 + wc] = s;
                *(u32x4*)(va + (size_t)row * 2048 + h * 128 + cw) = pack8bf(acc[ai][1][m][0] * rl[ai][m], acc[ai][1][m][1] * rl[ai][m]); }
        EPI_LDSBAR();
        const f32x4 g0 = *(const f32x4*)(gk + cw), g1 = *(const f32x4*)(gk + cw + 4);
        const int pp = 8 * wc + 2 * fq_;
        const float ga0 = gk[128 + pp], ga1 = gk[128 + pp + 1], gb0 = gk[160 + pp], gb1 = gk[160 + pp + 1];
#pragma unroll
        for (int ai = 0; ai < 2; ++ai)
#pragma unroll
            for (int m = 0; m < 4; ++m) { const int row = row0 + ai * HALF + m * 16;
                const f32x4 t4 = *(const PG8_LAS f32x4*)(xs + (ai * HALF + wr * 64 + m * 16 + fr) * 4);
                const float r = rsqrtf(((t4[0] + t4[1]) + (t4[2] + t4[3])) * (1.f / 192.f) + 1e-6f), rn = r * rl[ai][m];
                bf16_t* rowp = ka + (size_t)row * 3072 + h * 192;
                *(u32x4*)(rowp + cw) = pack8bf(acc[ai][0][m][0] * g0 * rn, acc[ai][0][m][1] * g1 * rn);
                const f32x4 cs = *(const f32x4*)(ropeT + (size_t)row * 32 + pp);
                const float a0 = kp[ai][m][0] * r * ga0, b0 = kp[ai][m][1] * r * gb0, a1 = kp[ai][m][2] * r * ga1, b1 = kp[ai][m][3] * r * gb1;
                uint2 o; o.x = cvt_pk_bf16(a0 * cs[0] - b0 * cs[1], a0 * cs[1] + b0 * cs[0]); o.y = cvt_pk_bf16(a1 * cs[2] - b1 * cs[3], a1 * cs[3] + b1 * cs[2]);
                *(uint2*)(rowp + 128 + 16 * wc + 4 * fq_) = o; }
    }
};

struct EpiX1 {
    static constexpr bool PERM = true, AFTER_DRAIN = false;
    float* x1; const float* x; bf16_t* xg; const float* g; float* ssq2;
    __device__ __forceinline__ void operator()(const f32x4 (&acc)[2][2][4][2], const Unit& u, int wr, int wc, int fr, int fq_) const {
        const int row0 = u.pm * BM + wr * 64 + fr, col0 = u.pn * BM + wc * 32 + 8 * fq_;
        f32x4 gg[2][2];
#pragma unroll
        for (int bj = 0; bj < 2; ++bj) { gg[bj][0] = *(const f32x4*)(g + col0 + bj * HALF); gg[bj][1] = *(const f32x4*)(g + col0 + bj * HALF + 4); }
#pragma unroll
        for (int ai = 0; ai < 2; ++ai)
#pragma unroll
            for (int m = 0; m < 4; ++m) { const int row = row0 + ai * HALF + m * 16; const size_t off = (size_t)row * 2048 + col0; float s = 0.f;
#pragma unroll
                for (int bj = 0; bj < 2; ++bj) { const f32x4 v0 = acc[ai][bj][m][0] + *(const f32x4*)(x + off + bj * HALF), v1 = acc[ai][bj][m][1] + *(const f32x4*)(x + off + bj * HALF + 4);
                    *(f32x4*)(x1 + off + bj * HALF) = v0; *(f32x4*)(x1 + off + bj * HALF + 4) = v1;
                    s += (v0[0] * v0[0] + v0[1] * v0[1]) + (v0[2] * v0[2] + v0[3] * v0[3]) + (v1[0] * v1[0] + v1[1] * v1[1]) + (v1[2] * v1[2] + v1[3] * v1[3]);
                    *(u32x4*)(xg + off + bj * HALF) = pack8bf(v0 * gg[bj][0], v1 * gg[bj][1]); }
                s += __shfl_xor(s, 16); s += __shfl_xor(s, 32);
                if (fq_ == 0) ssq2[((size_t)u.pn * 8192 + row) * 4 + wc] = s; }
    }
};
__device__ __forceinline__ float ffn_rinv(const float* ssq2, int row) {
    float t = 0.f;
#pragma unroll
    for (int pn = 0; pn < 8; ++pn) { const f32x4 a = *(const f32x4*)(ssq2 + ((size_t)pn * 8192 + row) * 4); t += (a[0] + a[1]) + (a[2] + a[3]); }
    return rsqrtf(t * (1.f / 2048.f) + 1e-6f);
}
struct EpiScores {
    static constexpr bool PERM = true, AFTER_DRAIN = false;
    float* O; const float* ssq2;
    __device__ __forceinline__ void operator()(const f32x4 (&acc)[2][2][4][2], const Unit& u, int wr, int wc, int fr, int fq_) const {
        const int row0 = u.pm * BM + wr * 64 + fr, col0 = u.pn * BM + wc * 32 + 8 * fq_;
#pragma unroll
        for (int ai = 0; ai < 2; ++ai)
#pragma unroll
            for (int m = 0; m < 4; ++m) { const int row = row0 + ai * HALF + m * 16; const float r = ffn_rinv(ssq2, row); const size_t off = (size_t)row * 2048 + col0;
#pragma unroll
                for (int bj = 0; bj < 2; ++bj) { *(f32x4*)(O + off + bj * HALF) = acc[ai][bj][m][0] * r; *(f32x4*)(O + off + bj * HALF + 4) = acc[ai][bj][m][1] * r; } }
    }
};
template <class Epi, class Sched, bool ALIGN_EPI = false, bool SP2 = false>
__device__ __forceinline__ void gemm_phase(PG8_LAS unsigned char* lds, const Gemm g, const Sched& S, const Epi& E) {
    int tid = threadIdx.x; asm volatile("" : "+v"(tid));
    const int wid = __builtin_amdgcn_readfirstlane(tid >> 6), lane = tid & 63, wr = wid >> 2, wc = wid & 3, fr = lane & 15, fq = lane >> 4;
    const int K = g.K, nt = K / BK;
    unsigned voffA[2], voffB[2];
#pragma unroll
    for (int i = 0; i < 2; ++i) { int R, C; stage_rc(tid * 16 + i * 8192, R, C); const int Rb = Epi::PERM ? ((R & ~31) + perm32(R & 31)) : R;
        voffA[i] = (unsigned)(R * K + C) * 2u; voffB[i] = (unsigned)(Rb * K + C) * 2u; }
    const size_t kstep = (size_t)(BK * 2);
    const size_t hstep = (size_t)HALF * K * 2;
    const size_t tstep = 2 * hstep;
    const unsigned ldsw = (unsigned)wid * 1024u;
    const int aoff = lds_byte(wr * 64 + fr, fq * 8), boff = lds_byte(wc * 32 + fr, fq * 8);
#define PG8_SA(b, h) (((b) * 2 + (h)) * HTB)
#define PG8_SB(b, h) ((4 + (b) * 2 + (h)) * HTB)
#define PG8_STAGE(bufoff, gbase, voff) do { _Pragma("unroll") for (int _i = 0; _i < 2; ++_i) \
        __builtin_amdgcn_global_load_lds((const unsigned*)((const char*)(gbase) + (voff)[_i]), (PG8_LAS unsigned*)(lds + (bufoff) + ldsw + _i * 8192), 16, 0, 0); } while (0)
#define PG8_LDA(dst, b, h) do { _Pragma("unroll") for (int m = 0; m < 4; ++m) _Pragma("unroll") for (int k = 0; k < 2; ++k) dst[m][k] = *(const PG8_LAS bf16x8*)(lds + PG8_SA(b, h) + aoff + m * 2048 + k * 1024); } while (0)
#define PG8_LDB(dst, b, h) do { _Pragma("unroll") for (int n = 0; n < 2; ++n) _Pragma("unroll") for (int k = 0; k < 2; ++k) dst[n][k] = *(const PG8_LAS bf16x8*)(lds + PG8_SB(b, h) + boff + n * 2048 + k * 1024); } while (0)
#define PG8_MMA(ai, bj, At, Bt) do { __builtin_amdgcn_s_setprio(1); _Pragma("unroll") for (int m = 0; m < 4; ++m) _Pragma("unroll") for (int n = 0; n < 2; ++n) _Pragma("unroll") for (int k = 0; k < 2; ++k) \
        acc[ai][bj][m][n] = __builtin_amdgcn_mfma_f32_16x16x32_bf16(Bt[n][k], At[m][k], acc[ai][bj][m][n], 0, 0, 0); __builtin_amdgcn_s_setprio(0); } while (0)
#define PG8_WAIT_V(n) asm volatile("s_waitcnt vmcnt(" #n ")" ::: "memory")
#define PG8_WAIT_L(n) asm volatile("s_waitcnt lgkmcnt(" #n ")" ::: "memory")
#define PG8_BAR __builtin_amdgcn_s_barrier()
#define PG8_SCHED __builtin_amdgcn_sched_barrier(0)
    Unit cur, nxt; int ui = 0;
    if (!S.next(0, cur)) return;
    f32x4 acc[2][2][4][2];
#pragma unroll
    for (int a = 0; a < 2; ++a)
#pragma unroll
        for (int b = 0; b < 2; ++b)
#pragma unroll
            for (int m = 0; m < 4; ++m)
#pragma unroll
                for (int n = 0; n < 2; ++n) acc[a][b][m][n] = (f32x4){0.f, 0.f, 0.f, 0.f};
    bf16x8 At[4][2], B0[2][2], B1[2][2];
    const char* cA = (const char*)g.A + (size_t)cur.pm * tstep; const char* cB = (const char*)g.Bt + (size_t)cur.pn * tstep;
    S.a_ready(cur);
    if constexpr (SP2) {
        PG8_STAGE(PG8_SB(0, 0), cB, voffB); PG8_STAGE(PG8_SB(0, 1), cB + hstep, voffB); PG8_STAGE(PG8_SA(0, 0), cA, voffA); PG8_STAGE(PG8_SA(0, 1), cA + hstep, voffA);
        if (wr == 1) PG8_BAR;
        PG8_WAIT_V(2); PG8_BAR;
        PG8_STAGE(PG8_SB(1, 0), cB + kstep, voffB); PG8_STAGE(PG8_SA(1, 0), cA + kstep, voffA); PG8_STAGE(PG8_SB(1, 1), cB + hstep + kstep, voffB);
        PG8_WAIT_V(6); PG8_BAR;
    } else {
        PG8_STAGE(PG8_SB(0, 0), cB, voffB); PG8_STAGE(PG8_SA(0, 0), cA, voffA); PG8_STAGE(PG8_SB(0, 1), cB + hstep, voffB); PG8_STAGE(PG8_SA(0, 1), cA + hstep, voffA);
        if (wr == 1) PG8_BAR;
        PG8_WAIT_V(4); PG8_BAR;
        PG8_STAGE(PG8_SB(1, 0), cB + kstep, voffB); PG8_STAGE(PG8_SA(1, 0), cA + kstep, voffA); PG8_STAGE(PG8_SB(1, 1), cB + hstep + kstep, voffB);
        PG8_WAIT_V(6); PG8_BAR;
    }
    for (;;) {
        const bool has_next = S.next(ui + 1, nxt);
        const char* nA = has_next ? (const char*)g.A + (size_t)nxt.pm * tstep : cA; const char* nB = has_next ? (const char*)g.Bt + (size_t)nxt.pn * tstep : cB;
        for (int t = 0; t < nt; t += 2) {
            const bool last = (t == nt - 2);
            const char* a1 = cA + (size_t)(t + 1) * kstep;
            const char* a2 = last ? nA : cA + (size_t)(t + 2) * kstep; const char* b2 = last ? nB : cB + (size_t)(t + 2) * kstep;
            const char* a3 = a2 + kstep; const char* b3 = b2 + kstep;
            if (last && has_next) S.a_ready(nxt);
            if constexpr (SP2) {
            PG8_LDB(B0, 0, 0); PG8_LDB(B1, 0, 1); PG8_SCHED; PG8_LDA(At, 0, 0); PG8_STAGE(PG8_SA(1, 1), a1 + hstep, voffA);
            PG8_WAIT_V(8); PG8_WAIT_L(0); PG8_BAR; PG8_MMA(0, 0, At, B0); PG8_MMA(0, 1, At, B1); PG8_BAR; PG8_SCHED;
            PG8_LDA(At, 0, 1); PG8_STAGE(PG8_SB(0, 0), b2, voffB); PG8_STAGE(PG8_SB(0, 1), b2 + hstep, voffB); PG8_STAGE(PG8_SA(0, 0), a2, voffA);
            PG8_WAIT_V(8); PG8_WAIT_L(0); PG8_BAR; PG8_MMA(1, 0, At, B0); PG8_MMA(1, 1, At, B1); PG8_BAR; PG8_SCHED;
            PG8_LDB(B0, 1, 0); PG8_LDB(B1, 1, 1); PG8_SCHED; PG8_LDA(At, 1, 0); PG8_STAGE(PG8_SA(0, 1), a2 + hstep, voffA);
            PG8_WAIT_V(8); PG8_WAIT_L(0); PG8_BAR; PG8_MMA(0, 0, At, B0); PG8_MMA(0, 1, At, B1); PG8_BAR; PG8_SCHED;
            PG8_LDA(At, 1, 1); PG8_STAGE(PG8_SB(1, 0), b3, voffB); PG8_STAGE(PG8_SB(1, 1), b3 + hstep, voffB); PG8_STAGE(PG8_SA(1, 0), a3, voffA);
            PG8_WAIT_V(8); PG8_WAIT_L(0); PG8_BAR; PG8_MMA(1, 0, At, B0); PG8_MMA(1, 1, At, B1); PG8_BAR; PG8_SCHED;
            } else {
            PG8_LDB(B0, 0, 0); PG8_SCHED; PG8_LDA(At, 0, 0); PG8_STAGE(PG8_SA(1, 1), a1 + hstep, voffA);
            PG8_WAIT_L(8); PG8_BAR; PG8_WAIT_L(0); PG8_MMA(0, 0, At, B0); PG8_BAR; PG8_SCHED;
            PG8_LDB(B1, 0, 1); PG8_STAGE(PG8_SB(0, 0), b2, voffB);
            PG8_BAR; PG8_WAIT_L(0); PG8_MMA(0, 1, At, B1); PG8_BAR;
            PG8_LDA(At, 0, 1); PG8_STAGE(PG8_SA(0, 0), a2, voffA);
            PG8_BAR; PG8_WAIT_L(0); PG8_MMA(1, 0, At, B0); PG8_BAR; PG8_SCHED;
            PG8_STAGE(PG8_SB(0, 1), b2 + hstep, voffB);
            PG8_WAIT_V(6); PG8_BAR; PG8_MMA(1, 1, At, B1); PG8_BAR;
            PG8_LDB(B0, 1, 0); PG8_SCHED; PG8_LDA(At, 1, 0); PG8_STAGE(PG8_SA(0, 1), a2 + hstep, voffA);
            PG8_WAIT_L(8); PG8_BAR; PG8_WAIT_L(0); PG8_MMA(0, 0, At, B0); PG8_BAR; PG8_SCHED;
            PG8_LDB(B1, 1, 1); PG8_STAGE(PG8_SB(1, 0), b3, voffB);
            PG8_BAR; PG8_WAIT_L(0); PG8_MMA(0, 1, At, B1); PG8_BAR;
            PG8_LDA(At, 1, 1); PG8_STAGE(PG8_SA(1, 0), a3, voffA);
            PG8_BAR; PG8_WAIT_L(0); PG8_MMA(1, 0, At, B0); PG8_BAR; PG8_SCHED;
            PG8_STAGE(PG8_SB(1, 1), b3 + hstep, voffB);
            PG8_WAIT_V(6); PG8_BAR; PG8_MMA(1, 1, At, B1); PG8_BAR;
            }
        }
        if constexpr (ALIGN_EPI) { if (wr == 0) PG8_BAR; }
        if constexpr (!Epi::AFTER_DRAIN) { E(acc, cur, wr, wc, fr, fq); S.done(cur); }
        if (!has_next) break;
#pragma unroll
        for (int a = 0; a < 2; ++a)
#pragma unroll
            for (int b = 0; b < 2; ++b)
#pragma unroll
                for (int m = 0; m < 4; ++m)
#pragma unroll
                    for (int n = 0; n < 2; ++n) acc[a][b][m][n] = (f32x4){0.f, 0.f, 0.f, 0.f};
        cur = nxt; cA = nA; cB = nB; ++ui;
        if constexpr (ALIGN_EPI) { if (wr == 1) PG8_BAR; }
    }
    PG8_WAIT_V(0);
    if constexpr (!ALIGN_EPI) { if (wr == 0) PG8_BAR; }
    PG8_BAR;
    if constexpr (Epi::AFTER_DRAIN) { E.fused(acc, cur, wr, wc, fr, fq, lds, wid, lane); S.done(cur); }
#undef PG8_SA
#undef PG8_SB
#undef PG8_STAGE
#undef PG8_LDA
#undef PG8_LDB
#undef PG8_MMA
#undef PG8_WAIT_V
#undef PG8_WAIT_L
#undef PG8_BAR
#undef PG8_SCHED
}
}
namespace att {
typedef unsigned short bf16_t;
typedef short bf16x8 __attribute__((ext_vector_type(8)));
typedef short s16x4 __attribute__((ext_vector_type(4)));
typedef float f32x16 __attribute__((ext_vector_type(16)));
typedef float f32x4 __attribute__((ext_vector_type(4)));
typedef unsigned u32x4 __attribute__((ext_vector_type(4)));
#define ALAS __attribute__((address_space(3)))
#define ASBAR() __builtin_amdgcn_sched_barrier(0)
constexpr int SHM_V = 16384;
template <int DK> struct Lay { static constexpr int ROWB = DK * 2, SHM_K = 64 * ROWB, OFF_K = 2 * SHM_V, OFF_F = OFF_K + 2 * SHM_K, OFF_WS = OFF_F + 512, TOTAL = OFF_WS + 8 * 256; };

__device__ __forceinline__ int v_st(int k, int c) { const int kk = (k & ~0xC) | ((k & 4) << 1) | ((k & 8) >> 1); return ((kk >> 3) * 4 + (c >> 5)) * 512 + ((kk & 7) * 32 + (c & 31)) * 2; }
__device__ __forceinline__ int v_rd_base(int lane) { return ((lane & 3) << 3) | (((lane >> 2) & 3) << 6) | (((lane >> 4) & 1) << 5) | (((lane >> 5) & 1) << 8); }
__device__ __forceinline__ int crow(int r, int hi) { return (r & 3) + 8 * (r >> 2) + 4 * hi; }
typedef float cvtpk_f32x2 __attribute__((ext_vector_type(2))); typedef __bf16 cvtpk_bf16x2 __attribute__((ext_vector_type(2)));
__device__ __forceinline__ unsigned cvtpk(float lo, float hi) { const cvtpk_f32x2 v = {lo, hi}; const cvtpk_bf16x2 b = __builtin_convertvector(v, cvtpk_bf16x2); return __builtin_bit_cast(unsigned, b); }

__device__ __forceinline__ float wave_max_f(float v) {
#pragma unroll
    for (int o = 32; o >= 1; o >>= 1) v = fmaxf(v, __shfl_xor(v, o));
    return v;
}
__device__ __forceinline__ float att_max3(float a, float b, float c) { return __builtin_fmaxf(__builtin_fmaxf(a, b), c); }
typedef float f32x16v __attribute__((ext_vector_type(16)));
typedef unsigned u32x6v __attribute__((ext_vector_type(6)));
constexpr int ROW6 = 1536;
__device__ __forceinline__ void fp6_put(unsigned char* __restrict__ T6, int row, int hf, int l, int g, f32x16v f0, f32x16v f1, float sc) {
    f0 *= sc; f1 *= sc;
    f32x16v ev, od;
#pragma unroll
    for (int k = 0; k < 8; ++k) { ev[k] = f0[2 * k]; od[k] = f0[2 * k + 1]; ev[8 + k] = f1[2 * k]; od[8 + k] = f1[2 * k + 1]; }
    const u32x6v w = __builtin_amdgcn_cvt_scalef32_2xpk16_fp6_f32(ev, od, 1.0f);
    unsigned char* base = T6 + (size_t)row * ROW6 + hf * 768 + l * 16;
    if (g == 0) { *(u32x4*)base = (u32x4){w[0], w[1], w[2], w[3]}; *(uint2*)(base + 256) = make_uint2(w[4], w[5]); }
    else { *(uint2*)(base + 264) = make_uint2(w[0], w[1]); *(u32x4*)(base + 512) = (u32x4){w[2], w[3], w[4], w[5]}; }
}
constexpr int SIDE_STG = 86016;
template <int DK, bool FOX, bool NOMAX>
__device__ __forceinline__ void attn_block(unsigned char* smem, const bf16_t* __restrict__ Q, int ldq, const bf16_t* __restrict__ K, int ldk, const bf16_t* __restrict__ V, int ldv,
                                           const float* __restrict__ Fh, const bf16_t* __restrict__ gate, bf16_t* __restrict__ gout  , int qbk, const float* __restrict__ gq, const float* __restrict__ gk  ,
                                           const float* __restrict__ side_u, const float* __restrict__ side_v, unsigned char* __restrict__ side_u8, unsigned char* __restrict__ side_v8, int& side_next) {
    typedef Lay<DK> LY;
    constexpr int ND = DK / 16, NKC = DK / 8, NKI = (64 * NKC) / 512;
    int tid = threadIdx.x; asm volatile("" : "+v"(tid));
    const int wid = __builtin_amdgcn_readfirstlane(tid >> 6), lane = tid & 63, r32 = lane & 31, hi = lane >> 5;
    const int q0 = qbk * 256, qlo = q0 + wid * 32, qm = qlo + r32 - 4 * hi;
    const int NT = 4 * qbk + 4;
    ALAS unsigned char* lds = (ALAS unsigned char*)smem;
    ALAS float* F_lds = (ALAS float*)(lds + LY::OFF_F);
    ALAS float* wsl = (ALAS float*)(lds + LY::OFF_WS) + wid * 64;
    bf16x8 qr[ND];
#pragma unroll
    for (int d0 = 0; d0 < ND; ++d0) qr[d0] = *(const bf16x8*)(Q + (size_t)(qlo + r32) * ldq + d0 * 16 + hi * 8);
    const float fq = FOX ? Fh[qlo + r32] : 0.f;
    int kgo[NKI], vgo[2];
#pragma unroll
    for (int i = 0; i < NKI; ++i) { const int pp = (wid * NKI + i) * 64 + lane, row = pp / NKC, cpos = pp % NKC, ch = cpos ^ ((row >> 1) & 7); kgo[i] = row * ldk + ch * 8; }
#pragma unroll
    for (int i = 0; i < 2; ++i) { const int o = ((wid * 2 + i) * 64 + lane) * 16, st = o >> 9, e = (o & 511) >> 1, kk = (st >> 2) * 8 + (e >> 5), c = (st & 3) * 32 + (e & 31);
        const int k = (kk & ~0xC) | ((kk & 4) << 1) | ((kk & 8) >> 1); vgo[i] = k * ldv + c; }
    const int vb0 = (int)(uintptr_t)smem + v_rd_base(lane);
    int kbase[4];
#pragma unroll
    for (int dd = 0; dd < 4; ++dd) kbase[dd] = LY::OFF_K + r32 * LY::ROWB + (((((dd << 1) | hi) ^ ((r32 >> 1) & 7))) << 4);
    float stf = 0.f;
#define ATT_GLDS(kb, bf) do { _Pragma("unroll") for (int i = 0; i < NKI; ++i) \
            __builtin_amdgcn_global_load_lds((const unsigned*)(K + (size_t)(kb) * ldk + kgo[i]), (ALAS unsigned*)(lds + LY::OFF_K + (bf) * LY::SHM_K + (wid * NKI + i) * 1024), 16, 0, 0); \
        _Pragma("unroll") for (int i = 0; i < 2; ++i) \
            __builtin_amdgcn_global_load_lds((const unsigned*)(V + (size_t)(kb) * ldv + vgo[i]), (ALAS unsigned*)(lds + (bf) * SHM_V + (wid * 2 + i) * 1024), 16, 0, 0); \
        if (FOX && tid < 64) stf = Fh[(kb) + tid]; } while (0)
#define ATT_WRITEF(bf) do { if (FOX && tid < 64) F_lds[(bf) * 64 + tid] = stf; } while (0)
    int t_start = 0; float m_init = 0.f;
    if (FOX) {
        const float gqm = wave_max_f(fmaxf(fabsf(gq[lane]), fabsf(gq[lane + 64]))), gkm = wave_max_f(fmaxf(fabsf(gk[lane]), fabsf(gk[lane + 64])));
        const float qk_bound = 0.12751743f * 128.f * gqm * gkm;
        const float thr = 2.02f * qk_bound + 40.f, f0 = Fh[q0]; m_init = -thr;
        const int j0 = lane, j1 = lane + 64;
        const bool c0 = (j0 < 4 * qbk) && (Fh[j0 * 64 + 63] - f0 >= thr), c1 = (j1 < 4 * qbk) && (Fh[(j1 < 4 * qbk ? j1 : 0) * 64 + 63] - f0 >= thr);
        t_start = __builtin_popcountll(__ballot(c0)) + __builtin_popcountll(__ballot(c1));
        t_start = __builtin_amdgcn_readfirstlane(t_start); }
    ATT_GLDS(t_start * 64, t_start & 1); ATT_WRITEF(t_start & 1);
    float m_reg = FOX ? m_init : 0.f, l_reg = 0.f; f32x16 o[4];
#pragma unroll
    for (int d = 0; d < 4; ++d)
#pragma unroll
        for (int r = 0; r < 16; ++r) o[d][r] = 0.f;
    int side_pend = -1;
    for (int t = t_start; t < NT; ++t) {
        const int buf = t & 1, kb = t * 64;
        asm volatile("s_waitcnt vmcnt(0)" ::: "memory");
        __syncthreads();
        if (t + 1 < NT) ATT_GLDS(kb + 64, buf ^ 1);
        if (side_pend >= 0) { const int sv = side_pend; side_pend = -1;
            if ((wid >> 2) == (sv & 1)) {
                const int c = tid & 255, rr = c >> 6, hf2 = (c >> 5) & 1, l = (c >> 1) & 15, g = c & 1;
                const ALAS float* sp = (const ALAS float*)(lds + SIDE_STG) + rr * 2048 + hf2 * 1024 + (2 * g) * 256 + l * 16;
                f32x16v f0, f1;
#pragma unroll
                for (int k = 0; k < 4; ++k) { const f32x4 a = *(const ALAS f32x4*)(sp + 4 * k), b2 = *(const ALAS f32x4*)(sp + 256 + 4 * k);
#pragma unroll
                    for (int e = 0; e < 4; ++e) { f0[4 * k + e] = a[e]; f1[4 * k + e] = b2[e]; } }
                const bool isv = sv >= 16;
                fp6_put(isv ? side_v8 : side_u8, blockIdx.x * 64 + (sv & 15) * 4 + rr, hf2, l, g, f0, f1, isv ? 4.f : 64.f); }
        } else if (side_next < 32 && t + 1 < NT) { const int sv = side_next; const bool isv = sv >= 16;
            const float* src = (isv ? side_v : side_u) + (size_t)(blockIdx.x * 64 + (sv & 15) * 4) * 2048;
#pragma unroll
            for (int i = 0; i < 4; ++i)
                __builtin_amdgcn_global_load_lds((const unsigned*)(src + ((i * 8 + wid) * 64 + lane) * 4), (ALAS unsigned*)(lds + SIDE_STG + (i * 8 + wid) * 1024), 16, 0, 0);
            side_pend = sv; ++side_next; }
        f32x16 p0, p1;
        if (FOX) { const float fqm = NOMAX ? fq : fq - m_reg;
#pragma unroll
            for (int g = 0; g < 4; ++g) { const f32x4 f0 = *(const ALAS f32x4*)(F_lds + buf * 64 + 8 * g + 4 * hi), f1 = *(const ALAS f32x4*)(F_lds + buf * 64 + 32 + 8 * g + 4 * hi);
#pragma unroll
                for (int e = 0; e < 4; ++e) { p0[4 * g + e] = fqm - f0[e]; p1[4 * g + e] = fqm - f1[e]; } }
        } else if (NOMAX) {
#pragma unroll
            for (int r = 0; r < 16; ++r) { p0[r] = 0.f; p1[r] = 0.f; }
        } else { const float nm = -m_reg;
#pragma unroll
            for (int r = 0; r < 16; ++r) { p0[r] = nm; p1[r] = nm; }
        }
        {
            constexpr int KPF = 2;
            int ka[4];
#pragma unroll
            for (int dd = 0; dd < 4; ++dd) ka[dd] = (int)(uintptr_t)smem + buf * LY::SHM_K + kbase[dd];
            bf16x8 kb0[KPF + 1], kb1[KPF + 1];
#define ATT_KRD(dst, addr, off) asm volatile("ds_read_b128 %0, %1 offset:%2" : "=&v"(dst) : "v"(addr), "i"(off) : "memory")
#pragma unroll
            for (int d0 = 0; d0 < KPF; ++d0) { ATT_KRD(kb0[d0 % (KPF + 1)], ka[d0 & 3], (d0 >> 2) * 128); ATT_KRD(kb1[d0 % (KPF + 1)], ka[d0 & 3], (d0 >> 2) * 128 + 32 * LY::ROWB); }
#pragma unroll
            for (int d0 = 0; d0 < ND; ++d0) {
                if (d0 + KPF < ND) { constexpr int dummy = 0; (void)dummy;
                    ATT_KRD(kb0[(d0 + KPF) % (KPF + 1)], ka[(d0 + KPF) & 3], ((d0 + KPF) >> 2) * 128); ATT_KRD(kb1[(d0 + KPF) % (KPF + 1)], ka[(d0 + KPF) & 3], ((d0 + KPF) >> 2) * 128 + 32 * LY::ROWB); }
                const int rem = (ND - 1 - d0) < KPF ? (ND - 1 - d0) : KPF;
                if (rem >= 2) asm volatile("s_waitcnt lgkmcnt(4)" ::: "memory");
                else if (rem == 1) asm volatile("s_waitcnt lgkmcnt(2)" ::: "memory");
                else asm volatile("s_waitcnt lgkmcnt(0)" ::: "memory");
                ASBAR();
                p0 = __builtin_amdgcn_mfma_f32_32x32x16_bf16(kb0[d0 % (KPF + 1)], qr[d0], p0, 0, 0, 0);
                p1 = __builtin_amdgcn_mfma_f32_32x32x16_bf16(kb1[d0 % (KPF + 1)], qr[d0], p1, 0, 0, 0);
            }
#undef ATT_KRD
        }
        if (kb + 63 > qlo) {
            const float NEG = -__builtin_inff(); const int dq = qm - kb;
#pragma unroll
            for (int r = 0; r < 16; ++r) { const int c = (r & 3) + 8 * (r >> 2); if (dq - c < 0) p0[r] = NEG; if (dq - c - 32 < 0) p1[r] = NEG; }
        }
        float alpha = 1.f;
        if (!NOMAX) {
        float pmax;
        { float a = att_max3(p0[0], p0[1], p1[0]), b = att_max3(p0[2], p0[3], p1[1]); a = att_max3(a, p1[2], p1[3]);
#pragma unroll
          for (int r = 4; r < 16; r += 4) { a = att_max3(a, p0[r], p0[r + 1]); b = att_max3(b, p0[r + 2], p0[r + 3]); a = att_max3(a, p1[r], p1[r + 1]); b = att_max3(b, p1[r + 2], p1[r + 3]); }
          pmax = fmaxf(a, b); }
        { auto rr = __builtin_amdgcn_permlane32_swap(__float_as_uint(pmax), __float_as_uint(pmax), false, false);
          pmax = fmaxf(__uint_as_float(rr[0]), __uint_as_float(rr[1])); }
        if (!__builtin_expect(__all(pmax <= 8.f), 1)) { const float dm = fmaxf(pmax, 0.f); alpha = __builtin_amdgcn_exp2f(-dm); m_reg += dm;
#pragma unroll
            for (int r = 0; r < 16; ++r) { p0[r] -= dm; p1[r] -= dm; } }
        }
        float ps = 0.f;
#pragma unroll
        for (int r = 0; r < 16; ++r) { p0[r] = __builtin_amdgcn_exp2f(p0[r]); ps += p0[r]; }
#pragma unroll
        for (int r = 0; r < 16; ++r) { p1[r] = __builtin_amdgcn_exp2f(p1[r]); ps += p1[r]; }
        { auto rr = __builtin_amdgcn_permlane32_swap(__float_as_uint(ps), __float_as_uint(ps), false, false);
          ps = __uint_as_float(rr[0]) + __uint_as_float(rr[1]); }
        l_reg = NOMAX ? l_reg + ps : l_reg * alpha + ps;
        bf16x8 pa0, pa1, pa2, pa3;
#define ATT_PK4(P, B_, OUT) do { unsigned a0 = cvtpk(P[B_+0], P[B_+1]), a1 = cvtpk(P[B_+2], P[B_+3]); unsigned b0_ = cvtpk(P[B_+4], P[B_+5]), b1_ = cvtpk(P[B_+6], P[B_+7]); \
        auto r0 = __builtin_amdgcn_permlane32_swap(a0, b0_, false, false); auto r1 = __builtin_amdgcn_permlane32_swap(a1, b1_, false, false); \
        u32x4 w = {r0[0], r1[0], r0[1], r1[1]}; OUT = *reinterpret_cast<bf16x8*>(&w); } while (0)
        ATT_PK4(p0, 0, pa0); ATT_PK4(p0, 8, pa1); ATT_PK4(p1, 0, pa2); ATT_PK4(p1, 8, pa3);
        if (!NOMAX && __any(alpha < 1.f)) {
            if (hi == 0) wsl[r32] = alpha;
            asm volatile("s_waitcnt lgkmcnt(0)" ::: "memory");
#pragma unroll
            for (int g = 0; g < 4; ++g) { const f32x4 al = *(const ALAS f32x4*)(wsl + 8 * g + 4 * hi);
#pragma unroll
                for (int d = 0; d < 4; ++d)
#pragma unroll
                    for (int e = 0; e < 4; ++e) o[d][4 * g + e] *= al[e]; }
        }
#define ATT_TRRD(dst, off) asm volatile("ds_read_b64_tr_b16 %0, %1 offset:%2" : "=&v"(dst) : "v"(vbb), "i"(off) : "memory")
#define ATT_PV(d0) do { s16x4 l0, l1, l2, l3, h0, h1, h2, h3; constexpr int b_ = (d0) * 512; \
        ATT_TRRD(l0, b_); ATT_TRRD(h0, b_ + 2048); ATT_TRRD(l1, b_ + 4096); ATT_TRRD(h1, b_ + 6144); ATT_TRRD(l2, b_ + 8192); ATT_TRRD(h2, b_ + 10240); ATT_TRRD(l3, b_ + 12288); ATT_TRRD(h3, b_ + 14336); \
        asm volatile("s_waitcnt lgkmcnt(0)" ::: "memory"); ASBAR(); \
        o[d0] = __builtin_amdgcn_mfma_f32_32x32x16_bf16(pa0, (bf16x8){l0[0], l0[1], l0[2], l0[3], h0[0], h0[1], h0[2], h0[3]}, o[d0], 0, 0, 0); \
        o[d0] = __builtin_amdgcn_mfma_f32_32x32x16_bf16(pa1, (bf16x8){l1[0], l1[1], l1[2], l1[3], h1[0], h1[1], h1[2], h1[3]}, o[d0], 0, 0, 0); \
        o[d0] = __builtin_amdgcn_mfma_f32_32x32x16_bf16(pa2, (bf16x8){l2[0], l2[1], l2[2], l2[3], h2[0], h2[1], h2[2], h2[3]}, o[d0], 0, 0, 0); \
        o[d0] = __builtin_amdgcn_mfma_f32_32x32x16_bf16(pa3, (bf16x8){l3[0], l3[1], l3[2], l3[3], h3[0], h3[1], h3[2], h3[3]}, o[d0], 0, 0, 0); } while (0)
        { const int vbb = vb0 + buf * SHM_V; ATT_PV(0); ATT_PV(1); ATT_PV(2); ATT_PV(3); }
        if (t + 1 < NT) ATT_WRITEF(buf ^ 1);
    }
    if (hi == 0) wsl[r32] = l_reg;
    asm volatile("s_waitcnt lgkmcnt(0)" ::: "memory");
#pragma unroll
    for (int r = 0; r < 16; ++r) {
        const int orow = crow(r, hi); const float rli = __builtin_amdgcn_rcpf(wsl[orow]);
        bf16_t* rowp = gout + (size_t)(qlo + orow) * 4096; const bf16_t* growp = gate + (size_t)(qlo + orow) * 4096;
#pragma unroll
        for (int d0 = 0; d0 < 4; ++d0) {
            const float v = o[d0][r] * rli; const float vn = __shfl_xor(v, 1);
            if ((r32 & 1) == 0) { unsigned* gp = (unsigned*)(rowp + d0 * 32 + r32); const unsigned g = *(const unsigned*)(growp + d0 * 32 + r32);
                *gp = cvtpk(v * __uint_as_float(g << 16), vn * __uint_as_float(g & 0xffff0000u)); }
        }
    }
    __syncthreads();
#undef ATT_GLDS
#undef ATT_WRITEF
#undef ATT_PK4
#undef ATT_TRRD
#undef ATT_PV
}
}
using pg8::bf16_t; using pg8::f32x4; using pg8::u32x4;
#define LAS __attribute__((address_space(3)))
constexpr int S = 8192, DM = 2048, INW = 11344, INWP = 11520;
constexpr float EPS = 1e-6f;
constexpr size_t MiB = 1u << 20;

__device__ __forceinline__ float bf2f(bf16_t v) { return __uint_as_float(((unsigned)v) << 16); }
__device__ __forceinline__ bf16_t f2bf(float f) { unsigned u = __float_as_uint(f); u += 0x7fffu + ((u >> 16) & 1u); return (bf16_t)(u >> 16); }
__device__ __forceinline__ unsigned pk2(float lo, float hi) { return (unsigned)f2bf(lo) | ((unsigned)f2bf(hi) << 16); }
__device__ __forceinline__ float wave_sum(float v) {
#pragma unroll
    for (int o = 32; o >= 1; o >>= 1) v += __shfl_xor(v, o);
    return v;
}
__device__ __forceinline__ float wave_max(float v) {
#pragma unroll
    for (int o = 32; o >= 1; o >>= 1) v = fmaxf(v, __shfl_xor(v, o));
    return v;
}

__device__ __forceinline__ int opaque_tid() { int t = threadIdx.x; asm volatile("" : "+v"(t)); return t; }

struct Params {
    const float* x; const int* pos; const float *mix_g, *w_in, *b_forget, *b_gate, *q_lat_g, *w_q_up, *kv_lat_g, *w_kv_up, *mla_qg, *mla_kg, *fox_qg, *fox_kg, *w_out, *ffn_g, *w_peer_q, *sub_keys, *peer_u, *peer_v;
    float* out;
    bf16_t *WqT, *WkvT, *WoT, *WpT, *WinT;
    bf16_t *h, *cq, *ckv, *fq, *fk, *fv, *merged, *kpe, *qa, *va, *ka;
    float *lf, *F, *x1, *scores;
    unsigned char *U8, *V8; bf16_t* attout;
    unsigned* ctl;
    float2* ropeT; float* ssq; float* ssq2; bf16_t* xg;
};

struct DstId { __device__ __forceinline__ int operator()(int n) const { return n; } };
struct DstWin { __device__ __forceinline__ int operator()(int n) const {
    if (n < 1024) return n; if (n < 1088) { const int r = n - 1024; return 11264 + 2 * (r & 31) + (r >> 5); } if (n < 7232) return n - 64; if (n < 7248) return 11264 + 64 + (n - 7232); return n - 80; } };
struct DstQ { __device__ __forceinline__ int operator()(int n) const {
    const int h = n / 192, d = n - h * 192; if (d < 128) return h * 256 + d; const int r = d - 128; return h * 256 + 128 + 2 * (r & 31) + (r >> 5); } };
template <class Dst>
__device__ __forceinline__ void transpose_item(const float* __restrict__ W, int K, int N, bf16_t* __restrict__ WT, Dst dst, float* scr, int item, int lane, const float* __restrict__ gk = nullptr) {
    const int nblk = (N + 31) / 32, kb = item / nblk, nb = item % nblk, k0 = 64 * kb, n0 = 32 * nb;
    { const int rr = lane >> 3, c4 = (lane & 7) * 4; const bool ok = (n0 + c4) < N;
      f32x4 v[8];
#pragma unroll
      for (int i = 0; i < 8; ++i) v[i] = ok ? *(const f32x4*)(W + (size_t)(k0 + 8 * i + rr) * N + n0 + c4) : (f32x4){0.f, 0.f, 0.f, 0.f};
      if (gk) {
#pragma unroll
          for (int i = 0; i < 8; ++i) v[i] *= gk[k0 + 8 * i + rr]; }
#pragma unroll
      for (int i = 0; i < 8; ++i) { float* sp = scr + (8 * i + rr) * 33 + c4; sp[0] = v[i][0]; sp[1] = v[i][1]; sp[2] = v[i][2]; sp[3] = v[i][3]; } }
    asm volatile("s_waitcnt lgkmcnt(0)" ::: "memory");
    const int c = lane & 7;
#pragma unroll
    for (int j = 0; j < 4; ++j) { const int nl = (lane >> 3) + 8 * j, n = n0 + nl; const float* s = scr + (8 * c) * 33 + nl;
        u32x4 o; o.x = pk2(s[0 * 33], s[1 * 33]); o.y = pk2(s[2 * 33], s[3 * 33]); o.z = pk2(s[4 * 33], s[5 * 33]); o.w = pk2(s[6 * 33], s[7 * 33]);
        if (n < N) *(u32x4*)(WT + (size_t)dst(n) * K + k0 + 8 * c) = o; }
    asm volatile("s_waitcnt lgkmcnt(0)" ::: "memory");
}
__device__ __forceinline__ void wfold_item(const float* __restrict__ wq, const float* __restrict__ keys, bf16_t* __restrict__ WpT, float* sm, int item) {
    const int tid = opaque_tid(), hc = item >> 5, d0 = (item & 31) * 64;
    float* keysL = sm; float* wqL = sm + 128 * 132;
    for (int idx = tid; idx < 128 * 32; idx += 512) { const int r = idx >> 5, c4 = (idx & 31) * 4; *(f32x4*)(keysL + r * 132 + c4) = *(const f32x4*)(keys + (size_t)hc * 16384 + r * 128 + c4); }
    for (int idx = tid; idx < 64 * 32; idx += 512) { const int r = idx >> 5, c4 = (idx & 31) * 4; *(f32x4*)(wqL + r * 132 + c4) = *(const f32x4*)(wq + (size_t)(d0 + r) * 2048 + hc * 128 + c4); }
    __syncthreads();
    const int n2 = (tid & 63) * 2, dg = tid >> 6;
    float acc[2][8];
#pragma unroll
    for (int a = 0; a < 2; ++a)
#pragma unroll
        for (int i = 0; i < 8; ++i) acc[a][i] = 0.f;
#pragma unroll 2
    for (int j4 = 0; j4 < 32; ++j4) {
        const f32x4 k0v = *(const f32x4*)(keysL + n2 * 132 + 4 * j4), k1v = *(const f32x4*)(keysL + (n2 + 1) * 132 + 4 * j4);
#pragma unroll
        for (int i = 0; i < 8; ++i) { const f32x4 w = *(const f32x4*)(wqL + (dg * 8 + i) * 132 + 4 * j4);
            acc[0][i] += (k0v[0] * w[0] + k0v[1] * w[1]) + (k0v[2] * w[2] + k0v[3] * w[3]);
            acc[1][i] += (k1v[0] * w[0] + k1v[1] * w[1]) + (k1v[2] * w[2] + k1v[3] * w[3]); }
    }
#pragma unroll
    for (int a = 0; a < 2; ++a) { u32x4 o; o.x = pk2(acc[a][0], acc[a][1]); o.y = pk2(acc[a][2], acc[a][3]); o.z = pk2(acc[a][4], acc[a][5]); o.w = pk2(acc[a][6], acc[a][7]);
        *(u32x4*)(WpT + (size_t)(hc * 128 + n2 + a) * 2048 + d0 + dg * 8) = o; }
    __syncthreads();
}
__device__ __forceinline__ void rms_row2048(const float* __restrict__ xr, const float* __restrict__ g, bf16_t* __restrict__ orow, int lane) {
    f32x4 v[8]; float ss = 0.f;
#pragma unroll
    for (int j = 0; j < 8; ++j) { v[j] = *(const f32x4*)(xr + j * 256 + lane * 4); ss += (v[j][0] * v[j][0] + v[j][1] * v[j][1]) + (v[j][2] * v[j][2] + v[j][3] * v[j][3]); }
    const float r = rsqrtf(wave_sum(ss) * (1.f / 2048.f) + EPS);
#pragma unroll
    for (int j = 0; j < 8; ++j) { const f32x4 gg = *(const f32x4*)(g + j * 256 + lane * 4);
        uint2 o; o.x = pk2(v[j][0] * r * gg[0], v[j][1] * r * gg[1]); o.y = pk2(v[j][2] * r * gg[2], v[j][3] * r * gg[3]);
        *(uint2*)(orow + j * 256 + lane * 4) = o; }
}
__device__ __forceinline__ void fox_cumsum(double* part, int h, const float* __restrict__ lf, float* __restrict__ F) {
    const int tid = opaque_tid(), lane = tid & 63, wave = tid >> 6;
    float v[16]; double sum = 0.0;
#pragma unroll
    for (int i = 0; i < 16; ++i) { v[i] = lf[(size_t)(tid * 16 + i) * 16 + h]; sum += (double)v[i]; }
    double inc = sum;
#pragma unroll
    for (int o = 1; o < 64; o <<= 1) { const double n = __shfl_up(inc, o); if (lane >= o) inc += n; }
    if (lane == 63) part[wave] = inc;
    __syncthreads();
    double base = 0.0;
    for (int w = 0; w < wave; ++w) base += part[w];
    double run = base + inc - sum;
#pragma unroll
    for (int i = 0; i < 16; ++i) { run += (double)v[i]; F[(size_t)h * S + tid * 16 + i] = (float)(run * 1.4426950408889634); }
    __syncthreads();
}
__device__ __forceinline__ void rope_table(const int* __restrict__ pos, float2* __restrict__ ropeT, int gtid, int nthreads) {
    for (int idx = gtid; idx < S * 32; idx += nthreads) { const int t = idx >> 5, i = idx & 31;
        const double inv = exp(-(double)i * (1.0 / 32.0) * 9.210340371976184);
        double ang = (double)((float)pos[t] * (float)inv);
        const double twopi = 6.283185307179586;
        ang -= twopi * rint(ang / twopi);
        ropeT[idx] = make_float2(cosf((float)ang), sinf((float)ang)); }
}
typedef float f32x2 __attribute__((ext_vector_type(2)));
__device__ __forceinline__ unsigned pk4_fp8(float a, float b, float c, float d) {
    int w = __builtin_amdgcn_cvt_pk_fp8_f32(fminf(fmaxf(a, -448.f), 448.f), fminf(fmaxf(b, -448.f), 448.f), 0, false);
    w = __builtin_amdgcn_cvt_pk_fp8_f32(fminf(fmaxf(c, -448.f), 448.f), fminf(fmaxf(d, -448.f), 448.f), w, true); return (unsigned)w; }
__device__ __forceinline__ void cvt_rows_fp8(const float* __restrict__ src, unsigned char* __restrict__ dst, size_t n, float scale, int gw, int NGW, int lane) {
    const size_t nchunk = n / 1024;
    for (size_t c = gw; c < nchunk; c += NGW) { const size_t o = c * 1024 + lane * 16;
        f32x4 a[4];
#pragma unroll
        for (int q = 0; q < 4; ++q) a[q] = *(const f32x4*)(src + o + 4 * q) * scale;
        u32x4 w; w.x = pk4_fp8(a[0][0], a[0][1], a[0][2], a[0][3]); w.y = pk4_fp8(a[1][0], a[1][1], a[1][2], a[1][3]);
        w.z = pk4_fp8(a[2][0], a[2][1], a[2][2], a[2][3]); w.w = pk4_fp8(a[3][0], a[3][1], a[3][2], a[3][3]);
        *(u32x4*)(dst + o) = w; }
}
constexpr float U_SCALE = 64.f, V_SCALE = 4.f;
typedef __bf16 bf16x2_t __attribute__((ext_vector_type(2)));
__device__ __forceinline__ float dot2bf(unsigned a, unsigned b, float c) { return __builtin_amdgcn_fdot2_f32_bf16(__builtin_bit_cast(bf16x2_t, a), __builtin_bit_cast(bf16x2_t, b), c, false); }
#define PEER_INS(top, x) do { float x_ = (x); _Pragma("unroll") for (int i_ = 0; i_ < 16; ++i_) { const float hi_ = fmaxf(top[i_], x_); x_ = fminf(top[i_], x_); top[i_] = hi_; } } while (0)
__device__ __forceinline__ void fp6_cvt_rows(const float* __restrict__ src, unsigned char* __restrict__ T6, int row0, int nrows, float sc, int t, int nt) {
    for (int u = t; u < nrows * 64; u += nt) { const int rr = u >> 6, hf = (u >> 5) & 1, l = (u >> 1) & 15, g = u & 1;
        const float* s0 = src + (size_t)(row0 + rr) * 2048 + hf * 1024 + (2 * g) * 256 + l * 16;
        att::f32x16v f0, f1;
#pragma unroll
        for (int k = 0; k < 4; ++k) { const f32x4 a = *(const f32x4*)(s0 + 4 * k), b2 = *(const f32x4*)(s0 + 256 + 4 * k);
#pragma unroll
            for (int e = 0; e < 4; ++e) { f0[4 * k + e] = a[e]; f1[4 * k + e] = b2[e]; } }
        att::fp6_put(T6, row0 + rr, hf, l, g, f0, f1, sc); }
}
typedef float f32x32v __attribute__((ext_vector_type(32)));
__device__ __forceinline__ void peer_group(unsigned char* smem, int g, const float* __restrict__ scores, const bf16_t* __restrict__ h2  , const float* __restrict__ ssq2, const float* __restrict__ x1,
                                           const unsigned char* __restrict__ U8, const unsigned char* __restrict__ V8, float* __restrict__ out) {
    const int tid = opaque_tid(), lane = tid & 63, wave = __builtin_amdgcn_readfirstlane(tid >> 6);
    float* topL = (float*)smem;
    int* selE = (int*)(smem + 32768);
    float* selG = (float*)(smem + 49152);
    {
        const int tl = tid >> 4, hc = tid & 15;
        const float* sp = scores + (size_t)(g * 32 + tl) * 2048 + hc * 128;
#define PEER_CE(a, b) do { const float hi_ = fmaxf(a, b), lo_ = fminf(a, b); a = hi_; b = lo_; } while (0)
        float top[16];
#pragma unroll 1
        for (int gi = 0; gi < 8; ++gi) {
            float gr[16];
#pragma unroll
            for (int q = 0; q < 4; ++q) { const f32x4 v = *(const f32x4*)(sp + gi * 16 + q * 4);
#pragma unroll
                for (int e = 0; e < 4; ++e) gr[q * 4 + e] = __uint_as_float((__float_as_uint(v[e]) & ~0x7Fu) | (unsigned)(gi * 16 + q * 4 + e)); }
#pragma unroll
            for (int k = 2; k <= 16; k <<= 1)
#pragma unroll
                for (int j = k >> 1; j > 0; j >>= 1)
#pragma unroll
                    for (int i = 0; i < 16; ++i) { const int l = i ^ j; if (l > i) { if ((i & k) == 0) PEER_CE(gr[i], gr[l]); else PEER_CE(gr[l], gr[i]); } }
            if (gi == 0) {
#pragma unroll
                for (int i = 0; i < 16; ++i) top[i] = gr[i];
            } else {
#pragma unroll
                for (int i = 0; i < 16; ++i) top[i] = fmaxf(top[i], gr[15 - i]);
#pragma unroll
                for (int j = 8; j > 0; j >>= 1)
#pragma unroll
                    for (int i = 0; i < 16; ++i) { const int l = i ^ j; if (l > i) PEER_CE(top[i], top[l]); }
            }
        }
#undef PEER_CE
        float* tp = topL + (tl * 16 + hc) * 16;
#pragma unroll
        for (int i = 0; i < 16; i += 4) *(f32x4*)(tp + i) = (f32x4){top[i], top[i + 1], top[i + 2], top[i + 3]};
    }
    __syncthreads();
    if (tid < 256) {
        const int tl = tid >> 3, h = tid & 7;
        const float* t1 = topL + (tl * 16 + 2 * h) * 16; const float* t2 = t1 + 16;
        float s1[16], s2[16];
#pragma unroll
        for (int i = 0; i < 16; i += 4) { const f32x4 a = *(const f32x4*)(t1 + i), b2 = *(const f32x4*)(t2 + i);
            s1[i] = a[0]; s1[i + 1] = a[1]; s1[i + 2] = a[2]; s1[i + 3] = a[3]; s2[i] = b2[0]; s2[i + 1] = b2[1]; s2[i + 2] = b2[2]; s2[i + 3] = b2[3]; }
#define PEER_CE(a, b) do { const float hi_ = fmaxf(a, b), lo_ = fminf(a, b); a = hi_; b = lo_; } while (0)
#define PEER_KEY(i, j) __uint_as_float((__float_as_uint(s1[i] + s2[j]) & ~0xFFu) | (unsigned)((i) * 16 + (j)))
        float ts[16], cand[34];
#pragma unroll
        for (int j = 0; j < 16; ++j) ts[j] = PEER_KEY(0, j);
        { int n = 0;
#pragma unroll
          for (int i = 1; i < 16; ++i)
#pragma unroll
              for (int j = 0; j < 8; ++j)
                  if ((i + 1) * (j + 1) <= 16) cand[n++] = PEER_KEY(i, j); }
#pragma unroll
        for (int gi = 0; gi < 2; ++gi) { float gr[16];
#pragma unroll
            for (int i = 0; i < 16; ++i) gr[i] = cand[gi * 16 + i];
#pragma unroll
            for (int k = 2; k <= 16; k <<= 1)
#pragma unroll
                for (int j = k >> 1; j > 0; j >>= 1)
#pragma unroll
                    for (int i = 0; i < 16; ++i) { const int l = i ^ j; if (l > i) { if ((i & k) == 0) PEER_CE(gr[i], gr[l]); else PEER_CE(gr[l], gr[i]); } }
#pragma unroll
            for (int i = 0; i < 16; ++i) ts[i] = fmaxf(ts[i], gr[15 - i]);
#pragma unroll
            for (int j = 8; j > 0; j >>= 1)
#pragma unroll
                for (int i = 0; i < 16; ++i) { const int l = i ^ j; if (l > i) PEER_CE(ts[i], ts[l]); } }
        PEER_INS(ts, cand[32]); PEER_INS(ts, cand[33]);
#undef PEER_CE
#undef PEER_KEY
        float ex[16], sum = 0.f;
#pragma unroll
        for (int k = 0; k < 16; ++k) { ex[k] = __expf(ts[k] - ts[0]); sum += ex[k]; }
        const float inv = 1.f / sum;
#pragma unroll
        for (int k = 0; k < 16; ++k) { const unsigned pos = __float_as_uint(ts[k]) & 0xFFu;
            const int i1 = (int)(__float_as_uint(t1[pos >> 4]) & 0x7Fu), i2 = (int)(__float_as_uint(t2[pos & 15]) & 0x7Fu);
            selE[tl * 128 + h * 16 + k] = i1 * 128 + i2; selG[tl * 128 + h * 16 + k] = ex[k] * inv; }
    }
    __syncthreads();
    const int grp = lane >> 4, l16 = lane & 15, tl = wave * 4 + grp;
    unsigned* sortK = (unsigned*)(smem + 65536) + tl * 128;
    float* wS = (float*)(smem + 81920) + tl * 128;
    unsigned* hist = (unsigned*)(smem + 98304) + wave * 512 + grp * 64;
    {
#pragma unroll
        for (int i = 0; i < 4; ++i) hist[l16 * 4 + i] = 0u;
        asm volatile("s_waitcnt lgkmcnt(0)" ::: "memory");
        unsigned ek[8], rk[8];
#pragma unroll
        for (int j = 0; j < 8; ++j) { ek[j] = (unsigned)selE[tl * 128 + l16 + 16 * j]; rk[j] = atomicAdd(&hist[ek[j] >> 8], 1u); }
        asm volatile("s_waitcnt lgkmcnt(0)" ::: "memory");
        unsigned c[4], tot = 0u;
#pragma unroll
        for (int i = 0; i < 4; ++i) { c[i] = hist[l16 * 4 + i]; tot += c[i]; }
        unsigned inc = tot;
#pragma unroll
        for (int o = 1; o < 16; o <<= 1) { const unsigned n = __shfl_up(inc, o, 16); if (l16 >= o) inc += n; }
        unsigned run = inc - tot;
#pragma unroll
        for (int i = 0; i < 4; ++i) { hist[256 + l16 * 4 + i] = run; run += c[i]; }
        asm volatile("s_waitcnt lgkmcnt(0)" ::: "memory");
#pragma unroll
        for (int j = 0; j < 8; ++j) sortK[hist[256 + (ek[j] >> 8)] + rk[j]] = (ek[j] << 7) | (unsigned)(l16 + 16 * j);
    }
    __syncthreads();
    const size_t tok = (size_t)g * 32 + tl;
    float rinv_tok;
    { float t = 0.f; if (l16 < 8) { const f32x4 a = *(const f32x4*)(ssq2 + ((size_t)l16 * 8192 + tok) * 4); t = (a[0] + a[1]) + (a[2] + a[3]); }
      t += __shfl_xor(t, 8); t += __shfl_xor(t, 4); t += __shfl_xor(t, 2); t += __shfl_xor(t, 1); rinv_tok = rsqrtf(t * (1.f / 2048.f) + 1e-6f); }
    {
        const int m16 = lane & 15, kg = lane >> 4, pt = m16 >> 2, sub = m16 & 3, l6 = kg * 4 + sub;
        const unsigned* sKa = (const unsigned*)(smem + 65536) + (wave * 4 + pt) * 128;
        const bool diag = pt == kg;
        const size_t tokb = (size_t)g * 32 + wave * 4 + pt;
        typedef int i32x8v __attribute__((ext_vector_type(8)));
        const float xsc = 1.4f * __shfl(rinv_tok, pt * 16);
#pragma unroll 1
        for (int hf = 0; hf < 2; ++hf) {
            i32x8v xb[2];
#pragma unroll
            for (int gq = 0; gq < 2; ++gq) { att::f32x16v ev, od;
#pragma unroll
                for (int h = 0; h < 2; ++h) { const bf16_t* xp = h2 + tokb * DM + hf * 1024 + (2 * gq + h) * 256 + l6 * 16;
                    const u32x4 w0 = *(const u32x4*)xp, w1 = *(const u32x4*)(xp + 8);
#pragma unroll
                    for (int q = 0; q < 4; ++q) { ev[8 * h + q] = __uint_as_float(w0[q] << 16) * xsc; od[8 * h + q] = __uint_as_float(w0[q] & 0xffff0000u) * xsc;
                        ev[8 * h + 4 + q] = __uint_as_float(w1[q] << 16) * xsc; od[8 * h + 4 + q] = __uint_as_float(w1[q] & 0xffff0000u) * xsc; } }
                const att::u32x6v w6 = __builtin_amdgcn_cvt_scalef32_2xpk16_fp6_f32(ev, od, 1.0f);
                xb[gq] = (i32x8v){(int)w6[0], (int)w6[1], (int)w6[2], (int)w6[3], (int)w6[4], (int)w6[5], 0, 0}; }
            u32x4 urA[4][3], urB[4][3];
#define PEER_LDA(ur, it0) do { _Pragma("unroll") for (int j = 0; j < 4; ++j) { const unsigned ro = (sKa[(it0) + j] >> 7) * (unsigned)att::ROW6 + (unsigned)(hf * 768 + l6 * 16); \
                    _Pragma("unroll") for (int c = 0; c < 3; ++c) ur[j][c] = *(const u32x4*)(U8 + ro + c * 256); } } while (0)
#define PEER_CMA(ur, it0) do { float dsel = 0.f; \
                _Pragma("unroll") for (int j = 0; j < 4; ++j) { f32x4 acc = (f32x4){0.f, 0.f, 0.f, 0.f}; \
                    acc = __builtin_amdgcn_mfma_scale_f32_16x16x128_f8f6f4((i32x8v){(int)ur[j][0][0], (int)ur[j][0][1], (int)ur[j][0][2], (int)ur[j][0][3], (int)ur[j][1][0], (int)ur[j][1][1], 0, 0}, xb[0], acc, 2, 2, 0, 0x7F7F7F7F, 0, 0x7F7F7F7F); \
                    acc = __builtin_amdgcn_mfma_scale_f32_16x16x128_f8f6f4((i32x8v){(int)ur[j][1][2], (int)ur[j][1][3], (int)ur[j][2][0], (int)ur[j][2][1], (int)ur[j][2][2], (int)ur[j][2][3], 0, 0}, xb[1], acc, 2, 2, 0, 0x7F7F7F7F, 0, 0x7F7F7F7F); \
                    float d = sub == 0 ? acc[0] : sub == 1 ? acc[1] : sub == 2 ? acc[2] : acc[3]; \
                    d += __builtin_bit_cast(float, __builtin_amdgcn_update_dpp(0, __builtin_bit_cast(int, d), 0xB1, 0xF, 0xF, true)); \
                    d += __builtin_bit_cast(float, __builtin_amdgcn_update_dpp(0, __builtin_bit_cast(int, d), 0x4E, 0xF, 0xF, true)); \
                    if (sub == j) dsel = d; } \
                if (diag) { float* wSt = (float*)(smem + 81920) + (wave * 4 + pt) * 128; \
                    if (hf == 0) wSt[(it0) + sub] = dsel; \
                    else { const float a = (wSt[(it0) + sub] + dsel) * (1.f / (1.4f * U_SCALE)); \
                        wSt[(it0) + sub] = selG[(wave * 4 + pt) * 128 + (sKa[(it0) + sub] & 127u)] * 0.5f * a * (1.f + erff(a * 0.70710678118654752f)) * (1.f / V_SCALE); } } } while (0)
            PEER_LDA(urA, 0);
#pragma unroll 1
            for (int it = 0; it < 128; it += 8) {
                if (it) __builtin_amdgcn_s_barrier();
                PEER_LDA(urB, it + 4);
                PEER_CMA(urA, it);
                if (it + 8 < 128) PEER_LDA(urA, it + 8);
                PEER_CMA(urB, it + 4);
            }
#undef PEER_LDA
#undef PEER_CMA
            __syncthreads();
        }
    }
#pragma unroll 1
    for (int hf = 0; hf < 2; ++hf) {
        typedef _Float16 h16x2v __attribute__((ext_vector_type(2)));
        typedef _Float16 h16x32v __attribute__((ext_vector_type(32)));
        h16x2v acc[32];
#pragma unroll
        for (int c = 0; c < 32; ++c) acc[c] = (h16x2v){(_Float16)0.f, (_Float16)0.f};
        for (int it = 0; it < 128; it += 4) {
            if ((it & 7) == 0 && it) __syncthreads();
            unsigned key[4]; u32x4 vr[4][3];
#pragma unroll
            for (int p = 0; p < 4; ++p) { key[p] = sortK[it + p];
#pragma unroll
                for (int j = 0; j < 3; ++j) vr[p][j] = *(const u32x4*)(V8 + (size_t)(key[p] >> 7) * att::ROW6 + hf * 768 + j * 256 + l16 * 16); }
#pragma unroll
            for (int p = 0; p < 4; ++p) { const _Float16 wh = (_Float16)wS[it + p]; const h16x2v w2 = (h16x2v){wh, wh};
                const h16x32v c0 = __builtin_amdgcn_cvt_scalef32_pk32_f16_fp6((att::u32x6v){vr[p][0][0], vr[p][0][1], vr[p][0][2], vr[p][0][3], vr[p][1][0], vr[p][1][1]}, 1.0f);
#pragma unroll
                for (int k = 0; k < 16; ++k) acc[k] = __builtin_elementwise_fma(w2, (h16x2v){c0[2 * k], c0[2 * k + 1]}, acc[k]);
                const h16x32v c1 = __builtin_amdgcn_cvt_scalef32_pk32_f16_fp6((att::u32x6v){vr[p][1][2], vr[p][1][3], vr[p][2][0], vr[p][2][1], vr[p][2][2], vr[p][2][3]}, 1.0f);
#pragma unroll
                for (int k = 0; k < 16; ++k) acc[16 + k] = __builtin_elementwise_fma(w2, (h16x2v){c1[2 * k], c1[2 * k + 1]}, acc[16 + k]); }
        }
#pragma unroll
        for (int j = 0; j < 4; ++j)
#pragma unroll
            for (int q = 0; q < 4; ++q) { const size_t o = tok * DM + hf * 1024 + j * 256 + l16 * 16 + q * 4;
                const f32x4 a = *(const f32x4*)(x1 + o);
                *(f32x4*)(out + o) = (f32x4){a[0] + (float)acc[j * 8 + 2 * q][0], a[1] + (float)acc[j * 8 + 2 * q][1], a[2] + (float)acc[j * 8 + 2 * q + 1][0], a[3] + (float)acc[j * 8 + 2 * q + 1][1]}; }
        __syncthreads();
    }
    __syncthreads();
}

#define XB_TMO      128
#define XB_XCNT(j)  (256  + 64 * (j))
#define XB_XSUB(j)  (1280 + 64 * (j))
#define XB_XGEN(j)  (2304 + 64 * (j))
#define XB_TOP      3328
#define XB_TOPGEN   3392
#define XCD_BAR_WORDS 3456
#define XB_SPIN_CAP (1u << 18)

__device__ __forceinline__ unsigned xb_ld(unsigned* p)              { return __hip_atomic_load(p, __ATOMIC_RELAXED, __HIP_MEMORY_SCOPE_AGENT); }
__device__ __forceinline__ unsigned xb_add(unsigned* p, unsigned v) { return __hip_atomic_fetch_add(p, v, __ATOMIC_RELAXED, __HIP_MEMORY_SCOPE_AGENT); }
__device__ __forceinline__ unsigned xb_xcc_id() { return (unsigned)__builtin_amdgcn_s_getreg((3 << 11) | 20) & 0xFu; }
#define XB_SPIN(cond, bar) do { unsigned _sp = 0; while (cond) { __builtin_amdgcn_s_sleep(1); \
    if ((++_sp & 255u) == 0u) { if (xb_ld(&(bar)[XB_TMO])) break; if (_sp > XB_SPIN_CAP) { atomicAdd(&(bar)[XB_TMO], 1u); break; } } } } while (0)

struct XcdBarrier {
    unsigned* bar; unsigned x;
    volatile LAS unsigned* st;
};

__device__ __forceinline__ XcdBarrier xcd_barrier_post(unsigned* bar, volatile LAS unsigned* st) {
    XcdBarrier b; b.bar = bar; b.x = xb_xcc_id(); b.st = st;
    if (threadIdx.x == 0) (void)xb_add(&bar[XB_XCNT(b.x)], 1u);
    return b;
}
__device__ __forceinline__ void xcd_barrier_complete(unsigned* bar, unsigned x, unsigned& nloc, unsigned& nx) {
    const unsigned G = gridDim.x * gridDim.y * gridDim.z;
    unsigned sum, cnt, mine, sp = 0u;
    for (;;) {
        sum = 0u; cnt = 0u; mine = 0u;
#pragma unroll
        for (unsigned j = 0; j < 16; ++j) { const unsigned c = xb_ld(&bar[XB_XCNT(j)]); sum += c; cnt += (c > 0u) ? 1u : 0u; mine = (j == x) ? c : mine; }
        if (sum == G) break;
        __builtin_amdgcn_s_sleep(1);
        if ((++sp & 255u) == 0u) { if (xb_ld(&bar[XB_TMO])) break; if (sp > XB_SPIN_CAP) { atomicAdd(&bar[XB_TMO], 1u); break; } }
    }
    nloc = mine > 0u ? mine : 1u; nx = cnt > 0u ? cnt : 1u;
}

__device__ __forceinline__ void xcd_barrier(const XcdBarrier& b) {
    asm volatile("s_waitcnt vmcnt(0)" ::: "memory");
    __syncthreads();
    if (threadIdx.x == 0) {
        unsigned* bar = b.bar;
        __builtin_amdgcn_s_waitcnt(0);
        unsigned nloc = b.st[0], nx = b.st[1];
        if (nloc == 0u) { xcd_barrier_complete(bar, b.x, nloc, nx); b.st[0] = nloc; b.st[1] = nx; }
        const unsigned old = xb_add(&bar[XB_XSUB(b.x)], 1u);
        const unsigned gen = old / nloc;
        if (old + 1u == (gen + 1u) * nloc) {
            __builtin_amdgcn_fence(__ATOMIC_RELEASE, "agent");
            asm volatile("s_waitcnt vmcnt(0)" ::: "memory");
            const unsigned og = xb_add(&bar[XB_TOP], 1u);
            const unsigned tg = og / nx;
            if (og + 1u == (tg + 1u) * nx) xb_add(&bar[XB_TOPGEN], 1u);
            else XB_SPIN(xb_ld(&bar[XB_TOPGEN]) == tg, bar);
            __builtin_amdgcn_fence(__ATOMIC_ACQUIRE, "agent");
            xb_add(&bar[XB_XGEN(b.x)], 1u);
            asm volatile("s_waitcnt vmcnt(0)" ::: "memory");
        } else {
            XB_SPIN(xb_ld(&bar[XB_XGEN(b.x)]) == gen, bar);
            __builtin_amdgcn_fence(__ATOMIC_ACQUIRE, "agent");
            asm volatile("s_waitcnt vmcnt(0)" ::: "memory");
        }
    }
    __syncthreads();
}

#define PROBE_DOUBLE 0
#define REP(k) for (int rep_ = 0; rep_ < ((PROBE_DOUBLE == (k)) ? 2 : 1); ++rep_)
constexpr int LDS_BYTES = 147456;
__global__ __launch_bounds__(512, 2) void mega(Params p) {
    extern __shared__ __attribute__((aligned(16))) unsigned char smem[];
    { volatile LAS unsigned* st0 = (volatile LAS unsigned*)((LAS unsigned char*)smem + 131072); if (threadIdx.x < 2) st0[threadIdx.x] = 0u; }
    __syncthreads();
    const XcdBarrier bar = xcd_barrier_post(p.ctl, (volatile LAS unsigned*)((LAS unsigned char*)smem + 131072));
    float* smf = (float*)smem;
    LAS unsigned char* lds = (LAS unsigned char*)smem;
    const int G = gridDim.x, b = blockIdx.x, NGW = G * 8;
#define PHASE_IDS() const int tid = opaque_tid(), lane = tid & 63, wave = __builtin_amdgcn_readfirstlane(tid >> 6), gw = b * 8 + wave; (void)lane; (void)gw

    REP(7) {
        PHASE_IDS();
        float* scr = smf + wave * 4096;
        constexpr int dummy_ = 0; (void)dummy_;
        constexpr int I_IN = 32 * 355, I_Q = 8 * 96, I_KV = 8 * 128, I_O = 64 * 64;
        for (int it = gw; it < I_IN + I_Q + I_KV + I_O; it += NGW) {
            int r = it;
            if (r < I_IN) { transpose_item(p.w_in, 2048, INW, p.WinT, DstWin(), scr, r, lane); continue; } r -= I_IN;
            if (r < I_Q) { transpose_item(p.w_q_up, 512, 3072, p.WqT, DstQ(), scr, r, lane, p.q_lat_g); continue; } r -= I_Q;
            if (r < I_KV) { transpose_item(p.w_kv_up, 512, 4096, p.WkvT, DstId(), scr, r, lane, p.kv_lat_g); continue; } r -= I_KV;
            transpose_item(p.w_out, 4096, 2048, p.WoT, DstId(), scr, r, lane);
        }
        for (int m = gw; m < S; m += NGW) rms_row2048(p.x + (size_t)m * DM, p.mix_g, p.h + (size_t)m * DM, lane);
        for (int idx = b * 512 + tid; idx < 16 * 64 * 64; idx += G * 512) { const int hh = idx >> 12, rr = (idx >> 6) & 63, c8 = idx & 63;
            *(u32x4*)(p.WqT + (size_t)(hh * 256 + 192 + rr) * 512 + c8 * 8) = (u32x4){0u, 0u, 0u, 0u}; }
        rope_table(p.pos, p.ropeT, b * 512 + tid, G * 512);
        __syncthreads();
        for (int it = b; it < 512; it += G) wfold_item(p.w_peer_q, p.sub_keys, p.WpT, smf, it);
    }
    xcd_barrier(bar);
    REP(1) {
        pg8::Gemm g{p.h, p.WinT, S, INWP, DM}; pg8::StaticOrder so; so.init(S, INWP, G, b);
        pg8::EpiInProj E{p.cq, p.ckv, p.fq, p.fk, p.fv, p.merged, p.kpe, p.lf, p.b_gate, p.b_forget, p.ssq, p.fox_qg, p.fox_kg, (LAS float*)(lds + 131072 + 64)};
        pg8::gemm_phase<pg8::EpiInProj, pg8::StaticOrder, true, true>(lds, g, so, E);
    }
    xcd_barrier(bar);
    for (int hh = b; hh < 16; hh += G) fox_cumsum((double*)smem, hh, p.lf, p.F);
    REP(2) {
        pg8::Gemm g{p.cq, p.WqT, S, 4096, 512}; pg8::StaticOrder so; so.init(S, 4096, G, b);
        pg8::EpiQ E{p.qa, p.ssq, p.mla_qg, p.ropeT, (LAS float*)(lds + 131072 + 64)};
        pg8::gemm_phase<pg8::EpiQ, pg8::StaticOrder, true, true>(lds, g, so, E);
    }
    {
        pg8::Gemm g{p.ckv, p.WkvT, S, 4096, 512}; pg8::StaticOrder so; so.init(S, 4096, G, b);
        pg8::EpiKV E{p.ka, p.va, p.kpe, p.ssq, p.mla_kg, p.ropeT, (LAS float*)(lds + 131072 + 64)};
        pg8::gemm_phase<pg8::EpiKV, pg8::StaticOrder, true, true>(lds, g, so, E);
    }
    xcd_barrier(bar);
    int side_next = 0;
    bool nomax_mla, nomax_fox;
    { const int ln = threadIdx.x & 63;
      float a = 0.f, c = 0.f;
      for (int j = ln; j < 192; j += 64) { a = fmaxf(a, fabsf(p.mla_qg[j])); c = fmaxf(c, fabsf(p.mla_kg[j])); }
      const float bm = 1.02f * 192.f * 0.10411754f * att::wave_max_f(a) * att::wave_max_f(c);
      float e = 0.f, f = 0.f;
      for (int j = ln; j < 128; j += 64) { e = fmaxf(e, fabsf(p.fox_qg[j])); f = fmaxf(f, fabsf(p.fox_kg[j])); }
      const float bf = 1.02f * 128.f * 0.12751743f * att::wave_max_f(e) * att::wave_max_f(f);
      nomax_mla = bm <= 80.f; nomax_fox = bf <= 80.f; }
    REP(3) for (int L = b; L < 1024; L += G) {
        const int i = L >> 8, vc = L & 255, vcx = (vc & 7) * 32 + (vc >> 3), hh = vcx >> 4, x = vcx & 15, qbk = (i & 1) ? x : 31 - x;
        if (i < 2) { if (nomax_mla) att::attn_block<192, false, true>(smem, p.qa + hh * 192, 3072, p.ka + hh * 192, 3072, p.va + hh * 128, 2048, nullptr, p.merged + hh * 128, p.attout + hh * 128, qbk, nullptr, nullptr, p.peer_u, p.peer_v, p.U8, p.V8, side_next); else att::attn_block<192, false, false>(smem, p.qa + hh * 192, 3072, p.ka + hh * 192, 3072, p.va + hh * 128, 2048, nullptr, p.merged + hh * 128, p.attout + hh * 128, qbk, nullptr, nullptr, p.peer_u, p.peer_v, p.U8, p.V8, side_next); }
        else { if (nomax_fox) att::attn_block<128, true, true>(smem, p.fq + hh * 128, 2048, p.fk + hh * 128, 2048, p.fv + hh * 128, 2048, p.F + (size_t)hh * S, p.merged + 2048 + hh * 128, p.attout + 2048 + hh * 128, qbk, p.fox_qg, p.fox_kg, p.peer_u, p.peer_v, p.U8, p.V8, side_next); else att::attn_block<128, true, false>(smem, p.fq + hh * 128, 2048, p.fk + hh * 128, 2048, p.fv + hh * 128, 2048, p.F + (size_t)hh * S, p.merged + 2048 + hh * 128, p.attout + 2048 + hh * 128, qbk, p.fox_qg, p.fox_kg, p.peer_u, p.peer_v, p.U8, p.V8, side_next); }
    }
    if (G == 256) { PHASE_IDS(); (void)wave;
        for (; side_next < 32; ++side_next) { const bool isv = side_next >= 16;
            fp6_cvt_rows(isv ? p.peer_v : p.peer_u, isv ? p.V8 : p.U8, b * 64 + (side_next & 15) * 4, 4, isv ? V_SCALE : U_SCALE, tid, 512); } }
    else { PHASE_IDS(); (void)wave; fp6_cvt_rows(p.peer_u, p.U8, 0, 16384, U_SCALE, b * 512 + tid, G * 512); fp6_cvt_rows(p.peer_v, p.V8, 0, 16384, V_SCALE, b * 512 + tid, G * 512); }
    xcd_barrier(bar);
    REP(4) {
        pg8::Gemm g{p.attout, p.WoT, S, 2048, 4096}; pg8::StaticOrder so; so.init(S, 2048, G, b);
        pg8::EpiX1 E{p.x1, p.x, p.xg, p.ffn_g, p.ssq2};
        pg8::gemm_phase<pg8::EpiX1, pg8::StaticOrder, true, true>(lds, g, so, E);
    }
    xcd_barrier(bar);
    REP(5) {
        pg8::Gemm g{p.xg, p.WpT, S, 2048, 2048}; pg8::StaticOrder so; so.init(S, 2048, G, b);
        pg8::EpiScores E{p.scores, p.ssq2};
        pg8::gemm_phase<pg8::EpiScores, pg8::StaticOrder, true, true>(lds, g, so, E);
    }
    xcd_barrier(bar);
    REP(6) for (int g = b; g < S / 32; g += G) peer_group(smem, g, p.scores, p.xg, p.ssq2, p.x1, p.U8, p.V8, p.out);
}

extern "C" void kernel_launch(void* const* d_in, const int* in_sizes, int n_in,
                              void* d_out, int out_size, void* d_ws, size_t ws_size,
                              hipStream_t stream) {
    if (ws_size < 512 * MiB) { fprintf(stderr, "kernel_launch: workspace too small (%zu)\n", ws_size); return; }
    Params p{};
    p.x = (const float*)d_in[0]; p.pos = (const int*)d_in[1]; p.mix_g = (const float*)d_in[2]; p.w_in = (const float*)d_in[3];
    p.b_forget = (const float*)d_in[4]; p.b_gate = (const float*)d_in[5]; p.q_lat_g = (const float*)d_in[6]; p.w_q_up = (const float*)d_in[7];
    p.kv_lat_g = (const float*)d_in[8]; p.w_kv_up = (const float*)d_in[9]; p.mla_qg = (const float*)d_in[10]; p.mla_kg = (const float*)d_in[11];
    p.fox_qg = (const float*)d_in[12]; p.fox_kg = (const float*)d_in[13]; p.w_out = (const float*)d_in[14]; p.ffn_g = (const float*)d_in[15];
    p.w_peer_q = (const float*)d_in[16]; p.sub_keys = (const float*)d_in[17]; p.peer_u = (const float*)d_in[18]; p.peer_v = (const float*)d_in[19];
    p.out = (float*)d_out;
    char* ws = (char*)d_ws;
    p.WqT = (bf16_t*)(ws + 1 * MiB); p.WkvT = (bf16_t*)(ws + 5 * MiB); p.WoT = (bf16_t*)(ws + 9 * MiB); p.WpT = (bf16_t*)(ws + 25 * MiB); p.WinT = (bf16_t*)(ws + 33 * MiB);
    p.h = (bf16_t*)(ws + 78 * MiB); p.cq = (bf16_t*)(ws + 110 * MiB); p.ckv = (bf16_t*)(ws + 118 * MiB);
    p.fq = (bf16_t*)(ws + 126 * MiB); p.fk = (bf16_t*)(ws + 158 * MiB); p.fv = (bf16_t*)(ws + 190 * MiB); p.merged = (bf16_t*)(ws + 222 * MiB);
    p.kpe = (bf16_t*)(ws + 286 * MiB); p.lf = (float*)(ws + 287 * MiB); p.F = (float*)(ws + 287 * MiB + 512 * 1024);
    p.qa = (bf16_t*)(ws + 288 * MiB); p.va = (bf16_t*)(ws + 336 * MiB); p.ka = (bf16_t*)(ws + 400 * MiB); p.x1 = (float*)(ws + 126 * MiB);
    p.scores = (float*)(ws + 222 * MiB);
    p.ctl = (unsigned*)ws;
    p.ropeT = (float2*)(ws + 448 * MiB);
    p.ssq = (float*)(ws + 64 * 1024);
    p.attout = (bf16_t*)(ws + 33 * MiB);
    p.U8 = (unsigned char*)(ws + 450 * MiB); p.V8 = (unsigned char*)(ws + 368 * MiB);
    p.xg = (bf16_t*)(ws + 190 * MiB);
    p.ssq2 = (float*)(ws + 482 * MiB);

    static int grid_blocks = 0;
    if (!grid_blocks) {
        if (hipFuncSetAttribute((const void*)mega, hipFuncAttributeMaxDynamicSharedMemorySize, LDS_BYTES) != hipSuccess) { fprintf(stderr, "hipFuncSetAttribute failed\n"); return; }
        int dev = 0, cus = 0, per_cu = 0;
        (void)hipGetDevice(&dev);
        (void)hipDeviceGetAttribute(&cus, hipDeviceAttributeMultiprocessorCount, dev);
        (void)hipOccupancyMaxActiveBlocksPerMultiprocessor(&per_cu, (const void*)mega, 512, LDS_BYTES);
        if (per_cu < 1 || cus < 1) { fprintf(stderr, "occupancy query says %d blocks/CU on %d CUs\n", per_cu, cus); return; }
        grid_blocks = cus;
    }
    if (hipMemsetAsync(d_ws, 0, 16384, stream) != hipSuccess) { fprintf(stderr, "memset of the barrier words failed\n"); return; }
    void* args[] = {&p};
    hipError_t e = hipLaunchCooperativeKernel((const void*)mega, dim3(grid_blocks), dim3(512), args, LDS_BYTES, stream);
    if (e != hipSuccess) fprintf(stderr, "cooperative launch failed: %s (grid %d)\n", hipGetErrorString(e), grid_blocks);
}
```

```cpp
#include <hip/hip_runtime.h>
#include <hip/hip_cooperative_groups.h>
#include <stdint.h>
#include <math.h>
#include <cstdio>
namespace cg = cooperative_groups;

namespace pg8 {
#define PG8_LAS __attribute__((address_space(3)))
typedef unsigned short bf16_t;
typedef short bf16x8 __attribute__((ext_vector_type(8)));
typedef float f32x4 __attribute__((ext_vector_type(4)));
typedef unsigned u32x4 __attribute__((ext_vector_type(4)));
constexpr int BM = 256, BK = 64, HALF = 128, HTB = HALF * BK * 2  , STAGE_BYTES = 8 * HTB, NXCD = 8, WGM = 8;

__host__ __device__ __forceinline__ int lds_byte(int r, int c) { const int st = (r >> 4) * 2 + (c >> 5), rr = r & 15, cc = c & 31, ob = rr * 64 + cc * 2; return st * 1024 + (ob ^ (((ob >> 9) & 1) << 5)); }
__host__ __device__ __forceinline__ void stage_rc(int b, int& R, int& C) { const int st = b / 1024, sb = b % 1024, swz = sb ^ (((sb >> 9) & 1) << 5); R = (st >> 1) * 16 + swz / 64; C = (st & 1) * 32 + (swz % 64) / 2; }
__host__ __device__ __forceinline__ int perm32(int rho) { const int n = rho >> 4, i = rho & 15; return 8 * (i >> 2) + 4 * n + (i & 3); }

struct Unit { int pm, pn; };
struct Gemm { const bf16_t* A; const bf16_t* Bt; int M, N, K; };

struct StaticOrder {
    int nM, nN, nwg, G, c;
    __host__ __device__ void init(int M, int N, int G_, int c_) { nM = M / BM; nN = N / BM; nwg = nM * nN; G = G_; c = c_; }
    __host__ __device__ bool next(int i, Unit& u) const {
        const long L = (long)i * G + c; if (L >= nwg) return false;
        int wgid = (int)L; { const int q = nwg / NXCD, r = nwg % NXCD, xcd = wgid % NXCD, off = wgid / NXCD; wgid = (xcd < r ? xcd * (q + 1) : r * (q + 1) + (xcd - r) * q) + off; }
        const int nig = WGM * nN, gid = wgid / nig, fm = gid * WGM, gsz = (nM - fm) < WGM ? (nM - fm) : WGM;
        u.pm = fm + ((wgid % nig) % gsz); u.pn = (wgid % nig) / gsz; return true;
    }
    __device__ __forceinline__ void a_ready(const Unit&) const {}
    __device__ __forceinline__ void done(const Unit&) const {}
};

typedef float cvt_pk_bf16_f32x2 __attribute__((ext_vector_type(2))); typedef __bf16 cvt_pk_bf16_bf16x2 __attribute__((ext_vector_type(2)));
__device__ __forceinline__ unsigned cvt_pk_bf16(float lo, float hi) { const cvt_pk_bf16_f32x2 v = {lo, hi}; const cvt_pk_bf16_bf16x2 b = __builtin_convertvector(v, cvt_pk_bf16_bf16x2); return __builtin_bit_cast(unsigned, b); }
__device__ __forceinline__ u32x4 pack8bf(const f32x4& v0, const f32x4& v1) { u32x4 w; w.x = cvt_pk_bf16(v0[0], v0[1]); w.y = cvt_pk_bf16(v0[2], v0[3]); w.z = cvt_pk_bf16(v1[0], v1[1]); w.w = cvt_pk_bf16(v1[2], v1[3]); return w; }

struct EpiStoreBf16 {
    static constexpr bool PERM = true, AFTER_DRAIN = false;
    bf16_t* O; int ldc;
    __device__ __forceinline__ void operator()(const f32x4 (&acc)[2][2][4][2], const Unit& u, int wr, int wc, int fr, int fq) const {
        const int row0 = u.pm * BM + wr * 64 + fr, col0 = u.pn * BM + wc * 32 + 8 * fq;
#pragma unroll
        for (int ai = 0; ai < 2; ++ai)
#pragma unroll
            for (int m = 0; m < 4; ++m) { bf16_t* rowp = O + (size_t)(row0 + ai * HALF + m * 16) * ldc + col0;
#pragma unroll
                for (int bj = 0; bj < 2; ++bj) *(u32x4*)(rowp + bj * HALF) = pack8bf(acc[ai][bj][m][0], acc[ai][bj][m][1]); }
    }
};
template <bool RES> struct EpiStoreF32 {
    static constexpr bool PERM = true, AFTER_DRAIN = false;
    float* O; const float* res; int ldc;
    __device__ __forceinline__ void operator()(const f32x4 (&acc)[2][2][4][2], const Unit& u, int wr, int wc, int fr, int fq) const {
        const int row0 = u.pm * BM + wr * 64 + fr, col0 = u.pn * BM + wc * 32 + 8 * fq;
#pragma unroll
        for (int ai = 0; ai < 2; ++ai)
#pragma unroll
            for (int m = 0; m < 4; ++m) { const size_t off = (size_t)(row0 + ai * HALF + m * 16) * ldc + col0;
#pragma unroll
                for (int bj = 0; bj < 2; ++bj) { f32x4 v0 = acc[ai][bj][m][0], v1 = acc[ai][bj][m][1];
                    if (RES) { v0 += *(const f32x4*)(res + off + bj * HALF); v1 += *(const f32x4*)(res + off + bj * HALF + 4); }
                    *(f32x4*)(O + off + bj * HALF) = v0; *(f32x4*)(O + off + bj * HALF + 4) = v1; } }
    }
};
#define EPI_LDSBAR() do { asm volatile("s_waitcnt lgkmcnt(0)" ::: "memory"); __builtin_amdgcn_s_barrier(); asm volatile("" ::: "memory"); } while (0)
struct EpiInProj {
    static constexpr bool PERM = true, AFTER_DRAIN = false;
    bf16_t *cq, *ckv, *fq, *fk, *fv, *gates, *kpe; float* lf; const float *b_gate, *b_forget; float* ssq; const float *gfq, *gfk; PG8_LAS float* xs;
    __device__ __forceinline__ void operator()(const f32x4 (&acc)[2][2][4][2], const Unit& u, int wr, int wc, int fr, int fq_) const {
        const int pn = u.pn, row0 = u.pm * BM + wr * 64 + fr, cw = wc * 32 + 8 * fq_;
        if (pn < 4) {
            bf16_t* base = pn < 2 ? cq : ckv; const int colt = (pn & 1) * 256;
#pragma unroll
            for (int ai = 0; ai < 2; ++ai)
#pragma unroll
                for (int m = 0; m < 4; ++m) { const int row = row0 + ai * HALF + m * 16; bf16_t* rowp = base + (size_t)row * 512 + colt + cw; float s = 0.f;
#pragma unroll
                    for (int bj = 0; bj < 2; ++bj) { const f32x4 v0 = acc[ai][bj][m][0], v1 = acc[ai][bj][m][1];
                        s += (v0[0] * v0[0] + v0[1] * v0[1]) + (v0[2] * v0[2] + v0[3] * v0[3]) + (v1[0] * v1[0] + v1[1] * v1[1]) + (v1[2] * v1[2] + v1[3] * v1[3]);
                        *(u32x4*)(rowp + bj * HALF) = pack8bf(v0, v1); }
                    s += __shfl_xor(s, 16); s += __shfl_xor(s, 32);
                    if (fq_ == 0) ssq[((size_t)pn * 8192 + row) * 4 + wc] = s; }
        } else if (pn < 20) {
            const bool isq = pn < 12; bf16_t* base = isq ? fq : fk; const int colt = (pn - (isq ? 4 : 12)) * 256; const float* g = isq ? gfq : gfk;
            const float qs = isq ? 0.12751743f : 1.f;
#pragma unroll
            for (int ai = 0; ai < 2; ++ai)
#pragma unroll
                for (int m = 0; m < 4; ++m)
#pragma unroll
                    for (int bj = 0; bj < 2; ++bj) { const f32x4 v0 = acc[ai][bj][m][0], v1 = acc[ai][bj][m][1];
                        float s = (v0[0] * v0[0] + v0[1] * v0[1]) + (v0[2] * v0[2] + v0[3] * v0[3]) + (v1[0] * v1[0] + v1[1] * v1[1]) + (v1[2] * v1[2] + v1[3] * v1[3]);
                        s += __shfl_xor(s, 16); s += __shfl_xor(s, 32);
                        if (fq_ == 0) xs[((ai * HALF + wr * 64 + m * 16 + fr) * 2 + bj) * 4 + wc] = s; }
            EPI_LDSBAR();
            const f32x4 g0 = *(const f32x4*)(g + cw) * qs, g1 = *(const f32x4*)(g + cw + 4) * qs;
#pragma unroll
            for (int ai = 0; ai < 2; ++ai)
#pragma unroll
                for (int m = 0; m < 4; ++m) { bf16_t* rowp = base + (size_t)(row0 + ai * HALF + m * 16) * 2048 + colt + cw;
#pragma unroll
                    for (int bj = 0; bj < 2; ++bj) { const f32x4 t4 = *(const PG8_LAS f32x4*)(xs + ((ai * HALF + wr * 64 + m * 16 + fr) * 2 + bj) * 4);
                        const float r = rsqrtf(((t4[0] + t4[1]) + (t4[2] + t4[3])) * (1.f / 128.f) + 1e-6f);
                        *(u32x4*)(rowp + bj * HALF) = pack8bf(acc[ai][bj][m][0] * g0 * r, acc[ai][bj][m][1] * g1 * r); } }
        } else if (pn < 28) {
            const int colt = (pn - 20) * 256;
#pragma unroll
            for (int ai = 0; ai < 2; ++ai)
#pragma unroll
                for (int m = 0; m < 4; ++m) { bf16_t* rowp = fv + (size_t)(row0 + ai * HALF + m * 16) * 2048 + colt + cw;
#pragma unroll
                    for (int bj = 0; bj < 2; ++bj) *(u32x4*)(rowp + bj * HALF) = pack8bf(acc[ai][bj][m][0], acc[ai][bj][m][1]); }
        } else if (pn < 44) {
            const int colt = (pn - 28) * 256 + cw;
#pragma unroll
            for (int bj = 0; bj < 2; ++bj) {
                const f32x4 b0 = *(const f32x4*)(b_gate + colt + bj * HALF), b1 = *(const f32x4*)(b_gate + colt + bj * HALF + 4);
#pragma unroll
                for (int ai = 0; ai < 2; ++ai)
#pragma unroll
                    for (int m = 0; m < 4; ++m) {
                        f32x4 v0 = acc[ai][bj][m][0] + b0, v1 = acc[ai][bj][m][1] + b1;
#pragma unroll
                        for (int e = 0; e < 4; ++e) { v0[e] = __builtin_amdgcn_rcpf(1.f + __expf(-v0[e])); v1[e] = __builtin_amdgcn_rcpf(1.f + __expf(-v1[e])); }
                        *(u32x4*)(gates + (size_t)(row0 + ai * HALF + m * 16) * 4096 + colt + bj * HALF) = pack8bf(v0, v1); }
            }
        } else {
            if (cw < 64) {
#pragma unroll
                for (int ai = 0; ai < 2; ++ai)
#pragma unroll
                    for (int m = 0; m < 4; ++m) *(u32x4*)(kpe + (size_t)(row0 + ai * HALF + m * 16) * 64 + cw) = pack8bf(acc[ai][0][m][0], acc[ai][0][m][1]);
            } else if (cw < 80) {
                const int h0 = cw - 64;
                const f32x4 b0 = *(const f32x4*)(b_forget + h0), b1 = *(const f32x4*)(b_forget + h0 + 4);
#pragma unroll
                for (int ai = 0; ai < 2; ++ai)
#pragma unroll
                    for (int m = 0; m < 4; ++m) { const int row = row0 + ai * HALF + m * 16;
                        f32x4 z0 = acc[ai][0][m][0] + b0, z1 = acc[ai][0][m][1] + b1;
#pragma unroll
                        for (int e = 0; e < 4; ++e) { z0[e] = fminf(z0[e], 0.f) - __logf(1.f + __expf(-fabsf(z0[e]))); z1[e] = fminf(z1[e], 0.f) - __logf(1.f + __expf(-fabsf(z1[e]))); }
                        *(f32x4*)(lf + (size_t)row * 16 + h0) = z0; *(f32x4*)(lf + (size_t)row * 16 + h0 + 4) = z1; }
            }
        }
    }
};
__device__ __forceinline__ float lat_rinv(const float* ssq, int part0, int row) {
    const f32x4 a = *(const f32x4*)(ssq + ((size_t)part0 * 8192 + row) * 4), b = *(const f32x4*)(ssq + ((size_t)(part0 + 1) * 8192 + row) * 4);
    return rsqrtf((((a[0] + a[1]) + (a[2] + a[3])) + ((b[0] + b[1]) + (b[2] + b[3]))) * (1.f / 512.f) + 1e-6f);
}
struct EpiQ {
    static constexpr bool PERM = true, AFTER_DRAIN = false;
    bf16_t* qa; const float* ssq; const float* gq; const float2* ropeT; PG8_LAS float* xs;
    __device__ __forceinline__ void operator()(const f32x4 (&acc)[2][2][4][2], const Unit& u, int wr, int wc, int fr, int fq_) const {
        const int h = u.pn, row0 = u.pm * BM + wr * 64 + fr, cw = wc * 32 + 8 * fq_;
        float rl[2][4];
#pragma unroll
        for (int ai = 0; ai < 2; ++ai)
#pragma unroll
            for (int m = 0; m < 4; ++m) { rl[ai][m] = lat_rinv(ssq, 0, row0 + ai * HALF + m * 16); float s = 0.f;
#pragma unroll
                for (int bj = 0; bj < 2; ++bj) { const f32x4 v0 = acc[ai][bj][m][0], v1 = acc[ai][bj][m][1];
                    s += (v0[0] * v0[0] + v0[1] * v0[1]) + (v0[2] * v0[2] + v0[3] * v0[3]) + (v1[0] * v1[0] + v1[1] * v1[1]) + (v1[2] * v1[2] + v1[3] * v1[3]); }
                s *= rl[ai][m] * rl[ai][m];
                s += __shfl_xor(s, 16); s += __shfl_xor(s, 32);
                if (fq_ == 0) xs[(ai * HALF + wr * 64 + m * 16 + fr) * 4 + wc] = s; }
        EPI_LDSBAR();
        const float qs = 0.10411754f;
        const f32x4 g0 = *(const f32x4*)(gq + cw) * qs, g1 = *(const f32x4*)(gq + cw + 4) * qs;
        const int pp = 16 * (wc & 1) + 4 * fq_;
        const f32x4 ga = *(const f32x4*)(gq + 128 + pp) * qs, gb = *(const f32x4*)(gq + 160 + pp) * qs;
#pragma unroll
        for (int ai = 0; ai < 2; ++ai)
#pragma unroll
            for (int m = 0; m < 4; ++m) { const int row = row0 + ai * HALF + m * 16;
                const f32x4 t4 = *(const PG8_LAS f32x4*)(xs + (ai * HALF + wr * 64 + m * 16 + fr) * 4);
                const float r = rsqrtf(((t4[0] + t4[1]) + (t4[2] + t4[3])) * (1.f / 192.f) + 1e-6f) * rl[ai][m];
                bf16_t* rowp = qa + (size_t)row * 3072 + h * 192;
                *(u32x4*)(rowp + cw) = pack8bf(acc[ai][0][m][0] * g0 * r, acc[ai][0][m][1] * g1 * r);
                if (wc < 2) { const f32x4 c01 = *(const f32x4*)(ropeT + (size_t)row * 32 + pp), c23 = *(const f32x4*)(ropeT + (size_t)row * 32 + pp + 2);
                    const f32x4 z0 = acc[ai][1][m][0] * r, z1 = acc[ai][1][m][1] * r;
                    const float a0 = z0[0] * ga[0], b0 = z0[1] * gb[0], a1 = z0[2] * ga[1], b1 = z0[3] * gb[1], a2 = z1[0] * ga[2], b2 = z1[1] * gb[2], a3 = z1[2] * ga[3], b3 = z1[3] * gb[3];
                    const f32x4 o0 = {a0 * c01[0] - b0 * c01[1], a0 * c01[1] + b0 * c01[0], a1 * c01[2] - b1 * c01[3], a1 * c01[3] + b1 * c01[2]};
                    const f32x4 o1 = {a2 * c23[0] - b2 * c23[1], a2 * c23[1] + b2 * c23[0], a3 * c23[2] - b3 * c23[3], a3 * c23[3] + b3 * c23[2]};
                    *(u32x4*)(rowp + 128 + cw) = pack8bf(o0, o1); } }
    }
};
struct EpiKV {
    static constexpr bool PERM = true, AFTER_DRAIN = false;
    bf16_t *ka, *va; const bf16_t* kpe; const float* ssq; const float* gk; const float2* ropeT; PG8_LAS float* xs;
    __device__ __forceinline__ void operator()(const f32x4 (&acc)[2][2][4][2], const Unit& u, int wr, int wc, int fr, int fq_) const {
        const int h = u.pn, row0 = u.pm * BM + wr * 64 + fr, cw = wc * 32 + 8 * fq_;
        float rl[2][4]; f32x4 kp[2][4];
#pragma unroll
        for (int ai = 0; ai < 2; ++ai)
#pragma unroll
            for (int m = 0; m < 4; ++m) { const int row = row0 + ai * HALF + m * 16; rl[ai][m] = lat_rinv(ssq, 2, row);
                const uint2 w = *(const uint2*)(kpe + (size_t)row * 64 + 16 * wc + 4 * fq_);
                kp[ai][m] = (f32x4){__uint_as_float(w.x << 16), __uint_as_float(w.x & 0xffff0000u), __uint_as_float(w.y << 16), __uint_as_float(w.y & 0xffff0000u)};
                const f32x4 v0 = acc[ai][0][m][0], v1 = acc[ai][0][m][1];
                float s = ((v0[0] * v0[0] + v0[1] * v0[1]) + (v0[2] * v0[2] + v0[3] * v0[3]) + (v1[0] * v1[0] + v1[1] * v1[1]) + (v1[2] * v1[2] + v1[3] * v1[3])) * (rl[ai][m] * rl[ai][m]);
                s += (kp[ai][m][0] * kp[ai][m][0] + kp[ai][m][1] * kp[ai][m][1]) + (kp[ai][m][2] * kp[ai][m][2] + kp[ai][m][3] * kp[ai][m][3]);
                s += __shfl_xor(s, 16); s += __shfl_xor(s, 32);
                if (fq_ == 0) xs[(ai * HALF + wr * 64 + m * 16 + fr) * 4 + wc] = s;
                *(u32x4*)(va + (size_t)row * 2048 + h * 128 + cw) = pack8bf(acc[ai][1][m][0] * rl[ai][m], acc[ai][1][m][1] * rl[ai][m]); }
        EPI_LDSBAR();
        const f32x4 g0 = *(const f32x4*)(gk + cw), g1 = *(const f32x4*)(gk + cw + 4);
        const int pp = 8 * wc + 2 * fq_;
        const float ga0 = gk[128 + pp], ga1 = gk[128 + pp + 1], gb0 = gk[160 + pp], gb1 = gk[160 + pp + 1];
#pragma unroll
        for (int ai = 0; ai < 2; ++ai)
#pragma unroll
            for (int m = 0; m < 4; ++m) { const int row = row0 + ai * HALF + m * 16;
                const f32x4 t4 = *(const PG8_LAS f32x4*)(xs + (ai * HALF + wr * 64 + m * 16 + fr) * 4);
                const float r = rsqrtf(((t4[0] + t4[1]) + (t4[2] + t4[3])) * (1.f / 192.f) + 1e-6f), rn = r * rl[ai][m];
                bf16_t* rowp = ka + (size_t)row * 3072 + h * 192;
                *(u32x4*)(rowp + cw) = pack8bf(acc[ai][0][m][0] * g0 * rn, acc[ai][0][m][1] * g1 * rn);
                const f32x4 cs = *(const f32x4*)(ropeT + (size_t)row * 32 + pp);
                const float a0 = kp[ai][m][0] * r * ga0, b0 = kp[ai][m][1] * r * gb0, a1 = kp[ai][m][2] * r * ga1, b1 = kp[ai][m][3] * r * gb1;
                uint2 o; o.x = cvt_pk_bf16(a0 * cs[0] - b0 * cs[1], a0 * cs[1] + b0 * cs[0]); o.y = cvt_pk_bf16(a1 * cs[2] - b1 * cs[3], a1 * cs[3] + b1 * cs[2]);
                *(uint2*)(rowp + 128 + 16 * wc + 4 * fq_) = o; }
    }
};

struct EpiX1 {
    static constexpr bool PERM = true, AFTER_DRAIN = false;
    float* x1; const float* x; bf16_t* xg; const float* g; float* ssq2;
    __device__ __forceinline__ void operator()(const f32x4 (&acc)[2][2][4][2], const Unit& u, int wr, int wc, int fr, int fq_) const {
        const int row0 = u.pm * BM + wr * 64 + fr, col0 = u.pn * BM + wc * 32 + 8 * fq_;
        f32x4 gg[2][2];
#pragma unroll
        for (int bj = 0; bj < 2; ++bj) { gg[bj][0] = *(const f32x4*)(g + col0 + bj * HALF); gg[bj][1] = *(const f32x4*)(g + col0 + bj * HALF + 4); }
#pragma unroll
        for (int ai = 0; ai < 2; ++ai)
#pragma unroll
            for (int m = 0; m < 4; ++m) { const int row = row0 + ai * HALF + m * 16; const size_t off = (size_t)row * 2048 + col0; float s = 0.f;
#pragma unroll
                for (int bj = 0; bj < 2; ++bj) { const f32x4 v0 = acc[ai][bj][m][0] + *(const f32x4*)(x + off + bj * HALF), v1 = acc[ai][bj][m][1] + *(const f32x4*)(x + off + bj * HALF + 4);
                    *(f32x4*)(x1 + off + bj * HALF) = v0; *(f32x4*)(x1 + off + bj * HALF + 4) = v1;
                    s += (v0[0] * v0[0] + v0[1] * v0[1]) + (v0[2] * v0[2] + v0[3] * v0[3]) + (v1[0] * v1[0] + v1[1] * v1[1]) + (v1[2] * v1[2] + v1[3] * v1[3]);
                    *(u32x4*)(xg + off + bj * HALF) = pack8bf(v0 * gg[bj][0], v1 * gg[bj][1]); }
                s += __shfl_xor(s, 16); s += __shfl_xor(s, 32);
                if (fq_ == 0) ssq2[((size_t)u.pn * 8192 + row) * 4 + wc] = s; }
    }
};
__device__ __forceinline__ float ffn_rinv(const float* ssq2, int row) {
    float t = 0.f;
#pragma unroll
    for (int pn = 0; pn < 8; ++pn) { const f32x4 a = *(const f32x4*)(ssq2 + ((size_t)pn * 8192 + row) * 4); t += (a[0] + a[1]) + (a[2] + a[3]); }
    return rsqrtf(t * (1.f / 2048.f) + 1e-6f);
}
struct EpiScores {
    static constexpr bool PERM = true, AFTER_DRAIN = false;
    float* O; const float* ssq2;
    __device__ __forceinline__ void operator()(const f32x4 (&acc)[2][2][4][2], const Unit& u, int wr, int wc, int fr, int fq_) const {
        const int row0 = u.pm * BM + wr * 64 + fr, col0 = u.pn * BM + wc * 32 + 8 * fq_;
#pragma unroll
        for (int ai = 0; ai < 2; ++ai)
#pragma unroll
            for (int m = 0; m < 4; ++m) { const int row = row0 + ai * HALF + m * 16; const float r = ffn_rinv(ssq2, row); const size_t off = (size_t)row * 2048 + col0;
#pragma unroll
                for (int bj = 0; bj < 2; ++bj) { *(f32x4*)(O + off + bj * HALF) = acc[ai][bj][m][0] * r; *(f32x4*)(O + off + bj * HALF + 4) = acc[ai][bj][m][1] * r; } }
    }
};
template <class Epi, class Sched, bool ALIGN_EPI = false, bool SP2 = false>
__device__ __forceinline__ void gemm_phase(PG8_LAS unsigned char* lds, const Gemm g, const Sched& S, const Epi& E) {
    int tid = threadIdx.x; asm volatile("" : "+v"(tid));
    const int wid = __builtin_amdgcn_readfirstlane(tid >> 6), lane = tid & 63, wr = wid >> 2, wc = wid & 3, fr = lane & 15, fq = lane >> 4;
    const int K = g.K, nt = K / BK;
    unsigned voffA[2], voffB[2];
#pragma unroll
    for (int i = 0; i < 2; ++i) { int R, C; stage_rc(tid * 16 + i * 8192, R, C); const int Rb = Epi::PERM ? ((R & ~31) + perm32(R & 31)) : R;
        voffA[i] = (unsigned)(R * K + C) * 2u; voffB[i] = (unsigned)(Rb * K + C) * 2u; }
    const size_t kstep = (size_t)(BK * 2);
    const size_t hstep = (size_t)HALF * K * 2;
    const size_t tstep = 2 * hstep;
    const unsigned ldsw = (unsigned)wid * 1024u;
    const int aoff = lds_byte(wr * 64 + fr, fq * 8), boff = lds_byte(wc * 32 + fr, fq * 8);
#define PG8_SA(b, h) (((b) * 2 + (h)) * HTB)
#define PG8_SB(b, h) ((4 + (b) * 2 + (h)) * HTB)
#define PG8_STAGE(bufoff, gbase, voff) do { _Pragma("unroll") for (int _i = 0; _i < 2; ++_i) \
        __builtin_amdgcn_global_load_lds((const unsigned*)((const char*)(gbase) + (voff)[_i]), (PG8_LAS unsigned*)(lds + (bufoff) + ldsw + _i * 8192), 16, 0, 0); } while (0)
#define PG8_LDA(dst, b, h) do { _Pragma("unroll") for (int m = 0; m < 4; ++m) _Pragma("unroll") for (int k = 0; k < 2; ++k) dst[m][k] = *(const PG8_LAS bf16x8*)(lds + PG8_SA(b, h) + aoff + m * 2048 + k * 1024); } while (0)
#define PG8_LDB(dst, b, h) do { _Pragma("unroll") for (int n = 0; n < 2; ++n) _Pragma("unroll") for (int k = 0; k < 2; ++k) dst[n][k] = *(const PG8_LAS bf16x8*)(lds + PG8_SB(b, h) + boff + n * 2048 + k * 1024); } while (0)
#define PG8_MMA(ai, bj, At, Bt) do { __builtin_amdgcn_s_setprio(1); _Pragma("unroll") for (int m = 0; m < 4; ++m) _Pragma("unroll") for (int n = 0; n < 2; ++n) _Pragma("unroll") for (int k = 0; k < 2; ++k) \
        acc[ai][bj][m][n] = __builtin_amdgcn_mfma_f32_16x16x32_bf16(Bt[n][k], At[m][k], acc[ai][bj][m][n], 0, 0, 0); __builtin_amdgcn_s_setprio(0); } while (0)
#define PG8_WAIT_V(n) asm volatile("s_waitcnt vmcnt(" #n ")" ::: "memory")
#define PG8_WAIT_L(n) asm volatile("s_waitcnt lgkmcnt(" #n ")" ::: "memory")
#define PG8_BAR __builtin_amdgcn_s_barrier()
#define PG8_SCHED __builtin_amdgcn_sched_barrier(0)
    Unit cur, nxt; int ui = 0;
    if (!S.next(0, cur)) return;
    f32x4 acc[2][2][4][2];
#pragma unroll
    for (int a = 0; a < 2; ++a)
#pragma unroll
        for (int b = 0; b < 2; ++b)
#pragma unroll
            for (int m = 0; m < 4; ++m)
#pragma unroll
                for (int n = 0; n < 2; ++n) acc[a][b][m][n] = (f32x4){0.f, 0.f, 0.f, 0.f};
    bf16x8 At[4][2], B0[2][2], B1[2][2];
    const char* cA = (const char*)g.A + (size_t)cur.pm * tstep; const char* cB = (const char*)g.Bt + (size_t)cur.pn * tstep;
    S.a_ready(cur);
    if constexpr (SP2) {
        PG8_STAGE(PG8_SB(0, 0), cB, voffB); PG8_STAGE(PG8_SB(0, 1), cB + hstep, voffB); PG8_STAGE(PG8_SA(0, 0), cA, voffA); PG8_STAGE(PG8_SA(0, 1), cA + hstep, voffA);
        if (wr == 1) PG8_BAR;
        PG8_WAIT_V(2); PG8_BAR;
        PG8_STAGE(PG8_SB(1, 0), cB + kstep, voffB); PG8_STAGE(PG8_SA(1, 0), cA + kstep, voffA); PG8_STAGE(PG8_SB(1, 1), cB + hstep + kstep, voffB);
        PG8_WAIT_V(6); PG8_BAR;
    } else {
        PG8_STAGE(PG8_SB(0, 0), cB, voffB); PG8_STAGE(PG8_SA(0, 0), cA, voffA); PG8_STAGE(PG8_SB(0, 1), cB + hstep, voffB); PG8_STAGE(PG8_SA(0, 1), cA + hstep, voffA);
        if (wr == 1) PG8_BAR;
        PG8_WAIT_V(4); PG8_BAR;
        PG8_STAGE(PG8_SB(1, 0), cB + kstep, voffB); PG8_STAGE(PG8_SA(1, 0), cA + kstep, voffA); PG8_STAGE(PG8_SB(1, 1), cB + hstep + kstep, voffB);
        PG8_WAIT_V(6); PG8_BAR;
    }
    for (;;) {
        const bool has_next = S.next(ui + 1, nxt);
        const char* nA = has_next ? (const char*)g.A + (size_t)nxt.pm * tstep : cA; const char* nB = has_next ? (const char*)g.Bt + (size_t)nxt.pn * tstep : cB;
        for (int t = 0; t < nt; t += 2) {
            const bool last = (t == nt - 2);
            const char* a1 = cA + (size_t)(t + 1) * kstep;
            const char* a2 = last ? nA : cA + (size_t)(t + 2) * kstep; const char* b2 = last ? nB : cB + (size_t)(t + 2) * kstep;
            const char* a3 = a2 + kstep; const char* b3 = b2 + kstep;
            if (last && has_next) S.a_ready(nxt);
            if constexpr (SP2) {
            PG8_LDB(B0, 0, 0); PG8_LDB(B1, 0, 1); PG8_SCHED; PG8_LDA(At, 0, 0); PG8_STAGE(PG8_SA(1, 1), a1 + hstep, voffA);
            PG8_WAIT_V(8); PG8_WAIT_L(0); PG8_BAR; PG8_MMA(0, 0, At, B0); PG8_MMA(0, 1, At, B1); PG8_BAR; PG8_SCHED;
            PG8_LDA(At, 0, 1); PG8_STAGE(PG8_SB(0, 0), b2, voffB); PG8_STAGE(PG8_SB(0, 1), b2 + hstep, voffB); PG8_STAGE(PG8_SA(0, 0), a2, voffA);
            PG8_WAIT_V(8); PG8_WAIT_L(0); PG8_BAR; PG8_MMA(1, 0, At, B0); PG8_MMA(1, 1, At, B1); PG8_BAR; PG8_SCHED;
            PG8_LDB(B0, 1, 0); PG8_LDB(B1, 1, 1); PG8_SCHED; PG8_LDA(At, 1, 0); PG8_STAGE(PG8_SA(0, 1), a2 + hstep, voffA);
            PG8_WAIT_V(8); PG8_WAIT_L(0); PG8_BAR; PG8_MMA(0, 0, At, B0); PG8_MMA(0, 1, At, B1); PG8_BAR; PG8_SCHED;
            PG8_LDA(At, 1, 1); PG8_STAGE(PG8_SB(1, 0), b3, voffB); PG8_STAGE(PG8_SB(1, 1), b3 + hstep, voffB); PG8_STAGE(PG8_SA(1, 0), a3, voffA);
            PG8_WAIT_V(8); PG8_WAIT_L(0); PG8_BAR; PG8_MMA(1, 0, At, B0); PG8_MMA(1, 1, At, B1); PG8_BAR; PG8_SCHED;
            } else {
            PG8_LDB(B0, 0, 0); PG8_SCHED; PG8_LDA(At, 0, 0); PG8_STAGE(PG8_SA(1, 1), a1 + hstep, voffA);
            PG8_WAIT_L(8); PG8_BAR; PG8_WAIT_L(0); PG8_MMA(0, 0, At, B0); PG8_BAR; PG8_SCHED;
            PG8_LDB(B1, 0, 1); PG8_STAGE(PG8_SB(0, 0), b2, voffB);
            PG8_BAR; PG8_WAIT_L(0); PG8_MMA(0, 1, At, B1); PG8_BAR;
            PG8_LDA(At, 0, 1); PG8_STAGE(PG8_SA(0, 0), a2, voffA);
            PG8_BAR; PG8_WAIT_L(0); PG8_MMA(1, 0, At, B0); PG8_BAR; PG8_SCHED;
            PG8_STAGE(PG8_SB(0, 1), b2 + hstep, voffB);
            PG8_WAIT_V(6); PG8_BAR; PG8_MMA(1, 1, At, B1); PG8_BAR;
            PG8_LDB(B0, 1, 0); PG8_SCHED; PG8_LDA(At, 1, 0); PG8_STAGE(PG8_SA(0, 1), a2 + hstep, voffA);
            PG8_WAIT_L(8); PG8_BAR; PG8_WAIT_L(0); PG8_MMA(0, 0, At, B0); PG8_BAR; PG8_SCHED;
            PG8_LDB(B1, 1, 1); PG8_STAGE(PG8_SB(1, 0), b3, voffB);
            PG8_BAR; PG8_WAIT_L(0); PG8_MMA(0, 1, At, B1); PG8_BAR;
            PG8_LDA(At, 1, 1); PG8_STAGE(PG8_SA(1, 0), a3, voffA);
            PG8_BAR; PG8_WAIT_L(0); PG8_MMA(1, 0, At, B0); PG8_BAR; PG8_SCHED;
            PG8_STAGE(PG8_SB(1, 1), b3 + hstep, voffB);
            PG8_WAIT_V(6); PG8_BAR; PG8_MMA(1, 1, At, B1); PG8_BAR;
            }
        }
        if constexpr (ALIGN_EPI) { if (wr == 0) PG8_BAR; }
        if constexpr (!Epi::AFTER_DRAIN) { E(acc, cur, wr, wc, fr, fq); S.done(cur); }
        if (!has_next) break;
#pragma unroll
        for (int a = 0; a < 2; ++a)
#pragma unroll
            for (int b = 0; b < 2; ++b)
#pragma unroll
                for (int m = 0; m < 4; ++m)
#pragma unroll
                    for (int n = 0; n < 2; ++n) acc[a][b][m][n] = (f32x4){0.f, 0.f, 0.f, 0.f};
        cur = nxt; cA = nA; cB = nB; ++ui;
        if constexpr (ALIGN_EPI) { if (wr == 1) PG8_BAR; }
    }
    PG8_WAIT_V(0);
    if constexpr (!ALIGN_EPI) { if (wr == 0) PG8_BAR; }
    PG8_BAR;
    if constexpr (Epi::AFTER_DRAIN) { E.fused(acc, cur, wr, wc, fr, fq, lds, wid, lane); S.done(cur); }
#undef PG8_SA
#undef PG8_SB
#undef PG8_STAGE
#undef PG8_LDA
#undef PG8_LDB
#undef PG8_MMA
#undef PG8_WAIT_V
#undef PG8_WAIT_L
#undef PG8_BAR
#undef PG8_SCHED
}
}
namespace att {
typedef unsigned short bf16_t;
typedef short bf16x8 __attribute__((ext_vector_type(8)));
typedef short s16x4 __attribute__((ext_vector_type(4)));
typedef float f32x16 __attribute__((ext_vector_type(16)));
typedef float f32x4 __attribute__((ext_vector_type(4)));
typedef unsigned u32x4 __attribute__((ext_vector_type(4)));
#define ALAS __attribute__((address_space(3)))
#define ASBAR() __builtin_amdgcn_sched_barrier(0)
constexpr int SHM_V = 16384;
template <int DK> struct Lay { static constexpr int ROWB = DK * 2, SHM_K = 64 * ROWB, OFF_K = 2 * SHM_V, OFF_F = OFF_K + 2 * SHM_K, OFF_WS = OFF_F + 512, TOTAL = OFF_WS + 8 * 256; };

__device__ __forceinline__ int v_st(int k, int c) { const int kk = (k & ~0xC) | ((k & 4) << 1) | ((k & 8) >> 1); return ((kk >> 3) * 4 + (c >> 5)) * 512 + ((kk & 7) * 32 + (c & 31)) * 2; }
__device__ __forceinline__ int v_rd_base(int lane) { return ((lane & 3) << 3) | (((lane >> 2) & 3) << 6) | (((lane >> 4) & 1) << 5) | (((lane >> 5) & 1) << 8); }
__device__ __forceinline__ int crow(int r, int hi) { return (r & 3) + 8 * (r >> 2) + 4 * hi; }
typedef float cvtpk_f32x2 __attribute__((ext_vector_type(2))); typedef __bf16 cvtpk_bf16x2 __attribute__((ext_vector_type(2)));
__device__ __forceinline__ unsigned cvtpk(float lo, float hi) { const cvtpk_f32x2 v = {lo, hi}; const cvtpk_bf16x2 b = __builtin_convertvector(v, cvtpk_bf16x2); return __builtin_bit_cast(unsigned, b); }

__device__ __forceinline__ float wave_max_f(float v) {
#pragma unroll
    for (int o = 32; o >= 1; o >>= 1) v = fmaxf(v, __shfl_xor(v, o));
    return v;
}
__device__ __forceinline__ float att_max3(float a, float b, float c) { return __builtin_fmaxf(__builtin_fmaxf(a, b), c); }
typedef float f32x16v __attribute__((ext_vector_type(16)));
typedef unsigned u32x6v __attribute__((ext_vector_type(6)));
constexpr int ROW6 = 1536;
__device__ __forceinline__ void fp6_put(unsigned char* __restrict__ T6, int row, int hf, int l, int g, f32x16v f0, f32x16v f1, float sc) {
    f0 *= sc; f1 *= sc;
    f32x16v ev, od;
#pragma unroll
    for (int k = 0; k < 8; ++k) { ev[k] = f0[2 * k]; od[k] = f0[2 * k + 1]; ev[8 + k] = f1[2 * k]; od[8 + k] = f1[2 * k + 1]; }
    const u32x6v w = __builtin_amdgcn_cvt_scalef32_2xpk16_fp6_f32(ev, od, 1.0f);
    unsigned char* base = T6 + (size_t)row * ROW6 + hf * 768 + l * 16;
    if (g == 0) { *(u32x4*)base = (u32x4){w[0], w[1], w[2], w[3]}; *(uint2*)(base + 256) = make_uint2(w[4], w[5]); }
    else { *(uint2*)(base + 264) = make_uint2(w[0], w[1]); *(u32x4*)(base + 512) = (u32x4){w[2], w[3], w[4], w[5]}; }
}
constexpr int SIDE_STG = 86016;
template <int DK, bool FOX, bool NOMAX>
__device__ __forceinline__ void attn_block(unsigned char* smem, const bf16_t* __restrict__ Q, int ldq, const bf16_t* __restrict__ K, int ldk, const bf16_t* __restrict__ V, int ldv,
                                           const float* __restrict__ Fh, const bf16_t* __restrict__ gate, bf16_t* __restrict__ gout  , int qbk, const float* __restrict__ gq, const float* __restrict__ gk  ,
                                           const float* __restrict__ side_u, const float* __restrict__ side_v, unsigned char* __restrict__ side_u8, unsigned char* __restrict__ side_v8, int& side_next) {
    typedef Lay<DK> LY;
    constexpr int ND = DK / 16, NKC = DK / 8, NKI = (64 * NKC) / 512;
    int tid = threadIdx.x; asm volatile("" : "+v"(tid));
    const int wid = __builtin_amdgcn_readfirstlane(tid >> 6), lane = tid & 63, r32 = lane & 31, hi = lane >> 5;
    const int q0 = qbk * 256, qlo = q0 + wid * 32, qm = qlo + r32 - 4 * hi;
    const int NT = 4 * qbk + 4;
    ALAS unsigned char* lds = (ALAS unsigned char*)smem;
    ALAS float* F_lds = (ALAS float*)(lds + LY::OFF_F);
    ALAS float* wsl = (ALAS float*)(lds + LY::OFF_WS) + wid * 64;
    bf16x8 qr[ND];
#pragma unroll
    for (int d0 = 0; d0 < ND; ++d0) qr[d0] = *(const bf16x8*)(Q + (size_t)(qlo + r32) * ldq + d0 * 16 + hi * 8);
    const float fq = FOX ? Fh[qlo + r32] : 0.f;
    int kgo[NKI], vgo[2];
#pragma unroll
    for (int i = 0; i < NKI; ++i) { const int pp = (wid * NKI + i) * 64 + lane, row = pp / NKC, cpos = pp % NKC, ch = cpos ^ ((row >> 1) & 7); kgo[i] = row * ldk + ch * 8; }
#pragma unroll
    for (int i = 0; i < 2; ++i) { const int o = ((wid * 2 + i) * 64 + lane) * 16, st = o >> 9, e = (o & 511) >> 1, kk = (st >> 2) * 8 + (e >> 5), c = (st & 3) * 32 + (e & 31);
        const int k = (kk & ~0xC) | ((kk & 4) << 1) | ((kk & 8) >> 1); vgo[i] = k * ldv + c; }
    const int vb0 = (int)(uintptr_t)smem + v_rd_base(lane);
    int kbase[4];
#pragma unroll
    for (int dd = 0; dd < 4; ++dd) kbase[dd] = LY::OFF_K + r32 * LY::ROWB + (((((dd << 1) | hi) ^ ((r32 >> 1) & 7))) << 4);
    float stf = 0.f;
#define ATT_GLDS(kb, bf) do { _Pragma("unroll") for (int i = 0; i < NKI; ++i) \
            __builtin_amdgcn_global_load_lds((const unsigned*)(K + (size_t)(kb) * ldk + kgo[i]), (ALAS unsigned*)(lds + LY::OFF_K + (bf) * LY::SHM_K + (wid * NKI + i) * 1024), 16, 0, 0); \
        _Pragma("unroll") for (int i = 0; i < 2; ++i) \
            __builtin_amdgcn_global_load_lds((const unsigned*)(V + (size_t)(kb) * ldv + vgo[i]), (ALAS unsigned*)(lds + (bf) * SHM_V + (wid * 2 + i) * 1024), 16, 0, 0); \
        if (FOX && tid < 64) stf = Fh[(kb) + tid]; } while (0)
#define ATT_WRITEF(bf) do { if (FOX && tid < 64) F_lds[(bf) * 64 + tid] = stf; } while (0)
    int t_start = 0; float m_init = 0.f;
    if (FOX) {
        const float gqm = wave_max_f(fmaxf(fabsf(gq[lane]), fabsf(gq[lane + 64]))), gkm = wave_max_f(fmaxf(fabsf(gk[lane]), fabsf(gk[lane + 64])));
        const float qk_bound = 0.12751743f * 128.f * gqm * gkm;
        const float thr = 2.02f * qk_bound + 40.f, f0 = Fh[q0]; m_init = -thr;
        const int j0 = lane, j1 = lane + 64;
        const bool c0 = (j0 < 4 * qbk) && (Fh[j0 * 64 + 63] - f0 >= thr), c1 = (j1 < 4 * qbk) && (Fh[(j1 < 4 * qbk ? j1 : 0) * 64 + 63] - f0 >= thr);
        t_start = __builtin_popcountll(__ballot(c0)) + __builtin_popcountll(__ballot(c1));
        t_start = __builtin_amdgcn_readfirstlane(t_start); }
    ATT_GLDS(t_start * 64, t_start & 1); ATT_WRITEF(t_start & 1);
    float m_reg = FOX ? m_init : 0.f, l_reg = 0.f; f32x16 o[4];
#pragma unroll
    for (int d = 0; d < 4; ++d)
#pragma unroll
        for (int r = 0; r < 16; ++r) o[d][r] = 0.f;
    int side_pend = -1;
    for (int t = t_start; t < NT; ++t) {
        const int buf = t & 1, kb = t * 64;
        asm volatile("s_waitcnt vmcnt(0)" ::: "memory");
        __syncthreads();
        if (t + 1 < NT) ATT_GLDS(kb + 64, buf ^ 1);
        if (side_pend >= 0) { const int sv = side_pend; side_pend = -1;
            if ((wid >> 2) == (sv & 1)) {
                const int c = tid & 255, rr = c >> 6, hf2 = (c >> 5) & 1, l = (c >> 1) & 15, g = c & 1;
                const ALAS float* sp = (const ALAS float*)(lds + SIDE_STG) + rr * 2048 + hf2 * 1024 + (2 * g) * 256 + l * 16;
                f32x16v f0, f1;
#pragma unroll
                for (int k = 0; k < 4; ++k) { const f32x4 a = *(const ALAS f32x4*)(sp + 4 * k), b2 = *(const ALAS f32x4*)(sp + 256 + 4 * k);
#pragma unroll
                    for (int e = 0; e < 4; ++e) { f0[4 * k + e] = a[e]; f1[4 * k + e] = b2[e]; } }
                const bool isv = sv >= 16;
                fp6_put(isv ? side_v8 : side_u8, blockIdx.x * 64 + (sv & 15) * 4 + rr, hf2, l, g, f0, f1, isv ? 4.f : 64.f); }
        } else if (side_next < 32 && t + 1 < NT) { const int sv = side_next; const bool isv = sv >= 16;
            const float* src = (isv ? side_v : side_u) + (size_t)(blockIdx.x * 64 + (sv & 15) * 4) * 2048;
#pragma unroll
            for (int i = 0; i < 4; ++i)
                __builtin_amdgcn_global_load_lds((const unsigned*)(src + ((i * 8 + wid) * 64 + lane) * 4), (ALAS unsigned*)(lds + SIDE_STG + (i * 8 + wid) * 1024), 16, 0, 0);
            side_pend = sv; ++side_next; }
        f32x16 p0, p1;
        if (FOX) { const float fqm = NOMAX ? fq : fq - m_reg;
#pragma unroll
            for (int g = 0; g < 4; ++g) { const f32x4 f0 = *(const ALAS f32x4*)(F_lds + buf * 64 + 8 * g + 4 * hi), f1 = *(const ALAS f32x4*)(F_lds + buf * 64 + 32 + 8 * g + 4 * hi);
#pragma unroll
                for (int e = 0; e < 4; ++e) { p0[4 * g + e] = fqm - f0[e]; p1[4 * g + e] = fqm - f1[e]; } }
        } else if (NOMAX) {
#pragma unroll
            for (int r = 0; r < 16; ++r) { p0[r] = 0.f; p1[r] = 0.f; }
        } else { const float nm = -m_reg;
#pragma unroll
            for (int r = 0; r < 16; ++r) { p0[r] = nm; p1[r] = nm; }
        }
        {
            constexpr int KPF = 2;
            int ka[4];
#pragma unroll
            for (int dd = 0; dd < 4; ++dd) ka[dd] = (int)(uintptr_t)smem + buf * LY::SHM_K + kbase[dd];
            bf16x8 kb0[KPF + 1], kb1[KPF + 1];
#define ATT_KRD(dst, addr, off) asm volatile("ds_read_b128 %0, %1 offset:%2" : "=&v"(dst) : "v"(addr), "i"(off) : "memory")
#pragma unroll
            for (int d0 = 0; d0 < KPF; ++d0) { ATT_KRD(kb0[d0 % (KPF + 1)], ka[d0 & 3], (d0 >> 2) * 128); ATT_KRD(kb1[d0 % (KPF + 1)], ka[d0 & 3], (d0 >> 2) * 128 + 32 * LY::ROWB); }
#pragma unroll
            for (int d0 = 0; d0 < ND; ++d0) {
                if (d0 + KPF < ND) { constexpr int dummy = 0; (void)dummy;
                    ATT_KRD(kb0[(d0 + KPF) % (KPF + 1)], ka[(d0 + KPF) & 3], ((d0 + KPF) >> 2) * 128); ATT_KRD(kb1[(d0 + KPF) % (KPF + 1)], ka[(d0 + KPF) & 3], ((d0 + KPF) >> 2) * 128 + 32 * LY::ROWB); }
                const int rem = (ND - 1 - d0) < KPF ? (ND - 1 - d0) : KPF;
                if (rem >= 2) asm volatile("s_waitcnt lgkmcnt(4)" ::: "memory");
                else if (rem == 1) asm volatile("s_waitcnt lgkmcnt(2)" ::: "memory");
                else asm volatile("s_waitcnt lgkmcnt(0)" ::: "memory");
                ASBAR();
                p0 = __builtin_amdgcn_mfma_f32_32x32x16_bf16(kb0[d0 % (KPF + 1)], qr[d0], p0, 0, 0, 0);
                p1 = __builtin_amdgcn_mfma_f32_32x32x16_bf16(kb1[d0 % (KPF + 1)], qr[d0], p1, 0, 0, 0);
            }
#undef ATT_KRD
        }
        if (kb + 63 > qlo) {
            const float NEG = -__builtin_inff(); const int dq = qm - kb;
#pragma unroll
            for (int r = 0; r < 16; ++r) { const int c = (r & 3) + 8 * (r >> 2); if (dq - c < 0) p0[r] = NEG; if (dq - c - 32 < 0) p1[r] = NEG; }
        }
        float alpha = 1.f;
        if (!NOMAX) {
        float pmax;
        { float a = att_max3(p0[0], p0[1], p1[0]), b = att_max3(p0[2], p0[3], p1[1]); a = att_max3(a, p1[2], p1[3]);
#pragma unroll
          for (int r = 4; r < 16; r += 4) { a = att_max3(a, p0[r], p0[r + 1]); b = att_max3(b, p0[r + 2], p0[r + 3]); a = att_max3(a, p1[r], p1[r + 1]); b = att_max3(b, p1[r + 2], p1[r + 3]); }
          pmax = fmaxf(a, b); }
        { auto rr = __builtin_amdgcn_permlane32_swap(__float_as_uint(pmax), __float_as_uint(pmax), false, false);
          pmax = fmaxf(__uint_as_float(rr[0]), __uint_as_float(rr[1])); }
        if (!__builtin_expect(__all(pmax <= 8.f), 1)) { const float dm = fmaxf(pmax, 0.f); alpha = __builtin_amdgcn_exp2f(-dm); m_reg += dm;
#pragma unroll
            for (int r = 0; r < 16; ++r) { p0[r] -= dm; p1[r] -= dm; } }
        }
        float ps = 0.f;
#pragma unroll
        for (int r = 0; r < 16; ++r) { p0[r] = __builtin_amdgcn_exp2f(p0[r]); ps += p0[r]; }
#pragma unroll
        for (int r = 0; r < 16; ++r) { p1[r] = __builtin_amdgcn_exp2f(p1[r]); ps += p1[r]; }
        { auto rr = __builtin_amdgcn_permlane32_swap(__float_as_uint(ps), __float_as_uint(ps), false, false);
          ps = __uint_as_float(rr[0]) + __uint_as_float(rr[1]); }
        l_reg = NOMAX ? l_reg + ps : l_reg * alpha + ps;
        bf16x8 pa0, pa1, pa2, pa3;
#define ATT_PK4(P, B_, OUT) do { unsigned a0 = cvtpk(P[B_+0], P[B_+1]), a1 = cvtpk(P[B_+2], P[B_+3]); unsigned b0_ = cvtpk(P[B_+4], P[B_+5]), b1_ = cvtpk(P[B_+6], P[B_+7]); \
        auto r0 = __builtin_amdgcn_permlane32_swap(a0, b0_, false, false); auto r1 = __builtin_amdgcn_permlane32_swap(a1, b1_, false, false); \
        u32x4 w = {r0[0], r1[0], r0[1], r1[1]}; OUT = *reinterpret_cast<bf16x8*>(&w); } while (0)
        ATT_PK4(p0, 0, pa0); ATT_PK4(p0, 8, pa1); ATT_PK4(p1, 0, pa2); ATT_PK4(p1, 8, pa3);
        if (!NOMAX && __any(alpha < 1.f)) {
            if (hi == 0) wsl[r32] = alpha;
            asm volatile("s_waitcnt lgkmcnt(0)" ::: "memory");
#pragma unroll
            for (int g = 0; g < 4; ++g) { const f32x4 al = *(const ALAS f32x4*)(wsl + 8 * g + 4 * hi);
#pragma unroll
                for (int d = 0; d < 4; ++d)
#pragma unroll
                    for (int e = 0; e < 4; ++e) o[d][4 * g + e] *= al[e]; }
        }
#define ATT_TRRD(dst, off) asm volatile("ds_read_b64_tr_b16 %0, %1 offset:%2" : "=&v"(dst) : "v"(vbb), "i"(off) : "memory")
#define ATT_PV(d0) do { s16x4 l0, l1, l2, l3, h0, h1, h2, h3; constexpr int b_ = (d0) * 512; \
        ATT_TRRD(l0, b_); ATT_TRRD(h0, b_ + 2048); ATT_TRRD(l1, b_ + 4096); ATT_TRRD(h1, b_ + 6144); ATT_TRRD(l2, b_ + 8192); ATT_TRRD(h2, b_ + 10240); ATT_TRRD(l3, b_ + 12288); ATT_TRRD(h3, b_ + 14336); \
        asm volatile("s_waitcnt lgkmcnt(0)" ::: "memory"); ASBAR(); \
        o[d0] = __builtin_amdgcn_mfma_f32_32x32x16_bf16(pa0, (bf16x8){l0[0], l0[1], l0[2], l0[3], h0[0], h0[1], h0[2], h0[3]}, o[d0], 0, 0, 0); \
        o[d0] = __builtin_amdgcn_mfma_f32_32x32x16_bf16(pa1, (bf16x8){l1[0], l1[1], l1[2], l1[3], h1[0], h1[1], h1[2], h1[3]}, o[d0], 0, 0, 0); \
        o[d0] = __builtin_amdgcn_mfma_f32_32x32x16_bf16(pa2, (bf16x8){l2[0], l2[1], l2[2], l2[3], h2[0], h2[1], h2[2], h2[3]}, o[d0], 0, 0, 0); \
        o[d0] = __builtin_amdgcn_mfma_f32_32x32x16_bf16(pa3, (bf16x8){l3[0], l3[1], l3[2], l3[3], h3[0], h3[1], h3[2], h3[3]}, o[d0], 0, 0, 0); } while (0)
        { const int vbb = vb0 + buf * SHM_V; ATT_PV(0); ATT_PV(1); ATT_PV(2); ATT_PV(3); }
        if (t + 1 < NT) ATT_WRITEF(buf ^ 1);
    }
    if (hi == 0) wsl[r32] = l_reg;
    asm volatile("s_waitcnt lgkmcnt(0)" ::: "memory");
#pragma unroll
    for (int r = 0; r < 16; ++r) {
        const int orow = crow(r, hi); const float rli = __builtin_amdgcn_rcpf(wsl[orow]);
        bf16_t* rowp = gout + (size_t)(qlo + orow) * 4096; const bf16_t* growp = gate + (size_t)(qlo + orow) * 4096;
#pragma unroll
        for (int d0 = 0; d0 < 4; ++d0) {
            const float v = o[d0][r] * rli; const float vn = __shfl_xor(v, 1);
            if ((r32 & 1) == 0) { unsigned* gp = (unsigned*)(rowp + d0 * 32 + r32); const unsigned g = *(const unsigned*)(growp + d0 * 32 + r32);
                *gp = cvtpk(v * __uint_as_float(g << 16), vn * __uint_as_float(g & 0xffff0000u)); }
        }
    }
    __syncthreads();
#undef ATT_GLDS
#undef ATT_WRITEF
#undef ATT_PK4
#undef ATT_TRRD
#undef ATT_PV
}
}
using pg8::bf16_t; using pg8::f32x4; using pg8::u32x4;
#define LAS __attribute__((address_space(3)))
constexpr int S = 8192, DM = 2048, INW = 11344, INWP = 11520;
constexpr float EPS = 1e-6f;
constexpr size_t MiB = 1u << 20;

__device__ __forceinline__ float bf2f(bf16_t v) { return __uint_as_float(((unsigned)v) << 16); }
__device__ __forceinline__ bf16_t f2bf(float f) { unsigned u = __float_as_uint(f); u += 0x7fffu + ((u >> 16) & 1u); return (bf16_t)(u >> 16); }
__device__ __forceinline__ unsigned pk2(float lo, float hi) { return (unsigned)f2bf(lo) | ((unsigned)f2bf(hi) << 16); }
__device__ __forceinline__ float wave_sum(float v) {
#pragma unroll
    for (int o = 32; o >= 1; o >>= 1) v += __shfl_xor(v, o);
    return v;
}
__device__ __forceinline__ float wave_max(float v) {
#pragma unroll
    for (int o = 32; o >= 1; o >>= 1) v = fmaxf(v, __shfl_xor(v, o));
    return v;
}

__device__ __forceinline__ int opaque_tid() { int t = threadIdx.x; asm volatile("" : "+v"(t)); return t; }

struct Params {
    const float* x; const int* pos; const float *mix_g, *w_in, *b_forget, *b_gate, *q_lat_g, *w_q_up, *kv_lat_g, *w_kv_up, *mla_qg, *mla_kg, *fox_qg, *fox_kg, *w_out, *ffn_g, *w_peer_q, *sub_keys, *peer_u, *peer_v;
    float* out;
    bf16_t *WqT, *WkvT, *WoT, *WpT, *WinT;
    bf16_t *h, *cq, *ckv, *fq, *fk, *fv, *merged, *kpe, *qa, *va, *ka;
    float *lf, *F, *x1, *scores;
    unsigned char *U8, *V8; bf16_t* attout;
    unsigned* ctl;
    float2* ropeT; float* ssq; float* ssq2; bf16_t* xg;
};

struct DstId { __device__ __forceinline__ int operator()(int n) const { return n; } };
struct DstWin { __device__ __forceinline__ int operator()(int n) const {
    if (n < 1024) return n; if (n < 1088) { const int r = n - 1024; return 11264 + 2 * (r & 31) + (r >> 5); } if (n < 7232) return n - 64; if (n < 7248) return 11264 + 64 + (n - 7232); return n - 80; } };
struct DstQ { __device__ __forceinline__ int operator()(int n) const {
    const int h = n / 192, d = n - h * 192; if (d < 128) return h * 256 + d; const int r = d - 128; return h * 256 + 128 + 2 * (r & 31) + (r >> 5); } };
template <class Dst>
__device__ __forceinline__ void transpose_item(const float* __restrict__ W, int K, int N, bf16_t* __restrict__ WT, Dst dst, float* scr, int item, int lane, const float* __restrict__ gk = nullptr) {
    const int nblk = (N + 31) / 32, kb = item / nblk, nb = item % nblk, k0 = 64 * kb, n0 = 32 * nb;
    { const int rr = lane >> 3, c4 = (lane & 7) * 4; const bool ok = (n0 + c4) < N;
      f32x4 v[8];
#pragma unroll
      for (int i = 0; i < 8; ++i) v[i] = ok ? *(const f32x4*)(W + (size_t)(k0 + 8 * i + rr) * N + n0 + c4) : (f32x4){0.f, 0.f, 0.f, 0.f};
      if (gk) {
#pragma unroll
          for (int i = 0; i < 8; ++i) v[i] *= gk[k0 + 8 * i + rr]; }
#pragma unroll
      for (int i = 0; i < 8; ++i) { float* sp = scr + (8 * i + rr) * 33 + c4; sp[0] = v[i][0]; sp[1] = v[i][1]; sp[2] = v[i][2]; sp[3] = v[i][3]; } }
    asm volatile("s_waitcnt lgkmcnt(0)" ::: "memory");
    const int c = lane & 7;
#pragma unroll
    for (int j = 0; j < 4; ++j) { const int nl = (lane >> 3) + 8 * j, n = n0 + nl; const float* s = scr + (8 * c) * 33 + nl;
        u32x4 o; o.x = pk2(s[0 * 33], s[1 * 33]); o.y = pk2(s[2 * 33], s[3 * 33]); o.z = pk2(s[4 * 33], s[5 * 33]); o.w = pk2(s[6 * 33], s[7 * 33]);
        if (n < N) *(u32x4*)(WT + (size_t)dst(n) * K + k0 + 8 * c) = o; }
    asm volatile("s_waitcnt lgkmcnt(0)" ::: "memory");
}
typedef __bf16 wf_bf16x8 __attribute__((ext_vector_type(8)));
typedef float wf_f32x8 __attribute__((ext_vector_type(8)));
__device__ __forceinline__ void wf_split(const f32x4 x0, const f32x4 x1, wf_bf16x8& hi, wf_bf16x8& lo) {
    const wf_f32x8 x = {x0[0], x0[1], x0[2], x0[3], x1[0], x1[1], x1[2], x1[3]};
    hi = __builtin_convertvector(x, wf_bf16x8);
    const wf_f32x8 r = x - __builtin_convertvector(hi, wf_f32x8);
    lo = __builtin_convertvector(r, wf_bf16x8);
}
__device__ __forceinline__ void wfold_item(const float* __restrict__ wq, const float* __restrict__ keys, bf16_t* __restrict__ WpT, float* sm, int item) {
    (void)sm;
    const int tid = opaque_tid(), lane = tid & 63, wave = tid >> 6, hc = item >> 5, d0 = (item & 31) * 64, m = lane & 15, kg = lane >> 4;
    f32x4 acc[4];
#pragma unroll
    for (int c = 0; c < 4; ++c) acc[c] = (f32x4){0.f, 0.f, 0.f, 0.f};
#pragma unroll
    for (int s4 = 0; s4 < 4; ++s4) {
        const float* kp = keys + (size_t)hc * 16384 + (16 * wave + m) * 128 + 32 * s4 + 8 * kg;
        wf_bf16x8 bh, bl; wf_split(*(const f32x4*)kp, *(const f32x4*)(kp + 4), bh, bl);
#pragma unroll
        for (int c = 0; c < 4; ++c) { const float* ap = wq + (size_t)(d0 + 16 * c + m) * 2048 + hc * 128 + 32 * s4 + 8 * kg;
            wf_bf16x8 ah, al; wf_split(*(const f32x4*)ap, *(const f32x4*)(ap + 4), ah, al);
            acc[c] = __builtin_amdgcn_mfma_f32_16x16x32_bf16(ah, bh, acc[c], 0, 0, 0);
            acc[c] = __builtin_amdgcn_mfma_f32_16x16x32_bf16(ah, bl, acc[c], 0, 0, 0);
            acc[c] = __builtin_amdgcn_mfma_f32_16x16x32_bf16(al, bh, acc[c], 0, 0, 0); }
    }
#pragma unroll
    for (int c = 0; c < 4; ++c) { uint2 o; o.x = pk2(acc[c][0], acc[c][1]); o.y = pk2(acc[c][2], acc[c][3]);
        *(uint2*)(WpT + (size_t)(hc * 128 + 16 * wave + m) * 2048 + d0 + 16 * c + 4 * kg) = o; }
}
__device__ __forceinline__ void rms_row2048(const float* __restrict__ xr, const float* __restrict__ g, bf16_t* __restrict__ orow, int lane) {
    f32x4 v[8]; float ss = 0.f;
#pragma unroll
    for (int j = 0; j < 8; ++j) { v[j] = *(const f32x4*)(xr + j * 256 + lane * 4); ss += (v[j][0] * v[j][0] + v[j][1] * v[j][1]) + (v[j][2] * v[j][2] + v[j][3] * v[j][3]); }
    const float r = rsqrtf(wave_sum(ss) * (1.f / 2048.f) + EPS);
#pragma unroll
    for (int j = 0; j < 8; ++j) { const f32x4 gg = *(const f32x4*)(g + j * 256 + lane * 4);
        uint2 o; o.x = pk2(v[j][0] * r * gg[0], v[j][1] * r * gg[1]); o.y = pk2(v[j][2] * r * gg[2], v[j][3] * r * gg[3]);
        *(uint2*)(orow + j * 256 + lane * 4) = o; }
}
__device__ __forceinline__ void fox_cumsum(double* part, int h, const float* __restrict__ lf, float* __restrict__ F) {
    const int tid = opaque_tid(), lane = tid & 63, wave = tid >> 6;
    float v[16]; double sum = 0.0;
#pragma unroll
    for (int i = 0; i < 16; ++i) { v[i] = lf[(size_t)(tid * 16 + i) * 16 + h]; sum += (double)v[i]; }
    double inc = sum;
#pragma unroll
    for (int o = 1; o < 64; o <<= 1) { const double n = __shfl_up(inc, o); if (lane >= o) inc += n; }
    if (lane == 63) part[wave] = inc;
    __syncthreads();
    double base = 0.0;
    for (int w = 0; w < wave; ++w) base += part[w];
    double run = base + inc - sum;
#pragma unroll
    for (int i = 0; i < 16; ++i) { run += (double)v[i]; F[(size_t)h * S + tid * 16 + i] = (float)(run * 1.4426950408889634); }
    __syncthreads();
}
__device__ __forceinline__ void rope_table(const int* __restrict__ pos, float2* __restrict__ ropeT, int gtid, int nthreads) {
    for (int idx = gtid; idx < S * 32; idx += nthreads) { const int t = idx >> 5, i = idx & 31;
        const double inv = exp(-(double)i * (1.0 / 32.0) * 9.210340371976184);
        double ang = (double)((float)pos[t] * (float)inv);
        const double twopi = 6.283185307179586;
        ang -= twopi * rint(ang / twopi);
        ropeT[idx] = make_float2(cosf((float)ang), sinf((float)ang)); }
}
typedef float f32x2 __attribute__((ext_vector_type(2)));
__device__ __forceinline__ unsigned pk4_fp8(float a, float b, float c, float d) {
    int w = __builtin_amdgcn_cvt_pk_fp8_f32(fminf(fmaxf(a, -448.f), 448.f), fminf(fmaxf(b, -448.f), 448.f), 0, false);
    w = __builtin_amdgcn_cvt_pk_fp8_f32(fminf(fmaxf(c, -448.f), 448.f), fminf(fmaxf(d, -448.f), 448.f), w, true); return (unsigned)w; }
__device__ __forceinline__ void cvt_rows_fp8(const float* __restrict__ src, unsigned char* __restrict__ dst, size_t n, float scale, int gw, int NGW, int lane) {
    const size_t nchunk = n / 1024;
    for (size_t c = gw; c < nchunk; c += NGW) { const size_t o = c * 1024 + lane * 16;
        f32x4 a[4];
#pragma unroll
        for (int q = 0; q < 4; ++q) a[q] = *(const f32x4*)(src + o + 4 * q) * scale;
        u32x4 w; w.x = pk4_fp8(a[0][0], a[0][1], a[0][2], a[0][3]); w.y = pk4_fp8(a[1][0], a[1][1], a[1][2], a[1][3]);
        w.z = pk4_fp8(a[2][0], a[2][1], a[2][2], a[2][3]); w.w = pk4_fp8(a[3][0], a[3][1], a[3][2], a[3][3]);
        *(u32x4*)(dst + o) = w; }
}
constexpr float U_SCALE = 64.f, V_SCALE = 4.f;
typedef __bf16 bf16x2_t __attribute__((ext_vector_type(2)));
__device__ __forceinline__ float dot2bf(unsigned a, unsigned b, float c) { return __builtin_amdgcn_fdot2_f32_bf16(__builtin_bit_cast(bf16x2_t, a), __builtin_bit_cast(bf16x2_t, b), c, false); }
#define PEER_INS(top, x) do { float x_ = (x); _Pragma("unroll") for (int i_ = 0; i_ < 16; ++i_) { const float hi_ = fmaxf(top[i_], x_); x_ = fminf(top[i_], x_); top[i_] = hi_; } } while (0)
__device__ __forceinline__ void fp6_cvt_rows(const float* __restrict__ src, unsigned char* __restrict__ T6, int row0, int nrows, float sc, int t, int nt) {
    for (int u = t; u < nrows * 64; u += nt) { const int rr = u >> 6, hf = (u >> 5) & 1, l = (u >> 1) & 15, g = u & 1;
        const float* s0 = src + (size_t)(row0 + rr) * 2048 + hf * 1024 + (2 * g) * 256 + l * 16;
        att::f32x16v f0, f1;
#pragma unroll
        for (int k = 0; k < 4; ++k) { const f32x4 a = *(const f32x4*)(s0 + 4 * k), b2 = *(const f32x4*)(s0 + 256 + 4 * k);
#pragma unroll
            for (int e = 0; e < 4; ++e) { f0[4 * k + e] = a[e]; f1[4 * k + e] = b2[e]; } }
        att::fp6_put(T6, row0 + rr, hf, l, g, f0, f1, sc); }
}
typedef float f32x32v __attribute__((ext_vector_type(32)));
__device__ __forceinline__ void peer_group(unsigned char* smem, int g, const float* __restrict__ scores, const bf16_t* __restrict__ h2  , const float* __restrict__ ssq2, const float* __restrict__ x1,
                                           const unsigned char* __restrict__ U8, const unsigned char* __restrict__ V8, float* __restrict__ out) {
    const int tid = opaque_tid(), lane = tid & 63, wave = __builtin_amdgcn_readfirstlane(tid >> 6);
    float* topL = (float*)smem;
    int* selE = (int*)(smem + 32768);
    float* selG = (float*)(smem + 49152);
    {
        const int tl = tid >> 4, hc = tid & 15;
        const float* sp = scores + (size_t)(g * 32 + tl) * 2048 + hc * 128;
#define PEER_CE(a, b) do { const float hi_ = fmaxf(a, b), lo_ = fminf(a, b); a = hi_; b = lo_; } while (0)
        float top[16];
#pragma unroll 1
        for (int gi = 0; gi < 8; ++gi) {
            float gr[16];
#pragma unroll
            for (int q = 0; q < 4; ++q) { const f32x4 v = *(const f32x4*)(sp + gi * 16 + q * 4);
#pragma unroll
                for (int e = 0; e < 4; ++e) gr[q * 4 + e] = __uint_as_float((__float_as_uint(v[e]) & ~0x7Fu) | (unsigned)(gi * 16 + q * 4 + e)); }
#pragma unroll
            for (int k = 2; k <= 16; k <<= 1)
#pragma unroll
                for (int j = k >> 1; j > 0; j >>= 1)
#pragma unroll
                    for (int i = 0; i < 16; ++i) { const int l = i ^ j; if (l > i) { if ((i & k) == 0) PEER_CE(gr[i], gr[l]); else PEER_CE(gr[l], gr[i]); } }
            if (gi == 0) {
#pragma unroll
                for (int i = 0; i < 16; ++i) top[i] = gr[i];
            } else {
#pragma unroll
                for (int i = 0; i < 16; ++i) top[i] = fmaxf(top[i], gr[15 - i]);
#pragma unroll
                for (int j = 8; j > 0; j >>= 1)
#pragma unroll
                    for (int i = 0; i < 16; ++i) { const int l = i ^ j; if (l > i) PEER_CE(top[i], top[l]); }
            }
        }
#undef PEER_CE
        float* tp = topL + (tl * 16 + hc) * 16;
#pragma unroll
        for (int i = 0; i < 16; i += 4) *(f32x4*)(tp + i) = (f32x4){top[i], top[i + 1], top[i + 2], top[i + 3]};
    }
    __syncthreads();
    if (tid < 256) {
        const int tl = tid >> 3, h = tid & 7;
        const float* t1 = topL + (tl * 16 + 2 * h) * 16; const float* t2 = t1 + 16;
        float s1[16], s2[16];
#pragma unroll
        for (int i = 0; i < 16; i += 4) { const f32x4 a = *(const f32x4*)(t1 + i), b2 = *(const f32x4*)(t2 + i);
            s1[i] = a[0]; s1[i + 1] = a[1]; s1[i + 2] = a[2]; s1[i + 3] = a[3]; s2[i] = b2[0]; s2[i + 1] = b2[1]; s2[i + 2] = b2[2]; s2[i + 3] = b2[3]; }
#define PEER_CE(a, b) do { const float hi_ = fmaxf(a, b), lo_ = fminf(a, b); a = hi_; b = lo_; } while (0)
#define PEER_KEY(i, j) __uint_as_float((__float_as_uint(s1[i] + s2[j]) & ~0xFFu) | (unsigned)((i) * 16 + (j)))
        float ts[16], cand[34];
#pragma unroll
        for (int j = 0; j < 16; ++j) ts[j] = PEER_KEY(0, j);
        { int n = 0;
#pragma unroll
          for (int i = 1; i < 16; ++i)
#pragma unroll
              for (int j = 0; j < 8; ++j)
                  if ((i + 1) * (j + 1) <= 16) cand[n++] = PEER_KEY(i, j); }
#pragma unroll
        for (int gi = 0; gi < 2; ++gi) { float gr[16];
#pragma unroll
            for (int i = 0; i < 16; ++i) gr[i] = cand[gi * 16 + i];
#pragma unroll
            for (int k = 2; k <= 16; k <<= 1)
#pragma unroll
                for (int j = k >> 1; j > 0; j >>= 1)
#pragma unroll
                    for (int i = 0; i < 16; ++i) { const int l = i ^ j; if (l > i) { if ((i & k) == 0) PEER_CE(gr[i], gr[l]); else PEER_CE(gr[l], gr[i]); } }
#pragma unroll
            for (int i = 0; i < 16; ++i) ts[i] = fmaxf(ts[i], gr[15 - i]);
#pragma unroll
            for (int j = 8; j > 0; j >>= 1)
#pragma unroll
                for (int i = 0; i < 16; ++i) { const int l = i ^ j; if (l > i) PEER_CE(ts[i], ts[l]); } }
        PEER_INS(ts, cand[32]); PEER_INS(ts, cand[33]);
#undef PEER_CE
#undef PEER_KEY
        float ex[16], sum = 0.f;
#pragma unroll
        for (int k = 0; k < 16; ++k) { ex[k] = __expf(ts[k] - ts[0]); sum += ex[k]; }
        const float inv = 1.f / sum;
#pragma unroll
        for (int k = 0; k < 16; ++k) { const unsigned pos = __float_as_uint(ts[k]) & 0xFFu;
            const int i1 = (int)(__float_as_uint(t1[pos >> 4]) & 0x7Fu), i2 = (int)(__float_as_uint(t2[pos & 15]) & 0x7Fu);
            selE[tl * 128 + h * 16 + k] = i1 * 128 + i2; selG[tl * 128 + h * 16 + k] = ex[k] * inv; }
    }
    __syncthreads();
    const int grp = lane >> 4, l16 = lane & 15, tl = wave * 4 + grp;
    unsigned* sortK = (unsigned*)(smem + 65536) + tl * 128;
    float* wS = (float*)(smem + 81920) + tl * 128;
    unsigned* hist = (unsigned*)(smem + 98304) + wave * 512 + grp * 64;
    {
#pragma unroll
        for (int i = 0; i < 4; ++i) hist[l16 * 4 + i] = 0u;
        asm volatile("s_waitcnt lgkmcnt(0)" ::: "memory");
        unsigned ek[8], rk[8];
#pragma unroll
        for (int j = 0; j < 8; ++j) { ek[j] = (unsigned)selE[tl * 128 + l16 + 16 * j]; rk[j] = atomicAdd(&hist[ek[j] >> 8], 1u); }
        asm volatile("s_waitcnt lgkmcnt(0)" ::: "memory");
        unsigned c[4], tot = 0u;
#pragma unroll
        for (int i = 0; i < 4; ++i) { c[i] = hist[l16 * 4 + i]; tot += c[i]; }
        unsigned inc = tot;
#pragma unroll
        for (int o = 1; o < 16; o <<= 1) { const unsigned n = __shfl_up(inc, o, 16); if (l16 >= o) inc += n; }
        unsigned run = inc - tot;
#pragma unroll
        for (int i = 0; i < 4; ++i) { hist[256 + l16 * 4 + i] = run; run += c[i]; }
        asm volatile("s_waitcnt lgkmcnt(0)" ::: "memory");
#pragma unroll
        for (int j = 0; j < 8; ++j) sortK[hist[256 + (ek[j] >> 8)] + rk[j]] = (ek[j] << 7) | (unsigned)(l16 + 16 * j);
    }
    __syncthreads();
    const size_t tok = (size_t)g * 32 + tl;
    float rinv_tok;
    { float t = 0.f; if (l16 < 8) { const f32x4 a = *(const f32x4*)(ssq2 + ((size_t)l16 * 8192 + tok) * 4); t = (a[0] + a[1]) + (a[2] + a[3]); }
      t += __shfl_xor(t, 8); t += __shfl_xor(t, 4); t += __shfl_xor(t, 2); t += __shfl_xor(t, 1); rinv_tok = rsqrtf(t * (1.f / 2048.f) + 1e-6f); }
    {
        const int m16 = lane & 15, kg = lane >> 4, pt = m16 >> 2, sub = m16 & 3, l6 = kg * 4 + sub;
        const unsigned* sKa = (const unsigned*)(smem + 65536) + (wave * 4 + pt) * 128;
        const bool diag = pt == kg;
        const size_t tokb = (size_t)g * 32 + wave * 4 + pt;
        typedef int i32x8v __attribute__((ext_vector_type(8)));
        const float xsc = 1.4f * __shfl(rinv_tok, pt * 16);
#pragma unroll 1
        for (int hf = 0; hf < 2; ++hf) {
            i32x8v xb[2];
#pragma unroll
            for (int gq = 0; gq < 2; ++gq) { att::f32x16v ev, od;
#pragma unroll
                for (int h = 0; h < 2; ++h) { const bf16_t* xp = h2 + tokb * DM + hf * 1024 + (2 * gq + h) * 256 + l6 * 16;
                    const u32x4 w0 = *(const u32x4*)xp, w1 = *(const u32x4*)(xp + 8);
#pragma unroll
                    for (int q = 0; q < 4; ++q) { ev[8 * h + q] = __uint_as_float(w0[q] << 16) * xsc; od[8 * h + q] = __uint_as_float(w0[q] & 0xffff0000u) * xsc;
                        ev[8 * h + 4 + q] = __uint_as_float(w1[q] << 16) * xsc; od[8 * h + 4 + q] = __uint_as_float(w1[q] & 0xffff0000u) * xsc; } }
                const att::u32x6v w6 = __builtin_amdgcn_cvt_scalef32_2xpk16_fp6_f32(ev, od, 1.0f);
                xb[gq] = (i32x8v){(int)w6[0], (int)w6[1], (int)w6[2], (int)w6[3], (int)w6[4], (int)w6[5], 0, 0}; }
            u32x4 urA[4][3], urB[4][3];
#define PEER_LDA(ur, it0) do { _Pragma("unroll") for (int j = 0; j < 4; ++j) { const unsigned ro = (sKa[(it0) + j] >> 7) * (unsigned)att::ROW6 + (unsigned)(hf * 768 + l6 * 16); \
                    _Pragma("unroll") for (int c = 0; c < 3; ++c) ur[j][c] = *(const u32x4*)(U8 + ro + c * 256); } } while (0)
#define PEER_CMA(ur, it0) do { float dsel = 0.f; \
                _Pragma("unroll") for (int j = 0; j < 4; ++j) { f32x4 acc = (f32x4){0.f, 0.f, 0.f, 0.f}; \
                    acc = __builtin_amdgcn_mfma_scale_f32_16x16x128_f8f6f4((i32x8v){(int)ur[j][0][0], (int)ur[j][0][1], (int)ur[j][0][2], (int)ur[j][0][3], (int)ur[j][1][0], (int)ur[j][1][1], 0, 0}, xb[0], acc, 2, 2, 0, 0x7F7F7F7F, 0, 0x7F7F7F7F); \
                    acc = __builtin_amdgcn_mfma_scale_f32_16x16x128_f8f6f4((i32x8v){(int)ur[j][1][2], (int)ur[j][1][3], (int)ur[j][2][0], (int)ur[j][2][1], (int)ur[j][2][2], (int)ur[j][2][3], 0, 0}, xb[1], acc, 2, 2, 0, 0x7F7F7F7F, 0, 0x7F7F7F7F); \
                    float d = sub == 0 ? acc[0] : sub == 1 ? acc[1] : sub == 2 ? acc[2] : acc[3]; \
                    d += __builtin_bit_cast(float, __builtin_amdgcn_update_dpp(0, __builtin_bit_cast(int, d), 0xB1, 0xF, 0xF, true)); \
                    d += __builtin_bit_cast(float, __builtin_amdgcn_update_dpp(0, __builtin_bit_cast(int, d), 0x4E, 0xF, 0xF, true)); \
                    if (sub == j) dsel = d; } \
                if (diag) { float* wSt = (float*)(smem + 81920) + (wave * 4 + pt) * 128; \
                    if (hf == 0) wSt[(it0) + sub] = dsel; \
                    else { const float a = (wSt[(it0) + sub] + dsel) * (1.f / (1.4f * U_SCALE)); \
                        wSt[(it0) + sub] = selG[(wave * 4 + pt) * 128 + (sKa[(it0) + sub] & 127u)] * 0.5f * a * (1.f + erff(a * 0.70710678118654752f)) * (1.f / V_SCALE); } } } while (0)
            PEER_LDA(urA, 0);
#pragma unroll 1
            for (int it = 0; it < 128; it += 8) {
                if (it) __builtin_amdgcn_s_barrier();
                PEER_LDA(urB, it + 4);
                PEER_CMA(urA, it);
                if (it + 8 < 128) PEER_LDA(urA, it + 8);
                PEER_CMA(urB, it + 4);
            }
#undef PEER_LDA
#undef PEER_CMA
            __syncthreads();
        }
    }
#pragma unroll 1
    for (int hf = 0; hf < 2; ++hf) {
        typedef _Float16 h16x2v __attribute__((ext_vector_type(2)));
        typedef _Float16 h16x32v __attribute__((ext_vector_type(32)));
        h16x2v acc[32];
#pragma unroll
        for (int c = 0; c < 32; ++c) acc[c] = (h16x2v){(_Float16)0.f, (_Float16)0.f};
        for (int it = 0; it < 128; it += 4) {
            if ((it & 7) == 0 && it) __syncthreads();
            unsigned key[4]; u32x4 vr[4][3];
#pragma unroll
            for (int p = 0; p < 4; ++p) { key[p] = sortK[it + p];
#pragma unroll
                for (int j = 0; j < 3; ++j) vr[p][j] = *(const u32x4*)(V8 + (size_t)(key[p] >> 7) * att::ROW6 + hf * 768 + j * 256 + l16 * 16); }
#pragma unroll
            for (int p = 0; p < 4; ++p) { const _Float16 wh = (_Float16)wS[it + p]; const h16x2v w2 = (h16x2v){wh, wh};
                const h16x32v c0 = __builtin_amdgcn_cvt_scalef32_pk32_f16_fp6((att::u32x6v){vr[p][0][0], vr[p][0][1], vr[p][0][2], vr[p][0][3], vr[p][1][0], vr[p][1][1]}, 1.0f);
#pragma unroll
                for (int k = 0; k < 16; ++k) acc[k] = __builtin_elementwise_fma(w2, (h16x2v){c0[2 * k], c0[2 * k + 1]}, acc[k]);
                const h16x32v c1 = __builtin_amdgcn_cvt_scalef32_pk32_f16_fp6((att::u32x6v){vr[p][1][2], vr[p][1][3], vr[p][2][0], vr[p][2][1], vr[p][2][2], vr[p][2][3]}, 1.0f);
#pragma unroll
                for (int k = 0; k < 16; ++k) acc[16 + k] = __builtin_elementwise_fma(w2, (h16x2v){c1[2 * k], c1[2 * k + 1]}, acc[16 + k]); }
        }
#pragma unroll
        for (int j = 0; j < 4; ++j)
#pragma unroll
            for (int q = 0; q < 4; ++q) { const size_t o = tok * DM + hf * 1024 + j * 256 + l16 * 16 + q * 4;
                const f32x4 a = *(const f32x4*)(x1 + o);
                *(f32x4*)(out + o) = (f32x4){a[0] + (float)acc[j * 8 + 2 * q][0], a[1] + (float)acc[j * 8 + 2 * q][1], a[2] + (float)acc[j * 8 + 2 * q + 1][0], a[3] + (float)acc[j * 8 + 2 * q + 1][1]}; }
        __syncthreads();
    }
    __syncthreads();
}

#define XB_TMO      128
#define XB_XCNT(j)  (256  + 64 * (j))
#define XB_XSUB(j)  (1280 + 64 * (j))
#define XB_XGEN(j)  (2304 + 64 * (j))
#define XB_TOP      3328
#define XB_TOPGEN   3392
#define XCD_BAR_WORDS 3456
#define XB_SPIN_CAP (1u << 18)

__device__ __forceinline__ unsigned xb_ld(unsigned* p)              { return __hip_atomic_load(p, __ATOMIC_RELAXED, __HIP_MEMORY_SCOPE_AGENT); }
__device__ __forceinline__ unsigned xb_add(unsigned* p, unsigned v) { return __hip_atomic_fetch_add(p, v, __ATOMIC_RELAXED, __HIP_MEMORY_SCOPE_AGENT); }
__device__ __forceinline__ unsigned xb_xcc_id() { return (unsigned)__builtin_amdgcn_s_getreg((3 << 11) | 20) & 0xFu; }
#define XB_SPIN(cond, bar) do { unsigned _sp = 0; while (cond) { __builtin_amdgcn_s_sleep(1); \
    if ((++_sp & 255u) == 0u) { if (xb_ld(&(bar)[XB_TMO])) break; if (_sp > XB_SPIN_CAP) { atomicAdd(&(bar)[XB_TMO], 1u); break; } } } } while (0)

struct XcdBarrier {
    unsigned* bar; unsigned x;
    volatile LAS unsigned* st;
};

__device__ __forceinline__ XcdBarrier xcd_barrier_post(unsigned* bar, volatile LAS unsigned* st) {
    XcdBarrier b; b.bar = bar; b.x = xb_xcc_id(); b.st = st;
    if (threadIdx.x == 0) (void)xb_add(&bar[XB_XCNT(b.x)], 1u);
    return b;
}
__device__ __forceinline__ void xcd_barrier_complete(unsigned* bar, unsigned x, unsigned& nloc, unsigned& nx) {
    const unsigned G = gridDim.x * gridDim.y * gridDim.z;
    unsigned sum, cnt, mine, sp = 0u;
    for (;;) {
        sum = 0u; cnt = 0u; mine = 0u;
#pragma unroll
        for (unsigned j = 0; j < 16; ++j) { const unsigned c = xb_ld(&bar[XB_XCNT(j)]); sum += c; cnt += (c > 0u) ? 1u : 0u; mine = (j == x) ? c : mine; }
        if (sum == G) break;
        __builtin_amdgcn_s_sleep(1);
        if ((++sp & 255u) == 0u) { if (xb_ld(&bar[XB_TMO])) break; if (sp > XB_SPIN_CAP) { atomicAdd(&bar[XB_TMO], 1u); break; } }
    }
    nloc = mine > 0u ? mine : 1u; nx = cnt > 0u ? cnt : 1u;
}

__device__ __forceinline__ void xcd_barrier(const XcdBarrier& b) {
    asm volatile("s_waitcnt vmcnt(0)" ::: "memory");
    __syncthreads();
    if (threadIdx.x == 0) {
        unsigned* bar = b.bar;
        __builtin_amdgcn_s_waitcnt(0);
        unsigned nloc = b.st[0], nx = b.st[1];
        if (nloc == 0u) { xcd_barrier_complete(bar, b.x, nloc, nx); b.st[0] = nloc; b.st[1] = nx; }
        const unsigned old = xb_add(&bar[XB_XSUB(b.x)], 1u);
        const unsigned gen = old / nloc;
        if (old + 1u == (gen + 1u) * nloc) {
            __builtin_amdgcn_fence(__ATOMIC_RELEASE, "agent");
            asm volatile("s_waitcnt vmcnt(0)" ::: "memory");
            const unsigned og = xb_add(&bar[XB_TOP], 1u);
            const unsigned tg = og / nx;
            if (og + 1u == (tg + 1u) * nx) xb_add(&bar[XB_TOPGEN], 1u);
            else XB_SPIN(xb_ld(&bar[XB_TOPGEN]) == tg, bar);
            __builtin_amdgcn_fence(__ATOMIC_ACQUIRE, "agent");
            xb_add(&bar[XB_XGEN(b.x)], 1u);
            asm volatile("s_waitcnt vmcnt(0)" ::: "memory");
        } else {
            XB_SPIN(xb_ld(&bar[XB_XGEN(b.x)]) == gen, bar);
            __builtin_amdgcn_fence(__ATOMIC_ACQUIRE, "agent");
            asm volatile("s_waitcnt vmcnt(0)" ::: "memory");
        }
    }
    __syncthreads();
}

#define PROBE_P0 0
#define PROBE_DOUBLE 0
#define REP(k) for (int rep_ = 0; rep_ < ((PROBE_DOUBLE == (k)) ? 2 : 1); ++rep_)
constexpr int LDS_BYTES = 147456;
__global__ __launch_bounds__(512, 2) void mega(Params p) {
    extern __shared__ __attribute__((aligned(16))) unsigned char smem[];
    { volatile LAS unsigned* st0 = (volatile LAS unsigned*)((LAS unsigned char*)smem + 131072); if (threadIdx.x < 2) st0[threadIdx.x] = 0u; }
    __syncthreads();
    const XcdBarrier bar = xcd_barrier_post(p.ctl, (volatile LAS unsigned*)((LAS unsigned char*)smem + 131072));
    float* smf = (float*)smem;
    LAS unsigned char* lds = (LAS unsigned char*)smem;
    const int G = gridDim.x, b = blockIdx.x, NGW = G * 8;
#define PHASE_IDS() const int tid = opaque_tid(), lane = tid & 63, wave = __builtin_amdgcn_readfirstlane(tid >> 6), gw = b * 8 + wave; (void)lane; (void)gw

    REP(7) {
        PHASE_IDS();
        float* scr = smf + wave * 4096;
        constexpr int dummy_ = 0; (void)dummy_;
        constexpr int I_IN = 32 * 355, I_Q = 8 * 96, I_KV = 8 * 128, I_O = 64 * 64;
        for (int rp_ = 0; rp_ < (PROBE_P0 == 1 ? 2 : 1); ++rp_)
        for (int it = gw; it < I_IN + I_Q + I_KV + I_O; it += NGW) {
            int r = it;
            if (r < I_IN) { transpose_item(p.w_in, 2048, INW, p.WinT, DstWin(), scr, r, lane); continue; } r -= I_IN;
            if (r < I_Q) { transpose_item(p.w_q_up, 512, 3072, p.WqT, DstQ(), scr, r, lane, p.q_lat_g); continue; } r -= I_Q;
            if (r < I_KV) { transpose_item(p.w_kv_up, 512, 4096, p.WkvT, DstId(), scr, r, lane, p.kv_lat_g); continue; } r -= I_KV;
            transpose_item(p.w_out, 4096, 2048, p.WoT, DstId(), scr, r, lane);
        }
        for (int rp_ = 0; rp_ < (PROBE_P0 == 2 ? 2 : 1); ++rp_)
        for (int m = gw; m < S; m += NGW) rms_row2048(p.x + (size_t)m * DM, p.mix_g, p.h + (size_t)m * DM, lane);
        for (int idx = b * 512 + tid; idx < 16 * 64 * 64; idx += G * 512) { const int hh = idx >> 12, rr = (idx >> 6) & 63, c8 = idx & 63;
            *(u32x4*)(p.WqT + (size_t)(hh * 256 + 192 + rr) * 512 + c8 * 8) = (u32x4){0u, 0u, 0u, 0u}; }
        rope_table(p.pos, p.ropeT, b * 512 + tid, G * 512);
        __syncthreads();
        for (int rp_ = 0; rp_ < (PROBE_P0 == 3 ? 2 : 1); ++rp_)
        for (int it = b; it < 512; it += G) wfold_item(p.w_peer_q, p.sub_keys, p.WpT, smf, it);
    }
    xcd_barrier(bar);
    REP(1) {
        pg8::Gemm g{p.h, p.WinT, S, INWP, DM}; pg8::StaticOrder so; so.init(S, INWP, G, b);
        pg8::EpiInProj E{p.cq, p.ckv, p.fq, p.fk, p.fv, p.merged, p.kpe, p.lf, p.b_gate, p.b_forget, p.ssq, p.fox_qg, p.fox_kg, (LAS float*)(lds + 131072 + 64)};
        pg8::gemm_phase<pg8::EpiInProj, pg8::StaticOrder, true, true>(lds, g, so, E);
    }
    xcd_barrier(bar);
    for (int hh = b; hh < 16; hh += G) fox_cumsum((double*)smem, hh, p.lf, p.F);
    REP(2) {
        pg8::Gemm g{p.cq, p.WqT, S, 4096, 512}; pg8::StaticOrder so; so.init(S, 4096, G, b);
        pg8::EpiQ E{p.qa, p.ssq, p.mla_qg, p.ropeT, (LAS float*)(lds + 131072 + 64)};
        pg8::gemm_phase<pg8::EpiQ, pg8::StaticOrder, true, true>(lds, g, so, E);
    }
    {
        pg8::Gemm g{p.ckv, p.WkvT, S, 4096, 512}; pg8::StaticOrder so; so.init(S, 4096, G, b);
        pg8::EpiKV E{p.ka, p.va, p.kpe, p.ssq, p.mla_kg, p.ropeT, (LAS float*)(lds + 131072 + 64)};
        pg8::gemm_phase<pg8::EpiKV, pg8::StaticOrder, true, true>(lds, g, so, E);
    }
    xcd_barrier(bar);
    int side_next = 0;
    bool nomax_mla, nomax_fox;
    { const int ln = threadIdx.x & 63;
      float a = 0.f, c = 0.f;
      for (int j = ln; j < 192; j += 64) { a = fmaxf(a, fabsf(p.mla_qg[j])); c = fmaxf(c, fabsf(p.mla_kg[j])); }
      const float bm = 1.02f * 192.f * 0.10411754f * att::wave_max_f(a) * att::wave_max_f(c);
      float e = 0.f, f = 0.f;
      for (int j = ln; j < 128; j += 64) { e = fmaxf(e, fabsf(p.fox_qg[j])); f = fmaxf(f, fabsf(p.fox_kg[j])); }
      const float bf = 1.02f * 128.f * 0.12751743f * att::wave_max_f(e) * att::wave_max_f(f);
      nomax_mla = bm <= 80.f; nomax_fox = bf <= 80.f; }
    REP(3) for (int L = b; L < 1024; L += G) {
        const int i = L >> 8, vc = L & 255, vcx = (vc & 7) * 32 + (vc >> 3), hh = vcx >> 4, x = vcx & 15, qbk = (i & 1) ? x : 31 - x;
        if (i < 2) { if (nomax_mla) att::attn_block<192, false, true>(smem, p.qa + hh * 192, 3072, p.ka + hh * 192, 3072, p.va + hh * 128, 2048, nullptr, p.merged + hh * 128, p.attout + hh * 128, qbk, nullptr, nullptr, p.peer_u, p.peer_v, p.U8, p.V8, side_next); else att::attn_block<192, false, false>(smem, p.qa + hh * 192, 3072, p.ka + hh * 192, 3072, p.va + hh * 128, 2048, nullptr, p.merged + hh * 128, p.attout + hh * 128, qbk, nullptr, nullptr, p.peer_u, p.peer_v, p.U8, p.V8, side_next); }
        else { if (nomax_fox) att::attn_block<128, true, true>(smem, p.fq + hh * 128, 2048, p.fk + hh * 128, 2048, p.fv + hh * 128, 2048, p.F + (size_t)hh * S, p.merged + 2048 + hh * 128, p.attout + 2048 + hh * 128, qbk, p.fox_qg, p.fox_kg, p.peer_u, p.peer_v, p.U8, p.V8, side_next); else att::attn_block<128, true, false>(smem, p.fq + hh * 128, 2048, p.fk + hh * 128, 2048, p.fv + hh * 128, 2048, p.F + (size_t)hh * S, p.merged + 2048 + hh * 128, p.attout + 2048 + hh * 128, qbk, p.fox_qg, p.fox_kg, p.peer_u, p.peer_v, p.U8, p.V8, side_next); }
    }
    if (G == 256) { PHASE_IDS(); (void)wave;
        for (; side_next < 32; ++side_next) { const bool isv = side_next >= 16;
            fp6_cvt_rows(isv ? p.peer_v : p.peer_u, isv ? p.V8 : p.U8, b * 64 + (side_next & 15) * 4, 4, isv ? V_SCALE : U_SCALE, tid, 512); } }
    else { PHASE_IDS(); (void)wave; fp6_cvt_rows(p.peer_u, p.U8, 0, 16384, U_SCALE, b * 512 + tid, G * 512); fp6_cvt_rows(p.peer_v, p.V8, 0, 16384, V_SCALE, b * 512 + tid, G * 512); }
    xcd_barrier(bar);
    REP(4) {
        pg8::Gemm g{p.attout, p.WoT, S, 2048, 4096}; pg8::StaticOrder so; so.init(S, 2048, G, b);
        pg8::EpiX1 E{p.x1, p.x, p.xg, p.ffn_g, p.ssq2};
        pg8::gemm_phase<pg8::EpiX1, pg8::StaticOrder, true, true>(lds, g, so, E);
    }
    xcd_barrier(bar);
    REP(5) {
        pg8::Gemm g{p.xg, p.WpT, S, 2048, 2048}; pg8::StaticOrder so; so.init(S, 2048, G, b);
        pg8::EpiScores E{p.scores, p.ssq2};
        pg8::gemm_phase<pg8::EpiScores, pg8::StaticOrder, true, true>(lds, g, so, E);
    }
    xcd_barrier(bar);
    REP(6) for (int g = b; g < S / 32; g += G) peer_group(smem, g, p.scores, p.xg, p.ssq2, p.x1, p.U8, p.V8, p.out);
}

extern "C" void kernel_launch(void* const* d_in, const int* in_sizes, int n_in,
                              void* d_out, int out_size, void* d_ws, size_t ws_size,
                              hipStream_t stream) {
    if (ws_size < 512 * MiB) { fprintf(stderr, "kernel_launch: workspace too small (%zu)\n", ws_size); return; }
    Params p{};
    p.x = (const float*)d_in[0]; p.pos = (const int*)d_in[1]; p.mix_g = (const float*)d_in[2]; p.w_in = (const float*)d_in[3];
    p.b_forget = (const float*)d_in[4]; p.b_gate = (const float*)d_in[5]; p.q_lat_g = (const float*)d_in[6]; p.w_q_up = (const float*)d_in[7];
    p.kv_lat_g = (const float*)d_in[8]; p.w_kv_up = (const float*)d_in[9]; p.mla_qg = (const float*)d_in[10]; p.mla_kg = (const float*)d_in[11];
    p.fox_qg = (const float*)d_in[12]; p.fox_kg = (const float*)d_in[13]; p.w_out = (const float*)d_in[14]; p.ffn_g = (const float*)d_in[15];
    p.w_peer_q = (const float*)d_in[16]; p.sub_keys = (const float*)d_in[17]; p.peer_u = (const float*)d_in[18]; p.peer_v = (const float*)d_in[19];
    p.out = (float*)d_out;
    char* ws = (char*)d_ws;
    p.WqT = (bf16_t*)(ws + 1 * MiB); p.WkvT = (bf16_t*)(ws + 5 * MiB); p.WoT = (bf16_t*)(ws + 9 * MiB); p.WpT = (bf16_t*)(ws + 25 * MiB); p.WinT = (bf16_t*)(ws + 33 * MiB);
    p.h = (bf16_t*)(ws + 78 * MiB); p.cq = (bf16_t*)(ws + 110 * MiB); p.ckv = (bf16_t*)(ws + 118 * MiB);
    p.fq = (bf16_t*)(ws + 126 * MiB); p.fk = (bf16_t*)(ws + 158 * MiB); p.fv = (bf16_t*)(ws + 190 * MiB); p.merged = (bf16_t*)(ws + 222 * MiB);
    p.kpe = (bf16_t*)(ws + 286 * MiB); p.lf = (float*)(ws + 287 * MiB); p.F = (float*)(ws + 287 * MiB + 512 * 1024);
    p.qa = (bf16_t*)(ws + 288 * MiB); p.va = (bf16_t*)(ws + 336 * MiB); p.ka = (bf16_t*)(ws + 400 * MiB); p.x1 = (float*)(ws + 126 * MiB);
    p.scores = (float*)(ws + 222 * MiB);
    p.ctl = (unsigned*)ws;
    p.ropeT = (float2*)(ws + 448 * MiB);
    p.ssq = (float*)(ws + 64 * 1024);
    p.attout = (bf16_t*)(ws + 33 * MiB);
    p.U8 = (unsigned char*)(ws + 450 * MiB); p.V8 = (unsigned char*)(ws + 368 * MiB);
    p.xg = (bf16_t*)(ws + 190 * MiB);
    p.ssq2 = (float*)(ws + 482 * MiB);

    static int grid_blocks = 0;
    if (!grid_blocks) {
        if (hipFuncSetAttribute((const void*)mega, hipFuncAttributeMaxDynamicSharedMemorySize, LDS_BYTES) != hipSuccess) { fprintf(stderr, "hipFuncSetAttribute failed\n"); return; }
        int dev = 0, cus = 0, per_cu = 0;
        (void)hipGetDevice(&dev);
        (void)hipDeviceGetAttribute(&cus, hipDeviceAttributeMultiprocessorCount, dev);
        (void)hipOccupancyMaxActiveBlocksPerMultiprocessor(&per_cu, (const void*)mega, 512, LDS_BYTES);
        if (per_cu < 1 || cus < 1) { fprintf(stderr, "occupancy query says %d blocks/CU on %d CUs\n", per_cu, cus); return; }
        grid_blocks = cus;
    }
    if (hipMemsetAsync(d_ws, 0, 16384, stream) != hipSuccess) { fprintf(stderr, "memset of the barrier words failed\n"); return; }
    void* args[] = {&p};
    hipError_t e = hipLaunchCooperativeKernel((const void*)mega, dim3(grid_blocks), dim3(512), args, LDS_BYTES, stream);
    if (e != hipSuccess) fprintf(stderr, "cooperative launch failed: %s (grid %d)\n", hipGetErrorString(e), grid_blocks);
}
```

```cpp
#include <hip/hip_runtime.h>
#include <hip/hip_cooperative_groups.h>
#include <stdint.h>
#include <math.h>
#include <cstdio>
namespace cg = cooperative_groups;

namespace pg8 {
#define PG8_LAS __attribute__((address_space(3)))
typedef unsigned short bf16_t;
typedef short bf16x8 __attribute__((ext_vector_type(8)));
typedef float f32x4 __attribute__((ext_vector_type(4)));
typedef unsigned u32x4 __attribute__((ext_vector_type(4)));
constexpr int BM = 256, BK = 64, HALF = 128, HTB = HALF * BK * 2  , STAGE_BYTES = 8 * HTB, NXCD = 8, WGM = 8;

__host__ __device__ __forceinline__ int lds_byte(int r, int c) { const int st = (r >> 4) * 2 + (c >> 5), rr = r & 15, cc = c & 31, ob = rr * 64 + cc * 2; return st * 1024 + (ob ^ (((ob >> 9) & 1) << 5)); }
__host__ __device__ __forceinline__ void stage_rc(int b, int& R, int& C) { const int st = b / 1024, sb = b % 1024, swz = sb ^ (((sb >> 9) & 1) << 5); R = (st >> 1) * 16 + swz / 64; C = (st & 1) * 32 + (swz % 64) / 2; }
__host__ __device__ __forceinline__ int perm32(int rho) { const int n = rho >> 4, i = rho & 15; return 8 * (i >> 2) + 4 * n + (i & 3); }

struct Unit { int pm, pn; };
struct Gemm { const bf16_t* A; const bf16_t* Bt; int M, N, K; };

struct StaticOrder {
    int nM, nN, nwg, G, c;
    __host__ __device__ void init(int M, int N, int G_, int c_) { nM = M / BM; nN = N / BM; nwg = nM * nN; G = G_; c = c_; }
    __host__ __device__ bool next(int i, Unit& u) const {
        const long L = (long)i * G + c; if (L >= nwg) return false;
        int wgid = (int)L; { const int q = nwg / NXCD, r = nwg % NXCD, xcd = wgid % NXCD, off = wgid / NXCD; wgid = (xcd < r ? xcd * (q + 1) : r * (q + 1) + (xcd - r) * q) + off; }
        const int nig = WGM * nN, gid = wgid / nig, fm = gid * WGM, gsz = (nM - fm) < WGM ? (nM - fm) : WGM;
        u.pm = fm + ((wgid % nig) % gsz); u.pn = (wgid % nig) / gsz; return true;
    }
    __device__ __forceinline__ void a_ready(const Unit&) const {}
    __device__ __forceinline__ void done(const Unit&) const {}
};

typedef float cvt_pk_bf16_f32x2 __attribute__((ext_vector_type(2))); typedef __bf16 cvt_pk_bf16_bf16x2 __attribute__((ext_vector_type(2)));
__device__ __forceinline__ unsigned cvt_pk_bf16(float lo, float hi) { const cvt_pk_bf16_f32x2 v = {lo, hi}; const cvt_pk_bf16_bf16x2 b = __builtin_convertvector(v, cvt_pk_bf16_bf16x2); return __builtin_bit_cast(unsigned, b); }
__device__ __forceinline__ u32x4 pack8bf(const f32x4& v0, const f32x4& v1) { u32x4 w; w.x = cvt_pk_bf16(v0[0], v0[1]); w.y = cvt_pk_bf16(v0[2], v0[3]); w.z = cvt_pk_bf16(v1[0], v1[1]); w.w = cvt_pk_bf16(v1[2], v1[3]); return w; }

struct EpiStoreBf16 {
    static constexpr bool PERM = true, AFTER_DRAIN = false;
    bf16_t* O; int ldc;
    __device__ __forceinline__ void operator()(const f32x4 (&acc)[2][2][4][2], const Unit& u, int wr, int wc, int fr, int fq) const {
        const int row0 = u.pm * BM + wr * 64 + fr, col0 = u.pn * BM + wc * 32 + 8 * fq;
#pragma unroll
        for (int ai = 0; ai < 2; ++ai)
#pragma unroll
            for (int m = 0; m < 4; ++m) { bf16_t* rowp = O + (size_t)(row0 + ai * HALF + m * 16) * ldc + col0;
#pragma unroll
                for (int bj = 0; bj < 2; ++bj) *(u32x4*)(rowp + bj * HALF) = pack8bf(acc[ai][bj][m][0], acc[ai][bj][m][1]); }
    }
};
template <bool RES> struct EpiStoreF32 {
    static constexpr bool PERM = true, AFTER_DRAIN = false;
    float* O; const float* res; int ldc;
    __device__ __forceinline__ void operator()(const f32x4 (&acc)[2][2][4][2], const Unit& u, int wr, int wc, int fr, int fq) const {
        const int row0 = u.pm * BM + wr * 64 + fr, col0 = u.pn * BM + wc * 32 + 8 * fq;
#pragma unroll
        for (int ai = 0; ai < 2; ++ai)
#pragma unroll
            for (int m = 0; m < 4; ++m) { const size_t off = (size_t)(row0 + ai * HALF + m * 16) * ldc + col0;
#pragma unroll
                for (int bj = 0; bj < 2; ++bj) { f32x4 v0 = acc[ai][bj][m][0], v1 = acc[ai][bj][m][1];
                    if (RES) { v0 += *(const f32x4*)(res + off + bj * HALF); v1 += *(const f32x4*)(res + off + bj * HALF + 4); }
                    *(f32x4*)(O + off + bj * HALF) = v0; *(f32x4*)(O + off + bj * HALF + 4) = v1; } }
    }
};
#define EPI_LDSBAR() do { asm volatile("s_waitcnt lgkmcnt(0)" ::: "memory"); __builtin_amdgcn_s_barrier(); asm volatile("" ::: "memory"); } while (0)
struct EpiInProj {
    static constexpr bool PERM = true, AFTER_DRAIN = false;
    bf16_t *cq, *ckv, *fq, *fk, *fv, *gates, *kpe; float* lf; const float *b_gate, *b_forget; float* ssq; const float *gfq, *gfk; PG8_LAS float* xs;
    __device__ __forceinline__ void operator()(const f32x4 (&acc)[2][2][4][2], const Unit& u, int wr, int wc, int fr, int fq_) const {
        const int pn = u.pn, row0 = u.pm * BM + wr * 64 + fr, cw = wc * 32 + 8 * fq_;
        if (pn < 4) {
            bf16_t* base = pn < 2 ? cq : ckv; const int colt = (pn & 1) * 256;
#pragma unroll
            for (int ai = 0; ai < 2; ++ai)
#pragma unroll
                for (int m = 0; m < 4; ++m) { const int row = row0 + ai * HALF + m * 16; bf16_t* rowp = base + (size_t)row * 512 + colt + cw; float s = 0.f;
#pragma unroll
                    for (int bj = 0; bj < 2; ++bj) { const f32x4 v0 = acc[ai][bj][m][0], v1 = acc[ai][bj][m][1];
                        s += (v0[0] * v0[0] + v0[1] * v0[1]) + (v0[2] * v0[2] + v0[3] * v0[3]) + (v1[0] * v1[0] + v1[1] * v1[1]) + (v1[2] * v1[2] + v1[3] * v1[3]);
                        *(u32x4*)(rowp + bj * HALF) = pack8bf(v0, v1); }
                    s += __shfl_xor(s, 16); s += __shfl_xor(s, 32);
                    if (fq_ == 0) ssq[((size_t)pn * 8192 + row) * 4 + wc] = s; }
        } else if (pn < 20) {
            const bool isq = pn < 12; bf16_t* base = isq ? fq : fk; const int colt = (pn - (isq ? 4 : 12)) * 256; const float* g = isq ? gfq : gfk;
            const float qs = isq ? 0.12751743f : 1.f;
#pragma unroll
            for (int ai = 0; ai < 2; ++ai)
#pragma unroll
                for (int m = 0; m < 4; ++m)
#pragma unroll
                    for (int bj = 0; bj < 2; ++bj) { const f32x4 v0 = acc[ai][bj][m][0], v1 = acc[ai][bj][m][1];
                        float s = (v0[0] * v0[0] + v0[1] * v0[1]) + (v0[2] * v0[2] + v0[3] * v0[3]) + (v1[0] * v1[0] + v1[1] * v1[1]) + (v1[2] * v1[2] + v1[3] * v1[3]);
                        s += __shfl_xor(s, 16); s += __shfl_xor(s, 32);
                        if (fq_ == 0) xs[((ai * HALF + wr * 64 + m * 16 + fr) * 2 + bj) * 4 + wc] = s; }
            EPI_LDSBAR();
            const f32x4 g0 = *(const f32x4*)(g + cw) * qs, g1 = *(const f32x4*)(g + cw + 4) * qs;
#pragma unroll
            for (int ai = 0; ai < 2; ++ai)
#pragma unroll
                for (int m = 0; m < 4; ++m) { bf16_t* rowp = base + (size_t)(row0 + ai * HALF + m * 16) * 2048 + colt + cw;
#pragma unroll
                    for (int bj = 0; bj < 2; ++bj) { const f32x4 t4 = *(const PG8_LAS f32x4*)(xs + ((ai * HALF + wr * 64 + m * 16 + fr) * 2 + bj) * 4);
                        const float r = rsqrtf(((t4[0] + t4[1]) + (t4[2] + t4[3])) * (1.f / 128.f) + 1e-6f);
                        *(u32x4*)(rowp + bj * HALF) = pack8bf(acc[ai][bj][m][0] * g0 * r, acc[ai][bj][m][1] * g1 * r); } }
        } else if (pn < 28) {
            const int colt = (pn - 20) * 256;
#pragma unroll
            for (int ai = 0; ai < 2; ++ai)
#pragma unroll
                for (int m = 0; m < 4; ++m) { bf16_t* rowp = fv + (size_t)(row0 + ai * HALF + m * 16) * 2048 + colt + cw;
#pragma unroll
                    for (int bj = 0; bj < 2; ++bj) *(u32x4*)(rowp + bj * HALF) = pack8bf(acc[ai][bj][m][0], acc[ai][bj][m][1]); }
        } else if (pn < 44) {
            const int colt = (pn - 28) * 256 + cw;
#pragma unroll
            for (int bj = 0; bj < 2; ++bj) {
                const f32x4 b0 = *(const f32x4*)(b_gate + colt + bj * HALF), b1 = *(const f32x4*)(b_gate + colt + bj * HALF + 4);
#pragma unroll
                for (int ai = 0; ai < 2; ++ai)
#pragma unroll
                    for (int m = 0; m < 4; ++m) {
                        f32x4 v0 = acc[ai][bj][m][0] + b0, v1 = acc[ai][bj][m][1] + b1;
#pragma unroll
                        for (int e = 0; e < 4; ++e) { v0[e] = __builtin_amdgcn_rcpf(1.f + __expf(-v0[e])); v1[e] = __builtin_amdgcn_rcpf(1.f + __expf(-v1[e])); }
                        *(u32x4*)(gates + (size_t)(row0 + ai * HALF + m * 16) * 4096 + colt + bj * HALF) = pack8bf(v0, v1); }
            }
        } else {
            if (cw < 64) {
#pragma unroll
                for (int ai = 0; ai < 2; ++ai)
#pragma unroll
                    for (int m = 0; m < 4; ++m) *(u32x4*)(kpe + (size_t)(row0 + ai * HALF + m * 16) * 64 + cw) = pack8bf(acc[ai][0][m][0], acc[ai][0][m][1]);
            } else if (cw < 80) {
                const int h0 = cw - 64;
                const f32x4 b0 = *(const f32x4*)(b_forget + h0), b1 = *(const f32x4*)(b_forget + h0 + 4);
#pragma unroll
                for (int ai = 0; ai < 2; ++ai)
#pragma unroll
                    for (int m = 0; m < 4; ++m) { const int row = row0 + ai * HALF + m * 16;
                        f32x4 z0 = acc[ai][0][m][0] + b0, z1 = acc[ai][0][m][1] + b1;
#pragma unroll
                        for (int e = 0; e < 4; ++e) { z0[e] = fminf(z0[e], 0.f) - __logf(1.f + __expf(-fabsf(z0[e]))); z1[e] = fminf(z1[e], 0.f) - __logf(1.f + __expf(-fabsf(z1[e]))); }
                        *(f32x4*)(lf + (size_t)row * 16 + h0) = z0; *(f32x4*)(lf + (size_t)row * 16 + h0 + 4) = z1; }
            }
        }
    }
};
__device__ __forceinline__ float lat_rinv(const float* ssq, int part0, int row) {
    const f32x4 a = *(const f32x4*)(ssq + ((size_t)part0 * 8192 + row) * 4), b = *(const f32x4*)(ssq + ((size_t)(part0 + 1) * 8192 + row) * 4);
    return rsqrtf((((a[0] + a[1]) + (a[2] + a[3])) + ((b[0] + b[1]) + (b[2] + b[3]))) * (1.f / 512.f) + 1e-6f);
}
struct EpiQ {
    static constexpr bool PERM = true, AFTER_DRAIN = false;
    bf16_t* qa; const float* ssq; const float* gq; const float2* ropeT; PG8_LAS float* xs;
    __device__ __forceinline__ void operator()(const f32x4 (&acc)[2][2][4][2], const Unit& u, int wr, int wc, int fr, int fq_) const {
        const int h = u.pn, row0 = u.pm * BM + wr * 64 + fr, cw = wc * 32 + 8 * fq_;
        float rl[2][4];
#pragma unroll
        for (int ai = 0; ai < 2; ++ai)
#pragma unroll
            for (int m = 0; m < 4; ++m) { rl[ai][m] = lat_rinv(ssq, 0, row0 + ai * HALF + m * 16); float s = 0.f;
#pragma unroll
                for (int bj = 0; bj < 2; ++bj) { const f32x4 v0 = acc[ai][bj][m][0], v1 = acc[ai][bj][m][1];
                    s += (v0[0] * v0[0] + v0[1] * v0[1]) + (v0[2] * v0[2] + v0[3] * v0[3]) + (v1[0] * v1[0] + v1[1] * v1[1]) + (v1[2] * v1[2] + v1[3] * v1[3]); }
                s *= rl[ai][m] * rl[ai][m];
                s += __shfl_xor(s, 16); s += __shfl_xor(s, 32);
                if (fq_ == 0) xs[(ai * HALF + wr * 64 + m * 16 + fr) * 4 + wc] = s; }
        EPI_LDSBAR();
        const float qs = 0.10411754f;
        const f32x4 g0 = *(const f32x4*)(gq + cw) * qs, g1 = *(const f32x4*)(gq + cw + 4) * qs;
        const int pp = 16 * (wc & 1) + 4 * fq_;
        const f32x4 ga = *(const f32x4*)(gq + 128 + pp) * qs, gb = *(const f32x4*)(gq + 160 + pp) * qs;
#pragma unroll
        for (int ai = 0; ai < 2; ++ai)
#pragma unroll
            for (int m = 0; m < 4; ++m) { const int row = row0 + ai * HALF + m * 16;
                const f32x4 t4 = *(const PG8_LAS f32x4*)(xs + (ai * HALF + wr * 64 + m * 16 + fr) * 4);
                const float r = rsqrtf(((t4[0] + t4[1]) + (t4[2] + t4[3])) * (1.f / 192.f) + 1e-6f) * rl[ai][m];
                bf16_t* rowp = qa + (size_t)row * 3072 + h * 192;
                *(u32x4*)(rowp + cw) = pack8bf(acc[ai][0][m][0] * g0 * r, acc[ai][0][m][1] * g1 * r);
                if (wc < 2) { const f32x4 c01 = *(const f32x4*)(ropeT + (size_t)row * 32 + pp), c23 = *(const f32x4*)(ropeT + (size_t)row * 32 + pp + 2);
                    const f32x4 z0 = acc[ai][1][m][0] * r, z1 = acc[ai][1][m][1] * r;
                    const float a0 = z0[0] * ga[0], b0 = z0[1] * gb[0], a1 = z0[2] * ga[1], b1 = z0[3] * gb[1], a2 = z1[0] * ga[2], b2 = z1[1] * gb[2], a3 = z1[2] * ga[3], b3 = z1[3] * gb[3];
                    const f32x4 o0 = {a0 * c01[0] - b0 * c01[1], a0 * c01[1] + b0 * c01[0], a1 * c01[2] - b1 * c01[3], a1 * c01[3] + b1 * c01[2]};
                    const f32x4 o1 = {a2 * c23[0] - b2 * c23[1], a2 * c23[1] + b2 * c23[0], a3 * c23[2] - b3 * c23[3], a3 * c23[3] + b3 * c23[2]};
                    *(u32x4*)(rowp + 128 + cw) = pack8bf(o0, o1); } }
    }
};
struct EpiKV {
    static constexpr bool PERM = true, AFTER_DRAIN = false;
    bf16_t *ka, *va; const bf16_t* kpe; const float* ssq; const float* gk; const float2* ropeT; PG8_LAS float* xs;
    __device__ __forceinline__ void operator()(const f32x4 (&acc)[2][2][4][2], const Unit& u, int wr, int wc, int fr, int fq_) const {
        const int h = u.pn, row0 = u.pm * BM + wr * 64 + fr, cw = wc * 32 + 8 * fq_;
        float rl[2][4]; f32x4 kp[2][4];
#pragma unroll
        for (int ai = 0; ai < 2; ++ai)
#pragma unroll
            for (int m = 0; m < 4; ++m) { const int row = row0 + ai * HALF + m * 16; rl[ai][m] = lat_rinv(ssq, 2, row);
                const uint2 w = *(const uint2*)(kpe + (size_t)row * 64 + 16 * wc + 4 * fq_);
                kp[ai][m] = (f32x4){__uint_as_float(w.x << 16), __uint_as_float(w.x & 0xffff0000u), __uint_as_float(w.y << 16), __uint_as_float(w.y & 0xffff0000u)};
                const f32x4 v0 = acc[ai][0][m][0], v1 = acc[ai][0][m][1];
                float s = ((v0[0] * v0[0] + v0[1] * v0[1]) + (v0[2] * v0[2] + v0[3] * v0[3]) + (v1[0] * v1[0] + v1[1] * v1[1]) + (v1[2] * v1[2] + v1[3] * v1[3])) * (rl[ai][m] * rl[ai][m]);
                s += (kp[ai][m][0] * kp[ai][m][0] + kp[ai][m][1] * kp[ai][m][1]) + (kp[ai][m][2] * kp[ai][m][2] + kp[ai][m][3] * kp[ai][m][3]);
                s += __shfl_xor(s, 16); s += __shfl_xor(s, 32);
                if (fq_ == 0) xs[(ai * HALF + wr * 64 + m * 16 + fr) * 4 + wc] = s;
                *(u32x4*)(va + (size_t)row * 2048 + h * 128 + cw) = pack8bf(acc[ai][1][m][0] * rl[ai][m], acc[ai][1][m][1] * rl[ai][m]); }
        EPI_LDSBAR();
        const f32x4 g0 = *(const f32x4*)(gk + cw), g1 = *(const f32x4*)(gk + cw + 4);
        const int pp = 8 * wc + 2 * fq_;
        const float ga0 = gk[128 + pp], ga1 = gk[128 + pp + 1], gb0 = gk[160 + pp], gb1 = gk[160 + pp + 1];
#pragma unroll
        for (int ai = 0; ai < 2; ++ai)
#pragma unroll
            for (int m = 0; m < 4; ++m) { const int row = row0 + ai * HALF + m * 16;
                const f32x4 t4 = *(const PG8_LAS f32x4*)(xs + (ai * HALF + wr * 64 + m * 16 + fr) * 4);
                const float r = rsqrtf(((t4[0] + t4[1]) + (t4[2] + t4[3])) * (1.f / 192.f) + 1e-6f), rn = r * rl[ai][m];
                bf16_t* rowp = ka + (size_t)row * 3072 + h * 192;
                *(u32x4*)(rowp + cw) = pack8bf(acc[ai][0][m][0] * g0 * rn, acc[ai][0][m][1] * g1 * rn);
                const f32x4 cs = *(const f32x4*)(ropeT + (size_t)row * 32 + pp);
                const float a0 = kp[ai][m][0] * r * ga0, b0 = kp[ai][m][1] * r * gb0, a1 = kp[ai][m][2] * r * ga1, b1 = kp[ai][m][3] * r * gb1;
                uint2 o; o.x = cvt_pk_bf16(a0 * cs[0] - b0 * cs[1], a0 * cs[1] + b0 * cs[0]); o.y = cvt_pk_bf16(a1 * cs[2] - b1 * cs[3], a1 * cs[3] + b1 * cs[2]);
                *(uint2*)(rowp + 128 + 16 * wc + 4 * fq_) = o; }
    }
};

struct EpiX1 {
    static constexpr bool PERM = true, AFTER_DRAIN = false;
    float* x1; const float* x; bf16_t* xg; const float* g; float* ssq2;
    __device__ __forceinline__ void operator()(const f32x4 (&acc)[2][2][4][2], const Unit& u, int wr, int wc, int fr, int fq_) const {
        const int row0 = u.pm * BM + wr * 64 + fr, col0 = u.pn * BM + wc * 32 + 8 * fq_;
        f32x4 gg[2][2];
#pragma unroll
        for (int bj = 0; bj < 2; ++bj) { gg[bj][0] = *(const f32x4*)(g + col0 + bj * HALF); gg[bj][1] = *(const f32x4*)(g + col0 + bj * HALF + 4); }
#pragma unroll
        for (int ai = 0; ai < 2; ++ai)
#pragma unroll
            for (int m = 0; m < 4; ++m) { const int row = row0 + ai * HALF + m * 16; const size_t off = (size_t)row * 2048 + col0; float s = 0.f;
#pragma unroll
                for (int bj = 0; bj < 2; ++bj) { const f32x4 v0 = acc[ai][bj][m][0] + *(const f32x4*)(x + off + bj * HALF), v1 = acc[ai][bj][m][1] + *(const f32x4*)(x + off + bj * HALF + 4);
                    *(f32x4*)(x1 + off + bj * HALF) = v0; *(f32x4*)(x1 + off + bj * HALF + 4) = v1;
                    s += (v0[0] * v0[0] + v0[1] * v0[1]) + (v0[2] * v0[2] + v0[3] * v0[3]) + (v1[0] * v1[0] + v1[1] * v1[1]) + (v1[2] * v1[2] + v1[3] * v1[3]);
                    *(u32x4*)(xg + off + bj * HALF) = pack8bf(v0 * gg[bj][0], v1 * gg[bj][1]); }
                s += __shfl_xor(s, 16); s += __shfl_xor(s, 32);
                if (fq_ == 0) ssq2[((size_t)u.pn * 8192 + row) * 4 + wc] = s; }
    }
};
__device__ __forceinline__ float ffn_rinv(const float* ssq2, int row) {
    float t = 0.f;
#pragma unroll
    for (int pn = 0; pn < 8; ++pn) { const f32x4 a = *(const f32x4*)(ssq2 + ((size_t)pn * 8192 + row) * 4); t += (a[0] + a[1]) + (a[2] + a[3]); }
    return rsqrtf(t * (1.f / 2048.f) + 1e-6f);
}
struct EpiScores {
    static constexpr bool PERM = true, AFTER_DRAIN = false;
    float* O; const float* ssq2;
    __device__ __forceinline__ void operator()(const f32x4 (&acc)[2][2][4][2], const Unit& u, int wr, int wc, int fr, int fq_) const {
        const int row0 = u.pm * BM + wr * 64 + fr, col0 = u.pn * BM + wc * 32 + 8 * fq_;
#pragma unroll
        for (int ai = 0; ai < 2; ++ai)
#pragma unroll
            for (int m = 0; m < 4; ++m) { const int row = row0 + ai * HALF + m * 16; const float r = ffn_rinv(ssq2, row); const size_t off = (size_t)row * 2048 + col0;
#pragma unroll
                for (int bj = 0; bj < 2; ++bj) { *(f32x4*)(O + off + bj * HALF) = acc[ai][bj][m][0] * r; *(f32x4*)(O + off + bj * HALF + 4) = acc[ai][bj][m][1] * r; } }
    }
};
template <class Epi, class Sched, bool ALIGN_EPI = false, bool SP2 = false>
__device__ __forceinline__ void gemm_phase(PG8_LAS unsigned char* lds, const Gemm g, const Sched& S, const Epi& E) {
    int tid = threadIdx.x; asm volatile("" : "+v"(tid));
    const int wid = __builtin_amdgcn_readfirstlane(tid >> 6), lane = tid & 63, wr = wid >> 2, wc = wid & 3, fr = lane & 15, fq = lane >> 4;
    const int K = g.K, nt = K / BK;
    unsigned voffA[2], voffB[2];
#pragma unroll
    for (int i = 0; i < 2; ++i) { int R, C; stage_rc(tid * 16 + i * 8192, R, C); const int Rb = Epi::PERM ? ((R & ~31) + perm32(R & 31)) : R;
        voffA[i] = (unsigned)(R * K + C) * 2u; voffB[i] = (unsigned)(Rb * K + C) * 2u; }
    const size_t kstep = (size_t)(BK * 2);
    const size_t hstep = (size_t)HALF * K * 2;
    const size_t tstep = 2 * hstep;
    const unsigned ldsw = (unsigned)wid * 1024u;
    const int aoff = lds_byte(wr * 64 + fr, fq * 8), boff = lds_byte(wc * 32 + fr, fq * 8);
#define PG8_SA(b, h) (((b) * 2 + (h)) * HTB)
#define PG8_SB(b, h) ((4 + (b) * 2 + (h)) * HTB)
#define PG8_STAGE(bufoff, gbase, voff) do { _Pragma("unroll") for (int _i = 0; _i < 2; ++_i) \
        __builtin_amdgcn_global_load_lds((const unsigned*)((const char*)(gbase) + (voff)[_i]), (PG8_LAS unsigned*)(lds + (bufoff) + ldsw + _i * 8192), 16, 0, 0); } while (0)
#define PG8_LDA(dst, b, h) do { _Pragma("unroll") for (int m = 0; m < 4; ++m) _Pragma("unroll") for (int k = 0; k < 2; ++k) dst[m][k] = *(const PG8_LAS bf16x8*)(lds + PG8_SA(b, h) + aoff + m * 2048 + k * 1024); } while (0)
#define PG8_LDB(dst, b, h) do { _Pragma("unroll") for (int n = 0; n < 2; ++n) _Pragma("unroll") for (int k = 0; k < 2; ++k) dst[n][k] = *(const PG8_LAS bf16x8*)(lds + PG8_SB(b, h) + boff + n * 2048 + k * 1024); } while (0)
#define PG8_MMA(ai, bj, At, Bt) do { __builtin_amdgcn_s_setprio(1); _Pragma("unroll") for (int m = 0; m < 4; ++m) _Pragma("unroll") for (int n = 0; n < 2; ++n) _Pragma("unroll") for (int k = 0; k < 2; ++k) \
        acc[ai][bj][m][n] = __builtin_amdgcn_mfma_f32_16x16x32_bf16(Bt[n][k], At[m][k], acc[ai][bj][m][n], 0, 0, 0); __builtin_amdgcn_s_setprio(0); } while (0)
#define PG8_WAIT_V(n) asm volatile("s_waitcnt vmcnt(" #n ")" ::: "memory")
#define PG8_WAIT_L(n) asm volatile("s_waitcnt lgkmcnt(" #n ")" ::: "memory")
#define PG8_BAR __builtin_amdgcn_s_barrier()
#define PG8_SCHED __builtin_amdgcn_sched_barrier(0)
    Unit cur, nxt; int ui = 0;
    if (!S.next(0, cur)) return;
    f32x4 acc[2][2][4][2];
#pragma unroll
    for (int a = 0; a < 2; ++a)
#pragma unroll
        for (int b = 0; b < 2; ++b)
#pragma unroll
            for (int m = 0; m < 4; ++m)
#pragma unroll
                for (int n = 0; n < 2; ++n) acc[a][b][m][n] = (f32x4){0.f, 0.f, 0.f, 0.f};
    bf16x8 At[4][2], B0[2][2], B1[2][2];
    const char* cA = (const char*)g.A + (size_t)cur.pm * tstep; const char* cB = (const char*)g.Bt + (size_t)cur.pn * tstep;
    S.a_ready(cur);
    if constexpr (SP2) {
        PG8_STAGE(PG8_SB(0, 0), cB, voffB); PG8_STAGE(PG8_SB(0, 1), cB + hstep, voffB); PG8_STAGE(PG8_SA(0, 0), cA, voffA); PG8_STAGE(PG8_SA(0, 1), cA + hstep, voffA);
        if (wr == 1) PG8_BAR;
        PG8_WAIT_V(2); PG8_BAR;
        PG8_STAGE(PG8_SB(1, 0), cB + kstep, voffB); PG8_STAGE(PG8_SA(1, 0), cA + kstep, voffA); PG8_STAGE(PG8_SB(1, 1), cB + hstep + kstep, voffB);
        PG8_WAIT_V(6); PG8_BAR;
    } else {
        PG8_STAGE(PG8_SB(0, 0), cB, voffB); PG8_STAGE(PG8_SA(0, 0), cA, voffA); PG8_STAGE(PG8_SB(0, 1), cB + hstep, voffB); PG8_STAGE(PG8_SA(0, 1), cA + hstep, voffA);
        if (wr == 1) PG8_BAR;
        PG8_WAIT_V(4); PG8_BAR;
        PG8_STAGE(PG8_SB(1, 0), cB + kstep, voffB); PG8_STAGE(PG8_SA(1, 0), cA + kstep, voffA); PG8_STAGE(PG8_SB(1, 1), cB + hstep + kstep, voffB);
        PG8_WAIT_V(6); PG8_BAR;
    }
    for (;;) {
        const bool has_next = S.next(ui + 1, nxt);
        const char* nA = has_next ? (const char*)g.A + (size_t)nxt.pm * tstep : cA; const char* nB = has_next ? (const char*)g.Bt + (size_t)nxt.pn * tstep : cB;
        for (int t = 0; t < nt; t += 2) {
            const bool last = (t == nt - 2);
            const char* a1 = cA + (size_t)(t + 1) * kstep;
            const char* a2 = last ? nA : cA + (size_t)(t + 2) * kstep; const char* b2 = last ? nB : cB + (size_t)(t + 2) * kstep;
            const char* a3 = a2 + kstep; const char* b3 = b2 + kstep;
            if (last && has_next) S.a_ready(nxt);
            if constexpr (SP2) {
            PG8_LDB(B0, 0, 0); PG8_LDB(B1, 0, 1); PG8_SCHED; PG8_LDA(At, 0, 0); PG8_STAGE(PG8_SA(1, 1), a1 + hstep, voffA);
            PG8_WAIT_V(8); PG8_WAIT_L(0); PG8_BAR; PG8_MMA(0, 0, At, B0); PG8_MMA(0, 1, At, B1); PG8_BAR; PG8_SCHED;
            PG8_LDA(At, 0, 1); PG8_STAGE(PG8_SB(0, 0), b2, voffB); PG8_STAGE(PG8_SB(0, 1), b2 + hstep, voffB); PG8_STAGE(PG8_SA(0, 0), a2, voffA);
            PG8_WAIT_V(8); PG8_WAIT_L(0); PG8_BAR; PG8_MMA(1, 0, At, B0); PG8_MMA(1, 1, At, B1); PG8_BAR; PG8_SCHED;
            PG8_LDB(B0, 1, 0); PG8_LDB(B1, 1, 1); PG8_SCHED; PG8_LDA(At, 1, 0); PG8_STAGE(PG8_SA(0, 1), a2 + hstep, voffA);
            PG8_WAIT_V(8); PG8_WAIT_L(0); PG8_BAR; PG8_MMA(0, 0, At, B0); PG8_MMA(0, 1, At, B1); PG8_BAR; PG8_SCHED;
            PG8_LDA(At, 1, 1); PG8_STAGE(PG8_SB(1, 0), b3, voffB); PG8_STAGE(PG8_SB(1, 1), b3 + hstep, voffB); PG8_STAGE(PG8_SA(1, 0), a3, voffA);
            PG8_WAIT_V(8); PG8_WAIT_L(0); PG8_BAR; PG8_MMA(1, 0, At, B0); PG8_MMA(1, 1, At, B1); PG8_BAR; PG8_SCHED;
            } else {
            PG8_LDB(B0, 0, 0); PG8_SCHED; PG8_LDA(At, 0, 0); PG8_STAGE(PG8_SA(1, 1), a1 + hstep, voffA);
            PG8_WAIT_L(8); PG8_BAR; PG8_WAIT_L(0); PG8_MMA(0, 0, At, B0); PG8_BAR; PG8_SCHED;
            PG8_LDB(B1, 0, 1); PG8_STAGE(PG8_SB(0, 0), b2, voffB);
            PG8_BAR; PG8_WAIT_L(0); PG8_MMA(0, 1, At, B1); PG8_BAR;
            PG8_LDA(At, 0, 1); PG8_STAGE(PG8_SA(0, 0), a2, voffA);
            PG8_BAR; PG8_WAIT_L(0); PG8_MMA(1, 0, At, B0); PG8_BAR; PG8_SCHED;
            PG8_STAGE(PG8_SB(0, 1), b2 + hstep, voffB);
            PG8_WAIT_V(6); PG8_BAR; PG8_MMA(1, 1, At, B1); PG8_BAR;
            PG8_LDB(B0, 1, 0); PG8_SCHED; PG8_LDA(At, 1, 0); PG8_STAGE(PG8_SA(0, 1), a2 + hstep, voffA);
            PG8_WAIT_L(8); PG8_BAR; PG8_WAIT_L(0); PG8_MMA(0, 0, At, B0); PG8_BAR; PG8_SCHED;
            PG8_LDB(B1, 1, 1); PG8_STAGE(PG8_SB(1, 0), b3, voffB);
            PG8_BAR; PG8_WAIT_L(0); PG8_MMA(0, 1, At, B1); PG8_BAR;
            PG8_LDA(At, 1, 1); PG8_STAGE(PG8_SA(1, 0), a3, voffA);
            PG8_BAR; PG8_WAIT_L(0); PG8_MMA(1, 0, At, B0); PG8_BAR; PG8_SCHED;
            PG8_STAGE(PG8_SB(1, 1), b3 + hstep, voffB);
            PG8_WAIT_V(6); PG8_BAR; PG8_MMA(1, 1, At, B1); PG8_BAR;
            }
        }
        if constexpr (ALIGN_EPI) { if (wr == 0) PG8_BAR; }
        if constexpr (!Epi::AFTER_DRAIN) { E(acc, cur, wr, wc, fr, fq); S.done(cur); }
        if (!has_next) break;
#pragma unroll
        for (int a = 0; a < 2; ++a)
#pragma unroll
            for (int b = 0; b < 2; ++b)
#pragma unroll
                for (int m = 0; m < 4; ++m)
#pragma unroll
                    for (int n = 0; n < 2; ++n) acc[a][b][m][n] = (f32x4){0.f, 0.f, 0.f, 0.f};
        cur = nxt; cA = nA; cB = nB; ++ui;
        if constexpr (ALIGN_EPI) { if (wr == 1) PG8_BAR; }
    }
    PG8_WAIT_V(0);
    if constexpr (!ALIGN_EPI) { if (wr == 0) PG8_BAR; }
    PG8_BAR;
    if constexpr (Epi::AFTER_DRAIN) { E.fused(acc, cur, wr, wc, fr, fq, lds, wid, lane); S.done(cur); }
#undef PG8_SA
#undef PG8_SB
#undef PG8_STAGE
#undef PG8_LDA
#undef PG8_LDB
#undef PG8_MMA
#undef PG8_WAIT_V
#undef PG8_WAIT_L
#undef PG8_BAR
#undef PG8_SCHED
}
}
namespace att {
typedef unsigned short bf16_t;
typedef short bf16x8 __attribute__((ext_vector_type(8)));
typedef short s16x4 __attribute__((ext_vector_type(4)));
typedef float f32x16 __attribute__((ext_vector_type(16)));
typedef float f32x4 __attribute__((ext_vector_type(4)));
typedef unsigned u32x4 __attribute__((ext_vector_type(4)));
#define ALAS __attribute__((address_space(3)))
#define ASBAR() __builtin_amdgcn_sched_barrier(0)
constexpr int SHM_V = 16384;
template <int DK> struct Lay { static constexpr int ROWB = DK * 2, SHM_K = 64 * ROWB, OFF_K = 2 * SHM_V, OFF_F = OFF_K + 2 * SHM_K, OFF_WS = OFF_F + 512, TOTAL = OFF_WS + 8 * 256; };

__device__ __forceinline__ int v_st(int k, int c) { const int kk = (k & ~0xC) | ((k & 4) << 1) | ((k & 8) >> 1); return ((kk >> 3) * 4 + (c >> 5)) * 512 + ((kk & 7) * 32 + (c & 31)) * 2; }
__device__ __forceinline__ int v_rd_base(int lane) { return ((lane & 3) << 3) | (((lane >> 2) & 3) << 6) | (((lane >> 4) & 1) << 5) | (((lane >> 5) & 1) << 8); }
__device__ __forceinline__ int crow(int r, int hi) { return (r & 3) + 8 * (r >> 2) + 4 * hi; }
typedef float cvtpk_f32x2 __attribute__((ext_vector_type(2))); typedef __bf16 cvtpk_bf16x2 __attribute__((ext_vector_type(2)));
__device__ __forceinline__ unsigned cvtpk(float lo, float hi) { const cvtpk_f32x2 v = {lo, hi}; const cvtpk_bf16x2 b = __builtin_convertvector(v, cvtpk_bf16x2); return __builtin_bit_cast(unsigned, b); }

__device__ __forceinline__ float wave_max_f(float v) {
#pragma unroll
    for (int o = 32; o >= 1; o >>= 1) v = fmaxf(v, __shfl_xor(v, o));
    return v;
}
__device__ __forceinline__ float att_max3(float a, float b, float c) { return __builtin_fmaxf(__builtin_fmaxf(a, b), c); }
typedef float f32x16v __attribute__((ext_vector_type(16)));
typedef unsigned u32x6v __attribute__((ext_vector_type(6)));
constexpr int ROW6 = 1536;
__device__ __forceinline__ void fp6_put(unsigned char* __restrict__ T6, int row, int hf, int l, int g, f32x16v f0, f32x16v f1, float sc) {
    f0 *= sc; f1 *= sc;
    f32x16v ev, od;
#pragma unroll
    for (int k = 0; k < 8; ++k) { ev[k] = f0[2 * k]; od[k] = f0[2 * k + 1]; ev[8 + k] = f1[2 * k]; od[8 + k] = f1[2 * k + 1]; }
    const u32x6v w = __builtin_amdgcn_cvt_scalef32_2xpk16_fp6_f32(ev, od, 1.0f);
    unsigned char* base = T6 + (size_t)row * ROW6 + hf * 768 + l * 16;
    if (g == 0) { *(u32x4*)base = (u32x4){w[0], w[1], w[2], w[3]}; *(uint2*)(base + 256) = make_uint2(w[4], w[5]); }
    else { *(uint2*)(base + 264) = make_uint2(w[0], w[1]); *(u32x4*)(base + 512) = (u32x4){w[2], w[3], w[4], w[5]}; }
}
constexpr int SIDE_STG = 86016;
template <int DK, bool FOX, bool NOMAX>
__device__ __forceinline__ void attn_block(unsigned char* smem, const bf16_t* __restrict__ Q, int ldq, const bf16_t* __restrict__ K, int ldk, const bf16_t* __restrict__ V, int ldv,
                                           const float* __restrict__ Fh, const bf16_t* __restrict__ gate, bf16_t* __restrict__ gout  , int qbk, const float* __restrict__ gq, const float* __restrict__ gk  ,
                                           const float* __restrict__ side_u, const float* __restrict__ side_v, unsigned char* __restrict__ side_u8, unsigned char* __restrict__ side_v8, int& side_next) {
    typedef Lay<DK> LY;
    constexpr int ND = DK / 16, NKC = DK / 8, NKI = (64 * NKC) / 512;
    int tid = threadIdx.x; asm volatile("" : "+v"(tid));
    const int wid = __builtin_amdgcn_readfirstlane(tid >> 6), lane = tid & 63, r32 = lane & 31, hi = lane >> 5;
    const int q0 = qbk * 256, qlo = q0 + wid * 32, qm = qlo + r32 - 4 * hi;
    const int NT = 4 * qbk + 4;
    ALAS unsigned char* lds = (ALAS unsigned char*)smem;
    ALAS float* F_lds = (ALAS float*)(lds + LY::OFF_F);
    ALAS float* wsl = (ALAS float*)(lds + LY::OFF_WS) + wid * 64;
    bf16x8 qr[ND];
#pragma unroll
    for (int d0 = 0; d0 < ND; ++d0) qr[d0] = *(const bf16x8*)(Q + (size_t)(qlo + r32) * ldq + d0 * 16 + hi * 8);
    const float fq = FOX ? Fh[qlo + r32] : 0.f;
    int kgo[NKI], vgo[2];
#pragma unroll
    for (int i = 0; i < NKI; ++i) { const int pp = (wid * NKI + i) * 64 + lane, row = pp / NKC, cpos = pp % NKC, ch = cpos ^ ((row >> 1) & 7); kgo[i] = row * ldk + ch * 8; }
#pragma unroll
    for (int i = 0; i < 2; ++i) { const int o = ((wid * 2 + i) * 64 + lane) * 16, st = o >> 9, e = (o & 511) >> 1, kk = (st >> 2) * 8 + (e >> 5), c = (st & 3) * 32 + (e & 31);
        const int k = (kk & ~0xC) | ((kk & 4) << 1) | ((kk & 8) >> 1); vgo[i] = k * ldv + c; }
    const int vb0 = (int)(uintptr_t)smem + v_rd_base(lane);
    int kbase[4];
#pragma unroll
    for (int dd = 0; dd < 4; ++dd) kbase[dd] = LY::OFF_K + r32 * LY::ROWB + (((((dd << 1) | hi) ^ ((r32 >> 1) & 7))) << 4);
    float stf = 0.f;
#define ATT_GLDS(kb, bf) do { _Pragma("unroll") for (int i = 0; i < NKI; ++i) \
            __builtin_amdgcn_global_load_lds((const unsigned*)(K + (size_t)(kb) * ldk + kgo[i]), (ALAS unsigned*)(lds + LY::OFF_K + (bf) * LY::SHM_K + (wid * NKI + i) * 1024), 16, 0, 0); \
        _Pragma("unroll") for (int i = 0; i < 2; ++i) \
            __builtin_amdgcn_global_load_lds((const unsigned*)(V + (size_t)(kb) * ldv + vgo[i]), (ALAS unsigned*)(lds + (bf) * SHM_V + (wid * 2 + i) * 1024), 16, 0, 0); \
        if (FOX && tid < 64) stf = Fh[(kb) + tid]; } while (0)
#define ATT_WRITEF(bf) do { if (FOX && tid < 64) F_lds[(bf) * 64 + tid] = stf; } while (0)
    int t_start = 0; float m_init = 0.f;
    if (FOX) {
        const float gqm = wave_max_f(fmaxf(fabsf(gq[lane]), fabsf(gq[lane + 64]))), gkm = wave_max_f(fmaxf(fabsf(gk[lane]), fabsf(gk[lane + 64])));
        const float qk_bound = 0.12751743f * 128.f * gqm * gkm;
        const float thr = 2.02f * qk_bound + 40.f, f0 = Fh[q0]; m_init = -thr;
        const int j0 = lane, j1 = lane + 64;
        const bool c0 = (j0 < 4 * qbk) && (Fh[j0 * 64 + 63] - f0 >= thr), c1 = (j1 < 4 * qbk) && (Fh[(j1 < 4 * qbk ? j1 : 0) * 64 + 63] - f0 >= thr);
        t_start = __builtin_popcountll(__ballot(c0)) + __builtin_popcountll(__ballot(c1));
        t_start = __builtin_amdgcn_readfirstlane(t_start); }
    ATT_GLDS(t_start * 64, t_start & 1); ATT_WRITEF(t_start & 1);
    float m_reg = FOX ? m_init : 0.f, l_reg = 0.f; f32x16 o[4];
#pragma unroll
    for (int d = 0; d < 4; ++d)
#pragma unroll
        for (int r = 0; r < 16; ++r) o[d][r] = 0.f;
    int side_pend = -1;
    for (int t = t_start; t < NT; ++t) {
        const int buf = t & 1, kb = t * 64;
        asm volatile("s_waitcnt vmcnt(0)" ::: "memory");
        __syncthreads();
        if (t + 1 < NT) ATT_GLDS(kb + 64, buf ^ 1);
        if (side_pend >= 0) { const int sv = side_pend; side_pend = -1;
            if ((wid >> 2) == (sv & 1)) {
                const int c = tid & 255, rr = c >> 6, hf2 = (c >> 5) & 1, l = (c >> 1) & 15, g = c & 1;
                const ALAS float* sp = (const ALAS float*)(lds + SIDE_STG) + rr * 2048 + hf2 * 1024 + (2 * g) * 256 + l * 16;
                f32x16v f0, f1;
#pragma unroll
                for (int k = 0; k < 4; ++k) { const f32x4 a = *(const ALAS f32x4*)(sp + 4 * k), b2 = *(const ALAS f32x4*)(sp + 256 + 4 * k);
#pragma unroll
                    for (int e = 0; e < 4; ++e) { f0[4 * k + e] = a[e]; f1[4 * k + e] = b2[e]; } }
                const bool isv = sv >= 16;
                fp6_put(isv ? side_v8 : side_u8, blockIdx.x * 64 + (sv & 15) * 4 + rr, hf2, l, g, f0, f1, isv ? 4.f : 64.f); }
        } else if (side_next < 32 && t + 1 < NT) { const int sv = side_next; const bool isv = sv >= 16;
            const float* src = (isv ? side_v : side_u) + (size_t)(blockIdx.x * 64 + (sv & 15) * 4) * 2048;
#pragma unroll
            for (int i = 0; i < 4; ++i)
                __builtin_amdgcn_global_load_lds((const unsigned*)(src + ((i * 8 + wid) * 64 + lane) * 4), (ALAS unsigned*)(lds + SIDE_STG + (i * 8 + wid) * 1024), 16, 0, 0);
            side_pend = sv; ++side_next; }
        f32x16 p0, p1;
        if (FOX) { const float fqm = NOMAX ? fq : fq - m_reg;
#pragma unroll
            for (int g = 0; g < 4; ++g) { const f32x4 f0 = *(const ALAS f32x4*)(F_lds + buf * 64 + 8 * g + 4 * hi), f1 = *(const ALAS f32x4*)(F_lds + buf * 64 + 32 + 8 * g + 4 * hi);
#pragma unroll
                for (int e = 0; e < 4; ++e) { p0[4 * g + e] = fqm - f0[e]; p1[4 * g + e] = fqm - f1[e]; } }
        } else if (NOMAX) {
#pragma unroll
            for (int r = 0; r < 16; ++r) { p0[r] = 0.f; p1[r] = 0.f; }
        } else { const float nm = -m_reg;
#pragma unroll
            for (int r = 0; r < 16; ++r) { p0[r] = nm; p1[r] = nm; }
        }
        {
            constexpr int KPF = 2;
            int ka[4];
#pragma unroll
            for (int dd = 0; dd < 4; ++dd) ka[dd] = (int)(uintptr_t)smem + buf * LY::SHM_K + kbase[dd];
            bf16x8 kb0[KPF + 1], kb1[KPF + 1];
#define ATT_KRD(dst, addr, off) asm volatile("ds_read_b128 %0, %1 offset:%2" : "=&v"(dst) : "v"(addr), "i"(off) : "memory")
#pragma unroll
            for (int d0 = 0; d0 < KPF; ++d0) { ATT_KRD(kb0[d0 % (KPF + 1)], ka[d0 & 3], (d0 >> 2) * 128); ATT_KRD(kb1[d0 % (KPF + 1)], ka[d0 & 3], (d0 >> 2) * 128 + 32 * LY::ROWB); }
#pragma unroll
            for (int d0 = 0; d0 < ND; ++d0) {
                if (d0 + KPF < ND) { constexpr int dummy = 0; (void)dummy;
                    ATT_KRD(kb0[(d0 + KPF) % (KPF + 1)], ka[(d0 + KPF) & 3], ((d0 + KPF) >> 2) * 128); ATT_KRD(kb1[(d0 + KPF) % (KPF + 1)], ka[(d0 + KPF) & 3], ((d0 + KPF) >> 2) * 128 + 32 * LY::ROWB); }
                const int rem = (ND - 1 - d0) < KPF ? (ND - 1 - d0) : KPF;
                if (rem >= 2) asm volatile("s_waitcnt lgkmcnt(4)" ::: "memory");
                else if (rem == 1) asm volatile("s_waitcnt lgkmcnt(2)" ::: "memory");
                else asm volatile("s_waitcnt lgkmcnt(0)" ::: "memory");
                ASBAR();
                p0 = __builtin_amdgcn_mfma_f32_32x32x16_bf16(kb0[d0 % (KPF + 1)], qr[d0], p0, 0, 0, 0);
                p1 = __builtin_amdgcn_mfma_f32_32x32x16_bf16(kb1[d0 % (KPF + 1)], qr[d0], p1, 0, 0, 0);
            }
#undef ATT_KRD
        }
        if (kb + 63 > qlo) {
            const float NEG = -__builtin_inff(); const int dq = qm - kb;
#pragma unroll
            for (int r = 0; r < 16; ++r) { const int c = (r & 3) + 8 * (r >> 2); if (dq - c < 0) p0[r] = NEG; if (dq - c - 32 < 0) p1[r] = NEG; }
        }
        float alpha = 1.f;
        if (!NOMAX) {
        float pmax;
        { float a = att_max3(p0[0], p0[1], p1[0]), b = att_max3(p0[2], p0[3], p1[1]); a = att_max3(a, p1[2], p1[3]);
#pragma unroll
          for (int r = 4; r < 16; r += 4) { a = att_max3(a, p0[r], p0[r + 1]); b = att_max3(b, p0[r + 2], p0[r + 3]); a = att_max3(a, p1[r], p1[r + 1]); b = att_max3(b, p1[r + 2], p1[r + 3]); }
          pmax = fmaxf(a, b); }
        { auto rr = __builtin_amdgcn_permlane32_swap(__float_as_uint(pmax), __float_as_uint(pmax), false, false);
          pmax = fmaxf(__uint_as_float(rr[0]), __uint_as_float(rr[1])); }
        if (!__builtin_expect(__all(pmax <= 8.f), 1)) { const float dm = fmaxf(pmax, 0.f); alpha = __builtin_amdgcn_exp2f(-dm); m_reg += dm;
#pragma unroll
            for (int r = 0; r < 16; ++r) { p0[r] -= dm; p1[r] -= dm; } }
        }
        float ps = 0.f;
#pragma unroll
        for (int r = 0; r < 16; ++r) { p0[r] = __builtin_amdgcn_exp2f(p0[r]); ps += p0[r]; }
#pragma unroll
        for (int r = 0; r < 16; ++r) { p1[r] = __builtin_amdgcn_exp2f(p1[r]); ps += p1[r]; }
        { auto rr = __builtin_amdgcn_permlane32_swap(__float_as_uint(ps), __float_as_uint(ps), false, false);
          ps = __uint_as_float(rr[0]) + __uint_as_float(rr[1]); }
        l_reg = NOMAX ? l_reg + ps : l_reg * alpha + ps;
        bf16x8 pa0, pa1, pa2, pa3;
#define ATT_PK4(P, B_, OUT) do { unsigned a0 = cvtpk(P[B_+0], P[B_+1]), a1 = cvtpk(P[B_+2], P[B_+3]); unsigned b0_ = cvtpk(P[B_+4], P[B_+5]), b1_ = cvtpk(P[B_+6], P[B_+7]); \
        auto r0 = __builtin_amdgcn_permlane32_swap(a0, b0_, false, false); auto r1 = __builtin_amdgcn_permlane32_swap(a1, b1_, false, false); \
        u32x4 w = {r0[0], r1[0], r0[1], r1[1]}; OUT = *reinterpret_cast<bf16x8*>(&w); } while (0)
        ATT_PK4(p0, 0, pa0); ATT_PK4(p0, 8, pa1); ATT_PK4(p1, 0, pa2); ATT_PK4(p1, 8, pa3);
        if (!NOMAX && __any(alpha < 1.f)) {
            if (hi == 0) wsl[r32] = alpha;
            asm volatile("s_waitcnt lgkmcnt(0)" ::: "memory");
#pragma unroll
            for (int g = 0; g < 4; ++g) { const f32x4 al = *(const ALAS f32x4*)(wsl + 8 * g + 4 * hi);
#pragma unroll
                for (int d = 0; d < 4; ++d)
#pragma unroll
                    for (int e = 0; e < 4; ++e) o[d][4 * g + e] *= al[e]; }
        }
#define ATT_TRRD(dst, off) asm volatile("ds_read_b64_tr_b16 %0, %1 offset:%2" : "=&v"(dst) : "v"(vbb), "i"(off) : "memory")
#define ATT_PV(d0) do { s16x4 l0, l1, l2, l3, h0, h1, h2, h3; constexpr int b_ = (d0) * 512; \
        ATT_TRRD(l0, b_); ATT_TRRD(h0, b_ + 2048); ATT_TRRD(l1, b_ + 4096); ATT_TRRD(h1, b_ + 6144); ATT_TRRD(l2, b_ + 8192); ATT_TRRD(h2, b_ + 10240); ATT_TRRD(l3, b_ + 12288); ATT_TRRD(h3, b_ + 14336); \
        asm volatile("s_waitcnt lgkmcnt(0)" ::: "memory"); ASBAR(); \
        o[d0] = __builtin_amdgcn_mfma_f32_32x32x16_bf16(pa0, (bf16x8){l0[0], l0[1], l0[2], l0[3], h0[0], h0[1], h0[2], h0[3]}, o[d0], 0, 0, 0); \
        o[d0] = __builtin_amdgcn_mfma_f32_32x32x16_bf16(pa1, (bf16x8){l1[0], l1[1], l1[2], l1[3], h1[0], h1[1], h1[2], h1[3]}, o[d0], 0, 0, 0); \
        o[d0] = __builtin_amdgcn_mfma_f32_32x32x16_bf16(pa2, (bf16x8){l2[0], l2[1], l2[2], l2[3], h2[0], h2[1], h2[2], h2[3]}, o[d0], 0, 0, 0); \
        o[d0] = __builtin_amdgcn_mfma_f32_32x32x16_bf16(pa3, (bf16x8){l3[0], l3[1], l3[2], l3[3], h3[0], h3[1], h3[2], h3[3]}, o[d0], 0, 0, 0); } while (0)
        { const int vbb = vb0 + buf * SHM_V; ATT_PV(0); ATT_PV(1); ATT_PV(2); ATT_PV(3); }
        if (t + 1 < NT) ATT_WRITEF(buf ^ 1);
    }
    if (hi == 0) wsl[r32] = l_reg;
    asm volatile("s_waitcnt lgkmcnt(0)" ::: "memory");
#pragma unroll
    for (int rh = 0; rh < 16; rh += 8) {
        unsigned gv[8][4];
#pragma unroll
        for (int r = 0; r < 8; ++r) { const bf16_t* growp = gate + (size_t)(qlo + crow(rh + r, hi)) * 4096 + (r32 & ~1);
#pragma unroll
            for (int d0 = 0; d0 < 4; ++d0) gv[r][d0] = *(const unsigned*)(growp + d0 * 32); }
#pragma unroll
        for (int r = 0; r < 8; ++r) { const int orow = crow(rh + r, hi); const float rli = __builtin_amdgcn_rcpf(wsl[orow]);
            bf16_t* rowp = gout + (size_t)(qlo + orow) * 4096;
#pragma unroll
            for (int d0 = 0; d0 < 4; ++d0) {
                const float v = o[d0][rh + r] * rli; const float vn = __shfl_xor(v, 1); const unsigned g = gv[r][d0];
                const bool ev = (r32 & 1) == 0; const float ve = ev ? v : vn, vo = ev ? vn : v;
                *(unsigned*)(rowp + d0 * 32 + (r32 & ~1)) = cvtpk(ve * __uint_as_float(g << 16), vo * __uint_as_float(g & 0xffff0000u)); }
        }
    }
    __syncthreads();
#undef ATT_GLDS
#undef ATT_WRITEF
#undef ATT_PK4
#undef ATT_TRRD
#undef ATT_PV
}
}
using pg8::bf16_t; using pg8::f32x4; using pg8::u32x4;
#define LAS __attribute__((address_space(3)))
constexpr int S = 8192, DM = 2048, INW = 11344, INWP = 11520;
constexpr float EPS = 1e-6f;
constexpr size_t MiB = 1u << 20;

__device__ __forceinline__ float bf2f(bf16_t v) { return __uint_as_float(((unsigned)v) << 16); }
__device__ __forceinline__ bf16_t f2bf(float f) { unsigned u = __float_as_uint(f); u += 0x7fffu + ((u >> 16) & 1u); return (bf16_t)(u >> 16); }
__device__ __forceinline__ unsigned pk2(float lo, float hi) { return (unsigned)f2bf(lo) | ((unsigned)f2bf(hi) << 16); }
__device__ __forceinline__ float wave_sum(float v) {
#pragma unroll
    for (int o = 32; o >= 1; o >>= 1) v += __shfl_xor(v, o);
    return v;
}
__device__ __forceinline__ float wave_max(float v) {
#pragma unroll
    for (int o = 32; o >= 1; o >>= 1) v = fmaxf(v, __shfl_xor(v, o));
    return v;
}

__device__ __forceinline__ int opaque_tid() { int t = threadIdx.x; asm volatile("" : "+v"(t)); return t; }

struct Params {
    const float* x; const int* pos; const float *mix_g, *w_in, *b_forget, *b_gate, *q_lat_g, *w_q_up, *kv_lat_g, *w_kv_up, *mla_qg, *mla_kg, *fox_qg, *fox_kg, *w_out, *ffn_g, *w_peer_q, *sub_keys, *peer_u, *peer_v;
    float* out;
    bf16_t *WqT, *WkvT, *WoT, *WpT, *WinT;
    bf16_t *h, *cq, *ckv, *fq, *fk, *fv, *merged, *kpe, *qa, *va, *ka;
    float *lf, *F, *x1, *scores;
    unsigned char *U8, *V8; bf16_t* attout;
    unsigned* ctl;
    float2* ropeT; float* ssq; float* ssq2; bf16_t* xg;
};

struct DstId { __device__ __forceinline__ int operator()(int n) const { return n; } };
struct DstWin { __device__ __forceinline__ int operator()(int n) const {
    if (n < 1024) return n; if (n < 1088) { const int r = n - 1024; return 11264 + 2 * (r & 31) + (r >> 5); } if (n < 7232) return n - 64; if (n < 7248) return 11264 + 64 + (n - 7232); return n - 80; } };
struct DstQ { __device__ __forceinline__ int operator()(int n) const {
    const int h = n / 192, d = n - h * 192; if (d < 128) return h * 256 + d; const int r = d - 128; return h * 256 + 128 + 2 * (r & 31) + (r >> 5); } };
template <class Dst>
__device__ __forceinline__ void transpose_item(const float* __restrict__ W, int K, int N, bf16_t* __restrict__ WT, Dst dst, float* scr, int item, int lane, const float* __restrict__ gk = nullptr) {
    const int nblk = (N + 31) / 32, kb = item / nblk, nb = item % nblk, k0 = 64 * kb, n0 = 32 * nb;
    { const int rr = lane >> 3, c4 = (lane & 7) * 4; const bool ok = (n0 + c4) < N;
      f32x4 v[8];
#pragma unroll
      for (int i = 0; i < 8; ++i) v[i] = ok ? *(const f32x4*)(W + (size_t)(k0 + 8 * i + rr) * N + n0 + c4) : (f32x4){0.f, 0.f, 0.f, 0.f};
      if (gk) {
#pragma unroll
          for (int i = 0; i < 8; ++i) v[i] *= gk[k0 + 8 * i + rr]; }
#pragma unroll
      for (int i = 0; i < 8; ++i) { float* sp = scr + (8 * i + rr) * 33 + c4; sp[0] = v[i][0]; sp[1] = v[i][1]; sp[2] = v[i][2]; sp[3] = v[i][3]; } }
    asm volatile("s_waitcnt lgkmcnt(0)" ::: "memory");
    const int c = lane & 7;
#pragma unroll
    for (int j = 0; j < 4; ++j) { const int nl = (lane >> 3) + 8 * j, n = n0 + nl; const float* s = scr + (8 * c) * 33 + nl;
        u32x4 o; o.x = pk2(s[0 * 33], s[1 * 33]); o.y = pk2(s[2 * 33], s[3 * 33]); o.z = pk2(s[4 * 33], s[5 * 33]); o.w = pk2(s[6 * 33], s[7 * 33]);
        if (n < N) *(u32x4*)(WT + (size_t)dst(n) * K + k0 + 8 * c) = o; }
    asm volatile("s_waitcnt lgkmcnt(0)" ::: "memory");
}
typedef __bf16 wf_bf16x8 __attribute__((ext_vector_type(8)));
typedef float wf_f32x8 __attribute__((ext_vector_type(8)));
__device__ __forceinline__ void wf_split(const f32x4 x0, const f32x4 x1, wf_bf16x8& hi, wf_bf16x8& lo) {
    const wf_f32x8 x = {x0[0], x0[1], x0[2], x0[3], x1[0], x1[1], x1[2], x1[3]};
    hi = __builtin_convertvector(x, wf_bf16x8);
    const wf_f32x8 r = x - __builtin_convertvector(hi, wf_f32x8);
    lo = __builtin_convertvector(r, wf_bf16x8);
}
__device__ __forceinline__ void wfold_item(const float* __restrict__ wq, const float* __restrict__ keys, bf16_t* __restrict__ WpT, float* sm, int item) {
    (void)sm;
    const int tid = opaque_tid(), lane = tid & 63, wave = tid >> 6, hc = item >> 5, d0 = (item & 31) * 64, m = lane & 15, kg = lane >> 4;
    f32x4 acc[4];
#pragma unroll
    for (int c = 0; c < 4; ++c) acc[c] = (f32x4){0.f, 0.f, 0.f, 0.f};
#pragma unroll
    for (int s4 = 0; s4 < 4; ++s4) {
        const float* kp = keys + (size_t)hc * 16384 + (16 * wave + m) * 128 + 32 * s4 + 8 * kg;
        wf_bf16x8 bh, bl; wf_split(*(const f32x4*)kp, *(const f32x4*)(kp + 4), bh, bl);
#pragma unroll
        for (int c = 0; c < 4; ++c) { const float* ap = wq + (size_t)(d0 + 16 * c + m) * 2048 + hc * 128 + 32 * s4 + 8 * kg;
            wf_bf16x8 ah, al; wf_split(*(const f32x4*)ap, *(const f32x4*)(ap + 4), ah, al);
            acc[c] = __builtin_amdgcn_mfma_f32_16x16x32_bf16(ah, bh, acc[c], 0, 0, 0);
            acc[c] = __builtin_amdgcn_mfma_f32_16x16x32_bf16(ah, bl, acc[c], 0, 0, 0);
            acc[c] = __builtin_amdgcn_mfma_f32_16x16x32_bf16(al, bh, acc[c], 0, 0, 0); }
    }
#pragma unroll
    for (int c = 0; c < 4; ++c) { uint2 o; o.x = pk2(acc[c][0], acc[c][1]); o.y = pk2(acc[c][2], acc[c][3]);
        *(uint2*)(WpT + (size_t)(hc * 128 + 16 * wave + m) * 2048 + d0 + 16 * c + 4 * kg) = o; }
}
__device__ __forceinline__ void rms_row2048(const float* __restrict__ xr, const float* __restrict__ g, bf16_t* __restrict__ orow, int lane) {
    f32x4 v[8]; float ss = 0.f;
#pragma unroll
    for (int j = 0; j < 8; ++j) { v[j] = *(const f32x4*)(xr + j * 256 + lane * 4); ss += (v[j][0] * v[j][0] + v[j][1] * v[j][1]) + (v[j][2] * v[j][2] + v[j][3] * v[j][3]); }
    const float r = rsqrtf(wave_sum(ss) * (1.f / 2048.f) + EPS);
#pragma unroll
    for (int j = 0; j < 8; ++j) { const f32x4 gg = *(const f32x4*)(g + j * 256 + lane * 4);
        uint2 o; o.x = pk2(v[j][0] * r * gg[0], v[j][1] * r * gg[1]); o.y = pk2(v[j][2] * r * gg[2], v[j][3] * r * gg[3]);
        *(uint2*)(orow + j * 256 + lane * 4) = o; }
}
__device__ __forceinline__ void fox_cumsum(double* part, int h, const float* __restrict__ lf, float* __restrict__ F) {
    const int tid = opaque_tid(), lane = tid & 63, wave = tid >> 6;
    float v[16]; double sum = 0.0;
#pragma unroll
    for (int i = 0; i < 16; ++i) { v[i] = lf[(size_t)(tid * 16 + i) * 16 + h]; sum += (double)v[i]; }
    double inc = sum;
#pragma unroll
    for (int o = 1; o < 64; o <<= 1) { const double n = __shfl_up(inc, o); if (lane >= o) inc += n; }
    if (lane == 63) part[wave] = inc;
    __syncthreads();
    double base = 0.0;
    for (int w = 0; w < wave; ++w) base += part[w];
    double run = base + inc - sum;
#pragma unroll
    for (int i = 0; i < 16; ++i) { run += (double)v[i]; F[(size_t)h * S + tid * 16 + i] = (float)(run * 1.4426950408889634); }
    __syncthreads();
}
__device__ __forceinline__ void rope_table(const int* __restrict__ pos, float2* __restrict__ ropeT, int gtid, int nthreads) {
    for (int idx = gtid; idx < S * 32; idx += nthreads) { const int t = idx >> 5, i = idx & 31;
        const double inv = exp(-(double)i * (1.0 / 32.0) * 9.210340371976184);
        double ang = (double)((float)pos[t] * (float)inv);
        const double twopi = 6.283185307179586;
        ang -= twopi * rint(ang / twopi);
        ropeT[idx] = make_float2(cosf((float)ang), sinf((float)ang)); }
}
typedef float f32x2 __attribute__((ext_vector_type(2)));
__device__ __forceinline__ unsigned pk4_fp8(float a, float b, float c, float d) {
    int w = __builtin_amdgcn_cvt_pk_fp8_f32(fminf(fmaxf(a, -448.f), 448.f), fminf(fmaxf(b, -448.f), 448.f), 0, false);
    w = __builtin_amdgcn_cvt_pk_fp8_f32(fminf(fmaxf(c, -448.f), 448.f), fminf(fmaxf(d, -448.f), 448.f), w, true); return (unsigned)w; }
__device__ __forceinline__ void cvt_rows_fp8(const float* __restrict__ src, unsigned char* __restrict__ dst, size_t n, float scale, int gw, int NGW, int lane) {
    const size_t nchunk = n / 1024;
    for (size_t c = gw; c < nchunk; c += NGW) { const size_t o = c * 1024 + lane * 16;
        f32x4 a[4];
#pragma unroll
        for (int q = 0; q < 4; ++q) a[q] = *(const f32x4*)(src + o + 4 * q) * scale;
        u32x4 w; w.x = pk4_fp8(a[0][0], a[0][1], a[0][2], a[0][3]); w.y = pk4_fp8(a[1][0], a[1][1], a[1][2], a[1][3]);
        w.z = pk4_fp8(a[2][0], a[2][1], a[2][2], a[2][3]); w.w = pk4_fp8(a[3][0], a[3][1], a[3][2], a[3][3]);
        *(u32x4*)(dst + o) = w; }
}
constexpr float U_SCALE = 64.f, V_SCALE = 4.f;
typedef __bf16 bf16x2_t __attribute__((ext_vector_type(2)));
__device__ __forceinline__ float dot2bf(unsigned a, unsigned b, float c) { return __builtin_amdgcn_fdot2_f32_bf16(__builtin_bit_cast(bf16x2_t, a), __builtin_bit_cast(bf16x2_t, b), c, false); }
#define PEER_INS(top, x) do { float x_ = (x); _Pragma("unroll") for (int i_ = 0; i_ < 16; ++i_) { const float hi_ = fmaxf(top[i_], x_); x_ = fminf(top[i_], x_); top[i_] = hi_; } } while (0)
__device__ __forceinline__ void fp6_cvt_rows(const float* __restrict__ src, unsigned char* __restrict__ T6, int row0, int nrows, float sc, int t, int nt) {
    for (int u = t; u < nrows * 64; u += nt) { const int rr = u >> 6, hf = (u >> 5) & 1, l = (u >> 1) & 15, g = u & 1;
        const float* s0 = src + (size_t)(row0 + rr) * 2048 + hf * 1024 + (2 * g) * 256 + l * 16;
        att::f32x16v f0, f1;
#pragma unroll
        for (int k = 0; k < 4; ++k) { const f32x4 a = *(const f32x4*)(s0 + 4 * k), b2 = *(const f32x4*)(s0 + 256 + 4 * k);
#pragma unroll
            for (int e = 0; e < 4; ++e) { f0[4 * k + e] = a[e]; f1[4 * k + e] = b2[e]; } }
        att::fp6_put(T6, row0 + rr, hf, l, g, f0, f1, sc); }
}
typedef float f32x32v __attribute__((ext_vector_type(32)));
__device__ __forceinline__ void peer_group(unsigned char* smem, int g, const float* __restrict__ scores, const bf16_t* __restrict__ h2  , const float* __restrict__ ssq2, const float* __restrict__ x1,
                                           const unsigned char* __restrict__ U8, const unsigned char* __restrict__ V8, float* __restrict__ out) {
    const int tid = opaque_tid(), lane = tid & 63, wave = __builtin_amdgcn_readfirstlane(tid >> 6);
    float* topL = (float*)smem;
    int* selE = (int*)(smem + 32768);
    float* selG = (float*)(smem + 49152);
    {
        const int tl = tid >> 4, hc = tid & 15;
        const float* sp = scores + (size_t)(g * 32 + tl) * 2048 + hc * 128;
#define PEER_CE(a, b) do { const float hi_ = fmaxf(a, b), lo_ = fminf(a, b); a = hi_; b = lo_; } while (0)
        float top[16];
#pragma unroll 1
        for (int gi = 0; gi < 8; ++gi) {
            float gr[16];
#pragma unroll
            for (int q = 0; q < 4; ++q) { const f32x4 v = *(const f32x4*)(sp + gi * 16 + q * 4);
#pragma unroll
                for (int e = 0; e < 4; ++e) gr[q * 4 + e] = __uint_as_float((__float_as_uint(v[e]) & ~0x7Fu) | (unsigned)(gi * 16 + q * 4 + e)); }
#pragma unroll
            for (int k = 2; k <= 16; k <<= 1)
#pragma unroll
                for (int j = k >> 1; j > 0; j >>= 1)
#pragma unroll
                    for (int i = 0; i < 16; ++i) { const int l = i ^ j; if (l > i) { if ((i & k) == 0) PEER_CE(gr[i], gr[l]); else PEER_CE(gr[l], gr[i]); } }
            if (gi == 0) {
#pragma unroll
                for (int i = 0; i < 16; ++i) top[i] = gr[i];
            } else {
#pragma unroll
                for (int i = 0; i < 16; ++i) top[i] = fmaxf(top[i], gr[15 - i]);
#pragma unroll
                for (int j = 8; j > 0; j >>= 1)
#pragma unroll
                    for (int i = 0; i < 16; ++i) { const int l = i ^ j; if (l > i) PEER_CE(top[i], top[l]); }
            }
        }
#undef PEER_CE
        float* tp = topL + (tl * 16 + hc) * 16;
#pragma unroll
        for (int i = 0; i < 16; i += 4) *(f32x4*)(tp + i) = (f32x4){top[i], top[i + 1], top[i + 2], top[i + 3]};
    }
    __syncthreads();
    if (tid < 256) {
        const int tl = tid >> 3, h = tid & 7;
        const float* t1 = topL + (tl * 16 + 2 * h) * 16; const float* t2 = t1 + 16;
        float s1[16], s2[16];
#pragma unroll
        for (int i = 0; i < 16; i += 4) { const f32x4 a = *(const f32x4*)(t1 + i), b2 = *(const f32x4*)(t2 + i);
            s1[i] = a[0]; s1[i + 1] = a[1]; s1[i + 2] = a[2]; s1[i + 3] = a[3]; s2[i] = b2[0]; s2[i + 1] = b2[1]; s2[i + 2] = b2[2]; s2[i + 3] = b2[3]; }
#define PEER_CE(a, b) do { const float hi_ = fmaxf(a, b), lo_ = fminf(a, b); a = hi_; b = lo_; } while (0)
#define PEER_KEY(i, j) __uint_as_float((__float_as_uint(s1[i] + s2[j]) & ~0xFFu) | (unsigned)((i) * 16 + (j)))
        float ts[16], cand[34];
#pragma unroll
        for (int j = 0; j < 16; ++j) ts[j] = PEER_KEY(0, j);
        { int n = 0;
#pragma unroll
          for (int i = 1; i < 16; ++i)
#pragma unroll
              for (int j = 0; j < 8; ++j)
                  if ((i + 1) * (j + 1) <= 16) cand[n++] = PEER_KEY(i, j); }
#pragma unroll
        for (int gi = 0; gi < 2; ++gi) { float gr[16];
#pragma unroll
            for (int i = 0; i < 16; ++i) gr[i] = cand[gi * 16 + i];
#pragma unroll
            for (int k = 2; k <= 16; k <<= 1)
#pragma unroll
                for (int j = k >> 1; j > 0; j >>= 1)
#pragma unroll
                    for (int i = 0; i < 16; ++i) { const int l = i ^ j; if (l > i) { if ((i & k) == 0) PEER_CE(gr[i], gr[l]); else PEER_CE(gr[l], gr[i]); } }
#pragma unroll
            for (int i = 0; i < 16; ++i) ts[i] = fmaxf(ts[i], gr[15 - i]);
#pragma unroll
            for (int j = 8; j > 0; j >>= 1)
#pragma unroll
                for (int i = 0; i < 16; ++i) { const int l = i ^ j; if (l > i) PEER_CE(ts[i], ts[l]); } }
        PEER_INS(ts, cand[32]); PEER_INS(ts, cand[33]);
#undef PEER_CE
#undef PEER_KEY
        float ex[16], sum = 0.f;
#pragma unroll
        for (int k = 0; k < 16; ++k) { ex[k] = __expf(ts[k] - ts[0]); sum += ex[k]; }
        const float inv = 1.f / sum;
#pragma unroll
        for (int k = 0; k < 16; ++k) { const unsigned pos = __float_as_uint(ts[k]) & 0xFFu;
            const int i1 = (int)(__float_as_uint(t1[pos >> 4]) & 0x7Fu), i2 = (int)(__float_as_uint(t2[pos & 15]) & 0x7Fu);
            selE[tl * 128 + h * 16 + k] = i1 * 128 + i2; selG[tl * 128 + h * 16 + k] = ex[k] * inv; }
    }
    __syncthreads();
    const int grp = lane >> 4, l16 = lane & 15, tl = wave * 4 + grp;
    unsigned* sortK = (unsigned*)(smem + 65536) + tl * 128;
    float* wS = (float*)(smem + 81920) + tl * 128;
    unsigned* hist = (unsigned*)(smem + 98304) + wave * 512 + grp * 64;
    {
#pragma unroll
        for (int i = 0; i < 4; ++i) hist[l16 * 4 + i] = 0u;
        asm volatile("s_waitcnt lgkmcnt(0)" ::: "memory");
        unsigned ek[8], rk[8];
#pragma unroll
        for (int j = 0; j < 8; ++j) { ek[j] = (unsigned)selE[tl * 128 + l16 + 16 * j]; rk[j] = atomicAdd(&hist[ek[j] >> 8], 1u); }
        asm volatile("s_waitcnt lgkmcnt(0)" ::: "memory");
        unsigned c[4], tot = 0u;
#pragma unroll
        for (int i = 0; i < 4; ++i) { c[i] = hist[l16 * 4 + i]; tot += c[i]; }
        unsigned inc = tot;
#pragma unroll
        for (int o = 1; o < 16; o <<= 1) { const unsigned n = __shfl_up(inc, o, 16); if (l16 >= o) inc += n; }
        unsigned run = inc - tot;
#pragma unroll
        for (int i = 0; i < 4; ++i) { hist[256 + l16 * 4 + i] = run; run += c[i]; }
        asm volatile("s_waitcnt lgkmcnt(0)" ::: "memory");
#pragma unroll
        for (int j = 0; j < 8; ++j) sortK[hist[256 + (ek[j] >> 8)] + rk[j]] = (ek[j] << 7) | (unsigned)(l16 + 16 * j);
    }
    __syncthreads();
    const size_t tok = (size_t)g * 32 + tl;
    float rinv_tok;
    { float t = 0.f; if (l16 < 8) { const f32x4 a = *(const f32x4*)(ssq2 + ((size_t)l16 * 8192 + tok) * 4); t = (a[0] + a[1]) + (a[2] + a[3]); }
      t += __shfl_xor(t, 8); t += __shfl_xor(t, 4); t += __shfl_xor(t, 2); t += __shfl_xor(t, 1); rinv_tok = rsqrtf(t * (1.f / 2048.f) + 1e-6f); }
    {
        const int m16 = lane & 15, kg = lane >> 4, pt = m16 >> 2, sub = m16 & 3, l6 = kg * 4 + sub;
        const unsigned* sKa = (const unsigned*)(smem + 65536) + (wave * 4 + pt) * 128;
        const bool diag = pt == kg;
        const size_t tokb = (size_t)g * 32 + wave * 4 + pt;
        typedef int i32x8v __attribute__((ext_vector_type(8)));
        const float xsc = 1.4f * __shfl(rinv_tok, pt * 16);
#pragma unroll 1
        for (int hf = 0; hf < 2; ++hf) {
            i32x8v xb[2];
#pragma unroll
            for (int gq = 0; gq < 2; ++gq) { att::f32x16v ev, od;
#pragma unroll
                for (int h = 0; h < 2; ++h) { const bf16_t* xp = h2 + tokb * DM + hf * 1024 + (2 * gq + h) * 256 + l6 * 16;
                    const u32x4 w0 = *(const u32x4*)xp, w1 = *(const u32x4*)(xp + 8);
#pragma unroll
                    for (int q = 0; q < 4; ++q) { ev[8 * h + q] = __uint_as_float(w0[q] << 16) * xsc; od[8 * h + q] = __uint_as_float(w0[q] & 0xffff0000u) * xsc;
                        ev[8 * h + 4 + q] = __uint_as_float(w1[q] << 16) * xsc; od[8 * h + 4 + q] = __uint_as_float(w1[q] & 0xffff0000u) * xsc; } }
                const att::u32x6v w6 = __builtin_amdgcn_cvt_scalef32_2xpk16_fp6_f32(ev, od, 1.0f);
                xb[gq] = (i32x8v){(int)w6[0], (int)w6[1], (int)w6[2], (int)w6[3], (int)w6[4], (int)w6[5], 0, 0}; }
            u32x4 urA[4][3], urB[4][3];
#define PEER_LDA(ur, it0) do { _Pragma("unroll") for (int j = 0; j < 4; ++j) { const unsigned ro = (sKa[(it0) + j] >> 7) * (unsigned)att::ROW6 + (unsigned)(hf * 768 + l6 * 16); \
                    _Pragma("unroll") for (int c = 0; c < 3; ++c) ur[j][c] = *(const u32x4*)(U8 + ro + c * 256); } } while (0)
#define PEER_CMA(ur, it0) do { float dsel = 0.f; \
                _Pragma("unroll") for (int j = 0; j < 4; ++j) { f32x4 acc = (f32x4){0.f, 0.f, 0.f, 0.f}; \
                    acc = __builtin_amdgcn_mfma_scale_f32_16x16x128_f8f6f4((i32x8v){(int)ur[j][0][0], (int)ur[j][0][1], (int)ur[j][0][2], (int)ur[j][0][3], (int)ur[j][1][0], (int)ur[j][1][1], 0, 0}, xb[0], acc, 2, 2, 0, 0x7F7F7F7F, 0, 0x7F7F7F7F); \
                    acc = __builtin_amdgcn_mfma_scale_f32_16x16x128_f8f6f4((i32x8v){(int)ur[j][1][2], (int)ur[j][1][3], (int)ur[j][2][0], (int)ur[j][2][1], (int)ur[j][2][2], (int)ur[j][2][3], 0, 0}, xb[1], acc, 2, 2, 0, 0x7F7F7F7F, 0, 0x7F7F7F7F); \
                    float d = sub == 0 ? acc[0] : sub == 1 ? acc[1] : sub == 2 ? acc[2] : acc[3]; \
                    d += __builtin_bit_cast(float, __builtin_amdgcn_update_dpp(0, __builtin_bit_cast(int, d), 0xB1, 0xF, 0xF, true)); \
                    d += __builtin_bit_cast(float, __builtin_amdgcn_update_dpp(0, __builtin_bit_cast(int, d), 0x4E, 0xF, 0xF, true)); \
                    if (sub == j) dsel = d; } \
                if (diag) { float* wSt = (float*)(smem + 81920) + (wave * 4 + pt) * 128; \
                    if (hf == 0) wSt[(it0) + sub] = dsel; \
                    else { const float a = (wSt[(it0) + sub] + dsel) * (1.f / (1.4f * U_SCALE)); \
                        wSt[(it0) + sub] = selG[(wave * 4 + pt) * 128 + (sKa[(it0) + sub] & 127u)] * 0.5f * a * (1.f + erff(a * 0.70710678118654752f)) * (1.f / V_SCALE); } } } while (0)
            PEER_LDA(urA, 0);
#pragma unroll 1
            for (int it = 0; it < 128; it += 8) {
                if (it) __builtin_amdgcn_s_barrier();
                PEER_LDA(urB, it + 4);
                PEER_CMA(urA, it);
                if (it + 8 < 128) PEER_LDA(urA, it + 8);
                PEER_CMA(urB, it + 4);
            }
#undef PEER_LDA
#undef PEER_CMA
            __syncthreads();
        }
    }
#pragma unroll 1
    for (int hf = 0; hf < 2; ++hf) {
        typedef _Float16 h16x2v __attribute__((ext_vector_type(2)));
        typedef _Float16 h16x32v __attribute__((ext_vector_type(32)));
        h16x2v acc[32];
#pragma unroll
        for (int c = 0; c < 32; ++c) acc[c] = (h16x2v){(_Float16)0.f, (_Float16)0.f};
        for (int it = 0; it < 128; it += 4) {
            if ((it & 7) == 0 && it) __syncthreads();
            unsigned key[4]; u32x4 vr[4][3];
#pragma unroll
            for (int p = 0; p < 4; ++p) { key[p] = sortK[it + p];
#pragma unroll
                for (int j = 0; j < 3; ++j) vr[p][j] = *(const u32x4*)(V8 + (size_t)(key[p] >> 7) * att::ROW6 + hf * 768 + j * 256 + l16 * 16); }
#pragma unroll
            for (int p = 0; p < 4; ++p) { const _Float16 wh = (_Float16)wS[it + p]; const h16x2v w2 = (h16x2v){wh, wh};
                const h16x32v c0 = __builtin_amdgcn_cvt_scalef32_pk32_f16_fp6((att::u32x6v){vr[p][0][0], vr[p][0][1], vr[p][0][2], vr[p][0][3], vr[p][1][0], vr[p][1][1]}, 1.0f);
#pragma unroll
                for (int k = 0; k < 16; ++k) acc[k] = __builtin_elementwise_fma(w2, (h16x2v){c0[2 * k], c0[2 * k + 1]}, acc[k]);
                const h16x32v c1 = __builtin_amdgcn_cvt_scalef32_pk32_f16_fp6((att::u32x6v){vr[p][1][2], vr[p][1][3], vr[p][2][0], vr[p][2][1], vr[p][2][2], vr[p][2][3]}, 1.0f);
#pragma unroll
                for (int k = 0; k < 16; ++k) acc[16 + k] = __builtin_elementwise_fma(w2, (h16x2v){c1[2 * k], c1[2 * k + 1]}, acc[16 + k]); }
        }
#pragma unroll
        for (int j = 0; j < 4; ++j)
#pragma unroll
            for (int q = 0; q < 4; ++q) { const size_t o = tok * DM + hf * 1024 + j * 256 + l16 * 16 + q * 4;
                const f32x4 a = *(const f32x4*)(x1 + o);
                *(f32x4*)(out + o) = (f32x4){a[0] + (float)acc[j * 8 + 2 * q][0], a[1] + (float)acc[j * 8 + 2 * q][1], a[2] + (float)acc[j * 8 + 2 * q + 1][0], a[3] + (float)acc[j * 8 + 2 * q + 1][1]}; }
        __syncthreads();
    }
    __syncthreads();
}

#define XB_TMO      128
#define XB_XCNT(j)  (256  + 64 * (j))
#define XB_XSUB(j)  (1280 + 64 * (j))
#define XB_XGEN(j)  (2304 + 64 * (j))
#define XB_TOP      3328
#define XB_TOPGEN   3392
#define XCD_BAR_WORDS 3456
#define XB_SPIN_CAP (1u << 18)

__device__ __forceinline__ unsigned xb_ld(unsigned* p)              { return __hip_atomic_load(p, __ATOMIC_RELAXED, __HIP_MEMORY_SCOPE_AGENT); }
__device__ __forceinline__ unsigned xb_add(unsigned* p, unsigned v) { return __hip_atomic_fetch_add(p, v, __ATOMIC_RELAXED, __HIP_MEMORY_SCOPE_AGENT); }
__device__ __forceinline__ unsigned xb_xcc_id() { return (unsigned)__builtin_amdgcn_s_getreg((3 << 11) | 20) & 0xFu; }
#define XB_SPIN(cond, bar) do { unsigned _sp = 0; while (cond) { __builtin_amdgcn_s_sleep(1); \
    if ((++_sp & 255u) == 0u) { if (xb_ld(&(bar)[XB_TMO])) break; if (_sp > XB_SPIN_CAP) { atomicAdd(&(bar)[XB_TMO], 1u); break; } } } } while (0)

struct XcdBarrier {
    unsigned* bar; unsigned x;
    volatile LAS unsigned* st;
};

__device__ __forceinline__ XcdBarrier xcd_barrier_post(unsigned* bar, volatile LAS unsigned* st) {
    XcdBarrier b; b.bar = bar; b.x = xb_xcc_id(); b.st = st;
    if (threadIdx.x == 0) (void)xb_add(&bar[XB_XCNT(b.x)], 1u);
    return b;
}
__device__ __forceinline__ void xcd_barrier_complete(unsigned* bar, unsigned x, unsigned& nloc, unsigned& nx) {
    const unsigned G = gridDim.x * gridDim.y * gridDim.z;
    unsigned sum, cnt, mine, sp = 0u;
    for (;;) {
        sum = 0u; cnt = 0u; mine = 0u;
#pragma unroll
        for (unsigned j = 0; j < 16; ++j) { const unsigned c = xb_ld(&bar[XB_XCNT(j)]); sum += c; cnt += (c > 0u) ? 1u : 0u; mine = (j == x) ? c : mine; }
        if (sum == G) break;
        __builtin_amdgcn_s_sleep(1);
        if ((++sp & 255u) == 0u) { if (xb_ld(&bar[XB_TMO])) break; if (sp > XB_SPIN_CAP) { atomicAdd(&bar[XB_TMO], 1u); break; } }
    }
    nloc = mine > 0u ? mine : 1u; nx = cnt > 0u ? cnt : 1u;
}

__device__ __forceinline__ void xcd_barrier(const XcdBarrier& b) {
    asm volatile("s_waitcnt vmcnt(0)" ::: "memory");
    __syncthreads();
    if (threadIdx.x == 0) {
        unsigned* bar = b.bar;
        __builtin_amdgcn_s_waitcnt(0);
        unsigned nloc = b.st[0], nx = b.st[1];
        if (nloc == 0u) { xcd_barrier_complete(bar, b.x, nloc, nx); b.st[0] = nloc; b.st[1] = nx; }
        const unsigned old = xb_add(&bar[XB_XSUB(b.x)], 1u);
        const unsigned gen = old / nloc;
        if (old + 1u == (gen + 1u) * nloc) {
            __builtin_amdgcn_fence(__ATOMIC_RELEASE, "agent");
            asm volatile("s_waitcnt vmcnt(0)" ::: "memory");
            const unsigned og = xb_add(&bar[XB_TOP], 1u);
            const unsigned tg = og / nx;
            if (og + 1u == (tg + 1u) * nx) xb_add(&bar[XB_TOPGEN], 1u);
            else XB_SPIN(xb_ld(&bar[XB_TOPGEN]) == tg, bar);
            __builtin_amdgcn_fence(__ATOMIC_ACQUIRE, "agent");
            xb_add(&bar[XB_XGEN(b.x)], 1u);
            asm volatile("s_waitcnt vmcnt(0)" ::: "memory");
        } else {
            XB_SPIN(xb_ld(&bar[XB_XGEN(b.x)]) == gen, bar);
            __builtin_amdgcn_fence(__ATOMIC_ACQUIRE, "agent");
            asm volatile("s_waitcnt vmcnt(0)" ::: "memory");
        }
    }
    __syncthreads();
}

#define PROBE_P0 0
#define PROBE_DOUBLE 0
#define REP(k) for (int rep_ = 0; rep_ < ((PROBE_DOUBLE == (k)) ? 2 : 1); ++rep_)
constexpr int LDS_BYTES = 147456;
__global__ __launch_bounds__(512, 2) void mega(Params p) {
    extern __shared__ __attribute__((aligned(16))) unsigned char smem[];
    { volatile LAS unsigned* st0 = (volatile LAS unsigned*)((LAS unsigned char*)smem + 131072); if (threadIdx.x < 2) st0[threadIdx.x] = 0u; }
    __syncthreads();
    const XcdBarrier bar = xcd_barrier_post(p.ctl, (volatile LAS unsigned*)((LAS unsigned char*)smem + 131072));
    float* smf = (float*)smem;
    LAS unsigned char* lds = (LAS unsigned char*)smem;
    const int G = gridDim.x, b = blockIdx.x, NGW = G * 8;
#define PHASE_IDS() const int tid = opaque_tid(), lane = tid & 63, wave = __builtin_amdgcn_readfirstlane(tid >> 6), gw = b * 8 + wave; (void)lane; (void)gw

    REP(7) {
        PHASE_IDS();
        float* scr = smf + wave * 4096;
        constexpr int dummy_ = 0; (void)dummy_;
        constexpr int I_IN = 32 * 355, I_Q = 8 * 96, I_KV = 8 * 128, I_O = 64 * 64;
        for (int rp_ = 0; rp_ < (PROBE_P0 == 1 ? 2 : 1); ++rp_)
        for (int it = gw; it < I_IN + I_Q + I_KV + I_O; it += NGW) {
            int r = it;
            if (r < I_IN) { transpose_item(p.w_in, 2048, INW, p.WinT, DstWin(), scr, r, lane); continue; } r -= I_IN;
            if (r < I_Q) { transpose_item(p.w_q_up, 512, 3072, p.WqT, DstQ(), scr, r, lane, p.q_lat_g); continue; } r -= I_Q;
            if (r < I_KV) { transpose_item(p.w_kv_up, 512, 4096, p.WkvT, DstId(), scr, r, lane, p.kv_lat_g); continue; } r -= I_KV;
            transpose_item(p.w_out, 4096, 2048, p.WoT, DstId(), scr, r, lane);
        }
        for (int rp_ = 0; rp_ < (PROBE_P0 == 2 ? 2 : 1); ++rp_)
        for (int m = gw; m < S; m += NGW) rms_row2048(p.x + (size_t)m * DM, p.mix_g, p.h + (size_t)m * DM, lane);
        for (int idx = b * 512 + tid; idx < 16 * 64 * 64; idx += G * 512) { const int hh = idx >> 12, rr = (idx >> 6) & 63, c8 = idx & 63;
            *(u32x4*)(p.WqT + (size_t)(hh * 256 + 192 + rr) * 512 + c8 * 8) = (u32x4){0u, 0u, 0u, 0u}; }
        rope_table(p.pos, p.ropeT, b * 512 + tid, G * 512);
        __syncthreads();
        for (int rp_ = 0; rp_ < (PROBE_P0 == 3 ? 2 : 1); ++rp_)
        for (int it = b; it < 512; it += G) wfold_item(p.w_peer_q, p.sub_keys, p.WpT, smf, it);
    }
    xcd_barrier(bar);
    REP(1) {
        pg8::Gemm g{p.h, p.WinT, S, INWP, DM}; pg8::StaticOrder so; so.init(S, INWP, G, b);
        pg8::EpiInProj E{p.cq, p.ckv, p.fq, p.fk, p.fv, p.merged, p.kpe, p.lf, p.b_gate, p.b_forget, p.ssq, p.fox_qg, p.fox_kg, (LAS float*)(lds + 131072 + 64)};
        pg8::gemm_phase<pg8::EpiInProj, pg8::StaticOrder, true, true>(lds, g, so, E);
    }
    xcd_barrier(bar);
    for (int hh = b; hh < 16; hh += G) fox_cumsum((double*)smem, hh, p.lf, p.F);
    REP(2) {
        pg8::Gemm g{p.cq, p.WqT, S, 4096, 512}; pg8::StaticOrder so; so.init(S, 4096, G, b);
        pg8::EpiQ E{p.qa, p.ssq, p.mla_qg, p.ropeT, (LAS float*)(lds + 131072 + 64)};
        pg8::gemm_phase<pg8::EpiQ, pg8::StaticOrder, true, true>(lds, g, so, E);
    }
    {
        pg8::Gemm g{p.ckv, p.WkvT, S, 4096, 512}; pg8::StaticOrder so; so.init(S, 4096, G, b);
        pg8::EpiKV E{p.ka, p.va, p.kpe, p.ssq, p.mla_kg, p.ropeT, (LAS float*)(lds + 131072 + 64)};
        pg8::gemm_phase<pg8::EpiKV, pg8::StaticOrder, true, true>(lds, g, so, E);
    }
    xcd_barrier(bar);
    int side_next = 0;
    bool nomax_mla, nomax_fox;
    { const int ln = threadIdx.x & 63;
      float a = 0.f, c = 0.f;
      for (int j = ln; j < 192; j += 64) { a = fmaxf(a, fabsf(p.mla_qg[j])); c = fmaxf(c, fabsf(p.mla_kg[j])); }
      const float bm = 1.02f * 192.f * 0.10411754f * att::wave_max_f(a) * att::wave_max_f(c);
      float e = 0.f, f = 0.f;
      for (int j = ln; j < 128; j += 64) { e = fmaxf(e, fabsf(p.fox_qg[j])); f = fmaxf(f, fabsf(p.fox_kg[j])); }
      const float bf = 1.02f * 128.f * 0.12751743f * att::wave_max_f(e) * att::wave_max_f(f);
      nomax_mla = bm <= 80.f; nomax_fox = bf <= 80.f; }
    REP(3) for (int L = b; L < 1024; L += G) {
        const int i = L >> 8, vc = L & 255, vcx = (vc & 7) * 32 + (vc >> 3), hh = vcx >> 4, x = vcx & 15, qbk = (i & 1) ? x : 31 - x;
        if (i < 2) { if (nomax_mla) att::attn_block<192, false, true>(smem, p.qa + hh * 192, 3072, p.ka + hh * 192, 3072, p.va + hh * 128, 2048, nullptr, p.merged + hh * 128, p.attout + hh * 128, qbk, nullptr, nullptr, p.peer_u, p.peer_v, p.U8, p.V8, side_next); else att::attn_block<192, false, false>(smem, p.qa + hh * 192, 3072, p.ka + hh * 192, 3072, p.va + hh * 128, 2048, nullptr, p.merged + hh * 128, p.attout + hh * 128, qbk, nullptr, nullptr, p.peer_u, p.peer_v, p.U8, p.V8, side_next); }
        else { if (nomax_fox) att::attn_block<128, true, true>(smem, p.fq + hh * 128, 2048, p.fk + hh * 128, 2048, p.fv + hh * 128, 2048, p.F + (size_t)hh * S, p.merged + 2048 + hh * 128, p.attout + 2048 + hh * 128, qbk, p.fox_qg, p.fox_kg, p.peer_u, p.peer_v, p.U8, p.V8, side_next); else att::attn_block<128, true, false>(smem, p.fq + hh * 128, 2048, p.fk + hh * 128, 2048, p.fv + hh * 128, 2048, p.F + (size_t)hh * S, p.merged + 2048 + hh * 128, p.attout + 2048 + hh * 128, qbk, p.fox_qg, p.fox_kg, p.peer_u, p.peer_v, p.U8, p.V8, side_next); }
    }
    if (G == 256) { PHASE_IDS(); (void)wave;
        for (; side_next < 32; ++side_next) { const bool isv = side_next >= 16;
            fp6_cvt_rows(isv ? p.peer_v : p.peer_u, isv ? p.V8 : p.U8, b * 64 + (side_next & 15) * 4, 4, isv ? V_SCALE : U_SCALE, tid, 512); } }
    else { PHASE_IDS(); (void)wave; fp6_cvt_rows(p.peer_u, p.U8, 0, 16384, U_SCALE, b * 512 + tid, G * 512); fp6_cvt_rows(p.peer_v, p.V8, 0, 16384, V_SCALE, b * 512 + tid, G * 512); }
    xcd_barrier(bar);
    REP(4) {
        pg8::Gemm g{p.attout, p.WoT, S, 2048, 4096}; pg8::StaticOrder so; so.init(S, 2048, G, b);
        pg8::EpiX1 E{p.x1, p.x, p.xg, p.ffn_g, p.ssq2};
        pg8::gemm_phase<pg8::EpiX1, pg8::StaticOrder, true, true>(lds, g, so, E);
    }
    xcd_barrier(bar);
    REP(5) {
        pg8::Gemm g{p.xg, p.WpT, S, 2048, 2048}; pg8::StaticOrder so; so.init(S, 2048, G, b);
        pg8::EpiScores E{p.scores, p.ssq2};
        pg8::gemm_phase<pg8::EpiScores, pg8::StaticOrder, true, true>(lds, g, so, E);
    }
    xcd_barrier(bar);
    REP(6) for (int g = b; g < S / 32; g += G) peer_group(smem, g, p.scores, p.xg, p.ssq2, p.x1, p.U8, p.V8, p.out);
}

extern "C" void kernel_launch(void* const* d_in, const int* in_sizes, int n_in,
                              void* d_out, int out_size, void* d_ws, size_t ws_size,
                              hipStream_t stream) {
    if (ws_size < 512 * MiB) { fprintf(stderr, "kernel_launch: workspace too small (%zu)\n", ws_size); return; }
    Params p{};
    p.x = (const float*)d_in[0]; p.pos = (const int*)d_in[1]; p.mix_g = (const float*)d_in[2]; p.w_in = (const float*)d_in[3];
    p.b_forget = (const float*)d_in[4]; p.b_gate = (const float*)d_in[5]; p.q_lat_g = (const float*)d_in[6]; p.w_q_up = (const float*)d_in[7];
    p.kv_lat_g = (const float*)d_in[8]; p.w_kv_up = (const float*)d_in[9]; p.mla_qg = (const float*)d_in[10]; p.mla_kg = (const float*)d_in[11];
    p.fox_qg = (const float*)d_in[12]; p.fox_kg = (const float*)d_in[13]; p.w_out = (const float*)d_in[14]; p.ffn_g = (const float*)d_in[15];
    p.w_peer_q = (const float*)d_in[16]; p.sub_keys = (const float*)d_in[17]; p.peer_u = (const float*)d_in[18]; p.peer_v = (const float*)d_in[19];
    p.out = (float*)d_out;
    char* ws = (char*)d_ws;
    p.WqT = (bf16_t*)(ws + 1 * MiB); p.WkvT = (bf16_t*)(ws + 5 * MiB); p.WoT = (bf16_t*)(ws + 9 * MiB); p.WpT = (bf16_t*)(ws + 25 * MiB); p.WinT = (bf16_t*)(ws + 33 * MiB);
    p.h = (bf16_t*)(ws + 78 * MiB); p.cq = (bf16_t*)(ws + 110 * MiB); p.ckv = (bf16_t*)(ws + 118 * MiB);
    p.fq = (bf16_t*)(ws + 126 * MiB); p.fk = (bf16_t*)(ws + 158 * MiB); p.fv = (bf16_t*)(ws + 190 * MiB); p.merged = (bf16_t*)(ws + 222 * MiB);
    p.kpe = (bf16_t*)(ws + 286 * MiB); p.lf = (float*)(ws + 287 * MiB); p.F = (float*)(ws + 287 * MiB + 512 * 1024);
    p.qa = (bf16_t*)(ws + 288 * MiB); p.va = (bf16_t*)(ws + 336 * MiB); p.ka = (bf16_t*)(ws + 400 * MiB); p.x1 = (float*)(ws + 126 * MiB);
    p.scores = (float*)(ws + 222 * MiB);
    p.ctl = (unsigned*)ws;
    p.ropeT = (float2*)(ws + 448 * MiB);
    p.ssq = (float*)(ws + 64 * 1024);
    p.attout = (bf16_t*)(ws + 33 * MiB);
    p.U8 = (unsigned char*)(ws + 450 * MiB); p.V8 = (unsigned char*)(ws + 368 * MiB);
    p.xg = (bf16_t*)(ws + 190 * MiB);
    p.ssq2 = (float*)(ws + 482 * MiB);

    static int grid_blocks = 0;
    if (!grid_blocks) {
        if (hipFuncSetAttribute((const void*)mega, hipFuncAttributeMaxDynamicSharedMemorySize, LDS_BYTES) != hipSuccess) { fprintf(stderr, "hipFuncSetAttribute failed\n"); return; }
        int dev = 0, cus = 0, per_cu = 0;
        (void)hipGetDevice(&dev);
        (void)hipDeviceGetAttribute(&cus, hipDeviceAttributeMultiprocessorCount, dev);
        (void)hipOccupancyMaxActiveBlocksPerMultiprocessor(&per_cu, (const void*)mega, 512, LDS_BYTES);
        if (per_cu < 1 || cus < 1) { fprintf(stderr, "occupancy query says %d blocks/CU on %d CUs\n", per_cu, cus); return; }
        grid_blocks = cus;
    }
    if (hipMemsetAsync(d_ws, 0, 16384, stream) != hipSuccess) { fprintf(stderr, "memset of the barrier words failed\n"); return; }
    void* args[] = {&p};
    hipError_t e = hipLaunchCooperativeKernel((const void*)mega, dim3(grid_blocks), dim3(512), args, LDS_BYTES, stream);
    if (e != hipSuccess) fprintf(stderr, "cooperative launch failed: %s (grid %d)\n", hipGetErrorString(e), grid_blocks);
}
```

```cpp
#include <hip/hip_runtime.h>
#include <hip/hip_cooperative_groups.h>
#include <stdint.h>
#include <math.h>
#include <cstdio>
namespace cg = cooperative_groups;

namespace pg8 {
#define PG8_LAS __attribute__((address_space(3)))
typedef unsigned short bf16_t;
typedef short bf16x8 __attribute__((ext_vector_type(8)));
typedef float f32x4 __attribute__((ext_vector_type(4)));
typedef unsigned u32x4 __attribute__((ext_vector_type(4)));
constexpr int BM = 256, BK = 64, HALF = 128, HTB = HALF * BK * 2  , STAGE_BYTES = 8 * HTB, NXCD = 8, WGM = 8;

__host__ __device__ __forceinline__ int lds_byte(int r, int c) { const int st = (r >> 4) * 2 + (c >> 5), rr = r & 15, cc = c & 31, ob = rr * 64 + cc * 2; return st * 1024 + (ob ^ (((ob >> 9) & 1) << 5)); }
__host__ __device__ __forceinline__ void stage_rc(int b, int& R, int& C) { const int st = b / 1024, sb = b % 1024, swz = sb ^ (((sb >> 9) & 1) << 5); R = (st >> 1) * 16 + swz / 64; C = (st & 1) * 32 + (swz % 64) / 2; }
__host__ __device__ __forceinline__ int perm32(int rho) { const int n = rho >> 4, i = rho & 15; return 8 * (i >> 2) + 4 * n + (i & 3); }

struct Unit { int pm, pn; };
struct Gemm { const bf16_t* A; const bf16_t* Bt; int M, N, K; };

struct StaticOrder {
    int nM, nN, nwg, G, c;
    __host__ __device__ void init(int M, int N, int G_, int c_) { nM = M / BM; nN = N / BM; nwg = nM * nN; G = G_; c = c_; }
    __host__ __device__ bool next(int i, Unit& u) const {
        const long L = (long)i * G + c; if (L >= nwg) return false;
        int wgid = (int)L; { const int q = nwg / NXCD, r = nwg % NXCD, xcd = wgid % NXCD, off = wgid / NXCD; wgid = (xcd < r ? xcd * (q + 1) : r * (q + 1) + (xcd - r) * q) + off; }
        const int nig = WGM * nN, gid = wgid / nig, fm = gid * WGM, gsz = (nM - fm) < WGM ? (nM - fm) : WGM;
        u.pm = fm + ((wgid % nig) % gsz); u.pn = (wgid % nig) / gsz; return true;
    }
    __device__ __forceinline__ void a_ready(const Unit&) const {}
    __device__ __forceinline__ void done(const Unit&) const {}
};

typedef float cvt_pk_bf16_f32x2 __attribute__((ext_vector_type(2))); typedef __bf16 cvt_pk_bf16_bf16x2 __attribute__((ext_vector_type(2)));
__device__ __forceinline__ unsigned cvt_pk_bf16(float lo, float hi) { const cvt_pk_bf16_f32x2 v = {lo, hi}; const cvt_pk_bf16_bf16x2 b = __builtin_convertvector(v, cvt_pk_bf16_bf16x2); return __builtin_bit_cast(unsigned, b); }
__device__ __forceinline__ u32x4 pack8bf(const f32x4& v0, const f32x4& v1) { u32x4 w; w.x = cvt_pk_bf16(v0[0], v0[1]); w.y = cvt_pk_bf16(v0[2], v0[3]); w.z = cvt_pk_bf16(v1[0], v1[1]); w.w = cvt_pk_bf16(v1[2], v1[3]); return w; }

struct EpiStoreBf16 {
    static constexpr bool PERM = true, AFTER_DRAIN = false;
    bf16_t* O; int ldc;
    __device__ __forceinline__ void operator()(const f32x4 (&acc)[2][2][4][2], const Unit& u, int wr, int wc, int fr, int fq) const {
        const int row0 = u.pm * BM + wr * 64 + fr, col0 = u.pn * BM + wc * 32 + 8 * fq;
#pragma unroll
        for (int ai = 0; ai < 2; ++ai)
#pragma unroll
            for (int m = 0; m < 4; ++m) { bf16_t* rowp = O + (size_t)(row0 + ai * HALF + m * 16) * ldc + col0;
#pragma unroll
                for (int bj = 0; bj < 2; ++bj) *(u32x4*)(rowp + bj * HALF) = pack8bf(acc[ai][bj][m][0], acc[ai][bj][m][1]); }
    }
};
template <bool RES> struct EpiStoreF32 {
    static constexpr bool PERM = true, AFTER_DRAIN = false;
    float* O; const float* res; int ldc;
    __device__ __forceinline__ void operator()(const f32x4 (&acc)[2][2][4][2], const Unit& u, int wr, int wc, int fr, int fq) const {
        const int row0 = u.pm * BM + wr * 64 + fr, col0 = u.pn * BM + wc * 32 + 8 * fq;
#pragma unroll
        for (int ai = 0; ai < 2; ++ai)
#pragma unroll
            for (int m = 0; m < 4; ++m) { const size_t off = (size_t)(row0 + ai * HALF + m * 16) * ldc + col0;
#pragma unroll
                for (int bj = 0; bj < 2; ++bj) { f32x4 v0 = acc[ai][bj][m][0], v1 = acc[ai][bj][m][1];
                    if (RES) { v0 += *(const f32x4*)(res + off + bj * HALF); v1 += *(const f32x4*)(res + off + bj * HALF + 4); }
                    *(f32x4*)(O + off + bj * HALF) = v0; *(f32x4*)(O + off + bj * HALF + 4) = v1; } }
    }
};
#define EPI_LDSBAR() do { asm volatile("s_waitcnt lgkmcnt(0)" ::: "memory"); __builtin_amdgcn_s_barrier(); asm volatile("" ::: "memory"); } while (0)
struct EpiInProj {
    static constexpr bool PERM = true, AFTER_DRAIN = false;
    bf16_t *cq, *ckv, *fq, *fk, *fv, *gates, *kpe; float* lf; const float *b_gate, *b_forget; float* ssq; const float *gfq, *gfk; PG8_LAS float* xs;
    __device__ __forceinline__ void operator()(const f32x4 (&acc)[2][2][4][2], const Unit& u, int wr, int wc, int fr, int fq_) const {
        const int pn = u.pn, row0 = u.pm * BM + wr * 64 + fr, cw = wc * 32 + 8 * fq_;
        if (pn < 4) {
            bf16_t* base = pn < 2 ? cq : ckv; const int colt = (pn & 1) * 256;
#pragma unroll
            for (int ai = 0; ai < 2; ++ai)
#pragma unroll
                for (int m = 0; m < 4; ++m) { const int row = row0 + ai * HALF + m * 16; bf16_t* rowp = base + (size_t)row * 512 + colt + cw; float s = 0.f;
#pragma unroll
                    for (int bj = 0; bj < 2; ++bj) { const f32x4 v0 = acc[ai][bj][m][0], v1 = acc[ai][bj][m][1];
                        s += (v0[0] * v0[0] + v0[1] * v0[1]) + (v0[2] * v0[2] + v0[3] * v0[3]) + (v1[0] * v1[0] + v1[1] * v1[1]) + (v1[2] * v1[2] + v1[3] * v1[3]);
                        *(u32x4*)(rowp + bj * HALF) = pack8bf(v0, v1); }
                    s += __shfl_xor(s, 16); s += __shfl_xor(s, 32);
                    if (fq_ == 0) ssq[((size_t)pn * 8192 + row) * 4 + wc] = s; }
        } else if (pn < 20) {
            const bool isq = pn < 12; bf16_t* base = isq ? fq : fk; const int colt = (pn - (isq ? 4 : 12)) * 256; const float* g = isq ? gfq : gfk;
            const float qs = isq ? 0.12751743f : 1.f;
#pragma unroll
            for (int ai = 0; ai < 2; ++ai)
#pragma unroll
                for (int m = 0; m < 4; ++m)
#pragma unroll
                    for (int bj = 0; bj < 2; ++bj) { const f32x4 v0 = acc[ai][bj][m][0], v1 = acc[ai][bj][m][1];
                        float s = (v0[0] * v0[0] + v0[1] * v0[1]) + (v0[2] * v0[2] + v0[3] * v0[3]) + (v1[0] * v1[0] + v1[1] * v1[1]) + (v1[2] * v1[2] + v1[3] * v1[3]);
                        s += __shfl_xor(s, 16); s += __shfl_xor(s, 32);
                        if (fq_ == 0) xs[((ai * HALF + wr * 64 + m * 16 + fr) * 2 + bj) * 4 + wc] = s; }
            EPI_LDSBAR();
            const f32x4 g0 = *(const f32x4*)(g + cw) * qs, g1 = *(const f32x4*)(g + cw + 4) * qs;
#pragma unroll
            for (int ai = 0; ai < 2; ++ai)
#pragma unroll
                for (int m = 0; m < 4; ++m) { bf16_t* rowp = base + (size_t)(row0 + ai * HALF + m * 16) * 2048 + colt + cw;
#pragma unroll
                    for (int bj = 0; bj < 2; ++bj) { const f32x4 t4 = *(const PG8_LAS f32x4*)(xs + ((ai * HALF + wr * 64 + m * 16 + fr) * 2 + bj) * 4);
                        const float r = rsqrtf(((t4[0] + t4[1]) + (t4[2] + t4[3])) * (1.f / 128.f) + 1e-6f);
                        *(u32x4*)(rowp + bj * HALF) = pack8bf(acc[ai][bj][m][0] * g0 * r, acc[ai][bj][m][1] * g1 * r); } }
        } else if (pn < 28) {
            const int colt = (pn - 20) * 256;
#pragma unroll
            for (int ai = 0; ai < 2; ++ai)
#pragma unroll
                for (int m = 0; m < 4; ++m) { bf16_t* rowp = fv + (size_t)(row0 + ai * HALF + m * 16) * 2048 + colt + cw;
#pragma unroll
                    for (int bj = 0; bj < 2; ++bj) *(u32x4*)(rowp + bj * HALF) = pack8bf(acc[ai][bj][m][0], acc[ai][bj][m][1]); }
        } else if (pn < 44) {
            const int colt = (pn - 28) * 256 + cw;
#pragma unroll
            for (int bj = 0; bj < 2; ++bj) {
                const f32x4 b0 = *(const f32x4*)(b_gate + colt + bj * HALF), b1 = *(const f32x4*)(b_gate + colt + bj * HALF + 4);
#pragma unroll
                for (int ai = 0; ai < 2; ++ai)
#pragma unroll
                    for (int m = 0; m < 4; ++m) {
                        f32x4 v0 = acc[ai][bj][m][0] + b0, v1 = acc[ai][bj][m][1] + b1;
#pragma unroll
                        for (int e = 0; e < 4; ++e) { v0[e] = __builtin_amdgcn_rcpf(1.f + __expf(-v0[e])); v1[e] = __builtin_amdgcn_rcpf(1.f + __expf(-v1[e])); }
                        *(u32x4*)(gates + (size_t)(row0 + ai * HALF + m * 16) * 4096 + colt + bj * HALF) = pack8bf(v0, v1); }
            }
        } else {
            if (cw < 64) {
#pragma unroll
                for (int ai = 0; ai < 2; ++ai)
#pragma unroll
                    for (int m = 0; m < 4; ++m) *(u32x4*)(kpe + (size_t)(row0 + ai * HALF + m * 16) * 64 + cw) = pack8bf(acc[ai][0][m][0], acc[ai][0][m][1]);
            } else if (cw < 80) {
                const int h0 = cw - 64;
                const f32x4 b0 = *(const f32x4*)(b_forget + h0), b1 = *(const f32x4*)(b_forget + h0 + 4);
#pragma unroll
                for (int ai = 0; ai < 2; ++ai)
#pragma unroll
                    for (int m = 0; m < 4; ++m) { const int row = row0 + ai * HALF + m * 16;
                        f32x4 z0 = acc[ai][0][m][0] + b0, z1 = acc[ai][0][m][1] + b1;
#pragma unroll
                        for (int e = 0; e < 4; ++e) { z0[e] = fminf(z0[e], 0.f) - __logf(1.f + __expf(-fabsf(z0[e]))); z1[e] = fminf(z1[e], 0.f) - __logf(1.f + __expf(-fabsf(z1[e]))); }
                        *(f32x4*)(lf + (size_t)row * 16 + h0) = z0; *(f32x4*)(lf + (size_t)row * 16 + h0 + 4) = z1; }
            }
        }
    }
};
__device__ __forceinline__ float lat_rinv(const float* ssq, int part0, int row) {
    const f32x4 a = *(const f32x4*)(ssq + ((size_t)part0 * 8192 + row) * 4), b = *(const f32x4*)(ssq + ((size_t)(part0 + 1) * 8192 + row) * 4);
    return rsqrtf((((a[0] + a[1]) + (a[2] + a[3])) + ((b[0] + b[1]) + (b[2] + b[3]))) * (1.f / 512.f) + 1e-6f);
}
struct EpiQ {
    static constexpr bool PERM = true, AFTER_DRAIN = false;
    bf16_t* qa; const float* ssq; const float* gq; const float2* ropeT; PG8_LAS float* xs;
    __device__ __forceinline__ void operator()(const f32x4 (&acc)[2][2][4][2], const Unit& u, int wr, int wc, int fr, int fq_) const {
        const int h = u.pn, row0 = u.pm * BM + wr * 64 + fr, cw = wc * 32 + 8 * fq_;
        float rl[2][4];
#pragma unroll
        for (int ai = 0; ai < 2; ++ai)
#pragma unroll
            for (int m = 0; m < 4; ++m) { rl[ai][m] = lat_rinv(ssq, 0, row0 + ai * HALF + m * 16); float s = 0.f;
#pragma unroll
                for (int bj = 0; bj < 2; ++bj) { const f32x4 v0 = acc[ai][bj][m][0], v1 = acc[ai][bj][m][1];
                    s += (v0[0] * v0[0] + v0[1] * v0[1]) + (v0[2] * v0[2] + v0[3] * v0[3]) + (v1[0] * v1[0] + v1[1] * v1[1]) + (v1[2] * v1[2] + v1[3] * v1[3]); }
                s *= rl[ai][m] * rl[ai][m];
                s += __shfl_xor(s, 16); s += __shfl_xor(s, 32);
                if (fq_ == 0) xs[(ai * HALF + wr * 64 + m * 16 + fr) * 4 + wc] = s; }
        EPI_LDSBAR();
        const float qs = 0.10411754f;
        const f32x4 g0 = *(const f32x4*)(gq + cw) * qs, g1 = *(const f32x4*)(gq + cw + 4) * qs;
        const int pp = 16 * (wc & 1) + 4 * fq_;
        const f32x4 ga = *(const f32x4*)(gq + 128 + pp) * qs, gb = *(const f32x4*)(gq + 160 + pp) * qs;
#pragma unroll
        for (int ai = 0; ai < 2; ++ai) {
            f32x4 rc0[4], rc1[4];
            if (wc < 2) {
#pragma unroll
                for (int m = 0; m < 4; ++m) { const size_t ro = (size_t)(row0 + ai * HALF + m * 16) * 32 + pp; rc0[m] = *(const f32x4*)(ropeT + ro); rc1[m] = *(const f32x4*)(ropeT + ro + 2); } }
#pragma unroll
            for (int m = 0; m < 4; ++m) { const int row = row0 + ai * HALF + m * 16;
                const f32x4 t4 = *(const PG8_LAS f32x4*)(xs + (ai * HALF + wr * 64 + m * 16 + fr) * 4);
                const float r = rsqrtf(((t4[0] + t4[1]) + (t4[2] + t4[3])) * (1.f / 192.f) + 1e-6f) * rl[ai][m];
                bf16_t* rowp = qa + (size_t)row * 3072 + h * 192;
                *(u32x4*)(rowp + cw) = pack8bf(acc[ai][0][m][0] * g0 * r, acc[ai][0][m][1] * g1 * r);
                if (wc < 2) { const f32x4 c01 = rc0[m], c23 = rc1[m];
                    const f32x4 z0 = acc[ai][1][m][0] * r, z1 = acc[ai][1][m][1] * r;
                    const float a0 = z0[0] * ga[0], b0 = z0[1] * gb[0], a1 = z0[2] * ga[1], b1 = z0[3] * gb[1], a2 = z1[0] * ga[2], b2 = z1[1] * gb[2], a3 = z1[2] * ga[3], b3 = z1[3] * gb[3];
                    const f32x4 o0 = {a0 * c01[0] - b0 * c01[1], a0 * c01[1] + b0 * c01[0], a1 * c01[2] - b1 * c01[3], a1 * c01[3] + b1 * c01[2]};
                    const f32x4 o1 = {a2 * c23[0] - b2 * c23[1], a2 * c23[1] + b2 * c23[0], a3 * c23[2] - b3 * c23[3], a3 * c23[3] + b3 * c23[2]};
                    *(u32x4*)(rowp + 128 + cw) = pack8bf(o0, o1); } }
        }
    }
};
struct EpiKV {
    static constexpr bool PERM = true, AFTER_DRAIN = false;
    bf16_t *ka, *va; const bf16_t* kpe; const float* ssq; const float* gk; const float2* ropeT; PG8_LAS float* xs;
    __device__ __forceinline__ void operator()(const f32x4 (&acc)[2][2][4][2], const Unit& u, int wr, int wc, int fr, int fq_) const {
        const int h = u.pn, row0 = u.pm * BM + wr * 64 + fr, cw = wc * 32 + 8 * fq_;
        float rl[2][4]; f32x4 kp[2][4];
#pragma unroll
        for (int ai = 0; ai < 2; ++ai)
#pragma unroll
            for (int m = 0; m < 4; ++m) { const int row = row0 + ai * HALF + m * 16; rl[ai][m] = lat_rinv(ssq, 2, row);
                const uint2 w = *(const uint2*)(kpe + (size_t)row * 64 + 16 * wc + 4 * fq_);
                kp[ai][m] = (f32x4){__uint_as_float(w.x << 16), __uint_as_float(w.x & 0xffff0000u), __uint_as_float(w.y << 16), __uint_as_float(w.y & 0xffff0000u)};
                const f32x4 v0 = acc[ai][0][m][0], v1 = acc[ai][0][m][1];
                float s = ((v0[0] * v0[0] + v0[1] * v0[1]) + (v0[2] * v0[2] + v0[3] * v0[3]) + (v1[0] * v1[0] + v1[1] * v1[1]) + (v1[2] * v1[2] + v1[3] * v1[3])) * (rl[ai][m] * rl[ai][m]);
                s += (kp[ai][m][0] * kp[ai][m][0] + kp[ai][m][1] * kp[ai][m][1]) + (kp[ai][m][2] * kp[ai][m][2] + kp[ai][m][3] * kp[ai][m][3]);
                s += __shfl_xor(s, 16); s += __shfl_xor(s, 32);
                if (fq_ == 0) xs[(ai * HALF + wr * 64 + m * 16 + fr) * 4 + wc] = s; }
        const int pp = 8 * wc + 2 * fq_;
#pragma unroll
        for (int ai = 0; ai < 2; ++ai)
#pragma unroll
            for (int m = 0; m < 4; ++m) *(u32x4*)(va + (size_t)(row0 + ai * HALF + m * 16) * 2048 + h * 128 + cw) = pack8bf(acc[ai][1][m][0] * rl[ai][m], acc[ai][1][m][1] * rl[ai][m]);
        EPI_LDSBAR();
        const f32x4 g0 = *(const f32x4*)(gk + cw), g1 = *(const f32x4*)(gk + cw + 4);
        const float ga0 = gk[128 + pp], ga1 = gk[128 + pp + 1], gb0 = gk[160 + pp], gb1 = gk[160 + pp + 1];
#pragma unroll
        for (int ai = 0; ai < 2; ++ai) {
            f32x4 rcs[4];
#pragma unroll
            for (int m = 0; m < 4; ++m) rcs[m] = *(const f32x4*)(ropeT + (size_t)(row0 + ai * HALF + m * 16) * 32 + pp);
#pragma unroll
            for (int m = 0; m < 4; ++m) { const int row = row0 + ai * HALF + m * 16;
                const f32x4 t4 = *(const PG8_LAS f32x4*)(xs + (ai * HALF + wr * 64 + m * 16 + fr) * 4);
                const float r = rsqrtf(((t4[0] + t4[1]) + (t4[2] + t4[3])) * (1.f / 192.f) + 1e-6f), rn = r * rl[ai][m];
                bf16_t* rowp = ka + (size_t)row * 3072 + h * 192;
                *(u32x4*)(rowp + cw) = pack8bf(acc[ai][0][m][0] * g0 * rn, acc[ai][0][m][1] * g1 * rn);
                const f32x4 cs = rcs[m];
                const float a0 = kp[ai][m][0] * r * ga0, b0 = kp[ai][m][1] * r * gb0, a1 = kp[ai][m][2] * r * ga1, b1 = kp[ai][m][3] * r * gb1;
                uint2 o; o.x = cvt_pk_bf16(a0 * cs[0] - b0 * cs[1], a0 * cs[1] + b0 * cs[0]); o.y = cvt_pk_bf16(a1 * cs[2] - b1 * cs[3], a1 * cs[3] + b1 * cs[2]);
                *(uint2*)(rowp + 128 + 16 * wc + 4 * fq_) = o; }
        }
    }
};

struct EpiX1 {
    static constexpr bool PERM = true, AFTER_DRAIN = false;
    float* x1; const float* x; bf16_t* xg; const float* g; float* ssq2;
    __device__ __forceinline__ void operator()(const f32x4 (&acc)[2][2][4][2], const Unit& u, int wr, int wc, int fr, int fq_) const {
        const int row0 = u.pm * BM + wr * 64 + fr, col0 = u.pn * BM + wc * 32 + 8 * fq_;
        f32x4 gg[2][2];
#pragma unroll
        for (int bj = 0; bj < 2; ++bj) { gg[bj][0] = *(const f32x4*)(g + col0 + bj * HALF); gg[bj][1] = *(const f32x4*)(g + col0 + bj * HALF + 4); }
#pragma unroll
        for (int am = 0; am < 4; ++am) { const int ai = am >> 1;
            f32x4 xr[4][2][2];
#pragma unroll
            for (int m = 2 * (am & 1); m < 2 * (am & 1) + 2; ++m)
#pragma unroll
                for (int bj = 0; bj < 2; ++bj) { const size_t off = (size_t)(row0 + ai * HALF + m * 16) * 2048 + col0 + bj * HALF; xr[m][bj][0] = *(const f32x4*)(x + off); xr[m][bj][1] = *(const f32x4*)(x + off + 4); }
#pragma unroll
            for (int m = 2 * (am & 1); m < 2 * (am & 1) + 2; ++m) { const int row = row0 + ai * HALF + m * 16; const size_t off = (size_t)row * 2048 + col0; float s = 0.f;
#pragma unroll
                for (int bj = 0; bj < 2; ++bj) { const f32x4 v0 = acc[ai][bj][m][0] + xr[m][bj][0], v1 = acc[ai][bj][m][1] + xr[m][bj][1];
                    *(f32x4*)(x1 + off + bj * HALF) = v0; *(f32x4*)(x1 + off + bj * HALF + 4) = v1;
                    s += (v0[0] * v0[0] + v0[1] * v0[1]) + (v0[2] * v0[2] + v0[3] * v0[3]) + (v1[0] * v1[0] + v1[1] * v1[1]) + (v1[2] * v1[2] + v1[3] * v1[3]);
                    *(u32x4*)(xg + off + bj * HALF) = pack8bf(v0 * gg[bj][0], v1 * gg[bj][1]); }
                s += __shfl_xor(s, 16); s += __shfl_xor(s, 32);
                if (fq_ == 0) ssq2[((size_t)u.pn * 8192 + row) * 4 + wc] = s; }
        }
    }
};
__device__ __forceinline__ float ffn_rinv(const float* ssq2, int row) {
    float t = 0.f;
#pragma unroll
    for (int pn = 0; pn < 8; ++pn) { const f32x4 a = *(const f32x4*)(ssq2 + ((size_t)pn * 8192 + row) * 4); t += (a[0] + a[1]) + (a[2] + a[3]); }
    return rsqrtf(t * (1.f / 2048.f) + 1e-6f);
}
struct EpiScores {
    static constexpr bool PERM = true, AFTER_DRAIN = false;
    float* O; const float* ssq2;
    __device__ __forceinline__ void operator()(const f32x4 (&acc)[2][2][4][2], const Unit& u, int wr, int wc, int fr, int fq_) const {
        const int row0 = u.pm * BM + wr * 64 + fr, col0 = u.pn * BM + wc * 32 + 8 * fq_;
        float rr[2][4];
#pragma unroll
        for (int ai = 0; ai < 2; ++ai)
#pragma unroll
            for (int m = 0; m < 4; ++m) rr[ai][m] = ffn_rinv(ssq2, row0 + ai * HALF + m * 16);
#pragma unroll
        for (int ai = 0; ai < 2; ++ai)
#pragma unroll
            for (int m = 0; m < 4; ++m) { const int row = row0 + ai * HALF + m * 16; const float r = rr[ai][m]; const size_t off = (size_t)row * 2048 + col0;
#pragma unroll
                for (int bj = 0; bj < 2; ++bj) { *(f32x4*)(O + off + bj * HALF) = acc[ai][bj][m][0] * r; *(f32x4*)(O + off + bj * HALF + 4) = acc[ai][bj][m][1] * r; } }
    }
};
template <class Epi, class Sched, bool ALIGN_EPI = false, bool SP2 = false>
__device__ __forceinline__ void gemm_phase(PG8_LAS unsigned char* lds, const Gemm g, const Sched& S, const Epi& E) {
    int tid = threadIdx.x; asm volatile("" : "+v"(tid));
    const int wid = __builtin_amdgcn_readfirstlane(tid >> 6), lane = tid & 63, wr = wid >> 2, wc = wid & 3, fr = lane & 15, fq = lane >> 4;
    const int K = g.K, nt = K / BK;
    unsigned voffA[2], voffB[2];
#pragma unroll
    for (int i = 0; i < 2; ++i) { int R, C; stage_rc(tid * 16 + i * 8192, R, C); const int Rb = Epi::PERM ? ((R & ~31) + perm32(R & 31)) : R;
        voffA[i] = (unsigned)(R * K + C) * 2u; voffB[i] = (unsigned)(Rb * K + C) * 2u; }
    const size_t kstep = (size_t)(BK * 2);
    const size_t hstep = (size_t)HALF * K * 2;
    const size_t tstep = 2 * hstep;
    const unsigned ldsw = (unsigned)wid * 1024u;
    const int aoff = lds_byte(wr * 64 + fr, fq * 8), boff = lds_byte(wc * 32 + fr, fq * 8);
#define PG8_SA(b, h) (((b) * 2 + (h)) * HTB)
#define PG8_SB(b, h) ((4 + (b) * 2 + (h)) * HTB)
#define PG8_STAGE(bufoff, gbase, voff) do { _Pragma("unroll") for (int _i = 0; _i < 2; ++_i) \
        __builtin_amdgcn_global_load_lds((const unsigned*)((const char*)(gbase) + (voff)[_i]), (PG8_LAS unsigned*)(lds + (bufoff) + ldsw + _i * 8192), 16, 0, 0); } while (0)
#define PG8_LDA(dst, b, h) do { _Pragma("unroll") for (int m = 0; m < 4; ++m) _Pragma("unroll") for (int k = 0; k < 2; ++k) dst[m][k] = *(const PG8_LAS bf16x8*)(lds + PG8_SA(b, h) + aoff + m * 2048 + k * 1024); } while (0)
#define PG8_LDB(dst, b, h) do { _Pragma("unroll") for (int n = 0; n < 2; ++n) _Pragma("unroll") for (int k = 0; k < 2; ++k) dst[n][k] = *(const PG8_LAS bf16x8*)(lds + PG8_SB(b, h) + boff + n * 2048 + k * 1024); } while (0)
#define PG8_MMA(ai, bj, At, Bt) do { __builtin_amdgcn_s_setprio(1); _Pragma("unroll") for (int m = 0; m < 4; ++m) _Pragma("unroll") for (int n = 0; n < 2; ++n) _Pragma("unroll") for (int k = 0; k < 2; ++k) \
        acc[ai][bj][m][n] = __builtin_amdgcn_mfma_f32_16x16x32_bf16(Bt[n][k], At[m][k], acc[ai][bj][m][n], 0, 0, 0); __builtin_amdgcn_s_setprio(0); } while (0)
#define PG8_WAIT_V(n) asm volatile("s_waitcnt vmcnt(" #n ")" ::: "memory")
#define PG8_WAIT_L(n) asm volatile("s_waitcnt lgkmcnt(" #n ")" ::: "memory")
#define PG8_BAR __builtin_amdgcn_s_barrier()
#define PG8_SCHED __builtin_amdgcn_sched_barrier(0)
    Unit cur, nxt; int ui = 0;
    if (!S.next(0, cur)) return;
    f32x4 acc[2][2][4][2];
#pragma unroll
    for (int a = 0; a < 2; ++a)
#pragma unroll
        for (int b = 0; b < 2; ++b)
#pragma unroll
            for (int m = 0; m < 4; ++m)
#pragma unroll
                for (int n = 0; n < 2; ++n) acc[a][b][m][n] = (f32x4){0.f, 0.f, 0.f, 0.f};
    bf16x8 At[4][2], B0[2][2], B1[2][2];
    const char* cA = (const char*)g.A + (size_t)cur.pm * tstep; const char* cB = (const char*)g.Bt + (size_t)cur.pn * tstep;
    S.a_ready(cur);
    if constexpr (SP2) {
        PG8_STAGE(PG8_SB(0, 0), cB, voffB); PG8_STAGE(PG8_SB(0, 1), cB + hstep, voffB); PG8_STAGE(PG8_SA(0, 0), cA, voffA); PG8_STAGE(PG8_SA(0, 1), cA + hstep, voffA);
        if (wr == 1) PG8_BAR;
        PG8_WAIT_V(2); PG8_BAR;
        PG8_STAGE(PG8_SB(1, 0), cB + kstep, voffB); PG8_STAGE(PG8_SA(1, 0), cA + kstep, voffA); PG8_STAGE(PG8_SB(1, 1), cB + hstep + kstep, voffB);
        PG8_WAIT_V(6); PG8_BAR;
    } else {
        PG8_STAGE(PG8_SB(0, 0), cB, voffB); PG8_STAGE(PG8_SA(0, 0), cA, voffA); PG8_STAGE(PG8_SB(0, 1), cB + hstep, voffB); PG8_STAGE(PG8_SA(0, 1), cA + hstep, voffA);
        if (wr == 1) PG8_BAR;
        PG8_WAIT_V(4); PG8_BAR;
        PG8_STAGE(PG8_SB(1, 0), cB + kstep, voffB); PG8_STAGE(PG8_SA(1, 0), cA + kstep, voffA); PG8_STAGE(PG8_SB(1, 1), cB + hstep + kstep, voffB);
        PG8_WAIT_V(6); PG8_BAR;
    }
    for (;;) {
        const bool has_next = S.next(ui + 1, nxt);
        const char* nA = has_next ? (const char*)g.A + (size_t)nxt.pm * tstep : cA; const char* nB = has_next ? (const char*)g.Bt + (size_t)nxt.pn * tstep : cB;
        for (int t = 0; t < nt; t += 2) {
            const bool last = (t == nt - 2);
            const char* a1 = cA + (size_t)(t + 1) * kstep;
            const char* a2 = last ? nA : cA + (size_t)(t + 2) * kstep; const char* b2 = last ? nB : cB + (size_t)(t + 2) * kstep;
            const char* a3 = a2 + kstep; const char* b3 = b2 + kstep;
            if (last && has_next) S.a_ready(nxt);
            if constexpr (SP2) {
            PG8_LDB(B0, 0, 0); PG8_LDB(B1, 0, 1); PG8_SCHED; PG8_LDA(At, 0, 0); PG8_STAGE(PG8_SA(1, 1), a1 + hstep, voffA);
            PG8_WAIT_V(8); PG8_WAIT_L(0); PG8_BAR; PG8_MMA(0, 0, At, B0); PG8_MMA(0, 1, At, B1); PG8_BAR; PG8_SCHED;
            PG8_LDA(At, 0, 1); PG8_STAGE(PG8_SB(0, 0), b2, voffB); PG8_STAGE(PG8_SB(0, 1), b2 + hstep, voffB); PG8_STAGE(PG8_SA(0, 0), a2, voffA);
            PG8_WAIT_V(8); PG8_WAIT_L(0); PG8_BAR; PG8_MMA(1, 0, At, B0); PG8_MMA(1, 1, At, B1); PG8_BAR; PG8_SCHED;
            PG8_LDB(B0, 1, 0); PG8_LDB(B1, 1, 1); PG8_SCHED; PG8_LDA(At, 1, 0); PG8_STAGE(PG8_SA(0, 1), a2 + hstep, voffA);
            PG8_WAIT_V(8); PG8_WAIT_L(0); PG8_BAR; PG8_MMA(0, 0, At, B0); PG8_MMA(0, 1, At, B1); PG8_BAR; PG8_SCHED;
            PG8_LDA(At, 1, 1); PG8_STAGE(PG8_SB(1, 0), b3, voffB); PG8_STAGE(PG8_SB(1, 1), b3 + hstep, voffB); PG8_STAGE(PG8_SA(1, 0), a3, voffA);
            PG8_WAIT_V(8); PG8_WAIT_L(0); PG8_BAR; PG8_MMA(1, 0, At, B0); PG8_MMA(1, 1, At, B1); PG8_BAR; PG8_SCHED;
            } else {
            PG8_LDB(B0, 0, 0); PG8_SCHED; PG8_LDA(At, 0, 0); PG8_STAGE(PG8_SA(1, 1), a1 + hstep, voffA);
            PG8_WAIT_L(8); PG8_BAR; PG8_WAIT_L(0); PG8_MMA(0, 0, At, B0); PG8_BAR; PG8_SCHED;
            PG8_LDB(B1, 0, 1); PG8_STAGE(PG8_SB(0, 0), b2, voffB);
            PG8_BAR; PG8_WAIT_L(0); PG8_MMA(0, 1, At, B1); PG8_BAR;
            PG8_LDA(At, 0, 1); PG8_STAGE(PG8_SA(0, 0), a2, voffA);
            PG8_BAR; PG8_WAIT_L(0); PG8_MMA(1, 0, At, B0); PG8_BAR; PG8_SCHED;
            PG8_STAGE(PG8_SB(0, 1), b2 + hstep, voffB);
            PG8_WAIT_V(6); PG8_BAR; PG8_MMA(1, 1, At, B1); PG8_BAR;
            PG8_LDB(B0, 1, 0); PG8_SCHED; PG8_LDA(At, 1, 0); PG8_STAGE(PG8_SA(0, 1), a2 + hstep, voffA);
            PG8_WAIT_L(8); PG8_BAR; PG8_WAIT_L(0); PG8_MMA(0, 0, At, B0); PG8_BAR; PG8_SCHED;
            PG8_LDB(B1, 1, 1); PG8_STAGE(PG8_SB(1, 0), b3, voffB);
            PG8_BAR; PG8_WAIT_L(0); PG8_MMA(0, 1, At, B1); PG8_BAR;
            PG8_LDA(At, 1, 1); PG8_STAGE(PG8_SA(1, 0), a3, voffA);
            PG8_BAR; PG8_WAIT_L(0); PG8_MMA(1, 0, At, B0); PG8_BAR; PG8_SCHED;
            PG8_STAGE(PG8_SB(1, 1), b3 + hstep, voffB);
            PG8_WAIT_V(6); PG8_BAR; PG8_MMA(1, 1, At, B1); PG8_BAR;
            }
        }
        if constexpr (ALIGN_EPI) { if (wr == 0) PG8_BAR; }
        if constexpr (!Epi::AFTER_DRAIN) { E(acc, cur, wr, wc, fr, fq); S.done(cur); }
        if (!has_next) break;
#pragma unroll
        for (int a = 0; a < 2; ++a)
#pragma unroll
            for (int b = 0; b < 2; ++b)
#pragma unroll
                for (int m = 0; m < 4; ++m)
#pragma unroll
                    for (int n = 0; n < 2; ++n) acc[a][b][m][n] = (f32x4){0.f, 0.f, 0.f, 0.f};
        cur = nxt; cA = nA; cB = nB; ++ui;
        if constexpr (ALIGN_EPI) { if (wr == 1) PG8_BAR; }
    }
    PG8_WAIT_V(0);
    if constexpr (!ALIGN_EPI) { if (wr == 0) PG8_BAR; }
    PG8_BAR;
    if constexpr (Epi::AFTER_DRAIN) { E.fused(acc, cur, wr, wc, fr, fq, lds, wid, lane); S.done(cur); }
#undef PG8_SA
#undef PG8_SB
#undef PG8_STAGE
#undef PG8_LDA
#undef PG8_LDB
#undef PG8_MMA
#undef PG8_WAIT_V
#undef PG8_WAIT_L
#undef PG8_BAR
#undef PG8_SCHED
}
}
namespace att {
typedef unsigned short bf16_t;
typedef short bf16x8 __attribute__((ext_vector_type(8)));
typedef short s16x4 __attribute__((ext_vector_type(4)));
typedef float f32x16 __attribute__((ext_vector_type(16)));
typedef float f32x4 __attribute__((ext_vector_type(4)));
typedef unsigned u32x4 __attribute__((ext_vector_type(4)));
#define ALAS __attribute__((address_space(3)))
#define ASBAR() __builtin_amdgcn_sched_barrier(0)
constexpr int SHM_V = 16384;
template <int DK> struct Lay { static constexpr int ROWB = DK * 2, SHM_K = 64 * ROWB, OFF_K = 2 * SHM_V, OFF_F = OFF_K + 2 * SHM_K, OFF_WS = OFF_F + 512, TOTAL = OFF_WS + 8 * 256; };

__device__ __forceinline__ int v_st(int k, int c) { const int kk = (k & ~0xC) | ((k & 4) << 1) | ((k & 8) >> 1); return ((kk >> 3) * 4 + (c >> 5)) * 512 + ((kk & 7) * 32 + (c & 31)) * 2; }
__device__ __forceinline__ int v_rd_base(int lane) { return ((lane & 3) << 3) | (((lane >> 2) & 3) << 6) | (((lane >> 4) & 1) << 5) | (((lane >> 5) & 1) << 8); }
__device__ __forceinline__ int crow(int r, int hi) { return (r & 3) + 8 * (r >> 2) + 4 * hi; }
typedef float cvtpk_f32x2 __attribute__((ext_vector_type(2))); typedef __bf16 cvtpk_bf16x2 __attribute__((ext_vector_type(2)));
__device__ __forceinline__ unsigned cvtpk(float lo, float hi) { const cvtpk_f32x2 v = {lo, hi}; const cvtpk_bf16x2 b = __builtin_convertvector(v, cvtpk_bf16x2); return __builtin_bit_cast(unsigned, b); }

__device__ __forceinline__ float wave_max_f(float v) {
#pragma unroll
    for (int o = 32; o >= 1; o >>= 1) v = fmaxf(v, __shfl_xor(v, o));
    return v;
}
__device__ __forceinline__ float att_max3(float a, float b, float c) { return __builtin_fmaxf(__builtin_fmaxf(a, b), c); }
typedef float f32x16v __attribute__((ext_vector_type(16)));
typedef unsigned u32x6v __attribute__((ext_vector_type(6)));
constexpr int ROW6 = 1536;
__device__ __forceinline__ void fp6_put(unsigned char* __restrict__ T6, int row, int hf, int l, int g, f32x16v f0, f32x16v f1, float sc) {
    f0 *= sc; f1 *= sc;
    f32x16v ev, od;
#pragma unroll
    for (int k = 0; k < 8; ++k) { ev[k] = f0[2 * k]; od[k] = f0[2 * k + 1]; ev[8 + k] = f1[2 * k]; od[8 + k] = f1[2 * k + 1]; }
    const u32x6v w = __builtin_amdgcn_cvt_scalef32_2xpk16_fp6_f32(ev, od, 1.0f);
    unsigned char* base = T6 + (size_t)row * ROW6 + hf * 768 + l * 16;
    if (g == 0) { *(u32x4*)base = (u32x4){w[0], w[1], w[2], w[3]}; *(uint2*)(base + 256) = make_uint2(w[4], w[5]); }
    else { *(uint2*)(base + 264) = make_uint2(w[0], w[1]); *(u32x4*)(base + 512) = (u32x4){w[2], w[3], w[4], w[5]}; }
}
constexpr int SIDE_STG = 86016;
template <int DK, bool FOX, bool NOMAX>
__device__ __forceinline__ void attn_block(unsigned char* smem, const bf16_t* __restrict__ Q, int ldq, const bf16_t* __restrict__ K, int ldk, const bf16_t* __restrict__ V, int ldv,
                                           const float* __restrict__ Fh, const bf16_t* __restrict__ gate, bf16_t* __restrict__ gout  , int qbk, const float* __restrict__ gq, const float* __restrict__ gk  ,
                                           const float* __restrict__ side_u, const float* __restrict__ side_v, unsigned char* __restrict__ side_u8, unsigned char* __restrict__ side_v8, int& side_next) {
    typedef Lay<DK> LY;
    constexpr int ND = DK / 16, NKC = DK / 8, NKI = (64 * NKC) / 512;
    int tid = threadIdx.x; asm volatile("" : "+v"(tid));
    const int wid = __builtin_amdgcn_readfirstlane(tid >> 6), lane = tid & 63, r32 = lane & 31, hi = lane >> 5;
    const int q0 = qbk * 256, qlo = q0 + wid * 32, qm = qlo + r32 - 4 * hi;
    const int NT = 4 * qbk + 4;
    ALAS unsigned char* lds = (ALAS unsigned char*)smem;
    ALAS float* F_lds = (ALAS float*)(lds + LY::OFF_F);
    ALAS float* wsl = (ALAS float*)(lds + LY::OFF_WS) + wid * 64;
    bf16x8 qr[ND];
#pragma unroll
    for (int d0 = 0; d0 < ND; ++d0) qr[d0] = *(const bf16x8*)(Q + (size_t)(qlo + r32) * ldq + d0 * 16 + hi * 8);
    const float fq = FOX ? Fh[qlo + r32] : 0.f;
    int kgo[NKI], vgo[2];
#pragma unroll
    for (int i = 0; i < NKI; ++i) { const int pp = (wid * NKI + i) * 64 + lane, row = pp / NKC, cpos = pp % NKC, ch = cpos ^ ((row >> 1) & 7); kgo[i] = row * ldk + ch * 8; }
#pragma unroll
    for (int i = 0; i < 2; ++i) { const int o = ((wid * 2 + i) * 64 + lane) * 16, st = o >> 9, e = (o & 511) >> 1, kk = (st >> 2) * 8 + (e >> 5), c = (st & 3) * 32 + (e & 31);
        const int k = (kk & ~0xC) | ((kk & 4) << 1) | ((kk & 8) >> 1); vgo[i] = k * ldv + c; }
    const int vb0 = (int)(uintptr_t)smem + v_rd_base(lane);
    int kbase[4];
#pragma unroll
    for (int dd = 0; dd < 4; ++dd) kbase[dd] = LY::OFF_K + r32 * LY::ROWB + (((((dd << 1) | hi) ^ ((r32 >> 1) & 7))) << 4);
    float stf = 0.f;
#define ATT_GLDS(kb, bf) do { _Pragma("unroll") for (int i = 0; i < NKI; ++i) \
            __builtin_amdgcn_global_load_lds((const unsigned*)(K + (size_t)(kb) * ldk + kgo[i]), (ALAS unsigned*)(lds + LY::OFF_K + (bf) * LY::SHM_K + (wid * NKI + i) * 1024), 16, 0, 0); \
        _Pragma("unroll") for (int i = 0; i < 2; ++i) \
            __builtin_amdgcn_global_load_lds((const unsigned*)(V + (size_t)(kb) * ldv + vgo[i]), (ALAS unsigned*)(lds + (bf) * SHM_V + (wid * 2 + i) * 1024), 16, 0, 0); \
        if (FOX && tid < 64) stf = Fh[(kb) + tid]; } while (0)
#define ATT_WRITEF(bf) do { if (FOX && tid < 64) F_lds[(bf) * 64 + tid] = stf; } while (0)
    int t_start = 0; float m_init = 0.f;
    if (FOX) {
        const float gqm = wave_max_f(fmaxf(fabsf(gq[lane]), fabsf(gq[lane + 64]))), gkm = wave_max_f(fmaxf(fabsf(gk[lane]), fabsf(gk[lane + 64])));
        const float qk_bound = 0.12751743f * 128.f * gqm * gkm;
        const float thr = 2.02f * qk_bound + 40.f, f0 = Fh[q0]; m_init = -thr;
        const int j0 = lane, j1 = lane + 64;
        const bool c0 = (j0 < 4 * qbk) && (Fh[j0 * 64 + 63] - f0 >= thr), c1 = (j1 < 4 * qbk) && (Fh[(j1 < 4 * qbk ? j1 : 0) * 64 + 63] - f0 >= thr);
        t_start = __builtin_popcountll(__ballot(c0)) + __builtin_popcountll(__ballot(c1));
        t_start = __builtin_amdgcn_readfirstlane(t_start); }
    ATT_GLDS(t_start * 64, t_start & 1); ATT_WRITEF(t_start & 1);
    float m_reg = FOX ? m_init : 0.f, l_reg = 0.f; f32x16 o[4];
#pragma unroll
    for (int d = 0; d < 4; ++d)
#pragma unroll
        for (int r = 0; r < 16; ++r) o[d][r] = 0.f;
    int side_pend = -1;
    for (int t = t_start; t < NT; ++t) {
        const int buf = t & 1, kb = t * 64;
        asm volatile("s_waitcnt vmcnt(0)" ::: "memory");
        __syncthreads();
        if (t + 1 < NT) ATT_GLDS(kb + 64, buf ^ 1);
        if (side_pend >= 0) { const int sv = side_pend; side_pend = -1;
            if ((wid >> 2) == (sv & 1)) {
                const int c = tid & 255, rr = c >> 6, hf2 = (c >> 5) & 1, l = (c >> 1) & 15, g = c & 1;
                const ALAS float* sp = (const ALAS float*)(lds + SIDE_STG) + rr * 2048 + hf2 * 1024 + (2 * g) * 256 + l * 16;
                f32x16v f0, f1;
#pragma unroll
                for (int k = 0; k < 4; ++k) { const f32x4 a = *(const ALAS f32x4*)(sp + 4 * k), b2 = *(const ALAS f32x4*)(sp + 256 + 4 * k);
#pragma unroll
                    for (int e = 0; e < 4; ++e) { f0[4 * k + e] = a[e]; f1[4 * k + e] = b2[e]; } }
                const bool isv = sv >= 16;
                fp6_put(isv ? side_v8 : side_u8, blockIdx.x * 64 + (sv & 15) * 4 + rr, hf2, l, g, f0, f1, isv ? 4.f : 64.f); }
        } else if (side_next < 32 && t + 1 < NT) { const int sv = side_next; const bool isv = sv >= 16;
            const float* src = (isv ? side_v : side_u) + (size_t)(blockIdx.x * 64 + (sv & 15) * 4) * 2048;
#pragma unroll
            for (int i = 0; i < 4; ++i)
                __builtin_amdgcn_global_load_lds((const unsigned*)(src + ((i * 8 + wid) * 64 + lane) * 4), (ALAS unsigned*)(lds + SIDE_STG + (i * 8 + wid) * 1024), 16, 0, 0);
            side_pend = sv; ++side_next; }
        f32x16 p0, p1;
        if (FOX) { const float fqm = NOMAX ? fq : fq - m_reg;
#pragma unroll
            for (int g = 0; g < 4; ++g) { const f32x4 f0 = *(const ALAS f32x4*)(F_lds + buf * 64 + 8 * g + 4 * hi), f1 = *(const ALAS f32x4*)(F_lds + buf * 64 + 32 + 8 * g + 4 * hi);
#pragma unroll
                for (int e = 0; e < 4; ++e) { p0[4 * g + e] = fqm - f0[e]; p1[4 * g + e] = fqm - f1[e]; } }
        } else if (NOMAX) {
#pragma unroll
            for (int r = 0; r < 16; ++r) { p0[r] = 0.f; p1[r] = 0.f; }
        } else { const float nm = -m_reg;
#pragma unroll
            for (int r = 0; r < 16; ++r) { p0[r] = nm; p1[r] = nm; }
        }
        {
            constexpr int KPF = 2;
            int ka[4];
#pragma unroll
            for (int dd = 0; dd < 4; ++dd) ka[dd] = (int)(uintptr_t)smem + buf * LY::SHM_K + kbase[dd];
            bf16x8 kb0[KPF + 1], kb1[KPF + 1];
#define ATT_KRD(dst, addr, off) asm volatile("ds_read_b128 %0, %1 offset:%2" : "=&v"(dst) : "v"(addr), "i"(off) : "memory")
#pragma unroll
            for (int d0 = 0; d0 < KPF; ++d0) { ATT_KRD(kb0[d0 % (KPF + 1)], ka[d0 & 3], (d0 >> 2) * 128); ATT_KRD(kb1[d0 % (KPF + 1)], ka[d0 & 3], (d0 >> 2) * 128 + 32 * LY::ROWB); }
#pragma unroll
            for (int d0 = 0; d0 < ND; ++d0) {
                if (d0 + KPF < ND) { constexpr int dummy = 0; (void)dummy;
                    ATT_KRD(kb0[(d0 + KPF) % (KPF + 1)], ka[(d0 + KPF) & 3], ((d0 + KPF) >> 2) * 128); ATT_KRD(kb1[(d0 + KPF) % (KPF + 1)], ka[(d0 + KPF) & 3], ((d0 + KPF) >> 2) * 128 + 32 * LY::ROWB); }
                const int rem = (ND - 1 - d0) < KPF ? (ND - 1 - d0) : KPF;
                if (rem >= 2) asm volatile("s_waitcnt lgkmcnt(4)" ::: "memory");
                else if (rem == 1) asm volatile("s_waitcnt lgkmcnt(2)" ::: "memory");
                else asm volatile("s_waitcnt lgkmcnt(0)" ::: "memory");
                ASBAR();
                p0 = __builtin_amdgcn_mfma_f32_32x32x16_bf16(kb0[d0 % (KPF + 1)], qr[d0], p0, 0, 0, 0);
                p1 = __builtin_amdgcn_mfma_f32_32x32x16_bf16(kb1[d0 % (KPF + 1)], qr[d0], p1, 0, 0, 0);
            }
#undef ATT_KRD
        }
        if (kb + 63 > qlo) {
            const float NEG = -__builtin_inff(); const int dq = qm - kb;
#pragma unroll
            for (int r = 0; r < 16; ++r) { const int c = (r & 3) + 8 * (r >> 2); if (dq - c < 0) p0[r] = NEG; if (dq - c - 32 < 0) p1[r] = NEG; }
        }
        float alpha = 1.f;
        if (!NOMAX) {
        float pmax;
        { float a = att_max3(p0[0], p0[1], p1[0]), b = att_max3(p0[2], p0[3], p1[1]); a = att_max3(a, p1[2], p1[3]);
#pragma unroll
          for (int r = 4; r < 16; r += 4) { a = att_max3(a, p0[r], p0[r + 1]); b = att_max3(b, p0[r + 2], p0[r + 3]); a = att_max3(a, p1[r], p1[r + 1]); b = att_max3(b, p1[r + 2], p1[r + 3]); }
          pmax = fmaxf(a, b); }
        { auto rr = __builtin_amdgcn_permlane32_swap(__float_as_uint(pmax), __float_as_uint(pmax), false, false);
          pmax = fmaxf(__uint_as_float(rr[0]), __uint_as_float(rr[1])); }
        if (!__builtin_expect(__all(pmax <= 8.f), 1)) { const float dm = fmaxf(pmax, 0.f); alpha = __builtin_amdgcn_exp2f(-dm); m_reg += dm;
#pragma unroll
            for (int r = 0; r < 16; ++r) { p0[r] -= dm; p1[r] -= dm; } }
        }
        float ps = 0.f;
#pragma unroll
        for (int r = 0; r < 16; ++r) { p0[r] = __builtin_amdgcn_exp2f(p0[r]); ps += p0[r]; }
#pragma unroll
        for (int r = 0; r < 16; ++r) { p1[r] = __builtin_amdgcn_exp2f(p1[r]); ps += p1[r]; }
        { auto rr = __builtin_amdgcn_permlane32_swap(__float_as_uint(ps), __float_as_uint(ps), false, false);
          ps = __uint_as_float(rr[0]) + __uint_as_float(rr[1]); }
        l_reg = NOMAX ? l_reg + ps : l_reg * alpha + ps;
        bf16x8 pa0, pa1, pa2, pa3;
#define ATT_PK4(P, B_, OUT) do { unsigned a0 = cvtpk(P[B_+0], P[B_+1]), a1 = cvtpk(P[B_+2], P[B_+3]); unsigned b0_ = cvtpk(P[B_+4], P[B_+5]), b1_ = cvtpk(P[B_+6], P[B_+7]); \
        auto r0 = __builtin_amdgcn_permlane32_swap(a0, b0_, false, false); auto r1 = __builtin_amdgcn_permlane32_swap(a1, b1_, false, false); \
        u32x4 w = {r0[0], r1[0], r0[1], r1[1]}; OUT = *reinterpret_cast<bf16x8*>(&w); } while (0)
        ATT_PK4(p0, 0, pa0); ATT_PK4(p0, 8, pa1); ATT_PK4(p1, 0, pa2); ATT_PK4(p1, 8, pa3);
        if (!NOMAX && __any(alpha < 1.f)) {
            if (hi == 0) wsl[r32] = alpha;
            asm volatile("s_waitcnt lgkmcnt(0)" ::: "memory");
#pragma unroll
            for (int g = 0; g < 4; ++g) { const f32x4 al = *(const ALAS f32x4*)(wsl + 8 * g + 4 * hi);
#pragma unroll
                for (int d = 0; d < 4; ++d)
#pragma unroll
                    for (int e = 0; e < 4; ++e) o[d][4 * g + e] *= al[e]; }
        }
#define ATT_TRRD(dst, off) asm volatile("ds_read_b64_tr_b16 %0, %1 offset:%2" : "=&v"(dst) : "v"(vbb), "i"(off) : "memory")
#define ATT_PV(d0) do { s16x4 l0, l1, l2, l3, h0, h1, h2, h3; constexpr int b_ = (d0) * 512; \
        ATT_TRRD(l0, b_); ATT_TRRD(h0, b_ + 2048); ATT_TRRD(l1, b_ + 4096); ATT_TRRD(h1, b_ + 6144); ATT_TRRD(l2, b_ + 8192); ATT_TRRD(h2, b_ + 10240); ATT_TRRD(l3, b_ + 12288); ATT_TRRD(h3, b_ + 14336); \
        asm volatile("s_waitcnt lgkmcnt(0)" ::: "memory"); ASBAR(); \
        o[d0] = __builtin_amdgcn_mfma_f32_32x32x16_bf16(pa0, (bf16x8){l0[0], l0[1], l0[2], l0[3], h0[0], h0[1], h0[2], h0[3]}, o[d0], 0, 0, 0); \
        o[d0] = __builtin_amdgcn_mfma_f32_32x32x16_bf16(pa1, (bf16x8){l1[0], l1[1], l1[2], l1[3], h1[0], h1[1], h1[2], h1[3]}, o[d0], 0, 0, 0); \
        o[d0] = __builtin_amdgcn_mfma_f32_32x32x16_bf16(pa2, (bf16x8){l2[0], l2[1], l2[2], l2[3], h2[0], h2[1], h2[2], h2[3]}, o[d0], 0, 0, 0); \
        o[d0] = __builtin_amdgcn_mfma_f32_32x32x16_bf16(pa3, (bf16x8){l3[0], l3[1], l3[2], l3[3], h3[0], h3[1], h3[2], h3[3]}, o[d0], 0, 0, 0); } while (0)
        { const int vbb = vb0 + buf * SHM_V; ATT_PV(0); ATT_PV(1); ATT_PV(2); ATT_PV(3); }
        if (t + 1 < NT) ATT_WRITEF(buf ^ 1);
    }
    if (hi == 0) wsl[r32] = l_reg;
    asm volatile("s_waitcnt lgkmcnt(0)" ::: "memory");
#pragma unroll
    for (int rh = 0; rh < 16; rh += 8) {
        unsigned gv[8][4];
#pragma unroll
        for (int r = 0; r < 8; ++r) { const bf16_t* growp = gate + (size_t)(qlo + crow(rh + r, hi)) * 4096 + (r32 & ~1);
#pragma unroll
            for (int d0 = 0; d0 < 4; ++d0) gv[r][d0] = *(const unsigned*)(growp + d0 * 32); }
#pragma unroll
        for (int r = 0; r < 8; ++r) { const int orow = crow(rh + r, hi); const float rli = __builtin_amdgcn_rcpf(wsl[orow]);
            bf16_t* rowp = gout + (size_t)(qlo + orow) * 4096;
#pragma unroll
            for (int d0 = 0; d0 < 4; ++d0) {
                const float v = o[d0][rh + r] * rli; const float vn = __shfl_xor(v, 1); const unsigned g = gv[r][d0];
                const bool ev = (r32 & 1) == 0; const float ve = ev ? v : vn, vo = ev ? vn : v;
                *(unsigned*)(rowp + d0 * 32 + (r32 & ~1)) = cvtpk(ve * __uint_as_float(g << 16), vo * __uint_as_float(g & 0xffff0000u)); }
        }
    }
    __syncthreads();
#undef ATT_GLDS
#undef ATT_WRITEF
#undef ATT_PK4
#undef ATT_TRRD
#undef ATT_PV
}
}
using pg8::bf16_t; using pg8::f32x4; using pg8::u32x4;
#define LAS __attribute__((address_space(3)))
constexpr int S = 8192, DM = 2048, INW = 11344, INWP = 11520;
constexpr float EPS = 1e-6f;
constexpr size_t MiB = 1u << 20;

__device__ __forceinline__ float bf2f(bf16_t v) { return __uint_as_float(((unsigned)v) << 16); }
__device__ __forceinline__ bf16_t f2bf(float f) { unsigned u = __float_as_uint(f); u += 0x7fffu + ((u >> 16) & 1u); return (bf16_t)(u >> 16); }
__device__ __forceinline__ unsigned pk2(float lo, float hi) { return (unsigned)f2bf(lo) | ((unsigned)f2bf(hi) << 16); }
__device__ __forceinline__ float wave_sum(float v) {
#pragma unroll
    for (int o = 32; o >= 1; o >>= 1) v += __shfl_xor(v, o);
    return v;
}
__device__ __forceinline__ float wave_max(float v) {
#pragma unroll
    for (int o = 32; o >= 1; o >>= 1) v = fmaxf(v, __shfl_xor(v, o));
    return v;
}

__device__ __forceinline__ int opaque_tid() { int t = threadIdx.x; asm volatile("" : "+v"(t)); return t; }

struct Params {
    const float* x; const int* pos; const float *mix_g, *w_in, *b_forget, *b_gate, *q_lat_g, *w_q_up, *kv_lat_g, *w_kv_up, *mla_qg, *mla_kg, *fox_qg, *fox_kg, *w_out, *ffn_g, *w_peer_q, *sub_keys, *peer_u, *peer_v;
    float* out;
    bf16_t *WqT, *WkvT, *WoT, *WpT, *WinT;
    bf16_t *h, *cq, *ckv, *fq, *fk, *fv, *merged, *kpe, *qa, *va, *ka;
    float *lf, *F, *x1, *scores;
    unsigned char *U8, *V8; bf16_t* attout;
    unsigned* ctl;
    float2* ropeT; float* ssq; float* ssq2; bf16_t* xg;
};

struct DstId { __device__ __forceinline__ int operator()(int n) const { return n; } };
struct DstWin { __device__ __forceinline__ int operator()(int n) const {
    if (n < 1024) return n; if (n < 1088) { const int r = n - 1024; return 11264 + 2 * (r & 31) + (r >> 5); } if (n < 7232) return n - 64; if (n < 7248) return 11264 + 64 + (n - 7232); return n - 80; } };
struct DstQ { __device__ __forceinline__ int operator()(int n) const {
    const int h = n / 192, d = n - h * 192; if (d < 128) return h * 256 + d; const int r = d - 128; return h * 256 + 128 + 2 * (r & 31) + (r >> 5); } };
template <class Dst>
__device__ __forceinline__ void transpose_item(const float* __restrict__ W, int K, int N, bf16_t* __restrict__ WT, Dst dst, float* scr, int item, int lane, const float* __restrict__ gk = nullptr) {
    const int nblk = (N + 31) / 32, kb = item / nblk, nb = item % nblk, k0 = 64 * kb, n0 = 32 * nb;
    { const int rr = lane >> 3, c4 = (lane & 7) * 4; const bool ok = (n0 + c4) < N;
      f32x4 v[8];
#pragma unroll
      for (int i = 0; i < 8; ++i) v[i] = ok ? *(const f32x4*)(W + (size_t)(k0 + 8 * i + rr) * N + n0 + c4) : (f32x4){0.f, 0.f, 0.f, 0.f};
      if (gk) {
#pragma unroll
          for (int i = 0; i < 8; ++i) v[i] *= gk[k0 + 8 * i + rr]; }
#pragma unroll
      for (int i = 0; i < 8; ++i) { float* sp = scr + (8 * i + rr) * 33 + c4; sp[0] = v[i][0]; sp[1] = v[i][1]; sp[2] = v[i][2]; sp[3] = v[i][3]; } }
    asm volatile("s_waitcnt lgkmcnt(0)" ::: "memory");
    const int c = lane & 7;
#pragma unroll
    for (int j = 0; j < 4; ++j) { const int nl = (lane >> 3) + 8 * j, n = n0 + nl; const float* s = scr + (8 * c) * 33 + nl;
        u32x4 o; o.x = pk2(s[0 * 33], s[1 * 33]); o.y = pk2(s[2 * 33], s[3 * 33]); o.z = pk2(s[4 * 33], s[5 * 33]); o.w = pk2(s[6 * 33], s[7 * 33]);
        if (n < N) *(u32x4*)(WT + (size_t)dst(n) * K + k0 + 8 * c) = o; }
    asm volatile("s_waitcnt lgkmcnt(0)" ::: "memory");
}
typedef __bf16 wf_bf16x8 __attribute__((ext_vector_type(8)));
typedef float wf_f32x8 __attribute__((ext_vector_type(8)));
__device__ __forceinline__ void wf_split(const f32x4 x0, const f32x4 x1, wf_bf16x8& hi, wf_bf16x8& lo) {
    const wf_f32x8 x = {x0[0], x0[1], x0[2], x0[3], x1[0], x1[1], x1[2], x1[3]};
    hi = __builtin_convertvector(x, wf_bf16x8);
    const wf_f32x8 r = x - __builtin_convertvector(hi, wf_f32x8);
    lo = __builtin_convertvector(r, wf_bf16x8);
}
__device__ __forceinline__ void wfold_item(const float* __restrict__ wq, const float* __restrict__ keys, bf16_t* __restrict__ WpT, float* sm, int item) {
    (void)sm;
    const int tid = opaque_tid(), lane = tid & 63, wave = tid >> 6, hc = item >> 5, d0 = (item & 31) * 64, m = lane & 15, kg = lane >> 4;
    f32x4 acc[4];
#pragma unroll
    for (int c = 0; c < 4; ++c) acc[c] = (f32x4){0.f, 0.f, 0.f, 0.f};
#pragma unroll
    for (int s4 = 0; s4 < 4; ++s4) {
        const float* kp = keys + (size_t)hc * 16384 + (16 * wave + m) * 128 + 32 * s4 + 8 * kg;
        wf_bf16x8 bh, bl; wf_split(*(const f32x4*)kp, *(const f32x4*)(kp + 4), bh, bl);
#pragma unroll
        for (int c = 0; c < 4; ++c) { const float* ap = wq + (size_t)(d0 + 16 * c + m) * 2048 + hc * 128 + 32 * s4 + 8 * kg;
            wf_bf16x8 ah, al; wf_split(*(const f32x4*)ap, *(const f32x4*)(ap + 4), ah, al);
            acc[c] = __builtin_amdgcn_mfma_f32_16x16x32_bf16(ah, bh, acc[c], 0, 0, 0);
            acc[c] = __builtin_amdgcn_mfma_f32_16x16x32_bf16(ah, bl, acc[c], 0, 0, 0);
            acc[c] = __builtin_amdgcn_mfma_f32_16x16x32_bf16(al, bh, acc[c], 0, 0, 0); }
    }
#pragma unroll
    for (int c = 0; c < 4; ++c) { uint2 o; o.x = pk2(acc[c][0], acc[c][1]); o.y = pk2(acc[c][2], acc[c][3]);
        *(uint2*)(WpT + (size_t)(hc * 128 + 16 * wave + m) * 2048 + d0 + 16 * c + 4 * kg) = o; }
}
__device__ __forceinline__ void rms_row2048(const float* __restrict__ xr, const float* __restrict__ g, bf16_t* __restrict__ orow, int lane) {
    f32x4 v[8]; float ss = 0.f;
#pragma unroll
    for (int j = 0; j < 8; ++j) { v[j] = *(const f32x4*)(xr + j * 256 + lane * 4); ss += (v[j][0] * v[j][0] + v[j][1] * v[j][1]) + (v[j][2] * v[j][2] + v[j][3] * v[j][3]); }
    const float r = rsqrtf(wave_sum(ss) * (1.f / 2048.f) + EPS);
#pragma unroll
    for (int j = 0; j < 8; ++j) { const f32x4 gg = *(const f32x4*)(g + j * 256 + lane * 4);
        uint2 o; o.x = pk2(v[j][0] * r * gg[0], v[j][1] * r * gg[1]); o.y = pk2(v[j][2] * r * gg[2], v[j][3] * r * gg[3]);
        *(uint2*)(orow + j * 256 + lane * 4) = o; }
}
__device__ __forceinline__ void fox_cumsum(double* part, int h, const float* __restrict__ lf, float* __restrict__ F) {
    const int tid = opaque_tid(), lane = tid & 63, wave = tid >> 6;
    float v[16]; double sum = 0.0;
#pragma unroll
    for (int i = 0; i < 16; ++i) { v[i] = lf[(size_t)(tid * 16 + i) * 16 + h]; sum += (double)v[i]; }
    double inc = sum;
#pragma unroll
    for (int o = 1; o < 64; o <<= 1) { const double n = __shfl_up(inc, o); if (lane >= o) inc += n; }
    if (lane == 63) part[wave] = inc;
    __syncthreads();
    double base = 0.0;
    for (int w = 0; w < wave; ++w) base += part[w];
    double run = base + inc - sum;
#pragma unroll
    for (int i = 0; i < 16; ++i) { run += (double)v[i]; F[(size_t)h * S + tid * 16 + i] = (float)(run * 1.4426950408889634); }
    __syncthreads();
}
__device__ __forceinline__ void rope_table(const int* __restrict__ pos, float2* __restrict__ ropeT, int gtid, int nthreads) {
    for (int idx = gtid; idx < S * 32; idx += nthreads) { const int t = idx >> 5, i = idx & 31;
        const double inv = exp(-(double)i * (1.0 / 32.0) * 9.210340371976184);
        double ang = (double)((float)pos[t] * (float)inv);
        const double twopi = 6.283185307179586;
        ang -= twopi * rint(ang / twopi);
        ropeT[idx] = make_float2(cosf((float)ang), sinf((float)ang)); }
}
typedef float f32x2 __attribute__((ext_vector_type(2)));
__device__ __forceinline__ unsigned pk4_fp8(float a, float b, float c, float d) {
    int w = __builtin_amdgcn_cvt_pk_fp8_f32(fminf(fmaxf(a, -448.f), 448.f), fminf(fmaxf(b, -448.f), 448.f), 0, false);
    w = __builtin_amdgcn_cvt_pk_fp8_f32(fminf(fmaxf(c, -448.f), 448.f), fminf(fmaxf(d, -448.f), 448.f), w, true); return (unsigned)w; }
__device__ __forceinline__ void cvt_rows_fp8(const float* __restrict__ src, unsigned char* __restrict__ dst, size_t n, float scale, int gw, int NGW, int lane) {
    const size_t nchunk = n / 1024;
    for (size_t c = gw; c < nchunk; c += NGW) { const size_t o = c * 1024 + lane * 16;
        f32x4 a[4];
#pragma unroll
        for (int q = 0; q < 4; ++q) a[q] = *(const f32x4*)(src + o + 4 * q) * scale;
        u32x4 w; w.x = pk4_fp8(a[0][0], a[0][1], a[0][2], a[0][3]); w.y = pk4_fp8(a[1][0], a[1][1], a[1][2], a[1][3]);
        w.z = pk4_fp8(a[2][0], a[2][1], a[2][2], a[2][3]); w.w = pk4_fp8(a[3][0], a[3][1], a[3][2], a[3][3]);
        *(u32x4*)(dst + o) = w; }
}
constexpr float U_SCALE = 64.f, V_SCALE = 4.f;
typedef __bf16 bf16x2_t __attribute__((ext_vector_type(2)));
__device__ __forceinline__ float dot2bf(unsigned a, unsigned b, float c) { return __builtin_amdgcn_fdot2_f32_bf16(__builtin_bit_cast(bf16x2_t, a), __builtin_bit_cast(bf16x2_t, b), c, false); }
#define PEER_INS(top, x) do { float x_ = (x); _Pragma("unroll") for (int i_ = 0; i_ < 16; ++i_) { const float hi_ = fmaxf(top[i_], x_); x_ = fminf(top[i_], x_); top[i_] = hi_; } } while (0)
__device__ __forceinline__ void fp6_cvt_rows(const float* __restrict__ src, unsigned char* __restrict__ T6, int row0, int nrows, float sc, int t, int nt) {
    for (int u = t; u < nrows * 64; u += nt) { const int rr = u >> 6, hf = (u >> 5) & 1, l = (u >> 1) & 15, g = u & 1;
        const float* s0 = src + (size_t)(row0 + rr) * 2048 + hf * 1024 + (2 * g) * 256 + l * 16;
        att::f32x16v f0, f1;
#pragma unroll
        for (int k = 0; k < 4; ++k) { const f32x4 a = *(const f32x4*)(s0 + 4 * k), b2 = *(const f32x4*)(s0 + 256 + 4 * k);
#pragma unroll
            for (int e = 0; e < 4; ++e) { f0[4 * k + e] = a[e]; f1[4 * k + e] = b2[e]; } }
        att::fp6_put(T6, row0 + rr, hf, l, g, f0, f1, sc); }
}
typedef float f32x32v __attribute__((ext_vector_type(32)));
__device__ __forceinline__ void peer_group(unsigned char* smem, int g, const float* __restrict__ scores, const bf16_t* __restrict__ h2  , const float* __restrict__ ssq2, const float* __restrict__ x1,
                                           const unsigned char* __restrict__ U8, const unsigned char* __restrict__ V8, float* __restrict__ out) {
    const int tid = opaque_tid(), lane = tid & 63, wave = __builtin_amdgcn_readfirstlane(tid >> 6);
    float* topL = (float*)smem;
    int* selE = (int*)(smem + 32768);
    float* selG = (float*)(smem + 49152);
    {
        const int tl = tid >> 4, hc = tid & 15;
        const float* sp = scores + (size_t)(g * 32 + tl) * 2048 + hc * 128;
#define PEER_CE(a, b) do { const float hi_ = fmaxf(a, b), lo_ = fminf(a, b); a = hi_; b = lo_; } while (0)
        float top[16];
#pragma unroll 1
        for (int gi = 0; gi < 8; ++gi) {
            float gr[16];
#pragma unroll
            for (int q = 0; q < 4; ++q) { const f32x4 v = *(const f32x4*)(sp + gi * 16 + q * 4);
#pragma unroll
                for (int e = 0; e < 4; ++e) gr[q * 4 + e] = __uint_as_float((__float_as_uint(v[e]) & ~0x7Fu) | (unsigned)(gi * 16 + q * 4 + e)); }
#pragma unroll
            for (int k = 2; k <= 16; k <<= 1)
#pragma unroll
                for (int j = k >> 1; j > 0; j >>= 1)
#pragma unroll
                    for (int i = 0; i < 16; ++i) { const int l = i ^ j; if (l > i) { if ((i & k) == 0) PEER_CE(gr[i], gr[l]); else PEER_CE(gr[l], gr[i]); } }
            if (gi == 0) {
#pragma unroll
                for (int i = 0; i < 16; ++i) top[i] = gr[i];
            } else {
#pragma unroll
                for (int i = 0; i < 16; ++i) top[i] = fmaxf(top[i], gr[15 - i]);
#pragma unroll
                for (int j = 8; j > 0; j >>= 1)
#pragma unroll
                    for (int i = 0; i < 16; ++i) { const int l = i ^ j; if (l > i) PEER_CE(top[i], top[l]); }
            }
        }
#undef PEER_CE
        float* tp = topL + (tl * 16 + hc) * 16;
#pragma unroll
        for (int i = 0; i < 16; i += 4) *(f32x4*)(tp + i) = (f32x4){top[i], top[i + 1], top[i + 2], top[i + 3]};
    }
    __syncthreads();
    if (tid < 256) {
        const int tl = tid >> 3, h = tid & 7;
        const float* t1 = topL + (tl * 16 + 2 * h) * 16; const float* t2 = t1 + 16;
        float s1[16], s2[16];
#pragma unroll
        for (int i = 0; i < 16; i += 4) { const f32x4 a = *(const f32x4*)(t1 + i), b2 = *(const f32x4*)(t2 + i);
            s1[i] = a[0]; s1[i + 1] = a[1]; s1[i + 2] = a[2]; s1[i + 3] = a[3]; s2[i] = b2[0]; s2[i + 1] = b2[1]; s2[i + 2] = b2[2]; s2[i + 3] = b2[3]; }
#define PEER_CE(a, b) do { const float hi_ = fmaxf(a, b), lo_ = fminf(a, b); a = hi_; b = lo_; } while (0)
#define PEER_KEY(i, j) __uint_as_float((__float_as_uint(s1[i] + s2[j]) & ~0xFFu) | (unsigned)((i) * 16 + (j)))
        float ts[16], cand[34];
#pragma unroll
        for (int j = 0; j < 16; ++j) ts[j] = PEER_KEY(0, j);
        { int n = 0;
#pragma unroll
          for (int i = 1; i < 16; ++i)
#pragma unroll
              for (int j = 0; j < 8; ++j)
                  if ((i + 1) * (j + 1) <= 16) cand[n++] = PEER_KEY(i, j); }
#pragma unroll
        for (int gi = 0; gi < 2; ++gi) { float gr[16];
#pragma unroll
            for (int i = 0; i < 16; ++i) gr[i] = cand[gi * 16 + i];
#pragma unroll
            for (int k = 2; k <= 16; k <<= 1)
#pragma unroll
                for (int j = k >> 1; j > 0; j >>= 1)
#pragma unroll
                    for (int i = 0; i < 16; ++i) { const int l = i ^ j; if (l > i) { if ((i & k) == 0) PEER_CE(gr[i], gr[l]); else PEER_CE(gr[l], gr[i]); } }
#pragma unroll
            for (int i = 0; i < 16; ++i) ts[i] = fmaxf(ts[i], gr[15 - i]);
#pragma unroll
            for (int j = 8; j > 0; j >>= 1)
#pragma unroll
                for (int i = 0; i < 16; ++i) { const int l = i ^ j; if (l > i) PEER_CE(ts[i], ts[l]); } }
        PEER_INS(ts, cand[32]); PEER_INS(ts, cand[33]);
#undef PEER_CE
#undef PEER_KEY
        float ex[16], sum = 0.f;
#pragma unroll
        for (int k = 0; k < 16; ++k) { ex[k] = __expf(ts[k] - ts[0]); sum += ex[k]; }
        const float inv = 1.f / sum;
#pragma unroll
        for (int k = 0; k < 16; ++k) { const unsigned pos = __float_as_uint(ts[k]) & 0xFFu;
            const int i1 = (int)(__float_as_uint(t1[pos >> 4]) & 0x7Fu), i2 = (int)(__float_as_uint(t2[pos & 15]) & 0x7Fu);
            selE[tl * 128 + h * 16 + k] = i1 * 128 + i2; selG[tl * 128 + h * 16 + k] = ex[k] * inv; }
    }
    __syncthreads();
    const int grp = lane >> 4, l16 = lane & 15, tl = wave * 4 + grp;
    unsigned* sortK = (unsigned*)(smem + 65536) + tl * 128;
    float* wS = (float*)(smem + 81920) + tl * 128;
    unsigned* hist = (unsigned*)(smem + 98304) + wave * 512 + grp * 64;
    {
#pragma unroll
        for (int i = 0; i < 4; ++i) hist[l16 * 4 + i] = 0u;
        asm volatile("s_waitcnt lgkmcnt(0)" ::: "memory");
        unsigned ek[8], rk[8];
#pragma unroll
        for (int j = 0; j < 8; ++j) { ek[j] = (unsigned)selE[tl * 128 + l16 + 16 * j]; rk[j] = atomicAdd(&hist[ek[j] >> 8], 1u); }
        asm volatile("s_waitcnt lgkmcnt(0)" ::: "memory");
        unsigned c[4], tot = 0u;
#pragma unroll
        for (int i = 0; i < 4; ++i) { c[i] = hist[l16 * 4 + i]; tot += c[i]; }
        unsigned inc = tot;
#pragma unroll
        for (int o = 1; o < 16; o <<= 1) { const unsigned n = __shfl_up(inc, o, 16); if (l16 >= o) inc += n; }
        unsigned run = inc - tot;
#pragma unroll
        for (int i = 0; i < 4; ++i) { hist[256 + l16 * 4 + i] = run; run += c[i]; }
        asm volatile("s_waitcnt lgkmcnt(0)" ::: "memory");
#pragma unroll
        for (int j = 0; j < 8; ++j) sortK[hist[256 + (ek[j] >> 8)] + rk[j]] = (ek[j] << 7) | (unsigned)(l16 + 16 * j);
    }
    __syncthreads();
    const size_t tok = (size_t)g * 32 + tl;
    float rinv_tok;
    { float t = 0.f; if (l16 < 8) { const f32x4 a = *(const f32x4*)(ssq2 + ((size_t)l16 * 8192 + tok) * 4); t = (a[0] + a[1]) + (a[2] + a[3]); }
      t += __shfl_xor(t, 8); t += __shfl_xor(t, 4); t += __shfl_xor(t, 2); t += __shfl_xor(t, 1); rinv_tok = rsqrtf(t * (1.f / 2048.f) + 1e-6f); }
    {
        const int m16 = lane & 15, kg = lane >> 4, pt = m16 >> 2, sub = m16 & 3, l6 = kg * 4 + sub;
        const unsigned* sKa = (const unsigned*)(smem + 65536) + (wave * 4 + pt) * 128;
        const bool diag = pt == kg;
        const size_t tokb = (size_t)g * 32 + wave * 4 + pt;
        typedef int i32x8v __attribute__((ext_vector_type(8)));
        const float xsc = 1.4f * __shfl(rinv_tok, pt * 16);
#pragma unroll 1
        for (int hf = 0; hf < 2; ++hf) {
            i32x8v xb[2];
#pragma unroll
            for (int gq = 0; gq < 2; ++gq) { att::f32x16v ev, od;
#pragma unroll
                for (int h = 0; h < 2; ++h) { const bf16_t* xp = h2 + tokb * DM + hf * 1024 + (2 * gq + h) * 256 + l6 * 16;
                    const u32x4 w0 = *(const u32x4*)xp, w1 = *(const u32x4*)(xp + 8);
#pragma unroll
                    for (int q = 0; q < 4; ++q) { ev[8 * h + q] = __uint_as_float(w0[q] << 16) * xsc; od[8 * h + q] = __uint_as_float(w0[q] & 0xffff0000u) * xsc;
                        ev[8 * h + 4 + q] = __uint_as_float(w1[q] << 16) * xsc; od[8 * h + 4 + q] = __uint_as_float(w1[q] & 0xffff0000u) * xsc; } }
                const att::u32x6v w6 = __builtin_amdgcn_cvt_scalef32_2xpk16_fp6_f32(ev, od, 1.0f);
                xb[gq] = (i32x8v){(int)w6[0], (int)w6[1], (int)w6[2], (int)w6[3], (int)w6[4], (int)w6[5], 0, 0}; }
            u32x4 urA[4][3], urB[4][3];
#define PEER_LDA(ur, it0) do { _Pragma("unroll") for (int j = 0; j < 4; ++j) { const unsigned ro = (sKa[(it0) + j] >> 7) * (unsigned)att::ROW6 + (unsigned)(hf * 768 + l6 * 16); \
                    _Pragma("unroll") for (int c = 0; c < 3; ++c) ur[j][c] = *(const u32x4*)(U8 + ro + c * 256); } } while (0)
#define PEER_CMA(ur, it0) do { float dsel = 0.f; \
                _Pragma("unroll") for (int j = 0; j < 4; ++j) { f32x4 acc = (f32x4){0.f, 0.f, 0.f, 0.f}; \
                    acc = __builtin_amdgcn_mfma_scale_f32_16x16x128_f8f6f4((i32x8v){(int)ur[j][0][0], (int)ur[j][0][1], (int)ur[j][0][2], (int)ur[j][0][3], (int)ur[j][1][0], (int)ur[j][1][1], 0, 0}, xb[0], acc, 2, 2, 0, 0x7F7F7F7F, 0, 0x7F7F7F7F); \
                    acc = __builtin_amdgcn_mfma_scale_f32_16x16x128_f8f6f4((i32x8v){(int)ur[j][1][2], (int)ur[j][1][3], (int)ur[j][2][0], (int)ur[j][2][1], (int)ur[j][2][2], (int)ur[j][2][3], 0, 0}, xb[1], acc, 2, 2, 0, 0x7F7F7F7F, 0, 0x7F7F7F7F); \
                    float d = sub == 0 ? acc[0] : sub == 1 ? acc[1] : sub == 2 ? acc[2] : acc[3]; \
                    d += __builtin_bit_cast(float, __builtin_amdgcn_update_dpp(0, __builtin_bit_cast(int, d), 0xB1, 0xF, 0xF, true)); \
                    d += __builtin_bit_cast(float, __builtin_amdgcn_update_dpp(0, __builtin_bit_cast(int, d), 0x4E, 0xF, 0xF, true)); \
                    if (sub == j) dsel = d; } \
                if (diag) { float* wSt = (float*)(smem + 81920) + (wave * 4 + pt) * 128; \
                    if (hf == 0) wSt[(it0) + sub] = dsel; \
                    else { const float a = (wSt[(it0) + sub] + dsel) * (1.f / (1.4f * U_SCALE)); \
                        wSt[(it0) + sub] = selG[(wave * 4 + pt) * 128 + (sKa[(it0) + sub] & 127u)] * 0.5f * a * (1.f + erff(a * 0.70710678118654752f)) * (1.f / V_SCALE); } } } while (0)
            PEER_LDA(urA, 0);
#pragma unroll 1
            for (int it = 0; it < 128; it += 8) {
                if (it) __builtin_amdgcn_s_barrier();
                PEER_LDA(urB, it + 4);
                PEER_CMA(urA, it);
                if (it + 8 < 128) PEER_LDA(urA, it + 8);
                PEER_CMA(urB, it + 4);
            }
#undef PEER_LDA
#undef PEER_CMA
            __syncthreads();
        }
    }
#pragma unroll 1
    for (int hf = 0; hf < 2; ++hf) {
        typedef _Float16 h16x2v __attribute__((ext_vector_type(2)));
        typedef _Float16 h16x32v __attribute__((ext_vector_type(32)));
        h16x2v acc[32];
#pragma unroll
        for (int c = 0; c < 32; ++c) acc[c] = (h16x2v){(_Float16)0.f, (_Float16)0.f};
        for (int it = 0; it < 128; it += 4) {
            if ((it & 7) == 0 && it) __syncthreads();
            unsigned key[4]; u32x4 vr[4][3];
#pragma unroll
            for (int p = 0; p < 4; ++p) { key[p] = sortK[it + p];
#pragma unroll
                for (int j = 0; j < 3; ++j) vr[p][j] = *(const u32x4*)(V8 + (size_t)(key[p] >> 7) * att::ROW6 + hf * 768 + j * 256 + l16 * 16); }
#pragma unroll
            for (int p = 0; p < 4; ++p) { const _Float16 wh = (_Float16)wS[it + p]; const h16x2v w2 = (h16x2v){wh, wh};
                const h16x32v c0 = __builtin_amdgcn_cvt_scalef32_pk32_f16_fp6((att::u32x6v){vr[p][0][0], vr[p][0][1], vr[p][0][2], vr[p][0][3], vr[p][1][0], vr[p][1][1]}, 1.0f);
#pragma unroll
                for (int k = 0; k < 16; ++k) acc[k] = __builtin_elementwise_fma(w2, (h16x2v){c0[2 * k], c0[2 * k + 1]}, acc[k]);
                const h16x32v c1 = __builtin_amdgcn_cvt_scalef32_pk32_f16_fp6((att::u32x6v){vr[p][1][2], vr[p][1][3], vr[p][2][0], vr[p][2][1], vr[p][2][2], vr[p][2][3]}, 1.0f);
#pragma unroll
                for (int k = 0; k < 16; ++k) acc[16 + k] = __builtin_elementwise_fma(w2, (h16x2v){c1[2 * k], c1[2 * k + 1]}, acc[16 + k]); }
        }
#pragma unroll
        for (int j = 0; j < 4; ++j)
#pragma unroll
            for (int q = 0; q < 4; ++q) { const size_t o = tok * DM + hf * 1024 + j * 256 + l16 * 16 + q * 4;
                const f32x4 a = *(const f32x4*)(x1 + o);
                *(f32x4*)(out + o) = (f32x4){a[0] + (float)acc[j * 8 + 2 * q][0], a[1] + (float)acc[j * 8 + 2 * q][1], a[2] + (float)acc[j * 8 + 2 * q + 1][0], a[3] + (float)acc[j * 8 + 2 * q + 1][1]}; }
        __syncthreads();
    }
    __syncthreads();
}

#define XB_TMO      128
#define XB_XCNT(j)  (256  + 64 * (j))
#define XB_XSUB(j)  (1280 + 64 * (j))
#define XB_XGEN(j)  (2304 + 64 * (j))
#define XB_TOP      3328
#define XB_TOPGEN   3392
#define XCD_BAR_WORDS 3456
#define XB_SPIN_CAP (1u << 18)

__device__ __forceinline__ unsigned xb_ld(unsigned* p)              { return __hip_atomic_load(p, __ATOMIC_RELAXED, __HIP_MEMORY_SCOPE_AGENT); }
__device__ __forceinline__ unsigned xb_add(unsigned* p, unsigned v) { return __hip_atomic_fetch_add(p, v, __ATOMIC_RELAXED, __HIP_MEMORY_SCOPE_AGENT); }
__device__ __forceinline__ unsigned xb_xcc_id() { return (unsigned)__builtin_amdgcn_s_getreg((3 << 11) | 20) & 0xFu; }
#define XB_SPIN(cond, bar) do { unsigned _sp = 0; while (cond) { __builtin_amdgcn_s_sleep(1); \
    if ((++_sp & 255u) == 0u) { if (xb_ld(&(bar)[XB_TMO])) break; if (_sp > XB_SPIN_CAP) { atomicAdd(&(bar)[XB_TMO], 1u); break; } } } } while (0)

struct XcdBarrier {
    unsigned* bar; unsigned x;
    volatile LAS unsigned* st;
};

__device__ __forceinline__ XcdBarrier xcd_barrier_post(unsigned* bar, volatile LAS unsigned* st) {
    XcdBarrier b; b.bar = bar; b.x = xb_xcc_id(); b.st = st;
    if (threadIdx.x == 0) (void)xb_add(&bar[XB_XCNT(b.x)], 1u);
    return b;
}
__device__ __forceinline__ void xcd_barrier_complete(unsigned* bar, unsigned x, unsigned& nloc, unsigned& nx) {
    const unsigned G = gridDim.x * gridDim.y * gridDim.z;
    unsigned sum, cnt, mine, sp = 0u;
    for (;;) {
        sum = 0u; cnt = 0u; mine = 0u;
#pragma unroll
        for (unsigned j = 0; j < 16; ++j) { const unsigned c = xb_ld(&bar[XB_XCNT(j)]); sum += c; cnt += (c > 0u) ? 1u : 0u; mine = (j == x) ? c : mine; }
        if (sum == G) break;
        __builtin_amdgcn_s_sleep(1);
        if ((++sp & 255u) == 0u) { if (xb_ld(&bar[XB_TMO])) break; if (sp > XB_SPIN_CAP) { atomicAdd(&bar[XB_TMO], 1u); break; } }
    }
    nloc = mine > 0u ? mine : 1u; nx = cnt > 0u ? cnt : 1u;
}

__device__ __forceinline__ void xcd_barrier(const XcdBarrier& b) {
    asm volatile("s_waitcnt vmcnt(0)" ::: "memory");
    __syncthreads();
    if (threadIdx.x == 0) {
        unsigned* bar = b.bar;
        __builtin_amdgcn_s_waitcnt(0);
        unsigned nloc = b.st[0], nx = b.st[1];
        if (nloc == 0u) { xcd_barrier_complete(bar, b.x, nloc, nx); b.st[0] = nloc; b.st[1] = nx; }
        const unsigned old = xb_add(&bar[XB_XSUB(b.x)], 1u);
        const unsigned gen = old / nloc;
        if (old + 1u == (gen + 1u) * nloc) {
            __builtin_amdgcn_fence(__ATOMIC_RELEASE, "agent");
            asm volatile("s_waitcnt vmcnt(0)" ::: "memory");
            const unsigned og = xb_add(&bar[XB_TOP], 1u);
            const unsigned tg = og / nx;
            if (og + 1u == (tg + 1u) * nx) xb_add(&bar[XB_TOPGEN], 1u);
            else XB_SPIN(xb_ld(&bar[XB_TOPGEN]) == tg, bar);
            __builtin_amdgcn_fence(__ATOMIC_ACQUIRE, "agent");
            xb_add(&bar[XB_XGEN(b.x)], 1u);
            asm volatile("s_waitcnt vmcnt(0)" ::: "memory");
        } else {
            XB_SPIN(xb_ld(&bar[XB_XGEN(b.x)]) == gen, bar);
            __builtin_amdgcn_fence(__ATOMIC_ACQUIRE, "agent");
            asm volatile("s_waitcnt vmcnt(0)" ::: "memory");
        }
    }
    __syncthreads();
}

#define PROBE_P0 0
#define PROBE_DOUBLE 0
#define REP(k) for (int rep_ = 0; rep_ < ((PROBE_DOUBLE == (k)) ? 2 : 1); ++rep_)
constexpr int LDS_BYTES = 147456;
__global__ __launch_bounds__(512, 2) void mega(Params p) {
    extern __shared__ __attribute__((aligned(16))) unsigned char smem[];
    { volatile LAS unsigned* st0 = (volatile LAS unsigned*)((LAS unsigned char*)smem + 131072); if (threadIdx.x < 2) st0[threadIdx.x] = 0u; }
    __syncthreads();
    const XcdBarrier bar = xcd_barrier_post(p.ctl, (volatile LAS unsigned*)((LAS unsigned char*)smem + 131072));
    float* smf = (float*)smem;
    LAS unsigned char* lds = (LAS unsigned char*)smem;
    const int G = gridDim.x, b = blockIdx.x, NGW = G * 8;
#define PHASE_IDS() const int tid = opaque_tid(), lane = tid & 63, wave = __builtin_amdgcn_readfirstlane(tid >> 6), gw = b * 8 + wave; (void)lane; (void)gw

    REP(7) {
        PHASE_IDS();
        float* scr = smf + wave * 4096;
        constexpr int dummy_ = 0; (void)dummy_;
        constexpr int I_IN = 32 * 355, I_Q = 8 * 96, I_KV = 8 * 128, I_O = 64 * 64;
        for (int rp_ = 0; rp_ < (PROBE_P0 == 1 ? 2 : 1); ++rp_)
        for (int it = gw; it < I_IN + I_Q + I_KV + I_O; it += NGW) {
            int r = it;
            if (r < I_IN) { transpose_item(p.w_in, 2048, INW, p.WinT, DstWin(), scr, r, lane); continue; } r -= I_IN;
            if (r < I_Q) { transpose_item(p.w_q_up, 512, 3072, p.WqT, DstQ(), scr, r, lane, p.q_lat_g); continue; } r -= I_Q;
            if (r < I_KV) { transpose_item(p.w_kv_up, 512, 4096, p.WkvT, DstId(), scr, r, lane, p.kv_lat_g); continue; } r -= I_KV;
            transpose_item(p.w_out, 4096, 2048, p.WoT, DstId(), scr, r, lane);
        }
        for (int rp_ = 0; rp_ < (PROBE_P0 == 2 ? 2 : 1); ++rp_)
        for (int m = gw; m < S; m += NGW) rms_row2048(p.x + (size_t)m * DM, p.mix_g, p.h + (size_t)m * DM, lane);
        for (int idx = b * 512 + tid; idx < 16 * 64 * 64; idx += G * 512) { const int hh = idx >> 12, rr = (idx >> 6) & 63, c8 = idx & 63;
            *(u32x4*)(p.WqT + (size_t)(hh * 256 + 192 + rr) * 512 + c8 * 8) = (u32x4){0u, 0u, 0u, 0u}; }
        rope_table(p.pos, p.ropeT, b * 512 + tid, G * 512);
        __syncthreads();
        for (int rp_ = 0; rp_ < (PROBE_P0 == 3 ? 2 : 1); ++rp_)
        for (int it = b; it < 512; it += G) wfold_item(p.w_peer_q, p.sub_keys, p.WpT, smf, it);
    }
    xcd_barrier(bar);
    REP(1) {
        pg8::Gemm g{p.h, p.WinT, S, INWP, DM}; pg8::StaticOrder so; so.init(S, INWP, G, b);
        pg8::EpiInProj E{p.cq, p.ckv, p.fq, p.fk, p.fv, p.merged, p.kpe, p.lf, p.b_gate, p.b_forget, p.ssq, p.fox_qg, p.fox_kg, (LAS float*)(lds + 131072 + 64)};
        pg8::gemm_phase<pg8::EpiInProj, pg8::StaticOrder, true, true>(lds, g, so, E);
    }
    xcd_barrier(bar);
    for (int hh = b; hh < 16; hh += G) fox_cumsum((double*)smem, hh, p.lf, p.F);
    REP(2) {
        pg8::Gemm g{p.cq, p.WqT, S, 4096, 512}; pg8::StaticOrder so; so.init(S, 4096, G, b);
        pg8::EpiQ E{p.qa, p.ssq, p.mla_qg, p.ropeT, (LAS float*)(lds + 131072 + 64)};
        pg8::gemm_phase<pg8::EpiQ, pg8::StaticOrder, true, true>(lds, g, so, E);
    }
    {
        pg8::Gemm g{p.ckv, p.WkvT, S, 4096, 512}; pg8::StaticOrder so; so.init(S, 4096, G, b);
        pg8::EpiKV E{p.ka, p.va, p.kpe, p.ssq, p.mla_kg, p.ropeT, (LAS float*)(lds + 131072 + 64)};
        pg8::gemm_phase<pg8::EpiKV, pg8::StaticOrder, true, true>(lds, g, so, E);
    }
    xcd_barrier(bar);
    int side_next = 0;
    bool nomax_mla, nomax_fox;
    { const int ln = threadIdx.x & 63;
      float a = 0.f, c = 0.f;
      for (int j = ln; j < 192; j += 64) { a = fmaxf(a, fabsf(p.mla_qg[j])); c = fmaxf(c, fabsf(p.mla_kg[j])); }
      const float bm = 1.02f * 192.f * 0.10411754f * att::wave_max_f(a) * att::wave_max_f(c);
      float e = 0.f, f = 0.f;
      for (int j = ln; j < 128; j += 64) { e = fmaxf(e, fabsf(p.fox_qg[j])); f = fmaxf(f, fabsf(p.fox_kg[j])); }
      const float bf = 1.02f * 128.f * 0.12751743f * att::wave_max_f(e) * att::wave_max_f(f);
      nomax_mla = bm <= 80.f; nomax_fox = bf <= 80.f; }
    REP(3) for (int L = b; L < 1024; L += G) {
        const int i = L >> 8, vc = L & 255, vcx = (vc & 7) * 32 + (vc >> 3), hh = vcx >> 4, x = vcx & 15, qbk = (i & 1) ? x : 31 - x;
        if (i < 2) { if (nomax_mla) att::attn_block<192, false, true>(smem, p.qa + hh * 192, 3072, p.ka + hh * 192, 3072, p.va + hh * 128, 2048, nullptr, p.merged + hh * 128, p.attout + hh * 128, qbk, nullptr, nullptr, p.peer_u, p.peer_v, p.U8, p.V8, side_next); else att::attn_block<192, false, false>(smem, p.qa + hh * 192, 3072, p.ka + hh * 192, 3072, p.va + hh * 128, 2048, nullptr, p.merged + hh * 128, p.attout + hh * 128, qbk, nullptr, nullptr, p.peer_u, p.peer_v, p.U8, p.V8, side_next); }
        else { if (nomax_fox) att::attn_block<128, true, true>(smem, p.fq + hh * 128, 2048, p.fk + hh * 128, 2048, p.fv + hh * 128, 2048, p.F + (size_t)hh * S, p.merged + 2048 + hh * 128, p.attout + 2048 + hh * 128, qbk, p.fox_qg, p.fox_kg, p.peer_u, p.peer_v, p.U8, p.V8, side_next); else att::attn_block<128, true, false>(smem, p.fq + hh * 128, 2048, p.fk + hh * 128, 2048, p.fv + hh * 128, 2048, p.F + (size_t)hh * S, p.merged + 2048 + hh * 128, p.attout + 2048 + hh * 128, qbk, p.fox_qg, p.fox_kg, p.peer_u, p.peer_v, p.U8, p.V8, side_next); }
    }
    if (G == 256) { PHASE_IDS(); (void)wave;
        for (; side_next < 32; ++side_next) { const bool isv = side_next >= 16;
            fp6_cvt_rows(isv ? p.peer_v : p.peer_u, isv ? p.V8 : p.U8, b * 64 + (side_next & 15) * 4, 4, isv ? V_SCALE : U_SCALE, tid, 512); } }
    else { PHASE_IDS(); (void)wave; fp6_cvt_rows(p.peer_u, p.U8, 0, 16384, U_SCALE, b * 512 + tid, G * 512); fp6_cvt_rows(p.peer_v, p.V8, 0, 16384, V_SCALE, b * 512 + tid, G * 512); }
    xcd_barrier(bar);
    REP(4) {
        pg8::Gemm g{p.attout, p.WoT, S, 2048, 4096}; pg8::StaticOrder so; so.init(S, 2048, G, b);
        pg8::EpiX1 E{p.x1, p.x, p.xg, p.ffn_g, p.ssq2};
        pg8::gemm_phase<pg8::EpiX1, pg8::StaticOrder, true, true>(lds, g, so, E);
    }
    xcd_barrier(bar);
    REP(5) {
        pg8::Gemm g{p.xg, p.WpT, S, 2048, 2048}; pg8::StaticOrder so; so.init(S, 2048, G, b);
        pg8::EpiScores E{p.scores, p.ssq2};
        pg8::gemm_phase<pg8::EpiScores, pg8::StaticOrder, true, true>(lds, g, so, E);
    }
    xcd_barrier(bar);
    REP(6) for (int g = b; g < S / 32; g += G) peer_group(smem, g, p.scores, p.xg, p.ssq2, p.x1, p.U8, p.V8, p.out);
}

extern "C" void kernel_launch(void* const* d_in, const int* in_sizes, int n_in,
                              void* d_out, int out_size, void* d_ws, size_t ws_size,
                              hipStream_t stream) {
    if (ws_size < 512 * MiB) { fprintf(stderr, "kernel_launch: workspace too small (%zu)\n", ws_size); return; }
    Params p{};
    p.x = (const float*)d_in[0]; p.pos = (const int*)d_in[1]; p.mix_g = (const float*)d_in[2]; p.w_in = (const float*)d_in[3];
    p.b_forget = (const float*)d_in[4]; p.b_gate = (const float*)d_in[5]; p.q_lat_g = (const float*)d_in[6]; p.w_q_up = (const float*)d_in[7];
    p.kv_lat_g = (const float*)d_in[8]; p.w_kv_up = (const float*)d_in[9]; p.mla_qg = (const float*)d_in[10]; p.mla_kg = (const float*)d_in[11];
    p.fox_qg = (const float*)d_in[12]; p.fox_kg = (const float*)d_in[13]; p.w_out = (const float*)d_in[14]; p.ffn_g = (const float*)d_in[15];
    p.w_peer_q = (const float*)d_in[16]; p.sub_keys = (const float*)d_in[17]; p.peer_u = (const float*)d_in[18]; p.peer_v = (const float*)d_in[19];
    p.out = (float*)d_out;
    char* ws = (char*)d_ws;
    p.WqT = (bf16_t*)(ws + 1 * MiB); p.WkvT = (bf16_t*)(ws + 5 * MiB); p.WoT = (bf16_t*)(ws + 9 * MiB); p.WpT = (bf16_t*)(ws + 25 * MiB); p.WinT = (bf16_t*)(ws + 33 * MiB);
    p.h = (bf16_t*)(ws + 78 * MiB); p.cq = (bf16_t*)(ws + 110 * MiB); p.ckv = (bf16_t*)(ws + 118 * MiB);
    p.fq = (bf16_t*)(ws + 126 * MiB); p.fk = (bf16_t*)(ws + 158 * MiB); p.fv = (bf16_t*)(ws + 190 * MiB); p.merged = (bf16_t*)(ws + 222 * MiB);
    p.kpe = (bf16_t*)(ws + 286 * MiB); p.lf = (float*)(ws + 287 * MiB); p.F = (float*)(ws + 287 * MiB + 512 * 1024);
    p.qa = (bf16_t*)(ws + 288 * MiB); p.va = (bf16_t*)(ws + 336 * MiB); p.ka = (bf16_t*)(ws + 400 * MiB); p.x1 = (float*)(ws + 126 * MiB);
    p.scores = (float*)(ws + 222 * MiB);
    p.ctl = (unsigned*)ws;
    p.ropeT = (float2*)(ws + 448 * MiB);
    p.ssq = (float*)(ws + 64 * 1024);
    p.attout = (bf16_t*)(ws + 33 * MiB);
    p.U8 = (unsigned char*)(ws + 450 * MiB); p.V8 = (unsigned char*)(ws + 368 * MiB);
    p.xg = (bf16_t*)(ws + 190 * MiB);
    p.ssq2 = (float*)(ws + 482 * MiB);

    static int grid_blocks = 0;
    if (!grid_blocks) {
        if (hipFuncSetAttribute((const void*)mega, hipFuncAttributeMaxDynamicSharedMemorySize, LDS_BYTES) != hipSuccess) { fprintf(stderr, "hipFuncSetAttribute failed\n"); return; }
        int dev = 0, cus = 0, per_cu = 0;
        (void)hipGetDevice(&dev);
        (void)hipDeviceGetAttribute(&cus, hipDeviceAttributeMultiprocessorCount, dev);
        (void)hipOccupancyMaxActiveBlocksPerMultiprocessor(&per_cu, (const void*)mega, 512, LDS_BYTES);
        if (per_cu < 1 || cus < 1) { fprintf(stderr, "occupancy query says %d blocks/CU on %d CUs\n", per_cu, cus); return; }
        grid_blocks = cus;
    }
    if (hipMemsetAsync(d_ws, 0, 16384, stream) != hipSuccess) { fprintf(stderr, "memset of the barrier words failed\n"); return; }
    void* args[] = {&p};
    hipError_t e = hipLaunchCooperativeKernel((const void*)mega, dim3(grid_blocks), dim3(512), args, LDS_BYTES, stream);
    if (e != hipSuccess) fprintf(stderr, "cooperative launch failed: %s (grid %d)\n", hipGetErrorString(e), grid_blocks);
}
```

```cpp
#include <hip/hip_runtime.h>
#include <hip/hip_cooperative_groups.h>
#include <stdint.h>
#include <math.h>
#include <cstdio>
namespace cg = cooperative_groups;

namespace pg8 {
#define PG8_LAS __attribute__((address_space(3)))
typedef unsigned short bf16_t;
typedef short bf16x8 __attribute__((ext_vector_type(8)));
typedef float f32x4 __attribute__((ext_vector_type(4)));
typedef unsigned u32x4 __attribute__((ext_vector_type(4)));
constexpr int BM = 256, BK = 64, HALF = 128, HTB = HALF * BK * 2  , STAGE_BYTES = 8 * HTB, NXCD = 8, WGM = 8;

__host__ __device__ __forceinline__ int lds_byte(int r, int c) { const int st = (r >> 4) * 2 + (c >> 5), rr = r & 15, cc = c & 31, ob = rr * 64 + cc * 2; return st * 1024 + (ob ^ (((ob >> 9) & 1) << 5)); }
__host__ __device__ __forceinline__ void stage_rc(int b, int& R, int& C) { const int st = b / 1024, sb = b % 1024, swz = sb ^ (((sb >> 9) & 1) << 5); R = (st >> 1) * 16 + swz / 64; C = (st & 1) * 32 + (swz % 64) / 2; }
__host__ __device__ __forceinline__ int perm32(int rho) { const int n = rho >> 4, i = rho & 15; return 8 * (i >> 2) + 4 * n + (i & 3); }

struct Unit { int pm, pn; };
struct Gemm { const bf16_t* A; const bf16_t* Bt; int M, N, K; };

struct StaticOrder {
    int nM, nN, nwg, G, c;
    __host__ __device__ void init(int M, int N, int G_, int c_) { nM = M / BM; nN = N / BM; nwg = nM * nN; G = G_; c = c_; }
    __host__ __device__ bool next(int i, Unit& u) const {
        const long L = (long)i * G + c; if (L >= nwg) return false;
        int wgid = (int)L; { const int q = nwg / NXCD, r = nwg % NXCD, xcd = wgid % NXCD, off = wgid / NXCD; wgid = (xcd < r ? xcd * (q + 1) : r * (q + 1) + (xcd - r) * q) + off; }
        const int nig = WGM * nN, gid = wgid / nig, fm = gid * WGM, gsz = (nM - fm) < WGM ? (nM - fm) : WGM;
        u.pm = fm + ((wgid % nig) % gsz); u.pn = (wgid % nig) / gsz; return true;
    }
    __device__ __forceinline__ void a_ready(const Unit&) const {}
    __device__ __forceinline__ void done(const Unit&) const {}
};

typedef float cvt_pk_bf16_f32x2 __attribute__((ext_vector_type(2))); typedef __bf16 cvt_pk_bf16_bf16x2 __attribute__((ext_vector_type(2)));
__device__ __forceinline__ unsigned cvt_pk_bf16(float lo, float hi) { const cvt_pk_bf16_f32x2 v = {lo, hi}; const cvt_pk_bf16_bf16x2 b = __builtin_convertvector(v, cvt_pk_bf16_bf16x2); return __builtin_bit_cast(unsigned, b); }
__device__ __forceinline__ u32x4 pack8bf(const f32x4& v0, const f32x4& v1) { u32x4 w; w.x = cvt_pk_bf16(v0[0], v0[1]); w.y = cvt_pk_bf16(v0[2], v0[3]); w.z = cvt_pk_bf16(v1[0], v1[1]); w.w = cvt_pk_bf16(v1[2], v1[3]); return w; }

struct EpiStoreBf16 {
    static constexpr bool PERM = true, AFTER_DRAIN = false;
    bf16_t* O; int ldc;
    __device__ __forceinline__ void operator()(const f32x4 (&acc)[2][2][4][2], const Unit& u, int wr, int wc, int fr, int fq) const {
        const int row0 = u.pm * BM + wr * 64 + fr, col0 = u.pn * BM + wc * 32 + 8 * fq;
#pragma unroll
        for (int ai = 0; ai < 2; ++ai)
#pragma unroll
            for (int m = 0; m < 4; ++m) { bf16_t* rowp = O + (size_t)(row0 + ai * HALF + m * 16) * ldc + col0;
#pragma unroll
                for (int bj = 0; bj < 2; ++bj) *(u32x4*)(rowp + bj * HALF) = pack8bf(acc[ai][bj][m][0], acc[ai][bj][m][1]); }
    }
};
template <bool RES> struct EpiStoreF32 {
    static constexpr bool PERM = true, AFTER_DRAIN = false;
    float* O; const float* res; int ldc;
    __device__ __forceinline__ void operator()(const f32x4 (&acc)[2][2][4][2], const Unit& u, int wr, int wc, int fr, int fq) const {
        const int row0 = u.pm * BM + wr * 64 + fr, col0 = u.pn * BM + wc * 32 + 8 * fq;
#pragma unroll
        for (int ai = 0; ai < 2; ++ai)
#pragma unroll
            for (int m = 0; m < 4; ++m) { const size_t off = (size_t)(row0 + ai * HALF + m * 16) * ldc + col0;
#pragma unroll
                for (int bj = 0; bj < 2; ++bj) { f32x4 v0 = acc[ai][bj][m][0], v1 = acc[ai][bj][m][1];
                    if (RES) { v0 += *(const f32x4*)(res + off + bj * HALF); v1 += *(const f32x4*)(res + off + bj * HALF + 4); }
                    *(f32x4*)(O + off + bj * HALF) = v0; *(f32x4*)(O + off + bj * HALF + 4) = v1; } }
    }
};
#define EPI_LDSBAR() do { asm volatile("s_waitcnt lgkmcnt(0)" ::: "memory"); __builtin_amdgcn_s_barrier(); asm volatile("" ::: "memory"); } while (0)
struct EpiInProj {
    static constexpr bool PERM = true, AFTER_DRAIN = false;
    bf16_t *cq, *ckv, *fq, *fk, *fv, *gates, *kpe; float* lf; const float *b_gate, *b_forget; float* ssq; const float *gfq, *gfk; PG8_LAS float* xs;
    __device__ __forceinline__ void operator()(const f32x4 (&acc)[2][2][4][2], const Unit& u, int wr, int wc, int fr, int fq_) const {
        const int pn = u.pn, row0 = u.pm * BM + wr * 64 + fr, cw = wc * 32 + 8 * fq_;
        if (pn < 4) {
            bf16_t* base = pn < 2 ? cq : ckv; const int colt = (pn & 1) * 256;
#pragma unroll
            for (int ai = 0; ai < 2; ++ai)
#pragma unroll
                for (int m = 0; m < 4; ++m) { const int row = row0 + ai * HALF + m * 16; bf16_t* rowp = base + (size_t)row * 512 + colt + cw; float s = 0.f;
#pragma unroll
                    for (int bj = 0; bj < 2; ++bj) { const f32x4 v0 = acc[ai][bj][m][0], v1 = acc[ai][bj][m][1];
                        s += (v0[0] * v0[0] + v0[1] * v0[1]) + (v0[2] * v0[2] + v0[3] * v0[3]) + (v1[0] * v1[0] + v1[1] * v1[1]) + (v1[2] * v1[2] + v1[3] * v1[3]);
                        *(u32x4*)(rowp + bj * HALF) = pack8bf(v0, v1); }
                    s += __shfl_xor(s, 16); s += __shfl_xor(s, 32);
                    if (fq_ == 0) ssq[((size_t)pn * 8192 + row) * 4 + wc] = s; }
        } else if (pn < 20) {
            const bool isq = pn < 12; bf16_t* base = isq ? fq : fk; const int colt = (pn - (isq ? 4 : 12)) * 256; const float* g = isq ? gfq : gfk;
            const float qs = isq ? 0.12751743f : 1.f;
#pragma unroll
            for (int ai = 0; ai < 2; ++ai)
#pragma unroll
                for (int m = 0; m < 4; ++m)
#pragma unroll
                    for (int bj = 0; bj < 2; ++bj) { const f32x4 v0 = acc[ai][bj][m][0], v1 = acc[ai][bj][m][1];
                        float s = (v0[0] * v0[0] + v0[1] * v0[1]) + (v0[2] * v0[2] + v0[3] * v0[3]) + (v1[0] * v1[0] + v1[1] * v1[1]) + (v1[2] * v1[2] + v1[3] * v1[3]);
                        s += __shfl_xor(s, 16); s += __shfl_xor(s, 32);
                        if (fq_ == 0) xs[((ai * HALF + wr * 64 + m * 16 + fr) * 2 + bj) * 4 + wc] = s; }
            EPI_LDSBAR();
            const f32x4 g0 = *(const f32x4*)(g + cw) * qs, g1 = *(const f32x4*)(g + cw + 4) * qs;
#pragma unroll
            for (int ai = 0; ai < 2; ++ai)
#pragma unroll
                for (int m = 0; m < 4; ++m) { bf16_t* rowp = base + (size_t)(row0 + ai * HALF + m * 16) * 2048 + colt + cw;
#pragma unroll
                    for (int bj = 0; bj < 2; ++bj) { const f32x4 t4 = *(const PG8_LAS f32x4*)(xs + ((ai * HALF + wr * 64 + m * 16 + fr) * 2 + bj) * 4);
                        const float r = rsqrtf(((t4[0] + t4[1]) + (t4[2] + t4[3])) * (1.f / 128.f) + 1e-6f);
                        *(u32x4*)(rowp + bj * HALF) = pack8bf(acc[ai][bj][m][0] * g0 * r, acc[ai][bj][m][1] * g1 * r); } }
        } else if (pn < 28) {
            const int colt = (pn - 20) * 256;
#pragma unroll
            for (int ai = 0; ai < 2; ++ai)
#pragma unroll
                for (int m = 0; m < 4; ++m) { bf16_t* rowp = fv + (size_t)(row0 + ai * HALF + m * 16) * 2048 + colt + cw;
#pragma unroll
                    for (int bj = 0; bj < 2; ++bj) *(u32x4*)(rowp + bj * HALF) = pack8bf(acc[ai][bj][m][0], acc[ai][bj][m][1]); }
        } else if (pn < 44) {
            const int colt = (pn - 28) * 256 + cw;
#pragma unroll
            for (int bj = 0; bj < 2; ++bj) {
                const f32x4 b0 = *(const f32x4*)(b_gate + colt + bj * HALF), b1 = *(const f32x4*)(b_gate + colt + bj * HALF + 4);
#pragma unroll
                for (int ai = 0; ai < 2; ++ai)
#pragma unroll
                    for (int m = 0; m < 4; ++m) {
                        f32x4 v0 = acc[ai][bj][m][0] + b0, v1 = acc[ai][bj][m][1] + b1;
#pragma unroll
                        for (int e = 0; e < 4; ++e) { v0[e] = __builtin_amdgcn_rcpf(1.f + __expf(-v0[e])); v1[e] = __builtin_amdgcn_rcpf(1.f + __expf(-v1[e])); }
                        *(u32x4*)(gates + (size_t)(row0 + ai * HALF + m * 16) * 4096 + colt + bj * HALF) = pack8bf(v0, v1); }
            }
        } else {
            if (cw < 64) {
#pragma unroll
                for (int ai = 0; ai < 2; ++ai)
#pragma unroll
                    for (int m = 0; m < 4; ++m) *(u32x4*)(kpe + (size_t)(row0 + ai * HALF + m * 16) * 64 + cw) = pack8bf(acc[ai][0][m][0], acc[ai][0][m][1]);
            } else if (cw < 80) {
                const int h0 = cw - 64;
                const f32x4 b0 = *(const f32x4*)(b_forget + h0), b1 = *(const f32x4*)(b_forget + h0 + 4);
#pragma unroll
                for (int ai = 0; ai < 2; ++ai)
#pragma unroll
                    for (int m = 0; m < 4; ++m) { const int row = row0 + ai * HALF + m * 16;
                        f32x4 z0 = acc[ai][0][m][0] + b0, z1 = acc[ai][0][m][1] + b1;
#pragma unroll
                        for (int e = 0; e < 4; ++e) { z0[e] = fminf(z0[e], 0.f) - __logf(1.f + __expf(-fabsf(z0[e]))); z1[e] = fminf(z1[e], 0.f) - __logf(1.f + __expf(-fabsf(z1[e]))); }
                        *(f32x4*)(lf + (size_t)row * 16 + h0) = z0; *(f32x4*)(lf + (size_t)row * 16 + h0 + 4) = z1; }
            }
        }
    }
};
__device__ __forceinline__ float lat_rinv(const float* ssq, int part0, int row) {
    const f32x4 a = *(const f32x4*)(ssq + ((size_t)part0 * 8192 + row) * 4), b = *(const f32x4*)(ssq + ((size_t)(part0 + 1) * 8192 + row) * 4);
    return rsqrtf((((a[0] + a[1]) + (a[2] + a[3])) + ((b[0] + b[1]) + (b[2] + b[3]))) * (1.f / 512.f) + 1e-6f);
}
struct EpiQ {
    static constexpr bool PERM = true, AFTER_DRAIN = false;
    bf16_t* qa; const float* ssq; const float* gq; const float2* ropeT; PG8_LAS float* xs;
    __device__ __forceinline__ void operator()(const f32x4 (&acc)[2][2][4][2], const Unit& u, int wr, int wc, int fr, int fq_) const {
        const int h = u.pn, row0 = u.pm * BM + wr * 64 + fr, cw = wc * 32 + 8 * fq_;
        float rl[2][4];
#pragma unroll
        for (int ai = 0; ai < 2; ++ai)
#pragma unroll
            for (int m = 0; m < 4; ++m) { rl[ai][m] = lat_rinv(ssq, 0, row0 + ai * HALF + m * 16); float s = 0.f;
#pragma unroll
                for (int bj = 0; bj < 2; ++bj) { const f32x4 v0 = acc[ai][bj][m][0], v1 = acc[ai][bj][m][1];
                    s += (v0[0] * v0[0] + v0[1] * v0[1]) + (v0[2] * v0[2] + v0[3] * v0[3]) + (v1[0] * v1[0] + v1[1] * v1[1]) + (v1[2] * v1[2] + v1[3] * v1[3]); }
                s *= rl[ai][m] * rl[ai][m];
                s += __shfl_xor(s, 16); s += __shfl_xor(s, 32);
                if (fq_ == 0) xs[(ai * HALF + wr * 64 + m * 16 + fr) * 4 + wc] = s; }
        EPI_LDSBAR();
        const float qs = 0.10411754f;
        const f32x4 g0 = *(const f32x4*)(gq + cw) * qs, g1 = *(const f32x4*)(gq + cw + 4) * qs;
        const int pp = 16 * (wc & 1) + 4 * fq_;
        const f32x4 ga = *(const f32x4*)(gq + 128 + pp) * qs, gb = *(const f32x4*)(gq + 160 + pp) * qs;
#pragma unroll
        for (int ai = 0; ai < 2; ++ai) {
            f32x4 rc0[4], rc1[4];
            if (wc < 2) {
#pragma unroll
                for (int m = 0; m < 4; ++m) { const size_t ro = (size_t)(row0 + ai * HALF + m * 16) * 32 + pp; rc0[m] = *(const f32x4*)(ropeT + ro); rc1[m] = *(const f32x4*)(ropeT + ro + 2); } }
#pragma unroll
            for (int m = 0; m < 4; ++m) { const int row = row0 + ai * HALF + m * 16;
                const f32x4 t4 = *(const PG8_LAS f32x4*)(xs + (ai * HALF + wr * 64 + m * 16 + fr) * 4);
                const float r = rsqrtf(((t4[0] + t4[1]) + (t4[2] + t4[3])) * (1.f / 192.f) + 1e-6f) * rl[ai][m];
                bf16_t* rowp = qa + (size_t)row * 3072 + h * 192;
                *(u32x4*)(rowp + cw) = pack8bf(acc[ai][0][m][0] * g0 * r, acc[ai][0][m][1] * g1 * r);
                if (wc < 2) { const f32x4 c01 = rc0[m], c23 = rc1[m];
                    const f32x4 z0 = acc[ai][1][m][0] * r, z1 = acc[ai][1][m][1] * r;
                    const float a0 = z0[0] * ga[0], b0 = z0[1] * gb[0], a1 = z0[2] * ga[1], b1 = z0[3] * gb[1], a2 = z1[0] * ga[2], b2 = z1[1] * gb[2], a3 = z1[2] * ga[3], b3 = z1[3] * gb[3];
                    const f32x4 o0 = {a0 * c01[0] - b0 * c01[1], a0 * c01[1] + b0 * c01[0], a1 * c01[2] - b1 * c01[3], a1 * c01[3] + b1 * c01[2]};
                    const f32x4 o1 = {a2 * c23[0] - b2 * c23[1], a2 * c23[1] + b2 * c23[0], a3 * c23[2] - b3 * c23[3], a3 * c23[3] + b3 * c23[2]};
                    *(u32x4*)(rowp + 128 + cw) = pack8bf(o0, o1); } }
        }
    }
};
struct EpiKV {
    static constexpr bool PERM = true, AFTER_DRAIN = false;
    bf16_t *ka, *va; const bf16_t* kpe; const float* ssq; const float* gk; const float2* ropeT; PG8_LAS float* xs;
    __device__ __forceinline__ void operator()(const f32x4 (&acc)[2][2][4][2], const Unit& u, int wr, int wc, int fr, int fq_) const {
        const int h = u.pn, row0 = u.pm * BM + wr * 64 + fr, cw = wc * 32 + 8 * fq_;
        float rl[2][4]; f32x4 kp[2][4];
#pragma unroll
        for (int ai = 0; ai < 2; ++ai)
#pragma unroll
            for (int m = 0; m < 4; ++m) { const int row = row0 + ai * HALF + m * 16; rl[ai][m] = lat_rinv(ssq, 2, row);
                const uint2 w = *(const uint2*)(kpe + (size_t)row * 64 + 16 * wc + 4 * fq_);
                kp[ai][m] = (f32x4){__uint_as_float(w.x << 16), __uint_as_float(w.x & 0xffff0000u), __uint_as_float(w.y << 16), __uint_as_float(w.y & 0xffff0000u)};
                const f32x4 v0 = acc[ai][0][m][0], v1 = acc[ai][0][m][1];
                float s = ((v0[0] * v0[0] + v0[1] * v0[1]) + (v0[2] * v0[2] + v0[3] * v0[3]) + (v1[0] * v1[0] + v1[1] * v1[1]) + (v1[2] * v1[2] + v1[3] * v1[3])) * (rl[ai][m] * rl[ai][m]);
                s += (kp[ai][m][0] * kp[ai][m][0] + kp[ai][m][1] * kp[ai][m][1]) + (kp[ai][m][2] * kp[ai][m][2] + kp[ai][m][3] * kp[ai][m][3]);
                s += __shfl_xor(s, 16); s += __shfl_xor(s, 32);
                if (fq_ == 0) xs[(ai * HALF + wr * 64 + m * 16 + fr) * 4 + wc] = s; }
        const int pp = 8 * wc + 2 * fq_;
#pragma unroll
        for (int ai = 0; ai < 2; ++ai)
#pragma unroll
            for (int m = 0; m < 4; ++m) *(u32x4*)(va + (size_t)(row0 + ai * HALF + m * 16) * 2048 + h * 128 + cw) = pack8bf(acc[ai][1][m][0] * rl[ai][m], acc[ai][1][m][1] * rl[ai][m]);
        EPI_LDSBAR();
        const f32x4 g0 = *(const f32x4*)(gk + cw), g1 = *(const f32x4*)(gk + cw + 4);
        const float ga0 = gk[128 + pp], ga1 = gk[128 + pp + 1], gb0 = gk[160 + pp], gb1 = gk[160 + pp + 1];
#pragma unroll
        for (int ai = 0; ai < 2; ++ai) {
            f32x4 rcs[4];
#pragma unroll
            for (int m = 0; m < 4; ++m) rcs[m] = *(const f32x4*)(ropeT + (size_t)(row0 + ai * HALF + m * 16) * 32 + pp);
#pragma unroll
            for (int m = 0; m < 4; ++m) { const int row = row0 + ai * HALF + m * 16;
                const f32x4 t4 = *(const PG8_LAS f32x4*)(xs + (ai * HALF + wr * 64 + m * 16 + fr) * 4);
                const float r = rsqrtf(((t4[0] + t4[1]) + (t4[2] + t4[3])) * (1.f / 192.f) + 1e-6f), rn = r * rl[ai][m];
                bf16_t* rowp = ka + (size_t)row * 3072 + h * 192;
                *(u32x4*)(rowp + cw) = pack8bf(acc[ai][0][m][0] * g0 * rn, acc[ai][0][m][1] * g1 * rn);
                const f32x4 cs = rcs[m];
                const float a0 = kp[ai][m][0] * r * ga0, b0 = kp[ai][m][1] * r * gb0, a1 = kp[ai][m][2] * r * ga1, b1 = kp[ai][m][3] * r * gb1;
                uint2 o; o.x = cvt_pk_bf16(a0 * cs[0] - b0 * cs[1], a0 * cs[1] + b0 * cs[0]); o.y = cvt_pk_bf16(a1 * cs[2] - b1 * cs[3], a1 * cs[3] + b1 * cs[2]);
                *(uint2*)(rowp + 128 + 16 * wc + 4 * fq_) = o; }
        }
    }
};

struct EpiX1 {
    static constexpr bool PERM = true, AFTER_DRAIN = false;
    float* x1; const float* x; bf16_t* xg; const float* g; float* ssq2;
    __device__ __forceinline__ void operator()(const f32x4 (&acc)[2][2][4][2], const Unit& u, int wr, int wc, int fr, int fq_) const {
        const int row0 = u.pm * BM + wr * 64 + fr, col0 = u.pn * BM + wc * 32 + 8 * fq_;
        f32x4 gg[2][2];
#pragma unroll
        for (int bj = 0; bj < 2; ++bj) { gg[bj][0] = *(const f32x4*)(g + col0 + bj * HALF); gg[bj][1] = *(const f32x4*)(g + col0 + bj * HALF + 4); }
#pragma unroll
        for (int am = 0; am < 4; ++am) { const int ai = am >> 1;
            f32x4 xr[4][2][2];
#pragma unroll
            for (int m = 2 * (am & 1); m < 2 * (am & 1) + 2; ++m)
#pragma unroll
                for (int bj = 0; bj < 2; ++bj) { const size_t off = (size_t)(row0 + ai * HALF + m * 16) * 2048 + col0 + bj * HALF; xr[m][bj][0] = *(const f32x4*)(x + off); xr[m][bj][1] = *(const f32x4*)(x + off + 4); }
#pragma unroll
            for (int m = 2 * (am & 1); m < 2 * (am & 1) + 2; ++m) { const int row = row0 + ai * HALF + m * 16; const size_t off = (size_t)row * 2048 + col0; float s = 0.f;
#pragma unroll
                for (int bj = 0; bj < 2; ++bj) { const f32x4 v0 = acc[ai][bj][m][0] + xr[m][bj][0], v1 = acc[ai][bj][m][1] + xr[m][bj][1];
                    *(f32x4*)(x1 + off + bj * HALF) = v0; *(f32x4*)(x1 + off + bj * HALF + 4) = v1;
                    s += (v0[0] * v0[0] + v0[1] * v0[1]) + (v0[2] * v0[2] + v0[3] * v0[3]) + (v1[0] * v1[0] + v1[1] * v1[1]) + (v1[2] * v1[2] + v1[3] * v1[3]);
                    *(u32x4*)(xg + off + bj * HALF) = pack8bf(v0 * gg[bj][0], v1 * gg[bj][1]); }
                s += __shfl_xor(s, 16); s += __shfl_xor(s, 32);
                if (fq_ == 0) ssq2[((size_t)u.pn * 8192 + row) * 4 + wc] = s; }
        }
    }
};
__device__ __forceinline__ float ffn_rinv(const float* ssq2, int row) {
    float t = 0.f;
#pragma unroll
    for (int pn = 0; pn < 8; ++pn) { const f32x4 a = *(const f32x4*)(ssq2 + ((size_t)pn * 8192 + row) * 4); t += (a[0] + a[1]) + (a[2] + a[3]); }
    return rsqrtf(t * (1.f / 2048.f) + 1e-6f);
}
struct EpiScores {
    static constexpr bool PERM = true, AFTER_DRAIN = false;
    float* O; const float* ssq2;
    __device__ __forceinline__ void operator()(const f32x4 (&acc)[2][2][4][2], const Unit& u, int wr, int wc, int fr, int fq_) const {
        const int row0 = u.pm * BM + wr * 64 + fr, col0 = u.pn * BM + wc * 32 + 8 * fq_;
        float rr[2][4];
#pragma unroll
        for (int ai = 0; ai < 2; ++ai)
#pragma unroll
            for (int m = 0; m < 4; ++m) rr[ai][m] = ffn_rinv(ssq2, row0 + ai * HALF + m * 16);
#pragma unroll
        for (int ai = 0; ai < 2; ++ai)
#pragma unroll
            for (int m = 0; m < 4; ++m) { const int row = row0 + ai * HALF + m * 16; const float r = rr[ai][m]; const size_t off = (size_t)row * 2048 + col0;
#pragma unroll
                for (int bj = 0; bj < 2; ++bj) { *(f32x4*)(O + off + bj * HALF) = acc[ai][bj][m][0] * r; *(f32x4*)(O + off + bj * HALF + 4) = acc[ai][bj][m][1] * r; } }
    }
};
template <class Epi, class Sched, bool ALIGN_EPI = false, bool SP2 = false>
__device__ __forceinline__ void gemm_phase(PG8_LAS unsigned char* lds, const Gemm g, const Sched& S, const Epi& E) {
    int tid = threadIdx.x; asm volatile("" : "+v"(tid));
    const int wid = __builtin_amdgcn_readfirstlane(tid >> 6), lane = tid & 63, wr = wid >> 2, wc = wid & 3, fr = lane & 15, fq = lane >> 4;
    const int K = g.K, nt = K / BK;
    unsigned voffA[2], voffB[2];
#pragma unroll
    for (int i = 0; i < 2; ++i) { int R, C; stage_rc(tid * 16 + i * 8192, R, C); const int Rb = Epi::PERM ? ((R & ~31) + perm32(R & 31)) : R;
        voffA[i] = (unsigned)(R * K + C) * 2u; voffB[i] = (unsigned)(Rb * K + C) * 2u; }
    const size_t kstep = (size_t)(BK * 2);
    const size_t hstep = (size_t)HALF * K * 2;
    const size_t tstep = 2 * hstep;
    const unsigned ldsw = (unsigned)wid * 1024u;
    const int aoff = lds_byte(wr * 64 + fr, fq * 8), boff = lds_byte(wc * 32 + fr, fq * 8);
#define PG8_SA(b, h) (((b) * 2 + (h)) * HTB)
#define PG8_SB(b, h) ((4 + (b) * 2 + (h)) * HTB)
#define PG8_STAGE(bufoff, gbase, voff) do { _Pragma("unroll") for (int _i = 0; _i < 2; ++_i) \
        __builtin_amdgcn_global_load_lds((const unsigned*)((const char*)(gbase) + (voff)[_i]), (PG8_LAS unsigned*)(lds + (bufoff) + ldsw + _i * 8192), 16, 0, 0); } while (0)
#define PG8_LDA(dst, b, h) do { _Pragma("unroll") for (int m = 0; m < 4; ++m) _Pragma("unroll") for (int k = 0; k < 2; ++k) dst[m][k] = *(const PG8_LAS bf16x8*)(lds + PG8_SA(b, h) + aoff + m * 2048 + k * 1024); } while (0)
#define PG8_LDB(dst, b, h) do { _Pragma("unroll") for (int n = 0; n < 2; ++n) _Pragma("unroll") for (int k = 0; k < 2; ++k) dst[n][k] = *(const PG8_LAS bf16x8*)(lds + PG8_SB(b, h) + boff + n * 2048 + k * 1024); } while (0)
#define PG8_MMA(ai, bj, At, Bt) do { __builtin_amdgcn_s_setprio(1); _Pragma("unroll") for (int m = 0; m < 4; ++m) _Pragma("unroll") for (int n = 0; n < 2; ++n) _Pragma("unroll") for (int k = 0; k < 2; ++k) \
        acc[ai][bj][m][n] = __builtin_amdgcn_mfma_f32_16x16x32_bf16(Bt[n][k], At[m][k], acc[ai][bj][m][n], 0, 0, 0); __builtin_amdgcn_s_setprio(0); } while (0)
#define PG8_WAIT_V(n) asm volatile("s_waitcnt vmcnt(" #n ")" ::: "memory")
#define PG8_WAIT_L(n) asm volatile("s_waitcnt lgkmcnt(" #n ")" ::: "memory")
#define PG8_BAR __builtin_amdgcn_s_barrier()
#define PG8_SCHED __builtin_amdgcn_sched_barrier(0)
    Unit cur, nxt; int ui = 0;
    if (!S.next(0, cur)) return;
    f32x4 acc[2][2][4][2];
#pragma unroll
    for (int a = 0; a < 2; ++a)
#pragma unroll
        for (int b = 0; b < 2; ++b)
#pragma unroll
            for (int m = 0; m < 4; ++m)
#pragma unroll
                for (int n = 0; n < 2; ++n) acc[a][b][m][n] = (f32x4){0.f, 0.f, 0.f, 0.f};
    bf16x8 At[4][2], B0[2][2], B1[2][2];
    const char* cA = (const char*)g.A + (size_t)cur.pm * tstep; const char* cB = (const char*)g.Bt + (size_t)cur.pn * tstep;
    S.a_ready(cur);
    if constexpr (SP2) {
        PG8_STAGE(PG8_SB(0, 0), cB, voffB); PG8_STAGE(PG8_SB(0, 1), cB + hstep, voffB); PG8_STAGE(PG8_SA(0, 0), cA, voffA); PG8_STAGE(PG8_SA(0, 1), cA + hstep, voffA);
        if (wr == 1) PG8_BAR;
        PG8_WAIT_V(2); PG8_BAR;
        PG8_STAGE(PG8_SB(1, 0), cB + kstep, voffB); PG8_STAGE(PG8_SA(1, 0), cA + kstep, voffA); PG8_STAGE(PG8_SB(1, 1), cB + hstep + kstep, voffB);
        PG8_WAIT_V(6); PG8_BAR;
    } else {
        PG8_STAGE(PG8_SB(0, 0), cB, voffB); PG8_STAGE(PG8_SA(0, 0), cA, voffA); PG8_STAGE(PG8_SB(0, 1), cB + hstep, voffB); PG8_STAGE(PG8_SA(0, 1), cA + hstep, voffA);
        if (wr == 1) PG8_BAR;
        PG8_WAIT_V(4); PG8_BAR;
        PG8_STAGE(PG8_SB(1, 0), cB + kstep, voffB); PG8_STAGE(PG8_SA(1, 0), cA + kstep, voffA); PG8_STAGE(PG8_SB(1, 1), cB + hstep + kstep, voffB);
        PG8_WAIT_V(6); PG8_BAR;
    }
    for (;;) {
        const bool has_next = S.next(ui + 1, nxt);
        const char* nA = has_next ? (const char*)g.A + (size_t)nxt.pm * tstep : cA; const char* nB = has_next ? (const char*)g.Bt + (size_t)nxt.pn * tstep : cB;
        for (int t = 0; t < nt; t += 2) {
            const bool last = (t == nt - 2);
            const char* a1 = cA + (size_t)(t + 1) * kstep;
            const char* a2 = last ? nA : cA + (size_t)(t + 2) * kstep; const char* b2 = last ? nB : cB + (size_t)(t + 2) * kstep;
            const char* a3 = a2 + kstep; const char* b3 = b2 + kstep;
            if (last && has_next) S.a_ready(nxt);
            if constexpr (SP2) {
            PG8_LDB(B0, 0, 0); PG8_LDB(B1, 0, 1); PG8_SCHED; PG8_LDA(At, 0, 0); PG8_STAGE(PG8_SA(1, 1), a1 + hstep, voffA);
            PG8_WAIT_V(8); PG8_WAIT_L(0); PG8_BAR; PG8_MMA(0, 0, At, B0); PG8_MMA(0, 1, At, B1); PG8_BAR; PG8_SCHED;
            PG8_LDA(At, 0, 1); PG8_STAGE(PG8_SB(0, 0), b2, voffB); PG8_STAGE(PG8_SB(0, 1), b2 + hstep, voffB); PG8_STAGE(PG8_SA(0, 0), a2, voffA);
            PG8_WAIT_V(8); PG8_WAIT_L(0); PG8_BAR; PG8_MMA(1, 0, At, B0); PG8_MMA(1, 1, At, B1); PG8_BAR; PG8_SCHED;
            PG8_LDB(B0, 1, 0); PG8_LDB(B1, 1, 1); PG8_SCHED; PG8_LDA(At, 1, 0); PG8_STAGE(PG8_SA(0, 1), a2 + hstep, voffA);
            PG8_WAIT_V(8); PG8_WAIT_L(0); PG8_BAR; PG8_MMA(0, 0, At, B0); PG8_MMA(0, 1, At, B1); PG8_BAR; PG8_SCHED;
            PG8_LDA(At, 1, 1); PG8_STAGE(PG8_SB(1, 0), b3, voffB); PG8_STAGE(PG8_SB(1, 1), b3 + hstep, voffB); PG8_STAGE(PG8_SA(1, 0), a3, voffA);
            PG8_WAIT_V(8); PG8_WAIT_L(0); PG8_BAR; PG8_MMA(1, 0, At, B0); PG8_MMA(1, 1, At, B1); PG8_BAR; PG8_SCHED;
            } else {
            PG8_LDB(B0, 0, 0); PG8_SCHED; PG8_LDA(At, 0, 0); PG8_STAGE(PG8_SA(1, 1), a1 + hstep, voffA);
            PG8_WAIT_L(8); PG8_BAR; PG8_WAIT_L(0); PG8_MMA(0, 0, At, B0); PG8_BAR; PG8_SCHED;
            PG8_LDB(B1, 0, 1); PG8_STAGE(PG8_SB(0, 0), b2, voffB);
            PG8_BAR; PG8_WAIT_L(0); PG8_MMA(0, 1, At, B1); PG8_BAR;
            PG8_LDA(At, 0, 1); PG8_STAGE(PG8_SA(0, 0), a2, voffA);
            PG8_BAR; PG8_WAIT_L(0); PG8_MMA(1, 0, At, B0); PG8_BAR; PG8_SCHED;
            PG8_STAGE(PG8_SB(0, 1), b2 + hstep, voffB);
            PG8_WAIT_V(6); PG8_BAR; PG8_MMA(1, 1, At, B1); PG8_BAR;
            PG8_LDB(B0, 1, 0); PG8_SCHED; PG8_LDA(At, 1, 0); PG8_STAGE(PG8_SA(0, 1), a2 + hstep, voffA);
            PG8_WAIT_L(8); PG8_BAR; PG8_WAIT_L(0); PG8_MMA(0, 0, At, B0); PG8_BAR; PG8_SCHED;
            PG8_LDB(B1, 1, 1); PG8_STAGE(PG8_SB(1, 0), b3, voffB);
            PG8_BAR; PG8_WAIT_L(0); PG8_MMA(0, 1, At, B1); PG8_BAR;
            PG8_LDA(At, 1, 1); PG8_STAGE(PG8_SA(1, 0), a3, voffA);
            PG8_BAR; PG8_WAIT_L(0); PG8_MMA(1, 0, At, B0); PG8_BAR; PG8_SCHED;
            PG8_STAGE(PG8_SB(1, 1), b3 + hstep, voffB);
            PG8_WAIT_V(6); PG8_BAR; PG8_MMA(1, 1, At, B1); PG8_BAR;
            }
        }
        if constexpr (ALIGN_EPI) { if (wr == 0) PG8_BAR; }
        if constexpr (!Epi::AFTER_DRAIN) { E(acc, cur, wr, wc, fr, fq); S.done(cur); }
        if (!has_next) break;
#pragma unroll
        for (int a = 0; a < 2; ++a)
#pragma unroll
            for (int b = 0; b < 2; ++b)
#pragma unroll
                for (int m = 0; m < 4; ++m)
#pragma unroll
                    for (int n = 0; n < 2; ++n) acc[a][b][m][n] = (f32x4){0.f, 0.f, 0.f, 0.f};
        cur = nxt; cA = nA; cB = nB; ++ui;
        if constexpr (ALIGN_EPI) { if (wr == 1) PG8_BAR; }
    }
    PG8_WAIT_V(0);
    if constexpr (!ALIGN_EPI) { if (wr == 0) PG8_BAR; }
    PG8_BAR;
    if constexpr (Epi::AFTER_DRAIN) { E.fused(acc, cur, wr, wc, fr, fq, lds, wid, lane); S.done(cur); }
#undef PG8_SA
#undef PG8_SB
#undef PG8_STAGE
#undef PG8_LDA
#undef PG8_LDB
#undef PG8_MMA
#undef PG8_WAIT_V
#undef PG8_WAIT_L
#undef PG8_BAR
#undef PG8_SCHED
}
}
namespace att {
typedef unsigned short bf16_t;
typedef short bf16x8 __attribute__((ext_vector_type(8)));
typedef short s16x4 __attribute__((ext_vector_type(4)));
typedef float f32x16 __attribute__((ext_vector_type(16)));
typedef float f32x4 __attribute__((ext_vector_type(4)));
typedef unsigned u32x4 __attribute__((ext_vector_type(4)));
#define ALAS __attribute__((address_space(3)))
#define ASBAR() __builtin_amdgcn_sched_barrier(0)
constexpr int SHM_V = 16384;
template <int DK> struct Lay { static constexpr int ROWB = DK * 2, SHM_K = 64 * ROWB, OFF_K = 2 * SHM_V, OFF_F = OFF_K + 2 * SHM_K, OFF_WS = OFF_F + 512, TOTAL = OFF_WS + 8 * 256; };

__device__ __forceinline__ int v_st(int k, int c) { const int kk = (k & ~0xC) | ((k & 4) << 1) | ((k & 8) >> 1); return ((kk >> 3) * 4 + (c >> 5)) * 512 + ((kk & 7) * 32 + (c & 31)) * 2; }
__device__ __forceinline__ int v_rd_base(int lane) { return ((lane & 3) << 3) | (((lane >> 2) & 3) << 6) | (((lane >> 4) & 1) << 5) | (((lane >> 5) & 1) << 8); }
__device__ __forceinline__ int crow(int r, int hi) { return (r & 3) + 8 * (r >> 2) + 4 * hi; }
typedef float cvtpk_f32x2 __attribute__((ext_vector_type(2))); typedef __bf16 cvtpk_bf16x2 __attribute__((ext_vector_type(2)));
__device__ __forceinline__ unsigned cvtpk(float lo, float hi) { const cvtpk_f32x2 v = {lo, hi}; const cvtpk_bf16x2 b = __builtin_convertvector(v, cvtpk_bf16x2); return __builtin_bit_cast(unsigned, b); }

__device__ __forceinline__ float wave_max_f(float v) {
#pragma unroll
    for (int o = 32; o >= 1; o >>= 1) v = fmaxf(v, __shfl_xor(v, o));
    return v;
}
__device__ __forceinline__ float att_max3(float a, float b, float c) { return __builtin_fmaxf(__builtin_fmaxf(a, b), c); }
typedef float f32x16v __attribute__((ext_vector_type(16)));
typedef unsigned u32x6v __attribute__((ext_vector_type(6)));
constexpr int ROW6 = 1536;
__device__ __forceinline__ void fp6_put(unsigned char* __restrict__ T6, int row, int hf, int l, int g, f32x16v f0, f32x16v f1, float sc) {
    f0 *= sc; f1 *= sc;
    f32x16v ev, od;
#pragma unroll
    for (int k = 0; k < 8; ++k) { ev[k] = f0[2 * k]; od[k] = f0[2 * k + 1]; ev[8 + k] = f1[2 * k]; od[8 + k] = f1[2 * k + 1]; }
    const u32x6v w = __builtin_amdgcn_cvt_scalef32_2xpk16_fp6_f32(ev, od, 1.0f);
    unsigned char* base = T6 + (size_t)row * ROW6 + hf * 768 + l * 16;
    if (g == 0) { *(u32x4*)base = (u32x4){w[0], w[1], w[2], w[3]}; *(uint2*)(base + 256) = make_uint2(w[4], w[5]); }
    else { *(uint2*)(base + 264) = make_uint2(w[0], w[1]); *(u32x4*)(base + 512) = (u32x4){w[2], w[3], w[4], w[5]}; }
}
constexpr int SIDE_STG = 86016;
template <int DK, bool FOX, bool NOMAX>
__device__ __forceinline__ void attn_block(unsigned char* smem, const bf16_t* __restrict__ Q, int ldq, const bf16_t* __restrict__ K, int ldk, const bf16_t* __restrict__ V, int ldv,
                                           const float* __restrict__ Fh, const bf16_t* __restrict__ gate, bf16_t* __restrict__ gout  , int qbk, const float* __restrict__ gq, const float* __restrict__ gk  ,
                                           const float* __restrict__ side_u, const float* __restrict__ side_v, unsigned char* __restrict__ side_u8, unsigned char* __restrict__ side_v8, int& side_next) {
    typedef Lay<DK> LY;
    constexpr int ND = DK / 16, NKC = DK / 8, NKI = (64 * NKC) / 512;
    int tid = threadIdx.x; asm volatile("" : "+v"(tid));
    const int wid = __builtin_amdgcn_readfirstlane(tid >> 6), lane = tid & 63, r32 = lane & 31, hi = lane >> 5;
    const int q0 = qbk * 256, qlo = q0 + wid * 32, qm = qlo + r32 - 4 * hi;
    const int NT = 4 * qbk + 4;
    ALAS unsigned char* lds = (ALAS unsigned char*)smem;
    ALAS float* F_lds = (ALAS float*)(lds + LY::OFF_F);
    ALAS float* wsl = (ALAS float*)(lds + LY::OFF_WS) + wid * 64;
    bf16x8 qr[ND];
#pragma unroll
    for (int d0 = 0; d0 < ND; ++d0) qr[d0] = *(const bf16x8*)(Q + (size_t)(qlo + r32) * ldq + d0 * 16 + hi * 8);
    const float fq = FOX ? Fh[qlo + r32] : 0.f;
    int kgo[NKI], vgo[2];
#pragma unroll
    for (int i = 0; i < NKI; ++i) { const int pp = (wid * NKI + i) * 64 + lane, row = pp / NKC, cpos = pp % NKC, ch = cpos ^ ((row >> 1) & 7); kgo[i] = row * ldk + ch * 8; }
#pragma unroll
    for (int i = 0; i < 2; ++i) { const int o = ((wid * 2 + i) * 64 + lane) * 16, st = o >> 9, e = (o & 511) >> 1, kk = (st >> 2) * 8 + (e >> 5), c = (st & 3) * 32 + (e & 31);
        const int k = (kk & ~0xC) | ((kk & 4) << 1) | ((kk & 8) >> 1); vgo[i] = k * ldv + c; }
    const int vb0 = (int)(uintptr_t)smem + v_rd_base(lane);
    int kbase[4];
#pragma unroll
    for (int dd = 0; dd < 4; ++dd) kbase[dd] = LY::OFF_K + r32 * LY::ROWB + (((((dd << 1) | hi) ^ ((r32 >> 1) & 7))) << 4);
    float stf = 0.f;
#define ATT_GLDS(kb, bf) do { _Pragma("unroll") for (int i = 0; i < NKI; ++i) \
            __builtin_amdgcn_global_load_lds((const unsigned*)(K + (size_t)(kb) * ldk + kgo[i]), (ALAS unsigned*)(lds + LY::OFF_K + (bf) * LY::SHM_K + (wid * NKI + i) * 1024), 16, 0, 0); \
        _Pragma("unroll") for (int i = 0; i < 2; ++i) \
            __builtin_amdgcn_global_load_lds((const unsigned*)(V + (size_t)(kb) * ldv + vgo[i]), (ALAS unsigned*)(lds + (bf) * SHM_V + (wid * 2 + i) * 1024), 16, 0, 0); \
        if (FOX && tid < 64) stf = Fh[(kb) + tid]; } while (0)
#define ATT_WRITEF(bf) do { if (FOX && tid < 64) F_lds[(bf) * 64 + tid] = stf; } while (0)
    int t_start = 0; float m_init = 0.f;
    if (FOX) {
        const float gqm = wave_max_f(fmaxf(fabsf(gq[lane]), fabsf(gq[lane + 64]))), gkm = wave_max_f(fmaxf(fabsf(gk[lane]), fabsf(gk[lane + 64])));
        const float qk_bound = 0.12751743f * 128.f * gqm * gkm;
        const float thr = 2.02f * qk_bound + 40.f, f0 = Fh[q0]; m_init = -thr;
        const int j0 = lane, j1 = lane + 64;
        const bool c0 = (j0 < 4 * qbk) && (Fh[j0 * 64 + 63] - f0 >= thr), c1 = (j1 < 4 * qbk) && (Fh[(j1 < 4 * qbk ? j1 : 0) * 64 + 63] - f0 >= thr);
        t_start = __builtin_popcountll(__ballot(c0)) + __builtin_popcountll(__ballot(c1));
        t_start = __builtin_amdgcn_readfirstlane(t_start); }
    ATT_GLDS(t_start * 64, t_start & 1); ATT_WRITEF(t_start & 1);
    float m_reg = FOX ? m_init : 0.f, l_reg = 0.f; f32x16 o[4];
#pragma unroll
    for (int d = 0; d < 4; ++d)
#pragma unroll
        for (int r = 0; r < 16; ++r) o[d][r] = 0.f;
    int side_pend = -1;
    for (int t = t_start; t < NT; ++t) {
        const int buf = t & 1, kb = t * 64;
        asm volatile("s_waitcnt vmcnt(0)" ::: "memory");
        __syncthreads();
        if (t + 1 < NT) ATT_GLDS(kb + 64, buf ^ 1);
        if (side_pend >= 0) { const int sv = side_pend; side_pend = -1;
            if ((wid >> 2) == (sv & 1)) {
                const int c = tid & 255, rr = c >> 6, hf2 = (c >> 5) & 1, l = (c >> 1) & 15, g = c & 1;
                const ALAS float* sp = (const ALAS float*)(lds + SIDE_STG) + rr * 2048 + hf2 * 1024 + (2 * g) * 256 + l * 16;
                f32x16v f0, f1;
#pragma unroll
                for (int k = 0; k < 4; ++k) { const f32x4 a = *(const ALAS f32x4*)(sp + 4 * k), b2 = *(const ALAS f32x4*)(sp + 256 + 4 * k);
#pragma unroll
                    for (int e = 0; e < 4; ++e) { f0[4 * k + e] = a[e]; f1[4 * k + e] = b2[e]; } }
                const bool isv = sv >= 16;
                fp6_put(isv ? side_v8 : side_u8, blockIdx.x * 64 + (sv & 15) * 4 + rr, hf2, l, g, f0, f1, isv ? 4.f : 64.f); }
        } else if (side_next < 32 && t + 1 < NT) { const int sv = side_next; const bool isv = sv >= 16;
            const float* src = (isv ? side_v : side_u) + (size_t)(blockIdx.x * 64 + (sv & 15) * 4) * 2048;
#pragma unroll
            for (int i = 0; i < 4; ++i)
                __builtin_amdgcn_global_load_lds((const unsigned*)(src + ((i * 8 + wid) * 64 + lane) * 4), (ALAS unsigned*)(lds + SIDE_STG + (i * 8 + wid) * 1024), 16, 0, 0);
            side_pend = sv; ++side_next; }
        f32x16 p0, p1;
        if (FOX) { const float fqm = NOMAX ? fq : fq - m_reg;
#pragma unroll
            for (int g = 0; g < 4; ++g) { const f32x4 f0 = *(const ALAS f32x4*)(F_lds + buf * 64 + 8 * g + 4 * hi), f1 = *(const ALAS f32x4*)(F_lds + buf * 64 + 32 + 8 * g + 4 * hi);
#pragma unroll
                for (int e = 0; e < 4; ++e) { p0[4 * g + e] = fqm - f0[e]; p1[4 * g + e] = fqm - f1[e]; } }
        } else if (NOMAX) {
#pragma unroll
            for (int r = 0; r < 16; ++r) { p0[r] = 0.f; p1[r] = 0.f; }
        } else { const float nm = -m_reg;
#pragma unroll
            for (int r = 0; r < 16; ++r) { p0[r] = nm; p1[r] = nm; }
        }
        {
            constexpr int KPF = 2;
            int ka[4];
#pragma unroll
            for (int dd = 0; dd < 4; ++dd) ka[dd] = (int)(uintptr_t)smem + buf * LY::SHM_K + kbase[dd];
            bf16x8 kb0[KPF + 1], kb1[KPF + 1];
#define ATT_KRD(dst, addr, off) asm volatile("ds_read_b128 %0, %1 offset:%2" : "=&v"(dst) : "v"(addr), "i"(off) : "memory")
#pragma unroll
            for (int d0 = 0; d0 < KPF; ++d0) { ATT_KRD(kb0[d0 % (KPF + 1)], ka[d0 & 3], (d0 >> 2) * 128); ATT_KRD(kb1[d0 % (KPF + 1)], ka[d0 & 3], (d0 >> 2) * 128 + 32 * LY::ROWB); }
#pragma unroll
            for (int d0 = 0; d0 < ND; ++d0) {
                if (d0 + KPF < ND) { constexpr int dummy = 0; (void)dummy;
                    ATT_KRD(kb0[(d0 + KPF) % (KPF + 1)], ka[(d0 + KPF) & 3], ((d0 + KPF) >> 2) * 128); ATT_KRD(kb1[(d0 + KPF) % (KPF + 1)], ka[(d0 + KPF) & 3], ((d0 + KPF) >> 2) * 128 + 32 * LY::ROWB); }
                const int rem = (ND - 1 - d0) < KPF ? (ND - 1 - d0) : KPF;
                if (rem >= 2) asm volatile("s_waitcnt lgkmcnt(4)" ::: "memory");
                else if (rem == 1) asm volatile("s_waitcnt lgkmcnt(2)" ::: "memory");
                else asm volatile("s_waitcnt lgkmcnt(0)" ::: "memory");
                ASBAR();
                p0 = __builtin_amdgcn_mfma_f32_32x32x16_bf16(kb0[d0 % (KPF + 1)], qr[d0], p0, 0, 0, 0);
                p1 = __builtin_amdgcn_mfma_f32_32x32x16_bf16(kb1[d0 % (KPF + 1)], qr[d0], p1, 0, 0, 0);
            }
#undef ATT_KRD
        }
        if (kb + 63 > qlo) {
            const float NEG = -__builtin_inff(); const int dq = qm - kb;
#pragma unroll
            for (int r = 0; r < 16; ++r) { const int c = (r & 3) + 8 * (r >> 2); if (dq - c < 0) p0[r] = NEG; if (dq - c - 32 < 0) p1[r] = NEG; }
        }
        float alpha = 1.f;
        if (!NOMAX) {
        float pmax;
        { float a = att_max3(p0[0], p0[1], p1[0]), b = att_max3(p0[2], p0[3], p1[1]); a = att_max3(a, p1[2], p1[3]);
#pragma unroll
          for (int r = 4; r < 16; r += 4) { a = att_max3(a, p0[r], p0[r + 1]); b = att_max3(b, p0[r + 2], p0[r + 3]); a = att_max3(a, p1[r], p1[r + 1]); b = att_max3(b, p1[r + 2], p1[r + 3]); }
          pmax = fmaxf(a, b); }
        { auto rr = __builtin_amdgcn_permlane32_swap(__float_as_uint(pmax), __float_as_uint(pmax), false, false);
          pmax = fmaxf(__uint_as_float(rr[0]), __uint_as_float(rr[1])); }
        if (!__builtin_expect(__all(pmax <= 8.f), 1)) { const float dm = fmaxf(pmax, 0.f); alpha = __builtin_amdgcn_exp2f(-dm); m_reg += dm;
#pragma unroll
            for (int r = 0; r < 16; ++r) { p0[r] -= dm; p1[r] -= dm; } }
        }
        float ps = 0.f;
#pragma unroll
        for (int r = 0; r < 16; ++r) { p0[r] = __builtin_amdgcn_exp2f(p0[r]); ps += p0[r]; }
#pragma unroll
        for (int r = 0; r < 16; ++r) { p1[r] = __builtin_amdgcn_exp2f(p1[r]); ps += p1[r]; }
        { auto rr = __builtin_amdgcn_permlane32_swap(__float_as_uint(ps), __float_as_uint(ps), false, false);
          ps = __uint_as_float(rr[0]) + __uint_as_float(rr[1]); }
        l_reg = NOMAX ? l_reg + ps : l_reg * alpha + ps;
        bf16x8 pa0, pa1, pa2, pa3;
#define ATT_PK4(P, B_, OUT) do { unsigned a0 = cvtpk(P[B_+0], P[B_+1]), a1 = cvtpk(P[B_+2], P[B_+3]); unsigned b0_ = cvtpk(P[B_+4], P[B_+5]), b1_ = cvtpk(P[B_+6], P[B_+7]); \
        auto r0 = __builtin_amdgcn_permlane32_swap(a0, b0_, false, false); auto r1 = __builtin_amdgcn_permlane32_swap(a1, b1_, false, false); \
        u32x4 w = {r0[0], r1[0], r0[1], r1[1]}; OUT = *reinterpret_cast<bf16x8*>(&w); } while (0)
        ATT_PK4(p0, 0, pa0); ATT_PK4(p0, 8, pa1); ATT_PK4(p1, 0, pa2); ATT_PK4(p1, 8, pa3);
        if (!NOMAX && __any(alpha < 1.f)) {
            if (hi == 0) wsl[r32] = alpha;
            asm volatile("s_waitcnt lgkmcnt(0)" ::: "memory");
#pragma unroll
            for (int g = 0; g < 4; ++g) { const f32x4 al = *(const ALAS f32x4*)(wsl + 8 * g + 4 * hi);
#pragma unroll
                for (int d = 0; d < 4; ++d)
#pragma unroll
                    for (int e = 0; e < 4; ++e) o[d][4 * g + e] *= al[e]; }
        }
#define ATT_TRRD(dst, off) asm volatile("ds_read_b64_tr_b16 %0, %1 offset:%2" : "=&v"(dst) : "v"(vbb), "i"(off) : "memory")
#define ATT_PV(d0) do { s16x4 l0, l1, l2, l3, h0, h1, h2, h3; constexpr int b_ = (d0) * 512; \
        ATT_TRRD(l0, b_); ATT_TRRD(h0, b_ + 2048); ATT_TRRD(l1, b_ + 4096); ATT_TRRD(h1, b_ + 6144); ATT_TRRD(l2, b_ + 8192); ATT_TRRD(h2, b_ + 10240); ATT_TRRD(l3, b_ + 12288); ATT_TRRD(h3, b_ + 14336); \
        asm volatile("s_waitcnt lgkmcnt(0)" ::: "memory"); ASBAR(); \
        o[d0] = __builtin_amdgcn_mfma_f32_32x32x16_bf16(pa0, (bf16x8){l0[0], l0[1], l0[2], l0[3], h0[0], h0[1], h0[2], h0[3]}, o[d0], 0, 0, 0); \
        o[d0] = __builtin_amdgcn_mfma_f32_32x32x16_bf16(pa1, (bf16x8){l1[0], l1[1], l1[2], l1[3], h1[0], h1[1], h1[2], h1[3]}, o[d0], 0, 0, 0); \
        o[d0] = __builtin_amdgcn_mfma_f32_32x32x16_bf16(pa2, (bf16x8){l2[0], l2[1], l2[2], l2[3], h2[0], h2[1], h2[2], h2[3]}, o[d0], 0, 0, 0); \
        o[d0] = __builtin_amdgcn_mfma_f32_32x32x16_bf16(pa3, (bf16x8){l3[0], l3[1], l3[2], l3[3], h3[0], h3[1], h3[2], h3[3]}, o[d0], 0, 0, 0); } while (0)
        { const int vbb = vb0 + buf * SHM_V; ATT_PV(0); ATT_PV(1); ATT_PV(2); ATT_PV(3); }
        if (t + 1 < NT) ATT_WRITEF(buf ^ 1);
    }
    if (hi == 0) wsl[r32] = l_reg;
    asm volatile("s_waitcnt lgkmcnt(0)" ::: "memory");
#pragma unroll
    for (int rh = 0; rh < 16; rh += 8) {
        unsigned gv[8][4];
#pragma unroll
        for (int r = 0; r < 8; ++r) { const bf16_t* growp = gate + (size_t)(qlo + crow(rh + r, hi)) * 4096 + (r32 & ~1);
#pragma unroll
            for (int d0 = 0; d0 < 4; ++d0) gv[r][d0] = *(const unsigned*)(growp + d0 * 32); }
#pragma unroll
        for (int r = 0; r < 8; ++r) { const int orow = crow(rh + r, hi); const float rli = __builtin_amdgcn_rcpf(wsl[orow]);
            bf16_t* rowp = gout + (size_t)(qlo + orow) * 4096;
#pragma unroll
            for (int d0 = 0; d0 < 4; ++d0) {
                const float v = o[d0][rh + r] * rli; const float vn = __shfl_xor(v, 1); const unsigned g = gv[r][d0];
                const bool ev = (r32 & 1) == 0; const float ve = ev ? v : vn, vo = ev ? vn : v;
                *(unsigned*)(rowp + d0 * 32 + (r32 & ~1)) = cvtpk(ve * __uint_as_float(g << 16), vo * __uint_as_float(g & 0xffff0000u)); }
        }
    }
    __syncthreads();
#undef ATT_GLDS
#undef ATT_WRITEF
#undef ATT_PK4
#undef ATT_TRRD
#undef ATT_PV
}
}
using pg8::bf16_t; using pg8::f32x4; using pg8::u32x4;
#define LAS __attribute__((address_space(3)))
constexpr int S = 8192, DM = 2048, INW = 11344, INWP = 11520;
constexpr float EPS = 1e-6f;
constexpr size_t MiB = 1u << 20;

__device__ __forceinline__ float bf2f(bf16_t v) { return __uint_as_float(((unsigned)v) << 16); }
__device__ __forceinline__ bf16_t f2bf(float f) { unsigned u = __float_as_uint(f); u += 0x7fffu + ((u >> 16) & 1u); return (bf16_t)(u >> 16); }
__device__ __forceinline__ unsigned pk2(float lo, float hi) { return (unsigned)f2bf(lo) | ((unsigned)f2bf(hi) << 16); }
__device__ __forceinline__ float wave_sum(float v) {
#pragma unroll
    for (int o = 32; o >= 1; o >>= 1) v += __shfl_xor(v, o);
    return v;
}
__device__ __forceinline__ float wave_max(float v) {
#pragma unroll
    for (int o = 32; o >= 1; o >>= 1) v = fmaxf(v, __shfl_xor(v, o));
    return v;
}

__device__ __forceinline__ int opaque_tid() { int t = threadIdx.x; asm volatile("" : "+v"(t)); return t; }

struct Params {
    const float* x; const int* pos; const float *mix_g, *w_in, *b_forget, *b_gate, *q_lat_g, *w_q_up, *kv_lat_g, *w_kv_up, *mla_qg, *mla_kg, *fox_qg, *fox_kg, *w_out, *ffn_g, *w_peer_q, *sub_keys, *peer_u, *peer_v;
    float* out;
    bf16_t *WqT, *WkvT, *WoT, *WpT, *WinT;
    bf16_t *h, *cq, *ckv, *fq, *fk, *fv, *merged, *kpe, *qa, *va, *ka;
    float *lf, *F, *x1, *scores;
    unsigned char *U8, *V8; bf16_t* attout;
    unsigned* ctl;
    float2* ropeT; float* ssq; float* ssq2; bf16_t* xg;
};

struct DstId { __device__ __forceinline__ int operator()(int n) const { return n; } };
struct DstWin { __device__ __forceinline__ int operator()(int n) const {
    if (n < 1024) return n; if (n < 1088) { const int r = n - 1024; return 11264 + 2 * (r & 31) + (r >> 5); } if (n < 7232) return n - 64; if (n < 7248) return 11264 + 64 + (n - 7232); return n - 80; } };
struct DstQ { __device__ __forceinline__ int operator()(int n) const {
    const int h = n / 192, d = n - h * 192; if (d < 128) return h * 256 + d; const int r = d - 128; return h * 256 + 128 + 2 * (r & 31) + (r >> 5); } };
template <class Dst>
__device__ __forceinline__ void transpose_item(const float* __restrict__ W, int K, int N, bf16_t* __restrict__ WT, Dst dst, float* scr, int item, int lane, const float* __restrict__ gk = nullptr) {
    const int nblk = (N + 31) / 32, kb = item / nblk, nb = item % nblk, k0 = 64 * kb, n0 = 32 * nb;
    { const int rr = lane >> 3, c4 = (lane & 7) * 4; const bool ok = (n0 + c4) < N;
      f32x4 v[8];
#pragma unroll
      for (int i = 0; i < 8; ++i) v[i] = ok ? *(const f32x4*)(W + (size_t)(k0 + 8 * i + rr) * N + n0 + c4) : (f32x4){0.f, 0.f, 0.f, 0.f};
      if (gk) {
#pragma unroll
          for (int i = 0; i < 8; ++i) v[i] *= gk[k0 + 8 * i + rr]; }
#pragma unroll
      for (int i = 0; i < 8; ++i) { float* sp = scr + (8 * i + rr) * 33 + c4; sp[0] = v[i][0]; sp[1] = v[i][1]; sp[2] = v[i][2]; sp[3] = v[i][3]; } }
    asm volatile("s_waitcnt lgkmcnt(0)" ::: "memory");
    const int c = lane & 7;
#pragma unroll
    for (int j = 0; j < 4; ++j) { const int nl = (lane >> 3) + 8 * j, n = n0 + nl; const float* s = scr + (8 * c) * 33 + nl;
        u32x4 o; o.x = pk2(s[0 * 33], s[1 * 33]); o.y = pk2(s[2 * 33], s[3 * 33]); o.z = pk2(s[4 * 33], s[5 * 33]); o.w = pk2(s[6 * 33], s[7 * 33]);
        if (n < N) *(u32x4*)(WT + (size_t)dst(n) * K + k0 + 8 * c) = o; }
    asm volatile("s_waitcnt lgkmcnt(0)" ::: "memory");
}
typedef __bf16 wf_bf16x8 __attribute__((ext_vector_type(8)));
typedef float wf_f32x8 __attribute__((ext_vector_type(8)));
__device__ __forceinline__ void wf_split(const f32x4 x0, const f32x4 x1, wf_bf16x8& hi, wf_bf16x8& lo) {
    const wf_f32x8 x = {x0[0], x0[1], x0[2], x0[3], x1[0], x1[1], x1[2], x1[3]};
    hi = __builtin_convertvector(x, wf_bf16x8);
    const wf_f32x8 r = x - __builtin_convertvector(hi, wf_f32x8);
    lo = __builtin_convertvector(r, wf_bf16x8);
}
__device__ __forceinline__ void wfold_item(const float* __restrict__ wq, const float* __restrict__ keys, bf16_t* __restrict__ WpT, float* sm, int item) {
    (void)sm;
    const int tid = opaque_tid(), lane = tid & 63, wave = tid >> 6, hc = item >> 5, d0 = (item & 31) * 64, m = lane & 15, kg = lane >> 4;
    f32x4 acc[4];
#pragma unroll
    for (int c = 0; c < 4; ++c) acc[c] = (f32x4){0.f, 0.f, 0.f, 0.f};
#pragma unroll
    for (int s4 = 0; s4 < 4; ++s4) {
        const float* kp = keys + (size_t)hc * 16384 + (16 * wave + m) * 128 + 32 * s4 + 8 * kg;
        wf_bf16x8 bh, bl; wf_split(*(const f32x4*)kp, *(const f32x4*)(kp + 4), bh, bl);
#pragma unroll
        for (int c = 0; c < 4; ++c) { const float* ap = wq + (size_t)(d0 + 16 * c + m) * 2048 + hc * 128 + 32 * s4 + 8 * kg;
            wf_bf16x8 ah, al; wf_split(*(const f32x4*)ap, *(const f32x4*)(ap + 4), ah, al);
            acc[c] = __builtin_amdgcn_mfma_f32_16x16x32_bf16(ah, bh, acc[c], 0, 0, 0);
            acc[c] = __builtin_amdgcn_mfma_f32_16x16x32_bf16(ah, bl, acc[c], 0, 0, 0);
            acc[c] = __builtin_amdgcn_mfma_f32_16x16x32_bf16(al, bh, acc[c], 0, 0, 0); }
    }
#pragma unroll
    for (int c = 0; c < 4; ++c) { uint2 o; o.x = pk2(acc[c][0], acc[c][1]); o.y = pk2(acc[c][2], acc[c][3]);
        *(uint2*)(WpT + (size_t)(hc * 128 + 16 * wave + m) * 2048 + d0 + 16 * c + 4 * kg) = o; }
}
__device__ __forceinline__ void rms_row2048(const float* __restrict__ xr, const float* __restrict__ g, bf16_t* __restrict__ orow, int lane) {
    f32x4 v[8]; float ss = 0.f;
#pragma unroll
    for (int j = 0; j < 8; ++j) { v[j] = *(const f32x4*)(xr + j * 256 + lane * 4); ss += (v[j][0] * v[j][0] + v[j][1] * v[j][1]) + (v[j][2] * v[j][2] + v[j][3] * v[j][3]); }
    const float r = rsqrtf(wave_sum(ss) * (1.f / 2048.f) + EPS);
#pragma unroll
    for (int j = 0; j < 8; ++j) { const f32x4 gg = *(const f32x4*)(g + j * 256 + lane * 4);
        uint2 o; o.x = pk2(v[j][0] * r * gg[0], v[j][1] * r * gg[1]); o.y = pk2(v[j][2] * r * gg[2], v[j][3] * r * gg[3]);
        *(uint2*)(orow + j * 256 + lane * 4) = o; }
}
__device__ __forceinline__ void fox_cumsum(double* part, int h, const float* __restrict__ lf, float* __restrict__ F) {
    const int tid = opaque_tid(), lane = tid & 63, wave = tid >> 6;
    float v[16]; double sum = 0.0;
#pragma unroll
    for (int i = 0; i < 16; ++i) { v[i] = lf[(size_t)(tid * 16 + i) * 16 + h]; sum += (double)v[i]; }
    double inc = sum;
#pragma unroll
    for (int o = 1; o < 64; o <<= 1) { const double n = __shfl_up(inc, o); if (lane >= o) inc += n; }
    if (lane == 63) part[wave] = inc;
    __syncthreads();
    double base = 0.0;
    for (int w = 0; w < wave; ++w) base += part[w];
    double run = base + inc - sum;
#pragma unroll
    for (int i = 0; i < 16; ++i) { run += (double)v[i]; F[(size_t)h * S + tid * 16 + i] = (float)(run * 1.4426950408889634); }
    __syncthreads();
}
__device__ __forceinline__ void rope_table(const int* __restrict__ pos, float2* __restrict__ ropeT, int gtid, int nthreads) {
    for (int idx = gtid; idx < S * 32; idx += nthreads) { const int t = idx >> 5, i = idx & 31;
        const double inv = exp(-(double)i * (1.0 / 32.0) * 9.210340371976184);
        double ang = (double)((float)pos[t] * (float)inv);
        const double twopi = 6.283185307179586;
        ang -= twopi * rint(ang / twopi);
        ropeT[idx] = make_float2(cosf((float)ang), sinf((float)ang)); }
}
typedef float f32x2 __attribute__((ext_vector_type(2)));
__device__ __forceinline__ unsigned pk4_fp8(float a, float b, float c, float d) {
    int w = __builtin_amdgcn_cvt_pk_fp8_f32(fminf(fmaxf(a, -448.f), 448.f), fminf(fmaxf(b, -448.f), 448.f), 0, false);
    w = __builtin_amdgcn_cvt_pk_fp8_f32(fminf(fmaxf(c, -448.f), 448.f), fminf(fmaxf(d, -448.f), 448.f), w, true); return (unsigned)w; }
__device__ __forceinline__ void cvt_rows_fp8(const float* __restrict__ src, unsigned char* __restrict__ dst, size_t n, float scale, int gw, int NGW, int lane) {
    const size_t nchunk = n / 1024;
    for (size_t c = gw; c < nchunk; c += NGW) { const size_t o = c * 1024 + lane * 16;
        f32x4 a[4];
#pragma unroll
        for (int q = 0; q < 4; ++q) a[q] = *(const f32x4*)(src + o + 4 * q) * scale;
        u32x4 w; w.x = pk4_fp8(a[0][0], a[0][1], a[0][2], a[0][3]); w.y = pk4_fp8(a[1][0], a[1][1], a[1][2], a[1][3]);
        w.z = pk4_fp8(a[2][0], a[2][1], a[2][2], a[2][3]); w.w = pk4_fp8(a[3][0], a[3][1], a[3][2], a[3][3]);
        *(u32x4*)(dst + o) = w; }
}
constexpr float U_SCALE = 64.f, V_SCALE = 4.f;
typedef __bf16 bf16x2_t __attribute__((ext_vector_type(2)));
__device__ __forceinline__ float dot2bf(unsigned a, unsigned b, float c) { return __builtin_amdgcn_fdot2_f32_bf16(__builtin_bit_cast(bf16x2_t, a), __builtin_bit_cast(bf16x2_t, b), c, false); }
#define PEER_INS(top, x) do { float x_ = (x); _Pragma("unroll") for (int i_ = 0; i_ < 16; ++i_) { const float hi_ = fmaxf(top[i_], x_); x_ = fminf(top[i_], x_); top[i_] = hi_; } } while (0)
__device__ __forceinline__ void fp6_cvt_rows(const float* __restrict__ src, unsigned char* __restrict__ T6, int row0, int nrows, float sc, int t, int nt) {
    for (int u = t; u < nrows * 64; u += nt) { const int rr = u >> 6, hf = (u >> 5) & 1, l = (u >> 1) & 15, g = u & 1;
        const float* s0 = src + (size_t)(row0 + rr) * 2048 + hf * 1024 + (2 * g) * 256 + l * 16;
        att::f32x16v f0, f1;
#pragma unroll
        for (int k = 0; k < 4; ++k) { const f32x4 a = *(const f32x4*)(s0 + 4 * k), b2 = *(const f32x4*)(s0 + 256 + 4 * k);
#pragma unroll
            for (int e = 0; e < 4; ++e) { f0[4 * k + e] = a[e]; f1[4 * k + e] = b2[e]; } }
        att::fp6_put(T6, row0 + rr, hf, l, g, f0, f1, sc); }
}
typedef float f32x32v __attribute__((ext_vector_type(32)));
__device__ __forceinline__ void peer_group(unsigned char* smem, int g, const float* __restrict__ scores, const bf16_t* __restrict__ h2  , const float* __restrict__ ssq2, const float* __restrict__ x1,
                                           const unsigned char* __restrict__ U8, const unsigned char* __restrict__ V8, float* __restrict__ out) {
    const int tid = opaque_tid(), lane = tid & 63, wave = __builtin_amdgcn_readfirstlane(tid >> 6);
    float* topL = (float*)smem;
    int* selE = (int*)(smem + 32768);
    float* selG = (float*)(smem + 49152);
    {
        const int tl = tid >> 4, hc = tid & 15;
        const float* sp = scores + (size_t)(g * 32 + tl) * 2048 + hc * 128;
#define PEER_CE(a, b) do { const float hi_ = fmaxf(a, b), lo_ = fminf(a, b); a = hi_; b = lo_; } while (0)
        float top[16];
#pragma unroll 1
        for (int gi = 0; gi < 8; ++gi) {
            float gr[16];
#pragma unroll
            for (int q = 0; q < 4; ++q) { const f32x4 v = *(const f32x4*)(sp + gi * 16 + q * 4);
#pragma unroll
                for (int e = 0; e < 4; ++e) gr[q * 4 + e] = __uint_as_float((__float_as_uint(v[e]) & ~0x7Fu) | (unsigned)(gi * 16 + q * 4 + e)); }
#pragma unroll
            for (int k = 2; k <= 16; k <<= 1)
#pragma unroll
                for (int j = k >> 1; j > 0; j >>= 1)
#pragma unroll
                    for (int i = 0; i < 16; ++i) { const int l = i ^ j; if (l > i) { if ((i & k) == 0) PEER_CE(gr[i], gr[l]); else PEER_CE(gr[l], gr[i]); } }
            if (gi == 0) {
#pragma unroll
                for (int i = 0; i < 16; ++i) top[i] = gr[i];
            } else {
#pragma unroll
                for (int i = 0; i < 16; ++i) top[i] = fmaxf(top[i], gr[15 - i]);
#pragma unroll
                for (int j = 8; j > 0; j >>= 1)
#pragma unroll
                    for (int i = 0; i < 16; ++i) { const int l = i ^ j; if (l > i) PEER_CE(top[i], top[l]); }
            }
        }
#undef PEER_CE
        float* tp = topL + (tl * 16 + hc) * 16;
#pragma unroll
        for (int i = 0; i < 16; i += 4) *(f32x4*)(tp + i) = (f32x4){top[i], top[i + 1], top[i + 2], top[i + 3]};
    }
    __syncthreads();
    if (tid < 256) {
        const int tl = tid >> 3, h = tid & 7;
        const float* t1 = topL + (tl * 16 + 2 * h) * 16; const float* t2 = t1 + 16;
        float s1[16], s2[16];
#pragma unroll
        for (int i = 0; i < 16; i += 4) { const f32x4 a = *(const f32x4*)(t1 + i), b2 = *(const f32x4*)(t2 + i);
            s1[i] = a[0]; s1[i + 1] = a[1]; s1[i + 2] = a[2]; s1[i + 3] = a[3]; s2[i] = b2[0]; s2[i + 1] = b2[1]; s2[i + 2] = b2[2]; s2[i + 3] = b2[3]; }
#define PEER_CE(a, b) do { const float hi_ = fmaxf(a, b), lo_ = fminf(a, b); a = hi_; b = lo_; } while (0)
#define PEER_KEY(i, j) __uint_as_float((__float_as_uint(s1[i] + s2[j]) & ~0xFFu) | (unsigned)((i) * 16 + (j)))
        float ts[16], cand[34];
#pragma unroll
        for (int j = 0; j < 16; ++j) ts[j] = PEER_KEY(0, j);
        { int n = 0;
#pragma unroll
          for (int i = 1; i < 16; ++i)
#pragma unroll
              for (int j = 0; j < 8; ++j)
                  if ((i + 1) * (j + 1) <= 16) cand[n++] = PEER_KEY(i, j); }
#pragma unroll
        for (int gi = 0; gi < 2; ++gi) { float gr[16];
#pragma unroll
            for (int i = 0; i < 16; ++i) gr[i] = cand[gi * 16 + i];
#pragma unroll
            for (int k = 2; k <= 16; k <<= 1)
#pragma unroll
                for (int j = k >> 1; j > 0; j >>= 1)
#pragma unroll
                    for (int i = 0; i < 16; ++i) { const int l = i ^ j; if (l > i) { if ((i & k) == 0) PEER_CE(gr[i], gr[l]); else PEER_CE(gr[l], gr[i]); } }
#pragma unroll
            for (int i = 0; i < 16; ++i) ts[i] = fmaxf(ts[i], gr[15 - i]);
#pragma unroll
            for (int j = 8; j > 0; j >>= 1)
#pragma unroll
                for (int i = 0; i < 16; ++i) { const int l = i ^ j; if (l > i) PEER_CE(ts[i], ts[l]); } }
        PEER_INS(ts, cand[32]); PEER_INS(ts, cand[33]);
#undef PEER_CE
#undef PEER_KEY
        float ex[16], sum = 0.f;
#pragma unroll
        for (int k = 0; k < 16; ++k) { ex[k] = __expf(ts[k] - ts[0]); sum += ex[k]; }
        const float inv = 1.f / sum;
#pragma unroll
        for (int k = 0; k < 16; ++k) { const unsigned pos = __float_as_uint(ts[k]) & 0xFFu;
            const int i1 = (int)(__float_as_uint(t1[pos >> 4]) & 0x7Fu), i2 = (int)(__float_as_uint(t2[pos & 15]) & 0x7Fu);
            selE[tl * 128 + h * 16 + k] = i1 * 128 + i2; selG[tl * 128 + h * 16 + k] = ex[k] * inv; }
    }
    __syncthreads();
    const int grp = lane >> 4, l16 = lane & 15, tl = wave * 4 + grp;
    unsigned* sortK = (unsigned*)(smem + 65536) + tl * 128;
    float* wS = (float*)(smem + 81920) + tl * 128;
    unsigned* hist = (unsigned*)(smem + 98304) + wave * 512 + grp * 64;
    {
#pragma unroll
        for (int i = 0; i < 4; ++i) hist[l16 * 4 + i] = 0u;
        asm volatile("s_waitcnt lgkmcnt(0)" ::: "memory");
        unsigned ek[8], rk[8];
#pragma unroll
        for (int j = 0; j < 8; ++j) { ek[j] = (unsigned)selE[tl * 128 + l16 + 16 * j]; rk[j] = atomicAdd(&hist[ek[j] >> 8], 1u); }
        asm volatile("s_waitcnt lgkmcnt(0)" ::: "memory");
        unsigned c[4], tot = 0u;
#pragma unroll
        for (int i = 0; i < 4; ++i) { c[i] = hist[l16 * 4 + i]; tot += c[i]; }
        unsigned inc = tot;
#pragma unroll
        for (int o = 1; o < 16; o <<= 1) { const unsigned n = __shfl_up(inc, o, 16); if (l16 >= o) inc += n; }
        unsigned run = inc - tot;
#pragma unroll
        for (int i = 0; i < 4; ++i) { hist[256 + l16 * 4 + i] = run; run += c[i]; }
        asm volatile("s_waitcnt lgkmcnt(0)" ::: "memory");
#pragma unroll
        for (int j = 0; j < 8; ++j) sortK[hist[256 + (ek[j] >> 8)] + rk[j]] = (ek[j] << 7) | (unsigned)(l16 + 16 * j);
    }
    __syncthreads();
    const size_t tok = (size_t)g * 32 + tl;
    float rinv_tok;
    { float t = 0.f; if (l16 < 8) { const f32x4 a = *(const f32x4*)(ssq2 + ((size_t)l16 * 8192 + tok) * 4); t = (a[0] + a[1]) + (a[2] + a[3]); }
      t += __shfl_xor(t, 8); t += __shfl_xor(t, 4); t += __shfl_xor(t, 2); t += __shfl_xor(t, 1); rinv_tok = rsqrtf(t * (1.f / 2048.f) + 1e-6f); }
    {
        const int m16 = lane & 15, kg = lane >> 4, pt = m16 >> 2, sub = m16 & 3, l6 = kg * 4 + sub;
        const unsigned* sKa = (const unsigned*)(smem + 65536) + (wave * 4 + pt) * 128;
        const bool diag = pt == kg;
        const size_t tokb = (size_t)g * 32 + wave * 4 + pt;
        typedef int i32x8v __attribute__((ext_vector_type(8)));
        const float xsc = 1.4f * __shfl(rinv_tok, pt * 16);
#pragma unroll 1
        for (int hf = 0; hf < 2; ++hf) {
            i32x8v xb[2];
#pragma unroll
            for (int gq = 0; gq < 2; ++gq) { att::f32x16v ev, od;
#pragma unroll
                for (int h = 0; h < 2; ++h) { const bf16_t* xp = h2 + tokb * DM + hf * 1024 + (2 * gq + h) * 256 + l6 * 16;
                    const u32x4 w0 = *(const u32x4*)xp, w1 = *(const u32x4*)(xp + 8);
#pragma unroll
                    for (int q = 0; q < 4; ++q) { ev[8 * h + q] = __uint_as_float(w0[q] << 16) * xsc; od[8 * h + q] = __uint_as_float(w0[q] & 0xffff0000u) * xsc;
                        ev[8 * h + 4 + q] = __uint_as_float(w1[q] << 16) * xsc; od[8 * h + 4 + q] = __uint_as_float(w1[q] & 0xffff0000u) * xsc; } }
                const att::u32x6v w6 = __builtin_amdgcn_cvt_scalef32_2xpk16_fp6_f32(ev, od, 1.0f);
                xb[gq] = (i32x8v){(int)w6[0], (int)w6[1], (int)w6[2], (int)w6[3], (int)w6[4], (int)w6[5], 0, 0}; }
            u32x4 urA[4][3], urB[4][3];
#define PEER_LDA(ur, it0) do { _Pragma("unroll") for (int j = 0; j < 4; ++j) { const unsigned ro = (sKa[(it0) + j] >> 7) * (unsigned)att::ROW6 + (unsigned)(hf * 768 + l6 * 16); \
                    _Pragma("unroll") for (int c = 0; c < 3; ++c) ur[j][c] = *(const u32x4*)(U8 + ro + c * 256); } } while (0)
#define PEER_CMA(ur, it0) do { float dsel = 0.f; \
                _Pragma("unroll") for (int j = 0; j < 4; ++j) { f32x4 acc = (f32x4){0.f, 0.f, 0.f, 0.f}; \
                    acc = __builtin_amdgcn_mfma_scale_f32_16x16x128_f8f6f4((i32x8v){(int)ur[j][0][0], (int)ur[j][0][1], (int)ur[j][0][2], (int)ur[j][0][3], (int)ur[j][1][0], (int)ur[j][1][1], 0, 0}, xb[0], acc, 2, 2, 0, 0x7F7F7F7F, 0, 0x7F7F7F7F); \
                    acc = __builtin_amdgcn_mfma_scale_f32_16x16x128_f8f6f4((i32x8v){(int)ur[j][1][2], (int)ur[j][1][3], (int)ur[j][2][0], (int)ur[j][2][1], (int)ur[j][2][2], (int)ur[j][2][3], 0, 0}, xb[1], acc, 2, 2, 0, 0x7F7F7F7F, 0, 0x7F7F7F7F); \
                    float d = sub == 0 ? acc[0] : sub == 1 ? acc[1] : sub == 2 ? acc[2] : acc[3]; \
                    d += __builtin_bit_cast(float, __builtin_amdgcn_update_dpp(0, __builtin_bit_cast(int, d), 0xB1, 0xF, 0xF, true)); \
                    d += __builtin_bit_cast(float, __builtin_amdgcn_update_dpp(0, __builtin_bit_cast(int, d), 0x4E, 0xF, 0xF, true)); \
                    if (sub == j) dsel = d; } \
                if (diag) { float* wSt = (float*)(smem + 81920) + (wave * 4 + pt) * 128; \
                    if (hf == 0) wSt[(it0) + sub] = dsel; \
                    else { const float a = (wSt[(it0) + sub] + dsel) * (1.f / (1.4f * U_SCALE)); \
                        wSt[(it0) + sub] = selG[(wave * 4 + pt) * 128 + (sKa[(it0) + sub] & 127u)] * 0.5f * a * (1.f + erff(a * 0.70710678118654752f)) * (1.f / V_SCALE); } } } while (0)
            PEER_LDA(urA, 0);
#pragma unroll 1
            for (int it = 0; it < 128; it += 8) {
                if (it) __builtin_amdgcn_s_barrier();
                PEER_LDA(urB, it + 4);
                PEER_CMA(urA, it);
                if (it + 8 < 128) PEER_LDA(urA, it + 8);
                PEER_CMA(urB, it + 4);
            }
#undef PEER_LDA
#undef PEER_CMA
            __syncthreads();
        }
    }
#pragma unroll 1
    for (int hf = 0; hf < 2; ++hf) {
        typedef _Float16 h16x2v __attribute__((ext_vector_type(2)));
        typedef _Float16 h16x32v __attribute__((ext_vector_type(32)));
        h16x2v acc[32];
#pragma unroll
        for (int c = 0; c < 32; ++c) acc[c] = (h16x2v){(_Float16)0.f, (_Float16)0.f};
        for (int it = 0; it < 128; it += 4) {
            if ((it & 7) == 0 && it) __syncthreads();
            unsigned key[4]; u32x4 vr[4][3];
#pragma unroll
            for (int p = 0; p < 4; ++p) { key[p] = sortK[it + p];
#pragma unroll
                for (int j = 0; j < 3; ++j) vr[p][j] = *(const u32x4*)(V8 + (size_t)(key[p] >> 7) * att::ROW6 + hf * 768 + j * 256 + l16 * 16); }
#pragma unroll
            for (int p = 0; p < 4; ++p) { const _Float16 wh = (_Float16)wS[it + p]; const h16x2v w2 = (h16x2v){wh, wh};
                const h16x32v c0 = __builtin_amdgcn_cvt_scalef32_pk32_f16_fp6((att::u32x6v){vr[p][0][0], vr[p][0][1], vr[p][0][2], vr[p][0][3], vr[p][1][0], vr[p][1][1]}, 1.0f);
#pragma unroll
                for (int k = 0; k < 16; ++k) acc[k] = __builtin_elementwise_fma(w2, (h16x2v){c0[2 * k], c0[2 * k + 1]}, acc[k]);
                const h16x32v c1 = __builtin_amdgcn_cvt_scalef32_pk32_f16_fp6((att::u32x6v){vr[p][1][2], vr[p][1][3], vr[p][2][0], vr[p][2][1], vr[p][2][2], vr[p][2][3]}, 1.0f);
#pragma unroll
                for (int k = 0; k < 16; ++k) acc[16 + k] = __builtin_elementwise_fma(w2, (h16x2v){c1[2 * k], c1[2 * k + 1]}, acc[16 + k]); }
        }
#pragma unroll
        for (int j = 0; j < 4; ++j)
#pragma unroll
            for (int q = 0; q < 4; ++q) { const size_t o = tok * DM + hf * 1024 + j * 256 + l16 * 16 + q * 4;
                const f32x4 a = *(const f32x4*)(x1 + o);
                *(f32x4*)(out + o) = (f32x4){a[0] + (float)acc[j * 8 + 2 * q][0], a[1] + (float)acc[j * 8 + 2 * q][1], a[2] + (float)acc[j * 8 + 2 * q + 1][0], a[3] + (float)acc[j * 8 + 2 * q + 1][1]}; }
        __syncthreads();
    }
    __syncthreads();
}

#define XB_TMO      128
#define XB_XCNT(j)  (256  + 64 * (j))
#define XB_XSUB(j)  (1280 + 64 * (j))
#define XB_XGEN(j)  (2304 + 64 * (j))
#define XB_TOP      3328
#define XB_TOPGEN   3392
#define XCD_BAR_WORDS 3456
#define XB_EXIT 3584
__device__ unsigned g_bar[4096];
#define XB_SPIN_CAP (1u << 18)

__device__ __forceinline__ unsigned xb_ld(unsigned* p)              { return __hip_atomic_load(p, __ATOMIC_RELAXED, __HIP_MEMORY_SCOPE_AGENT); }
__device__ __forceinline__ unsigned xb_add(unsigned* p, unsigned v) { return __hip_atomic_fetch_add(p, v, __ATOMIC_RELAXED, __HIP_MEMORY_SCOPE_AGENT); }
__device__ __forceinline__ unsigned xb_xcc_id() { return (unsigned)__builtin_amdgcn_s_getreg((3 << 11) | 20) & 0xFu; }
#define XB_SPIN(cond, bar) do { unsigned _sp = 0; while (cond) { __builtin_amdgcn_s_sleep(1); \
    if ((++_sp & 255u) == 0u) { if (xb_ld(&(bar)[XB_TMO])) break; if (_sp > XB_SPIN_CAP) { atomicAdd(&(bar)[XB_TMO], 1u); break; } } } } while (0)

struct XcdBarrier {
    unsigned* bar; unsigned x;
    volatile LAS unsigned* st;
};

__device__ __forceinline__ XcdBarrier xcd_barrier_post(unsigned* bar, volatile LAS unsigned* st) {
    XcdBarrier b; b.bar = bar; b.x = xb_xcc_id(); b.st = st;
    if (threadIdx.x == 0) (void)xb_add(&bar[XB_XCNT(b.x)], 1u);
    return b;
}
__device__ __forceinline__ void xcd_barrier_complete(unsigned* bar, unsigned x, unsigned& nloc, unsigned& nx) {
    const unsigned G = gridDim.x * gridDim.y * gridDim.z;
    unsigned sum, cnt, mine, sp = 0u;
    for (;;) {
        sum = 0u; cnt = 0u; mine = 0u;
#pragma unroll
        for (unsigned j = 0; j < 16; ++j) { const unsigned c = xb_ld(&bar[XB_XCNT(j)]); sum += c; cnt += (c > 0u) ? 1u : 0u; mine = (j == x) ? c : mine; }
        if (sum == G) break;
        __builtin_amdgcn_s_sleep(1);
        if ((++sp & 255u) == 0u) { if (xb_ld(&bar[XB_TMO])) break; if (sp > XB_SPIN_CAP) { atomicAdd(&bar[XB_TMO], 1u); break; } }
    }
    nloc = mine > 0u ? mine : 1u; nx = cnt > 0u ? cnt : 1u;
}

__device__ __forceinline__ void xcd_barrier(const XcdBarrier& b) {
    asm volatile("s_waitcnt vmcnt(0)" ::: "memory");
    __syncthreads();
    if (threadIdx.x == 0) {
        unsigned* bar = b.bar;
        __builtin_amdgcn_s_waitcnt(0);
        unsigned nloc = b.st[0], nx = b.st[1];
        if (nloc == 0u) { xcd_barrier_complete(bar, b.x, nloc, nx); b.st[0] = nloc; b.st[1] = nx; }
        const unsigned old = xb_add(&bar[XB_XSUB(b.x)], 1u);
        const unsigned gen = old / nloc;
        if (old + 1u == (gen + 1u) * nloc) {
            __builtin_amdgcn_fence(__ATOMIC_RELEASE, "agent");
            asm volatile("s_waitcnt vmcnt(0)" ::: "memory");
            const unsigned og = xb_add(&bar[XB_TOP], 1u);
            const unsigned tg = og / nx;
            if (og + 1u == (tg + 1u) * nx) xb_add(&bar[XB_TOPGEN], 1u);
            else XB_SPIN(xb_ld(&bar[XB_TOPGEN]) == tg, bar);
            __builtin_amdgcn_fence(__ATOMIC_ACQUIRE, "agent");
            xb_add(&bar[XB_XGEN(b.x)], 1u);
            asm volatile("s_waitcnt vmcnt(0)" ::: "memory");
        } else {
            XB_SPIN(xb_ld(&bar[XB_XGEN(b.x)]) == gen, bar);
            __builtin_amdgcn_fence(__ATOMIC_ACQUIRE, "agent");
            asm volatile("s_waitcnt vmcnt(0)" ::: "memory");
        }
    }
    __syncthreads();
}

#define PROBE_P0 0
#define PROBE_DOUBLE 0
#define REP(k) for (int rep_ = 0; rep_ < ((PROBE_DOUBLE == (k)) ? 2 : 1); ++rep_)
constexpr int LDS_BYTES = 147456;
__global__ __launch_bounds__(512, 2) void mega(Params p) {
    extern __shared__ __attribute__((aligned(16))) unsigned char smem[];
    { volatile LAS unsigned* st0 = (volatile LAS unsigned*)((LAS unsigned char*)smem + 131072); if (threadIdx.x < 2) st0[threadIdx.x] = 0u; }
    __syncthreads();
    const XcdBarrier bar = xcd_barrier_post(g_bar, (volatile LAS unsigned*)((LAS unsigned char*)smem + 131072));
    float* smf = (float*)smem;
    LAS unsigned char* lds = (LAS unsigned char*)smem;
    const int G = gridDim.x, b = blockIdx.x, NGW = G * 8;
#define PHASE_IDS() const int tid = opaque_tid(), lane = tid & 63, wave = __builtin_amdgcn_readfirstlane(tid >> 6), gw = b * 8 + wave; (void)lane; (void)gw

    REP(7) {
        PHASE_IDS();
        float* scr = smf + wave * 4096;
        constexpr int dummy_ = 0; (void)dummy_;
        constexpr int I_IN = 32 * 355, I_Q = 8 * 96, I_KV = 8 * 128, I_O = 64 * 64;
        for (int rp_ = 0; rp_ < (PROBE_P0 == 1 ? 2 : 1); ++rp_)
        for (int it = gw; it < I_IN + I_Q + I_KV + I_O; it += NGW) {
            int r = it;
            if (r < I_IN) { transpose_item(p.w_in, 2048, INW, p.WinT, DstWin(), scr, r, lane); continue; } r -= I_IN;
            if (r < I_Q) { transpose_item(p.w_q_up, 512, 3072, p.WqT, DstQ(), scr, r, lane, p.q_lat_g); continue; } r -= I_Q;
            if (r < I_KV) { transpose_item(p.w_kv_up, 512, 4096, p.WkvT, DstId(), scr, r, lane, p.kv_lat_g); continue; } r -= I_KV;
            transpose_item(p.w_out, 4096, 2048, p.WoT, DstId(), scr, r, lane);
        }
        for (int rp_ = 0; rp_ < (PROBE_P0 == 2 ? 2 : 1); ++rp_)
        for (int m = gw; m < S; m += NGW) rms_row2048(p.x + (size_t)m * DM, p.mix_g, p.h + (size_t)m * DM, lane);
        for (int idx = b * 512 + tid; idx < 16 * 64 * 64; idx += G * 512) { const int hh = idx >> 12, rr = (idx >> 6) & 63, c8 = idx & 63;
            *(u32x4*)(p.WqT + (size_t)(hh * 256 + 192 + rr) * 512 + c8 * 8) = (u32x4){0u, 0u, 0u, 0u}; }
        rope_table(p.pos, p.ropeT, b * 512 + tid, G * 512);
        __syncthreads();
        for (int rp_ = 0; rp_ < (PROBE_P0 == 3 ? 2 : 1); ++rp_)
        for (int it = b; it < 512; it += G) wfold_item(p.w_peer_q, p.sub_keys, p.WpT, smf, it);
    }
    xcd_barrier(bar);
    REP(1) {
        pg8::Gemm g{p.h, p.WinT, S, INWP, DM}; pg8::StaticOrder so; so.init(S, INWP, G, b);
        pg8::EpiInProj E{p.cq, p.ckv, p.fq, p.fk, p.fv, p.merged, p.kpe, p.lf, p.b_gate, p.b_forget, p.ssq, p.fox_qg, p.fox_kg, (LAS float*)(lds + 131072 + 64)};
        pg8::gemm_phase<pg8::EpiInProj, pg8::StaticOrder, true, true>(lds, g, so, E);
    }
    xcd_barrier(bar);
    for (int hh = b; hh < 16; hh += G) fox_cumsum((double*)smem, hh, p.lf, p.F);
    REP(2) {
        pg8::Gemm g{p.cq, p.WqT, S, 4096, 512}; pg8::StaticOrder so; so.init(S, 4096, G, b);
        pg8::EpiQ E{p.qa, p.ssq, p.mla_qg, p.ropeT, (LAS float*)(lds + 131072 + 64)};
        pg8::gemm_phase<pg8::EpiQ, pg8::StaticOrder, true, true>(lds, g, so, E);
    }
    {
        pg8::Gemm g{p.ckv, p.WkvT, S, 4096, 512}; pg8::StaticOrder so; so.init(S, 4096, G, b);
        pg8::EpiKV E{p.ka, p.va, p.kpe, p.ssq, p.mla_kg, p.ropeT, (LAS float*)(lds + 131072 + 64)};
        pg8::gemm_phase<pg8::EpiKV, pg8::StaticOrder, true, true>(lds, g, so, E);
    }
    xcd_barrier(bar);
    int side_next = 0;
    bool nomax_mla, nomax_fox;
    { const int ln = threadIdx.x & 63;
      float a = 0.f, c = 0.f;
      for (int j = ln; j < 192; j += 64) { a = fmaxf(a, fabsf(p.mla_qg[j])); c = fmaxf(c, fabsf(p.mla_kg[j])); }
      const float bm = 1.02f * 192.f * 0.10411754f * att::wave_max_f(a) * att::wave_max_f(c);
      float e = 0.f, f = 0.f;
      for (int j = ln; j < 128; j += 64) { e = fmaxf(e, fabsf(p.fox_qg[j])); f = fmaxf(f, fabsf(p.fox_kg[j])); }
      const float bf = 1.02f * 128.f * 0.12751743f * att::wave_max_f(e) * att::wave_max_f(f);
      nomax_mla = bm <= 80.f; nomax_fox = bf <= 80.f; }
    REP(3) for (int L = b; L < 1024; L += G) {
        const int i = L >> 8, vc = L & 255, vcx = (vc & 7) * 32 + (vc >> 3), hh = vcx >> 4, x = vcx & 15, qbk = (i & 1) ? x : 31 - x;
        if (i < 2) { if (nomax_mla) att::attn_block<192, false, true>(smem, p.qa + hh * 192, 3072, p.ka + hh * 192, 3072, p.va + hh * 128, 2048, nullptr, p.merged + hh * 128, p.attout + hh * 128, qbk, nullptr, nullptr, p.peer_u, p.peer_v, p.U8, p.V8, side_next); else att::attn_block<192, false, false>(smem, p.qa + hh * 192, 3072, p.ka + hh * 192, 3072, p.va + hh * 128, 2048, nullptr, p.merged + hh * 128, p.attout + hh * 128, qbk, nullptr, nullptr, p.peer_u, p.peer_v, p.U8, p.V8, side_next); }
        else { if (nomax_fox) att::attn_block<128, true, true>(smem, p.fq + hh * 128, 2048, p.fk + hh * 128, 2048, p.fv + hh * 128, 2048, p.F + (size_t)hh * S, p.merged + 2048 + hh * 128, p.attout + 2048 + hh * 128, qbk, p.fox_qg, p.fox_kg, p.peer_u, p.peer_v, p.U8, p.V8, side_next); else att::attn_block<128, true, false>(smem, p.fq + hh * 128, 2048, p.fk + hh * 128, 2048, p.fv + hh * 128, 2048, p.F + (size_t)hh * S, p.merged + 2048 + hh * 128, p.attout + 2048 + hh * 128, qbk, p.fox_qg, p.fox_kg, p.peer_u, p.peer_v, p.U8, p.V8, side_next); }
    }
    if (G == 256) { PHASE_IDS(); (void)wave;
        for (; side_next < 32; ++side_next) { const bool isv = side_next >= 16;
            fp6_cvt_rows(isv ? p.peer_v : p.peer_u, isv ? p.V8 : p.U8, b * 64 + (side_next & 15) * 4, 4, isv ? V_SCALE : U_SCALE, tid, 512); } }
    else { PHASE_IDS(); (void)wave; fp6_cvt_rows(p.peer_u, p.U8, 0, 16384, U_SCALE, b * 512 + tid, G * 512); fp6_cvt_rows(p.peer_v, p.V8, 0, 16384, V_SCALE, b * 512 + tid, G * 512); }
    xcd_barrier(bar);
    REP(4) {
        pg8::Gemm g{p.attout, p.WoT, S, 2048, 4096}; pg8::StaticOrder so; so.init(S, 2048, G, b);
        pg8::EpiX1 E{p.x1, p.x, p.xg, p.ffn_g, p.ssq2};
        pg8::gemm_phase<pg8::EpiX1, pg8::StaticOrder, true, true>(lds, g, so, E);
    }
    xcd_barrier(bar);
    REP(5) {
        pg8::Gemm g{p.xg, p.WpT, S, 2048, 2048}; pg8::StaticOrder so; so.init(S, 2048, G, b);
        pg8::EpiScores E{p.scores, p.ssq2};
        pg8::gemm_phase<pg8::EpiScores, pg8::StaticOrder, true, true>(lds, g, so, E);
    }
    xcd_barrier(bar);
    REP(6) for (int g = b; g < S / 32; g += G) peer_group(smem, g, p.scores, p.xg, p.ssq2, p.x1, p.U8, p.V8, p.out);
    __syncthreads();
    { volatile LAS unsigned* xf = (volatile LAS unsigned*)((LAS unsigned char*)smem + 131072 + 32);
      if (threadIdx.x == 0) { const unsigned old = xb_add(&g_bar[XB_EXIT], 1u); xf[0] = (old + 1u == (unsigned)G) ? 1u : 0u; }
      __syncthreads();
      if (xf[0]) { for (int i = threadIdx.x; i < 4096; i += 512) __hip_atomic_store(&g_bar[i], 0u, __ATOMIC_RELAXED, __HIP_MEMORY_SCOPE_AGENT); } }
}

extern "C" void kernel_launch(void* const* d_in, const int* in_sizes, int n_in,
                              void* d_out, int out_size, void* d_ws, size_t ws_size,
                              hipStream_t stream) {
    if (ws_size < 512 * MiB) { fprintf(stderr, "kernel_launch: workspace too small (%zu)\n", ws_size); return; }
    Params p{};
    p.x = (const float*)d_in[0]; p.pos = (const int*)d_in[1]; p.mix_g = (const float*)d_in[2]; p.w_in = (const float*)d_in[3];
    p.b_forget = (const float*)d_in[4]; p.b_gate = (const float*)d_in[5]; p.q_lat_g = (const float*)d_in[6]; p.w_q_up = (const float*)d_in[7];
    p.kv_lat_g = (const float*)d_in[8]; p.w_kv_up = (const float*)d_in[9]; p.mla_qg = (const float*)d_in[10]; p.mla_kg = (const float*)d_in[11];
    p.fox_qg = (const float*)d_in[12]; p.fox_kg = (const float*)d_in[13]; p.w_out = (const float*)d_in[14]; p.ffn_g = (const float*)d_in[15];
    p.w_peer_q = (const float*)d_in[16]; p.sub_keys = (const float*)d_in[17]; p.peer_u = (const float*)d_in[18]; p.peer_v = (const float*)d_in[19];
    p.out = (float*)d_out;
    char* ws = (char*)d_ws;
    p.WqT = (bf16_t*)(ws + 1 * MiB); p.WkvT = (bf16_t*)(ws + 5 * MiB); p.WoT = (bf16_t*)(ws + 9 * MiB); p.WpT = (bf16_t*)(ws + 25 * MiB); p.WinT = (bf16_t*)(ws + 33 * MiB);
    p.h = (bf16_t*)(ws + 78 * MiB); p.cq = (bf16_t*)(ws + 110 * MiB); p.ckv = (bf16_t*)(ws + 118 * MiB);
    p.fq = (bf16_t*)(ws + 126 * MiB); p.fk = (bf16_t*)(ws + 158 * MiB); p.fv = (bf16_t*)(ws + 190 * MiB); p.merged = (bf16_t*)(ws + 222 * MiB);
    p.kpe = (bf16_t*)(ws + 286 * MiB); p.lf = (float*)(ws + 287 * MiB); p.F = (float*)(ws + 287 * MiB + 512 * 1024);
    p.qa = (bf16_t*)(ws + 288 * MiB); p.va = (bf16_t*)(ws + 336 * MiB); p.ka = (bf16_t*)(ws + 400 * MiB); p.x1 = (float*)(ws + 126 * MiB);
    p.scores = (float*)(ws + 222 * MiB);
    p.ctl = (unsigned*)ws;
    p.ropeT = (float2*)(ws + 448 * MiB);
    p.ssq = (float*)(ws + 64 * 1024);
    p.attout = (bf16_t*)(ws + 33 * MiB);
    p.U8 = (unsigned char*)(ws + 450 * MiB); p.V8 = (unsigned char*)(ws + 368 * MiB);
    p.xg = (bf16_t*)(ws + 190 * MiB);
    p.ssq2 = (float*)(ws + 482 * MiB);

    static int grid_blocks = 0;
    if (!grid_blocks) {
        if (hipFuncSetAttribute((const void*)mega, hipFuncAttributeMaxDynamicSharedMemorySize, LDS_BYTES) != hipSuccess) { fprintf(stderr, "hipFuncSetAttribute failed\n"); return; }
        int dev = 0, cus = 0, per_cu = 0;
        (void)hipGetDevice(&dev);
        (void)hipDeviceGetAttribute(&cus, hipDeviceAttributeMultiprocessorCount, dev);
        (void)hipOccupancyMaxActiveBlocksPerMultiprocessor(&per_cu, (const void*)mega, 512, LDS_BYTES);
        if (per_cu < 1 || cus < 1) { fprintf(stderr, "occupancy query says %d blocks/CU on %d CUs\n", per_cu, cus); return; }
        grid_blocks = cus;
    }
    void* args[] = {&p};
    hipError_t e = hipLaunchCooperativeKernel((const void*)mega, dim3(grid_blocks), dim3(512), args, LDS_BYTES, stream);
    if (e != hipSuccess) fprintf(stderr, "cooperative launch failed: %s (grid %d)\n", hipGetErrorString(e), grid_blocks);
}
```

```cpp
#include <hip/hip_runtime.h>
#include <hip/hip_cooperative_groups.h>
#include <stdint.h>
#include <math.h>
#include <cstdio>
namespace cg = cooperative_groups;

namespace pg8 {
#define PG8_LAS __attribute__((address_space(3)))
typedef unsigned short bf16_t;
typedef short bf16x8 __attribute__((ext_vector_type(8)));
typedef float f32x4 __attribute__((ext_vector_type(4)));
typedef unsigned u32x4 __attribute__((ext_vector_type(4)));
constexpr int BM = 256, BK = 64, HALF = 128, HTB = HALF * BK * 2  , STAGE_BYTES = 8 * HTB, NXCD = 8, WGM = 8;

__host__ __device__ __forceinline__ int lds_byte(int r, int c) { const int st = (r >> 4) * 2 + (c >> 5), rr = r & 15, cc = c & 31, ob = rr * 64 + cc * 2; return st * 1024 + (ob ^ (((ob >> 9) & 1) << 5)); }
__host__ __device__ __forceinline__ void stage_rc(int b, int& R, int& C) { const int st = b / 1024, sb = b % 1024, swz = sb ^ (((sb >> 9) & 1) << 5); R = (st >> 1) * 16 + swz / 64; C = (st & 1) * 32 + (swz % 64) / 2; }
__host__ __device__ __forceinline__ int perm32(int rho) { const int n = rho >> 4, i = rho & 15; return 8 * (i >> 2) + 4 * n + (i & 3); }

struct Unit { int pm, pn; };
struct Gemm { const bf16_t* A; const bf16_t* Bt; int M, N, K; };

struct StaticOrder {
    int nM, nN, nwg, G, c;
    __host__ __device__ void init(int M, int N, int G_, int c_) { nM = M / BM; nN = N / BM; nwg = nM * nN; G = G_; c = c_; }
    __host__ __device__ bool next(int i, Unit& u) const {
        const long L = (long)i * G + c; if (L >= nwg) return false;
        int wgid = (int)L; { const int q = nwg / NXCD, r = nwg % NXCD, xcd = wgid % NXCD, off = wgid / NXCD; wgid = (xcd < r ? xcd * (q + 1) : r * (q + 1) + (xcd - r) * q) + off; }
        const int nig = WGM * nN, gid = wgid / nig, fm = gid * WGM, gsz = (nM - fm) < WGM ? (nM - fm) : WGM;
        u.pm = fm + ((wgid % nig) % gsz); u.pn = (wgid % nig) / gsz; return true;
    }
    __device__ __forceinline__ void a_ready(const Unit&) const {}
    __device__ __forceinline__ void done(const Unit&) const {}
};

typedef float cvt_pk_bf16_f32x2 __attribute__((ext_vector_type(2))); typedef __bf16 cvt_pk_bf16_bf16x2 __attribute__((ext_vector_type(2)));
__device__ __forceinline__ unsigned cvt_pk_bf16(float lo, float hi) { const cvt_pk_bf16_f32x2 v = {lo, hi}; const cvt_pk_bf16_bf16x2 b = __builtin_convertvector(v, cvt_pk_bf16_bf16x2); return __builtin_bit_cast(unsigned, b); }
__device__ __forceinline__ u32x4 pack8bf(const f32x4& v0, const f32x4& v1) { u32x4 w; w.x = cvt_pk_bf16(v0[0], v0[1]); w.y = cvt_pk_bf16(v0[2], v0[3]); w.z = cvt_pk_bf16(v1[0], v1[1]); w.w = cvt_pk_bf16(v1[2], v1[3]); return w; }

struct EpiStoreBf16 {
    static constexpr bool PERM = true, AFTER_DRAIN = false;
    bf16_t* O; int ldc;
    __device__ __forceinline__ void operator()(const f32x4 (&acc)[2][2][4][2], const Unit& u, int wr, int wc, int fr, int fq) const {
        const int row0 = u.pm * BM + wr * 64 + fr, col0 = u.pn * BM + wc * 32 + 8 * fq;
#pragma unroll
        for (int ai = 0; ai < 2; ++ai)
#pragma unroll
            for (int m = 0; m < 4; ++m) { bf16_t* rowp = O + (size_t)(row0 + ai * HALF + m * 16) * ldc + col0;
#pragma unroll
                for (int bj = 0; bj < 2; ++bj) *(u32x4*)(rowp + bj * HALF) = pack8bf(acc[ai][bj][m][0], acc[ai][bj][m][1]); }
    }
};
template <bool RES> struct EpiStoreF32 {
    static constexpr bool PERM = true, AFTER_DRAIN = false;
    float* O; const float* res; int ldc;
    __device__ __forceinline__ void operator()(const f32x4 (&acc)[2][2][4][2], const Unit& u, int wr, int wc, int fr, int fq) const {
        const int row0 = u.pm * BM + wr * 64 + fr, col0 = u.pn * BM + wc * 32 + 8 * fq;
#pragma unroll
        for (int ai = 0; ai < 2; ++ai)
#pragma unroll
            for (int m = 0; m < 4; ++m) { const size_t off = (size_t)(row0 + ai * HALF + m * 16) * ldc + col0;
#pragma unroll
                for (int bj = 0; bj < 2; ++bj) { f32x4 v0 = acc[ai][bj][m][0], v1 = acc[ai][bj][m][1];
                    if (RES) { v0 += *(const f32x4*)(res + off + bj * HALF); v1 += *(const f32x4*)(res + off + bj * HALF + 4); }
                    *(f32x4*)(O + off + bj * HALF) = v0; *(f32x4*)(O + off + bj * HALF + 4) = v1; } }
    }
};
#define EPI_LDSBAR() do { asm volatile("s_waitcnt lgkmcnt(0)" ::: "memory"); __builtin_amdgcn_s_barrier(); asm volatile("" ::: "memory"); } while (0)
struct EpiInProj {
    static constexpr bool PERM = true, AFTER_DRAIN = false;
    bf16_t *cq, *ckv, *fq, *fk, *fv, *gates, *kpe; float* lf; const float *b_gate, *b_forget; float* ssq; const float *gfq, *gfk; PG8_LAS float* xs;
    __device__ __forceinline__ void operator()(const f32x4 (&acc)[2][2][4][2], const Unit& u, int wr, int wc, int fr, int fq_) const {
        const int pn = u.pn, row0 = u.pm * BM + wr * 64 + fr, cw = wc * 32 + 8 * fq_;
        if (pn < 4) {
            bf16_t* base = pn < 2 ? cq : ckv; const int colt = (pn & 1) * 256;
#pragma unroll
            for (int ai = 0; ai < 2; ++ai)
#pragma unroll
                for (int m = 0; m < 4; ++m) { const int row = row0 + ai * HALF + m * 16; bf16_t* rowp = base + (size_t)row * 512 + colt + cw; float s = 0.f;
#pragma unroll
                    for (int bj = 0; bj < 2; ++bj) { const f32x4 v0 = acc[ai][bj][m][0], v1 = acc[ai][bj][m][1];
                        s += (v0[0] * v0[0] + v0[1] * v0[1]) + (v0[2] * v0[2] + v0[3] * v0[3]) + (v1[0] * v1[0] + v1[1] * v1[1]) + (v1[2] * v1[2] + v1[3] * v1[3]);
                        *(u32x4*)(rowp + bj * HALF) = pack8bf(v0, v1); }
                    s += __shfl_xor(s, 16); s += __shfl_xor(s, 32);
                    if (fq_ == 0) ssq[((size_t)pn * 8192 + row) * 4 + wc] = s; }
        } else if (pn < 20) {
            const bool isq = pn < 12; bf16_t* base = isq ? fq : fk; const int colt = (pn - (isq ? 4 : 12)) * 256; const float* g = isq ? gfq : gfk;
            const float qs = isq ? 0.12751743f : 1.f;
#pragma unroll
            for (int ai = 0; ai < 2; ++ai)
#pragma unroll
                for (int m = 0; m < 4; ++m)
#pragma unroll
                    for (int bj = 0; bj < 2; ++bj) { const f32x4 v0 = acc[ai][bj][m][0], v1 = acc[ai][bj][m][1];
                        float s = (v0[0] * v0[0] + v0[1] * v0[1]) + (v0[2] * v0[2] + v0[3] * v0[3]) + (v1[0] * v1[0] + v1[1] * v1[1]) + (v1[2] * v1[2] + v1[3] * v1[3]);
                        s += __shfl_xor(s, 16); s += __shfl_xor(s, 32);
                        if (fq_ == 0) xs[((ai * HALF + wr * 64 + m * 16 + fr) * 2 + bj) * 4 + wc] = s; }
            EPI_LDSBAR();
            const f32x4 g0 = *(const f32x4*)(g + cw) * qs, g1 = *(const f32x4*)(g + cw + 4) * qs;
#pragma unroll
            for (int ai = 0; ai < 2; ++ai)
#pragma unroll
                for (int m = 0; m < 4; ++m) { bf16_t* rowp = base + (size_t)(row0 + ai * HALF + m * 16) * 2048 + colt + cw;
#pragma unroll
                    for (int bj = 0; bj < 2; ++bj) { const f32x4 t4 = *(const PG8_LAS f32x4*)(xs + ((ai * HALF + wr * 64 + m * 16 + fr) * 2 + bj) * 4);
                        const float r = rsqrtf(((t4[0] + t4[1]) + (t4[2] + t4[3])) * (1.f / 128.f) + 1e-6f);
                        *(u32x4*)(rowp + bj * HALF) = pack8bf(acc[ai][bj][m][0] * g0 * r, acc[ai][bj][m][1] * g1 * r); } }
        } else if (pn < 28) {
            const int colt = (pn - 20) * 256;
#pragma unroll
            for (int ai = 0; ai < 2; ++ai)
#pragma unroll
                for (int m = 0; m < 4; ++m) { bf16_t* rowp = fv + (size_t)(row0 + ai * HALF + m * 16) * 2048 + colt + cw;
#pragma unroll
                    for (int bj = 0; bj < 2; ++bj) *(u32x4*)(rowp + bj * HALF) = pack8bf(acc[ai][bj][m][0], acc[ai][bj][m][1]); }
        } else if (pn < 44) {
            const int colt = (pn - 28) * 256 + cw;
#pragma unroll
            for (int bj = 0; bj < 2; ++bj) {
                const f32x4 b0 = *(const f32x4*)(b_gate + colt + bj * HALF), b1 = *(const f32x4*)(b_gate + colt + bj * HALF + 4);
#pragma unroll
                for (int ai = 0; ai < 2; ++ai)
#pragma unroll
                    for (int m = 0; m < 4; ++m) {
                        f32x4 v0 = acc[ai][bj][m][0] + b0, v1 = acc[ai][bj][m][1] + b1;
#pragma unroll
                        for (int e = 0; e < 4; ++e) { v0[e] = __builtin_amdgcn_rcpf(1.f + __expf(-v0[e])); v1[e] = __builtin_amdgcn_rcpf(1.f + __expf(-v1[e])); }
                        *(u32x4*)(gates + (size_t)(row0 + ai * HALF + m * 16) * 4096 + colt + bj * HALF) = pack8bf(v0, v1); }
            }
        } else {
            if (cw < 64) {
#pragma unroll
                for (int ai = 0; ai < 2; ++ai)
#pragma unroll
                    for (int m = 0; m < 4; ++m) *(u32x4*)(kpe + (size_t)(row0 + ai * HALF + m * 16) * 64 + cw) = pack8bf(acc[ai][0][m][0], acc[ai][0][m][1]);
            } else if (cw < 80) {
                const int h0 = cw - 64;
                const f32x4 b0 = *(const f32x4*)(b_forget + h0), b1 = *(const f32x4*)(b_forget + h0 + 4);
#pragma unroll
                for (int ai = 0; ai < 2; ++ai)
#pragma unroll
                    for (int m = 0; m < 4; ++m) { const int row = row0 + ai * HALF + m * 16;
                        f32x4 z0 = acc[ai][0][m][0] + b0, z1 = acc[ai][0][m][1] + b1;
#pragma unroll
                        for (int e = 0; e < 4; ++e) { z0[e] = fminf(z0[e], 0.f) - __logf(1.f + __expf(-fabsf(z0[e]))); z1[e] = fminf(z1[e], 0.f) - __logf(1.f + __expf(-fabsf(z1[e]))); }
                        *(f32x4*)(lf + (size_t)row * 16 + h0) = z0; *(f32x4*)(lf + (size_t)row * 16 + h0 + 4) = z1; }
            }
        }
    }
};
__device__ __forceinline__ float lat_rinv(const float* ssq, int part0, int row) {
    const f32x4 a = *(const f32x4*)(ssq + ((size_t)part0 * 8192 + row) * 4), b = *(const f32x4*)(ssq + ((size_t)(part0 + 1) * 8192 + row) * 4);
    return rsqrtf((((a[0] + a[1]) + (a[2] + a[3])) + ((b[0] + b[1]) + (b[2] + b[3]))) * (1.f / 512.f) + 1e-6f);
}
struct EpiQ {
    static constexpr bool PERM = true, AFTER_DRAIN = false;
    bf16_t* qa; const float* ssq; const float* gq; const float2* ropeT; PG8_LAS float* xs;
    __device__ __forceinline__ void operator()(const f32x4 (&acc)[2][2][4][2], const Unit& u, int wr, int wc, int fr, int fq_) const {
        const int h = u.pn, row0 = u.pm * BM + wr * 64 + fr, cw = wc * 32 + 8 * fq_;
        float rl[2][4];
#pragma unroll
        for (int ai = 0; ai < 2; ++ai)
#pragma unroll
            for (int m = 0; m < 4; ++m) rl[ai][m] = lat_rinv(ssq, 0, row0 + ai * HALF + m * 16);
#pragma unroll
        for (int ai = 0; ai < 2; ++ai)
#pragma unroll
            for (int m = 0; m < 4; ++m) { float s = 0.f;
#pragma unroll
                for (int bj = 0; bj < 2; ++bj) { const f32x4 v0 = acc[ai][bj][m][0], v1 = acc[ai][bj][m][1];
                    s += (v0[0] * v0[0] + v0[1] * v0[1]) + (v0[2] * v0[2] + v0[3] * v0[3]) + (v1[0] * v1[0] + v1[1] * v1[1]) + (v1[2] * v1[2] + v1[3] * v1[3]); }
                s *= rl[ai][m] * rl[ai][m];
                s += __shfl_xor(s, 16); s += __shfl_xor(s, 32);
                if (fq_ == 0) xs[(ai * HALF + wr * 64 + m * 16 + fr) * 4 + wc] = s; }
        EPI_LDSBAR();
        const float qs = 0.10411754f;
        const f32x4 g0 = *(const f32x4*)(gq + cw) * qs, g1 = *(const f32x4*)(gq + cw + 4) * qs;
        const int pp = 16 * (wc & 1) + 4 * fq_;
        const f32x4 ga = *(const f32x4*)(gq + 128 + pp) * qs, gb = *(const f32x4*)(gq + 160 + pp) * qs;
#pragma unroll
        for (int ai = 0; ai < 2; ++ai) {
            f32x4 rc0[4], rc1[4];
            if (wc < 2) {
#pragma unroll
                for (int m = 0; m < 4; ++m) { const size_t ro = (size_t)(row0 + ai * HALF + m * 16) * 32 + pp; rc0[m] = *(const f32x4*)(ropeT + ro); rc1[m] = *(const f32x4*)(ropeT + ro + 2); } }
#pragma unroll
            for (int m = 0; m < 4; ++m) { const int row = row0 + ai * HALF + m * 16;
                const f32x4 t4 = *(const PG8_LAS f32x4*)(xs + (ai * HALF + wr * 64 + m * 16 + fr) * 4);
                const float r = rsqrtf(((t4[0] + t4[1]) + (t4[2] + t4[3])) * (1.f / 192.f) + 1e-6f) * rl[ai][m];
                bf16_t* rowp = qa + (size_t)row * 3072 + h * 192;
                *(u32x4*)(rowp + cw) = pack8bf(acc[ai][0][m][0] * g0 * r, acc[ai][0][m][1] * g1 * r);
                if (wc < 2) { const f32x4 c01 = rc0[m], c23 = rc1[m];
                    const f32x4 z0 = acc[ai][1][m][0] * r, z1 = acc[ai][1][m][1] * r;
                    const float a0 = z0[0] * ga[0], b0 = z0[1] * gb[0], a1 = z0[2] * ga[1], b1 = z0[3] * gb[1], a2 = z1[0] * ga[2], b2 = z1[1] * gb[2], a3 = z1[2] * ga[3], b3 = z1[3] * gb[3];
                    const f32x4 o0 = {a0 * c01[0] - b0 * c01[1], a0 * c01[1] + b0 * c01[0], a1 * c01[2] - b1 * c01[3], a1 * c01[3] + b1 * c01[2]};
                    const f32x4 o1 = {a2 * c23[0] - b2 * c23[1], a2 * c23[1] + b2 * c23[0], a3 * c23[2] - b3 * c23[3], a3 * c23[3] + b3 * c23[2]};
                    *(u32x4*)(rowp + 128 + cw) = pack8bf(o0, o1); } }
        }
    }
};
struct EpiKV {
    static constexpr bool PERM = true, AFTER_DRAIN = false;
    bf16_t *ka, *va; const bf16_t* kpe; const float* ssq; const float* gk; const float2* ropeT; PG8_LAS float* xs;
    __device__ __forceinline__ void operator()(const f32x4 (&acc)[2][2][4][2], const Unit& u, int wr, int wc, int fr, int fq_) const {
        const int h = u.pn, row0 = u.pm * BM + wr * 64 + fr, cw = wc * 32 + 8 * fq_;
        float rl[2][4]; f32x4 kp[2][4];
#pragma unroll
        for (int ai = 0; ai < 2; ++ai)
#pragma unroll
            for (int m = 0; m < 4; ++m) { const int row = row0 + ai * HALF + m * 16; rl[ai][m] = lat_rinv(ssq, 2, row);
                const uint2 w = *(const uint2*)(kpe + (size_t)row * 64 + 16 * wc + 4 * fq_);
                kp[ai][m] = (f32x4){__uint_as_float(w.x << 16), __uint_as_float(w.x & 0xffff0000u), __uint_as_float(w.y << 16), __uint_as_float(w.y & 0xffff0000u)}; }
#pragma unroll
        for (int ai = 0; ai < 2; ++ai)
#pragma unroll
            for (int m = 0; m < 4; ++m) {
                const f32x4 v0 = acc[ai][0][m][0], v1 = acc[ai][0][m][1];
                float s = ((v0[0] * v0[0] + v0[1] * v0[1]) + (v0[2] * v0[2] + v0[3] * v0[3]) + (v1[0] * v1[0] + v1[1] * v1[1]) + (v1[2] * v1[2] + v1[3] * v1[3])) * (rl[ai][m] * rl[ai][m]);
                s += (kp[ai][m][0] * kp[ai][m][0] + kp[ai][m][1] * kp[ai][m][1]) + (kp[ai][m][2] * kp[ai][m][2] + kp[ai][m][3] * kp[ai][m][3]);
                s += __shfl_xor(s, 16); s += __shfl_xor(s, 32);
                if (fq_ == 0) xs[(ai * HALF + wr * 64 + m * 16 + fr) * 4 + wc] = s; }
        const int pp = 8 * wc + 2 * fq_;
#pragma unroll
        for (int ai = 0; ai < 2; ++ai)
#pragma unroll
            for (int m = 0; m < 4; ++m) *(u32x4*)(va + (size_t)(row0 + ai * HALF + m * 16) * 2048 + h * 128 + cw) = pack8bf(acc[ai][1][m][0] * rl[ai][m], acc[ai][1][m][1] * rl[ai][m]);
        EPI_LDSBAR();
        const f32x4 g0 = *(const f32x4*)(gk + cw), g1 = *(const f32x4*)(gk + cw + 4);
        const float ga0 = gk[128 + pp], ga1 = gk[128 + pp + 1], gb0 = gk[160 + pp], gb1 = gk[160 + pp + 1];
#pragma unroll
        for (int ai = 0; ai < 2; ++ai) {
            f32x4 rcs[4];
#pragma unroll
            for (int m = 0; m < 4; ++m) rcs[m] = *(const f32x4*)(ropeT + (size_t)(row0 + ai * HALF + m * 16) * 32 + pp);
#pragma unroll
            for (int m = 0; m < 4; ++m) { const int row = row0 + ai * HALF + m * 16;
                const f32x4 t4 = *(const PG8_LAS f32x4*)(xs + (ai * HALF + wr * 64 + m * 16 + fr) * 4);
                const float r = rsqrtf(((t4[0] + t4[1]) + (t4[2] + t4[3])) * (1.f / 192.f) + 1e-6f), rn = r * rl[ai][m];
                bf16_t* rowp = ka + (size_t)row * 3072 + h * 192;
                *(u32x4*)(rowp + cw) = pack8bf(acc[ai][0][m][0] * g0 * rn, acc[ai][0][m][1] * g1 * rn);
                const f32x4 cs = rcs[m];
                const float a0 = kp[ai][m][0] * r * ga0, b0 = kp[ai][m][1] * r * gb0, a1 = kp[ai][m][2] * r * ga1, b1 = kp[ai][m][3] * r * gb1;
                uint2 o; o.x = cvt_pk_bf16(a0 * cs[0] - b0 * cs[1], a0 * cs[1] + b0 * cs[0]); o.y = cvt_pk_bf16(a1 * cs[2] - b1 * cs[3], a1 * cs[3] + b1 * cs[2]);
                *(uint2*)(rowp + 128 + 16 * wc + 4 * fq_) = o; }
        }
    }
};

struct EpiX1 {
    static constexpr bool PERM = true, AFTER_DRAIN = false;
    float* x1; const float* x; bf16_t* xg; const float* g; float* ssq2;
    __device__ __forceinline__ void operator()(const f32x4 (&acc)[2][2][4][2], const Unit& u, int wr, int wc, int fr, int fq_) const {
        const int row0 = u.pm * BM + wr * 64 + fr, col0 = u.pn * BM + wc * 32 + 8 * fq_;
        f32x4 gg[2][2];
#pragma unroll
        for (int bj = 0; bj < 2; ++bj) { gg[bj][0] = *(const f32x4*)(g + col0 + bj * HALF); gg[bj][1] = *(const f32x4*)(g + col0 + bj * HALF + 4); }
#pragma unroll
        for (int am = 0; am < 4; ++am) { const int ai = am >> 1;
            f32x4 xr[4][2][2];
#pragma unroll
            for (int m = 2 * (am & 1); m < 2 * (am & 1) + 2; ++m)
#pragma unroll
                for (int bj = 0; bj < 2; ++bj) { const size_t off = (size_t)(row0 + ai * HALF + m * 16) * 2048 + col0 + bj * HALF; xr[m][bj][0] = *(const f32x4*)(x + off); xr[m][bj][1] = *(const f32x4*)(x + off + 4); }
#pragma unroll
            for (int m = 2 * (am & 1); m < 2 * (am & 1) + 2; ++m) { const int row = row0 + ai * HALF + m * 16; const size_t off = (size_t)row * 2048 + col0; float s = 0.f;
#pragma unroll
                for (int bj = 0; bj < 2; ++bj) { const f32x4 v0 = acc[ai][bj][m][0] + xr[m][bj][0], v1 = acc[ai][bj][m][1] + xr[m][bj][1];
                    *(f32x4*)(x1 + off + bj * HALF) = v0; *(f32x4*)(x1 + off + bj * HALF + 4) = v1;
                    s += (v0[0] * v0[0] + v0[1] * v0[1]) + (v0[2] * v0[2] + v0[3] * v0[3]) + (v1[0] * v1[0] + v1[1] * v1[1]) + (v1[2] * v1[2] + v1[3] * v1[3]);
                    *(u32x4*)(xg + off + bj * HALF) = pack8bf(v0 * gg[bj][0], v1 * gg[bj][1]); }
                s += __shfl_xor(s, 16); s += __shfl_xor(s, 32);
                if (fq_ == 0) ssq2[((size_t)u.pn * 8192 + row) * 4 + wc] = s; }
        }
    }
};
__device__ __forceinline__ float ffn_rinv(const float* ssq2, int row) {
    float t = 0.f;
#pragma unroll
    for (int pn = 0; pn < 8; ++pn) { const f32x4 a = *(const f32x4*)(ssq2 + ((size_t)pn * 8192 + row) * 4); t += (a[0] + a[1]) + (a[2] + a[3]); }
    return rsqrtf(t * (1.f / 2048.f) + 1e-6f);
}
struct EpiScores {
    static constexpr bool PERM = true, AFTER_DRAIN = false;
    float* O; const float* ssq2;
    __device__ __forceinline__ void operator()(const f32x4 (&acc)[2][2][4][2], const Unit& u, int wr, int wc, int fr, int fq_) const {
        const int row0 = u.pm * BM + wr * 64 + fr, col0 = u.pn * BM + wc * 32 + 8 * fq_;
        float rr[2][4];
#pragma unroll
        for (int ai = 0; ai < 2; ++ai)
#pragma unroll
            for (int m = 0; m < 4; ++m) rr[ai][m] = ffn_rinv(ssq2, row0 + ai * HALF + m * 16);
#pragma unroll
        for (int ai = 0; ai < 2; ++ai)
#pragma unroll
            for (int m = 0; m < 4; ++m) { const int row = row0 + ai * HALF + m * 16; const float r = rr[ai][m]; const size_t off = (size_t)row * 2048 + col0;
#pragma unroll
                for (int bj = 0; bj < 2; ++bj) { *(f32x4*)(O + off + bj * HALF) = acc[ai][bj][m][0] * r; *(f32x4*)(O + off + bj * HALF + 4) = acc[ai][bj][m][1] * r; } }
    }
};
template <class Epi, class Sched, bool ALIGN_EPI = false, bool SP2 = false>
__device__ __forceinline__ void gemm_phase(PG8_LAS unsigned char* lds, const Gemm g, const Sched& S, const Epi& E) {
    int tid = threadIdx.x; asm volatile("" : "+v"(tid));
    const int wid = __builtin_amdgcn_readfirstlane(tid >> 6), lane = tid & 63, wr = wid >> 2, wc = wid & 3, fr = lane & 15, fq = lane >> 4;
    const int K = g.K, nt = K / BK;
    unsigned voffA[2], voffB[2];
#pragma unroll
    for (int i = 0; i < 2; ++i) { int R, C; stage_rc(tid * 16 + i * 8192, R, C); const int Rb = Epi::PERM ? ((R & ~31) + perm32(R & 31)) : R;
        voffA[i] = (unsigned)(R * K + C) * 2u; voffB[i] = (unsigned)(Rb * K + C) * 2u; }
    const size_t kstep = (size_t)(BK * 2);
    const size_t hstep = (size_t)HALF * K * 2;
    const size_t tstep = 2 * hstep;
    const unsigned ldsw = (unsigned)wid * 1024u;
    const int aoff = lds_byte(wr * 64 + fr, fq * 8), boff = lds_byte(wc * 32 + fr, fq * 8);
#define PG8_SA(b, h) (((b) * 2 + (h)) * HTB)
#define PG8_SB(b, h) ((4 + (b) * 2 + (h)) * HTB)
#define PG8_STAGE(bufoff, gbase, voff) do { _Pragma("unroll") for (int _i = 0; _i < 2; ++_i) \
        __builtin_amdgcn_global_load_lds((const unsigned*)((const char*)(gbase) + (voff)[_i]), (PG8_LAS unsigned*)(lds + (bufoff) + ldsw + _i * 8192), 16, 0, 0); } while (0)
#define PG8_LDA(dst, b, h) do { _Pragma("unroll") for (int m = 0; m < 4; ++m) _Pragma("unroll") for (int k = 0; k < 2; ++k) dst[m][k] = *(const PG8_LAS bf16x8*)(lds + PG8_SA(b, h) + aoff + m * 2048 + k * 1024); } while (0)
#define PG8_LDB(dst, b, h) do { _Pragma("unroll") for (int n = 0; n < 2; ++n) _Pragma("unroll") for (int k = 0; k < 2; ++k) dst[n][k] = *(const PG8_LAS bf16x8*)(lds + PG8_SB(b, h) + boff + n * 2048 + k * 1024); } while (0)
#define PG8_MMA(ai, bj, At, Bt) do { __builtin_amdgcn_s_setprio(1); _Pragma("unroll") for (int m = 0; m < 4; ++m) _Pragma("unroll") for (int n = 0; n < 2; ++n) _Pragma("unroll") for (int k = 0; k < 2; ++k) \
        acc[ai][bj][m][n] = __builtin_amdgcn_mfma_f32_16x16x32_bf16(Bt[n][k], At[m][k], acc[ai][bj][m][n], 0, 0, 0); __builtin_amdgcn_s_setprio(0); } while (0)
#define PG8_WAIT_V(n) asm volatile("s_waitcnt vmcnt(" #n ")" ::: "memory")
#define PG8_WAIT_L(n) asm volatile("s_waitcnt lgkmcnt(" #n ")" ::: "memory")
#define PG8_BAR __builtin_amdgcn_s_barrier()
#define PG8_SCHED __builtin_amdgcn_sched_barrier(0)
    Unit cur, nxt; int ui = 0;
    if (!S.next(0, cur)) return;
    f32x4 acc[2][2][4][2];
#pragma unroll
    for (int a = 0; a < 2; ++a)
#pragma unroll
        for (int b = 0; b < 2; ++b)
#pragma unroll
            for (int m = 0; m < 4; ++m)
#pragma unroll
                for (int n = 0; n < 2; ++n) acc[a][b][m][n] = (f32x4){0.f, 0.f, 0.f, 0.f};
    bf16x8 At[4][2], B0[2][2], B1[2][2];
    const char* cA = (const char*)g.A + (size_t)cur.pm * tstep; const char* cB = (const char*)g.Bt + (size_t)cur.pn * tstep;
    S.a_ready(cur);
    if constexpr (SP2) {
        PG8_STAGE(PG8_SB(0, 0), cB, voffB); PG8_STAGE(PG8_SB(0, 1), cB + hstep, voffB); PG8_STAGE(PG8_SA(0, 0), cA, voffA); PG8_STAGE(PG8_SA(0, 1), cA + hstep, voffA);
        if (wr == 1) PG8_BAR;
        PG8_WAIT_V(2); PG8_BAR;
        PG8_STAGE(PG8_SB(1, 0), cB + kstep, voffB); PG8_STAGE(PG8_SA(1, 0), cA + kstep, voffA); PG8_STAGE(PG8_SB(1, 1), cB + hstep + kstep, voffB);
        PG8_WAIT_V(6); PG8_BAR;
    } else {
        PG8_STAGE(PG8_SB(0, 0), cB, voffB); PG8_STAGE(PG8_SA(0, 0), cA, voffA); PG8_STAGE(PG8_SB(0, 1), cB + hstep, voffB); PG8_STAGE(PG8_SA(0, 1), cA + hstep, voffA);
        if (wr == 1) PG8_BAR;
        PG8_WAIT_V(4); PG8_BAR;
        PG8_STAGE(PG8_SB(1, 0), cB + kstep, voffB); PG8_STAGE(PG8_SA(1, 0), cA + kstep, voffA); PG8_STAGE(PG8_SB(1, 1), cB + hstep + kstep, voffB);
        PG8_WAIT_V(6); PG8_BAR;
    }
    for (;;) {
        const bool has_next = S.next(ui + 1, nxt);
        const char* nA = has_next ? (const char*)g.A + (size_t)nxt.pm * tstep : cA; const char* nB = has_next ? (const char*)g.Bt + (size_t)nxt.pn * tstep : cB;
        for (int t = 0; t < nt; t += 2) {
            const bool last = (t == nt - 2);
            const char* a1 = cA + (size_t)(t + 1) * kstep;
            const char* a2 = last ? nA : cA + (size_t)(t + 2) * kstep; const char* b2 = last ? nB : cB + (size_t)(t + 2) * kstep;
            const char* a3 = a2 + kstep; const char* b3 = b2 + kstep;
            if (last && has_next) S.a_ready(nxt);
            if constexpr (SP2) {
            PG8_LDB(B0, 0, 0); PG8_LDB(B1, 0, 1); PG8_SCHED; PG8_LDA(At, 0, 0); PG8_STAGE(PG8_SA(1, 1), a1 + hstep, voffA);
            PG8_WAIT_V(8); PG8_WAIT_L(0); PG8_BAR; PG8_MMA(0, 0, At, B0); PG8_MMA(0, 1, At, B1); PG8_BAR; PG8_SCHED;
            PG8_LDA(At, 0, 1); PG8_STAGE(PG8_SB(0, 0), b2, voffB); PG8_STAGE(PG8_SB(0, 1), b2 + hstep, voffB); PG8_STAGE(PG8_SA(0, 0), a2, voffA);
            PG8_WAIT_V(8); PG8_WAIT_L(0); PG8_BAR; PG8_MMA(1, 0, At, B0); PG8_MMA(1, 1, At, B1); PG8_BAR; PG8_SCHED;
            PG8_LDB(B0, 1, 0); PG8_LDB(B1, 1, 1); PG8_SCHED; PG8_LDA(At, 1, 0); PG8_STAGE(PG8_SA(0, 1), a2 + hstep, voffA);
            PG8_WAIT_V(8); PG8_WAIT_L(0); PG8_BAR; PG8_MMA(0, 0, At, B0); PG8_MMA(0, 1, At, B1); PG8_BAR; PG8_SCHED;
            PG8_LDA(At, 1, 1); PG8_STAGE(PG8_SB(1, 0), b3, voffB); PG8_STAGE(PG8_SB(1, 1), b3 + hstep, voffB); PG8_STAGE(PG8_SA(1, 0), a3, voffA);
            PG8_WAIT_V(8); PG8_WAIT_L(0); PG8_BAR; PG8_MMA(1, 0, At, B0); PG8_MMA(1, 1, At, B1); PG8_BAR; PG8_SCHED;
            } else {
            PG8_LDB(B0, 0, 0); PG8_SCHED; PG8_LDA(At, 0, 0); PG8_STAGE(PG8_SA(1, 1), a1 + hstep, voffA);
            PG8_WAIT_L(8); PG8_BAR; PG8_WAIT_L(0); PG8_MMA(0, 0, At, B0); PG8_BAR; PG8_SCHED;
            PG8_LDB(B1, 0, 1); PG8_STAGE(PG8_SB(0, 0), b2, voffB);
            PG8_BAR; PG8_WAIT_L(0); PG8_MMA(0, 1, At, B1); PG8_BAR;
            PG8_LDA(At, 0, 1); PG8_STAGE(PG8_SA(0, 0), a2, voffA);
            PG8_BAR; PG8_WAIT_L(0); PG8_MMA(1, 0, At, B0); PG8_BAR; PG8_SCHED;
            PG8_STAGE(PG8_SB(0, 1), b2 + hstep, voffB);
            PG8_WAIT_V(6); PG8_BAR; PG8_MMA(1, 1, At, B1); PG8_BAR;
            PG8_LDB(B0, 1, 0); PG8_SCHED; PG8_LDA(At, 1, 0); PG8_STAGE(PG8_SA(0, 1), a2 + hstep, voffA);
            PG8_WAIT_L(8); PG8_BAR; PG8_WAIT_L(0); PG8_MMA(0, 0, At, B0); PG8_BAR; PG8_SCHED;
            PG8_LDB(B1, 1, 1); PG8_STAGE(PG8_SB(1, 0), b3, voffB);
            PG8_BAR; PG8_WAIT_L(0); PG8_MMA(0, 1, At, B1); PG8_BAR;
            PG8_LDA(At, 1, 1); PG8_STAGE(PG8_SA(1, 0), a3, voffA);
            PG8_BAR; PG8_WAIT_L(0); PG8_MMA(1, 0, At, B0); PG8_BAR; PG8_SCHED;
            PG8_STAGE(PG8_SB(1, 1), b3 + hstep, voffB);
            PG8_WAIT_V(6); PG8_BAR; PG8_MMA(1, 1, At, B1); PG8_BAR;
            }
        }
        if constexpr (ALIGN_EPI) { if (wr == 0) PG8_BAR; }
        if constexpr (!Epi::AFTER_DRAIN) { E(acc, cur, wr, wc, fr, fq); S.done(cur); }
        if (!has_next) break;
#pragma unroll
        for (int a = 0; a < 2; ++a)
#pragma unroll
            for (int b = 0; b < 2; ++b)
#pragma unroll
                for (int m = 0; m < 4; ++m)
#pragma unroll
                    for (int n = 0; n < 2; ++n) acc[a][b][m][n] = (f32x4){0.f, 0.f, 0.f, 0.f};
        cur = nxt; cA = nA; cB = nB; ++ui;
        if constexpr (ALIGN_EPI) { if (wr == 1) PG8_BAR; }
    }
    PG8_WAIT_V(0);
    if constexpr (!ALIGN_EPI) { if (wr == 0) PG8_BAR; }
    PG8_BAR;
    if constexpr (Epi::AFTER_DRAIN) { E.fused(acc, cur, wr, wc, fr, fq, lds, wid, lane); S.done(cur); }
#undef PG8_SA
#undef PG8_SB
#undef PG8_STAGE
#undef PG8_LDA
#undef PG8_LDB
#undef PG8_MMA
#undef PG8_WAIT_V
#undef PG8_WAIT_L
#undef PG8_BAR
#undef PG8_SCHED
}
}
namespace att {
typedef unsigned short bf16_t;
typedef short bf16x8 __attribute__((ext_vector_type(8)));
typedef short s16x4 __attribute__((ext_vector_type(4)));
typedef float f32x16 __attribute__((ext_vector_type(16)));
typedef float f32x4 __attribute__((ext_vector_type(4)));
typedef unsigned u32x4 __attribute__((ext_vector_type(4)));
#define ALAS __attribute__((address_space(3)))
#define ASBAR() __builtin_amdgcn_sched_barrier(0)
constexpr int SHM_V = 16384;
template <int DK> struct Lay { static constexpr int ROWB = DK * 2, SHM_K = 64 * ROWB, OFF_K = 2 * SHM_V, OFF_F = OFF_K + 2 * SHM_K, OFF_WS = OFF_F + 512, TOTAL = OFF_WS + 8 * 256; };

__device__ __forceinline__ int v_st(int k, int c) { const int kk = (k & ~0xC) | ((k & 4) << 1) | ((k & 8) >> 1); return ((kk >> 3) * 4 + (c >> 5)) * 512 + ((kk & 7) * 32 + (c & 31)) * 2; }
__device__ __forceinline__ int v_rd_base(int lane) { return ((lane & 3) << 3) | (((lane >> 2) & 3) << 6) | (((lane >> 4) & 1) << 5) | (((lane >> 5) & 1) << 8); }
__device__ __forceinline__ int crow(int r, int hi) { return (r & 3) + 8 * (r >> 2) + 4 * hi; }
typedef float cvtpk_f32x2 __attribute__((ext_vector_type(2))); typedef __bf16 cvtpk_bf16x2 __attribute__((ext_vector_type(2)));
__device__ __forceinline__ unsigned cvtpk(float lo, float hi) { const cvtpk_f32x2 v = {lo, hi}; const cvtpk_bf16x2 b = __builtin_convertvector(v, cvtpk_bf16x2); return __builtin_bit_cast(unsigned, b); }

__device__ __forceinline__ float wave_max_f(float v) {
#pragma unroll
    for (int o = 32; o >= 1; o >>= 1) v = fmaxf(v, __shfl_xor(v, o));
    return v;
}
__device__ __forceinline__ float att_max3(float a, float b, float c) { return __builtin_fmaxf(__builtin_fmaxf(a, b), c); }
typedef float f32x16v __attribute__((ext_vector_type(16)));
typedef unsigned u32x6v __attribute__((ext_vector_type(6)));
constexpr int ROW6 = 1536;
__device__ __forceinline__ void fp6_put(unsigned char* __restrict__ T6, int row, int hf, int l, int g, f32x16v f0, f32x16v f1, float sc) {
    f0 *= sc; f1 *= sc;
    f32x16v ev, od;
#pragma unroll
    for (int k = 0; k < 8; ++k) { ev[k] = f0[2 * k]; od[k] = f0[2 * k + 1]; ev[8 + k] = f1[2 * k]; od[8 + k] = f1[2 * k + 1]; }
    const u32x6v w = __builtin_amdgcn_cvt_scalef32_2xpk16_fp6_f32(ev, od, 1.0f);
    unsigned char* base = T6 + (size_t)row * ROW6 + hf * 768 + l * 16;
    if (g == 0) { *(u32x4*)base = (u32x4){w[0], w[1], w[2], w[3]}; *(uint2*)(base + 256) = make_uint2(w[4], w[5]); }
    else { *(uint2*)(base + 264) = make_uint2(w[0], w[1]); *(u32x4*)(base + 512) = (u32x4){w[2], w[3], w[4], w[5]}; }
}
constexpr int SIDE_STG = 86016;
template <int DK, bool FOX, bool NOMAX>
__device__ __forceinline__ void attn_block(unsigned char* smem, const bf16_t* __restrict__ Q, int ldq, const bf16_t* __restrict__ K, int ldk, const bf16_t* __restrict__ V, int ldv,
                                           const float* __restrict__ Fh, const bf16_t* __restrict__ gate, bf16_t* __restrict__ gout  , int qbk, float qk_bound_in  ,
                                           const float* __restrict__ side_u, const float* __restrict__ side_v, unsigned char* __restrict__ side_u8, unsigned char* __restrict__ side_v8, int& side_next) {
    typedef Lay<DK> LY;
    constexpr int ND = DK / 16, NKC = DK / 8, NKI = (64 * NKC) / 512;
    int tid = threadIdx.x; asm volatile("" : "+v"(tid));
    const int wid = __builtin_amdgcn_readfirstlane(tid >> 6), lane = tid & 63, r32 = lane & 31, hi = lane >> 5;
    const int q0 = qbk * 256, qlo = q0 + wid * 32, qm = qlo + r32 - 4 * hi;
    const int NT = 4 * qbk + 4;
    ALAS unsigned char* lds = (ALAS unsigned char*)smem;
    ALAS float* F_lds = (ALAS float*)(lds + LY::OFF_F);
    ALAS float* wsl = (ALAS float*)(lds + LY::OFF_WS) + wid * 64;
    bf16x8 qr[ND];
#pragma unroll
    for (int d0 = 0; d0 < ND; ++d0) qr[d0] = *(const bf16x8*)(Q + (size_t)(qlo + r32) * ldq + d0 * 16 + hi * 8);
    const float fq = FOX ? Fh[qlo + r32] : 0.f;
    int kgo[NKI], vgo[2];
#pragma unroll
    for (int i = 0; i < NKI; ++i) { const int pp = (wid * NKI + i) * 64 + lane, row = pp / NKC, cpos = pp % NKC, ch = cpos ^ ((row >> 1) & 7); kgo[i] = row * ldk + ch * 8; }
#pragma unroll
    for (int i = 0; i < 2; ++i) { const int o = ((wid * 2 + i) * 64 + lane) * 16, st = o >> 9, e = (o & 511) >> 1, kk = (st >> 2) * 8 + (e >> 5), c = (st & 3) * 32 + (e & 31);
        const int k = (kk & ~0xC) | ((kk & 4) << 1) | ((kk & 8) >> 1); vgo[i] = k * ldv + c; }
    const int vb0 = (int)(uintptr_t)smem + v_rd_base(lane);
    int kbase[4];
#pragma unroll
    for (int dd = 0; dd < 4; ++dd) kbase[dd] = LY::OFF_K + r32 * LY::ROWB + (((((dd << 1) | hi) ^ ((r32 >> 1) & 7))) << 4);
    float stf = 0.f;
#define ATT_GLDS(kb, bf) do { _Pragma("unroll") for (int i = 0; i < NKI; ++i) \
            __builtin_amdgcn_global_load_lds((const unsigned*)(K + (size_t)(kb) * ldk + kgo[i]), (ALAS unsigned*)(lds + LY::OFF_K + (bf) * LY::SHM_K + (wid * NKI + i) * 1024), 16, 0, 0); \
        _Pragma("unroll") for (int i = 0; i < 2; ++i) \
            __builtin_amdgcn_global_load_lds((const unsigned*)(V + (size_t)(kb) * ldv + vgo[i]), (ALAS unsigned*)(lds + (bf) * SHM_V + (wid * 2 + i) * 1024), 16, 0, 0); \
        if (FOX && tid < 64) stf = Fh[(kb) + tid]; } while (0)
#define ATT_WRITEF(bf) do { if (FOX && tid < 64) F_lds[(bf) * 64 + tid] = stf; } while (0)
    int t_start = 0; float m_init = 0.f;
    if (FOX) {
        const float qk_bound = qk_bound_in;
        const float thr = 2.02f * qk_bound + 40.f, f0 = Fh[q0]; m_init = -thr;
        const int j0 = lane, j1 = lane + 64;
        const float fa0 = Fh[(j0 < 4 * qbk ? j0 : 0) * 64 + 63], fa1 = Fh[(j1 < 4 * qbk ? j1 : 0) * 64 + 63];
        const bool c0 = (j0 < 4 * qbk) & (fa0 - f0 >= thr), c1 = (j1 < 4 * qbk) & (fa1 - f0 >= thr);
        t_start = __builtin_popcountll(__ballot(c0)) + __builtin_popcountll(__ballot(c1));
        t_start = __builtin_amdgcn_readfirstlane(t_start); }
    ATT_GLDS(t_start * 64, t_start & 1); ATT_WRITEF(t_start & 1);
    float m_reg = FOX ? m_init : 0.f, l_reg = 0.f; f32x16 o[4];
#pragma unroll
    for (int d = 0; d < 4; ++d)
#pragma unroll
        for (int r = 0; r < 16; ++r) o[d][r] = 0.f;
    int side_pend = -1;
    for (int t = t_start; t < NT; ++t) {
        const int buf = t & 1, kb = t * 64;
        asm volatile("s_waitcnt vmcnt(0)" ::: "memory");
        __syncthreads();
        if (t + 1 < NT) ATT_GLDS(kb + 64, buf ^ 1);
        if (side_pend >= 0) { const int sv = side_pend; side_pend = -1;
            if ((wid >> 2) == (sv & 1)) {
                const int c = tid & 255, rr = c >> 6, hf2 = (c >> 5) & 1, l = (c >> 1) & 15, g = c & 1;
                const ALAS float* sp = (const ALAS float*)(lds + SIDE_STG) + rr * 2048 + hf2 * 1024 + (2 * g) * 256 + l * 16;
                f32x16v f0, f1;
#pragma unroll
                for (int k = 0; k < 4; ++k) { const f32x4 a = *(const ALAS f32x4*)(sp + 4 * k), b2 = *(const ALAS f32x4*)(sp + 256 + 4 * k);
#pragma unroll
                    for (int e = 0; e < 4; ++e) { f0[4 * k + e] = a[e]; f1[4 * k + e] = b2[e]; } }
                const bool isv = sv >= 16;
                fp6_put(isv ? side_v8 : side_u8, blockIdx.x * 64 + (sv & 15) * 4 + rr, hf2, l, g, f0, f1, isv ? 4.f : 64.f); }
        } else if (side_next < 32 && t + 1 < NT) { const int sv = side_next; const bool isv = sv >= 16;
            const float* src = (isv ? side_v : side_u) + (size_t)(blockIdx.x * 64 + (sv & 15) * 4) * 2048;
#pragma unroll
            for (int i = 0; i < 4; ++i)
                __builtin_amdgcn_global_load_lds((const unsigned*)(src + ((i * 8 + wid) * 64 + lane) * 4), (ALAS unsigned*)(lds + SIDE_STG + (i * 8 + wid) * 1024), 16, 0, 0);
            side_pend = sv; ++side_next; }
        f32x16 p0, p1;
        if (FOX) { const float fqm = NOMAX ? fq : fq - m_reg;
#pragma unroll
            for (int g = 0; g < 4; ++g) { const f32x4 f0 = *(const ALAS f32x4*)(F_lds + buf * 64 + 8 * g + 4 * hi), f1 = *(const ALAS f32x4*)(F_lds + buf * 64 + 32 + 8 * g + 4 * hi);
#pragma unroll
                for (int e = 0; e < 4; ++e) { p0[4 * g + e] = fqm - f0[e]; p1[4 * g + e] = fqm - f1[e]; } }
        } else if (NOMAX) {
#pragma unroll
            for (int r = 0; r < 16; ++r) { p0[r] = 0.f; p1[r] = 0.f; }
        } else { const float nm = -m_reg;
#pragma unroll
            for (int r = 0; r < 16; ++r) { p0[r] = nm; p1[r] = nm; }
        }
        {
            constexpr int KPF = 2;
            int ka[4];
#pragma unroll
            for (int dd = 0; dd < 4; ++dd) ka[dd] = (int)(uintptr_t)smem + buf * LY::SHM_K + kbase[dd];
            bf16x8 kb0[KPF + 1], kb1[KPF + 1];
#define ATT_KRD(dst, addr, off) asm volatile("ds_read_b128 %0, %1 offset:%2" : "=&v"(dst) : "v"(addr), "i"(off) : "memory")
#pragma unroll
            for (int d0 = 0; d0 < KPF; ++d0) { ATT_KRD(kb0[d0 % (KPF + 1)], ka[d0 & 3], (d0 >> 2) * 128); ATT_KRD(kb1[d0 % (KPF + 1)], ka[d0 & 3], (d0 >> 2) * 128 + 32 * LY::ROWB); }
#pragma unroll
            for (int d0 = 0; d0 < ND; ++d0) {
                if (d0 + KPF < ND) { constexpr int dummy = 0; (void)dummy;
                    ATT_KRD(kb0[(d0 + KPF) % (KPF + 1)], ka[(d0 + KPF) & 3], ((d0 + KPF) >> 2) * 128); ATT_KRD(kb1[(d0 + KPF) % (KPF + 1)], ka[(d0 + KPF) & 3], ((d0 + KPF) >> 2) * 128 + 32 * LY::ROWB); }
                const int rem = (ND - 1 - d0) < KPF ? (ND - 1 - d0) : KPF;
                if (rem >= 2) asm volatile("s_waitcnt lgkmcnt(4)" ::: "memory");
                else if (rem == 1) asm volatile("s_waitcnt lgkmcnt(2)" ::: "memory");
                else asm volatile("s_waitcnt lgkmcnt(0)" ::: "memory");
                ASBAR();
                p0 = __builtin_amdgcn_mfma_f32_32x32x16_bf16(kb0[d0 % (KPF + 1)], qr[d0], p0, 0, 0, 0);
                p1 = __builtin_amdgcn_mfma_f32_32x32x16_bf16(kb1[d0 % (KPF + 1)], qr[d0], p1, 0, 0, 0);
            }
#undef ATT_KRD
        }
        if (kb + 63 > qlo) {
            const float NEG = -__builtin_inff(); const int dq = qm - kb;
#pragma unroll
            for (int r = 0; r < 16; ++r) { const int c = (r & 3) + 8 * (r >> 2); if (dq - c < 0) p0[r] = NEG; if (dq - c - 32 < 0) p1[r] = NEG; }
        }
        float alpha = 1.f;
        if (!NOMAX) {
        float pmax;
        { float a = att_max3(p0[0], p0[1], p1[0]), b = att_max3(p0[2], p0[3], p1[1]); a = att_max3(a, p1[2], p1[3]);
#pragma unroll
          for (int r = 4; r < 16; r += 4) { a = att_max3(a, p0[r], p0[r + 1]); b = att_max3(b, p0[r + 2], p0[r + 3]); a = att_max3(a, p1[r], p1[r + 1]); b = att_max3(b, p1[r + 2], p1[r + 3]); }
          pmax = fmaxf(a, b); }
        { auto rr = __builtin_amdgcn_permlane32_swap(__float_as_uint(pmax), __float_as_uint(pmax), false, false);
          pmax = fmaxf(__uint_as_float(rr[0]), __uint_as_float(rr[1])); }
        if (!__builtin_expect(__all(pmax <= 8.f), 1)) { const float dm = fmaxf(pmax, 0.f); alpha = __builtin_amdgcn_exp2f(-dm); m_reg += dm;
#pragma unroll
            for (int r = 0; r < 16; ++r) { p0[r] -= dm; p1[r] -= dm; } }
        }
        float ps = 0.f;
#pragma unroll
        for (int r = 0; r < 16; ++r) { p0[r] = __builtin_amdgcn_exp2f(p0[r]); ps += p0[r]; }
#pragma unroll
        for (int r = 0; r < 16; ++r) { p1[r] = __builtin_amdgcn_exp2f(p1[r]); ps += p1[r]; }
        { auto rr = __builtin_amdgcn_permlane32_swap(__float_as_uint(ps), __float_as_uint(ps), false, false);
          ps = __uint_as_float(rr[0]) + __uint_as_float(rr[1]); }
        l_reg = NOMAX ? l_reg + ps : l_reg * alpha + ps;
        bf16x8 pa0, pa1, pa2, pa3;
#define ATT_PK4(P, B_, OUT) do { unsigned a0 = cvtpk(P[B_+0], P[B_+1]), a1 = cvtpk(P[B_+2], P[B_+3]); unsigned b0_ = cvtpk(P[B_+4], P[B_+5]), b1_ = cvtpk(P[B_+6], P[B_+7]); \
        auto r0 = __builtin_amdgcn_permlane32_swap(a0, b0_, false, false); auto r1 = __builtin_amdgcn_permlane32_swap(a1, b1_, false, false); \
        u32x4 w = {r0[0], r1[0], r0[1], r1[1]}; OUT = *reinterpret_cast<bf16x8*>(&w); } while (0)
        ATT_PK4(p0, 0, pa0); ATT_PK4(p0, 8, pa1); ATT_PK4(p1, 0, pa2); ATT_PK4(p1, 8, pa3);
        if (!NOMAX && __any(alpha < 1.f)) {
            if (hi == 0) wsl[r32] = alpha;
            asm volatile("s_waitcnt lgkmcnt(0)" ::: "memory");
#pragma unroll
            for (int g = 0; g < 4; ++g) { const f32x4 al = *(const ALAS f32x4*)(wsl + 8 * g + 4 * hi);
#pragma unroll
                for (int d = 0; d < 4; ++d)
#pragma unroll
                    for (int e = 0; e < 4; ++e) o[d][4 * g + e] *= al[e]; }
        }
#define ATT_TRRD(dst, off) asm volatile("ds_read_b64_tr_b16 %0, %1 offset:%2" : "=&v"(dst) : "v"(vbb), "i"(off) : "memory")
#define ATT_PV(d0) do { s16x4 l0, l1, l2, l3, h0, h1, h2, h3; constexpr int b_ = (d0) * 512; \
        ATT_TRRD(l0, b_); ATT_TRRD(h0, b_ + 2048); ATT_TRRD(l1, b_ + 4096); ATT_TRRD(h1, b_ + 6144); ATT_TRRD(l2, b_ + 8192); ATT_TRRD(h2, b_ + 10240); ATT_TRRD(l3, b_ + 12288); ATT_TRRD(h3, b_ + 14336); \
        asm volatile("s_waitcnt lgkmcnt(0)" ::: "memory"); ASBAR(); \
        o[d0] = __builtin_amdgcn_mfma_f32_32x32x16_bf16(pa0, (bf16x8){l0[0], l0[1], l0[2], l0[3], h0[0], h0[1], h0[2], h0[3]}, o[d0], 0, 0, 0); \
        o[d0] = __builtin_amdgcn_mfma_f32_32x32x16_bf16(pa1, (bf16x8){l1[0], l1[1], l1[2], l1[3], h1[0], h1[1], h1[2], h1[3]}, o[d0], 0, 0, 0); \
        o[d0] = __builtin_amdgcn_mfma_f32_32x32x16_bf16(pa2, (bf16x8){l2[0], l2[1], l2[2], l2[3], h2[0], h2[1], h2[2], h2[3]}, o[d0], 0, 0, 0); \
        o[d0] = __builtin_amdgcn_mfma_f32_32x32x16_bf16(pa3, (bf16x8){l3[0], l3[1], l3[2], l3[3], h3[0], h3[1], h3[2], h3[3]}, o[d0], 0, 0, 0); } while (0)
        { const int vbb = vb0 + buf * SHM_V; ATT_PV(0); ATT_PV(1); ATT_PV(2); ATT_PV(3); }
        if (t + 1 < NT) ATT_WRITEF(buf ^ 1);
    }
    if (hi == 0) wsl[r32] = l_reg;
    asm volatile("s_waitcnt lgkmcnt(0)" ::: "memory");
#pragma unroll
    for (int rh = 0; rh < 16; rh += 8) {
        unsigned gv[8][4];
#pragma unroll
        for (int r = 0; r < 8; ++r) { const bf16_t* growp = gate + (size_t)(qlo + crow(rh + r, hi)) * 4096 + (r32 & ~1);
#pragma unroll
            for (int d0 = 0; d0 < 4; ++d0) gv[r][d0] = *(const unsigned*)(growp + d0 * 32); }
#pragma unroll
        for (int r = 0; r < 8; ++r) { const int orow = crow(rh + r, hi); const float rli = __builtin_amdgcn_rcpf(wsl[orow]);
            bf16_t* rowp = gout + (size_t)(qlo + orow) * 4096;
#pragma unroll
            for (int d0 = 0; d0 < 4; ++d0) {
                const float v = o[d0][rh + r] * rli; const float vn = __shfl_xor(v, 1); const unsigned g = gv[r][d0];
                const bool ev = (r32 & 1) == 0; const float ve = ev ? v : vn, vo = ev ? vn : v;
                *(unsigned*)(rowp + d0 * 32 + (r32 & ~1)) = cvtpk(ve * __uint_as_float(g << 16), vo * __uint_as_float(g & 0xffff0000u)); }
        }
    }
    __syncthreads();
#undef ATT_GLDS
#undef ATT_WRITEF
#undef ATT_PK4
#undef ATT_TRRD
#undef ATT_PV
}
}
using pg8::bf16_t; using pg8::f32x4; using pg8::u32x4;
#define LAS __attribute__((address_space(3)))
constexpr int S = 8192, DM = 2048, INW = 11344, INWP = 11520;
constexpr float EPS = 1e-6f;
constexpr size_t MiB = 1u << 20;

__device__ __forceinline__ float bf2f(bf16_t v) { return __uint_as_float(((unsigned)v) << 16); }
__device__ __forceinline__ bf16_t f2bf(float f) { unsigned u = __float_as_uint(f); u += 0x7fffu + ((u >> 16) & 1u); return (bf16_t)(u >> 16); }
__device__ __forceinline__ unsigned pk2(float lo, float hi) { return (unsigned)f2bf(lo) | ((unsigned)f2bf(hi) << 16); }
__device__ __forceinline__ float wave_sum(float v) {
#pragma unroll
    for (int o = 32; o >= 1; o >>= 1) v += __shfl_xor(v, o);
    return v;
}
__device__ __forceinline__ float wave_max(float v) {
#pragma unroll
    for (int o = 32; o >= 1; o >>= 1) v = fmaxf(v, __shfl_xor(v, o));
    return v;
}

__device__ __forceinline__ int opaque_tid() { int t = threadIdx.x; asm volatile("" : "+v"(t)); return t; }

struct Params {
    const float* x; const int* pos; const float *mix_g, *w_in, *b_forget, *b_gate, *q_lat_g, *w_q_up, *kv_lat_g, *w_kv_up, *mla_qg, *mla_kg, *fox_qg, *fox_kg, *w_out, *ffn_g, *w_peer_q, *sub_keys, *peer_u, *peer_v;
    float* out;
    bf16_t *WqT, *WkvT, *WoT, *WpT, *WinT;
    bf16_t *h, *cq, *ckv, *fq, *fk, *fv, *merged, *kpe, *qa, *va, *ka;
    float *lf, *F, *x1, *scores;
    unsigned char *U8, *V8; bf16_t* attout;
    unsigned* ctl;
    float2* ropeT; float* ssq; float* ssq2; bf16_t* xg;
};

struct DstId { __device__ __forceinline__ int operator()(int n) const { return n; } };
struct DstWin { __device__ __forceinline__ int operator()(int n) const {
    if (n < 1024) return n; if (n < 1088) { const int r = n - 1024; return 11264 + 2 * (r & 31) + (r >> 5); } if (n < 7232) return n - 64; if (n < 7248) return 11264 + 64 + (n - 7232); return n - 80; } };
struct DstQ { __device__ __forceinline__ int operator()(int n) const {
    const int h = n / 192, d = n - h * 192; if (d < 128) return h * 256 + d; const int r = d - 128; return h * 256 + 128 + 2 * (r & 31) + (r >> 5); } };
template <class Dst>
__device__ __forceinline__ void transpose_item(const float* __restrict__ W, int K, int N, bf16_t* __restrict__ WT, Dst dst, float* scr, int item, int lane, const float* __restrict__ gk = nullptr) {
    const int nblk = (N + 31) / 32, kb = item / nblk, nb = item % nblk, k0 = 64 * kb, n0 = 32 * nb;
    { const int rr = lane >> 3, c4 = (lane & 7) * 4; const bool ok = (n0 + c4) < N;
      f32x4 v[8];
#pragma unroll
      for (int i = 0; i < 8; ++i) v[i] = ok ? *(const f32x4*)(W + (size_t)(k0 + 8 * i + rr) * N + n0 + c4) : (f32x4){0.f, 0.f, 0.f, 0.f};
      if (gk) {
#pragma unroll
          for (int i = 0; i < 8; ++i) v[i] *= gk[k0 + 8 * i + rr]; }
#pragma unroll
      for (int i = 0; i < 8; ++i) { float* sp = scr + (8 * i + rr) * 33 + c4; sp[0] = v[i][0]; sp[1] = v[i][1]; sp[2] = v[i][2]; sp[3] = v[i][3]; } }
    asm volatile("s_waitcnt lgkmcnt(0)" ::: "memory");
    const int c = lane & 7;
#pragma unroll
    for (int j = 0; j < 4; ++j) { const int nl = (lane >> 3) + 8 * j, n = n0 + nl; const float* s = scr + (8 * c) * 33 + nl;
        u32x4 o; o.x = pk2(s[0 * 33], s[1 * 33]); o.y = pk2(s[2 * 33], s[3 * 33]); o.z = pk2(s[4 * 33], s[5 * 33]); o.w = pk2(s[6 * 33], s[7 * 33]);
        if (n < N) *(u32x4*)(WT + (size_t)dst(n) * K + k0 + 8 * c) = o; }
    asm volatile("s_waitcnt lgkmcnt(0)" ::: "memory");
}
typedef __bf16 wf_bf16x8 __attribute__((ext_vector_type(8)));
typedef float wf_f32x8 __attribute__((ext_vector_type(8)));
__device__ __forceinline__ void wf_split(const f32x4 x0, const f32x4 x1, wf_bf16x8& hi, wf_bf16x8& lo) {
    const wf_f32x8 x = {x0[0], x0[1], x0[2], x0[3], x1[0], x1[1], x1[2], x1[3]};
    hi = __builtin_convertvector(x, wf_bf16x8);
    const wf_f32x8 r = x - __builtin_convertvector(hi, wf_f32x8);
    lo = __builtin_convertvector(r, wf_bf16x8);
}
__device__ __forceinline__ void wfold_item(const float* __restrict__ wq, const float* __restrict__ keys, bf16_t* __restrict__ WpT, float* sm, int item) {
    (void)sm;
    const int tid = opaque_tid(), lane = tid & 63, wave = tid >> 6, hc = item >> 5, d0 = (item & 31) * 64, m = lane & 15, kg = lane >> 4;
    f32x4 acc[4];
#pragma unroll
    for (int c = 0; c < 4; ++c) acc[c] = (f32x4){0.f, 0.f, 0.f, 0.f};
#pragma unroll
    for (int s4 = 0; s4 < 4; ++s4) {
        const float* kp = keys + (size_t)hc * 16384 + (16 * wave + m) * 128 + 32 * s4 + 8 * kg;
        wf_bf16x8 bh, bl; wf_split(*(const f32x4*)kp, *(const f32x4*)(kp + 4), bh, bl);
#pragma unroll
        for (int c = 0; c < 4; ++c) { const float* ap = wq + (size_t)(d0 + 16 * c + m) * 2048 + hc * 128 + 32 * s4 + 8 * kg;
            wf_bf16x8 ah, al; wf_split(*(const f32x4*)ap, *(const f32x4*)(ap + 4), ah, al);
            acc[c] = __builtin_amdgcn_mfma_f32_16x16x32_bf16(ah, bh, acc[c], 0, 0, 0);
            acc[c] = __builtin_amdgcn_mfma_f32_16x16x32_bf16(ah, bl, acc[c], 0, 0, 0);
            acc[c] = __builtin_amdgcn_mfma_f32_16x16x32_bf16(al, bh, acc[c], 0, 0, 0); }
    }
#pragma unroll
    for (int c = 0; c < 4; ++c) { uint2 o; o.x = pk2(acc[c][0], acc[c][1]); o.y = pk2(acc[c][2], acc[c][3]);
        *(uint2*)(WpT + (size_t)(hc * 128 + 16 * wave + m) * 2048 + d0 + 16 * c + 4 * kg) = o; }
}
__device__ __forceinline__ void rms_row2048(const float* __restrict__ xr, const float* __restrict__ g, bf16_t* __restrict__ orow, int lane) {
    f32x4 v[8]; float ss = 0.f;
#pragma unroll
    for (int j = 0; j < 8; ++j) { v[j] = *(const f32x4*)(xr + j * 256 + lane * 4); ss += (v[j][0] * v[j][0] + v[j][1] * v[j][1]) + (v[j][2] * v[j][2] + v[j][3] * v[j][3]); }
    const float r = rsqrtf(wave_sum(ss) * (1.f / 2048.f) + EPS);
#pragma unroll
    for (int j = 0; j < 8; ++j) { const f32x4 gg = *(const f32x4*)(g + j * 256 + lane * 4);
        uint2 o; o.x = pk2(v[j][0] * r * gg[0], v[j][1] * r * gg[1]); o.y = pk2(v[j][2] * r * gg[2], v[j][3] * r * gg[3]);
        *(uint2*)(orow + j * 256 + lane * 4) = o; }
}
__device__ __forceinline__ void fox_cumsum(double* part, int h, const float* __restrict__ lf, float* __restrict__ F) {
    const int tid = opaque_tid(), lane = tid & 63, wave = tid >> 6;
    float v[16]; double sum = 0.0;
#pragma unroll
    for (int i = 0; i < 16; ++i) { v[i] = lf[(size_t)(tid * 16 + i) * 16 + h]; sum += (double)v[i]; }
    double inc = sum;
#pragma unroll
    for (int o = 1; o < 64; o <<= 1) { const double n = __shfl_up(inc, o); if (lane >= o) inc += n; }
    if (lane == 63) part[wave] = inc;
    __syncthreads();
    double base = 0.0;
    for (int w = 0; w < wave; ++w) base += part[w];
    double run = base + inc - sum;
#pragma unroll
    for (int i = 0; i < 16; ++i) { run += (double)v[i]; F[(size_t)h * S + tid * 16 + i] = (float)(run * 1.4426950408889634); }
    __syncthreads();
}
__device__ __forceinline__ void rope_table(const int* __restrict__ pos, float2* __restrict__ ropeT, int gtid, int nthreads) {
    for (int idx = gtid; idx < S * 32; idx += nthreads) { const int t = idx >> 5, i = idx & 31;
        const double inv = exp(-(double)i * (1.0 / 32.0) * 9.210340371976184);
        double ang = (double)((float)pos[t] * (float)inv);
        const double twopi = 6.283185307179586;
        ang -= twopi * rint(ang / twopi);
        ropeT[idx] = make_float2(cosf((float)ang), sinf((float)ang)); }
}
typedef float f32x2 __attribute__((ext_vector_type(2)));
__device__ __forceinline__ unsigned pk4_fp8(float a, float b, float c, float d) {
    int w = __builtin_amdgcn_cvt_pk_fp8_f32(fminf(fmaxf(a, -448.f), 448.f), fminf(fmaxf(b, -448.f), 448.f), 0, false);
    w = __builtin_amdgcn_cvt_pk_fp8_f32(fminf(fmaxf(c, -448.f), 448.f), fminf(fmaxf(d, -448.f), 448.f), w, true); return (unsigned)w; }
__device__ __forceinline__ void cvt_rows_fp8(const float* __restrict__ src, unsigned char* __restrict__ dst, size_t n, float scale, int gw, int NGW, int lane) {
    const size_t nchunk = n / 1024;
    for (size_t c = gw; c < nchunk; c += NGW) { const size_t o = c * 1024 + lane * 16;
        f32x4 a[4];
#pragma unroll
        for (int q = 0; q < 4; ++q) a[q] = *(const f32x4*)(src + o + 4 * q) * scale;
        u32x4 w; w.x = pk4_fp8(a[0][0], a[0][1], a[0][2], a[0][3]); w.y = pk4_fp8(a[1][0], a[1][1], a[1][2], a[1][3]);
        w.z = pk4_fp8(a[2][0], a[2][1], a[2][2], a[2][3]); w.w = pk4_fp8(a[3][0], a[3][1], a[3][2], a[3][3]);
        *(u32x4*)(dst + o) = w; }
}
constexpr float U_SCALE = 64.f, V_SCALE = 4.f;
typedef __bf16 bf16x2_t __attribute__((ext_vector_type(2)));
__device__ __forceinline__ float dot2bf(unsigned a, unsigned b, float c) { return __builtin_amdgcn_fdot2_f32_bf16(__builtin_bit_cast(bf16x2_t, a), __builtin_bit_cast(bf16x2_t, b), c, false); }
#define PEER_INS(top, x) do { float x_ = (x); _Pragma("unroll") for (int i_ = 0; i_ < 16; ++i_) { const float hi_ = fmaxf(top[i_], x_); x_ = fminf(top[i_], x_); top[i_] = hi_; } } while (0)
__device__ __forceinline__ void fp6_cvt_rows(const float* __restrict__ src, unsigned char* __restrict__ T6, int row0, int nrows, float sc, int t, int nt) {
    for (int u = t; u < nrows * 64; u += nt) { const int rr = u >> 6, hf = (u >> 5) & 1, l = (u >> 1) & 15, g = u & 1;
        const float* s0 = src + (size_t)(row0 + rr) * 2048 + hf * 1024 + (2 * g) * 256 + l * 16;
        att::f32x16v f0, f1;
#pragma unroll
        for (int k = 0; k < 4; ++k) { const f32x4 a = *(const f32x4*)(s0 + 4 * k), b2 = *(const f32x4*)(s0 + 256 + 4 * k);
#pragma unroll
            for (int e = 0; e < 4; ++e) { f0[4 * k + e] = a[e]; f1[4 * k + e] = b2[e]; } }
        att::fp6_put(T6, row0 + rr, hf, l, g, f0, f1, sc); }
}
typedef float f32x32v __attribute__((ext_vector_type(32)));
__device__ __forceinline__ void peer_group(unsigned char* smem, int g, const float* __restrict__ scores, const bf16_t* __restrict__ h2  , const float* __restrict__ ssq2, const float* __restrict__ x1,
                                           const unsigned char* __restrict__ U8, const unsigned char* __restrict__ V8, float* __restrict__ out) {
    const int tid = opaque_tid(), lane = tid & 63, wave = __builtin_amdgcn_readfirstlane(tid >> 6);
    float* topL = (float*)smem;
    int* selE = (int*)(smem + 32768);
    float* selG = (float*)(smem + 49152);
    {
        const int tl = tid >> 4, hc = tid & 15;
        const float* sp = scores + (size_t)(g * 32 + tl) * 2048 + hc * 128;
#define PEER_CE(a, b) do { const float hi_ = fmaxf(a, b), lo_ = fminf(a, b); a = hi_; b = lo_; } while (0)
        float top[16]; f32x4 nx[4];
#pragma unroll
        for (int q = 0; q < 4; ++q) nx[q] = *(const f32x4*)(sp + q * 4);
#pragma unroll 1
        for (int gi = 0; gi < 8; ++gi) {
            float gr[16];
#pragma unroll
            for (int q = 0; q < 4; ++q) { const f32x4 v = nx[q];
#pragma unroll
                for (int e = 0; e < 4; ++e) gr[q * 4 + e] = __uint_as_float((__float_as_uint(v[e]) & ~0x7Fu) | (unsigned)(gi * 16 + q * 4 + e)); }
            if (gi < 7) {
#pragma unroll
                for (int q = 0; q < 4; ++q) nx[q] = *(const f32x4*)(sp + (gi + 1) * 16 + q * 4); }
#pragma unroll
            for (int k = 2; k <= 16; k <<= 1)
#pragma unroll
                for (int j = k >> 1; j > 0; j >>= 1)
#pragma unroll
                    for (int i = 0; i < 16; ++i) { const int l = i ^ j; if (l > i) { if ((i & k) == 0) PEER_CE(gr[i], gr[l]); else PEER_CE(gr[l], gr[i]); } }
            if (gi == 0) {
#pragma unroll
                for (int i = 0; i < 16; ++i) top[i] = gr[i];
            } else {
#pragma unroll
                for (int i = 0; i < 16; ++i) top[i] = fmaxf(top[i], gr[15 - i]);
#pragma unroll
                for (int j = 8; j > 0; j >>= 1)
#pragma unroll
                    for (int i = 0; i < 16; ++i) { const int l = i ^ j; if (l > i) PEER_CE(top[i], top[l]); }
            }
        }
#undef PEER_CE
        float* tp = topL + (tl * 16 + hc) * 16;
#pragma unroll
        for (int i = 0; i < 16; i += 4) *(f32x4*)(tp + i) = (f32x4){top[i], top[i + 1], top[i + 2], top[i + 3]};
    }
    __syncthreads();
    if (tid < 256) {
        const int tl = tid >> 3, h = tid & 7;
        const float* t1 = topL + (tl * 16 + 2 * h) * 16; const float* t2 = t1 + 16;
        float s1[16], s2[16];
#pragma unroll
        for (int i = 0; i < 16; i += 4) { const f32x4 a = *(const f32x4*)(t1 + i), b2 = *(const f32x4*)(t2 + i);
            s1[i] = a[0]; s1[i + 1] = a[1]; s1[i + 2] = a[2]; s1[i + 3] = a[3]; s2[i] = b2[0]; s2[i + 1] = b2[1]; s2[i + 2] = b2[2]; s2[i + 3] = b2[3]; }
#define PEER_CE(a, b) do { const float hi_ = fmaxf(a, b), lo_ = fminf(a, b); a = hi_; b = lo_; } while (0)
#define PEER_KEY(i, j) __uint_as_float((__float_as_uint(s1[i] + s2[j]) & ~0xFFu) | (unsigned)((i) * 16 + (j)))
        float ts[16], cand[34];
#pragma unroll
        for (int j = 0; j < 16; ++j) ts[j] = PEER_KEY(0, j);
        { int n = 0;
#pragma unroll
          for (int i = 1; i < 16; ++i)
#pragma unroll
              for (int j = 0; j < 8; ++j)
                  if ((i + 1) * (j + 1) <= 16) cand[n++] = PEER_KEY(i, j); }
#pragma unroll
        for (int gi = 0; gi < 2; ++gi) { float gr[16];
#pragma unroll
            for (int i = 0; i < 16; ++i) gr[i] = cand[gi * 16 + i];
#pragma unroll
            for (int k = 2; k <= 16; k <<= 1)
#pragma unroll
                for (int j = k >> 1; j > 0; j >>= 1)
#pragma unroll
                    for (int i = 0; i < 16; ++i) { const int l = i ^ j; if (l > i) { if ((i & k) == 0) PEER_CE(gr[i], gr[l]); else PEER_CE(gr[l], gr[i]); } }
#pragma unroll
            for (int i = 0; i < 16; ++i) ts[i] = fmaxf(ts[i], gr[15 - i]);
#pragma unroll
            for (int j = 8; j > 0; j >>= 1)
#pragma unroll
                for (int i = 0; i < 16; ++i) { const int l = i ^ j; if (l > i) PEER_CE(ts[i], ts[l]); } }
        PEER_INS(ts, cand[32]); PEER_INS(ts, cand[33]);
#undef PEER_CE
#undef PEER_KEY
        float ex[16], sum = 0.f;
#pragma unroll
        for (int k = 0; k < 16; ++k) { ex[k] = __expf(ts[k] - ts[0]); sum += ex[k]; }
        const float inv = 1.f / sum;
#pragma unroll
        for (int k = 0; k < 16; ++k) { const unsigned pos = __float_as_uint(ts[k]) & 0xFFu;
            const int i1 = (int)(__float_as_uint(t1[pos >> 4]) & 0x7Fu), i2 = (int)(__float_as_uint(t2[pos & 15]) & 0x7Fu);
            selE[tl * 128 + h * 16 + k] = i1 * 128 + i2; selG[tl * 128 + h * 16 + k] = ex[k] * inv; }
    }
    __syncthreads();
    const int grp = lane >> 4, l16 = lane & 15, tl = wave * 4 + grp;
    unsigned* sortK = (unsigned*)(smem + 65536) + tl * 128;
    float* wS = (float*)(smem + 81920) + tl * 128;
    unsigned* hist = (unsigned*)(smem + 98304) + wave * 512 + grp * 64;
    {
#pragma unroll
        for (int i = 0; i < 4; ++i) hist[l16 * 4 + i] = 0u;
        asm volatile("s_waitcnt lgkmcnt(0)" ::: "memory");
        unsigned ek[8], rk[8];
#pragma unroll
        for (int j = 0; j < 8; ++j) { ek[j] = (unsigned)selE[tl * 128 + l16 + 16 * j]; rk[j] = atomicAdd(&hist[ek[j] >> 8], 1u); }
        asm volatile("s_waitcnt lgkmcnt(0)" ::: "memory");
        unsigned c[4], tot = 0u;
#pragma unroll
        for (int i = 0; i < 4; ++i) { c[i] = hist[l16 * 4 + i]; tot += c[i]; }
        unsigned inc = tot;
#pragma unroll
        for (int o = 1; o < 16; o <<= 1) { const unsigned n = __shfl_up(inc, o, 16); if (l16 >= o) inc += n; }
        unsigned run = inc - tot;
#pragma unroll
        for (int i = 0; i < 4; ++i) { hist[256 + l16 * 4 + i] = run; run += c[i]; }
        asm volatile("s_waitcnt lgkmcnt(0)" ::: "memory");
#pragma unroll
        for (int j = 0; j < 8; ++j) sortK[hist[256 + (ek[j] >> 8)] + rk[j]] = (ek[j] << 7) | (unsigned)(l16 + 16 * j);
    }
    __syncthreads();
    const size_t tok = (size_t)g * 32 + tl;
    float rinv_tok;
    { float t = 0.f; if (l16 < 8) { const f32x4 a = *(const f32x4*)(ssq2 + ((size_t)l16 * 8192 + tok) * 4); t = (a[0] + a[1]) + (a[2] + a[3]); }
      t += __shfl_xor(t, 8); t += __shfl_xor(t, 4); t += __shfl_xor(t, 2); t += __shfl_xor(t, 1); rinv_tok = rsqrtf(t * (1.f / 2048.f) + 1e-6f); }
    {
        const int m16 = lane & 15, kg = lane >> 4, pt = m16 >> 2, sub = m16 & 3, l6 = kg * 4 + sub;
        const unsigned* sKa = (const unsigned*)(smem + 65536) + (wave * 4 + pt) * 128;
        const bool diag = pt == kg;
        const size_t tokb = (size_t)g * 32 + wave * 4 + pt;
        typedef int i32x8v __attribute__((ext_vector_type(8)));
        const float xsc = 1.4f * __shfl(rinv_tok, pt * 16);
#pragma unroll 1
        for (int hf = 0; hf < 2; ++hf) {
            i32x8v xb[2];
#pragma unroll
            for (int gq = 0; gq < 2; ++gq) { att::f32x16v ev, od;
#pragma unroll
                for (int h = 0; h < 2; ++h) { const bf16_t* xp = h2 + tokb * DM + hf * 1024 + (2 * gq + h) * 256 + l6 * 16;
                    const u32x4 w0 = *(const u32x4*)xp, w1 = *(const u32x4*)(xp + 8);
#pragma unroll
                    for (int q = 0; q < 4; ++q) { ev[8 * h + q] = __uint_as_float(w0[q] << 16) * xsc; od[8 * h + q] = __uint_as_float(w0[q] & 0xffff0000u) * xsc;
                        ev[8 * h + 4 + q] = __uint_as_float(w1[q] << 16) * xsc; od[8 * h + 4 + q] = __uint_as_float(w1[q] & 0xffff0000u) * xsc; } }
                const att::u32x6v w6 = __builtin_amdgcn_cvt_scalef32_2xpk16_fp6_f32(ev, od, 1.0f);
                xb[gq] = (i32x8v){(int)w6[0], (int)w6[1], (int)w6[2], (int)w6[3], (int)w6[4], (int)w6[5], 0, 0}; }
            u32x4 urA[4][3], urB[4][3];
#define PEER_LDA(ur, it0) do { _Pragma("unroll") for (int j = 0; j < 4; ++j) { const unsigned ro = (sKa[(it0) + j] >> 7) * (unsigned)att::ROW6 + (unsigned)(hf * 768 + l6 * 16); \
                    _Pragma("unroll") for (int c = 0; c < 3; ++c) ur[j][c] = *(const u32x4*)(U8 + ro + c * 256); } } while (0)
#define PEER_CMA(ur, it0) do { float dsel = 0.f; \
                _Pragma("unroll") for (int j = 0; j < 4; ++j) { f32x4 acc = (f32x4){0.f, 0.f, 0.f, 0.f}; \
                    acc = __builtin_amdgcn_mfma_scale_f32_16x16x128_f8f6f4((i32x8v){(int)ur[j][0][0], (int)ur[j][0][1], (int)ur[j][0][2], (int)ur[j][0][3], (int)ur[j][1][0], (int)ur[j][1][1], 0, 0}, xb[0], acc, 2, 2, 0, 0x7F7F7F7F, 0, 0x7F7F7F7F); \
                    acc = __builtin_amdgcn_mfma_scale_f32_16x16x128_f8f6f4((i32x8v){(int)ur[j][1][2], (int)ur[j][1][3], (int)ur[j][2][0], (int)ur[j][2][1], (int)ur[j][2][2], (int)ur[j][2][3], 0, 0}, xb[1], acc, 2, 2, 0, 0x7F7F7F7F, 0, 0x7F7F7F7F); \
                    float d = sub == 0 ? acc[0] : sub == 1 ? acc[1] : sub == 2 ? acc[2] : acc[3]; \
                    d += __builtin_bit_cast(float, __builtin_amdgcn_update_dpp(0, __builtin_bit_cast(int, d), 0xB1, 0xF, 0xF, true)); \
                    d += __builtin_bit_cast(float, __builtin_amdgcn_update_dpp(0, __builtin_bit_cast(int, d), 0x4E, 0xF, 0xF, true)); \
                    if (sub == j) dsel = d; } \
                if (diag) { float* wSt = (float*)(smem + 81920) + (wave * 4 + pt) * 128; \
                    if (hf == 0) wSt[(it0) + sub] = dsel; \
                    else { const float a = (wSt[(it0) + sub] + dsel) * (1.f / (1.4f * U_SCALE)); \
                        wSt[(it0) + sub] = selG[(wave * 4 + pt) * 128 + (sKa[(it0) + sub] & 127u)] * 0.5f * a * (1.f + erff(a * 0.70710678118654752f)) * (1.f / V_SCALE); } } } while (0)
            PEER_LDA(urA, 0);
#pragma unroll 1
            for (int it = 0; it < 128; it += 8) {
                if (it) __builtin_amdgcn_s_barrier();
                PEER_LDA(urB, it + 4);
                PEER_CMA(urA, it);
                if (it + 8 < 128) PEER_LDA(urA, it + 8);
                PEER_CMA(urB, it + 4);
            }
#undef PEER_LDA
#undef PEER_CMA
            __syncthreads();
        }
    }
#pragma unroll 1
    for (int hf = 0; hf < 2; ++hf) {
        typedef _Float16 h16x2v __attribute__((ext_vector_type(2)));
        typedef _Float16 h16x32v __attribute__((ext_vector_type(32)));
        h16x2v acc[32];
#pragma unroll
        for (int c = 0; c < 32; ++c) acc[c] = (h16x2v){(_Float16)0.f, (_Float16)0.f};
        for (int it = 0; it < 128; it += 4) {
            if ((it & 7) == 0 && it) __syncthreads();
            unsigned key[4]; u32x4 vr[4][3];
#pragma unroll
            for (int p = 0; p < 4; ++p) { key[p] = sortK[it + p];
#pragma unroll
                for (int j = 0; j < 3; ++j) vr[p][j] = *(const u32x4*)(V8 + (size_t)(key[p] >> 7) * att::ROW6 + hf * 768 + j * 256 + l16 * 16); }
#pragma unroll
            for (int p = 0; p < 4; ++p) { const _Float16 wh = (_Float16)wS[it + p]; const h16x2v w2 = (h16x2v){wh, wh};
                const h16x32v c0 = __builtin_amdgcn_cvt_scalef32_pk32_f16_fp6((att::u32x6v){vr[p][0][0], vr[p][0][1], vr[p][0][2], vr[p][0][3], vr[p][1][0], vr[p][1][1]}, 1.0f);
#pragma unroll
                for (int k = 0; k < 16; ++k) acc[k] = __builtin_elementwise_fma(w2, (h16x2v){c0[2 * k], c0[2 * k + 1]}, acc[k]);
                const h16x32v c1 = __builtin_amdgcn_cvt_scalef32_pk32_f16_fp6((att::u32x6v){vr[p][1][2], vr[p][1][3], vr[p][2][0], vr[p][2][1], vr[p][2][2], vr[p][2][3]}, 1.0f);
#pragma unroll
                for (int k = 0; k < 16; ++k) acc[16 + k] = __builtin_elementwise_fma(w2, (h16x2v){c1[2 * k], c1[2 * k + 1]}, acc[16 + k]); }
        }
#pragma unroll
        for (int j = 0; j < 4; ++j)
#pragma unroll
            for (int q = 0; q < 4; ++q) { const size_t o = tok * DM + hf * 1024 + j * 256 + l16 * 16 + q * 4;
                const f32x4 a = *(const f32x4*)(x1 + o);
                *(f32x4*)(out + o) = (f32x4){a[0] + (float)acc[j * 8 + 2 * q][0], a[1] + (float)acc[j * 8 + 2 * q][1], a[2] + (float)acc[j * 8 + 2 * q + 1][0], a[3] + (float)acc[j * 8 + 2 * q + 1][1]}; }
        __syncthreads();
    }
    __syncthreads();
}

#define XB_TMO      128
#define XB_XCNT(j)  (256  + 64 * (j))
#define XB_XSUB(j)  (1280 + 64 * (j))
#define XB_XGEN(j)  (2304 + 64 * (j))
#define XB_TOP      3328
#define XB_TOPGEN   3392
#define XCD_BAR_WORDS 3456
#define XB_EXIT 3584
__device__ unsigned g_bar[4096];
#define XB_SPIN_CAP (1u << 18)

__device__ __forceinline__ unsigned xb_ld(unsigned* p)              { return __hip_atomic_load(p, __ATOMIC_RELAXED, __HIP_MEMORY_SCOPE_AGENT); }
__device__ __forceinline__ unsigned xb_add(unsigned* p, unsigned v) { return __hip_atomic_fetch_add(p, v, __ATOMIC_RELAXED, __HIP_MEMORY_SCOPE_AGENT); }
__device__ __forceinline__ unsigned xb_xcc_id() { return (unsigned)__builtin_amdgcn_s_getreg((3 << 11) | 20) & 0xFu; }
#define XB_SPIN(cond, bar) do { unsigned _sp = 0; while (cond) { __builtin_amdgcn_s_sleep(1); \
    if ((++_sp & 255u) == 0u) { if (xb_ld(&(bar)[XB_TMO])) break; if (_sp > XB_SPIN_CAP) { atomicAdd(&(bar)[XB_TMO], 1u); break; } } } } while (0)

struct XcdBarrier {
    unsigned* bar; unsigned x;
    volatile LAS unsigned* st;
};

__device__ __forceinline__ XcdBarrier xcd_barrier_post(unsigned* bar, volatile LAS unsigned* st) {
    XcdBarrier b; b.bar = bar; b.x = xb_xcc_id(); b.st = st;
    if (threadIdx.x == 0) (void)xb_add(&bar[XB_XCNT(b.x)], 1u);
    return b;
}
__device__ __forceinline__ void xcd_barrier_complete(unsigned* bar, unsigned x, unsigned& nloc, unsigned& nx) {
    const unsigned G = gridDim.x * gridDim.y * gridDim.z;
    unsigned sum, cnt, mine, sp = 0u;
    for (;;) {
        sum = 0u; cnt = 0u; mine = 0u;
#pragma unroll
        for (unsigned j = 0; j < 16; ++j) { const unsigned c = xb_ld(&bar[XB_XCNT(j)]); sum += c; cnt += (c > 0u) ? 1u : 0u; mine = (j == x) ? c : mine; }
        if (sum == G) break;
        __builtin_amdgcn_s_sleep(1);
        if ((++sp & 255u) == 0u) { if (xb_ld(&bar[XB_TMO])) break; if (sp > XB_SPIN_CAP) { atomicAdd(&bar[XB_TMO], 1u); break; } }
    }
    nloc = mine > 0u ? mine : 1u; nx = cnt > 0u ? cnt : 1u;
}

__device__ __forceinline__ void xcd_barrier(const XcdBarrier& b) {
    asm volatile("s_waitcnt vmcnt(0)" ::: "memory");
    __syncthreads();
    if (threadIdx.x == 0) {
        unsigned* bar = b.bar;
        __builtin_amdgcn_s_waitcnt(0);
        unsigned nloc = b.st[0], nx = b.st[1];
        if (nloc == 0u) { xcd_barrier_complete(bar, b.x, nloc, nx); b.st[0] = nloc; b.st[1] = nx; }
        const unsigned old = xb_add(&bar[XB_XSUB(b.x)], 1u);
        const unsigned gen = old / nloc;
        if (old + 1u == (gen + 1u) * nloc) {
            __builtin_amdgcn_fence(__ATOMIC_RELEASE, "agent");
            asm volatile("s_waitcnt vmcnt(0)" ::: "memory");
            const unsigned og = xb_add(&bar[XB_TOP], 1u);
            const unsigned tg = og / nx;
            if (og + 1u == (tg + 1u) * nx) xb_add(&bar[XB_TOPGEN], 1u);
            else XB_SPIN(xb_ld(&bar[XB_TOPGEN]) == tg, bar);
            __builtin_amdgcn_fence(__ATOMIC_ACQUIRE, "agent");
            xb_add(&bar[XB_XGEN(b.x)], 1u);
            asm volatile("s_waitcnt vmcnt(0)" ::: "memory");
        } else {
            XB_SPIN(xb_ld(&bar[XB_XGEN(b.x)]) == gen, bar);
            __builtin_amdgcn_fence(__ATOMIC_ACQUIRE, "agent");
            asm volatile("s_waitcnt vmcnt(0)" ::: "memory");
        }
    }
    __syncthreads();
}

#define PROBE_P0 0
#define PROBE_DOUBLE 0
#define REP(k) for (int rep_ = 0; rep_ < ((PROBE_DOUBLE == (k)) ? 2 : 1); ++rep_)
constexpr int LDS_BYTES = 147456;
__global__ __launch_bounds__(512, 2) void mega(Params p) {
    extern __shared__ __attribute__((aligned(16))) unsigned char smem[];
    { volatile LAS unsigned* st0 = (volatile LAS unsigned*)((LAS unsigned char*)smem + 131072); if (threadIdx.x < 2) st0[threadIdx.x] = 0u; }
    __syncthreads();
    const XcdBarrier bar = xcd_barrier_post(g_bar, (volatile LAS unsigned*)((LAS unsigned char*)smem + 131072));
    float* smf = (float*)smem;
    LAS unsigned char* lds = (LAS unsigned char*)smem;
    const int G = gridDim.x, b = blockIdx.x, NGW = G * 8;
#define PHASE_IDS() const int tid = opaque_tid(), lane = tid & 63, wave = __builtin_amdgcn_readfirstlane(tid >> 6), gw = b * 8 + wave; (void)lane; (void)gw

    REP(7) {
        PHASE_IDS();
        float* scr = smf + wave * 4096;
        constexpr int dummy_ = 0; (void)dummy_;
        constexpr int I_IN = 32 * 355, I_Q = 8 * 96, I_KV = 8 * 128, I_O = 64 * 64;
        for (int rp_ = 0; rp_ < (PROBE_P0 == 1 ? 2 : 1); ++rp_)
        for (int it = gw; it < I_IN + I_Q + I_KV + I_O; it += NGW) {
            int r = it;
            if (r < I_IN) { transpose_item(p.w_in, 2048, INW, p.WinT, DstWin(), scr, r, lane); continue; } r -= I_IN;
            if (r < I_Q) { transpose_item(p.w_q_up, 512, 3072, p.WqT, DstQ(), scr, r, lane, p.q_lat_g); continue; } r -= I_Q;
            if (r < I_KV) { transpose_item(p.w_kv_up, 512, 4096, p.WkvT, DstId(), scr, r, lane, p.kv_lat_g); continue; } r -= I_KV;
            transpose_item(p.w_out, 4096, 2048, p.WoT, DstId(), scr, r, lane);
        }
        for (int rp_ = 0; rp_ < (PROBE_P0 == 2 ? 2 : 1); ++rp_)
        for (int m = gw; m < S; m += NGW) rms_row2048(p.x + (size_t)m * DM, p.mix_g, p.h + (size_t)m * DM, lane);
        for (int idx = b * 512 + tid; idx < 16 * 64 * 64; idx += G * 512) { const int hh = idx >> 12, rr = (idx >> 6) & 63, c8 = idx & 63;
            *(u32x4*)(p.WqT + (size_t)(hh * 256 + 192 + rr) * 512 + c8 * 8) = (u32x4){0u, 0u, 0u, 0u}; }
        rope_table(p.pos, p.ropeT, b * 512 + tid, G * 512);
        __syncthreads();
        for (int rp_ = 0; rp_ < (PROBE_P0 == 3 ? 2 : 1); ++rp_)
        for (int it = b; it < 512; it += G) wfold_item(p.w_peer_q, p.sub_keys, p.WpT, smf, it);
    }
    xcd_barrier(bar);
    REP(1) {
        pg8::Gemm g{p.h, p.WinT, S, INWP, DM}; pg8::StaticOrder so; so.init(S, INWP, G, b);
        pg8::EpiInProj E{p.cq, p.ckv, p.fq, p.fk, p.fv, p.merged, p.kpe, p.lf, p.b_gate, p.b_forget, p.ssq, p.fox_qg, p.fox_kg, (LAS float*)(lds + 131072 + 64)};
        pg8::gemm_phase<pg8::EpiInProj, pg8::StaticOrder, true, true>(lds, g, so, E);
    }
    xcd_barrier(bar);
    for (int hh = b; hh < 16; hh += G) fox_cumsum((double*)smem, hh, p.lf, p.F);
    REP(2) {
        pg8::Gemm g{p.cq, p.WqT, S, 4096, 512}; pg8::StaticOrder so; so.init(S, 4096, G, b);
        pg8::EpiQ E{p.qa, p.ssq, p.mla_qg, p.ropeT, (LAS float*)(lds + 131072 + 64)};
        pg8::gemm_phase<pg8::EpiQ, pg8::StaticOrder, true, true>(lds, g, so, E);
    }
    {
        pg8::Gemm g{p.ckv, p.WkvT, S, 4096, 512}; pg8::StaticOrder so; so.init(S, 4096, G, b);
        pg8::EpiKV E{p.ka, p.va, p.kpe, p.ssq, p.mla_kg, p.ropeT, (LAS float*)(lds + 131072 + 64)};
        pg8::gemm_phase<pg8::EpiKV, pg8::StaticOrder, true, true>(lds, g, so, E);
    }
    xcd_barrier(bar);
    int side_next = 0;
    bool nomax_mla, nomax_fox; float fox_bound;
    { const int ln = threadIdx.x & 63;
      float a = 0.f, c = 0.f;
      for (int j = ln; j < 192; j += 64) { a = fmaxf(a, fabsf(p.mla_qg[j])); c = fmaxf(c, fabsf(p.mla_kg[j])); }
      const float bm = 1.02f * 192.f * 0.10411754f * att::wave_max_f(a) * att::wave_max_f(c);
      float e = 0.f, f = 0.f;
      for (int j = ln; j < 128; j += 64) { e = fmaxf(e, fabsf(p.fox_qg[j])); f = fmaxf(f, fabsf(p.fox_kg[j])); }
      fox_bound = 128.f * 0.12751743f * att::wave_max_f(e) * att::wave_max_f(f); const float bf = 1.02f * fox_bound;
      nomax_mla = bm <= 80.f; nomax_fox = bf <= 80.f; }
    REP(3) for (int L = b; L < 1024; L += G) {
        const int i = L >> 8, vc = L & 255, vcx = (vc & 7) * 32 + (vc >> 3), hh = vcx >> 4, x = vcx & 15, qbk = (i & 1) ? x : 31 - x;
        if (i < 2) { if (nomax_mla) att::attn_block<192, false, true>(smem, p.qa + hh * 192, 3072, p.ka + hh * 192, 3072, p.va + hh * 128, 2048, nullptr, p.merged + hh * 128, p.attout + hh * 128, qbk, 0.f, p.peer_u, p.peer_v, p.U8, p.V8, side_next); else att::attn_block<192, false, false>(smem, p.qa + hh * 192, 3072, p.ka + hh * 192, 3072, p.va + hh * 128, 2048, nullptr, p.merged + hh * 128, p.attout + hh * 128, qbk, 0.f, p.peer_u, p.peer_v, p.U8, p.V8, side_next); }
        else { if (nomax_fox) att::attn_block<128, true, true>(smem, p.fq + hh * 128, 2048, p.fk + hh * 128, 2048, p.fv + hh * 128, 2048, p.F + (size_t)hh * S, p.merged + 2048 + hh * 128, p.attout + 2048 + hh * 128, qbk, fox_bound, p.peer_u, p.peer_v, p.U8, p.V8, side_next); else att::attn_block<128, true, false>(smem, p.fq + hh * 128, 2048, p.fk + hh * 128, 2048, p.fv + hh * 128, 2048, p.F + (size_t)hh * S, p.merged + 2048 + hh * 128, p.attout + 2048 + hh * 128, qbk, fox_bound, p.peer_u, p.peer_v, p.U8, p.V8, side_next); }
    }
    if (G == 256) { PHASE_IDS(); (void)wave;
        for (; side_next < 32; ++side_next) { const bool isv = side_next >= 16;
            fp6_cvt_rows(isv ? p.peer_v : p.peer_u, isv ? p.V8 : p.U8, b * 64 + (side_next & 15) * 4, 4, isv ? V_SCALE : U_SCALE, tid, 512); } }
    else { PHASE_IDS(); (void)wave; fp6_cvt_rows(p.peer_u, p.U8, 0, 16384, U_SCALE, b * 512 + tid, G * 512); fp6_cvt_rows(p.peer_v, p.V8, 0, 16384, V_SCALE, b * 512 + tid, G * 512); }
    xcd_barrier(bar);
    REP(4) {
        pg8::Gemm g{p.attout, p.WoT, S, 2048, 4096}; pg8::StaticOrder so; so.init(S, 2048, G, b);
        pg8::EpiX1 E{p.x1, p.x, p.xg, p.ffn_g, p.ssq2};
        pg8::gemm_phase<pg8::EpiX1, pg8::StaticOrder, true, true>(lds, g, so, E);
    }
    xcd_barrier(bar);
    REP(5) {
        pg8::Gemm g{p.xg, p.WpT, S, 2048, 2048}; pg8::StaticOrder so; so.init(S, 2048, G, b);
        pg8::EpiScores E{p.scores, p.ssq2};
        pg8::gemm_phase<pg8::EpiScores, pg8::StaticOrder, true, true>(lds, g, so, E);
    }
    xcd_barrier(bar);
    REP(6) for (int g = b; g < S / 32; g += G) peer_group(smem, g, p.scores, p.xg, p.ssq2, p.x1, p.U8, p.V8, p.out);
    __syncthreads();
    { volatile LAS unsigned* xf = (volatile LAS unsigned*)((LAS unsigned char*)smem + 131072 + 32);
      if (threadIdx.x == 0) { const unsigned old = xb_add(&g_bar[XB_EXIT], 1u); xf[0] = (old + 1u == (unsigned)G) ? 1u : 0u; }
      __syncthreads();
      if (xf[0]) { for (int i = threadIdx.x; i < 4096; i += 512) __hip_atomic_store(&g_bar[i], 0u, __ATOMIC_RELAXED, __HIP_MEMORY_SCOPE_AGENT); } }
}

extern "C" void kernel_launch(void* const* d_in, const int* in_sizes, int n_in,
                              void* d_out, int out_size, void* d_ws, size_t ws_size,
                              hipStream_t stream) {
    if (ws_size < 512 * MiB) { fprintf(stderr, "kernel_launch: workspace too small (%zu)\n", ws_size); return; }
    Params p{};
    p.x = (const float*)d_in[0]; p.pos = (const int*)d_in[1]; p.mix_g = (const float*)d_in[2]; p.w_in = (const float*)d_in[3];
    p.b_forget = (const float*)d_in[4]; p.b_gate = (const float*)d_in[5]; p.q_lat_g = (const float*)d_in[6]; p.w_q_up = (const float*)d_in[7];
    p.kv_lat_g = (const float*)d_in[8]; p.w_kv_up = (const float*)d_in[9]; p.mla_qg = (const float*)d_in[10]; p.mla_kg = (const float*)d_in[11];
    p.fox_qg = (const float*)d_in[12]; p.fox_kg = (const float*)d_in[13]; p.w_out = (const float*)d_in[14]; p.ffn_g = (const float*)d_in[15];
    p.w_peer_q = (const float*)d_in[16]; p.sub_keys = (const float*)d_in[17]; p.peer_u = (const float*)d_in[18]; p.peer_v = (const float*)d_in[19];
    p.out = (float*)d_out;
    char* ws = (char*)d_ws;
    p.WqT = (bf16_t*)(ws + 1 * MiB); p.WkvT = (bf16_t*)(ws + 5 * MiB); p.WoT = (bf16_t*)(ws + 9 * MiB); p.WpT = (bf16_t*)(ws + 25 * MiB); p.WinT = (bf16_t*)(ws + 33 * MiB);
    p.h = (bf16_t*)(ws + 78 * MiB); p.cq = (bf16_t*)(ws + 110 * MiB); p.ckv = (bf16_t*)(ws + 118 * MiB);
    p.fq = (bf16_t*)(ws + 126 * MiB); p.fk = (bf16_t*)(ws + 158 * MiB); p.fv = (bf16_t*)(ws + 190 * MiB); p.merged = (bf16_t*)(ws + 222 * MiB);
    p.kpe = (bf16_t*)(ws + 286 * MiB); p.lf = (float*)(ws + 287 * MiB); p.F = (float*)(ws + 287 * MiB + 512 * 1024);
    p.qa = (bf16_t*)(ws + 288 * MiB); p.va = (bf16_t*)(ws + 336 * MiB); p.ka = (bf16_t*)(ws + 400 * MiB); p.x1 = (float*)(ws + 126 * MiB);
    p.scores = (float*)(ws + 222 * MiB);
    p.ctl = (unsigned*)ws;
    p.ropeT = (float2*)(ws + 448 * MiB);
    p.ssq = (float*)(ws + 64 * 1024);
    p.attout = (bf16_t*)(ws + 33 * MiB);
    p.U8 = (unsigned char*)(ws + 450 * MiB); p.V8 = (unsigned char*)(ws + 368 * MiB);
    p.xg = (bf16_t*)(ws + 190 * MiB);
    p.ssq2 = (float*)(ws + 482 * MiB);

    static int grid_blocks = 0;
    if (!grid_blocks) {
        if (hipFuncSetAttribute((const void*)mega, hipFuncAttributeMaxDynamicSharedMemorySize, LDS_BYTES) != hipSuccess) { fprintf(stderr, "hipFuncSetAttribute failed\n"); return; }
        int dev = 0, cus = 0, per_cu = 0;
        (void)hipGetDevice(&dev);
        (void)hipDeviceGetAttribute(&cus, hipDeviceAttributeMultiprocessorCount, dev);
        (void)hipOccupancyMaxActiveBlocksPerMultiprocessor(&per_cu, (const void*)mega, 512, LDS_BYTES);
        if (per_cu < 1 || cus < 1) { fprintf(stderr, "occupancy query says %d blocks/CU on %d CUs\n", per_cu, cus); return; }
        grid_blocks = cus;
    }
    void* args[] = {&p};
    hipError_t e = hipLaunchCooperativeKernel((const void*)mega, dim3(grid_blocks), dim3(512), args, LDS_BYTES, stream);
    if (e != hipSuccess) fprintf(stderr, "cooperative launch failed: %s (grid %d)\n", hipGetErrorString(e), grid_blocks);
}
```

```cpp
#include <hip/hip_runtime.h>
#include <hip/hip_cooperative_groups.h>
#include <stdint.h>
#include <math.h>
#include <cstdio>
namespace cg = cooperative_groups;

namespace pg8 {
#define PG8_LAS __attribute__((address_space(3)))
typedef unsigned short bf16_t;
typedef short bf16x8 __attribute__((ext_vector_type(8)));
typedef float f32x4 __attribute__((ext_vector_type(4)));
typedef unsigned u32x4 __attribute__((ext_vector_type(4)));
constexpr int BM = 256, BK = 64, HALF = 128, HTB = HALF * BK * 2  , STAGE_BYTES = 8 * HTB, NXCD = 8, WGM = 8;

__host__ __device__ __forceinline__ int lds_byte(int r, int c) { const int st = (r >> 4) * 2 + (c >> 5), rr = r & 15, cc = c & 31, ob = rr * 64 + cc * 2; return st * 1024 + (ob ^ (((ob >> 9) & 1) << 5)); }
__host__ __device__ __forceinline__ void stage_rc(int b, int& R, int& C) { const int st = b / 1024, sb = b % 1024, swz = sb ^ (((sb >> 9) & 1) << 5); R = (st >> 1) * 16 + swz / 64; C = (st & 1) * 32 + (swz % 64) / 2; }
__host__ __device__ __forceinline__ int perm32(int rho) { const int n = rho >> 4, i = rho & 15; return 8 * (i >> 2) + 4 * n + (i & 3); }

struct Unit { int pm, pn; };
struct Gemm { const bf16_t* A; const bf16_t* Bt; int M, N, K; };

struct StaticOrder {
    int nM, nN, nwg, G, c;
    __host__ __device__ void init(int M, int N, int G_, int c_) { nM = M / BM; nN = N / BM; nwg = nM * nN; G = G_; c = c_; }
    __host__ __device__ bool next(int i, Unit& u) const {
        const long L = (long)i * G + c; if (L >= nwg) return false;
        int wgid = (int)L; { const int q = nwg / NXCD, r = nwg % NXCD, xcd = wgid % NXCD, off = wgid / NXCD; wgid = (xcd < r ? xcd * (q + 1) : r * (q + 1) + (xcd - r) * q) + off; }
        const int nig = WGM * nN, gid = wgid / nig, fm = gid * WGM, gsz = (nM - fm) < WGM ? (nM - fm) : WGM;
        u.pm = fm + ((wgid % nig) % gsz); u.pn = (wgid % nig) / gsz; return true;
    }
    __device__ __forceinline__ void a_ready(const Unit&) const {}
    __device__ __forceinline__ void done(const Unit&) const {}
};

typedef float cvt_pk_bf16_f32x2 __attribute__((ext_vector_type(2))); typedef __bf16 cvt_pk_bf16_bf16x2 __attribute__((ext_vector_type(2)));
__device__ __forceinline__ unsigned cvt_pk_bf16(float lo, float hi) { const cvt_pk_bf16_f32x2 v = {lo, hi}; const cvt_pk_bf16_bf16x2 b = __builtin_convertvector(v, cvt_pk_bf16_bf16x2); return __builtin_bit_cast(unsigned, b); }
__device__ __forceinline__ uint2 pack8fp8(const f32x4& v0, const f32x4& v1) {
    int a = __builtin_amdgcn_cvt_pk_fp8_f32(v0[0], v0[1], 0, false); a = __builtin_amdgcn_cvt_pk_fp8_f32(v0[2], v0[3], a, true);
    int b = __builtin_amdgcn_cvt_pk_fp8_f32(v1[0], v1[1], 0, false); b = __builtin_amdgcn_cvt_pk_fp8_f32(v1[2], v1[3], b, true);
    return make_uint2((unsigned)a, (unsigned)b); }
__device__ __forceinline__ u32x4 pack8bf(const f32x4& v0, const f32x4& v1) { u32x4 w; w.x = cvt_pk_bf16(v0[0], v0[1]); w.y = cvt_pk_bf16(v0[2], v0[3]); w.z = cvt_pk_bf16(v1[0], v1[1]); w.w = cvt_pk_bf16(v1[2], v1[3]); return w; }

struct EpiStoreBf16 {
    static constexpr bool PERM = true, AFTER_DRAIN = false;
    bf16_t* O; int ldc;
    __device__ __forceinline__ void operator()(const f32x4 (&acc)[2][2][4][2], const Unit& u, int wr, int wc, int fr, int fq) const {
        const int row0 = u.pm * BM + wr * 64 + fr, col0 = u.pn * BM + wc * 32 + 8 * fq;
#pragma unroll
        for (int ai = 0; ai < 2; ++ai)
#pragma unroll
            for (int m = 0; m < 4; ++m) { bf16_t* rowp = O + (size_t)(row0 + ai * HALF + m * 16) * ldc + col0;
#pragma unroll
                for (int bj = 0; bj < 2; ++bj) *(u32x4*)(rowp + bj * HALF) = pack8bf(acc[ai][bj][m][0], acc[ai][bj][m][1]); }
    }
};
template <bool RES> struct EpiStoreF32 {
    static constexpr bool PERM = true, AFTER_DRAIN = false;
    float* O; const float* res; int ldc;
    __device__ __forceinline__ void operator()(const f32x4 (&acc)[2][2][4][2], const Unit& u, int wr, int wc, int fr, int fq) const {
        const int row0 = u.pm * BM + wr * 64 + fr, col0 = u.pn * BM + wc * 32 + 8 * fq;
#pragma unroll
        for (int ai = 0; ai < 2; ++ai)
#pragma unroll
            for (int m = 0; m < 4; ++m) { const size_t off = (size_t)(row0 + ai * HALF + m * 16) * ldc + col0;
#pragma unroll
                for (int bj = 0; bj < 2; ++bj) { f32x4 v0 = acc[ai][bj][m][0], v1 = acc[ai][bj][m][1];
                    if (RES) { v0 += *(const f32x4*)(res + off + bj * HALF); v1 += *(const f32x4*)(res + off + bj * HALF + 4); }
                    *(f32x4*)(O + off + bj * HALF) = v0; *(f32x4*)(O + off + bj * HALF + 4) = v1; } }
    }
};
#define EPI_LDSBAR() do { asm volatile("s_waitcnt lgkmcnt(0)" ::: "memory"); __builtin_amdgcn_s_barrier(); asm volatile("" ::: "memory"); } while (0)
struct EpiInProj {
    static constexpr bool PERM = true, AFTER_DRAIN = false;
    bf16_t *cq, *ckv, *fq, *fk, *fv; unsigned char* gates  ; bf16_t* kpe; float* lf; const float *b_gate, *b_forget; float* ssq; const float *gfq, *gfk; PG8_LAS float* xs;
    __device__ __forceinline__ void operator()(const f32x4 (&acc)[2][2][4][2], const Unit& u, int wr, int wc, int fr, int fq_) const {
        const int pn = u.pn, row0 = u.pm * BM + wr * 64 + fr, cw = wc * 32 + 8 * fq_;
        if (pn < 4) {
            bf16_t* base = pn < 2 ? cq : ckv; const int colt = (pn & 1) * 256;
#pragma unroll
            for (int ai = 0; ai < 2; ++ai)
#pragma unroll
                for (int m = 0; m < 4; ++m) { const int row = row0 + ai * HALF + m * 16; bf16_t* rowp = base + (size_t)row * 512 + colt + cw; float s = 0.f;
#pragma unroll
                    for (int bj = 0; bj < 2; ++bj) { const f32x4 v0 = acc[ai][bj][m][0], v1 = acc[ai][bj][m][1];
                        s += (v0[0] * v0[0] + v0[1] * v0[1]) + (v0[2] * v0[2] + v0[3] * v0[3]) + (v1[0] * v1[0] + v1[1] * v1[1]) + (v1[2] * v1[2] + v1[3] * v1[3]);
                        *(u32x4*)(rowp + bj * HALF) = pack8bf(v0, v1); }
                    s += __shfl_xor(s, 16); s += __shfl_xor(s, 32);
                    if (fq_ == 0) ssq[((size_t)pn * 8192 + row) * 4 + wc] = s; }
        } else if (pn < 20) {
            const bool isq = pn < 12; bf16_t* base = isq ? fq : fk; const int colt = (pn - (isq ? 4 : 12)) * 256; const float* g = isq ? gfq : gfk;
            const float qs = isq ? 0.12751743f : 1.f;
            const f32x4 g0 = *(const f32x4*)(g + cw) * qs, g1 = *(const f32x4*)(g + cw + 4) * qs;
#pragma unroll
            for (int ai = 0; ai < 2; ++ai)
#pragma unroll
                for (int m = 0; m < 4; ++m)
#pragma unroll
                    for (int bj = 0; bj < 2; ++bj) { const f32x4 v0 = acc[ai][bj][m][0], v1 = acc[ai][bj][m][1];
                        float s = (v0[0] * v0[0] + v0[1] * v0[1]) + (v0[2] * v0[2] + v0[3] * v0[3]) + (v1[0] * v1[0] + v1[1] * v1[1]) + (v1[2] * v1[2] + v1[3] * v1[3]);
                        s += __shfl_xor(s, 16); s += __shfl_xor(s, 32);
                        if (fq_ == 0) xs[((ai * HALF + wr * 64 + m * 16 + fr) * 2 + bj) * 4 + wc] = s; }
            EPI_LDSBAR();
#pragma unroll
            for (int ai = 0; ai < 2; ++ai)
#pragma unroll
                for (int m = 0; m < 4; ++m) {
#pragma unroll
                    for (int bj = 0; bj < 2; ++bj) { const f32x4 t4 = *(const PG8_LAS f32x4*)(xs + ((ai * HALF + wr * 64 + m * 16 + fr) * 2 + bj) * 4);
                        const float r = rsqrtf(((t4[0] + t4[1]) + (t4[2] + t4[3])) * (1.f / 128.f) + 1e-6f);
                        *(uint2*)((unsigned char*)base + (size_t)(row0 + ai * HALF + m * 16) * 2048 + colt + cw + bj * HALF) = pack8fp8(acc[ai][bj][m][0] * g0 * r, acc[ai][bj][m][1] * g1 * r); } }
        } else if (pn < 28) {
            const int colt = (pn - 20) * 256;
#pragma unroll
            for (int ai = 0; ai < 2; ++ai)
#pragma unroll
                for (int m = 0; m < 4; ++m) { unsigned char* rowp = (unsigned char*)fv + (size_t)(row0 + ai * HALF + m * 16) * 2048 + colt + cw;
#pragma unroll
                    for (int bj = 0; bj < 2; ++bj) *(uint2*)(rowp + bj * HALF) = pack8fp8(acc[ai][bj][m][0], acc[ai][bj][m][1]); }
        } else if (pn < 44) {
            const int colt = (pn - 28) * 256 + cw;
            f32x4 bb[2][2];
#pragma unroll
            for (int bj = 0; bj < 2; ++bj) { bb[bj][0] = *(const f32x4*)(b_gate + colt + bj * HALF); bb[bj][1] = *(const f32x4*)(b_gate + colt + bj * HALF + 4); }
#pragma unroll
            for (int bj = 0; bj < 2; ++bj) {
                const f32x4 b0 = bb[bj][0], b1 = bb[bj][1];
#pragma unroll
                for (int ai = 0; ai < 2; ++ai)
#pragma unroll
                    for (int m = 0; m < 4; ++m) {
                        f32x4 v0 = acc[ai][bj][m][0] + b0, v1 = acc[ai][bj][m][1] + b1;
#pragma unroll
                        for (int e = 0; e < 4; ++e) { v0[e] = __builtin_amdgcn_rcpf(1.f + __expf(-v0[e])); v1[e] = __builtin_amdgcn_rcpf(1.f + __expf(-v1[e])); }
                        { const f32x4 s0 = v0 * 255.f, s1 = v1 * 255.f;
                          unsigned w0 = 0u, w1 = 0u;
                          w0 = __builtin_amdgcn_cvt_pk_u8_f32(s0[0], 0, w0); w0 = __builtin_amdgcn_cvt_pk_u8_f32(s0[1], 1, w0); w0 = __builtin_amdgcn_cvt_pk_u8_f32(s0[2], 2, w0); w0 = __builtin_amdgcn_cvt_pk_u8_f32(s0[3], 3, w0);
                          w1 = __builtin_amdgcn_cvt_pk_u8_f32(s1[0], 0, w1); w1 = __builtin_amdgcn_cvt_pk_u8_f32(s1[1], 1, w1); w1 = __builtin_amdgcn_cvt_pk_u8_f32(s1[2], 2, w1); w1 = __builtin_amdgcn_cvt_pk_u8_f32(s1[3], 3, w1);
                          *(uint2*)(gates + (size_t)(row0 + ai * HALF + m * 16) * 4096 + colt + bj * HALF) = make_uint2(w0, w1); } }
            }
        } else {
            if (cw < 64) {
#pragma unroll
                for (int ai = 0; ai < 2; ++ai)
#pragma unroll
                    for (int m = 0; m < 4; ++m) *(u32x4*)(kpe + (size_t)(row0 + ai * HALF + m * 16) * 64 + cw) = pack8bf(acc[ai][0][m][0], acc[ai][0][m][1]);
            } else if (cw < 80) {
                const int h0 = cw - 64;
                const f32x4 b0 = *(const f32x4*)(b_forget + h0), b1 = *(const f32x4*)(b_forget + h0 + 4);
#pragma unroll
                for (int ai = 0; ai < 2; ++ai)
#pragma unroll
                    for (int m = 0; m < 4; ++m) { const int row = row0 + ai * HALF + m * 16;
                        f32x4 z0 = acc[ai][0][m][0] + b0, z1 = acc[ai][0][m][1] + b1;
#pragma unroll
                        for (int e = 0; e < 4; ++e) { z0[e] = fminf(z0[e], 0.f) - __logf(1.f + __expf(-fabsf(z0[e]))); z1[e] = fminf(z1[e], 0.f) - __logf(1.f + __expf(-fabsf(z1[e]))); }
                        *(f32x4*)(lf + (size_t)row * 16 + h0) = z0; *(f32x4*)(lf + (size_t)row * 16 + h0 + 4) = z1; }
            }
        }
    }
};
__device__ __forceinline__ float lat_rinv(const float* ssq, int part0, int row) {
    const f32x4 a = *(const f32x4*)(ssq + ((size_t)part0 * 8192 + row) * 4), b = *(const f32x4*)(ssq + ((size_t)(part0 + 1) * 8192 + row) * 4);
    return rsqrtf((((a[0] + a[1]) + (a[2] + a[3])) + ((b[0] + b[1]) + (b[2] + b[3]))) * (1.f / 512.f) + 1e-6f);
}
struct EpiQ {
    static constexpr bool PERM = true, AFTER_DRAIN = false;
    bf16_t* qa; const float* ssq; const float* gq; const float2* ropeT; PG8_LAS float* xs;
    __device__ __forceinline__ void operator()(const f32x4 (&acc)[2][2][4][2], const Unit& u, int wr, int wc, int fr, int fq_) const {
        const int h = u.pn, row0 = u.pm * BM + wr * 64 + fr, cw = wc * 32 + 8 * fq_;
        float rl[2][4];
#pragma unroll
        for (int ai = 0; ai < 2; ++ai)
#pragma unroll
            for (int m = 0; m < 4; ++m) rl[ai][m] = lat_rinv(ssq, 0, row0 + ai * HALF + m * 16);
#pragma unroll
        for (int ai = 0; ai < 2; ++ai)
#pragma unroll
            for (int m = 0; m < 4; ++m) { float s = 0.f;
#pragma unroll
                for (int bj = 0; bj < 2; ++bj) { const f32x4 v0 = acc[ai][bj][m][0], v1 = acc[ai][bj][m][1];
                    s += (v0[0] * v0[0] + v0[1] * v0[1]) + (v0[2] * v0[2] + v0[3] * v0[3]) + (v1[0] * v1[0] + v1[1] * v1[1]) + (v1[2] * v1[2] + v1[3] * v1[3]); }
                s *= rl[ai][m] * rl[ai][m];
                s += __shfl_xor(s, 16); s += __shfl_xor(s, 32);
                if (fq_ == 0) xs[(ai * HALF + wr * 64 + m * 16 + fr) * 4 + wc] = s; }
        const float qs = 0.10411754f;
        const f32x4 g0 = *(const f32x4*)(gq + cw) * qs, g1 = *(const f32x4*)(gq + cw + 4) * qs;
        const int pp = 16 * (wc & 1) + 4 * fq_;
        const f32x4 ga = *(const f32x4*)(gq + 128 + pp) * qs, gb = *(const f32x4*)(gq + 160 + pp) * qs;
        EPI_LDSBAR();
#pragma unroll
        for (int ai = 0; ai < 2; ++ai) {
            f32x4 rc0[4], rc1[4];
            if (wc < 2) {
#pragma unroll
                for (int m = 0; m < 4; ++m) { const size_t ro = (size_t)(row0 + ai * HALF + m * 16) * 32 + pp; rc0[m] = *(const f32x4*)(ropeT + ro); rc1[m] = *(const f32x4*)(ropeT + ro + 2); } }
#pragma unroll
            for (int m = 0; m < 4; ++m) { const int row = row0 + ai * HALF + m * 16;
                const f32x4 t4 = *(const PG8_LAS f32x4*)(xs + (ai * HALF + wr * 64 + m * 16 + fr) * 4);
                const float r = rsqrtf(((t4[0] + t4[1]) + (t4[2] + t4[3])) * (1.f / 192.f) + 1e-6f) * rl[ai][m];
                unsigned char* rowp = (unsigned char*)qa + (size_t)row * 3072 + h * 192;
                *(uint2*)(rowp + cw) = pack8fp8(acc[ai][0][m][0] * g0 * r, acc[ai][0][m][1] * g1 * r);
                if (wc < 2) { const f32x4 c01 = rc0[m], c23 = rc1[m];
                    const f32x4 z0 = acc[ai][1][m][0] * r, z1 = acc[ai][1][m][1] * r;
                    const float a0 = z0[0] * ga[0], b0 = z0[1] * gb[0], a1 = z0[2] * ga[1], b1 = z0[3] * gb[1], a2 = z1[0] * ga[2], b2 = z1[1] * gb[2], a3 = z1[2] * ga[3], b3 = z1[3] * gb[3];
                    const f32x4 o0 = {a0 * c01[0] - b0 * c01[1], a0 * c01[1] + b0 * c01[0], a1 * c01[2] - b1 * c01[3], a1 * c01[3] + b1 * c01[2]};
                    const f32x4 o1 = {a2 * c23[0] - b2 * c23[1], a2 * c23[1] + b2 * c23[0], a3 * c23[2] - b3 * c23[3], a3 * c23[3] + b3 * c23[2]};
                    *(uint2*)(rowp + 128 + cw) = pack8fp8(o0, o1); } }
        }
    }
};
struct EpiKV {
    static constexpr bool PERM = true, AFTER_DRAIN = false;
    bf16_t *ka, *va; const bf16_t* kpe; const float* ssq; const float* gk; const float2* ropeT; PG8_LAS float* xs;
    __device__ __forceinline__ void operator()(const f32x4 (&acc)[2][2][4][2], const Unit& u, int wr, int wc, int fr, int fq_) const {
        int cw = wc * 32 + 8 * fq_; asm volatile("" : "+v"(cw));
        const int h = u.pn, row0 = u.pm * BM + wr * 64 + fr;
        float rl[2][4]; f32x4 kp[2][4];
#pragma unroll
        for (int ai = 0; ai < 2; ++ai)
#pragma unroll
            for (int m = 0; m < 4; ++m) { const int row = row0 + ai * HALF + m * 16; rl[ai][m] = lat_rinv(ssq, 2, row);
                const uint2 w = *(const uint2*)(kpe + (size_t)row * 64 + 16 * wc + 4 * fq_);
                kp[ai][m] = (f32x4){__uint_as_float(w.x << 16), __uint_as_float(w.x & 0xffff0000u), __uint_as_float(w.y << 16), __uint_as_float(w.y & 0xffff0000u)}; }
#pragma unroll
        for (int ai = 0; ai < 2; ++ai)
#pragma unroll
            for (int m = 0; m < 4; ++m) {
                const f32x4 v0 = acc[ai][0][m][0], v1 = acc[ai][0][m][1];
                float s = ((v0[0] * v0[0] + v0[1] * v0[1]) + (v0[2] * v0[2] + v0[3] * v0[3]) + (v1[0] * v1[0] + v1[1] * v1[1]) + (v1[2] * v1[2] + v1[3] * v1[3])) * (rl[ai][m] * rl[ai][m]);
                s += (kp[ai][m][0] * kp[ai][m][0] + kp[ai][m][1] * kp[ai][m][1]) + (kp[ai][m][2] * kp[ai][m][2] + kp[ai][m][3] * kp[ai][m][3]);
                s += __shfl_xor(s, 16); s += __shfl_xor(s, 32);
                if (fq_ == 0) xs[(ai * HALF + wr * 64 + m * 16 + fr) * 4 + wc] = s; }
        const int pp = 8 * wc + 2 * fq_;
#pragma unroll
        for (int ai = 0; ai < 2; ++ai)
#pragma unroll
            for (int m = 0; m < 4; ++m) *(uint2*)((unsigned char*)va + (size_t)(row0 + ai * HALF + m * 16) * 2048 + h * 128 + cw) = pack8fp8(acc[ai][1][m][0] * rl[ai][m], acc[ai][1][m][1] * rl[ai][m]);
        const f32x4 g0 = *(const f32x4*)(gk + cw), g1 = *(const f32x4*)(gk + cw + 4);
        const float ga0 = gk[128 + pp], ga1 = gk[128 + pp + 1], gb0 = gk[160 + pp], gb1 = gk[160 + pp + 1];
        EPI_LDSBAR();
#pragma unroll
        for (int ai = 0; ai < 2; ++ai) {
            f32x4 rcs[4];
#pragma unroll
            for (int m = 0; m < 4; ++m) rcs[m] = *(const f32x4*)(ropeT + (size_t)(row0 + ai * HALF + m * 16) * 32 + pp);
#pragma unroll
            for (int m = 0; m < 4; ++m) { const int row = row0 + ai * HALF + m * 16;
                const f32x4 t4 = *(const PG8_LAS f32x4*)(xs + (ai * HALF + wr * 64 + m * 16 + fr) * 4);
                const float r = rsqrtf(((t4[0] + t4[1]) + (t4[2] + t4[3])) * (1.f / 192.f) + 1e-6f), rn = r * rl[ai][m];
                unsigned char* rowp = (unsigned char*)ka + (size_t)row * 3072 + h * 192;
                *(uint2*)(rowp + cw) = pack8fp8(acc[ai][0][m][0] * g0 * rn, acc[ai][0][m][1] * g1 * rn);
                const f32x4 cs = rcs[m];
                const float a0 = kp[ai][m][0] * r * ga0, b0 = kp[ai][m][1] * r * gb0, a1 = kp[ai][m][2] * r * ga1, b1 = kp[ai][m][3] * r * gb1;
                int o = __builtin_amdgcn_cvt_pk_fp8_f32(a0 * cs[0] - b0 * cs[1], a0 * cs[1] + b0 * cs[0], 0, false); o = __builtin_amdgcn_cvt_pk_fp8_f32(a1 * cs[2] - b1 * cs[3], a1 * cs[3] + b1 * cs[2], o, true);
                *(unsigned*)(rowp + 128 + 16 * wc + 4 * fq_) = (unsigned)o; }
        }
    }
};

struct EpiX1 {
    static constexpr bool PERM = true, AFTER_DRAIN = false;
    float* x1; const float* x; bf16_t* xg; const float* g; float* ssq2;
    __device__ __forceinline__ void operator()(const f32x4 (&acc)[2][2][4][2], const Unit& u, int wr, int wc, int fr, int fq_) const {
        const int row0 = u.pm * BM + wr * 64 + fr, col0 = u.pn * BM + wc * 32 + 8 * fq_;
        f32x4 gg[2][2];
#pragma unroll
        for (int bj = 0; bj < 2; ++bj) { gg[bj][0] = *(const f32x4*)(g + col0 + bj * HALF); gg[bj][1] = *(const f32x4*)(g + col0 + bj * HALF + 4); }
#pragma unroll
        for (int am = 0; am < 4; ++am) { const int ai = am >> 1;
            f32x4 xr[4][2][2];
#pragma unroll
            for (int m = 2 * (am & 1); m < 2 * (am & 1) + 2; ++m)
#pragma unroll
                for (int bj = 0; bj < 2; ++bj) { const size_t off = (size_t)(row0 + ai * HALF + m * 16) * 2048 + col0 + bj * HALF; xr[m][bj][0] = *(const f32x4*)(x + off); xr[m][bj][1] = *(const f32x4*)(x + off + 4); }
#pragma unroll
            for (int m = 2 * (am & 1); m < 2 * (am & 1) + 2; ++m) { const int row = row0 + ai * HALF + m * 16; const size_t off = (size_t)row * 2048 + col0; float s = 0.f;
#pragma unroll
                for (int bj = 0; bj < 2; ++bj) { const f32x4 v0 = acc[ai][bj][m][0] + xr[m][bj][0], v1 = acc[ai][bj][m][1] + xr[m][bj][1];
                    *(f32x4*)(x1 + off + bj * HALF) = v0; *(f32x4*)(x1 + off + bj * HALF + 4) = v1;
                    s += (v0[0] * v0[0] + v0[1] * v0[1]) + (v0[2] * v0[2] + v0[3] * v0[3]) + (v1[0] * v1[0] + v1[1] * v1[1]) + (v1[2] * v1[2] + v1[3] * v1[3]);
                    *(u32x4*)(xg + off + bj * HALF) = pack8bf(v0 * gg[bj][0], v1 * gg[bj][1]); }
                s += __shfl_xor(s, 16); s += __shfl_xor(s, 32);
                if (fq_ == 0) ssq2[((size_t)u.pn * 8192 + row) * 4 + wc] = s; }
        }
    }
};
__device__ __forceinline__ float ffn_rinv(const float* ssq2, int row) {
    float t = 0.f;
#pragma unroll
    for (int pn = 0; pn < 8; ++pn) { const f32x4 a = *(const f32x4*)(ssq2 + ((size_t)pn * 8192 + row) * 4); t += (a[0] + a[1]) + (a[2] + a[3]); }
    return rsqrtf(t * (1.f / 2048.f) + 1e-6f);
}
struct EpiScores {
    static constexpr bool PERM = true, AFTER_DRAIN = false;
    float* O; const float* ssq2;
    __device__ __forceinline__ void operator()(const f32x4 (&acc)[2][2][4][2], const Unit& u, int wr, int wc, int fr, int fq_) const {
        const int row0 = u.pm * BM + wr * 64 + fr, col0 = u.pn * BM + wc * 32 + 8 * fq_;
        float rr[2][4];
#pragma unroll
        for (int ai = 0; ai < 2; ++ai)
#pragma unroll
            for (int m = 0; m < 4; ++m) rr[ai][m] = ffn_rinv(ssq2, row0 + ai * HALF + m * 16);
#pragma unroll
        for (int ai = 0; ai < 2; ++ai)
#pragma unroll
            for (int m = 0; m < 4; ++m) { const int row = row0 + ai * HALF + m * 16; const float r = rr[ai][m]; const size_t off = (size_t)row * 2048 + col0;
#pragma unroll
                for (int bj = 0; bj < 2; ++bj) { *(f32x4*)(O + off + bj * HALF) = acc[ai][bj][m][0] * r; *(f32x4*)(O + off + bj * HALF + 4) = acc[ai][bj][m][1] * r; } }
    }
};
template <class Epi, class Sched, bool ALIGN_EPI = false, bool SP2 = false>
__device__ __forceinline__ void gemm_phase(PG8_LAS unsigned char* lds, const Gemm g, const Sched& S, const Epi& E) {
    int tid = threadIdx.x; asm volatile("" : "+v"(tid));
    const int wid = __builtin_amdgcn_readfirstlane(tid >> 6), lane = tid & 63, wr = wid >> 2, wc = wid & 3, fr = lane & 15, fq = lane >> 4;
    const int K = g.K, nt = K / BK;
    unsigned voffA[2], voffB[2];
#pragma unroll
    for (int i = 0; i < 2; ++i) { int R, C; stage_rc(tid * 16 + i * 8192, R, C); const int Rb = Epi::PERM ? ((R & ~31) + perm32(R & 31)) : R;
        voffA[i] = (unsigned)(R * K + C) * 2u; voffB[i] = (unsigned)(Rb * K + C) * 2u; }
    const size_t kstep = (size_t)(BK * 2);
    const size_t hstep = (size_t)HALF * K * 2;
    const size_t tstep = 2 * hstep;
    const unsigned ldsw = (unsigned)wid * 1024u;
    const int aoff = lds_byte(wr * 64 + fr, fq * 8), boff = lds_byte(wc * 32 + fr, fq * 8);
#define PG8_SA(b, h) (((b) * 2 + (h)) * HTB)
#define PG8_SB(b, h) ((4 + (b) * 2 + (h)) * HTB)
#define PG8_STAGE(bufoff, gbase, voff) do { _Pragma("unroll") for (int _i = 0; _i < 2; ++_i) \
        __builtin_amdgcn_global_load_lds((const unsigned*)((const char*)(gbase) + (voff)[_i]), (PG8_LAS unsigned*)(lds + (bufoff) + ldsw + _i * 8192), 16, 0, 0); } while (0)
#define PG8_LDA(dst, b, h) do { _Pragma("unroll") for (int m = 0; m < 4; ++m) _Pragma("unroll") for (int k = 0; k < 2; ++k) dst[m][k] = *(const PG8_LAS bf16x8*)(lds + PG8_SA(b, h) + aoff + m * 2048 + k * 1024); } while (0)
#define PG8_LDB(dst, b, h) do { _Pragma("unroll") for (int n = 0; n < 2; ++n) _Pragma("unroll") for (int k = 0; k < 2; ++k) dst[n][k] = *(const PG8_LAS bf16x8*)(lds + PG8_SB(b, h) + boff + n * 2048 + k * 1024); } while (0)
#define PG8_MMA(ai, bj, At, Bt) do { __builtin_amdgcn_s_setprio(1); _Pragma("unroll") for (int m = 0; m < 4; ++m) _Pragma("unroll") for (int n = 0; n < 2; ++n) _Pragma("unroll") for (int k = 0; k < 2; ++k) \
        acc[ai][bj][m][n] = __builtin_amdgcn_mfma_f32_16x16x32_bf16(Bt[n][k], At[m][k], acc[ai][bj][m][n], 0, 0, 0); __builtin_amdgcn_s_setprio(0); } while (0)
#define PG8_WAIT_V(n) asm volatile("s_waitcnt vmcnt(" #n ")" ::: "memory")
#define PG8_WAIT_L(n) asm volatile("s_waitcnt lgkmcnt(" #n ")" ::: "memory")
#define PG8_BAR __builtin_amdgcn_s_barrier()
#define PG8_SCHED __builtin_amdgcn_sched_barrier(0)
    Unit cur, nxt; int ui = 0;
    if (!S.next(0, cur)) return;
    f32x4 acc[2][2][4][2];
#pragma unroll
    for (int a = 0; a < 2; ++a)
#pragma unroll
        for (int b = 0; b < 2; ++b)
#pragma unroll
            for (int m = 0; m < 4; ++m)
#pragma unroll
                for (int n = 0; n < 2; ++n) acc[a][b][m][n] = (f32x4){0.f, 0.f, 0.f, 0.f};
    bf16x8 At[4][2], B0[2][2], B1[2][2];
    const char* cA = (const char*)g.A + (size_t)cur.pm * tstep; const char* cB = (const char*)g.Bt + (size_t)cur.pn * tstep;
    S.a_ready(cur);
    if constexpr (SP2) {
        PG8_STAGE(PG8_SB(0, 0), cB, voffB); PG8_STAGE(PG8_SB(0, 1), cB + hstep, voffB); PG8_STAGE(PG8_SA(0, 0), cA, voffA); PG8_STAGE(PG8_SA(0, 1), cA + hstep, voffA);
        if (wr == 1) PG8_BAR;
        PG8_WAIT_V(2); PG8_BAR;
        PG8_STAGE(PG8_SB(1, 0), cB + kstep, voffB); PG8_STAGE(PG8_SA(1, 0), cA + kstep, voffA); PG8_STAGE(PG8_SB(1, 1), cB + hstep + kstep, voffB);
        PG8_WAIT_V(6); PG8_BAR;
    } else {
        PG8_STAGE(PG8_SB(0, 0), cB, voffB); PG8_STAGE(PG8_SA(0, 0), cA, voffA); PG8_STAGE(PG8_SB(0, 1), cB + hstep, voffB); PG8_STAGE(PG8_SA(0, 1), cA + hstep, voffA);
        if (wr == 1) PG8_BAR;
        PG8_WAIT_V(4); PG8_BAR;
        PG8_STAGE(PG8_SB(1, 0), cB + kstep, voffB); PG8_STAGE(PG8_SA(1, 0), cA + kstep, voffA); PG8_STAGE(PG8_SB(1, 1), cB + hstep + kstep, voffB);
        PG8_WAIT_V(6); PG8_BAR;
    }
    for (;;) {
        const bool has_next = S.next(ui + 1, nxt);
        const char* nA = has_next ? (const char*)g.A + (size_t)nxt.pm * tstep : cA; const char* nB = has_next ? (const char*)g.Bt + (size_t)nxt.pn * tstep : cB;
        for (int t = 0; t < nt; t += 2) {
            const bool last = (t == nt - 2);
            const char* a1 = cA + (size_t)(t + 1) * kstep;
            const char* a2 = last ? nA : cA + (size_t)(t + 2) * kstep; const char* b2 = last ? nB : cB + (size_t)(t + 2) * kstep;
            const char* a3 = a2 + kstep; const char* b3 = b2 + kstep;
            if (last && has_next) S.a_ready(nxt);
            if constexpr (SP2) {
            PG8_LDB(B0, 0, 0); PG8_LDB(B1, 0, 1); PG8_SCHED; PG8_LDA(At, 0, 0); PG8_STAGE(PG8_SA(1, 1), a1 + hstep, voffA);
            PG8_WAIT_V(8); PG8_WAIT_L(0); PG8_BAR; PG8_MMA(0, 0, At, B0); PG8_MMA(0, 1, At, B1); PG8_BAR; PG8_SCHED;
            PG8_LDA(At, 0, 1); PG8_STAGE(PG8_SB(0, 0), b2, voffB); PG8_STAGE(PG8_SB(0, 1), b2 + hstep, voffB); PG8_STAGE(PG8_SA(0, 0), a2, voffA);
            PG8_WAIT_V(8); PG8_WAIT_L(0); PG8_BAR; PG8_MMA(1, 0, At, B0); PG8_MMA(1, 1, At, B1); PG8_BAR; PG8_SCHED;
            PG8_LDB(B0, 1, 0); PG8_LDB(B1, 1, 1); PG8_SCHED; PG8_LDA(At, 1, 0); PG8_STAGE(PG8_SA(0, 1), a2 + hstep, voffA);
            PG8_WAIT_V(8); PG8_WAIT_L(0); PG8_BAR; PG8_MMA(0, 0, At, B0); PG8_MMA(0, 1, At, B1); PG8_BAR; PG8_SCHED;
            PG8_LDA(At, 1, 1); PG8_STAGE(PG8_SB(1, 0), b3, voffB); PG8_STAGE(PG8_SB(1, 1), b3 + hstep, voffB); PG8_STAGE(PG8_SA(1, 0), a3, voffA);
            PG8_WAIT_V(8); PG8_WAIT_L(0); PG8_BAR; PG8_MMA(1, 0, At, B0); PG8_MMA(1, 1, At, B1); PG8_BAR; PG8_SCHED;
            } else {
            PG8_LDB(B0, 0, 0); PG8_SCHED; PG8_LDA(At, 0, 0); PG8_STAGE(PG8_SA(1, 1), a1 + hstep, voffA);
            PG8_WAIT_L(8); PG8_BAR; PG8_WAIT_L(0); PG8_MMA(0, 0, At, B0); PG8_BAR; PG8_SCHED;
            PG8_LDB(B1, 0, 1); PG8_STAGE(PG8_SB(0, 0), b2, voffB);
            PG8_BAR; PG8_WAIT_L(0); PG8_MMA(0, 1, At, B1); PG8_BAR;
            PG8_LDA(At, 0, 1); PG8_STAGE(PG8_SA(0, 0), a2, voffA);
            PG8_BAR; PG8_WAIT_L(0); PG8_MMA(1, 0, At, B0); PG8_BAR; PG8_SCHED;
            PG8_STAGE(PG8_SB(0, 1), b2 + hstep, voffB);
            PG8_WAIT_V(6); PG8_BAR; PG8_MMA(1, 1, At, B1); PG8_BAR;
            PG8_LDB(B0, 1, 0); PG8_SCHED; PG8_LDA(At, 1, 0); PG8_STAGE(PG8_SA(0, 1), a2 + hstep, voffA);
            PG8_WAIT_L(8); PG8_BAR; PG8_WAIT_L(0); PG8_MMA(0, 0, At, B0); PG8_BAR; PG8_SCHED;
            PG8_LDB(B1, 1, 1); PG8_STAGE(PG8_SB(1, 0), b3, voffB);
            PG8_BAR; PG8_WAIT_L(0); PG8_MMA(0, 1, At, B1); PG8_BAR;
            PG8_LDA(At, 1, 1); PG8_STAGE(PG8_SA(1, 0), a3, voffA);
            PG8_BAR; PG8_WAIT_L(0); PG8_MMA(1, 0, At, B0); PG8_BAR; PG8_SCHED;
            PG8_STAGE(PG8_SB(1, 1), b3 + hstep, voffB);
            PG8_WAIT_V(6); PG8_BAR; PG8_MMA(1, 1, At, B1); PG8_BAR;
            }
        }
        if constexpr (ALIGN_EPI) { if (wr == 0) PG8_BAR; }
        if constexpr (!Epi::AFTER_DRAIN) { E(acc, cur, wr, wc, fr, fq); S.done(cur); }
        if (!has_next) break;
#pragma unroll
        for (int a = 0; a < 2; ++a)
#pragma unroll
            for (int b = 0; b < 2; ++b)
#pragma unroll
                for (int m = 0; m < 4; ++m)
#pragma unroll
                    for (int n = 0; n < 2; ++n) acc[a][b][m][n] = (f32x4){0.f, 0.f, 0.f, 0.f};
        cur = nxt; cA = nA; cB = nB; ++ui;
        if constexpr (ALIGN_EPI) { if (wr == 1) PG8_BAR; }
    }
    PG8_WAIT_V(0);
    if constexpr (!ALIGN_EPI) { if (wr == 0) PG8_BAR; }
    PG8_BAR;
    if constexpr (Epi::AFTER_DRAIN) { E.fused(acc, cur, wr, wc, fr, fq, lds, wid, lane); S.done(cur); }
#undef PG8_SA
#undef PG8_SB
#undef PG8_STAGE
#undef PG8_LDA
#undef PG8_LDB
#undef PG8_MMA
#undef PG8_WAIT_V
#undef PG8_WAIT_L
#undef PG8_BAR
#undef PG8_SCHED
}
}
namespace att {
typedef unsigned short bf16_t;
typedef short bf16x8 __attribute__((ext_vector_type(8)));
typedef short s16x4 __attribute__((ext_vector_type(4)));
typedef float f32x16 __attribute__((ext_vector_type(16)));
typedef float f32x4 __attribute__((ext_vector_type(4)));
typedef unsigned u32x4 __attribute__((ext_vector_type(4)));
#define ALAS __attribute__((address_space(3)))
#define ASBAR() __builtin_amdgcn_sched_barrier(0)
constexpr int SHM_V = 16384;
template <int DK> struct Lay { static constexpr int ROWB = DK  , SHM_K = 64 * ROWB, OFF_K = 2 * SHM_V, OFF_F = OFF_K + 2 * SHM_K, OFF_WS = OFF_F + 512, TOTAL = OFF_WS + 8 * 256; };

__device__ __forceinline__ int v_st(int k, int c) { const int kk = (k & ~0xC) | ((k & 4) << 1) | ((k & 8) >> 1); return ((kk >> 3) * 4 + (c >> 5)) * 512 + ((kk & 7) * 32 + (c & 31)) * 2; }
__device__ __forceinline__ int v_rd_base(int lane) { return ((lane & 3) << 3) | (((lane >> 2) & 3) << 6) | (((lane >> 4) & 1) << 5) | (((lane >> 5) & 1) << 8); }
__device__ __forceinline__ int crow(int r, int hi) { return (r & 3) + 8 * (r >> 2) + 4 * hi; }
typedef float cvtpk_f32x2 __attribute__((ext_vector_type(2))); typedef __bf16 cvtpk_bf16x2 __attribute__((ext_vector_type(2)));
__device__ __forceinline__ unsigned cvtpk(float lo, float hi) { const cvtpk_f32x2 v = {lo, hi}; const cvtpk_bf16x2 b = __builtin_convertvector(v, cvtpk_bf16x2); return __builtin_bit_cast(unsigned, b); }

__device__ __forceinline__ float wave_max_f(float v) {
#pragma unroll
    for (int o = 32; o >= 1; o >>= 1) v = fmaxf(v, __shfl_xor(v, o));
    return v;
}
__device__ __forceinline__ float att_max3(float a, float b, float c) { return __builtin_fmaxf(__builtin_fmaxf(a, b), c); }
typedef float f32x16v __attribute__((ext_vector_type(16)));
typedef unsigned u32x6v __attribute__((ext_vector_type(6)));
constexpr int ROW6 = 1536;
__device__ __forceinline__ void fp6_put(unsigned char* __restrict__ T6, int row, int hf, int l, int g, f32x16v f0, f32x16v f1, float sc) {
    f0 *= sc; f1 *= sc;
    f32x16v ev, od;
#pragma unroll
    for (int k = 0; k < 8; ++k) { ev[k] = f0[2 * k]; od[k] = f0[2 * k + 1]; ev[8 + k] = f1[2 * k]; od[8 + k] = f1[2 * k + 1]; }
    const u32x6v w = __builtin_amdgcn_cvt_scalef32_2xpk16_fp6_f32(ev, od, 1.0f);
    unsigned char* base = T6 + (size_t)row * ROW6 + hf * 768 + l * 16;
    if (g == 0) { *(u32x4*)base = (u32x4){w[0], w[1], w[2], w[3]}; *(uint2*)(base + 256) = make_uint2(w[4], w[5]); }
    else { *(uint2*)(base + 264) = make_uint2(w[0], w[1]); *(u32x4*)(base + 512) = (u32x4){w[2], w[3], w[4], w[5]}; }
}
constexpr int SIDE_STG = 86016;
template <int DK, bool FOX, bool NOMAX>
__device__ __forceinline__ void attn_block(unsigned char* smem, const bf16_t* __restrict__ Q, int ldq, const bf16_t* __restrict__ K, int ldk, const bf16_t* __restrict__ V, int ldv,
                                           const float* __restrict__ Fh, const unsigned char* __restrict__ gate  , bf16_t* __restrict__ gout  , int qbk, float qk_bound_in  ,
                                           const float* __restrict__ side_u, const float* __restrict__ side_v, unsigned char* __restrict__ side_u8, unsigned char* __restrict__ side_v8, int& side_next) {
    typedef Lay<DK> LY;
    constexpr int ND = DK / 16, NKC = DK / 16;
    int tid = threadIdx.x; asm volatile("" : "+v"(tid));
    const int wid = __builtin_amdgcn_readfirstlane(tid >> 6), lane = tid & 63, r32 = lane & 31, hi = lane >> 5;
    const int q0 = qbk * 256, qlo = q0 + wid * 32, qm = qlo + r32 - 4 * hi;
    const int NT = 4 * qbk + 4;
    ALAS unsigned char* lds = (ALAS unsigned char*)smem;
    ALAS float* F_lds = (ALAS float*)(lds + LY::OFF_F);
    ALAS float* wsl = (ALAS float*)(lds + LY::OFF_WS) + wid * 64;
    constexpr int NJ = DK / 32;
    u32x4 qv[NJ];
#pragma unroll
    for (int j = 0; j < NJ; ++j) qv[j] = *(const u32x4*)((const unsigned char*)Q + (size_t)(qlo + r32) * ldq + (2 * j + hi) * 16);
    const float fq = FOX ? Fh[qlo + r32] : 0.f;
    int kgo[2], vgo[2];
#pragma unroll
    for (int i = 0; i < 2; ++i) { const int pp = ((wid + 8 * i) * 64 + lane) % (64 * NKC), row = pp / NKC, cpos = pp % NKC, ch = cpos ^ (DK == 192 ? ((row >> 2) & 3) : ((row >> 1) & 7)); kgo[i] = row * ldk + ch * 16; }
    { const int pp = wid * 64 + lane; vgo[0] = (pp >> 3) * ldv + (pp & 7) * 16; vgo[1] = 0; }
    int vkb[4];
    { const int li = lane & 15, rr = li >> 1, cc = li & 1, ch = (lane >> 4) & 1;
#pragma unroll
      for (int a4 = 0; a4 < 4; ++a4) { const int key = (rr & 3) + 8 * ((2 * a4 + (rr >> 2)) & 3) + 4 * hi + 32 * (a4 >> 1); vkb[a4] = (int)(uintptr_t)smem + key * 128 + ch * 16 + cc * 8; } }
    constexpr int NKB = DK == 192 ? 2 : 4;
    int kbase[NKB];
#pragma unroll
    for (int jj = 0; jj < NKB; ++jj) kbase[jj] = LY::OFF_K + r32 * LY::ROWB + (((2 * jj + hi) ^ (DK == 192 ? ((r32 >> 2) & 3) : ((r32 >> 1) & 7))) << 4);
    float stf = 0.f;
#define ATT_GLDS(kb, bf) do { _Pragma("unroll") for (int i = 0; i < 2; ++i) if (wid + 8 * i < NKC) \
            __builtin_amdgcn_global_load_lds((const unsigned*)((const unsigned char*)K + (size_t)(kb) * ldk + kgo[i]), (ALAS unsigned*)(lds + LY::OFF_K + (bf) * LY::SHM_K + (wid + 8 * i) * 1024), 16, 0, 0); \
        __builtin_amdgcn_global_load_lds((const unsigned*)((const unsigned char*)V + (size_t)(kb) * ldv + vgo[0]), (ALAS unsigned*)(lds + (bf) * SHM_V + wid * 1024), 16, 0, 0); \
        if (FOX && tid < 64) stf = Fh[(kb) + tid]; } while (0)
#define ATT_WRITEF(bf) do { if (FOX && tid < 64) F_lds[(bf) * 64 + tid] = stf; } while (0)
    int t_start = 0; float m_init = 0.f;
    if (FOX) {
        const float qk_bound = qk_bound_in;
        const float thr = 2.02f * qk_bound + 24.f, f0 = Fh[q0]; m_init = -thr;
        const int j0 = lane, j1 = lane + 64;
        const float fa0 = Fh[(j0 < 4 * qbk ? j0 : 0) * 64 + 63], fa1 = Fh[(j1 < 4 * qbk ? j1 : 0) * 64 + 63];
        const bool c0 = (j0 < 4 * qbk) & (fa0 - f0 >= thr), c1 = (j1 < 4 * qbk) & (fa1 - f0 >= thr);
        t_start = __builtin_popcountll(__ballot(c0)) + __builtin_popcountll(__ballot(c1));
        t_start = __builtin_amdgcn_readfirstlane(t_start); }
    ATT_GLDS(t_start * 64, t_start & 1); ATT_WRITEF(t_start & 1);
    float m_reg = FOX ? m_init : 0.f, l_reg = 0.f; f32x16 o[4];
#pragma unroll
    for (int d = 0; d < 4; ++d)
#pragma unroll
        for (int r = 0; r < 16; ++r) o[d][r] = 0.f;
    int side_pend = -1;
    for (int t = t_start; t < NT; ++t) {
        const int buf = t & 1, kb = t * 64;
        asm volatile("s_waitcnt vmcnt(0)" ::: "memory");
        __syncthreads();
        if (t + 1 < NT) ATT_GLDS(kb + 64, buf ^ 1);
        if (side_pend >= 0) { const int sv = side_pend; side_pend = -1;
            if ((wid >> 2) == (sv & 1)) {
                const int c = tid & 255, rr = c >> 6, hf2 = (c >> 5) & 1, l = (c >> 1) & 15, g = c & 1;
                const ALAS float* sp = (const ALAS float*)(lds + SIDE_STG) + rr * 2048 + hf2 * 1024 + (2 * g) * 256 + l * 16;
                f32x16v f0, f1;
#pragma unroll
                for (int k = 0; k < 4; ++k) { const f32x4 a = *(const ALAS f32x4*)(sp + 4 * k), b2 = *(const ALAS f32x4*)(sp + 256 + 4 * k);
#pragma unroll
                    for (int e = 0; e < 4; ++e) { f0[4 * k + e] = a[e]; f1[4 * k + e] = b2[e]; } }
                const bool isv = sv >= 16;
                fp6_put(isv ? side_v8 : side_u8, blockIdx.x * 64 + (sv & 15) * 4 + rr, hf2, l, g, f0, f1, isv ? 4.f : 64.f); }
        } else if (side_next < 32 && t + 1 < NT) { const int sv = side_next; const bool isv = sv >= 16;
            const float* src = (isv ? side_v : side_u) + (size_t)(blockIdx.x * 64 + (sv & 15) * 4) * 2048;
#pragma unroll
            for (int i = 0; i < 4; ++i)
                __builtin_amdgcn_global_load_lds((const unsigned*)(src + ((i * 8 + wid) * 64 + lane) * 4), (ALAS unsigned*)(lds + SIDE_STG + (i * 8 + wid) * 1024), 16, 0, 0);
            side_pend = sv; ++side_next; }
        if (kb <= qlo + 31) {
        f32x16 p0, p1;
        if (FOX) { const float fqm = NOMAX ? fq : fq - m_reg;
#pragma unroll
            for (int g = 0; g < 4; ++g) { const f32x4 f0 = *(const ALAS f32x4*)(F_lds + buf * 64 + 8 * g + 4 * hi), f1 = *(const ALAS f32x4*)(F_lds + buf * 64 + 32 + 8 * g + 4 * hi);
#pragma unroll
                for (int e = 0; e < 4; ++e) { p0[4 * g + e] = fqm - f0[e]; p1[4 * g + e] = fqm - f1[e]; } }
        } else if (NOMAX) {
#pragma unroll
            for (int r = 0; r < 16; ++r) { p0[r] = 0.f; p1[r] = 0.f; }
        } else { const float nm = -m_reg;
#pragma unroll
            for (int r = 0; r < 16; ++r) { p0[r] = nm; p1[r] = nm; }
        }
        {
            typedef int att_i32x8 __attribute__((ext_vector_type(8)));
            constexpr int NS = DK / 64;
            int ka[NKB];
#pragma unroll
            for (int jj = 0; jj < NKB; ++jj) ka[jj] = (int)(uintptr_t)smem + buf * LY::SHM_K + kbase[jj];
            u32x4 kb0[2][2], kb1[2][2];
#define ATT_KRD(dst, addr, off) asm volatile("ds_read_b128 %0, %1 offset:%2" : "=&v"(dst) : "v"(addr), "i"(off) : "memory")
#define ATT_KOFF(j) (DK == 192 ? ((j) >> 1) * 64 : 0)
#define ATT_KSTEP(s_) do { _Pragma("unroll") for (int e = 0; e < 2; ++e) { constexpr int dummy_ = 0; (void)dummy_; \
                ATT_KRD(kb0[(s_) & 1][e], ka[(2 * (s_) + e) % NKB], ATT_KOFF(2 * (s_) + e)); ATT_KRD(kb1[(s_) & 1][e], ka[(2 * (s_) + e) % NKB], ATT_KOFF(2 * (s_) + e) + 32 * LY::ROWB); } } while (0)
            ATT_KSTEP(0);
#pragma unroll
            for (int s_ = 0; s_ < NS; ++s_) {
                if (s_ + 1 < NS) { ATT_KSTEP(s_ + 1); asm volatile("s_waitcnt lgkmcnt(4)" ::: "memory"); }
                else asm volatile("s_waitcnt lgkmcnt(0)" ::: "memory");
                ASBAR();
                const u32x4 a00 = kb0[s_ & 1][0], a01 = kb0[s_ & 1][1], a10 = kb1[s_ & 1][0], a11 = kb1[s_ & 1][1], q0_ = qv[2 * s_], q1_ = qv[2 * s_ + 1];
                const att_i32x8 A0 = {(int)a00[0], (int)a00[1], (int)a00[2], (int)a00[3], (int)a01[0], (int)a01[1], (int)a01[2], (int)a01[3]};
                const att_i32x8 A1 = {(int)a10[0], (int)a10[1], (int)a10[2], (int)a10[3], (int)a11[0], (int)a11[1], (int)a11[2], (int)a11[3]};
                const att_i32x8 QB = {(int)q0_[0], (int)q0_[1], (int)q0_[2], (int)q0_[3], (int)q1_[0], (int)q1_[1], (int)q1_[2], (int)q1_[3]};
                p0 = __builtin_amdgcn_mfma_scale_f32_32x32x64_f8f6f4(A0, QB, p0, 0, 0, 0, 0x7F7F7F7F, 0, 0x7F7F7F7F);
                p1 = __builtin_amdgcn_mfma_scale_f32_32x32x64_f8f6f4(A1, QB, p1, 0, 0, 0, 0x7F7F7F7F, 0, 0x7F7F7F7F);
            }
#undef ATT_KSTEP
#undef ATT_KOFF
#undef ATT_KRD
        }
        if (kb + 63 > qlo) {
            const float NEG = -__builtin_inff(); const int dq = qm - kb;
#pragma unroll
            for (int r = 0; r < 16; ++r) { const int c = (r & 3) + 8 * (r >> 2); if (dq - c < 0) p0[r] = NEG; if (dq - c - 32 < 0) p1[r] = NEG; }
        }
        float alpha = 1.f;
        if (!NOMAX) {
        float pmax;
        { float a = att_max3(p0[0], p0[1], p1[0]), b = att_max3(p0[2], p0[3], p1[1]); a = att_max3(a, p1[2], p1[3]);
#pragma unroll
          for (int r = 4; r < 16; r += 4) { a = att_max3(a, p0[r], p0[r + 1]); b = att_max3(b, p0[r + 2], p0[r + 3]); a = att_max3(a, p1[r], p1[r + 1]); b = att_max3(b, p1[r + 2], p1[r + 3]); }
          pmax = fmaxf(a, b); }
        { auto rr = __builtin_amdgcn_permlane32_swap(__float_as_uint(pmax), __float_as_uint(pmax), false, false);
          pmax = fmaxf(__uint_as_float(rr[0]), __uint_as_float(rr[1])); }
        if (!__builtin_expect(__all(pmax <= 8.f), 1)) { const float dm = fmaxf(pmax, 0.f); alpha = __builtin_amdgcn_exp2f(-dm); m_reg += dm;
#pragma unroll
            for (int r = 0; r < 16; ++r) { p0[r] -= dm; p1[r] -= dm; } }
        }
        float ps = 0.f;
#pragma unroll
        for (int r = 0; r < 16; ++r) { p0[r] = __builtin_amdgcn_exp2f(p0[r]); ps += p0[r]; }
#pragma unroll
        for (int r = 0; r < 16; ++r) { p1[r] = __builtin_amdgcn_exp2f(p1[r]); ps += p1[r]; }
        l_reg = NOMAX ? l_reg + ps : l_reg * alpha + ps;
        typedef int att_i32x8p __attribute__((ext_vector_type(8)));
        typedef short att_s16x2 __attribute__((ext_vector_type(2)));
        att_i32x8p PA; int pscale;
        {
            float m0 = att_max3(p0[0], p0[1], p0[2]), m1 = att_max3(p1[0], p1[1], p1[2]);
#pragma unroll
            for (int r = 3; r < 15; r += 2) { m0 = att_max3(m0, p0[r], p0[r + 1]); m1 = att_max3(m1, p1[r], p1[r + 1]); }
            m0 = fmaxf(m0, p0[15]); m1 = fmaxf(m1, p1[15]);
            { auto rr = __builtin_amdgcn_permlane32_swap(__float_as_uint(m0), __float_as_uint(m0), false, false); m0 = fmaxf(__uint_as_float(rr[0]), __uint_as_float(rr[1])); }
            { auto rr = __builtin_amdgcn_permlane32_swap(__float_as_uint(m1), __float_as_uint(m1), false, false); m1 = fmaxf(__uint_as_float(rr[0]), __uint_as_float(rr[1])); }
            int e0 = (int)(__float_as_uint(m0) >> 23) - 7, e1 = (int)(__float_as_uint(m1) >> 23) - 7; e0 = e0 < 1 ? 1 : e0; e1 = e1 < 1 ? 1 : e1;
            pscale = hi ? e1 : e0;
            const float sc0 = __uint_as_float((unsigned)e0 << 23), sc1 = __uint_as_float((unsigned)e1 << 23);
#pragma unroll
            for (int k = 0; k < 8; ++k) { const float iv = k < 4 ? sc0 : sc1;
                const float x0 = k < 4 ? p0[4 * k] : p1[4 * k - 16], x1 = k < 4 ? p0[4 * k + 1] : p1[4 * k - 15], x2 = k < 4 ? p0[4 * k + 2] : p1[4 * k - 14], x3 = k < 4 ? p0[4 * k + 3] : p1[4 * k - 13];
                att_s16x2 w = {0, 0}; w = __builtin_amdgcn_cvt_scalef32_pk_fp8_f32(w, x0, x1, iv, false); w = __builtin_amdgcn_cvt_scalef32_pk_fp8_f32(w, x2, x3, iv, true);
                PA[k] = __builtin_bit_cast(int, w); } }
        if (!NOMAX && __any(alpha < 1.f)) {
            if (hi == 0) wsl[r32] = alpha;
            asm volatile("s_waitcnt lgkmcnt(0)" ::: "memory");
#pragma unroll
            for (int g = 0; g < 4; ++g) { const f32x4 al = *(const ALAS f32x4*)(wsl + 8 * g + 4 * hi);
#pragma unroll
                for (int d = 0; d < 4; ++d)
#pragma unroll
                    for (int e = 0; e < 4; ++e) o[d][4 * g + e] *= al[e]; }
        }
#define ATT_TR8(dst, addr, off) asm volatile("ds_read_b64_tr_b8 %0, %1 offset:%2" : "=&v"(dst) : "v"(addr), "i"(off) : "memory")
#define ATT_PV(d0) do { uint2 t0, t1, t2, t3; ATT_TR8(t0, va0, (d0) * 32); ATT_TR8(t1, va1, (d0) * 32); ATT_TR8(t2, va2, (d0) * 32); ATT_TR8(t3, va3, (d0) * 32); \
        asm volatile("s_waitcnt lgkmcnt(0)" ::: "memory"); ASBAR(); \
        const att_i32x8p VB = {(int)t0.x, (int)t0.y, (int)t1.x, (int)t1.y, (int)t2.x, (int)t2.y, (int)t3.x, (int)t3.y}; \
        o[d0] = __builtin_amdgcn_mfma_scale_f32_32x32x64_f8f6f4(PA, VB, o[d0], 0, 0, 0, pscale, 0, 0x7F7F7F7F); } while (0)
        { const int va0 = vkb[0] + buf * SHM_V, va1 = vkb[1] + buf * SHM_V, va2 = vkb[2] + buf * SHM_V, va3 = vkb[3] + buf * SHM_V; ATT_PV(0); ATT_PV(1); ATT_PV(2); ATT_PV(3); }
#undef ATT_TR8
        }
        if (t + 1 < NT) ATT_WRITEF(buf ^ 1);
    }
    __syncthreads();
    { ALAS float* wl = (ALAS float*)(lds + 131136) + wid * 64;
      ALAS float* stg = (ALAS float*)(lds + wid * 16384);
      { auto rr = __builtin_amdgcn_permlane32_swap(__float_as_uint(l_reg), __float_as_uint(l_reg), false, false); l_reg = __uint_as_float(rr[0]) + __uint_as_float(rr[1]); }
      if (hi == 0) wl[r32] = l_reg;
      asm volatile("s_waitcnt lgkmcnt(0)" ::: "memory");
#pragma unroll
      for (int r = 0; r < 16; ++r) { const int orow = crow(r, hi); const float rli = __builtin_amdgcn_rcpf(wl[orow]);
#pragma unroll
          for (int d0 = 0; d0 < 4; ++d0) stg[orow * 128 + d0 * 32 + r32] = o[d0][r] * rli; }
      uint2 gv[8];
      const int c8 = (lane & 15) * 8, rq = lane >> 4;
#pragma unroll
      for (int j = 0; j < 8; ++j) gv[j] = *(const uint2*)(gate + (size_t)(qlo + 4 * j + rq) * 4096 + c8);
      asm volatile("s_waitcnt lgkmcnt(0)" ::: "memory");
#pragma unroll
      for (int j = 0; j < 8; ++j) { const int row = 4 * j + rq;
          const f32x4 a = *(const ALAS f32x4*)(stg + row * 128 + c8), b2 = *(const ALAS f32x4*)(stg + row * 128 + c8 + 4); const uint2 g = gv[j]; u32x4 w;
          constexpr float k255 = 1.f / 255.f;
          w[0] = cvtpk(a[0] * ((float)((g.x >> 0) & 0xffu) * k255), a[1] * ((float)((g.x >> 8) & 0xffu) * k255)); w[1] = cvtpk(a[2] * ((float)((g.x >> 16) & 0xffu) * k255), a[3] * ((float)((g.x >> 24) & 0xffu) * k255));
          w[2] = cvtpk(b2[0] * ((float)((g.y >> 0) & 0xffu) * k255), b2[1] * ((float)((g.y >> 8) & 0xffu) * k255)); w[3] = cvtpk(b2[2] * ((float)((g.y >> 16) & 0xffu) * k255), b2[3] * ((float)((g.y >> 24) & 0xffu) * k255));
          *(u32x4*)(gout + (size_t)(qlo + row) * 4096 + c8) = w; } }
    __syncthreads();
#undef ATT_GLDS
#undef ATT_WRITEF
#undef ATT_PV
}
}
using pg8::bf16_t; using pg8::f32x4; using pg8::u32x4;
#define LAS __attribute__((address_space(3)))
constexpr int S = 8192, DM = 2048, INW = 11344, INWP = 11520;
constexpr float EPS = 1e-6f;
constexpr size_t MiB = 1u << 20;

__device__ __forceinline__ float bf2f(bf16_t v) { return __uint_as_float(((unsigned)v) << 16); }
__device__ __forceinline__ bf16_t f2bf(float f) { unsigned u = __float_as_uint(f); u += 0x7fffu + ((u >> 16) & 1u); return (bf16_t)(u >> 16); }
__device__ __forceinline__ unsigned pk2(float lo, float hi) { return (unsigned)f2bf(lo) | ((unsigned)f2bf(hi) << 16); }
__device__ __forceinline__ float wave_sum(float v) {
#pragma unroll
    for (int o = 32; o >= 1; o >>= 1) v += __shfl_xor(v, o);
    return v;
}
__device__ __forceinline__ float wave_max(float v) {
#pragma unroll
    for (int o = 32; o >= 1; o >>= 1) v = fmaxf(v, __shfl_xor(v, o));
    return v;
}

__device__ __forceinline__ int opaque_tid() { int t = threadIdx.x; asm volatile("" : "+v"(t)); return t; }

struct Params {
    const float* x; const int* pos; const float *mix_g, *w_in, *b_forget, *b_gate, *q_lat_g, *w_q_up, *kv_lat_g, *w_kv_up, *mla_qg, *mla_kg, *fox_qg, *fox_kg, *w_out, *ffn_g, *w_peer_q, *sub_keys, *peer_u, *peer_v;
    float* out;
    bf16_t *WqT, *WkvT, *WoT, *WpT, *WinT;
    bf16_t *h, *cq, *ckv, *fq, *fk, *fv, *kpe, *qa, *va, *ka; unsigned char* merged;
    float *lf, *F, *x1, *scores;
    unsigned char *U8, *V8; bf16_t* attout;
    unsigned* ctl;
    float2* ropeT; float* ssq; float* ssq2; bf16_t* xg;
};

struct DstId { __device__ __forceinline__ int operator()(int n) const { return n; } };
struct DstWin { __device__ __forceinline__ int operator()(int n) const {
    if (n < 1024) return n; if (n < 1088) { const int r = n - 1024; return 11264 + 2 * (r & 31) + (r >> 5); } if (n < 7232) return n - 64; if (n < 7248) return 11264 + 64 + (n - 7232); return n - 80; } };
struct DstQ { __device__ __forceinline__ int operator()(int n) const {
    const int h = n / 192, d = n - h * 192; if (d < 128) return h * 256 + d; const int r = d - 128; return h * 256 + 128 + 2 * (r & 31) + (r >> 5); } };
template <class Dst>
__device__ __forceinline__ void transpose_item(const float* __restrict__ W, int K, int N, bf16_t* __restrict__ WT, Dst dst, float* scr, int item, int lane, const float* __restrict__ gk = nullptr) {
    const int nblk = (N + 31) / 32, kb = item / nblk, nb = item % nblk, k0 = 64 * kb, n0 = 32 * nb;
    { const int rr = lane >> 3, c4 = (lane & 7) * 4; const bool ok = (n0 + c4) < N;
      f32x4 v[8];
#pragma unroll
      for (int i = 0; i < 8; ++i) v[i] = ok ? *(const f32x4*)(W + (size_t)(k0 + 8 * i + rr) * N + n0 + c4) : (f32x4){0.f, 0.f, 0.f, 0.f};
      if (gk) {
#pragma unroll
          for (int i = 0; i < 8; ++i) v[i] *= gk[k0 + 8 * i + rr]; }
#pragma unroll
      for (int i = 0; i < 8; ++i) { float* sp = scr + (8 * i + rr) * 33 + c4; sp[0] = v[i][0]; sp[1] = v[i][1]; sp[2] = v[i][2]; sp[3] = v[i][3]; } }
    asm volatile("s_waitcnt lgkmcnt(0)" ::: "memory");
    const int c = lane & 7;
#pragma unroll
    for (int j = 0; j < 4; ++j) { const int nl = (lane >> 3) + 8 * j, n = n0 + nl; const float* s = scr + (8 * c) * 33 + nl;
        u32x4 o; o.x = pk2(s[0 * 33], s[1 * 33]); o.y = pk2(s[2 * 33], s[3 * 33]); o.z = pk2(s[4 * 33], s[5 * 33]); o.w = pk2(s[6 * 33], s[7 * 33]);
        if (n < N) *(u32x4*)(WT + (size_t)dst(n) * K + k0 + 8 * c) = o; }
    asm volatile("s_waitcnt lgkmcnt(0)" ::: "memory");
}
typedef __bf16 wf_bf16x8 __attribute__((ext_vector_type(8)));
typedef float wf_f32x8 __attribute__((ext_vector_type(8)));
__device__ __forceinline__ void wf_split(const f32x4 x0, const f32x4 x1, wf_bf16x8& hi, wf_bf16x8& lo) {
    const wf_f32x8 x = {x0[0], x0[1], x0[2], x0[3], x1[0], x1[1], x1[2], x1[3]};
    hi = __builtin_convertvector(x, wf_bf16x8);
    const wf_f32x8 r = x - __builtin_convertvector(hi, wf_f32x8);
    lo = __builtin_convertvector(r, wf_bf16x8);
}
__device__ __forceinline__ void wfold_item(const float* __restrict__ wq, const float* __restrict__ keys, bf16_t* __restrict__ WpT, float* sm, int item) {
    (void)sm;
    const int tid = opaque_tid(), lane = tid & 63, wave = tid >> 6, hc = item >> 5, d0 = (item & 31) * 64, m = lane & 15, kg = lane >> 4;
    f32x4 acc[4];
#pragma unroll
    for (int c = 0; c < 4; ++c) acc[c] = (f32x4){0.f, 0.f, 0.f, 0.f};
#pragma unroll
    for (int s4 = 0; s4 < 4; ++s4) {
        const float* kp = keys + (size_t)hc * 16384 + (16 * wave + m) * 128 + 32 * s4 + 8 * kg;
        wf_bf16x8 bh, bl; wf_split(*(const f32x4*)kp, *(const f32x4*)(kp + 4), bh, bl);
#pragma unroll
        for (int c = 0; c < 4; ++c) { const float* ap = wq + (size_t)(d0 + 16 * c + m) * 2048 + hc * 128 + 32 * s4 + 8 * kg;
            wf_bf16x8 ah, al; wf_split(*(const f32x4*)ap, *(const f32x4*)(ap + 4), ah, al);
            acc[c] = __builtin_amdgcn_mfma_f32_16x16x32_bf16(ah, bh, acc[c], 0, 0, 0);
            acc[c] = __builtin_amdgcn_mfma_f32_16x16x32_bf16(ah, bl, acc[c], 0, 0, 0);
            acc[c] = __builtin_amdgcn_mfma_f32_16x16x32_bf16(al, bh, acc[c], 0, 0, 0); }
    }
#pragma unroll
    for (int c = 0; c < 4; ++c) { uint2 o; o.x = pk2(acc[c][0], acc[c][1]); o.y = pk2(acc[c][2], acc[c][3]);
        *(uint2*)(WpT + (size_t)(hc * 128 + 16 * wave + m) * 2048 + d0 + 16 * c + 4 * kg) = o; }
}
__device__ __forceinline__ void rms_row2048(const float* __restrict__ xr, const f32x4 (&gg)[8], bf16_t* __restrict__ orow, int lane) {
    f32x4 v[8]; float ss = 0.f;
#pragma unroll
    for (int j = 0; j < 8; ++j) { v[j] = *(const f32x4*)(xr + j * 256 + lane * 4); ss += (v[j][0] * v[j][0] + v[j][1] * v[j][1]) + (v[j][2] * v[j][2] + v[j][3] * v[j][3]); }
    const float r = rsqrtf(wave_sum(ss) * (1.f / 2048.f) + EPS);
#pragma unroll
    for (int j = 0; j < 8; ++j) {
        uint2 o; o.x = pk2(v[j][0] * r * gg[j][0], v[j][1] * r * gg[j][1]); o.y = pk2(v[j][2] * r * gg[j][2], v[j][3] * r * gg[j][3]);
        *(uint2*)(orow + j * 256 + lane * 4) = o; }
}
__device__ __forceinline__ void fox_cumsum(double* part, int h, const float* __restrict__ lf, float* __restrict__ F) {
    const int tid = opaque_tid(), lane = tid & 63, wave = tid >> 6;
    float v[16]; double sum = 0.0;
#pragma unroll
    for (int i = 0; i < 16; ++i) { v[i] = lf[(size_t)(tid * 16 + i) * 16 + h]; sum += (double)v[i]; }
    double inc = sum;
#pragma unroll
    for (int o = 1; o < 64; o <<= 1) { const double n = __shfl_up(inc, o); if (lane >= o) inc += n; }
    if (lane == 63) part[wave] = inc;
    __syncthreads();
    double base = 0.0;
    for (int w = 0; w < wave; ++w) base += part[w];
    double run = base + inc - sum;
#pragma unroll
    for (int i = 0; i < 16; ++i) { run += (double)v[i]; F[(size_t)h * S + tid * 16 + i] = (float)(run * 1.4426950408889634); }
    __syncthreads();
}
__device__ __forceinline__ void rope_table(const int* __restrict__ pos, float2* __restrict__ ropeT, int gtid, int nthreads) {
    for (int idx = gtid; idx < S * 32; idx += nthreads) { const int t = idx >> 5, i = idx & 31;
        const double inv = exp(-(double)i * (1.0 / 32.0) * 9.210340371976184);
        double ang = (double)((float)pos[t] * (float)inv);
        const double twopi = 6.283185307179586;
        ang -= twopi * rint(ang / twopi);
        ropeT[idx] = make_float2(cosf((float)ang), sinf((float)ang)); }
}
typedef float f32x2 __attribute__((ext_vector_type(2)));
__device__ __forceinline__ unsigned pk4_fp8(float a, float b, float c, float d) {
    int w = __builtin_amdgcn_cvt_pk_fp8_f32(fminf(fmaxf(a, -448.f), 448.f), fminf(fmaxf(b, -448.f), 448.f), 0, false);
    w = __builtin_amdgcn_cvt_pk_fp8_f32(fminf(fmaxf(c, -448.f), 448.f), fminf(fmaxf(d, -448.f), 448.f), w, true); return (unsigned)w; }
__device__ __forceinline__ void cvt_rows_fp8(const float* __restrict__ src, unsigned char* __restrict__ dst, size_t n, float scale, int gw, int NGW, int lane) {
    const size_t nchunk = n / 1024;
    for (size_t c = gw; c < nchunk; c += NGW) { const size_t o = c * 1024 + lane * 16;
        f32x4 a[4];
#pragma unroll
        for (int q = 0; q < 4; ++q) a[q] = *(const f32x4*)(src + o + 4 * q) * scale;
        u32x4 w; w.x = pk4_fp8(a[0][0], a[0][1], a[0][2], a[0][3]); w.y = pk4_fp8(a[1][0], a[1][1], a[1][2], a[1][3]);
        w.z = pk4_fp8(a[2][0], a[2][1], a[2][2], a[2][3]); w.w = pk4_fp8(a[3][0], a[3][1], a[3][2], a[3][3]);
        *(u32x4*)(dst + o) = w; }
}
constexpr float U_SCALE = 64.f, V_SCALE = 4.f;
typedef __bf16 bf16x2_t __attribute__((ext_vector_type(2)));
__device__ __forceinline__ float dot2bf(unsigned a, unsigned b, float c) { return __builtin_amdgcn_fdot2_f32_bf16(__builtin_bit_cast(bf16x2_t, a), __builtin_bit_cast(bf16x2_t, b), c, false); }
#define PEER_INS(top, x) do { float x_ = (x); _Pragma("unroll") for (int i_ = 0; i_ < 16; ++i_) { const float hi_ = fmaxf(top[i_], x_); x_ = fminf(top[i_], x_); top[i_] = hi_; } } while (0)
__device__ __forceinline__ void fp6_cvt_rows(const float* __restrict__ src, unsigned char* __restrict__ T6, int row0, int nrows, float sc, int t, int nt) {
    for (int u = t; u < nrows * 64; u += nt) { const int rr = u >> 6, hf = (u >> 5) & 1, l = (u >> 1) & 15, g = u & 1;
        const float* s0 = src + (size_t)(row0 + rr) * 2048 + hf * 1024 + (2 * g) * 256 + l * 16;
        att::f32x16v f0, f1;
#pragma unroll
        for (int k = 0; k < 4; ++k) { const f32x4 a = *(const f32x4*)(s0 + 4 * k), b2 = *(const f32x4*)(s0 + 256 + 4 * k);
#pragma unroll
            for (int e = 0; e < 4; ++e) { f0[4 * k + e] = a[e]; f1[4 * k + e] = b2[e]; } }
        att::fp6_put(T6, row0 + rr, hf, l, g, f0, f1, sc); }
}
typedef float f32x32v __attribute__((ext_vector_type(32)));
__device__ __forceinline__ void peer_group(unsigned char* smem, int g, const float* __restrict__ scores, const bf16_t* __restrict__ h2  , const float* __restrict__ ssq2, const float* __restrict__ x1,
                                           const unsigned char* __restrict__ U8, const unsigned char* __restrict__ V8, float* __restrict__ out) {
    const int tid = opaque_tid(), lane = tid & 63, wave = __builtin_amdgcn_readfirstlane(tid >> 6);
    float* topL = (float*)smem;
    int* selE = (int*)(smem + 32768);
    float* selG = (float*)(smem + 49152);
    {
        const int tl = tid >> 4, hc = tid & 15;
        const float* sp = scores + (size_t)(g * 32 + tl) * 2048 + hc * 128;
#define PEER_CE(a, b) do { const float hi_ = fmaxf(a, b), lo_ = fminf(a, b); a = hi_; b = lo_; } while (0)
        float top[16]; f32x4 nx[4];
#pragma unroll
        for (int q = 0; q < 4; ++q) nx[q] = *(const f32x4*)(sp + q * 4);
#pragma unroll 1
        for (int gi = 0; gi < 8; ++gi) {
            float gr[16];
#pragma unroll
            for (int q = 0; q < 4; ++q) { const f32x4 v = nx[q];
#pragma unroll
                for (int e = 0; e < 4; ++e) gr[q * 4 + e] = __uint_as_float((__float_as_uint(v[e]) & ~0x7Fu) | (unsigned)(gi * 16 + q * 4 + e)); }
            if (gi < 7) {
#pragma unroll
                for (int q = 0; q < 4; ++q) nx[q] = *(const f32x4*)(sp + (gi + 1) * 16 + q * 4); }
#pragma unroll
            for (int k = 2; k <= 16; k <<= 1)
#pragma unroll
                for (int j = k >> 1; j > 0; j >>= 1)
#pragma unroll
                    for (int i = 0; i < 16; ++i) { const int l = i ^ j; if (l > i) { if ((i & k) == 0) PEER_CE(gr[i], gr[l]); else PEER_CE(gr[l], gr[i]); } }
            if (gi == 0) {
#pragma unroll
                for (int i = 0; i < 16; ++i) top[i] = gr[i];
            } else {
#pragma unroll
                for (int i = 0; i < 16; ++i) top[i] = fmaxf(top[i], gr[15 - i]);
#pragma unroll
                for (int j = 8; j > 0; j >>= 1)
#pragma unroll
                    for (int i = 0; i < 16; ++i) { const int l = i ^ j; if (l > i) PEER_CE(top[i], top[l]); }
            }
        }
#undef PEER_CE
        float* tp = topL + (tl * 16 + hc) * 16;
#pragma unroll
        for (int i = 0; i < 16; i += 4) *(f32x4*)(tp + i) = (f32x4){top[i], top[i + 1], top[i + 2], top[i + 3]};
    }
    __syncthreads();
    if (tid < 256) {
        const int tl = tid >> 3, h = tid & 7;
        const float* t1 = topL + (tl * 16 + 2 * h) * 16; const float* t2 = t1 + 16;
        float s1[16], s2[16];
#pragma unroll
        for (int i = 0; i < 16; i += 4) { const f32x4 a = *(const f32x4*)(t1 + i), b2 = *(const f32x4*)(t2 + i);
            s1[i] = a[0]; s1[i + 1] = a[1]; s1[i + 2] = a[2]; s1[i + 3] = a[3]; s2[i] = b2[0]; s2[i + 1] = b2[1]; s2[i + 2] = b2[2]; s2[i + 3] = b2[3]; }
#define PEER_CE(a, b) do { const float hi_ = fmaxf(a, b), lo_ = fminf(a, b); a = hi_; b = lo_; } while (0)
#define PEER_KEY(i, j) __uint_as_float((__float_as_uint(s1[i] + s2[j]) & ~0xFFu) | (unsigned)((i) * 16 + (j)))
        float ts[16], cand[34];
#pragma unroll
        for (int j = 0; j < 16; ++j) ts[j] = PEER_KEY(0, j);
        { int n = 0;
#pragma unroll
          for (int i = 1; i < 16; ++i)
#pragma unroll
              for (int j = 0; j < 8; ++j)
                  if ((i + 1) * (j + 1) <= 16) cand[n++] = PEER_KEY(i, j); }
#pragma unroll
        for (int gi = 0; gi < 2; ++gi) { float gr[16];
#pragma unroll
            for (int i = 0; i < 16; ++i) gr[i] = cand[gi * 16 + i];
#pragma unroll
            for (int k = 2; k <= 16; k <<= 1)
#pragma unroll
                for (int j = k >> 1; j > 0; j >>= 1)
#pragma unroll
                    for (int i = 0; i < 16; ++i) { const int l = i ^ j; if (l > i) { if ((i & k) == 0) PEER_CE(gr[i], gr[l]); else PEER_CE(gr[l], gr[i]); } }
#pragma unroll
            for (int i = 0; i < 16; ++i) ts[i] = fmaxf(ts[i], gr[15 - i]);
#pragma unroll
            for (int j = 8; j > 0; j >>= 1)
#pragma unroll
                for (int i = 0; i < 16; ++i) { const int l = i ^ j; if (l > i) PEER_CE(ts[i], ts[l]); } }
        PEER_INS(ts, cand[32]); PEER_INS(ts, cand[33]);
#undef PEER_CE
#undef PEER_KEY
        float ex[16], sum = 0.f;
#pragma unroll
        for (int k = 0; k < 16; ++k) { ex[k] = __expf(ts[k] - ts[0]); sum += ex[k]; }
        const float inv = 1.f / sum;
#pragma unroll
        for (int k = 0; k < 16; ++k) { const unsigned pos = __float_as_uint(ts[k]) & 0xFFu;
            const int i1 = (int)(__float_as_uint(t1[pos >> 4]) & 0x7Fu), i2 = (int)(__float_as_uint(t2[pos & 15]) & 0x7Fu);
            selE[tl * 128 + h * 16 + k] = i1 * 128 + i2; selG[tl * 128 + h * 16 + k] = ex[k] * inv; }
    }
    __syncthreads();
    const int grp = lane >> 4, l16 = lane & 15, tl = wave * 4 + grp;
    unsigned* sortK = (unsigned*)(smem + 65536) + tl * 128;
    float* wS = (float*)(smem + 81920) + tl * 128;
    unsigned* hist = (unsigned*)(smem + 98304) + wave * 512 + grp * 64;
    {
#pragma unroll
        for (int i = 0; i < 4; ++i) hist[l16 * 4 + i] = 0u;
        asm volatile("s_waitcnt lgkmcnt(0)" ::: "memory");
        unsigned ek[8], rk[8];
#pragma unroll
        for (int j = 0; j < 8; ++j) { ek[j] = (unsigned)selE[tl * 128 + l16 + 16 * j]; rk[j] = atomicAdd(&hist[ek[j] >> 8], 1u); }
        asm volatile("s_waitcnt lgkmcnt(0)" ::: "memory");
        unsigned c[4], tot = 0u;
#pragma unroll
        for (int i = 0; i < 4; ++i) { c[i] = hist[l16 * 4 + i]; tot += c[i]; }
        unsigned inc = tot;
#pragma unroll
        for (int o = 1; o < 16; o <<= 1) { const unsigned n = __shfl_up(inc, o, 16); if (l16 >= o) inc += n; }
        unsigned run = inc - tot;
#pragma unroll
        for (int i = 0; i < 4; ++i) { hist[256 + l16 * 4 + i] = run; run += c[i]; }
        asm volatile("s_waitcnt lgkmcnt(0)" ::: "memory");
#pragma unroll
        for (int j = 0; j < 8; ++j) sortK[hist[256 + (ek[j] >> 8)] + rk[j]] = (ek[j] << 7) | (unsigned)(l16 + 16 * j);
    }
    __syncthreads();
    const size_t tok = (size_t)g * 32 + tl;
    float rinv_tok;
    { float t = 0.f; if (l16 < 8) { const f32x4 a = *(const f32x4*)(ssq2 + ((size_t)l16 * 8192 + tok) * 4); t = (a[0] + a[1]) + (a[2] + a[3]); }
      t += __shfl_xor(t, 8); t += __shfl_xor(t, 4); t += __shfl_xor(t, 2); t += __shfl_xor(t, 1); rinv_tok = rsqrtf(t * (1.f / 2048.f) + 1e-6f); }
    {
        const int m16 = lane & 15, kg = lane >> 4, pt = m16 >> 2, sub = m16 & 3, l6 = kg * 4 + sub;
        const unsigned* sKa = (const unsigned*)(smem + 65536) + (wave * 4 + pt) * 128;
        const bool diag = pt == kg;
        const size_t tokb = (size_t)g * 32 + wave * 4 + pt;
        typedef int i32x8v __attribute__((ext_vector_type(8)));
        const float xsc = 1.4f * __shfl(rinv_tok, pt * 16);
#pragma unroll 1
        for (int hf = 0; hf < 2; ++hf) {
            i32x8v xb[2];
#pragma unroll
            for (int gq = 0; gq < 2; ++gq) { att::f32x16v ev, od;
#pragma unroll
                for (int h = 0; h < 2; ++h) { const bf16_t* xp = h2 + tokb * DM + hf * 1024 + (2 * gq + h) * 256 + l6 * 16;
                    const u32x4 w0 = *(const u32x4*)xp, w1 = *(const u32x4*)(xp + 8);
#pragma unroll
                    for (int q = 0; q < 4; ++q) { ev[8 * h + q] = __uint_as_float(w0[q] << 16) * xsc; od[8 * h + q] = __uint_as_float(w0[q] & 0xffff0000u) * xsc;
                        ev[8 * h + 4 + q] = __uint_as_float(w1[q] << 16) * xsc; od[8 * h + 4 + q] = __uint_as_float(w1[q] & 0xffff0000u) * xsc; } }
                const att::u32x6v w6 = __builtin_amdgcn_cvt_scalef32_2xpk16_fp6_f32(ev, od, 1.0f);
                xb[gq] = (i32x8v){(int)w6[0], (int)w6[1], (int)w6[2], (int)w6[3], (int)w6[4], (int)w6[5], 0, 0}; }
            u32x4 urA[4][3], urB[4][3];
#define PEER_LDA(ur, it0) do { _Pragma("unroll") for (int j = 0; j < 4; ++j) { const unsigned ro = (sKa[(it0) + j] >> 7) * (unsigned)att::ROW6 + (unsigned)(hf * 768 + l6 * 16); \
                    _Pragma("unroll") for (int c = 0; c < 3; ++c) ur[j][c] = *(const u32x4*)(U8 + ro + c * 256); } } while (0)
#define PEER_CMA(ur, it0) do { float dsel = 0.f; \
                _Pragma("unroll") for (int j = 0; j < 4; ++j) { f32x4 acc = (f32x4){0.f, 0.f, 0.f, 0.f}; \
                    acc = __builtin_amdgcn_mfma_scale_f32_16x16x128_f8f6f4((i32x8v){(int)ur[j][0][0], (int)ur[j][0][1], (int)ur[j][0][2], (int)ur[j][0][3], (int)ur[j][1][0], (int)ur[j][1][1], 0, 0}, xb[0], acc, 2, 2, 0, 0x7F7F7F7F, 0, 0x7F7F7F7F); \
                    acc = __builtin_amdgcn_mfma_scale_f32_16x16x128_f8f6f4((i32x8v){(int)ur[j][1][2], (int)ur[j][1][3], (int)ur[j][2][0], (int)ur[j][2][1], (int)ur[j][2][2], (int)ur[j][2][3], 0, 0}, xb[1], acc, 2, 2, 0, 0x7F7F7F7F, 0, 0x7F7F7F7F); \
                    float d = sub == 0 ? acc[0] : sub == 1 ? acc[1] : sub == 2 ? acc[2] : acc[3]; \
                    d += __builtin_bit_cast(float, __builtin_amdgcn_update_dpp(0, __builtin_bit_cast(int, d), 0xB1, 0xF, 0xF, true)); \
                    d += __builtin_bit_cast(float, __builtin_amdgcn_update_dpp(0, __builtin_bit_cast(int, d), 0x4E, 0xF, 0xF, true)); \
                    if (sub == j) dsel = d; } \
                if (diag) { float* wSt = (float*)(smem + 81920) + (wave * 4 + pt) * 128; \
                    if (hf == 0) wSt[(it0) + sub] = dsel; \
                    else { const float a = (wSt[(it0) + sub] + dsel) * (1.f / (1.4f * U_SCALE)); \
                        wSt[(it0) + sub] = selG[(wave * 4 + pt) * 128 + (sKa[(it0) + sub] & 127u)] * 0.5f * a * (1.f + erff(a * 0.70710678118654752f)) * (1.f / V_SCALE); } } } while (0)
            PEER_LDA(urA, 0);
#pragma unroll 1
            for (int it = 0; it < 128; it += 8) {
                if (0 && it) __builtin_amdgcn_s_barrier();
                PEER_LDA(urB, it + 4);
                PEER_CMA(urA, it);
                if (it + 8 < 128) PEER_LDA(urA, it + 8);
                PEER_CMA(urB, it + 4);
            }
#undef PEER_LDA
#undef PEER_CMA
            __syncthreads();
        }
    }
#pragma unroll 1
    for (int hf = 0; hf < 2; ++hf) {
        typedef _Float16 h16x2v __attribute__((ext_vector_type(2)));
        typedef _Float16 h16x32v __attribute__((ext_vector_type(32)));
        h16x2v acc[32];
#pragma unroll
        for (int c = 0; c < 32; ++c) acc[c] = (h16x2v){(_Float16)0.f, (_Float16)0.f};
        for (int it = 0; it < 128; it += 4) {
            if (0 && (it & 7) == 0 && it) __syncthreads();
            unsigned key[4]; u32x4 vr[4][3];
#pragma unroll
            for (int p = 0; p < 4; ++p) { key[p] = sortK[it + p];
#pragma unroll
                for (int j = 0; j < 3; ++j) vr[p][j] = *(const u32x4*)(V8 + (size_t)(key[p] >> 7) * att::ROW6 + hf * 768 + j * 256 + l16 * 16); }
#pragma unroll
            for (int p = 0; p < 4; ++p) { const _Float16 wh = (_Float16)wS[it + p]; const h16x2v w2 = (h16x2v){wh, wh};
                const h16x32v c0 = __builtin_amdgcn_cvt_scalef32_pk32_f16_fp6((att::u32x6v){vr[p][0][0], vr[p][0][1], vr[p][0][2], vr[p][0][3], vr[p][1][0], vr[p][1][1]}, 1.0f);
#pragma unroll
                for (int k = 0; k < 16; ++k) acc[k] = __builtin_elementwise_fma(w2, (h16x2v){c0[2 * k], c0[2 * k + 1]}, acc[k]);
                const h16x32v c1 = __builtin_amdgcn_cvt_scalef32_pk32_f16_fp6((att::u32x6v){vr[p][1][2], vr[p][1][3], vr[p][2][0], vr[p][2][1], vr[p][2][2], vr[p][2][3]}, 1.0f);
#pragma unroll
                for (int k = 0; k < 16; ++k) acc[16 + k] = __builtin_elementwise_fma(w2, (h16x2v){c1[2 * k], c1[2 * k + 1]}, acc[16 + k]); }
        }
#pragma unroll
        for (int j = 0; j < 4; ++j)
#pragma unroll
            for (int q = 0; q < 4; ++q) { const size_t o = tok * DM + hf * 1024 + j * 256 + l16 * 16 + q * 4;
                const f32x4 a = *(const f32x4*)(x1 + o);
                *(f32x4*)(out + o) = (f32x4){a[0] + (float)acc[j * 8 + 2 * q][0], a[1] + (float)acc[j * 8 + 2 * q][1], a[2] + (float)acc[j * 8 + 2 * q + 1][0], a[3] + (float)acc[j * 8 + 2 * q + 1][1]}; }
        __syncthreads();
    }
    __syncthreads();
}

#define XB_TMO      128
#define XB_XCNT(j)  (256  + 64 * (j))
#define XB_XSUB(j)  (1280 + 64 * (j))
#define XB_XGEN(j)  (2304 + 64 * (j))
#define XB_TOP      3328
#define XB_TOPGEN   3392
#define XCD_BAR_WORDS 3456
#define XB_EXIT 3584
__device__ unsigned g_bar[4096];
#define XB_SPIN_CAP (1u << 18)

__device__ __forceinline__ unsigned xb_ld(unsigned* p)              { return __hip_atomic_load(p, __ATOMIC_RELAXED, __HIP_MEMORY_SCOPE_AGENT); }
__device__ __forceinline__ unsigned xb_add(unsigned* p, unsigned v) { return __hip_atomic_fetch_add(p, v, __ATOMIC_RELAXED, __HIP_MEMORY_SCOPE_AGENT); }
__device__ __forceinline__ unsigned xb_xcc_id() { return (unsigned)__builtin_amdgcn_s_getreg((3 << 11) | 20) & 0xFu; }
#define XB_SPIN(cond, bar) do { unsigned _sp = 0; while (cond) { __builtin_amdgcn_s_sleep(1); \
    if ((++_sp & 255u) == 0u) { if (xb_ld(&(bar)[XB_TMO])) break; if (_sp > XB_SPIN_CAP) { atomicAdd(&(bar)[XB_TMO], 1u); break; } } } } while (0)

struct XcdBarrier {
    unsigned* bar; unsigned x;
    volatile LAS unsigned* st;
};

__device__ __forceinline__ XcdBarrier xcd_barrier_post(unsigned* bar, volatile LAS unsigned* st) {
    XcdBarrier b; b.bar = bar; b.x = xb_xcc_id(); b.st = st;
    if (threadIdx.x == 0) (void)xb_add(&bar[XB_XCNT(b.x)], 1u);
    return b;
}
__device__ __forceinline__ void xcd_barrier_complete(unsigned* bar, unsigned x, unsigned& nloc, unsigned& nx) {
    const unsigned G = gridDim.x * gridDim.y * gridDim.z;
    unsigned sum, cnt, mine, sp = 0u;
    for (;;) {
        sum = 0u; cnt = 0u; mine = 0u;
#pragma unroll
        for (unsigned j = 0; j < 16; ++j) { const unsigned c = xb_ld(&bar[XB_XCNT(j)]); sum += c; cnt += (c > 0u) ? 1u : 0u; mine = (j == x) ? c : mine; }
        if (sum == G) break;
        __builtin_amdgcn_s_sleep(1);
        if ((++sp & 255u) == 0u) { if (xb_ld(&bar[XB_TMO])) break; if (sp > XB_SPIN_CAP) { atomicAdd(&bar[XB_TMO], 1u); break; } }
    }
    nloc = mine > 0u ? mine : 1u; nx = cnt > 0u ? cnt : 1u;
}

__device__ __forceinline__ void xcd_barrier(const XcdBarrier& b) {
    asm volatile("s_waitcnt vmcnt(0)" ::: "memory");
    __syncthreads();
    if (threadIdx.x == 0) {
        unsigned* bar = b.bar;
        __builtin_amdgcn_s_waitcnt(0);
        unsigned nloc = b.st[0], nx = b.st[1];
        if (nloc == 0u) { xcd_barrier_complete(bar, b.x, nloc, nx); b.st[0] = nloc; b.st[1] = nx; }
        const unsigned old = xb_add(&bar[XB_XSUB(b.x)], 1u);
        const unsigned gen = old / nloc;
        if (old + 1u == (gen + 1u) * nloc) {
            __builtin_amdgcn_fence(__ATOMIC_RELEASE, "agent");
            asm volatile("s_waitcnt vmcnt(0)" ::: "memory");
            const unsigned og = xb_add(&bar[XB_TOP], 1u);
            const unsigned tg = og / nx;
            if (og + 1u == (tg + 1u) * nx) xb_add(&bar[XB_TOPGEN], 1u);
            else XB_SPIN(xb_ld(&bar[XB_TOPGEN]) == tg, bar);
            __builtin_amdgcn_fence(__ATOMIC_ACQUIRE, "agent");
            xb_add(&bar[XB_XGEN(b.x)], 1u);
            asm volatile("s_waitcnt vmcnt(0)" ::: "memory");
        } else {
            XB_SPIN(xb_ld(&bar[XB_XGEN(b.x)]) == gen, bar);
            __builtin_amdgcn_fence(__ATOMIC_ACQUIRE, "agent");
            asm volatile("s_waitcnt vmcnt(0)" ::: "memory");
        }
    }
    __syncthreads();
}

#define PROBE_P0 0
#define PROBE_DOUBLE 0
#define REP(k) for (int rep_ = 0; rep_ < ((PROBE_DOUBLE == (k)) ? 2 : 1); ++rep_)
constexpr int LDS_BYTES = 147456;
__global__ __launch_bounds__(512, 2) void mega(Params p) {
    extern __shared__ __attribute__((aligned(16))) unsigned char smem[];
    { volatile LAS unsigned* st0 = (volatile LAS unsigned*)((LAS unsigned char*)smem + 131072); if (threadIdx.x < 2) st0[threadIdx.x] = 0u; }
    __syncthreads();
    const XcdBarrier bar = xcd_barrier_post(g_bar, (volatile LAS unsigned*)((LAS unsigned char*)smem + 131072));
    float* smf = (float*)smem;
    LAS unsigned char* lds = (LAS unsigned char*)smem;
    const int G = gridDim.x, b = blockIdx.x, NGW = G * 8;
#define PHASE_IDS() const int tid = opaque_tid(), lane = tid & 63, wave = __builtin_amdgcn_readfirstlane(tid >> 6), gw = b * 8 + wave; (void)lane; (void)gw

    REP(7) {
        PHASE_IDS();
        float* scr = smf + wave * 4096;
        constexpr int dummy_ = 0; (void)dummy_;
        constexpr int I_IN = 32 * 355, I_Q = 8 * 96, I_KV = 8 * 128, I_O = 64 * 64;
        for (int rp_ = 0; rp_ < (PROBE_P0 == 1 ? 2 : 1); ++rp_)
        for (int it = gw; it < I_IN; it += NGW) transpose_item(p.w_in, 2048, INW, p.WinT, DstWin(), scr, it, lane);
        for (int rp_ = 0; rp_ < (PROBE_P0 == 2 ? 2 : 1); ++rp_)
        { f32x4 gg[8];
#pragma unroll
          for (int j = 0; j < 8; ++j) gg[j] = *(const f32x4*)(p.mix_g + j * 256 + lane * 4);
          for (int m = gw; m < S; m += NGW) rms_row2048(p.x + (size_t)m * DM, gg, p.h + (size_t)m * DM, lane); }
        for (int idx = b * 512 + tid; idx < 16 * 64 * 64; idx += G * 512) { const int hh = idx >> 12, rr = (idx >> 6) & 63, c8 = idx & 63;
            *(u32x4*)(p.WqT + (size_t)(hh * 256 + 192 + rr) * 512 + c8 * 8) = (u32x4){0u, 0u, 0u, 0u}; }
        rope_table(p.pos, p.ropeT, b * 512 + tid, G * 512);
        __syncthreads();
        for (int rp_ = 0; rp_ < (PROBE_P0 == 3 ? 2 : 1); ++rp_)
        for (int it = b; it < 512; it += G) wfold_item(p.w_peer_q, p.sub_keys, p.WpT, smf, it);
    }
    xcd_barrier(bar);
    REP(1) {
        pg8::Gemm g{p.h, p.WinT, S, INWP, DM}; pg8::StaticOrder so; so.init(S, INWP, G, b);
        pg8::EpiInProj E{p.cq, p.ckv, p.fq, p.fk, p.fv, p.merged, p.kpe, p.lf, p.b_gate, p.b_forget, p.ssq, p.fox_qg, p.fox_kg, (LAS float*)(lds + 131072 + 64)};
        pg8::gemm_phase<pg8::EpiInProj, pg8::StaticOrder, true, true>(lds, g, so, E);
        constexpr int LAST_BUSY = (S / 256) * (INWP / 256) - 5 * 256;
        if (G == 256 && b >= LAST_BUSY) { PHASE_IDS(); __syncthreads(); float* scr = smf + wave * 4096;
            for (int it = (b - LAST_BUSY) * 8 + wave; it < 8 * 96 + 8 * 128 + 64 * 64; it += (256 - LAST_BUSY) * 8) { int r = it;
                if (r < 8 * 96) { transpose_item(p.w_q_up, 512, 3072, p.WqT, DstQ(), scr, r, lane, p.q_lat_g); continue; } r -= 8 * 96;
                if (r < 8 * 128) { transpose_item(p.w_kv_up, 512, 4096, p.WkvT, DstId(), scr, r, lane, p.kv_lat_g); continue; } r -= 8 * 128;
                transpose_item(p.w_out, 4096, 2048, p.WoT, DstId(), scr, r, lane); }
            __syncthreads(); }
        else if (G != 256) { PHASE_IDS(); __syncthreads(); float* scr = smf + wave * 4096;
            for (int it = gw; it < 8 * 96 + 8 * 128 + 64 * 64; it += NGW) { int r = it;
                if (r < 8 * 96) { transpose_item(p.w_q_up, 512, 3072, p.WqT, DstQ(), scr, r, lane, p.q_lat_g); continue; } r -= 8 * 96;
                if (r < 8 * 128) { transpose_item(p.w_kv_up, 512, 4096, p.WkvT, DstId(), scr, r, lane, p.kv_lat_g); continue; } r -= 8 * 128;
                transpose_item(p.w_out, 4096, 2048, p.WoT, DstId(), scr, r, lane); }
            __syncthreads(); }
    }
    xcd_barrier(bar);
    for (int hh = b; hh < 16; hh += G) fox_cumsum((double*)smem, hh, p.lf, p.F);
    REP(2) {
        pg8::Gemm g{p.cq, p.WqT, S, 4096, 512}; pg8::StaticOrder so; so.init(S, 4096, G, b);
        pg8::EpiQ E{p.qa, p.ssq, p.mla_qg, p.ropeT, (LAS float*)(lds + 131072 + 64)};
        pg8::gemm_phase<pg8::EpiQ, pg8::StaticOrder, true, true>(lds, g, so, E);
    }
    {
        pg8::Gemm g{p.ckv, p.WkvT, S, 4096, 512}; pg8::StaticOrder so; so.init(S, 4096, G, b);
        pg8::EpiKV E{p.ka, p.va, p.kpe, p.ssq, p.mla_kg, p.ropeT, (LAS float*)(lds + 131072 + 64)};
        pg8::gemm_phase<pg8::EpiKV, pg8::StaticOrder, true, true>(lds, g, so, E);
    }
    xcd_barrier(bar);
    int side_next = 0;
    bool nomax_mla, nomax_fox; float fox_bound;
    { const int ln = threadIdx.x & 63;
      float a = 0.f, c = 0.f;
      for (int j = ln; j < 192; j += 64) { a = fmaxf(a, fabsf(p.mla_qg[j])); c = fmaxf(c, fabsf(p.mla_kg[j])); }
      const float bm = 1.02f * 192.f * 0.10411754f * att::wave_max_f(a) * att::wave_max_f(c);
      float e = 0.f, f = 0.f;
      for (int j = ln; j < 128; j += 64) { e = fmaxf(e, fabsf(p.fox_qg[j])); f = fmaxf(f, fabsf(p.fox_kg[j])); }
      fox_bound = 128.f * 0.12751743f * att::wave_max_f(e) * att::wave_max_f(f); const float bf = 1.02f * fox_bound;
      nomax_mla = bm <= 80.f; nomax_fox = bf <= 80.f; }
    REP(3) for (int L = b; L < 1024; L += G) {
        const int i = L >> 8, vc = L & 255, vcx = (vc & 7) * 32 + (vc >> 3), hh = vcx >> 4, x = vcx & 15, qbk = (i & 1) ? x : 31 - x;
        if (i < 2) { if (nomax_mla) att::attn_block<192, false, true>(smem, (const att::bf16_t*)((const unsigned char*)p.qa + hh * 192), 3072, (const att::bf16_t*)((const unsigned char*)p.ka + hh * 192), 3072, (const att::bf16_t*)((const unsigned char*)p.va + hh * 128), 2048, nullptr, p.merged + hh * 128, p.attout + hh * 128, qbk, 0.f, p.peer_u, p.peer_v, p.U8, p.V8, side_next); else att::attn_block<192, false, false>(smem, (const att::bf16_t*)((const unsigned char*)p.qa + hh * 192), 3072, (const att::bf16_t*)((const unsigned char*)p.ka + hh * 192), 3072, (const att::bf16_t*)((const unsigned char*)p.va + hh * 128), 2048, nullptr, p.merged + hh * 128, p.attout + hh * 128, qbk, 0.f, p.peer_u, p.peer_v, p.U8, p.V8, side_next); }
        else { if (nomax_fox) att::attn_block<128, true, true>(smem, (const att::bf16_t*)((const unsigned char*)p.fq + hh * 128), 2048, (const att::bf16_t*)((const unsigned char*)p.fk + hh * 128), 2048, (const att::bf16_t*)((const unsigned char*)p.fv + hh * 128), 2048, p.F + (size_t)hh * S, p.merged + 2048 + hh * 128, p.attout + 2048 + hh * 128, qbk, fox_bound, p.peer_u, p.peer_v, p.U8, p.V8, side_next); else att::attn_block<128, true, false>(smem, (const att::bf16_t*)((const unsigned char*)p.fq + hh * 128), 2048, (const att::bf16_t*)((const unsigned char*)p.fk + hh * 128), 2048, (const att::bf16_t*)((const unsigned char*)p.fv + hh * 128), 2048, p.F + (size_t)hh * S, p.merged + 2048 + hh * 128, p.attout + 2048 + hh * 128, qbk, fox_bound, p.peer_u, p.peer_v, p.U8, p.V8, side_next); }
    }
    if (G == 256) { PHASE_IDS(); (void)wave;
        for (; side_next < 32; ++side_next) { const bool isv = side_next >= 16;
            fp6_cvt_rows(isv ? p.peer_v : p.peer_u, isv ? p.V8 : p.U8, b * 64 + (side_next & 15) * 4, 4, isv ? V_SCALE : U_SCALE, tid, 512); } }
    else { PHASE_IDS(); (void)wave; fp6_cvt_rows(p.peer_u, p.U8, 0, 16384, U_SCALE, b * 512 + tid, G * 512); fp6_cvt_rows(p.peer_v, p.V8, 0, 16384, V_SCALE, b * 512 + tid, G * 512); }
    xcd_barrier(bar);
    REP(4) {
        pg8::Gemm g{p.attout, p.WoT, S, 2048, 4096}; pg8::StaticOrder so; so.init(S, 2048, G, b);
        pg8::EpiX1 E{p.x1, p.x, p.xg, p.ffn_g, p.ssq2};
        pg8::gemm_phase<pg8::EpiX1, pg8::StaticOrder, true, true>(lds, g, so, E);
    }
    xcd_barrier(bar);
    REP(5) {
        pg8::Gemm g{p.xg, p.WpT, S, 2048, 2048}; pg8::StaticOrder so; so.init(S, 2048, G, b);
        pg8::EpiScores E{p.scores, p.ssq2};
        pg8::gemm_phase<pg8::EpiScores, pg8::StaticOrder, true, true>(lds, g, so, E);
    }
    xcd_barrier(bar);
    REP(6) for (int g = b; g < S / 32; g += G) peer_group(smem, g, p.scores, p.xg, p.ssq2, p.x1, p.U8, p.V8, p.out);
    __syncthreads();
    { volatile LAS unsigned* xf = (volatile LAS unsigned*)((LAS unsigned char*)smem + 131072 + 32);
      if (threadIdx.x == 0) { const unsigned old = xb_add(&g_bar[XB_EXIT], 1u); xf[0] = (old + 1u == (unsigned)G) ? 1u : 0u; }
      __syncthreads();
      if (xf[0]) { for (int i = threadIdx.x; i < 4096; i += 512) __hip_atomic_store(&g_bar[i], 0u, __ATOMIC_RELAXED, __HIP_MEMORY_SCOPE_AGENT); } }
}

extern "C" void kernel_launch(void* const* d_in, const int* in_sizes, int n_in,
                              void* d_out, int out_size, void* d_ws, size_t ws_size,
                              hipStream_t stream) {
    if (ws_size < 512 * MiB) { fprintf(stderr, "kernel_launch: workspace too small (%zu)\n", ws_size); return; }
    Params p{};
    p.x = (const float*)d_in[0]; p.pos = (const int*)d_in[1]; p.mix_g = (const float*)d_in[2]; p.w_in = (const float*)d_in[3];
    p.b_forget = (const float*)d_in[4]; p.b_gate = (const float*)d_in[5]; p.q_lat_g = (const float*)d_in[6]; p.w_q_up = (const float*)d_in[7];
    p.kv_lat_g = (const float*)d_in[8]; p.w_kv_up = (const float*)d_in[9]; p.mla_qg = (const float*)d_in[10]; p.mla_kg = (const float*)d_in[11];
    p.fox_qg = (const float*)d_in[12]; p.fox_kg = (const float*)d_in[13]; p.w_out = (const float*)d_in[14]; p.ffn_g = (const float*)d_in[15];
    p.w_peer_q = (const float*)d_in[16]; p.sub_keys = (const float*)d_in[17]; p.peer_u = (const float*)d_in[18]; p.peer_v = (const float*)d_in[19];
    p.out = (float*)d_out;
    char* ws = (char*)d_ws;
    p.WqT = (bf16_t*)(ws + 1 * MiB); p.WkvT = (bf16_t*)(ws + 5 * MiB); p.WoT = (bf16_t*)(ws + 9 * MiB); p.WpT = (bf16_t*)(ws + 25 * MiB); p.WinT = (bf16_t*)(ws + 33 * MiB);
    p.h = (bf16_t*)(ws + 78 * MiB); p.cq = (bf16_t*)(ws + 110 * MiB); p.ckv = (bf16_t*)(ws + 118 * MiB);
    p.fq = (bf16_t*)(ws + 126 * MiB); p.fk = (bf16_t*)(ws + 158 * MiB); p.fv = (bf16_t*)(ws + 190 * MiB); p.merged = (unsigned char*)(ws + 222 * MiB);
    p.kpe = (bf16_t*)(ws + 286 * MiB); p.lf = (float*)(ws + 287 * MiB); p.F = (float*)(ws + 287 * MiB + 512 * 1024);
    p.qa = (bf16_t*)(ws + 288 * MiB); p.va = (bf16_t*)(ws + 336 * MiB); p.ka = (bf16_t*)(ws + 400 * MiB); p.x1 = (float*)(ws + 126 * MiB);
    p.scores = (float*)(ws + 222 * MiB);
    p.ctl = (unsigned*)ws;
    p.ropeT = (float2*)(ws + 448 * MiB);
    p.ssq = (float*)(ws + 64 * 1024);
    p.attout = (bf16_t*)(ws + 33 * MiB);
    p.U8 = (unsigned char*)(ws + 450 * MiB); p.V8 = (unsigned char*)(ws + 368 * MiB);
    p.xg = (bf16_t*)(ws + 190 * MiB);
    p.ssq2 = (float*)(ws + 482 * MiB);

    static int grid_blocks = 0;
    if (!grid_blocks) {
        if (hipFuncSetAttribute((const void*)mega, hipFuncAttributeMaxDynamicSharedMemorySize, LDS_BYTES) != hipSuccess) { fprintf(stderr, "hipFuncSetAttribute failed\n"); return; }
        int dev = 0, cus = 0, per_cu = 0;
        (void)hipGetDevice(&dev);
        (void)hipDeviceGetAttribute(&cus, hipDeviceAttributeMultiprocessorCount, dev);
        (void)hipOccupancyMaxActiveBlocksPerMultiprocessor(&per_cu, (const void*)mega, 512, LDS_BYTES);
        if (per_cu < 1 || cus < 1) { fprintf(stderr, "occupancy query says %d blocks/CU on %d CUs\n", per_cu, cus); return; }
        grid_blocks = cus;
    }
    void* args[] = {&p};
    hipError_t e = hipLaunchCooperativeKernel((const void*)mega, dim3(grid_blocks), dim3(512), args, LDS_BYTES, stream);
    if (e != hipSuccess) fprintf(stderr, "cooperative launch failed: %s (grid %d)\n", hipGetErrorString(e), grid_blocks);
}
```
